# Optimizing an MI355X kernel written in HIP

```python
import jax, jax.numpy as jnp
from jax import lax
import numpy as np

D_MODEL = 1024
BATCH = 1
SEQ = 16384
DEPTH = 2

HEAD_DIM = 64
MIX_WIDTH = D_MODEL
FOX_HEADS = MIX_WIDTH // (2 * HEAD_DIM)
DSA_HEADS = MIX_WIDTH // (2 * HEAD_DIM)
MOBA_HEADS = MIX_WIDTH // HEAD_DIM
FOX_W = FOX_HEADS * HEAD_DIM
DSA_W = DSA_HEADS * HEAD_DIM
MOBA_W = MOBA_HEADS * HEAD_DIM
ROT_DIM = HEAD_DIM // 4
ROPE_THETA = 500000.0
Q_BLOCK = 128
IDX_HEADS = 8
IDX_DIM = 64
DSA_TOPK = 256
MOBA_BLOCK = 256
MOBA_TOPK = 3
MOBA_Q_CHUNK = 64
MEM_TOKENS = 256
MEM_HEADS = 4
MEM_HEAD_DIM = 64
MEM_W = MEM_HEADS * MEM_HEAD_DIM
D_FF = 2816
RMS_EPS = 1e-6

EVEN_SPLITS = (FOX_W, FOX_W, FOX_W, FOX_HEADS,
               DSA_W, DSA_W, DSA_W,
               IDX_HEADS * IDX_DIM, IDX_DIM, IDX_HEADS)
EVEN_IN = sum(EVEN_SPLITS)
EVEN_OFFSETS = tuple(sum(EVEN_SPLITS[:i + 1]) for i in range(len(EVEN_SPLITS) - 1))

kernel_name = 'hybrid_fox_dsa_moba_macaron'


def rms_norm(x, g):
    xf = x.astype(jnp.float32)
    y = xf * lax.rsqrt(jnp.mean(xf * xf, axis=-1, keepdims=True) + RMS_EPS)
    return (y * g.astype(jnp.float32)).astype(x.dtype)


def rope_tables(seq):
    pos = jnp.arange(seq, dtype=jnp.float32)
    inv = ROPE_THETA ** (-jnp.arange(0, ROT_DIM, 2, dtype=jnp.float32) / ROT_DIM)
    ang = pos[:, None] * inv[None, :]
    return jnp.cos(ang), jnp.sin(ang)


def partial_rope(x, cos, sin):
    half = ROT_DIM // 2
    c = cos[None, :, None, :]
    s = sin[None, :, None, :]
    x1 = x[..., :half].astype(jnp.float32)
    x2 = x[..., half:ROT_DIM].astype(jnp.float32)
    rot = jnp.concatenate([x1 * c - x2 * s, x2 * c + x1 * s], axis=-1).astype(x.dtype)
    return jnp.concatenate([rot, x[..., ROT_DIM:]], axis=-1)


def swiglu_ffn(h, g, w_in, w_out):
    a, b = jnp.split(rms_norm(h, g) @ w_in, 2, axis=-1)
    return (jax.nn.silu(a) * b) @ w_out


def forgetting_attention(q, k, v, log_f):
    B, S, H, Dh = q.shape
    nblk = S // Q_BLOCK
    scale = Dh ** -0.5
    F = jnp.cumsum(log_f, axis=1)
    Fk = F.transpose(0, 2, 1)[:, :, None, :]
    qb = jnp.moveaxis(q.reshape(B, nblk, Q_BLOCK, H, Dh), 1, 0)
    Fq = jnp.moveaxis(F.reshape(B, nblk, Q_BLOCK, H), 1, 0)
    kpos = jnp.arange(S)

    def one_block(args):
        i, q_blk, fq_blk = args
        qpos = i * Q_BLOCK + jnp.arange(Q_BLOCK)
        s = jnp.einsum('bqhd,bkhd->bhqk', q_blk, k, preferred_element_type=jnp.float32) * scale
        s = s + fq_blk.transpose(0, 2, 1)[..., None] - Fk
        s = jnp.where(kpos[None, :] <= qpos[:, None], s, -jnp.inf)
        p = jax.nn.softmax(s, axis=-1)
        return jnp.einsum('bhqk,bkhd->bqhd', p.astype(v.dtype), v)

    out = lax.map(one_block, (jnp.arange(nblk), qb, Fq))
    return jnp.moveaxis(out, 0, 1).reshape(B, S, H, Dh)


def dsa_attention(q, k, v, iq, ik, iw):
    B, S, H, Dh = q.shape
    nblk = S // Q_BLOCK
    topk = min(DSA_TOPK, S // 4)
    scale = Dh ** -0.5
    qb = jnp.moveaxis(q.reshape(B, nblk, Q_BLOCK, H, Dh), 1, 0)
    iqb = jnp.moveaxis(iq.reshape(B, nblk, Q_BLOCK, IDX_HEADS, IDX_DIM), 1, 0)
    iwb = jnp.moveaxis(iw.reshape(B, nblk, Q_BLOCK, IDX_HEADS), 1, 0)
    kpos = jnp.arange(S)
    bidx = jnp.arange(B)[:, None, None]

    def one_block(args):
        i, q_blk, iq_blk, iw_blk = args
        qpos = i * Q_BLOCK + jnp.arange(Q_BLOCK)
        dots = jnp.einsum('bqhd,bkd->bqhk', iq_blk, ik, preferred_element_type=jnp.float32) * (IDX_DIM ** -0.5)
        w = iw_blk.astype(jnp.float32) * (IDX_HEADS ** -0.5)
        score = jnp.einsum('bqh,bqhk->bqk', w, jax.nn.relu(dots))
        score = jnp.where(kpos[None, None, :] <= qpos[None, :, None], score, -jnp.inf)
        _, sel = lax.top_k(score, topk)
        valid = sel <= qpos[None, :, None]
        ks = k[bidx, sel]
        vs = v[bidx, sel]
        s = jnp.einsum('bqhd,bqkhd->bhqk', q_blk, ks, preferred_element_type=jnp.float32) * scale
        s = jnp.where(valid[:, None], s, -jnp.inf)
        p = jax.nn.softmax(s, axis=-1)
        return jnp.einsum('bhqk,bqkhd->bqhd', p.astype(vs.dtype), vs)

    out = lax.map(one_block, (jnp.arange(nblk), qb, iqb, iwb))
    return jnp.moveaxis(out, 0, 1).reshape(B, S, H, Dh)


def moba_attention(q, k, v):
    B, S, H, Dh = q.shape
    scale = Dh ** -0.5
    nb = -(-S // MOBA_BLOCK)
    pad = ((0, 0), (0, nb * MOBA_BLOCK - S), (0, 0), (0, 0))
    kp = jnp.pad(k, pad)
    vp = jnp.pad(v, pad)
    kb = kp.reshape(B, nb, MOBA_BLOCK, H, Dh).transpose(0, 1, 3, 2, 4)
    vb = vp.reshape(B, nb, MOBA_BLOCK, H, Dh).transpose(0, 1, 3, 2, 4)
    kmean = jnp.mean(kb.astype(jnp.float32), axis=3)
    n_sel = min(MOBA_TOPK, nb - 1)
    nchunk = S // MOBA_Q_CHUNK
    qc = jnp.moveaxis(q.reshape(B, nchunk, MOBA_Q_CHUNK, H, Dh), 1, 0)
    bidx = jnp.arange(B)[:, None, None, None]
    hidx = jnp.arange(H)[None, None, :, None]
    blk_ids = jnp.arange(nb)

    def one_chunk(args):
        i, q_c = args
        start = i * MOBA_Q_CHUNK
        qpos = start + jnp.arange(MOBA_Q_CHUNK)
        own = start // MOBA_BLOCK
        k_own = lax.dynamic_slice_in_dim(kp, own * MOBA_BLOCK, MOBA_BLOCK, axis=1)
        v_own = lax.dynamic_slice_in_dim(vp, own * MOBA_BLOCK, MOBA_BLOCK, axis=1)
        own_pos = own * MOBA_BLOCK + jnp.arange(MOBA_BLOCK)
        s_own = jnp.einsum('bqhd,bkhd->bhqk', q_c, k_own, preferred_element_type=jnp.float32) * scale
        s_own = jnp.where(own_pos[None, :] <= qpos[:, None], s_own, -jnp.inf)
        if n_sel == 0:
            p = jax.nn.softmax(s_own, axis=-1)
            return jnp.einsum('bhqk,bkhd->bqhd', p.astype(v_own.dtype), v_own)
        gate = jnp.einsum('bqhd,bnhd->bqhn', q_c.astype(jnp.float32), kmean)
        gate = jnp.where(blk_ids < own, gate, -jnp.inf)
        _, sel = lax.top_k(gate, n_sel)
        valid = (sel < own).transpose(0, 2, 1, 3)[..., None]
        ks = kb[bidx, sel, hidx]
        vs = vb[bidx, sel, hidx]
        s_sel = jnp.einsum('bqhd,bqhnkd->bhqnk', q_c, ks, preferred_element_type=jnp.float32) * scale
        s_sel = jnp.where(valid, s_sel, -jnp.inf).reshape(B, H, MOBA_Q_CHUNK, n_sel * MOBA_BLOCK)
        p = jax.nn.softmax(jnp.concatenate([s_sel, s_own], axis=-1), axis=-1)
        p_sel = p[..., :n_sel * MOBA_BLOCK].reshape(B, H, MOBA_Q_CHUNK, n_sel, MOBA_BLOCK)
        p_own = p[..., n_sel * MOBA_BLOCK:]
        return (jnp.einsum('bhqnk,bqhnkd->bqhd', p_sel.astype(vs.dtype), vs)
                + jnp.einsum('bhqk,bkhd->bqhd', p_own.astype(v_own.dtype), v_own))

    out = lax.map(one_chunk, (jnp.arange(nchunk), qc))
    return jnp.moveaxis(out, 0, 1).reshape(B, S, H, Dh)


def fox_dsa_heads(hn, w_in, b_forget, fox_qn, fox_kn, dsa_qn, dsa_kn, cos, sin):
    B, S, _ = hn.shape
    fq, fk, fv, f_logit, dq, dk, dv, iq, ik, iw = jnp.split(hn @ w_in, EVEN_OFFSETS, axis=-1)
    fq = rms_norm(fq.reshape(B, S, FOX_HEADS, HEAD_DIM), fox_qn)
    fk = rms_norm(fk.reshape(B, S, FOX_HEADS, HEAD_DIM), fox_kn)
    fv = fv.reshape(B, S, FOX_HEADS, HEAD_DIM)
    log_f = jax.nn.log_sigmoid(f_logit.astype(jnp.float32) + b_forget.astype(jnp.float32))
    fox_out = forgetting_attention(fq, fk, fv, log_f)
    dq = partial_rope(rms_norm(dq.reshape(B, S, DSA_HEADS, HEAD_DIM), dsa_qn), cos, sin)
    dk = partial_rope(rms_norm(dk.reshape(B, S, DSA_HEADS, HEAD_DIM), dsa_kn), cos, sin)
    dv = dv.reshape(B, S, DSA_HEADS, HEAD_DIM)
    iq = partial_rope(iq.reshape(B, S, IDX_HEADS, IDX_DIM), cos, sin)
    ik = partial_rope(ik.reshape(B, S, 1, IDX_DIM), cos, sin)[:, :, 0]
    dsa_out = dsa_attention(dq, dk, dv, iq, ik, iw)
    return jnp.concatenate([fox_out.reshape(B, S, FOX_W), dsa_out.reshape(B, S, DSA_W)], axis=-1)


def moba_heads(hn, w_in, moba_qn, moba_kn, cos, sin):
    B, S, _ = hn.shape
    q, k, v = jnp.split(hn @ w_in, 3, axis=-1)
    q = partial_rope(rms_norm(q.reshape(B, S, MOBA_HEADS, HEAD_DIM), moba_qn), cos, sin)
    k = partial_rope(rms_norm(k.reshape(B, S, MOBA_HEADS, HEAD_DIM), moba_kn), cos, sin)
    v = v.reshape(B, S, MOBA_HEADS, HEAD_DIM)
    return moba_attention(q, k, v).reshape(B, S, MOBA_W)


def memory_cross_attention(h, mem, g_x, g_m, wq, wkv, qn, kn, wo):
    B, S, _ = h.shape
    M = mem.shape[1]
    q = rms_norm((rms_norm(h, g_x) @ wq).reshape(B, S, MEM_HEADS, MEM_HEAD_DIM), qn)
    k, v = jnp.split(rms_norm(mem, g_m) @ wkv, 2, axis=-1)
    k = rms_norm(k.reshape(B, M, MEM_HEADS, MEM_HEAD_DIM), kn)
    v = v.reshape(B, M, MEM_HEADS, MEM_HEAD_DIM)
    s = jnp.einsum('bqhd,bkhd->bhqk', q, k, preferred_element_type=jnp.float32) * (MEM_HEAD_DIM ** -0.5)
    p = jax.nn.softmax(s, axis=-1)
    o = jnp.einsum('bhqk,bkhd->bqhd', p.astype(v.dtype), v)
    return o.reshape(B, S, MEM_W) @ wo


def setup_inputs(seed: int = 0) -> dict:
    key = jax.random.key(seed)
    ks = jax.random.split(key, 32)
    n_even = (DEPTH + 1) // 2
    n_odd = DEPTH // 2

    def dense(k, shape, fan_in):
        return jax.random.normal(k, shape, jnp.float32) * (fan_in ** -0.5)

    def gain(k, shape):
        return 1.0 + 0.02 * jax.random.normal(k, shape, jnp.float32)

    return {
        'x': jax.random.normal(ks[0], (BATCH, SEQ, D_MODEL), jnp.float32),
        'mem': jax.random.normal(ks[1], (BATCH, MEM_TOKENS, D_MODEL), jnp.float32),
        'ffn1_norm': gain(ks[2], (DEPTH, D_MODEL)),
        'ffn1_w_in': dense(ks[3], (DEPTH, D_MODEL, 2 * D_FF), D_MODEL),
        'ffn1_w_out': dense(ks[4], (DEPTH, D_FF, D_MODEL), D_FF),
        'mix_norm': gain(ks[5], (DEPTH, D_MODEL)),
        'even_w_in': dense(ks[6], (n_even, D_MODEL, EVEN_IN), D_MODEL),
        'even_b_forget': jax.random.uniform(ks[7], (n_even, FOX_HEADS), jnp.float32, 1.0, 5.0),
        'fox_q_norm': gain(ks[8], (n_even, HEAD_DIM)),
        'fox_k_norm': gain(ks[9], (n_even, HEAD_DIM)),
        'dsa_q_norm': gain(ks[10], (n_even, HEAD_DIM)),
        'dsa_k_norm': gain(ks[11], (n_even, HEAD_DIM)),
        'odd_w_in': dense(ks[12], (n_odd, D_MODEL, 3 * MOBA_W), D_MODEL),
        'moba_q_norm': gain(ks[13], (n_odd, HEAD_DIM)),
        'moba_k_norm': gain(ks[14], (n_odd, HEAD_DIM)),
        'mix_w_out': dense(ks[15], (DEPTH, MIX_WIDTH, D_MODEL), MIX_WIDTH),
        'mem_norm_x': gain(ks[16], (DEPTH, D_MODEL)),
        'mem_norm_m': gain(ks[17], (DEPTH, D_MODEL)),
        'mem_wq': dense(ks[18], (DEPTH, D_MODEL, MEM_W), D_MODEL),
        'mem_wkv': dense(ks[19], (DEPTH, D_MODEL, 2 * MEM_W), D_MODEL),
        'mem_q_norm': gain(ks[20], (DEPTH, MEM_HEAD_DIM)),
        'mem_k_norm': gain(ks[21], (DEPTH, MEM_HEAD_DIM)),
        'mem_wo': dense(ks[22], (DEPTH, MEM_W, D_MODEL), MEM_W),
        'ffn2_norm': gain(ks[23], (DEPTH, D_MODEL)),
        'ffn2_w_in': dense(ks[24], (DEPTH, D_MODEL, 2 * D_FF), D_MODEL),
        'ffn2_w_out': dense(ks[25], (DEPTH, D_FF, D_MODEL), D_FF),
    }


def reference(x, mem, ffn1_norm, ffn1_w_in, ffn1_w_out, mix_norm, even_w_in, even_b_forget,
              fox_q_norm, fox_k_norm, dsa_q_norm, dsa_k_norm, odd_w_in, moba_q_norm, moba_k_norm,
              mix_w_out, mem_norm_x, mem_norm_m, mem_wq, mem_wkv, mem_q_norm, mem_k_norm, mem_wo,
              ffn2_norm, ffn2_w_in, ffn2_w_out):
    cos, sin = rope_tables(x.shape[1])
    h = x
    for layer in range(DEPTH):
        h = h + 0.5 * swiglu_ffn(h, ffn1_norm[layer], ffn1_w_in[layer], ffn1_w_out[layer])
        hn = rms_norm(h, mix_norm[layer])
        if layer % 2 == 0:
            e = layer // 2
            mixed = fox_dsa_heads(hn, even_w_in[e], even_b_forget[e], fox_q_norm[e], fox_k_norm[e],
                                  dsa_q_norm[e], dsa_k_norm[e], cos, sin)
        else:
            o = layer // 2
            mixed = moba_heads(hn, odd_w_in[o], moba_q_norm[o], moba_k_norm[o], cos, sin)
        h = h + mixed @ mix_w_out[layer]
        h = h + memory_cross_attention(h, mem, mem_norm_x[layer], mem_norm_m[layer], mem_wq[layer],
                                       mem_wkv[layer], mem_q_norm[layer], mem_k_norm[layer], mem_wo[layer])
        h = h + 0.5 * swiglu_ffn(h, ffn2_norm[layer], ffn2_w_in[layer], ffn2_w_out[layer])
    return h
```

```cpp
#include <hip/hip_runtime.h>
#include <cstdio>
#include <cstdint>

template <int M> __device__ __forceinline__ int shx_i(int v) {
    if constexpr (M == 1) return __builtin_amdgcn_mov_dpp(v, 0xB1, 0xF, 0xF, true);
    else if constexpr (M == 2) return __builtin_amdgcn_mov_dpp(v, 0x4E, 0xF, 0xF, true);
    else return __builtin_amdgcn_ds_swizzle(v, (M << 10) | 0x1f);
}
template <int M> __device__ __forceinline__ float shx(float v) { return __int_as_float(shx_i<M>(__float_as_int(v))); }
__device__ __forceinline__ float sh32_sum(float v) { auto r = __builtin_amdgcn_permlane32_swap(__float_as_uint(v), __float_as_uint(v), false, false); return __uint_as_float(r[0]) + __uint_as_float(r[1]); }
__device__ __forceinline__ float sh32_max(float v) { auto r = __builtin_amdgcn_permlane32_swap(__float_as_uint(v), __float_as_uint(v), false, false); return fmaxf(__uint_as_float(r[0]), __uint_as_float(r[1])); }
__device__ __forceinline__ int sum32_i(int c) { c += shx_i<1>(c); c += shx_i<2>(c); c += shx_i<4>(c); c += shx_i<8>(c); c += shx_i<16>(c); return c; }
namespace pg8 {
#define PG8_LAS __attribute__((address_space(3)))
typedef unsigned short bf16_t;
typedef short bf16x8 __attribute__((ext_vector_type(8)));
typedef float f32x4 __attribute__((ext_vector_type(4)));
typedef unsigned u32x4 __attribute__((ext_vector_type(4)));
constexpr int BM = 256, BK = 64, HALF = 128, HTB = HALF * BK * 2  , STAGE_BYTES = 8 * HTB, NXCD = 8, WGM = 8;

__host__ __device__ __forceinline__ int lds_byte(int r, int c) { const int st = (r >> 4) * 2 + (c >> 5), rr = r & 15, cc = c & 31, ob = rr * 64 + cc * 2; return st * 1024 + (ob ^ (((ob >> 9) & 1) << 5)); }
__host__ __device__ __forceinline__ void stage_rc(int b, int& R, int& C) { const int st = b / 1024, sb = b % 1024, swz = sb ^ (((sb >> 9) & 1) << 5); R = (st >> 1) * 16 + swz / 64; C = (st & 1) * 32 + (swz % 64) / 2; }
__host__ __device__ __forceinline__ int perm32(int rho) { const int n = rho >> 4, i = rho & 15; return 8 * (i >> 2) + 4 * n + (i & 3); }

struct Unit { int pm, pn; };
struct Gemm { const bf16_t* A; const bf16_t* Bt; int M, N, K, lda; };

struct StaticOrder {
    int nM, nN, nwg, G, c;
    __host__ __device__ void init(int M, int N, int G_, int c_) { nM = M / BM; nN = N / BM; nwg = nM * nN; G = G_; c = c_; }
    __host__ __device__ bool next(int i, Unit& u) const {
        const long L = (long)i * G + c; if (L >= nwg) return false;
        int wgid = (int)L; { const int q = nwg / NXCD, r = nwg % NXCD, xcd = wgid % NXCD, off = wgid / NXCD; wgid = (xcd < r ? xcd * (q + 1) : r * (q + 1) + (xcd - r) * q) + off; }
        const int nig = WGM * nN, gid = wgid / nig, fm = gid * WGM, gsz = (nM - fm) < WGM ? (nM - fm) : WGM;
        u.pm = fm + ((wgid % nig) % gsz); u.pn = (wgid % nig) / gsz; return true;
    }
    __device__ __forceinline__ void a_ready(const Unit&) const {}
    __device__ __forceinline__ void done(const Unit&) const {}
};

__device__ __forceinline__ unsigned cvt_pk_bf16(float lo, float hi) { unsigned r; asm volatile("v_cvt_pk_bf16_f32 %0, %1, %2" : "=v"(r) : "v"(lo), "v"(hi)); return r; }
typedef float f32x2 __attribute__((ext_vector_type(2)));
constexpr float RMS_EPS_F = 1e-6f;
__device__ __forceinline__ float silu_f(float x) { return x * __builtin_amdgcn_rcpf(1.0f + __builtin_amdgcn_exp2f(-1.4426950408889634f * x)); }
__device__ __forceinline__ float row_rstd(const float* ssq, int row) {
    const f32x4* p = (const f32x4*)(ssq + (size_t)row * 16); const f32x4 a = p[0], b = p[1], c = p[2], d = p[3];
    const float s = ((a[0] + a[1]) + (a[2] + a[3])) + ((b[0] + b[1]) + (b[2] + b[3])) + ((c[0] + c[1]) + (c[2] + c[3])) + ((d[0] + d[1]) + (d[2] + d[3]));
    return rsqrtf(s * (1.0f / 1024.0f) + RMS_EPS_F); }

struct EpiSwiGLU {
    static constexpr bool PERM = true, AFTER_DRAIN = false;
    bf16_t* U; const float* ssq; int ldu;
    __device__ __forceinline__ void operator()(const f32x4 (&acc)[2][2][4][2], const Unit& u, int wr, int wc, int fr, int fq) const {
        const int row0 = u.pm * BM + wr * 64 + fr, col0 = u.pn * HALF + wc * 32 + 8 * fq;
#pragma unroll
        for (int ai = 0; ai < 2; ++ai)
#pragma unroll
            for (int m = 0; m < 4; ++m) {
                const int row = row0 + ai * HALF + m * 16; const float r = row_rstd(ssq, row);
                const f32x4 a0 = acc[ai][0][m][0] * r, a1 = acc[ai][0][m][1] * r, b0 = acc[ai][1][m][0] * r, b1 = acc[ai][1][m][1] * r;
                u32x4 w;
                w.x = cvt_pk_bf16(silu_f(a0[0]) * b0[0], silu_f(a0[1]) * b0[1]); w.y = cvt_pk_bf16(silu_f(a0[2]) * b0[2], silu_f(a0[3]) * b0[3]);
                w.z = cvt_pk_bf16(silu_f(a1[0]) * b1[0], silu_f(a1[1]) * b1[1]); w.w = cvt_pk_bf16(silu_f(a1[2]) * b1[2], silu_f(a1[3]) * b1[3]);
                *(u32x4*)(U + (size_t)row * ldu + col0) = w;
            }
    }
};
struct EpiResid {
    static constexpr bool PERM = true, AFTER_DRAIN = false;
    float* H; bf16_t* HB; float* ssq_out; float scale;
    __device__ __forceinline__ void operator()(const f32x4 (&acc)[2][2][4][2], const Unit& u, int wr, int wc, int fr, int fq) const {
        const int row0 = u.pm * BM + wr * 64 + fr, col0 = u.pn * BM + wc * 32 + 8 * fq;
#pragma unroll
        for (int ai = 0; ai < 2; ++ai)
#pragma unroll
            for (int m = 0; m < 4; ++m) {
                const int row = row0 + ai * HALF + m * 16; float sq = 0.f;
#pragma unroll
                for (int bj = 0; bj < 2; ++bj) {
                    float* hp = H + (size_t)row * 1024 + col0 + bj * HALF;
                    f32x4 h0 = *(const f32x4*)hp, h1 = *(const f32x4*)(hp + 4);
                    h0 = h0 + acc[ai][bj][m][0] * scale; h1 = h1 + acc[ai][bj][m][1] * scale;
                    *(f32x4*)hp = h0; *(f32x4*)(hp + 4) = h1;
                    sq += (h0[0] * h0[0] + h0[1] * h0[1]) + (h0[2] * h0[2] + h0[3] * h0[3]) + (h1[0] * h1[0] + h1[1] * h1[1]) + (h1[2] * h1[2] + h1[3] * h1[3]);
                    if (HB) { u32x4 w; w.x = cvt_pk_bf16(h0[0], h0[1]); w.y = cvt_pk_bf16(h0[2], h0[3]); w.z = cvt_pk_bf16(h1[0], h1[1]); w.w = cvt_pk_bf16(h1[2], h1[3]);
                        *(u32x4*)(HB + (size_t)row * 1024 + col0 + bj * HALF) = w; }
                }
                if (ssq_out) { sq += shx<16>(sq); sq = sh32_sum(sq); if (fq == 0) ssq_out[(size_t)row * 16 + u.pn * 4 + wc] = sq; }
            }
    }
};
struct EpiScale {
    static constexpr bool PERM = true, AFTER_DRAIN = false;
    bf16_t* O; int ldc; const float* ssq; int split_cols; size_t split_stride;
    __device__ __forceinline__ void operator()(const f32x4 (&acc)[2][2][4][2], const Unit& u, int wr, int wc, int fr, int fq) const {
        const int row0 = u.pm * BM + wr * 64 + fr; int colt = u.pn * BM; bf16_t* base = O;
        if (split_cols) { const int t = colt / split_cols; base += (size_t)t * split_stride; colt -= t * split_cols; }
        const int col0 = colt + wc * 32 + 8 * fq;
#pragma unroll
        for (int ai = 0; ai < 2; ++ai)
#pragma unroll
            for (int m = 0; m < 4; ++m) {
                const int row = row0 + ai * HALF + m * 16; const float r = row_rstd(ssq, row);
                bf16_t* rowp = base + (size_t)row * ldc + col0;
#pragma unroll
                for (int bj = 0; bj < 2; ++bj) { const f32x4 v0 = acc[ai][bj][m][0] * r, v1 = acc[ai][bj][m][1] * r;
                    u32x4 w; w.x = cvt_pk_bf16(v0[0], v0[1]); w.y = cvt_pk_bf16(v0[2], v0[3]); w.z = cvt_pk_bf16(v1[0], v1[1]); w.w = cvt_pk_bf16(v1[2], v1[3]);
                    *(u32x4*)(rowp + bj * HALF) = w; }
            }
    }
};
template <class Epi, class Sched, bool ALIGN_EPI = false, bool SP2 = false>
__device__ __forceinline__ void gemm_phase(PG8_LAS unsigned char* lds, const Gemm g, const Sched& S, const Epi& E, const int tid) {
    const int wid = __builtin_amdgcn_readfirstlane(tid >> 6), lane = tid & 63, wr = wid >> 2, wc = wid & 3, fr = lane & 15, fq = lane >> 4;
    const int K = g.K, nt = K / BK;
    unsigned voffA[2], voffB[2];
#pragma unroll
    for (int i = 0; i < 2; ++i) { int R, C; stage_rc(tid * 16 + i * 8192, R, C); const int Rb = Epi::PERM ? ((R & ~31) + perm32(R & 31)) : R;
        voffA[i] = (unsigned)(R * g.lda + C) * 2u; voffB[i] = (unsigned)(Rb * K + C) * 2u; }
    const size_t kstep = (size_t)(BK * 2);
    const size_t hstepA = (size_t)HALF * g.lda * 2, hstepB = (size_t)HALF * K * 2;
    const size_t tstepA = 2 * hstepA, tstepB = 2 * hstepB;
    const unsigned ldsw = (unsigned)wid * 1024u;
    const int aoff = lds_byte(wr * 64 + fr, fq * 8), boff = lds_byte(wc * 32 + fr, fq * 8);
#define PG8_SA(b, h) (((b) * 2 + (h)) * HTB)
#define PG8_SB(b, h) ((4 + (b) * 2 + (h)) * HTB)
#define PG8_STAGE(bufoff, gbase, voff) do { _Pragma("unroll") for (int _i = 0; _i < 2; ++_i) \
        __builtin_amdgcn_global_load_lds((const unsigned*)((const char*)(gbase) + (voff)[_i]), (PG8_LAS unsigned*)(lds + (bufoff) + ldsw + _i * 8192), 16, 0, 0); } while (0)
#define PG8_LDA(dst, b, h) do { _Pragma("unroll") for (int m = 0; m < 4; ++m) _Pragma("unroll") for (int k = 0; k < 2; ++k) dst[m][k] = *(const PG8_LAS bf16x8*)(lds + PG8_SA(b, h) + aoff + m * 2048 + k * 1024); } while (0)
#define PG8_LDB(dst, b, h) do { _Pragma("unroll") for (int n = 0; n < 2; ++n) _Pragma("unroll") for (int k = 0; k < 2; ++k) dst[n][k] = *(const PG8_LAS bf16x8*)(lds + PG8_SB(b, h) + boff + n * 2048 + k * 1024); } while (0)
#define PG8_MMA(ai, bj, At, Bt) do { __builtin_amdgcn_s_setprio(1); _Pragma("unroll") for (int m = 0; m < 4; ++m) _Pragma("unroll") for (int n = 0; n < 2; ++n) _Pragma("unroll") for (int k = 0; k < 2; ++k) \
        acc[ai][bj][m][n] = __builtin_amdgcn_mfma_f32_16x16x32_bf16(Bt[n][k], At[m][k], acc[ai][bj][m][n], 0, 0, 0); __builtin_amdgcn_s_setprio(0); } while (0)
#define PG8_WAIT_V(n) asm volatile("s_waitcnt vmcnt(" #n ")" ::: "memory")
#define PG8_WAIT_L(n) asm volatile("s_waitcnt lgkmcnt(" #n ")" ::: "memory")
#define PG8_BAR __builtin_amdgcn_s_barrier()
#define PG8_SCHED __builtin_amdgcn_sched_barrier(0)
    Unit cur, nxt; int ui = 0;
    if (!S.next(0, cur)) return;
    f32x4 acc[2][2][4][2];
#pragma unroll
    for (int a = 0; a < 2; ++a)
#pragma unroll
        for (int b = 0; b < 2; ++b)
#pragma unroll
            for (int m = 0; m < 4; ++m)
#pragma unroll
                for (int n = 0; n < 2; ++n) acc[a][b][m][n] = (f32x4){0.f, 0.f, 0.f, 0.f};
    bf16x8 At[4][2], B0[2][2], B1[2][2];
    const char* cA = (const char*)g.A + (size_t)cur.pm * tstepA; const char* cB = (const char*)g.Bt + (size_t)cur.pn * tstepB;
    S.a_ready(cur);
    if constexpr (SP2) {
        PG8_STAGE(PG8_SB(0, 0), cB, voffB); PG8_STAGE(PG8_SB(0, 1), cB + hstepB, voffB); PG8_STAGE(PG8_SA(0, 0), cA, voffA); PG8_STAGE(PG8_SA(0, 1), cA + hstepA, voffA);
        if (wr == 1) PG8_BAR;
        PG8_WAIT_V(2); PG8_BAR;
        PG8_STAGE(PG8_SB(1, 0), cB + kstep, voffB); PG8_STAGE(PG8_SA(1, 0), cA + kstep, voffA); PG8_STAGE(PG8_SB(1, 1), cB + hstepB + kstep, voffB);
        PG8_WAIT_V(6); PG8_BAR;
    } else {
        PG8_STAGE(PG8_SB(0, 0), cB, voffB); PG8_STAGE(PG8_SA(0, 0), cA, voffA); PG8_STAGE(PG8_SB(0, 1), cB + hstepB, voffB); PG8_STAGE(PG8_SA(0, 1), cA + hstepA, voffA);
        if (wr == 1) PG8_BAR;
        PG8_WAIT_V(4); PG8_BAR;
        PG8_STAGE(PG8_SB(1, 0), cB + kstep, voffB); PG8_STAGE(PG8_SA(1, 0), cA + kstep, voffA); PG8_STAGE(PG8_SB(1, 1), cB + hstepB + kstep, voffB);
        PG8_WAIT_V(6); PG8_BAR;
    }
    for (;;) {
        const bool has_next = S.next(ui + 1, nxt);
        const char* nA = has_next ? (const char*)g.A + (size_t)nxt.pm * tstepA : cA; const char* nB = has_next ? (const char*)g.Bt + (size_t)nxt.pn * tstepB : cB;
        for (int t = 0; t < nt; t += 2) {
            const bool last = (t == nt - 2);
            const char* a1 = cA + (size_t)(t + 1) * kstep;
            const char* a2 = last ? nA : cA + (size_t)(t + 2) * kstep; const char* b2 = last ? nB : cB + (size_t)(t + 2) * kstep;
            const char* a3 = a2 + kstep; const char* b3 = b2 + kstep;
            if (last && has_next) S.a_ready(nxt);
            if constexpr (SP2) {
            PG8_LDB(B0, 0, 0); PG8_LDB(B1, 0, 1); PG8_SCHED; PG8_LDA(At, 0, 0); PG8_STAGE(PG8_SA(1, 1), a1 + hstepA, voffA);
            PG8_WAIT_V(8); PG8_WAIT_L(0); PG8_BAR; PG8_MMA(0, 0, At, B0); PG8_MMA(0, 1, At, B1); PG8_BAR; PG8_SCHED;
            PG8_LDA(At, 0, 1); PG8_STAGE(PG8_SB(0, 0), b2, voffB); PG8_STAGE(PG8_SB(0, 1), b2 + hstepB, voffB); PG8_STAGE(PG8_SA(0, 0), a2, voffA);
            PG8_WAIT_V(8); PG8_WAIT_L(0); PG8_BAR; PG8_MMA(1, 0, At, B0); PG8_MMA(1, 1, At, B1); PG8_BAR; PG8_SCHED;
            PG8_LDB(B0, 1, 0); PG8_LDB(B1, 1, 1); PG8_SCHED; PG8_LDA(At, 1, 0); PG8_STAGE(PG8_SA(0, 1), a2 + hstepA, voffA);
            PG8_WAIT_V(8); PG8_WAIT_L(0); PG8_BAR; PG8_MMA(0, 0, At, B0); PG8_MMA(0, 1, At, B1); PG8_BAR; PG8_SCHED;
            PG8_LDA(At, 1, 1); PG8_STAGE(PG8_SB(1, 0), b3, voffB); PG8_STAGE(PG8_SB(1, 1), b3 + hstepB, voffB); PG8_STAGE(PG8_SA(1, 0), a3, voffA);
            PG8_WAIT_V(8); PG8_WAIT_L(0); PG8_BAR; PG8_MMA(1, 0, At, B0); PG8_MMA(1, 1, At, B1); PG8_BAR; PG8_SCHED;
            } else {
            PG8_LDB(B0, 0, 0); PG8_SCHED; PG8_LDA(At, 0, 0); PG8_STAGE(PG8_SA(1, 1), a1 + hstepA, voffA);
            PG8_WAIT_L(8); PG8_BAR; PG8_WAIT_L(0); PG8_MMA(0, 0, At, B0); PG8_BAR; PG8_SCHED;
            PG8_LDB(B1, 0, 1); PG8_STAGE(PG8_SB(0, 0), b2, voffB);
            PG8_BAR; PG8_WAIT_L(0); PG8_MMA(0, 1, At, B1); PG8_BAR;
            PG8_LDA(At, 0, 1); PG8_STAGE(PG8_SA(0, 0), a2, voffA);
            PG8_BAR; PG8_WAIT_L(0); PG8_MMA(1, 0, At, B0); PG8_BAR; PG8_SCHED;
            PG8_STAGE(PG8_SB(0, 1), b2 + hstepB, voffB);
            PG8_WAIT_V(6); PG8_BAR; PG8_MMA(1, 1, At, B1); PG8_BAR;
            PG8_LDB(B0, 1, 0); PG8_SCHED; PG8_LDA(At, 1, 0); PG8_STAGE(PG8_SA(0, 1), a2 + hstepA, voffA);
            PG8_WAIT_L(8); PG8_BAR; PG8_WAIT_L(0); PG8_MMA(0, 0, At, B0); PG8_BAR; PG8_SCHED;
            PG8_LDB(B1, 1, 1); PG8_STAGE(PG8_SB(1, 0), b3, voffB);
            PG8_BAR; PG8_WAIT_L(0); PG8_MMA(0, 1, At, B1); PG8_BAR;
            PG8_LDA(At, 1, 1); PG8_STAGE(PG8_SA(1, 0), a3, voffA);
            PG8_BAR; PG8_WAIT_L(0); PG8_MMA(1, 0, At, B0); PG8_BAR; PG8_SCHED;
            PG8_STAGE(PG8_SB(1, 1), b3 + hstepB, voffB);
            PG8_WAIT_V(6); PG8_BAR; PG8_MMA(1, 1, At, B1); PG8_BAR;
            }
        }
        if constexpr (ALIGN_EPI) { if (wr == 0) PG8_BAR; }
        if constexpr (!Epi::AFTER_DRAIN) { E(acc, cur, wr, wc, fr, fq); S.done(cur); }
        if (!has_next) break;
#pragma unroll
        for (int a = 0; a < 2; ++a)
#pragma unroll
            for (int b = 0; b < 2; ++b)
#pragma unroll
                for (int m = 0; m < 4; ++m)
#pragma unroll
                    for (int n = 0; n < 2; ++n) acc[a][b][m][n] = (f32x4){0.f, 0.f, 0.f, 0.f};
        cur = nxt; cA = nA; cB = nB; ++ui;
        if constexpr (ALIGN_EPI) { if (wr == 1) PG8_BAR; }
    }
    PG8_WAIT_V(0);
    if constexpr (!ALIGN_EPI) { if (wr == 0) PG8_BAR; }
    PG8_BAR;
    if constexpr (Epi::AFTER_DRAIN) { E.fused(acc, cur, wr, wc, fr, fq, lds, wid, lane); S.done(cur); }
#undef PG8_SA
#undef PG8_SB
#undef PG8_STAGE
#undef PG8_LDA
#undef PG8_LDB
#undef PG8_MMA
#undef PG8_WAIT_V
#undef PG8_WAIT_L
#undef PG8_BAR
#undef PG8_SCHED
}
}

constexpr int S = 16384, DM = 1024, FF = 2816, FF2 = 5632, EVEN_SRC = 3664, EVEN_NP = 3840, ODD_N = 3072, NLAYER = 2, MEMT = 256, MEMW = 256;
constexpr float RMS_EPS = 1e-6f;
constexpr float LOG2E = 1.4426950408889634f;
constexpr float C2 = 0.125f * LOG2E;
constexpr int NWAVES = 8, NTHREADS = 512;
constexpr int EC_FQ = 0, EC_DQ = 512, EC_FK = 1024, EC_DK = 1536, EC_FV = 2048, EC_DV = 2560, EC_IQ = 3072, EC_IK = 3584;
constexpr int ES_FQ = 0, ES_FK = 512, ES_FV = 1024, ES_FL = 1536, ES_DQ = 1544, ES_DK = 2056, ES_DV = 2568, ES_IQ = 3080, ES_IK = 3592, ES_IW = 3656;

constexpr size_t MiB = 1u << 20;
constexpr size_t WS_CTL = 0, CTL_ZERO_BYTES = 1 * MiB;
constexpr size_t WS_SSQ = 1 * MiB;
constexpr size_t WS_KSUM = 6 * MiB;
constexpr size_t WS_ROPE = 2 * MiB;
constexpr size_t WS_FL = 3 * MiB;
constexpr size_t WS_MEMK = 4 * MiB;
constexpr size_t WS_IW = 5 * MiB;
constexpr size_t WS_W = 12 * MiB;
constexpr size_t WS_BIG = 60 * MiB;
constexpr size_t WS_HB = 224 * MiB;
constexpr size_t WS_END = 256 * MiB;
constexpr size_t W_FFN1_IN = 0, W_FFN1_OUT = 11 * MiB, W_MIX_IN = 17 * MiB, W_MIX_OUT = 25 * MiB, W_MEMQ = 27 * MiB, W_MEMO = 28 * MiB, W_FFN2_IN = 29 * MiB, W_FFN2_OUT = 40 * MiB;
constexpr size_t B_U = 0;
constexpr size_t B_PROJ = 0;
constexpr size_t B_VTF = 120 * MiB;
constexpr size_t B_IKC = 136 * MiB;
constexpr size_t B_VTM = 96 * MiB;
constexpr size_t B_QM = 140 * MiB, B_OM = 148 * MiB;
constexpr int CW_TMO = 0, CW_CODE = 1, CW_BAR = 4096;

constexpr int RING_BYTES = 131072;
constexpr int LDSCTL_OFF = RING_BYTES, MISC_OFF = LDSCTL_OFF + 320;
constexpr int LDS_BYTES = 147456;

#define GAS __attribute__((address_space(1)))
#define LAS __attribute__((address_space(3)))
typedef unsigned short bf16;
typedef unsigned v4u __attribute__((ext_vector_type(4)));
typedef float f32x4 __attribute__((ext_vector_type(4)));
typedef short bf16x8 __attribute__((ext_vector_type(8)));
typedef GAS unsigned gu32;
typedef GAS unsigned long long gu64;
#define RLX_AGENT __ATOMIC_RELAXED, __HIP_MEMORY_SCOPE_AGENT
#define LDS_WAIT() asm volatile("s_waitcnt lgkmcnt(0)" ::: "memory")
#define VM_WAIT() asm volatile("s_waitcnt vmcnt(0)" ::: "memory")
__device__ __forceinline__ unsigned long long rt() { return __builtin_amdgcn_s_memrealtime(); }
__device__ __forceinline__ unsigned f2bf(float f) { unsigned u = __builtin_bit_cast(unsigned, f); return (u + 0x7fffu + ((u >> 16) & 1u)) >> 16; }
__device__ __forceinline__ unsigned pk2(float lo, float hi) { return f2bf(lo) | (f2bf(hi) << 16); }

#define XB_TMO      128
#define XB_XCNT(j)  (256  + 64 * (j))
#define XB_XSUB(j)  (1280 + 64 * (j))
#define XB_XGEN(j)  (2304 + 64 * (j))
#define XB_TOP      3328
#define XB_TOPGEN   3392
#define XCD_BAR_WORDS 3456
#define XB_SPIN_CAP (1u << 18)

__device__ __forceinline__ unsigned xb_ld(unsigned* p)              { return __hip_atomic_load(p, __ATOMIC_RELAXED, __HIP_MEMORY_SCOPE_AGENT); }
__device__ __forceinline__ unsigned xb_add(unsigned* p, unsigned v) { return __hip_atomic_fetch_add(p, v, __ATOMIC_RELAXED, __HIP_MEMORY_SCOPE_AGENT); }
__device__ __forceinline__ unsigned xb_xcc_id() { return (unsigned)__builtin_amdgcn_s_getreg((3 << 11) | 20) & 0xFu; }
#define XB_SPIN(cond, bar) do { unsigned _sp = 0; while (cond) { __builtin_amdgcn_s_sleep(1); \
    if ((++_sp & 255u) == 0u) { if (xb_ld(&(bar)[XB_TMO])) break; if (_sp > XB_SPIN_CAP) { atomicAdd(&(bar)[XB_TMO], 1u); break; } } } } while (0)

struct XcdBarrier {
    unsigned* bar; unsigned x;
    volatile LAS unsigned* st;
};

__device__ __forceinline__ XcdBarrier xcd_barrier_post(unsigned* bar, volatile LAS unsigned* st) {
    XcdBarrier b; b.bar = bar; b.x = xb_xcc_id(); b.st = st;
    if (threadIdx.x == 0) (void)xb_add(&bar[XB_XCNT(b.x)], 1u);
    return b;
}
__device__ __forceinline__ void xcd_barrier_complete(unsigned* bar, unsigned x, unsigned& nloc, unsigned& nx) {
    const unsigned G = gridDim.x * gridDim.y * gridDim.z;
    unsigned sum, cnt, mine, sp = 0u;
    for (;;) {
        sum = 0u; cnt = 0u; mine = 0u;
#pragma unroll
        for (unsigned j = 0; j < 16; ++j) { const unsigned c = xb_ld(&bar[XB_XCNT(j)]); sum += c; cnt += (c > 0u) ? 1u : 0u; mine = (j == x) ? c : mine; }
        if (sum == G) break;
        __builtin_amdgcn_s_sleep(1);
        if ((++sp & 255u) == 0u) { if (xb_ld(&bar[XB_TMO])) break; if (sp > XB_SPIN_CAP) { atomicAdd(&bar[XB_TMO], 1u); break; } }
    }
    nloc = mine > 0u ? mine : 1u; nx = cnt > 0u ? cnt : 1u;
}

__device__ __forceinline__ void xcd_barrier(const XcdBarrier& b) {
    asm volatile("s_waitcnt vmcnt(0)" ::: "memory");
    __syncthreads();
    if (threadIdx.x == 0) {
        unsigned* bar = b.bar;
        __builtin_amdgcn_s_waitcnt(0);
        unsigned nloc = b.st[0], nx = b.st[1];
        if (nloc == 0u) { xcd_barrier_complete(bar, b.x, nloc, nx); b.st[0] = nloc; b.st[1] = nx; }
        const unsigned old = xb_add(&bar[XB_XSUB(b.x)], 1u);
        const unsigned gen = old / nloc;
        if (old + 1u == (gen + 1u) * nloc) {
            __builtin_amdgcn_fence(__ATOMIC_RELEASE, "agent");
            asm volatile("s_waitcnt vmcnt(0)" ::: "memory");
            const unsigned og = xb_add(&bar[XB_TOP], 1u);
            const unsigned tg = og / nx;
            if (og + 1u == (tg + 1u) * nx) xb_add(&bar[XB_TOPGEN], 1u);
            else XB_SPIN(xb_ld(&bar[XB_TOPGEN]) == tg, bar);
            __builtin_amdgcn_fence(__ATOMIC_ACQUIRE, "agent");
            xb_add(&bar[XB_XGEN(b.x)], 1u);
            asm volatile("s_waitcnt vmcnt(0)" ::: "memory");
        } else {
            XB_SPIN(xb_ld(&bar[XB_XGEN(b.x)]) == gen, bar);
            __builtin_amdgcn_fence(__ATOMIC_ACQUIRE, "agent");
            asm volatile("s_waitcnt vmcnt(0)" ::: "memory");
        }
    }
    __syncthreads();
}

typedef float f32x16 __attribute__((ext_vector_type(16)));
typedef float f32x2_t __attribute__((ext_vector_type(2)));
typedef __bf16 bf16x2_t __attribute__((ext_vector_type(2)));
typedef unsigned u32x2 __attribute__((ext_vector_type(2)));
__device__ __forceinline__ unsigned cvtpk(float lo, float hi) { f32x2_t v = {lo, hi}; bf16x2_t b = __builtin_convertvector(v, bf16x2_t); return __builtin_bit_cast(unsigned, b); }
__device__ __forceinline__ float bflo(unsigned w) { return __uint_as_float(w << 16); }
__device__ __forceinline__ float bfhi(unsigned w) { return __uint_as_float(w & 0xffff0000u); }
__device__ __forceinline__ void unpack8(const v4u& w, float (&x)[8]) { x[0] = bflo(w.x); x[1] = bfhi(w.x); x[2] = bflo(w.y); x[3] = bfhi(w.y); x[4] = bflo(w.z); x[5] = bfhi(w.z); x[6] = bflo(w.w); x[7] = bfhi(w.w); }
__device__ __forceinline__ v4u pack8(const float (&x)[8]) { v4u w; w.x = cvtpk(x[0], x[1]); w.y = cvtpk(x[2], x[3]); w.z = cvtpk(x[4], x[5]); w.w = cvtpk(x[6], x[7]); return w; }
__device__ __forceinline__ float wave_sum(float v) { v += shx<1>(v); v += shx<2>(v); v += shx<4>(v); v += shx<8>(v); v += shx<16>(v); return sh32_sum(v); }
__device__ __forceinline__ float wave_max(float v) { v = fmaxf(v, shx<1>(v)); v = fmaxf(v, shx<2>(v)); v = fmaxf(v, shx<4>(v)); v = fmaxf(v, shx<8>(v)); v = fmaxf(v, shx<16>(v)); return sh32_max(v); }
__device__ __forceinline__ int crow(int r, int hi) { return (r & 3) + 8 * (r >> 2) + 4 * hi; }

__device__ __forceinline__ int even_map(int n) {
    if (n < 512) return ES_FQ + n;
    if (n < 1024) return ES_DQ + (n - 512);
    if (n < 1536) return ES_FK + (n - 1024);
    if (n < 2048) return ES_DK + (n - 1536);
    if (n < 2560) return ES_FV + (n - 2048);
    if (n < 3072) return ES_DV + (n - 2560);
    if (n < 3584) return ES_IQ + (n - 3072);
    if (n < 3648) return ES_IK + (n - 3584);
    return -1;
}
__device__ __forceinline__ void conv_item(const float* W, int K, int Nsrc, int nblk, const float* gain, bf16* WT, int mode, LAS float* scr, int item, int lane) {
    const int kb = item / nblk, nb = item % nblk, k0 = 64 * kb, n0 = 32 * nb;
    const int n = n0 + (lane & 31);
    int sc;
    if (mode == 0) sc = n; else if (mode == 1) { const int T = n >> 8, hf = (n >> 7) & 1, j = n & 127; sc = hf * FF + 128 * T + j; } else sc = even_map(n);
#pragma unroll 8
    for (int i = 0; i < 32; ++i) { const int kk = 2 * i + (lane >> 5); float v = 0.f;
        if (sc >= 0) { v = W[(size_t)(k0 + kk) * Nsrc + sc]; if (gain) v *= gain[k0 + kk]; }
        scr[kk * 33 + (lane & 31)] = v; }
    LDS_WAIT(); asm volatile("" ::: "memory");
    const int c = lane & 7;
#pragma unroll
    for (int j = 0; j < 4; ++j) { const int nn = (lane >> 3) + 8 * j; const LAS float* s = scr + (8 * c) * 33 + nn;
        v4u o; o.x = cvtpk(s[0 * 33], s[1 * 33]); o.y = cvtpk(s[2 * 33], s[3 * 33]); o.z = cvtpk(s[4 * 33], s[5 * 33]); o.w = cvtpk(s[6 * 33], s[7 * 33]);
        *(GAS v4u*)(WT + (size_t)(n0 + nn) * K + k0 + 8 * c) = o; }
    LDS_WAIT(); asm volatile("" ::: "memory");
}
struct InPtrs { const float* p[26]; };
__device__ __forceinline__ void conv_weights(const InPtrs& in, unsigned char* ws, int L, LAS unsigned char* lds, int gw, int NGW, int wave, int lane) {
    LAS float* scr = (LAS float*)(lds + wave * 16384);
    bf16* Wr = (bf16*)(ws + WS_W);
    const float* ffn1_norm = in.p[2] + (size_t)L * DM; const float* ffn1_in = in.p[3] + (size_t)L * DM * FF2; const float* ffn1_out = in.p[4] + (size_t)L * FF * DM;
    const float* mix_norm = in.p[5] + (size_t)L * DM; const float* mix_out = in.p[15] + (size_t)L * DM * DM;
    const float* memx_norm = in.p[16] + (size_t)L * DM; const float* mem_wq = in.p[18] + (size_t)L * DM * MEMW; const float* mem_wo = in.p[22] + (size_t)L * MEMW * DM;
    const float* ffn2_norm = in.p[23] + (size_t)L * DM; const float* ffn2_in = in.p[24] + (size_t)L * DM * FF2; const float* ffn2_out = in.p[25] + (size_t)L * FF * DM;
    const bool even = (L & 1) == 0;
    const float* mix_in = even ? in.p[6] : in.p[12];
    const int mixN = even ? EVEN_NP : ODD_N, mixSrc = even ? EVEN_SRC : ODD_N;
    const int I_FIN = (DM / 64) * (FF2 / 32), I_FOUT = (FF / 64) * (DM / 32), I_MIN = (DM / 64) * (mixN / 32), I_MOUT = (DM / 64) * (DM / 32), I_MQ = (DM / 64) * (MEMW / 32), I_MO = (MEMW / 64) * (DM / 32);
    const int NITEMS = 2 * I_FIN + 2 * I_FOUT + I_MIN + I_MOUT + I_MQ + I_MO;
    for (int it = gw; it < NITEMS; it += NGW) {
        int r = it;
        if (r < I_FIN) { conv_item(ffn1_in, DM, FF2, FF2 / 32, ffn1_norm, (bf16*)((unsigned char*)Wr + W_FFN1_IN), 1, scr, r, lane); continue; } r -= I_FIN;
        if (r < I_FIN) { conv_item(ffn2_in, DM, FF2, FF2 / 32, ffn2_norm, (bf16*)((unsigned char*)Wr + W_FFN2_IN), 1, scr, r, lane); continue; } r -= I_FIN;
        if (r < I_FOUT) { conv_item(ffn1_out, FF, DM, DM / 32, nullptr, (bf16*)((unsigned char*)Wr + W_FFN1_OUT), 0, scr, r, lane); continue; } r -= I_FOUT;
        if (r < I_FOUT) { conv_item(ffn2_out, FF, DM, DM / 32, nullptr, (bf16*)((unsigned char*)Wr + W_FFN2_OUT), 0, scr, r, lane); continue; } r -= I_FOUT;
        if (r < I_MIN) { conv_item(mix_in, DM, mixSrc, mixN / 32, mix_norm, (bf16*)((unsigned char*)Wr + W_MIX_IN), even ? 2 : 0, scr, r, lane); continue; } r -= I_MIN;
        if (r < I_MOUT) { conv_item(mix_out, DM, DM, DM / 32, nullptr, (bf16*)((unsigned char*)Wr + W_MIX_OUT), 0, scr, r, lane); continue; } r -= I_MOUT;
        if (r < I_MQ) { conv_item(mem_wq, DM, MEMW, MEMW / 32, memx_norm, (bf16*)((unsigned char*)Wr + W_MEMQ), 0, scr, r, lane); continue; } r -= I_MQ;
        conv_item(mem_wo, MEMW, DM, DM / 32, nullptr, (bf16*)((unsigned char*)Wr + W_MEMO), 0, scr, r, lane);
    }
}
__device__ __forceinline__ void copy_x(const float* x, float* out, bf16* HB, float* ssq0, int gw, int NGW, int lane) {
    for (int m = gw; m < S; m += NGW) {
        const GAS f32x4* xr = (const GAS f32x4*)(x + (size_t)m * DM) + lane; GAS f32x4* orow = (GAS f32x4*)(out + (size_t)m * DM) + lane;
        GAS u32x2* hb = (GAS u32x2*)(HB + (size_t)m * DM) + lane;
        float s = 0.f;
#pragma unroll
        for (int j = 0; j < 4; ++j) { const f32x4 v = xr[64 * j]; orow[64 * j] = v; s += (v.x * v.x + v.y * v.y) + (v.z * v.z + v.w * v.w);
            u32x2 w; w.x = cvtpk(v.x, v.y); w.y = cvtpk(v.z, v.w); hb[64 * j] = w; }
        s = wave_sum(s);
        if (lane < 16) ssq0[(size_t)m * 16 + lane] = (lane == 0) ? s : 0.f;
    }
}
__device__ __forceinline__ void rope_tables(float* cosT, float* sinT, int gtid, int nthreads) {
    for (int idx = gtid; idx < S * 8; idx += nthreads) {
        const int t = idx >> 3, j = idx & 7;
        float inv;
        switch (j) { case 0: inv = 1.0f; break; case 1: inv = 0.193922743f; break; case 2: inv = 0.0376060307f; break; case 3: inv = 0.00729266461f; break;
                     case 4: inv = 0.00141421356f; break; case 5: inv = 0.000274248188f; break; case 6: inv = 5.3182961e-05f; break; default: inv = 1.03133862e-05f; break; }
        const float ang = (float)t * inv;
        const float kq = __builtin_rintf(ang * 0.63661977236758134f);
        float r = ang - kq * 1.5703125f; r = r - kq * 0.00048351287841796875f; r = r - kq * 3.1391647326017846e-07f;
        const float r2 = r * r;
        float sp = 2.7557319e-6f; sp = sp * r2 - 1.9841270e-4f; sp = sp * r2 + 8.3333333e-3f; sp = sp * r2 - 1.6666667e-1f; const float sn = r + r * r2 * sp;
        float cp = -2.7557319e-7f; cp = cp * r2 + 2.4801587e-5f; cp = cp * r2 - 1.3888889e-3f; cp = cp * r2 + 4.1666667e-2f; cp = cp * r2 - 0.5f; const float cs = 1.0f + r2 * cp;
        const int q = ((int)kq) & 3;
        const float sv = (q == 0) ? sn : (q == 1) ? cs : (q == 2) ? -sn : -cs;
        const float cv = (q == 0) ? cs : (q == 1) ? -sn : (q == 2) ? -cs : sn;
        cosT[idx] = cv; sinT[idx] = sv;
    }
}
__device__ __forceinline__ void mem_kv(const InPtrs& in, unsigned char* ws, LAS unsigned char* lds, int w, int tid, int wave, int lane) {
    LAS float* memn = (LAS float*)lds;
    LAS float* red = (LAS float*)(lds + 4096);
    bf16* memK = (bf16*)(ws + WS_MEMK); bf16* memVt = (bf16*)(ws + WS_MEMK + 256 * 1024);
    for (int L = 0; L < NLAYER; ++L) {
        const float* mrow = in.p[1] + (size_t)w * DM; const float* gm = in.p[17] + (size_t)L * DM; const float* wkv = in.p[19] + (size_t)L * DM * 512; const float* kn = in.p[21] + (size_t)L * 64;
        const float x0 = mrow[tid], x1 = mrow[tid + 512];
        float s = wave_sum(x0 * x0 + x1 * x1);
        if (lane == 0) red[wave] = s;
        __syncthreads();
        float tot = 0.f;
#pragma unroll
        for (int i = 0; i < 8; ++i) tot += red[i];
        const float rstd = rsqrtf(tot * (1.0f / DM) + RMS_EPS);
        memn[tid] = x0 * rstd * gm[tid]; memn[tid + 512] = x1 * rstd * gm[tid + 512];
        __syncthreads();
        float acc = 0.f;
#pragma unroll 8
        for (int k = 0; k < DM; ++k) acc += memn[k] * wkv[(size_t)k * 512 + tid];
        if (tid < 256) {
            const float ss = wave_sum(acc * acc);
            const float y = acc * rsqrtf(ss * (1.0f / 64.0f) + RMS_EPS) * kn[tid & 63];
            memK[(size_t)L * 256 * 256 + (size_t)w * 256 + tid] = (bf16)(cvtpk(y, 0.f) & 0xffffu);
        } else {
            const int c = tid - 256;
            memVt[(size_t)L * 256 * 256 + (size_t)c * 256 + w] = (bf16)(cvtpk(acc, 0.f) & 0xffffu);
        }
        __syncthreads();
    }
}

__device__ __forceinline__ void head_norm8(float (&x)[8], const float* gain, int lane) {
    float ss = 0.f;
#pragma unroll
    for (int j = 0; j < 8; ++j) ss += x[j] * x[j];
    ss += shx<1>(ss); ss += shx<2>(ss); ss += shx<4>(ss);
    const float r = rsqrtf(ss * (1.0f / 64.0f) + RMS_EPS);
    const int d0 = 8 * (lane & 7);
#pragma unroll
    for (int j = 0; j < 8; ++j) x[j] = x[j] * r * gain[d0 + j];
}
__device__ __forceinline__ void rope8(float (&x)[8], const float (&cs)[8], const float (&sn)[8], int lane) {
    const int sub = lane & 7;
#pragma unroll
    for (int j = 0; j < 8; ++j) {
        const float other = shx<1>(x[j]);
        if (sub == 0) x[j] = x[j] * cs[j] - other * sn[j];
        else if (sub == 1) x[j] = x[j] * cs[j] + other * sn[j];
    }
}
__device__ __forceinline__ void post_even(const InPtrs& in, unsigned char* ws, const float* H, const float* ssq, LAS unsigned char* lds, int G, int tid, int wave, int lane) {
    bf16* proj = (bf16*)(ws + WS_BIG + B_PROJ); bf16* VtF = (bf16*)(ws + WS_BIG + B_VTF); bf16* IKc = (bf16*)(ws + WS_BIG + B_IKC);
    const float* cosT = (const float*)(ws + WS_ROPE); const float* sinT = cosT + S * 8;
    float* Flocal = (float*)(ws + WS_FL); float* Btot = Flocal + S * 8; float* IW = (float*)(ws + WS_IW);
    const float* fqn = in.p[8]; const float* fkn = in.p[9]; const float* dqn = in.p[10]; const float* dkn = in.p[11]; const float* bfg = in.p[7];
    const float* Wsrc = in.p[6]; const float* mixg = in.p[5];
    constexpr int FVP = 1040;
    LAS unsigned char* fvbuf = lds; LAS float* lf = (LAS float*)(lds + 64 * FVP);
    for (int u = blockIdx.x; u < S / 64; u += G) {
        const int t0 = u * 64;
        for (int i = 0; i < 8; ++i) {
            const int rl = wave * 8 + i, t = t0 + rl;
            bf16* rowp = proj + (size_t)t * EVEN_NP;
            float cs[8], sn[8];
#pragma unroll
            for (int j = 0; j < 8; ++j) { cs[j] = cosT[t * 8 + j]; sn[j] = sinT[t * 8 + j]; }
            float x[8];
            { v4u w = *(const GAS v4u*)(rowp + EC_FQ + lane * 8); unpack8(w, x); head_norm8(x, fqn, lane); *(GAS v4u*)(rowp + EC_FQ + lane * 8) = pack8(x); }
            { v4u w = *(const GAS v4u*)(rowp + EC_DQ + lane * 8); unpack8(w, x); head_norm8(x, dqn, lane); rope8(x, cs, sn, lane); *(GAS v4u*)(rowp + EC_DQ + lane * 8) = pack8(x); }
            { v4u w = *(const GAS v4u*)(rowp + EC_FK + lane * 8); unpack8(w, x); head_norm8(x, fkn, lane); *(GAS v4u*)(rowp + EC_FK + lane * 8) = pack8(x); }
            { v4u w = *(const GAS v4u*)(rowp + EC_DK + lane * 8); unpack8(w, x); head_norm8(x, dkn, lane); rope8(x, cs, sn, lane); *(GAS v4u*)(rowp + EC_DK + lane * 8) = pack8(x); }
            { v4u w = *(const GAS v4u*)(rowp + EC_FV + lane * 8); *(LAS v4u*)(fvbuf + rl * FVP + lane * 16) = w; }
            { v4u w = *(const GAS v4u*)(rowp + EC_IQ + lane * 8); unpack8(w, x); rope8(x, cs, sn, lane); *(GAS v4u*)(rowp + EC_IQ + lane * 8) = pack8(x); }
            { v4u w = (v4u){0u, 0u, 0u, 0u}; if (lane < 8) w = *(const GAS v4u*)(rowp + EC_IK + lane * 8); unpack8(w, x); rope8(x, cs, sn, lane); if (lane < 8) *(GAS v4u*)(IKc + (size_t)t * 64 + lane * 8) = pack8(x); }
            {
                const GAS f32x4* hr = (const GAS f32x4*)(H + (size_t)t * DM) + lane;
                float acc[16];
#pragma unroll
                for (int j = 0; j < 16; ++j) acc[j] = 0.f;
#pragma unroll
                for (int q = 0; q < 4; ++q) {
                    const f32x4 hv = hr[64 * q]; const int k0 = 4 * lane + 256 * q;
#pragma unroll
                    for (int e = 0; e < 4; ++e) { const int k = k0 + e; const float hg = hv[e] * mixg[k];
                        const f32x4 a0 = *(const GAS f32x4*)(Wsrc + (size_t)k * EVEN_SRC + ES_FL), a1 = *(const GAS f32x4*)(Wsrc + (size_t)k * EVEN_SRC + ES_FL + 4);
                        const f32x4 b0 = *(const GAS f32x4*)(Wsrc + (size_t)k * EVEN_SRC + ES_IW), b1 = *(const GAS f32x4*)(Wsrc + (size_t)k * EVEN_SRC + ES_IW + 4);
#pragma unroll
                        for (int j = 0; j < 4; ++j) { acc[j] += hg * a0[j]; acc[4 + j] += hg * a1[j]; acc[8 + j] += hg * b0[j]; acc[12 + j] += hg * b1[j]; } }
                }
                const float rstd = pg8::row_rstd(ssq, t);
#pragma unroll
                for (int j = 0; j < 16; ++j) acc[j] = wave_sum(acc[j]) * rstd;
                if (lane < 8) { float z = 0.f;
#pragma unroll
                    for (int j = 0; j < 8; ++j) if (lane == j) z = acc[j];
                    z += bfg[lane];
                    lf[rl * 8 + lane] = (z > 15.f) ? -expf(-z) : -log1pf(expf(-z)); }
                else if (lane < 16) { float z = 0.f;
#pragma unroll
                    for (int j = 0; j < 8; ++j) if (lane == 8 + j) z = acc[8 + j];
                    IW[(size_t)t * 8 + (lane - 8)] = z * 0.044194173824159216f; }
            }
        }
        __syncthreads();
        {
            float v = lf[lane * 8 + wave];
#pragma unroll
            for (int o = 1; o < 64; o <<= 1) { const float up = __int_as_float(__builtin_amdgcn_ds_bpermute(((lane - o) & 63) << 2, __float_as_int(v))); if (lane >= o) v += up; }
            Flocal[(size_t)(t0 + lane) * 8 + wave] = v;
            if (lane == 63) Btot[u * 8 + wave] = v;
        }
#pragma unroll 2
        for (int p = 0; p < 8; ++p) {
            const int item = p * 512 + tid, c = item >> 3, k = item & 7;
            float dummy; (void)dummy;
            unsigned short e[8];
#pragma unroll
            for (int j = 0; j < 8; ++j) e[j] = *(const LAS unsigned short*)(fvbuf + (8 * k + j) * FVP + c * 2);
            v4u o; o.x = e[0] | ((unsigned)e[1] << 16); o.y = e[2] | ((unsigned)e[3] << 16); o.z = e[4] | ((unsigned)e[5] << 16); o.w = e[6] | ((unsigned)e[7] << 16);
            *(GAS v4u*)(VtF + (size_t)c * S + t0 + 8 * k) = o;
        }
        __syncthreads();
    }
}
__device__ __forceinline__ void post_odd(const InPtrs& in, unsigned char* ws, LAS unsigned char* lds, int G, int tid, int wave, int lane) {
    bf16* Q = (bf16*)(ws + WS_BIG + B_PROJ); bf16* Kb = Q + (size_t)S * DM; bf16* V = Kb + (size_t)S * DM; bf16* Vt = (bf16*)(ws + WS_BIG + B_VTM);
    const float* cosT = (const float*)(ws + WS_ROPE); const float* sinT = cosT + S * 8;
    float* ksum = (float*)(ws + WS_KSUM);
    const float* qn = in.p[13]; const float* kn = in.p[14];
    constexpr int VP = 1040;
    LAS unsigned char* vbuf = lds; LAS float* kred = (LAS float*)(lds + 64 * VP);
    for (int u = blockIdx.x; u < S / 64; u += G) {
        const int t0 = u * 64;
        float ks0[8], ks1[8];
#pragma unroll
        for (int j = 0; j < 8; ++j) { ks0[j] = 0.f; ks1[j] = 0.f; }
        for (int i = 0; i < 8; ++i) {
            const int rl = wave * 8 + i, t = t0 + rl;
            float cs[8], sn[8];
#pragma unroll
            for (int j = 0; j < 8; ++j) { cs[j] = cosT[t * 8 + j]; sn[j] = sinT[t * 8 + j]; }
            float x[8];
#pragma unroll
            for (int sec = 0; sec < 2; ++sec) {
                bf16* qp = Q + (size_t)t * DM + sec * 512 + lane * 8;
                { v4u w = *(const GAS v4u*)qp; unpack8(w, x); head_norm8(x, qn, lane); rope8(x, cs, sn, lane); *(GAS v4u*)qp = pack8(x); }
                bf16* kp = Kb + (size_t)t * DM + sec * 512 + lane * 8;
                { v4u w = *(const GAS v4u*)kp; unpack8(w, x); head_norm8(x, kn, lane); rope8(x, cs, sn, lane); *(GAS v4u*)kp = pack8(x);
#pragma unroll
                  for (int j = 0; j < 8; ++j) { if (sec == 0) ks0[j] += x[j]; else ks1[j] += x[j]; } }
            }
        }
#pragma unroll
        for (int j = 0; j < 8; ++j) { kred[wave * 1024 + lane * 8 + j] = ks0[j]; kred[wave * 1024 + 512 + lane * 8 + j] = ks1[j]; }
        __syncthreads();
        {
#pragma unroll
            for (int e = 0; e < 2; ++e) { const int c = tid + 512 * e; float s = 0.f;
#pragma unroll
                for (int w8 = 0; w8 < 8; ++w8) s += kred[w8 * 1024 + c];
                ksum[(size_t)u * 1024 + c] = s; }
        }
        for (int half = 0; half < 2; ++half) {
            for (int i = 0; i < 8; ++i) { const int rl = wave * 8 + i, t = t0 + rl;
                v4u w = *(const GAS v4u*)(V + (size_t)t * DM + half * 512 + lane * 8); *(LAS v4u*)(vbuf + rl * VP + lane * 16) = w; }
            __syncthreads();
#pragma unroll 2
            for (int p = 0; p < 8; ++p) {
                const int item = p * 512 + tid, c = item >> 3, k = item & 7;
                unsigned short e[8];
#pragma unroll
                for (int j = 0; j < 8; ++j) e[j] = *(const LAS unsigned short*)(vbuf + (8 * k + j) * VP + c * 2);
                v4u o; o.x = e[0] | ((unsigned)e[1] << 16); o.y = e[2] | ((unsigned)e[3] << 16); o.z = e[4] | ((unsigned)e[5] << 16); o.w = e[6] | ((unsigned)e[7] << 16);
                *(GAS v4u*)(Vt + (size_t)(half * 512 + c) * S + t0 + 8 * k) = o;
            }
            __syncthreads();
        }
    }
}

constexpr int KV_K_BYTES = 8192, KV_VT_PITCH = 136, KV_BUF_BYTES = KV_K_BYTES + 64 * KV_VT_PITCH;
struct KVRegs { v4u k, v; };
__device__ __forceinline__ void kv_load(KVRegs& r, const bf16* Kp, size_t kpitch, const bf16* Vtp, size_t vtpitch, int key0, int tid) {
    r.k = *(const GAS v4u*)(Kp + (size_t)(key0 + (tid & 63)) * kpitch + (tid >> 6) * 8);
    r.v = *(const GAS v4u*)(Vtp + (size_t)(tid >> 3) * vtpitch + key0 + (tid & 7) * 8);
}
__device__ __forceinline__ void kv_store(const KVRegs& r, LAS unsigned char* buf, int tid) {
    *(LAS v4u*)(buf + ((tid >> 6) * 64 + (tid & 63)) * 16) = r.k;
    LAS unsigned char* vp = buf + KV_K_BYTES + (tid >> 3) * KV_VT_PITCH + (tid & 7) * 16;
    *(LAS u32x2*)vp = (u32x2){r.v.x, r.v.y}; *(LAS u32x2*)(vp + 8) = (u32x2){r.v.z, r.v.w};
}
struct AttnAcc { float m, l; f32x16 o0, o1; };
__device__ __forceinline__ void attn_init(AttnAcc& a) { a.m = -INFINITY; a.l = 0.f;
#pragma unroll
    for (int r = 0; r < 16; ++r) { a.o0[r] = 0.f; a.o1[r] = 0.f; } }
__device__ __forceinline__ void attn_scores(f32x16& p0, f32x16& p1, const LAS unsigned char* buf, const bf16x8 (&qf)[4], int lane) {
    const int r32 = lane & 31, hi = lane >> 5;
#pragma unroll
    for (int r = 0; r < 16; ++r) { p0[r] = 0.f; p1[r] = 0.f; }
#pragma unroll
    for (int ks = 0; ks < 4; ++ks) {
        const bf16x8 k0 = *(const LAS bf16x8*)(buf + ((2 * ks + hi) * 64 + r32) * 16);
        const bf16x8 k1 = *(const LAS bf16x8*)(buf + ((2 * ks + hi) * 64 + 32 + r32) * 16);
        p0 = __builtin_amdgcn_mfma_f32_32x32x16_bf16(k0, qf[ks], p0, 0, 0, 0);
        p1 = __builtin_amdgcn_mfma_f32_32x32x16_bf16(k1, qf[ks], p1, 0, 0, 0);
    }
}
__device__ __forceinline__ void attn_update(AttnAcc& a, f32x16& p0, f32x16& p1, const LAS unsigned char* buf, int lane) {
    const int r32 = lane & 31, hi = lane >> 5;
    float mx = fmaxf(p0[0], p1[0]);
#pragma unroll
    for (int r = 1; r < 16; ++r) mx = fmaxf(mx, fmaxf(p0[r], p1[r]));
    mx = sh32_max(mx);
    const float mnew = fmaxf(a.m, mx);
    const float msafe = (mnew == -INFINITY) ? 0.f : mnew;
    const float alpha = __builtin_amdgcn_exp2f(a.m - msafe);
    float sum = 0.f;
#pragma unroll
    for (int r = 0; r < 16; ++r) { p0[r] = __builtin_amdgcn_exp2f(p0[r] - msafe); p1[r] = __builtin_amdgcn_exp2f(p1[r] - msafe); sum += p0[r] + p1[r]; }
    a.l = a.l * alpha + sum; a.m = mnew;
#pragma unroll
    for (int r = 0; r < 16; ++r) { a.o0[r] *= alpha; a.o1[r] *= alpha; }
    const LAS unsigned char* vt = buf + KV_K_BYTES + r32 * KV_VT_PITCH + hi * 8;
#pragma unroll
    for (int half = 0; half < 2; ++half) {
#pragma unroll
        for (int s = 0; s < 2; ++s) {
            v4u pw;
            if (half == 0) { pw.x = cvtpk(p0[8 * s + 0], p0[8 * s + 1]); pw.y = cvtpk(p0[8 * s + 2], p0[8 * s + 3]); pw.z = cvtpk(p0[8 * s + 4], p0[8 * s + 5]); pw.w = cvtpk(p0[8 * s + 6], p0[8 * s + 7]); }
            else           { pw.x = cvtpk(p1[8 * s + 0], p1[8 * s + 1]); pw.y = cvtpk(p1[8 * s + 2], p1[8 * s + 3]); pw.z = cvtpk(p1[8 * s + 4], p1[8 * s + 5]); pw.w = cvtpk(p1[8 * s + 6], p1[8 * s + 7]); }
            const bf16x8 pb = __builtin_bit_cast(bf16x8, pw);
            const int kb = (32 * half + 16 * s) * 2;
#pragma unroll
            for (int d0 = 0; d0 < 2; ++d0) {
                const u32x2 lo = *(const LAS u32x2*)(vt + d0 * 32 * KV_VT_PITCH + kb), hi2 = *(const LAS u32x2*)(vt + d0 * 32 * KV_VT_PITCH + kb + 16);
                const bf16x8 va = __builtin_bit_cast(bf16x8, (v4u){lo.x, lo.y, hi2.x, hi2.y});
                if (d0 == 0) a.o0 = __builtin_amdgcn_mfma_f32_32x32x16_bf16(va, pb, a.o0, 0, 0, 0);
                else         a.o1 = __builtin_amdgcn_mfma_f32_32x32x16_bf16(va, pb, a.o1, 0, 0, 0);
            }
        }
    }
}
__device__ __forceinline__ void attn_store(const AttnAcc& a, bf16* orow, int lane) {
    const int hi = lane >> 5;
    float l = sh32_sum(a.l);
    const float inv = (l > 0.f) ? 1.0f / l : 0.f;
#pragma unroll
    for (int g = 0; g < 4; ++g) {
        u32x2 w0, w1;
        w0.x = cvtpk(a.o0[4 * g] * inv, a.o0[4 * g + 1] * inv); w0.y = cvtpk(a.o0[4 * g + 2] * inv, a.o0[4 * g + 3] * inv);
        w1.x = cvtpk(a.o1[4 * g] * inv, a.o1[4 * g + 1] * inv); w1.y = cvtpk(a.o1[4 * g + 2] * inv, a.o1[4 * g + 3] * inv);
        *(GAS u32x2*)(orow + 8 * g + 4 * hi) = w0; *(GAS u32x2*)(orow + 32 + 8 * g + 4 * hi) = w1;
    }
}
__device__ __forceinline__ void load_q(bf16x8 (&qf)[4], const bf16* qrow, int lane) {
    const int hi = lane >> 5;
#pragma unroll
    for (int ks = 0; ks < 4; ++ks) qf[ks] = *(const GAS bf16x8*)(qrow + 16 * ks + 8 * hi);
}

__device__ __forceinline__ void fox_phase(unsigned char* ws, LAS unsigned char* lds, int G, int tid, int wave, int lane) {
    bf16* proj = (bf16*)(ws + WS_BIG + B_PROJ); const bf16* VtF = (const bf16*)(ws + WS_BIG + B_VTF);
    const float* Flocal = (const float*)(ws + WS_FL); const float* Btot = Flocal + S * 8;
    LAS unsigned char* kvb = lds; LAS float* kbt = (LAS float*)(lds + 2 * KV_BUF_BYTES); LAS float* bt = (LAS float*)(lds + 2 * KV_BUF_BYTES + 65536); LAS float* Et = bt + 272;
    const int r32 = lane & 31, hi = lane >> 5;
    for (int pi = blockIdx.x; pi < 256; pi += G) {
        const int h = pi >> 5, sidx = pi & 31;
        for (int uu = 0; uu < 2; ++uu) {
            const int QB = uu ? 63 - sidx : sidx, q0 = QB * 256, nt = 4 * (QB + 1), nt64 = nt;
            __syncthreads();
            for (int j = tid; j < nt64; j += NTHREADS) bt[j] = Btot[j * 8 + h];
            __syncthreads();
            for (int j = tid; j < nt64; j += NTHREADS) { float e = 0.f;
                if (j <= 4 * QB) { for (int i = 4 * QB - 1; i >= j; --i) e -= bt[i]; } else { for (int i = 4 * QB; i < j; ++i) e += bt[i]; }
                Et[j] = e; }
            __syncthreads();
            for (int s = tid; s < q0 + 256; s += NTHREADS) kbt[s] = -(Et[s >> 6] + Flocal[(size_t)s * 8 + h]) * LOG2E;
            const int qrow = q0 + wave * 32 + r32;
            bf16x8 qf[4]; load_q(qf, proj + (size_t)qrow * EVEN_NP + EC_FQ + h * 64, lane);
            AttnAcc a; attn_init(a);
            const bf16* Kp = proj + EC_FK + h * 64; const bf16* Vtp = VtF + (size_t)h * 64 * S;
            KVRegs kr; kv_load(kr, Kp, EVEN_NP, Vtp, S, 0, tid); kv_store(kr, kvb, tid);
            __syncthreads();
            for (int t = 0; t < nt; ++t) {
                LAS unsigned char* cur = kvb + (t & 1) * KV_BUF_BYTES;
                if (t + 1 < nt) kv_load(kr, Kp, EVEN_NP, Vtp, S, (t + 1) * 64, tid);
                const int key0 = t * 64;
                if (key0 <= q0 + wave * 32 + 31) {
                    f32x16 p0, p1; attn_scores(p0, p1, cur, qf, lane);
#pragma unroll
                    for (int g = 0; g < 4; ++g) {
                        const f32x4 b0 = *(const LAS f32x4*)(kbt + key0 + 8 * g + 4 * hi), b1 = *(const LAS f32x4*)(kbt + key0 + 32 + 8 * g + 4 * hi);
#pragma unroll
                        for (int e = 0; e < 4; ++e) { p0[4 * g + e] = p0[4 * g + e] * C2 + b0[e]; p1[4 * g + e] = p1[4 * g + e] * C2 + b1[e]; }
                    }
                    if (key0 + 63 > q0 + wave * 32) {
#pragma unroll
                        for (int r = 0; r < 16; ++r) { const int kv = key0 + crow(r, hi); if (kv > qrow) p0[r] = -INFINITY; if (kv + 32 > qrow) p1[r] = -INFINITY; }
                    }
                    attn_update(a, p0, p1, cur, lane);
                }
                if (t + 1 < nt) kv_store(kr, kvb + ((t + 1) & 1) * KV_BUF_BYTES, tid);
                __syncthreads();
            }
            attn_store(a, proj + (size_t)qrow * EVEN_NP + EC_FQ + h * 64, lane);
        }
    }
}

__device__ __forceinline__ void memattn_phase(const InPtrs& in, unsigned char* ws, int L, LAS unsigned char* lds, int G, int tid, int wave, int lane) {
    const bf16* QM = (const bf16*)(ws + WS_BIG + B_QM); bf16* OM = (bf16*)(ws + WS_BIG + B_OM);
    const bf16* memK = (const bf16*)(ws + WS_MEMK) + (size_t)L * 256 * 256; const bf16* memVt = (const bf16*)(ws + WS_MEMK + 256 * 1024) + (size_t)L * 256 * 256;
    const float* qn = in.p[20] + (size_t)L * 64;
    LAS unsigned char* kvb = lds;
    const int r32 = lane & 31, hi = lane >> 5;
    for (int un = blockIdx.x; un < 256; un += G) {
        const int QB = un >> 2, hm = un & 3, qrow = QB * 256 + wave * 32 + r32;
        bf16x8 qf[4];
        {
            const bf16* qp = QM + (size_t)qrow * MEMW + hm * 64; float x[4][8]; float ss = 0.f;
#pragma unroll
            for (int ks = 0; ks < 4; ++ks) { const v4u w = *(const GAS v4u*)(qp + 16 * ks + 8 * hi); unpack8(w, x[ks]);
#pragma unroll
                for (int j = 0; j < 8; ++j) ss += x[ks][j] * x[ks][j]; }
            ss = sh32_sum(ss);
            const float r = rsqrtf(ss * (1.0f / 64.0f) + RMS_EPS);
#pragma unroll
            for (int ks = 0; ks < 4; ++ks) {
#pragma unroll
                for (int j = 0; j < 8; ++j) x[ks][j] = x[ks][j] * r * qn[16 * ks + 8 * hi + j];
                qf[ks] = __builtin_bit_cast(bf16x8, pack8(x[ks])); }
        }
        AttnAcc a; attn_init(a);
        const bf16* Kp = memK + hm * 64; const bf16* Vtp = memVt + (size_t)hm * 64 * 256;
        __syncthreads();
        KVRegs kr; kv_load(kr, Kp, 256, Vtp, 256, 0, tid); kv_store(kr, kvb, tid);
        __syncthreads();
        for (int t = 0; t < 4; ++t) {
            LAS unsigned char* cur = kvb + (t & 1) * KV_BUF_BYTES;
            if (t + 1 < 4) kv_load(kr, Kp, 256, Vtp, 256, (t + 1) * 64, tid);
            f32x16 p0, p1; attn_scores(p0, p1, cur, qf, lane);
#pragma unroll
            for (int r = 0; r < 16; ++r) { p0[r] *= C2; p1[r] *= C2; }
            attn_update(a, p0, p1, cur, lane);
            if (t + 1 < 4) kv_store(kr, kvb + ((t + 1) & 1) * KV_BUF_BYTES, tid);
            __syncthreads();
        }
        attn_store(a, OM + (size_t)qrow * MEMW + hm * 64, lane);
    }
}

__device__ __forceinline__ void moba_phase(unsigned char* ws, LAS unsigned char* lds, int G, int tid, int wave, int lane) {
    bf16* Q = (bf16*)(ws + WS_BIG + B_PROJ); const bf16* Kb = Q + (size_t)S * DM; const bf16* Vt = (const bf16*)(ws + WS_BIG + B_VTM);
    const float* ksum = (const float*)(ws + WS_KSUM);
    LAS unsigned char* kvb = lds;
    LAS float* kms = (LAS float*)(lds + 2 * KV_BUF_BYTES);
    LAS unsigned* selb = (LAS unsigned*)(lds + 2 * KV_BUF_BYTES + 16384);
    LAS unsigned* wmask = selb + 512;
    LAS int* blist = (LAS int*)(wmask + 32);
    const int r32 = lane & 31, hi = lane >> 5;
    for (int pi = blockIdx.x; pi < 512; pi += G) {
        const int h = pi >> 5, sidx = pi & 31;
        for (int uu = 0; uu < 2; ++uu) {
            const int QB = uu ? 63 - sidx : sidx, q0 = QB * 256;
            __syncthreads();
            for (int e = tid; e < QB * 64; e += NTHREADS) { const float* kp = ksum + (size_t)(e >> 6) * 4096 + h * 64 + (e & 63); kms[e] = ((kp[0] + kp[1024]) + (kp[2048] + kp[3072])) * (1.0f / 256.0f); }
            if (tid < 18) wmask[tid] = 0u;
            __syncthreads();
            if (tid < 256) {
                const bf16* qp = Q + (size_t)(q0 + tid) * DM + h * 64;
                float q[64];
#pragma unroll
                for (int c = 0; c < 8; ++c) { const v4u w = *(const GAS v4u*)(qp + 8 * c); float x[8]; unpack8(w, x);
#pragma unroll
                    for (int j = 0; j < 8; ++j) q[8 * c + j] = x[j]; }
                float g0 = -INFINITY, g1 = -INFINITY, g2 = -INFINITY; int n0 = -1, n1 = -1, n2 = -1;
                for (int n = 0; n < QB; ++n) {
                    float g = 0.f;
#pragma unroll
                    for (int d = 0; d < 64; ++d) g += q[d] * kms[n * 64 + d];
                    if (g > g0) { g2 = g1; n2 = n1; g1 = g0; n1 = n0; g0 = g; n0 = n; }
                    else if (g > g1) { g2 = g1; n2 = n1; g1 = g; n1 = n; }
                    else if (g > g2) { g2 = g; n2 = n; }
                }
                unsigned lo = 0u, hi32 = 0u;
                if (n0 >= 0) { if (n0 < 32) lo |= 1u << n0; else hi32 |= 1u << (n0 - 32); }
                if (n1 >= 0) { if (n1 < 32) lo |= 1u << n1; else hi32 |= 1u << (n1 - 32); }
                if (n2 >= 0) { if (n2 < 32) lo |= 1u << n2; else hi32 |= 1u << (n2 - 32); }
                selb[tid * 2] = lo; selb[tid * 2 + 1] = hi32;
                atomicOr((unsigned*)&wmask[(tid >> 5) * 2], lo); atomicOr((unsigned*)&wmask[(tid >> 5) * 2 + 1], hi32);
                atomicOr((unsigned*)&wmask[16], lo); atomicOr((unsigned*)&wmask[17], hi32);
            }
            __syncthreads();
            if (tid == 0) { int c = 0; const unsigned lo = wmask[16], hi32 = wmask[17];
                for (int n = 0; n < QB; ++n) { const unsigned bit = (n < 32) ? (lo >> n) & 1u : (hi32 >> (n - 32)) & 1u; if (bit) blist[c++] = n; }
                blist[c++] = QB; blist[64 + 1] = c; }
            __syncthreads();
            const int nb = blist[65];
            const unsigned mylo = selb[(wave * 32 + r32) * 2], myhi = selb[(wave * 32 + r32) * 2 + 1];
            const unsigned wlo = wmask[wave * 2], whi = wmask[wave * 2 + 1];
            const int qrow = q0 + wave * 32 + r32;
            bf16x8 qf[4]; load_q(qf, Q + (size_t)qrow * DM + h * 64, lane);
            AttnAcc a; attn_init(a);
            const bf16* Kp = Kb + h * 64; const bf16* Vtp = Vt + (size_t)h * 64 * S;
            const int nt = nb * 4;
            KVRegs kr; kv_load(kr, Kp, DM, Vtp, S, blist[0] * 256, tid); kv_store(kr, kvb, tid);
            __syncthreads();
            for (int t = 0; t < nt; ++t) {
                LAS unsigned char* cur = kvb + (t & 1) * KV_BUF_BYTES;
                const int n = blist[t >> 2], key0 = n * 256 + (t & 3) * 64;
                if (t + 1 < nt) kv_load(kr, Kp, DM, Vtp, S, blist[(t + 1) >> 2] * 256 + ((t + 1) & 3) * 64, tid);
                const bool own = (n == QB);
                const unsigned wbit = own ? 1u : ((n < 32) ? (wlo >> n) & 1u : (whi >> (n - 32)) & 1u);
                if (wbit && (!own || key0 <= q0 + wave * 32 + 31)) {
                    f32x16 p0, p1; attn_scores(p0, p1, cur, qf, lane);
                    if (!own) {
                        const unsigned mbit = (n < 32) ? (mylo >> n) & 1u : (myhi >> (n - 32)) & 1u;
                        const float bias = mbit ? 0.f : -INFINITY;
#pragma unroll
                        for (int r = 0; r < 16; ++r) { p0[r] = p0[r] * C2 + bias; p1[r] = p1[r] * C2 + bias; }
                    } else {
#pragma unroll
                        for (int r = 0; r < 16; ++r) { const int kv = key0 + crow(r, hi); p0[r] = (kv > qrow) ? -INFINITY : p0[r] * C2; p1[r] = (kv + 32 > qrow) ? -INFINITY : p1[r] * C2; }
                    }
                    attn_update(a, p0, p1, cur, lane);
                }
                if (t + 1 < nt) kv_store(kr, kvb + ((t + 1) & 1) * KV_BUF_BYTES, tid);
                __syncthreads();
            }
            attn_store(a, Q + (size_t)qrow * DM + h * 64, lane);
        }
    }
}

typedef float f32x4v __attribute__((ext_vector_type(4)));
__device__ __forceinline__ unsigned mono_key(float s) { if (s == 0.f) s = 0.f; const unsigned u = __float_as_uint(s); return (u & 0x80000000u) ? ~u : (u | 0x80000000u); }
__device__ __forceinline__ void dsa_phase(unsigned char* ws, LAS unsigned char* lds, int G, int tid, int wave, int lane) {
    bf16* proj = (bf16*)(ws + WS_BIG + B_PROJ); const bf16* IKc = (const bf16*)(ws + WS_BIG + B_IKC); const float* IW = (const float*)(ws + WS_IW);
    LAS int* cntbuf = (LAS int*)lds;
    LAS int* wcnt = cntbuf + 32;
    LAS int* flag = wcnt + 16;
    LAS int* selidx = (LAS int*)(lds + 1024);
    LAS float* Ssm = (LAS float*)(lds + 4096);
    LAS float* red = (LAS float*)(lds + 4096 + 16384);
    LAS float* inv = (LAS float*)(lds + 4096 + 32768);
    const int myq = lane >> 5, g = lane >> 4, l15 = lane & 15;
    for (int p = blockIdx.x; p < S / 2; p += G) {
        const int t0 = 2 * p;
        unsigned sc[64];
        {
            const bf16* iqrow = proj + (size_t)(t0 + (l15 >> 3)) * EVEN_NP + EC_IQ + (l15 & 7) * 64 + g * 8;
            const bf16x8 a0 = *(const GAS bf16x8*)iqrow, a1 = *(const GAS bf16x8*)(iqrow + 32);
            const f32x4v wv = *(const GAS f32x4v*)(IW + (size_t)(t0 + (g >> 1)) * 8 + 4 * (g & 1));
            const int myt = t0 + myq;
            const int nsteps = (t0 + 2 + 31) >> 5;
            const bf16* ikl = IKc + (size_t)(32 * wave + l15) * 64 + g * 8; asm volatile("" : "+v"(ikl));
            const int kbase = 32 * wave + 16 * (g & 1) + l15;
#pragma unroll
            for (int c = 0; c < 32; ++c) {
                if (wave + 16 * c < nsteps) {
                    bf16x8 b[2][4];
#pragma unroll
                    for (int i = 0; i < 2; ++i) {
                        const bf16* kA = ikl + (size_t)(2 * c + i) * 16384; const bf16* kB = kA + 16 * 64;
                        b[i][0] = *(const GAS bf16x8*)kA; b[i][1] = *(const GAS bf16x8*)(kA + 32); b[i][2] = *(const GAS bf16x8*)kB; b[i][3] = *(const GAS bf16x8*)(kB + 32); }
#pragma unroll
                    for (int i = 0; i < 2; ++i) {
                        f32x4v cA = {0.f, 0.f, 0.f, 0.f}, cB = {0.f, 0.f, 0.f, 0.f};
                        cA = __builtin_amdgcn_mfma_f32_16x16x32_bf16(a0, b[i][0], cA, 0, 0, 0); cA = __builtin_amdgcn_mfma_f32_16x16x32_bf16(a1, b[i][1], cA, 0, 0, 0);
                        cB = __builtin_amdgcn_mfma_f32_16x16x32_bf16(a0, b[i][2], cB, 0, 0, 0); cB = __builtin_amdgcn_mfma_f32_16x16x32_bf16(a1, b[i][3], cB, 0, 0, 0);
                        float sA = wv[0] * fmaxf(cA[0], 0.f) + wv[1] * fmaxf(cA[1], 0.f) + wv[2] * fmaxf(cA[2], 0.f) + wv[3] * fmaxf(cA[3], 0.f);
                        float sB = wv[0] * fmaxf(cB[0], 0.f) + wv[1] * fmaxf(cB[1], 0.f) + wv[2] * fmaxf(cB[2], 0.f) + wv[3] * fmaxf(cB[3], 0.f);
                        sA += shx<16>(sA); sB += shx<16>(sB);
                        const float my = (g & 1) ? sB : sA; const int mykey = kbase + 256 * (2 * c + i);
                        sc[2 * c + i] = (mykey <= myt) ? mono_key(my) : 0u; }
                } else {
#pragma unroll
                    for (int i = 0; i < 2; ++i) sc[2 * c + i] = 0u;
                }
            }
        }
        const int Ksel = min(256, t0 + 1 + myq);
        unsigned T = 0u; int cntT = 1 << 30;
        for (int bit = 31; bit >= 0; --bit) {
            const unsigned cand = T | (1u << bit);
            int c = 0;
#pragma unroll
            for (int i = 0; i < 64; ++i) c += (sc[i] >= cand) ? 1 : 0;
            c = sum32_i(c);
            LAS int* cb = cntbuf + (bit & 1) * 16;
            if ((lane & 31) == 0) cb[wave * 2 + myq] = c;
            __syncthreads();
            int tot = 0;
#pragma unroll
            for (int w8 = 0; w8 < 8; ++w8) tot += cb[w8 * 2 + myq];
            if (tot >= Ksel) { T = cand; cntT = tot; }
        }
        int Jstar = S;
        const int ibase = 32 * wave + 16 * (g & 1) + l15;
        {
            if (tid == 0) flag[0] = 0;
            __syncthreads();
            if (cntT > Ksel && (lane & 31) == 0) flag[0] = 1;
            __syncthreads();
            if (flag[0]) {
                int c = 0;
#pragma unroll
                for (int i = 0; i < 64; ++i) c += (sc[i] > T) ? 1 : 0;
                c = sum32_i(c);
                if ((lane & 31) == 0) cntbuf[wave * 2 + myq] = c;
                __syncthreads();
                int gt = 0;
#pragma unroll
                for (int w8 = 0; w8 < 8; ++w8) gt += cntbuf[w8 * 2 + myq];
                const int need = Ksel - gt;
                int Jm = 0;
                for (int bit = 14; bit >= 0; --bit) {
                    const int cand = Jm | (1 << bit);
                    int candm = cand - ibase; asm volatile("" : "+v"(candm));
                    int c2 = 0;
#pragma unroll
                    for (int i = 0; i < 64; ++i) c2 += (sc[i] == T && 256 * i < candm) ? 1 : 0;
                    c2 = sum32_i(c2);
                    LAS int* cb = cntbuf + (bit & 1) * 16;
                    __syncthreads();
                    if ((lane & 31) == 0) cb[wave * 2 + myq] = c2;
                    __syncthreads();
                    int tot = 0;
#pragma unroll
                    for (int w8 = 0; w8 < 8; ++w8) tot += cb[w8 * 2 + myq];
                    if (tot < need) Jm = cand;
                }
                Jstar = Jm + 1;
            }
        }
        {
            int c = 0;
            int jm = Jstar - ibase; asm volatile("" : "+v"(jm));
#pragma unroll
            for (int i = 0; i < 64; ++i) c += (sc[i] > T || (sc[i] == T && 256 * i < jm)) ? 1 : 0;
            c = sum32_i(c);
            __syncthreads();
            if ((lane & 31) == 0) wcnt[wave * 2 + myq] = c;
            __syncthreads();
            int base = 0;
            for (int w8 = 0; w8 < wave; ++w8) base += wcnt[w8 * 2 + myq];
            const unsigned lowmask = (1u << (lane & 31)) - 1u;
#pragma unroll
            for (int i = 0; i < 64; ++i) {
                const bool pred = (sc[i] > T || (sc[i] == T && 256 * i < jm));
                const unsigned long long mask = __ballot(pred);
                const unsigned hm = myq ? (unsigned)(mask >> 32) : (unsigned)mask;
                const int pos = base + __popc(hm & lowmask);
                if (pred && pos < 256) selidx[myq * 256 + pos] = ibase + 256 * i;
                base += __popc(hm);
                if ((i & 7) == 7) __builtin_amdgcn_sched_barrier(0); }
        }
        __syncthreads();
        const int aq = wave >> 2, part = wave & 3, hh = lane >> 3;
        const int Ka = min(256, t0 + 1 + aq);
        float qv[8];
        { const v4u w = *(const GAS v4u*)(proj + (size_t)(t0 + aq) * EVEN_NP + EC_DQ + lane * 8); unpack8(w, qv);
#pragma unroll
          for (int j = 0; j < 8; ++j) qv[j] *= C2; }
        for (int e0 = 0; e0 < 64; e0 += 8) {
            v4u kw[8]; int ev[8];
#pragma unroll
            for (int j = 0; j < 8; ++j) { const int e = part * 64 + e0 + j; ev[j] = e; const int idx = (e < Ka) ? selidx[aq * 256 + e] : 0;
                kw[j] = *(const GAS v4u*)(proj + (size_t)idx * EVEN_NP + EC_DK + lane * 8); }
#pragma unroll
            for (int j = 0; j < 8; ++j) { float x[8]; unpack8(kw[j], x); float d = 0.f;
#pragma unroll
                for (int i = 0; i < 8; ++i) d += qv[i] * x[i];
                d += shx<1>(d); d += shx<2>(d); d += shx<4>(d);
                if ((lane & 7) == 0) Ssm[(aq * 8 + hh) * 256 + ev[j]] = (ev[j] < Ka) ? d : -INFINITY; }
        }
        __syncthreads();
#pragma unroll
        for (int rr = 0; rr < 2; ++rr) {
            const int row = wave * 2 + rr; LAS float* sr = Ssm + row * 256;
            float v0 = sr[lane], v1 = sr[lane + 64], v2 = sr[lane + 128], v3 = sr[lane + 192];
            const float mx = wave_max(fmaxf(fmaxf(v0, v1), fmaxf(v2, v3)));
            v0 = __builtin_amdgcn_exp2f(v0 - mx); v1 = __builtin_amdgcn_exp2f(v1 - mx); v2 = __builtin_amdgcn_exp2f(v2 - mx); v3 = __builtin_amdgcn_exp2f(v3 - mx);
            const float sm = wave_sum((v0 + v1) + (v2 + v3));
            sr[lane] = v0; sr[lane + 64] = v1; sr[lane + 128] = v2; sr[lane + 192] = v3;
            if (lane == 0) inv[row] = 1.0f / sm;
        }
        __syncthreads();
        {
            float acc[8];
#pragma unroll
            for (int j = 0; j < 8; ++j) acc[j] = 0.f;
            for (int e0 = 0; e0 < 64; e0 += 8) {
                v4u vw[8]; float pv[8];
#pragma unroll
                for (int j = 0; j < 8; ++j) { const int e = part * 64 + e0 + j; const int idx = (e < Ka) ? selidx[aq * 256 + e] : 0;
                    vw[j] = *(const GAS v4u*)(proj + (size_t)idx * EVEN_NP + EC_DV + lane * 8); pv[j] = Ssm[(aq * 8 + hh) * 256 + e]; }
#pragma unroll
                for (int j = 0; j < 8; ++j) { float x[8]; unpack8(vw[j], x);
#pragma unroll
                    for (int i = 0; i < 8; ++i) acc[i] += pv[j] * x[i]; }
            }
            LAS float* rp = red + (aq * 4 + part) * 512 + lane * 8;
            *(LAS f32x4v*)rp = (f32x4v){acc[0], acc[1], acc[2], acc[3]}; *(LAS f32x4v*)(rp + 4) = (f32x4v){acc[4], acc[5], acc[6], acc[7]};
        }
        __syncthreads();
        {
            const int q = tid >> 8, c = (tid & 255) * 2;
            const float iv = inv[q * 8 + (c >> 6)];
            const float o0 = (red[(q * 4 + 0) * 512 + c] + red[(q * 4 + 1) * 512 + c]) + (red[(q * 4 + 2) * 512 + c] + red[(q * 4 + 3) * 512 + c]);
            const float o1 = (red[(q * 4 + 0) * 512 + c + 1] + red[(q * 4 + 1) * 512 + c + 1]) + (red[(q * 4 + 2) * 512 + c + 1] + red[(q * 4 + 3) * 512 + c + 1]);
            *(GAS unsigned*)(proj + (size_t)(t0 + q) * EVEN_NP + EC_DQ + c) = cvtpk(o0 * iv, o1 * iv);
        }
        __syncthreads();
    }
}

struct Args { InPtrs in; float* out; unsigned char* ws; int ph_lo, ph_hi, li, pad; };
constexpr int PH_PER_LAYER = 12, N_PHASES = 1 + 2 * PH_PER_LAYER - 1;

__global__ void __launch_bounds__(NTHREADS, 2) hyb_fwd(Args args) {
    extern __shared__ __attribute__((aligned(16))) unsigned char lds_raw[];
    LAS unsigned char* lds = (LAS unsigned char*)lds_raw;
    volatile LAS unsigned* MISC = (volatile LAS unsigned*)(lds + MISC_OFF);
    const int tid = threadIdx.x, lane = tid & 63, wave = __builtin_amdgcn_readfirstlane(tid >> 6);
    const int G = gridDim.x;
    const int vcu = (G % 8 == 0) ? ((int)blockIdx.x % 8) * (G / 8) + (int)blockIdx.x / 8 : (int)blockIdx.x;
    unsigned char* ws = args.ws;
    gu32* ctl = (gu32*)(ws + WS_CTL);
    for (int u = tid; u < (LDS_BYTES - LDSCTL_OFF) / 4; u += NTHREADS) ((LAS unsigned*)(lds + LDSCTL_OFF))[u] = 0u;
    __syncthreads();
    XcdBarrier bar = xcd_barrier_post((unsigned*)(ctl + CW_BAR) + args.li * XCD_BAR_WORDS, MISC + 8);
    const int tid0 = tid; unsigned char* const ws0 = ws;
    for (int ph = args.ph_lo; ph < args.ph_hi; ++ph) {
        int tid = tid0; asm volatile("" : "+v"(tid));
        unsigned char* ws = ws0; asm volatile("" : "+s"(ws));
        const int lane = tid & 63, wave = __builtin_amdgcn_readfirstlane(tid >> 6);
        LAS unsigned char* lds = (LAS unsigned char*)lds_raw; { unsigned lo_ = (unsigned)(uintptr_t)lds; asm volatile("" : "+s"(lo_)); lds = (LAS unsigned char*)(uintptr_t)lo_; }
        float* ssqA = (float*)(ws + WS_SSQ);
        bf16* HB = (bf16*)(ws + WS_HB);
        unsigned char* Wr = ws + WS_W;
        unsigned char* BIG = ws + WS_BIG;
        const int gw = vcu * NWAVES + wave, NGW = G * NWAVES;
        if (ph == 0) {
#ifndef NO_P0
            conv_weights(args.in, ws, 0, lds, gw, NGW, wave, lane);
            copy_x(args.in.p[0], args.out, HB, ssqA, gw, NGW, lane);
            rope_tables((float*)(ws + WS_ROPE), (float*)(ws + WS_ROPE) + S * 8, (int)blockIdx.x * NTHREADS + tid, G * NTHREADS);
            __syncthreads();
            for (int w = blockIdx.x; w < MEMT; w += G) mem_kv(args.in, ws, lds, w, tid, wave, lane);
#endif
        } else {
            const int L = (ph - 1) / PH_PER_LAYER, sub = (ph - 1) % PH_PER_LAYER;
            const bool even = (L & 1) == 0;
            float* ssq_in = ssqA;
            if (sub == 0 || sub == 9) {
                pg8::Gemm g{(const pg8::bf16_t*)HB, (const pg8::bf16_t*)(Wr + (sub == 0 ? W_FFN1_IN : W_FFN2_IN)), S, FF2, DM, DM};
                pg8::StaticOrder So; So.init(S, FF2, G, (int)blockIdx.x);
                pg8::EpiSwiGLU E{(pg8::bf16_t*)(BIG + B_U), ssq_in, FF};
                #ifndef NO_G1
                pg8::gemm_phase<pg8::EpiSwiGLU, pg8::StaticOrder, true, true>(lds, g, So, E, tid);
#endif
            } else if (sub == 1 || sub == 5 || sub == 8 || sub == 10) {
                pg8::Gemm g; float scale; int so;
                if (sub == 1)       { g = pg8::Gemm{(const pg8::bf16_t*)(BIG + B_U), (const pg8::bf16_t*)(Wr + W_FFN1_OUT), S, DM, FF, FF}; scale = 0.5f; so = 1; }
                else if (sub == 5)  { g = pg8::Gemm{(const pg8::bf16_t*)(BIG + B_PROJ), (const pg8::bf16_t*)(Wr + W_MIX_OUT), S, DM, DM, even ? EVEN_NP : DM}; scale = 1.0f; so = 2; }
                else if (sub == 8)  { g = pg8::Gemm{(const pg8::bf16_t*)(BIG + B_OM), (const pg8::bf16_t*)(Wr + W_MEMO), S, DM, MEMW, MEMW}; scale = 1.0f; so = 3; }
                else                { g = pg8::Gemm{(const pg8::bf16_t*)(BIG + B_U), (const pg8::bf16_t*)(Wr + W_FFN2_OUT), S, DM, FF, FF}; scale = 0.5f; so = 4; }
                const bool last = (sub == 10 && L == NLAYER - 1);
                pg8::StaticOrder So; So.init(S, DM, G, (int)blockIdx.x);
                pg8::EpiResid E{args.out, last ? nullptr : (pg8::bf16_t*)HB, last ? nullptr : ssqA, scale};
                #ifndef NO_G2
                pg8::gemm_phase<pg8::EpiResid, pg8::StaticOrder, true, true>(lds, g, So, E, tid);
#endif
            } else if (sub == 2 || sub == 6) {
                pg8::Gemm g; pg8::EpiScale E;
                if (sub == 2) { const int N = even ? EVEN_NP : ODD_N;
                    g = pg8::Gemm{(const pg8::bf16_t*)HB, (const pg8::bf16_t*)(Wr + W_MIX_IN), S, N, DM, DM};
                    E = pg8::EpiScale{(pg8::bf16_t*)(BIG + B_PROJ), even ? EVEN_NP : DM, ssq_in, even ? 0 : DM, (size_t)S * DM}; }
                else { g = pg8::Gemm{(const pg8::bf16_t*)HB, (const pg8::bf16_t*)(Wr + W_MEMQ), S, MEMW, DM, DM};
                    E = pg8::EpiScale{(pg8::bf16_t*)(BIG + B_QM), MEMW, ssq_in, 0, 0}; }
                pg8::StaticOrder So; So.init(S, g.N, G, (int)blockIdx.x);
                #ifndef NO_G3
                pg8::gemm_phase<pg8::EpiScale, pg8::StaticOrder, true, true>(lds, g, So, E, tid);
#endif
            } else if (sub == 3) {
                #ifndef NO_POSTE
                if (even) post_even(args.in, ws, args.out, ssq_in, lds, G, tid, wave, lane);
#endif
#ifndef NO_POSTO
                if (!even) post_odd(args.in, ws, lds, G, tid, wave, lane);
#endif
            } else if (sub == 4) {
                if (even) {
#ifndef NO_FOX
                    fox_phase(ws, lds, G, tid, wave, lane);
#endif
                    __syncthreads();
#ifndef NO_DSA
                    dsa_phase(ws, lds, G, tid, wave, lane);
#endif
                }
#ifndef NO_MOBA
                else moba_phase(ws, lds, G, tid, wave, lane);
#endif
            } else if (sub == 7) {
                #ifndef NO_MEM
                memattn_phase(args.in, ws, L, lds, G, tid, wave, lane);
#endif
            } else if (sub == 11) {
#ifndef NO_P0
                conv_weights(args.in, ws, L + 1, lds, gw, NGW, wave, lane);
#endif
            }
        }
        if (ph + 1 < args.ph_hi) xcd_barrier(bar);
    }
}

#ifndef MK_N_LAUNCHES
#define MK_N_LAUNCHES 1
#endif
extern "C" void kernel_launch(void* const* d_in, const int* in_sizes, int n_in, void* d_out, int out_size, void* d_ws, size_t ws_size, hipStream_t stream) {
    static int grid = 0;
    if (grid == 0) {
        if (n_in != 26 || in_sizes[0] != S * DM || out_size != S * DM || ws_size < WS_END) {
            fprintf(stderr, "kernel_launch: unexpected problem (n_in %d, in0 %d, out %d, ws %zu); nothing launched\n", n_in, n_in > 0 ? in_sizes[0] : -1, out_size, ws_size); grid = -1; return; }
        int dev = 0, cus = 0, per_cu = 0;
        if (hipGetDevice(&dev) != hipSuccess || hipDeviceGetAttribute(&cus, hipDeviceAttributeMultiprocessorCount, dev) != hipSuccess) { grid = -1; return; }
        if (hipFuncSetAttribute((const void*)hyb_fwd, hipFuncAttributeMaxDynamicSharedMemorySize, LDS_BYTES) != hipSuccess) { fprintf(stderr, "kernel_launch: hipFuncSetAttribute failed\n"); grid = -1; return; }
        if (hipOccupancyMaxActiveBlocksPerMultiprocessor(&per_cu, (const void*)hyb_fwd, NTHREADS, LDS_BYTES) != hipSuccess || per_cu < 1)
            fprintf(stderr, "kernel_launch: note: occupancy query reports %d workgroups per CU\n", per_cu);
        (void)hipGetLastError();
        grid = cus;
    }
    if (grid < 0) return;
    if (hipMemsetAsync((char*)d_ws + WS_CTL, 0, CTL_ZERO_BYTES, stream) != hipSuccess) { fprintf(stderr, "kernel_launch: hipMemsetAsync failed\n"); return; }
    Args a{};
    for (int i = 0; i < 26; ++i) a.in.p[i] = (const float*)d_in[i];
    a.out = (float*)d_out; a.ws = (unsigned char*)d_ws;
#if MK_N_LAUNCHES == 1
    a.ph_lo = 0; a.ph_hi = N_PHASES; a.li = 0;
    hipLaunchKernelGGL(hyb_fwd, dim3(grid), dim3(NTHREADS), LDS_BYTES, stream, a);
#else
    for (int ph = 0; ph < N_PHASES; ++ph) { a.ph_lo = ph; a.ph_hi = ph + 1; a.li = 0; hipLaunchKernelGGL(hyb_fwd, dim3(grid), dim3(NTHREADS), LDS_BYTES, stream, a); }
#endif
    const hipError_t le = hipPeekAtLastError();
    if (le != hipSuccess) fprintf(stderr, "kernel_launch: launch failed: %s\n", hipGetErrorName(le));
}
```

```cpp
#include <hip/hip_runtime.h>
#include <cstdio>
#include <cstdint>

template <int M> __device__ __forceinline__ int shx_i(int v) {
    if constexpr (M == 1) return __builtin_amdgcn_mov_dpp(v, 0xB1, 0xF, 0xF, true);
    else if constexpr (M == 2) return __builtin_amdgcn_mov_dpp(v, 0x4E, 0xF, 0xF, true);
    else return __builtin_amdgcn_ds_swizzle(v, (M << 10) | 0x1f);
}
template <int M> __device__ __forceinline__ float shx(float v) { return __int_as_float(shx_i<M>(__float_as_int(v))); }
__device__ __forceinline__ float sh32_sum(float v) { auto r = __builtin_amdgcn_permlane32_swap(__float_as_uint(v), __float_as_uint(v), false, false); return __uint_as_float(r[0]) + __uint_as_float(r[1]); }
__device__ __forceinline__ float sh32_max(float v) { auto r = __builtin_amdgcn_permlane32_swap(__float_as_uint(v), __float_as_uint(v), false, false); return fmaxf(__uint_as_float(r[0]), __uint_as_float(r[1])); }
__device__ __forceinline__ int sum32_i(int c) { c += shx_i<1>(c); c += shx_i<2>(c); c += shx_i<4>(c); c += shx_i<8>(c); c += shx_i<16>(c); return c; }
namespace pg8 {
#define PG8_LAS __attribute__((address_space(3)))
typedef unsigned short bf16_t;
typedef short bf16x8 __attribute__((ext_vector_type(8)));
typedef float f32x4 __attribute__((ext_vector_type(4)));
typedef unsigned u32x4 __attribute__((ext_vector_type(4)));
constexpr int BM = 256, BK = 64, HALF = 128, HTB = HALF * BK * 2  , STAGE_BYTES = 8 * HTB, NXCD = 8, WGM = 8;

__host__ __device__ __forceinline__ int lds_byte(int r, int c) { const int st = (r >> 4) * 2 + (c >> 5), rr = r & 15, cc = c & 31, ob = rr * 64 + cc * 2; return st * 1024 + (ob ^ (((ob >> 9) & 1) << 5)); }
__host__ __device__ __forceinline__ void stage_rc(int b, int& R, int& C) { const int st = b / 1024, sb = b % 1024, swz = sb ^ (((sb >> 9) & 1) << 5); R = (st >> 1) * 16 + swz / 64; C = (st & 1) * 32 + (swz % 64) / 2; }
__host__ __device__ __forceinline__ int perm32(int rho) { const int n = rho >> 4, i = rho & 15; return 8 * (i >> 2) + 4 * n + (i & 3); }

struct Unit { int pm, pn; };
struct Gemm { const bf16_t* A; const bf16_t* Bt; int M, N, K, lda; };

struct StaticOrder {
    int nM, nN, nwg, G, c;
    __host__ __device__ void init(int M, int N, int G_, int c_) { nM = M / BM; nN = N / BM; nwg = nM * nN; G = G_; c = c_; }
    __host__ __device__ bool next(int i, Unit& u) const {
        const long L = (long)i * G + c; if (L >= nwg) return false;
        int wgid = (int)L; { const int q = nwg / NXCD, r = nwg % NXCD, xcd = wgid % NXCD, off = wgid / NXCD; wgid = (xcd < r ? xcd * (q + 1) : r * (q + 1) + (xcd - r) * q) + off; }
        const int nig = WGM * nN, gid = wgid / nig, fm = gid * WGM, gsz = (nM - fm) < WGM ? (nM - fm) : WGM;
        u.pm = fm + ((wgid % nig) % gsz); u.pn = (wgid % nig) / gsz; return true;
    }
    __device__ __forceinline__ void a_ready(const Unit&) const {}
    __device__ __forceinline__ void done(const Unit&) const {}
};

__device__ __forceinline__ unsigned cvt_pk_bf16(float lo, float hi) { unsigned r; asm volatile("v_cvt_pk_bf16_f32 %0, %1, %2" : "=v"(r) : "v"(lo), "v"(hi)); return r; }
typedef float f32x2 __attribute__((ext_vector_type(2)));
constexpr float RMS_EPS_F = 1e-6f;
__device__ __forceinline__ float silu_f(float x) { return x * __builtin_amdgcn_rcpf(1.0f + __builtin_amdgcn_exp2f(-1.4426950408889634f * x)); }
__device__ __forceinline__ float row_rstd(const float* ssq, int row) {
    const f32x4* p = (const f32x4*)(ssq + (size_t)row * 16); const f32x4 a = p[0], b = p[1], c = p[2], d = p[3];
    const float s = ((a[0] + a[1]) + (a[2] + a[3])) + ((b[0] + b[1]) + (b[2] + b[3])) + ((c[0] + c[1]) + (c[2] + c[3])) + ((d[0] + d[1]) + (d[2] + d[3]));
    return rsqrtf(s * (1.0f / 1024.0f) + RMS_EPS_F); }

struct EpiSwiGLU {
    static constexpr bool PERM = true, AFTER_DRAIN = false;
    bf16_t* U; const float* ssq; int ldu;
    __device__ __forceinline__ void operator()(const f32x4 (&acc)[2][2][4][2], const Unit& u, int wr, int wc, int fr, int fq) const {
        const int row0 = u.pm * BM + wr * 64 + fr, col0 = u.pn * HALF + wc * 32 + 8 * fq;
#pragma unroll
        for (int ai = 0; ai < 2; ++ai)
#pragma unroll
            for (int m = 0; m < 4; ++m) {
                const int row = row0 + ai * HALF + m * 16; const float r = row_rstd(ssq, row);
                const f32x4 a0 = acc[ai][0][m][0] * r, a1 = acc[ai][0][m][1] * r, b0 = acc[ai][1][m][0] * r, b1 = acc[ai][1][m][1] * r;
                u32x4 w;
                w.x = cvt_pk_bf16(silu_f(a0[0]) * b0[0], silu_f(a0[1]) * b0[1]); w.y = cvt_pk_bf16(silu_f(a0[2]) * b0[2], silu_f(a0[3]) * b0[3]);
                w.z = cvt_pk_bf16(silu_f(a1[0]) * b1[0], silu_f(a1[1]) * b1[1]); w.w = cvt_pk_bf16(silu_f(a1[2]) * b1[2], silu_f(a1[3]) * b1[3]);
                *(u32x4*)(U + (size_t)row * ldu + col0) = w;
            }
    }
};
struct EpiResid {
    static constexpr bool PERM = true, AFTER_DRAIN = false;
    float* H; bf16_t* HB; float* ssq_out; float scale;
    __device__ __forceinline__ void operator()(const f32x4 (&acc)[2][2][4][2], const Unit& u, int wr, int wc, int fr, int fq) const {
        const int row0 = u.pm * BM + wr * 64 + fr, col0 = u.pn * BM + wc * 32 + 8 * fq;
#pragma unroll
        for (int ai = 0; ai < 2; ++ai)
#pragma unroll
            for (int m = 0; m < 4; ++m) {
                const int row = row0 + ai * HALF + m * 16; float sq = 0.f;
#pragma unroll
                for (int bj = 0; bj < 2; ++bj) {
                    float* hp = H + (size_t)row * 1024 + col0 + bj * HALF;
                    f32x4 h0 = *(const f32x4*)hp, h1 = *(const f32x4*)(hp + 4);
                    h0 = h0 + acc[ai][bj][m][0] * scale; h1 = h1 + acc[ai][bj][m][1] * scale;
                    *(f32x4*)hp = h0; *(f32x4*)(hp + 4) = h1;
                    sq += (h0[0] * h0[0] + h0[1] * h0[1]) + (h0[2] * h0[2] + h0[3] * h0[3]) + (h1[0] * h1[0] + h1[1] * h1[1]) + (h1[2] * h1[2] + h1[3] * h1[3]);
                    if (HB) { u32x4 w; w.x = cvt_pk_bf16(h0[0], h0[1]); w.y = cvt_pk_bf16(h0[2], h0[3]); w.z = cvt_pk_bf16(h1[0], h1[1]); w.w = cvt_pk_bf16(h1[2], h1[3]);
                        *(u32x4*)(HB + (size_t)row * 1024 + col0 + bj * HALF) = w; }
                }
                if (ssq_out) { sq += shx<16>(sq); sq = sh32_sum(sq); if (fq == 0) ssq_out[(size_t)row * 16 + u.pn * 4 + wc] = sq; }
            }
    }
};
struct EpiScale {
    static constexpr bool PERM = true, AFTER_DRAIN = false;
    bf16_t* O; int ldc; const float* ssq; int split_cols; size_t split_stride;
    __device__ __forceinline__ void operator()(const f32x4 (&acc)[2][2][4][2], const Unit& u, int wr, int wc, int fr, int fq) const {
        const int row0 = u.pm * BM + wr * 64 + fr; int colt = u.pn * BM; bf16_t* base = O;
        if (split_cols) { const int t = colt / split_cols; base += (size_t)t * split_stride; colt -= t * split_cols; }
        const int col0 = colt + wc * 32 + 8 * fq;
#pragma unroll
        for (int ai = 0; ai < 2; ++ai)
#pragma unroll
            for (int m = 0; m < 4; ++m) {
                const int row = row0 + ai * HALF + m * 16; const float r = row_rstd(ssq, row);
                bf16_t* rowp = base + (size_t)row * ldc + col0;
#pragma unroll
                for (int bj = 0; bj < 2; ++bj) { const f32x4 v0 = acc[ai][bj][m][0] * r, v1 = acc[ai][bj][m][1] * r;
                    u32x4 w; w.x = cvt_pk_bf16(v0[0], v0[1]); w.y = cvt_pk_bf16(v0[2], v0[3]); w.z = cvt_pk_bf16(v1[0], v1[1]); w.w = cvt_pk_bf16(v1[2], v1[3]);
                    *(u32x4*)(rowp + bj * HALF) = w; }
            }
    }
};
template <class Epi, class Sched, bool ALIGN_EPI = false, bool SP2 = false>
__device__ __forceinline__ void gemm_phase(PG8_LAS unsigned char* lds, const Gemm g, const Sched& S, const Epi& E, const int tid) {
    const int wid = __builtin_amdgcn_readfirstlane(tid >> 6), lane = tid & 63, wr = wid >> 2, wc = wid & 3, fr = lane & 15, fq = lane >> 4;
    const int K = g.K, nt = K / BK;
    unsigned voffA[2], voffB[2];
#pragma unroll
    for (int i = 0; i < 2; ++i) { int R, C; stage_rc(tid * 16 + i * 8192, R, C); const int Rb = Epi::PERM ? ((R & ~31) + perm32(R & 31)) : R;
        voffA[i] = (unsigned)(R * g.lda + C) * 2u; voffB[i] = (unsigned)(Rb * K + C) * 2u; }
    const size_t kstep = (size_t)(BK * 2);
    const size_t hstepA = (size_t)HALF * g.lda * 2, hstepB = (size_t)HALF * K * 2;
    const size_t tstepA = 2 * hstepA, tstepB = 2 * hstepB;
    const unsigned ldsw = (unsigned)wid * 1024u;
    const int aoff = lds_byte(wr * 64 + fr, fq * 8), boff = lds_byte(wc * 32 + fr, fq * 8);
#define PG8_SA(b, h) (((b) * 2 + (h)) * HTB)
#define PG8_SB(b, h) ((4 + (b) * 2 + (h)) * HTB)
#define PG8_STAGE(bufoff, gbase, voff) do { _Pragma("unroll") for (int _i = 0; _i < 2; ++_i) \
        __builtin_amdgcn_global_load_lds((const unsigned*)((const char*)(gbase) + (voff)[_i]), (PG8_LAS unsigned*)(lds + (bufoff) + ldsw + _i * 8192), 16, 0, 0); } while (0)
#define PG8_LDA(dst, b, h) do { _Pragma("unroll") for (int m = 0; m < 4; ++m) _Pragma("unroll") for (int k = 0; k < 2; ++k) dst[m][k] = *(const PG8_LAS bf16x8*)(lds + PG8_SA(b, h) + aoff + m * 2048 + k * 1024); } while (0)
#define PG8_LDB(dst, b, h) do { _Pragma("unroll") for (int n = 0; n < 2; ++n) _Pragma("unroll") for (int k = 0; k < 2; ++k) dst[n][k] = *(const PG8_LAS bf16x8*)(lds + PG8_SB(b, h) + boff + n * 2048 + k * 1024); } while (0)
#define PG8_MMA(ai, bj, At, Bt) do { __builtin_amdgcn_s_setprio(1); _Pragma("unroll") for (int m = 0; m < 4; ++m) _Pragma("unroll") for (int n = 0; n < 2; ++n) _Pragma("unroll") for (int k = 0; k < 2; ++k) \
        acc[ai][bj][m][n] = __builtin_amdgcn_mfma_f32_16x16x32_bf16(Bt[n][k], At[m][k], acc[ai][bj][m][n], 0, 0, 0); __builtin_amdgcn_s_setprio(0); } while (0)
#define PG8_WAIT_V(n) asm volatile("s_waitcnt vmcnt(" #n ")" ::: "memory")
#define PG8_WAIT_L(n) asm volatile("s_waitcnt lgkmcnt(" #n ")" ::: "memory")
#define PG8_BAR __builtin_amdgcn_s_barrier()
#define PG8_SCHED __builtin_amdgcn_sched_barrier(0)
    Unit cur, nxt; int ui = 0;
    if (!S.next(0, cur)) return;
    f32x4 acc[2][2][4][2];
#pragma unroll
    for (int a = 0; a < 2; ++a)
#pragma unroll
        for (int b = 0; b < 2; ++b)
#pragma unroll
            for (int m = 0; m < 4; ++m)
#pragma unroll
                for (int n = 0; n < 2; ++n) acc[a][b][m][n] = (f32x4){0.f, 0.f, 0.f, 0.f};
    bf16x8 At[4][2], B0[2][2], B1[2][2];
    const char* cA = (const char*)g.A + (size_t)cur.pm * tstepA; const char* cB = (const char*)g.Bt + (size_t)cur.pn * tstepB;
    S.a_ready(cur);
    if constexpr (SP2) {
        PG8_STAGE(PG8_SB(0, 0), cB, voffB); PG8_STAGE(PG8_SB(0, 1), cB + hstepB, voffB); PG8_STAGE(PG8_SA(0, 0), cA, voffA); PG8_STAGE(PG8_SA(0, 1), cA + hstepA, voffA);
        if (wr == 1) PG8_BAR;
        PG8_WAIT_V(2); PG8_BAR;
        PG8_STAGE(PG8_SB(1, 0), cB + kstep, voffB); PG8_STAGE(PG8_SA(1, 0), cA + kstep, voffA); PG8_STAGE(PG8_SB(1, 1), cB + hstepB + kstep, voffB);
        PG8_WAIT_V(6); PG8_BAR;
    } else {
        PG8_STAGE(PG8_SB(0, 0), cB, voffB); PG8_STAGE(PG8_SA(0, 0), cA, voffA); PG8_STAGE(PG8_SB(0, 1), cB + hstepB, voffB); PG8_STAGE(PG8_SA(0, 1), cA + hstepA, voffA);
        if (wr == 1) PG8_BAR;
        PG8_WAIT_V(4); PG8_BAR;
        PG8_STAGE(PG8_SB(1, 0), cB + kstep, voffB); PG8_STAGE(PG8_SA(1, 0), cA + kstep, voffA); PG8_STAGE(PG8_SB(1, 1), cB + hstepB + kstep, voffB);
        PG8_WAIT_V(6); PG8_BAR;
    }
    for (;;) {
        const bool has_next = S.next(ui + 1, nxt);
        const char* nA = has_next ? (const char*)g.A + (size_t)nxt.pm * tstepA : cA; const char* nB = has_next ? (const char*)g.Bt + (size_t)nxt.pn * tstepB : cB;
        for (int t = 0; t < nt; t += 2) {
            const bool last = (t == nt - 2);
            const char* a1 = cA + (size_t)(t + 1) * kstep;
            const char* a2 = last ? nA : cA + (size_t)(t + 2) * kstep; const char* b2 = last ? nB : cB + (size_t)(t + 2) * kstep;
            const char* a3 = a2 + kstep; const char* b3 = b2 + kstep;
            if (last && has_next) S.a_ready(nxt);
            if constexpr (SP2) {
            PG8_LDB(B0, 0, 0); PG8_LDB(B1, 0, 1); PG8_SCHED; PG8_LDA(At, 0, 0); PG8_STAGE(PG8_SA(1, 1), a1 + hstepA, voffA);
            PG8_WAIT_V(8); PG8_WAIT_L(0); PG8_BAR; PG8_MMA(0, 0, At, B0); PG8_MMA(0, 1, At, B1); PG8_BAR; PG8_SCHED;
            PG8_LDA(At, 0, 1); PG8_STAGE(PG8_SB(0, 0), b2, voffB); PG8_STAGE(PG8_SB(0, 1), b2 + hstepB, voffB); PG8_STAGE(PG8_SA(0, 0), a2, voffA);
            PG8_WAIT_V(8); PG8_WAIT_L(0); PG8_BAR; PG8_MMA(1, 0, At, B0); PG8_MMA(1, 1, At, B1); PG8_BAR; PG8_SCHED;
            PG8_LDB(B0, 1, 0); PG8_LDB(B1, 1, 1); PG8_SCHED; PG8_LDA(At, 1, 0); PG8_STAGE(PG8_SA(0, 1), a2 + hstepA, voffA);
            PG8_WAIT_V(8); PG8_WAIT_L(0); PG8_BAR; PG8_MMA(0, 0, At, B0); PG8_MMA(0, 1, At, B1); PG8_BAR; PG8_SCHED;
            PG8_LDA(At, 1, 1); PG8_STAGE(PG8_SB(1, 0), b3, voffB); PG8_STAGE(PG8_SB(1, 1), b3 + hstepB, voffB); PG8_STAGE(PG8_SA(1, 0), a3, voffA);
            PG8_WAIT_V(8); PG8_WAIT_L(0); PG8_BAR; PG8_MMA(1, 0, At, B0); PG8_MMA(1, 1, At, B1); PG8_BAR; PG8_SCHED;
            } else {
            PG8_LDB(B0, 0, 0); PG8_SCHED; PG8_LDA(At, 0, 0); PG8_STAGE(PG8_SA(1, 1), a1 + hstepA, voffA);
            PG8_WAIT_L(8); PG8_BAR; PG8_WAIT_L(0); PG8_MMA(0, 0, At, B0); PG8_BAR; PG8_SCHED;
            PG8_LDB(B1, 0, 1); PG8_STAGE(PG8_SB(0, 0), b2, voffB);
            PG8_BAR; PG8_WAIT_L(0); PG8_MMA(0, 1, At, B1); PG8_BAR;
            PG8_LDA(At, 0, 1); PG8_STAGE(PG8_SA(0, 0), a2, voffA);
            PG8_BAR; PG8_WAIT_L(0); PG8_MMA(1, 0, At, B0); PG8_BAR; PG8_SCHED;
            PG8_STAGE(PG8_SB(0, 1), b2 + hstepB, voffB);
            PG8_WAIT_V(6); PG8_BAR; PG8_MMA(1, 1, At, B1); PG8_BAR;
            PG8_LDB(B0, 1, 0); PG8_SCHED; PG8_LDA(At, 1, 0); PG8_STAGE(PG8_SA(0, 1), a2 + hstepA, voffA);
            PG8_WAIT_L(8); PG8_BAR; PG8_WAIT_L(0); PG8_MMA(0, 0, At, B0); PG8_BAR; PG8_SCHED;
            PG8_LDB(B1, 1, 1); PG8_STAGE(PG8_SB(1, 0), b3, voffB);
            PG8_BAR; PG8_WAIT_L(0); PG8_MMA(0, 1, At, B1); PG8_BAR;
            PG8_LDA(At, 1, 1); PG8_STAGE(PG8_SA(1, 0), a3, voffA);
            PG8_BAR; PG8_WAIT_L(0); PG8_MMA(1, 0, At, B0); PG8_BAR; PG8_SCHED;
            PG8_STAGE(PG8_SB(1, 1), b3 + hstepB, voffB);
            PG8_WAIT_V(6); PG8_BAR; PG8_MMA(1, 1, At, B1); PG8_BAR;
            }
        }
        if constexpr (ALIGN_EPI) { if (wr == 0) PG8_BAR; }
        if constexpr (!Epi::AFTER_DRAIN) { E(acc, cur, wr, wc, fr, fq); S.done(cur); }
        if (!has_next) break;
#pragma unroll
        for (int a = 0; a < 2; ++a)
#pragma unroll
            for (int b = 0; b < 2; ++b)
#pragma unroll
                for (int m = 0; m < 4; ++m)
#pragma unroll
                    for (int n = 0; n < 2; ++n) acc[a][b][m][n] = (f32x4){0.f, 0.f, 0.f, 0.f};
        cur = nxt; cA = nA; cB = nB; ++ui;
        if constexpr (ALIGN_EPI) { if (wr == 1) PG8_BAR; }
    }
    PG8_WAIT_V(0);
    if constexpr (!ALIGN_EPI) { if (wr == 0) PG8_BAR; }
    PG8_BAR;
    if constexpr (Epi::AFTER_DRAIN) { E.fused(acc, cur, wr, wc, fr, fq, lds, wid, lane); S.done(cur); }
#undef PG8_SA
#undef PG8_SB
#undef PG8_STAGE
#undef PG8_LDA
#undef PG8_LDB
#undef PG8_MMA
#undef PG8_WAIT_V
#undef PG8_WAIT_L
#undef PG8_BAR
#undef PG8_SCHED
}
}

constexpr int S = 16384, DM = 1024, FF = 2816, FF2 = 5632, EVEN_SRC = 3664, EVEN_NP = 3840, ODD_N = 3072, NLAYER = 2, MEMT = 256, MEMW = 256;
constexpr float RMS_EPS = 1e-6f;
constexpr float LOG2E = 1.4426950408889634f;
constexpr float C2 = 0.125f * LOG2E;
constexpr int NWAVES = 8, NTHREADS = 512;
constexpr int EC_FQ = 0, EC_DQ = 512, EC_FK = 1024, EC_DK = 1536, EC_FV = 2048, EC_DV = 2560, EC_IQ = 3072, EC_IK = 3584;
constexpr int ES_FQ = 0, ES_FK = 512, ES_FV = 1024, ES_FL = 1536, ES_DQ = 1544, ES_DK = 2056, ES_DV = 2568, ES_IQ = 3080, ES_IK = 3592, ES_IW = 3656;

constexpr size_t MiB = 1u << 20;
constexpr size_t WS_CTL = 0, CTL_ZERO_BYTES = 1 * MiB;
constexpr size_t WS_SSQ = 1 * MiB;
constexpr size_t WS_KSUM = 6 * MiB;
constexpr size_t WS_ROPE = 2 * MiB;
constexpr size_t WS_FL = 3 * MiB;
constexpr size_t WS_MEMK = 4 * MiB;
constexpr size_t WS_IW = 5 * MiB;
constexpr size_t WS_W = 12 * MiB;
constexpr size_t WS_BIG = 60 * MiB;
constexpr size_t WS_HB = 224 * MiB;
constexpr size_t WS_END = 256 * MiB;
constexpr size_t W_FFN1_IN = 0, W_FFN1_OUT = 11 * MiB, W_MIX_IN = 17 * MiB, W_MIX_OUT = 25 * MiB, W_MEMQ = 27 * MiB, W_MEMO = 28 * MiB, W_FFN2_IN = 29 * MiB, W_FFN2_OUT = 40 * MiB;
constexpr size_t B_U = 0;
constexpr size_t B_PROJ = 0;
constexpr size_t B_VTF = 120 * MiB;
constexpr size_t B_IKC = 136 * MiB;
constexpr size_t B_VTM = 96 * MiB;
constexpr size_t B_SEL = 156 * MiB;
constexpr size_t B_QM = 140 * MiB, B_OM = 148 * MiB;
constexpr int CW_TMO = 0, CW_CODE = 1, CW_BAR = 4096;

constexpr int RING_BYTES = 147456;
constexpr int LDSCTL_OFF = RING_BYTES, MISC_OFF = LDSCTL_OFF + 320;
constexpr int LDS_BYTES = 163840;

#define GAS __attribute__((address_space(1)))
#define LAS __attribute__((address_space(3)))
typedef unsigned short bf16;
typedef unsigned v4u __attribute__((ext_vector_type(4)));
typedef float f32x4 __attribute__((ext_vector_type(4)));
typedef short bf16x8 __attribute__((ext_vector_type(8)));
typedef GAS unsigned gu32;
typedef GAS unsigned long long gu64;
#define RLX_AGENT __ATOMIC_RELAXED, __HIP_MEMORY_SCOPE_AGENT
#define LDS_WAIT() asm volatile("s_waitcnt lgkmcnt(0)" ::: "memory")
#define VM_WAIT() asm volatile("s_waitcnt vmcnt(0)" ::: "memory")
__device__ __forceinline__ unsigned long long rt() { return __builtin_amdgcn_s_memrealtime(); }
__device__ __forceinline__ unsigned f2bf(float f) { unsigned u = __builtin_bit_cast(unsigned, f); return (u + 0x7fffu + ((u >> 16) & 1u)) >> 16; }
__device__ __forceinline__ unsigned pk2(float lo, float hi) { return f2bf(lo) | (f2bf(hi) << 16); }

#define XB_TMO      128
#define XB_XCNT(j)  (256  + 64 * (j))
#define XB_XSUB(j)  (1280 + 64 * (j))
#define XB_XGEN(j)  (2304 + 64 * (j))
#define XB_TOP      3328
#define XB_TOPGEN   3392
#define XCD_BAR_WORDS 3456
#define XB_SPIN_CAP (1u << 18)

__device__ __forceinline__ unsigned xb_ld(unsigned* p)              { return __hip_atomic_load(p, __ATOMIC_RELAXED, __HIP_MEMORY_SCOPE_AGENT); }
__device__ __forceinline__ unsigned xb_add(unsigned* p, unsigned v) { return __hip_atomic_fetch_add(p, v, __ATOMIC_RELAXED, __HIP_MEMORY_SCOPE_AGENT); }
__device__ __forceinline__ unsigned xb_xcc_id() { return (unsigned)__builtin_amdgcn_s_getreg((3 << 11) | 20) & 0xFu; }
#define XB_SPIN(cond, bar) do { unsigned _sp = 0; while (cond) { __builtin_amdgcn_s_sleep(1); \
    if ((++_sp & 255u) == 0u) { if (xb_ld(&(bar)[XB_TMO])) break; if (_sp > XB_SPIN_CAP) { atomicAdd(&(bar)[XB_TMO], 1u); break; } } } } while (0)

struct XcdBarrier {
    unsigned* bar; unsigned x;
    volatile LAS unsigned* st;
};

__device__ __forceinline__ XcdBarrier xcd_barrier_post(unsigned* bar, volatile LAS unsigned* st) {
    XcdBarrier b; b.bar = bar; b.x = xb_xcc_id(); b.st = st;
    if (threadIdx.x == 0) (void)xb_add(&bar[XB_XCNT(b.x)], 1u);
    return b;
}
__device__ __forceinline__ void xcd_barrier_complete(unsigned* bar, unsigned x, unsigned& nloc, unsigned& nx) {
    const unsigned G = gridDim.x * gridDim.y * gridDim.z;
    unsigned sum, cnt, mine, sp = 0u;
    for (;;) {
        sum = 0u; cnt = 0u; mine = 0u;
#pragma unroll
        for (unsigned j = 0; j < 16; ++j) { const unsigned c = xb_ld(&bar[XB_XCNT(j)]); sum += c; cnt += (c > 0u) ? 1u : 0u; mine = (j == x) ? c : mine; }
        if (sum == G) break;
        __builtin_amdgcn_s_sleep(1);
        if ((++sp & 255u) == 0u) { if (xb_ld(&bar[XB_TMO])) break; if (sp > XB_SPIN_CAP) { atomicAdd(&bar[XB_TMO], 1u); break; } }
    }
    nloc = mine > 0u ? mine : 1u; nx = cnt > 0u ? cnt : 1u;
}

__device__ __forceinline__ void xcd_barrier(const XcdBarrier& b) {
    asm volatile("s_waitcnt vmcnt(0)" ::: "memory");
    __syncthreads();
    if (threadIdx.x == 0) {
        unsigned* bar = b.bar;
        __builtin_amdgcn_s_waitcnt(0);
        unsigned nloc = b.st[0], nx = b.st[1];
        if (nloc == 0u) { xcd_barrier_complete(bar, b.x, nloc, nx); b.st[0] = nloc; b.st[1] = nx; }
        const unsigned old = xb_add(&bar[XB_XSUB(b.x)], 1u);
        const unsigned gen = old / nloc;
        if (old + 1u == (gen + 1u) * nloc) {
            __builtin_amdgcn_fence(__ATOMIC_RELEASE, "agent");
            asm volatile("s_waitcnt vmcnt(0)" ::: "memory");
            const unsigned og = xb_add(&bar[XB_TOP], 1u);
            const unsigned tg = og / nx;
            if (og + 1u == (tg + 1u) * nx) xb_add(&bar[XB_TOPGEN], 1u);
            else XB_SPIN(xb_ld(&bar[XB_TOPGEN]) == tg, bar);
            __builtin_amdgcn_fence(__ATOMIC_ACQUIRE, "agent");
            xb_add(&bar[XB_XGEN(b.x)], 1u);
            asm volatile("s_waitcnt vmcnt(0)" ::: "memory");
        } else {
            XB_SPIN(xb_ld(&bar[XB_XGEN(b.x)]) == gen, bar);
            __builtin_amdgcn_fence(__ATOMIC_ACQUIRE, "agent");
            asm volatile("s_waitcnt vmcnt(0)" ::: "memory");
        }
    }
    __syncthreads();
}

typedef float f32x16 __attribute__((ext_vector_type(16)));
typedef float f32x2_t __attribute__((ext_vector_type(2)));
typedef __bf16 bf16x2_t __attribute__((ext_vector_type(2)));
typedef unsigned u32x2 __attribute__((ext_vector_type(2)));
__device__ __forceinline__ unsigned cvtpk(float lo, float hi) { f32x2_t v = {lo, hi}; bf16x2_t b = __builtin_convertvector(v, bf16x2_t); return __builtin_bit_cast(unsigned, b); }
__device__ __forceinline__ float bflo(unsigned w) { return __uint_as_float(w << 16); }
__device__ __forceinline__ float bfhi(unsigned w) { return __uint_as_float(w & 0xffff0000u); }
__device__ __forceinline__ void unpack8(const v4u& w, float (&x)[8]) { x[0] = bflo(w.x); x[1] = bfhi(w.x); x[2] = bflo(w.y); x[3] = bfhi(w.y); x[4] = bflo(w.z); x[5] = bfhi(w.z); x[6] = bflo(w.w); x[7] = bfhi(w.w); }
__device__ __forceinline__ v4u pack8(const float (&x)[8]) { v4u w; w.x = cvtpk(x[0], x[1]); w.y = cvtpk(x[2], x[3]); w.z = cvtpk(x[4], x[5]); w.w = cvtpk(x[6], x[7]); return w; }
__device__ __forceinline__ float wave_sum(float v) { v += shx<1>(v); v += shx<2>(v); v += shx<4>(v); v += shx<8>(v); v += shx<16>(v); return sh32_sum(v); }
__device__ __forceinline__ float wave_max(float v) { v = fmaxf(v, shx<1>(v)); v = fmaxf(v, shx<2>(v)); v = fmaxf(v, shx<4>(v)); v = fmaxf(v, shx<8>(v)); v = fmaxf(v, shx<16>(v)); return sh32_max(v); }
__device__ __forceinline__ int crow(int r, int hi) { return (r & 3) + 8 * (r >> 2) + 4 * hi; }

__device__ __forceinline__ int even_map(int n) {
    if (n < 512) return ES_FQ + n;
    if (n < 1024) return ES_DQ + (n - 512);
    if (n < 1536) return ES_FK + (n - 1024);
    if (n < 2048) return ES_DK + (n - 1536);
    if (n < 2560) return ES_FV + (n - 2048);
    if (n < 3072) return ES_DV + (n - 2560);
    if (n < 3584) return ES_IQ + (n - 3072);
    if (n < 3648) return ES_IK + (n - 3584);
    return -1;
}
__device__ __forceinline__ void conv_item(const float* W, int K, int Nsrc, int nblk, const float* gain, bf16* WT, int mode, LAS float* scr, int item, int lane) {
    const int kb = item / nblk, nb = item % nblk, k0 = 64 * kb, n0 = 32 * nb;
    const int n = n0 + (lane & 31);
    int sc;
    if (mode == 0) sc = n; else if (mode == 1) { const int T = n >> 8, hf = (n >> 7) & 1, j = n & 127; sc = hf * FF + 128 * T + j; } else sc = even_map(n);
#pragma unroll 8
    for (int i = 0; i < 32; ++i) { const int kk = 2 * i + (lane >> 5); float v = 0.f;
        if (sc >= 0) { v = W[(size_t)(k0 + kk) * Nsrc + sc]; if (gain) v *= gain[k0 + kk]; }
        scr[kk * 33 + (lane & 31)] = v; }
    LDS_WAIT(); asm volatile("" ::: "memory");
    const int c = lane & 7;
#pragma unroll
    for (int j = 0; j < 4; ++j) { const int nn = (lane >> 3) + 8 * j; const LAS float* s = scr + (8 * c) * 33 + nn;
        v4u o; o.x = cvtpk(s[0 * 33], s[1 * 33]); o.y = cvtpk(s[2 * 33], s[3 * 33]); o.z = cvtpk(s[4 * 33], s[5 * 33]); o.w = cvtpk(s[6 * 33], s[7 * 33]);
        *(GAS v4u*)(WT + (size_t)(n0 + nn) * K + k0 + 8 * c) = o; }
    LDS_WAIT(); asm volatile("" ::: "memory");
}
struct InPtrs { const float* p[26]; };
__device__ __forceinline__ void conv_weights(const InPtrs& in, unsigned char* ws, int L, LAS unsigned char* lds, int gw, int NGW, int wave, int lane) {
    LAS float* scr = (LAS float*)(lds + wave * 16384);
    bf16* Wr = (bf16*)(ws + WS_W);
    const float* ffn1_norm = in.p[2] + (size_t)L * DM; const float* ffn1_in = in.p[3] + (size_t)L * DM * FF2; const float* ffn1_out = in.p[4] + (size_t)L * FF * DM;
    const float* mix_norm = in.p[5] + (size_t)L * DM; const float* mix_out = in.p[15] + (size_t)L * DM * DM;
    const float* memx_norm = in.p[16] + (size_t)L * DM; const float* mem_wq = in.p[18] + (size_t)L * DM * MEMW; const float* mem_wo = in.p[22] + (size_t)L * MEMW * DM;
    const float* ffn2_norm = in.p[23] + (size_t)L * DM; const float* ffn2_in = in.p[24] + (size_t)L * DM * FF2; const float* ffn2_out = in.p[25] + (size_t)L * FF * DM;
    const bool even = (L & 1) == 0;
    const float* mix_in = even ? in.p[6] : in.p[12];
    const int mixN = even ? EVEN_NP : ODD_N, mixSrc = even ? EVEN_SRC : ODD_N;
    const int I_FIN = (DM / 64) * (FF2 / 32), I_FOUT = (FF / 64) * (DM / 32), I_MIN = (DM / 64) * (mixN / 32), I_MOUT = (DM / 64) * (DM / 32), I_MQ = (DM / 64) * (MEMW / 32), I_MO = (MEMW / 64) * (DM / 32);
    const int NITEMS = 2 * I_FIN + 2 * I_FOUT + I_MIN + I_MOUT + I_MQ + I_MO;
    for (int it = gw; it < NITEMS; it += NGW) {
        int r = it;
        if (r < I_FIN) { conv_item(ffn1_in, DM, FF2, FF2 / 32, ffn1_norm, (bf16*)((unsigned char*)Wr + W_FFN1_IN), 1, scr, r, lane); continue; } r -= I_FIN;
        if (r < I_FIN) { conv_item(ffn2_in, DM, FF2, FF2 / 32, ffn2_norm, (bf16*)((unsigned char*)Wr + W_FFN2_IN), 1, scr, r, lane); continue; } r -= I_FIN;
        if (r < I_FOUT) { conv_item(ffn1_out, FF, DM, DM / 32, nullptr, (bf16*)((unsigned char*)Wr + W_FFN1_OUT), 0, scr, r, lane); continue; } r -= I_FOUT;
        if (r < I_FOUT) { conv_item(ffn2_out, FF, DM, DM / 32, nullptr, (bf16*)((unsigned char*)Wr + W_FFN2_OUT), 0, scr, r, lane); continue; } r -= I_FOUT;
        if (r < I_MIN) { conv_item(mix_in, DM, mixSrc, mixN / 32, mix_norm, (bf16*)((unsigned char*)Wr + W_MIX_IN), even ? 2 : 0, scr, r, lane); continue; } r -= I_MIN;
        if (r < I_MOUT) { conv_item(mix_out, DM, DM, DM / 32, nullptr, (bf16*)((unsigned char*)Wr + W_MIX_OUT), 0, scr, r, lane); continue; } r -= I_MOUT;
        if (r < I_MQ) { conv_item(mem_wq, DM, MEMW, MEMW / 32, memx_norm, (bf16*)((unsigned char*)Wr + W_MEMQ), 0, scr, r, lane); continue; } r -= I_MQ;
        conv_item(mem_wo, MEMW, DM, DM / 32, nullptr, (bf16*)((unsigned char*)Wr + W_MEMO), 0, scr, r, lane);
    }
}
__device__ __forceinline__ void copy_x(const float* x, float* out, bf16* HB, float* ssq0, int gw, int NGW, int lane) {
    for (int m = gw; m < S; m += NGW) {
        const GAS f32x4* xr = (const GAS f32x4*)(x + (size_t)m * DM) + lane; GAS f32x4* orow = (GAS f32x4*)(out + (size_t)m * DM) + lane;
        GAS u32x2* hb = (GAS u32x2*)(HB + (size_t)m * DM) + lane;
        float s = 0.f;
#pragma unroll
        for (int j = 0; j < 4; ++j) { const f32x4 v = xr[64 * j]; orow[64 * j] = v; s += (v.x * v.x + v.y * v.y) + (v.z * v.z + v.w * v.w);
            u32x2 w; w.x = cvtpk(v.x, v.y); w.y = cvtpk(v.z, v.w); hb[64 * j] = w; }
        s = wave_sum(s);
        if (lane < 16) ssq0[(size_t)m * 16 + lane] = (lane == 0) ? s : 0.f;
    }
}
__device__ __forceinline__ void rope_tables(float* cosT, float* sinT, int gtid, int nthreads) {
    for (int idx = gtid; idx < S * 8; idx += nthreads) {
        const int t = idx >> 3, j = idx & 7;
        float inv;
        switch (j) { case 0: inv = 1.0f; break; case 1: inv = 0.193922743f; break; case 2: inv = 0.0376060307f; break; case 3: inv = 0.00729266461f; break;
                     case 4: inv = 0.00141421356f; break; case 5: inv = 0.000274248188f; break; case 6: inv = 5.3182961e-05f; break; default: inv = 1.03133862e-05f; break; }
        const float ang = (float)t * inv;
        const float kq = __builtin_rintf(ang * 0.63661977236758134f);
        float r = ang - kq * 1.5703125f; r = r - kq * 0.00048351287841796875f; r = r - kq * 3.1391647326017846e-07f;
        const float r2 = r * r;
        float sp = 2.7557319e-6f; sp = sp * r2 - 1.9841270e-4f; sp = sp * r2 + 8.3333333e-3f; sp = sp * r2 - 1.6666667e-1f; const float sn = r + r * r2 * sp;
        float cp = -2.7557319e-7f; cp = cp * r2 + 2.4801587e-5f; cp = cp * r2 - 1.3888889e-3f; cp = cp * r2 + 4.1666667e-2f; cp = cp * r2 - 0.5f; const float cs = 1.0f + r2 * cp;
        const int q = ((int)kq) & 3;
        const float sv = (q == 0) ? sn : (q == 1) ? cs : (q == 2) ? -sn : -cs;
        const float cv = (q == 0) ? cs : (q == 1) ? -sn : (q == 2) ? -cs : sn;
        cosT[idx] = cv; sinT[idx] = sv;
    }
}
__device__ __forceinline__ void mem_kv(const InPtrs& in, unsigned char* ws, LAS unsigned char* lds, int w, int tid, int wave, int lane) {
    LAS float* memn = (LAS float*)lds;
    LAS float* red = (LAS float*)(lds + 4096);
    bf16* memK = (bf16*)(ws + WS_MEMK); bf16* memVt = (bf16*)(ws + WS_MEMK + 256 * 1024);
    for (int L = 0; L < NLAYER; ++L) {
        const float* mrow = in.p[1] + (size_t)w * DM; const float* gm = in.p[17] + (size_t)L * DM; const float* wkv = in.p[19] + (size_t)L * DM * 512; const float* kn = in.p[21] + (size_t)L * 64;
        const float x0 = mrow[tid], x1 = mrow[tid + 512];
        float s = wave_sum(x0 * x0 + x1 * x1);
        if (lane == 0) red[wave] = s;
        __syncthreads();
        float tot = 0.f;
#pragma unroll
        for (int i = 0; i < 8; ++i) tot += red[i];
        const float rstd = rsqrtf(tot * (1.0f / DM) + RMS_EPS);
        memn[tid] = x0 * rstd * gm[tid]; memn[tid + 512] = x1 * rstd * gm[tid + 512];
        __syncthreads();
        float acc = 0.f;
#pragma unroll 8
        for (int k = 0; k < DM; ++k) acc += memn[k] * wkv[(size_t)k * 512 + tid];
        if (tid < 256) {
            const float ss = wave_sum(acc * acc);
            const float y = acc * rsqrtf(ss * (1.0f / 64.0f) + RMS_EPS) * kn[tid & 63];
            memK[(size_t)L * 256 * 256 + (size_t)w * 256 + tid] = (bf16)(cvtpk(y, 0.f) & 0xffffu);
        } else {
            const int c = tid - 256;
            memVt[(size_t)L * 256 * 256 + (size_t)c * 256 + w] = (bf16)(cvtpk(acc, 0.f) & 0xffffu);
        }
        __syncthreads();
    }
}

__device__ __forceinline__ void head_norm8(float (&x)[8], const float* gain, int lane) {
    float ss = 0.f;
#pragma unroll
    for (int j = 0; j < 8; ++j) ss += x[j] * x[j];
    ss += shx<1>(ss); ss += shx<2>(ss); ss += shx<4>(ss);
    const float r = rsqrtf(ss * (1.0f / 64.0f) + RMS_EPS);
    const int d0 = 8 * (lane & 7);
#pragma unroll
    for (int j = 0; j < 8; ++j) x[j] = x[j] * r * gain[d0 + j];
}
__device__ __forceinline__ void rope8(float (&x)[8], const float (&cs)[8], const float (&sn)[8], int lane) {
    const int sub = lane & 7;
#pragma unroll
    for (int j = 0; j < 8; ++j) {
        const float other = shx<1>(x[j]);
        if (sub == 0) x[j] = x[j] * cs[j] - other * sn[j];
        else if (sub == 1) x[j] = x[j] * cs[j] + other * sn[j];
    }
}
__device__ __forceinline__ float sh32_get(float v, int lane) { auto r = __builtin_amdgcn_permlane32_swap(__float_as_uint(v), __float_as_uint(v), false, false); return __uint_as_float((lane < 32) ? r[1] : r[0]); }
__device__ __forceinline__ float reduce_scatter64(float (&v)[64], int lane) {
    { const bool up = (lane & 32) != 0;
#pragma unroll
      for (int j = 0; j < 32; ++j) { const float send = up ? v[j] : v[j + 32], keep = up ? v[j + 32] : v[j]; v[j] = keep + sh32_get(send, lane); } }
    { const bool up = (lane & 16) != 0;
#pragma unroll
      for (int j = 0; j < 16; ++j) { const float send = up ? v[j] : v[j + 16], keep = up ? v[j + 16] : v[j]; v[j] = keep + shx<16>(send); } }
    { const bool up = (lane & 8) != 0;
#pragma unroll
      for (int j = 0; j < 8; ++j) { const float send = up ? v[j] : v[j + 8], keep = up ? v[j + 8] : v[j]; v[j] = keep + shx<8>(send); } }
    { const bool up = (lane & 4) != 0;
#pragma unroll
      for (int j = 0; j < 4; ++j) { const float send = up ? v[j] : v[j + 4], keep = up ? v[j + 4] : v[j]; v[j] = keep + shx<4>(send); } }
    { const bool up = (lane & 2) != 0;
#pragma unroll
      for (int j = 0; j < 2; ++j) { const float send = up ? v[j] : v[j + 2], keep = up ? v[j + 2] : v[j]; v[j] = keep + shx<2>(send); } }
    { const bool up = (lane & 1) != 0; const float send = up ? v[0] : v[1], keep = up ? v[1] : v[0]; v[0] = keep + shx<1>(send); }
    return v[0];
}
__device__ __forceinline__ void post_even(const InPtrs& in, unsigned char* ws, const float* H, const float* ssq, LAS unsigned char* lds, int G, int tid, int wave, int lane) {
    bf16* proj = (bf16*)(ws + WS_BIG + B_PROJ); bf16* VtF = (bf16*)(ws + WS_BIG + B_VTF); bf16* IKc = (bf16*)(ws + WS_BIG + B_IKC);
    const float* cosT = (const float*)(ws + WS_ROPE); const float* sinT = cosT + S * 8;
    float* Flocal = (float*)(ws + WS_FL); float* Btot = Flocal + S * 8; float* IW = (float*)(ws + WS_IW);
    const float* fqn = in.p[8]; const float* fkn = in.p[9]; const float* dqn = in.p[10]; const float* dkn = in.p[11]; const float* bfg = in.p[7];
    const float* Wsrc = in.p[6]; const float* mixg = in.p[5];
    constexpr int FVP = 1040;
    LAS f32x4* Tw = (LAS f32x4*)lds;
    LAS unsigned char* fvbuf = lds + 65536; LAS float* lf = (LAS float*)(lds + 65536 + 64 * FVP);
    for (int idx = tid; idx < 1024 * 16; idx += NTHREADS) {
        const int k = idx >> 4, col = idx & 15;
        const float v = mixg[k] * Wsrc[(size_t)k * EVEN_SRC + (col < 8 ? ES_FL + col : ES_IW + col - 8)];
        const int ln = (k & 255) >> 2, e = k & 3, q = k >> 8, c = col >> 2;
        ((LAS float*)Tw)[((((q * 4 + e) * 4 + c) * 64 + ln) << 2) + (col & 3)] = v;
    }
    __syncthreads();
    const int d0 = 8 * (lane & 7);
    for (int u = blockIdx.x; u < S / 64; u += G) {
        const int t0 = u * 64, tw0 = t0 + wave * 8;
        bf16* rowb = proj + (size_t)tw0 * EVEN_NP + lane * 8;
        v4u raw[8];
#pragma unroll
        for (int sec = 0; sec < 5; ++sec) {
            const int coff = (sec == 0) ? EC_FQ : (sec == 1) ? EC_DQ : (sec == 2) ? EC_FK : (sec == 3) ? EC_DK : EC_IQ;
            const float* gn = (sec == 0) ? fqn : (sec == 1) ? dqn : (sec == 2) ? fkn : dkn;
            float gv[8];
            if (sec < 4) {
#pragma unroll
                for (int j = 0; j < 8; ++j) gv[j] = gn[d0 + j]; }
#pragma unroll
            for (int i = 0; i < 8; ++i) raw[i] = *(const GAS v4u*)(rowb + (size_t)i * EVEN_NP + coff);
#pragma unroll
            for (int i = 0; i < 8; ++i) {
                float x[8]; unpack8(raw[i], x);
                if (sec < 4) { float ss = 0.f;
#pragma unroll
                    for (int j = 0; j < 8; ++j) ss += x[j] * x[j];
                    ss += shx<1>(ss); ss += shx<2>(ss); ss += shx<4>(ss);
                    const float r = rsqrtf(ss * (1.0f / 64.0f) + RMS_EPS);
#pragma unroll
                    for (int j = 0; j < 8; ++j) x[j] = x[j] * r * gv[j]; }
                if (sec == 1 || sec == 3 || sec == 4) { float cs[8], sn[8]; const int t = tw0 + i;
#pragma unroll
                    for (int j = 0; j < 8; ++j) { cs[j] = cosT[t * 8 + j]; sn[j] = sinT[t * 8 + j]; }
                    rope8(x, cs, sn, lane); }
                *(GAS v4u*)(rowb + (size_t)i * EVEN_NP + coff) = pack8(x);
            }
        }
#pragma unroll
        for (int i = 0; i < 8; ++i) raw[i] = *(const GAS v4u*)(rowb + (size_t)i * EVEN_NP + EC_FV);
#pragma unroll
        for (int i = 0; i < 8; ++i) *(LAS v4u*)(fvbuf + (wave * 8 + i) * FVP + lane * 16) = raw[i];
#pragma unroll
        for (int i = 0; i < 8; ++i) { raw[i] = (v4u){0u, 0u, 0u, 0u}; if (lane < 8) raw[i] = *(const GAS v4u*)(rowb + (size_t)i * EVEN_NP + EC_IK); }
#pragma unroll
        for (int i = 0; i < 8; ++i) { float x[8]; unpack8(raw[i], x); float cs[8], sn[8]; const int t = tw0 + i;
#pragma unroll
            for (int j = 0; j < 8; ++j) { cs[j] = cosT[t * 8 + j]; sn[j] = sinT[t * 8 + j]; }
            rope8(x, cs, sn, lane); if (lane < 8) *(GAS v4u*)(IKc + (size_t)t * 64 + lane * 8) = pack8(x); }
#pragma unroll 1
        for (int rb = 0; rb < 2; ++rb) {
            float acc[64];
#pragma unroll
            for (int j = 0; j < 64; ++j) acc[j] = 0.f;
#pragma unroll
            for (int q = 0; q < 4; ++q) {
                f32x4 hv[4];
#pragma unroll
                for (int r = 0; r < 4; ++r) hv[r] = *((const GAS f32x4*)(H + (size_t)(tw0 + rb * 4 + r) * DM) + lane + 64 * q);
#pragma unroll
                for (int e = 0; e < 4; ++e)
#pragma unroll
                    for (int c = 0; c < 4; ++c) { const f32x4 w = Tw[((q * 4 + e) * 4 + c) * 64 + lane];
#pragma unroll
                        for (int r = 0; r < 4; ++r) { acc[r * 16 + 4 * c + 0] += hv[r][e] * w[0]; acc[r * 16 + 4 * c + 1] += hv[r][e] * w[1]; acc[r * 16 + 4 * c + 2] += hv[r][e] * w[2]; acc[r * 16 + 4 * c + 3] += hv[r][e] * w[3]; } }
            }
            const float zs = reduce_scatter64(acc, lane);
            const int rl = wave * 8 + rb * 4 + (lane >> 4), t = t0 + rl, j = lane & 15;
            const float z = zs * pg8::row_rstd(ssq, t);
            if (j < 8) { const float zz = z + bfg[j]; lf[rl * 8 + j] = (zz > 15.f) ? -expf(-zz) : -log1pf(expf(-zz)); }
            else IW[(size_t)t * 8 + (j - 8)] = z * 0.044194173824159216f;
        }
        __syncthreads();
        {
            float v = lf[lane * 8 + wave];
#pragma unroll
            for (int o = 1; o < 64; o <<= 1) { const float up = __int_as_float(__builtin_amdgcn_ds_bpermute(((lane - o) & 63) << 2, __float_as_int(v))); if (lane >= o) v += up; }
            Flocal[(size_t)(t0 + lane) * 8 + wave] = v;
            if (lane == 63) Btot[u * 8 + wave] = v;
        }
#pragma unroll 2
        for (int p = 0; p < 8; ++p) {
            const int item = p * 512 + tid, c = item >> 3, k = item & 7;
            unsigned short e[8];
#pragma unroll
            for (int j = 0; j < 8; ++j) e[j] = *(const LAS unsigned short*)(fvbuf + (8 * k + j) * FVP + c * 2);
            v4u o; o.x = e[0] | ((unsigned)e[1] << 16); o.y = e[2] | ((unsigned)e[3] << 16); o.z = e[4] | ((unsigned)e[5] << 16); o.w = e[6] | ((unsigned)e[7] << 16);
            *(GAS v4u*)(VtF + (size_t)c * S + t0 + 8 * k) = o;
        }
        __syncthreads();
    }
}
__device__ __forceinline__ void post_odd(const InPtrs& in, unsigned char* ws, LAS unsigned char* lds, int G, int tid, int wave, int lane) {
    bf16* Q = (bf16*)(ws + WS_BIG + B_PROJ); bf16* Kb = Q + (size_t)S * DM; bf16* V = Kb + (size_t)S * DM; bf16* Vt = (bf16*)(ws + WS_BIG + B_VTM);
    const float* cosT = (const float*)(ws + WS_ROPE); const float* sinT = cosT + S * 8;
    float* ksum = (float*)(ws + WS_KSUM);
    const float* qn = in.p[13]; const float* kn = in.p[14];
    constexpr int VP = 1040;
    LAS unsigned char* vbuf = lds; LAS float* kred = (LAS float*)(lds + 64 * VP);
    for (int u = blockIdx.x; u < S / 64; u += G) {
        const int t0 = u * 64;
        float ks0[8], ks1[8];
#pragma unroll
        for (int j = 0; j < 8; ++j) { ks0[j] = 0.f; ks1[j] = 0.f; }
        const int tw0 = t0 + wave * 8, d0 = 8 * (lane & 7);
        v4u raw[8];
#pragma unroll
        for (int sec4 = 0; sec4 < 4; ++sec4) {
            const bool isk = sec4 >= 2; const int sec = sec4 & 1;
            bf16* base = (isk ? Kb : Q) + (size_t)tw0 * DM + sec * 512 + lane * 8;
            const float* gn = isk ? kn : qn;
            float gv[8];
#pragma unroll
            for (int j = 0; j < 8; ++j) gv[j] = gn[d0 + j];
#pragma unroll
            for (int i = 0; i < 8; ++i) raw[i] = *(const GAS v4u*)(base + (size_t)i * DM);
#pragma unroll
            for (int i = 0; i < 8; ++i) {
                float x[8]; unpack8(raw[i], x); float ss = 0.f;
#pragma unroll
                for (int j = 0; j < 8; ++j) ss += x[j] * x[j];
                ss += shx<1>(ss); ss += shx<2>(ss); ss += shx<4>(ss);
                const float r = rsqrtf(ss * (1.0f / 64.0f) + RMS_EPS);
#pragma unroll
                for (int j = 0; j < 8; ++j) x[j] = x[j] * r * gv[j];
                float cs[8], sn[8]; const int t = tw0 + i;
#pragma unroll
                for (int j = 0; j < 8; ++j) { cs[j] = cosT[t * 8 + j]; sn[j] = sinT[t * 8 + j]; }
                rope8(x, cs, sn, lane);
                *(GAS v4u*)(base + (size_t)i * DM) = pack8(x);
                if (isk) {
#pragma unroll
                    for (int j = 0; j < 8; ++j) { if (sec == 0) ks0[j] += x[j]; else ks1[j] += x[j]; } }
            }
        }
#pragma unroll
        for (int j = 0; j < 8; ++j) { kred[wave * 1024 + lane * 8 + j] = ks0[j]; kred[wave * 1024 + 512 + lane * 8 + j] = ks1[j]; }
        __syncthreads();
        {
#pragma unroll
            for (int e = 0; e < 2; ++e) { const int c = tid + 512 * e; float s = 0.f;
#pragma unroll
                for (int w8 = 0; w8 < 8; ++w8) s += kred[w8 * 1024 + c];
                ksum[(size_t)u * 1024 + c] = s; }
        }
        for (int half = 0; half < 2; ++half) {
#pragma unroll
            for (int i = 0; i < 8; ++i) raw[i] = *(const GAS v4u*)(V + (size_t)(tw0 + i) * DM + half * 512 + lane * 8);
#pragma unroll
            for (int i = 0; i < 8; ++i) *(LAS v4u*)(vbuf + (wave * 8 + i) * VP + lane * 16) = raw[i];
            __syncthreads();
#pragma unroll 2
            for (int p = 0; p < 8; ++p) {
                const int item = p * 512 + tid, c = item >> 3, k = item & 7;
                unsigned short e[8];
#pragma unroll
                for (int j = 0; j < 8; ++j) e[j] = *(const LAS unsigned short*)(vbuf + (8 * k + j) * VP + c * 2);
                v4u o; o.x = e[0] | ((unsigned)e[1] << 16); o.y = e[2] | ((unsigned)e[3] << 16); o.z = e[4] | ((unsigned)e[5] << 16); o.w = e[6] | ((unsigned)e[7] << 16);
                *(GAS v4u*)(Vt + (size_t)(half * 512 + c) * S + t0 + 8 * k) = o;
            }
            __syncthreads();
        }
    }
}

constexpr int KV_K_BYTES = 8192, KV_VT_PITCH = 136, KV_BUF_BYTES = KV_K_BYTES + 64 * KV_VT_PITCH;
struct KVRegs { v4u k, v; };
__device__ __forceinline__ void kv_load(KVRegs& r, const bf16* Kp, size_t kpitch, const bf16* Vtp, size_t vtpitch, int key0, int tid) {
    r.k = *(const GAS v4u*)(Kp + (size_t)(key0 + (tid & 63)) * kpitch + (tid >> 6) * 8);
    r.v = *(const GAS v4u*)(Vtp + (size_t)(tid >> 3) * vtpitch + key0 + (tid & 7) * 8);
}
__device__ __forceinline__ void kv_store(const KVRegs& r, LAS unsigned char* buf, int tid) {
    *(LAS v4u*)(buf + ((tid >> 6) * 64 + (tid & 63)) * 16) = r.k;
    LAS unsigned char* vp = buf + KV_K_BYTES + (tid >> 3) * KV_VT_PITCH + (tid & 7) * 16;
    *(LAS u32x2*)vp = (u32x2){r.v.x, r.v.y}; *(LAS u32x2*)(vp + 8) = (u32x2){r.v.z, r.v.w};
}
struct AttnAcc { float m, l; f32x16 o0, o1; };
__device__ __forceinline__ void attn_init(AttnAcc& a) { a.m = -INFINITY; a.l = 0.f;
#pragma unroll
    for (int r = 0; r < 16; ++r) { a.o0[r] = 0.f; a.o1[r] = 0.f; } }
__device__ __forceinline__ void attn_scores(f32x16& p0, f32x16& p1, const LAS unsigned char* buf, const bf16x8 (&qf)[4], int lane) {
    const int r32 = lane & 31, hi = lane >> 5;
#pragma unroll
    for (int r = 0; r < 16; ++r) { p0[r] = 0.f; p1[r] = 0.f; }
#pragma unroll
    for (int ks = 0; ks < 4; ++ks) {
        const bf16x8 k0 = *(const LAS bf16x8*)(buf + ((2 * ks + hi) * 64 + r32) * 16);
        const bf16x8 k1 = *(const LAS bf16x8*)(buf + ((2 * ks + hi) * 64 + 32 + r32) * 16);
        p0 = __builtin_amdgcn_mfma_f32_32x32x16_bf16(k0, qf[ks], p0, 0, 0, 0);
        p1 = __builtin_amdgcn_mfma_f32_32x32x16_bf16(k1, qf[ks], p1, 0, 0, 0);
    }
}
__device__ __forceinline__ void attn_update(AttnAcc& a, f32x16& p0, f32x16& p1, const LAS unsigned char* buf, int lane) {
    const int r32 = lane & 31, hi = lane >> 5;
    float mx = fmaxf(p0[0], p1[0]);
#pragma unroll
    for (int r = 1; r < 16; ++r) mx = fmaxf(mx, fmaxf(p0[r], p1[r]));
    mx = sh32_max(mx);
    const float mnew = fmaxf(a.m, mx);
    const float msafe = (mnew == -INFINITY) ? 0.f : mnew;
    const float alpha = __builtin_amdgcn_exp2f(a.m - msafe);
    float sum = 0.f;
#pragma unroll
    for (int r = 0; r < 16; ++r) { p0[r] = __builtin_amdgcn_exp2f(p0[r] - msafe); p1[r] = __builtin_amdgcn_exp2f(p1[r] - msafe); sum += p0[r] + p1[r]; }
    a.l = a.l * alpha + sum; a.m = mnew;
#pragma unroll
    for (int r = 0; r < 16; ++r) { a.o0[r] *= alpha; a.o1[r] *= alpha; }
    const LAS unsigned char* vt = buf + KV_K_BYTES + r32 * KV_VT_PITCH + hi * 8;
#pragma unroll
    for (int half = 0; half < 2; ++half) {
#pragma unroll
        for (int s = 0; s < 2; ++s) {
            v4u pw;
            if (half == 0) { pw.x = cvtpk(p0[8 * s + 0], p0[8 * s + 1]); pw.y = cvtpk(p0[8 * s + 2], p0[8 * s + 3]); pw.z = cvtpk(p0[8 * s + 4], p0[8 * s + 5]); pw.w = cvtpk(p0[8 * s + 6], p0[8 * s + 7]); }
            else           { pw.x = cvtpk(p1[8 * s + 0], p1[8 * s + 1]); pw.y = cvtpk(p1[8 * s + 2], p1[8 * s + 3]); pw.z = cvtpk(p1[8 * s + 4], p1[8 * s + 5]); pw.w = cvtpk(p1[8 * s + 6], p1[8 * s + 7]); }
            const bf16x8 pb = __builtin_bit_cast(bf16x8, pw);
            const int kb = (32 * half + 16 * s) * 2;
#pragma unroll
            for (int d0 = 0; d0 < 2; ++d0) {
                const u32x2 lo = *(const LAS u32x2*)(vt + d0 * 32 * KV_VT_PITCH + kb), hi2 = *(const LAS u32x2*)(vt + d0 * 32 * KV_VT_PITCH + kb + 16);
                const bf16x8 va = __builtin_bit_cast(bf16x8, (v4u){lo.x, lo.y, hi2.x, hi2.y});
                if (d0 == 0) a.o0 = __builtin_amdgcn_mfma_f32_32x32x16_bf16(va, pb, a.o0, 0, 0, 0);
                else         a.o1 = __builtin_amdgcn_mfma_f32_32x32x16_bf16(va, pb, a.o1, 0, 0, 0);
            }
        }
    }
}
__device__ __forceinline__ void attn_store(const AttnAcc& a, bf16* orow, int lane) {
    const int hi = lane >> 5;
    float l = sh32_sum(a.l);
    const float inv = (l > 0.f) ? 1.0f / l : 0.f;
#pragma unroll
    for (int g = 0; g < 4; ++g) {
        u32x2 w0, w1;
        w0.x = cvtpk(a.o0[4 * g] * inv, a.o0[4 * g + 1] * inv); w0.y = cvtpk(a.o0[4 * g + 2] * inv, a.o0[4 * g + 3] * inv);
        w1.x = cvtpk(a.o1[4 * g] * inv, a.o1[4 * g + 1] * inv); w1.y = cvtpk(a.o1[4 * g + 2] * inv, a.o1[4 * g + 3] * inv);
        *(GAS u32x2*)(orow + 8 * g + 4 * hi) = w0; *(GAS u32x2*)(orow + 32 + 8 * g + 4 * hi) = w1;
    }
}
__device__ __forceinline__ void load_q(bf16x8 (&qf)[4], const bf16* qrow, int lane) {
    const int hi = lane >> 5;
#pragma unroll
    for (int ks = 0; ks < 4; ++ks) qf[ks] = *(const GAS bf16x8*)(qrow + 16 * ks + 8 * hi);
}

__device__ __forceinline__ void fox_phase(unsigned char* ws, LAS unsigned char* lds, int G, int tid, int wave, int lane, bf16* obase, size_t opitch) {
    bf16* proj = (bf16*)(ws + WS_BIG + B_PROJ); const bf16* VtF = (const bf16*)(ws + WS_BIG + B_VTF);
    const float* Flocal = (const float*)(ws + WS_FL); const float* Btot = Flocal + S * 8;
    LAS unsigned char* kvb = lds; LAS float* kbt = (LAS float*)(lds + 2 * KV_BUF_BYTES); LAS float* bt = (LAS float*)(lds + 2 * KV_BUF_BYTES + 65536); LAS float* Et = bt + 272;
    const int r32 = lane & 31, hi = lane >> 5;
    for (int pi = blockIdx.x; pi < 256; pi += G) {
        const int h = pi >> 5, sidx = pi & 31;
        for (int uu = 0; uu < 2; ++uu) {
            const int QB = uu ? 63 - sidx : sidx, q0 = QB * 256, nt = 4 * (QB + 1), nt64 = nt;
            __syncthreads();
            for (int j = tid; j < nt64; j += NTHREADS) bt[j] = Btot[j * 8 + h];
            __syncthreads();
            for (int j = tid; j < nt64; j += NTHREADS) { float e = 0.f;
                if (j <= 4 * QB) { for (int i = 4 * QB - 1; i >= j; --i) e -= bt[i]; } else { for (int i = 4 * QB; i < j; ++i) e += bt[i]; }
                Et[j] = e; }
            __syncthreads();
            for (int s = tid; s < q0 + 256; s += NTHREADS) kbt[s] = -(Et[s >> 6] + Flocal[(size_t)s * 8 + h]) * LOG2E;
            const int qrow = q0 + wave * 32 + r32;
            bf16x8 qf[4]; load_q(qf, proj + (size_t)qrow * EVEN_NP + EC_FQ + h * 64, lane);
            AttnAcc a; attn_init(a);
            const bf16* Kp = proj + EC_FK + h * 64; const bf16* Vtp = VtF + (size_t)h * 64 * S;
            KVRegs kr; kv_load(kr, Kp, EVEN_NP, Vtp, S, 0, tid); kv_store(kr, kvb, tid);
            __syncthreads();
            for (int t = 0; t < nt; ++t) {
                LAS unsigned char* cur = kvb + (t & 1) * KV_BUF_BYTES;
                if (t + 1 < nt) kv_load(kr, Kp, EVEN_NP, Vtp, S, (t + 1) * 64, tid);
                const int key0 = t * 64;
                if (key0 <= q0 + wave * 32 + 31) {
                    f32x16 p0, p1; attn_scores(p0, p1, cur, qf, lane);
#pragma unroll
                    for (int g = 0; g < 4; ++g) {
                        const f32x4 b0 = *(const LAS f32x4*)(kbt + key0 + 8 * g + 4 * hi), b1 = *(const LAS f32x4*)(kbt + key0 + 32 + 8 * g + 4 * hi);
#pragma unroll
                        for (int e = 0; e < 4; ++e) { p0[4 * g + e] = p0[4 * g + e] * C2 + b0[e]; p1[4 * g + e] = p1[4 * g + e] * C2 + b1[e]; }
                    }
                    if (key0 + 63 > q0 + wave * 32) {
#pragma unroll
                        for (int r = 0; r < 16; ++r) { const int kv = key0 + crow(r, hi); if (kv > qrow) p0[r] = -INFINITY; if (kv + 32 > qrow) p1[r] = -INFINITY; }
                    }
                    attn_update(a, p0, p1, cur, lane);
                }
                if (t + 1 < nt) kv_store(kr, kvb + ((t + 1) & 1) * KV_BUF_BYTES, tid);
                __syncthreads();
            }
            attn_store(a, obase + (size_t)qrow * opitch + h * 64, lane);
        }
    }
}

__device__ __forceinline__ void memattn_phase(const InPtrs& in, unsigned char* ws, int L, LAS unsigned char* lds, int G, int tid, int wave, int lane) {
    const bf16* QM = (const bf16*)(ws + WS_BIG + B_QM); bf16* OM = (bf16*)(ws + WS_BIG + B_OM);
    const bf16* memK = (const bf16*)(ws + WS_MEMK) + (size_t)L * 256 * 256; const bf16* memVt = (const bf16*)(ws + WS_MEMK + 256 * 1024) + (size_t)L * 256 * 256;
    const float* qn = in.p[20] + (size_t)L * 64;
    LAS unsigned char* kvb = lds;
    const int r32 = lane & 31, hi = lane >> 5;
    for (int un = blockIdx.x; un < 256; un += G) {
        const int QB = un >> 2, hm = un & 3, qrow = QB * 256 + wave * 32 + r32;
        bf16x8 qf[4];
        {
            const bf16* qp = QM + (size_t)qrow * MEMW + hm * 64; float x[4][8]; float ss = 0.f;
#pragma unroll
            for (int ks = 0; ks < 4; ++ks) { const v4u w = *(const GAS v4u*)(qp + 16 * ks + 8 * hi); unpack8(w, x[ks]);
#pragma unroll
                for (int j = 0; j < 8; ++j) ss += x[ks][j] * x[ks][j]; }
            ss = sh32_sum(ss);
            const float r = rsqrtf(ss * (1.0f / 64.0f) + RMS_EPS);
#pragma unroll
            for (int ks = 0; ks < 4; ++ks) {
#pragma unroll
                for (int j = 0; j < 8; ++j) x[ks][j] = x[ks][j] * r * qn[16 * ks + 8 * hi + j];
                qf[ks] = __builtin_bit_cast(bf16x8, pack8(x[ks])); }
        }
        AttnAcc a; attn_init(a);
        const bf16* Kp = memK + hm * 64; const bf16* Vtp = memVt + (size_t)hm * 64 * 256;
        __syncthreads();
        KVRegs kr; kv_load(kr, Kp, 256, Vtp, 256, 0, tid); kv_store(kr, kvb, tid);
        __syncthreads();
        for (int t = 0; t < 4; ++t) {
            LAS unsigned char* cur = kvb + (t & 1) * KV_BUF_BYTES;
            if (t + 1 < 4) kv_load(kr, Kp, 256, Vtp, 256, (t + 1) * 64, tid);
            f32x16 p0, p1; attn_scores(p0, p1, cur, qf, lane);
#pragma unroll
            for (int r = 0; r < 16; ++r) { p0[r] *= C2; p1[r] *= C2; }
            attn_update(a, p0, p1, cur, lane);
            if (t + 1 < 4) kv_store(kr, kvb + ((t + 1) & 1) * KV_BUF_BYTES, tid);
            __syncthreads();
        }
        attn_store(a, OM + (size_t)qrow * MEMW + hm * 64, lane);
    }
}

__device__ __forceinline__ void moba_phase(unsigned char* ws, LAS unsigned char* lds, int G, int tid, int wave, int lane, bf16* obase) {
    bf16* Q = (bf16*)(ws + WS_BIG + B_PROJ); const bf16* Kb = Q + (size_t)S * DM; const bf16* Vt = (const bf16*)(ws + WS_BIG + B_VTM);
    const float* ksum = (const float*)(ws + WS_KSUM);
    LAS unsigned char* kvb = lds;
    LAS float* kms = (LAS float*)(lds + 2 * KV_BUF_BYTES);
    LAS unsigned* selb = (LAS unsigned*)(lds + 2 * KV_BUF_BYTES + 16384);
    LAS unsigned* wmask = selb + 512;
    LAS int* blist = (LAS int*)(wmask + 32);
    const int r32 = lane & 31, hi = lane >> 5;
    for (int pi = blockIdx.x; pi < 512; pi += G) {
        const int h = pi >> 5, sidx = pi & 31;
        for (int uu = 0; uu < 2; ++uu) {
            const int QB = uu ? 63 - sidx : sidx, q0 = QB * 256;
            __syncthreads();
            for (int e = tid; e < QB * 64; e += NTHREADS) { const float* kp = ksum + (size_t)(e >> 6) * 4096 + h * 64 + (e & 63); kms[e] = ((kp[0] + kp[1024]) + (kp[2048] + kp[3072])) * (1.0f / 256.0f); }
            if (tid < 18) wmask[tid] = 0u;
            __syncthreads();
            if (tid < 256) {
                const bf16* qp = Q + (size_t)(q0 + tid) * DM + h * 64;
                float q[64];
#pragma unroll
                for (int c = 0; c < 8; ++c) { const v4u w = *(const GAS v4u*)(qp + 8 * c); float x[8]; unpack8(w, x);
#pragma unroll
                    for (int j = 0; j < 8; ++j) q[8 * c + j] = x[j]; }
                float g0 = -INFINITY, g1 = -INFINITY, g2 = -INFINITY; int n0 = -1, n1 = -1, n2 = -1;
                for (int n = 0; n < QB; ++n) {
                    float g = 0.f;
#pragma unroll
                    for (int d = 0; d < 64; ++d) g += q[d] * kms[n * 64 + d];
                    if (g > g0) { g2 = g1; n2 = n1; g1 = g0; n1 = n0; g0 = g; n0 = n; }
                    else if (g > g1) { g2 = g1; n2 = n1; g1 = g; n1 = n; }
                    else if (g > g2) { g2 = g; n2 = n; }
                }
                unsigned lo = 0u, hi32 = 0u;
                if (n0 >= 0) { if (n0 < 32) lo |= 1u << n0; else hi32 |= 1u << (n0 - 32); }
                if (n1 >= 0) { if (n1 < 32) lo |= 1u << n1; else hi32 |= 1u << (n1 - 32); }
                if (n2 >= 0) { if (n2 < 32) lo |= 1u << n2; else hi32 |= 1u << (n2 - 32); }
                selb[tid * 2] = lo; selb[tid * 2 + 1] = hi32;
                atomicOr((unsigned*)&wmask[(tid >> 5) * 2], lo); atomicOr((unsigned*)&wmask[(tid >> 5) * 2 + 1], hi32);
                atomicOr((unsigned*)&wmask[16], lo); atomicOr((unsigned*)&wmask[17], hi32);
            }
            __syncthreads();
            if (tid == 0) { int c = 0; const unsigned lo = wmask[16], hi32 = wmask[17];
                for (int n = 0; n < QB; ++n) { const unsigned bit = (n < 32) ? (lo >> n) & 1u : (hi32 >> (n - 32)) & 1u; if (bit) blist[c++] = n; }
                blist[c++] = QB; blist[64 + 1] = c; }
            __syncthreads();
            const int nb = blist[65];
            const unsigned mylo = selb[(wave * 32 + r32) * 2], myhi = selb[(wave * 32 + r32) * 2 + 1];
            const unsigned wlo = wmask[wave * 2], whi = wmask[wave * 2 + 1];
            const int qrow = q0 + wave * 32 + r32;
            bf16x8 qf[4]; load_q(qf, Q + (size_t)qrow * DM + h * 64, lane);
            AttnAcc a; attn_init(a);
            const bf16* Kp = Kb + h * 64; const bf16* Vtp = Vt + (size_t)h * 64 * S;
            const int nt = nb * 4;
            KVRegs kr; kv_load(kr, Kp, DM, Vtp, S, blist[0] * 256, tid); kv_store(kr, kvb, tid);
            __syncthreads();
            for (int t = 0; t < nt; ++t) {
                LAS unsigned char* cur = kvb + (t & 1) * KV_BUF_BYTES;
                const int n = blist[t >> 2], key0 = n * 256 + (t & 3) * 64;
                if (t + 1 < nt) kv_load(kr, Kp, DM, Vtp, S, blist[(t + 1) >> 2] * 256 + ((t + 1) & 3) * 64, tid);
                const bool own = (n == QB);
                const unsigned wbit = own ? 1u : ((n < 32) ? (wlo >> n) & 1u : (whi >> (n - 32)) & 1u);
                if (wbit && (!own || key0 <= q0 + wave * 32 + 31)) {
                    f32x16 p0, p1; attn_scores(p0, p1, cur, qf, lane);
                    if (!own) {
                        const unsigned mbit = (n < 32) ? (mylo >> n) & 1u : (myhi >> (n - 32)) & 1u;
                        const float bias = mbit ? 0.f : -INFINITY;
#pragma unroll
                        for (int r = 0; r < 16; ++r) { p0[r] = p0[r] * C2 + bias; p1[r] = p1[r] * C2 + bias; }
                    } else {
#pragma unroll
                        for (int r = 0; r < 16; ++r) { const int kv = key0 + crow(r, hi); p0[r] = (kv > qrow) ? -INFINITY : p0[r] * C2; p1[r] = (kv + 32 > qrow) ? -INFINITY : p1[r] * C2; }
                    }
                    attn_update(a, p0, p1, cur, lane);
                }
                if (t + 1 < nt) kv_store(kr, kvb + ((t + 1) & 1) * KV_BUF_BYTES, tid);
                __syncthreads();
            }
            attn_store(a, obase + (size_t)qrow * DM + h * 64, lane);
        }
    }
}

typedef float f32x4v __attribute__((ext_vector_type(4)));
__device__ __forceinline__ unsigned mono_key(float s) { if (s == 0.f) s = 0.f; const unsigned u = __float_as_uint(s); return (u & 0x80000000u) ? ~u : (u | 0x80000000u); }
constexpr int DS_CAP = 512, DS_CHUNK = 128;
__device__ __forceinline__ unsigned dsa_compact(LAS unsigned* keys, LAS unsigned short* idxs, int n, int lane) {
    unsigned k[8]; unsigned short ix[8];
#pragma unroll
    for (int j = 0; j < 8; ++j) { const int e = lane + 64 * j; const bool in = e < n; k[j] = in ? keys[e] : 0u; ix[j] = in ? idxs[e] : (unsigned short)0; }
    unsigned T = 0u; int cntT = n;
    for (int bit = 31; bit >= 0; --bit) {
        const unsigned cand = T | (1u << bit); int c = 0;
#pragma unroll
        for (int j = 0; j < 8; ++j) c += __popcll(__ballot(k[j] >= cand));
        if (c >= 256) { T = cand; cntT = c; }
    }
    int Jstar = 0x10000;
    if (cntT > 256) {
        int gt = 0;
#pragma unroll
        for (int j = 0; j < 8; ++j) gt += __popcll(__ballot(k[j] > T));
        const int need = 256 - gt; int Jm = 0;
        for (int bit = 14; bit >= 0; --bit) { const int cand = Jm | (1 << bit); int c = 0;
#pragma unroll
            for (int j = 0; j < 8; ++j) c += __popcll(__ballot(k[j] == T && (int)ix[j] < cand));
            if (c < need) Jm = cand; }
        Jstar = Jm + 1;
    }
    int base = 0;
    const unsigned long long lt = (1ull << lane) - 1ull;
#pragma unroll
    for (int j = 0; j < 8; ++j) { const bool pred = (k[j] > T) || (k[j] == T && T != 0u && (int)ix[j] < Jstar);
        const unsigned long long mask = __ballot(pred); const int pos = base + __popcll(mask & lt);
        if (pred) { keys[pos] = k[j]; idxs[pos] = ix[j]; }
        base += __popcll(mask); }
    return T;
}
__device__ __forceinline__ void dsa_select_phase(unsigned char* ws, LAS unsigned char* lds, int G, int tid, int wave, int lane) {
    const bf16* proj = (const bf16*)(ws + WS_BIG + B_PROJ); const bf16* IKc = (const bf16*)(ws + WS_BIG + B_IKC); const float* IW = (const float*)(ws + WS_IW);
    unsigned short* selg = (unsigned short*)(ws + WS_BIG + B_SEL);
    LAS unsigned char* kbuf = lds;
    LAS unsigned* ckeys = (LAS unsigned*)(lds + 32768);
    LAS unsigned short* cidx = (LAS unsigned short*)(lds + 32768 + 65536);
    const int r32 = lane & 31, hi = lane >> 5;
    const unsigned lowmask = (1u << r32) - 1u;
    for (int pi = blockIdx.x; pi < 256; pi += G) {
        for (int uu = 0; uu < 2; ++uu) {
            const int blk = uu ? 511 - pi : pi, tb = blk * 32;
            const int tw = tb + 4 * wave;
            bf16x8 af[4];
            { const int i = r32, qi = 2 * (i >> 4) + ((i >> 2) & 1), hd = 4 * ((i >> 3) & 1) + (i & 3);
              const bf16* ap = proj + (size_t)(tw + qi) * EVEN_NP + EC_IQ + hd * 64 + 8 * hi;
#pragma unroll
              for (int ks = 0; ks < 4; ++ks) af[ks] = *(const GAS bf16x8*)(ap + 16 * ks); }
            float w0[8], w1[8];
            { const f32x4 a = *(const GAS f32x4*)(IW + (size_t)(tw + hi) * 8), b = *(const GAS f32x4*)(IW + (size_t)(tw + hi) * 8 + 4);
              const f32x4 c = *(const GAS f32x4*)(IW + (size_t)(tw + 2 + hi) * 8), d = *(const GAS f32x4*)(IW + (size_t)(tw + 2 + hi) * 8 + 4);
#pragma unroll
              for (int j = 0; j < 4; ++j) { w0[j] = a[j]; w0[4 + j] = b[j]; w1[j] = c[j]; w1[4 + j] = d[j]; } }
            const int q0t = tw + hi, q1t = tw + 2 + hi;
            LAS unsigned* kq0 = ckeys + (4 * wave + hi) * DS_CAP; LAS unsigned* kq1 = ckeys + (4 * wave + 2 + hi) * DS_CAP;
            LAS unsigned short* iq0 = cidx + (4 * wave + hi) * DS_CAP; LAS unsigned short* iq1 = cidx + (4 * wave + 2 + hi) * DS_CAP;
            unsigned thr0 = 0u, thr1 = 0u; int cnt0 = 0, cnt1 = 0;
            const int nch = (tb + 32 + DS_CHUNK - 1) / DS_CHUNK;
            __syncthreads();
            v4u st[2];
#pragma unroll
            for (int c = 0; c < 2; ++c) { const int piece = tid + 512 * c; st[c] = *(const GAS v4u*)(IKc + (size_t)(piece >> 3) * 64 + (piece & 7) * 8); }
#pragma unroll
            for (int c = 0; c < 2; ++c) { const int piece = tid + 512 * c, key = piece >> 3, ch = piece & 7; *(LAS v4u*)(kbuf + key * 128 + ((ch ^ (key & 7)) * 16)) = st[c]; }
            __syncthreads();
            for (int cb = 0; cb < nch; ++cb) {
                LAS unsigned char* cur = kbuf + (cb & 1) * 16384;
                if (cb + 1 < nch) {
#pragma unroll
                    for (int c = 0; c < 2; ++c) { const int piece = tid + 512 * c; st[c] = *(const GAS v4u*)(IKc + (size_t)((cb + 1) * DS_CHUNK + (piece >> 3)) * 64 + (piece & 7) * 8); } }
#pragma unroll 1
                for (int j = 0; j < 4; ++j) {
                    const int key0 = cb * DS_CHUNK + 32 * j;
                    if (key0 > tw + 3) break;
                    f32x16 p;
#pragma unroll
                    for (int r = 0; r < 16; ++r) p[r] = 0.f;
                    const int kl = 32 * j + r32;
#pragma unroll
                    for (int ks = 0; ks < 4; ++ks) { const bf16x8 bfr = *(const LAS bf16x8*)(cur + kl * 128 + (((2 * ks + hi) ^ (kl & 7)) * 16));
                        p = __builtin_amdgcn_mfma_f32_32x32x16_bf16(af[ks], bfr, p, 0, 0, 0); }
                    float s0 = 0.f, s1 = 0.f;
#pragma unroll
                    for (int r = 0; r < 8; ++r) { s0 += w0[r] * fmaxf(p[r], 0.f); s1 += w1[r] * fmaxf(p[8 + r], 0.f); }
                    const int key = key0 + r32;
                    const unsigned u0 = mono_key(s0), u1 = mono_key(s1);
                    const bool pr0 = (key <= q0t) && (u0 > thr0), pr1 = (key <= q1t) && (u1 > thr1);
                    const unsigned long long m0 = __ballot(pr0), m1 = __ballot(pr1);
                    if (m0 | m1) {
                        const unsigned h0 = hi ? (unsigned)(m0 >> 32) : (unsigned)m0, h1 = hi ? (unsigned)(m1 >> 32) : (unsigned)m1;
                        if (pr0) { const int pos = cnt0 + __popc(h0 & lowmask); kq0[pos] = u0; iq0[pos] = (unsigned short)key; }
                        if (pr1) { const int pos = cnt1 + __popc(h1 & lowmask); kq1[pos] = u1; iq1[pos] = (unsigned short)key; }
                        cnt0 += __popc(h0); cnt1 += __popc(h1);
                        const unsigned long long need = __ballot(cnt0 > DS_CAP - 32 || cnt1 > DS_CAP - 32);
                        if (need) {
#pragma unroll 1
                            for (int hh = 0; hh < 2; ++hh) {
                                const int c0 = __builtin_amdgcn_readlane(cnt0, 0), c0b = __builtin_amdgcn_readlane(cnt0, 32);
                                const int c1 = __builtin_amdgcn_readlane(cnt1, 0), c1b = __builtin_amdgcn_readlane(cnt1, 32);
                                const int n0 = hh ? c0b : c0, n1 = hh ? c1b : c1;
                                if (n0 > DS_CAP - 32) { const unsigned T = dsa_compact(ckeys + (4 * wave + hh) * DS_CAP, cidx + (4 * wave + hh) * DS_CAP, n0, lane); if (hi == hh) { thr0 = T; cnt0 = 256; } }
                                if (n1 > DS_CAP - 32) { const unsigned T = dsa_compact(ckeys + (4 * wave + 2 + hh) * DS_CAP, cidx + (4 * wave + 2 + hh) * DS_CAP, n1, lane); if (hi == hh) { thr1 = T; cnt1 = 256; } }
                            }
                        }
                    }
                }
                if (cb + 1 < nch) {
                    LAS unsigned char* nxt = kbuf + ((cb + 1) & 1) * 16384;
#pragma unroll
                    for (int c = 0; c < 2; ++c) { const int piece = tid + 512 * c, key = piece >> 3, ch = piece & 7; *(LAS v4u*)(nxt + key * 128 + ((ch ^ (key & 7)) * 16)) = st[c]; }
                }
                __syncthreads();
            }
#pragma unroll 1
            for (int qq = 0; qq < 4; ++qq) {
                const int hh = qq & 1, sl = qq >> 1;
                int n = sl ? __builtin_amdgcn_readlane(cnt1, 32 * hh) : __builtin_amdgcn_readlane(cnt0, 32 * hh);
                LAS unsigned* kk = ckeys + (4 * wave + qq) * DS_CAP; LAS unsigned short* ii = cidx + (4 * wave + qq) * DS_CAP;
                if (n > 256) { (void)dsa_compact(kk, ii, n, lane); n = 256; }
                unsigned short* row = selg + (size_t)(tw + qq) * 256;
#pragma unroll
                for (int e4 = 0; e4 < 4; ++e4) { const int e = lane + 64 * e4; row[e] = (e < n) ? ii[e] : (unsigned short)0xFFFFu; }
            }
        }
    }
}

__device__ __forceinline__ void dsa_sparse_phase(unsigned char* ws, int G, int wave, int lane, bf16* obase, size_t opitch) {
    const bf16* proj = (const bf16*)(ws + WS_BIG + B_PROJ); const unsigned short* selg = (const unsigned short*)(ws + WS_BIG + B_SEL);
    const int h = (int)blockIdx.x & 7, wg = (int)blockIdx.x >> 3, nwg = G >> 3;
    const int kg = lane >> 3, ds8 = (lane & 7) * 8;
    for (int t = wg * NWAVES + wave; t < S; t += nwg * NWAVES) {
        v4u iw[4];
#pragma unroll
        for (int c = 0; c < 4; ++c) iw[c] = *(const GAS v4u*)(selg + (size_t)t * 256 + 32 * kg + 8 * c);
        float qv[8];
        { const v4u w = *(const GAS v4u*)(proj + (size_t)t * EVEN_NP + EC_DQ + h * 64 + ds8); unpack8(w, qv);
#pragma unroll
          for (int j = 0; j < 8; ++j) qv[j] *= C2; }
        float sc[32];
#pragma unroll
        for (int i0 = 0; i0 < 32; i0 += 8) {
            v4u kw[8];
#pragma unroll
            for (int j = 0; j < 8; ++j) { const int i = i0 + j; const unsigned wd = (i & 1) ? (iw[i >> 3][(i >> 1) & 3] >> 16) : (iw[i >> 3][(i >> 1) & 3] & 0xffffu);
                const unsigned idx = (wd == 0xffffu) ? 0u : wd;
                kw[j] = *(const GAS v4u*)(proj + (size_t)idx * EVEN_NP + EC_DK + h * 64 + ds8); }
#pragma unroll
            for (int j = 0; j < 8; ++j) { const int i = i0 + j; const unsigned wd = (i & 1) ? (iw[i >> 3][(i >> 1) & 3] >> 16) : (iw[i >> 3][(i >> 1) & 3] & 0xffffu);
                float x[8]; unpack8(kw[j], x); float d = 0.f;
#pragma unroll
                for (int e = 0; e < 8; ++e) d += qv[e] * x[e];
                d += shx<1>(d); d += shx<2>(d); d += shx<4>(d);
                sc[i] = (wd == 0xffffu) ? -INFINITY : d; }
        }
        float mx = sc[0];
#pragma unroll
        for (int i = 1; i < 32; ++i) mx = fmaxf(mx, sc[i]);
        mx = fmaxf(mx, shx<8>(mx)); mx = fmaxf(mx, shx<16>(mx)); mx = sh32_max(mx);
        float l = 0.f;
#pragma unroll
        for (int i = 0; i < 32; ++i) { sc[i] = __builtin_amdgcn_exp2f(sc[i] - mx); l += sc[i]; }
        l += shx<8>(l); l += shx<16>(l); l = sh32_sum(l);
        float acc[8];
#pragma unroll
        for (int e = 0; e < 8; ++e) acc[e] = 0.f;
#pragma unroll
        for (int i0 = 0; i0 < 32; i0 += 8) {
            v4u vw[8];
#pragma unroll
            for (int j = 0; j < 8; ++j) { const int i = i0 + j; const unsigned wd = (i & 1) ? (iw[i >> 3][(i >> 1) & 3] >> 16) : (iw[i >> 3][(i >> 1) & 3] & 0xffffu);
                const unsigned idx = (wd == 0xffffu) ? 0u : wd;
                vw[j] = *(const GAS v4u*)(proj + (size_t)idx * EVEN_NP + EC_DV + h * 64 + ds8); }
#pragma unroll
            for (int j = 0; j < 8; ++j) { float x[8]; unpack8(vw[j], x);
#pragma unroll
                for (int e = 0; e < 8; ++e) acc[e] += sc[i0 + j] * x[e]; }
        }
        const float inv = 1.0f / l;
#pragma unroll
        for (int e = 0; e < 8; ++e) { float a = acc[e]; a += shx<8>(a); a += shx<16>(a); a = sh32_sum(a); acc[e] = a * inv; }
        if (kg == 0) *(GAS v4u*)(obase + (size_t)t * opitch + h * 64 + ds8) = pack8(acc);
    }
}

struct Args { InPtrs in; float* out; unsigned char* ws; int ph_lo, ph_hi, li, pad; };
constexpr int PH_PER_LAYER = 13, N_PHASES = 1 + 2 * PH_PER_LAYER - 1;

__global__ void __launch_bounds__(NTHREADS, 2) hyb_fwd(Args args) {
    extern __shared__ __attribute__((aligned(16))) unsigned char lds_raw[];
    LAS unsigned char* lds = (LAS unsigned char*)lds_raw;
    volatile LAS unsigned* MISC = (volatile LAS unsigned*)(lds + MISC_OFF);
    const int tid = threadIdx.x, lane = tid & 63, wave = __builtin_amdgcn_readfirstlane(tid >> 6);
    const int G = gridDim.x;
    const int vcu = (G % 8 == 0) ? ((int)blockIdx.x % 8) * (G / 8) + (int)blockIdx.x / 8 : (int)blockIdx.x;
    unsigned char* ws = args.ws;
    gu32* ctl = (gu32*)(ws + WS_CTL);
    for (int u = tid; u < (LDS_BYTES - LDSCTL_OFF) / 4; u += NTHREADS) ((LAS unsigned*)(lds + LDSCTL_OFF))[u] = 0u;
    __syncthreads();
    XcdBarrier bar = xcd_barrier_post((unsigned*)(ctl + CW_BAR) + args.li * XCD_BAR_WORDS, MISC + 8);
    const int tid0 = tid; unsigned char* const ws0 = ws;
    for (int ph = args.ph_lo; ph < args.ph_hi; ++ph) {
        int tid = tid0; asm volatile("" : "+v"(tid));
        unsigned char* ws = ws0; asm volatile("" : "+s"(ws));
        const int lane = tid & 63, wave = __builtin_amdgcn_readfirstlane(tid >> 6);
        LAS unsigned char* lds = (LAS unsigned char*)lds_raw; { unsigned lo_ = (unsigned)(uintptr_t)lds; asm volatile("" : "+s"(lo_)); lds = (LAS unsigned char*)(uintptr_t)lo_; }
        float* ssqA = (float*)(ws + WS_SSQ);
        bf16* HB = (bf16*)(ws + WS_HB);
        unsigned char* Wr = ws + WS_W;
        unsigned char* BIG = ws + WS_BIG;
        const int gw = vcu * NWAVES + wave, NGW = G * NWAVES;
        if (ph == 0) {
#ifdef PROBE_P02
            conv_weights(args.in, ws, 0, lds, gw, NGW, wave, lane);
            copy_x(args.in.p[0], args.out, HB, ssqA, gw, NGW, lane);
            rope_tables((float*)(ws + WS_ROPE), (float*)(ws + WS_ROPE) + S * 8, (int)blockIdx.x * NTHREADS + tid, G * NTHREADS);
            __syncthreads();
            for (int w = blockIdx.x; w < MEMT; w += G) mem_kv(args.in, ws, lds, w, tid, wave, lane);
            __syncthreads();
#endif
#ifndef NO_P0
            conv_weights(args.in, ws, 0, lds, gw, NGW, wave, lane);
            copy_x(args.in.p[0], args.out, HB, ssqA, gw, NGW, lane);
            rope_tables((float*)(ws + WS_ROPE), (float*)(ws + WS_ROPE) + S * 8, (int)blockIdx.x * NTHREADS + tid, G * NTHREADS);
            __syncthreads();
            for (int w = blockIdx.x; w < MEMT; w += G) mem_kv(args.in, ws, lds, w, tid, wave, lane);
#endif
        } else {
            const int L = (ph - 1) / PH_PER_LAYER, sub = (ph - 1) % PH_PER_LAYER;
            const bool even = (L & 1) == 0;
            float* ssq_in = ssqA;
            if (sub == 0 || sub == 10) {
                pg8::Gemm g{(const pg8::bf16_t*)HB, (const pg8::bf16_t*)(Wr + (sub == 0 ? W_FFN1_IN : W_FFN2_IN)), S, FF2, DM, DM};
                pg8::StaticOrder So; So.init(S, FF2, G, (int)blockIdx.x);
                pg8::EpiSwiGLU E{(pg8::bf16_t*)(BIG + B_U), ssq_in, FF};
#ifdef PROBE_GEMM2
                pg8::gemm_phase<pg8::EpiSwiGLU, pg8::StaticOrder, true, true>(lds, g, So, E, tid); __syncthreads();
#endif
                pg8::gemm_phase<pg8::EpiSwiGLU, pg8::StaticOrder, true, true>(lds, g, So, E, tid);
            } else if (sub == 1 || sub == 6 || sub == 9 || sub == 11) {
                pg8::Gemm g; float scale; int so;
                if (sub == 1)       { g = pg8::Gemm{(const pg8::bf16_t*)(BIG + B_U), (const pg8::bf16_t*)(Wr + W_FFN1_OUT), S, DM, FF, FF}; scale = 0.5f; so = 1; }
                else if (sub == 6)  { g = pg8::Gemm{(const pg8::bf16_t*)(BIG + B_PROJ), (const pg8::bf16_t*)(Wr + W_MIX_OUT), S, DM, DM, even ? EVEN_NP : DM}; scale = 1.0f; so = 2; }
                else if (sub == 9)  { g = pg8::Gemm{(const pg8::bf16_t*)(BIG + B_OM), (const pg8::bf16_t*)(Wr + W_MEMO), S, DM, MEMW, MEMW}; scale = 1.0f; so = 3; }
                else                { g = pg8::Gemm{(const pg8::bf16_t*)(BIG + B_U), (const pg8::bf16_t*)(Wr + W_FFN2_OUT), S, DM, FF, FF}; scale = 0.5f; so = 4; }
                const bool last = (sub == 11 && L == NLAYER - 1);
                pg8::StaticOrder So; So.init(S, DM, G, (int)blockIdx.x);
                pg8::EpiResid E{args.out, last ? nullptr : (pg8::bf16_t*)HB, last ? nullptr : ssqA, scale};
                pg8::gemm_phase<pg8::EpiResid, pg8::StaticOrder, true, true>(lds, g, So, E, tid);
#ifdef PROBE_GEMM2
                { __syncthreads(); pg8::EpiResid E0 = E; E0.scale = 0.f; pg8::gemm_phase<pg8::EpiResid, pg8::StaticOrder, true, true>(lds, g, So, E0, tid); }
#endif
            } else if (sub == 2 || sub == 7) {
                pg8::Gemm g; pg8::EpiScale E;
                if (sub == 2) { const int N = even ? EVEN_NP : ODD_N;
                    g = pg8::Gemm{(const pg8::bf16_t*)HB, (const pg8::bf16_t*)(Wr + W_MIX_IN), S, N, DM, DM};
                    E = pg8::EpiScale{(pg8::bf16_t*)(BIG + B_PROJ), even ? EVEN_NP : DM, ssq_in, even ? 0 : DM, (size_t)S * DM}; }
                else { g = pg8::Gemm{(const pg8::bf16_t*)HB, (const pg8::bf16_t*)(Wr + W_MEMQ), S, MEMW, DM, DM};
                    E = pg8::EpiScale{(pg8::bf16_t*)(BIG + B_QM), MEMW, ssq_in, 0, 0}; }
                pg8::StaticOrder So; So.init(S, g.N, G, (int)blockIdx.x);
#ifdef PROBE_GEMM2
                pg8::gemm_phase<pg8::EpiScale, pg8::StaticOrder, true, true>(lds, g, So, E, tid); __syncthreads();
#endif
                pg8::gemm_phase<pg8::EpiScale, pg8::StaticOrder, true, true>(lds, g, So, E, tid);
            } else if (sub == 3) {
                #ifndef NO_POSTE
                if (even) post_even(args.in, ws, args.out, ssq_in, lds, G, tid, wave, lane);
#endif
#ifndef NO_POSTO
                if (!even) post_odd(args.in, ws, lds, G, tid, wave, lane);
#endif
            } else if (sub == 4) {
                if (even) {
                    dsa_select_phase(ws, lds, G, tid, wave, lane);
                } else {
#ifdef PROBE_MOBA2
                    moba_phase(ws, lds, G, tid, wave, lane, HB); __syncthreads();
#endif
                    moba_phase(ws, lds, G, tid, wave, lane, (bf16*)(BIG + B_PROJ));
                }
            } else if (sub == 5) {
                if (even) {
                    bf16* projb = (bf16*)(BIG + B_PROJ);
#ifdef PROBE_FOX2
                    fox_phase(ws, lds, G, tid, wave, lane, HB, 512); __syncthreads();
#endif
#ifdef PROBE_SPARSE2
                    dsa_sparse_phase(ws, G, wave, lane, HB, 512);
#endif
                    fox_phase(ws, lds, G, tid, wave, lane, projb + EC_FQ, EVEN_NP);
                    dsa_sparse_phase(ws, G, wave, lane, projb + EC_DQ, EVEN_NP);
                }
            } else if (sub == 8) {
#ifdef PROBE_MEM2
                memattn_phase(args.in, ws, L, lds, G, tid, wave, lane); __syncthreads();
#endif
                memattn_phase(args.in, ws, L, lds, G, tid, wave, lane);
            } else if (sub == 12) {
#ifdef PROBE_P02
                conv_weights(args.in, ws, L + 1, lds, gw, NGW, wave, lane); __syncthreads();
#endif
                conv_weights(args.in, ws, L + 1, lds, gw, NGW, wave, lane);
            }
        }
        if (ph + 1 < args.ph_hi) xcd_barrier(bar);
#ifdef PROBE_BAR2
        if (ph + 1 < args.ph_hi) xcd_barrier(bar);
#endif
    }
}

#ifndef MK_N_LAUNCHES
#define MK_N_LAUNCHES 1
#endif
extern "C" void kernel_launch(void* const* d_in, const int* in_sizes, int n_in, void* d_out, int out_size, void* d_ws, size_t ws_size, hipStream_t stream) {
    static int grid = 0;
    if (grid == 0) {
        if (n_in != 26 || in_sizes[0] != S * DM || out_size != S * DM || ws_size < WS_END) {
            fprintf(stderr, "kernel_launch: unexpected problem (n_in %d, in0 %d, out %d, ws %zu); nothing launched\n", n_in, n_in > 0 ? in_sizes[0] : -1, out_size, ws_size); grid = -1; return; }
        int dev = 0, cus = 0, per_cu = 0;
        if (hipGetDevice(&dev) != hipSuccess || hipDeviceGetAttribute(&cus, hipDeviceAttributeMultiprocessorCount, dev) != hipSuccess) { grid = -1; return; }
        if (hipFuncSetAttribute((const void*)hyb_fwd, hipFuncAttributeMaxDynamicSharedMemorySize, LDS_BYTES) != hipSuccess) { fprintf(stderr, "kernel_launch: hipFuncSetAttribute failed\n"); grid = -1; return; }
        if (hipOccupancyMaxActiveBlocksPerMultiprocessor(&per_cu, (const void*)hyb_fwd, NTHREADS, LDS_BYTES) != hipSuccess || per_cu < 1)
            fprintf(stderr, "kernel_launch: note: occupancy query reports %d workgroups per CU\n", per_cu);
        (void)hipGetLastError();
        grid = cus;
    }
    if (grid < 0) return;
    if (hipMemsetAsync((char*)d_ws + WS_CTL, 0, CTL_ZERO_BYTES, stream) != hipSuccess) { fprintf(stderr, "kernel_launch: hipMemsetAsync failed\n"); return; }
    Args a{};
    for (int i = 0; i < 26; ++i) a.in.p[i] = (const float*)d_in[i];
    a.out = (float*)d_out; a.ws = (unsigned char*)d_ws;
#if MK_N_LAUNCHES == 1
    a.ph_lo = 0; a.ph_hi = N_PHASES; a.li = 0;
    hipLaunchKernelGGL(hyb_fwd, dim3(grid), dim3(NTHREADS), LDS_BYTES, stream, a);
#else
    for (int ph = 0; ph < N_PHASES; ++ph) { a.ph_lo = ph; a.ph_hi = ph + 1; a.li = 0; hipLaunchKernelGGL(hyb_fwd, dim3(grid), dim3(NTHREADS), LDS_BYTES, stream, a); }
#endif
    const hipError_t le = hipPeekAtLastError();
    if (le != hipSuccess) fprintf(stderr, "kernel_launch: launch failed: %s\n", hipGetErrorName(le));
}
```

```cpp
#include <hip/hip_runtime.h>
#include <cstdio>
#include <cstdint>

template <int M> __device__ __forceinline__ int shx_i(int v) {
    if constexpr (M == 1) return __builtin_amdgcn_mov_dpp(v, 0xB1, 0xF, 0xF, true);
    else if constexpr (M == 2) return __builtin_amdgcn_mov_dpp(v, 0x4E, 0xF, 0xF, true);
    else return __builtin_amdgcn_ds_swizzle(v, (M << 10) | 0x1f);
}
template <int M> __device__ __forceinline__ float shx(float v) { return __int_as_float(shx_i<M>(__float_as_int(v))); }
__device__ __forceinline__ float sh32_sum(float v) { auto r = __builtin_amdgcn_permlane32_swap(__float_as_uint(v), __float_as_uint(v), false, false); return __uint_as_float(r[0]) + __uint_as_float(r[1]); }
__device__ __forceinline__ float sh32_max(float v) { auto r = __builtin_amdgcn_permlane32_swap(__float_as_uint(v), __float_as_uint(v), false, false); return fmaxf(__uint_as_float(r[0]), __uint_as_float(r[1])); }
__device__ __forceinline__ int sum32_i(int c) { c += shx_i<1>(c); c += shx_i<2>(c); c += shx_i<4>(c); c += shx_i<8>(c); c += shx_i<16>(c); return c; }
namespace pg8 {
#define PG8_LAS __attribute__((address_space(3)))
typedef unsigned short bf16_t;
typedef short bf16x8 __attribute__((ext_vector_type(8)));
typedef float f32x4 __attribute__((ext_vector_type(4)));
typedef unsigned u32x4 __attribute__((ext_vector_type(4)));
constexpr int BM = 256, BK = 64, HALF = 128, HTB = HALF * BK * 2  , STAGE_BYTES = 8 * HTB, NXCD = 8, WGM = 8;

__host__ __device__ __forceinline__ int lds_byte(int r, int c) { const int st = (r >> 4) * 2 + (c >> 5), rr = r & 15, cc = c & 31, ob = rr * 64 + cc * 2; return st * 1024 + (ob ^ (((ob >> 9) & 1) << 5)); }
__host__ __device__ __forceinline__ void stage_rc(int b, int& R, int& C) { const int st = b / 1024, sb = b % 1024, swz = sb ^ (((sb >> 9) & 1) << 5); R = (st >> 1) * 16 + swz / 64; C = (st & 1) * 32 + (swz % 64) / 2; }
__host__ __device__ __forceinline__ int perm32(int rho) { const int n = rho >> 4, i = rho & 15; return 8 * (i >> 2) + 4 * n + (i & 3); }

struct Unit { int pm, pn; };
struct Gemm { const bf16_t* A; const bf16_t* Bt; int M, N, K, lda; };

struct StaticOrder {
    int nM, nN, nwg, G, c;
    __host__ __device__ void init(int M, int N, int G_, int c_) { nM = M / BM; nN = N / BM; nwg = nM * nN; G = G_; c = c_; }
    __host__ __device__ bool next(int i, Unit& u) const {
        const long L = (long)i * G + c; if (L >= nwg) return false;
        int wgid = (int)L; { const int q = nwg / NXCD, r = nwg % NXCD, xcd = wgid % NXCD, off = wgid / NXCD; wgid = (xcd < r ? xcd * (q + 1) : r * (q + 1) + (xcd - r) * q) + off; }
        const int nig = WGM * nN, gid = wgid / nig, fm = gid * WGM, gsz = (nM - fm) < WGM ? (nM - fm) : WGM;
        u.pm = fm + ((wgid % nig) % gsz); u.pn = (wgid % nig) / gsz; return true;
    }
    __device__ __forceinline__ void a_ready(const Unit&) const {}
    __device__ __forceinline__ void done(const Unit&) const {}
};

__device__ __forceinline__ unsigned cvt_pk_bf16(float lo, float hi) { unsigned r; asm volatile("v_cvt_pk_bf16_f32 %0, %1, %2" : "=v"(r) : "v"(lo), "v"(hi)); return r; }
typedef float f32x2 __attribute__((ext_vector_type(2)));
constexpr float RMS_EPS_F = 1e-6f;
__device__ __forceinline__ float silu_f(float x) { return x * __builtin_amdgcn_rcpf(1.0f + __builtin_amdgcn_exp2f(-1.4426950408889634f * x)); }
__device__ __forceinline__ float row_rstd(const float* ssq, int row) {
    const f32x4* p = (const f32x4*)(ssq + (size_t)row * 16); const f32x4 a = p[0], b = p[1], c = p[2], d = p[3];
    const float s = ((a[0] + a[1]) + (a[2] + a[3])) + ((b[0] + b[1]) + (b[2] + b[3])) + ((c[0] + c[1]) + (c[2] + c[3])) + ((d[0] + d[1]) + (d[2] + d[3]));
    return rsqrtf(s * (1.0f / 1024.0f) + RMS_EPS_F); }

struct EpiSwiGLU {
    static constexpr bool PERM = true, AFTER_DRAIN = false;
    bf16_t* U; const float* ssq; int ldu;
    __device__ __forceinline__ void operator()(const f32x4 (&acc)[2][2][4][2], const Unit& u, int wr, int wc, int fr, int fq) const {
        const int row0 = u.pm * BM + wr * 64 + fr, col0 = u.pn * HALF + wc * 32 + 8 * fq;
#pragma unroll
        for (int ai = 0; ai < 2; ++ai)
#pragma unroll
            for (int m = 0; m < 4; ++m) {
                const int row = row0 + ai * HALF + m * 16; const float r = row_rstd(ssq, row);
                const f32x4 a0 = acc[ai][0][m][0] * r, a1 = acc[ai][0][m][1] * r, b0 = acc[ai][1][m][0] * r, b1 = acc[ai][1][m][1] * r;
                u32x4 w;
                w.x = cvt_pk_bf16(silu_f(a0[0]) * b0[0], silu_f(a0[1]) * b0[1]); w.y = cvt_pk_bf16(silu_f(a0[2]) * b0[2], silu_f(a0[3]) * b0[3]);
                w.z = cvt_pk_bf16(silu_f(a1[0]) * b1[0], silu_f(a1[1]) * b1[1]); w.w = cvt_pk_bf16(silu_f(a1[2]) * b1[2], silu_f(a1[3]) * b1[3]);
                *(u32x4*)(U + (size_t)row * ldu + col0) = w;
            }
    }
};
struct EpiResid {
    static constexpr bool PERM = true, AFTER_DRAIN = false;
    float* H; bf16_t* HB; float* ssq_out; float scale;
    __device__ __forceinline__ void operator()(const f32x4 (&acc)[2][2][4][2], const Unit& u, int wr, int wc, int fr, int fq) const {
        const int row0 = u.pm * BM + wr * 64 + fr, col0 = u.pn * BM + wc * 32 + 8 * fq;
#pragma unroll
        for (int ai = 0; ai < 2; ++ai)
#pragma unroll
            for (int m = 0; m < 4; ++m) {
                const int row = row0 + ai * HALF + m * 16; float sq = 0.f;
#pragma unroll
                for (int bj = 0; bj < 2; ++bj) {
                    float* hp = H + (size_t)row * 1024 + col0 + bj * HALF;
                    f32x4 h0 = *(const f32x4*)hp, h1 = *(const f32x4*)(hp + 4);
                    h0 = h0 + acc[ai][bj][m][0] * scale; h1 = h1 + acc[ai][bj][m][1] * scale;
                    *(f32x4*)hp = h0; *(f32x4*)(hp + 4) = h1;
                    sq += (h0[0] * h0[0] + h0[1] * h0[1]) + (h0[2] * h0[2] + h0[3] * h0[3]) + (h1[0] * h1[0] + h1[1] * h1[1]) + (h1[2] * h1[2] + h1[3] * h1[3]);
                    if (HB) { u32x4 w; w.x = cvt_pk_bf16(h0[0], h0[1]); w.y = cvt_pk_bf16(h0[2], h0[3]); w.z = cvt_pk_bf16(h1[0], h1[1]); w.w = cvt_pk_bf16(h1[2], h1[3]);
                        *(u32x4*)(HB + (size_t)row * 1024 + col0 + bj * HALF) = w; }
                }
                if (ssq_out) { sq += shx<16>(sq); sq = sh32_sum(sq); if (fq == 0) ssq_out[(size_t)row * 16 + u.pn * 4 + wc] = sq; }
            }
    }
};
struct EpiScale {
    static constexpr bool PERM = true, AFTER_DRAIN = false;
    bf16_t* O; int ldc; const float* ssq; int split_cols; size_t split_stride;
    __device__ __forceinline__ void operator()(const f32x4 (&acc)[2][2][4][2], const Unit& u, int wr, int wc, int fr, int fq) const {
        const int row0 = u.pm * BM + wr * 64 + fr; int colt = u.pn * BM; bf16_t* base = O;
        if (split_cols) { const int t = colt / split_cols; base += (size_t)t * split_stride; colt -= t * split_cols; }
        const int col0 = colt + wc * 32 + 8 * fq;
#pragma unroll
        for (int ai = 0; ai < 2; ++ai)
#pragma unroll
            for (int m = 0; m < 4; ++m) {
                const int row = row0 + ai * HALF + m * 16; const float r = row_rstd(ssq, row);
                bf16_t* rowp = base + (size_t)row * ldc + col0;
#pragma unroll
                for (int bj = 0; bj < 2; ++bj) { const f32x4 v0 = acc[ai][bj][m][0] * r, v1 = acc[ai][bj][m][1] * r;
                    u32x4 w; w.x = cvt_pk_bf16(v0[0], v0[1]); w.y = cvt_pk_bf16(v0[2], v0[3]); w.z = cvt_pk_bf16(v1[0], v1[1]); w.w = cvt_pk_bf16(v1[2], v1[3]);
                    *(u32x4*)(rowp + bj * HALF) = w; }
            }
    }
};
template <class Epi, class Sched, bool ALIGN_EPI = false, bool SP2 = false>
__device__ __forceinline__ void gemm_phase(PG8_LAS unsigned char* lds, const Gemm g, const Sched& S, const Epi& E, const int tid) {
    const int wid = __builtin_amdgcn_readfirstlane(tid >> 6), lane = tid & 63, wr = wid >> 2, wc = wid & 3, fr = lane & 15, fq = lane >> 4;
    const int K = g.K, nt = K / BK;
    unsigned voffA[2], voffB[2];
#pragma unroll
    for (int i = 0; i < 2; ++i) { int R, C; stage_rc(tid * 16 + i * 8192, R, C); const int Rb = Epi::PERM ? ((R & ~31) + perm32(R & 31)) : R;
        voffA[i] = (unsigned)(R * g.lda + C) * 2u; voffB[i] = (unsigned)(Rb * K + C) * 2u; }
    const size_t kstep = (size_t)(BK * 2);
    const size_t hstepA = (size_t)HALF * g.lda * 2, hstepB = (size_t)HALF * K * 2;
    const size_t tstepA = 2 * hstepA, tstepB = 2 * hstepB;
    const unsigned ldsw = (unsigned)wid * 1024u;
    const int aoff = lds_byte(wr * 64 + fr, fq * 8), boff = lds_byte(wc * 32 + fr, fq * 8);
#define PG8_SA(b, h) (((b) * 2 + (h)) * HTB)
#define PG8_SB(b, h) ((4 + (b) * 2 + (h)) * HTB)
#define PG8_STAGE(bufoff, gbase, voff) do { _Pragma("unroll") for (int _i = 0; _i < 2; ++_i) \
        __builtin_amdgcn_global_load_lds((const unsigned*)((const char*)(gbase) + (voff)[_i]), (PG8_LAS unsigned*)(lds + (bufoff) + ldsw + _i * 8192), 16, 0, 0); } while (0)
#define PG8_LDA(dst, b, h) do { _Pragma("unroll") for (int m = 0; m < 4; ++m) _Pragma("unroll") for (int k = 0; k < 2; ++k) dst[m][k] = *(const PG8_LAS bf16x8*)(lds + PG8_SA(b, h) + aoff + m * 2048 + k * 1024); } while (0)
#define PG8_LDB(dst, b, h) do { _Pragma("unroll") for (int n = 0; n < 2; ++n) _Pragma("unroll") for (int k = 0; k < 2; ++k) dst[n][k] = *(const PG8_LAS bf16x8*)(lds + PG8_SB(b, h) + boff + n * 2048 + k * 1024); } while (0)
#define PG8_MMA(ai, bj, At, Bt) do { __builtin_amdgcn_s_setprio(1); _Pragma("unroll") for (int m = 0; m < 4; ++m) _Pragma("unroll") for (int n = 0; n < 2; ++n) _Pragma("unroll") for (int k = 0; k < 2; ++k) \
        acc[ai][bj][m][n] = __builtin_amdgcn_mfma_f32_16x16x32_bf16(Bt[n][k], At[m][k], acc[ai][bj][m][n], 0, 0, 0); __builtin_amdgcn_s_setprio(0); } while (0)
#define PG8_WAIT_V(n) asm volatile("s_waitcnt vmcnt(" #n ")" ::: "memory")
#define PG8_WAIT_L(n) asm volatile("s_waitcnt lgkmcnt(" #n ")" ::: "memory")
#define PG8_BAR __builtin_amdgcn_s_barrier()
#define PG8_SCHED __builtin_amdgcn_sched_barrier(0)
    Unit cur, nxt; int ui = 0;
    if (!S.next(0, cur)) return;
    f32x4 acc[2][2][4][2];
#pragma unroll
    for (int a = 0; a < 2; ++a)
#pragma unroll
        for (int b = 0; b < 2; ++b)
#pragma unroll
            for (int m = 0; m < 4; ++m)
#pragma unroll
                for (int n = 0; n < 2; ++n) acc[a][b][m][n] = (f32x4){0.f, 0.f, 0.f, 0.f};
    bf16x8 At[4][2], B0[2][2], B1[2][2];
    const char* cA = (const char*)g.A + (size_t)cur.pm * tstepA; const char* cB = (const char*)g.Bt + (size_t)cur.pn * tstepB;
    S.a_ready(cur);
    if constexpr (SP2) {
        PG8_STAGE(PG8_SB(0, 0), cB, voffB); PG8_STAGE(PG8_SB(0, 1), cB + hstepB, voffB); PG8_STAGE(PG8_SA(0, 0), cA, voffA); PG8_STAGE(PG8_SA(0, 1), cA + hstepA, voffA);
        if (wr == 1) PG8_BAR;
        PG8_WAIT_V(2); PG8_BAR;
        PG8_STAGE(PG8_SB(1, 0), cB + kstep, voffB); PG8_STAGE(PG8_SA(1, 0), cA + kstep, voffA); PG8_STAGE(PG8_SB(1, 1), cB + hstepB + kstep, voffB);
        PG8_WAIT_V(6); PG8_BAR;
    } else {
        PG8_STAGE(PG8_SB(0, 0), cB, voffB); PG8_STAGE(PG8_SA(0, 0), cA, voffA); PG8_STAGE(PG8_SB(0, 1), cB + hstepB, voffB); PG8_STAGE(PG8_SA(0, 1), cA + hstepA, voffA);
        if (wr == 1) PG8_BAR;
        PG8_WAIT_V(4); PG8_BAR;
        PG8_STAGE(PG8_SB(1, 0), cB + kstep, voffB); PG8_STAGE(PG8_SA(1, 0), cA + kstep, voffA); PG8_STAGE(PG8_SB(1, 1), cB + hstepB + kstep, voffB);
        PG8_WAIT_V(6); PG8_BAR;
    }
    for (;;) {
        const bool has_next = S.next(ui + 1, nxt);
        const char* nA = has_next ? (const char*)g.A + (size_t)nxt.pm * tstepA : cA; const char* nB = has_next ? (const char*)g.Bt + (size_t)nxt.pn * tstepB : cB;
        for (int t = 0; t < nt; t += 2) {
            const bool last = (t == nt - 2);
            const char* a1 = cA + (size_t)(t + 1) * kstep;
            const char* a2 = last ? nA : cA + (size_t)(t + 2) * kstep; const char* b2 = last ? nB : cB + (size_t)(t + 2) * kstep;
            const char* a3 = a2 + kstep; const char* b3 = b2 + kstep;
            if (last && has_next) S.a_ready(nxt);
            if constexpr (SP2) {
            PG8_LDB(B0, 0, 0); PG8_LDB(B1, 0, 1); PG8_SCHED; PG8_LDA(At, 0, 0); PG8_STAGE(PG8_SA(1, 1), a1 + hstepA, voffA);
            PG8_WAIT_V(8); PG8_WAIT_L(0); PG8_BAR; PG8_MMA(0, 0, At, B0); PG8_MMA(0, 1, At, B1); PG8_BAR; PG8_SCHED;
            PG8_LDA(At, 0, 1); PG8_STAGE(PG8_SB(0, 0), b2, voffB); PG8_STAGE(PG8_SB(0, 1), b2 + hstepB, voffB); PG8_STAGE(PG8_SA(0, 0), a2, voffA);
            PG8_WAIT_V(8); PG8_WAIT_L(0); PG8_BAR; PG8_MMA(1, 0, At, B0); PG8_MMA(1, 1, At, B1); PG8_BAR; PG8_SCHED;
            PG8_LDB(B0, 1, 0); PG8_LDB(B1, 1, 1); PG8_SCHED; PG8_LDA(At, 1, 0); PG8_STAGE(PG8_SA(0, 1), a2 + hstepA, voffA);
            PG8_WAIT_V(8); PG8_WAIT_L(0); PG8_BAR; PG8_MMA(0, 0, At, B0); PG8_MMA(0, 1, At, B1); PG8_BAR; PG8_SCHED;
            PG8_LDA(At, 1, 1); PG8_STAGE(PG8_SB(1, 0), b3, voffB); PG8_STAGE(PG8_SB(1, 1), b3 + hstepB, voffB); PG8_STAGE(PG8_SA(1, 0), a3, voffA);
            PG8_WAIT_V(8); PG8_WAIT_L(0); PG8_BAR; PG8_MMA(1, 0, At, B0); PG8_MMA(1, 1, At, B1); PG8_BAR; PG8_SCHED;
            } else {
            PG8_LDB(B0, 0, 0); PG8_SCHED; PG8_LDA(At, 0, 0); PG8_STAGE(PG8_SA(1, 1), a1 + hstepA, voffA);
            PG8_WAIT_L(8); PG8_BAR; PG8_WAIT_L(0); PG8_MMA(0, 0, At, B0); PG8_BAR; PG8_SCHED;
            PG8_LDB(B1, 0, 1); PG8_STAGE(PG8_SB(0, 0), b2, voffB);
            PG8_BAR; PG8_WAIT_L(0); PG8_MMA(0, 1, At, B1); PG8_BAR;
            PG8_LDA(At, 0, 1); PG8_STAGE(PG8_SA(0, 0), a2, voffA);
            PG8_BAR; PG8_WAIT_L(0); PG8_MMA(1, 0, At, B0); PG8_BAR; PG8_SCHED;
            PG8_STAGE(PG8_SB(0, 1), b2 + hstepB, voffB);
            PG8_WAIT_V(6); PG8_BAR; PG8_MMA(1, 1, At, B1); PG8_BAR;
            PG8_LDB(B0, 1, 0); PG8_SCHED; PG8_LDA(At, 1, 0); PG8_STAGE(PG8_SA(0, 1), a2 + hstepA, voffA);
            PG8_WAIT_L(8); PG8_BAR; PG8_WAIT_L(0); PG8_MMA(0, 0, At, B0); PG8_BAR; PG8_SCHED;
            PG8_LDB(B1, 1, 1); PG8_STAGE(PG8_SB(1, 0), b3, voffB);
            PG8_BAR; PG8_WAIT_L(0); PG8_MMA(0, 1, At, B1); PG8_BAR;
            PG8_LDA(At, 1, 1); PG8_STAGE(PG8_SA(1, 0), a3, voffA);
            PG8_BAR; PG8_WAIT_L(0); PG8_MMA(1, 0, At, B0); PG8_BAR; PG8_SCHED;
            PG8_STAGE(PG8_SB(1, 1), b3 + hstepB, voffB);
            PG8_WAIT_V(6); PG8_BAR; PG8_MMA(1, 1, At, B1); PG8_BAR;
            }
        }
        if constexpr (ALIGN_EPI) { if (wr == 0) PG8_BAR; }
        if constexpr (!Epi::AFTER_DRAIN) { E(acc, cur, wr, wc, fr, fq); S.done(cur); }
        if (!has_next) break;
#pragma unroll
        for (int a = 0; a < 2; ++a)
#pragma unroll
            for (int b = 0; b < 2; ++b)
#pragma unroll
                for (int m = 0; m < 4; ++m)
#pragma unroll
                    for (int n = 0; n < 2; ++n) acc[a][b][m][n] = (f32x4){0.f, 0.f, 0.f, 0.f};
        cur = nxt; cA = nA; cB = nB; ++ui;
        if constexpr (ALIGN_EPI) { if (wr == 1) PG8_BAR; }
    }
    PG8_WAIT_V(0);
    if constexpr (!ALIGN_EPI) { if (wr == 0) PG8_BAR; }
    PG8_BAR;
    if constexpr (Epi::AFTER_DRAIN) { E.fused(acc, cur, wr, wc, fr, fq, lds, wid, lane); S.done(cur); }
#undef PG8_SA
#undef PG8_SB
#undef PG8_STAGE
#undef PG8_LDA
#undef PG8_LDB
#undef PG8_MMA
#undef PG8_WAIT_V
#undef PG8_WAIT_L
#undef PG8_BAR
#undef PG8_SCHED
}
}

constexpr int S = 16384, DM = 1024, FF = 2816, FF2 = 5632, EVEN_SRC = 3664, EVEN_NP = 3840, ODD_N = 3072, NLAYER = 2, MEMT = 256, MEMW = 256;
constexpr float RMS_EPS = 1e-6f;
constexpr float LOG2E = 1.4426950408889634f;
constexpr float C2 = 0.125f * LOG2E;
constexpr int NWAVES = 8, NTHREADS = 512;
constexpr int EC_FQ = 0, EC_DQ = 512, EC_FK = 1024, EC_DK = 1536, EC_FV = 2048, EC_DV = 2560, EC_IQ = 3072, EC_IK = 3584;
constexpr int ES_FQ = 0, ES_FK = 512, ES_FV = 1024, ES_FL = 1536, ES_DQ = 1544, ES_DK = 2056, ES_DV = 2568, ES_IQ = 3080, ES_IK = 3592, ES_IW = 3656;

constexpr size_t MiB = 1u << 20;
constexpr size_t WS_CTL = 0, CTL_ZERO_BYTES = 1 * MiB;
constexpr size_t WS_SSQ = 1 * MiB;
constexpr size_t WS_KSUM = 6 * MiB;
constexpr size_t WS_ROPE = 2 * MiB;
constexpr size_t WS_FL = 3 * MiB;
constexpr size_t WS_MEMK = 4 * MiB;
constexpr size_t WS_IW = 5 * MiB;
constexpr size_t WS_W = 12 * MiB;
constexpr size_t WS_BIG = 60 * MiB;
constexpr size_t WS_HB = 224 * MiB;
constexpr size_t WS_END = 256 * MiB;
constexpr size_t W_FFN1_IN = 0, W_FFN1_OUT = 11 * MiB, W_MIX_IN = 17 * MiB, W_MIX_OUT = 25 * MiB, W_MEMQ = 27 * MiB, W_MEMO = 28 * MiB, W_FFN2_IN = 29 * MiB, W_FFN2_OUT = 40 * MiB;
constexpr size_t B_U = 0;
constexpr size_t B_PROJ = 0;
constexpr size_t B_VTF = 120 * MiB;
constexpr size_t B_IKC = 136 * MiB;
constexpr size_t B_VTM = 96 * MiB;
constexpr size_t B_SEL = 156 * MiB;
constexpr size_t B_QM = 140 * MiB, B_OM = 148 * MiB;
constexpr int CW_TMO = 0, CW_CODE = 1, CW_BAR = 4096;

constexpr int RING_BYTES = 147456;
constexpr int LDSCTL_OFF = RING_BYTES, MISC_OFF = LDSCTL_OFF + 320;
constexpr int LDS_BYTES = 163840;

#define GAS __attribute__((address_space(1)))
#define LAS __attribute__((address_space(3)))
typedef unsigned short bf16;
typedef unsigned v4u __attribute__((ext_vector_type(4)));
typedef float f32x4 __attribute__((ext_vector_type(4)));
typedef short bf16x8 __attribute__((ext_vector_type(8)));
typedef GAS unsigned gu32;
typedef GAS unsigned long long gu64;
#define RLX_AGENT __ATOMIC_RELAXED, __HIP_MEMORY_SCOPE_AGENT
#define LDS_WAIT() asm volatile("s_waitcnt lgkmcnt(0)" ::: "memory")
#define VM_WAIT() asm volatile("s_waitcnt vmcnt(0)" ::: "memory")
__device__ __forceinline__ unsigned long long rt() { return __builtin_amdgcn_s_memrealtime(); }
__device__ __forceinline__ unsigned f2bf(float f) { unsigned u = __builtin_bit_cast(unsigned, f); return (u + 0x7fffu + ((u >> 16) & 1u)) >> 16; }
__device__ __forceinline__ unsigned pk2(float lo, float hi) { return f2bf(lo) | (f2bf(hi) << 16); }

#define XB_TMO      128
#define XB_XCNT(j)  (256  + 64 * (j))
#define XB_XSUB(j)  (1280 + 64 * (j))
#define XB_XGEN(j)  (2304 + 64 * (j))
#define XB_TOP      3328
#define XB_TOPGEN   3392
#define XCD_BAR_WORDS 3456
#define XB_SPIN_CAP (1u << 18)

__device__ __forceinline__ unsigned xb_ld(unsigned* p)              { return __hip_atomic_load(p, __ATOMIC_RELAXED, __HIP_MEMORY_SCOPE_AGENT); }
__device__ __forceinline__ unsigned xb_add(unsigned* p, unsigned v) { return __hip_atomic_fetch_add(p, v, __ATOMIC_RELAXED, __HIP_MEMORY_SCOPE_AGENT); }
__device__ __forceinline__ unsigned xb_xcc_id() { return (unsigned)__builtin_amdgcn_s_getreg((3 << 11) | 20) & 0xFu; }
#define XB_SPIN(cond, bar) do { unsigned _sp = 0; while (cond) { __builtin_amdgcn_s_sleep(1); \
    if ((++_sp & 255u) == 0u) { if (xb_ld(&(bar)[XB_TMO])) break; if (_sp > XB_SPIN_CAP) { atomicAdd(&(bar)[XB_TMO], 1u); break; } } } } while (0)

struct XcdBarrier {
    unsigned* bar; unsigned x;
    volatile LAS unsigned* st;
};

__device__ __forceinline__ XcdBarrier xcd_barrier_post(unsigned* bar, volatile LAS unsigned* st) {
    XcdBarrier b; b.bar = bar; b.x = xb_xcc_id(); b.st = st;
    if (threadIdx.x == 0) (void)xb_add(&bar[XB_XCNT(b.x)], 1u);
    return b;
}
__device__ __forceinline__ void xcd_barrier_complete(unsigned* bar, unsigned x, unsigned& nloc, unsigned& nx) {
    const unsigned G = gridDim.x * gridDim.y * gridDim.z;
    unsigned sum, cnt, mine, sp = 0u;
    for (;;) {
        sum = 0u; cnt = 0u; mine = 0u;
#pragma unroll
        for (unsigned j = 0; j < 16; ++j) { const unsigned c = xb_ld(&bar[XB_XCNT(j)]); sum += c; cnt += (c > 0u) ? 1u : 0u; mine = (j == x) ? c : mine; }
        if (sum == G) break;
        __builtin_amdgcn_s_sleep(1);
        if ((++sp & 255u) == 0u) { if (xb_ld(&bar[XB_TMO])) break; if (sp > XB_SPIN_CAP) { atomicAdd(&bar[XB_TMO], 1u); break; } }
    }
    nloc = mine > 0u ? mine : 1u; nx = cnt > 0u ? cnt : 1u;
}

__device__ __forceinline__ void xcd_barrier(const XcdBarrier& b) {
    asm volatile("s_waitcnt vmcnt(0)" ::: "memory");
    __syncthreads();
    if (threadIdx.x == 0) {
        unsigned* bar = b.bar;
        __builtin_amdgcn_s_waitcnt(0);
        unsigned nloc = b.st[0], nx = b.st[1];
        if (nloc == 0u) { xcd_barrier_complete(bar, b.x, nloc, nx); b.st[0] = nloc; b.st[1] = nx; }
        const unsigned old = xb_add(&bar[XB_XSUB(b.x)], 1u);
        const unsigned gen = old / nloc;
        if (old + 1u == (gen + 1u) * nloc) {
            __builtin_amdgcn_fence(__ATOMIC_RELEASE, "agent");
            asm volatile("s_waitcnt vmcnt(0)" ::: "memory");
            const unsigned og = xb_add(&bar[XB_TOP], 1u);
            const unsigned tg = og / nx;
            if (og + 1u == (tg + 1u) * nx) xb_add(&bar[XB_TOPGEN], 1u);
            else XB_SPIN(xb_ld(&bar[XB_TOPGEN]) == tg, bar);
            __builtin_amdgcn_fence(__ATOMIC_ACQUIRE, "agent");
            xb_add(&bar[XB_XGEN(b.x)], 1u);
            asm volatile("s_waitcnt vmcnt(0)" ::: "memory");
        } else {
            XB_SPIN(xb_ld(&bar[XB_XGEN(b.x)]) == gen, bar);
            __builtin_amdgcn_fence(__ATOMIC_ACQUIRE, "agent");
            asm volatile("s_waitcnt vmcnt(0)" ::: "memory");
        }
    }
    __syncthreads();
}

typedef float f32x16 __attribute__((ext_vector_type(16)));
typedef float f32x2_t __attribute__((ext_vector_type(2)));
typedef __bf16 bf16x2_t __attribute__((ext_vector_type(2)));
typedef unsigned u32x2 __attribute__((ext_vector_type(2)));
__device__ __forceinline__ unsigned cvtpk(float lo, float hi) { f32x2_t v = {lo, hi}; bf16x2_t b = __builtin_convertvector(v, bf16x2_t); return __builtin_bit_cast(unsigned, b); }
__device__ __forceinline__ float bflo(unsigned w) { return __uint_as_float(w << 16); }
__device__ __forceinline__ float bfhi(unsigned w) { return __uint_as_float(w & 0xffff0000u); }
__device__ __forceinline__ void unpack8(const v4u& w, float (&x)[8]) { x[0] = bflo(w.x); x[1] = bfhi(w.x); x[2] = bflo(w.y); x[3] = bfhi(w.y); x[4] = bflo(w.z); x[5] = bfhi(w.z); x[6] = bflo(w.w); x[7] = bfhi(w.w); }
__device__ __forceinline__ v4u pack8(const float (&x)[8]) { v4u w; w.x = cvtpk(x[0], x[1]); w.y = cvtpk(x[2], x[3]); w.z = cvtpk(x[4], x[5]); w.w = cvtpk(x[6], x[7]); return w; }
__device__ __forceinline__ float wave_sum(float v) { v += shx<1>(v); v += shx<2>(v); v += shx<4>(v); v += shx<8>(v); v += shx<16>(v); return sh32_sum(v); }
__device__ __forceinline__ float wave_max(float v) { v = fmaxf(v, shx<1>(v)); v = fmaxf(v, shx<2>(v)); v = fmaxf(v, shx<4>(v)); v = fmaxf(v, shx<8>(v)); v = fmaxf(v, shx<16>(v)); return sh32_max(v); }
__device__ __forceinline__ int crow(int r, int hi) { return (r & 3) + 8 * (r >> 2) + 4 * hi; }

__device__ __forceinline__ int even_map(int n) {
    if (n < 512) return ES_FQ + n;
    if (n < 1024) return ES_DQ + (n - 512);
    if (n < 1536) return ES_FK + (n - 1024);
    if (n < 2048) return ES_DK + (n - 1536);
    if (n < 2560) return ES_FV + (n - 2048);
    if (n < 3072) return ES_DV + (n - 2560);
    if (n < 3584) return ES_IQ + (n - 3072);
    if (n < 3648) return ES_IK + (n - 3584);
    return -1;
}
__device__ __forceinline__ void conv_item(const float* W, int K, int Nsrc, int nblk, const float* gain, bf16* WT, int mode, LAS float* scr, int item, int lane) {
    const int kb = item / nblk, nb = item % nblk, k0 = 64 * kb, n0 = 32 * nb;
    const int n = n0 + (lane & 31);
    int sc;
    if (mode == 0) sc = n; else if (mode == 1) { const int T = n >> 8, hf = (n >> 7) & 1, j = n & 127; sc = hf * FF + 128 * T + j; } else sc = even_map(n);
#pragma unroll 8
    for (int i = 0; i < 32; ++i) { const int kk = 2 * i + (lane >> 5); float v = 0.f;
        if (sc >= 0) { v = W[(size_t)(k0 + kk) * Nsrc + sc]; if (gain) v *= gain[k0 + kk]; }
        scr[kk * 33 + (lane & 31)] = v; }
    LDS_WAIT(); asm volatile("" ::: "memory");
    const int c = lane & 7;
#pragma unroll
    for (int j = 0; j < 4; ++j) { const int nn = (lane >> 3) + 8 * j; const LAS float* s = scr + (8 * c) * 33 + nn;
        v4u o; o.x = cvtpk(s[0 * 33], s[1 * 33]); o.y = cvtpk(s[2 * 33], s[3 * 33]); o.z = cvtpk(s[4 * 33], s[5 * 33]); o.w = cvtpk(s[6 * 33], s[7 * 33]);
        *(GAS v4u*)(WT + (size_t)(n0 + nn) * K + k0 + 8 * c) = o; }
    LDS_WAIT(); asm volatile("" ::: "memory");
}
struct InPtrs { const float* p[26]; };
__device__ __forceinline__ void conv_weights(const InPtrs& in, unsigned char* ws, int L, LAS unsigned char* lds, int gw, int NGW, int wave, int lane) {
    LAS float* scr = (LAS float*)(lds + wave * 16384);
    bf16* Wr = (bf16*)(ws + WS_W);
    const float* ffn1_norm = in.p[2] + (size_t)L * DM; const float* ffn1_in = in.p[3] + (size_t)L * DM * FF2; const float* ffn1_out = in.p[4] + (size_t)L * FF * DM;
    const float* mix_norm = in.p[5] + (size_t)L * DM; const float* mix_out = in.p[15] + (size_t)L * DM * DM;
    const float* memx_norm = in.p[16] + (size_t)L * DM; const float* mem_wq = in.p[18] + (size_t)L * DM * MEMW; const float* mem_wo = in.p[22] + (size_t)L * MEMW * DM;
    const float* ffn2_norm = in.p[23] + (size_t)L * DM; const float* ffn2_in = in.p[24] + (size_t)L * DM * FF2; const float* ffn2_out = in.p[25] + (size_t)L * FF * DM;
    const bool even = (L & 1) == 0;
    const float* mix_in = even ? in.p[6] : in.p[12];
    const int mixN = even ? EVEN_NP : ODD_N, mixSrc = even ? EVEN_SRC : ODD_N;
    const int I_FIN = (DM / 64) * (FF2 / 32), I_FOUT = (FF / 64) * (DM / 32), I_MIN = (DM / 64) * (mixN / 32), I_MOUT = (DM / 64) * (DM / 32), I_MQ = (DM / 64) * (MEMW / 32), I_MO = (MEMW / 64) * (DM / 32);
    const int NITEMS = 2 * I_FIN + 2 * I_FOUT + I_MIN + I_MOUT + I_MQ + I_MO;
    for (int it = gw; it < NITEMS; it += NGW) {
        int r = it;
        if (r < I_FIN) { conv_item(ffn1_in, DM, FF2, FF2 / 32, ffn1_norm, (bf16*)((unsigned char*)Wr + W_FFN1_IN), 1, scr, r, lane); continue; } r -= I_FIN;
        if (r < I_FIN) { conv_item(ffn2_in, DM, FF2, FF2 / 32, ffn2_norm, (bf16*)((unsigned char*)Wr + W_FFN2_IN), 1, scr, r, lane); continue; } r -= I_FIN;
        if (r < I_FOUT) { conv_item(ffn1_out, FF, DM, DM / 32, nullptr, (bf16*)((unsigned char*)Wr + W_FFN1_OUT), 0, scr, r, lane); continue; } r -= I_FOUT;
        if (r < I_FOUT) { conv_item(ffn2_out, FF, DM, DM / 32, nullptr, (bf16*)((unsigned char*)Wr + W_FFN2_OUT), 0, scr, r, lane); continue; } r -= I_FOUT;
        if (r < I_MIN) { conv_item(mix_in, DM, mixSrc, mixN / 32, mix_norm, (bf16*)((unsigned char*)Wr + W_MIX_IN), even ? 2 : 0, scr, r, lane); continue; } r -= I_MIN;
        if (r < I_MOUT) { conv_item(mix_out, DM, DM, DM / 32, nullptr, (bf16*)((unsigned char*)Wr + W_MIX_OUT), 0, scr, r, lane); continue; } r -= I_MOUT;
        if (r < I_MQ) { conv_item(mem_wq, DM, MEMW, MEMW / 32, memx_norm, (bf16*)((unsigned char*)Wr + W_MEMQ), 0, scr, r, lane); continue; } r -= I_MQ;
        conv_item(mem_wo, MEMW, DM, DM / 32, nullptr, (bf16*)((unsigned char*)Wr + W_MEMO), 0, scr, r, lane);
    }
}
__device__ __forceinline__ void copy_x(const float* x, float* out, bf16* HB, float* ssq0, int gw, int NGW, int lane) {
    for (int m = gw; m < S; m += NGW) {
        const GAS f32x4* xr = (const GAS f32x4*)(x + (size_t)m * DM) + lane; GAS f32x4* orow = (GAS f32x4*)(out + (size_t)m * DM) + lane;
        GAS u32x2* hb = (GAS u32x2*)(HB + (size_t)m * DM) + lane;
        float s = 0.f;
#pragma unroll
        for (int j = 0; j < 4; ++j) { const f32x4 v = xr[64 * j]; orow[64 * j] = v; s += (v.x * v.x + v.y * v.y) + (v.z * v.z + v.w * v.w);
            u32x2 w; w.x = cvtpk(v.x, v.y); w.y = cvtpk(v.z, v.w); hb[64 * j] = w; }
        s = wave_sum(s);
        if (lane < 16) ssq0[(size_t)m * 16 + lane] = (lane == 0) ? s : 0.f;
    }
}
__device__ __forceinline__ void rope_tables(float* cosT, float* sinT, int gtid, int nthreads) {
    for (int idx = gtid; idx < S * 8; idx += nthreads) {
        const int t = idx >> 3, j = idx & 7;
        float inv;
        switch (j) { case 0: inv = 1.0f; break; case 1: inv = 0.193922743f; break; case 2: inv = 0.0376060307f; break; case 3: inv = 0.00729266461f; break;
                     case 4: inv = 0.00141421356f; break; case 5: inv = 0.000274248188f; break; case 6: inv = 5.3182961e-05f; break; default: inv = 1.03133862e-05f; break; }
        const float ang = (float)t * inv;
        const float kq = __builtin_rintf(ang * 0.63661977236758134f);
        float r = ang - kq * 1.5703125f; r = r - kq * 0.00048351287841796875f; r = r - kq * 3.1391647326017846e-07f;
        const float r2 = r * r;
        float sp = 2.7557319e-6f; sp = sp * r2 - 1.9841270e-4f; sp = sp * r2 + 8.3333333e-3f; sp = sp * r2 - 1.6666667e-1f; const float sn = r + r * r2 * sp;
        float cp = -2.7557319e-7f; cp = cp * r2 + 2.4801587e-5f; cp = cp * r2 - 1.3888889e-3f; cp = cp * r2 + 4.1666667e-2f; cp = cp * r2 - 0.5f; const float cs = 1.0f + r2 * cp;
        const int q = ((int)kq) & 3;
        const float sv = (q == 0) ? sn : (q == 1) ? cs : (q == 2) ? -sn : -cs;
        const float cv = (q == 0) ? cs : (q == 1) ? -sn : (q == 2) ? -cs : sn;
        cosT[idx] = cv; sinT[idx] = sv;
    }
}
__device__ __forceinline__ void mem_kv(const InPtrs& in, unsigned char* ws, LAS unsigned char* lds, int w, int tid, int wave, int lane) {
    LAS float* memn = (LAS float*)lds;
    LAS float* red = (LAS float*)(lds + 4096);
    bf16* memK = (bf16*)(ws + WS_MEMK); bf16* memVt = (bf16*)(ws + WS_MEMK + 256 * 1024);
    for (int L = 0; L < NLAYER; ++L) {
        const float* mrow = in.p[1] + (size_t)w * DM; const float* gm = in.p[17] + (size_t)L * DM; const float* wkv = in.p[19] + (size_t)L * DM * 512; const float* kn = in.p[21] + (size_t)L * 64;
        const float x0 = mrow[tid], x1 = mrow[tid + 512];
        float s = wave_sum(x0 * x0 + x1 * x1);
        if (lane == 0) red[wave] = s;
        __syncthreads();
        float tot = 0.f;
#pragma unroll
        for (int i = 0; i < 8; ++i) tot += red[i];
        const float rstd = rsqrtf(tot * (1.0f / DM) + RMS_EPS);
        memn[tid] = x0 * rstd * gm[tid]; memn[tid + 512] = x1 * rstd * gm[tid + 512];
        __syncthreads();
        float acc = 0.f;
#pragma unroll 8
        for (int k = 0; k < DM; ++k) acc += memn[k] * wkv[(size_t)k * 512 + tid];
        if (tid < 256) {
            const float ss = wave_sum(acc * acc);
            const float y = acc * rsqrtf(ss * (1.0f / 64.0f) + RMS_EPS) * kn[tid & 63];
            memK[(size_t)L * 256 * 256 + (size_t)w * 256 + tid] = (bf16)(cvtpk(y, 0.f) & 0xffffu);
        } else {
            const int c = tid - 256;
            memVt[(size_t)L * 256 * 256 + (size_t)c * 256 + w] = (bf16)(cvtpk(acc, 0.f) & 0xffffu);
        }
        __syncthreads();
    }
}

__device__ __forceinline__ void head_norm8(float (&x)[8], const float* gain, int lane) {
    float ss = 0.f;
#pragma unroll
    for (int j = 0; j < 8; ++j) ss += x[j] * x[j];
    ss += shx<1>(ss); ss += shx<2>(ss); ss += shx<4>(ss);
    const float r = rsqrtf(ss * (1.0f / 64.0f) + RMS_EPS);
    const int d0 = 8 * (lane & 7);
#pragma unroll
    for (int j = 0; j < 8; ++j) x[j] = x[j] * r * gain[d0 + j];
}
__device__ __forceinline__ void rope8(float (&x)[8], const float (&cs)[8], const float (&sn)[8], int lane) {
    const int sub = lane & 7;
#pragma unroll
    for (int j = 0; j < 8; ++j) {
        const float other = shx<1>(x[j]);
        if (sub == 0) x[j] = x[j] * cs[j] - other * sn[j];
        else if (sub == 1) x[j] = x[j] * cs[j] + other * sn[j];
    }
}
__device__ __forceinline__ float sh32_get(float v, int lane) { auto r = __builtin_amdgcn_permlane32_swap(__float_as_uint(v), __float_as_uint(v), false, false); return __uint_as_float((lane < 32) ? r[1] : r[0]); }
__device__ __forceinline__ float reduce_scatter64(float (&v)[64], int lane) {
    { const bool up = (lane & 32) != 0;
#pragma unroll
      for (int j = 0; j < 32; ++j) { const float send = up ? v[j] : v[j + 32], keep = up ? v[j + 32] : v[j]; v[j] = keep + sh32_get(send, lane); } }
    { const bool up = (lane & 16) != 0;
#pragma unroll
      for (int j = 0; j < 16; ++j) { const float send = up ? v[j] : v[j + 16], keep = up ? v[j + 16] : v[j]; v[j] = keep + shx<16>(send); } }
    { const bool up = (lane & 8) != 0;
#pragma unroll
      for (int j = 0; j < 8; ++j) { const float send = up ? v[j] : v[j + 8], keep = up ? v[j + 8] : v[j]; v[j] = keep + shx<8>(send); } }
    { const bool up = (lane & 4) != 0;
#pragma unroll
      for (int j = 0; j < 4; ++j) { const float send = up ? v[j] : v[j + 4], keep = up ? v[j + 4] : v[j]; v[j] = keep + shx<4>(send); } }
    { const bool up = (lane & 2) != 0;
#pragma unroll
      for (int j = 0; j < 2; ++j) { const float send = up ? v[j] : v[j + 2], keep = up ? v[j + 2] : v[j]; v[j] = keep + shx<2>(send); } }
    { const bool up = (lane & 1) != 0; const float send = up ? v[0] : v[1], keep = up ? v[1] : v[0]; v[0] = keep + shx<1>(send); }
    return v[0];
}
__device__ __forceinline__ void post_even(const InPtrs& in, unsigned char* ws, const float* H, const float* ssq, LAS unsigned char* lds, int G, int tid, int wave, int lane) {
    bf16* proj = (bf16*)(ws + WS_BIG + B_PROJ); bf16* VtF = (bf16*)(ws + WS_BIG + B_VTF); bf16* IKc = (bf16*)(ws + WS_BIG + B_IKC);
    const float* cosT = (const float*)(ws + WS_ROPE); const float* sinT = cosT + S * 8;
    float* Flocal = (float*)(ws + WS_FL); float* Btot = Flocal + S * 8; float* IW = (float*)(ws + WS_IW);
    const float* fqn = in.p[8]; const float* fkn = in.p[9]; const float* dqn = in.p[10]; const float* dkn = in.p[11]; const float* bfg = in.p[7];
    const float* Wsrc = in.p[6]; const float* mixg = in.p[5];
    constexpr int FVP = 1040;
    LAS f32x4* Tw = (LAS f32x4*)lds;
    LAS unsigned char* fvbuf = lds + 65536; LAS float* lf = (LAS float*)(lds + 65536 + 64 * FVP);
    for (int idx = tid; idx < 1024 * 16; idx += NTHREADS) {
        const int k = idx >> 4, col = idx & 15;
        const float v = mixg[k] * Wsrc[(size_t)k * EVEN_SRC + (col < 8 ? ES_FL + col : ES_IW + col - 8)];
        const int ln = (k & 255) >> 2, e = k & 3, q = k >> 8, c = col >> 2;
        ((LAS float*)Tw)[((((q * 4 + e) * 4 + c) * 64 + ln) << 2) + (col & 3)] = v;
    }
    __syncthreads();
    const int d0 = 8 * (lane & 7);
    for (int u = blockIdx.x; u < S / 64; u += G) {
        const int t0 = u * 64, tw0 = t0 + wave * 8;
        bf16* rowb = proj + (size_t)tw0 * EVEN_NP + lane * 8;
        v4u raw[8];
#pragma unroll
        for (int sec = 0; sec < 5; ++sec) {
            const int coff = (sec == 0) ? EC_FQ : (sec == 1) ? EC_DQ : (sec == 2) ? EC_FK : (sec == 3) ? EC_DK : EC_IQ;
            const float* gn = (sec == 0) ? fqn : (sec == 1) ? dqn : (sec == 2) ? fkn : dkn;
            float gv[8];
            if (sec < 4) {
#pragma unroll
                for (int j = 0; j < 8; ++j) gv[j] = gn[d0 + j]; }
#pragma unroll
            for (int i = 0; i < 8; ++i) raw[i] = *(const GAS v4u*)(rowb + (size_t)i * EVEN_NP + coff);
#pragma unroll
            for (int i = 0; i < 8; ++i) {
                float x[8]; unpack8(raw[i], x);
                if (sec < 4) { float ss = 0.f;
#pragma unroll
                    for (int j = 0; j < 8; ++j) ss += x[j] * x[j];
                    ss += shx<1>(ss); ss += shx<2>(ss); ss += shx<4>(ss);
                    const float r = rsqrtf(ss * (1.0f / 64.0f) + RMS_EPS);
#pragma unroll
                    for (int j = 0; j < 8; ++j) x[j] = x[j] * r * gv[j]; }
                if (sec == 1 || sec == 3 || sec == 4) { float cs[8], sn[8]; const int t = tw0 + i;
#pragma unroll
                    for (int j = 0; j < 8; ++j) { cs[j] = cosT[t * 8 + j]; sn[j] = sinT[t * 8 + j]; }
                    rope8(x, cs, sn, lane); }
                *(GAS v4u*)(rowb + (size_t)i * EVEN_NP + coff) = pack8(x);
            }
        }
#pragma unroll
        for (int i = 0; i < 8; ++i) raw[i] = *(const GAS v4u*)(rowb + (size_t)i * EVEN_NP + EC_FV);
#pragma unroll
        for (int i = 0; i < 8; ++i) *(LAS v4u*)(fvbuf + (wave * 8 + i) * FVP + lane * 16) = raw[i];
#pragma unroll
        for (int i = 0; i < 8; ++i) { raw[i] = (v4u){0u, 0u, 0u, 0u}; if (lane < 8) raw[i] = *(const GAS v4u*)(rowb + (size_t)i * EVEN_NP + EC_IK); }
#pragma unroll
        for (int i = 0; i < 8; ++i) { float x[8]; unpack8(raw[i], x); float cs[8], sn[8]; const int t = tw0 + i;
#pragma unroll
            for (int j = 0; j < 8; ++j) { cs[j] = cosT[t * 8 + j]; sn[j] = sinT[t * 8 + j]; }
            rope8(x, cs, sn, lane); if (lane < 8) *(GAS v4u*)(IKc + (size_t)t * 64 + lane * 8) = pack8(x); }
#pragma unroll 1
        for (int rb = 0; rb < 2; ++rb) {
            float acc[64];
#pragma unroll
            for (int j = 0; j < 64; ++j) acc[j] = 0.f;
#pragma unroll
            for (int q = 0; q < 4; ++q) {
                f32x4 hv[4];
#pragma unroll
                for (int r = 0; r < 4; ++r) hv[r] = *((const GAS f32x4*)(H + (size_t)(tw0 + rb * 4 + r) * DM) + lane + 64 * q);
#pragma unroll
                for (int e = 0; e < 4; ++e)
#pragma unroll
                    for (int c = 0; c < 4; ++c) { const f32x4 w = Tw[((q * 4 + e) * 4 + c) * 64 + lane];
#pragma unroll
                        for (int r = 0; r < 4; ++r) { acc[r * 16 + 4 * c + 0] += hv[r][e] * w[0]; acc[r * 16 + 4 * c + 1] += hv[r][e] * w[1]; acc[r * 16 + 4 * c + 2] += hv[r][e] * w[2]; acc[r * 16 + 4 * c + 3] += hv[r][e] * w[3]; } }
            }
            const float zs = reduce_scatter64(acc, lane);
            const int rl = wave * 8 + rb * 4 + (lane >> 4), t = t0 + rl, j = lane & 15;
            const float z = zs * pg8::row_rstd(ssq, t);
            if (j < 8) { const float zz = z + bfg[j]; lf[rl * 8 + j] = (zz > 15.f) ? -expf(-zz) : -log1pf(expf(-zz)); }
            else IW[(size_t)t * 8 + (j - 8)] = z * 0.044194173824159216f;
        }
        __syncthreads();
        {
            float v = lf[lane * 8 + wave];
#pragma unroll
            for (int o = 1; o < 64; o <<= 1) { const float up = __int_as_float(__builtin_amdgcn_ds_bpermute(((lane - o) & 63) << 2, __float_as_int(v))); if (lane >= o) v += up; }
            Flocal[(size_t)(t0 + lane) * 8 + wave] = v;
            if (lane == 63) Btot[u * 8 + wave] = v;
        }
#pragma unroll 2
        for (int p = 0; p < 8; ++p) {
            const int item = p * 512 + tid, c = item >> 3, k = item & 7;
            unsigned short e[8];
#pragma unroll
            for (int j = 0; j < 8; ++j) e[j] = *(const LAS unsigned short*)(fvbuf + (8 * k + j) * FVP + c * 2);
            v4u o; o.x = e[0] | ((unsigned)e[1] << 16); o.y = e[2] | ((unsigned)e[3] << 16); o.z = e[4] | ((unsigned)e[5] << 16); o.w = e[6] | ((unsigned)e[7] << 16);
            *(GAS v4u*)(VtF + (size_t)c * S + t0 + 8 * k) = o;
        }
        __syncthreads();
    }
}
__device__ __forceinline__ void post_odd(const InPtrs& in, unsigned char* ws, LAS unsigned char* lds, int G, int tid, int wave, int lane) {
    bf16* Q = (bf16*)(ws + WS_BIG + B_PROJ); bf16* Kb = Q + (size_t)S * DM; bf16* V = Kb + (size_t)S * DM; bf16* Vt = (bf16*)(ws + WS_BIG + B_VTM);
    const float* cosT = (const float*)(ws + WS_ROPE); const float* sinT = cosT + S * 8;
    float* ksum = (float*)(ws + WS_KSUM);
    const float* qn = in.p[13]; const float* kn = in.p[14];
    constexpr int VP = 1040;
    LAS unsigned char* vbuf = lds; LAS float* kred = (LAS float*)(lds + 64 * VP);
    for (int u = blockIdx.x; u < S / 64; u += G) {
        const int t0 = u * 64;
        float ks0[8], ks1[8];
#pragma unroll
        for (int j = 0; j < 8; ++j) { ks0[j] = 0.f; ks1[j] = 0.f; }
        const int tw0 = t0 + wave * 8, d0 = 8 * (lane & 7);
        v4u raw[8];
#pragma unroll
        for (int sec4 = 0; sec4 < 4; ++sec4) {
            const bool isk = sec4 >= 2; const int sec = sec4 & 1;
            bf16* base = (isk ? Kb : Q) + (size_t)tw0 * DM + sec * 512 + lane * 8;
            const float* gn = isk ? kn : qn;
            float gv[8];
#pragma unroll
            for (int j = 0; j < 8; ++j) gv[j] = gn[d0 + j];
#pragma unroll
            for (int i = 0; i < 8; ++i) raw[i] = *(const GAS v4u*)(base + (size_t)i * DM);
#pragma unroll
            for (int i = 0; i < 8; ++i) {
                float x[8]; unpack8(raw[i], x); float ss = 0.f;
#pragma unroll
                for (int j = 0; j < 8; ++j) ss += x[j] * x[j];
                ss += shx<1>(ss); ss += shx<2>(ss); ss += shx<4>(ss);
                const float r = rsqrtf(ss * (1.0f / 64.0f) + RMS_EPS);
#pragma unroll
                for (int j = 0; j < 8; ++j) x[j] = x[j] * r * gv[j];
                float cs[8], sn[8]; const int t = tw0 + i;
#pragma unroll
                for (int j = 0; j < 8; ++j) { cs[j] = cosT[t * 8 + j]; sn[j] = sinT[t * 8 + j]; }
                rope8(x, cs, sn, lane);
                *(GAS v4u*)(base + (size_t)i * DM) = pack8(x);
                if (isk) {
#pragma unroll
                    for (int j = 0; j < 8; ++j) { if (sec == 0) ks0[j] += x[j]; else ks1[j] += x[j]; } }
            }
        }
#pragma unroll
        for (int j = 0; j < 8; ++j) { kred[wave * 1024 + lane * 8 + j] = ks0[j]; kred[wave * 1024 + 512 + lane * 8 + j] = ks1[j]; }
        __syncthreads();
        {
#pragma unroll
            for (int e = 0; e < 2; ++e) { const int c = tid + 512 * e; float s = 0.f;
#pragma unroll
                for (int w8 = 0; w8 < 8; ++w8) s += kred[w8 * 1024 + c];
                ksum[(size_t)u * 1024 + c] = s; }
        }
        for (int half = 0; half < 2; ++half) {
#pragma unroll
            for (int i = 0; i < 8; ++i) raw[i] = *(const GAS v4u*)(V + (size_t)(tw0 + i) * DM + half * 512 + lane * 8);
#pragma unroll
            for (int i = 0; i < 8; ++i) *(LAS v4u*)(vbuf + (wave * 8 + i) * VP + lane * 16) = raw[i];
            __syncthreads();
#pragma unroll 2
            for (int p = 0; p < 8; ++p) {
                const int item = p * 512 + tid, c = item >> 3, k = item & 7;
                unsigned short e[8];
#pragma unroll
                for (int j = 0; j < 8; ++j) e[j] = *(const LAS unsigned short*)(vbuf + (8 * k + j) * VP + c * 2);
                v4u o; o.x = e[0] | ((unsigned)e[1] << 16); o.y = e[2] | ((unsigned)e[3] << 16); o.z = e[4] | ((unsigned)e[5] << 16); o.w = e[6] | ((unsigned)e[7] << 16);
                *(GAS v4u*)(Vt + (size_t)(half * 512 + c) * S + t0 + 8 * k) = o;
            }
            __syncthreads();
        }
    }
}

constexpr int KV_K_BYTES = 8192, KV_VT_PITCH = 136, KV_BUF_BYTES = KV_K_BYTES + 64 * KV_VT_PITCH;
struct KVRegs { v4u k, v; };
__device__ __forceinline__ void kv_load(KVRegs& r, const bf16* Kp, size_t kpitch, const bf16* Vtp, size_t vtpitch, int key0, int tid) {
    r.k = *(const GAS v4u*)(Kp + (size_t)(key0 + (tid & 63)) * kpitch + (tid >> 6) * 8);
    r.v = *(const GAS v4u*)(Vtp + (size_t)(tid >> 3) * vtpitch + key0 + (tid & 7) * 8);
}
__device__ __forceinline__ void kv_store(const KVRegs& r, LAS unsigned char* buf, int tid) {
    *(LAS v4u*)(buf + ((tid >> 6) * 64 + (tid & 63)) * 16) = r.k;
    LAS unsigned char* vp = buf + KV_K_BYTES + (tid >> 3) * KV_VT_PITCH + (tid & 7) * 16;
    *(LAS u32x2*)vp = (u32x2){r.v.x, r.v.y}; *(LAS u32x2*)(vp + 8) = (u32x2){r.v.z, r.v.w};
}
struct AttnAcc { float m, l; f32x16 o0, o1; };
__device__ __forceinline__ void attn_init(AttnAcc& a) { a.m = -INFINITY; a.l = 0.f;
#pragma unroll
    for (int r = 0; r < 16; ++r) { a.o0[r] = 0.f; a.o1[r] = 0.f; } }
template <int CHS = 1024>
__device__ __forceinline__ void attn_scores(f32x16& p0, f32x16& p1, const LAS unsigned char* buf, const bf16x8 (&qf)[4], int lane) {
    const int r32 = lane & 31, hi = lane >> 5;
#pragma unroll
    for (int r = 0; r < 16; ++r) { p0[r] = 0.f; p1[r] = 0.f; }
#pragma unroll
    for (int ks = 0; ks < 4; ++ks) {
        const bf16x8 k0 = *(const LAS bf16x8*)(buf + (2 * ks + hi) * CHS + r32 * 16);
        const bf16x8 k1 = *(const LAS bf16x8*)(buf + (2 * ks + hi) * CHS + (32 + r32) * 16);
        p0 = __builtin_amdgcn_mfma_f32_32x32x16_bf16(k0, qf[ks], p0, 0, 0, 0);
        p1 = __builtin_amdgcn_mfma_f32_32x32x16_bf16(k1, qf[ks], p1, 0, 0, 0);
    }
}
template <int VTP = KV_VT_PITCH, int VOFF = KV_K_BYTES>
__device__ __forceinline__ void attn_update(AttnAcc& a, f32x16& p0, f32x16& p1, const LAS unsigned char* buf, int lane) {
    const int r32 = lane & 31, hi = lane >> 5;
    float mx = fmaxf(p0[0], p1[0]);
#pragma unroll
    for (int r = 1; r < 16; ++r) mx = fmaxf(mx, fmaxf(p0[r], p1[r]));
    mx = sh32_max(mx);
    const float mnew = fmaxf(a.m, mx);
    const float msafe = (mnew == -INFINITY) ? 0.f : mnew;
    const float alpha = __builtin_amdgcn_exp2f(a.m - msafe);
    float sum = 0.f;
#pragma unroll
    for (int r = 0; r < 16; ++r) { p0[r] = __builtin_amdgcn_exp2f(p0[r] - msafe); p1[r] = __builtin_amdgcn_exp2f(p1[r] - msafe); sum += p0[r] + p1[r]; }
    a.l = a.l * alpha + sum; a.m = mnew;
#pragma unroll
    for (int r = 0; r < 16; ++r) { a.o0[r] *= alpha; a.o1[r] *= alpha; }
    const LAS unsigned char* vt = buf + VOFF + r32 * VTP + hi * 8;
#pragma unroll
    for (int half = 0; half < 2; ++half) {
#pragma unroll
        for (int s = 0; s < 2; ++s) {
            v4u pw;
            if (half == 0) { pw.x = cvtpk(p0[8 * s + 0], p0[8 * s + 1]); pw.y = cvtpk(p0[8 * s + 2], p0[8 * s + 3]); pw.z = cvtpk(p0[8 * s + 4], p0[8 * s + 5]); pw.w = cvtpk(p0[8 * s + 6], p0[8 * s + 7]); }
            else           { pw.x = cvtpk(p1[8 * s + 0], p1[8 * s + 1]); pw.y = cvtpk(p1[8 * s + 2], p1[8 * s + 3]); pw.z = cvtpk(p1[8 * s + 4], p1[8 * s + 5]); pw.w = cvtpk(p1[8 * s + 6], p1[8 * s + 7]); }
            const bf16x8 pb = __builtin_bit_cast(bf16x8, pw);
            const int kb = (32 * half + 16 * s) * 2;
#pragma unroll
            for (int d0 = 0; d0 < 2; ++d0) {
                const u32x2 lo = *(const LAS u32x2*)(vt + d0 * 32 * VTP + kb), hi2 = *(const LAS u32x2*)(vt + d0 * 32 * VTP + kb + 16);
                const bf16x8 va = __builtin_bit_cast(bf16x8, (v4u){lo.x, lo.y, hi2.x, hi2.y});
                if (d0 == 0) a.o0 = __builtin_amdgcn_mfma_f32_32x32x16_bf16(va, pb, a.o0, 0, 0, 0);
                else         a.o1 = __builtin_amdgcn_mfma_f32_32x32x16_bf16(va, pb, a.o1, 0, 0, 0);
            }
        }
    }
}
__device__ __forceinline__ void attn_store(const AttnAcc& a, bf16* orow, int lane) {
    const int hi = lane >> 5;
    float l = sh32_sum(a.l);
    const float inv = (l > 0.f) ? 1.0f / l : 0.f;
#pragma unroll
    for (int g = 0; g < 4; ++g) {
        u32x2 w0, w1;
        w0.x = cvtpk(a.o0[4 * g] * inv, a.o0[4 * g + 1] * inv); w0.y = cvtpk(a.o0[4 * g + 2] * inv, a.o0[4 * g + 3] * inv);
        w1.x = cvtpk(a.o1[4 * g] * inv, a.o1[4 * g + 1] * inv); w1.y = cvtpk(a.o1[4 * g + 2] * inv, a.o1[4 * g + 3] * inv);
        *(GAS u32x2*)(orow + 8 * g + 4 * hi) = w0; *(GAS u32x2*)(orow + 32 + 8 * g + 4 * hi) = w1;
    }
}
__device__ __forceinline__ void load_q(bf16x8 (&qf)[4], const bf16* qrow, int lane) {
    const int hi = lane >> 5;
#pragma unroll
    for (int ks = 0; ks < 4; ++ks) qf[ks] = *(const GAS bf16x8*)(qrow + 16 * ks + 8 * hi);
}

__device__ __forceinline__ void fox_phase(unsigned char* ws, LAS unsigned char* lds, int G, int tid, int wave, int lane, bf16* obase, size_t opitch) {
    bf16* proj = (bf16*)(ws + WS_BIG + B_PROJ); const bf16* VtF = (const bf16*)(ws + WS_BIG + B_VTF);
    const float* Flocal = (const float*)(ws + WS_FL); const float* Btot = Flocal + S * 8;
    LAS unsigned char* kvb = lds; LAS float* kbt = (LAS float*)(lds + 2 * KV_BUF_BYTES); LAS float* bt = (LAS float*)(lds + 2 * KV_BUF_BYTES + 65536); LAS float* Et = bt + 272;
    const int r32 = lane & 31, hi = lane >> 5;
    for (int pi = blockIdx.x; pi < 256; pi += G) {
        const int h = pi >> 5, sidx = pi & 31;
        for (int uu = 0; uu < 2; ++uu) {
            const int QB = uu ? 63 - sidx : sidx, q0 = QB * 256, nt = 4 * (QB + 1), nt64 = nt;
            __syncthreads();
            for (int j = tid; j < nt64; j += NTHREADS) bt[j] = Btot[j * 8 + h];
            __syncthreads();
            for (int j = tid; j < nt64; j += NTHREADS) { float e = 0.f;
                if (j <= 4 * QB) { for (int i = 4 * QB - 1; i >= j; --i) e -= bt[i]; } else { for (int i = 4 * QB; i < j; ++i) e += bt[i]; }
                Et[j] = e; }
            __syncthreads();
            for (int s = tid; s < q0 + 256; s += NTHREADS) kbt[s] = -(Et[s >> 6] + Flocal[(size_t)s * 8 + h]) * LOG2E;
            const int qrow = q0 + wave * 32 + r32;
            bf16x8 qf[4]; load_q(qf, proj + (size_t)qrow * EVEN_NP + EC_FQ + h * 64, lane);
            AttnAcc a; attn_init(a);
            const bf16* Kp = proj + EC_FK + h * 64; const bf16* Vtp = VtF + (size_t)h * 64 * S;
            KVRegs kr; kv_load(kr, Kp, EVEN_NP, Vtp, S, 0, tid); kv_store(kr, kvb, tid);
            __syncthreads();
            for (int t = 0; t < nt; ++t) {
                LAS unsigned char* cur = kvb + (t & 1) * KV_BUF_BYTES;
                if (t + 1 < nt) kv_load(kr, Kp, EVEN_NP, Vtp, S, (t + 1) * 64, tid);
                const int key0 = t * 64;
                if (key0 <= q0 + wave * 32 + 31) {
                    f32x16 p0, p1; attn_scores(p0, p1, cur, qf, lane);
#pragma unroll
                    for (int g = 0; g < 4; ++g) {
                        const f32x4 b0 = *(const LAS f32x4*)(kbt + key0 + 8 * g + 4 * hi), b1 = *(const LAS f32x4*)(kbt + key0 + 32 + 8 * g + 4 * hi);
#pragma unroll
                        for (int e = 0; e < 4; ++e) { p0[4 * g + e] = p0[4 * g + e] * C2 + b0[e]; p1[4 * g + e] = p1[4 * g + e] * C2 + b1[e]; }
                    }
                    if (key0 + 63 > q0 + wave * 32) {
#pragma unroll
                        for (int r = 0; r < 16; ++r) { const int kv = key0 + crow(r, hi); if (kv > qrow) p0[r] = -INFINITY; if (kv + 32 > qrow) p1[r] = -INFINITY; }
                    }
                    attn_update(a, p0, p1, cur, lane);
                }
                if (t + 1 < nt) kv_store(kr, kvb + ((t + 1) & 1) * KV_BUF_BYTES, tid);
                __syncthreads();
            }
            attn_store(a, obase + (size_t)qrow * opitch + h * 64, lane);
        }
    }
}

__device__ __forceinline__ void memattn_phase(const InPtrs& in, unsigned char* ws, int L, LAS unsigned char* lds, int G, int tid, int wave, int lane) {
    const bf16* QM = (const bf16*)(ws + WS_BIG + B_QM); bf16* OM = (bf16*)(ws + WS_BIG + B_OM);
    const bf16* memK = (const bf16*)(ws + WS_MEMK) + (size_t)L * 256 * 256; const bf16* memVt = (const bf16*)(ws + WS_MEMK + 256 * 1024) + (size_t)L * 256 * 256;
    const float* qn = in.p[20] + (size_t)L * 64;
    LAS unsigned char* kvb = lds;
    const int r32 = lane & 31, hi = lane >> 5;
    for (int un = blockIdx.x; un < 256; un += G) {
        const int QB = un >> 2, hm = un & 3, qrow = QB * 256 + wave * 32 + r32;
        bf16x8 qf[4];
        {
            const bf16* qp = QM + (size_t)qrow * MEMW + hm * 64; float x[4][8]; float ss = 0.f;
#pragma unroll
            for (int ks = 0; ks < 4; ++ks) { const v4u w = *(const GAS v4u*)(qp + 16 * ks + 8 * hi); unpack8(w, x[ks]);
#pragma unroll
                for (int j = 0; j < 8; ++j) ss += x[ks][j] * x[ks][j]; }
            ss = sh32_sum(ss);
            const float r = rsqrtf(ss * (1.0f / 64.0f) + RMS_EPS);
#pragma unroll
            for (int ks = 0; ks < 4; ++ks) {
#pragma unroll
                for (int j = 0; j < 8; ++j) x[ks][j] = x[ks][j] * r * qn[16 * ks + 8 * hi + j];
                qf[ks] = __builtin_bit_cast(bf16x8, pack8(x[ks])); }
        }
        AttnAcc a; attn_init(a);
        const bf16* Kp = memK + hm * 64; const bf16* Vtp = memVt + (size_t)hm * 64 * 256;
        __syncthreads();
        KVRegs kr; kv_load(kr, Kp, 256, Vtp, 256, 0, tid); kv_store(kr, kvb, tid);
        __syncthreads();
        for (int t = 0; t < 4; ++t) {
            LAS unsigned char* cur = kvb + (t & 1) * KV_BUF_BYTES;
            if (t + 1 < 4) kv_load(kr, Kp, 256, Vtp, 256, (t + 1) * 64, tid);
            f32x16 p0, p1; attn_scores(p0, p1, cur, qf, lane);
#pragma unroll
            for (int r = 0; r < 16; ++r) { p0[r] *= C2; p1[r] *= C2; }
            attn_update(a, p0, p1, cur, lane);
            if (t + 1 < 4) kv_store(kr, kvb + ((t + 1) & 1) * KV_BUF_BYTES, tid);
            __syncthreads();
        }
        attn_store(a, OM + (size_t)qrow * MEMW + hm * 64, lane);
    }
}

constexpr size_t WS_MSEL = 7 * MiB;
constexpr size_t WS_MLSE = 8 * MiB;
constexpr size_t B_OP0 = 64 * MiB, B_OP1 = 128 * MiB;
__device__ __forceinline__ bool gate_better(float g1, int n1, float g2, int n2) { return g1 > g2 || (g1 == g2 && n1 < n2); }
__device__ __forceinline__ void moba_gate_phase(unsigned char* ws, int G, int wave, int lane) {
    const bf16* Q = (const bf16*)(ws + WS_BIG + B_PROJ); const float* ksum = (const float*)(ws + WS_KSUM); unsigned* selg = (unsigned*)(ws + WS_MSEL);
    const int r32 = lane & 31, hi = lane >> 5;
    const int NW = G * NWAVES;
    const int gwid = (int)blockIdx.x * NWAVES + wave;
    const int per_head = NW / 16;
    if (per_head == 0) return;
    const int h = gwid / per_head, wi = gwid % per_head;
    if (h >= 16) return;
    float af[2][32];
#pragma unroll
    for (int g = 0; g < 2; ++g)
#pragma unroll
        for (int kk = 0; kk < 32; ++kk) { const float* kp = ksum + (size_t)(32 * g + r32) * 4096 + h * 64 + 2 * kk + hi;
            af[g][kk] = ((kp[0] + kp[1024]) + (kp[2048] + kp[3072])) * (1.0f / 256.0f); }
    for (int tile = wi; tile < S / 32; tile += per_head) {
        const int t = tile * 32 + r32, own = (tile * 32) >> 8;
        float bq[32];
        { const bf16* qp = Q + (size_t)t * DM + h * 64;
#pragma unroll
          for (int c = 0; c < 8; ++c) { const unsigned sh = hi ? 0u : 16u;   const v4u w = *(const GAS v4u*)(qp + 8 * c);
              bq[4 * c + 0] = __uint_as_float((w.x << sh) & 0xffff0000u); bq[4 * c + 1] = __uint_as_float((w.y << sh) & 0xffff0000u);
              bq[4 * c + 2] = __uint_as_float((w.z << sh) & 0xffff0000u); bq[4 * c + 3] = __uint_as_float((w.w << sh) & 0xffff0000u); } }
        float g0 = -INFINITY, g1 = -INFINITY, g2 = -INFINITY; int n0 = 255, n1 = 255, n2 = 255;
#pragma unroll
        for (int g = 0; g < 2; ++g) {
            if (32 * g < own) {
                f32x16 c;
#pragma unroll
                for (int r = 0; r < 16; ++r) c[r] = 0.f;
#pragma unroll
                for (int kk = 0; kk < 32; ++kk) c = __builtin_amdgcn_mfma_f32_32x32x2f32(af[g][kk], bq[kk], c, 0, 0, 0);
#pragma unroll
                for (int r = 0; r < 16; ++r) { const int n = 32 * g + crow(r, hi); const float gv = (n < own) ? c[r] : -INFINITY;
                    if (n < own) {
                        if (gate_better(gv, n, g0, n0)) { g2 = g1; n2 = n1; g1 = g0; n1 = n0; g0 = gv; n0 = n; }
                        else if (gate_better(gv, n, g1, n1)) { g2 = g1; n2 = n1; g1 = gv; n1 = n; }
                        else if (gate_better(gv, n, g2, n2)) { g2 = gv; n2 = n; } } }
            }
        }
        const float p0 = sh32_get(g0, lane), p1 = sh32_get(g1, lane), p2 = sh32_get(g2, lane);
        const int pn0 = __float_as_int(sh32_get(__int_as_float(n0), lane)), pn1 = __float_as_int(sh32_get(__int_as_float(n1), lane)), pn2 = __float_as_int(sh32_get(__int_as_float(n2), lane));
        float fg[3]; int fn[3]; int ia = 0, ib = 0;
#pragma unroll
        for (int k = 0; k < 3; ++k) {
            const float ga = (ia == 0) ? g0 : (ia == 1) ? g1 : (ia == 2) ? g2 : -INFINITY; const int na = (ia == 0) ? n0 : (ia == 1) ? n1 : (ia == 2) ? n2 : 255;
            const float gb = (ib == 0) ? p0 : (ib == 1) ? p1 : (ib == 2) ? p2 : -INFINITY; const int nb = (ib == 0) ? pn0 : (ib == 1) ? pn1 : (ib == 2) ? pn2 : 255;
            const bool ta = (na != 255) && (nb == 255 || gate_better(ga, na, gb, nb));
            if (ta) { fg[k] = ga; fn[k] = na; ++ia; } else { fg[k] = gb; fn[k] = nb; ++ib; }
        }
        (void)fg;
        if (hi == 0) selg[(size_t)h * S + t] = (unsigned)(fn[0] & 255) | ((unsigned)(fn[1] & 255) << 8) | ((unsigned)(fn[2] & 255) << 16);
    }
}
constexpr int MR_KIMG = 32768, MR_VTP = 520, MR_VIMG = 64 * MR_VTP;
__device__ __forceinline__ void moba_route_phase(unsigned char* ws, LAS unsigned char* lds, int G, int tid, int wave, int lane) {
    const bf16* Q = (const bf16*)(ws + WS_BIG + B_PROJ); const bf16* Kb = Q + (size_t)S * DM; const bf16* Vt = (const bf16*)(ws + WS_BIG + B_VTM);
    const unsigned* selg = (const unsigned*)(ws + WS_MSEL); float* lse = (float*)(ws + WS_MLSE);
    LAS unsigned char* kimg = lds; LAS unsigned char* vimg = lds + MR_KIMG;
    LAS int* list = (LAS int*)(lds + MR_KIMG + MR_VIMG);
    LAS int* wtot = list + 2048;
    const int r32 = lane & 31, hi = lane >> 5;
    const int NUNITS = 16 * 280;
    for (int u = blockIdx.x; u < NUNITS; u += G) {
        int c = 0, rem = u;
        while (rem >= 16 * (8 * c + 7)) { rem -= 16 * (8 * c + 7); ++c; }
        const int n = rem >> 4, h = rem & 15;
        const int tlo = max(2048 * c, 256 * (n + 1));
        __syncthreads();
        int myent[4]; bool mysel[4];
#pragma unroll
        for (int i = 0; i < 4; ++i) { const int t = 2048 * c + 512 * i + tid; mysel[i] = false; myent[i] = 0;
            if (t >= tlo) { const unsigned w = selg[(size_t)h * S + t];
                const int slot = ((w & 255u) == (unsigned)n) ? 0 : (((w >> 8) & 255u) == (unsigned)n) ? 1 : (((w >> 16) & 255u) == (unsigned)n) ? 2 : -1;
                if (slot >= 0) { mysel[i] = true; myent[i] = t | (slot << 16); } }
            const unsigned long long mk = __ballot(mysel[i]);
            if (lane == 0) wtot[i * 8 + wave] = __popcll(mk); }
        __syncthreads();
        int cnt = 0;
#pragma unroll
        for (int i = 0; i < 4; ++i) { int base = cnt;
#pragma unroll
            for (int w8 = 0; w8 < 8; ++w8) { const int v = wtot[i * 8 + w8]; if (w8 < wave) base += v; cnt += v; }
            const unsigned long long mk = __ballot(mysel[i]);
            if (mysel[i]) list[base + __popcll(mk & ((1ull << lane) - 1ull))] = myent[i]; }
        { const bf16* Kp = Kb + (size_t)(256 * n) * DM + h * 64; const bf16* Vp = Vt + (size_t)h * 64 * S + 256 * n;
#pragma unroll
          for (int i = 0; i < 4; ++i) { const int piece = tid + 512 * i, key = piece & 255, ch = piece >> 8;
              const v4u kv = *(const GAS v4u*)(Kp + (size_t)key * DM + ch * 8); *(LAS v4u*)(kimg + (ch * 256 + key) * 16) = kv;
              const int d = piece >> 5, c16 = piece & 31;
              const v4u vv = *(const GAS v4u*)(Vp + (size_t)d * S + c16 * 8); LAS unsigned char* vp = vimg + d * MR_VTP + c16 * 16;
              *(LAS u32x2*)vp = (u32x2){vv.x, vv.y}; *(LAS u32x2*)(vp + 8) = (u32x2){vv.z, vv.w}; } }
        __syncthreads();
        if (cnt == 0) continue;
        const int ntile = (cnt + 31) >> 5;
        for (int ti = wave; ti < ntile; ti += NWAVES) {
            const int e = ti * 32 + r32; const bool live = e < cnt;
            const int ent = list[live ? e : 0]; const int t = ent & 0xffff, slot = ent >> 16;
            bf16x8 qf[4]; load_q(qf, Q + (size_t)t * DM + h * 64, lane);
            AttnAcc a; attn_init(a);
#pragma unroll 1
            for (int j = 0; j < 4; ++j) {
                f32x16 p0, p1; attn_scores<4096>(p0, p1, kimg + j * 64 * 16, qf, lane);
#pragma unroll
                for (int r = 0; r < 16; ++r) { p0[r] *= C2; p1[r] *= C2; }
                attn_update<MR_VTP, 0>(a, p0, p1, vimg + j * 128, lane);
            }
            const float l = sh32_sum(a.l); const float inv = 1.0f / l;
            if (live) {
                bf16* orow = (bf16*)(ws + (slot == 0 ? WS_BIG + B_OP0 : slot == 1 ? WS_BIG + B_OP1 : WS_HB)) + ((size_t)t * 16 + h) * 64;
#pragma unroll
                for (int g = 0; g < 4; ++g) { u32x2 w0, w1;
                    w0.x = cvtpk(a.o0[4 * g] * inv, a.o0[4 * g + 1] * inv); w0.y = cvtpk(a.o0[4 * g + 2] * inv, a.o0[4 * g + 3] * inv);
                    w1.x = cvtpk(a.o1[4 * g] * inv, a.o1[4 * g + 1] * inv); w1.y = cvtpk(a.o1[4 * g + 2] * inv, a.o1[4 * g + 3] * inv);
                    *(GAS u32x2*)(orow + 8 * g + 4 * hi) = w0; *(GAS u32x2*)(orow + 32 + 8 * g + 4 * hi) = w1; }
                if (hi == 0) lse[((size_t)slot * S + t) * 16 + h] = a.m + __builtin_amdgcn_logf(l);
            }
        }
    }
}
__device__ __forceinline__ void moba_own_phase(unsigned char* ws, LAS unsigned char* lds, int G, int tid, int wave, int lane) {
    bf16* Q = (bf16*)(ws + WS_BIG + B_PROJ); const bf16* Kb = Q + (size_t)S * DM; const bf16* Vt = (const bf16*)(ws + WS_BIG + B_VTM);
    const unsigned* selg = (const unsigned*)(ws + WS_MSEL); const float* lse = (const float*)(ws + WS_MLSE);
    LAS unsigned char* kvb = lds;
    const int r32 = lane & 31, hi = lane >> 5;
    for (int un = blockIdx.x; un < 1024; un += G) {
        const int h = un & 15, QB = un >> 4, q0 = QB * 256, qrow = q0 + wave * 32 + r32;
        bf16x8 qf[4]; load_q(qf, Q + (size_t)qrow * DM + h * 64, lane);
        AttnAcc a; attn_init(a);
        const bf16* Kp = Kb + h * 64; const bf16* Vtp = Vt + (size_t)h * 64 * S;
        __syncthreads();
        KVRegs kr; kv_load(kr, Kp, DM, Vtp, S, q0, tid); kv_store(kr, kvb, tid);
        __syncthreads();
        for (int t = 0; t < 4; ++t) {
            LAS unsigned char* cur = kvb + (t & 1) * KV_BUF_BYTES;
            const int key0 = q0 + t * 64;
            if (t + 1 < 4) kv_load(kr, Kp, DM, Vtp, S, key0 + 64, tid);
            if (key0 <= q0 + wave * 32 + 31) {
                f32x16 p0, p1; attn_scores(p0, p1, cur, qf, lane);
#pragma unroll
                for (int r = 0; r < 16; ++r) { const int kv = key0 + crow(r, hi); p0[r] = (kv > qrow) ? -INFINITY : p0[r] * C2; p1[r] = (kv + 32 > qrow) ? -INFINITY : p1[r] * C2; }
                attn_update(a, p0, p1, cur, lane);
            }
            if (t + 1 < 4) kv_store(kr, kvb + ((t + 1) & 1) * KV_BUF_BYTES, tid);
            __syncthreads();
        }
        const unsigned sw = selg[(size_t)h * S + qrow];
        float L[3];
#pragma unroll
        for (int j = 0; j < 3; ++j) L[j] = (((sw >> (8 * j)) & 255u) != 255u) ? lse[((size_t)j * S + qrow) * 16 + h] : -INFINITY;
        const float M = fmaxf(fmaxf(a.m, L[0]), fmaxf(L[1], L[2]));
        const float so = __builtin_amdgcn_exp2f(a.m - M);
        float W = sh32_sum(a.l) * so;
#pragma unroll
        for (int r = 0; r < 16; ++r) { a.o0[r] *= so; a.o1[r] *= so; }
#pragma unroll
        for (int j = 0; j < 3; ++j) {
            if (L[j] != -INFINITY) {
                const float wj = __builtin_amdgcn_exp2f(L[j] - M); W += wj;
                const bf16* orow = (const bf16*)(ws + (j == 0 ? WS_BIG + B_OP0 : j == 1 ? WS_BIG + B_OP1 : WS_HB)) + ((size_t)qrow * 16 + h) * 64;
#pragma unroll
                for (int g = 0; g < 4; ++g) { const u32x2 w0 = *(const GAS u32x2*)(orow + 8 * g + 4 * hi), w1 = *(const GAS u32x2*)(orow + 32 + 8 * g + 4 * hi);
                    a.o0[4 * g] += wj * bflo(w0.x); a.o0[4 * g + 1] += wj * bfhi(w0.x); a.o0[4 * g + 2] += wj * bflo(w0.y); a.o0[4 * g + 3] += wj * bfhi(w0.y);
                    a.o1[4 * g] += wj * bflo(w1.x); a.o1[4 * g + 1] += wj * bfhi(w1.x); a.o1[4 * g + 2] += wj * bflo(w1.y); a.o1[4 * g + 3] += wj * bfhi(w1.y); }
            }
        }
        const float inv = 1.0f / W;
        bf16* orow = Q + (size_t)qrow * DM + h * 64;
#pragma unroll
        for (int g = 0; g < 4; ++g) { u32x2 w0, w1;
            w0.x = cvtpk(a.o0[4 * g] * inv, a.o0[4 * g + 1] * inv); w0.y = cvtpk(a.o0[4 * g + 2] * inv, a.o0[4 * g + 3] * inv);
            w1.x = cvtpk(a.o1[4 * g] * inv, a.o1[4 * g + 1] * inv); w1.y = cvtpk(a.o1[4 * g + 2] * inv, a.o1[4 * g + 3] * inv);
            *(GAS u32x2*)(orow + 8 * g + 4 * hi) = w0; *(GAS u32x2*)(orow + 32 + 8 * g + 4 * hi) = w1; }
    }
}

typedef float f32x4v __attribute__((ext_vector_type(4)));
__device__ __forceinline__ unsigned mono_key(float s) { if (s == 0.f) s = 0.f; const unsigned u = __float_as_uint(s); return (u & 0x80000000u) ? ~u : (u | 0x80000000u); }
constexpr int DS_CAP = 512, DS_CHUNK = 128;
__device__ __forceinline__ unsigned dsa_compact(LAS unsigned* keys, LAS unsigned short* idxs, int n, int lane) {
    unsigned k[8]; unsigned short ix[8];
#pragma unroll
    for (int j = 0; j < 8; ++j) { const int e = lane + 64 * j; const bool in = e < n; k[j] = in ? keys[e] : 0u; ix[j] = in ? idxs[e] : (unsigned short)0; }
    unsigned T = 0u; int cntT = n;
    for (int bit = 31; bit >= 0; --bit) {
        const unsigned cand = T | (1u << bit); int c = 0;
#pragma unroll
        for (int j = 0; j < 8; ++j) c += __popcll(__ballot(k[j] >= cand));
        if (c >= 256) { T = cand; cntT = c; }
    }
    int Jstar = 0x10000;
    if (cntT > 256) {
        int gt = 0;
#pragma unroll
        for (int j = 0; j < 8; ++j) gt += __popcll(__ballot(k[j] > T));
        const int need = 256 - gt; int Jm = 0;
        for (int bit = 14; bit >= 0; --bit) { const int cand = Jm | (1 << bit); int c = 0;
#pragma unroll
            for (int j = 0; j < 8; ++j) c += __popcll(__ballot(k[j] == T && (int)ix[j] < cand));
            if (c < need) Jm = cand; }
        Jstar = Jm + 1;
    }
    int base = 0;
    const unsigned long long lt = (1ull << lane) - 1ull;
#pragma unroll
    for (int j = 0; j < 8; ++j) { const bool pred = (k[j] > T) || (k[j] == T && T != 0u && (int)ix[j] < Jstar);
        const unsigned long long mask = __ballot(pred); const int pos = base + __popcll(mask & lt);
        if (pred) { keys[pos] = k[j]; idxs[pos] = ix[j]; }
        base += __popcll(mask); }
    return T;
}
__device__ __forceinline__ void dsa_select_phase(unsigned char* ws, LAS unsigned char* lds, int G, int tid, int wave, int lane) {
    const bf16* proj = (const bf16*)(ws + WS_BIG + B_PROJ); const bf16* IKc = (const bf16*)(ws + WS_BIG + B_IKC); const float* IW = (const float*)(ws + WS_IW);
    unsigned short* selg = (unsigned short*)(ws + WS_BIG + B_SEL);
    LAS unsigned char* kbuf = lds;
    LAS unsigned* ckeys = (LAS unsigned*)(lds + 32768);
    LAS unsigned short* cidx = (LAS unsigned short*)(lds + 32768 + 65536);
    const int r32 = lane & 31, hi = lane >> 5;
    const unsigned lowmask = (1u << r32) - 1u;
    for (int pi = blockIdx.x; pi < 256; pi += G) {
        for (int uu = 0; uu < 2; ++uu) {
            const int blk = uu ? 511 - pi : pi, tb = blk * 32;
            const int tw = tb + 4 * wave;
            bf16x8 af[4];
            { const int i = r32, qi = 2 * (i >> 4) + ((i >> 2) & 1), hd = 4 * ((i >> 3) & 1) + (i & 3);
              const bf16* ap = proj + (size_t)(tw + qi) * EVEN_NP + EC_IQ + hd * 64 + 8 * hi;
#pragma unroll
              for (int ks = 0; ks < 4; ++ks) af[ks] = *(const GAS bf16x8*)(ap + 16 * ks); }
            float w0[8], w1[8];
            { const f32x4 a = *(const GAS f32x4*)(IW + (size_t)(tw + hi) * 8), b = *(const GAS f32x4*)(IW + (size_t)(tw + hi) * 8 + 4);
              const f32x4 c = *(const GAS f32x4*)(IW + (size_t)(tw + 2 + hi) * 8), d = *(const GAS f32x4*)(IW + (size_t)(tw + 2 + hi) * 8 + 4);
#pragma unroll
              for (int j = 0; j < 4; ++j) { w0[j] = a[j]; w0[4 + j] = b[j]; w1[j] = c[j]; w1[4 + j] = d[j]; } }
            const int q0t = tw + hi, q1t = tw + 2 + hi;
            LAS unsigned* kq0 = ckeys + (4 * wave + hi) * DS_CAP; LAS unsigned* kq1 = ckeys + (4 * wave + 2 + hi) * DS_CAP;
            LAS unsigned short* iq0 = cidx + (4 * wave + hi) * DS_CAP; LAS unsigned short* iq1 = cidx + (4 * wave + 2 + hi) * DS_CAP;
            unsigned thr0 = 0u, thr1 = 0u; int cnt0 = 0, cnt1 = 0;
            const int nch = (tb + 32 + DS_CHUNK - 1) / DS_CHUNK;
            __syncthreads();
            v4u st[2];
#pragma unroll
            for (int c = 0; c < 2; ++c) { const int piece = tid + 512 * c; st[c] = *(const GAS v4u*)(IKc + (size_t)(piece >> 3) * 64 + (piece & 7) * 8); }
#pragma unroll
            for (int c = 0; c < 2; ++c) { const int piece = tid + 512 * c, key = piece >> 3, ch = piece & 7; *(LAS v4u*)(kbuf + key * 128 + ((ch ^ (key & 7)) * 16)) = st[c]; }
            __syncthreads();
            for (int cb = 0; cb < nch; ++cb) {
                LAS unsigned char* cur = kbuf + (cb & 1) * 16384;
                if (cb + 1 < nch) {
#pragma unroll
                    for (int c = 0; c < 2; ++c) { const int piece = tid + 512 * c; st[c] = *(const GAS v4u*)(IKc + (size_t)((cb + 1) * DS_CHUNK + (piece >> 3)) * 64 + (piece & 7) * 8); } }
#pragma unroll 1
                for (int j = 0; j < 4; ++j) {
                    const int key0 = cb * DS_CHUNK + 32 * j;
                    if (key0 > tw + 3) break;
                    f32x16 p;
#pragma unroll
                    for (int r = 0; r < 16; ++r) p[r] = 0.f;
                    const int kl = 32 * j + r32;
#pragma unroll
                    for (int ks = 0; ks < 4; ++ks) { const bf16x8 bfr = *(const LAS bf16x8*)(cur + kl * 128 + (((2 * ks + hi) ^ (kl & 7)) * 16));
                        p = __builtin_amdgcn_mfma_f32_32x32x16_bf16(af[ks], bfr, p, 0, 0, 0); }
                    float s0 = 0.f, s1 = 0.f;
#pragma unroll
                    for (int r = 0; r < 8; ++r) { s0 += w0[r] * fmaxf(p[r], 0.f); s1 += w1[r] * fmaxf(p[8 + r], 0.f); }
                    const int key = key0 + r32;
                    const unsigned u0 = mono_key(s0), u1 = mono_key(s1);
                    const bool pr0 = (key <= q0t) && (u0 > thr0), pr1 = (key <= q1t) && (u1 > thr1);
                    const unsigned long long m0 = __ballot(pr0), m1 = __ballot(pr1);
                    if (m0 | m1) {
                        const unsigned h0 = hi ? (unsigned)(m0 >> 32) : (unsigned)m0, h1 = hi ? (unsigned)(m1 >> 32) : (unsigned)m1;
                        if (pr0) { const int pos = cnt0 + __popc(h0 & lowmask); kq0[pos] = u0; iq0[pos] = (unsigned short)key; }
                        if (pr1) { const int pos = cnt1 + __popc(h1 & lowmask); kq1[pos] = u1; iq1[pos] = (unsigned short)key; }
                        cnt0 += __popc(h0); cnt1 += __popc(h1);
                        const unsigned long long need = __ballot(cnt0 > DS_CAP - 32 || cnt1 > DS_CAP - 32);
                        if (need) {
#pragma unroll 1
                            for (int hh = 0; hh < 2; ++hh) {
                                const int c0 = __builtin_amdgcn_readlane(cnt0, 0), c0b = __builtin_amdgcn_readlane(cnt0, 32);
                                const int c1 = __builtin_amdgcn_readlane(cnt1, 0), c1b = __builtin_amdgcn_readlane(cnt1, 32);
                                const int n0 = hh ? c0b : c0, n1 = hh ? c1b : c1;
                                if (n0 > DS_CAP - 32) { const unsigned T = dsa_compact(ckeys + (4 * wave + hh) * DS_CAP, cidx + (4 * wave + hh) * DS_CAP, n0, lane); if (hi == hh) { thr0 = T; cnt0 = 256; } }
                                if (n1 > DS_CAP - 32) { const unsigned T = dsa_compact(ckeys + (4 * wave + 2 + hh) * DS_CAP, cidx + (4 * wave + 2 + hh) * DS_CAP, n1, lane); if (hi == hh) { thr1 = T; cnt1 = 256; } }
                            }
                        }
                    }
                }
                if (cb + 1 < nch) {
                    LAS unsigned char* nxt = kbuf + ((cb + 1) & 1) * 16384;
#pragma unroll
                    for (int c = 0; c < 2; ++c) { const int piece = tid + 512 * c, key = piece >> 3, ch = piece & 7; *(LAS v4u*)(nxt + key * 128 + ((ch ^ (key & 7)) * 16)) = st[c]; }
                }
                __syncthreads();
            }
#pragma unroll 1
            for (int qq = 0; qq < 4; ++qq) {
                const int hh = qq & 1, sl = qq >> 1;
                int n = sl ? __builtin_amdgcn_readlane(cnt1, 32 * hh) : __builtin_amdgcn_readlane(cnt0, 32 * hh);
                LAS unsigned* kk = ckeys + (4 * wave + qq) * DS_CAP; LAS unsigned short* ii = cidx + (4 * wave + qq) * DS_CAP;
                if (n > 256) { (void)dsa_compact(kk, ii, n, lane); n = 256; }
                unsigned short* row = selg + (size_t)(tw + qq) * 256;
#pragma unroll
                for (int e4 = 0; e4 < 4; ++e4) { const int e = lane + 64 * e4; row[e] = (e < n) ? ii[e] : (unsigned short)0xFFFFu; }
            }
        }
    }
}

__device__ __forceinline__ void dsa_sparse_phase(unsigned char* ws, int G, int wave, int lane, bf16* obase, size_t opitch) {
    const bf16* proj = (const bf16*)(ws + WS_BIG + B_PROJ); const unsigned short* selg = (const unsigned short*)(ws + WS_BIG + B_SEL);
    const int h = (int)blockIdx.x & 7, wg = (int)blockIdx.x >> 3, nwg = G >> 3;
    const int kg = lane >> 3, ds8 = (lane & 7) * 8;
    for (int t = wg * NWAVES + wave; t < S; t += nwg * NWAVES) {
        v4u iw[4];
#pragma unroll
        for (int c = 0; c < 4; ++c) iw[c] = *(const GAS v4u*)(selg + (size_t)t * 256 + 32 * kg + 8 * c);
        float qv[8];
        { const v4u w = *(const GAS v4u*)(proj + (size_t)t * EVEN_NP + EC_DQ + h * 64 + ds8); unpack8(w, qv);
#pragma unroll
          for (int j = 0; j < 8; ++j) qv[j] *= C2; }
        float sc[32];
#pragma unroll
        for (int i0 = 0; i0 < 32; i0 += 8) {
            v4u kw[8];
#pragma unroll
            for (int j = 0; j < 8; ++j) { const int i = i0 + j; const unsigned wd = (i & 1) ? (iw[i >> 3][(i >> 1) & 3] >> 16) : (iw[i >> 3][(i >> 1) & 3] & 0xffffu);
                const unsigned idx = (wd == 0xffffu) ? 0u : wd;
                kw[j] = *(const GAS v4u*)(proj + (size_t)idx * EVEN_NP + EC_DK + h * 64 + ds8); }
#pragma unroll
            for (int j = 0; j < 8; ++j) { const int i = i0 + j; const unsigned wd = (i & 1) ? (iw[i >> 3][(i >> 1) & 3] >> 16) : (iw[i >> 3][(i >> 1) & 3] & 0xffffu);
                float x[8]; unpack8(kw[j], x); float d = 0.f;
#pragma unroll
                for (int e = 0; e < 8; ++e) d += qv[e] * x[e];
                d += shx<1>(d); d += shx<2>(d); d += shx<4>(d);
                sc[i] = (wd == 0xffffu) ? -INFINITY : d; }
        }
        float mx = sc[0];
#pragma unroll
        for (int i = 1; i < 32; ++i) mx = fmaxf(mx, sc[i]);
        mx = fmaxf(mx, shx<8>(mx)); mx = fmaxf(mx, shx<16>(mx)); mx = sh32_max(mx);
        float l = 0.f;
#pragma unroll
        for (int i = 0; i < 32; ++i) { sc[i] = __builtin_amdgcn_exp2f(sc[i] - mx); l += sc[i]; }
        l += shx<8>(l); l += shx<16>(l); l = sh32_sum(l);
        float acc[8];
#pragma unroll
        for (int e = 0; e < 8; ++e) acc[e] = 0.f;
#pragma unroll
        for (int i0 = 0; i0 < 32; i0 += 8) {
            v4u vw[8];
#pragma unroll
            for (int j = 0; j < 8; ++j) { const int i = i0 + j; const unsigned wd = (i & 1) ? (iw[i >> 3][(i >> 1) & 3] >> 16) : (iw[i >> 3][(i >> 1) & 3] & 0xffffu);
                const unsigned idx = (wd == 0xffffu) ? 0u : wd;
                vw[j] = *(const GAS v4u*)(proj + (size_t)idx * EVEN_NP + EC_DV + h * 64 + ds8); }
#pragma unroll
            for (int j = 0; j < 8; ++j) { float x[8]; unpack8(vw[j], x);
#pragma unroll
                for (int e = 0; e < 8; ++e) acc[e] += sc[i0 + j] * x[e]; }
        }
        const float inv = 1.0f / l;
#pragma unroll
        for (int e = 0; e < 8; ++e) { float a = acc[e]; a += shx<8>(a); a += shx<16>(a); a = sh32_sum(a); acc[e] = a * inv; }
        if (kg == 0) *(GAS v4u*)(obase + (size_t)t * opitch + h * 64 + ds8) = pack8(acc);
    }
}

struct Args { InPtrs in; float* out; unsigned char* ws; int ph_lo, ph_hi, li, pad; };
constexpr int PH_PER_LAYER = 14, N_PHASES = 1 + 2 * PH_PER_LAYER - 1;

__global__ void __launch_bounds__(NTHREADS, 2) hyb_fwd(Args args) {
    extern __shared__ __attribute__((aligned(16))) unsigned char lds_raw[];
    LAS unsigned char* lds = (LAS unsigned char*)lds_raw;
    volatile LAS unsigned* MISC = (volatile LAS unsigned*)(lds + MISC_OFF);
    const int tid = threadIdx.x, lane = tid & 63, wave = __builtin_amdgcn_readfirstlane(tid >> 6);
    const int G = gridDim.x;
    const int vcu = (G % 8 == 0) ? ((int)blockIdx.x % 8) * (G / 8) + (int)blockIdx.x / 8 : (int)blockIdx.x;
    unsigned char* ws = args.ws;
    gu32* ctl = (gu32*)(ws + WS_CTL);
    for (int u = tid; u < (LDS_BYTES - LDSCTL_OFF) / 4; u += NTHREADS) ((LAS unsigned*)(lds + LDSCTL_OFF))[u] = 0u;
    __syncthreads();
    XcdBarrier bar = xcd_barrier_post((unsigned*)(ctl + CW_BAR) + args.li * XCD_BAR_WORDS, MISC + 8);
    const int tid0 = tid; unsigned char* const ws0 = ws;
    for (int ph = args.ph_lo; ph < args.ph_hi; ++ph) {
        int tid = tid0; asm volatile("" : "+v"(tid));
        unsigned char* ws = ws0; asm volatile("" : "+s"(ws));
        const int lane = tid & 63, wave = __builtin_amdgcn_readfirstlane(tid >> 6);
        LAS unsigned char* lds = (LAS unsigned char*)lds_raw; { unsigned lo_ = (unsigned)(uintptr_t)lds; asm volatile("" : "+s"(lo_)); lds = (LAS unsigned char*)(uintptr_t)lo_; }
        float* ssqA = (float*)(ws + WS_SSQ);
        bf16* HB = (bf16*)(ws + WS_HB);
        unsigned char* Wr = ws + WS_W;
        unsigned char* BIG = ws + WS_BIG;
        const int gw = vcu * NWAVES + wave, NGW = G * NWAVES;
        if (ph == 0) {
#ifdef PROBE_P02
            conv_weights(args.in, ws, 0, lds, gw, NGW, wave, lane);
            copy_x(args.in.p[0], args.out, HB, ssqA, gw, NGW, lane);
            rope_tables((float*)(ws + WS_ROPE), (float*)(ws + WS_ROPE) + S * 8, (int)blockIdx.x * NTHREADS + tid, G * NTHREADS);
            __syncthreads();
            for (int w = blockIdx.x; w < MEMT; w += G) mem_kv(args.in, ws, lds, w, tid, wave, lane);
            __syncthreads();
#endif
#ifndef NO_P0
            conv_weights(args.in, ws, 0, lds, gw, NGW, wave, lane);
            copy_x(args.in.p[0], args.out, HB, ssqA, gw, NGW, lane);
            rope_tables((float*)(ws + WS_ROPE), (float*)(ws + WS_ROPE) + S * 8, (int)blockIdx.x * NTHREADS + tid, G * NTHREADS);
            __syncthreads();
            for (int w = blockIdx.x; w < MEMT; w += G) mem_kv(args.in, ws, lds, w, tid, wave, lane);
#endif
        } else {
            const int L = (ph - 1) / PH_PER_LAYER, sub = (ph - 1) % PH_PER_LAYER;
            const bool even = (L & 1) == 0;
            float* ssq_in = ssqA;
            if (sub == 0 || sub == 11) {
                pg8::Gemm g{(const pg8::bf16_t*)HB, (const pg8::bf16_t*)(Wr + (sub == 0 ? W_FFN1_IN : W_FFN2_IN)), S, FF2, DM, DM};
                pg8::StaticOrder So; So.init(S, FF2, G, (int)blockIdx.x);
                pg8::EpiSwiGLU E{(pg8::bf16_t*)(BIG + B_U), ssq_in, FF};
#ifdef PROBE_GEMM2
                pg8::gemm_phase<pg8::EpiSwiGLU, pg8::StaticOrder, true, true>(lds, g, So, E, tid); __syncthreads();
#endif
                pg8::gemm_phase<pg8::EpiSwiGLU, pg8::StaticOrder, true, true>(lds, g, So, E, tid);
            } else if (sub == 1 || sub == 7 || sub == 10 || sub == 12) {
                pg8::Gemm g; float scale; int so;
                if (sub == 1)       { g = pg8::Gemm{(const pg8::bf16_t*)(BIG + B_U), (const pg8::bf16_t*)(Wr + W_FFN1_OUT), S, DM, FF, FF}; scale = 0.5f; so = 1; }
                else if (sub == 7)  { g = pg8::Gemm{(const pg8::bf16_t*)(BIG + B_PROJ), (const pg8::bf16_t*)(Wr + W_MIX_OUT), S, DM, DM, even ? EVEN_NP : DM}; scale = 1.0f; so = 2; }
                else if (sub == 10)  { g = pg8::Gemm{(const pg8::bf16_t*)(BIG + B_OM), (const pg8::bf16_t*)(Wr + W_MEMO), S, DM, MEMW, MEMW}; scale = 1.0f; so = 3; }
                else                { g = pg8::Gemm{(const pg8::bf16_t*)(BIG + B_U), (const pg8::bf16_t*)(Wr + W_FFN2_OUT), S, DM, FF, FF}; scale = 0.5f; so = 4; }
                const bool last = (sub == 12 && L == NLAYER - 1);
                pg8::StaticOrder So; So.init(S, DM, G, (int)blockIdx.x);
                pg8::EpiResid E{args.out, last ? nullptr : (pg8::bf16_t*)HB, last ? nullptr : ssqA, scale};
                pg8::gemm_phase<pg8::EpiResid, pg8::StaticOrder, true, true>(lds, g, So, E, tid);
#ifdef PROBE_GEMM2
                { __syncthreads(); pg8::EpiResid E0 = E; E0.scale = 0.f; pg8::gemm_phase<pg8::EpiResid, pg8::StaticOrder, true, true>(lds, g, So, E0, tid); }
#endif
            } else if (sub == 2 || sub == 8) {
                pg8::Gemm g; pg8::EpiScale E;
                if (sub == 2) { const int N = even ? EVEN_NP : ODD_N;
                    g = pg8::Gemm{(const pg8::bf16_t*)HB, (const pg8::bf16_t*)(Wr + W_MIX_IN), S, N, DM, DM};
                    E = pg8::EpiScale{(pg8::bf16_t*)(BIG + B_PROJ), even ? EVEN_NP : DM, ssq_in, even ? 0 : DM, (size_t)S * DM}; }
                else { g = pg8::Gemm{(const pg8::bf16_t*)HB, (const pg8::bf16_t*)(Wr + W_MEMQ), S, MEMW, DM, DM};
                    E = pg8::EpiScale{(pg8::bf16_t*)(BIG + B_QM), MEMW, ssq_in, 0, 0}; }
                pg8::StaticOrder So; So.init(S, g.N, G, (int)blockIdx.x);
#ifdef PROBE_GEMM2
                pg8::gemm_phase<pg8::EpiScale, pg8::StaticOrder, true, true>(lds, g, So, E, tid); __syncthreads();
#endif
                pg8::gemm_phase<pg8::EpiScale, pg8::StaticOrder, true, true>(lds, g, So, E, tid);
            } else if (sub == 3) {
                #ifndef NO_POSTE
                if (even) post_even(args.in, ws, args.out, ssq_in, lds, G, tid, wave, lane);
#endif
#ifndef NO_POSTO
                if (!even) post_odd(args.in, ws, lds, G, tid, wave, lane);
#endif
            } else if (sub == 4) {
                if (even) {
                    int nrep = 1;
#ifdef PROBE_DSA2
                    nrep = 2;
#endif
                    asm volatile("" : "+s"(nrep));
                    for (int rep = 0; rep < nrep; ++rep) { dsa_select_phase(ws, lds, G, tid, wave, lane); __syncthreads(); }
                } else {
                    moba_gate_phase(ws, G, wave, lane);
                }
            } else if (sub == 5) {
                if (even) {
                    bf16* projb = (bf16*)(BIG + B_PROJ);
#ifdef PROBE_FOX2
                    fox_phase(ws, lds, G, tid, wave, lane, HB, 512); __syncthreads();
#endif
#ifdef PROBE_SPARSE2
                    dsa_sparse_phase(ws, G, wave, lane, HB, 512);
#endif
                    fox_phase(ws, lds, G, tid, wave, lane, projb + EC_FQ, EVEN_NP);
                    dsa_sparse_phase(ws, G, wave, lane, projb + EC_DQ, EVEN_NP);
                } else {
#ifdef PROBE_MOBA2
                    moba_route_phase(ws, lds, G, tid, wave, lane); __syncthreads();
#endif
                    moba_route_phase(ws, lds, G, tid, wave, lane);
                }
            } else if (sub == 6) {
                if (!even) moba_own_phase(ws, lds, G, tid, wave, lane);
            } else if (sub == 9) {
#ifdef PROBE_MEM2
                memattn_phase(args.in, ws, L, lds, G, tid, wave, lane); __syncthreads();
#endif
                memattn_phase(args.in, ws, L, lds, G, tid, wave, lane);
            } else if (sub == 13) {
#ifdef PROBE_P02
                conv_weights(args.in, ws, L + 1, lds, gw, NGW, wave, lane); __syncthreads();
#endif
                conv_weights(args.in, ws, L + 1, lds, gw, NGW, wave, lane);
            }
        }
        if (ph + 1 < args.ph_hi) xcd_barrier(bar);
#ifdef PROBE_BAR2
        if (ph + 1 < args.ph_hi) xcd_barrier(bar);
#endif
    }
}

#ifndef MK_N_LAUNCHES
#define MK_N_LAUNCHES 1
#endif
extern "C" void kernel_launch(void* const* d_in, const int* in_sizes, int n_in, void* d_out, int out_size, void* d_ws, size_t ws_size, hipStream_t stream) {
    static int grid = 0;
    if (grid == 0) {
        if (n_in != 26 || in_sizes[0] != S * DM || out_size != S * DM || ws_size < WS_END) {
            fprintf(stderr, "kernel_launch: unexpected problem (n_in %d, in0 %d, out %d, ws %zu); nothing launched\n", n_in, n_in > 0 ? in_sizes[0] : -1, out_size, ws_size); grid = -1; return; }
        int dev = 0, cus = 0, per_cu = 0;
        if (hipGetDevice(&dev) != hipSuccess || hipDeviceGetAttribute(&cus, hipDeviceAttributeMultiprocessorCount, dev) != hipSuccess) { grid = -1; return; }
        if (hipFuncSetAttribute((const void*)hyb_fwd, hipFuncAttributeMaxDynamicSharedMemorySize, LDS_BYTES) != hipSuccess) { fprintf(stderr, "kernel_launch: hipFuncSetAttribute failed\n"); grid = -1; return; }
        if (hipOccupancyMaxActiveBlocksPerMultiprocessor(&per_cu, (const void*)hyb_fwd, NTHREADS, LDS_BYTES) != hipSuccess || per_cu < 1)
            fprintf(stderr, "kernel_launch: note: occupancy query reports %d workgroups per CU\n", per_cu);
        (void)hipGetLastError();
        grid = cus;
    }
    if (grid < 0) return;
    if (hipMemsetAsync((char*)d_ws + WS_CTL, 0, CTL_ZERO_BYTES, stream) != hipSuccess) { fprintf(stderr, "kernel_launch: hipMemsetAsync failed\n"); return; }
    Args a{};
    for (int i = 0; i < 26; ++i) a.in.p[i] = (const float*)d_in[i];
    a.out = (float*)d_out; a.ws = (unsigned char*)d_ws;
#if MK_N_LAUNCHES == 1
    a.ph_lo = 0; a.ph_hi = N_PHASES; a.li = 0;
    hipLaunchKernelGGL(hyb_fwd, dim3(grid), dim3(NTHREADS), LDS_BYTES, stream, a);
#else
    for (int ph = 0; ph < N_PHASES; ++ph) { a.ph_lo = ph; a.ph_hi = ph + 1; a.li = 0; hipLaunchKernelGGL(hyb_fwd, dim3(grid), dim3(NTHREADS), LDS_BYTES, stream, a); }
#endif
    const hipError_t le = hipPeekAtLastError();
    if (le != hipSuccess) fprintf(stderr, "kernel_launch: launch failed: %s\n", hipGetErrorName(le));
}
```

```cpp
#include <hip/hip_runtime.h>
#include <cstdio>
#include <cstdint>

template <int M> __device__ __forceinline__ int shx_i(int v) {
    if constexpr (M == 1) return __builtin_amdgcn_mov_dpp(v, 0xB1, 0xF, 0xF, true);
    else if constexpr (M == 2) return __builtin_amdgcn_mov_dpp(v, 0x4E, 0xF, 0xF, true);
    else return __builtin_amdgcn_ds_swizzle(v, (M << 10) | 0x1f);
}
template <int M> __device__ __forceinline__ float shx(float v) { return __int_as_float(shx_i<M>(__float_as_int(v))); }
__device__ __forceinline__ float sh32_sum(float v) { auto r = __builtin_amdgcn_permlane32_swap(__float_as_uint(v), __float_as_uint(v), false, false); return __uint_as_float(r[0]) + __uint_as_float(r[1]); }
__device__ __forceinline__ float sh32_max(float v) { auto r = __builtin_amdgcn_permlane32_swap(__float_as_uint(v), __float_as_uint(v), false, false); return fmaxf(__uint_as_float(r[0]), __uint_as_float(r[1])); }
__device__ __forceinline__ int sum32_i(int c) { c += shx_i<1>(c); c += shx_i<2>(c); c += shx_i<4>(c); c += shx_i<8>(c); c += shx_i<16>(c); return c; }
namespace pg8 {
#define PG8_LAS __attribute__((address_space(3)))
typedef unsigned short bf16_t;
typedef short bf16x8 __attribute__((ext_vector_type(8)));
typedef float f32x4 __attribute__((ext_vector_type(4)));
typedef unsigned u32x4 __attribute__((ext_vector_type(4)));
constexpr int BM = 256, BK = 64, HALF = 128, HTB = HALF * BK * 2  , STAGE_BYTES = 8 * HTB, NXCD = 8, WGM = 8;

__host__ __device__ __forceinline__ int lds_byte(int r, int c) { const int st = (r >> 4) * 2 + (c >> 5), rr = r & 15, cc = c & 31, ob = rr * 64 + cc * 2; return st * 1024 + (ob ^ (((ob >> 9) & 1) << 5)); }
__host__ __device__ __forceinline__ void stage_rc(int b, int& R, int& C) { const int st = b / 1024, sb = b % 1024, swz = sb ^ (((sb >> 9) & 1) << 5); R = (st >> 1) * 16 + swz / 64; C = (st & 1) * 32 + (swz % 64) / 2; }
__host__ __device__ __forceinline__ int perm32(int rho) { const int n = rho >> 4, i = rho & 15; return 8 * (i >> 2) + 4 * n + (i & 3); }

struct Unit { int pm, pn; };
struct Gemm { const bf16_t* A; const bf16_t* Bt; int M, N, K, lda; };

struct StaticOrder {
    int nM, nN, nwg, G, c;
    __host__ __device__ void init(int M, int N, int G_, int c_) { nM = M / BM; nN = N / BM; nwg = nM * nN; G = G_; c = c_; }
    __host__ __device__ bool next(int i, Unit& u) const {
        const long L = (long)i * G + c; if (L >= nwg) return false;
        int wgid = (int)L; { const int q = nwg / NXCD, r = nwg % NXCD, xcd = wgid % NXCD, off = wgid / NXCD; wgid = (xcd < r ? xcd * (q + 1) : r * (q + 1) + (xcd - r) * q) + off; }
        const int nig = WGM * nN, gid = wgid / nig, fm = gid * WGM, gsz = (nM - fm) < WGM ? (nM - fm) : WGM;
        u.pm = fm + ((wgid % nig) % gsz); u.pn = (wgid % nig) / gsz; return true;
    }
    __device__ __forceinline__ void a_ready(const Unit&) const {}
    __device__ __forceinline__ void done(const Unit&) const {}
};

__device__ __forceinline__ unsigned cvt_pk_bf16(float lo, float hi) { unsigned r; asm volatile("v_cvt_pk_bf16_f32 %0, %1, %2" : "=v"(r) : "v"(lo), "v"(hi)); return r; }
typedef float f32x2 __attribute__((ext_vector_type(2)));
constexpr float RMS_EPS_F = 1e-6f;
__device__ __forceinline__ float silu_f(float x) { return x * __builtin_amdgcn_rcpf(1.0f + __builtin_amdgcn_exp2f(-1.4426950408889634f * x)); }
__device__ __forceinline__ float row_rstd(const float* ssq, int row) {
    const f32x4* p = (const f32x4*)(ssq + (size_t)row * 16); const f32x4 a = p[0], b = p[1], c = p[2], d = p[3];
    const float s = ((a[0] + a[1]) + (a[2] + a[3])) + ((b[0] + b[1]) + (b[2] + b[3])) + ((c[0] + c[1]) + (c[2] + c[3])) + ((d[0] + d[1]) + (d[2] + d[3]));
    return rsqrtf(s * (1.0f / 1024.0f) + RMS_EPS_F); }

struct EpiSwiGLU {
    static constexpr bool PERM = true, AFTER_DRAIN = false;
    bf16_t* U; const float* ssq; int ldu;
    __device__ __forceinline__ void operator()(const f32x4 (&acc)[2][2][4][2], const Unit& u, int wr, int wc, int fr, int fq) const {
        const int row0 = u.pm * BM + wr * 64 + fr, col0 = u.pn * HALF + wc * 32 + 8 * fq;
#pragma unroll
        for (int ai = 0; ai < 2; ++ai)
#pragma unroll
            for (int m = 0; m < 4; ++m) {
                const int row = row0 + ai * HALF + m * 16; const float r = row_rstd(ssq, row);
                const f32x4 a0 = acc[ai][0][m][0] * r, a1 = acc[ai][0][m][1] * r, b0 = acc[ai][1][m][0] * r, b1 = acc[ai][1][m][1] * r;
                u32x4 w;
                w.x = cvt_pk_bf16(silu_f(a0[0]) * b0[0], silu_f(a0[1]) * b0[1]); w.y = cvt_pk_bf16(silu_f(a0[2]) * b0[2], silu_f(a0[3]) * b0[3]);
                w.z = cvt_pk_bf16(silu_f(a1[0]) * b1[0], silu_f(a1[1]) * b1[1]); w.w = cvt_pk_bf16(silu_f(a1[2]) * b1[2], silu_f(a1[3]) * b1[3]);
                *(u32x4*)(U + (size_t)row * ldu + col0) = w;
            }
    }
};
struct EpiResid {
    static constexpr bool PERM = true, AFTER_DRAIN = false;
    float* H; bf16_t* HB; float* ssq_out; float scale;
    __device__ __forceinline__ void operator()(const f32x4 (&acc)[2][2][4][2], const Unit& u, int wr, int wc, int fr, int fq) const {
        const int row0 = u.pm * BM + wr * 64 + fr, col0 = u.pn * BM + wc * 32 + 8 * fq;
#pragma unroll
        for (int ai = 0; ai < 2; ++ai)
#pragma unroll
            for (int m = 0; m < 4; ++m) {
                const int row = row0 + ai * HALF + m * 16; float sq = 0.f;
#pragma unroll
                for (int bj = 0; bj < 2; ++bj) {
                    float* hp = H + (size_t)row * 1024 + col0 + bj * HALF;
                    f32x4 h0 = *(const f32x4*)hp, h1 = *(const f32x4*)(hp + 4);
                    h0 = h0 + acc[ai][bj][m][0] * scale; h1 = h1 + acc[ai][bj][m][1] * scale;
                    *(f32x4*)hp = h0; *(f32x4*)(hp + 4) = h1;
                    sq += (h0[0] * h0[0] + h0[1] * h0[1]) + (h0[2] * h0[2] + h0[3] * h0[3]) + (h1[0] * h1[0] + h1[1] * h1[1]) + (h1[2] * h1[2] + h1[3] * h1[3]);
                    if (HB) { u32x4 w; w.x = cvt_pk_bf16(h0[0], h0[1]); w.y = cvt_pk_bf16(h0[2], h0[3]); w.z = cvt_pk_bf16(h1[0], h1[1]); w.w = cvt_pk_bf16(h1[2], h1[3]);
                        *(u32x4*)(HB + (size_t)row * 1024 + col0 + bj * HALF) = w; }
                }
                if (ssq_out) { sq += shx<16>(sq); sq = sh32_sum(sq); if (fq == 0) ssq_out[(size_t)row * 16 + u.pn * 4 + wc] = sq; }
            }
    }
};
struct EpiScale {
    static constexpr bool PERM = true, AFTER_DRAIN = false;
    bf16_t* O; int ldc; const float* ssq; int split_cols; size_t split_stride;
    __device__ __forceinline__ void operator()(const f32x4 (&acc)[2][2][4][2], const Unit& u, int wr, int wc, int fr, int fq) const {
        const int row0 = u.pm * BM + wr * 64 + fr; int colt = u.pn * BM; bf16_t* base = O;
        if (split_cols) { const int t = colt / split_cols; base += (size_t)t * split_stride; colt -= t * split_cols; }
        const int col0 = colt + wc * 32 + 8 * fq;
#pragma unroll
        for (int ai = 0; ai < 2; ++ai)
#pragma unroll
            for (int m = 0; m < 4; ++m) {
                const int row = row0 + ai * HALF + m * 16; const float r = row_rstd(ssq, row);
                bf16_t* rowp = base + (size_t)row * ldc + col0;
#pragma unroll
                for (int bj = 0; bj < 2; ++bj) { const f32x4 v0 = acc[ai][bj][m][0] * r, v1 = acc[ai][bj][m][1] * r;
                    u32x4 w; w.x = cvt_pk_bf16(v0[0], v0[1]); w.y = cvt_pk_bf16(v0[2], v0[3]); w.z = cvt_pk_bf16(v1[0], v1[1]); w.w = cvt_pk_bf16(v1[2], v1[3]);
                    *(u32x4*)(rowp + bj * HALF) = w; }
            }
    }
};
template <class Epi, class Sched, bool ALIGN_EPI = false, bool SP2 = false>
__device__ __forceinline__ void gemm_phase(PG8_LAS unsigned char* lds, const Gemm g, const Sched& S, const Epi& E, const int tid) {
    const int wid = __builtin_amdgcn_readfirstlane(tid >> 6), lane = tid & 63, wr = wid >> 2, wc = wid & 3, fr = lane & 15, fq = lane >> 4;
    const int K = g.K, nt = K / BK;
    unsigned voffA[2], voffB[2];
#pragma unroll
    for (int i = 0; i < 2; ++i) { int R, C; stage_rc(tid * 16 + i * 8192, R, C); const int Rb = Epi::PERM ? ((R & ~31) + perm32(R & 31)) : R;
        voffA[i] = (unsigned)(R * g.lda + C) * 2u; voffB[i] = (unsigned)(Rb * K + C) * 2u; }
    const size_t kstep = (size_t)(BK * 2);
    const size_t hstepA = (size_t)HALF * g.lda * 2, hstepB = (size_t)HALF * K * 2;
    const size_t tstepA = 2 * hstepA, tstepB = 2 * hstepB;
    const unsigned ldsw = (unsigned)wid * 1024u;
    const int aoff = lds_byte(wr * 64 + fr, fq * 8), boff = lds_byte(wc * 32 + fr, fq * 8);
#define PG8_SA(b, h) (((b) * 2 + (h)) * HTB)
#define PG8_SB(b, h) ((4 + (b) * 2 + (h)) * HTB)
#define PG8_STAGE(bufoff, gbase, voff) do { _Pragma("unroll") for (int _i = 0; _i < 2; ++_i) \
        __builtin_amdgcn_global_load_lds((const unsigned*)((const char*)(gbase) + (voff)[_i]), (PG8_LAS unsigned*)(lds + (bufoff) + ldsw + _i * 8192), 16, 0, 0); } while (0)
#define PG8_LDA(dst, b, h) do { _Pragma("unroll") for (int m = 0; m < 4; ++m) _Pragma("unroll") for (int k = 0; k < 2; ++k) dst[m][k] = *(const PG8_LAS bf16x8*)(lds + PG8_SA(b, h) + aoff + m * 2048 + k * 1024); } while (0)
#define PG8_LDB(dst, b, h) do { _Pragma("unroll") for (int n = 0; n < 2; ++n) _Pragma("unroll") for (int k = 0; k < 2; ++k) dst[n][k] = *(const PG8_LAS bf16x8*)(lds + PG8_SB(b, h) + boff + n * 2048 + k * 1024); } while (0)
#define PG8_MMA(ai, bj, At, Bt) do { __builtin_amdgcn_s_setprio(1); _Pragma("unroll") for (int m = 0; m < 4; ++m) _Pragma("unroll") for (int n = 0; n < 2; ++n) _Pragma("unroll") for (int k = 0; k < 2; ++k) \
        acc[ai][bj][m][n] = __builtin_amdgcn_mfma_f32_16x16x32_bf16(Bt[n][k], At[m][k], acc[ai][bj][m][n], 0, 0, 0); __builtin_amdgcn_s_setprio(0); } while (0)
#define PG8_WAIT_V(n) asm volatile("s_waitcnt vmcnt(" #n ")" ::: "memory")
#define PG8_WAIT_L(n) asm volatile("s_waitcnt lgkmcnt(" #n ")" ::: "memory")
#define PG8_BAR __builtin_amdgcn_s_barrier()
#define PG8_SCHED __builtin_amdgcn_sched_barrier(0)
    Unit cur, nxt; int ui = 0;
    if (!S.next(0, cur)) return;
    f32x4 acc[2][2][4][2];
#pragma unroll
    for (int a = 0; a < 2; ++a)
#pragma unroll
        for (int b = 0; b < 2; ++b)
#pragma unroll
            for (int m = 0; m < 4; ++m)
#pragma unroll
                for (int n = 0; n < 2; ++n) acc[a][b][m][n] = (f32x4){0.f, 0.f, 0.f, 0.f};
    bf16x8 At[4][2], B0[2][2], B1[2][2];
    const char* cA = (const char*)g.A + (size_t)cur.pm * tstepA; const char* cB = (const char*)g.Bt + (size_t)cur.pn * tstepB;
    S.a_ready(cur);
    if constexpr (SP2) {
        PG8_STAGE(PG8_SB(0, 0), cB, voffB); PG8_STAGE(PG8_SB(0, 1), cB + hstepB, voffB); PG8_STAGE(PG8_SA(0, 0), cA, voffA); PG8_STAGE(PG8_SA(0, 1), cA + hstepA, voffA);
        if (wr == 1) PG8_BAR;
        PG8_WAIT_V(2); PG8_BAR;
        PG8_STAGE(PG8_SB(1, 0), cB + kstep, voffB); PG8_STAGE(PG8_SA(1, 0), cA + kstep, voffA); PG8_STAGE(PG8_SB(1, 1), cB + hstepB + kstep, voffB);
        PG8_WAIT_V(6); PG8_BAR;
    } else {
        PG8_STAGE(PG8_SB(0, 0), cB, voffB); PG8_STAGE(PG8_SA(0, 0), cA, voffA); PG8_STAGE(PG8_SB(0, 1), cB + hstepB, voffB); PG8_STAGE(PG8_SA(0, 1), cA + hstepA, voffA);
        if (wr == 1) PG8_BAR;
        PG8_WAIT_V(4); PG8_BAR;
        PG8_STAGE(PG8_SB(1, 0), cB + kstep, voffB); PG8_STAGE(PG8_SA(1, 0), cA + kstep, voffA); PG8_STAGE(PG8_SB(1, 1), cB + hstepB + kstep, voffB);
        PG8_WAIT_V(6); PG8_BAR;
    }
    for (;;) {
        const bool has_next = S.next(ui + 1, nxt);
        const char* nA = has_next ? (const char*)g.A + (size_t)nxt.pm * tstepA : cA; const char* nB = has_next ? (const char*)g.Bt + (size_t)nxt.pn * tstepB : cB;
        for (int t = 0; t < nt; t += 2) {
            const bool last = (t == nt - 2);
            const char* a1 = cA + (size_t)(t + 1) * kstep;
            const char* a2 = last ? nA : cA + (size_t)(t + 2) * kstep; const char* b2 = last ? nB : cB + (size_t)(t + 2) * kstep;
            const char* a3 = a2 + kstep; const char* b3 = b2 + kstep;
            if (last && has_next) S.a_ready(nxt);
            if constexpr (SP2) {
            PG8_LDB(B0, 0, 0); PG8_LDB(B1, 0, 1); PG8_SCHED; PG8_LDA(At, 0, 0); PG8_STAGE(PG8_SA(1, 1), a1 + hstepA, voffA);
            PG8_WAIT_V(8); PG8_WAIT_L(0); PG8_BAR; PG8_MMA(0, 0, At, B0); PG8_MMA(0, 1, At, B1); PG8_BAR; PG8_SCHED;
            PG8_LDA(At, 0, 1); PG8_STAGE(PG8_SB(0, 0), b2, voffB); PG8_STAGE(PG8_SB(0, 1), b2 + hstepB, voffB); PG8_STAGE(PG8_SA(0, 0), a2, voffA);
            PG8_WAIT_V(8); PG8_WAIT_L(0); PG8_BAR; PG8_MMA(1, 0, At, B0); PG8_MMA(1, 1, At, B1); PG8_BAR; PG8_SCHED;
            PG8_LDB(B0, 1, 0); PG8_LDB(B1, 1, 1); PG8_SCHED; PG8_LDA(At, 1, 0); PG8_STAGE(PG8_SA(0, 1), a2 + hstepA, voffA);
            PG8_WAIT_V(8); PG8_WAIT_L(0); PG8_BAR; PG8_MMA(0, 0, At, B0); PG8_MMA(0, 1, At, B1); PG8_BAR; PG8_SCHED;
            PG8_LDA(At, 1, 1); PG8_STAGE(PG8_SB(1, 0), b3, voffB); PG8_STAGE(PG8_SB(1, 1), b3 + hstepB, voffB); PG8_STAGE(PG8_SA(1, 0), a3, voffA);
            PG8_WAIT_V(8); PG8_WAIT_L(0); PG8_BAR; PG8_MMA(1, 0, At, B0); PG8_MMA(1, 1, At, B1); PG8_BAR; PG8_SCHED;
            } else {
            PG8_LDB(B0, 0, 0); PG8_SCHED; PG8_LDA(At, 0, 0); PG8_STAGE(PG8_SA(1, 1), a1 + hstepA, voffA);
            PG8_WAIT_L(8); PG8_BAR; PG8_WAIT_L(0); PG8_MMA(0, 0, At, B0); PG8_BAR; PG8_SCHED;
            PG8_LDB(B1, 0, 1); PG8_STAGE(PG8_SB(0, 0), b2, voffB);
            PG8_BAR; PG8_WAIT_L(0); PG8_MMA(0, 1, At, B1); PG8_BAR;
            PG8_LDA(At, 0, 1); PG8_STAGE(PG8_SA(0, 0), a2, voffA);
            PG8_BAR; PG8_WAIT_L(0); PG8_MMA(1, 0, At, B0); PG8_BAR; PG8_SCHED;
            PG8_STAGE(PG8_SB(0, 1), b2 + hstepB, voffB);
            PG8_WAIT_V(6); PG8_BAR; PG8_MMA(1, 1, At, B1); PG8_BAR;
            PG8_LDB(B0, 1, 0); PG8_SCHED; PG8_LDA(At, 1, 0); PG8_STAGE(PG8_SA(0, 1), a2 + hstepA, voffA);
            PG8_WAIT_L(8); PG8_BAR; PG8_WAIT_L(0); PG8_MMA(0, 0, At, B0); PG8_BAR; PG8_SCHED;
            PG8_LDB(B1, 1, 1); PG8_STAGE(PG8_SB(1, 0), b3, voffB);
            PG8_BAR; PG8_WAIT_L(0); PG8_MMA(0, 1, At, B1); PG8_BAR;
            PG8_LDA(At, 1, 1); PG8_STAGE(PG8_SA(1, 0), a3, voffA);
            PG8_BAR; PG8_WAIT_L(0); PG8_MMA(1, 0, At, B0); PG8_BAR; PG8_SCHED;
            PG8_STAGE(PG8_SB(1, 1), b3 + hstepB, voffB);
            PG8_WAIT_V(6); PG8_BAR; PG8_MMA(1, 1, At, B1); PG8_BAR;
            }
        }
        if constexpr (ALIGN_EPI) { if (wr == 0) PG8_BAR; }
        if constexpr (!Epi::AFTER_DRAIN) { E(acc, cur, wr, wc, fr, fq); S.done(cur); }
        if (!has_next) break;
#pragma unroll
        for (int a = 0; a < 2; ++a)
#pragma unroll
            for (int b = 0; b < 2; ++b)
#pragma unroll
                for (int m = 0; m < 4; ++m)
#pragma unroll
                    for (int n = 0; n < 2; ++n) acc[a][b][m][n] = (f32x4){0.f, 0.f, 0.f, 0.f};
        cur = nxt; cA = nA; cB = nB; ++ui;
        if constexpr (ALIGN_EPI) { if (wr == 1) PG8_BAR; }
    }
    PG8_WAIT_V(0);
    if constexpr (!ALIGN_EPI) { if (wr == 0) PG8_BAR; }
    PG8_BAR;
    if constexpr (Epi::AFTER_DRAIN) { E.fused(acc, cur, wr, wc, fr, fq, lds, wid, lane); S.done(cur); }
#undef PG8_SA
#undef PG8_SB
#undef PG8_STAGE
#undef PG8_LDA
#undef PG8_LDB
#undef PG8_MMA
#undef PG8_WAIT_V
#undef PG8_WAIT_L
#undef PG8_BAR
#undef PG8_SCHED
}
}

constexpr int S = 16384, DM = 1024, FF = 2816, FF2 = 5632, EVEN_SRC = 3664, EVEN_NP = 3840, ODD_N = 3072, NLAYER = 2, MEMT = 256, MEMW = 256;
constexpr float RMS_EPS = 1e-6f;
constexpr float LOG2E = 1.4426950408889634f;
constexpr float C2 = 0.125f * LOG2E;
constexpr int NWAVES = 8, NTHREADS = 512;
constexpr int EC_FQ = 0, EC_DQ = 512, EC_FK = 1024, EC_DK = 1536, EC_FV = 2048, EC_DV = 2560, EC_IQ = 3072, EC_IK = 3584;
constexpr int ES_FQ = 0, ES_FK = 512, ES_FV = 1024, ES_FL = 1536, ES_DQ = 1544, ES_DK = 2056, ES_DV = 2568, ES_IQ = 3080, ES_IK = 3592, ES_IW = 3656;

constexpr size_t MiB = 1u << 20;
constexpr size_t WS_CTL = 0, CTL_ZERO_BYTES = 1 * MiB;
constexpr size_t WS_SSQ = 1 * MiB;
constexpr size_t WS_KSUM = 6 * MiB;
constexpr size_t WS_ROPE = 2 * MiB;
constexpr size_t WS_FL = 3 * MiB;
constexpr size_t WS_MEMK = 4 * MiB;
constexpr size_t WS_IW = 5 * MiB;
constexpr size_t WS_W = 12 * MiB;
constexpr size_t WS_BIG = 60 * MiB;
constexpr size_t WS_HB = 224 * MiB;
constexpr size_t WS_END = 256 * MiB;
constexpr size_t W_FFN1_IN = 0, W_FFN1_OUT = 11 * MiB, W_MIX_IN = 17 * MiB, W_MIX_OUT = 25 * MiB, W_MEMQ = 27 * MiB, W_MEMO = 28 * MiB, W_FFN2_IN = 29 * MiB, W_FFN2_OUT = 40 * MiB;
constexpr size_t B_U = 0;
constexpr size_t B_PROJ = 0;
constexpr size_t B_VTF = 120 * MiB;
constexpr size_t B_IKC = 136 * MiB;
constexpr size_t B_VTM = 96 * MiB;
constexpr size_t B_SEL = 156 * MiB;
constexpr size_t B_QM = 140 * MiB, B_OM = 148 * MiB;
constexpr int CW_TMO = 0, CW_CODE = 1, CW_BAR = 4096;

constexpr int RING_BYTES = 147456;
constexpr int LDSCTL_OFF = RING_BYTES, MISC_OFF = LDSCTL_OFF + 320;
constexpr int LDS_BYTES = 163840;

#define GAS __attribute__((address_space(1)))
#define LAS __attribute__((address_space(3)))
typedef unsigned short bf16;
typedef unsigned v4u __attribute__((ext_vector_type(4)));
typedef float f32x4 __attribute__((ext_vector_type(4)));
typedef short bf16x8 __attribute__((ext_vector_type(8)));
typedef GAS unsigned gu32;
typedef GAS unsigned long long gu64;
#define RLX_AGENT __ATOMIC_RELAXED, __HIP_MEMORY_SCOPE_AGENT
#define LDS_WAIT() asm volatile("s_waitcnt lgkmcnt(0)" ::: "memory")
#define VM_WAIT() asm volatile("s_waitcnt vmcnt(0)" ::: "memory")
__device__ __forceinline__ unsigned long long rt() { return __builtin_amdgcn_s_memrealtime(); }
__device__ __forceinline__ unsigned f2bf(float f) { unsigned u = __builtin_bit_cast(unsigned, f); return (u + 0x7fffu + ((u >> 16) & 1u)) >> 16; }
__device__ __forceinline__ unsigned pk2(float lo, float hi) { return f2bf(lo) | (f2bf(hi) << 16); }

#define XB_TMO      128
#define XB_XCNT(j)  (256  + 64 * (j))
#define XB_XSUB(j)  (1280 + 64 * (j))
#define XB_XGEN(j)  (2304 + 64 * (j))
#define XB_TOP      3328
#define XB_TOPGEN   3392
#define XCD_BAR_WORDS 3456
#define XB_SPIN_CAP (1u << 18)

__device__ __forceinline__ unsigned xb_ld(unsigned* p)              { return __hip_atomic_load(p, __ATOMIC_RELAXED, __HIP_MEMORY_SCOPE_AGENT); }
__device__ __forceinline__ unsigned xb_add(unsigned* p, unsigned v) { return __hip_atomic_fetch_add(p, v, __ATOMIC_RELAXED, __HIP_MEMORY_SCOPE_AGENT); }
__device__ __forceinline__ unsigned xb_xcc_id() { return (unsigned)__builtin_amdgcn_s_getreg((3 << 11) | 20) & 0xFu; }
#define XB_SPIN(cond, bar) do { unsigned _sp = 0; while (cond) { __builtin_amdgcn_s_sleep(1); \
    if ((++_sp & 255u) == 0u) { if (xb_ld(&(bar)[XB_TMO])) break; if (_sp > XB_SPIN_CAP) { atomicAdd(&(bar)[XB_TMO], 1u); break; } } } } while (0)

struct XcdBarrier {
    unsigned* bar; unsigned x;
    volatile LAS unsigned* st;
};

__device__ __forceinline__ XcdBarrier xcd_barrier_post(unsigned* bar, volatile LAS unsigned* st) {
    XcdBarrier b; b.bar = bar; b.x = xb_xcc_id(); b.st = st;
    if (threadIdx.x == 0) (void)xb_add(&bar[XB_XCNT(b.x)], 1u);
    return b;
}
__device__ __forceinline__ void xcd_barrier_complete(unsigned* bar, unsigned x, unsigned& nloc, unsigned& nx) {
    const unsigned G = gridDim.x * gridDim.y * gridDim.z;
    unsigned sum, cnt, mine, sp = 0u;
    for (;;) {
        sum = 0u; cnt = 0u; mine = 0u;
#pragma unroll
        for (unsigned j = 0; j < 16; ++j) { const unsigned c = xb_ld(&bar[XB_XCNT(j)]); sum += c; cnt += (c > 0u) ? 1u : 0u; mine = (j == x) ? c : mine; }
        if (sum == G) break;
        __builtin_amdgcn_s_sleep(1);
        if ((++sp & 255u) == 0u) { if (xb_ld(&bar[XB_TMO])) break; if (sp > XB_SPIN_CAP) { atomicAdd(&bar[XB_TMO], 1u); break; } }
    }
    nloc = mine > 0u ? mine : 1u; nx = cnt > 0u ? cnt : 1u;
}

__device__ __forceinline__ void xcd_barrier(const XcdBarrier& b) {
    asm volatile("s_waitcnt vmcnt(0)" ::: "memory");
    __syncthreads();
    if (threadIdx.x == 0) {
        unsigned* bar = b.bar;
        __builtin_amdgcn_s_waitcnt(0);
        unsigned nloc = b.st[0], nx = b.st[1];
        if (nloc == 0u) { xcd_barrier_complete(bar, b.x, nloc, nx); b.st[0] = nloc; b.st[1] = nx; }
        const unsigned old = xb_add(&bar[XB_XSUB(b.x)], 1u);
        const unsigned gen = old / nloc;
        if (old + 1u == (gen + 1u) * nloc) {
            __builtin_amdgcn_fence(__ATOMIC_RELEASE, "agent");
            asm volatile("s_waitcnt vmcnt(0)" ::: "memory");
            const unsigned og = xb_add(&bar[XB_TOP], 1u);
            const unsigned tg = og / nx;
            if (og + 1u == (tg + 1u) * nx) xb_add(&bar[XB_TOPGEN], 1u);
            else XB_SPIN(xb_ld(&bar[XB_TOPGEN]) == tg, bar);
            __builtin_amdgcn_fence(__ATOMIC_ACQUIRE, "agent");
            xb_add(&bar[XB_XGEN(b.x)], 1u);
            asm volatile("s_waitcnt vmcnt(0)" ::: "memory");
        } else {
            XB_SPIN(xb_ld(&bar[XB_XGEN(b.x)]) == gen, bar);
            __builtin_amdgcn_fence(__ATOMIC_ACQUIRE, "agent");
            asm volatile("s_waitcnt vmcnt(0)" ::: "memory");
        }
    }
    __syncthreads();
}

typedef float f32x16 __attribute__((ext_vector_type(16)));
typedef float f32x2_t __attribute__((ext_vector_type(2)));
typedef __bf16 bf16x2_t __attribute__((ext_vector_type(2)));
typedef unsigned u32x2 __attribute__((ext_vector_type(2)));
__device__ __forceinline__ unsigned cvtpk(float lo, float hi) { f32x2_t v = {lo, hi}; bf16x2_t b = __builtin_convertvector(v, bf16x2_t); return __builtin_bit_cast(unsigned, b); }
__device__ __forceinline__ float bflo(unsigned w) { return __uint_as_float(w << 16); }
__device__ __forceinline__ float bfhi(unsigned w) { return __uint_as_float(w & 0xffff0000u); }
__device__ __forceinline__ void unpack8(const v4u& w, float (&x)[8]) { x[0] = bflo(w.x); x[1] = bfhi(w.x); x[2] = bflo(w.y); x[3] = bfhi(w.y); x[4] = bflo(w.z); x[5] = bfhi(w.z); x[6] = bflo(w.w); x[7] = bfhi(w.w); }
__device__ __forceinline__ v4u pack8(const float (&x)[8]) { v4u w; w.x = cvtpk(x[0], x[1]); w.y = cvtpk(x[2], x[3]); w.z = cvtpk(x[4], x[5]); w.w = cvtpk(x[6], x[7]); return w; }
__device__ __forceinline__ float wave_sum(float v) { v += shx<1>(v); v += shx<2>(v); v += shx<4>(v); v += shx<8>(v); v += shx<16>(v); return sh32_sum(v); }
__device__ __forceinline__ float wave_max(float v) { v = fmaxf(v, shx<1>(v)); v = fmaxf(v, shx<2>(v)); v = fmaxf(v, shx<4>(v)); v = fmaxf(v, shx<8>(v)); v = fmaxf(v, shx<16>(v)); return sh32_max(v); }
__device__ __forceinline__ int crow(int r, int hi) { return (r & 3) + 8 * (r >> 2) + 4 * hi; }

__device__ __forceinline__ int even_map(int n) {
    if (n < 512) return ES_FQ + n;
    if (n < 1024) return ES_DQ + (n - 512);
    if (n < 1536) return ES_FK + (n - 1024);
    if (n < 2048) return ES_DK + (n - 1536);
    if (n < 2560) return ES_FV + (n - 2048);
    if (n < 3072) return ES_DV + (n - 2560);
    if (n < 3584) return ES_IQ + (n - 3072);
    if (n < 3648) return ES_IK + (n - 3584);
    return -1;
}
__device__ __forceinline__ void conv_item(const float* W, int K, int Nsrc, int nblk, const float* gain, bf16* WT, int mode, LAS float* scr, int item, int lane) {
    const int kb = item / nblk, nb = item % nblk, k0 = 64 * kb, n0 = 32 * nb;
    const int n = n0 + (lane & 31);
    int sc;
    if (mode == 0) sc = n; else if (mode == 1) { const int T = n >> 8, hf = (n >> 7) & 1, j = n & 127; sc = hf * FF + 128 * T + j; } else sc = even_map(n);
#pragma unroll 8
    for (int i = 0; i < 32; ++i) { const int kk = 2 * i + (lane >> 5); float v = 0.f;
        if (sc >= 0) { v = W[(size_t)(k0 + kk) * Nsrc + sc]; if (gain) v *= gain[k0 + kk]; }
        scr[kk * 33 + (lane & 31)] = v; }
    LDS_WAIT(); asm volatile("" ::: "memory");
    const int c = lane & 7;
#pragma unroll
    for (int j = 0; j < 4; ++j) { const int nn = (lane >> 3) + 8 * j; const LAS float* s = scr + (8 * c) * 33 + nn;
        v4u o; o.x = cvtpk(s[0 * 33], s[1 * 33]); o.y = cvtpk(s[2 * 33], s[3 * 33]); o.z = cvtpk(s[4 * 33], s[5 * 33]); o.w = cvtpk(s[6 * 33], s[7 * 33]);
        *(GAS v4u*)(WT + (size_t)(n0 + nn) * K + k0 + 8 * c) = o; }
    LDS_WAIT(); asm volatile("" ::: "memory");
}
struct InPtrs { const float* p[26]; };
__device__ __forceinline__ void conv_weights(const InPtrs& in, unsigned char* ws, int L, LAS unsigned char* lds, int gw, int NGW, int wave, int lane) {
    LAS float* scr = (LAS float*)(lds + wave * 16384);
    bf16* Wr = (bf16*)(ws + WS_W);
    const float* ffn1_norm = in.p[2] + (size_t)L * DM; const float* ffn1_in = in.p[3] + (size_t)L * DM * FF2; const float* ffn1_out = in.p[4] + (size_t)L * FF * DM;
    const float* mix_norm = in.p[5] + (size_t)L * DM; const float* mix_out = in.p[15] + (size_t)L * DM * DM;
    const float* memx_norm = in.p[16] + (size_t)L * DM; const float* mem_wq = in.p[18] + (size_t)L * DM * MEMW; const float* mem_wo = in.p[22] + (size_t)L * MEMW * DM;
    const float* ffn2_norm = in.p[23] + (size_t)L * DM; const float* ffn2_in = in.p[24] + (size_t)L * DM * FF2; const float* ffn2_out = in.p[25] + (size_t)L * FF * DM;
    const bool even = (L & 1) == 0;
    const float* mix_in = even ? in.p[6] : in.p[12];
    const int mixN = even ? EVEN_NP : ODD_N, mixSrc = even ? EVEN_SRC : ODD_N;
    const int I_FIN = (DM / 64) * (FF2 / 32), I_FOUT = (FF / 64) * (DM / 32), I_MIN = (DM / 64) * (mixN / 32), I_MOUT = (DM / 64) * (DM / 32), I_MQ = (DM / 64) * (MEMW / 32), I_MO = (MEMW / 64) * (DM / 32);
    const int NITEMS = 2 * I_FIN + 2 * I_FOUT + I_MIN + I_MOUT + I_MQ + I_MO;
    for (int it = gw; it < NITEMS; it += NGW) {
        int r = it;
        if (r < I_FIN) { conv_item(ffn1_in, DM, FF2, FF2 / 32, ffn1_norm, (bf16*)((unsigned char*)Wr + W_FFN1_IN), 1, scr, r, lane); continue; } r -= I_FIN;
        if (r < I_FIN) { conv_item(ffn2_in, DM, FF2, FF2 / 32, ffn2_norm, (bf16*)((unsigned char*)Wr + W_FFN2_IN), 1, scr, r, lane); continue; } r -= I_FIN;
        if (r < I_FOUT) { conv_item(ffn1_out, FF, DM, DM / 32, nullptr, (bf16*)((unsigned char*)Wr + W_FFN1_OUT), 0, scr, r, lane); continue; } r -= I_FOUT;
        if (r < I_FOUT) { conv_item(ffn2_out, FF, DM, DM / 32, nullptr, (bf16*)((unsigned char*)Wr + W_FFN2_OUT), 0, scr, r, lane); continue; } r -= I_FOUT;
        if (r < I_MIN) { conv_item(mix_in, DM, mixSrc, mixN / 32, mix_norm, (bf16*)((unsigned char*)Wr + W_MIX_IN), even ? 2 : 0, scr, r, lane); continue; } r -= I_MIN;
        if (r < I_MOUT) { conv_item(mix_out, DM, DM, DM / 32, nullptr, (bf16*)((unsigned char*)Wr + W_MIX_OUT), 0, scr, r, lane); continue; } r -= I_MOUT;
        if (r < I_MQ) { conv_item(mem_wq, DM, MEMW, MEMW / 32, memx_norm, (bf16*)((unsigned char*)Wr + W_MEMQ), 0, scr, r, lane); continue; } r -= I_MQ;
        conv_item(mem_wo, MEMW, DM, DM / 32, nullptr, (bf16*)((unsigned char*)Wr + W_MEMO), 0, scr, r, lane);
    }
}
__device__ __forceinline__ void copy_x(const float* x, float* out, bf16* HB, float* ssq0, int gw, int NGW, int lane) {
    for (int m = gw; m < S; m += NGW) {
        const GAS f32x4* xr = (const GAS f32x4*)(x + (size_t)m * DM) + lane; GAS f32x4* orow = (GAS f32x4*)(out + (size_t)m * DM) + lane;
        GAS u32x2* hb = (GAS u32x2*)(HB + (size_t)m * DM) + lane;
        float s = 0.f;
#pragma unroll
        for (int j = 0; j < 4; ++j) { const f32x4 v = xr[64 * j]; orow[64 * j] = v; s += (v.x * v.x + v.y * v.y) + (v.z * v.z + v.w * v.w);
            u32x2 w; w.x = cvtpk(v.x, v.y); w.y = cvtpk(v.z, v.w); hb[64 * j] = w; }
        s = wave_sum(s);
        if (lane < 16) ssq0[(size_t)m * 16 + lane] = (lane == 0) ? s : 0.f;
    }
}
__device__ __forceinline__ void rope_tables(float* cosT, float* sinT, int gtid, int nthreads) {
    for (int idx = gtid; idx < S * 8; idx += nthreads) {
        const int t = idx >> 3, j = idx & 7;
        float inv;
        switch (j) { case 0: inv = 1.0f; break; case 1: inv = 0.193922743f; break; case 2: inv = 0.0376060307f; break; case 3: inv = 0.00729266461f; break;
                     case 4: inv = 0.00141421356f; break; case 5: inv = 0.000274248188f; break; case 6: inv = 5.3182961e-05f; break; default: inv = 1.03133862e-05f; break; }
        const float ang = (float)t * inv;
        const float kq = __builtin_rintf(ang * 0.63661977236758134f);
        float r = ang - kq * 1.5703125f; r = r - kq * 0.00048351287841796875f; r = r - kq * 3.1391647326017846e-07f;
        const float r2 = r * r;
        float sp = 2.7557319e-6f; sp = sp * r2 - 1.9841270e-4f; sp = sp * r2 + 8.3333333e-3f; sp = sp * r2 - 1.6666667e-1f; const float sn = r + r * r2 * sp;
        float cp = -2.7557319e-7f; cp = cp * r2 + 2.4801587e-5f; cp = cp * r2 - 1.3888889e-3f; cp = cp * r2 + 4.1666667e-2f; cp = cp * r2 - 0.5f; const float cs = 1.0f + r2 * cp;
        const int q = ((int)kq) & 3;
        const float sv = (q == 0) ? sn : (q == 1) ? cs : (q == 2) ? -sn : -cs;
        const float cv = (q == 0) ? cs : (q == 1) ? -sn : (q == 2) ? -cs : sn;
        cosT[idx] = cv; sinT[idx] = sv;
    }
}
__device__ __forceinline__ void mem_kv(const InPtrs& in, unsigned char* ws, LAS unsigned char* lds, int w, int tid, int wave, int lane) {
    LAS float* memn = (LAS float*)lds;
    LAS float* red = (LAS float*)(lds + 4096);
    bf16* memK = (bf16*)(ws + WS_MEMK); bf16* memVt = (bf16*)(ws + WS_MEMK + 256 * 1024);
    for (int L = 0; L < NLAYER; ++L) {
        const float* mrow = in.p[1] + (size_t)w * DM; const float* gm = in.p[17] + (size_t)L * DM; const float* wkv = in.p[19] + (size_t)L * DM * 512; const float* kn = in.p[21] + (size_t)L * 64;
        const float x0 = mrow[tid], x1 = mrow[tid + 512];
        float s = wave_sum(x0 * x0 + x1 * x1);
        if (lane == 0) red[wave] = s;
        __syncthreads();
        float tot = 0.f;
#pragma unroll
        for (int i = 0; i < 8; ++i) tot += red[i];
        const float rstd = rsqrtf(tot * (1.0f / DM) + RMS_EPS);
        memn[tid] = x0 * rstd * gm[tid]; memn[tid + 512] = x1 * rstd * gm[tid + 512];
        __syncthreads();
        float acc = 0.f;
#pragma unroll 8
        for (int k = 0; k < DM; ++k) acc += memn[k] * wkv[(size_t)k * 512 + tid];
        if (tid < 256) {
            const float ss = wave_sum(acc * acc);
            const float y = acc * rsqrtf(ss * (1.0f / 64.0f) + RMS_EPS) * kn[tid & 63];
            memK[(size_t)L * 256 * 256 + (size_t)w * 256 + tid] = (bf16)(cvtpk(y, 0.f) & 0xffffu);
        } else {
            const int c = tid - 256;
            memVt[(size_t)L * 256 * 256 + (size_t)c * 256 + w] = (bf16)(cvtpk(acc, 0.f) & 0xffffu);
        }
        __syncthreads();
    }
}

__device__ __forceinline__ void head_norm8(float (&x)[8], const float* gain, int lane) {
    float ss = 0.f;
#pragma unroll
    for (int j = 0; j < 8; ++j) ss += x[j] * x[j];
    ss += shx<1>(ss); ss += shx<2>(ss); ss += shx<4>(ss);
    const float r = rsqrtf(ss * (1.0f / 64.0f) + RMS_EPS);
    const int d0 = 8 * (lane & 7);
#pragma unroll
    for (int j = 0; j < 8; ++j) x[j] = x[j] * r * gain[d0 + j];
}
__device__ __forceinline__ void rope8(float (&x)[8], const float (&cs)[8], const float (&sn)[8], int lane) {
    const int sub = lane & 7;
#pragma unroll
    for (int j = 0; j < 8; ++j) {
        const float other = shx<1>(x[j]);
        if (sub == 0) x[j] = x[j] * cs[j] - other * sn[j];
        else if (sub == 1) x[j] = x[j] * cs[j] + other * sn[j];
    }
}
__device__ __forceinline__ float sh32_get(float v, int lane) { auto r = __builtin_amdgcn_permlane32_swap(__float_as_uint(v), __float_as_uint(v), false, false); return __uint_as_float((lane < 32) ? r[1] : r[0]); }
__device__ __forceinline__ float reduce_scatter64(float (&v)[64], int lane) {
    { const bool up = (lane & 32) != 0;
#pragma unroll
      for (int j = 0; j < 32; ++j) { const float send = up ? v[j] : v[j + 32], keep = up ? v[j + 32] : v[j]; v[j] = keep + sh32_get(send, lane); } }
    { const bool up = (lane & 16) != 0;
#pragma unroll
      for (int j = 0; j < 16; ++j) { const float send = up ? v[j] : v[j + 16], keep = up ? v[j + 16] : v[j]; v[j] = keep + shx<16>(send); } }
    { const bool up = (lane & 8) != 0;
#pragma unroll
      for (int j = 0; j < 8; ++j) { const float send = up ? v[j] : v[j + 8], keep = up ? v[j + 8] : v[j]; v[j] = keep + shx<8>(send); } }
    { const bool up = (lane & 4) != 0;
#pragma unroll
      for (int j = 0; j < 4; ++j) { const float send = up ? v[j] : v[j + 4], keep = up ? v[j + 4] : v[j]; v[j] = keep + shx<4>(send); } }
    { const bool up = (lane & 2) != 0;
#pragma unroll
      for (int j = 0; j < 2; ++j) { const float send = up ? v[j] : v[j + 2], keep = up ? v[j + 2] : v[j]; v[j] = keep + shx<2>(send); } }
    { const bool up = (lane & 1) != 0; const float send = up ? v[0] : v[1], keep = up ? v[1] : v[0]; v[0] = keep + shx<1>(send); }
    return v[0];
}
__device__ __forceinline__ void post_even(const InPtrs& in, unsigned char* ws, const float* H, const float* ssq, LAS unsigned char* lds, int G, int tid, int wave, int lane) {
    bf16* proj = (bf16*)(ws + WS_BIG + B_PROJ); bf16* VtF = (bf16*)(ws + WS_BIG + B_VTF); bf16* IKc = (bf16*)(ws + WS_BIG + B_IKC);
    const float* cosT = (const float*)(ws + WS_ROPE); const float* sinT = cosT + S * 8;
    float* Flocal = (float*)(ws + WS_FL); float* Btot = Flocal + S * 8; float* IW = (float*)(ws + WS_IW);
    const float* fqn = in.p[8]; const float* fkn = in.p[9]; const float* dqn = in.p[10]; const float* dkn = in.p[11]; const float* bfg = in.p[7];
    const float* Wsrc = in.p[6]; const float* mixg = in.p[5];
    constexpr int FVP = 1040;
    LAS f32x4* Tw = (LAS f32x4*)lds;
    LAS unsigned char* fvbuf = lds + 65536; LAS float* lf = (LAS float*)(lds + 65536 + 64 * FVP);
    for (int idx = tid; idx < 1024 * 16; idx += NTHREADS) {
        const int k = idx >> 4, col = idx & 15;
        const float v = mixg[k] * Wsrc[(size_t)k * EVEN_SRC + (col < 8 ? ES_FL + col : ES_IW + col - 8)];
        const int ln = (k & 255) >> 2, e = k & 3, q = k >> 8, c = col >> 2;
        ((LAS float*)Tw)[((((q * 4 + e) * 4 + c) * 64 + ln) << 2) + (col & 3)] = v;
    }
    __syncthreads();
    const int d0 = 8 * (lane & 7);
    for (int u = blockIdx.x; u < S / 64; u += G) {
        const int t0 = u * 64, tw0 = t0 + wave * 8;
        bf16* rowb = proj + (size_t)tw0 * EVEN_NP + lane * 8;
        v4u raw[8];
#pragma unroll
        for (int sec = 0; sec < 5; ++sec) {
            const int coff = (sec == 0) ? EC_FQ : (sec == 1) ? EC_DQ : (sec == 2) ? EC_FK : (sec == 3) ? EC_DK : EC_IQ;
            const float* gn = (sec == 0) ? fqn : (sec == 1) ? dqn : (sec == 2) ? fkn : dkn;
            float gv[8];
            if (sec < 4) {
#pragma unroll
                for (int j = 0; j < 8; ++j) gv[j] = gn[d0 + j]; }
#pragma unroll
            for (int i = 0; i < 8; ++i) raw[i] = *(const GAS v4u*)(rowb + (size_t)i * EVEN_NP + coff);
#pragma unroll
            for (int i = 0; i < 8; ++i) {
                float x[8]; unpack8(raw[i], x);
                if (sec < 4) { float ss = 0.f;
#pragma unroll
                    for (int j = 0; j < 8; ++j) ss += x[j] * x[j];
                    ss += shx<1>(ss); ss += shx<2>(ss); ss += shx<4>(ss);
                    const float r = rsqrtf(ss * (1.0f / 64.0f) + RMS_EPS);
#pragma unroll
                    for (int j = 0; j < 8; ++j) x[j] = x[j] * r * gv[j]; }
                if (sec == 1 || sec == 3 || sec == 4) { float cs[8], sn[8]; const int t = tw0 + i;
#pragma unroll
                    for (int j = 0; j < 8; ++j) { cs[j] = cosT[t * 8 + j]; sn[j] = sinT[t * 8 + j]; }
                    rope8(x, cs, sn, lane); }
                *(GAS v4u*)(rowb + (size_t)i * EVEN_NP + coff) = pack8(x);
            }
        }
#pragma unroll
        for (int i = 0; i < 8; ++i) raw[i] = *(const GAS v4u*)(rowb + (size_t)i * EVEN_NP + EC_FV);
#pragma unroll
        for (int i = 0; i < 8; ++i) *(LAS v4u*)(fvbuf + (wave * 8 + i) * FVP + lane * 16) = raw[i];
#pragma unroll
        for (int i = 0; i < 8; ++i) { raw[i] = (v4u){0u, 0u, 0u, 0u}; if (lane < 8) raw[i] = *(const GAS v4u*)(rowb + (size_t)i * EVEN_NP + EC_IK); }
#pragma unroll
        for (int i = 0; i < 8; ++i) { float x[8]; unpack8(raw[i], x); float cs[8], sn[8]; const int t = tw0 + i;
#pragma unroll
            for (int j = 0; j < 8; ++j) { cs[j] = cosT[t * 8 + j]; sn[j] = sinT[t * 8 + j]; }
            rope8(x, cs, sn, lane); if (lane < 8) *(GAS v4u*)(IKc + (size_t)t * 64 + lane * 8) = pack8(x); }
#pragma unroll 1
        for (int rb = 0; rb < 2; ++rb) {
            float acc[64];
#pragma unroll
            for (int j = 0; j < 64; ++j) acc[j] = 0.f;
#pragma unroll
            for (int q = 0; q < 4; ++q) {
                f32x4 hv[4];
#pragma unroll
                for (int r = 0; r < 4; ++r) hv[r] = *((const GAS f32x4*)(H + (size_t)(tw0 + rb * 4 + r) * DM) + lane + 64 * q);
#pragma unroll
                for (int e = 0; e < 4; ++e)
#pragma unroll
                    for (int c = 0; c < 4; ++c) { const f32x4 w = Tw[((q * 4 + e) * 4 + c) * 64 + lane];
#pragma unroll
                        for (int r = 0; r < 4; ++r) { acc[r * 16 + 4 * c + 0] += hv[r][e] * w[0]; acc[r * 16 + 4 * c + 1] += hv[r][e] * w[1]; acc[r * 16 + 4 * c + 2] += hv[r][e] * w[2]; acc[r * 16 + 4 * c + 3] += hv[r][e] * w[3]; } }
            }
            const float zs = reduce_scatter64(acc, lane);
            const int rl = wave * 8 + rb * 4 + (lane >> 4), t = t0 + rl, j = lane & 15;
            const float z = zs * pg8::row_rstd(ssq, t);
            if (j < 8) { const float zz = z + bfg[j]; lf[rl * 8 + j] = (zz > 15.f) ? -expf(-zz) : -log1pf(expf(-zz)); }
            else IW[(size_t)t * 8 + (j - 8)] = z * 0.044194173824159216f;
        }
        __syncthreads();
        {
            float v = lf[lane * 8 + wave];
#pragma unroll
            for (int o = 1; o < 64; o <<= 1) { const float up = __int_as_float(__builtin_amdgcn_ds_bpermute(((lane - o) & 63) << 2, __float_as_int(v))); if (lane >= o) v += up; }
            Flocal[(size_t)(t0 + lane) * 8 + wave] = v;
            if (lane == 63) Btot[u * 8 + wave] = v;
        }
#pragma unroll 2
        for (int p = 0; p < 8; ++p) {
            const int item = p * 512 + tid, c = item >> 3, k = item & 7;
            unsigned short e[8];
#pragma unroll
            for (int j = 0; j < 8; ++j) e[j] = *(const LAS unsigned short*)(fvbuf + (8 * k + j) * FVP + c * 2);
            v4u o; o.x = e[0] | ((unsigned)e[1] << 16); o.y = e[2] | ((unsigned)e[3] << 16); o.z = e[4] | ((unsigned)e[5] << 16); o.w = e[6] | ((unsigned)e[7] << 16);
            *(GAS v4u*)(VtF + (size_t)c * S + t0 + 8 * k) = o;
        }
        __syncthreads();
    }
}
__device__ __forceinline__ void post_odd(const InPtrs& in, unsigned char* ws, LAS unsigned char* lds, int G, int tid, int wave, int lane) {
    bf16* Q = (bf16*)(ws + WS_BIG + B_PROJ); bf16* Kb = Q + (size_t)S * DM; bf16* V = Kb + (size_t)S * DM; bf16* Vt = (bf16*)(ws + WS_BIG + B_VTM);
    const float* cosT = (const float*)(ws + WS_ROPE); const float* sinT = cosT + S * 8;
    float* ksum = (float*)(ws + WS_KSUM);
    const float* qn = in.p[13]; const float* kn = in.p[14];
    constexpr int VP = 1040;
    LAS unsigned char* vbuf = lds; LAS float* kred = (LAS float*)(lds + 64 * VP);
    for (int u = blockIdx.x; u < S / 64; u += G) {
        const int t0 = u * 64;
        float ks0[8], ks1[8];
#pragma unroll
        for (int j = 0; j < 8; ++j) { ks0[j] = 0.f; ks1[j] = 0.f; }
        const int tw0 = t0 + wave * 8, d0 = 8 * (lane & 7);
        v4u raw[8];
#pragma unroll
        for (int sec4 = 0; sec4 < 4; ++sec4) {
            const bool isk = sec4 >= 2; const int sec = sec4 & 1;
            bf16* base = (isk ? Kb : Q) + (size_t)tw0 * DM + sec * 512 + lane * 8;
            const float* gn = isk ? kn : qn;
            float gv[8];
#pragma unroll
            for (int j = 0; j < 8; ++j) gv[j] = gn[d0 + j];
#pragma unroll
            for (int i = 0; i < 8; ++i) raw[i] = *(const GAS v4u*)(base + (size_t)i * DM);
#pragma unroll
            for (int i = 0; i < 8; ++i) {
                float x[8]; unpack8(raw[i], x); float ss = 0.f;
#pragma unroll
                for (int j = 0; j < 8; ++j) ss += x[j] * x[j];
                ss += shx<1>(ss); ss += shx<2>(ss); ss += shx<4>(ss);
                const float r = rsqrtf(ss * (1.0f / 64.0f) + RMS_EPS);
#pragma unroll
                for (int j = 0; j < 8; ++j) x[j] = x[j] * r * gv[j];
                float cs[8], sn[8]; const int t = tw0 + i;
#pragma unroll
                for (int j = 0; j < 8; ++j) { cs[j] = cosT[t * 8 + j]; sn[j] = sinT[t * 8 + j]; }
                rope8(x, cs, sn, lane);
                *(GAS v4u*)(base + (size_t)i * DM) = pack8(x);
                if (isk) {
#pragma unroll
                    for (int j = 0; j < 8; ++j) { if (sec == 0) ks0[j] += x[j]; else ks1[j] += x[j]; } }
            }
        }
#pragma unroll
        for (int j = 0; j < 8; ++j) { kred[wave * 1024 + lane * 8 + j] = ks0[j]; kred[wave * 1024 + 512 + lane * 8 + j] = ks1[j]; }
        __syncthreads();
        {
#pragma unroll
            for (int e = 0; e < 2; ++e) { const int c = tid + 512 * e; float s = 0.f;
#pragma unroll
                for (int w8 = 0; w8 < 8; ++w8) s += kred[w8 * 1024 + c];
                ksum[(size_t)u * 1024 + c] = s; }
        }
        for (int half = 0; half < 2; ++half) {
#pragma unroll
            for (int i = 0; i < 8; ++i) raw[i] = *(const GAS v4u*)(V + (size_t)(tw0 + i) * DM + half * 512 + lane * 8);
#pragma unroll
            for (int i = 0; i < 8; ++i) *(LAS v4u*)(vbuf + (wave * 8 + i) * VP + lane * 16) = raw[i];
            __syncthreads();
#pragma unroll 2
            for (int p = 0; p < 8; ++p) {
                const int item = p * 512 + tid, c = item >> 3, k = item & 7;
                unsigned short e[8];
#pragma unroll
                for (int j = 0; j < 8; ++j) e[j] = *(const LAS unsigned short*)(vbuf + (8 * k + j) * VP + c * 2);
                v4u o; o.x = e[0] | ((unsigned)e[1] << 16); o.y = e[2] | ((unsigned)e[3] << 16); o.z = e[4] | ((unsigned)e[5] << 16); o.w = e[6] | ((unsigned)e[7] << 16);
                *(GAS v4u*)(Vt + (size_t)(half * 512 + c) * S + t0 + 8 * k) = o;
            }
            __syncthreads();
        }
    }
}

constexpr int KV_K_BYTES = 8192, KV_VT_PITCH = 136, KV_BUF_BYTES = KV_K_BYTES + 64 * KV_VT_PITCH;
struct KVRegs { v4u k, v; };
__device__ __forceinline__ void kv_load(KVRegs& r, const bf16* Kp, size_t kpitch, const bf16* Vtp, size_t vtpitch, int key0, int tid) {
    r.k = *(const GAS v4u*)(Kp + (size_t)(key0 + (tid & 63)) * kpitch + (tid >> 6) * 8);
    r.v = *(const GAS v4u*)(Vtp + (size_t)(tid >> 3) * vtpitch + key0 + (tid & 7) * 8);
}
__device__ __forceinline__ void kv_store(const KVRegs& r, LAS unsigned char* buf, int tid) {
    *(LAS v4u*)(buf + ((tid >> 6) * 64 + (tid & 63)) * 16) = r.k;
    LAS unsigned char* vp = buf + KV_K_BYTES + (tid >> 3) * KV_VT_PITCH + (tid & 7) * 16;
    *(LAS u32x2*)vp = (u32x2){r.v.x, r.v.y}; *(LAS u32x2*)(vp + 8) = (u32x2){r.v.z, r.v.w};
}
struct AttnAcc { float m, l; f32x16 o0, o1; };
__device__ __forceinline__ void attn_init(AttnAcc& a) { a.m = -INFINITY; a.l = 0.f;
#pragma unroll
    for (int r = 0; r < 16; ++r) { a.o0[r] = 0.f; a.o1[r] = 0.f; } }
template <int CHS = 1024>
__device__ __forceinline__ void attn_scores(f32x16& p0, f32x16& p1, const LAS unsigned char* buf, const bf16x8 (&qf)[4], int lane) {
    const int r32 = lane & 31, hi = lane >> 5;
#pragma unroll
    for (int r = 0; r < 16; ++r) { p0[r] = 0.f; p1[r] = 0.f; }
#pragma unroll
    for (int ks = 0; ks < 4; ++ks) {
        const bf16x8 k0 = *(const LAS bf16x8*)(buf + (2 * ks + hi) * CHS + r32 * 16);
        const bf16x8 k1 = *(const LAS bf16x8*)(buf + (2 * ks + hi) * CHS + (32 + r32) * 16);
        p0 = __builtin_amdgcn_mfma_f32_32x32x16_bf16(k0, qf[ks], p0, 0, 0, 0);
        p1 = __builtin_amdgcn_mfma_f32_32x32x16_bf16(k1, qf[ks], p1, 0, 0, 0);
    }
}
template <int VTP = KV_VT_PITCH, int VOFF = KV_K_BYTES>
__device__ __forceinline__ void attn_update(AttnAcc& a, f32x16& p0, f32x16& p1, const LAS unsigned char* buf, int lane) {
    const int r32 = lane & 31, hi = lane >> 5;
    float mx = fmaxf(p0[0], p1[0]);
#pragma unroll
    for (int r = 1; r < 16; ++r) mx = fmaxf(mx, fmaxf(p0[r], p1[r]));
    mx = sh32_max(mx);
    const float mnew = fmaxf(a.m, mx);
    const float msafe = (mnew == -INFINITY) ? 0.f : mnew;
    const float alpha = __builtin_amdgcn_exp2f(a.m - msafe);
    float sum = 0.f;
#pragma unroll
    for (int r = 0; r < 16; ++r) { p0[r] = __builtin_amdgcn_exp2f(p0[r] - msafe); p1[r] = __builtin_amdgcn_exp2f(p1[r] - msafe); sum += p0[r] + p1[r]; }
    a.l = a.l * alpha + sum; a.m = mnew;
#pragma unroll
    for (int r = 0; r < 16; ++r) { a.o0[r] *= alpha; a.o1[r] *= alpha; }
    const LAS unsigned char* vt = buf + VOFF + r32 * VTP + hi * 8;
#pragma unroll
    for (int half = 0; half < 2; ++half) {
#pragma unroll
        for (int s = 0; s < 2; ++s) {
            v4u pw;
            if (half == 0) { pw.x = cvtpk(p0[8 * s + 0], p0[8 * s + 1]); pw.y = cvtpk(p0[8 * s + 2], p0[8 * s + 3]); pw.z = cvtpk(p0[8 * s + 4], p0[8 * s + 5]); pw.w = cvtpk(p0[8 * s + 6], p0[8 * s + 7]); }
            else           { pw.x = cvtpk(p1[8 * s + 0], p1[8 * s + 1]); pw.y = cvtpk(p1[8 * s + 2], p1[8 * s + 3]); pw.z = cvtpk(p1[8 * s + 4], p1[8 * s + 5]); pw.w = cvtpk(p1[8 * s + 6], p1[8 * s + 7]); }
            const bf16x8 pb = __builtin_bit_cast(bf16x8, pw);
            const int kb = (32 * half + 16 * s) * 2;
#pragma unroll
            for (int d0 = 0; d0 < 2; ++d0) {
                const u32x2 lo = *(const LAS u32x2*)(vt + d0 * 32 * VTP + kb), hi2 = *(const LAS u32x2*)(vt + d0 * 32 * VTP + kb + 16);
                const bf16x8 va = __builtin_bit_cast(bf16x8, (v4u){lo.x, lo.y, hi2.x, hi2.y});
                if (d0 == 0) a.o0 = __builtin_amdgcn_mfma_f32_32x32x16_bf16(va, pb, a.o0, 0, 0, 0);
                else         a.o1 = __builtin_amdgcn_mfma_f32_32x32x16_bf16(va, pb, a.o1, 0, 0, 0);
            }
        }
    }
}
__device__ __forceinline__ void attn_store(const AttnAcc& a, bf16* orow, int lane) {
    const int hi = lane >> 5;
    float l = sh32_sum(a.l);
    const float inv = (l > 0.f) ? 1.0f / l : 0.f;
#pragma unroll
    for (int g = 0; g < 4; ++g) {
        u32x2 w0, w1;
        w0.x = cvtpk(a.o0[4 * g] * inv, a.o0[4 * g + 1] * inv); w0.y = cvtpk(a.o0[4 * g + 2] * inv, a.o0[4 * g + 3] * inv);
        w1.x = cvtpk(a.o1[4 * g] * inv, a.o1[4 * g + 1] * inv); w1.y = cvtpk(a.o1[4 * g + 2] * inv, a.o1[4 * g + 3] * inv);
        *(GAS u32x2*)(orow + 8 * g + 4 * hi) = w0; *(GAS u32x2*)(orow + 32 + 8 * g + 4 * hi) = w1;
    }
}
__device__ __forceinline__ void load_q(bf16x8 (&qf)[4], const bf16* qrow, int lane) {
    const int hi = lane >> 5;
#pragma unroll
    for (int ks = 0; ks < 4; ++ks) qf[ks] = *(const GAS bf16x8*)(qrow + 16 * ks + 8 * hi);
}

constexpr int CW_FOXQ = 64;
__device__ __forceinline__ void fox_phase(const InPtrs& in, unsigned char* ws, LAS unsigned char* lds, int G, int tid, int wave, int lane, bf16* obase, size_t opitch, int qword) {
    bf16* proj = (bf16*)(ws + WS_BIG + B_PROJ); const bf16* VtF = (const bf16*)(ws + WS_BIG + B_VTF);
    const float* Flocal = (const float*)(ws + WS_FL); const float* Btot = Flocal + S * 8;
    unsigned* qctr = (unsigned*)(ws + WS_CTL) + qword;
    LAS unsigned char* kvb = lds; LAS float* kbt = (LAS float*)(lds + 2 * KV_BUF_BYTES); LAS float* bt = (LAS float*)(lds + 2 * KV_BUF_BYTES + 65536); LAS float* Et = bt + 272;
    LAS int* misc = (LAS int*)(Et + 272);
    const int r32 = lane & 31, hi = lane >> 5;
    if (wave == 0) { const float gq = wave_max(fabsf(in.p[8][lane])), gk = wave_max(fabsf(in.p[9][lane])); if (lane == 0) { ((LAS float*)misc)[2] = gq; ((LAS float*)misc)[3] = gk; } }
    __syncthreads();
    const float THR = 2.0f * (0.125f * LOG2E * 64.0f * 1.02f) * ((LAS float*)misc)[2] * ((LAS float*)misc)[3] + 32.0f;
    for (;;) {
        __syncthreads();
        if (tid == 0) misc[0] = (int)atomicAdd(qctr, 1u);
        __syncthreads();
        const int u = misc[0];
        if (u >= 512) break;
        const int QB = 63 - (u >> 3), h = u & 7, q0 = QB * 256, nt = 4 * (QB + 1);
        for (int j = tid; j < nt; j += NTHREADS) bt[j] = Btot[j * 8 + h];
        if (tid == 0) misc[1] = 4 * QB;
        __syncthreads();
        for (int j = tid; j <= nt; j += NTHREADS) { float e = 0.f;
            if (j <= 4 * QB) { for (int i = 4 * QB - 1; i >= j; --i) e -= bt[i]; } else { for (int i = 4 * QB; i < j; ++i) e += bt[i]; }
            Et[j] = e; }
        __syncthreads();
        for (int j = tid; j < 4 * QB; j += NTHREADS) if (Et[j + 1] * LOG2E <= THR) atomicMin((int*)&misc[1], j);
        __syncthreads();
        const int t_start = misc[1], s0 = 64 * t_start;
        for (int s = s0 + tid; s < q0 + 256; s += NTHREADS) kbt[s - s0] = -(Et[s >> 6] + Flocal[(size_t)s * 8 + h]) * LOG2E;
        const int qrow = q0 + wave * 32 + r32;
        bf16x8 qf[4]; load_q(qf, proj + (size_t)qrow * EVEN_NP + EC_FQ + h * 64, lane);
        AttnAcc a; attn_init(a);
        const bf16* Kp = proj + EC_FK + h * 64; const bf16* Vtp = VtF + (size_t)h * 64 * S;
        KVRegs kr; kv_load(kr, Kp, EVEN_NP, Vtp, S, s0, tid); kv_store(kr, kvb, tid);
        __syncthreads();
        const float kbw = kbt[q0 + wave * 32 - s0];
        for (int t = t_start; t < nt; ++t) {
            LAS unsigned char* cur = kvb + ((t - t_start) & 1) * KV_BUF_BYTES;
            if (t + 1 < nt) kv_load(kr, Kp, EVEN_NP, Vtp, S, (t + 1) * 64, tid);
            const int key0 = t * 64;
            const bool vis = key0 <= q0 + wave * 32 + 31;
            const bool live = (key0 + 63 >= q0) || (kbw - kbt[key0 + 63 - s0] <= THR);
            if (vis && __builtin_amdgcn_readfirstlane((int)live)) {
                f32x16 p0, p1; attn_scores(p0, p1, cur, qf, lane);
#pragma unroll
                for (int g = 0; g < 4; ++g) {
                    const f32x4 b0 = *(const LAS f32x4*)(kbt + key0 - s0 + 8 * g + 4 * hi), b1 = *(const LAS f32x4*)(kbt + key0 - s0 + 32 + 8 * g + 4 * hi);
#pragma unroll
                    for (int e = 0; e < 4; ++e) { p0[4 * g + e] = p0[4 * g + e] * C2 + b0[e]; p1[4 * g + e] = p1[4 * g + e] * C2 + b1[e]; }
                }
                if (key0 + 63 > q0 + wave * 32) {
#pragma unroll
                    for (int r = 0; r < 16; ++r) { const int kv = key0 + crow(r, hi); if (kv > qrow) p0[r] = -INFINITY; if (kv + 32 > qrow) p1[r] = -INFINITY; }
                }
                attn_update(a, p0, p1, cur, lane);
            }
            if (t + 1 < nt) kv_store(kr, kvb + ((t + 1 - t_start) & 1) * KV_BUF_BYTES, tid);
            __syncthreads();
        }
        attn_store(a, obase + (size_t)qrow * opitch + h * 64, lane);
    }
}

__device__ __forceinline__ void memattn_phase(const InPtrs& in, unsigned char* ws, int L, LAS unsigned char* lds, int G, int tid, int wave, int lane) {
    const bf16* QM = (const bf16*)(ws + WS_BIG + B_QM); bf16* OM = (bf16*)(ws + WS_BIG + B_OM);
    const bf16* memK = (const bf16*)(ws + WS_MEMK) + (size_t)L * 256 * 256; const bf16* memVt = (const bf16*)(ws + WS_MEMK + 256 * 1024) + (size_t)L * 256 * 256;
    const float* qn = in.p[20] + (size_t)L * 64;
    LAS unsigned char* kvb = lds;
    const int r32 = lane & 31, hi = lane >> 5;
    for (int un = blockIdx.x; un < 256; un += G) {
        const int QB = un >> 2, hm = un & 3, qrow = QB * 256 + wave * 32 + r32;
        bf16x8 qf[4];
        {
            const bf16* qp = QM + (size_t)qrow * MEMW + hm * 64; float x[4][8]; float ss = 0.f;
#pragma unroll
            for (int ks = 0; ks < 4; ++ks) { const v4u w = *(const GAS v4u*)(qp + 16 * ks + 8 * hi); unpack8(w, x[ks]);
#pragma unroll
                for (int j = 0; j < 8; ++j) ss += x[ks][j] * x[ks][j]; }
            ss = sh32_sum(ss);
            const float r = rsqrtf(ss * (1.0f / 64.0f) + RMS_EPS);
#pragma unroll
            for (int ks = 0; ks < 4; ++ks) {
#pragma unroll
                for (int j = 0; j < 8; ++j) x[ks][j] = x[ks][j] * r * qn[16 * ks + 8 * hi + j];
                qf[ks] = __builtin_bit_cast(bf16x8, pack8(x[ks])); }
        }
        AttnAcc a; attn_init(a);
        const bf16* Kp = memK + hm * 64; const bf16* Vtp = memVt + (size_t)hm * 64 * 256;
        __syncthreads();
        KVRegs kr; kv_load(kr, Kp, 256, Vtp, 256, 0, tid); kv_store(kr, kvb, tid);
        __syncthreads();
        for (int t = 0; t < 4; ++t) {
            LAS unsigned char* cur = kvb + (t & 1) * KV_BUF_BYTES;
            if (t + 1 < 4) kv_load(kr, Kp, 256, Vtp, 256, (t + 1) * 64, tid);
            f32x16 p0, p1; attn_scores(p0, p1, cur, qf, lane);
#pragma unroll
            for (int r = 0; r < 16; ++r) { p0[r] *= C2; p1[r] *= C2; }
            attn_update(a, p0, p1, cur, lane);
            if (t + 1 < 4) kv_store(kr, kvb + ((t + 1) & 1) * KV_BUF_BYTES, tid);
            __syncthreads();
        }
        attn_store(a, OM + (size_t)qrow * MEMW + hm * 64, lane);
    }
}

constexpr size_t WS_MSEL = 7 * MiB;
constexpr size_t WS_MLSE = 8 * MiB;
constexpr size_t B_OP0 = 64 * MiB, B_OP1 = 128 * MiB;
__device__ __forceinline__ bool gate_better(float g1, int n1, float g2, int n2) { return g1 > g2 || (g1 == g2 && n1 < n2); }
__device__ __forceinline__ void moba_gate_phase(unsigned char* ws, int G, int wave, int lane) {
    const bf16* Q = (const bf16*)(ws + WS_BIG + B_PROJ); const float* ksum = (const float*)(ws + WS_KSUM); unsigned* selg = (unsigned*)(ws + WS_MSEL);
    const int r32 = lane & 31, hi = lane >> 5;
    const int NW = G * NWAVES;
    const int gwid = (int)blockIdx.x * NWAVES + wave;
    const int per_head = NW / 16;
    if (per_head == 0) return;
    const int h = gwid / per_head, wi = gwid % per_head;
    if (h >= 16) return;
    float af[2][32];
#pragma unroll
    for (int g = 0; g < 2; ++g)
#pragma unroll
        for (int kk = 0; kk < 32; ++kk) { const float* kp = ksum + (size_t)(32 * g + r32) * 4096 + h * 64 + 2 * kk + hi;
            af[g][kk] = ((kp[0] + kp[1024]) + (kp[2048] + kp[3072])) * (1.0f / 256.0f); }
    for (int tile = wi; tile < S / 32; tile += per_head) {
        const int t = tile * 32 + r32, own = (tile * 32) >> 8;
        float bq[32];
        { const bf16* qp = Q + (size_t)t * DM + h * 64;
#pragma unroll
          for (int c = 0; c < 8; ++c) { const unsigned sh = hi ? 0u : 16u;   const v4u w = *(const GAS v4u*)(qp + 8 * c);
              bq[4 * c + 0] = __uint_as_float((w.x << sh) & 0xffff0000u); bq[4 * c + 1] = __uint_as_float((w.y << sh) & 0xffff0000u);
              bq[4 * c + 2] = __uint_as_float((w.z << sh) & 0xffff0000u); bq[4 * c + 3] = __uint_as_float((w.w << sh) & 0xffff0000u); } }
        float g0 = -INFINITY, g1 = -INFINITY, g2 = -INFINITY; int n0 = 255, n1 = 255, n2 = 255;
#pragma unroll
        for (int g = 0; g < 2; ++g) {
            if (32 * g < own) {
                f32x16 c;
#pragma unroll
                for (int r = 0; r < 16; ++r) c[r] = 0.f;
#pragma unroll
                for (int kk = 0; kk < 32; ++kk) c = __builtin_amdgcn_mfma_f32_32x32x2f32(af[g][kk], bq[kk], c, 0, 0, 0);
#pragma unroll
                for (int r = 0; r < 16; ++r) { const int n = 32 * g + crow(r, hi); const float gv = (n < own) ? c[r] : -INFINITY;
                    if (n < own) {
                        if (gate_better(gv, n, g0, n0)) { g2 = g1; n2 = n1; g1 = g0; n1 = n0; g0 = gv; n0 = n; }
                        else if (gate_better(gv, n, g1, n1)) { g2 = g1; n2 = n1; g1 = gv; n1 = n; }
                        else if (gate_better(gv, n, g2, n2)) { g2 = gv; n2 = n; } } }
            }
        }
        const float p0 = sh32_get(g0, lane), p1 = sh32_get(g1, lane), p2 = sh32_get(g2, lane);
        const int pn0 = __float_as_int(sh32_get(__int_as_float(n0), lane)), pn1 = __float_as_int(sh32_get(__int_as_float(n1), lane)), pn2 = __float_as_int(sh32_get(__int_as_float(n2), lane));
        float fg[3]; int fn[3]; int ia = 0, ib = 0;
#pragma unroll
        for (int k = 0; k < 3; ++k) {
            const float ga = (ia == 0) ? g0 : (ia == 1) ? g1 : (ia == 2) ? g2 : -INFINITY; const int na = (ia == 0) ? n0 : (ia == 1) ? n1 : (ia == 2) ? n2 : 255;
            const float gb = (ib == 0) ? p0 : (ib == 1) ? p1 : (ib == 2) ? p2 : -INFINITY; const int nb = (ib == 0) ? pn0 : (ib == 1) ? pn1 : (ib == 2) ? pn2 : 255;
            const bool ta = (na != 255) && (nb == 255 || gate_better(ga, na, gb, nb));
            if (ta) { fg[k] = ga; fn[k] = na; ++ia; } else { fg[k] = gb; fn[k] = nb; ++ib; }
        }
        (void)fg;
        if (hi == 0) selg[(size_t)h * S + t] = (unsigned)(fn[0] & 255) | ((unsigned)(fn[1] & 255) << 8) | ((unsigned)(fn[2] & 255) << 16);
    }
}
constexpr int MR_KIMG = 32768, MR_VTP = 520, MR_VIMG = 64 * MR_VTP;
__device__ __forceinline__ void moba_route_phase(unsigned char* ws, LAS unsigned char* lds, int G, int tid, int wave, int lane) {
    const bf16* Q = (const bf16*)(ws + WS_BIG + B_PROJ); const bf16* Kb = Q + (size_t)S * DM; const bf16* Vt = (const bf16*)(ws + WS_BIG + B_VTM);
    const unsigned* selg = (const unsigned*)(ws + WS_MSEL); float* lse = (float*)(ws + WS_MLSE);
    LAS unsigned char* kimg = lds; LAS unsigned char* vimg = lds + MR_KIMG;
    LAS int* list = (LAS int*)(lds + MR_KIMG + MR_VIMG);
    LAS int* wtot = list + 2048;
    const int r32 = lane & 31, hi = lane >> 5;
    const int NUNITS = 16 * 280;
    for (int u = blockIdx.x; u < NUNITS; u += G) {
        int c = 0, rem = u;
        while (rem >= 16 * (8 * c + 7)) { rem -= 16 * (8 * c + 7); ++c; }
        const int n = rem >> 4, h = rem & 15;
        const int tlo = max(2048 * c, 256 * (n + 1));
        __syncthreads();
        int myent[4]; bool mysel[4];
#pragma unroll
        for (int i = 0; i < 4; ++i) { const int t = 2048 * c + 512 * i + tid; mysel[i] = false; myent[i] = 0;
            if (t >= tlo) { const unsigned w = selg[(size_t)h * S + t];
                const int slot = ((w & 255u) == (unsigned)n) ? 0 : (((w >> 8) & 255u) == (unsigned)n) ? 1 : (((w >> 16) & 255u) == (unsigned)n) ? 2 : -1;
                if (slot >= 0) { mysel[i] = true; myent[i] = t | (slot << 16); } }
            const unsigned long long mk = __ballot(mysel[i]);
            if (lane == 0) wtot[i * 8 + wave] = __popcll(mk); }
        __syncthreads();
        int cnt = 0;
#pragma unroll
        for (int i = 0; i < 4; ++i) { int base = cnt;
#pragma unroll
            for (int w8 = 0; w8 < 8; ++w8) { const int v = wtot[i * 8 + w8]; if (w8 < wave) base += v; cnt += v; }
            const unsigned long long mk = __ballot(mysel[i]);
            if (mysel[i]) list[base + __popcll(mk & ((1ull << lane) - 1ull))] = myent[i]; }
        { const bf16* Kp = Kb + (size_t)(256 * n) * DM + h * 64; const bf16* Vp = Vt + (size_t)h * 64 * S + 256 * n;
#pragma unroll
          for (int i = 0; i < 4; ++i) { const int piece = tid + 512 * i, key = piece & 255, ch = piece >> 8;
              const v4u kv = *(const GAS v4u*)(Kp + (size_t)key * DM + ch * 8); *(LAS v4u*)(kimg + (ch * 256 + key) * 16) = kv;
              const int d = piece >> 5, c16 = piece & 31;
              const v4u vv = *(const GAS v4u*)(Vp + (size_t)d * S + c16 * 8); LAS unsigned char* vp = vimg + d * MR_VTP + c16 * 16;
              *(LAS u32x2*)vp = (u32x2){vv.x, vv.y}; *(LAS u32x2*)(vp + 8) = (u32x2){vv.z, vv.w}; } }
        __syncthreads();
        if (cnt == 0) continue;
        const int ntile = (cnt + 31) >> 5;
        for (int ti = wave; ti < ntile; ti += NWAVES) {
            const int e = ti * 32 + r32; const bool live = e < cnt;
            const int ent = list[live ? e : 0]; const int t = ent & 0xffff, slot = ent >> 16;
            bf16x8 qf[4]; load_q(qf, Q + (size_t)t * DM + h * 64, lane);
            AttnAcc a; attn_init(a);
#pragma unroll 1
            for (int j = 0; j < 4; ++j) {
                f32x16 p0, p1; attn_scores<4096>(p0, p1, kimg + j * 64 * 16, qf, lane);
#pragma unroll
                for (int r = 0; r < 16; ++r) { p0[r] *= C2; p1[r] *= C2; }
                attn_update<MR_VTP, 0>(a, p0, p1, vimg + j * 128, lane);
            }
            const float l = sh32_sum(a.l); const float inv = 1.0f / l;
            if (live) {
                bf16* orow = (bf16*)(ws + (slot == 0 ? WS_BIG + B_OP0 : slot == 1 ? WS_BIG + B_OP1 : WS_HB)) + ((size_t)t * 16 + h) * 64;
#pragma unroll
                for (int g = 0; g < 4; ++g) { u32x2 w0, w1;
                    w0.x = cvtpk(a.o0[4 * g] * inv, a.o0[4 * g + 1] * inv); w0.y = cvtpk(a.o0[4 * g + 2] * inv, a.o0[4 * g + 3] * inv);
                    w1.x = cvtpk(a.o1[4 * g] * inv, a.o1[4 * g + 1] * inv); w1.y = cvtpk(a.o1[4 * g + 2] * inv, a.o1[4 * g + 3] * inv);
                    *(GAS u32x2*)(orow + 8 * g + 4 * hi) = w0; *(GAS u32x2*)(orow + 32 + 8 * g + 4 * hi) = w1; }
                if (hi == 0) lse[((size_t)slot * S + t) * 16 + h] = a.m + __builtin_amdgcn_logf(l);
            }
        }
    }
}
__device__ __forceinline__ void moba_own_phase(unsigned char* ws, LAS unsigned char* lds, int G, int tid, int wave, int lane) {
    bf16* Q = (bf16*)(ws + WS_BIG + B_PROJ); const bf16* Kb = Q + (size_t)S * DM; const bf16* Vt = (const bf16*)(ws + WS_BIG + B_VTM);
    const unsigned* selg = (const unsigned*)(ws + WS_MSEL); const float* lse = (const float*)(ws + WS_MLSE);
    LAS unsigned char* kvb = lds;
    const int r32 = lane & 31, hi = lane >> 5;
    for (int un = blockIdx.x; un < 1024; un += G) {
        const int h = un & 15, QB = un >> 4, q0 = QB * 256, qrow = q0 + wave * 32 + r32;
        bf16x8 qf[4]; load_q(qf, Q + (size_t)qrow * DM + h * 64, lane);
        AttnAcc a; attn_init(a);
        const bf16* Kp = Kb + h * 64; const bf16* Vtp = Vt + (size_t)h * 64 * S;
        __syncthreads();
        KVRegs kr; kv_load(kr, Kp, DM, Vtp, S, q0, tid); kv_store(kr, kvb, tid);
        __syncthreads();
        for (int t = 0; t < 4; ++t) {
            LAS unsigned char* cur = kvb + (t & 1) * KV_BUF_BYTES;
            const int key0 = q0 + t * 64;
            if (t + 1 < 4) kv_load(kr, Kp, DM, Vtp, S, key0 + 64, tid);
            if (key0 <= q0 + wave * 32 + 31) {
                f32x16 p0, p1; attn_scores(p0, p1, cur, qf, lane);
#pragma unroll
                for (int r = 0; r < 16; ++r) { const int kv = key0 + crow(r, hi); p0[r] = (kv > qrow) ? -INFINITY : p0[r] * C2; p1[r] = (kv + 32 > qrow) ? -INFINITY : p1[r] * C2; }
                attn_update(a, p0, p1, cur, lane);
            }
            if (t + 1 < 4) kv_store(kr, kvb + ((t + 1) & 1) * KV_BUF_BYTES, tid);
            __syncthreads();
        }
        const unsigned sw = selg[(size_t)h * S + qrow];
        float L[3];
#pragma unroll
        for (int j = 0; j < 3; ++j) L[j] = (((sw >> (8 * j)) & 255u) != 255u) ? lse[((size_t)j * S + qrow) * 16 + h] : -INFINITY;
        const float M = fmaxf(fmaxf(a.m, L[0]), fmaxf(L[1], L[2]));
        const float so = __builtin_amdgcn_exp2f(a.m - M);
        float W = sh32_sum(a.l) * so;
#pragma unroll
        for (int r = 0; r < 16; ++r) { a.o0[r] *= so; a.o1[r] *= so; }
#pragma unroll
        for (int j = 0; j < 3; ++j) {
            if (L[j] != -INFINITY) {
                const float wj = __builtin_amdgcn_exp2f(L[j] - M); W += wj;
                const bf16* orow = (const bf16*)(ws + (j == 0 ? WS_BIG + B_OP0 : j == 1 ? WS_BIG + B_OP1 : WS_HB)) + ((size_t)qrow * 16 + h) * 64;
#pragma unroll
                for (int g = 0; g < 4; ++g) { const u32x2 w0 = *(const GAS u32x2*)(orow + 8 * g + 4 * hi), w1 = *(const GAS u32x2*)(orow + 32 + 8 * g + 4 * hi);
                    a.o0[4 * g] += wj * bflo(w0.x); a.o0[4 * g + 1] += wj * bfhi(w0.x); a.o0[4 * g + 2] += wj * bflo(w0.y); a.o0[4 * g + 3] += wj * bfhi(w0.y);
                    a.o1[4 * g] += wj * bflo(w1.x); a.o1[4 * g + 1] += wj * bfhi(w1.x); a.o1[4 * g + 2] += wj * bflo(w1.y); a.o1[4 * g + 3] += wj * bfhi(w1.y); }
            }
        }
        const float inv = 1.0f / W;
        bf16* orow = Q + (size_t)qrow * DM + h * 64;
#pragma unroll
        for (int g = 0; g < 4; ++g) { u32x2 w0, w1;
            w0.x = cvtpk(a.o0[4 * g] * inv, a.o0[4 * g + 1] * inv); w0.y = cvtpk(a.o0[4 * g + 2] * inv, a.o0[4 * g + 3] * inv);
            w1.x = cvtpk(a.o1[4 * g] * inv, a.o1[4 * g + 1] * inv); w1.y = cvtpk(a.o1[4 * g + 2] * inv, a.o1[4 * g + 3] * inv);
            *(GAS u32x2*)(orow + 8 * g + 4 * hi) = w0; *(GAS u32x2*)(orow + 32 + 8 * g + 4 * hi) = w1; }
    }
}

typedef float f32x4v __attribute__((ext_vector_type(4)));
__device__ __forceinline__ unsigned mono_key(float s) { if (s == 0.f) s = 0.f; const unsigned u = __float_as_uint(s); return (u & 0x80000000u) ? ~u : (u | 0x80000000u); }
constexpr int DS_CAP = 512;
__device__ __forceinline__ unsigned dsa_compact(LAS unsigned* keys, LAS unsigned short* idxs, int n, int lane) {
    unsigned k[8]; unsigned short ix[8];
#pragma unroll
    for (int j = 0; j < 8; ++j) { const int e = lane + 64 * j; const bool in = e < n; k[j] = in ? keys[e] : 0u; ix[j] = in ? idxs[e] : (unsigned short)0; }
    unsigned T = 0u; int cntT = n;
    for (int bit = 31; bit >= 0; --bit) {
        const unsigned cand = T | (1u << bit); int c = 0;
#pragma unroll
        for (int j = 0; j < 8; ++j) c += __popcll(__ballot(k[j] >= cand));
        if (c >= 256) { T = cand; cntT = c; }
    }
    int Jstar = 0x10000;
    if (cntT > 256) {
        int gt = 0;
#pragma unroll
        for (int j = 0; j < 8; ++j) gt += __popcll(__ballot(k[j] > T));
        const int need = 256 - gt; int Jm = 0;
        for (int bit = 14; bit >= 0; --bit) { const int cand = Jm | (1 << bit); int c = 0;
#pragma unroll
            for (int j = 0; j < 8; ++j) c += __popcll(__ballot(k[j] == T && (int)ix[j] < cand));
            if (c < need) Jm = cand; }
        Jstar = Jm + 1;
    }
    int base = 0;
    const unsigned long long lt = (1ull << lane) - 1ull;
#pragma unroll
    for (int j = 0; j < 8; ++j) { const bool pred = (k[j] > T) || (k[j] == T && T != 0u && (int)ix[j] < Jstar);
        const unsigned long long mask = __ballot(pred); const int pos = base + __popcll(mask & lt);
        if (pred) { keys[pos] = k[j]; idxs[pos] = ix[j]; }
        base += __popcll(mask); }
    return T;
}
__device__ __forceinline__ float relu_s(float x) { float r; asm("v_max_f32_e32 %0, 0, %1" : "=v"(r) : "v"(x)); return r; }
__device__ __forceinline__ void fmac_s(float& acc, float a, float b) { asm("v_fmac_f32_e32 %0, %1, %2" : "+v"(acc) : "v"(a), "v"(b)); }
struct DsaState { unsigned thr0, thr1; int cnt0, cnt1; };
__device__ __forceinline__ void dsa_tile(const bf16x8 (&af)[4], const bf16x8 (&bc)[4], const float (&w0)[8], const float (&w1)[8], int key0, int q0t, int q1t, DsaState& st,
                                         LAS unsigned* ckeys, LAS unsigned short* cidx, unsigned lowmask, int lane) {
    const int r32 = lane & 31, hi = lane >> 5;
    f32x16 p;
#pragma unroll
    for (int r = 0; r < 16; ++r) p[r] = 0.f;
#pragma unroll
    for (int ks = 0; ks < 4; ++ks) p = __builtin_amdgcn_mfma_f32_32x32x16_bf16(af[ks], bc[ks], p, 0, 0, 0);
    asm volatile("s_nop 15\n\ts_nop 7" : "+v"(p));
    float s0 = 0.f, s1 = 0.f;
#pragma unroll
    for (int r = 0; r < 8; ++r) { fmac_s(s0, w0[r], relu_s(p[r])); fmac_s(s1, w1[r], relu_s(p[8 + r])); }
    const int key = key0 + r32;
    const unsigned u0 = mono_key(s0), u1 = mono_key(s1);
    const bool pr0 = (key <= q0t) && (u0 > st.thr0), pr1 = (key <= q1t) && (u1 > st.thr1);
    const unsigned long long m0 = __ballot(pr0), m1 = __ballot(pr1);
    if (m0 | m1) {
        LAS unsigned* kq0 = ckeys + hi * DS_CAP; LAS unsigned* kq1 = ckeys + (2 + hi) * DS_CAP;
        LAS unsigned short* iq0 = cidx + hi * DS_CAP; LAS unsigned short* iq1 = cidx + (2 + hi) * DS_CAP;
        const unsigned h0 = hi ? (unsigned)(m0 >> 32) : (unsigned)m0, h1 = hi ? (unsigned)(m1 >> 32) : (unsigned)m1;
        if (pr0) { const int pos = st.cnt0 + __popc(h0 & lowmask); kq0[pos] = u0; iq0[pos] = (unsigned short)key; }
        if (pr1) { const int pos = st.cnt1 + __popc(h1 & lowmask); kq1[pos] = u1; iq1[pos] = (unsigned short)key; }
        st.cnt0 += __popc(h0); st.cnt1 += __popc(h1);
        const unsigned long long need = __ballot(st.cnt0 > DS_CAP - 32 || st.cnt1 > DS_CAP - 32);
        if (need) {
#pragma unroll 1
            for (int hh = 0; hh < 2; ++hh) {
                const int c0 = __builtin_amdgcn_readlane(st.cnt0, 0), c0b = __builtin_amdgcn_readlane(st.cnt0, 32);
                const int c1 = __builtin_amdgcn_readlane(st.cnt1, 0), c1b = __builtin_amdgcn_readlane(st.cnt1, 32);
                const int n0 = hh ? c0b : c0, n1 = hh ? c1b : c1;
                if (n0 > DS_CAP - 32) { const unsigned T = dsa_compact(ckeys + hh * DS_CAP, cidx + hh * DS_CAP, n0, lane); if (hi == hh) { st.thr0 = T; st.cnt0 = 256; } }
                if (n1 > DS_CAP - 32) { const unsigned T = dsa_compact(ckeys + (2 + hh) * DS_CAP, cidx + (2 + hh) * DS_CAP, n1, lane); if (hi == hh) { st.thr1 = T; st.cnt1 = 256; } }
            }
        }
    }
}
__device__ __forceinline__ void dsa_select_phase(unsigned char* ws, LAS unsigned char* lds, int G, int tid, int wave, int lane) {
    const bf16* proj = (const bf16*)(ws + WS_BIG + B_PROJ); const bf16* IKc = (const bf16*)(ws + WS_BIG + B_IKC); const float* IW = (const float*)(ws + WS_IW);
    unsigned short* selg = (unsigned short*)(ws + WS_BIG + B_SEL);
    LAS unsigned* ckeys = (LAS unsigned*)(lds) + wave * 4 * DS_CAP;
    LAS unsigned short* cidx = (LAS unsigned short*)(lds + 65536) + wave * 4 * DS_CAP;
    const int r32 = lane & 31, hi = lane >> 5;
    const unsigned lowmask = (1u << r32) - 1u;
    const int NWG = G * NWAVES, gw = (int)blockIdx.x * NWAVES + wave;
    for (int pu = gw; pu < 2048; pu += NWG) {
        for (int uu = 0; uu < 2; ++uu) {
            const int unit = uu ? 4095 - pu : pu, tw = unit * 4;
            bf16x8 af[4];
            { const int i = r32, qi = 2 * (i >> 4) + ((i >> 2) & 1), hd = 4 * ((i >> 3) & 1) + (i & 3);
              const bf16* ap = proj + (size_t)(tw + qi) * EVEN_NP + EC_IQ + hd * 64 + 8 * hi;
#pragma unroll
              for (int ks = 0; ks < 4; ++ks) af[ks] = *(const GAS bf16x8*)(ap + 16 * ks); }
            float w0[8], w1[8];
            { const f32x4 a = *(const GAS f32x4*)(IW + (size_t)(tw + hi) * 8), b = *(const GAS f32x4*)(IW + (size_t)(tw + hi) * 8 + 4);
              const f32x4 c = *(const GAS f32x4*)(IW + (size_t)(tw + 2 + hi) * 8), d = *(const GAS f32x4*)(IW + (size_t)(tw + 2 + hi) * 8 + 4);
#pragma unroll
              for (int j = 0; j < 4; ++j) { w0[j] = a[j]; w0[4 + j] = b[j]; w1[j] = c[j]; w1[4 + j] = d[j]; } }
            const int q0t = tw + hi, q1t = tw + 2 + hi;
            DsaState st; st.thr0 = 0u; st.thr1 = 0u; st.cnt0 = 0; st.cnt1 = 0;
            const int ntile = ((tw + 3) >> 5) + 1;
            const bf16* kp = IKc + (size_t)r32 * 64 + 8 * hi; asm volatile("" : "+v"(kp));
            bf16x8 bA[4], bB[4];
#define DSA_LOADB(dst, jj) do { const bf16* p_ = kp + (size_t)(jj) * 2048; \
                asm volatile("global_load_dwordx4 %0, %4, off\n\tglobal_load_dwordx4 %1, %4, off offset:32\n\tglobal_load_dwordx4 %2, %4, off offset:64\n\tglobal_load_dwordx4 %3, %4, off offset:96" \
                             : "=&v"(dst[0]), "=&v"(dst[1]), "=&v"(dst[2]), "=&v"(dst[3]) : "v"(p_) : "memory"); } while (0)
#define DSA_WAITB(dst, n) asm volatile("s_waitcnt vmcnt(" #n ")" : "+v"(dst[0]), "+v"(dst[1]), "+v"(dst[2]), "+v"(dst[3]) :: "memory")
            asm volatile("" : "+v"(af[0]), "+v"(af[1]), "+v"(af[2]), "+v"(af[3]));
#pragma unroll
            for (int r = 0; r < 8; ++r) asm volatile("" : "+v"(w0[r]), "+v"(w1[r]));
            DSA_LOADB(bA, 0);
#pragma unroll 1
            for (int j = 0; j < ntile; j += 2) {
                DSA_LOADB(bB, min(j + 1, ntile - 1));
                DSA_WAITB(bA, 4);
                dsa_tile(af, bA, w0, w1, 32 * j, q0t, q1t, st, ckeys, cidx, lowmask, lane);
                DSA_LOADB(bA, min(j + 2, ntile - 1));
                DSA_WAITB(bB, 4);
                if (j + 1 < ntile) dsa_tile(af, bB, w0, w1, 32 * (j + 1), q0t, q1t, st, ckeys, cidx, lowmask, lane);
            }
            DSA_WAITB(bA, 0);
#undef DSA_LOADB
#undef DSA_WAITB
            const int cnt0 = st.cnt0, cnt1 = st.cnt1;
#pragma unroll 1
            for (int qq = 0; qq < 4; ++qq) {
                const int hh = qq & 1, sl = qq >> 1;
                int n = sl ? __builtin_amdgcn_readlane(cnt1, 32 * hh) : __builtin_amdgcn_readlane(cnt0, 32 * hh);
                LAS unsigned* kk = ckeys + qq * DS_CAP; LAS unsigned short* ii = cidx + qq * DS_CAP;
                if (n > 256) { (void)dsa_compact(kk, ii, n, lane); n = 256; }
                unsigned short* row = selg + (size_t)(tw + qq) * 256;
#pragma unroll
                for (int e4 = 0; e4 < 4; ++e4) { const int e = lane + 64 * e4; row[e] = (e < n) ? ii[e] : (unsigned short)0xFFFFu; }
            }
        }
    }
}

__device__ __forceinline__ void dsa_sparse_phase(unsigned char* ws, int G, int wave, int lane, bf16* obase, size_t opitch) {
    const bf16* proj = (const bf16*)(ws + WS_BIG + B_PROJ); const unsigned short* selg = (const unsigned short*)(ws + WS_BIG + B_SEL);
    const int h = (int)blockIdx.x & 7, wg = (int)blockIdx.x >> 3, nwg = G >> 3;
    const int kg = lane >> 3, ds8 = (lane & 7) * 8;
    for (int t = wg * NWAVES + wave; t < S; t += nwg * NWAVES) {
        v4u iw[4];
#pragma unroll
        for (int c = 0; c < 4; ++c) iw[c] = *(const GAS v4u*)(selg + (size_t)t * 256 + 32 * kg + 8 * c);
        float qv[8];
        { const v4u w = *(const GAS v4u*)(proj + (size_t)t * EVEN_NP + EC_DQ + h * 64 + ds8); unpack8(w, qv);
#pragma unroll
          for (int j = 0; j < 8; ++j) qv[j] *= C2; }
        float sc[32];
#pragma unroll
        for (int i0 = 0; i0 < 32; i0 += 8) {
            v4u kw[8];
#pragma unroll
            for (int j = 0; j < 8; ++j) { const int i = i0 + j; const unsigned wd = (i & 1) ? (iw[i >> 3][(i >> 1) & 3] >> 16) : (iw[i >> 3][(i >> 1) & 3] & 0xffffu);
                const unsigned idx = (wd == 0xffffu) ? 0u : wd;
                kw[j] = *(const GAS v4u*)(proj + (size_t)idx * EVEN_NP + EC_DK + h * 64 + ds8); }
#pragma unroll
            for (int j = 0; j < 8; ++j) { const int i = i0 + j; const unsigned wd = (i & 1) ? (iw[i >> 3][(i >> 1) & 3] >> 16) : (iw[i >> 3][(i >> 1) & 3] & 0xffffu);
                float x[8]; unpack8(kw[j], x); float d = 0.f;
#pragma unroll
                for (int e = 0; e < 8; ++e) d += qv[e] * x[e];
                d += shx<1>(d); d += shx<2>(d); d += shx<4>(d);
                sc[i] = (wd == 0xffffu) ? -INFINITY : d; }
        }
        float mx = sc[0];
#pragma unroll
        for (int i = 1; i < 32; ++i) mx = fmaxf(mx, sc[i]);
        mx = fmaxf(mx, shx<8>(mx)); mx = fmaxf(mx, shx<16>(mx)); mx = sh32_max(mx);
        float l = 0.f;
#pragma unroll
        for (int i = 0; i < 32; ++i) { sc[i] = __builtin_amdgcn_exp2f(sc[i] - mx); l += sc[i]; }
        l += shx<8>(l); l += shx<16>(l); l = sh32_sum(l);
        float acc[8];
#pragma unroll
        for (int e = 0; e < 8; ++e) acc[e] = 0.f;
#pragma unroll
        for (int i0 = 0; i0 < 32; i0 += 8) {
            v4u vw[8];
#pragma unroll
            for (int j = 0; j < 8; ++j) { const int i = i0 + j; const unsigned wd = (i & 1) ? (iw[i >> 3][(i >> 1) & 3] >> 16) : (iw[i >> 3][(i >> 1) & 3] & 0xffffu);
                const unsigned idx = (wd == 0xffffu) ? 0u : wd;
                vw[j] = *(const GAS v4u*)(proj + (size_t)idx * EVEN_NP + EC_DV + h * 64 + ds8); }
#pragma unroll
            for (int j = 0; j < 8; ++j) { float x[8]; unpack8(vw[j], x);
#pragma unroll
                for (int e = 0; e < 8; ++e) acc[e] += sc[i0 + j] * x[e]; }
        }
        const float inv = 1.0f / l;
#pragma unroll
        for (int e = 0; e < 8; ++e) { float a = acc[e]; a += shx<8>(a); a += shx<16>(a); a = sh32_sum(a); acc[e] = a * inv; }
        if (kg == 0) *(GAS v4u*)(obase + (size_t)t * opitch + h * 64 + ds8) = pack8(acc);
    }
}

struct Args { InPtrs in; float* out; unsigned char* ws; int ph_lo, ph_hi, li, pad; };
constexpr int PH_PER_LAYER = 14, N_PHASES = 1 + 2 * PH_PER_LAYER - 1;

__global__ void __launch_bounds__(NTHREADS, 2) hyb_fwd(Args args) {
    extern __shared__ __attribute__((aligned(16))) unsigned char lds_raw[];
    LAS unsigned char* lds = (LAS unsigned char*)lds_raw;
    volatile LAS unsigned* MISC = (volatile LAS unsigned*)(lds + MISC_OFF);
    const int tid = threadIdx.x, lane = tid & 63, wave = __builtin_amdgcn_readfirstlane(tid >> 6);
    const int G = gridDim.x;
    const int vcu = (G % 8 == 0) ? ((int)blockIdx.x % 8) * (G / 8) + (int)blockIdx.x / 8 : (int)blockIdx.x;
    unsigned char* ws = args.ws;
    gu32* ctl = (gu32*)(ws + WS_CTL);
    for (int u = tid; u < (LDS_BYTES - LDSCTL_OFF) / 4; u += NTHREADS) ((LAS unsigned*)(lds + LDSCTL_OFF))[u] = 0u;
    __syncthreads();
    XcdBarrier bar = xcd_barrier_post((unsigned*)(ctl + CW_BAR) + args.li * XCD_BAR_WORDS, MISC + 8);
    const int tid0 = tid; unsigned char* const ws0 = ws;
    for (int ph = args.ph_lo; ph < args.ph_hi; ++ph) {
        int tid = tid0; asm volatile("" : "+v"(tid));
        unsigned char* ws = ws0; asm volatile("" : "+s"(ws));
        const int lane = tid & 63, wave = __builtin_amdgcn_readfirstlane(tid >> 6);
        LAS unsigned char* lds = (LAS unsigned char*)lds_raw; { unsigned lo_ = (unsigned)(uintptr_t)lds; asm volatile("" : "+s"(lo_)); lds = (LAS unsigned char*)(uintptr_t)lo_; }
        float* ssqA = (float*)(ws + WS_SSQ);
        bf16* HB = (bf16*)(ws + WS_HB);
        unsigned char* Wr = ws + WS_W;
        unsigned char* BIG = ws + WS_BIG;
        const int gw = vcu * NWAVES + wave, NGW = G * NWAVES;
        if (ph == 0) {
#ifdef PROBE_P02
            conv_weights(args.in, ws, 0, lds, gw, NGW, wave, lane);
            copy_x(args.in.p[0], args.out, HB, ssqA, gw, NGW, lane);
            rope_tables((float*)(ws + WS_ROPE), (float*)(ws + WS_ROPE) + S * 8, (int)blockIdx.x * NTHREADS + tid, G * NTHREADS);
            __syncthreads();
            for (int w = blockIdx.x; w < MEMT; w += G) mem_kv(args.in, ws, lds, w, tid, wave, lane);
            __syncthreads();
#endif
#ifndef NO_P0
            conv_weights(args.in, ws, 0, lds, gw, NGW, wave, lane);
            copy_x(args.in.p[0], args.out, HB, ssqA, gw, NGW, lane);
            rope_tables((float*)(ws + WS_ROPE), (float*)(ws + WS_ROPE) + S * 8, (int)blockIdx.x * NTHREADS + tid, G * NTHREADS);
            __syncthreads();
            for (int w = blockIdx.x; w < MEMT; w += G) mem_kv(args.in, ws, lds, w, tid, wave, lane);
#endif
        } else {
            const int L = (ph - 1) / PH_PER_LAYER, sub = (ph - 1) % PH_PER_LAYER;
            const bool even = (L & 1) == 0;
            float* ssq_in = ssqA;
            if (sub == 0 || sub == 11) {
                pg8::Gemm g{(const pg8::bf16_t*)HB, (const pg8::bf16_t*)(Wr + (sub == 0 ? W_FFN1_IN : W_FFN2_IN)), S, FF2, DM, DM};
                pg8::StaticOrder So; So.init(S, FF2, G, (int)blockIdx.x);
                pg8::EpiSwiGLU E{(pg8::bf16_t*)(BIG + B_U), ssq_in, FF};
#ifdef PROBE_GEMM2
                pg8::gemm_phase<pg8::EpiSwiGLU, pg8::StaticOrder, true, true>(lds, g, So, E, tid); __syncthreads();
#endif
                pg8::gemm_phase<pg8::EpiSwiGLU, pg8::StaticOrder, true, true>(lds, g, So, E, tid);
            } else if (sub == 1 || sub == 7 || sub == 10 || sub == 12) {
                pg8::Gemm g; float scale; int so;
                if (sub == 1)       { g = pg8::Gemm{(const pg8::bf16_t*)(BIG + B_U), (const pg8::bf16_t*)(Wr + W_FFN1_OUT), S, DM, FF, FF}; scale = 0.5f; so = 1; }
                else if (sub == 7)  { g = pg8::Gemm{(const pg8::bf16_t*)(BIG + B_PROJ), (const pg8::bf16_t*)(Wr + W_MIX_OUT), S, DM, DM, even ? EVEN_NP : DM}; scale = 1.0f; so = 2; }
                else if (sub == 10)  { g = pg8::Gemm{(const pg8::bf16_t*)(BIG + B_OM), (const pg8::bf16_t*)(Wr + W_MEMO), S, DM, MEMW, MEMW}; scale = 1.0f; so = 3; }
                else                { g = pg8::Gemm{(const pg8::bf16_t*)(BIG + B_U), (const pg8::bf16_t*)(Wr + W_FFN2_OUT), S, DM, FF, FF}; scale = 0.5f; so = 4; }
                const bool last = (sub == 12 && L == NLAYER - 1);
                pg8::StaticOrder So; So.init(S, DM, G, (int)blockIdx.x);
                pg8::EpiResid E{args.out, last ? nullptr : (pg8::bf16_t*)HB, last ? nullptr : ssqA, scale};
                pg8::gemm_phase<pg8::EpiResid, pg8::StaticOrder, true, true>(lds, g, So, E, tid);
#ifdef PROBE_GEMM2
                { __syncthreads(); pg8::EpiResid E0 = E; E0.scale = 0.f; pg8::gemm_phase<pg8::EpiResid, pg8::StaticOrder, true, true>(lds, g, So, E0, tid); }
#endif
            } else if (sub == 2 || sub == 8) {
                pg8::Gemm g; pg8::EpiScale E;
                if (sub == 2) { const int N = even ? EVEN_NP : ODD_N;
                    g = pg8::Gemm{(const pg8::bf16_t*)HB, (const pg8::bf16_t*)(Wr + W_MIX_IN), S, N, DM, DM};
                    E = pg8::EpiScale{(pg8::bf16_t*)(BIG + B_PROJ), even ? EVEN_NP : DM, ssq_in, even ? 0 : DM, (size_t)S * DM}; }
                else { g = pg8::Gemm{(const pg8::bf16_t*)HB, (const pg8::bf16_t*)(Wr + W_MEMQ), S, MEMW, DM, DM};
                    E = pg8::EpiScale{(pg8::bf16_t*)(BIG + B_QM), MEMW, ssq_in, 0, 0}; }
                pg8::StaticOrder So; So.init(S, g.N, G, (int)blockIdx.x);
#ifdef PROBE_GEMM2
                pg8::gemm_phase<pg8::EpiScale, pg8::StaticOrder, true, true>(lds, g, So, E, tid); __syncthreads();
#endif
                pg8::gemm_phase<pg8::EpiScale, pg8::StaticOrder, true, true>(lds, g, So, E, tid);
            } else if (sub == 3) {
                #ifndef NO_POSTE
                if (even) post_even(args.in, ws, args.out, ssq_in, lds, G, tid, wave, lane);
#endif
#ifndef NO_POSTO
                if (!even) post_odd(args.in, ws, lds, G, tid, wave, lane);
#endif
            } else if (sub == 4) {
                if (even) {
                    int nrep = 1;
#ifdef PROBE_DSA2
                    nrep = 2;
#endif
                    asm volatile("" : "+s"(nrep));
                    for (int rep = 0; rep < nrep; ++rep) { dsa_select_phase(ws, lds, G, tid, wave, lane); __syncthreads(); }
                } else {
                    moba_gate_phase(ws, G, wave, lane);
                }
            } else if (sub == 5) {
                if (even) {
                    bf16* projb = (bf16*)(BIG + B_PROJ);
#ifdef PROBE_FOX2
                    fox_phase(args.in, ws, lds, G, tid, wave, lane, HB, 512, CW_FOXQ + 64); __syncthreads();
#endif
#ifdef PROBE_SPARSE2
                    dsa_sparse_phase(ws, G, wave, lane, HB, 512);
#endif
                    fox_phase(args.in, ws, lds, G, tid, wave, lane, projb + EC_FQ, EVEN_NP, CW_FOXQ);
                    dsa_sparse_phase(ws, G, wave, lane, projb + EC_DQ, EVEN_NP);
                } else {
#ifdef PROBE_MOBA2
                    moba_route_phase(ws, lds, G, tid, wave, lane); __syncthreads();
#endif
                    moba_route_phase(ws, lds, G, tid, wave, lane);
                }
            } else if (sub == 6) {
                if (!even) moba_own_phase(ws, lds, G, tid, wave, lane);
            } else if (sub == 9) {
#ifdef PROBE_MEM2
                memattn_phase(args.in, ws, L, lds, G, tid, wave, lane); __syncthreads();
#endif
                memattn_phase(args.in, ws, L, lds, G, tid, wave, lane);
            } else if (sub == 13) {
#ifdef PROBE_P02
                conv_weights(args.in, ws, L + 1, lds, gw, NGW, wave, lane); __syncthreads();
#endif
                conv_weights(args.in, ws, L + 1, lds, gw, NGW, wave, lane);
            }
        }
        if (ph + 1 < args.ph_hi) xcd_barrier(bar);
#ifdef PROBE_BAR2
        if (ph + 1 < args.ph_hi) xcd_barrier(bar);
#endif
    }
}

#ifndef MK_N_LAUNCHES
#define MK_N_LAUNCHES 1
#endif
extern "C" void kernel_launch(void* const* d_in, const int* in_sizes, int n_in, void* d_out, int out_size, void* d_ws, size_t ws_size, hipStream_t stream) {
    static int grid = 0;
    if (grid == 0) {
        if (n_in != 26 || in_sizes[0] != S * DM || out_size != S * DM || ws_size < WS_END) {
            fprintf(stderr, "kernel_launch: unexpected problem (n_in %d, in0 %d, out %d, ws %zu); nothing launched\n", n_in, n_in > 0 ? in_sizes[0] : -1, out_size, ws_size); grid = -1; return; }
        int dev = 0, cus = 0, per_cu = 0;
        if (hipGetDevice(&dev) != hipSuccess || hipDeviceGetAttribute(&cus, hipDeviceAttributeMultiprocessorCount, dev) != hipSuccess) { grid = -1; return; }
        if (hipFuncSetAttribute((const void*)hyb_fwd, hipFuncAttributeMaxDynamicSharedMemorySize, LDS_BYTES) != hipSuccess) { fprintf(stderr, "kernel_launch: hipFuncSetAttribute failed\n"); grid = -1; return; }
        if (hipOccupancyMaxActiveBlocksPerMultiprocessor(&per_cu, (const void*)hyb_fwd, NTHREADS, LDS_BYTES) != hipSuccess || per_cu < 1)
            fprintf(stderr, "kernel_launch: note: occupancy query reports %d workgroups per CU\n", per_cu);
        (void)hipGetLastError();
        grid = cus;
    }
    if (grid < 0) return;
    if (hipMemsetAsync((char*)d_ws + WS_CTL, 0, CTL_ZERO_BYTES, stream) != hipSuccess) { fprintf(stderr, "kernel_launch: hipMemsetAsync failed\n"); return; }
    Args a{};
    for (int i = 0; i < 26; ++i) a.in.p[i] = (const float*)d_in[i];
    a.out = (float*)d_out; a.ws = (unsigned char*)d_ws;
#if MK_N_LAUNCHES == 1
    a.ph_lo = 0; a.ph_hi = N_PHASES; a.li = 0;
    hipLaunchKernelGGL(hyb_fwd, dim3(grid), dim3(NTHREADS), LDS_BYTES, stream, a);
#else
    for (int ph = 0; ph < N_PHASES; ++ph) { a.ph_lo = ph; a.ph_hi = ph + 1; a.li = 0; hipLaunchKernelGGL(hyb_fwd, dim3(grid), dim3(NTHREADS), LDS_BYTES, stream, a); }
#endif
    const hipError_t le = hipPeekAtLastError();
    if (le != hipSuccess) fprintf(stderr, "kernel_launch: launch failed: %s\n", hipGetErrorName(le));
}
```

```cpp
#include <hip/hip_runtime.h>
#include <cstdio>
#include <cstdint>

template <int M> __device__ __forceinline__ int shx_i(int v) {
    if constexpr (M == 1) return __builtin_amdgcn_mov_dpp(v, 0xB1, 0xF, 0xF, true);
    else if constexpr (M == 2) return __builtin_amdgcn_mov_dpp(v, 0x4E, 0xF, 0xF, true);
    else return __builtin_amdgcn_ds_swizzle(v, (M << 10) | 0x1f);
}
template <int M> __device__ __forceinline__ float shx(float v) { return __int_as_float(shx_i<M>(__float_as_int(v))); }
__device__ __forceinline__ float sh32_sum(float v) { auto r = __builtin_amdgcn_permlane32_swap(__float_as_uint(v), __float_as_uint(v), false, false); return __uint_as_float(r[0]) + __uint_as_float(r[1]); }
__device__ __forceinline__ float sh32_max(float v) { auto r = __builtin_amdgcn_permlane32_swap(__float_as_uint(v), __float_as_uint(v), false, false); return fmaxf(__uint_as_float(r[0]), __uint_as_float(r[1])); }
__device__ __forceinline__ int sum32_i(int c) { c += shx_i<1>(c); c += shx_i<2>(c); c += shx_i<4>(c); c += shx_i<8>(c); c += shx_i<16>(c); return c; }
namespace pg8 {
#define PG8_LAS __attribute__((address_space(3)))
typedef unsigned short bf16_t;
typedef short bf16x8 __attribute__((ext_vector_type(8)));
typedef float f32x4 __attribute__((ext_vector_type(4)));
typedef unsigned u32x4 __attribute__((ext_vector_type(4)));
constexpr int BM = 256, BK = 64, HALF = 128, HTB = HALF * BK * 2  , STAGE_BYTES = 8 * HTB, NXCD = 8, WGM = 8;

__host__ __device__ __forceinline__ int lds_byte(int r, int c) { const int st = (r >> 4) * 2 + (c >> 5), rr = r & 15, cc = c & 31, ob = rr * 64 + cc * 2; return st * 1024 + (ob ^ (((ob >> 9) & 1) << 5)); }
__host__ __device__ __forceinline__ void stage_rc(int b, int& R, int& C) { const int st = b / 1024, sb = b % 1024, swz = sb ^ (((sb >> 9) & 1) << 5); R = (st >> 1) * 16 + swz / 64; C = (st & 1) * 32 + (swz % 64) / 2; }
__host__ __device__ __forceinline__ int perm32(int rho) { const int n = rho >> 4, i = rho & 15; return 8 * (i >> 2) + 4 * n + (i & 3); }

struct Unit { int pm, pn; };
struct Gemm { const bf16_t* A; const bf16_t* Bt; int M, N, K, lda; };

struct StaticOrder {
    int nM, nN, nwg, G, c;
    __host__ __device__ void init(int M, int N, int G_, int c_) { nM = M / BM; nN = N / BM; nwg = nM * nN; G = G_; c = c_; }
    __host__ __device__ bool next(int i, Unit& u) const {
        const long L = (long)i * G + c; if (L >= nwg) return false;
        int wgid = (int)L; { const int q = nwg / NXCD, r = nwg % NXCD, xcd = wgid % NXCD, off = wgid / NXCD; wgid = (xcd < r ? xcd * (q + 1) : r * (q + 1) + (xcd - r) * q) + off; }
        const int nig = WGM * nN, gid = wgid / nig, fm = gid * WGM, gsz = (nM - fm) < WGM ? (nM - fm) : WGM;
        u.pm = fm + ((wgid % nig) % gsz); u.pn = (wgid % nig) / gsz; return true;
    }
    __device__ __forceinline__ void a_ready(const Unit&) const {}
    __device__ __forceinline__ void done(const Unit&) const {}
};

__device__ __forceinline__ unsigned cvt_pk_bf16(float lo, float hi) { unsigned r; asm volatile("v_cvt_pk_bf16_f32 %0, %1, %2" : "=v"(r) : "v"(lo), "v"(hi)); return r; }
typedef float f32x2 __attribute__((ext_vector_type(2)));
constexpr float RMS_EPS_F = 1e-6f;
__device__ __forceinline__ float silu_f(float x) { return x * __builtin_amdgcn_rcpf(1.0f + __builtin_amdgcn_exp2f(-1.4426950408889634f * x)); }
__device__ __forceinline__ float row_rstd(const float* ssq, int row) {
    const f32x4* p = (const f32x4*)(ssq + (size_t)row * 16); const f32x4 a = p[0], b = p[1], c = p[2], d = p[3];
    const float s = ((a[0] + a[1]) + (a[2] + a[3])) + ((b[0] + b[1]) + (b[2] + b[3])) + ((c[0] + c[1]) + (c[2] + c[3])) + ((d[0] + d[1]) + (d[2] + d[3]));
    return rsqrtf(s * (1.0f / 1024.0f) + RMS_EPS_F); }

struct EpiSwiGLU {
    static constexpr bool PERM = true, AFTER_DRAIN = false;
    bf16_t* U; const float* ssq; int ldu;
    __device__ __forceinline__ void operator()(const f32x4 (&acc)[2][2][4][2], const Unit& u, int wr, int wc, int fr, int fq) const {
        const int row0 = u.pm * BM + wr * 64 + fr, col0 = u.pn * HALF + wc * 32 + 8 * fq;
#pragma unroll
        for (int ai = 0; ai < 2; ++ai)
#pragma unroll
            for (int m = 0; m < 4; ++m) {
                const int row = row0 + ai * HALF + m * 16; const float r = row_rstd(ssq, row);
                const f32x4 a0 = acc[ai][0][m][0] * r, a1 = acc[ai][0][m][1] * r, b0 = acc[ai][1][m][0] * r, b1 = acc[ai][1][m][1] * r;
                u32x4 w;
                w.x = cvt_pk_bf16(silu_f(a0[0]) * b0[0], silu_f(a0[1]) * b0[1]); w.y = cvt_pk_bf16(silu_f(a0[2]) * b0[2], silu_f(a0[3]) * b0[3]);
                w.z = cvt_pk_bf16(silu_f(a1[0]) * b1[0], silu_f(a1[1]) * b1[1]); w.w = cvt_pk_bf16(silu_f(a1[2]) * b1[2], silu_f(a1[3]) * b1[3]);
                *(u32x4*)(U + (size_t)row * ldu + col0) = w;
            }
    }
};
struct EpiResid {
    static constexpr bool PERM = true, AFTER_DRAIN = false;
    float* H; bf16_t* HB; float* ssq_out; float scale;
    __device__ __forceinline__ void operator()(const f32x4 (&acc)[2][2][4][2], const Unit& u, int wr, int wc, int fr, int fq) const {
        const int row0 = u.pm * BM + wr * 64 + fr, col0 = u.pn * BM + wc * 32 + 8 * fq;
#pragma unroll
        for (int ai = 0; ai < 2; ++ai)
#pragma unroll
            for (int m = 0; m < 4; ++m) {
                const int row = row0 + ai * HALF + m * 16; float sq = 0.f;
#pragma unroll
                for (int bj = 0; bj < 2; ++bj) {
                    float* hp = H + (size_t)row * 1024 + col0 + bj * HALF;
                    f32x4 h0 = *(const f32x4*)hp, h1 = *(const f32x4*)(hp + 4);
                    h0 = h0 + acc[ai][bj][m][0] * scale; h1 = h1 + acc[ai][bj][m][1] * scale;
                    *(f32x4*)hp = h0; *(f32x4*)(hp + 4) = h1;
                    sq += (h0[0] * h0[0] + h0[1] * h0[1]) + (h0[2] * h0[2] + h0[3] * h0[3]) + (h1[0] * h1[0] + h1[1] * h1[1]) + (h1[2] * h1[2] + h1[3] * h1[3]);
                    if (HB) { u32x4 w; w.x = cvt_pk_bf16(h0[0], h0[1]); w.y = cvt_pk_bf16(h0[2], h0[3]); w.z = cvt_pk_bf16(h1[0], h1[1]); w.w = cvt_pk_bf16(h1[2], h1[3]);
                        *(u32x4*)(HB + (size_t)row * 1024 + col0 + bj * HALF) = w; }
                }
                if (ssq_out) { sq += shx<16>(sq); sq = sh32_sum(sq); if (fq == 0) ssq_out[(size_t)row * 16 + u.pn * 4 + wc] = sq; }
            }
    }
};
struct EpiScale {
    static constexpr bool PERM = true, AFTER_DRAIN = false;
    bf16_t* O; int ldc; const float* ssq; int split_cols; size_t split_stride;
    __device__ __forceinline__ void operator()(const f32x4 (&acc)[2][2][4][2], const Unit& u, int wr, int wc, int fr, int fq) const {
        const int row0 = u.pm * BM + wr * 64 + fr; int colt = u.pn * BM; bf16_t* base = O;
        if (split_cols) { const int t = colt / split_cols; base += (size_t)t * split_stride; colt -= t * split_cols; }
        const int col0 = colt + wc * 32 + 8 * fq;
#pragma unroll
        for (int ai = 0; ai < 2; ++ai)
#pragma unroll
            for (int m = 0; m < 4; ++m) {
                const int row = row0 + ai * HALF + m * 16; const float r = row_rstd(ssq, row);
                bf16_t* rowp = base + (size_t)row * ldc + col0;
#pragma unroll
                for (int bj = 0; bj < 2; ++bj) { const f32x4 v0 = acc[ai][bj][m][0] * r, v1 = acc[ai][bj][m][1] * r;
                    u32x4 w; w.x = cvt_pk_bf16(v0[0], v0[1]); w.y = cvt_pk_bf16(v0[2], v0[3]); w.z = cvt_pk_bf16(v1[0], v1[1]); w.w = cvt_pk_bf16(v1[2], v1[3]);
                    *(u32x4*)(rowp + bj * HALF) = w; }
            }
    }
};
template <class Epi, class Sched, bool ALIGN_EPI = false, bool SP2 = false>
__device__ __forceinline__ void gemm_phase(PG8_LAS unsigned char* lds, const Gemm g, const Sched& S, const Epi& E, const int tid) {
    const int wid = __builtin_amdgcn_readfirstlane(tid >> 6), lane = tid & 63, wr = wid >> 2, wc = wid & 3, fr = lane & 15, fq = lane >> 4;
    const int K = g.K, nt = K / BK;
    unsigned voffA[2], voffB[2];
#pragma unroll
    for (int i = 0; i < 2; ++i) { int R, C; stage_rc(tid * 16 + i * 8192, R, C); const int Rb = Epi::PERM ? ((R & ~31) + perm32(R & 31)) : R;
        voffA[i] = (unsigned)(R * g.lda + C) * 2u; voffB[i] = (unsigned)(Rb * K + C) * 2u; }
    const size_t kstep = (size_t)(BK * 2);
    const size_t hstepA = (size_t)HALF * g.lda * 2, hstepB = (size_t)HALF * K * 2;
    const size_t tstepA = 2 * hstepA, tstepB = 2 * hstepB;
    const unsigned ldsw = (unsigned)wid * 1024u;
    const int aoff = lds_byte(wr * 64 + fr, fq * 8), boff = lds_byte(wc * 32 + fr, fq * 8);
#define PG8_SA(b, h) (((b) * 2 + (h)) * HTB)
#define PG8_SB(b, h) ((4 + (b) * 2 + (h)) * HTB)
#define PG8_STAGE(bufoff, gbase, voff) do { _Pragma("unroll") for (int _i = 0; _i < 2; ++_i) \
        __builtin_amdgcn_global_load_lds((const unsigned*)((const char*)(gbase) + (voff)[_i]), (PG8_LAS unsigned*)(lds + (bufoff) + ldsw + _i * 8192), 16, 0, 0); } while (0)
#define PG8_LDA(dst, b, h) do { _Pragma("unroll") for (int m = 0; m < 4; ++m) _Pragma("unroll") for (int k = 0; k < 2; ++k) dst[m][k] = *(const PG8_LAS bf16x8*)(lds + PG8_SA(b, h) + aoff + m * 2048 + k * 1024); } while (0)
#define PG8_LDB(dst, b, h) do { _Pragma("unroll") for (int n = 0; n < 2; ++n) _Pragma("unroll") for (int k = 0; k < 2; ++k) dst[n][k] = *(const PG8_LAS bf16x8*)(lds + PG8_SB(b, h) + boff + n * 2048 + k * 1024); } while (0)
#define PG8_MMA(ai, bj, At, Bt) do { __builtin_amdgcn_s_setprio(1); _Pragma("unroll") for (int m = 0; m < 4; ++m) _Pragma("unroll") for (int n = 0; n < 2; ++n) _Pragma("unroll") for (int k = 0; k < 2; ++k) \
        acc[ai][bj][m][n] = __builtin_amdgcn_mfma_f32_16x16x32_bf16(Bt[n][k], At[m][k], acc[ai][bj][m][n], 0, 0, 0); __builtin_amdgcn_s_setprio(0); } while (0)
#define PG8_WAIT_V(n) asm volatile("s_waitcnt vmcnt(" #n ")" ::: "memory")
#define PG8_WAIT_L(n) asm volatile("s_waitcnt lgkmcnt(" #n ")" ::: "memory")
#define PG8_BAR __builtin_amdgcn_s_barrier()
#define PG8_SCHED __builtin_amdgcn_sched_barrier(0)
    Unit cur, nxt; int ui = 0;
    if (!S.next(0, cur)) return;
    f32x4 acc[2][2][4][2];
#pragma unroll
    for (int a = 0; a < 2; ++a)
#pragma unroll
        for (int b = 0; b < 2; ++b)
#pragma unroll
            for (int m = 0; m < 4; ++m)
#pragma unroll
                for (int n = 0; n < 2; ++n) acc[a][b][m][n] = (f32x4){0.f, 0.f, 0.f, 0.f};
    bf16x8 At[4][2], B0[2][2], B1[2][2];
    const char* cA = (const char*)g.A + (size_t)cur.pm * tstepA; const char* cB = (const char*)g.Bt + (size_t)cur.pn * tstepB;
    S.a_ready(cur);
    if constexpr (SP2) {
        PG8_STAGE(PG8_SB(0, 0), cB, voffB); PG8_STAGE(PG8_SB(0, 1), cB + hstepB, voffB); PG8_STAGE(PG8_SA(0, 0), cA, voffA); PG8_STAGE(PG8_SA(0, 1), cA + hstepA, voffA);
        if (wr == 1) PG8_BAR;
        PG8_WAIT_V(2); PG8_BAR;
        PG8_STAGE(PG8_SB(1, 0), cB + kstep, voffB); PG8_STAGE(PG8_SA(1, 0), cA + kstep, voffA); PG8_STAGE(PG8_SB(1, 1), cB + hstepB + kstep, voffB);
        PG8_WAIT_V(6); PG8_BAR;
    } else {
        PG8_STAGE(PG8_SB(0, 0), cB, voffB); PG8_STAGE(PG8_SA(0, 0), cA, voffA); PG8_STAGE(PG8_SB(0, 1), cB + hstepB, voffB); PG8_STAGE(PG8_SA(0, 1), cA + hstepA, voffA);
        if (wr == 1) PG8_BAR;
        PG8_WAIT_V(4); PG8_BAR;
        PG8_STAGE(PG8_SB(1, 0), cB + kstep, voffB); PG8_STAGE(PG8_SA(1, 0), cA + kstep, voffA); PG8_STAGE(PG8_SB(1, 1), cB + hstepB + kstep, voffB);
        PG8_WAIT_V(6); PG8_BAR;
    }
    for (;;) {
        const bool has_next = S.next(ui + 1, nxt);
        const char* nA = has_next ? (const char*)g.A + (size_t)nxt.pm * tstepA : cA; const char* nB = has_next ? (const char*)g.Bt + (size_t)nxt.pn * tstepB : cB;
        for (int t = 0; t < nt; t += 2) {
            const bool last = (t == nt - 2);
            const char* a1 = cA + (size_t)(t + 1) * kstep;
            const char* a2 = last ? nA : cA + (size_t)(t + 2) * kstep; const char* b2 = last ? nB : cB + (size_t)(t + 2) * kstep;
            const char* a3 = a2 + kstep; const char* b3 = b2 + kstep;
            if (last && has_next) S.a_ready(nxt);
            if constexpr (SP2) {
            PG8_LDB(B0, 0, 0); PG8_LDB(B1, 0, 1); PG8_SCHED; PG8_LDA(At, 0, 0); PG8_STAGE(PG8_SA(1, 1), a1 + hstepA, voffA);
            PG8_WAIT_V(8); PG8_WAIT_L(0); PG8_BAR; PG8_MMA(0, 0, At, B0); PG8_MMA(0, 1, At, B1); PG8_BAR; PG8_SCHED;
            PG8_LDA(At, 0, 1); PG8_STAGE(PG8_SB(0, 0), b2, voffB); PG8_STAGE(PG8_SB(0, 1), b2 + hstepB, voffB); PG8_STAGE(PG8_SA(0, 0), a2, voffA);
            PG8_WAIT_V(8); PG8_WAIT_L(0); PG8_BAR; PG8_MMA(1, 0, At, B0); PG8_MMA(1, 1, At, B1); PG8_BAR; PG8_SCHED;
            PG8_LDB(B0, 1, 0); PG8_LDB(B1, 1, 1); PG8_SCHED; PG8_LDA(At, 1, 0); PG8_STAGE(PG8_SA(0, 1), a2 + hstepA, voffA);
            PG8_WAIT_V(8); PG8_WAIT_L(0); PG8_BAR; PG8_MMA(0, 0, At, B0); PG8_MMA(0, 1, At, B1); PG8_BAR; PG8_SCHED;
            PG8_LDA(At, 1, 1); PG8_STAGE(PG8_SB(1, 0), b3, voffB); PG8_STAGE(PG8_SB(1, 1), b3 + hstepB, voffB); PG8_STAGE(PG8_SA(1, 0), a3, voffA);
            PG8_WAIT_V(8); PG8_WAIT_L(0); PG8_BAR; PG8_MMA(1, 0, At, B0); PG8_MMA(1, 1, At, B1); PG8_BAR; PG8_SCHED;
            } else {
            PG8_LDB(B0, 0, 0); PG8_SCHED; PG8_LDA(At, 0, 0); PG8_STAGE(PG8_SA(1, 1), a1 + hstepA, voffA);
            PG8_WAIT_L(8); PG8_BAR; PG8_WAIT_L(0); PG8_MMA(0, 0, At, B0); PG8_BAR; PG8_SCHED;
            PG8_LDB(B1, 0, 1); PG8_STAGE(PG8_SB(0, 0), b2, voffB);
            PG8_BAR; PG8_WAIT_L(0); PG8_MMA(0, 1, At, B1); PG8_BAR;
            PG8_LDA(At, 0, 1); PG8_STAGE(PG8_SA(0, 0), a2, voffA);
            PG8_BAR; PG8_WAIT_L(0); PG8_MMA(1, 0, At, B0); PG8_BAR; PG8_SCHED;
            PG8_STAGE(PG8_SB(0, 1), b2 + hstepB, voffB);
            PG8_WAIT_V(6); PG8_BAR; PG8_MMA(1, 1, At, B1); PG8_BAR;
            PG8_LDB(B0, 1, 0); PG8_SCHED; PG8_LDA(At, 1, 0); PG8_STAGE(PG8_SA(0, 1), a2 + hstepA, voffA);
            PG8_WAIT_L(8); PG8_BAR; PG8_WAIT_L(0); PG8_MMA(0, 0, At, B0); PG8_BAR; PG8_SCHED;
            PG8_LDB(B1, 1, 1); PG8_STAGE(PG8_SB(1, 0), b3, voffB);
            PG8_BAR; PG8_WAIT_L(0); PG8_MMA(0, 1, At, B1); PG8_BAR;
            PG8_LDA(At, 1, 1); PG8_STAGE(PG8_SA(1, 0), a3, voffA);
            PG8_BAR; PG8_WAIT_L(0); PG8_MMA(1, 0, At, B0); PG8_BAR; PG8_SCHED;
            PG8_STAGE(PG8_SB(1, 1), b3 + hstepB, voffB);
            PG8_WAIT_V(6); PG8_BAR; PG8_MMA(1, 1, At, B1); PG8_BAR;
            }
        }
        if constexpr (ALIGN_EPI) { if (wr == 0) PG8_BAR; }
        if constexpr (!Epi::AFTER_DRAIN) { E(acc, cur, wr, wc, fr, fq); S.done(cur); }
        if (!has_next) break;
#pragma unroll
        for (int a = 0; a < 2; ++a)
#pragma unroll
            for (int b = 0; b < 2; ++b)
#pragma unroll
                for (int m = 0; m < 4; ++m)
#pragma unroll
                    for (int n = 0; n < 2; ++n) acc[a][b][m][n] = (f32x4){0.f, 0.f, 0.f, 0.f};
        cur = nxt; cA = nA; cB = nB; ++ui;
        if constexpr (ALIGN_EPI) { if (wr == 1) PG8_BAR; }
    }
    PG8_WAIT_V(0);
    if constexpr (!ALIGN_EPI) { if (wr == 0) PG8_BAR; }
    PG8_BAR;
    if constexpr (Epi::AFTER_DRAIN) { E.fused(acc, cur, wr, wc, fr, fq, lds, wid, lane); S.done(cur); }
#undef PG8_SA
#undef PG8_SB
#undef PG8_STAGE
#undef PG8_LDA
#undef PG8_LDB
#undef PG8_MMA
#undef PG8_WAIT_V
#undef PG8_WAIT_L
#undef PG8_BAR
#undef PG8_SCHED
}
}

constexpr int S = 16384, DM = 1024, FF = 2816, FF2 = 5632, EVEN_SRC = 3664, EVEN_NP = 3840, ODD_N = 3072, NLAYER = 2, MEMT = 256, MEMW = 256;
constexpr float RMS_EPS = 1e-6f;
constexpr float LOG2E = 1.4426950408889634f;
constexpr float C2 = 0.125f * LOG2E;
constexpr int NWAVES = 8, NTHREADS = 512;
constexpr int EC_FQ = 0, EC_DQ = 512, EC_FK = 1024, EC_DK = 1536, EC_FV = 2048, EC_DV = 2560, EC_IQ = 3072, EC_IK = 3584;
constexpr int ES_FQ = 0, ES_FK = 512, ES_FV = 1024, ES_FL = 1536, ES_DQ = 1544, ES_DK = 2056, ES_DV = 2568, ES_IQ = 3080, ES_IK = 3592, ES_IW = 3656;

constexpr size_t MiB = 1u << 20;
constexpr size_t WS_CTL = 0, CTL_ZERO_BYTES = 1 * MiB;
constexpr size_t WS_SSQ = 1 * MiB;
constexpr size_t WS_KSUM = 6 * MiB;
constexpr size_t WS_ROPE = 2 * MiB;
constexpr size_t WS_FL = 3 * MiB;
constexpr size_t WS_MEMK = 4 * MiB;
constexpr size_t WS_IW = 5 * MiB;
constexpr size_t WS_W = 12 * MiB;
constexpr size_t WS_BIG = 60 * MiB;
constexpr size_t WS_HB = 224 * MiB;
constexpr size_t WS_END = 256 * MiB;
constexpr size_t W_FFN1_IN = 0, W_FFN1_OUT = 11 * MiB, W_MIX_IN = 17 * MiB, W_MIX_OUT = 25 * MiB, W_MEMQ = 27 * MiB, W_MEMO = 28 * MiB, W_FFN2_IN = 29 * MiB, W_FFN2_OUT = 40 * MiB;
constexpr size_t B_U = 0;
constexpr size_t B_PROJ = 0;
constexpr size_t B_VTF = 120 * MiB;
constexpr size_t B_IKC = 136 * MiB;
constexpr size_t B_VTM = 96 * MiB;
constexpr size_t B_SEL = 156 * MiB;
constexpr size_t B_QM = 140 * MiB, B_OM = 148 * MiB;
constexpr int CW_TMO = 0, CW_CODE = 1, CW_BAR = 4096;

constexpr int RING_BYTES = 147456;
constexpr int LDSCTL_OFF = RING_BYTES, MISC_OFF = LDSCTL_OFF + 320;
constexpr int LDS_BYTES = 163840;

#define GAS __attribute__((address_space(1)))
#define LAS __attribute__((address_space(3)))
typedef unsigned short bf16;
typedef unsigned v4u __attribute__((ext_vector_type(4)));
typedef float f32x4 __attribute__((ext_vector_type(4)));
typedef short bf16x8 __attribute__((ext_vector_type(8)));
typedef GAS unsigned gu32;
typedef GAS unsigned long long gu64;
#define RLX_AGENT __ATOMIC_RELAXED, __HIP_MEMORY_SCOPE_AGENT
#define LDS_WAIT() asm volatile("s_waitcnt lgkmcnt(0)" ::: "memory")
#define VM_WAIT() asm volatile("s_waitcnt vmcnt(0)" ::: "memory")
__device__ __forceinline__ unsigned long long rt() { return __builtin_amdgcn_s_memrealtime(); }
__device__ __forceinline__ unsigned f2bf(float f) { unsigned u = __builtin_bit_cast(unsigned, f); return (u + 0x7fffu + ((u >> 16) & 1u)) >> 16; }
__device__ __forceinline__ unsigned pk2(float lo, float hi) { return f2bf(lo) | (f2bf(hi) << 16); }

#define XB_TMO      128
#define XB_XCNT(j)  (256  + 64 * (j))
#define XB_XSUB(j)  (1280 + 64 * (j))
#define XB_XGEN(j)  (2304 + 64 * (j))
#define XB_TOP      3328
#define XB_TOPGEN   3392
#define XCD_BAR_WORDS 3456
#define XB_SPIN_CAP (1u << 18)

__device__ __forceinline__ unsigned xb_ld(unsigned* p)              { return __hip_atomic_load(p, __ATOMIC_RELAXED, __HIP_MEMORY_SCOPE_AGENT); }
__device__ __forceinline__ unsigned xb_add(unsigned* p, unsigned v) { return __hip_atomic_fetch_add(p, v, __ATOMIC_RELAXED, __HIP_MEMORY_SCOPE_AGENT); }
__device__ __forceinline__ unsigned xb_xcc_id() { return (unsigned)__builtin_amdgcn_s_getreg((3 << 11) | 20) & 0xFu; }
#define XB_SPIN(cond, bar) do { unsigned _sp = 0; while (cond) { __builtin_amdgcn_s_sleep(1); \
    if ((++_sp & 255u) == 0u) { if (xb_ld(&(bar)[XB_TMO])) break; if (_sp > XB_SPIN_CAP) { atomicAdd(&(bar)[XB_TMO], 1u); break; } } } } while (0)

struct XcdBarrier {
    unsigned* bar; unsigned x;
    volatile LAS unsigned* st;
};

__device__ __forceinline__ XcdBarrier xcd_barrier_post(unsigned* bar, volatile LAS unsigned* st) {
    XcdBarrier b; b.bar = bar; b.x = xb_xcc_id(); b.st = st;
    if (threadIdx.x == 0) (void)xb_add(&bar[XB_XCNT(b.x)], 1u);
    return b;
}
__device__ __forceinline__ void xcd_barrier_complete(unsigned* bar, unsigned x, unsigned& nloc, unsigned& nx) {
    const unsigned G = gridDim.x * gridDim.y * gridDim.z;
    unsigned sum, cnt, mine, sp = 0u;
    for (;;) {
        sum = 0u; cnt = 0u; mine = 0u;
#pragma unroll
        for (unsigned j = 0; j < 16; ++j) { const unsigned c = xb_ld(&bar[XB_XCNT(j)]); sum += c; cnt += (c > 0u) ? 1u : 0u; mine = (j == x) ? c : mine; }
        if (sum == G) break;
        __builtin_amdgcn_s_sleep(1);
        if ((++sp & 255u) == 0u) { if (xb_ld(&bar[XB_TMO])) break; if (sp > XB_SPIN_CAP) { atomicAdd(&bar[XB_TMO], 1u); break; } }
    }
    nloc = mine > 0u ? mine : 1u; nx = cnt > 0u ? cnt : 1u;
}

__device__ __forceinline__ void xcd_barrier(const XcdBarrier& b) {
    asm volatile("s_waitcnt vmcnt(0)" ::: "memory");
    __syncthreads();
    if (threadIdx.x == 0) {
        unsigned* bar = b.bar;
        __builtin_amdgcn_s_waitcnt(0);
        unsigned nloc = b.st[0], nx = b.st[1];
        if (nloc == 0u) { xcd_barrier_complete(bar, b.x, nloc, nx); b.st[0] = nloc; b.st[1] = nx; }
        const unsigned old = xb_add(&bar[XB_XSUB(b.x)], 1u);
        const unsigned gen = old / nloc;
        if (old + 1u == (gen + 1u) * nloc) {
            __builtin_amdgcn_fence(__ATOMIC_RELEASE, "agent");
            asm volatile("s_waitcnt vmcnt(0)" ::: "memory");
            const unsigned og = xb_add(&bar[XB_TOP], 1u);
            const unsigned tg = og / nx;
            if (og + 1u == (tg + 1u) * nx) xb_add(&bar[XB_TOPGEN], 1u);
            else XB_SPIN(xb_ld(&bar[XB_TOPGEN]) == tg, bar);
            __builtin_amdgcn_fence(__ATOMIC_ACQUIRE, "agent");
            xb_add(&bar[XB_XGEN(b.x)], 1u);
            asm volatile("s_waitcnt vmcnt(0)" ::: "memory");
        } else {
            XB_SPIN(xb_ld(&bar[XB_XGEN(b.x)]) == gen, bar);
            __builtin_amdgcn_fence(__ATOMIC_ACQUIRE, "agent");
            asm volatile("s_waitcnt vmcnt(0)" ::: "memory");
        }
    }
    __syncthreads();
}

typedef float f32x16 __attribute__((ext_vector_type(16)));
typedef float f32x2_t __attribute__((ext_vector_type(2)));
typedef __bf16 bf16x2_t __attribute__((ext_vector_type(2)));
typedef unsigned u32x2 __attribute__((ext_vector_type(2)));
__device__ __forceinline__ unsigned cvtpk(float lo, float hi) { f32x2_t v = {lo, hi}; bf16x2_t b = __builtin_convertvector(v, bf16x2_t); return __builtin_bit_cast(unsigned, b); }
__device__ __forceinline__ float bflo(unsigned w) { return __uint_as_float(w << 16); }
__device__ __forceinline__ float bfhi(unsigned w) { return __uint_as_float(w & 0xffff0000u); }
__device__ __forceinline__ void unpack8(const v4u& w, float (&x)[8]) { x[0] = bflo(w.x); x[1] = bfhi(w.x); x[2] = bflo(w.y); x[3] = bfhi(w.y); x[4] = bflo(w.z); x[5] = bfhi(w.z); x[6] = bflo(w.w); x[7] = bfhi(w.w); }
__device__ __forceinline__ v4u pack8(const float (&x)[8]) { v4u w; w.x = cvtpk(x[0], x[1]); w.y = cvtpk(x[2], x[3]); w.z = cvtpk(x[4], x[5]); w.w = cvtpk(x[6], x[7]); return w; }
__device__ __forceinline__ float wave_sum(float v) { v += shx<1>(v); v += shx<2>(v); v += shx<4>(v); v += shx<8>(v); v += shx<16>(v); return sh32_sum(v); }
__device__ __forceinline__ float wave_max(float v) { v = fmaxf(v, shx<1>(v)); v = fmaxf(v, shx<2>(v)); v = fmaxf(v, shx<4>(v)); v = fmaxf(v, shx<8>(v)); v = fmaxf(v, shx<16>(v)); return sh32_max(v); }
__device__ __forceinline__ int crow(int r, int hi) { return (r & 3) + 8 * (r >> 2) + 4 * hi; }

__device__ __forceinline__ int even_map(int n) {
    if (n < 512) return ES_FQ + n;
    if (n < 1024) return ES_DQ + (n - 512);
    if (n < 1536) return ES_FK + (n - 1024);
    if (n < 2048) return ES_DK + (n - 1536);
    if (n < 2560) return ES_FV + (n - 2048);
    if (n < 3072) return ES_DV + (n - 2560);
    if (n < 3584) return ES_IQ + (n - 3072);
    if (n < 3648) return ES_IK + (n - 3584);
    return -1;
}
__device__ __forceinline__ void conv_item(const float* W, int K, int Nsrc, int nblk, const float* gain, bf16* WT, int mode, LAS float* scr, int item, int lane) {
    const int kb = item / nblk, nb = item % nblk, k0 = 64 * kb, n0 = 32 * nb;
    const int n = n0 + (lane & 31);
    int sc;
    if (mode == 0) sc = n; else if (mode == 1) { const int T = n >> 8, hf = (n >> 7) & 1, j = n & 127; sc = hf * FF + 128 * T + j; } else sc = even_map(n);
#pragma unroll 8
    for (int i = 0; i < 32; ++i) { const int kk = 2 * i + (lane >> 5); float v = 0.f;
        if (sc >= 0) { v = W[(size_t)(k0 + kk) * Nsrc + sc]; if (gain) v *= gain[k0 + kk]; }
        scr[kk * 33 + (lane & 31)] = v; }
    LDS_WAIT(); asm volatile("" ::: "memory");
    const int c = lane & 7;
#pragma unroll
    for (int j = 0; j < 4; ++j) { const int nn = (lane >> 3) + 8 * j; const LAS float* s = scr + (8 * c) * 33 + nn;
        v4u o; o.x = cvtpk(s[0 * 33], s[1 * 33]); o.y = cvtpk(s[2 * 33], s[3 * 33]); o.z = cvtpk(s[4 * 33], s[5 * 33]); o.w = cvtpk(s[6 * 33], s[7 * 33]);
        *(GAS v4u*)(WT + (size_t)(n0 + nn) * K + k0 + 8 * c) = o; }
    LDS_WAIT(); asm volatile("" ::: "memory");
}
struct InPtrs { const float* p[26]; };
__device__ __forceinline__ void conv_weights(const InPtrs& in, unsigned char* ws, int L, LAS unsigned char* lds, int gw, int NGW, int wave, int lane) {
    LAS float* scr = (LAS float*)(lds + wave * 16384);
    bf16* Wr = (bf16*)(ws + WS_W);
    const float* ffn1_norm = in.p[2] + (size_t)L * DM; const float* ffn1_in = in.p[3] + (size_t)L * DM * FF2; const float* ffn1_out = in.p[4] + (size_t)L * FF * DM;
    const float* mix_norm = in.p[5] + (size_t)L * DM; const float* mix_out = in.p[15] + (size_t)L * DM * DM;
    const float* memx_norm = in.p[16] + (size_t)L * DM; const float* mem_wq = in.p[18] + (size_t)L * DM * MEMW; const float* mem_wo = in.p[22] + (size_t)L * MEMW * DM;
    const float* ffn2_norm = in.p[23] + (size_t)L * DM; const float* ffn2_in = in.p[24] + (size_t)L * DM * FF2; const float* ffn2_out = in.p[25] + (size_t)L * FF * DM;
    const bool even = (L & 1) == 0;
    const float* mix_in = even ? in.p[6] : in.p[12];
    const int mixN = even ? EVEN_NP : ODD_N, mixSrc = even ? EVEN_SRC : ODD_N;
    const int I_FIN = (DM / 64) * (FF2 / 32), I_FOUT = (FF / 64) * (DM / 32), I_MIN = (DM / 64) * (mixN / 32), I_MOUT = (DM / 64) * (DM / 32), I_MQ = (DM / 64) * (MEMW / 32), I_MO = (MEMW / 64) * (DM / 32);
    const int NITEMS = 2 * I_FIN + 2 * I_FOUT + I_MIN + I_MOUT + I_MQ + I_MO;
    for (int it = gw; it < NITEMS; it += NGW) {
        int r = it;
        if (r < I_FIN) { conv_item(ffn1_in, DM, FF2, FF2 / 32, ffn1_norm, (bf16*)((unsigned char*)Wr + W_FFN1_IN), 1, scr, r, lane); continue; } r -= I_FIN;
        if (r < I_FIN) { conv_item(ffn2_in, DM, FF2, FF2 / 32, ffn2_norm, (bf16*)((unsigned char*)Wr + W_FFN2_IN), 1, scr, r, lane); continue; } r -= I_FIN;
        if (r < I_FOUT) { conv_item(ffn1_out, FF, DM, DM / 32, nullptr, (bf16*)((unsigned char*)Wr + W_FFN1_OUT), 0, scr, r, lane); continue; } r -= I_FOUT;
        if (r < I_FOUT) { conv_item(ffn2_out, FF, DM, DM / 32, nullptr, (bf16*)((unsigned char*)Wr + W_FFN2_OUT), 0, scr, r, lane); continue; } r -= I_FOUT;
        if (r < I_MIN) { conv_item(mix_in, DM, mixSrc, mixN / 32, mix_norm, (bf16*)((unsigned char*)Wr + W_MIX_IN), even ? 2 : 0, scr, r, lane); continue; } r -= I_MIN;
        if (r < I_MOUT) { conv_item(mix_out, DM, DM, DM / 32, nullptr, (bf16*)((unsigned char*)Wr + W_MIX_OUT), 0, scr, r, lane); continue; } r -= I_MOUT;
        if (r < I_MQ) { conv_item(mem_wq, DM, MEMW, MEMW / 32, memx_norm, (bf16*)((unsigned char*)Wr + W_MEMQ), 0, scr, r, lane); continue; } r -= I_MQ;
        conv_item(mem_wo, MEMW, DM, DM / 32, nullptr, (bf16*)((unsigned char*)Wr + W_MEMO), 0, scr, r, lane);
    }
}
__device__ __forceinline__ void copy_x(const float* x, float* out, bf16* HB, float* ssq0, int gw, int NGW, int lane) {
    for (int m = gw; m < S; m += NGW) {
        const GAS f32x4* xr = (const GAS f32x4*)(x + (size_t)m * DM) + lane; GAS f32x4* orow = (GAS f32x4*)(out + (size_t)m * DM) + lane;
        GAS u32x2* hb = (GAS u32x2*)(HB + (size_t)m * DM) + lane;
        float s = 0.f;
#pragma unroll
        for (int j = 0; j < 4; ++j) { const f32x4 v = xr[64 * j]; orow[64 * j] = v; s += (v.x * v.x + v.y * v.y) + (v.z * v.z + v.w * v.w);
            u32x2 w; w.x = cvtpk(v.x, v.y); w.y = cvtpk(v.z, v.w); hb[64 * j] = w; }
        s = wave_sum(s);
        if (lane < 16) ssq0[(size_t)m * 16 + lane] = (lane == 0) ? s : 0.f;
    }
}
__device__ __forceinline__ void rope_tables(float* cosT, float* sinT, int gtid, int nthreads) {
    for (int idx = gtid; idx < S * 8; idx += nthreads) {
        const int t = idx >> 3, j = idx & 7;
        float inv;
        switch (j) { case 0: inv = 1.0f; break; case 1: inv = 0.193922743f; break; case 2: inv = 0.0376060307f; break; case 3: inv = 0.00729266461f; break;
                     case 4: inv = 0.00141421356f; break; case 5: inv = 0.000274248188f; break; case 6: inv = 5.3182961e-05f; break; default: inv = 1.03133862e-05f; break; }
        const float ang = (float)t * inv;
        const float kq = __builtin_rintf(ang * 0.63661977236758134f);
        float r = ang - kq * 1.5703125f; r = r - kq * 0.00048351287841796875f; r = r - kq * 3.1391647326017846e-07f;
        const float r2 = r * r;
        float sp = 2.7557319e-6f; sp = sp * r2 - 1.9841270e-4f; sp = sp * r2 + 8.3333333e-3f; sp = sp * r2 - 1.6666667e-1f; const float sn = r + r * r2 * sp;
        float cp = -2.7557319e-7f; cp = cp * r2 + 2.4801587e-5f; cp = cp * r2 - 1.3888889e-3f; cp = cp * r2 + 4.1666667e-2f; cp = cp * r2 - 0.5f; const float cs = 1.0f + r2 * cp;
        const int q = ((int)kq) & 3;
        const float sv = (q == 0) ? sn : (q == 1) ? cs : (q == 2) ? -sn : -cs;
        const float cv = (q == 0) ? cs : (q == 1) ? -sn : (q == 2) ? -cs : sn;
        cosT[idx] = cv; sinT[idx] = sv;
    }
}
__device__ __forceinline__ void mem_kv(const InPtrs& in, unsigned char* ws, LAS unsigned char* lds, int w, int tid, int wave, int lane) {
    LAS float* memn = (LAS float*)lds;
    LAS float* red = (LAS float*)(lds + 4096);
    bf16* memK = (bf16*)(ws + WS_MEMK); bf16* memVt = (bf16*)(ws + WS_MEMK + 256 * 1024);
    for (int L = 0; L < NLAYER; ++L) {
        const float* mrow = in.p[1] + (size_t)w * DM; const float* gm = in.p[17] + (size_t)L * DM; const float* wkv = in.p[19] + (size_t)L * DM * 512; const float* kn = in.p[21] + (size_t)L * 64;
        const float x0 = mrow[tid], x1 = mrow[tid + 512];
        float s = wave_sum(x0 * x0 + x1 * x1);
        if (lane == 0) red[wave] = s;
        __syncthreads();
        float tot = 0.f;
#pragma unroll
        for (int i = 0; i < 8; ++i) tot += red[i];
        const float rstd = rsqrtf(tot * (1.0f / DM) + RMS_EPS);
        memn[tid] = x0 * rstd * gm[tid]; memn[tid + 512] = x1 * rstd * gm[tid + 512];
        __syncthreads();
        float acc = 0.f;
#pragma unroll 8
        for (int k = 0; k < DM; ++k) acc += memn[k] * wkv[(size_t)k * 512 + tid];
        if (tid < 256) {
            const float ss = wave_sum(acc * acc);
            const float y = acc * rsqrtf(ss * (1.0f / 64.0f) + RMS_EPS) * kn[tid & 63];
            memK[(size_t)L * 256 * 256 + (size_t)w * 256 + tid] = (bf16)(cvtpk(y, 0.f) & 0xffffu);
        } else {
            const int c = tid - 256;
            memVt[(size_t)L * 256 * 256 + (size_t)c * 256 + w] = (bf16)(cvtpk(acc, 0.f) & 0xffffu);
        }
        __syncthreads();
    }
}

__device__ __forceinline__ void head_norm8(float (&x)[8], const float* gain, int lane) {
    float ss = 0.f;
#pragma unroll
    for (int j = 0; j < 8; ++j) ss += x[j] * x[j];
    ss += shx<1>(ss); ss += shx<2>(ss); ss += shx<4>(ss);
    const float r = rsqrtf(ss * (1.0f / 64.0f) + RMS_EPS);
    const int d0 = 8 * (lane & 7);
#pragma unroll
    for (int j = 0; j < 8; ++j) x[j] = x[j] * r * gain[d0 + j];
}
__device__ __forceinline__ void rope8(float (&x)[8], const float (&cs)[8], const float (&sn)[8], int lane) {
    const int sub = lane & 7;
#pragma unroll
    for (int j = 0; j < 8; ++j) {
        const float other = shx<1>(x[j]);
        if (sub == 0) x[j] = x[j] * cs[j] - other * sn[j];
        else if (sub == 1) x[j] = x[j] * cs[j] + other * sn[j];
    }
}
__device__ __forceinline__ float sh32_get(float v, int lane) { auto r = __builtin_amdgcn_permlane32_swap(__float_as_uint(v), __float_as_uint(v), false, false); return __uint_as_float((lane < 32) ? r[1] : r[0]); }
__device__ __forceinline__ float reduce_scatter64(float (&v)[64], int lane) {
    { const bool up = (lane & 32) != 0;
#pragma unroll
      for (int j = 0; j < 32; ++j) { const float send = up ? v[j] : v[j + 32], keep = up ? v[j + 32] : v[j]; v[j] = keep + sh32_get(send, lane); } }
    { const bool up = (lane & 16) != 0;
#pragma unroll
      for (int j = 0; j < 16; ++j) { const float send = up ? v[j] : v[j + 16], keep = up ? v[j + 16] : v[j]; v[j] = keep + shx<16>(send); } }
    { const bool up = (lane & 8) != 0;
#pragma unroll
      for (int j = 0; j < 8; ++j) { const float send = up ? v[j] : v[j + 8], keep = up ? v[j + 8] : v[j]; v[j] = keep + shx<8>(send); } }
    { const bool up = (lane & 4) != 0;
#pragma unroll
      for (int j = 0; j < 4; ++j) { const float send = up ? v[j] : v[j + 4], keep = up ? v[j + 4] : v[j]; v[j] = keep + shx<4>(send); } }
    { const bool up = (lane & 2) != 0;
#pragma unroll
      for (int j = 0; j < 2; ++j) { const float send = up ? v[j] : v[j + 2], keep = up ? v[j + 2] : v[j]; v[j] = keep + shx<2>(send); } }
    { const bool up = (lane & 1) != 0; const float send = up ? v[0] : v[1], keep = up ? v[1] : v[0]; v[0] = keep + shx<1>(send); }
    return v[0];
}
__device__ __forceinline__ void post_even(const InPtrs& in, unsigned char* ws, const float* H, const float* ssq, LAS unsigned char* lds, int G, int tid, int wave, int lane) {
    bf16* proj = (bf16*)(ws + WS_BIG + B_PROJ); bf16* VtF = (bf16*)(ws + WS_BIG + B_VTF); bf16* IKc = (bf16*)(ws + WS_BIG + B_IKC);
    const float* cosT = (const float*)(ws + WS_ROPE); const float* sinT = cosT + S * 8;
    float* Flocal = (float*)(ws + WS_FL); float* Btot = Flocal + S * 8; float* IW = (float*)(ws + WS_IW);
    const float* fqn = in.p[8]; const float* fkn = in.p[9]; const float* dqn = in.p[10]; const float* dkn = in.p[11]; const float* bfg = in.p[7];
    const float* Wsrc = in.p[6]; const float* mixg = in.p[5];
    constexpr int FVP = 1040;
    LAS f32x4* Tw = (LAS f32x4*)lds;
    LAS unsigned char* fvbuf = lds + 65536; LAS float* lf = (LAS float*)(lds + 65536 + 64 * FVP);
    for (int idx = tid; idx < 1024 * 16; idx += NTHREADS) {
        const int k = idx >> 4, col = idx & 15;
        const float v = mixg[k] * Wsrc[(size_t)k * EVEN_SRC + (col < 8 ? ES_FL + col : ES_IW + col - 8)];
        const int ln = (k & 255) >> 2, e = k & 3, q = k >> 8, c = col >> 2;
        ((LAS float*)Tw)[((((q * 4 + e) * 4 + c) * 64 + ln) << 2) + (col & 3)] = v;
    }
    __syncthreads();
    const int d0 = 8 * (lane & 7);
    for (int u = blockIdx.x; u < S / 64; u += G) {
        const int t0 = u * 64, tw0 = t0 + wave * 8;
        bf16* rowb = proj + (size_t)tw0 * EVEN_NP + lane * 8;
        v4u raw[8];
#pragma unroll
        for (int sec = 0; sec < 5; ++sec) {
            const int coff = (sec == 0) ? EC_FQ : (sec == 1) ? EC_DQ : (sec == 2) ? EC_FK : (sec == 3) ? EC_DK : EC_IQ;
            const float* gn = (sec == 0) ? fqn : (sec == 1) ? dqn : (sec == 2) ? fkn : dkn;
            float gv[8];
            if (sec < 4) {
#pragma unroll
                for (int j = 0; j < 8; ++j) gv[j] = gn[d0 + j]; }
#pragma unroll
            for (int i = 0; i < 8; ++i) raw[i] = *(const GAS v4u*)(rowb + (size_t)i * EVEN_NP + coff);
#pragma unroll
            for (int i = 0; i < 8; ++i) {
                float x[8]; unpack8(raw[i], x);
                if (sec < 4) { float ss = 0.f;
#pragma unroll
                    for (int j = 0; j < 8; ++j) ss += x[j] * x[j];
                    ss += shx<1>(ss); ss += shx<2>(ss); ss += shx<4>(ss);
                    const float r = rsqrtf(ss * (1.0f / 64.0f) + RMS_EPS);
#pragma unroll
                    for (int j = 0; j < 8; ++j) x[j] = x[j] * r * gv[j]; }
                if (sec == 1 || sec == 3 || sec == 4) { float cs[8], sn[8]; const int t = tw0 + i;
#pragma unroll
                    for (int j = 0; j < 8; ++j) { cs[j] = cosT[t * 8 + j]; sn[j] = sinT[t * 8 + j]; }
                    rope8(x, cs, sn, lane); }
                *(GAS v4u*)(rowb + (size_t)i * EVEN_NP + coff) = pack8(x);
            }
        }
#pragma unroll
        for (int i = 0; i < 8; ++i) raw[i] = *(const GAS v4u*)(rowb + (size_t)i * EVEN_NP + EC_FV);
#pragma unroll
        for (int i = 0; i < 8; ++i) *(LAS v4u*)(fvbuf + (wave * 8 + i) * FVP + lane * 16) = raw[i];
#pragma unroll
        for (int i = 0; i < 8; ++i) { raw[i] = (v4u){0u, 0u, 0u, 0u}; if (lane < 8) raw[i] = *(const GAS v4u*)(rowb + (size_t)i * EVEN_NP + EC_IK); }
#pragma unroll
        for (int i = 0; i < 8; ++i) { float x[8]; unpack8(raw[i], x); float cs[8], sn[8]; const int t = tw0 + i;
#pragma unroll
            for (int j = 0; j < 8; ++j) { cs[j] = cosT[t * 8 + j]; sn[j] = sinT[t * 8 + j]; }
            rope8(x, cs, sn, lane);
            if (lane < 8) *(GAS v4u*)(IKc + ((size_t)((t >> 5) * 4 + (lane >> 1)) * 64 + (lane & 1) * 32 + (t & 31)) * 8) = pack8(x); }
#pragma unroll 1
        for (int rb = 0; rb < 2; ++rb) {
            float acc[64];
#pragma unroll
            for (int j = 0; j < 64; ++j) acc[j] = 0.f;
#pragma unroll
            for (int q = 0; q < 4; ++q) {
                f32x4 hv[4];
#pragma unroll
                for (int r = 0; r < 4; ++r) hv[r] = *((const GAS f32x4*)(H + (size_t)(tw0 + rb * 4 + r) * DM) + lane + 64 * q);
#pragma unroll
                for (int e = 0; e < 4; ++e)
#pragma unroll
                    for (int c = 0; c < 4; ++c) { const f32x4 w = Tw[((q * 4 + e) * 4 + c) * 64 + lane];
#pragma unroll
                        for (int r = 0; r < 4; ++r) { acc[r * 16 + 4 * c + 0] += hv[r][e] * w[0]; acc[r * 16 + 4 * c + 1] += hv[r][e] * w[1]; acc[r * 16 + 4 * c + 2] += hv[r][e] * w[2]; acc[r * 16 + 4 * c + 3] += hv[r][e] * w[3]; } }
            }
            const float zs = reduce_scatter64(acc, lane);
            const int rl = wave * 8 + rb * 4 + (lane >> 4), t = t0 + rl, j = lane & 15;
            const float z = zs * pg8::row_rstd(ssq, t);
            if (j < 8) { const float zz = z + bfg[j]; lf[rl * 8 + j] = (zz > 15.f) ? -expf(-zz) : -log1pf(expf(-zz)); }
            else IW[(size_t)t * 8 + (j - 8)] = z * 0.044194173824159216f;
        }
        __syncthreads();
        {
            float v = lf[lane * 8 + wave];
#pragma unroll
            for (int o = 1; o < 64; o <<= 1) { const float up = __int_as_float(__builtin_amdgcn_ds_bpermute(((lane - o) & 63) << 2, __float_as_int(v))); if (lane >= o) v += up; }
            Flocal[(size_t)(t0 + lane) * 8 + wave] = v;
            if (lane == 63) Btot[u * 8 + wave] = v;
        }
#pragma unroll 2
        for (int p = 0; p < 8; ++p) {
            const int item = p * 512 + tid, c = item >> 3, k = item & 7;
            unsigned short e[8];
#pragma unroll
            for (int j = 0; j < 8; ++j) e[j] = *(const LAS unsigned short*)(fvbuf + (8 * k + j) * FVP + c * 2);
            v4u o; o.x = e[0] | ((unsigned)e[1] << 16); o.y = e[2] | ((unsigned)e[3] << 16); o.z = e[4] | ((unsigned)e[5] << 16); o.w = e[6] | ((unsigned)e[7] << 16);
            *(GAS v4u*)(VtF + (size_t)c * S + t0 + 8 * k) = o;
        }
        __syncthreads();
    }
}
__device__ __forceinline__ void post_odd(const InPtrs& in, unsigned char* ws, LAS unsigned char* lds, int G, int tid, int wave, int lane) {
    bf16* Q = (bf16*)(ws + WS_BIG + B_PROJ); bf16* Kb = Q + (size_t)S * DM; bf16* V = Kb + (size_t)S * DM; bf16* Vt = (bf16*)(ws + WS_BIG + B_VTM);
    const float* cosT = (const float*)(ws + WS_ROPE); const float* sinT = cosT + S * 8;
    float* ksum = (float*)(ws + WS_KSUM);
    const float* qn = in.p[13]; const float* kn = in.p[14];
    constexpr int VP = 1040;
    LAS unsigned char* vbuf = lds; LAS float* kred = (LAS float*)(lds + 64 * VP);
    for (int u = blockIdx.x; u < S / 64; u += G) {
        const int t0 = u * 64;
        float ks0[8], ks1[8];
#pragma unroll
        for (int j = 0; j < 8; ++j) { ks0[j] = 0.f; ks1[j] = 0.f; }
        const int tw0 = t0 + wave * 8, d0 = 8 * (lane & 7);
        v4u raw[8];
#pragma unroll
        for (int sec4 = 0; sec4 < 4; ++sec4) {
            const bool isk = sec4 >= 2; const int sec = sec4 & 1;
            bf16* base = (isk ? Kb : Q) + (size_t)tw0 * DM + sec * 512 + lane * 8;
            const float* gn = isk ? kn : qn;
            float gv[8];
#pragma unroll
            for (int j = 0; j < 8; ++j) gv[j] = gn[d0 + j];
#pragma unroll
            for (int i = 0; i < 8; ++i) raw[i] = *(const GAS v4u*)(base + (size_t)i * DM);
#pragma unroll
            for (int i = 0; i < 8; ++i) {
                float x[8]; unpack8(raw[i], x); float ss = 0.f;
#pragma unroll
                for (int j = 0; j < 8; ++j) ss += x[j] * x[j];
                ss += shx<1>(ss); ss += shx<2>(ss); ss += shx<4>(ss);
                const float r = rsqrtf(ss * (1.0f / 64.0f) + RMS_EPS);
#pragma unroll
                for (int j = 0; j < 8; ++j) x[j] = x[j] * r * gv[j];
                float cs[8], sn[8]; const int t = tw0 + i;
#pragma unroll
                for (int j = 0; j < 8; ++j) { cs[j] = cosT[t * 8 + j]; sn[j] = sinT[t * 8 + j]; }
                rope8(x, cs, sn, lane);
                *(GAS v4u*)(base + (size_t)i * DM) = pack8(x);
                if (isk) {
#pragma unroll
                    for (int j = 0; j < 8; ++j) { if (sec == 0) ks0[j] += x[j]; else ks1[j] += x[j]; } }
            }
        }
#pragma unroll
        for (int j = 0; j < 8; ++j) { kred[wave * 1024 + lane * 8 + j] = ks0[j]; kred[wave * 1024 + 512 + lane * 8 + j] = ks1[j]; }
        __syncthreads();
        {
#pragma unroll
            for (int e = 0; e < 2; ++e) { const int c = tid + 512 * e; float s = 0.f;
#pragma unroll
                for (int w8 = 0; w8 < 8; ++w8) s += kred[w8 * 1024 + c];
                ksum[(size_t)u * 1024 + c] = s; }
        }
        for (int half = 0; half < 2; ++half) {
#pragma unroll
            for (int i = 0; i < 8; ++i) raw[i] = *(const GAS v4u*)(V + (size_t)(tw0 + i) * DM + half * 512 + lane * 8);
#pragma unroll
            for (int i = 0; i < 8; ++i) *(LAS v4u*)(vbuf + (wave * 8 + i) * VP + lane * 16) = raw[i];
            __syncthreads();
#pragma unroll 2
            for (int p = 0; p < 8; ++p) {
                const int item = p * 512 + tid, c = item >> 3, k = item & 7;
                unsigned short e[8];
#pragma unroll
                for (int j = 0; j < 8; ++j) e[j] = *(const LAS unsigned short*)(vbuf + (8 * k + j) * VP + c * 2);
                v4u o; o.x = e[0] | ((unsigned)e[1] << 16); o.y = e[2] | ((unsigned)e[3] << 16); o.z = e[4] | ((unsigned)e[5] << 16); o.w = e[6] | ((unsigned)e[7] << 16);
                *(GAS v4u*)(Vt + (size_t)(half * 512 + c) * S + t0 + 8 * k) = o;
            }
            __syncthreads();
        }
    }
}

constexpr int KV_K_BYTES = 8192, KV_VT_PITCH = 136, KV_BUF_BYTES = KV_K_BYTES + 64 * KV_VT_PITCH;
struct KVRegs { v4u k, v; };
__device__ __forceinline__ void kv_load(KVRegs& r, const bf16* Kp, size_t kpitch, const bf16* Vtp, size_t vtpitch, int key0, int tid) {
    r.k = *(const GAS v4u*)(Kp + (size_t)(key0 + (tid & 63)) * kpitch + (tid >> 6) * 8);
    r.v = *(const GAS v4u*)(Vtp + (size_t)(tid >> 3) * vtpitch + key0 + (tid & 7) * 8);
}
__device__ __forceinline__ void kv_store(const KVRegs& r, LAS unsigned char* buf, int tid) {
    *(LAS v4u*)(buf + ((tid >> 6) * 64 + (tid & 63)) * 16) = r.k;
    LAS unsigned char* vp = buf + KV_K_BYTES + (tid >> 3) * KV_VT_PITCH + (tid & 7) * 16;
    *(LAS u32x2*)vp = (u32x2){r.v.x, r.v.y}; *(LAS u32x2*)(vp + 8) = (u32x2){r.v.z, r.v.w};
}
struct AttnAcc { float m, l; f32x16 o0, o1; };
__device__ __forceinline__ void attn_init(AttnAcc& a) { a.m = -INFINITY; a.l = 0.f;
#pragma unroll
    for (int r = 0; r < 16; ++r) { a.o0[r] = 0.f; a.o1[r] = 0.f; } }
template <int CHS = 1024>
__device__ __forceinline__ void attn_scores(f32x16& p0, f32x16& p1, const LAS unsigned char* buf, const bf16x8 (&qf)[4], int lane) {
    const int r32 = lane & 31, hi = lane >> 5;
#pragma unroll
    for (int r = 0; r < 16; ++r) { p0[r] = 0.f; p1[r] = 0.f; }
#pragma unroll
    for (int ks = 0; ks < 4; ++ks) {
        const bf16x8 k0 = *(const LAS bf16x8*)(buf + (2 * ks + hi) * CHS + r32 * 16);
        const bf16x8 k1 = *(const LAS bf16x8*)(buf + (2 * ks + hi) * CHS + (32 + r32) * 16);
        p0 = __builtin_amdgcn_mfma_f32_32x32x16_bf16(k0, qf[ks], p0, 0, 0, 0);
        p1 = __builtin_amdgcn_mfma_f32_32x32x16_bf16(k1, qf[ks], p1, 0, 0, 0);
    }
}
template <int VTP = KV_VT_PITCH, int VOFF = KV_K_BYTES>
__device__ __forceinline__ void attn_update(AttnAcc& a, f32x16& p0, f32x16& p1, const LAS unsigned char* buf, int lane) {
    const int r32 = lane & 31, hi = lane >> 5;
    float mx = fmaxf(p0[0], p1[0]);
#pragma unroll
    for (int r = 1; r < 16; ++r) mx = fmaxf(mx, fmaxf(p0[r], p1[r]));
    mx = sh32_max(mx);
    const float mnew = fmaxf(a.m, mx);
    const float msafe = (mnew == -INFINITY) ? 0.f : mnew;
    const float alpha = __builtin_amdgcn_exp2f(a.m - msafe);
    float sum = 0.f;
#pragma unroll
    for (int r = 0; r < 16; ++r) { p0[r] = __builtin_amdgcn_exp2f(p0[r] - msafe); p1[r] = __builtin_amdgcn_exp2f(p1[r] - msafe); sum += p0[r] + p1[r]; }
    a.l = a.l * alpha + sum; a.m = mnew;
#pragma unroll
    for (int r = 0; r < 16; ++r) { a.o0[r] *= alpha; a.o1[r] *= alpha; }
    const LAS unsigned char* vt = buf + VOFF + r32 * VTP + hi * 8;
#pragma unroll
    for (int half = 0; half < 2; ++half) {
#pragma unroll
        for (int s = 0; s < 2; ++s) {
            v4u pw;
            if (half == 0) { pw.x = cvtpk(p0[8 * s + 0], p0[8 * s + 1]); pw.y = cvtpk(p0[8 * s + 2], p0[8 * s + 3]); pw.z = cvtpk(p0[8 * s + 4], p0[8 * s + 5]); pw.w = cvtpk(p0[8 * s + 6], p0[8 * s + 7]); }
            else           { pw.x = cvtpk(p1[8 * s + 0], p1[8 * s + 1]); pw.y = cvtpk(p1[8 * s + 2], p1[8 * s + 3]); pw.z = cvtpk(p1[8 * s + 4], p1[8 * s + 5]); pw.w = cvtpk(p1[8 * s + 6], p1[8 * s + 7]); }
            const bf16x8 pb = __builtin_bit_cast(bf16x8, pw);
            const int kb = (32 * half + 16 * s) * 2;
#pragma unroll
            for (int d0 = 0; d0 < 2; ++d0) {
                const u32x2 lo = *(const LAS u32x2*)(vt + d0 * 32 * VTP + kb), hi2 = *(const LAS u32x2*)(vt + d0 * 32 * VTP + kb + 16);
                const bf16x8 va = __builtin_bit_cast(bf16x8, (v4u){lo.x, lo.y, hi2.x, hi2.y});
                if (d0 == 0) a.o0 = __builtin_amdgcn_mfma_f32_32x32x16_bf16(va, pb, a.o0, 0, 0, 0);
                else         a.o1 = __builtin_amdgcn_mfma_f32_32x32x16_bf16(va, pb, a.o1, 0, 0, 0);
            }
        }
    }
}
__device__ __forceinline__ void attn_store(const AttnAcc& a, bf16* orow, int lane) {
    const int hi = lane >> 5;
    float l = sh32_sum(a.l);
    const float inv = (l > 0.f) ? 1.0f / l : 0.f;
#pragma unroll
    for (int g = 0; g < 4; ++g) {
        u32x2 w0, w1;
        w0.x = cvtpk(a.o0[4 * g] * inv, a.o0[4 * g + 1] * inv); w0.y = cvtpk(a.o0[4 * g + 2] * inv, a.o0[4 * g + 3] * inv);
        w1.x = cvtpk(a.o1[4 * g] * inv, a.o1[4 * g + 1] * inv); w1.y = cvtpk(a.o1[4 * g + 2] * inv, a.o1[4 * g + 3] * inv);
        *(GAS u32x2*)(orow + 8 * g + 4 * hi) = w0; *(GAS u32x2*)(orow + 32 + 8 * g + 4 * hi) = w1;
    }
}
__device__ __forceinline__ void load_q(bf16x8 (&qf)[4], const bf16* qrow, int lane) {
    const int hi = lane >> 5;
#pragma unroll
    for (int ks = 0; ks < 4; ++ks) qf[ks] = *(const GAS bf16x8*)(qrow + 16 * ks + 8 * hi);
}

constexpr int CW_FOXQ = 64;
__device__ __forceinline__ void fox_phase(const InPtrs& in, unsigned char* ws, LAS unsigned char* lds, int G, int tid, int wave, int lane, bf16* obase, size_t opitch, int qword) {
    bf16* proj = (bf16*)(ws + WS_BIG + B_PROJ); const bf16* VtF = (const bf16*)(ws + WS_BIG + B_VTF);
    const float* Flocal = (const float*)(ws + WS_FL); const float* Btot = Flocal + S * 8;
    unsigned* qctr = (unsigned*)(ws + WS_CTL) + qword;
    LAS unsigned char* kvb = lds; LAS float* kbt = (LAS float*)(lds + 2 * KV_BUF_BYTES); LAS float* bt = (LAS float*)(lds + 2 * KV_BUF_BYTES + 65536); LAS float* Et = bt + 272;
    LAS int* misc = (LAS int*)(Et + 272);
    const int r32 = lane & 31, hi = lane >> 5;
    if (wave == 0) { const float gq = wave_max(fabsf(in.p[8][lane])), gk = wave_max(fabsf(in.p[9][lane])); if (lane == 0) { ((LAS float*)misc)[2] = gq; ((LAS float*)misc)[3] = gk; } }
    __syncthreads();
    const float THR = 2.0f * (0.125f * LOG2E * 64.0f * 1.02f) * ((LAS float*)misc)[2] * ((LAS float*)misc)[3] + 32.0f;
    for (;;) {
        __syncthreads();
        if (tid == 0) misc[0] = (int)atomicAdd(qctr, 1u);
        __syncthreads();
        const int u = misc[0];
        if (u >= 512) break;
        const int QB = 63 - (u >> 3), h = u & 7, q0 = QB * 256, nt = 4 * (QB + 1);
        for (int j = tid; j < nt; j += NTHREADS) bt[j] = Btot[j * 8 + h];
        if (tid == 0) misc[1] = 4 * QB;
        __syncthreads();
        for (int j = tid; j <= nt; j += NTHREADS) { float e = 0.f;
            if (j <= 4 * QB) { for (int i = 4 * QB - 1; i >= j; --i) e -= bt[i]; } else { for (int i = 4 * QB; i < j; ++i) e += bt[i]; }
            Et[j] = e; }
        __syncthreads();
        for (int j = tid; j < 4 * QB; j += NTHREADS) if (Et[j + 1] * LOG2E <= THR) atomicMin((int*)&misc[1], j);
        __syncthreads();
        const int t_start = misc[1], s0 = 64 * t_start;
        for (int s = s0 + tid; s < q0 + 256; s += NTHREADS) kbt[s - s0] = -(Et[s >> 6] + Flocal[(size_t)s * 8 + h]) * LOG2E;
        const int qrow = q0 + wave * 32 + r32;
        bf16x8 qf[4]; load_q(qf, proj + (size_t)qrow * EVEN_NP + EC_FQ + h * 64, lane);
        AttnAcc a; attn_init(a);
        const bf16* Kp = proj + EC_FK + h * 64; const bf16* Vtp = VtF + (size_t)h * 64 * S;
        KVRegs kr; kv_load(kr, Kp, EVEN_NP, Vtp, S, s0, tid); kv_store(kr, kvb, tid);
        __syncthreads();
        const float kbw = kbt[q0 + wave * 32 - s0];
        for (int t = t_start; t < nt; ++t) {
            LAS unsigned char* cur = kvb + ((t - t_start) & 1) * KV_BUF_BYTES;
            if (t + 1 < nt) kv_load(kr, Kp, EVEN_NP, Vtp, S, (t + 1) * 64, tid);
            const int key0 = t * 64;
            const bool vis = key0 <= q0 + wave * 32 + 31;
            const bool live = (key0 + 63 >= q0) || (kbw - kbt[key0 + 63 - s0] <= THR);
            if (vis && __builtin_amdgcn_readfirstlane((int)live)) {
                f32x16 p0, p1; attn_scores(p0, p1, cur, qf, lane);
#pragma unroll
                for (int g = 0; g < 4; ++g) {
                    const f32x4 b0 = *(const LAS f32x4*)(kbt + key0 - s0 + 8 * g + 4 * hi), b1 = *(const LAS f32x4*)(kbt + key0 - s0 + 32 + 8 * g + 4 * hi);
#pragma unroll
                    for (int e = 0; e < 4; ++e) { p0[4 * g + e] = p0[4 * g + e] * C2 + b0[e]; p1[4 * g + e] = p1[4 * g + e] * C2 + b1[e]; }
                }
                if (key0 + 63 > q0 + wave * 32) {
#pragma unroll
                    for (int r = 0; r < 16; ++r) { const int kv = key0 + crow(r, hi); if (kv > qrow) p0[r] = -INFINITY; if (kv + 32 > qrow) p1[r] = -INFINITY; }
                }
                attn_update(a, p0, p1, cur, lane);
            }
            if (t + 1 < nt) kv_store(kr, kvb + ((t + 1 - t_start) & 1) * KV_BUF_BYTES, tid);
            __syncthreads();
        }
        attn_store(a, obase + (size_t)qrow * opitch + h * 64, lane);
    }
}

__device__ __forceinline__ void memattn_phase(const InPtrs& in, unsigned char* ws, int L, LAS unsigned char* lds, int G, int tid, int wave, int lane) {
    const bf16* QM = (const bf16*)(ws + WS_BIG + B_QM); bf16* OM = (bf16*)(ws + WS_BIG + B_OM);
    const bf16* memK = (const bf16*)(ws + WS_MEMK) + (size_t)L * 256 * 256; const bf16* memVt = (const bf16*)(ws + WS_MEMK + 256 * 1024) + (size_t)L * 256 * 256;
    const float* qn = in.p[20] + (size_t)L * 64;
    LAS unsigned char* kvb = lds;
    const int r32 = lane & 31, hi = lane >> 5;
    for (int un = blockIdx.x; un < 256; un += G) {
        const int QB = un >> 2, hm = un & 3, qrow = QB * 256 + wave * 32 + r32;
        bf16x8 qf[4];
        {
            const bf16* qp = QM + (size_t)qrow * MEMW + hm * 64; float x[4][8]; float ss = 0.f;
#pragma unroll
            for (int ks = 0; ks < 4; ++ks) { const v4u w = *(const GAS v4u*)(qp + 16 * ks + 8 * hi); unpack8(w, x[ks]);
#pragma unroll
                for (int j = 0; j < 8; ++j) ss += x[ks][j] * x[ks][j]; }
            ss = sh32_sum(ss);
            const float r = rsqrtf(ss * (1.0f / 64.0f) + RMS_EPS);
#pragma unroll
            for (int ks = 0; ks < 4; ++ks) {
#pragma unroll
                for (int j = 0; j < 8; ++j) x[ks][j] = x[ks][j] * r * qn[16 * ks + 8 * hi + j];
                qf[ks] = __builtin_bit_cast(bf16x8, pack8(x[ks])); }
        }
        AttnAcc a; attn_init(a);
        const bf16* Kp = memK + hm * 64; const bf16* Vtp = memVt + (size_t)hm * 64 * 256;
        __syncthreads();
        KVRegs kr; kv_load(kr, Kp, 256, Vtp, 256, 0, tid); kv_store(kr, kvb, tid);
        __syncthreads();
        for (int t = 0; t < 4; ++t) {
            LAS unsigned char* cur = kvb + (t & 1) * KV_BUF_BYTES;
            if (t + 1 < 4) kv_load(kr, Kp, 256, Vtp, 256, (t + 1) * 64, tid);
            f32x16 p0, p1; attn_scores(p0, p1, cur, qf, lane);
#pragma unroll
            for (int r = 0; r < 16; ++r) { p0[r] *= C2; p1[r] *= C2; }
            attn_update(a, p0, p1, cur, lane);
            if (t + 1 < 4) kv_store(kr, kvb + ((t + 1) & 1) * KV_BUF_BYTES, tid);
            __syncthreads();
        }
        attn_store(a, OM + (size_t)qrow * MEMW + hm * 64, lane);
    }
}

constexpr size_t WS_MSEL = 7 * MiB;
constexpr size_t WS_MLSE = 8 * MiB;
constexpr size_t B_OP0 = 64 * MiB, B_OP1 = 128 * MiB;
__device__ __forceinline__ bool gate_better(float g1, int n1, float g2, int n2) { return g1 > g2 || (g1 == g2 && n1 < n2); }
__device__ __forceinline__ void moba_gate_phase(unsigned char* ws, int G, int wave, int lane) {
    const bf16* Q = (const bf16*)(ws + WS_BIG + B_PROJ); const float* ksum = (const float*)(ws + WS_KSUM); unsigned* selg = (unsigned*)(ws + WS_MSEL);
    const int r32 = lane & 31, hi = lane >> 5;
    const int NW = G * NWAVES;
    const int gwid = (int)blockIdx.x * NWAVES + wave;
    const int per_head = NW / 16;
    if (per_head == 0) return;
    const int h = gwid / per_head, wi = gwid % per_head;
    if (h >= 16) return;
    float af[2][32];
#pragma unroll
    for (int g = 0; g < 2; ++g)
#pragma unroll
        for (int kk = 0; kk < 32; ++kk) { const float* kp = ksum + (size_t)(32 * g + r32) * 4096 + h * 64 + 2 * kk + hi;
            af[g][kk] = ((kp[0] + kp[1024]) + (kp[2048] + kp[3072])) * (1.0f / 256.0f); }
    for (int tile = wi; tile < S / 32; tile += per_head) {
        const int t = tile * 32 + r32, own = (tile * 32) >> 8;
        float bq[32];
        { const bf16* qp = Q + (size_t)t * DM + h * 64;
#pragma unroll
          for (int c = 0; c < 8; ++c) { const unsigned sh = hi ? 0u : 16u;   const v4u w = *(const GAS v4u*)(qp + 8 * c);
              bq[4 * c + 0] = __uint_as_float((w.x << sh) & 0xffff0000u); bq[4 * c + 1] = __uint_as_float((w.y << sh) & 0xffff0000u);
              bq[4 * c + 2] = __uint_as_float((w.z << sh) & 0xffff0000u); bq[4 * c + 3] = __uint_as_float((w.w << sh) & 0xffff0000u); } }
        float g0 = -INFINITY, g1 = -INFINITY, g2 = -INFINITY; int n0 = 255, n1 = 255, n2 = 255;
#pragma unroll
        for (int g = 0; g < 2; ++g) {
            if (32 * g < own) {
                f32x16 c;
#pragma unroll
                for (int r = 0; r < 16; ++r) c[r] = 0.f;
#pragma unroll
                for (int kk = 0; kk < 32; ++kk) c = __builtin_amdgcn_mfma_f32_32x32x2f32(af[g][kk], bq[kk], c, 0, 0, 0);
#pragma unroll
                for (int r = 0; r < 16; ++r) { const int n = 32 * g + crow(r, hi); const float gv = (n < own) ? c[r] : -INFINITY;
                    if (n < own) {
                        if (gate_better(gv, n, g0, n0)) { g2 = g1; n2 = n1; g1 = g0; n1 = n0; g0 = gv; n0 = n; }
                        else if (gate_better(gv, n, g1, n1)) { g2 = g1; n2 = n1; g1 = gv; n1 = n; }
                        else if (gate_better(gv, n, g2, n2)) { g2 = gv; n2 = n; } } }
            }
        }
        const float p0 = sh32_get(g0, lane), p1 = sh32_get(g1, lane), p2 = sh32_get(g2, lane);
        const int pn0 = __float_as_int(sh32_get(__int_as_float(n0), lane)), pn1 = __float_as_int(sh32_get(__int_as_float(n1), lane)), pn2 = __float_as_int(sh32_get(__int_as_float(n2), lane));
        float fg[3]; int fn[3]; int ia = 0, ib = 0;
#pragma unroll
        for (int k = 0; k < 3; ++k) {
            const float ga = (ia == 0) ? g0 : (ia == 1) ? g1 : (ia == 2) ? g2 : -INFINITY; const int na = (ia == 0) ? n0 : (ia == 1) ? n1 : (ia == 2) ? n2 : 255;
            const float gb = (ib == 0) ? p0 : (ib == 1) ? p1 : (ib == 2) ? p2 : -INFINITY; const int nb = (ib == 0) ? pn0 : (ib == 1) ? pn1 : (ib == 2) ? pn2 : 255;
            const bool ta = (na != 255) && (nb == 255 || gate_better(ga, na, gb, nb));
            if (ta) { fg[k] = ga; fn[k] = na; ++ia; } else { fg[k] = gb; fn[k] = nb; ++ib; }
        }
        (void)fg;
        if (hi == 0) selg[(size_t)h * S + t] = (unsigned)(fn[0] & 255) | ((unsigned)(fn[1] & 255) << 8) | ((unsigned)(fn[2] & 255) << 16);
    }
}
constexpr int MR_KIMG = 32768, MR_VTP = 520, MR_VIMG = 64 * MR_VTP;
__device__ __forceinline__ void moba_route_phase(unsigned char* ws, LAS unsigned char* lds, int G, int tid, int wave, int lane) {
    const bf16* Q = (const bf16*)(ws + WS_BIG + B_PROJ); const bf16* Kb = Q + (size_t)S * DM; const bf16* Vt = (const bf16*)(ws + WS_BIG + B_VTM);
    const unsigned* selg = (const unsigned*)(ws + WS_MSEL); float* lse = (float*)(ws + WS_MLSE);
    LAS unsigned char* kimg = lds; LAS unsigned char* vimg = lds + MR_KIMG;
    LAS int* list = (LAS int*)(lds + MR_KIMG + MR_VIMG);
    LAS int* wtot = list + 2048;
    const int r32 = lane & 31, hi = lane >> 5;
    const int NUNITS = 16 * 280;
    for (int u = blockIdx.x; u < NUNITS; u += G) {
        int c = 0, rem = u;
        while (rem >= 16 * (8 * c + 7)) { rem -= 16 * (8 * c + 7); ++c; }
        const int n = rem >> 4, h = rem & 15;
        const int tlo = max(2048 * c, 256 * (n + 1));
        __syncthreads();
        int myent[4]; bool mysel[4];
#pragma unroll
        for (int i = 0; i < 4; ++i) { const int t = 2048 * c + 512 * i + tid; mysel[i] = false; myent[i] = 0;
            if (t >= tlo) { const unsigned w = selg[(size_t)h * S + t];
                const int slot = ((w & 255u) == (unsigned)n) ? 0 : (((w >> 8) & 255u) == (unsigned)n) ? 1 : (((w >> 16) & 255u) == (unsigned)n) ? 2 : -1;
                if (slot >= 0) { mysel[i] = true; myent[i] = t | (slot << 16); } }
            const unsigned long long mk = __ballot(mysel[i]);
            if (lane == 0) wtot[i * 8 + wave] = __popcll(mk); }
        __syncthreads();
        int cnt = 0;
#pragma unroll
        for (int i = 0; i < 4; ++i) { int base = cnt;
#pragma unroll
            for (int w8 = 0; w8 < 8; ++w8) { const int v = wtot[i * 8 + w8]; if (w8 < wave) base += v; cnt += v; }
            const unsigned long long mk = __ballot(mysel[i]);
            if (mysel[i]) list[base + __popcll(mk & ((1ull << lane) - 1ull))] = myent[i]; }
        { const bf16* Kp = Kb + (size_t)(256 * n) * DM + h * 64; const bf16* Vp = Vt + (size_t)h * 64 * S + 256 * n;
#pragma unroll
          for (int i = 0; i < 4; ++i) { const int piece = tid + 512 * i, key = piece & 255, ch = piece >> 8;
              const v4u kv = *(const GAS v4u*)(Kp + (size_t)key * DM + ch * 8); *(LAS v4u*)(kimg + (ch * 256 + key) * 16) = kv;
              const int d = piece >> 5, c16 = piece & 31;
              const v4u vv = *(const GAS v4u*)(Vp + (size_t)d * S + c16 * 8); LAS unsigned char* vp = vimg + d * MR_VTP + c16 * 16;
              *(LAS u32x2*)vp = (u32x2){vv.x, vv.y}; *(LAS u32x2*)(vp + 8) = (u32x2){vv.z, vv.w}; } }
        __syncthreads();
        if (cnt == 0) continue;
        const int ntile = (cnt + 31) >> 5;
        for (int ti = wave; ti < ntile; ti += NWAVES) {
            const int e = ti * 32 + r32; const bool live = e < cnt;
            const int ent = list[live ? e : 0]; const int t = ent & 0xffff, slot = ent >> 16;
            bf16x8 qf[4]; load_q(qf, Q + (size_t)t * DM + h * 64, lane);
            AttnAcc a; attn_init(a);
#pragma unroll 1
            for (int j = 0; j < 4; ++j) {
                f32x16 p0, p1; attn_scores<4096>(p0, p1, kimg + j * 64 * 16, qf, lane);
#pragma unroll
                for (int r = 0; r < 16; ++r) { p0[r] *= C2; p1[r] *= C2; }
                attn_update<MR_VTP, 0>(a, p0, p1, vimg + j * 128, lane);
            }
            const float l = sh32_sum(a.l); const float inv = 1.0f / l;
            if (live) {
                bf16* orow = (bf16*)(ws + (slot == 0 ? WS_BIG + B_OP0 : slot == 1 ? WS_BIG + B_OP1 : WS_HB)) + ((size_t)t * 16 + h) * 64;
#pragma unroll
                for (int g = 0; g < 4; ++g) { u32x2 w0, w1;
                    w0.x = cvtpk(a.o0[4 * g] * inv, a.o0[4 * g + 1] * inv); w0.y = cvtpk(a.o0[4 * g + 2] * inv, a.o0[4 * g + 3] * inv);
                    w1.x = cvtpk(a.o1[4 * g] * inv, a.o1[4 * g + 1] * inv); w1.y = cvtpk(a.o1[4 * g + 2] * inv, a.o1[4 * g + 3] * inv);
                    *(GAS u32x2*)(orow + 8 * g + 4 * hi) = w0; *(GAS u32x2*)(orow + 32 + 8 * g + 4 * hi) = w1; }
                if (hi == 0) lse[((size_t)slot * S + t) * 16 + h] = a.m + __builtin_amdgcn_logf(l);
            }
        }
    }
}
__device__ __forceinline__ void moba_own_phase(unsigned char* ws, LAS unsigned char* lds, int G, int tid, int wave, int lane) {
    bf16* Q = (bf16*)(ws + WS_BIG + B_PROJ); const bf16* Kb = Q + (size_t)S * DM; const bf16* Vt = (const bf16*)(ws + WS_BIG + B_VTM);
    const unsigned* selg = (const unsigned*)(ws + WS_MSEL); const float* lse = (const float*)(ws + WS_MLSE);
    LAS unsigned char* kvb = lds;
    const int r32 = lane & 31, hi = lane >> 5;
    for (int un = blockIdx.x; un < 1024; un += G) {
        const int h = un & 15, QB = un >> 4, q0 = QB * 256, qrow = q0 + wave * 32 + r32;
        bf16x8 qf[4]; load_q(qf, Q + (size_t)qrow * DM + h * 64, lane);
        AttnAcc a; attn_init(a);
        const bf16* Kp = Kb + h * 64; const bf16* Vtp = Vt + (size_t)h * 64 * S;
        __syncthreads();
        KVRegs kr; kv_load(kr, Kp, DM, Vtp, S, q0, tid); kv_store(kr, kvb, tid);
        __syncthreads();
        for (int t = 0; t < 4; ++t) {
            LAS unsigned char* cur = kvb + (t & 1) * KV_BUF_BYTES;
            const int key0 = q0 + t * 64;
            if (t + 1 < 4) kv_load(kr, Kp, DM, Vtp, S, key0 + 64, tid);
            if (key0 <= q0 + wave * 32 + 31) {
                f32x16 p0, p1; attn_scores(p0, p1, cur, qf, lane);
#pragma unroll
                for (int r = 0; r < 16; ++r) { const int kv = key0 + crow(r, hi); p0[r] = (kv > qrow) ? -INFINITY : p0[r] * C2; p1[r] = (kv + 32 > qrow) ? -INFINITY : p1[r] * C2; }
                attn_update(a, p0, p1, cur, lane);
            }
            if (t + 1 < 4) kv_store(kr, kvb + ((t + 1) & 1) * KV_BUF_BYTES, tid);
            __syncthreads();
        }
        const unsigned sw = selg[(size_t)h * S + qrow];
        float L[3];
#pragma unroll
        for (int j = 0; j < 3; ++j) L[j] = (((sw >> (8 * j)) & 255u) != 255u) ? lse[((size_t)j * S + qrow) * 16 + h] : -INFINITY;
        const float M = fmaxf(fmaxf(a.m, L[0]), fmaxf(L[1], L[2]));
        const float so = __builtin_amdgcn_exp2f(a.m - M);
        float W = sh32_sum(a.l) * so;
#pragma unroll
        for (int r = 0; r < 16; ++r) { a.o0[r] *= so; a.o1[r] *= so; }
#pragma unroll
        for (int j = 0; j < 3; ++j) {
            if (L[j] != -INFINITY) {
                const float wj = __builtin_amdgcn_exp2f(L[j] - M); W += wj;
                const bf16* orow = (const bf16*)(ws + (j == 0 ? WS_BIG + B_OP0 : j == 1 ? WS_BIG + B_OP1 : WS_HB)) + ((size_t)qrow * 16 + h) * 64;
#pragma unroll
                for (int g = 0; g < 4; ++g) { const u32x2 w0 = *(const GAS u32x2*)(orow + 8 * g + 4 * hi), w1 = *(const GAS u32x2*)(orow + 32 + 8 * g + 4 * hi);
                    a.o0[4 * g] += wj * bflo(w0.x); a.o0[4 * g + 1] += wj * bfhi(w0.x); a.o0[4 * g + 2] += wj * bflo(w0.y); a.o0[4 * g + 3] += wj * bfhi(w0.y);
                    a.o1[4 * g] += wj * bflo(w1.x); a.o1[4 * g + 1] += wj * bfhi(w1.x); a.o1[4 * g + 2] += wj * bflo(w1.y); a.o1[4 * g + 3] += wj * bfhi(w1.y); }
            }
        }
        const float inv = 1.0f / W;
        bf16* orow = Q + (size_t)qrow * DM + h * 64;
#pragma unroll
        for (int g = 0; g < 4; ++g) { u32x2 w0, w1;
            w0.x = cvtpk(a.o0[4 * g] * inv, a.o0[4 * g + 1] * inv); w0.y = cvtpk(a.o0[4 * g + 2] * inv, a.o0[4 * g + 3] * inv);
            w1.x = cvtpk(a.o1[4 * g] * inv, a.o1[4 * g + 1] * inv); w1.y = cvtpk(a.o1[4 * g + 2] * inv, a.o1[4 * g + 3] * inv);
            *(GAS u32x2*)(orow + 8 * g + 4 * hi) = w0; *(GAS u32x2*)(orow + 32 + 8 * g + 4 * hi) = w1; }
    }
}

typedef float f32x4v __attribute__((ext_vector_type(4)));
__device__ __forceinline__ unsigned mono_key(float s) { if (s == 0.f) s = 0.f; const unsigned u = __float_as_uint(s); return (u & 0x80000000u) ? ~u : (u | 0x80000000u); }
constexpr int DS_CAP = 512;
__device__ __forceinline__ unsigned wave_or(unsigned v) { v |= (unsigned)shx_i<1>((int)v); v |= (unsigned)shx_i<2>((int)v); v |= (unsigned)shx_i<4>((int)v); v |= (unsigned)shx_i<8>((int)v); v |= (unsigned)shx_i<16>((int)v);
    auto r = __builtin_amdgcn_permlane32_swap(v, v, false, false); return r[0] | r[1]; }
template <bool EXACT>
__device__ __forceinline__ unsigned dsa_compact(LAS u32x2* ent, int n, int& nkeep, int lane) {
    unsigned k[8]; unsigned ix[8]; unsigned orv = 0u, nandv = 0u;
#pragma unroll
    for (int j = 0; j < 8; ++j) { const int e = lane + 64 * j; const bool in = e < n; const u32x2 v = ent[in ? e : 0]; k[j] = in ? v.x : 0u; ix[j] = v.y; orv |= k[j]; nandv |= in ? ~v.x : 0u; }
    unsigned T = 0u; int cntT = n; int bit0 = 31;
    if (!EXACT) {
        const unsigned diff = (unsigned)__builtin_amdgcn_readfirstlane((int)(wave_or(orv) & wave_or(nandv)));
        if (diff != 0u) { bit0 = 31 - __builtin_clz(diff); const unsigned anyk = (unsigned)__builtin_amdgcn_readfirstlane((int)k[0]);
            T = (bit0 == 31) ? 0u : (anyk & ~((2u << bit0) - 1u)); }
    }
    for (int bit = bit0; bit >= 0; --bit) {
        const unsigned cand = T | (1u << bit); int c = 0;
#pragma unroll
        for (int j = 0; j < 8; ++j) c += __popcll(__ballot(k[j] >= cand));
        if (c >= 256) { T = cand; cntT = c; if (!EXACT && c <= 320) break; }
    }
    int Jstar = 0x10000;
    if (cntT > (EXACT ? 256 : 320)) {
        int gt = 0;
#pragma unroll
        for (int j = 0; j < 8; ++j) gt += __popcll(__ballot(k[j] > T));
        const int need = 256 - gt; int Jm = 0;
        for (int bit = 14; bit >= 0; --bit) { const int cand = Jm | (1 << bit); int c = 0;
#pragma unroll
            for (int j = 0; j < 8; ++j) c += __popcll(__ballot(k[j] == T && (int)ix[j] < cand));
            if (c < need) Jm = cand; }
        Jstar = Jm + 1;
    }
    int base = 0;
    const unsigned long long lt = (1ull << lane) - 1ull;
#pragma unroll
    for (int j = 0; j < 8; ++j) { const bool pred = (k[j] > T) || (k[j] == T && T != 0u && (int)ix[j] < Jstar);
        const unsigned long long mask = __ballot(pred); const int pos = base + __popcll(mask & lt);
        if (pred) ent[pos] = (u32x2){k[j], ix[j]};
        base += __popcll(mask); }
    nkeep = base;
    return T;
}
#define DSA_HEADSUM(s, P, B, W) asm("v_max_f32_e32 %1, 0, %2\n\tv_mul_f32_e32 %0, %10, %1\n\tv_max_f32_e32 %1, 0, %3\n\tv_fmac_f32_e32 %0, %11, %1\n\tv_max_f32_e32 %1, 0, %4\n\tv_fmac_f32_e32 %0, %12, %1\n\t" \
        "v_max_f32_e32 %1, 0, %5\n\tv_fmac_f32_e32 %0, %13, %1\n\tv_max_f32_e32 %1, 0, %6\n\tv_fmac_f32_e32 %0, %14, %1\n\tv_max_f32_e32 %1, 0, %7\n\tv_fmac_f32_e32 %0, %15, %1\n\t" \
        "v_max_f32_e32 %1, 0, %8\n\tv_fmac_f32_e32 %0, %16, %1\n\tv_max_f32_e32 %1, 0, %9\n\tv_fmac_f32_e32 %0, %17, %1" \
        : "=&v"(s), "=&v"(tmp_) : "v"(P[B + 0]), "v"(P[B + 1]), "v"(P[B + 2]), "v"(P[B + 3]), "v"(P[B + 4]), "v"(P[B + 5]), "v"(P[B + 6]), "v"(P[B + 7]), \
          "v"(W[0]), "v"(W[1]), "v"(W[2]), "v"(W[3]), "v"(W[4]), "v"(W[5]), "v"(W[6]), "v"(W[7]))
__device__ __forceinline__ float unmono_f(unsigned u) { return __uint_as_float((u & 0x80000000u) ? (u ^ 0x80000000u) : ~u); }
struct DsaState { float tf0, tf1; int cnt0, cnt1; };
template <bool NOCOMPACT = false>
__device__ __forceinline__ void dsa_tile(const bf16x8 (&af)[4], const bf16x8 (&bc)[4], const float (&w0)[8], const float (&w1)[8], int key0, int q0t, int q1t, DsaState& st,
                                         LAS u32x2* ents, int lane) {
    const int r32 = lane & 31, hi = lane >> 5;
    f32x16 p;
#pragma unroll
    for (int r = 0; r < 16; ++r) p[r] = 0.f;
#pragma unroll
    for (int ks = 0; ks < 4; ++ks) p = __builtin_amdgcn_mfma_f32_32x32x16_bf16(af[ks], bc[ks], p, 0, 0, 0);
    asm volatile("s_nop 15\n\ts_nop 7" : "+v"(p));
    float s0, s1, tmp_;
    DSA_HEADSUM(s0, p, 0, w0); DSA_HEADSUM(s1, p, 8, w1);
    const int key = key0 + r32;
    const bool pr0 = (key <= q0t) && (s0 >= st.tf0), pr1 = (key <= q1t) && (s1 >= st.tf1);
    const unsigned long long m0 = __ballot(pr0), m1 = __ballot(pr1);
    if (m0 | m1) {
        const unsigned h0 = hi ? (unsigned)(m0 >> 32) : (unsigned)m0, h1 = hi ? (unsigned)(m1 >> 32) : (unsigned)m1;
        const unsigned lowmask = (1u << r32) - 1u;
        if (pr0) ents[hi * DS_CAP + st.cnt0 + __popc(h0 & lowmask)] = (u32x2){mono_key(s0), (unsigned)key};
        if (pr1) ents[(2 + hi) * DS_CAP + st.cnt1 + __popc(h1 & lowmask)] = (u32x2){mono_key(s1), (unsigned)key};
        st.cnt0 += __popc(h0); st.cnt1 += __popc(h1);
        const unsigned long long need = __ballot(max(st.cnt0, st.cnt1) > DS_CAP - 32);
        if (need) {
#pragma unroll 1
            for (int hh = 0; hh < 2; ++hh) {
                const int c0 = __builtin_amdgcn_readlane(st.cnt0, 0), c0b = __builtin_amdgcn_readlane(st.cnt0, 32);
                const int c1 = __builtin_amdgcn_readlane(st.cnt1, 0), c1b = __builtin_amdgcn_readlane(st.cnt1, 32);
                const int n0 = hh ? c0b : c0, n1 = hh ? c1b : c1;
                if (NOCOMPACT) { if (n0 > DS_CAP - 32 && hi == hh) st.cnt0 = 256; if (n1 > DS_CAP - 32 && hi == hh) st.cnt1 = 256; continue; }
                if (n0 > DS_CAP - 32) { int nk; const unsigned T = dsa_compact<false>(ents + hh * DS_CAP, n0, nk, lane); if (hi == hh) { st.tf0 = unmono_f(T + 1u); st.cnt0 = nk; } }
                if (n1 > DS_CAP - 32) { int nk; const unsigned T = dsa_compact<false>(ents + (2 + hh) * DS_CAP, n1, nk, lane); if (hi == hh) { st.tf1 = unmono_f(T + 1u); st.cnt1 = nk; } }
            }
        }
    }
}
template <bool NOCOMPACT = false>
__device__ __forceinline__ void dsa_select_phase(unsigned char* ws, LAS unsigned char* lds, int G, int tid, int wave, int lane) {
    const bf16* proj = (const bf16*)(ws + WS_BIG + B_PROJ); const bf16* IKc = (const bf16*)(ws + WS_BIG + B_IKC); const float* IW = (const float*)(ws + WS_IW);
    unsigned short* selg = (unsigned short*)(ws + WS_BIG + B_SEL);
    LAS u32x2* ents = (LAS u32x2*)lds + wave * 4 * DS_CAP;
    const int r32 = lane & 31, hi = lane >> 5;
    const int NWG = G * NWAVES, gw = (int)blockIdx.x * NWAVES + wave;
    for (int pu = gw; pu < 2048; pu += NWG) {
        for (int uu = 0; uu < 2; ++uu) {
            const int unit = uu ? 4095 - pu : pu, tw = unit * 4;
            bf16x8 af[4];
            { const int i = r32, qi = 2 * (i >> 4) + ((i >> 2) & 1), hd = 4 * ((i >> 3) & 1) + (i & 3);
              const bf16* ap = proj + (size_t)(tw + qi) * EVEN_NP + EC_IQ + hd * 64 + 8 * hi;
#pragma unroll
              for (int ks = 0; ks < 4; ++ks) af[ks] = *(const GAS bf16x8*)(ap + 16 * ks); }
            float w0[8], w1[8];
            { const f32x4 a = *(const GAS f32x4*)(IW + (size_t)(tw + hi) * 8), b = *(const GAS f32x4*)(IW + (size_t)(tw + hi) * 8 + 4);
              const f32x4 c = *(const GAS f32x4*)(IW + (size_t)(tw + 2 + hi) * 8), d = *(const GAS f32x4*)(IW + (size_t)(tw + 2 + hi) * 8 + 4);
#pragma unroll
              for (int j = 0; j < 4; ++j) { w0[j] = a[j]; w0[4 + j] = b[j]; w1[j] = c[j]; w1[4 + j] = d[j]; } }
            const int q0t = tw + hi, q1t = tw + 2 + hi;
            DsaState st; st.tf0 = -INFINITY; st.tf1 = -INFINITY; st.cnt0 = 0; st.cnt1 = 0;
            const int ntile = ((tw + 3) >> 5) + 1;
            const bf16* kp = IKc + (size_t)lane * 8; asm volatile("" : "+v"(kp));
            bf16x8 bA[4], bB[4];
#define DSA_LOADB(dst, jj) do { const bf16* p_ = kp + (size_t)(jj) * 2048; \
                asm volatile("global_load_dwordx4 %0, %4, off\n\tglobal_load_dwordx4 %1, %4, off offset:1024\n\tglobal_load_dwordx4 %2, %4, off offset:2048\n\tglobal_load_dwordx4 %3, %4, off offset:3072" \
                             : "=&v"(dst[0]), "=&v"(dst[1]), "=&v"(dst[2]), "=&v"(dst[3]) : "v"(p_) : "memory"); } while (0)
#define DSA_WAITB(dst, n) asm volatile("s_waitcnt vmcnt(" #n ")" : "+v"(dst[0]), "+v"(dst[1]), "+v"(dst[2]), "+v"(dst[3]) :: "memory")
            asm volatile("" : "+v"(af[0]), "+v"(af[1]), "+v"(af[2]), "+v"(af[3]));
#pragma unroll
            for (int r = 0; r < 8; ++r) asm volatile("" : "+v"(w0[r]), "+v"(w1[r]));
            DSA_LOADB(bA, 0);
#pragma unroll 1
            for (int j = 0; j < ntile; j += 2) {
                DSA_LOADB(bB, min(j + 1, ntile - 1));
                DSA_WAITB(bA, 4);
                dsa_tile<NOCOMPACT>(af, bA, w0, w1, 32 * j, q0t, q1t, st, ents, lane);
                DSA_LOADB(bA, min(j + 2, ntile - 1));
                DSA_WAITB(bB, 4);
                if (j + 1 < ntile) dsa_tile<NOCOMPACT>(af, bB, w0, w1, 32 * (j + 1), q0t, q1t, st, ents, lane);
            }
            DSA_WAITB(bA, 0);
#undef DSA_LOADB
#undef DSA_WAITB
            const int cnt0 = st.cnt0, cnt1 = st.cnt1;
#pragma unroll 1
            for (int qq = 0; qq < 4; ++qq) {
                const int hh = qq & 1, sl = qq >> 1;
                int n = sl ? __builtin_amdgcn_readlane(cnt1, 32 * hh) : __builtin_amdgcn_readlane(cnt0, 32 * hh);
                LAS u32x2* ee = ents + qq * DS_CAP;
                if (n > 256) { int nk = 256; if (!NOCOMPACT) (void)dsa_compact<true>(ee, n, nk, lane); n = 256; }
                unsigned short* row = selg + (size_t)(tw + qq) * 256;
#pragma unroll
                for (int e4 = 0; e4 < 4; ++e4) { const int e = lane + 64 * e4; row[e] = (e < n) ? (unsigned short)ee[e].y : (unsigned short)0xFFFFu; }
            }
        }
    }
}

typedef __bf16 bf16x2v __attribute__((ext_vector_type(2)));
__device__ __forceinline__ float dot2bf(unsigned a, unsigned b, float acc) { return __builtin_amdgcn_fdot2_f32_bf16(__builtin_bit_cast(bf16x2v, a), __builtin_bit_cast(bf16x2v, b), acc, false); }
__device__ __forceinline__ void dsa_sparse_phase(unsigned char* ws, int G, int wave, int lane, bf16* obase, size_t opitch) {
    const bf16* proj = (const bf16*)(ws + WS_BIG + B_PROJ); const unsigned short* selg = (const unsigned short*)(ws + WS_BIG + B_SEL);
    const int h = (int)blockIdx.x & 7, wg = (int)blockIdx.x >> 3, nwg = G >> 3;
    const int kg = lane >> 3, ds8 = (lane & 7) * 8;
    for (int t = wg * NWAVES + wave; t < S; t += nwg * NWAVES) {
        v4u iw[4];
#pragma unroll
        for (int c = 0; c < 4; ++c) iw[c] = *(const GAS v4u*)(selg + (size_t)t * 256 + 32 * kg + 8 * c);
        const v4u qw = *(const GAS v4u*)(proj + (size_t)t * EVEN_NP + EC_DQ + h * 64 + ds8);
        float sc[32];
#pragma unroll
        for (int i0 = 0; i0 < 32; i0 += 8) {
            v4u kw[8];
#pragma unroll
            for (int j = 0; j < 8; ++j) { const int i = i0 + j; const unsigned wd = (i & 1) ? (iw[i >> 3][(i >> 1) & 3] >> 16) : (iw[i >> 3][(i >> 1) & 3] & 0xffffu);
                const unsigned idx = (wd == 0xffffu) ? 0u : wd;
                kw[j] = *(const GAS v4u*)(proj + (size_t)idx * EVEN_NP + EC_DK + h * 64 + ds8); }
#pragma unroll
            for (int j = 0; j < 8; ++j) { const int i = i0 + j; const unsigned wd = (i & 1) ? (iw[i >> 3][(i >> 1) & 3] >> 16) : (iw[i >> 3][(i >> 1) & 3] & 0xffffu);
                float d = dot2bf(qw.x, kw[j].x, 0.f); d = dot2bf(qw.y, kw[j].y, d); d = dot2bf(qw.z, kw[j].z, d); d = dot2bf(qw.w, kw[j].w, d);
                d += shx<1>(d); d += shx<2>(d); d += shx<4>(d);
                sc[i] = (wd == 0xffffu) ? -INFINITY : d * C2; }
        }
        float mx = sc[0];
#pragma unroll
        for (int i = 1; i < 32; ++i) mx = fmaxf(mx, sc[i]);
        mx = fmaxf(mx, shx<8>(mx)); mx = fmaxf(mx, shx<16>(mx)); mx = sh32_max(mx);
        float l = 0.f;
#pragma unroll
        for (int i = 0; i < 32; ++i) { sc[i] = __builtin_amdgcn_exp2f(sc[i] - mx); l += sc[i]; }
        l += shx<8>(l); l += shx<16>(l); l = sh32_sum(l);
        float acc[8];
#pragma unroll
        for (int e = 0; e < 8; ++e) acc[e] = 0.f;
#pragma unroll
        for (int i0 = 0; i0 < 32; i0 += 8) {
            v4u vw[8];
#pragma unroll
            for (int j = 0; j < 8; ++j) { const int i = i0 + j; const unsigned wd = (i & 1) ? (iw[i >> 3][(i >> 1) & 3] >> 16) : (iw[i >> 3][(i >> 1) & 3] & 0xffffu);
                const unsigned idx = (wd == 0xffffu) ? 0u : wd;
                vw[j] = *(const GAS v4u*)(proj + (size_t)idx * EVEN_NP + EC_DV + h * 64 + ds8); }
#pragma unroll
            for (int j = 0; j < 8; j += 2) {
                const unsigned pp = cvtpk(sc[i0 + j], sc[i0 + j + 1]);
                const v4u a = vw[j], b = vw[j + 1];
                acc[0] = dot2bf(pp, __builtin_amdgcn_perm(b.x, a.x, 0x05040100u), acc[0]); acc[1] = dot2bf(pp, __builtin_amdgcn_perm(b.x, a.x, 0x07060302u), acc[1]);
                acc[2] = dot2bf(pp, __builtin_amdgcn_perm(b.y, a.y, 0x05040100u), acc[2]); acc[3] = dot2bf(pp, __builtin_amdgcn_perm(b.y, a.y, 0x07060302u), acc[3]);
                acc[4] = dot2bf(pp, __builtin_amdgcn_perm(b.z, a.z, 0x05040100u), acc[4]); acc[5] = dot2bf(pp, __builtin_amdgcn_perm(b.z, a.z, 0x07060302u), acc[5]);
                acc[6] = dot2bf(pp, __builtin_amdgcn_perm(b.w, a.w, 0x05040100u), acc[6]); acc[7] = dot2bf(pp, __builtin_amdgcn_perm(b.w, a.w, 0x07060302u), acc[7]);
            }
        }
        const float inv = 1.0f / l;
#pragma unroll
        for (int e = 0; e < 8; ++e) { float a = acc[e]; a += shx<8>(a); a += shx<16>(a); a = sh32_sum(a); acc[e] = a * inv; }
        if (kg == 0) *(GAS v4u*)(obase + (size_t)t * opitch + h * 64 + ds8) = pack8(acc);
    }
}

struct Args { InPtrs in; float* out; unsigned char* ws; int ph_lo, ph_hi, li, pad; };
constexpr int PH_PER_LAYER = 14, N_PHASES = 1 + 2 * PH_PER_LAYER - 1;

__global__ void __launch_bounds__(NTHREADS, 2) hyb_fwd(Args args) {
    extern __shared__ __attribute__((aligned(16))) unsigned char lds_raw[];
    LAS unsigned char* lds = (LAS unsigned char*)lds_raw;
    volatile LAS unsigned* MISC = (volatile LAS unsigned*)(lds + MISC_OFF);
    const int tid = threadIdx.x, lane = tid & 63, wave = __builtin_amdgcn_readfirstlane(tid >> 6);
    const int G = gridDim.x;
    const int vcu = (G % 8 == 0) ? ((int)blockIdx.x % 8) * (G / 8) + (int)blockIdx.x / 8 : (int)blockIdx.x;
    unsigned char* ws = args.ws;
    gu32* ctl = (gu32*)(ws + WS_CTL);
    for (int u = tid; u < (LDS_BYTES - LDSCTL_OFF) / 4; u += NTHREADS) ((LAS unsigned*)(lds + LDSCTL_OFF))[u] = 0u;
    __syncthreads();
    XcdBarrier bar = xcd_barrier_post((unsigned*)(ctl + CW_BAR) + args.li * XCD_BAR_WORDS, MISC + 8);
    const int tid0 = tid; unsigned char* const ws0 = ws;
    for (int ph = args.ph_lo; ph < args.ph_hi; ++ph) {
        int tid = tid0; asm volatile("" : "+v"(tid));
        unsigned char* ws = ws0; asm volatile("" : "+s"(ws));
        const int lane = tid & 63, wave = __builtin_amdgcn_readfirstlane(tid >> 6);
        LAS unsigned char* lds = (LAS unsigned char*)lds_raw; { unsigned lo_ = (unsigned)(uintptr_t)lds; asm volatile("" : "+s"(lo_)); lds = (LAS unsigned char*)(uintptr_t)lo_; }
        float* ssqA = (float*)(ws + WS_SSQ);
        bf16* HB = (bf16*)(ws + WS_HB);
        unsigned char* Wr = ws + WS_W;
        unsigned char* BIG = ws + WS_BIG;
        const int gw = vcu * NWAVES + wave, NGW = G * NWAVES;
        if (ph == 0) {
#ifdef PROBE_P02
            conv_weights(args.in, ws, 0, lds, gw, NGW, wave, lane);
            copy_x(args.in.p[0], args.out, HB, ssqA, gw, NGW, lane);
            rope_tables((float*)(ws + WS_ROPE), (float*)(ws + WS_ROPE) + S * 8, (int)blockIdx.x * NTHREADS + tid, G * NTHREADS);
            __syncthreads();
            for (int w = blockIdx.x; w < MEMT; w += G) mem_kv(args.in, ws, lds, w, tid, wave, lane);
            __syncthreads();
#endif
#ifndef NO_P0
            conv_weights(args.in, ws, 0, lds, gw, NGW, wave, lane);
            copy_x(args.in.p[0], args.out, HB, ssqA, gw, NGW, lane);
            rope_tables((float*)(ws + WS_ROPE), (float*)(ws + WS_ROPE) + S * 8, (int)blockIdx.x * NTHREADS + tid, G * NTHREADS);
            __syncthreads();
            for (int w = blockIdx.x; w < MEMT; w += G) mem_kv(args.in, ws, lds, w, tid, wave, lane);
#endif
        } else {
            const int L = (ph - 1) / PH_PER_LAYER, sub = (ph - 1) % PH_PER_LAYER;
            const bool even = (L & 1) == 0;
            float* ssq_in = ssqA;
            if (sub == 0 || sub == 11) {
                pg8::Gemm g{(const pg8::bf16_t*)HB, (const pg8::bf16_t*)(Wr + (sub == 0 ? W_FFN1_IN : W_FFN2_IN)), S, FF2, DM, DM};
                pg8::StaticOrder So; So.init(S, FF2, G, (int)blockIdx.x);
                pg8::EpiSwiGLU E{(pg8::bf16_t*)(BIG + B_U), ssq_in, FF};
#ifdef PROBE_GEMM2
                pg8::gemm_phase<pg8::EpiSwiGLU, pg8::StaticOrder, true, true>(lds, g, So, E, tid); __syncthreads();
#endif
                pg8::gemm_phase<pg8::EpiSwiGLU, pg8::StaticOrder, true, true>(lds, g, So, E, tid);
            } else if (sub == 1 || sub == 7 || sub == 10 || sub == 12) {
                pg8::Gemm g; float scale; int so;
                if (sub == 1)       { g = pg8::Gemm{(const pg8::bf16_t*)(BIG + B_U), (const pg8::bf16_t*)(Wr + W_FFN1_OUT), S, DM, FF, FF}; scale = 0.5f; so = 1; }
                else if (sub == 7)  { g = pg8::Gemm{(const pg8::bf16_t*)(BIG + B_PROJ), (const pg8::bf16_t*)(Wr + W_MIX_OUT), S, DM, DM, even ? EVEN_NP : DM}; scale = 1.0f; so = 2; }
                else if (sub == 10)  { g = pg8::Gemm{(const pg8::bf16_t*)(BIG + B_OM), (const pg8::bf16_t*)(Wr + W_MEMO), S, DM, MEMW, MEMW}; scale = 1.0f; so = 3; }
                else                { g = pg8::Gemm{(const pg8::bf16_t*)(BIG + B_U), (const pg8::bf16_t*)(Wr + W_FFN2_OUT), S, DM, FF, FF}; scale = 0.5f; so = 4; }
                const bool last = (sub == 12 && L == NLAYER - 1);
                pg8::StaticOrder So; So.init(S, DM, G, (int)blockIdx.x);
                pg8::EpiResid E{args.out, last ? nullptr : (pg8::bf16_t*)HB, last ? nullptr : ssqA, scale};
                pg8::gemm_phase<pg8::EpiResid, pg8::StaticOrder, true, true>(lds, g, So, E, tid);
#ifdef PROBE_GEMM2
                { __syncthreads(); pg8::EpiResid E0 = E; E0.scale = 0.f; pg8::gemm_phase<pg8::EpiResid, pg8::StaticOrder, true, true>(lds, g, So, E0, tid); }
#endif
            } else if (sub == 2 || sub == 8) {
                pg8::Gemm g; pg8::EpiScale E;
                if (sub == 2) { const int N = even ? EVEN_NP : ODD_N;
                    g = pg8::Gemm{(const pg8::bf16_t*)HB, (const pg8::bf16_t*)(Wr + W_MIX_IN), S, N, DM, DM};
                    E = pg8::EpiScale{(pg8::bf16_t*)(BIG + B_PROJ), even ? EVEN_NP : DM, ssq_in, even ? 0 : DM, (size_t)S * DM}; }
                else { g = pg8::Gemm{(const pg8::bf16_t*)HB, (const pg8::bf16_t*)(Wr + W_MEMQ), S, MEMW, DM, DM};
                    E = pg8::EpiScale{(pg8::bf16_t*)(BIG + B_QM), MEMW, ssq_in, 0, 0}; }
                pg8::StaticOrder So; So.init(S, g.N, G, (int)blockIdx.x);
#ifdef PROBE_GEMM2
                pg8::gemm_phase<pg8::EpiScale, pg8::StaticOrder, true, true>(lds, g, So, E, tid); __syncthreads();
#endif
                pg8::gemm_phase<pg8::EpiScale, pg8::StaticOrder, true, true>(lds, g, So, E, tid);
            } else if (sub == 3) {
                #ifndef NO_POSTE
                if (even) post_even(args.in, ws, args.out, ssq_in, lds, G, tid, wave, lane);
#endif
#ifndef NO_POSTO
                if (!even) post_odd(args.in, ws, lds, G, tid, wave, lane);
#endif
            } else if (sub == 4) {
                if (even) {
                    int nrep = 1;
#ifdef PROBE_DSA2
                    nrep = 2;
#endif
                    asm volatile("" : "+s"(nrep));
#ifdef PROBE_SELNC
                    dsa_select_phase<true>(ws, lds, G, tid, wave, lane); __syncthreads();
#endif
                    for (int rep = 0; rep < nrep; ++rep) { dsa_select_phase<false>(ws, lds, G, tid, wave, lane); __syncthreads(); }
                } else {
                    moba_gate_phase(ws, G, wave, lane);
                }
            } else if (sub == 5) {
                if (even) {
                    bf16* projb = (bf16*)(BIG + B_PROJ);
#ifdef PROBE_FOX2
                    fox_phase(args.in, ws, lds, G, tid, wave, lane, HB, 512, CW_FOXQ + 64); __syncthreads();
#endif
#ifdef PROBE_SPARSE2
                    dsa_sparse_phase(ws, G, wave, lane, HB, 512);
#endif
                    fox_phase(args.in, ws, lds, G, tid, wave, lane, projb + EC_FQ, EVEN_NP, CW_FOXQ);
                    dsa_sparse_phase(ws, G, wave, lane, projb + EC_DQ, EVEN_NP);
                } else {
#ifdef PROBE_MOBA2
                    moba_route_phase(ws, lds, G, tid, wave, lane); __syncthreads();
#endif
                    moba_route_phase(ws, lds, G, tid, wave, lane);
                }
            } else if (sub == 6) {
                if (!even) moba_own_phase(ws, lds, G, tid, wave, lane);
            } else if (sub == 9) {
#ifdef PROBE_MEM2
                memattn_phase(args.in, ws, L, lds, G, tid, wave, lane); __syncthreads();
#endif
                memattn_phase(args.in, ws, L, lds, G, tid, wave, lane);
            } else if (sub == 13) {
#ifdef PROBE_P02
                conv_weights(args.in, ws, L + 1, lds, gw, NGW, wave, lane); __syncthreads();
#endif
                conv_weights(args.in, ws, L + 1, lds, gw, NGW, wave, lane);
            }
        }
        if (ph + 1 < args.ph_hi) xcd_barrier(bar);
#ifdef PROBE_BAR2
        if (ph + 1 < args.ph_hi) xcd_barrier(bar);
#endif
    }
}

#ifndef MK_N_LAUNCHES
#define MK_N_LAUNCHES 1
#endif
extern "C" void kernel_launch(void* const* d_in, const int* in_sizes, int n_in, void* d_out, int out_size, void* d_ws, size_t ws_size, hipStream_t stream) {
    static int grid = 0;
    if (grid == 0) {
        if (n_in != 26 || in_sizes[0] != S * DM || out_size != S * DM || ws_size < WS_END) {
            fprintf(stderr, "kernel_launch: unexpected problem (n_in %d, in0 %d, out %d, ws %zu); nothing launched\n", n_in, n_in > 0 ? in_sizes[0] : -1, out_size, ws_size); grid = -1; return; }
        int dev = 0, cus = 0, per_cu = 0;
        if (hipGetDevice(&dev) != hipSuccess || hipDeviceGetAttribute(&cus, hipDeviceAttributeMultiprocessorCount, dev) != hipSuccess) { grid = -1; return; }
        if (hipFuncSetAttribute((const void*)hyb_fwd, hipFuncAttributeMaxDynamicSharedMemorySize, LDS_BYTES) != hipSuccess) { fprintf(stderr, "kernel_launch: hipFuncSetAttribute failed\n"); grid = -1; return; }
        if (hipOccupancyMaxActiveBlocksPerMultiprocessor(&per_cu, (const void*)hyb_fwd, NTHREADS, LDS_BYTES) != hipSuccess || per_cu < 1)
            fprintf(stderr, "kernel_launch: note: occupancy query reports %d workgroups per CU\n", per_cu);
        (void)hipGetLastError();
        grid = cus;
    }
    if (grid < 0) return;
    if (hipMemsetAsync((char*)d_ws + WS_CTL, 0, CTL_ZERO_BYTES, stream) != hipSuccess) { fprintf(stderr, "kernel_launch: hipMemsetAsync failed\n"); return; }
    Args a{};
    for (int i = 0; i < 26; ++i) a.in.p[i] = (const float*)d_in[i];
    a.out = (float*)d_out; a.ws = (unsigned char*)d_ws;
#if MK_N_LAUNCHES == 1
    a.ph_lo = 0; a.ph_hi = N_PHASES; a.li = 0;
    hipLaunchKernelGGL(hyb_fwd, dim3(grid), dim3(NTHREADS), LDS_BYTES, stream, a);
#else
    for (int ph = 0; ph < N_PHASES; ++ph) { a.ph_lo = ph; a.ph_hi = ph + 1; a.li = 0; hipLaunchKernelGGL(hyb_fwd, dim3(grid), dim3(NTHREADS), LDS_BYTES, stream, a); }
#endif
    const hipError_t le = hipPeekAtLastError();
    if (le != hipSuccess) fprintf(stderr, "kernel_launch: launch failed: %s\n", hipGetErrorName(le));
}
```

```cpp
#include <hip/hip_runtime.h>
#include <cstdio>
#include <cstdint>

template <int M> __device__ __forceinline__ int shx_i(int v) {
    if constexpr (M == 1) return __builtin_amdgcn_mov_dpp(v, 0xB1, 0xF, 0xF, true);
    else if constexpr (M == 2) return __builtin_amdgcn_mov_dpp(v, 0x4E, 0xF, 0xF, true);
    else return __builtin_amdgcn_ds_swizzle(v, (M << 10) | 0x1f);
}
template <int M> __device__ __forceinline__ float shx(float v) { return __int_as_float(shx_i<M>(__float_as_int(v))); }
__device__ __forceinline__ float sh32_sum(float v) { auto r = __builtin_amdgcn_permlane32_swap(__float_as_uint(v), __float_as_uint(v), false, false); return __uint_as_float(r[0]) + __uint_as_float(r[1]); }
__device__ __forceinline__ float sh32_max(float v) { auto r = __builtin_amdgcn_permlane32_swap(__float_as_uint(v), __float_as_uint(v), false, false); return fmaxf(__uint_as_float(r[0]), __uint_as_float(r[1])); }
__device__ __forceinline__ int sum32_i(int c) { c += shx_i<1>(c); c += shx_i<2>(c); c += shx_i<4>(c); c += shx_i<8>(c); c += shx_i<16>(c); return c; }
namespace pg8 {
#define PG8_LAS __attribute__((address_space(3)))
typedef unsigned short bf16_t;
typedef short bf16x8 __attribute__((ext_vector_type(8)));
typedef float f32x4 __attribute__((ext_vector_type(4)));
typedef unsigned u32x4 __attribute__((ext_vector_type(4)));
constexpr int BM = 256, BK = 64, HALF = 128, HTB = HALF * BK * 2  , STAGE_BYTES = 8 * HTB, NXCD = 8, WGM = 8;

__host__ __device__ __forceinline__ int lds_byte(int r, int c) { const int st = (r >> 4) * 2 + (c >> 5), rr = r & 15, cc = c & 31, ob = rr * 64 + cc * 2; return st * 1024 + (ob ^ (((ob >> 9) & 1) << 5)); }
__host__ __device__ __forceinline__ void stage_rc(int b, int& R, int& C) { const int st = b / 1024, sb = b % 1024, swz = sb ^ (((sb >> 9) & 1) << 5); R = (st >> 1) * 16 + swz / 64; C = (st & 1) * 32 + (swz % 64) / 2; }
__host__ __device__ __forceinline__ int perm32(int rho) { const int n = rho >> 4, i = rho & 15; return 8 * (i >> 2) + 4 * n + (i & 3); }

struct Unit { int pm, pn; };
struct Gemm { const bf16_t* A; const bf16_t* Bt; int M, N, K, lda; };

struct StaticOrder {
    int nM, nN, nwg, G, c;
    __host__ __device__ __forceinline__ void init(int M, int N, int G_, int c_) { nM = M / BM; nN = N / BM; nwg = nM * nN; G = G_; c = c_; }
    __host__ __device__ __forceinline__ bool next(int i, Unit& u) const {
        const long L = (long)i * G + c; if (L >= nwg) return false;
        int wgid = (int)L; { const int q = nwg / NXCD, r = nwg % NXCD, xcd = wgid % NXCD, off = wgid / NXCD; wgid = (xcd < r ? xcd * (q + 1) : r * (q + 1) + (xcd - r) * q) + off; }
        const int nig = WGM * nN, gid = wgid / nig, fm = gid * WGM, gsz = (nM - fm) < WGM ? (nM - fm) : WGM;
        u.pm = fm + ((wgid % nig) % gsz); u.pn = (wgid % nig) / gsz; return true;
    }
    __device__ __forceinline__ void a_ready(const Unit&) const {}
    __device__ __forceinline__ void done(const Unit&) const {}
};

__device__ __forceinline__ unsigned cvt_pk_bf16(float lo, float hi) { unsigned r; asm volatile("v_cvt_pk_bf16_f32 %0, %1, %2" : "=v"(r) : "v"(lo), "v"(hi)); return r; }
typedef float f32x2 __attribute__((ext_vector_type(2)));
constexpr float RMS_EPS_F = 1e-6f;
__device__ __forceinline__ float silu_f(float x) { return x * __builtin_amdgcn_rcpf(1.0f + __builtin_amdgcn_exp2f(-1.4426950408889634f * x)); }
__device__ __forceinline__ float row_rstd(const float* ssq, int row) {
    const f32x4* p = (const f32x4*)(ssq + (size_t)row * 16); const f32x4 a = p[0], b = p[1], c = p[2], d = p[3];
    const float s = ((a[0] + a[1]) + (a[2] + a[3])) + ((b[0] + b[1]) + (b[2] + b[3])) + ((c[0] + c[1]) + (c[2] + c[3])) + ((d[0] + d[1]) + (d[2] + d[3]));
    return rsqrtf(s * (1.0f / 1024.0f) + RMS_EPS_F); }

struct EpiSwiGLU {
    static constexpr bool PERM = true, AFTER_DRAIN = false;
    bf16_t* U; const float* ssq; int ldu;
    __device__ __forceinline__ void operator()(const f32x4 (&acc)[2][2][4][2], const Unit& u, int wr, int wc, int fr, int fq) const {
        const int row0 = u.pm * BM + wr * 64 + fr, col0 = u.pn * HALF + wc * 32 + 8 * fq;
#pragma unroll
        for (int ai = 0; ai < 2; ++ai)
#pragma unroll
            for (int m = 0; m < 4; ++m) {
                const int row = row0 + ai * HALF + m * 16; const float r = row_rstd(ssq, row);
                const f32x4 a0 = acc[ai][0][m][0] * r, a1 = acc[ai][0][m][1] * r, b0 = acc[ai][1][m][0] * r, b1 = acc[ai][1][m][1] * r;
                u32x4 w;
                w.x = cvt_pk_bf16(silu_f(a0[0]) * b0[0], silu_f(a0[1]) * b0[1]); w.y = cvt_pk_bf16(silu_f(a0[2]) * b0[2], silu_f(a0[3]) * b0[3]);
                w.z = cvt_pk_bf16(silu_f(a1[0]) * b1[0], silu_f(a1[1]) * b1[1]); w.w = cvt_pk_bf16(silu_f(a1[2]) * b1[2], silu_f(a1[3]) * b1[3]);
                *(u32x4*)(U + (size_t)row * ldu + col0) = w;
            }
    }
};
struct EpiResid {
    static constexpr bool PERM = true, AFTER_DRAIN = false;
    float* H; bf16_t* HB; float* ssq_out; float scale;
    __device__ __forceinline__ void operator()(const f32x4 (&acc)[2][2][4][2], const Unit& u, int wr, int wc, int fr, int fq) const {
        const int row0 = u.pm * BM + wr * 64 + fr, col0 = u.pn * BM + wc * 32 + 8 * fq;
#pragma unroll
        for (int ai = 0; ai < 2; ++ai)
#pragma unroll
            for (int m = 0; m < 4; ++m) {
                const int row = row0 + ai * HALF + m * 16; float sq = 0.f;
#pragma unroll
                for (int bj = 0; bj < 2; ++bj) {
                    float* hp = H + (size_t)row * 1024 + col0 + bj * HALF;
                    f32x4 h0 = *(const f32x4*)hp, h1 = *(const f32x4*)(hp + 4);
                    h0 = h0 + acc[ai][bj][m][0] * scale; h1 = h1 + acc[ai][bj][m][1] * scale;
                    *(f32x4*)hp = h0; *(f32x4*)(hp + 4) = h1;
                    sq += (h0[0] * h0[0] + h0[1] * h0[1]) + (h0[2] * h0[2] + h0[3] * h0[3]) + (h1[0] * h1[0] + h1[1] * h1[1]) + (h1[2] * h1[2] + h1[3] * h1[3]);
                    if (HB) { u32x4 w; w.x = cvt_pk_bf16(h0[0], h0[1]); w.y = cvt_pk_bf16(h0[2], h0[3]); w.z = cvt_pk_bf16(h1[0], h1[1]); w.w = cvt_pk_bf16(h1[2], h1[3]);
                        *(u32x4*)(HB + (size_t)row * 1024 + col0 + bj * HALF) = w; }
                }
                if (ssq_out) { sq += shx<16>(sq); sq = sh32_sum(sq); if (fq == 0) ssq_out[(size_t)row * 16 + u.pn * 4 + wc] = sq; }
            }
    }
};
struct EpiScale {
    static constexpr bool PERM = true, AFTER_DRAIN = false;
    bf16_t* O; int ldc; const float* ssq; int split_cols; size_t split_stride;
    __device__ __forceinline__ void operator()(const f32x4 (&acc)[2][2][4][2], const Unit& u, int wr, int wc, int fr, int fq) const {
        const int row0 = u.pm * BM + wr * 64 + fr; int colt = u.pn * BM; bf16_t* base = O;
        if (split_cols) { const int t = colt / split_cols; base += (size_t)t * split_stride; colt -= t * split_cols; }
        const int col0 = colt + wc * 32 + 8 * fq;
#pragma unroll
        for (int ai = 0; ai < 2; ++ai)
#pragma unroll
            for (int m = 0; m < 4; ++m) {
                const int row = row0 + ai * HALF + m * 16; const float r = row_rstd(ssq, row);
                bf16_t* rowp = base + (size_t)row * ldc + col0;
#pragma unroll
                for (int bj = 0; bj < 2; ++bj) { const f32x4 v0 = acc[ai][bj][m][0] * r, v1 = acc[ai][bj][m][1] * r;
                    u32x4 w; w.x = cvt_pk_bf16(v0[0], v0[1]); w.y = cvt_pk_bf16(v0[2], v0[3]); w.z = cvt_pk_bf16(v1[0], v1[1]); w.w = cvt_pk_bf16(v1[2], v1[3]);
                    *(u32x4*)(rowp + bj * HALF) = w; }
            }
    }
};

enum { KIND_PLAIN = 0, KIND_NORM = 1, KIND_NORM_ROPE = 2, KIND_ROPE = 3, KIND_VT = 4, KIND_NORM_ROPE_KSUM = 5, KIND_IK = 6, KIND_SKIP = 7 };
struct EpiProj {
    static constexpr bool PERM = true, AFTER_DRAIN = false;
    bf16_t* O; int ldc; const float* ssq; int split_cols; size_t split_stride;
    int even;
    const float* gtab;
    const float* cosT; const float* sinT;
    bf16_t* Vt;
    bf16_t* IKf;
    PG8_LAS float* xch;
    __device__ __forceinline__ void operator()(const f32x4 (&acc)[2][2][4][2], const Unit& u, int wr, int wc, int fr, int fq) const {
        const int S_ = 16384;
        int kind; int gsel = 0; int vcol0 = 0;
        if (even) { const int p = u.pn;
            kind = (p < 2) ? KIND_NORM : (p < 4) ? KIND_NORM_ROPE : (p < 6) ? KIND_NORM : (p < 8) ? KIND_NORM_ROPE : (p < 10) ? KIND_VT : (p < 12) ? KIND_PLAIN : (p < 14) ? KIND_ROPE : KIND_IK;
            gsel = (p < 8) ? (p >> 1) : 0; vcol0 = (p - 8) * 256;
        } else { const int p = u.pn; kind = (p < 8) ? KIND_NORM_ROPE : KIND_VT; gsel = (p < 8) ? 4 + (p >> 2) : 0; vcol0 = (p - 8) * 256; }
        const float* gn = gtab + gsel * 64;
        const int row0 = u.pm * BM + wr * 64 + fr; int colt = u.pn * BM; bf16_t* base = O;
        if (split_cols) { const int t = colt / split_cols; base += (size_t)t * split_stride; colt -= t * split_cols; }
        const int co0 = wc * 32 + 8 * fq;
        const int hd0 = 32 * (wc & 1) + 8 * fq;
        int xo = ((wr * 64 + fr) * 2) * 4 + wc, xp = ((wr * 64 + fr) * 2) * 4 + (wc ^ 1);
        asm volatile("" : "+v"(xo), "+v"(xp));
        const bool normk = (kind == KIND_NORM || kind == KIND_NORM_ROPE || kind == KIND_NORM_ROPE_KSUM);
        const bool ropek = (kind == KIND_NORM_ROPE || kind == KIND_ROPE || kind == KIND_NORM_ROPE_KSUM || kind == KIND_IK);
        float gv[8];
#pragma unroll
        for (int e2 = 0; e2 < 8; ++e2) gv[e2] = normk ? gn[hd0 + e2] : 1.0f;
        if (normk) {
#pragma unroll
            for (int ai = 0; ai < 2; ++ai)
#pragma unroll
                for (int m = 0; m < 4; ++m)
#pragma unroll
                    for (int bj = 0; bj < 2; ++bj) { const f32x4 v0 = acc[ai][bj][m][0], v1 = acc[ai][bj][m][1];
                        float ss = (v0[0] * v0[0] + v0[1] * v0[1]) + (v0[2] * v0[2] + v0[3] * v0[3]) + (v1[0] * v1[0] + v1[1] * v1[1]) + (v1[2] * v1[2] + v1[3] * v1[3]);
                        ss += shx<16>(ss); ss = sh32_sum(ss);
                        if (fq == 0) xch[xo + (ai * 128 + m * 16) * 8 + bj * 4] = ss; }
            asm volatile("s_waitcnt lgkmcnt(0)" ::: "memory"); __builtin_amdgcn_s_barrier(); asm volatile("" ::: "memory");
        }
        if (kind != KIND_SKIP) {
#pragma unroll
        for (int ai = 0; ai < 2; ++ai)
#pragma unroll
            for (int m = 0; m < 4; ++m) {
                const int row = row0 + ai * HALF + m * 16; const float r = row_rstd(ssq, row);
                float cs[8], sn[8];
                if (ropek) { const f32x4 c0 = *(const f32x4*)(cosT + (unsigned)(row * 8)), c1 = *(const f32x4*)(cosT + (unsigned)(row * 8 + 4)), s0 = *(const f32x4*)(sinT + (unsigned)(row * 8)), s1 = *(const f32x4*)(sinT + (unsigned)(row * 8 + 4));
#pragma unroll
                    for (int e2 = 0; e2 < 4; ++e2) { cs[e2] = c0[e2]; cs[4 + e2] = c1[e2]; sn[e2] = s0[e2]; sn[4 + e2] = s1[e2]; } }
#pragma unroll
                for (int bj = 0; bj < 2; ++bj) {
                    if (kind == KIND_IK && (bj == 1 || wc >= 2)) continue;
                    float x[8];
                    { const f32x4 v0 = acc[ai][bj][m][0], v1 = acc[ai][bj][m][1];
#pragma unroll
                      for (int e2 = 0; e2 < 4; ++e2) { x[e2] = v0[e2]; x[4 + e2] = v1[e2]; } }
                    float sc = r;
                    if (normk) { const float tot = xch[xo + (ai * 128 + m * 16) * 8 + bj * 4] + xch[xp + (ai * 128 + m * 16) * 8 + bj * 4];
                        sc = r * rsqrtf(tot * (r * r) * (1.0f / 64.0f) + RMS_EPS_F); }
#pragma unroll
                    for (int e2 = 0; e2 < 8; ++e2) x[e2] = x[e2] * sc * gv[e2];
                    if (ropek) {
#pragma unroll
                        for (int e2 = 0; e2 < 8; ++e2) { const float other = shx<16>(x[e2]);
                            if ((wc & 1) == 0 && fq == 0) x[e2] = x[e2] * cs[e2] - other * sn[e2];
                            else if ((wc & 1) == 0 && fq == 1) x[e2] = x[e2] * cs[e2] + other * sn[e2]; }
                    }
                    if (kind == KIND_VT) {
                        bf16_t* vp = Vt + (unsigned)((vcol0 + bj * HALF + co0) * S_ + (row & ~1));
#pragma unroll
                        for (int e2 = 0; e2 < 8; ++e2) { const float other = shx<1>(x[e2]);
                            const unsigned w = (fr & 1) ? cvt_pk_bf16(other, x[e2]) : cvt_pk_bf16(x[e2], other);
                            if (((e2 >> 2) & 1) == (fr & 1)) *(unsigned*)(vp + (unsigned)(e2 * S_)) = w; }
                    } else if (kind == KIND_IK) {
                        const int c8 = 4 * wc + fq;
                        u32x4 w; w.x = cvt_pk_bf16(x[0], x[1]); w.y = cvt_pk_bf16(x[2], x[3]); w.z = cvt_pk_bf16(x[4], x[5]); w.w = cvt_pk_bf16(x[6], x[7]);
                        *(u32x4*)(IKf + (unsigned)((((row >> 5) * 4 + (c8 >> 1)) * 64 + (c8 & 1) * 32 + (row & 31)) * 8)) = w;
                    } else {
                        u32x4 w; w.x = cvt_pk_bf16(x[0], x[1]); w.y = cvt_pk_bf16(x[2], x[3]); w.z = cvt_pk_bf16(x[4], x[5]); w.w = cvt_pk_bf16(x[6], x[7]);
                        *(u32x4*)(base + (unsigned)(row * ldc + colt + bj * HALF + co0)) = w;
                    }
                }
            }
        }
        if (normk) { asm volatile("s_waitcnt lgkmcnt(0)" ::: "memory"); __builtin_amdgcn_s_barrier(); asm volatile("" ::: "memory"); }
    }
};
template <class Epi, class Sched, bool ALIGN_EPI = false, bool SP2 = false>
__device__ __forceinline__ void gemm_phase(PG8_LAS unsigned char* lds, const Gemm g, const Sched& S, const Epi& E, const int tid) {
    const int wid = __builtin_amdgcn_readfirstlane(tid >> 6), lane = tid & 63, wr = wid >> 2, wc = wid & 3, fr = lane & 15, fq = lane >> 4;
    const int K = g.K, nt = K / BK;
    unsigned voffA[2], voffB[2];
#pragma unroll
    for (int i = 0; i < 2; ++i) { int R, C; stage_rc(tid * 16 + i * 8192, R, C); const int Rb = Epi::PERM ? ((R & ~31) + perm32(R & 31)) : R;
        voffA[i] = (unsigned)(R * g.lda + C) * 2u; voffB[i] = (unsigned)(Rb * K + C) * 2u; }
    const size_t kstep = (size_t)(BK * 2);
    const size_t hstepA = (size_t)HALF * g.lda * 2, hstepB = (size_t)HALF * K * 2;
    const size_t tstepA = 2 * hstepA, tstepB = 2 * hstepB;
    const unsigned ldsw = (unsigned)wid * 1024u;
    const int aoff = lds_byte(wr * 64 + fr, fq * 8), boff = lds_byte(wc * 32 + fr, fq * 8);
#define PG8_SA(b, h) (((b) * 2 + (h)) * HTB)
#define PG8_SB(b, h) ((4 + (b) * 2 + (h)) * HTB)
#define PG8_STAGE(bufoff, gbase, voff) do { _Pragma("unroll") for (int _i = 0; _i < 2; ++_i) \
        __builtin_amdgcn_global_load_lds((const unsigned*)((const char*)(gbase) + (voff)[_i]), (PG8_LAS unsigned*)(lds + (bufoff) + ldsw + _i * 8192), 16, 0, 0); } while (0)
#define PG8_LDA(dst, b, h) do { _Pragma("unroll") for (int m = 0; m < 4; ++m) _Pragma("unroll") for (int k = 0; k < 2; ++k) dst[m][k] = *(const PG8_LAS bf16x8*)(lds + PG8_SA(b, h) + aoff + m * 2048 + k * 1024); } while (0)
#define PG8_LDB(dst, b, h) do { _Pragma("unroll") for (int n = 0; n < 2; ++n) _Pragma("unroll") for (int k = 0; k < 2; ++k) dst[n][k] = *(const PG8_LAS bf16x8*)(lds + PG8_SB(b, h) + boff + n * 2048 + k * 1024); } while (0)
#define PG8_MMA(ai, bj, At, Bt) do { __builtin_amdgcn_s_setprio(1); _Pragma("unroll") for (int m = 0; m < 4; ++m) _Pragma("unroll") for (int n = 0; n < 2; ++n) _Pragma("unroll") for (int k = 0; k < 2; ++k) \
        acc[ai][bj][m][n] = __builtin_amdgcn_mfma_f32_16x16x32_bf16(Bt[n][k], At[m][k], acc[ai][bj][m][n], 0, 0, 0); __builtin_amdgcn_s_setprio(0); } while (0)
#define PG8_WAIT_V(n) asm volatile("s_waitcnt vmcnt(" #n ")" ::: "memory")
#define PG8_WAIT_L(n) asm volatile("s_waitcnt lgkmcnt(" #n ")" ::: "memory")
#define PG8_BAR __builtin_amdgcn_s_barrier()
#define PG8_SCHED __builtin_amdgcn_sched_barrier(0)
    Unit cur, nxt; int ui = 0;
    if (!S.next(0, cur)) return;
    f32x4 acc[2][2][4][2];
#pragma unroll
    for (int a = 0; a < 2; ++a)
#pragma unroll
        for (int b = 0; b < 2; ++b)
#pragma unroll
            for (int m = 0; m < 4; ++m)
#pragma unroll
                for (int n = 0; n < 2; ++n) acc[a][b][m][n] = (f32x4){0.f, 0.f, 0.f, 0.f};
    bf16x8 At[4][2], B0[2][2], B1[2][2];
    const char* cA = (const char*)g.A + (size_t)cur.pm * tstepA; const char* cB = (const char*)g.Bt + (size_t)cur.pn * tstepB;
    S.a_ready(cur);
    if constexpr (SP2) {
        PG8_STAGE(PG8_SB(0, 0), cB, voffB); PG8_STAGE(PG8_SB(0, 1), cB + hstepB, voffB); PG8_STAGE(PG8_SA(0, 0), cA, voffA); PG8_STAGE(PG8_SA(0, 1), cA + hstepA, voffA);
        if (wr == 1) PG8_BAR;
        PG8_WAIT_V(2); PG8_BAR;
        PG8_STAGE(PG8_SB(1, 0), cB + kstep, voffB); PG8_STAGE(PG8_SA(1, 0), cA + kstep, voffA); PG8_STAGE(PG8_SB(1, 1), cB + hstepB + kstep, voffB);
        PG8_WAIT_V(6); PG8_BAR;
    } else {
        PG8_STAGE(PG8_SB(0, 0), cB, voffB); PG8_STAGE(PG8_SA(0, 0), cA, voffA); PG8_STAGE(PG8_SB(0, 1), cB + hstepB, voffB); PG8_STAGE(PG8_SA(0, 1), cA + hstepA, voffA);
        if (wr == 1) PG8_BAR;
        PG8_WAIT_V(4); PG8_BAR;
        PG8_STAGE(PG8_SB(1, 0), cB + kstep, voffB); PG8_STAGE(PG8_SA(1, 0), cA + kstep, voffA); PG8_STAGE(PG8_SB(1, 1), cB + hstepB + kstep, voffB);
        PG8_WAIT_V(6); PG8_BAR;
    }
    for (;;) {
        const bool has_next = S.next(ui + 1, nxt);
        const char* nA = has_next ? (const char*)g.A + (size_t)nxt.pm * tstepA : cA; const char* nB = has_next ? (const char*)g.Bt + (size_t)nxt.pn * tstepB : cB;
        for (int t = 0; t < nt; t += 2) {
            const bool last = (t == nt - 2);
            const char* a1 = cA + (size_t)(t + 1) * kstep;
            const char* a2 = last ? nA : cA + (size_t)(t + 2) * kstep; const char* b2 = last ? nB : cB + (size_t)(t + 2) * kstep;
            const char* a3 = a2 + kstep; const char* b3 = b2 + kstep;
            if (last && has_next) S.a_ready(nxt);
            if constexpr (SP2) {
            PG8_LDB(B0, 0, 0); PG8_LDB(B1, 0, 1); PG8_SCHED; PG8_LDA(At, 0, 0); PG8_STAGE(PG8_SA(1, 1), a1 + hstepA, voffA);
            PG8_WAIT_V(8); PG8_WAIT_L(0); PG8_BAR; PG8_MMA(0, 0, At, B0); PG8_MMA(0, 1, At, B1); PG8_BAR; PG8_SCHED;
            PG8_LDA(At, 0, 1); PG8_STAGE(PG8_SB(0, 0), b2, voffB); PG8_STAGE(PG8_SB(0, 1), b2 + hstepB, voffB); PG8_STAGE(PG8_SA(0, 0), a2, voffA);
            PG8_WAIT_V(8); PG8_WAIT_L(0); PG8_BAR; PG8_MMA(1, 0, At, B0); PG8_MMA(1, 1, At, B1); PG8_BAR; PG8_SCHED;
            PG8_LDB(B0, 1, 0); PG8_LDB(B1, 1, 1); PG8_SCHED; PG8_LDA(At, 1, 0); PG8_STAGE(PG8_SA(0, 1), a2 + hstepA, voffA);
            PG8_WAIT_V(8); PG8_WAIT_L(0); PG8_BAR; PG8_MMA(0, 0, At, B0); PG8_MMA(0, 1, At, B1); PG8_BAR; PG8_SCHED;
            PG8_LDA(At, 1, 1); PG8_STAGE(PG8_SB(1, 0), b3, voffB); PG8_STAGE(PG8_SB(1, 1), b3 + hstepB, voffB); PG8_STAGE(PG8_SA(1, 0), a3, voffA);
            PG8_WAIT_V(8); PG8_WAIT_L(0); PG8_BAR; PG8_MMA(1, 0, At, B0); PG8_MMA(1, 1, At, B1); PG8_BAR; PG8_SCHED;
            } else {
            PG8_LDB(B0, 0, 0); PG8_SCHED; PG8_LDA(At, 0, 0); PG8_STAGE(PG8_SA(1, 1), a1 + hstepA, voffA);
            PG8_WAIT_L(8); PG8_BAR; PG8_WAIT_L(0); PG8_MMA(0, 0, At, B0); PG8_BAR; PG8_SCHED;
            PG8_LDB(B1, 0, 1); PG8_STAGE(PG8_SB(0, 0), b2, voffB);
            PG8_BAR; PG8_WAIT_L(0); PG8_MMA(0, 1, At, B1); PG8_BAR;
            PG8_LDA(At, 0, 1); PG8_STAGE(PG8_SA(0, 0), a2, voffA);
            PG8_BAR; PG8_WAIT_L(0); PG8_MMA(1, 0, At, B0); PG8_BAR; PG8_SCHED;
            PG8_STAGE(PG8_SB(0, 1), b2 + hstepB, voffB);
            PG8_WAIT_V(6); PG8_BAR; PG8_MMA(1, 1, At, B1); PG8_BAR;
            PG8_LDB(B0, 1, 0); PG8_SCHED; PG8_LDA(At, 1, 0); PG8_STAGE(PG8_SA(0, 1), a2 + hstepA, voffA);
            PG8_WAIT_L(8); PG8_BAR; PG8_WAIT_L(0); PG8_MMA(0, 0, At, B0); PG8_BAR; PG8_SCHED;
            PG8_LDB(B1, 1, 1); PG8_STAGE(PG8_SB(1, 0), b3, voffB);
            PG8_BAR; PG8_WAIT_L(0); PG8_MMA(0, 1, At, B1); PG8_BAR;
            PG8_LDA(At, 1, 1); PG8_STAGE(PG8_SA(1, 0), a3, voffA);
            PG8_BAR; PG8_WAIT_L(0); PG8_MMA(1, 0, At, B0); PG8_BAR; PG8_SCHED;
            PG8_STAGE(PG8_SB(1, 1), b3 + hstepB, voffB);
            PG8_WAIT_V(6); PG8_BAR; PG8_MMA(1, 1, At, B1); PG8_BAR;
            }
        }
        if constexpr (ALIGN_EPI) { if (wr == 0) PG8_BAR; }
        if constexpr (!Epi::AFTER_DRAIN) { E(acc, cur, wr, wc, fr, fq); S.done(cur); }
        if (!has_next) break;
#pragma unroll
        for (int a = 0; a < 2; ++a)
#pragma unroll
            for (int b = 0; b < 2; ++b)
#pragma unroll
                for (int m = 0; m < 4; ++m)
#pragma unroll
                    for (int n = 0; n < 2; ++n) acc[a][b][m][n] = (f32x4){0.f, 0.f, 0.f, 0.f};
        cur = nxt; cA = nA; cB = nB; ++ui;
        if constexpr (ALIGN_EPI) { if (wr == 1) PG8_BAR; }
    }
    PG8_WAIT_V(0);
    if constexpr (!ALIGN_EPI) { if (wr == 0) PG8_BAR; }
    PG8_BAR;
    if constexpr (Epi::AFTER_DRAIN) { E.fused(acc, cur, wr, wc, fr, fq, lds, wid, lane); S.done(cur); }
#undef PG8_SA
#undef PG8_SB
#undef PG8_STAGE
#undef PG8_LDA
#undef PG8_LDB
#undef PG8_MMA
#undef PG8_WAIT_V
#undef PG8_WAIT_L
#undef PG8_BAR
#undef PG8_SCHED
}
}

constexpr int S = 16384, DM = 1024, FF = 2816, FF2 = 5632, EVEN_SRC = 3664, EVEN_NP = 3840, ODD_N = 3072, NLAYER = 2, MEMT = 256, MEMW = 256;
constexpr float RMS_EPS = 1e-6f;
constexpr float LOG2E = 1.4426950408889634f;
constexpr float C2 = 0.125f * LOG2E;
constexpr int NWAVES = 8, NTHREADS = 512;
constexpr int EC_FQ = 0, EC_DQ = 512, EC_FK = 1024, EC_DK = 1536, EC_FV = 2048, EC_DV = 2560, EC_IQ = 3072, EC_IK = 3584;
constexpr int ES_FQ = 0, ES_FK = 512, ES_FV = 1024, ES_FL = 1536, ES_DQ = 1544, ES_DK = 2056, ES_DV = 2568, ES_IQ = 3080, ES_IK = 3592, ES_IW = 3656;

constexpr size_t MiB = 1u << 20;
constexpr size_t WS_CTL = 0, CTL_ZERO_BYTES = 1 * MiB;
constexpr size_t WS_SSQ = 1 * MiB;
constexpr size_t WS_KSUM = 6 * MiB;
constexpr size_t WS_GT = 6 * MiB + 1 * MiB;
constexpr size_t WS_ROPE = 2 * MiB;
constexpr size_t WS_FL = 3 * MiB;
constexpr size_t WS_MEMK = 4 * MiB;
constexpr size_t WS_IW = 5 * MiB;
constexpr size_t WS_W = 12 * MiB;
constexpr size_t WS_BIG = 60 * MiB;
constexpr size_t WS_HB = 224 * MiB;
constexpr size_t WS_END = 256 * MiB;
constexpr size_t W_FFN1_IN = 0, W_FFN1_OUT = 11 * MiB, W_MIX_IN = 17 * MiB, W_MIX_OUT = 25 * MiB, W_MEMQ = 27 * MiB, W_MEMO = 28 * MiB, W_FFN2_IN = 29 * MiB, W_FFN2_OUT = 40 * MiB;
constexpr size_t B_U = 0;
constexpr size_t B_PROJ = 0;
constexpr size_t B_VTF = 120 * MiB;
constexpr size_t B_IKC = 136 * MiB;
constexpr size_t B_VTM = 96 * MiB;
constexpr size_t B_SEL = 156 * MiB;
constexpr size_t B_QM = 140 * MiB, B_OM = 148 * MiB;
constexpr int CW_TMO = 0, CW_CODE = 1, CW_BAR = 4096;

constexpr int RING_BYTES = 147456;
constexpr int LDSCTL_OFF = RING_BYTES, MISC_OFF = LDSCTL_OFF + 320;
constexpr int LDS_BYTES = 163840;

#define GAS __attribute__((address_space(1)))
#define LAS __attribute__((address_space(3)))
typedef unsigned short bf16;
typedef unsigned v4u __attribute__((ext_vector_type(4)));
typedef float f32x4 __attribute__((ext_vector_type(4)));
typedef short bf16x8 __attribute__((ext_vector_type(8)));
typedef GAS unsigned gu32;
typedef GAS unsigned long long gu64;
#define RLX_AGENT __ATOMIC_RELAXED, __HIP_MEMORY_SCOPE_AGENT
#define LDS_WAIT() asm volatile("s_waitcnt lgkmcnt(0)" ::: "memory")
#define VM_WAIT() asm volatile("s_waitcnt vmcnt(0)" ::: "memory")
__device__ __forceinline__ unsigned long long rt() { return __builtin_amdgcn_s_memrealtime(); }
__device__ __forceinline__ unsigned f2bf(float f) { unsigned u = __builtin_bit_cast(unsigned, f); return (u + 0x7fffu + ((u >> 16) & 1u)) >> 16; }
__device__ __forceinline__ unsigned pk2(float lo, float hi) { return f2bf(lo) | (f2bf(hi) << 16); }

#define XB_TMO      128
#define XB_XCNT(j)  (256  + 64 * (j))
#define XB_XSUB(j)  (1280 + 64 * (j))
#define XB_XGEN(j)  (2304 + 64 * (j))
#define XB_TOP      3328
#define XB_TOPGEN   3392
#define XCD_BAR_WORDS 3456
#define XB_SPIN_CAP (1u << 18)

__device__ __forceinline__ unsigned xb_ld(unsigned* p)              { return __hip_atomic_load(p, __ATOMIC_RELAXED, __HIP_MEMORY_SCOPE_AGENT); }
__device__ __forceinline__ unsigned xb_add(unsigned* p, unsigned v) { return __hip_atomic_fetch_add(p, v, __ATOMIC_RELAXED, __HIP_MEMORY_SCOPE_AGENT); }
__device__ __forceinline__ unsigned xb_xcc_id() { return (unsigned)__builtin_amdgcn_s_getreg((3 << 11) | 20) & 0xFu; }
#define XB_SPIN(cond, bar) do { unsigned _sp = 0; while (cond) { __builtin_amdgcn_s_sleep(1); \
    if ((++_sp & 255u) == 0u) { if (xb_ld(&(bar)[XB_TMO])) break; if (_sp > XB_SPIN_CAP) { atomicAdd(&(bar)[XB_TMO], 1u); break; } } } } while (0)

struct XcdBarrier {
    unsigned* bar; unsigned x;
    volatile LAS unsigned* st;
};

__device__ __forceinline__ XcdBarrier xcd_barrier_post(unsigned* bar, volatile LAS unsigned* st) {
    XcdBarrier b; b.bar = bar; b.x = xb_xcc_id(); b.st = st;
    if (threadIdx.x == 0) (void)xb_add(&bar[XB_XCNT(b.x)], 1u);
    return b;
}
__device__ __forceinline__ void xcd_barrier_complete(unsigned* bar, unsigned x, unsigned& nloc, unsigned& nx) {
    const unsigned G = gridDim.x * gridDim.y * gridDim.z;
    unsigned sum, cnt, mine, sp = 0u;
    for (;;) {
        sum = 0u; cnt = 0u; mine = 0u;
#pragma unroll
        for (unsigned j = 0; j < 16; ++j) { const unsigned c = xb_ld(&bar[XB_XCNT(j)]); sum += c; cnt += (c > 0u) ? 1u : 0u; mine = (j == x) ? c : mine; }
        if (sum == G) break;
        __builtin_amdgcn_s_sleep(1);
        if ((++sp & 255u) == 0u) { if (xb_ld(&bar[XB_TMO])) break; if (sp > XB_SPIN_CAP) { atomicAdd(&bar[XB_TMO], 1u); break; } }
    }
    nloc = mine > 0u ? mine : 1u; nx = cnt > 0u ? cnt : 1u;
}

__device__ __forceinline__ void xcd_barrier(const XcdBarrier& b) {
    asm volatile("s_waitcnt vmcnt(0)" ::: "memory");
    __syncthreads();
    if (threadIdx.x == 0) {
        unsigned* bar = b.bar;
        __builtin_amdgcn_s_waitcnt(0);
        unsigned nloc = b.st[0], nx = b.st[1];
        if (nloc == 0u) { xcd_barrier_complete(bar, b.x, nloc, nx); b.st[0] = nloc; b.st[1] = nx; }
        const unsigned old = xb_add(&bar[XB_XSUB(b.x)], 1u);
        const unsigned gen = old / nloc;
        if (old + 1u == (gen + 1u) * nloc) {
            __builtin_amdgcn_fence(__ATOMIC_RELEASE, "agent");
            asm volatile("s_waitcnt vmcnt(0)" ::: "memory");
            const unsigned og = xb_add(&bar[XB_TOP], 1u);
            const unsigned tg = og / nx;
            if (og + 1u == (tg + 1u) * nx) xb_add(&bar[XB_TOPGEN], 1u);
            else XB_SPIN(xb_ld(&bar[XB_TOPGEN]) == tg, bar);
            __builtin_amdgcn_fence(__ATOMIC_ACQUIRE, "agent");
            xb_add(&bar[XB_XGEN(b.x)], 1u);
            asm volatile("s_waitcnt vmcnt(0)" ::: "memory");
        } else {
            XB_SPIN(xb_ld(&bar[XB_XGEN(b.x)]) == gen, bar);
            __builtin_amdgcn_fence(__ATOMIC_ACQUIRE, "agent");
            asm volatile("s_waitcnt vmcnt(0)" ::: "memory");
        }
    }
    __syncthreads();
}

typedef float f32x16 __attribute__((ext_vector_type(16)));
typedef float f32x2_t __attribute__((ext_vector_type(2)));
typedef __bf16 bf16x2_t __attribute__((ext_vector_type(2)));
typedef unsigned u32x2 __attribute__((ext_vector_type(2)));
__device__ __forceinline__ unsigned cvtpk(float lo, float hi) { f32x2_t v = {lo, hi}; bf16x2_t b = __builtin_convertvector(v, bf16x2_t); return __builtin_bit_cast(unsigned, b); }
__device__ __forceinline__ float bflo(unsigned w) { return __uint_as_float(w << 16); }
__device__ __forceinline__ float bfhi(unsigned w) { return __uint_as_float(w & 0xffff0000u); }
__device__ __forceinline__ void unpack8(const v4u& w, float (&x)[8]) { x[0] = bflo(w.x); x[1] = bfhi(w.x); x[2] = bflo(w.y); x[3] = bfhi(w.y); x[4] = bflo(w.z); x[5] = bfhi(w.z); x[6] = bflo(w.w); x[7] = bfhi(w.w); }
__device__ __forceinline__ v4u pack8(const float (&x)[8]) { v4u w; w.x = cvtpk(x[0], x[1]); w.y = cvtpk(x[2], x[3]); w.z = cvtpk(x[4], x[5]); w.w = cvtpk(x[6], x[7]); return w; }
__device__ __forceinline__ float wave_sum(float v) { v += shx<1>(v); v += shx<2>(v); v += shx<4>(v); v += shx<8>(v); v += shx<16>(v); return sh32_sum(v); }
__device__ __forceinline__ float wave_max(float v) { v = fmaxf(v, shx<1>(v)); v = fmaxf(v, shx<2>(v)); v = fmaxf(v, shx<4>(v)); v = fmaxf(v, shx<8>(v)); v = fmaxf(v, shx<16>(v)); return sh32_max(v); }
__device__ __forceinline__ int crow(int r, int hi) { return (r & 3) + 8 * (r >> 2) + 4 * hi; }

__device__ __forceinline__ int even_map(int n) {
    if (n < 512) return ES_FQ + n;
    if (n < 1024) return ES_DQ + (n - 512);
    if (n < 1536) return ES_FK + (n - 1024);
    if (n < 2048) return ES_DK + (n - 1536);
    if (n < 2560) return ES_FV + (n - 2048);
    if (n < 3072) return ES_DV + (n - 2560);
    if (n < 3584) return ES_IQ + (n - 3072);
    if (n < 3648) return ES_IK + (n - 3584);
    return -1;
}
__device__ __forceinline__ void conv_item(const float* W, int K, int Nsrc, int nblk, const float* gain, bf16* WT, int mode, LAS float* scr, int item, int lane) {
    const int kb = item / nblk, nb = item % nblk, k0 = 32 * kb, n0 = 128 * nb;
    const int n = n0 + 4 * (lane & 31);
    int sc;
    if (mode == 0) sc = n; else if (mode == 1) { const int T = n >> 8, hf = (n >> 7) & 1, j = n & 127; sc = hf * FF + 128 * T + j; } else sc = even_map(n);
    f32x4 v[16];
#pragma unroll
    for (int i = 0; i < 16; ++i) { const int kk = 2 * i + (lane >> 5); v[i] = (f32x4){0.f, 0.f, 0.f, 0.f};
        if (sc >= 0) v[i] = *(const GAS f32x4*)(W + (size_t)(k0 + kk) * Nsrc + sc); }
#pragma unroll
    for (int i = 0; i < 16; ++i) { const int kk = 2 * i + (lane >> 5); const float g = gain ? gain[k0 + kk] : 1.0f;
        *(LAS f32x4*)(scr + kk * 132 + 4 * (lane & 31)) = v[i] * g; }
    LDS_WAIT(); asm volatile("" ::: "memory");
    const int c = lane & 3;
#pragma unroll
    for (int j = 0; j < 8; ++j) { const int nn = (lane >> 2) + 16 * j; const LAS float* s = scr + (8 * c) * 132 + nn;
        v4u o; o.x = cvtpk(s[0 * 132], s[1 * 132]); o.y = cvtpk(s[2 * 132], s[3 * 132]); o.z = cvtpk(s[4 * 132], s[5 * 132]); o.w = cvtpk(s[6 * 132], s[7 * 132]);
        *(GAS v4u*)(WT + (size_t)(n0 + nn) * K + k0 + 8 * c) = o; }
    LDS_WAIT(); asm volatile("" ::: "memory");
}
struct InPtrs { const float* p[26]; };
__device__ __forceinline__ void conv_weights(const InPtrs& in, unsigned char* ws, int L, LAS unsigned char* lds, int gw, int NGW, int wave, int lane) {
    LAS float* scr = (LAS float*)(lds + wave * 17408);
    bf16* Wr = (bf16*)(ws + WS_W);
    const float* ffn1_norm = in.p[2] + (size_t)L * DM; const float* ffn1_in = in.p[3] + (size_t)L * DM * FF2; const float* ffn1_out = in.p[4] + (size_t)L * FF * DM;
    const float* mix_norm = in.p[5] + (size_t)L * DM; const float* mix_out = in.p[15] + (size_t)L * DM * DM;
    const float* memx_norm = in.p[16] + (size_t)L * DM; const float* mem_wq = in.p[18] + (size_t)L * DM * MEMW; const float* mem_wo = in.p[22] + (size_t)L * MEMW * DM;
    const float* ffn2_norm = in.p[23] + (size_t)L * DM; const float* ffn2_in = in.p[24] + (size_t)L * DM * FF2; const float* ffn2_out = in.p[25] + (size_t)L * FF * DM;
    const bool even = (L & 1) == 0;
    const float* mix_in = even ? in.p[6] : in.p[12];
    const int mixN = even ? EVEN_NP : ODD_N, mixSrc = even ? EVEN_SRC : ODD_N;
    const int I_FIN = (DM / 32) * (FF2 / 128), I_FOUT = (FF / 32) * (DM / 128), I_MIN = (DM / 32) * (mixN / 128), I_MOUT = (DM / 32) * (DM / 128), I_MQ = (DM / 32) * (MEMW / 128), I_MO = (MEMW / 32) * (DM / 128);
    const int NITEMS = 2 * I_FIN + 2 * I_FOUT + I_MIN + I_MOUT + I_MQ + I_MO;
    for (int it = gw; it < NITEMS; it += NGW) {
        int r = it;
        if (r < I_FIN) { conv_item(ffn1_in, DM, FF2, FF2 / 128, ffn1_norm, (bf16*)((unsigned char*)Wr + W_FFN1_IN), 1, scr, r, lane); continue; } r -= I_FIN;
        if (r < I_FIN) { conv_item(ffn2_in, DM, FF2, FF2 / 128, ffn2_norm, (bf16*)((unsigned char*)Wr + W_FFN2_IN), 1, scr, r, lane); continue; } r -= I_FIN;
        if (r < I_FOUT) { conv_item(ffn1_out, FF, DM, DM / 128, nullptr, (bf16*)((unsigned char*)Wr + W_FFN1_OUT), 0, scr, r, lane); continue; } r -= I_FOUT;
        if (r < I_FOUT) { conv_item(ffn2_out, FF, DM, DM / 128, nullptr, (bf16*)((unsigned char*)Wr + W_FFN2_OUT), 0, scr, r, lane); continue; } r -= I_FOUT;
        if (r < I_MIN) { conv_item(mix_in, DM, mixSrc, mixN / 128, mix_norm, (bf16*)((unsigned char*)Wr + W_MIX_IN), even ? 2 : 0, scr, r, lane); continue; } r -= I_MIN;
        if (r < I_MOUT) { conv_item(mix_out, DM, DM, DM / 128, nullptr, (bf16*)((unsigned char*)Wr + W_MIX_OUT), 0, scr, r, lane); continue; } r -= I_MOUT;
        if (r < I_MQ) { conv_item(mem_wq, DM, MEMW, MEMW / 128, memx_norm, (bf16*)((unsigned char*)Wr + W_MEMQ), 0, scr, r, lane); continue; } r -= I_MQ;
        conv_item(mem_wo, MEMW, DM, DM / 128, nullptr, (bf16*)((unsigned char*)Wr + W_MEMO), 0, scr, r, lane);
    }
}
__device__ __forceinline__ void copy_x(const float* x, float* out, bf16* HB, float* ssq0, int gw, int NGW, int lane) {
    for (int m = gw; m < S; m += NGW) {
        const GAS f32x4* xr = (const GAS f32x4*)(x + (size_t)m * DM) + lane; GAS f32x4* orow = (GAS f32x4*)(out + (size_t)m * DM) + lane;
        GAS u32x2* hb = (GAS u32x2*)(HB + (size_t)m * DM) + lane;
        float s = 0.f;
#pragma unroll
        for (int j = 0; j < 4; ++j) { const f32x4 v = xr[64 * j]; orow[64 * j] = v; s += (v.x * v.x + v.y * v.y) + (v.z * v.z + v.w * v.w);
            u32x2 w; w.x = cvtpk(v.x, v.y); w.y = cvtpk(v.z, v.w); hb[64 * j] = w; }
        s = wave_sum(s);
        if (lane < 16) ssq0[(size_t)m * 16 + lane] = (lane == 0) ? s : 0.f;
    }
}
__device__ __forceinline__ void rope_tables(float* cosT, float* sinT, int gtid, int nthreads) {
    for (int idx = gtid; idx < S * 8; idx += nthreads) {
        const int t = idx >> 3, j = idx & 7;
        float inv;
        switch (j) { case 0: inv = 1.0f; break; case 1: inv = 0.193922743f; break; case 2: inv = 0.0376060307f; break; case 3: inv = 0.00729266461f; break;
                     case 4: inv = 0.00141421356f; break; case 5: inv = 0.000274248188f; break; case 6: inv = 5.3182961e-05f; break; default: inv = 1.03133862e-05f; break; }
        const float ang = (float)t * inv;
        const float kq = __builtin_rintf(ang * 0.63661977236758134f);
        float r = ang - kq * 1.5703125f; r = r - kq * 0.00048351287841796875f; r = r - kq * 3.1391647326017846e-07f;
        const float r2 = r * r;
        float sp = 2.7557319e-6f; sp = sp * r2 - 1.9841270e-4f; sp = sp * r2 + 8.3333333e-3f; sp = sp * r2 - 1.6666667e-1f; const float sn = r + r * r2 * sp;
        float cp = -2.7557319e-7f; cp = cp * r2 + 2.4801587e-5f; cp = cp * r2 - 1.3888889e-3f; cp = cp * r2 + 4.1666667e-2f; cp = cp * r2 - 0.5f; const float cs = 1.0f + r2 * cp;
        const int q = ((int)kq) & 3;
        const float sv = (q == 0) ? sn : (q == 1) ? cs : (q == 2) ? -sn : -cs;
        const float cv = (q == 0) ? cs : (q == 1) ? -sn : (q == 2) ? -cs : sn;
        cosT[idx] = cv; sinT[idx] = sv;
    }
}
__device__ __forceinline__ void mem_kv(const InPtrs& in, unsigned char* ws, LAS unsigned char* lds, int w, int tid, int wave, int lane) {
    LAS float* memn = (LAS float*)lds;
    LAS float* red = (LAS float*)(lds + 4096);
    bf16* memK = (bf16*)(ws + WS_MEMK); bf16* memVt = (bf16*)(ws + WS_MEMK + 256 * 1024);
    for (int L = 0; L < NLAYER; ++L) {
        const float* mrow = in.p[1] + (size_t)w * DM; const float* gm = in.p[17] + (size_t)L * DM; const float* wkv = in.p[19] + (size_t)L * DM * 512; const float* kn = in.p[21] + (size_t)L * 64;
        const float x0 = mrow[tid], x1 = mrow[tid + 512];
        float s = wave_sum(x0 * x0 + x1 * x1);
        if (lane == 0) red[wave] = s;
        __syncthreads();
        float tot = 0.f;
#pragma unroll
        for (int i = 0; i < 8; ++i) tot += red[i];
        const float rstd = rsqrtf(tot * (1.0f / DM) + RMS_EPS);
        memn[tid] = x0 * rstd * gm[tid]; memn[tid + 512] = x1 * rstd * gm[tid + 512];
        __syncthreads();
        float acc = 0.f;
#pragma unroll 8
        for (int k = 0; k < DM; ++k) acc += memn[k] * wkv[(size_t)k * 512 + tid];
        if (tid < 256) {
            const float ss = wave_sum(acc * acc);
            const float y = acc * rsqrtf(ss * (1.0f / 64.0f) + RMS_EPS) * kn[tid & 63];
            memK[(size_t)L * 256 * 256 + (size_t)w * 256 + tid] = (bf16)(cvtpk(y, 0.f) & 0xffffu);
        } else {
            const int c = tid - 256;
            memVt[(size_t)L * 256 * 256 + (size_t)c * 256 + w] = (bf16)(cvtpk(acc, 0.f) & 0xffffu);
        }
        __syncthreads();
    }
}

__device__ __forceinline__ void head_norm8(float (&x)[8], const float* gain, int lane) {
    float ss = 0.f;
#pragma unroll
    for (int j = 0; j < 8; ++j) ss += x[j] * x[j];
    ss += shx<1>(ss); ss += shx<2>(ss); ss += shx<4>(ss);
    const float r = rsqrtf(ss * (1.0f / 64.0f) + RMS_EPS);
    const int d0 = 8 * (lane & 7);
#pragma unroll
    for (int j = 0; j < 8; ++j) x[j] = x[j] * r * gain[d0 + j];
}
__device__ __forceinline__ void rope8(float (&x)[8], const float (&cs)[8], const float (&sn)[8], int lane) {
    const int sub = lane & 7;
#pragma unroll
    for (int j = 0; j < 8; ++j) {
        const float other = shx<1>(x[j]);
        if (sub == 0) x[j] = x[j] * cs[j] - other * sn[j];
        else if (sub == 1) x[j] = x[j] * cs[j] + other * sn[j];
    }
}
__device__ __forceinline__ float sh32_get(float v, int lane) { auto r = __builtin_amdgcn_permlane32_swap(__float_as_uint(v), __float_as_uint(v), false, false); return __uint_as_float((lane < 32) ? r[1] : r[0]); }
__device__ __forceinline__ float reduce_scatter64(float (&v)[64], int lane) {
    { const bool up = (lane & 32) != 0;
#pragma unroll
      for (int j = 0; j < 32; ++j) { const float send = up ? v[j] : v[j + 32], keep = up ? v[j + 32] : v[j]; v[j] = keep + sh32_get(send, lane); } }
    { const bool up = (lane & 16) != 0;
#pragma unroll
      for (int j = 0; j < 16; ++j) { const float send = up ? v[j] : v[j + 16], keep = up ? v[j + 16] : v[j]; v[j] = keep + shx<16>(send); } }
    { const bool up = (lane & 8) != 0;
#pragma unroll
      for (int j = 0; j < 8; ++j) { const float send = up ? v[j] : v[j + 8], keep = up ? v[j + 8] : v[j]; v[j] = keep + shx<8>(send); } }
    { const bool up = (lane & 4) != 0;
#pragma unroll
      for (int j = 0; j < 4; ++j) { const float send = up ? v[j] : v[j + 4], keep = up ? v[j + 4] : v[j]; v[j] = keep + shx<4>(send); } }
    { const bool up = (lane & 2) != 0;
#pragma unroll
      for (int j = 0; j < 2; ++j) { const float send = up ? v[j] : v[j + 2], keep = up ? v[j + 2] : v[j]; v[j] = keep + shx<2>(send); } }
    { const bool up = (lane & 1) != 0; const float send = up ? v[0] : v[1], keep = up ? v[1] : v[0]; v[0] = keep + shx<1>(send); }
    return v[0];
}
__device__ __forceinline__ void post_even(const InPtrs& in, unsigned char* ws, const float* H, const float* ssq, LAS unsigned char* lds, int G, int tid, int wave, int lane) {
    float* Flocal = (float*)(ws + WS_FL); float* Btot = Flocal + S * 8; float* IW = (float*)(ws + WS_IW);
    const float* bfg = in.p[7];
    const float* Wsrc = in.p[6]; const float* mixg = in.p[5];
    LAS f32x4* Tw = (LAS f32x4*)lds;
    LAS float* lf = (LAS float*)(lds + 65536);
    for (int idx = tid; idx < 1024 * 16; idx += NTHREADS) {
        const int k = idx >> 4, col = idx & 15;
        const float v = mixg[k] * Wsrc[(size_t)k * EVEN_SRC + (col < 8 ? ES_FL + col : ES_IW + col - 8)];
        const int ln = (k & 255) >> 2, e = k & 3, q = k >> 8, c = col >> 2;
        ((LAS float*)Tw)[((((q * 4 + e) * 4 + c) * 64 + ln) << 2) + (col & 3)] = v;
    }
    __syncthreads();
    for (int u = blockIdx.x; u < S / 64; u += G) {
        const int t0 = u * 64, tw0 = t0 + wave * 8;
#pragma unroll 1
        for (int rb = 0; rb < 2; ++rb) {
            float acc[64];
#pragma unroll
            for (int j = 0; j < 64; ++j) acc[j] = 0.f;
#pragma unroll
            for (int q = 0; q < 4; ++q) {
                f32x4 hv[4];
#pragma unroll
                for (int r = 0; r < 4; ++r) hv[r] = *((const GAS f32x4*)(H + (size_t)(tw0 + rb * 4 + r) * DM) + lane + 64 * q);
#pragma unroll
                for (int e = 0; e < 4; ++e)
#pragma unroll
                    for (int c = 0; c < 4; ++c) { const f32x4 w = Tw[((q * 4 + e) * 4 + c) * 64 + lane];
#pragma unroll
                        for (int r = 0; r < 4; ++r) { acc[r * 16 + 4 * c + 0] += hv[r][e] * w[0]; acc[r * 16 + 4 * c + 1] += hv[r][e] * w[1]; acc[r * 16 + 4 * c + 2] += hv[r][e] * w[2]; acc[r * 16 + 4 * c + 3] += hv[r][e] * w[3]; } }
            }
            const float zs = reduce_scatter64(acc, lane);
            const int rl = wave * 8 + rb * 4 + (lane >> 4), t = t0 + rl, j = lane & 15;
            const float z = zs * pg8::row_rstd(ssq, t);
            if (j < 8) { const float zz = z + bfg[j]; lf[rl * 8 + j] = (zz > 15.f) ? -expf(-zz) : -log1pf(expf(-zz)); }
            else IW[(size_t)t * 8 + (j - 8)] = z * 0.044194173824159216f;
        }
        __syncthreads();
        {
            float v = lf[lane * 8 + wave];
#pragma unroll
            for (int o = 1; o < 64; o <<= 1) { const float up = __int_as_float(__builtin_amdgcn_ds_bpermute(((lane - o) & 63) << 2, __float_as_int(v))); if (lane >= o) v += up; }
            Flocal[(size_t)(t0 + lane) * 8 + wave] = v;
            if (lane == 63) Btot[u * 8 + wave] = v;
        }
        __syncthreads();
    }
}

__device__ __forceinline__ void post_odd(unsigned char* ws, LAS unsigned char* lds, int G, int tid) {
    const bf16* Kb = (const bf16*)(ws + WS_BIG + B_PROJ) + (size_t)S * DM; float* ksum = (float*)(ws + WS_KSUM);
    LAS float* red = (LAS float*)lds;
    for (int u = blockIdx.x; u < 256; u += G) {
        const int n = u >> 2, cg = u & 3, c2 = tid & 127, rg = tid >> 7;
        const bf16* kp = Kb + (size_t)(n * 256 + rg * 64) * DM + cg * 256 + c2 * 2;
        float s0 = 0.f, s1 = 0.f;
#pragma unroll 16
        for (int r = 0; r < 64; ++r) { const unsigned w = *(const GAS unsigned*)(kp + (size_t)r * DM); s0 += bflo(w); s1 += bfhi(w); }
        __syncthreads();
        red[rg * 256 + c2 * 2] = s0; red[rg * 256 + c2 * 2 + 1] = s1;
        __syncthreads();
        if (tid < 256) ksum[(size_t)n * 1024 + cg * 256 + tid] = (red[tid] + red[256 + tid]) + (red[512 + tid] + red[768 + tid]);
    }
}

constexpr int KV_K_BYTES = 8192, KV_VT_PITCH = 136, KV_BUF_BYTES = KV_K_BYTES + 64 * KV_VT_PITCH;
struct KVRegs { v4u k, v; };
__device__ __forceinline__ void kv_load(KVRegs& r, const bf16* Kp, size_t kpitch, const bf16* Vtp, size_t vtpitch, int key0, int tid) {
    r.k = *(const GAS v4u*)(Kp + (size_t)(key0 + (tid & 63)) * kpitch + (tid >> 6) * 8);
    r.v = *(const GAS v4u*)(Vtp + (size_t)(tid >> 3) * vtpitch + key0 + (tid & 7) * 8);
}
__device__ __forceinline__ void kv_store(const KVRegs& r, LAS unsigned char* buf, int tid) {
    *(LAS v4u*)(buf + ((tid >> 6) * 64 + (tid & 63)) * 16) = r.k;
    LAS unsigned char* vp = buf + KV_K_BYTES + (tid >> 3) * KV_VT_PITCH + (tid & 7) * 16;
    *(LAS u32x2*)vp = (u32x2){r.v.x, r.v.y}; *(LAS u32x2*)(vp + 8) = (u32x2){r.v.z, r.v.w};
}
struct AttnAcc { float m, l; f32x16 o0, o1; };
__device__ __forceinline__ void attn_init(AttnAcc& a) { a.m = -INFINITY; a.l = 0.f;
#pragma unroll
    for (int r = 0; r < 16; ++r) { a.o0[r] = 0.f; a.o1[r] = 0.f; } }
template <int CHS = 1024>
__device__ __forceinline__ void attn_scores(f32x16& p0, f32x16& p1, const LAS unsigned char* buf, const bf16x8 (&qf)[4], int lane) {
    const int r32 = lane & 31, hi = lane >> 5;
#pragma unroll
    for (int r = 0; r < 16; ++r) { p0[r] = 0.f; p1[r] = 0.f; }
#pragma unroll
    for (int ks = 0; ks < 4; ++ks) {
        const bf16x8 k0 = *(const LAS bf16x8*)(buf + (2 * ks + hi) * CHS + r32 * 16);
        const bf16x8 k1 = *(const LAS bf16x8*)(buf + (2 * ks + hi) * CHS + (32 + r32) * 16);
        p0 = __builtin_amdgcn_mfma_f32_32x32x16_bf16(k0, qf[ks], p0, 0, 0, 0);
        p1 = __builtin_amdgcn_mfma_f32_32x32x16_bf16(k1, qf[ks], p1, 0, 0, 0);
    }
}
template <int VTP = KV_VT_PITCH, int VOFF = KV_K_BYTES>
__device__ __forceinline__ void attn_update(AttnAcc& a, f32x16& p0, f32x16& p1, const LAS unsigned char* buf, int lane) {
    const int r32 = lane & 31, hi = lane >> 5;
    float mx = fmaxf(p0[0], p1[0]);
#pragma unroll
    for (int r = 1; r < 16; ++r) mx = fmaxf(mx, fmaxf(p0[r], p1[r]));
    mx = sh32_max(mx);
    const float mnew = fmaxf(a.m, mx);
    const float msafe = (mnew == -INFINITY) ? 0.f : mnew;
    const float alpha = __builtin_amdgcn_exp2f(a.m - msafe);
    float sum = 0.f;
#pragma unroll
    for (int r = 0; r < 16; ++r) { p0[r] = __builtin_amdgcn_exp2f(p0[r] - msafe); p1[r] = __builtin_amdgcn_exp2f(p1[r] - msafe); sum += p0[r] + p1[r]; }
    a.l = a.l * alpha + sum; a.m = mnew;
#pragma unroll
    for (int r = 0; r < 16; ++r) { a.o0[r] *= alpha; a.o1[r] *= alpha; }
    const LAS unsigned char* vt = buf + VOFF + r32 * VTP + hi * 8;
#pragma unroll
    for (int half = 0; half < 2; ++half) {
#pragma unroll
        for (int s = 0; s < 2; ++s) {
            v4u pw;
            if (half == 0) { pw.x = cvtpk(p0[8 * s + 0], p0[8 * s + 1]); pw.y = cvtpk(p0[8 * s + 2], p0[8 * s + 3]); pw.z = cvtpk(p0[8 * s + 4], p0[8 * s + 5]); pw.w = cvtpk(p0[8 * s + 6], p0[8 * s + 7]); }
            else           { pw.x = cvtpk(p1[8 * s + 0], p1[8 * s + 1]); pw.y = cvtpk(p1[8 * s + 2], p1[8 * s + 3]); pw.z = cvtpk(p1[8 * s + 4], p1[8 * s + 5]); pw.w = cvtpk(p1[8 * s + 6], p1[8 * s + 7]); }
            const bf16x8 pb = __builtin_bit_cast(bf16x8, pw);
            const int kb = (32 * half + 16 * s) * 2;
#pragma unroll
            for (int d0 = 0; d0 < 2; ++d0) {
                const u32x2 lo = *(const LAS u32x2*)(vt + d0 * 32 * VTP + kb), hi2 = *(const LAS u32x2*)(vt + d0 * 32 * VTP + kb + 16);
                const bf16x8 va = __builtin_bit_cast(bf16x8, (v4u){lo.x, lo.y, hi2.x, hi2.y});
                if (d0 == 0) a.o0 = __builtin_amdgcn_mfma_f32_32x32x16_bf16(va, pb, a.o0, 0, 0, 0);
                else         a.o1 = __builtin_amdgcn_mfma_f32_32x32x16_bf16(va, pb, a.o1, 0, 0, 0);
            }
        }
    }
}
__device__ __forceinline__ void attn_store(const AttnAcc& a, bf16* orow, int lane) {
    const int hi = lane >> 5;
    float l = sh32_sum(a.l);
    const float inv = (l > 0.f) ? 1.0f / l : 0.f;
#pragma unroll
    for (int g = 0; g < 4; ++g) {
        u32x2 w0, w1;
        w0.x = cvtpk(a.o0[4 * g] * inv, a.o0[4 * g + 1] * inv); w0.y = cvtpk(a.o0[4 * g + 2] * inv, a.o0[4 * g + 3] * inv);
        w1.x = cvtpk(a.o1[4 * g] * inv, a.o1[4 * g + 1] * inv); w1.y = cvtpk(a.o1[4 * g + 2] * inv, a.o1[4 * g + 3] * inv);
        *(GAS u32x2*)(orow + 8 * g + 4 * hi) = w0; *(GAS u32x2*)(orow + 32 + 8 * g + 4 * hi) = w1;
    }
}
__device__ __forceinline__ void load_q(bf16x8 (&qf)[4], const bf16* qrow, int lane) {
    const int hi = lane >> 5;
#pragma unroll
    for (int ks = 0; ks < 4; ++ks) qf[ks] = *(const GAS bf16x8*)(qrow + 16 * ks + 8 * hi);
}

constexpr int CW_FOXQ = 64;
__device__ __forceinline__ void fox_phase(const InPtrs& in, unsigned char* ws, LAS unsigned char* lds, int G, int tid, int wave, int lane, bf16* obase, size_t opitch, int qword) {
    bf16* proj = (bf16*)(ws + WS_BIG + B_PROJ); const bf16* VtF = (const bf16*)(ws + WS_BIG + B_VTF);
    const float* Flocal = (const float*)(ws + WS_FL); const float* Btot = Flocal + S * 8;
    unsigned* qctr = (unsigned*)(ws + WS_CTL) + qword;
    LAS unsigned char* kvb = lds; LAS float* kbt = (LAS float*)(lds + 2 * KV_BUF_BYTES); LAS float* bt = (LAS float*)(lds + 2 * KV_BUF_BYTES + 65536); LAS float* Et = bt + 272;
    LAS int* misc = (LAS int*)(Et + 272);
    const int r32 = lane & 31, hi = lane >> 5;
    if (wave == 0) { const float gq = wave_max(fabsf(in.p[8][lane])), gk = wave_max(fabsf(in.p[9][lane])); if (lane == 0) { ((LAS float*)misc)[2] = gq; ((LAS float*)misc)[3] = gk; } }
    __syncthreads();
    const float THR = 2.0f * (0.125f * LOG2E * 64.0f * 1.02f) * ((LAS float*)misc)[2] * ((LAS float*)misc)[3] + 32.0f;
    for (;;) {
        __syncthreads();
        if (tid == 0) misc[0] = (int)atomicAdd(qctr, 1u);
        __syncthreads();
        const int u = misc[0];
        if (u >= 512) break;
        const int QB = 63 - (u >> 3), h = u & 7, q0 = QB * 256, nt = 4 * (QB + 1);
        for (int j = tid; j < nt; j += NTHREADS) bt[j] = Btot[j * 8 + h];
        if (tid == 0) misc[1] = 4 * QB;
        __syncthreads();
        for (int j = tid; j <= nt; j += NTHREADS) { float e = 0.f;
            if (j <= 4 * QB) { for (int i = 4 * QB - 1; i >= j; --i) e -= bt[i]; } else { for (int i = 4 * QB; i < j; ++i) e += bt[i]; }
            Et[j] = e; }
        __syncthreads();
        for (int j = tid; j < 4 * QB; j += NTHREADS) if (Et[j + 1] * LOG2E <= THR) atomicMin((int*)&misc[1], j);
        __syncthreads();
        const int t_start = misc[1], s0 = 64 * t_start;
        for (int s = s0 + tid; s < q0 + 256; s += NTHREADS) kbt[s - s0] = -(Et[s >> 6] + Flocal[(size_t)s * 8 + h]) * LOG2E;
        const int qrow = q0 + wave * 32 + r32;
        bf16x8 qf[4]; load_q(qf, proj + (size_t)qrow * EVEN_NP + EC_FQ + h * 64, lane);
        AttnAcc a; attn_init(a);
        const bf16* Kp = proj + EC_FK + h * 64; const bf16* Vtp = VtF + (size_t)h * 64 * S;
        KVRegs kr; kv_load(kr, Kp, EVEN_NP, Vtp, S, s0, tid); kv_store(kr, kvb, tid);
        __syncthreads();
        const float kbw = kbt[q0 + wave * 32 - s0];
        for (int t = t_start; t < nt; ++t) {
            LAS unsigned char* cur = kvb + ((t - t_start) & 1) * KV_BUF_BYTES;
            if (t + 1 < nt) kv_load(kr, Kp, EVEN_NP, Vtp, S, (t + 1) * 64, tid);
            const int key0 = t * 64;
            const bool vis = key0 <= q0 + wave * 32 + 31;
            const bool live = (key0 + 63 >= q0) || (kbw - kbt[key0 + 63 - s0] <= THR);
            if (vis && __builtin_amdgcn_readfirstlane((int)live)) {
                f32x16 p0, p1; attn_scores(p0, p1, cur, qf, lane);
#pragma unroll
                for (int g = 0; g < 4; ++g) {
                    const f32x4 b0 = *(const LAS f32x4*)(kbt + key0 - s0 + 8 * g + 4 * hi), b1 = *(const LAS f32x4*)(kbt + key0 - s0 + 32 + 8 * g + 4 * hi);
#pragma unroll
                    for (int e = 0; e < 4; ++e) { p0[4 * g + e] = p0[4 * g + e] * C2 + b0[e]; p1[4 * g + e] = p1[4 * g + e] * C2 + b1[e]; }
                }
                if (key0 + 63 > q0 + wave * 32) {
#pragma unroll
                    for (int r = 0; r < 16; ++r) { const int kv = key0 + crow(r, hi); if (kv > qrow) p0[r] = -INFINITY; if (kv + 32 > qrow) p1[r] = -INFINITY; }
                }
                attn_update(a, p0, p1, cur, lane);
            }
            if (t + 1 < nt) kv_store(kr, kvb + ((t + 1 - t_start) & 1) * KV_BUF_BYTES, tid);
            __syncthreads();
        }
        attn_store(a, obase + (size_t)qrow * opitch + h * 64, lane);
    }
}

__device__ __forceinline__ void memattn_phase(const InPtrs& in, unsigned char* ws, int L, LAS unsigned char* lds, int G, int tid, int wave, int lane) {
    const bf16* QM = (const bf16*)(ws + WS_BIG + B_QM); bf16* OM = (bf16*)(ws + WS_BIG + B_OM);
    const bf16* memK = (const bf16*)(ws + WS_MEMK) + (size_t)L * 256 * 256; const bf16* memVt = (const bf16*)(ws + WS_MEMK + 256 * 1024) + (size_t)L * 256 * 256;
    const float* qn = in.p[20] + (size_t)L * 64;
    LAS unsigned char* kvb = lds;
    const int r32 = lane & 31, hi = lane >> 5;
    for (int un = blockIdx.x; un < 256; un += G) {
        const int QB = un >> 2, hm = un & 3, qrow = QB * 256 + wave * 32 + r32;
        bf16x8 qf[4];
        {
            const bf16* qp = QM + (size_t)qrow * MEMW + hm * 64; float x[4][8]; float ss = 0.f;
#pragma unroll
            for (int ks = 0; ks < 4; ++ks) { const v4u w = *(const GAS v4u*)(qp + 16 * ks + 8 * hi); unpack8(w, x[ks]);
#pragma unroll
                for (int j = 0; j < 8; ++j) ss += x[ks][j] * x[ks][j]; }
            ss = sh32_sum(ss);
            const float r = rsqrtf(ss * (1.0f / 64.0f) + RMS_EPS);
#pragma unroll
            for (int ks = 0; ks < 4; ++ks) {
#pragma unroll
                for (int j = 0; j < 8; ++j) x[ks][j] = x[ks][j] * r * qn[16 * ks + 8 * hi + j];
                qf[ks] = __builtin_bit_cast(bf16x8, pack8(x[ks])); }
        }
        AttnAcc a; attn_init(a);
        const bf16* Kp = memK + hm * 64; const bf16* Vtp = memVt + (size_t)hm * 64 * 256;
        __syncthreads();
        KVRegs kr; kv_load(kr, Kp, 256, Vtp, 256, 0, tid); kv_store(kr, kvb, tid);
        __syncthreads();
        for (int t = 0; t < 4; ++t) {
            LAS unsigned char* cur = kvb + (t & 1) * KV_BUF_BYTES;
            if (t + 1 < 4) kv_load(kr, Kp, 256, Vtp, 256, (t + 1) * 64, tid);
            f32x16 p0, p1; attn_scores(p0, p1, cur, qf, lane);
#pragma unroll
            for (int r = 0; r < 16; ++r) { p0[r] *= C2; p1[r] *= C2; }
            attn_update(a, p0, p1, cur, lane);
            if (t + 1 < 4) kv_store(kr, kvb + ((t + 1) & 1) * KV_BUF_BYTES, tid);
            __syncthreads();
        }
        attn_store(a, OM + (size_t)qrow * MEMW + hm * 64, lane);
    }
}

constexpr size_t WS_MSEL = 7 * MiB;
constexpr size_t WS_MLSE = 8 * MiB;
constexpr size_t B_OP0 = 64 * MiB, B_OP1 = 128 * MiB;
__device__ __forceinline__ bool gate_better(float g1, int n1, float g2, int n2) { return g1 > g2 || (g1 == g2 && n1 < n2); }
__device__ __forceinline__ void moba_gate_phase(unsigned char* ws, int G, int wave, int lane) {
    const bf16* Q = (const bf16*)(ws + WS_BIG + B_PROJ); const float* ksum = (const float*)(ws + WS_KSUM); unsigned* selg = (unsigned*)(ws + WS_MSEL);
    const int r32 = lane & 31, hi = lane >> 5;
    const int NW = G * NWAVES;
    const int gwid = (int)blockIdx.x * NWAVES + wave;
    const int per_head = NW / 16;
    if (per_head == 0) return;
    const int h = gwid / per_head, wi = gwid % per_head;
    if (h >= 16) return;
    float af[2][32];
#pragma unroll
    for (int g = 0; g < 2; ++g)
#pragma unroll
        for (int kk = 0; kk < 32; ++kk) af[g][kk] = ksum[(size_t)(32 * g + r32) * 1024 + h * 64 + 2 * kk + hi] * (1.0f / 256.0f);
    for (int tile = wi; tile < S / 32; tile += per_head) {
        const int t = tile * 32 + r32, own = (tile * 32) >> 8;
        float bq[32];
        { const bf16* qp = Q + (size_t)t * DM + h * 64;
#pragma unroll
          for (int c = 0; c < 8; ++c) { const unsigned sh = hi ? 0u : 16u;   const v4u w = *(const GAS v4u*)(qp + 8 * c);
              bq[4 * c + 0] = __uint_as_float((w.x << sh) & 0xffff0000u); bq[4 * c + 1] = __uint_as_float((w.y << sh) & 0xffff0000u);
              bq[4 * c + 2] = __uint_as_float((w.z << sh) & 0xffff0000u); bq[4 * c + 3] = __uint_as_float((w.w << sh) & 0xffff0000u); } }
        float g0 = -INFINITY, g1 = -INFINITY, g2 = -INFINITY; int n0 = 255, n1 = 255, n2 = 255;
#pragma unroll
        for (int g = 0; g < 2; ++g) {
            if (32 * g < own) {
                f32x16 c;
#pragma unroll
                for (int r = 0; r < 16; ++r) c[r] = 0.f;
#pragma unroll
                for (int kk = 0; kk < 32; ++kk) c = __builtin_amdgcn_mfma_f32_32x32x2f32(af[g][kk], bq[kk], c, 0, 0, 0);
#pragma unroll
                for (int r = 0; r < 16; ++r) { const int n = 32 * g + crow(r, hi); const float gv = (n < own) ? c[r] : -INFINITY;
                    if (n < own) {
                        if (gate_better(gv, n, g0, n0)) { g2 = g1; n2 = n1; g1 = g0; n1 = n0; g0 = gv; n0 = n; }
                        else if (gate_better(gv, n, g1, n1)) { g2 = g1; n2 = n1; g1 = gv; n1 = n; }
                        else if (gate_better(gv, n, g2, n2)) { g2 = gv; n2 = n; } } }
            }
        }
        const float p0 = sh32_get(g0, lane), p1 = sh32_get(g1, lane), p2 = sh32_get(g2, lane);
        const int pn0 = __float_as_int(sh32_get(__int_as_float(n0), lane)), pn1 = __float_as_int(sh32_get(__int_as_float(n1), lane)), pn2 = __float_as_int(sh32_get(__int_as_float(n2), lane));
        float fg[3]; int fn[3]; int ia = 0, ib = 0;
#pragma unroll
        for (int k = 0; k < 3; ++k) {
            const float ga = (ia == 0) ? g0 : (ia == 1) ? g1 : (ia == 2) ? g2 : -INFINITY; const int na = (ia == 0) ? n0 : (ia == 1) ? n1 : (ia == 2) ? n2 : 255;
            const float gb = (ib == 0) ? p0 : (ib == 1) ? p1 : (ib == 2) ? p2 : -INFINITY; const int nb = (ib == 0) ? pn0 : (ib == 1) ? pn1 : (ib == 2) ? pn2 : 255;
            const bool ta = (na != 255) && (nb == 255 || gate_better(ga, na, gb, nb));
            if (ta) { fg[k] = ga; fn[k] = na; ++ia; } else { fg[k] = gb; fn[k] = nb; ++ib; }
        }
        (void)fg;
        if (hi == 0) selg[(size_t)h * S + t] = (unsigned)(fn[0] & 255) | ((unsigned)(fn[1] & 255) << 8) | ((unsigned)(fn[2] & 255) << 16);
    }
}
constexpr int MR_KIMG = 32768, MR_VTP = 520, MR_VIMG = 64 * MR_VTP;
__device__ __forceinline__ void moba_route_phase(unsigned char* ws, LAS unsigned char* lds, int G, int tid, int wave, int lane) {
    const bf16* Q = (const bf16*)(ws + WS_BIG + B_PROJ); const bf16* Kb = Q + (size_t)S * DM; const bf16* Vt = (const bf16*)(ws + WS_BIG + B_VTM);
    const unsigned* selg = (const unsigned*)(ws + WS_MSEL); float* lse = (float*)(ws + WS_MLSE);
    LAS unsigned char* kimg = lds; LAS unsigned char* vimg = lds + MR_KIMG;
    LAS int* list = (LAS int*)(lds + MR_KIMG + MR_VIMG);
    LAS int* wtot = list + 2048;
    const int r32 = lane & 31, hi = lane >> 5;
    const int NUNITS = 16 * 280;
    for (int u = blockIdx.x; u < NUNITS; u += G) {
        int c = 0, rem = u;
        while (rem >= 16 * (8 * c + 7)) { rem -= 16 * (8 * c + 7); ++c; }
        const int n = rem >> 4, h = rem & 15;
        const int tlo = max(2048 * c, 256 * (n + 1));
        __syncthreads();
        int myent[4]; bool mysel[4];
#pragma unroll
        for (int i = 0; i < 4; ++i) { const int t = 2048 * c + 512 * i + tid; mysel[i] = false; myent[i] = 0;
            if (t >= tlo) { const unsigned w = selg[(size_t)h * S + t];
                const int slot = ((w & 255u) == (unsigned)n) ? 0 : (((w >> 8) & 255u) == (unsigned)n) ? 1 : (((w >> 16) & 255u) == (unsigned)n) ? 2 : -1;
                if (slot >= 0) { mysel[i] = true; myent[i] = t | (slot << 16); } }
            const unsigned long long mk = __ballot(mysel[i]);
            if (lane == 0) wtot[i * 8 + wave] = __popcll(mk); }
        __syncthreads();
        int cnt = 0;
#pragma unroll
        for (int i = 0; i < 4; ++i) { int base = cnt;
#pragma unroll
            for (int w8 = 0; w8 < 8; ++w8) { const int v = wtot[i * 8 + w8]; if (w8 < wave) base += v; cnt += v; }
            const unsigned long long mk = __ballot(mysel[i]);
            if (mysel[i]) list[base + __popcll(mk & ((1ull << lane) - 1ull))] = myent[i]; }
        { const bf16* Kp = Kb + (size_t)(256 * n) * DM + h * 64; const bf16* Vp = Vt + (size_t)h * 64 * S + 256 * n;
#pragma unroll
          for (int i = 0; i < 4; ++i) { const int piece = tid + 512 * i, key = piece & 255, ch = piece >> 8;
              const v4u kv = *(const GAS v4u*)(Kp + (size_t)key * DM + ch * 8); *(LAS v4u*)(kimg + (ch * 256 + key) * 16) = kv;
              const int d = piece >> 5, c16 = piece & 31;
              const v4u vv = *(const GAS v4u*)(Vp + (size_t)d * S + c16 * 8); LAS unsigned char* vp = vimg + d * MR_VTP + c16 * 16;
              *(LAS u32x2*)vp = (u32x2){vv.x, vv.y}; *(LAS u32x2*)(vp + 8) = (u32x2){vv.z, vv.w}; } }
        __syncthreads();
        if (cnt == 0) continue;
        const int ntile = (cnt + 31) >> 5;
        for (int ti = wave; ti < ntile; ti += NWAVES) {
            const int e = ti * 32 + r32; const bool live = e < cnt;
            const int ent = list[live ? e : 0]; const int t = ent & 0xffff, slot = ent >> 16;
            bf16x8 qf[4]; load_q(qf, Q + (size_t)t * DM + h * 64, lane);
            AttnAcc a; attn_init(a);
#pragma unroll 1
            for (int j = 0; j < 4; ++j) {
                f32x16 p0, p1; attn_scores<4096>(p0, p1, kimg + j * 64 * 16, qf, lane);
#pragma unroll
                for (int r = 0; r < 16; ++r) { p0[r] *= C2; p1[r] *= C2; }
                attn_update<MR_VTP, 0>(a, p0, p1, vimg + j * 128, lane);
            }
            const float l = sh32_sum(a.l); const float inv = 1.0f / l;
            if (live) {
                bf16* orow = (bf16*)(ws + (slot == 0 ? WS_BIG + B_OP0 : slot == 1 ? WS_BIG + B_OP1 : WS_HB)) + ((size_t)t * 16 + h) * 64;
#pragma unroll
                for (int g = 0; g < 4; ++g) { u32x2 w0, w1;
                    w0.x = cvtpk(a.o0[4 * g] * inv, a.o0[4 * g + 1] * inv); w0.y = cvtpk(a.o0[4 * g + 2] * inv, a.o0[4 * g + 3] * inv);
                    w1.x = cvtpk(a.o1[4 * g] * inv, a.o1[4 * g + 1] * inv); w1.y = cvtpk(a.o1[4 * g + 2] * inv, a.o1[4 * g + 3] * inv);
                    *(GAS u32x2*)(orow + 8 * g + 4 * hi) = w0; *(GAS u32x2*)(orow + 32 + 8 * g + 4 * hi) = w1; }
                if (hi == 0) lse[((size_t)slot * S + t) * 16 + h] = a.m + __builtin_amdgcn_logf(l);
            }
        }
    }
}
__device__ __forceinline__ void moba_own_phase(unsigned char* ws, LAS unsigned char* lds, int G, int tid, int wave, int lane) {
    bf16* Q = (bf16*)(ws + WS_BIG + B_PROJ); const bf16* Kb = Q + (size_t)S * DM; const bf16* Vt = (const bf16*)(ws + WS_BIG + B_VTM);
    const unsigned* selg = (const unsigned*)(ws + WS_MSEL); const float* lse = (const float*)(ws + WS_MLSE);
    LAS unsigned char* kvb = lds;
    const int r32 = lane & 31, hi = lane >> 5;
    for (int un = blockIdx.x; un < 1024; un += G) {
        const int h = un & 15, QB = un >> 4, q0 = QB * 256, qrow = q0 + wave * 32 + r32;
        bf16x8 qf[4]; load_q(qf, Q + (size_t)qrow * DM + h * 64, lane);
        AttnAcc a; attn_init(a);
        const bf16* Kp = Kb + h * 64; const bf16* Vtp = Vt + (size_t)h * 64 * S;
        __syncthreads();
        KVRegs kr; kv_load(kr, Kp, DM, Vtp, S, q0, tid); kv_store(kr, kvb, tid);
        __syncthreads();
        for (int t = 0; t < 4; ++t) {
            LAS unsigned char* cur = kvb + (t & 1) * KV_BUF_BYTES;
            const int key0 = q0 + t * 64;
            if (t + 1 < 4) kv_load(kr, Kp, DM, Vtp, S, key0 + 64, tid);
            if (key0 <= q0 + wave * 32 + 31) {
                f32x16 p0, p1; attn_scores(p0, p1, cur, qf, lane);
#pragma unroll
                for (int r = 0; r < 16; ++r) { const int kv = key0 + crow(r, hi); p0[r] = (kv > qrow) ? -INFINITY : p0[r] * C2; p1[r] = (kv + 32 > qrow) ? -INFINITY : p1[r] * C2; }
                attn_update(a, p0, p1, cur, lane);
            }
            if (t + 1 < 4) kv_store(kr, kvb + ((t + 1) & 1) * KV_BUF_BYTES, tid);
            __syncthreads();
        }
        const unsigned sw = selg[(size_t)h * S + qrow];
        float L[3];
#pragma unroll
        for (int j = 0; j < 3; ++j) L[j] = (((sw >> (8 * j)) & 255u) != 255u) ? lse[((size_t)j * S + qrow) * 16 + h] : -INFINITY;
        const float M = fmaxf(fmaxf(a.m, L[0]), fmaxf(L[1], L[2]));
        const float so = __builtin_amdgcn_exp2f(a.m - M);
        float W = sh32_sum(a.l) * so;
#pragma unroll
        for (int r = 0; r < 16; ++r) { a.o0[r] *= so; a.o1[r] *= so; }
#pragma unroll
        for (int j = 0; j < 3; ++j) {
            if (L[j] != -INFINITY) {
                const float wj = __builtin_amdgcn_exp2f(L[j] - M); W += wj;
                const bf16* orow = (const bf16*)(ws + (j == 0 ? WS_BIG + B_OP0 : j == 1 ? WS_BIG + B_OP1 : WS_HB)) + ((size_t)qrow * 16 + h) * 64;
#pragma unroll
                for (int g = 0; g < 4; ++g) { const u32x2 w0 = *(const GAS u32x2*)(orow + 8 * g + 4 * hi), w1 = *(const GAS u32x2*)(orow + 32 + 8 * g + 4 * hi);
                    a.o0[4 * g] += wj * bflo(w0.x); a.o0[4 * g + 1] += wj * bfhi(w0.x); a.o0[4 * g + 2] += wj * bflo(w0.y); a.o0[4 * g + 3] += wj * bfhi(w0.y);
                    a.o1[4 * g] += wj * bflo(w1.x); a.o1[4 * g + 1] += wj * bfhi(w1.x); a.o1[4 * g + 2] += wj * bflo(w1.y); a.o1[4 * g + 3] += wj * bfhi(w1.y); }
            }
        }
        const float inv = 1.0f / W;
        bf16* orow = Q + (size_t)qrow * DM + h * 64;
#pragma unroll
        for (int g = 0; g < 4; ++g) { u32x2 w0, w1;
            w0.x = cvtpk(a.o0[4 * g] * inv, a.o0[4 * g + 1] * inv); w0.y = cvtpk(a.o0[4 * g + 2] * inv, a.o0[4 * g + 3] * inv);
            w1.x = cvtpk(a.o1[4 * g] * inv, a.o1[4 * g + 1] * inv); w1.y = cvtpk(a.o1[4 * g + 2] * inv, a.o1[4 * g + 3] * inv);
            *(GAS u32x2*)(orow + 8 * g + 4 * hi) = w0; *(GAS u32x2*)(orow + 32 + 8 * g + 4 * hi) = w1; }
    }
}

typedef float f32x4v __attribute__((ext_vector_type(4)));
__device__ __forceinline__ unsigned mono_key(float s) { if (s == 0.f) s = 0.f; const unsigned u = __float_as_uint(s); return (u & 0x80000000u) ? ~u : (u | 0x80000000u); }
constexpr int DS_CAP = 512;
__device__ __forceinline__ unsigned wave_or(unsigned v) { v |= (unsigned)shx_i<1>((int)v); v |= (unsigned)shx_i<2>((int)v); v |= (unsigned)shx_i<4>((int)v); v |= (unsigned)shx_i<8>((int)v); v |= (unsigned)shx_i<16>((int)v);
    auto r = __builtin_amdgcn_permlane32_swap(v, v, false, false); return r[0] | r[1]; }
template <bool EXACT>
__device__ __forceinline__ unsigned dsa_compact(LAS u32x2* ent, int n, int& nkeep, int lane) {
    unsigned k[8]; unsigned ix[8]; unsigned orv = 0u, nandv = 0u;
#pragma unroll
    for (int j = 0; j < 8; ++j) { const int e = lane + 64 * j; const bool in = e < n; const u32x2 v = ent[in ? e : 0]; k[j] = in ? v.x : 0u; ix[j] = v.y; orv |= k[j]; nandv |= in ? ~v.x : 0u; }
    unsigned T = 0u; int cntT = n; int bit0 = 31;
    if (!EXACT) {
        const unsigned diff = (unsigned)__builtin_amdgcn_readfirstlane((int)(wave_or(orv) & wave_or(nandv)));
        if (diff != 0u) { bit0 = 31 - __builtin_clz(diff); const unsigned anyk = (unsigned)__builtin_amdgcn_readfirstlane((int)k[0]);
            T = (bit0 == 31) ? 0u : (anyk & ~((2u << bit0) - 1u)); }
    }
    for (int bit = bit0; bit >= 0; --bit) {
        const unsigned cand = T | (1u << bit); int c = 0;
#pragma unroll
        for (int j = 0; j < 8; ++j) c += __popcll(__ballot(k[j] >= cand));
        if (c >= 256) { T = cand; cntT = c; if (!EXACT && c <= 320) break; }
    }
    int Jstar = 0x10000;
    if (cntT > (EXACT ? 256 : 320)) {
        int gt = 0;
#pragma unroll
        for (int j = 0; j < 8; ++j) gt += __popcll(__ballot(k[j] > T));
        const int need = 256 - gt; int Jm = 0;
        for (int bit = 14; bit >= 0; --bit) { const int cand = Jm | (1 << bit); int c = 0;
#pragma unroll
            for (int j = 0; j < 8; ++j) c += __popcll(__ballot(k[j] == T && (int)ix[j] < cand));
            if (c < need) Jm = cand; }
        Jstar = Jm + 1;
    }
    int base = 0;
    const unsigned long long lt = (1ull << lane) - 1ull;
#pragma unroll
    for (int j = 0; j < 8; ++j) { const bool pred = (k[j] > T) || (k[j] == T && T != 0u && (int)ix[j] < Jstar);
        const unsigned long long mask = __ballot(pred); const int pos = base + __popcll(mask & lt);
        if (pred) ent[pos] = (u32x2){k[j], ix[j]};
        base += __popcll(mask); }
    nkeep = base;
    return T;
}
#define DSA_HEADSUM(s, P, B, W) asm("v_max_f32_e32 %1, 0, %2\n\tv_mul_f32_e32 %0, %10, %1\n\tv_max_f32_e32 %1, 0, %3\n\tv_fmac_f32_e32 %0, %11, %1\n\tv_max_f32_e32 %1, 0, %4\n\tv_fmac_f32_e32 %0, %12, %1\n\t" \
        "v_max_f32_e32 %1, 0, %5\n\tv_fmac_f32_e32 %0, %13, %1\n\tv_max_f32_e32 %1, 0, %6\n\tv_fmac_f32_e32 %0, %14, %1\n\tv_max_f32_e32 %1, 0, %7\n\tv_fmac_f32_e32 %0, %15, %1\n\t" \
        "v_max_f32_e32 %1, 0, %8\n\tv_fmac_f32_e32 %0, %16, %1\n\tv_max_f32_e32 %1, 0, %9\n\tv_fmac_f32_e32 %0, %17, %1" \
        : "=&v"(s), "=&v"(tmp_) : "v"(P[B + 0]), "v"(P[B + 1]), "v"(P[B + 2]), "v"(P[B + 3]), "v"(P[B + 4]), "v"(P[B + 5]), "v"(P[B + 6]), "v"(P[B + 7]), \
          "v"(W[0]), "v"(W[1]), "v"(W[2]), "v"(W[3]), "v"(W[4]), "v"(W[5]), "v"(W[6]), "v"(W[7]))
__device__ __forceinline__ float unmono_f(unsigned u) { return __uint_as_float((u & 0x80000000u) ? (u ^ 0x80000000u) : ~u); }
struct DsaState { float tf0, tf1; int cnt0, cnt1; };
template <bool NOCOMPACT = false>
__device__ __forceinline__ void dsa_tile(const bf16x8 (&af)[4], const bf16x8 (&bc)[4], const float (&w0)[8], const float (&w1)[8], int key0, int q0t, int q1t, DsaState& st,
                                         LAS u32x2* ents, int lane) {
    const int r32 = lane & 31, hi = lane >> 5;
    f32x16 p;
#pragma unroll
    for (int r = 0; r < 16; ++r) p[r] = 0.f;
#pragma unroll
    for (int ks = 0; ks < 4; ++ks) p = __builtin_amdgcn_mfma_f32_32x32x16_bf16(af[ks], bc[ks], p, 0, 0, 0);
    asm volatile("s_nop 15\n\ts_nop 7" : "+v"(p));
    float s0, s1, tmp_;
    DSA_HEADSUM(s0, p, 0, w0); DSA_HEADSUM(s1, p, 8, w1);
    const int key = key0 + r32;
    const bool pr0 = (key <= q0t) && (s0 >= st.tf0), pr1 = (key <= q1t) && (s1 >= st.tf1);
    const unsigned long long m0 = __ballot(pr0), m1 = __ballot(pr1);
    if (m0 | m1) {
        const unsigned h0 = hi ? (unsigned)(m0 >> 32) : (unsigned)m0, h1 = hi ? (unsigned)(m1 >> 32) : (unsigned)m1;
        const unsigned lowmask = (1u << r32) - 1u;
        if (pr0) ents[hi * DS_CAP + st.cnt0 + __popc(h0 & lowmask)] = (u32x2){mono_key(s0), (unsigned)key};
        if (pr1) ents[(2 + hi) * DS_CAP + st.cnt1 + __popc(h1 & lowmask)] = (u32x2){mono_key(s1), (unsigned)key};
        st.cnt0 += __popc(h0); st.cnt1 += __popc(h1);
        const unsigned long long need = __ballot(max(st.cnt0, st.cnt1) > DS_CAP - 32);
        if (need) {
#pragma unroll 1
            for (int hh = 0; hh < 2; ++hh) {
                const int c0 = __builtin_amdgcn_readlane(st.cnt0, 0), c0b = __builtin_amdgcn_readlane(st.cnt0, 32);
                const int c1 = __builtin_amdgcn_readlane(st.cnt1, 0), c1b = __builtin_amdgcn_readlane(st.cnt1, 32);
                const int n0 = hh ? c0b : c0, n1 = hh ? c1b : c1;
                if (NOCOMPACT) { if (n0 > DS_CAP - 32 && hi == hh) st.cnt0 = 256; if (n1 > DS_CAP - 32 && hi == hh) st.cnt1 = 256; continue; }
                if (n0 > DS_CAP - 32) { int nk; const unsigned T = dsa_compact<false>(ents + hh * DS_CAP, n0, nk, lane); if (hi == hh) { st.tf0 = unmono_f(T + 1u); st.cnt0 = nk; } }
                if (n1 > DS_CAP - 32) { int nk; const unsigned T = dsa_compact<false>(ents + (2 + hh) * DS_CAP, n1, nk, lane); if (hi == hh) { st.tf1 = unmono_f(T + 1u); st.cnt1 = nk; } }
            }
        }
    }
}
template <bool NOCOMPACT = false>
__device__ __forceinline__ void dsa_select_phase(unsigned char* ws, LAS unsigned char* lds, int G, int tid, int wave, int lane) {
    const bf16* proj = (const bf16*)(ws + WS_BIG + B_PROJ); const bf16* IKc = (const bf16*)(ws + WS_BIG + B_IKC); const float* IW = (const float*)(ws + WS_IW);
    unsigned short* selg = (unsigned short*)(ws + WS_BIG + B_SEL);
    LAS u32x2* ents = (LAS u32x2*)lds + wave * 4 * DS_CAP;
    const int r32 = lane & 31, hi = lane >> 5;
    const int NWG = G * NWAVES, gw = (int)blockIdx.x * NWAVES + wave;
    for (int pu = gw; pu < 2048; pu += NWG) {
        for (int uu = 0; uu < 2; ++uu) {
            const int unit = uu ? 4095 - pu : pu, tw = unit * 4;
            bf16x8 af[4];
            { const int i = r32, qi = 2 * (i >> 4) + ((i >> 2) & 1), hd = 4 * ((i >> 3) & 1) + (i & 3);
              const bf16* ap = proj + (size_t)(tw + qi) * EVEN_NP + EC_IQ + hd * 64 + 8 * hi;
#pragma unroll
              for (int ks = 0; ks < 4; ++ks) af[ks] = *(const GAS bf16x8*)(ap + 16 * ks); }
            float w0[8], w1[8];
            { const f32x4 a = *(const GAS f32x4*)(IW + (size_t)(tw + hi) * 8), b = *(const GAS f32x4*)(IW + (size_t)(tw + hi) * 8 + 4);
              const f32x4 c = *(const GAS f32x4*)(IW + (size_t)(tw + 2 + hi) * 8), d = *(const GAS f32x4*)(IW + (size_t)(tw + 2 + hi) * 8 + 4);
#pragma unroll
              for (int j = 0; j < 4; ++j) { w0[j] = a[j]; w0[4 + j] = b[j]; w1[j] = c[j]; w1[4 + j] = d[j]; } }
            const int q0t = tw + hi, q1t = tw + 2 + hi;
            DsaState st; st.tf0 = -INFINITY; st.tf1 = -INFINITY; st.cnt0 = 0; st.cnt1 = 0;
            const int ntile = ((tw + 3) >> 5) + 1;
            const bf16* kp = IKc + (size_t)lane * 8; asm volatile("" : "+v"(kp));
            bf16x8 bA[4], bB[4];
#define DSA_LOADB(dst, jj) do { const bf16* p_ = kp + (size_t)(jj) * 2048; \
                asm volatile("global_load_dwordx4 %0, %4, off\n\tglobal_load_dwordx4 %1, %4, off offset:1024\n\tglobal_load_dwordx4 %2, %4, off offset:2048\n\tglobal_load_dwordx4 %3, %4, off offset:3072" \
                             : "=&v"(dst[0]), "=&v"(dst[1]), "=&v"(dst[2]), "=&v"(dst[3]) : "v"(p_) : "memory"); } while (0)
#define DSA_WAITB(dst, n) asm volatile("s_waitcnt vmcnt(" #n ")" : "+v"(dst[0]), "+v"(dst[1]), "+v"(dst[2]), "+v"(dst[3]) :: "memory")
            asm volatile("" : "+v"(af[0]), "+v"(af[1]), "+v"(af[2]), "+v"(af[3]));
#pragma unroll
            for (int r = 0; r < 8; ++r) asm volatile("" : "+v"(w0[r]), "+v"(w1[r]));
            DSA_LOADB(bA, 0);
#pragma unroll 1
            for (int j = 0; j < ntile; j += 2) {
                DSA_LOADB(bB, min(j + 1, ntile - 1));
                DSA_WAITB(bA, 4);
                dsa_tile<NOCOMPACT>(af, bA, w0, w1, 32 * j, q0t, q1t, st, ents, lane);
                DSA_LOADB(bA, min(j + 2, ntile - 1));
                DSA_WAITB(bB, 4);
                if (j + 1 < ntile) dsa_tile<NOCOMPACT>(af, bB, w0, w1, 32 * (j + 1), q0t, q1t, st, ents, lane);
            }
            DSA_WAITB(bA, 0);
#undef DSA_LOADB
#undef DSA_WAITB
            const int cnt0 = st.cnt0, cnt1 = st.cnt1;
#pragma unroll 1
            for (int qq = 0; qq < 4; ++qq) {
                const int hh = qq & 1, sl = qq >> 1;
                int n = sl ? __builtin_amdgcn_readlane(cnt1, 32 * hh) : __builtin_amdgcn_readlane(cnt0, 32 * hh);
                LAS u32x2* ee = ents + qq * DS_CAP;
                if (n > 256) { int nk = 256; if (!NOCOMPACT) (void)dsa_compact<true>(ee, n, nk, lane); n = 256; }
                unsigned short* row = selg + (size_t)(tw + qq) * 256;
#pragma unroll
                for (int e4 = 0; e4 < 4; ++e4) { const int e = lane + 64 * e4; row[e] = (e < n) ? (unsigned short)ee[e].y : (unsigned short)0xFFFFu; }
            }
        }
    }
}

typedef __bf16 bf16x2v __attribute__((ext_vector_type(2)));
__device__ __forceinline__ float dot2bf(unsigned a, unsigned b, float acc) { return __builtin_amdgcn_fdot2_f32_bf16(__builtin_bit_cast(bf16x2v, a), __builtin_bit_cast(bf16x2v, b), acc, false); }
__device__ __forceinline__ void dsa_sparse_phase(unsigned char* ws, int G, int wave, int lane, bf16* obase, size_t opitch) {
    const bf16* proj = (const bf16*)(ws + WS_BIG + B_PROJ); const unsigned short* selg = (const unsigned short*)(ws + WS_BIG + B_SEL);
    const int h = (int)blockIdx.x & 7, wg = (int)blockIdx.x >> 3, nwg = G >> 3;
    const int kg = lane >> 3, ds8 = (lane & 7) * 8;
    for (int t = wg * NWAVES + wave; t < S; t += nwg * NWAVES) {
        v4u iw[4];
#pragma unroll
        for (int c = 0; c < 4; ++c) iw[c] = *(const GAS v4u*)(selg + (size_t)t * 256 + 32 * kg + 8 * c);
        const v4u qw = *(const GAS v4u*)(proj + (size_t)t * EVEN_NP + EC_DQ + h * 64 + ds8);
        float sc[32];
#pragma unroll
        for (int i0 = 0; i0 < 32; i0 += 8) {
            v4u kw[8];
#pragma unroll
            for (int j = 0; j < 8; ++j) { const int i = i0 + j; const unsigned wd = (i & 1) ? (iw[i >> 3][(i >> 1) & 3] >> 16) : (iw[i >> 3][(i >> 1) & 3] & 0xffffu);
                const unsigned idx = (wd == 0xffffu) ? 0u : wd;
                kw[j] = *(const GAS v4u*)(proj + (size_t)idx * EVEN_NP + EC_DK + h * 64 + ds8); }
#pragma unroll
            for (int j = 0; j < 8; ++j) { const int i = i0 + j; const unsigned wd = (i & 1) ? (iw[i >> 3][(i >> 1) & 3] >> 16) : (iw[i >> 3][(i >> 1) & 3] & 0xffffu);
                float d = dot2bf(qw.x, kw[j].x, 0.f); d = dot2bf(qw.y, kw[j].y, d); d = dot2bf(qw.z, kw[j].z, d); d = dot2bf(qw.w, kw[j].w, d);
                d += shx<1>(d); d += shx<2>(d); d += shx<4>(d);
                sc[i] = (wd == 0xffffu) ? -INFINITY : d * C2; }
        }
        float mx = sc[0];
#pragma unroll
        for (int i = 1; i < 32; ++i) mx = fmaxf(mx, sc[i]);
        mx = fmaxf(mx, shx<8>(mx)); mx = fmaxf(mx, shx<16>(mx)); mx = sh32_max(mx);
        float l = 0.f;
#pragma unroll
        for (int i = 0; i < 32; ++i) { sc[i] = __builtin_amdgcn_exp2f(sc[i] - mx); l += sc[i]; }
        l += shx<8>(l); l += shx<16>(l); l = sh32_sum(l);
        float acc[8];
#pragma unroll
        for (int e = 0; e < 8; ++e) acc[e] = 0.f;
#pragma unroll
        for (int i0 = 0; i0 < 32; i0 += 8) {
            v4u vw[8];
#pragma unroll
            for (int j = 0; j < 8; ++j) { const int i = i0 + j; const unsigned wd = (i & 1) ? (iw[i >> 3][(i >> 1) & 3] >> 16) : (iw[i >> 3][(i >> 1) & 3] & 0xffffu);
                const unsigned idx = (wd == 0xffffu) ? 0u : wd;
                vw[j] = *(const GAS v4u*)(proj + (size_t)idx * EVEN_NP + EC_DV + h * 64 + ds8); }
#pragma unroll
            for (int j = 0; j < 8; j += 2) {
                const unsigned pp = cvtpk(sc[i0 + j], sc[i0 + j + 1]);
                const v4u a = vw[j], b = vw[j + 1];
                acc[0] = dot2bf(pp, __builtin_amdgcn_perm(b.x, a.x, 0x05040100u), acc[0]); acc[1] = dot2bf(pp, __builtin_amdgcn_perm(b.x, a.x, 0x07060302u), acc[1]);
                acc[2] = dot2bf(pp, __builtin_amdgcn_perm(b.y, a.y, 0x05040100u), acc[2]); acc[3] = dot2bf(pp, __builtin_amdgcn_perm(b.y, a.y, 0x07060302u), acc[3]);
                acc[4] = dot2bf(pp, __builtin_amdgcn_perm(b.z, a.z, 0x05040100u), acc[4]); acc[5] = dot2bf(pp, __builtin_amdgcn_perm(b.z, a.z, 0x07060302u), acc[5]);
                acc[6] = dot2bf(pp, __builtin_amdgcn_perm(b.w, a.w, 0x05040100u), acc[6]); acc[7] = dot2bf(pp, __builtin_amdgcn_perm(b.w, a.w, 0x07060302u), acc[7]);
            }
        }
        const float inv = 1.0f / l;
#pragma unroll
        for (int e = 0; e < 8; ++e) { float a = acc[e]; a += shx<8>(a); a += shx<16>(a); a = sh32_sum(a); acc[e] = a * inv; }
        if (kg == 0) *(GAS v4u*)(obase + (size_t)t * opitch + h * 64 + ds8) = pack8(acc);
    }
}

struct Args { InPtrs in; float* out; unsigned char* ws; int ph_lo, ph_hi, li, pad; };
constexpr int PH_PER_LAYER = 14, N_PHASES = 1 + 2 * PH_PER_LAYER - 1;

__global__ void __launch_bounds__(NTHREADS, 2) hyb_fwd(Args args) {
    extern __shared__ __attribute__((aligned(16))) unsigned char lds_raw[];
    LAS unsigned char* lds = (LAS unsigned char*)lds_raw;
    volatile LAS unsigned* MISC = (volatile LAS unsigned*)(lds + MISC_OFF);
    const int tid = threadIdx.x, lane = tid & 63, wave = __builtin_amdgcn_readfirstlane(tid >> 6);
    const int G = gridDim.x;
    const int vcu = (G % 8 == 0) ? ((int)blockIdx.x % 8) * (G / 8) + (int)blockIdx.x / 8 : (int)blockIdx.x;
    unsigned char* ws = args.ws;
    gu32* ctl = (gu32*)(ws + WS_CTL);
    for (int u = tid; u < (LDS_BYTES - LDSCTL_OFF) / 4; u += NTHREADS) ((LAS unsigned*)(lds + LDSCTL_OFF))[u] = 0u;
    __syncthreads();
    XcdBarrier bar = xcd_barrier_post((unsigned*)(ctl + CW_BAR) + args.li * XCD_BAR_WORDS, MISC + 8);
    const int tid0 = tid; unsigned char* const ws0 = ws;
    for (int ph = args.ph_lo; ph < args.ph_hi; ++ph) {
        int tid = tid0; asm volatile("" : "+v"(tid));
        unsigned char* ws = ws0; asm volatile("" : "+s"(ws));
        const int lane = tid & 63, wave = __builtin_amdgcn_readfirstlane(tid >> 6);
        LAS unsigned char* lds = (LAS unsigned char*)lds_raw; { unsigned lo_ = (unsigned)(uintptr_t)lds; asm volatile("" : "+s"(lo_)); lds = (LAS unsigned char*)(uintptr_t)lo_; }
        float* ssqA = (float*)(ws + WS_SSQ);
        bf16* HB = (bf16*)(ws + WS_HB);
        unsigned char* Wr = ws + WS_W;
        unsigned char* BIG = ws + WS_BIG;
        const int gw = vcu * NWAVES + wave, NGW = G * NWAVES;
        if (ph == 0) {
#ifdef PROBE_P02
            conv_weights(args.in, ws, 0, lds, gw, NGW, wave, lane);
            copy_x(args.in.p[0], args.out, HB, ssqA, gw, NGW, lane);
            rope_tables((float*)(ws + WS_ROPE), (float*)(ws + WS_ROPE) + S * 8, (int)blockIdx.x * NTHREADS + tid, G * NTHREADS);
            __syncthreads();
            for (int w = blockIdx.x; w < MEMT; w += G) mem_kv(args.in, ws, lds, w, tid, wave, lane);
            __syncthreads();
#endif
#ifndef NO_P0
            conv_weights(args.in, ws, 0, lds, gw, NGW, wave, lane);
            copy_x(args.in.p[0], args.out, HB, ssqA, gw, NGW, lane);
            if (blockIdx.x == 0 && tid < 384) { const int gi = tid >> 6, d = tid & 63;
                float v;
                if (gi == 0) v = args.in.p[8][d]; else if (gi == 1) v = args.in.p[10][d]; else if (gi == 2) v = args.in.p[9][d]; else if (gi == 3) v = args.in.p[11][d]; else if (gi == 4) v = args.in.p[13][d]; else v = args.in.p[14][d];
                ((float*)(ws + WS_GT))[tid] = v; }
            rope_tables((float*)(ws + WS_ROPE), (float*)(ws + WS_ROPE) + S * 8, (int)blockIdx.x * NTHREADS + tid, G * NTHREADS);
            __syncthreads();
            for (int w = blockIdx.x; w < MEMT; w += G) mem_kv(args.in, ws, lds, w, tid, wave, lane);
#endif
        } else {
            const int L = (ph - 1) / PH_PER_LAYER, sub = (ph - 1) % PH_PER_LAYER;
            const bool even = (L & 1) == 0;
            float* ssq_in = ssqA;
            if (sub == 0 || sub == 11) {
                pg8::Gemm g{(const pg8::bf16_t*)HB, (const pg8::bf16_t*)(Wr + (sub == 0 ? W_FFN1_IN : W_FFN2_IN)), S, FF2, DM, DM};
                pg8::StaticOrder So; So.init(S, FF2, G, (int)blockIdx.x);
                pg8::EpiSwiGLU E{(pg8::bf16_t*)(BIG + B_U), ssq_in, FF};
#ifdef PROBE_GEMM2
                pg8::gemm_phase<pg8::EpiSwiGLU, pg8::StaticOrder, true, true>(lds, g, So, E, tid); __syncthreads();
#endif
                pg8::gemm_phase<pg8::EpiSwiGLU, pg8::StaticOrder, true, true>(lds, g, So, E, tid);
            } else if (sub == 1 || sub == 7 || sub == 10 || sub == 12) {
                pg8::Gemm g; float scale; int so;
                if (sub == 1)       { g = pg8::Gemm{(const pg8::bf16_t*)(BIG + B_U), (const pg8::bf16_t*)(Wr + W_FFN1_OUT), S, DM, FF, FF}; scale = 0.5f; so = 1; }
                else if (sub == 7)  { g = pg8::Gemm{(const pg8::bf16_t*)(BIG + B_PROJ), (const pg8::bf16_t*)(Wr + W_MIX_OUT), S, DM, DM, even ? EVEN_NP : DM}; scale = 1.0f; so = 2; }
                else if (sub == 10)  { g = pg8::Gemm{(const pg8::bf16_t*)(BIG + B_OM), (const pg8::bf16_t*)(Wr + W_MEMO), S, DM, MEMW, MEMW}; scale = 1.0f; so = 3; }
                else                { g = pg8::Gemm{(const pg8::bf16_t*)(BIG + B_U), (const pg8::bf16_t*)(Wr + W_FFN2_OUT), S, DM, FF, FF}; scale = 0.5f; so = 4; }
                const bool last = (sub == 12 && L == NLAYER - 1);
                pg8::StaticOrder So; So.init(S, DM, G, (int)blockIdx.x);
                pg8::EpiResid E{args.out, last ? nullptr : (pg8::bf16_t*)HB, last ? nullptr : ssqA, scale};
                pg8::gemm_phase<pg8::EpiResid, pg8::StaticOrder, true, true>(lds, g, So, E, tid);
#ifdef PROBE_GEMM2
                { __syncthreads(); pg8::EpiResid E0 = E; E0.scale = 0.f; pg8::gemm_phase<pg8::EpiResid, pg8::StaticOrder, true, true>(lds, g, So, E0, tid); }
#endif
            } else if (sub == 2) {
                const int N = even ? EVEN_NP : ODD_N;
                pg8::Gemm g{(const pg8::bf16_t*)HB, (const pg8::bf16_t*)(Wr + W_MIX_IN), S, N, DM, DM};
                pg8::EpiProj E;
                E.O = (pg8::bf16_t*)(BIG + B_PROJ); E.ldc = even ? EVEN_NP : DM; E.ssq = ssq_in; E.split_cols = even ? 0 : DM; E.split_stride = (size_t)S * DM; E.even = even ? 1 : 0;
                E.gtab = (const float*)(ws + WS_GT);
                E.cosT = (const float*)(ws + WS_ROPE); E.sinT = E.cosT + S * 8;
                E.Vt = (pg8::bf16_t*)(BIG + (even ? B_VTF : B_VTM)); E.IKf = (pg8::bf16_t*)(BIG + B_IKC);
                E.xch = (LAS float*)(lds + 131072);
                pg8::StaticOrder So; So.init(S, N, G, (int)blockIdx.x);
                pg8::gemm_phase<pg8::EpiProj, pg8::StaticOrder, true, true>(lds, g, So, E, tid);
            } else if (sub == 8) {
                pg8::Gemm g{(const pg8::bf16_t*)HB, (const pg8::bf16_t*)(Wr + W_MEMQ), S, MEMW, DM, DM};
                pg8::EpiScale E{(pg8::bf16_t*)(BIG + B_QM), MEMW, ssq_in, 0, 0};
                pg8::StaticOrder So; So.init(S, g.N, G, (int)blockIdx.x);
#ifdef PROBE_GEMM2
                pg8::gemm_phase<pg8::EpiScale, pg8::StaticOrder, true, true>(lds, g, So, E, tid); __syncthreads();
#endif
                pg8::gemm_phase<pg8::EpiScale, pg8::StaticOrder, true, true>(lds, g, So, E, tid);
            } else if (sub == 3) {
                if (even) post_even(args.in, ws, args.out, ssq_in, lds, G, tid, wave, lane);
                else post_odd(ws, lds, G, tid);
            } else if (sub == 4) {
                if (even) {
                    int nrep = 1;
#ifdef PROBE_DSA2
                    nrep = 2;
#endif
                    asm volatile("" : "+s"(nrep));
#ifdef PROBE_SELNC
                    dsa_select_phase<true>(ws, lds, G, tid, wave, lane); __syncthreads();
#endif
                    for (int rep = 0; rep < nrep; ++rep) { dsa_select_phase<false>(ws, lds, G, tid, wave, lane); __syncthreads(); }
                } else {
                    moba_gate_phase(ws, G, wave, lane);
                }
            } else if (sub == 5) {
                if (even) {
                    bf16* projb = (bf16*)(BIG + B_PROJ);
#ifdef PROBE_FOX2
                    fox_phase(args.in, ws, lds, G, tid, wave, lane, HB, 512, CW_FOXQ + 64); __syncthreads();
#endif
#ifdef PROBE_SPARSE2
                    dsa_sparse_phase(ws, G, wave, lane, HB, 512);
#endif
                    fox_phase(args.in, ws, lds, G, tid, wave, lane, projb + EC_FQ, EVEN_NP, CW_FOXQ);
                    dsa_sparse_phase(ws, G, wave, lane, projb + EC_DQ, EVEN_NP);
                } else {
#ifdef PROBE_MOBA2
                    moba_route_phase(ws, lds, G, tid, wave, lane); __syncthreads();
#endif
                    moba_route_phase(ws, lds, G, tid, wave, lane);
                }
            } else if (sub == 6) {
                if (!even) moba_own_phase(ws, lds, G, tid, wave, lane);
            } else if (sub == 9) {
#ifdef PROBE_MEM2
                memattn_phase(args.in, ws, L, lds, G, tid, wave, lane); __syncthreads();
#endif
                memattn_phase(args.in, ws, L, lds, G, tid, wave, lane);
            } else if (sub == 13) {
#ifdef PROBE_P02
                conv_weights(args.in, ws, L + 1, lds, gw, NGW, wave, lane); __syncthreads();
#endif
                conv_weights(args.in, ws, L + 1, lds, gw, NGW, wave, lane);
            }
        }
        if (ph + 1 < args.ph_hi) xcd_barrier(bar);
#ifdef PROBE_BAR2
        if (ph + 1 < args.ph_hi) xcd_barrier(bar);
#endif
    }
}

#ifndef MK_N_LAUNCHES
#define MK_N_LAUNCHES 1
#endif
extern "C" void kernel_launch(void* const* d_in, const int* in_sizes, int n_in, void* d_out, int out_size, void* d_ws, size_t ws_size, hipStream_t stream) {
    static int grid = 0;
    if (grid == 0) {
        if (n_in != 26 || in_sizes[0] != S * DM || out_size != S * DM || ws_size < WS_END) {
            fprintf(stderr, "kernel_launch: unexpected problem (n_in %d, in0 %d, out %d, ws %zu); nothing launched\n", n_in, n_in > 0 ? in_sizes[0] : -1, out_size, ws_size); grid = -1; return; }
        int dev = 0, cus = 0, per_cu = 0;
        if (hipGetDevice(&dev) != hipSuccess || hipDeviceGetAttribute(&cus, hipDeviceAttributeMultiprocessorCount, dev) != hipSuccess) { grid = -1; return; }
        if (hipFuncSetAttribute((const void*)hyb_fwd, hipFuncAttributeMaxDynamicSharedMemorySize, LDS_BYTES) != hipSuccess) { fprintf(stderr, "kernel_launch: hipFuncSetAttribute failed\n"); grid = -1; return; }
        if (hipOccupancyMaxActiveBlocksPerMultiprocessor(&per_cu, (const void*)hyb_fwd, NTHREADS, LDS_BYTES) != hipSuccess || per_cu < 1)
            fprintf(stderr, "kernel_launch: note: occupancy query reports %d workgroups per CU\n", per_cu);
        (void)hipGetLastError();
        grid = cus;
    }
    if (grid < 0) return;
    if (hipMemsetAsync((char*)d_ws + WS_CTL, 0, CTL_ZERO_BYTES, stream) != hipSuccess) { fprintf(stderr, "kernel_launch: hipMemsetAsync failed\n"); return; }
    Args a{};
    for (int i = 0; i < 26; ++i) a.in.p[i] = (const float*)d_in[i];
    a.out = (float*)d_out; a.ws = (unsigned char*)d_ws;
#if MK_N_LAUNCHES == 1
    a.ph_lo = 0; a.ph_hi = N_PHASES; a.li = 0;
    hipLaunchKernelGGL(hyb_fwd, dim3(grid), dim3(NTHREADS), LDS_BYTES, stream, a);
#else
    for (int ph = 0; ph < N_PHASES; ++ph) { a.ph_lo = ph; a.ph_hi = ph + 1; a.li = 0; hipLaunchKernelGGL(hyb_fwd, dim3(grid), dim3(NTHREADS), LDS_BYTES, stream, a); }
#endif
    const hipError_t le = hipPeekAtLastError();
    if (le != hipSuccess) fprintf(stderr, "kernel_launch: launch failed: %s\n", hipGetErrorName(le));
}
```

```cpp
#include <hip/hip_runtime.h>
#include <cstdio>
#include <cstdint>

template <int M> __device__ __forceinline__ int shx_i(int v) {
    if constexpr (M == 1) return __builtin_amdgcn_mov_dpp(v, 0xB1, 0xF, 0xF, true);
    else if constexpr (M == 2) return __builtin_amdgcn_mov_dpp(v, 0x4E, 0xF, 0xF, true);
    else return __builtin_amdgcn_ds_swizzle(v, (M << 10) | 0x1f);
}
template <int M> __device__ __forceinline__ float shx(float v) { return __int_as_float(shx_i<M>(__float_as_int(v))); }
__device__ __forceinline__ float sh32_sum(float v) { auto r = __builtin_amdgcn_permlane32_swap(__float_as_uint(v), __float_as_uint(v), false, false); return __uint_as_float(r[0]) + __uint_as_float(r[1]); }
__device__ __forceinline__ float sh32_max(float v) { auto r = __builtin_amdgcn_permlane32_swap(__float_as_uint(v), __float_as_uint(v), false, false); return fmaxf(__uint_as_float(r[0]), __uint_as_float(r[1])); }
__device__ __forceinline__ int sum32_i(int c) { c += shx_i<1>(c); c += shx_i<2>(c); c += shx_i<4>(c); c += shx_i<8>(c); c += shx_i<16>(c); return c; }
namespace pg8 {
#define PG8_LAS __attribute__((address_space(3)))
typedef unsigned short bf16_t;
typedef short bf16x8 __attribute__((ext_vector_type(8)));
typedef float f32x4 __attribute__((ext_vector_type(4)));
typedef unsigned u32x4 __attribute__((ext_vector_type(4)));
constexpr int BM = 256, BK = 64, HALF = 128, HTB = HALF * BK * 2  , STAGE_BYTES = 8 * HTB, NXCD = 8, WGM = 8;

__host__ __device__ __forceinline__ int lds_byte(int r, int c) { const int st = (r >> 4) * 2 + (c >> 5), rr = r & 15, cc = c & 31, ob = rr * 64 + cc * 2; return st * 1024 + (ob ^ (((ob >> 9) & 1) << 5)); }
__host__ __device__ __forceinline__ void stage_rc(int b, int& R, int& C) { const int st = b / 1024, sb = b % 1024, swz = sb ^ (((sb >> 9) & 1) << 5); R = (st >> 1) * 16 + swz / 64; C = (st & 1) * 32 + (swz % 64) / 2; }
__host__ __device__ __forceinline__ int perm32(int rho) { const int n = rho >> 4, i = rho & 15; return 8 * (i >> 2) + 4 * n + (i & 3); }

struct Unit { int pm, pn; };
struct Gemm { const bf16_t* A; const bf16_t* Bt; int M, N, K, lda; };

struct StaticOrder {
    int nM, nN, nwg, G, c;
    __host__ __device__ __forceinline__ void init(int M, int N, int G_, int c_) { nM = M / BM; nN = N / BM; nwg = nM * nN; G = G_; c = c_; }
    __host__ __device__ __forceinline__ bool next(int i, Unit& u) const {
        const long L = (long)i * G + c; if (L >= nwg) return false;
        int wgid = (int)L; { const int q = nwg / NXCD, r = nwg % NXCD, xcd = wgid % NXCD, off = wgid / NXCD; wgid = (xcd < r ? xcd * (q + 1) : r * (q + 1) + (xcd - r) * q) + off; }
        const int nig = WGM * nN, gid = wgid / nig, fm = gid * WGM, gsz = (nM - fm) < WGM ? (nM - fm) : WGM;
        u.pm = fm + ((wgid % nig) % gsz); u.pn = (wgid % nig) / gsz; return true;
    }
    __device__ __forceinline__ void a_ready(const Unit&) const {}
    __device__ __forceinline__ void done(const Unit&) const {}
};

__device__ __forceinline__ unsigned cvt_pk_bf16(float lo, float hi) { unsigned r; asm volatile("v_cvt_pk_bf16_f32 %0, %1, %2" : "=v"(r) : "v"(lo), "v"(hi)); return r; }
typedef float f32x2 __attribute__((ext_vector_type(2)));
constexpr float RMS_EPS_F = 1e-6f;
__device__ __forceinline__ float silu_f(float x) { return x * __builtin_amdgcn_rcpf(1.0f + __builtin_amdgcn_exp2f(-1.4426950408889634f * x)); }
__device__ __forceinline__ float row_rstd(const float* ssq, int row) {
    const f32x4* p = (const f32x4*)(ssq + (size_t)row * 16); const f32x4 a = p[0], b = p[1], c = p[2], d = p[3];
    const float s = ((a[0] + a[1]) + (a[2] + a[3])) + ((b[0] + b[1]) + (b[2] + b[3])) + ((c[0] + c[1]) + (c[2] + c[3])) + ((d[0] + d[1]) + (d[2] + d[3]));
    return rsqrtf(s * (1.0f / 1024.0f) + RMS_EPS_F); }

struct EpiSwiGLU {
    static constexpr bool PERM = true, AFTER_DRAIN = false;
    bf16_t* U; const float* ssq; int ldu;
    __device__ __forceinline__ void operator()(const f32x4 (&acc)[2][2][4][2], const Unit& u, int wr, int wc, int fr, int fq) const {
        const int row0 = u.pm * BM + wr * 64 + fr, col0 = u.pn * HALF + wc * 32 + 8 * fq;
#pragma unroll
        for (int ai = 0; ai < 2; ++ai)
#pragma unroll
            for (int m = 0; m < 4; ++m) {
                const int row = row0 + ai * HALF + m * 16; const float r = row_rstd(ssq, row);
                const f32x4 a0 = acc[ai][0][m][0] * r, a1 = acc[ai][0][m][1] * r, b0 = acc[ai][1][m][0] * r, b1 = acc[ai][1][m][1] * r;
                u32x4 w;
                w.x = cvt_pk_bf16(silu_f(a0[0]) * b0[0], silu_f(a0[1]) * b0[1]); w.y = cvt_pk_bf16(silu_f(a0[2]) * b0[2], silu_f(a0[3]) * b0[3]);
                w.z = cvt_pk_bf16(silu_f(a1[0]) * b1[0], silu_f(a1[1]) * b1[1]); w.w = cvt_pk_bf16(silu_f(a1[2]) * b1[2], silu_f(a1[3]) * b1[3]);
                *(u32x4*)(U + (size_t)row * ldu + col0) = w;
            }
    }
};
struct EpiResid {
    static constexpr bool PERM = true, AFTER_DRAIN = false;
    float* H; bf16_t* HB; float* ssq_out; float scale;
    __device__ __forceinline__ void operator()(const f32x4 (&acc)[2][2][4][2], const Unit& u, int wr, int wc, int fr, int fq) const {
        const int row0 = u.pm * BM + wr * 64 + fr, col0 = u.pn * BM + wc * 32 + 8 * fq;
#pragma unroll
        for (int ai = 0; ai < 2; ++ai)
#pragma unroll
            for (int m = 0; m < 4; ++m) {
                const int row = row0 + ai * HALF + m * 16; float sq = 0.f;
#pragma unroll
                for (int bj = 0; bj < 2; ++bj) {
                    float* hp = H + (size_t)row * 1024 + col0 + bj * HALF;
                    f32x4 h0 = *(const f32x4*)hp, h1 = *(const f32x4*)(hp + 4);
                    h0 = h0 + acc[ai][bj][m][0] * scale; h1 = h1 + acc[ai][bj][m][1] * scale;
                    *(f32x4*)hp = h0; *(f32x4*)(hp + 4) = h1;
                    sq += (h0[0] * h0[0] + h0[1] * h0[1]) + (h0[2] * h0[2] + h0[3] * h0[3]) + (h1[0] * h1[0] + h1[1] * h1[1]) + (h1[2] * h1[2] + h1[3] * h1[3]);
                    if (HB) { u32x4 w; w.x = cvt_pk_bf16(h0[0], h0[1]); w.y = cvt_pk_bf16(h0[2], h0[3]); w.z = cvt_pk_bf16(h1[0], h1[1]); w.w = cvt_pk_bf16(h1[2], h1[3]);
                        *(u32x4*)(HB + (size_t)row * 1024 + col0 + bj * HALF) = w; }
                }
                if (ssq_out) { sq += shx<16>(sq); sq = sh32_sum(sq); if (fq == 0) ssq_out[(size_t)row * 16 + u.pn * 4 + wc] = sq; }
            }
    }
};
struct EpiScale {
    static constexpr bool PERM = true, AFTER_DRAIN = false;
    bf16_t* O; int ldc; const float* ssq; int split_cols; size_t split_stride;
    __device__ __forceinline__ void operator()(const f32x4 (&acc)[2][2][4][2], const Unit& u, int wr, int wc, int fr, int fq) const {
        const int row0 = u.pm * BM + wr * 64 + fr; int colt = u.pn * BM; bf16_t* base = O;
        if (split_cols) { const int t = colt / split_cols; base += (size_t)t * split_stride; colt -= t * split_cols; }
        const int col0 = colt + wc * 32 + 8 * fq;
#pragma unroll
        for (int ai = 0; ai < 2; ++ai)
#pragma unroll
            for (int m = 0; m < 4; ++m) {
                const int row = row0 + ai * HALF + m * 16; const float r = row_rstd(ssq, row);
                bf16_t* rowp = base + (size_t)row * ldc + col0;
#pragma unroll
                for (int bj = 0; bj < 2; ++bj) { const f32x4 v0 = acc[ai][bj][m][0] * r, v1 = acc[ai][bj][m][1] * r;
                    u32x4 w; w.x = cvt_pk_bf16(v0[0], v0[1]); w.y = cvt_pk_bf16(v0[2], v0[3]); w.z = cvt_pk_bf16(v1[0], v1[1]); w.w = cvt_pk_bf16(v1[2], v1[3]);
                    *(u32x4*)(rowp + bj * HALF) = w; }
            }
    }
};

enum { KIND_PLAIN = 0, KIND_NORM = 1, KIND_NORM_ROPE = 2, KIND_ROPE = 3, KIND_VT = 4, KIND_NORM_ROPE_KSUM = 5, KIND_IK = 6, KIND_SKIP = 7 };
struct EpiProj {
    static constexpr bool PERM = true, AFTER_DRAIN = false;
    bf16_t* O; int ldc; const float* ssq; int split_cols; size_t split_stride;
    int even;
    const float* gtab;
    const float* cosT; const float* sinT;
    bf16_t* Vt;
    bf16_t* IKf;
    PG8_LAS float* xch;
    __device__ __forceinline__ void operator()(const f32x4 (&acc)[2][2][4][2], const Unit& u, int wr, int wc, int fr, int fq) const {
        const int S_ = 16384;
        int kind; int gsel = 0; int vcol0 = 0;
        if (even) { const int p = u.pn;
            kind = (p < 2) ? KIND_NORM : (p < 4) ? KIND_NORM_ROPE : (p < 6) ? KIND_NORM : (p < 8) ? KIND_NORM_ROPE : (p < 10) ? KIND_VT : (p < 12) ? KIND_PLAIN : (p < 14) ? KIND_ROPE : KIND_IK;
            gsel = (p < 8) ? (p >> 1) : 0; vcol0 = (p - 8) * 256;
        } else { const int p = u.pn; kind = (p < 8) ? KIND_NORM_ROPE : KIND_VT; gsel = (p < 8) ? 4 + (p >> 2) : 0; vcol0 = (p - 8) * 256; }
        const float* gn = gtab + gsel * 64;
        const int row0 = u.pm * BM + wr * 64 + fr; int colt = u.pn * BM; bf16_t* base = O;
        if (split_cols) { const int t = colt / split_cols; base += (size_t)t * split_stride; colt -= t * split_cols; }
        const int co0 = wc * 32 + 8 * fq;
        const int hd0 = 32 * (wc & 1) + 8 * fq;
        int xo = ((wr * 64 + fr) * 2) * 4 + wc, xp = ((wr * 64 + fr) * 2) * 4 + (wc ^ 1);
        asm volatile("" : "+v"(xo), "+v"(xp));
        const bool normk = (kind == KIND_NORM || kind == KIND_NORM_ROPE || kind == KIND_NORM_ROPE_KSUM);
        const bool ropek = (kind == KIND_NORM_ROPE || kind == KIND_ROPE || kind == KIND_NORM_ROPE_KSUM || kind == KIND_IK);
        float gv[8];
#pragma unroll
        for (int e2 = 0; e2 < 8; ++e2) gv[e2] = normk ? gn[hd0 + e2] : 1.0f;
        if (normk) {
#pragma unroll
            for (int ai = 0; ai < 2; ++ai)
#pragma unroll
                for (int m = 0; m < 4; ++m)
#pragma unroll
                    for (int bj = 0; bj < 2; ++bj) { const f32x4 v0 = acc[ai][bj][m][0], v1 = acc[ai][bj][m][1];
                        float ss = (v0[0] * v0[0] + v0[1] * v0[1]) + (v0[2] * v0[2] + v0[3] * v0[3]) + (v1[0] * v1[0] + v1[1] * v1[1]) + (v1[2] * v1[2] + v1[3] * v1[3]);
                        ss += shx<16>(ss); ss = sh32_sum(ss);
                        if (fq == 0) xch[xo + (ai * 128 + m * 16) * 8 + bj * 4] = ss; }
            asm volatile("s_waitcnt lgkmcnt(0)" ::: "memory"); __builtin_amdgcn_s_barrier(); asm volatile("" ::: "memory");
        }
        if (kind != KIND_SKIP) {
#pragma unroll
        for (int ai = 0; ai < 2; ++ai)
#pragma unroll
            for (int m = 0; m < 4; ++m) {
                const int row = row0 + ai * HALF + m * 16; const float r = row_rstd(ssq, row);
                float cs[8], sn[8];
                if (ropek) { const f32x4 c0 = *(const f32x4*)(cosT + (unsigned)(row * 8)), c1 = *(const f32x4*)(cosT + (unsigned)(row * 8 + 4)), s0 = *(const f32x4*)(sinT + (unsigned)(row * 8)), s1 = *(const f32x4*)(sinT + (unsigned)(row * 8 + 4));
#pragma unroll
                    for (int e2 = 0; e2 < 4; ++e2) { cs[e2] = c0[e2]; cs[4 + e2] = c1[e2]; sn[e2] = s0[e2]; sn[4 + e2] = s1[e2]; } }
#pragma unroll
                for (int bj = 0; bj < 2; ++bj) {
                    if (kind == KIND_IK && (bj == 1 || wc >= 2)) continue;
                    float x[8];
                    { const f32x4 v0 = acc[ai][bj][m][0], v1 = acc[ai][bj][m][1];
#pragma unroll
                      for (int e2 = 0; e2 < 4; ++e2) { x[e2] = v0[e2]; x[4 + e2] = v1[e2]; } }
                    float sc = r;
                    if (normk) { const float tot = xch[xo + (ai * 128 + m * 16) * 8 + bj * 4] + xch[xp + (ai * 128 + m * 16) * 8 + bj * 4];
                        sc = r * rsqrtf(tot * (r * r) * (1.0f / 64.0f) + RMS_EPS_F); }
#pragma unroll
                    for (int e2 = 0; e2 < 8; ++e2) x[e2] = x[e2] * sc * gv[e2];
                    if (ropek) {
#pragma unroll
                        for (int e2 = 0; e2 < 8; ++e2) { const float other = shx<16>(x[e2]);
                            if ((wc & 1) == 0 && fq == 0) x[e2] = x[e2] * cs[e2] - other * sn[e2];
                            else if ((wc & 1) == 0 && fq == 1) x[e2] = x[e2] * cs[e2] + other * sn[e2]; }
                    }
                    if (kind == KIND_VT) {
                        bf16_t* vp = Vt + (unsigned)((vcol0 + bj * HALF + co0) * S_ + (row & ~1));
#pragma unroll
                        for (int e2 = 0; e2 < 8; ++e2) { const float other = shx<1>(x[e2]);
                            const unsigned w = (fr & 1) ? cvt_pk_bf16(other, x[e2]) : cvt_pk_bf16(x[e2], other);
                            if (((e2 >> 2) & 1) == (fr & 1)) *(unsigned*)(vp + (unsigned)(e2 * S_)) = w; }
                    } else if (kind == KIND_IK) {
                        const int c8 = 4 * wc + fq;
                        u32x4 w; w.x = cvt_pk_bf16(x[0], x[1]); w.y = cvt_pk_bf16(x[2], x[3]); w.z = cvt_pk_bf16(x[4], x[5]); w.w = cvt_pk_bf16(x[6], x[7]);
                        *(u32x4*)(IKf + (unsigned)((((row >> 5) * 4 + (c8 >> 1)) * 64 + (c8 & 1) * 32 + (row & 31)) * 8)) = w;
                    } else {
                        u32x4 w; w.x = cvt_pk_bf16(x[0], x[1]); w.y = cvt_pk_bf16(x[2], x[3]); w.z = cvt_pk_bf16(x[4], x[5]); w.w = cvt_pk_bf16(x[6], x[7]);
                        *(u32x4*)(base + (unsigned)(row * ldc + colt + bj * HALF + co0)) = w;
                    }
                }
            }
        }
        if (normk) { asm volatile("s_waitcnt lgkmcnt(0)" ::: "memory"); __builtin_amdgcn_s_barrier(); asm volatile("" ::: "memory"); }
    }
};
template <class Epi, class Sched, bool ALIGN_EPI = false, bool SP2 = false>
__device__ __forceinline__ void gemm_phase(PG8_LAS unsigned char* lds, const Gemm g, const Sched& S, const Epi& E, const int tid) {
    const int wid = __builtin_amdgcn_readfirstlane(tid >> 6), lane = tid & 63, wr = wid >> 2, wc = wid & 3, fr = lane & 15, fq = lane >> 4;
    const int K = g.K, nt = K / BK;
    unsigned voffA[2], voffB[2];
#pragma unroll
    for (int i = 0; i < 2; ++i) { int R, C; stage_rc(tid * 16 + i * 8192, R, C); const int Rb = Epi::PERM ? ((R & ~31) + perm32(R & 31)) : R;
        voffA[i] = (unsigned)(R * g.lda + C) * 2u; voffB[i] = (unsigned)(Rb * K + C) * 2u; }
    const size_t kstep = (size_t)(BK * 2);
    const size_t hstepA = (size_t)HALF * g.lda * 2, hstepB = (size_t)HALF * K * 2;
    const size_t tstepA = 2 * hstepA, tstepB = 2 * hstepB;
    const unsigned ldsw = (unsigned)wid * 1024u;
    const int aoff = lds_byte(wr * 64 + fr, fq * 8), boff = lds_byte(wc * 32 + fr, fq * 8);
#define PG8_SA(b, h) (((b) * 2 + (h)) * HTB)
#define PG8_SB(b, h) ((4 + (b) * 2 + (h)) * HTB)
#define PG8_STAGE(bufoff, gbase, voff) do { _Pragma("unroll") for (int _i = 0; _i < 2; ++_i) \
        __builtin_amdgcn_global_load_lds((const unsigned*)((const char*)(gbase) + (voff)[_i]), (PG8_LAS unsigned*)(lds + (bufoff) + ldsw + _i * 8192), 16, 0, 0); } while (0)
#define PG8_LDA(dst, b, h) do { _Pragma("unroll") for (int m = 0; m < 4; ++m) _Pragma("unroll") for (int k = 0; k < 2; ++k) dst[m][k] = *(const PG8_LAS bf16x8*)(lds + PG8_SA(b, h) + aoff + m * 2048 + k * 1024); } while (0)
#define PG8_LDB(dst, b, h) do { _Pragma("unroll") for (int n = 0; n < 2; ++n) _Pragma("unroll") for (int k = 0; k < 2; ++k) dst[n][k] = *(const PG8_LAS bf16x8*)(lds + PG8_SB(b, h) + boff + n * 2048 + k * 1024); } while (0)
#define PG8_MMA(ai, bj, At, Bt) do { __builtin_amdgcn_s_setprio(1); _Pragma("unroll") for (int m = 0; m < 4; ++m) _Pragma("unroll") for (int n = 0; n < 2; ++n) _Pragma("unroll") for (int k = 0; k < 2; ++k) \
        acc[ai][bj][m][n] = __builtin_amdgcn_mfma_f32_16x16x32_bf16(Bt[n][k], At[m][k], acc[ai][bj][m][n], 0, 0, 0); __builtin_amdgcn_s_setprio(0); } while (0)
#define PG8_WAIT_V(n) asm volatile("s_waitcnt vmcnt(" #n ")" ::: "memory")
#define PG8_WAIT_L(n) asm volatile("s_waitcnt lgkmcnt(" #n ")" ::: "memory")
#define PG8_BAR __builtin_amdgcn_s_barrier()
#define PG8_SCHED __builtin_amdgcn_sched_barrier(0)
    Unit cur, nxt; int ui = 0;
    if (!S.next(0, cur)) return;
    f32x4 acc[2][2][4][2];
#pragma unroll
    for (int a = 0; a < 2; ++a)
#pragma unroll
        for (int b = 0; b < 2; ++b)
#pragma unroll
            for (int m = 0; m < 4; ++m)
#pragma unroll
                for (int n = 0; n < 2; ++n) acc[a][b][m][n] = (f32x4){0.f, 0.f, 0.f, 0.f};
    bf16x8 At[4][2], B0[2][2], B1[2][2];
    const char* cA = (const char*)g.A + (size_t)cur.pm * tstepA; const char* cB = (const char*)g.Bt + (size_t)cur.pn * tstepB;
    S.a_ready(cur);
    if constexpr (SP2) {
        PG8_STAGE(PG8_SB(0, 0), cB, voffB); PG8_STAGE(PG8_SB(0, 1), cB + hstepB, voffB); PG8_STAGE(PG8_SA(0, 0), cA, voffA); PG8_STAGE(PG8_SA(0, 1), cA + hstepA, voffA);
        if (wr == 1) PG8_BAR;
        PG8_WAIT_V(2); PG8_BAR;
        PG8_STAGE(PG8_SB(1, 0), cB + kstep, voffB); PG8_STAGE(PG8_SA(1, 0), cA + kstep, voffA); PG8_STAGE(PG8_SB(1, 1), cB + hstepB + kstep, voffB);
        PG8_WAIT_V(6); PG8_BAR;
    } else {
        PG8_STAGE(PG8_SB(0, 0), cB, voffB); PG8_STAGE(PG8_SA(0, 0), cA, voffA); PG8_STAGE(PG8_SB(0, 1), cB + hstepB, voffB); PG8_STAGE(PG8_SA(0, 1), cA + hstepA, voffA);
        if (wr == 1) PG8_BAR;
        PG8_WAIT_V(4); PG8_BAR;
        PG8_STAGE(PG8_SB(1, 0), cB + kstep, voffB); PG8_STAGE(PG8_SA(1, 0), cA + kstep, voffA); PG8_STAGE(PG8_SB(1, 1), cB + hstepB + kstep, voffB);
        PG8_WAIT_V(6); PG8_BAR;
    }
    for (;;) {
        const bool has_next = S.next(ui + 1, nxt);
        const char* nA = has_next ? (const char*)g.A + (size_t)nxt.pm * tstepA : cA; const char* nB = has_next ? (const char*)g.Bt + (size_t)nxt.pn * tstepB : cB;
        for (int t = 0; t < nt; t += 2) {
            const bool last = (t == nt - 2);
            const char* a1 = cA + (size_t)(t + 1) * kstep;
            const char* a2 = last ? nA : cA + (size_t)(t + 2) * kstep; const char* b2 = last ? nB : cB + (size_t)(t + 2) * kstep;
            const char* a3 = a2 + kstep; const char* b3 = b2 + kstep;
            if (last && has_next) S.a_ready(nxt);
            if constexpr (SP2) {
            PG8_LDB(B0, 0, 0); PG8_LDB(B1, 0, 1); PG8_SCHED; PG8_LDA(At, 0, 0); PG8_STAGE(PG8_SA(1, 1), a1 + hstepA, voffA);
            PG8_WAIT_V(8); PG8_WAIT_L(0); PG8_BAR; PG8_MMA(0, 0, At, B0); PG8_MMA(0, 1, At, B1); PG8_BAR; PG8_SCHED;
            PG8_LDA(At, 0, 1); PG8_STAGE(PG8_SB(0, 0), b2, voffB); PG8_STAGE(PG8_SB(0, 1), b2 + hstepB, voffB); PG8_STAGE(PG8_SA(0, 0), a2, voffA);
            PG8_WAIT_V(8); PG8_WAIT_L(0); PG8_BAR; PG8_MMA(1, 0, At, B0); PG8_MMA(1, 1, At, B1); PG8_BAR; PG8_SCHED;
            PG8_LDB(B0, 1, 0); PG8_LDB(B1, 1, 1); PG8_SCHED; PG8_LDA(At, 1, 0); PG8_STAGE(PG8_SA(0, 1), a2 + hstepA, voffA);
            PG8_WAIT_V(8); PG8_WAIT_L(0); PG8_BAR; PG8_MMA(0, 0, At, B0); PG8_MMA(0, 1, At, B1); PG8_BAR; PG8_SCHED;
            PG8_LDA(At, 1, 1); PG8_STAGE(PG8_SB(1, 0), b3, voffB); PG8_STAGE(PG8_SB(1, 1), b3 + hstepB, voffB); PG8_STAGE(PG8_SA(1, 0), a3, voffA);
            PG8_WAIT_V(8); PG8_WAIT_L(0); PG8_BAR; PG8_MMA(1, 0, At, B0); PG8_MMA(1, 1, At, B1); PG8_BAR; PG8_SCHED;
            } else {
            PG8_LDB(B0, 0, 0); PG8_SCHED; PG8_LDA(At, 0, 0); PG8_STAGE(PG8_SA(1, 1), a1 + hstepA, voffA);
            PG8_WAIT_L(8); PG8_BAR; PG8_WAIT_L(0); PG8_MMA(0, 0, At, B0); PG8_BAR; PG8_SCHED;
            PG8_LDB(B1, 0, 1); PG8_STAGE(PG8_SB(0, 0), b2, voffB);
            PG8_BAR; PG8_WAIT_L(0); PG8_MMA(0, 1, At, B1); PG8_BAR;
            PG8_LDA(At, 0, 1); PG8_STAGE(PG8_SA(0, 0), a2, voffA);
            PG8_BAR; PG8_WAIT_L(0); PG8_MMA(1, 0, At, B0); PG8_BAR; PG8_SCHED;
            PG8_STAGE(PG8_SB(0, 1), b2 + hstepB, voffB);
            PG8_WAIT_V(6); PG8_BAR; PG8_MMA(1, 1, At, B1); PG8_BAR;
            PG8_LDB(B0, 1, 0); PG8_SCHED; PG8_LDA(At, 1, 0); PG8_STAGE(PG8_SA(0, 1), a2 + hstepA, voffA);
            PG8_WAIT_L(8); PG8_BAR; PG8_WAIT_L(0); PG8_MMA(0, 0, At, B0); PG8_BAR; PG8_SCHED;
            PG8_LDB(B1, 1, 1); PG8_STAGE(PG8_SB(1, 0), b3, voffB);
            PG8_BAR; PG8_WAIT_L(0); PG8_MMA(0, 1, At, B1); PG8_BAR;
            PG8_LDA(At, 1, 1); PG8_STAGE(PG8_SA(1, 0), a3, voffA);
            PG8_BAR; PG8_WAIT_L(0); PG8_MMA(1, 0, At, B0); PG8_BAR; PG8_SCHED;
            PG8_STAGE(PG8_SB(1, 1), b3 + hstepB, voffB);
            PG8_WAIT_V(6); PG8_BAR; PG8_MMA(1, 1, At, B1); PG8_BAR;
            }
        }
        if constexpr (ALIGN_EPI) { if (wr == 0) PG8_BAR; }
        if constexpr (!Epi::AFTER_DRAIN) { E(acc, cur, wr, wc, fr, fq); S.done(cur); }
        if (!has_next) break;
#pragma unroll
        for (int a = 0; a < 2; ++a)
#pragma unroll
            for (int b = 0; b < 2; ++b)
#pragma unroll
                for (int m = 0; m < 4; ++m)
#pragma unroll
                    for (int n = 0; n < 2; ++n) acc[a][b][m][n] = (f32x4){0.f, 0.f, 0.f, 0.f};
        cur = nxt; cA = nA; cB = nB; ++ui;
        if constexpr (ALIGN_EPI) { if (wr == 1) PG8_BAR; }
    }
    PG8_WAIT_V(0);
    if constexpr (!ALIGN_EPI) { if (wr == 0) PG8_BAR; }
    PG8_BAR;
    if constexpr (Epi::AFTER_DRAIN) { E.fused(acc, cur, wr, wc, fr, fq, lds, wid, lane); S.done(cur); }
#undef PG8_SA
#undef PG8_SB
#undef PG8_STAGE
#undef PG8_LDA
#undef PG8_LDB
#undef PG8_MMA
#undef PG8_WAIT_V
#undef PG8_WAIT_L
#undef PG8_BAR
#undef PG8_SCHED
}
}

constexpr int S = 16384, DM = 1024, FF = 2816, FF2 = 5632, EVEN_SRC = 3664, EVEN_NP = 3840, ODD_N = 3072, NLAYER = 2, MEMT = 256, MEMW = 256;
constexpr float RMS_EPS = 1e-6f;
constexpr float LOG2E = 1.4426950408889634f;
constexpr float C2 = 0.125f * LOG2E;
constexpr int NWAVES = 8, NTHREADS = 512;
constexpr int EC_FQ = 0, EC_DQ = 512, EC_FK = 1024, EC_DK = 1536, EC_FV = 2048, EC_DV = 2560, EC_IQ = 3072, EC_IK = 3584;
constexpr int ES_FQ = 0, ES_FK = 512, ES_FV = 1024, ES_FL = 1536, ES_DQ = 1544, ES_DK = 2056, ES_DV = 2568, ES_IQ = 3080, ES_IK = 3592, ES_IW = 3656;

constexpr size_t MiB = 1u << 20;
constexpr size_t WS_CTL = 0, CTL_ZERO_BYTES = 1 * MiB;
constexpr size_t WS_SSQ = 1 * MiB;
constexpr size_t WS_KSUM = 6 * MiB;
constexpr size_t WS_GT = 11 * MiB + 131072;
constexpr size_t WS_TW = 11 * MiB;
constexpr size_t WS_ROPE = 2 * MiB;
constexpr size_t WS_FL = 3 * MiB;
constexpr size_t WS_MEMK = 4 * MiB;
constexpr size_t WS_IW = 5 * MiB;
constexpr size_t WS_W = 12 * MiB;
constexpr size_t WS_BIG = 60 * MiB;
constexpr size_t WS_HB = 224 * MiB;
constexpr size_t WS_END = 256 * MiB;
constexpr size_t W_FFN1_IN = 0, W_FFN1_OUT = 11 * MiB, W_MIX_IN = 17 * MiB, W_MIX_OUT = 25 * MiB, W_MEMQ = 27 * MiB, W_MEMO = 28 * MiB, W_FFN2_IN = 29 * MiB, W_FFN2_OUT = 40 * MiB;
constexpr size_t B_U = 0;
constexpr size_t B_PROJ = 0;
constexpr size_t B_VTF = 120 * MiB;
constexpr size_t B_IKC = 136 * MiB;
constexpr size_t B_VTM = 96 * MiB;
constexpr size_t B_SEL = 156 * MiB;
constexpr size_t B_QM = 140 * MiB, B_OM = 148 * MiB;
constexpr int CW_TMO = 0, CW_CODE = 1, CW_BAR = 4096;

constexpr int RING_BYTES = 147456;
constexpr int LDSCTL_OFF = RING_BYTES, MISC_OFF = LDSCTL_OFF + 320;
constexpr int LDS_BYTES = 163840;

#define GAS __attribute__((address_space(1)))
#define LAS __attribute__((address_space(3)))
typedef unsigned short bf16;
typedef unsigned v4u __attribute__((ext_vector_type(4)));
typedef float f32x4 __attribute__((ext_vector_type(4)));
typedef short bf16x8 __attribute__((ext_vector_type(8)));
typedef GAS unsigned gu32;
typedef GAS unsigned long long gu64;
#define RLX_AGENT __ATOMIC_RELAXED, __HIP_MEMORY_SCOPE_AGENT
#define LDS_WAIT() asm volatile("s_waitcnt lgkmcnt(0)" ::: "memory")
#define VM_WAIT() asm volatile("s_waitcnt vmcnt(0)" ::: "memory")
__device__ __forceinline__ unsigned long long rt() { return __builtin_amdgcn_s_memrealtime(); }
__device__ __forceinline__ unsigned f2bf(float f) { unsigned u = __builtin_bit_cast(unsigned, f); return (u + 0x7fffu + ((u >> 16) & 1u)) >> 16; }
__device__ __forceinline__ unsigned pk2(float lo, float hi) { return f2bf(lo) | (f2bf(hi) << 16); }

#define XB_TMO      128
#define XB_XCNT(j)  (256  + 64 * (j))
#define XB_XSUB(j)  (1280 + 64 * (j))
#define XB_XGEN(j)  (2304 + 64 * (j))
#define XB_TOP      3328
#define XB_TOPGEN   3392
#define XCD_BAR_WORDS 3456
#define XB_SPIN_CAP (1u << 18)

__device__ __forceinline__ unsigned xb_ld(unsigned* p)              { return __hip_atomic_load(p, __ATOMIC_RELAXED, __HIP_MEMORY_SCOPE_AGENT); }
__device__ __forceinline__ unsigned xb_add(unsigned* p, unsigned v) { return __hip_atomic_fetch_add(p, v, __ATOMIC_RELAXED, __HIP_MEMORY_SCOPE_AGENT); }
__device__ __forceinline__ unsigned xb_xcc_id() { return (unsigned)__builtin_amdgcn_s_getreg((3 << 11) | 20) & 0xFu; }
#define XB_SPIN(cond, bar) do { unsigned _sp = 0; while (cond) { __builtin_amdgcn_s_sleep(1); \
    if ((++_sp & 255u) == 0u) { if (xb_ld(&(bar)[XB_TMO])) break; if (_sp > XB_SPIN_CAP) { atomicAdd(&(bar)[XB_TMO], 1u); break; } } } } while (0)

struct XcdBarrier {
    unsigned* bar; unsigned x;
    volatile LAS unsigned* st;
};

__device__ __forceinline__ XcdBarrier xcd_barrier_post(unsigned* bar, volatile LAS unsigned* st) {
    XcdBarrier b; b.bar = bar; b.x = xb_xcc_id(); b.st = st;
    if (threadIdx.x == 0) (void)xb_add(&bar[XB_XCNT(b.x)], 1u);
    return b;
}
__device__ __forceinline__ void xcd_barrier_complete(unsigned* bar, unsigned x, unsigned& nloc, unsigned& nx) {
    const unsigned G = gridDim.x * gridDim.y * gridDim.z;
    unsigned sum, cnt, mine, sp = 0u;
    for (;;) {
        sum = 0u; cnt = 0u; mine = 0u;
#pragma unroll
        for (unsigned j = 0; j < 16; ++j) { const unsigned c = xb_ld(&bar[XB_XCNT(j)]); sum += c; cnt += (c > 0u) ? 1u : 0u; mine = (j == x) ? c : mine; }
        if (sum == G) break;
        __builtin_amdgcn_s_sleep(1);
        if ((++sp & 255u) == 0u) { if (xb_ld(&bar[XB_TMO])) break; if (sp > XB_SPIN_CAP) { atomicAdd(&bar[XB_TMO], 1u); break; } }
    }
    nloc = mine > 0u ? mine : 1u; nx = cnt > 0u ? cnt : 1u;
}

__device__ __forceinline__ void xcd_barrier(const XcdBarrier& b) {
    asm volatile("s_waitcnt vmcnt(0)" ::: "memory");
    __syncthreads();
    if (threadIdx.x == 0) {
        unsigned* bar = b.bar;
        __builtin_amdgcn_s_waitcnt(0);
        unsigned nloc = b.st[0], nx = b.st[1];
        if (nloc == 0u) { xcd_barrier_complete(bar, b.x, nloc, nx); b.st[0] = nloc; b.st[1] = nx; }
        const unsigned old = xb_add(&bar[XB_XSUB(b.x)], 1u);
        const unsigned gen = old / nloc;
        if (old + 1u == (gen + 1u) * nloc) {
            __builtin_amdgcn_fence(__ATOMIC_RELEASE, "agent");
            asm volatile("s_waitcnt vmcnt(0)" ::: "memory");
            const unsigned og = xb_add(&bar[XB_TOP], 1u);
            const unsigned tg = og / nx;
            if (og + 1u == (tg + 1u) * nx) xb_add(&bar[XB_TOPGEN], 1u);
            else XB_SPIN(xb_ld(&bar[XB_TOPGEN]) == tg, bar);
            __builtin_amdgcn_fence(__ATOMIC_ACQUIRE, "agent");
            xb_add(&bar[XB_XGEN(b.x)], 1u);
            asm volatile("s_waitcnt vmcnt(0)" ::: "memory");
        } else {
            XB_SPIN(xb_ld(&bar[XB_XGEN(b.x)]) == gen, bar);
            __builtin_amdgcn_fence(__ATOMIC_ACQUIRE, "agent");
            asm volatile("s_waitcnt vmcnt(0)" ::: "memory");
        }
    }
    __syncthreads();
}

typedef float f32x16 __attribute__((ext_vector_type(16)));
typedef float f32x2_t __attribute__((ext_vector_type(2)));
typedef __bf16 bf16x2_t __attribute__((ext_vector_type(2)));
typedef unsigned u32x2 __attribute__((ext_vector_type(2)));
__device__ __forceinline__ unsigned cvtpk(float lo, float hi) { f32x2_t v = {lo, hi}; bf16x2_t b = __builtin_convertvector(v, bf16x2_t); return __builtin_bit_cast(unsigned, b); }
__device__ __forceinline__ float bflo(unsigned w) { return __uint_as_float(w << 16); }
__device__ __forceinline__ float bfhi(unsigned w) { return __uint_as_float(w & 0xffff0000u); }
__device__ __forceinline__ void unpack8(const v4u& w, float (&x)[8]) { x[0] = bflo(w.x); x[1] = bfhi(w.x); x[2] = bflo(w.y); x[3] = bfhi(w.y); x[4] = bflo(w.z); x[5] = bfhi(w.z); x[6] = bflo(w.w); x[7] = bfhi(w.w); }
__device__ __forceinline__ v4u pack8(const float (&x)[8]) { v4u w; w.x = cvtpk(x[0], x[1]); w.y = cvtpk(x[2], x[3]); w.z = cvtpk(x[4], x[5]); w.w = cvtpk(x[6], x[7]); return w; }
__device__ __forceinline__ float wave_sum(float v) { v += shx<1>(v); v += shx<2>(v); v += shx<4>(v); v += shx<8>(v); v += shx<16>(v); return sh32_sum(v); }
__device__ __forceinline__ float wave_max(float v) { v = fmaxf(v, shx<1>(v)); v = fmaxf(v, shx<2>(v)); v = fmaxf(v, shx<4>(v)); v = fmaxf(v, shx<8>(v)); v = fmaxf(v, shx<16>(v)); return sh32_max(v); }
__device__ __forceinline__ int crow(int r, int hi) { return (r & 3) + 8 * (r >> 2) + 4 * hi; }

__device__ __forceinline__ int even_map(int n) {
    if (n < 512) return ES_FQ + n;
    if (n < 1024) return ES_DQ + (n - 512);
    if (n < 1536) return ES_FK + (n - 1024);
    if (n < 2048) return ES_DK + (n - 1536);
    if (n < 2560) return ES_FV + (n - 2048);
    if (n < 3072) return ES_DV + (n - 2560);
    if (n < 3584) return ES_IQ + (n - 3072);
    if (n < 3648) return ES_IK + (n - 3584);
    return -1;
}
__device__ __forceinline__ void conv_item(const float* W, int K, int Nsrc, int nblk, const float* gain, bf16* WT, int mode, LAS float* scr, int item, int lane) {
    const int kb = item / nblk, nb = item % nblk, k0 = 32 * kb, n0 = 128 * nb;
    const int n = n0 + 4 * (lane & 31);
    int sc;
    if (mode == 0) sc = n; else if (mode == 1) { const int T = n >> 8, hf = (n >> 7) & 1, j = n & 127; sc = hf * FF + 128 * T + j; } else sc = even_map(n);
    f32x4 v[16];
#pragma unroll
    for (int i = 0; i < 16; ++i) { const int kk = 2 * i + (lane >> 5); v[i] = (f32x4){0.f, 0.f, 0.f, 0.f};
        if (sc >= 0) v[i] = *(const GAS f32x4*)(W + (size_t)(k0 + kk) * Nsrc + sc); }
#pragma unroll
    for (int i = 0; i < 16; ++i) { const int kk = 2 * i + (lane >> 5); const float g = gain ? gain[k0 + kk] : 1.0f;
        *(LAS f32x4*)(scr + kk * 132 + 4 * (lane & 31)) = v[i] * g; }
    LDS_WAIT(); asm volatile("" ::: "memory");
    const int c = lane & 3;
#pragma unroll
    for (int j = 0; j < 8; ++j) { const int nn = (lane >> 2) + 16 * j; const LAS float* s = scr + (8 * c) * 132 + nn;
        v4u o; o.x = cvtpk(s[0 * 132], s[1 * 132]); o.y = cvtpk(s[2 * 132], s[3 * 132]); o.z = cvtpk(s[4 * 132], s[5 * 132]); o.w = cvtpk(s[6 * 132], s[7 * 132]);
        *(GAS v4u*)(WT + (size_t)(n0 + nn) * K + k0 + 8 * c) = o; }
    LDS_WAIT(); asm volatile("" ::: "memory");
}
struct InPtrs { const float* p[26]; };
__device__ __forceinline__ void conv_weights(const InPtrs& in, unsigned char* ws, int L, LAS unsigned char* lds, int gw, int NGW, int wave, int lane) {
    LAS float* scr = (LAS float*)(lds + wave * 17408);
    bf16* Wr = (bf16*)(ws + WS_W);
    const float* ffn1_norm = in.p[2] + (size_t)L * DM; const float* ffn1_in = in.p[3] + (size_t)L * DM * FF2; const float* ffn1_out = in.p[4] + (size_t)L * FF * DM;
    const float* mix_norm = in.p[5] + (size_t)L * DM; const float* mix_out = in.p[15] + (size_t)L * DM * DM;
    const float* memx_norm = in.p[16] + (size_t)L * DM; const float* mem_wq = in.p[18] + (size_t)L * DM * MEMW; const float* mem_wo = in.p[22] + (size_t)L * MEMW * DM;
    const float* ffn2_norm = in.p[23] + (size_t)L * DM; const float* ffn2_in = in.p[24] + (size_t)L * DM * FF2; const float* ffn2_out = in.p[25] + (size_t)L * FF * DM;
    const bool even = (L & 1) == 0;
    const float* mix_in = even ? in.p[6] : in.p[12];
    const int mixN = even ? EVEN_NP : ODD_N, mixSrc = even ? EVEN_SRC : ODD_N;
    const int I_FIN = (DM / 32) * (FF2 / 128), I_FOUT = (FF / 32) * (DM / 128), I_MIN = (DM / 32) * (mixN / 128), I_MOUT = (DM / 32) * (DM / 128), I_MQ = (DM / 32) * (MEMW / 128), I_MO = (MEMW / 32) * (DM / 128);
    const int NITEMS = 2 * I_FIN + 2 * I_FOUT + I_MIN + I_MOUT + I_MQ + I_MO;
    for (int it = gw; it < NITEMS; it += NGW) {
        int r = it;
        if (r < I_FIN) { conv_item(ffn1_in, DM, FF2, FF2 / 128, ffn1_norm, (bf16*)((unsigned char*)Wr + W_FFN1_IN), 1, scr, r, lane); continue; } r -= I_FIN;
        if (r < I_FIN) { conv_item(ffn2_in, DM, FF2, FF2 / 128, ffn2_norm, (bf16*)((unsigned char*)Wr + W_FFN2_IN), 1, scr, r, lane); continue; } r -= I_FIN;
        if (r < I_FOUT) { conv_item(ffn1_out, FF, DM, DM / 128, nullptr, (bf16*)((unsigned char*)Wr + W_FFN1_OUT), 0, scr, r, lane); continue; } r -= I_FOUT;
        if (r < I_FOUT) { conv_item(ffn2_out, FF, DM, DM / 128, nullptr, (bf16*)((unsigned char*)Wr + W_FFN2_OUT), 0, scr, r, lane); continue; } r -= I_FOUT;
        if (r < I_MIN) { conv_item(mix_in, DM, mixSrc, mixN / 128, mix_norm, (bf16*)((unsigned char*)Wr + W_MIX_IN), even ? 2 : 0, scr, r, lane); continue; } r -= I_MIN;
        if (r < I_MOUT) { conv_item(mix_out, DM, DM, DM / 128, nullptr, (bf16*)((unsigned char*)Wr + W_MIX_OUT), 0, scr, r, lane); continue; } r -= I_MOUT;
        if (r < I_MQ) { conv_item(mem_wq, DM, MEMW, MEMW / 128, memx_norm, (bf16*)((unsigned char*)Wr + W_MEMQ), 0, scr, r, lane); continue; } r -= I_MQ;
        conv_item(mem_wo, MEMW, DM, DM / 128, nullptr, (bf16*)((unsigned char*)Wr + W_MEMO), 0, scr, r, lane);
    }
}
__device__ __forceinline__ void copy_x(const float* x, float* out, bf16* HB, float* ssq0, int gw, int NGW, int lane) {
    for (int m = gw; m < S; m += NGW) {
        const GAS f32x4* xr = (const GAS f32x4*)(x + (size_t)m * DM) + lane; GAS f32x4* orow = (GAS f32x4*)(out + (size_t)m * DM) + lane;
        GAS u32x2* hb = (GAS u32x2*)(HB + (size_t)m * DM) + lane;
        float s = 0.f;
#pragma unroll
        for (int j = 0; j < 4; ++j) { const f32x4 v = xr[64 * j]; orow[64 * j] = v; s += (v.x * v.x + v.y * v.y) + (v.z * v.z + v.w * v.w);
            u32x2 w; w.x = cvtpk(v.x, v.y); w.y = cvtpk(v.z, v.w); hb[64 * j] = w; }
        s = wave_sum(s);
        if (lane < 16) ssq0[(size_t)m * 16 + lane] = (lane == 0) ? s : 0.f;
    }
}
__device__ __forceinline__ void rope_tables(float* cosT, float* sinT, int gtid, int nthreads) {
    for (int idx = gtid; idx < S * 8; idx += nthreads) {
        const int t = idx >> 3, j = idx & 7;
        float inv;
        switch (j) { case 0: inv = 1.0f; break; case 1: inv = 0.193922743f; break; case 2: inv = 0.0376060307f; break; case 3: inv = 0.00729266461f; break;
                     case 4: inv = 0.00141421356f; break; case 5: inv = 0.000274248188f; break; case 6: inv = 5.3182961e-05f; break; default: inv = 1.03133862e-05f; break; }
        const float ang = (float)t * inv;
        const float kq = __builtin_rintf(ang * 0.63661977236758134f);
        float r = ang - kq * 1.5703125f; r = r - kq * 0.00048351287841796875f; r = r - kq * 3.1391647326017846e-07f;
        const float r2 = r * r;
        float sp = 2.7557319e-6f; sp = sp * r2 - 1.9841270e-4f; sp = sp * r2 + 8.3333333e-3f; sp = sp * r2 - 1.6666667e-1f; const float sn = r + r * r2 * sp;
        float cp = -2.7557319e-7f; cp = cp * r2 + 2.4801587e-5f; cp = cp * r2 - 1.3888889e-3f; cp = cp * r2 + 4.1666667e-2f; cp = cp * r2 - 0.5f; const float cs = 1.0f + r2 * cp;
        const int q = ((int)kq) & 3;
        const float sv = (q == 0) ? sn : (q == 1) ? cs : (q == 2) ? -sn : -cs;
        const float cv = (q == 0) ? cs : (q == 1) ? -sn : (q == 2) ? -cs : sn;
        cosT[idx] = cv; sinT[idx] = sv;
    }
}
__device__ __forceinline__ void mem_kv(const InPtrs& in, unsigned char* ws, LAS unsigned char* lds, int unit, int tid, int wave, int lane) {
    LAS float* memn = (LAS float*)lds;
    bf16* memK = (bf16*)(ws + WS_MEMK); bf16* memVt = (bf16*)(ws + WS_MEMK + 256 * 1024);
    const int L = unit >> 6, rb = (unit >> 3) & 7, cb = unit & 7;
    const float* gm = in.p[17] + (size_t)L * DM; const float* wkv = in.p[19] + (size_t)L * DM * 512; const float* kn = in.p[21] + (size_t)L * 64;
    __syncthreads();
    for (int i = 0; i < 4; ++i) { const int r = wave * 4 + i; const float* mrow = in.p[1] + (size_t)(rb * 32 + r) * DM;
        f32x4 v[4]; float s = 0.f;
#pragma unroll
        for (int j = 0; j < 4; ++j) { v[j] = *((const GAS f32x4*)mrow + lane + 64 * j); s += (v[j].x * v[j].x + v[j].y * v[j].y) + (v[j].z * v[j].z + v[j].w * v[j].w); }
        const float rstd = rsqrtf(wave_sum(s) * (1.0f / DM) + RMS_EPS);
#pragma unroll
        for (int j = 0; j < 4; ++j) { const f32x4 g = *((const GAS f32x4*)gm + lane + 64 * j); *(LAS f32x4*)(memn + r * 1028 + 4 * (lane + 64 * j)) = v[j] * rstd * g; } }
    __syncthreads();
    const int r = tid >> 4, c4 = (tid & 15) * 4;
    f32x4 acc = (f32x4){0.f, 0.f, 0.f, 0.f};
    const float* wp = wkv + cb * 64 + c4; const LAS float* mp = memn + r * 1028;
#pragma unroll 8
    for (int k = 0; k < DM; ++k) acc = acc + *(const GAS f32x4*)(wp + (size_t)k * 512) * mp[k];
    const int tok = rb * 32 + r;
    if (cb < 4) {
        float ss = (acc.x * acc.x + acc.y * acc.y) + (acc.z * acc.z + acc.w * acc.w);
        ss += shx<1>(ss); ss += shx<2>(ss); ss += shx<4>(ss); ss += shx<8>(ss);
        const float rs = rsqrtf(ss * (1.0f / 64.0f) + RMS_EPS);
        u32x2 w; w.x = cvtpk(acc.x * rs * kn[c4], acc.y * rs * kn[c4 + 1]); w.y = cvtpk(acc.z * rs * kn[c4 + 2], acc.w * rs * kn[c4 + 3]);
        *(GAS u32x2*)(memK + (size_t)L * 65536 + (size_t)tok * 256 + cb * 64 + c4) = w;
    } else {
        const int c = (cb - 4) * 64 + c4; bf16* vp = memVt + (size_t)L * 65536 + (size_t)c * 256 + tok;
        vp[0] = (bf16)(cvtpk(acc.x, 0.f) & 0xffffu); vp[256] = (bf16)(cvtpk(acc.y, 0.f) & 0xffffu); vp[512] = (bf16)(cvtpk(acc.z, 0.f) & 0xffffu); vp[768] = (bf16)(cvtpk(acc.w, 0.f) & 0xffffu);
    }
}

__device__ __forceinline__ void head_norm8(float (&x)[8], const float* gain, int lane) {
    float ss = 0.f;
#pragma unroll
    for (int j = 0; j < 8; ++j) ss += x[j] * x[j];
    ss += shx<1>(ss); ss += shx<2>(ss); ss += shx<4>(ss);
    const float r = rsqrtf(ss * (1.0f / 64.0f) + RMS_EPS);
    const int d0 = 8 * (lane & 7);
#pragma unroll
    for (int j = 0; j < 8; ++j) x[j] = x[j] * r * gain[d0 + j];
}
__device__ __forceinline__ void rope8(float (&x)[8], const float (&cs)[8], const float (&sn)[8], int lane) {
    const int sub = lane & 7;
#pragma unroll
    for (int j = 0; j < 8; ++j) {
        const float other = shx<1>(x[j]);
        if (sub == 0) x[j] = x[j] * cs[j] - other * sn[j];
        else if (sub == 1) x[j] = x[j] * cs[j] + other * sn[j];
    }
}
__device__ __forceinline__ float sh32_get(float v, int lane) { auto r = __builtin_amdgcn_permlane32_swap(__float_as_uint(v), __float_as_uint(v), false, false); return __uint_as_float((lane < 32) ? r[1] : r[0]); }
__device__ __forceinline__ float reduce_scatter64(float (&v)[64], int lane) {
    { const bool up = (lane & 32) != 0;
#pragma unroll
      for (int j = 0; j < 32; ++j) { const float send = up ? v[j] : v[j + 32], keep = up ? v[j + 32] : v[j]; v[j] = keep + sh32_get(send, lane); } }
    { const bool up = (lane & 16) != 0;
#pragma unroll
      for (int j = 0; j < 16; ++j) { const float send = up ? v[j] : v[j + 16], keep = up ? v[j + 16] : v[j]; v[j] = keep + shx<16>(send); } }
    { const bool up = (lane & 8) != 0;
#pragma unroll
      for (int j = 0; j < 8; ++j) { const float send = up ? v[j] : v[j + 8], keep = up ? v[j + 8] : v[j]; v[j] = keep + shx<8>(send); } }
    { const bool up = (lane & 4) != 0;
#pragma unroll
      for (int j = 0; j < 4; ++j) { const float send = up ? v[j] : v[j + 4], keep = up ? v[j + 4] : v[j]; v[j] = keep + shx<4>(send); } }
    { const bool up = (lane & 2) != 0;
#pragma unroll
      for (int j = 0; j < 2; ++j) { const float send = up ? v[j] : v[j + 2], keep = up ? v[j + 2] : v[j]; v[j] = keep + shx<2>(send); } }
    { const bool up = (lane & 1) != 0; const float send = up ? v[0] : v[1], keep = up ? v[1] : v[0]; v[0] = keep + shx<1>(send); }
    return v[0];
}
__device__ __forceinline__ void post_even(const InPtrs& in, unsigned char* ws, const float* H, const float* ssq, LAS unsigned char* lds, int G, int tid, int wave, int lane) {
    float* Flocal = (float*)(ws + WS_FL); float* Btot = Flocal + S * 8; float* IW = (float*)(ws + WS_IW);
    const float* bfg = in.p[7];
    LAS f32x4* Tw = (LAS f32x4*)lds;
    LAS float* lf = (LAS float*)(lds + 65536);
    { const GAS f32x4* src = (const GAS f32x4*)(ws + WS_TW);
#pragma unroll
      for (int i = 0; i < 8; ++i) Tw[tid + 512 * i] = src[tid + 512 * i]; }
    __syncthreads();
    for (int u = blockIdx.x; u < S / 64; u += G) {
        const int t0 = u * 64, tw0 = t0 + wave * 8;
#pragma unroll 1
        for (int rb = 0; rb < 2; ++rb) {
            float acc[64];
#pragma unroll
            for (int j = 0; j < 64; ++j) acc[j] = 0.f;
#pragma unroll
            for (int q = 0; q < 4; ++q) {
                f32x4 hv[4];
#pragma unroll
                for (int r = 0; r < 4; ++r) hv[r] = *((const GAS f32x4*)(H + (size_t)(tw0 + rb * 4 + r) * DM) + lane + 64 * q);
#pragma unroll
                for (int e = 0; e < 4; ++e)
#pragma unroll
                    for (int c = 0; c < 4; ++c) { const f32x4 w = Tw[((q * 4 + e) * 4 + c) * 64 + lane];
#pragma unroll
                        for (int r = 0; r < 4; ++r) { acc[r * 16 + 4 * c + 0] += hv[r][e] * w[0]; acc[r * 16 + 4 * c + 1] += hv[r][e] * w[1]; acc[r * 16 + 4 * c + 2] += hv[r][e] * w[2]; acc[r * 16 + 4 * c + 3] += hv[r][e] * w[3]; } }
            }
            const float zs = reduce_scatter64(acc, lane);
            const int rl = wave * 8 + rb * 4 + (lane >> 4), t = t0 + rl, j = lane & 15;
            const float z = zs * pg8::row_rstd(ssq, t);
            if (j < 8) { const float zz = z + bfg[j]; lf[rl * 8 + j] = (zz > 15.f) ? -expf(-zz) : -log1pf(expf(-zz)); }
            else IW[(size_t)t * 8 + (j - 8)] = z * 0.044194173824159216f;
        }
        __syncthreads();
        {
            float v = lf[lane * 8 + wave];
#pragma unroll
            for (int o = 1; o < 64; o <<= 1) { const float up = __int_as_float(__builtin_amdgcn_ds_bpermute(((lane - o) & 63) << 2, __float_as_int(v))); if (lane >= o) v += up; }
            Flocal[(size_t)(t0 + lane) * 8 + wave] = v;
            if (lane == 63) Btot[u * 8 + wave] = v;
        }
        __syncthreads();
    }
}

__device__ __forceinline__ void post_odd(unsigned char* ws, LAS unsigned char* lds, int G, int tid) {
    const bf16* Kb = (const bf16*)(ws + WS_BIG + B_PROJ) + (size_t)S * DM; float* ksum = (float*)(ws + WS_KSUM);
    LAS float* red = (LAS float*)lds;
    for (int u = blockIdx.x; u < 256; u += G) {
        const int n = u >> 2, cg = u & 3, c2 = tid & 127, rg = tid >> 7;
        const bf16* kp = Kb + (size_t)(n * 256 + rg * 64) * DM + cg * 256 + c2 * 2;
        float s0 = 0.f, s1 = 0.f;
#pragma unroll 16
        for (int r = 0; r < 64; ++r) { const unsigned w = *(const GAS unsigned*)(kp + (size_t)r * DM); s0 += bflo(w); s1 += bfhi(w); }
        __syncthreads();
        red[rg * 256 + c2 * 2] = s0; red[rg * 256 + c2 * 2 + 1] = s1;
        __syncthreads();
        if (tid < 256) ksum[(size_t)n * 1024 + cg * 256 + tid] = (red[tid] + red[256 + tid]) + (red[512 + tid] + red[768 + tid]);
    }
}

constexpr int KV_K_BYTES = 8192, KV_VT_PITCH = 136, KV_BUF_BYTES = KV_K_BYTES + 64 * KV_VT_PITCH;
struct KVRegs { v4u k, v; };
__device__ __forceinline__ void kv_load(KVRegs& r, const bf16* Kp, size_t kpitch, const bf16* Vtp, size_t vtpitch, int key0, int tid) {
    r.k = *(const GAS v4u*)(Kp + (size_t)(key0 + (tid & 63)) * kpitch + (tid >> 6) * 8);
    r.v = *(const GAS v4u*)(Vtp + (size_t)(tid >> 3) * vtpitch + key0 + (tid & 7) * 8);
}
__device__ __forceinline__ void kv_store(const KVRegs& r, LAS unsigned char* buf, int tid) {
    *(LAS v4u*)(buf + ((tid >> 6) * 64 + (tid & 63)) * 16) = r.k;
    LAS unsigned char* vp = buf + KV_K_BYTES + (tid >> 3) * KV_VT_PITCH + (tid & 7) * 16;
    *(LAS u32x2*)vp = (u32x2){r.v.x, r.v.y}; *(LAS u32x2*)(vp + 8) = (u32x2){r.v.z, r.v.w};
}
struct AttnAcc { float m, l; f32x16 o0, o1; };
__device__ __forceinline__ void attn_init(AttnAcc& a) { a.m = -INFINITY; a.l = 0.f;
#pragma unroll
    for (int r = 0; r < 16; ++r) { a.o0[r] = 0.f; a.o1[r] = 0.f; } }
template <int CHS = 1024>
__device__ __forceinline__ void attn_scores(f32x16& p0, f32x16& p1, const LAS unsigned char* buf, const bf16x8 (&qf)[4], int lane) {
    const int r32 = lane & 31, hi = lane >> 5;
#pragma unroll
    for (int r = 0; r < 16; ++r) { p0[r] = 0.f; p1[r] = 0.f; }
#pragma unroll
    for (int ks = 0; ks < 4; ++ks) {
        const bf16x8 k0 = *(const LAS bf16x8*)(buf + (2 * ks + hi) * CHS + r32 * 16);
        const bf16x8 k1 = *(const LAS bf16x8*)(buf + (2 * ks + hi) * CHS + (32 + r32) * 16);
        p0 = __builtin_amdgcn_mfma_f32_32x32x16_bf16(k0, qf[ks], p0, 0, 0, 0);
        p1 = __builtin_amdgcn_mfma_f32_32x32x16_bf16(k1, qf[ks], p1, 0, 0, 0);
    }
}
template <int VTP = KV_VT_PITCH, int VOFF = KV_K_BYTES>
__device__ __forceinline__ void attn_update(AttnAcc& a, f32x16& p0, f32x16& p1, const LAS unsigned char* buf, int lane) {
    const int r32 = lane & 31, hi = lane >> 5;
    float mx = fmaxf(p0[0], p1[0]);
#pragma unroll
    for (int r = 1; r < 16; ++r) mx = fmaxf(mx, fmaxf(p0[r], p1[r]));
    mx = sh32_max(mx);
    const float mnew = fmaxf(a.m, mx);
    const float msafe = (mnew == -INFINITY) ? 0.f : mnew;
    const float alpha = __builtin_amdgcn_exp2f(a.m - msafe);
    float sum = 0.f;
#pragma unroll
    for (int r = 0; r < 16; ++r) { p0[r] = __builtin_amdgcn_exp2f(p0[r] - msafe); p1[r] = __builtin_amdgcn_exp2f(p1[r] - msafe); sum += p0[r] + p1[r]; }
    a.l = a.l * alpha + sum; a.m = mnew;
#pragma unroll
    for (int r = 0; r < 16; ++r) { a.o0[r] *= alpha; a.o1[r] *= alpha; }
    const LAS unsigned char* vt = buf + VOFF + r32 * VTP + hi * 8;
#pragma unroll
    for (int half = 0; half < 2; ++half) {
#pragma unroll
        for (int s = 0; s < 2; ++s) {
            v4u pw;
            if (half == 0) { pw.x = cvtpk(p0[8 * s + 0], p0[8 * s + 1]); pw.y = cvtpk(p0[8 * s + 2], p0[8 * s + 3]); pw.z = cvtpk(p0[8 * s + 4], p0[8 * s + 5]); pw.w = cvtpk(p0[8 * s + 6], p0[8 * s + 7]); }
            else           { pw.x = cvtpk(p1[8 * s + 0], p1[8 * s + 1]); pw.y = cvtpk(p1[8 * s + 2], p1[8 * s + 3]); pw.z = cvtpk(p1[8 * s + 4], p1[8 * s + 5]); pw.w = cvtpk(p1[8 * s + 6], p1[8 * s + 7]); }
            const bf16x8 pb = __builtin_bit_cast(bf16x8, pw);
            const int kb = (32 * half + 16 * s) * 2;
#pragma unroll
            for (int d0 = 0; d0 < 2; ++d0) {
                const u32x2 lo = *(const LAS u32x2*)(vt + d0 * 32 * VTP + kb), hi2 = *(const LAS u32x2*)(vt + d0 * 32 * VTP + kb + 16);
                const bf16x8 va = __builtin_bit_cast(bf16x8, (v4u){lo.x, lo.y, hi2.x, hi2.y});
                if (d0 == 0) a.o0 = __builtin_amdgcn_mfma_f32_32x32x16_bf16(va, pb, a.o0, 0, 0, 0);
                else         a.o1 = __builtin_amdgcn_mfma_f32_32x32x16_bf16(va, pb, a.o1, 0, 0, 0);
            }
        }
    }
}
__device__ __forceinline__ void attn_store(const AttnAcc& a, bf16* orow, int lane) {
    const int hi = lane >> 5;
    float l = sh32_sum(a.l);
    const float inv = (l > 0.f) ? 1.0f / l : 0.f;
#pragma unroll
    for (int g = 0; g < 4; ++g) {
        u32x2 w0, w1;
        w0.x = cvtpk(a.o0[4 * g] * inv, a.o0[4 * g + 1] * inv); w0.y = cvtpk(a.o0[4 * g + 2] * inv, a.o0[4 * g + 3] * inv);
        w1.x = cvtpk(a.o1[4 * g] * inv, a.o1[4 * g + 1] * inv); w1.y = cvtpk(a.o1[4 * g + 2] * inv, a.o1[4 * g + 3] * inv);
        *(GAS u32x2*)(orow + 8 * g + 4 * hi) = w0; *(GAS u32x2*)(orow + 32 + 8 * g + 4 * hi) = w1;
    }
}
__device__ __forceinline__ void load_q(bf16x8 (&qf)[4], const bf16* qrow, int lane) {
    const int hi = lane >> 5;
#pragma unroll
    for (int ks = 0; ks < 4; ++ks) qf[ks] = *(const GAS bf16x8*)(qrow + 16 * ks + 8 * hi);
}

constexpr int CW_FOXQ = 64;
__device__ __forceinline__ void fox_phase(const InPtrs& in, unsigned char* ws, LAS unsigned char* lds, int G, int tid, int wave, int lane, bf16* obase, size_t opitch, int qword) {
    bf16* proj = (bf16*)(ws + WS_BIG + B_PROJ); const bf16* VtF = (const bf16*)(ws + WS_BIG + B_VTF);
    const float* Flocal = (const float*)(ws + WS_FL); const float* Btot = Flocal + S * 8;
    unsigned* qctr = (unsigned*)(ws + WS_CTL) + qword;
    LAS unsigned char* kvb = lds; LAS float* kbt = (LAS float*)(lds + 2 * KV_BUF_BYTES); LAS float* bt = (LAS float*)(lds + 2 * KV_BUF_BYTES + 65536); LAS float* Et = bt + 272;
    LAS int* misc = (LAS int*)(Et + 272);
    const int r32 = lane & 31, hi = lane >> 5;
    if (wave == 0) { const float gq = wave_max(fabsf(in.p[8][lane])), gk = wave_max(fabsf(in.p[9][lane])); if (lane == 0) { ((LAS float*)misc)[2] = gq; ((LAS float*)misc)[3] = gk; } }
    __syncthreads();
    const float THR = 2.0f * (0.125f * LOG2E * 64.0f * 1.02f) * ((LAS float*)misc)[2] * ((LAS float*)misc)[3] + 32.0f;
    for (;;) {
        __syncthreads();
        if (tid == 0) misc[0] = (int)atomicAdd(qctr, 1u);
        __syncthreads();
        const int u = misc[0];
        if (u >= 512) break;
        const int QB = 63 - (u >> 3), h = u & 7, q0 = QB * 256, nt = 4 * (QB + 1);
        for (int j = tid; j < nt; j += NTHREADS) bt[j] = Btot[j * 8 + h];
        if (tid == 0) misc[1] = 4 * QB;
        __syncthreads();
        for (int j = tid; j <= nt; j += NTHREADS) { float e = 0.f;
            if (j <= 4 * QB) { for (int i = 4 * QB - 1; i >= j; --i) e -= bt[i]; } else { for (int i = 4 * QB; i < j; ++i) e += bt[i]; }
            Et[j] = e; }
        __syncthreads();
        for (int j = tid; j < 4 * QB; j += NTHREADS) if (Et[j + 1] * LOG2E <= THR) atomicMin((int*)&misc[1], j);
        __syncthreads();
        const int t_start = misc[1], s0 = 64 * t_start;
        for (int s = s0 + tid; s < q0 + 256; s += NTHREADS) kbt[s - s0] = -(Et[s >> 6] + Flocal[(size_t)s * 8 + h]) * LOG2E;
        const int qrow = q0 + wave * 32 + r32;
        bf16x8 qf[4]; load_q(qf, proj + (size_t)qrow * EVEN_NP + EC_FQ + h * 64, lane);
        AttnAcc a; attn_init(a);
        const bf16* Kp = proj + EC_FK + h * 64; const bf16* Vtp = VtF + (size_t)h * 64 * S;
        KVRegs kr; kv_load(kr, Kp, EVEN_NP, Vtp, S, s0, tid); kv_store(kr, kvb, tid);
        __syncthreads();
        const float kbw = kbt[q0 + wave * 32 - s0];
        for (int t = t_start; t < nt; ++t) {
            LAS unsigned char* cur = kvb + ((t - t_start) & 1) * KV_BUF_BYTES;
            if (t + 1 < nt) kv_load(kr, Kp, EVEN_NP, Vtp, S, (t + 1) * 64, tid);
            const int key0 = t * 64;
            const bool vis = key0 <= q0 + wave * 32 + 31;
            const bool live = (key0 + 63 >= q0) || (kbw - kbt[key0 + 63 - s0] <= THR);
            if (vis && __builtin_amdgcn_readfirstlane((int)live)) {
                f32x16 p0, p1; attn_scores(p0, p1, cur, qf, lane);
#pragma unroll
                for (int g = 0; g < 4; ++g) {
                    const f32x4 b0 = *(const LAS f32x4*)(kbt + key0 - s0 + 8 * g + 4 * hi), b1 = *(const LAS f32x4*)(kbt + key0 - s0 + 32 + 8 * g + 4 * hi);
#pragma unroll
                    for (int e = 0; e < 4; ++e) { p0[4 * g + e] = p0[4 * g + e] * C2 + b0[e]; p1[4 * g + e] = p1[4 * g + e] * C2 + b1[e]; }
                }
                if (key0 + 63 > q0 + wave * 32) {
#pragma unroll
                    for (int r = 0; r < 16; ++r) { const int kv = key0 + crow(r, hi); if (kv > qrow) p0[r] = -INFINITY; if (kv + 32 > qrow) p1[r] = -INFINITY; }
                }
                attn_update(a, p0, p1, cur, lane);
            }
            if (t + 1 < nt) kv_store(kr, kvb + ((t + 1 - t_start) & 1) * KV_BUF_BYTES, tid);
            __syncthreads();
        }
        attn_store(a, obase + (size_t)qrow * opitch + h * 64, lane);
    }
}

__device__ __forceinline__ void memattn_phase(const InPtrs& in, unsigned char* ws, int L, LAS unsigned char* lds, int G, int tid, int wave, int lane) {
    const bf16* QM = (const bf16*)(ws + WS_BIG + B_QM); bf16* OM = (bf16*)(ws + WS_BIG + B_OM);
    const bf16* memK = (const bf16*)(ws + WS_MEMK) + (size_t)L * 256 * 256; const bf16* memVt = (const bf16*)(ws + WS_MEMK + 256 * 1024) + (size_t)L * 256 * 256;
    const float* qn = in.p[20] + (size_t)L * 64;
    LAS unsigned char* kvb = lds;
    const int r32 = lane & 31, hi = lane >> 5;
    for (int un = blockIdx.x; un < 256; un += G) {
        const int QB = un >> 2, hm = un & 3, qrow = QB * 256 + wave * 32 + r32;
        bf16x8 qf[4];
        {
            const bf16* qp = QM + (size_t)qrow * MEMW + hm * 64; float x[4][8]; float ss = 0.f;
#pragma unroll
            for (int ks = 0; ks < 4; ++ks) { const v4u w = *(const GAS v4u*)(qp + 16 * ks + 8 * hi); unpack8(w, x[ks]);
#pragma unroll
                for (int j = 0; j < 8; ++j) ss += x[ks][j] * x[ks][j]; }
            ss = sh32_sum(ss);
            const float r = rsqrtf(ss * (1.0f / 64.0f) + RMS_EPS);
#pragma unroll
            for (int ks = 0; ks < 4; ++ks) {
#pragma unroll
                for (int j = 0; j < 8; ++j) x[ks][j] = x[ks][j] * r * qn[16 * ks + 8 * hi + j];
                qf[ks] = __builtin_bit_cast(bf16x8, pack8(x[ks])); }
        }
        AttnAcc a; attn_init(a);
        const bf16* Kp = memK + hm * 64; const bf16* Vtp = memVt + (size_t)hm * 64 * 256;
        __syncthreads();
        KVRegs kr; kv_load(kr, Kp, 256, Vtp, 256, 0, tid); kv_store(kr, kvb, tid);
        __syncthreads();
        for (int t = 0; t < 4; ++t) {
            LAS unsigned char* cur = kvb + (t & 1) * KV_BUF_BYTES;
            if (t + 1 < 4) kv_load(kr, Kp, 256, Vtp, 256, (t + 1) * 64, tid);
            f32x16 p0, p1; attn_scores(p0, p1, cur, qf, lane);
#pragma unroll
            for (int r = 0; r < 16; ++r) { p0[r] *= C2; p1[r] *= C2; }
            attn_update(a, p0, p1, cur, lane);
            if (t + 1 < 4) kv_store(kr, kvb + ((t + 1) & 1) * KV_BUF_BYTES, tid);
            __syncthreads();
        }
        attn_store(a, OM + (size_t)qrow * MEMW + hm * 64, lane);
    }
}

constexpr size_t WS_MSEL = 7 * MiB;
constexpr size_t WS_MLSE = 8 * MiB;
constexpr size_t B_OP0 = 64 * MiB, B_OP1 = 128 * MiB;
__device__ __forceinline__ bool gate_better(float g1, int n1, float g2, int n2) { return g1 > g2 || (g1 == g2 && n1 < n2); }
__device__ __forceinline__ void moba_gate_phase(unsigned char* ws, int G, int wave, int lane) {
    const bf16* Q = (const bf16*)(ws + WS_BIG + B_PROJ); const float* ksum = (const float*)(ws + WS_KSUM); unsigned* selg = (unsigned*)(ws + WS_MSEL);
    const int r32 = lane & 31, hi = lane >> 5;
    const int NW = G * NWAVES;
    const int gwid = (int)blockIdx.x * NWAVES + wave;
    const int per_head = NW / 16;
    if (per_head == 0) return;
    const int h = gwid / per_head, wi = gwid % per_head;
    if (h >= 16) return;
    float af[2][32];
#pragma unroll
    for (int g = 0; g < 2; ++g)
#pragma unroll
        for (int kk = 0; kk < 32; ++kk) af[g][kk] = ksum[(size_t)(32 * g + r32) * 1024 + h * 64 + 2 * kk + hi] * (1.0f / 256.0f);
    for (int tile = wi; tile < S / 32; tile += per_head) {
        const int t = tile * 32 + r32, own = (tile * 32) >> 8;
        float bq[32];
        { const bf16* qp = Q + (size_t)t * DM + h * 64;
#pragma unroll
          for (int c = 0; c < 8; ++c) { const unsigned sh = hi ? 0u : 16u;   const v4u w = *(const GAS v4u*)(qp + 8 * c);
              bq[4 * c + 0] = __uint_as_float((w.x << sh) & 0xffff0000u); bq[4 * c + 1] = __uint_as_float((w.y << sh) & 0xffff0000u);
              bq[4 * c + 2] = __uint_as_float((w.z << sh) & 0xffff0000u); bq[4 * c + 3] = __uint_as_float((w.w << sh) & 0xffff0000u); } }
        float g0 = -INFINITY, g1 = -INFINITY, g2 = -INFINITY; int n0 = 255, n1 = 255, n2 = 255;
#pragma unroll
        for (int g = 0; g < 2; ++g) {
            if (32 * g < own) {
                f32x16 c;
#pragma unroll
                for (int r = 0; r < 16; ++r) c[r] = 0.f;
#pragma unroll
                for (int kk = 0; kk < 32; ++kk) c = __builtin_amdgcn_mfma_f32_32x32x2f32(af[g][kk], bq[kk], c, 0, 0, 0);
#pragma unroll
                for (int r = 0; r < 16; ++r) { const int n = 32 * g + crow(r, hi); const float gv = (n < own) ? c[r] : -INFINITY;
                    if (n < own) {
                        if (gate_better(gv, n, g0, n0)) { g2 = g1; n2 = n1; g1 = g0; n1 = n0; g0 = gv; n0 = n; }
                        else if (gate_better(gv, n, g1, n1)) { g2 = g1; n2 = n1; g1 = gv; n1 = n; }
                        else if (gate_better(gv, n, g2, n2)) { g2 = gv; n2 = n; } } }
            }
        }
        const float p0 = sh32_get(g0, lane), p1 = sh32_get(g1, lane), p2 = sh32_get(g2, lane);
        const int pn0 = __float_as_int(sh32_get(__int_as_float(n0), lane)), pn1 = __float_as_int(sh32_get(__int_as_float(n1), lane)), pn2 = __float_as_int(sh32_get(__int_as_float(n2), lane));
        float fg[3]; int fn[3]; int ia = 0, ib = 0;
#pragma unroll
        for (int k = 0; k < 3; ++k) {
            const float ga = (ia == 0) ? g0 : (ia == 1) ? g1 : (ia == 2) ? g2 : -INFINITY; const int na = (ia == 0) ? n0 : (ia == 1) ? n1 : (ia == 2) ? n2 : 255;
            const float gb = (ib == 0) ? p0 : (ib == 1) ? p1 : (ib == 2) ? p2 : -INFINITY; const int nb = (ib == 0) ? pn0 : (ib == 1) ? pn1 : (ib == 2) ? pn2 : 255;
            const bool ta = (na != 255) && (nb == 255 || gate_better(ga, na, gb, nb));
            if (ta) { fg[k] = ga; fn[k] = na; ++ia; } else { fg[k] = gb; fn[k] = nb; ++ib; }
        }
        (void)fg;
        if (hi == 0) selg[(size_t)h * S + t] = (unsigned)(fn[0] & 255) | ((unsigned)(fn[1] & 255) << 8) | ((unsigned)(fn[2] & 255) << 16);
    }
}
constexpr int MR_KIMG = 32768, MR_VTP = 520, MR_VIMG = 64 * MR_VTP;
constexpr int CW_MOBAQ = 192;
__device__ __forceinline__ void moba_route_phase(unsigned char* ws, LAS unsigned char* lds, int G, int tid, int wave, int lane, int qword) {
    const bf16* Q = (const bf16*)(ws + WS_BIG + B_PROJ); const bf16* Kb = Q + (size_t)S * DM; const bf16* Vt = (const bf16*)(ws + WS_BIG + B_VTM);
    const unsigned* selg = (const unsigned*)(ws + WS_MSEL); float* lse = (float*)(ws + WS_MLSE);
    unsigned* qctr = (unsigned*)(ws + WS_CTL) + qword;
    LAS unsigned char* kimg = lds; LAS unsigned char* vimg = lds + MR_KIMG;
    LAS int* list = (LAS int*)(lds + MR_KIMG + MR_VIMG);
    LAS int* wtot = list + 4096;
    LAS int* ubox = wtot + 64;
    const int r32 = lane & 31, hi = lane >> 5;
    const int NUNITS = 16 * 156;
    for (;;) {
        __syncthreads();
        if (tid == 0) ubox[0] = (int)atomicAdd(qctr, 1u);
        __syncthreads();
        const int u = ubox[0];
        if (u >= NUNITS) break;
        int c = 0, rem = u;
        while (rem >= 16 * min(63, 16 * c + 15)) { rem -= 16 * min(63, 16 * c + 15); ++c; }
        const int n = rem >> 4, h = rem & 15;
        const int tlo = max(4096 * c, 256 * (n + 1));
        v4u kst[4], vst[4];
        { const bf16* Kp = Kb + (size_t)(256 * n) * DM + h * 64; const bf16* Vp = Vt + (size_t)h * 64 * S + 256 * n;
#pragma unroll
          for (int i = 0; i < 4; ++i) { const int piece = tid + 512 * i;
              kst[i] = *(const GAS v4u*)(Kp + (size_t)(piece >> 3) * DM + (piece & 7) * 8);
              vst[i] = *(const GAS v4u*)(Vp + (size_t)(piece >> 5) * S + (piece & 31) * 8); } }
        int myent[8]; bool mysel[8];
#pragma unroll
        for (int i = 0; i < 8; ++i) { const int t = 4096 * c + 512 * i + tid; mysel[i] = false; myent[i] = 0;
            if (t >= tlo) { const unsigned w = selg[(size_t)h * S + t];
                const int slot = ((w & 255u) == (unsigned)n) ? 0 : (((w >> 8) & 255u) == (unsigned)n) ? 1 : (((w >> 16) & 255u) == (unsigned)n) ? 2 : -1;
                if (slot >= 0) { mysel[i] = true; myent[i] = t | (slot << 16); } }
            const unsigned long long mk = __ballot(mysel[i]);
            if (lane == 0) wtot[i * 8 + wave] = __popcll(mk); }
        __syncthreads();
        int cnt = 0;
#pragma unroll
        for (int i = 0; i < 8; ++i) { int base = cnt;
#pragma unroll
            for (int w8 = 0; w8 < 8; ++w8) { const int v = wtot[i * 8 + w8]; if (w8 < wave) base += v; cnt += v; }
            const unsigned long long mk = __ballot(mysel[i]);
            if (mysel[i]) list[base + __popcll(mk & ((1ull << lane) - 1ull))] = myent[i]; }
#pragma unroll
        for (int i = 0; i < 4; ++i) { const int piece = tid + 512 * i;
            *(LAS v4u*)(kimg + ((piece & 7) * 256 + (piece >> 3)) * 16) = kst[i];
            LAS unsigned char* vp = vimg + (piece >> 5) * MR_VTP + (piece & 31) * 16;
            *(LAS u32x2*)vp = (u32x2){vst[i].x, vst[i].y}; *(LAS u32x2*)(vp + 8) = (u32x2){vst[i].z, vst[i].w}; }
        __syncthreads();
        if (cnt == 0) continue;
        const int ntile = (cnt + 31) >> 5;
        for (int ti = wave; ti < ntile; ti += NWAVES) {
            const int e = ti * 32 + r32; const bool live = e < cnt;
            const int ent = list[live ? e : 0]; const int t = ent & 0xffff, slot = ent >> 16;
            bf16x8 qf[4]; load_q(qf, Q + (size_t)t * DM + h * 64, lane);
            AttnAcc a; attn_init(a);
#pragma unroll 1
            for (int j = 0; j < 4; ++j) {
                f32x16 p0, p1; attn_scores<4096>(p0, p1, kimg + j * 64 * 16, qf, lane);
#pragma unroll
                for (int r = 0; r < 16; ++r) { p0[r] *= C2; p1[r] *= C2; }
                attn_update<MR_VTP, 0>(a, p0, p1, vimg + j * 128, lane);
            }
            const float l = sh32_sum(a.l); const float inv = 1.0f / l;
            if (live) {
                bf16* orow = (bf16*)(ws + (slot == 0 ? WS_BIG + B_OP0 : slot == 1 ? WS_BIG + B_OP1 : WS_HB)) + ((size_t)t * 16 + h) * 64;
#pragma unroll
                for (int g = 0; g < 4; ++g) { u32x2 w0, w1;
                    w0.x = cvtpk(a.o0[4 * g] * inv, a.o0[4 * g + 1] * inv); w0.y = cvtpk(a.o0[4 * g + 2] * inv, a.o0[4 * g + 3] * inv);
                    w1.x = cvtpk(a.o1[4 * g] * inv, a.o1[4 * g + 1] * inv); w1.y = cvtpk(a.o1[4 * g + 2] * inv, a.o1[4 * g + 3] * inv);
                    *(GAS u32x2*)(orow + 8 * g + 4 * hi) = w0; *(GAS u32x2*)(orow + 32 + 8 * g + 4 * hi) = w1; }
                if (hi == 0) lse[((size_t)slot * S + t) * 16 + h] = a.m + __builtin_amdgcn_logf(l);
            }
        }
    }
}
__device__ __forceinline__ void moba_own_phase(unsigned char* ws, LAS unsigned char* lds, int G, int tid, int wave, int lane) {
    bf16* Q = (bf16*)(ws + WS_BIG + B_PROJ); const bf16* Kb = Q + (size_t)S * DM; const bf16* Vt = (const bf16*)(ws + WS_BIG + B_VTM);
    const unsigned* selg = (const unsigned*)(ws + WS_MSEL); const float* lse = (const float*)(ws + WS_MLSE);
    LAS unsigned char* kvb = lds;
    const int r32 = lane & 31, hi = lane >> 5;
    for (int un = blockIdx.x; un < 1024; un += G) {
        const int h = un & 15, QB = un >> 4, q0 = QB * 256, qrow = q0 + wave * 32 + r32;
        bf16x8 qf[4]; load_q(qf, Q + (size_t)qrow * DM + h * 64, lane);
        AttnAcc a; attn_init(a);
        const bf16* Kp = Kb + h * 64; const bf16* Vtp = Vt + (size_t)h * 64 * S;
        __syncthreads();
        KVRegs kr; kv_load(kr, Kp, DM, Vtp, S, q0, tid); kv_store(kr, kvb, tid);
        __syncthreads();
        for (int t = 0; t < 4; ++t) {
            LAS unsigned char* cur = kvb + (t & 1) * KV_BUF_BYTES;
            const int key0 = q0 + t * 64;
            if (t + 1 < 4) kv_load(kr, Kp, DM, Vtp, S, key0 + 64, tid);
            if (key0 <= q0 + wave * 32 + 31) {
                f32x16 p0, p1; attn_scores(p0, p1, cur, qf, lane);
#pragma unroll
                for (int r = 0; r < 16; ++r) { const int kv = key0 + crow(r, hi); p0[r] = (kv > qrow) ? -INFINITY : p0[r] * C2; p1[r] = (kv + 32 > qrow) ? -INFINITY : p1[r] * C2; }
                attn_update(a, p0, p1, cur, lane);
            }
            if (t + 1 < 4) kv_store(kr, kvb + ((t + 1) & 1) * KV_BUF_BYTES, tid);
            __syncthreads();
        }
        const unsigned sw = selg[(size_t)h * S + qrow];
        float L[3];
#pragma unroll
        for (int j = 0; j < 3; ++j) L[j] = (((sw >> (8 * j)) & 255u) != 255u) ? lse[((size_t)j * S + qrow) * 16 + h] : -INFINITY;
        const float M = fmaxf(fmaxf(a.m, L[0]), fmaxf(L[1], L[2]));
        const float so = __builtin_amdgcn_exp2f(a.m - M);
        float W = sh32_sum(a.l) * so;
#pragma unroll
        for (int r = 0; r < 16; ++r) { a.o0[r] *= so; a.o1[r] *= so; }
#pragma unroll
        for (int j = 0; j < 3; ++j) {
            if (L[j] != -INFINITY) {
                const float wj = __builtin_amdgcn_exp2f(L[j] - M); W += wj;
                const bf16* orow = (const bf16*)(ws + (j == 0 ? WS_BIG + B_OP0 : j == 1 ? WS_BIG + B_OP1 : WS_HB)) + ((size_t)qrow * 16 + h) * 64;
#pragma unroll
                for (int g = 0; g < 4; ++g) { const u32x2 w0 = *(const GAS u32x2*)(orow + 8 * g + 4 * hi), w1 = *(const GAS u32x2*)(orow + 32 + 8 * g + 4 * hi);
                    a.o0[4 * g] += wj * bflo(w0.x); a.o0[4 * g + 1] += wj * bfhi(w0.x); a.o0[4 * g + 2] += wj * bflo(w0.y); a.o0[4 * g + 3] += wj * bfhi(w0.y);
                    a.o1[4 * g] += wj * bflo(w1.x); a.o1[4 * g + 1] += wj * bfhi(w1.x); a.o1[4 * g + 2] += wj * bflo(w1.y); a.o1[4 * g + 3] += wj * bfhi(w1.y); }
            }
        }
        const float inv = 1.0f / W;
        bf16* orow = Q + (size_t)qrow * DM + h * 64;
#pragma unroll
        for (int g = 0; g < 4; ++g) { u32x2 w0, w1;
            w0.x = cvtpk(a.o0[4 * g] * inv, a.o0[4 * g + 1] * inv); w0.y = cvtpk(a.o0[4 * g + 2] * inv, a.o0[4 * g + 3] * inv);
            w1.x = cvtpk(a.o1[4 * g] * inv, a.o1[4 * g + 1] * inv); w1.y = cvtpk(a.o1[4 * g + 2] * inv, a.o1[4 * g + 3] * inv);
            *(GAS u32x2*)(orow + 8 * g + 4 * hi) = w0; *(GAS u32x2*)(orow + 32 + 8 * g + 4 * hi) = w1; }
    }
}

typedef float f32x4v __attribute__((ext_vector_type(4)));
__device__ __forceinline__ unsigned mono_key(float s) { if (s == 0.f) s = 0.f; const unsigned u = __float_as_uint(s); return (u & 0x80000000u) ? ~u : (u | 0x80000000u); }
constexpr int DS_CAP = 512;
__device__ __forceinline__ unsigned wave_or(unsigned v) { v |= (unsigned)shx_i<1>((int)v); v |= (unsigned)shx_i<2>((int)v); v |= (unsigned)shx_i<4>((int)v); v |= (unsigned)shx_i<8>((int)v); v |= (unsigned)shx_i<16>((int)v);
    auto r = __builtin_amdgcn_permlane32_swap(v, v, false, false); return r[0] | r[1]; }
template <bool EXACT>
__device__ __forceinline__ unsigned dsa_compact(LAS u32x2* ent, int n, int& nkeep, int lane) {
    unsigned k[8]; unsigned ix[8]; unsigned orv = 0u, nandv = 0u;
#pragma unroll
    for (int j = 0; j < 8; ++j) { const int e = lane + 64 * j; const bool in = e < n; const u32x2 v = ent[in ? e : 0]; k[j] = in ? v.x : 0u; ix[j] = v.y; orv |= k[j]; nandv |= in ? ~v.x : 0u; }
    unsigned T = 0u; int cntT = n; int bit0 = 31;
    if (!EXACT) {
        const unsigned diff = (unsigned)__builtin_amdgcn_readfirstlane((int)(wave_or(orv) & wave_or(nandv)));
        if (diff != 0u) { bit0 = 31 - __builtin_clz(diff); const unsigned anyk = (unsigned)__builtin_amdgcn_readfirstlane((int)k[0]);
            T = (bit0 == 31) ? 0u : (anyk & ~((2u << bit0) - 1u)); }
    }
    for (int bit = bit0; bit >= 0; --bit) {
        const unsigned cand = T | (1u << bit); int c = 0;
#pragma unroll
        for (int j = 0; j < 8; ++j) c += __popcll(__ballot(k[j] >= cand));
        if (c >= 256) { T = cand; cntT = c; if (!EXACT && c <= 320) break; }
    }
    int Jstar = 0x10000;
    if (cntT > (EXACT ? 256 : 320)) {
        int gt = 0;
#pragma unroll
        for (int j = 0; j < 8; ++j) gt += __popcll(__ballot(k[j] > T));
        const int need = 256 - gt; int Jm = 0;
        for (int bit = 14; bit >= 0; --bit) { const int cand = Jm | (1 << bit); int c = 0;
#pragma unroll
            for (int j = 0; j < 8; ++j) c += __popcll(__ballot(k[j] == T && (int)ix[j] < cand));
            if (c < need) Jm = cand; }
        Jstar = Jm + 1;
    }
    int base = 0;
    const unsigned long long lt = (1ull << lane) - 1ull;
#pragma unroll
    for (int j = 0; j < 8; ++j) { const bool pred = (k[j] > T) || (k[j] == T && T != 0u && (int)ix[j] < Jstar);
        const unsigned long long mask = __ballot(pred); const int pos = base + __popcll(mask & lt);
        if (pred) ent[pos] = (u32x2){k[j], ix[j]};
        base += __popcll(mask); }
    nkeep = base;
    return T;
}
#define DSA_HEADSUM(s, P, B, W) asm("v_max_f32_e32 %1, 0, %2\n\tv_mul_f32_e32 %0, %10, %1\n\tv_max_f32_e32 %1, 0, %3\n\tv_fmac_f32_e32 %0, %11, %1\n\tv_max_f32_e32 %1, 0, %4\n\tv_fmac_f32_e32 %0, %12, %1\n\t" \
        "v_max_f32_e32 %1, 0, %5\n\tv_fmac_f32_e32 %0, %13, %1\n\tv_max_f32_e32 %1, 0, %6\n\tv_fmac_f32_e32 %0, %14, %1\n\tv_max_f32_e32 %1, 0, %7\n\tv_fmac_f32_e32 %0, %15, %1\n\t" \
        "v_max_f32_e32 %1, 0, %8\n\tv_fmac_f32_e32 %0, %16, %1\n\tv_max_f32_e32 %1, 0, %9\n\tv_fmac_f32_e32 %0, %17, %1" \
        : "=&v"(s), "=&v"(tmp_) : "v"(P[B + 0]), "v"(P[B + 1]), "v"(P[B + 2]), "v"(P[B + 3]), "v"(P[B + 4]), "v"(P[B + 5]), "v"(P[B + 6]), "v"(P[B + 7]), \
          "v"(W[0]), "v"(W[1]), "v"(W[2]), "v"(W[3]), "v"(W[4]), "v"(W[5]), "v"(W[6]), "v"(W[7]))
__device__ __forceinline__ float unmono_f(unsigned u) { return __uint_as_float((u & 0x80000000u) ? (u ^ 0x80000000u) : ~u); }
struct DsaState { float tf0, tf1; int cnt0, cnt1; };
template <bool NOCOMPACT = false>
__device__ __forceinline__ void dsa_tile(const bf16x8 (&af)[4], const bf16x8 (&bc)[4], const float (&w0)[8], const float (&w1)[8], int key0, int q0t, int q1t, DsaState& st,
                                         LAS u32x2* ents, int lane) {
    const int r32 = lane & 31, hi = lane >> 5;
    f32x16 p;
#pragma unroll
    for (int r = 0; r < 16; ++r) p[r] = 0.f;
#pragma unroll
    for (int ks = 0; ks < 4; ++ks) p = __builtin_amdgcn_mfma_f32_32x32x16_bf16(af[ks], bc[ks], p, 0, 0, 0);
    asm volatile("s_nop 15\n\ts_nop 7" : "+v"(p));
    float s0, s1, tmp_;
    DSA_HEADSUM(s0, p, 0, w0); DSA_HEADSUM(s1, p, 8, w1);
    const int key = key0 + r32;
    const bool pr0 = (key <= q0t) && (s0 >= st.tf0), pr1 = (key <= q1t) && (s1 >= st.tf1);
    const unsigned long long m0 = __ballot(pr0), m1 = __ballot(pr1);
    if (m0 | m1) {
        const unsigned h0 = hi ? (unsigned)(m0 >> 32) : (unsigned)m0, h1 = hi ? (unsigned)(m1 >> 32) : (unsigned)m1;
        const unsigned lowmask = (1u << r32) - 1u;
        if (pr0) ents[hi * DS_CAP + st.cnt0 + __popc(h0 & lowmask)] = (u32x2){mono_key(s0), (unsigned)key};
        if (pr1) ents[(2 + hi) * DS_CAP + st.cnt1 + __popc(h1 & lowmask)] = (u32x2){mono_key(s1), (unsigned)key};
        st.cnt0 += __popc(h0); st.cnt1 += __popc(h1);
        const unsigned long long need = __ballot(max(st.cnt0, st.cnt1) > DS_CAP - 32);
        if (need) {
#pragma unroll 1
            for (int hh = 0; hh < 2; ++hh) {
                const int c0 = __builtin_amdgcn_readlane(st.cnt0, 0), c0b = __builtin_amdgcn_readlane(st.cnt0, 32);
                const int c1 = __builtin_amdgcn_readlane(st.cnt1, 0), c1b = __builtin_amdgcn_readlane(st.cnt1, 32);
                const int n0 = hh ? c0b : c0, n1 = hh ? c1b : c1;
                if (NOCOMPACT) { if (n0 > DS_CAP - 32 && hi == hh) st.cnt0 = 256; if (n1 > DS_CAP - 32 && hi == hh) st.cnt1 = 256; continue; }
                if (n0 > DS_CAP - 32) { int nk; const unsigned T = dsa_compact<false>(ents + hh * DS_CAP, n0, nk, lane); if (hi == hh) { st.tf0 = unmono_f(T + 1u); st.cnt0 = nk; } }
                if (n1 > DS_CAP - 32) { int nk; const unsigned T = dsa_compact<false>(ents + (2 + hh) * DS_CAP, n1, nk, lane); if (hi == hh) { st.tf1 = unmono_f(T + 1u); st.cnt1 = nk; } }
            }
        }
    }
}
template <bool NOCOMPACT = false>
__device__ __forceinline__ void dsa_select_phase(unsigned char* ws, LAS unsigned char* lds, int G, int tid, int wave, int lane) {
    const bf16* proj = (const bf16*)(ws + WS_BIG + B_PROJ); const bf16* IKc = (const bf16*)(ws + WS_BIG + B_IKC); const float* IW = (const float*)(ws + WS_IW);
    unsigned short* selg = (unsigned short*)(ws + WS_BIG + B_SEL);
    LAS u32x2* ents = (LAS u32x2*)lds + wave * 4 * DS_CAP;
    const int r32 = lane & 31, hi = lane >> 5;
    const int NWG = G * NWAVES, gw = (int)blockIdx.x * NWAVES + wave;
    for (int pu = gw; pu < 2048; pu += NWG) {
        for (int uu = 0; uu < 2; ++uu) {
            const int unit = uu ? 4095 - pu : pu, tw = unit * 4;
            bf16x8 af[4];
            { const int i = r32, qi = 2 * (i >> 4) + ((i >> 2) & 1), hd = 4 * ((i >> 3) & 1) + (i & 3);
              const bf16* ap = proj + (size_t)(tw + qi) * EVEN_NP + EC_IQ + hd * 64 + 8 * hi;
#pragma unroll
              for (int ks = 0; ks < 4; ++ks) af[ks] = *(const GAS bf16x8*)(ap + 16 * ks); }
            float w0[8], w1[8];
            { const f32x4 a = *(const GAS f32x4*)(IW + (size_t)(tw + hi) * 8), b = *(const GAS f32x4*)(IW + (size_t)(tw + hi) * 8 + 4);
              const f32x4 c = *(const GAS f32x4*)(IW + (size_t)(tw + 2 + hi) * 8), d = *(const GAS f32x4*)(IW + (size_t)(tw + 2 + hi) * 8 + 4);
#pragma unroll
              for (int j = 0; j < 4; ++j) { w0[j] = a[j]; w0[4 + j] = b[j]; w1[j] = c[j]; w1[4 + j] = d[j]; } }
            const int q0t = tw + hi, q1t = tw + 2 + hi;
            DsaState st; st.tf0 = -INFINITY; st.tf1 = -INFINITY; st.cnt0 = 0; st.cnt1 = 0;
            const int ntile = ((tw + 3) >> 5) + 1;
            const bf16* kp = IKc + (size_t)lane * 8; asm volatile("" : "+v"(kp));
            bf16x8 bA[4], bB[4];
#define DSA_LOADB(dst, jj) do { const bf16* p_ = kp + (size_t)(jj) * 2048; \
                asm volatile("global_load_dwordx4 %0, %4, off\n\tglobal_load_dwordx4 %1, %4, off offset:1024\n\tglobal_load_dwordx4 %2, %4, off offset:2048\n\tglobal_load_dwordx4 %3, %4, off offset:3072" \
                             : "=&v"(dst[0]), "=&v"(dst[1]), "=&v"(dst[2]), "=&v"(dst[3]) : "v"(p_) : "memory"); } while (0)
#define DSA_WAITB(dst, n) asm volatile("s_waitcnt vmcnt(" #n ")" : "+v"(dst[0]), "+v"(dst[1]), "+v"(dst[2]), "+v"(dst[3]) :: "memory")
            asm volatile("" : "+v"(af[0]), "+v"(af[1]), "+v"(af[2]), "+v"(af[3]));
#pragma unroll
            for (int r = 0; r < 8; ++r) asm volatile("" : "+v"(w0[r]), "+v"(w1[r]));
            DSA_LOADB(bA, 0);
#pragma unroll 1
            for (int j = 0; j < ntile; j += 2) {
                DSA_LOADB(bB, min(j + 1, ntile - 1));
                DSA_WAITB(bA, 4);
                dsa_tile<NOCOMPACT>(af, bA, w0, w1, 32 * j, q0t, q1t, st, ents, lane);
                DSA_LOADB(bA, min(j + 2, ntile - 1));
                DSA_WAITB(bB, 4);
                if (j + 1 < ntile) dsa_tile<NOCOMPACT>(af, bB, w0, w1, 32 * (j + 1), q0t, q1t, st, ents, lane);
            }
            DSA_WAITB(bA, 0);
#undef DSA_LOADB
#undef DSA_WAITB
            const int cnt0 = st.cnt0, cnt1 = st.cnt1;
#pragma unroll 1
            for (int qq = 0; qq < 4; ++qq) {
                const int hh = qq & 1, sl = qq >> 1;
                int n = sl ? __builtin_amdgcn_readlane(cnt1, 32 * hh) : __builtin_amdgcn_readlane(cnt0, 32 * hh);
                LAS u32x2* ee = ents + qq * DS_CAP;
                if (n > 256) { int nk = 256; if (!NOCOMPACT) (void)dsa_compact<true>(ee, n, nk, lane); n = 256; }
                unsigned short* row = selg + (size_t)(tw + qq) * 256;
#pragma unroll
                for (int e4 = 0; e4 < 4; ++e4) { const int e = lane + 64 * e4; row[e] = (e < n) ? (unsigned short)ee[e].y : (unsigned short)0xFFFFu; }
            }
        }
    }
}

typedef __bf16 bf16x2v __attribute__((ext_vector_type(2)));
__device__ __forceinline__ float dot2bf(unsigned a, unsigned b, float acc) { return __builtin_amdgcn_fdot2_f32_bf16(__builtin_bit_cast(bf16x2v, a), __builtin_bit_cast(bf16x2v, b), acc, false); }
__device__ __forceinline__ void dsa_sparse_phase(unsigned char* ws, int G, int wave, int lane, bf16* obase, size_t opitch) {
    const bf16* proj = (const bf16*)(ws + WS_BIG + B_PROJ); const unsigned short* selg = (const unsigned short*)(ws + WS_BIG + B_SEL);
    const int h = (int)blockIdx.x & 7, wg = (int)blockIdx.x >> 3, nwg = G >> 3;
    const int kg = lane >> 3, ds8 = (lane & 7) * 8;
    for (int t = wg * NWAVES + wave; t < S; t += nwg * NWAVES) {
        v4u iw[4];
#pragma unroll
        for (int c = 0; c < 4; ++c) iw[c] = *(const GAS v4u*)(selg + (size_t)t * 256 + 32 * kg + 8 * c);
        const v4u qw = *(const GAS v4u*)(proj + (size_t)t * EVEN_NP + EC_DQ + h * 64 + ds8);
        float sc[32];
#pragma unroll
        for (int i0 = 0; i0 < 32; i0 += 8) {
            v4u kw[8];
#pragma unroll
            for (int j = 0; j < 8; ++j) { const int i = i0 + j; const unsigned wd = (i & 1) ? (iw[i >> 3][(i >> 1) & 3] >> 16) : (iw[i >> 3][(i >> 1) & 3] & 0xffffu);
                const unsigned idx = (wd == 0xffffu) ? 0u : wd;
                kw[j] = *(const GAS v4u*)(proj + (size_t)idx * EVEN_NP + EC_DK + h * 64 + ds8); }
#pragma unroll
            for (int j = 0; j < 8; ++j) { const int i = i0 + j; const unsigned wd = (i & 1) ? (iw[i >> 3][(i >> 1) & 3] >> 16) : (iw[i >> 3][(i >> 1) & 3] & 0xffffu);
                float d = dot2bf(qw.x, kw[j].x, 0.f); d = dot2bf(qw.y, kw[j].y, d); d = dot2bf(qw.z, kw[j].z, d); d = dot2bf(qw.w, kw[j].w, d);
                d += shx<1>(d); d += shx<2>(d); d += shx<4>(d);
                sc[i] = (wd == 0xffffu) ? -INFINITY : d * C2; }
        }
        float mx = sc[0];
#pragma unroll
        for (int i = 1; i < 32; ++i) mx = fmaxf(mx, sc[i]);
        mx = fmaxf(mx, shx<8>(mx)); mx = fmaxf(mx, shx<16>(mx)); mx = sh32_max(mx);
        float l = 0.f;
#pragma unroll
        for (int i = 0; i < 32; ++i) { sc[i] = __builtin_amdgcn_exp2f(sc[i] - mx); l += sc[i]; }
        l += shx<8>(l); l += shx<16>(l); l = sh32_sum(l);
        float acc[8];
#pragma unroll
        for (int e = 0; e < 8; ++e) acc[e] = 0.f;
#pragma unroll
        for (int i0 = 0; i0 < 32; i0 += 8) {
            v4u vw[8];
#pragma unroll
            for (int j = 0; j < 8; ++j) { const int i = i0 + j; const unsigned wd = (i & 1) ? (iw[i >> 3][(i >> 1) & 3] >> 16) : (iw[i >> 3][(i >> 1) & 3] & 0xffffu);
                const unsigned idx = (wd == 0xffffu) ? 0u : wd;
                vw[j] = *(const GAS v4u*)(proj + (size_t)idx * EVEN_NP + EC_DV + h * 64 + ds8); }
#pragma unroll
            for (int j = 0; j < 8; j += 2) {
                const unsigned pp = cvtpk(sc[i0 + j], sc[i0 + j + 1]);
                const v4u a = vw[j], b = vw[j + 1];
                acc[0] = dot2bf(pp, __builtin_amdgcn_perm(b.x, a.x, 0x05040100u), acc[0]); acc[1] = dot2bf(pp, __builtin_amdgcn_perm(b.x, a.x, 0x07060302u), acc[1]);
                acc[2] = dot2bf(pp, __builtin_amdgcn_perm(b.y, a.y, 0x05040100u), acc[2]); acc[3] = dot2bf(pp, __builtin_amdgcn_perm(b.y, a.y, 0x07060302u), acc[3]);
                acc[4] = dot2bf(pp, __builtin_amdgcn_perm(b.z, a.z, 0x05040100u), acc[4]); acc[5] = dot2bf(pp, __builtin_amdgcn_perm(b.z, a.z, 0x07060302u), acc[5]);
                acc[6] = dot2bf(pp, __builtin_amdgcn_perm(b.w, a.w, 0x05040100u), acc[6]); acc[7] = dot2bf(pp, __builtin_amdgcn_perm(b.w, a.w, 0x07060302u), acc[7]);
            }
        }
        const float inv = 1.0f / l;
#pragma unroll
        for (int e = 0; e < 8; ++e) { float a = acc[e]; a += shx<8>(a); a += shx<16>(a); a = sh32_sum(a); acc[e] = a * inv; }
        if (kg == 0) *(GAS v4u*)(obase + (size_t)t * opitch + h * 64 + ds8) = pack8(acc);
    }
}

struct Args { InPtrs in; float* out; unsigned char* ws; int ph_lo, ph_hi, li, pad; };
constexpr int PH_PER_LAYER = 14, N_PHASES = 1 + 2 * PH_PER_LAYER - 1;

__global__ void __launch_bounds__(NTHREADS, 2) hyb_fwd(Args args) {
    extern __shared__ __attribute__((aligned(16))) unsigned char lds_raw[];
    LAS unsigned char* lds = (LAS unsigned char*)lds_raw;
    volatile LAS unsigned* MISC = (volatile LAS unsigned*)(lds + MISC_OFF);
    const int tid = threadIdx.x, lane = tid & 63, wave = __builtin_amdgcn_readfirstlane(tid >> 6);
    const int G = gridDim.x;
    const int vcu = (G % 8 == 0) ? ((int)blockIdx.x % 8) * (G / 8) + (int)blockIdx.x / 8 : (int)blockIdx.x;
    unsigned char* ws = args.ws;
    gu32* ctl = (gu32*)(ws + WS_CTL);
    for (int u = tid; u < (LDS_BYTES - LDSCTL_OFF) / 4; u += NTHREADS) ((LAS unsigned*)(lds + LDSCTL_OFF))[u] = 0u;
    __syncthreads();
    XcdBarrier bar = xcd_barrier_post((unsigned*)(ctl + CW_BAR) + args.li * XCD_BAR_WORDS, MISC + 8);
    const int tid0 = tid; unsigned char* const ws0 = ws;
    for (int ph = args.ph_lo; ph < args.ph_hi; ++ph) {
        int tid = tid0; asm volatile("" : "+v"(tid));
        unsigned char* ws = ws0; asm volatile("" : "+s"(ws));
        const int lane = tid & 63, wave = __builtin_amdgcn_readfirstlane(tid >> 6);
        LAS unsigned char* lds = (LAS unsigned char*)lds_raw; { unsigned lo_ = (unsigned)(uintptr_t)lds; asm volatile("" : "+s"(lo_)); lds = (LAS unsigned char*)(uintptr_t)lo_; }
        float* ssqA = (float*)(ws + WS_SSQ);
        bf16* HB = (bf16*)(ws + WS_HB);
        unsigned char* Wr = ws + WS_W;
        unsigned char* BIG = ws + WS_BIG;
        const int gw = vcu * NWAVES + wave, NGW = G * NWAVES;
        if (ph == 0) {
#ifdef PROBE_P02
            conv_weights(args.in, ws, 0, lds, gw, NGW, wave, lane);
            copy_x(args.in.p[0], args.out, HB, ssqA, gw, NGW, lane);
            rope_tables((float*)(ws + WS_ROPE), (float*)(ws + WS_ROPE) + S * 8, (int)blockIdx.x * NTHREADS + tid, G * NTHREADS);
            __syncthreads();
            for (int un = blockIdx.x; un < 128; un += G) mem_kv(args.in, ws, lds, un, tid, wave, lane);
            for (int idx = (int)blockIdx.x * NTHREADS + tid; idx < 1024 * 16; idx += G * NTHREADS) {
                const int k = idx >> 4, col = idx & 15;
                const float v = args.in.p[5][k] * args.in.p[6][(size_t)k * EVEN_SRC + (col < 8 ? ES_FL + col : ES_IW + col - 8)];
                const int ln = (k & 255) >> 2, e = k & 3, q = k >> 8, c = col >> 2;
                ((float*)(ws + WS_TW))[((((q * 4 + e) * 4 + c) * 64 + ln) << 2) + (col & 3)] = v; }
            __syncthreads();
#endif
#ifndef NO_P0
            conv_weights(args.in, ws, 0, lds, gw, NGW, wave, lane);
            copy_x(args.in.p[0], args.out, HB, ssqA, gw, NGW, lane);
            if (blockIdx.x == 0 && tid < 384) { const int gi = tid >> 6, d = tid & 63;
                float v;
                if (gi == 0) v = args.in.p[8][d]; else if (gi == 1) v = args.in.p[10][d]; else if (gi == 2) v = args.in.p[9][d]; else if (gi == 3) v = args.in.p[11][d]; else if (gi == 4) v = args.in.p[13][d]; else v = args.in.p[14][d];
                ((float*)(ws + WS_GT))[tid] = v; }
            rope_tables((float*)(ws + WS_ROPE), (float*)(ws + WS_ROPE) + S * 8, (int)blockIdx.x * NTHREADS + tid, G * NTHREADS);
            __syncthreads();
            for (int un = blockIdx.x; un < 128; un += G) mem_kv(args.in, ws, lds, un, tid, wave, lane);
            for (int idx = (int)blockIdx.x * NTHREADS + tid; idx < 1024 * 16; idx += G * NTHREADS) {
                const int k = idx >> 4, col = idx & 15;
                const float v = args.in.p[5][k] * args.in.p[6][(size_t)k * EVEN_SRC + (col < 8 ? ES_FL + col : ES_IW + col - 8)];
                const int ln = (k & 255) >> 2, e = k & 3, q = k >> 8, c = col >> 2;
                ((float*)(ws + WS_TW))[((((q * 4 + e) * 4 + c) * 64 + ln) << 2) + (col & 3)] = v; }
#endif
        } else {
            const int L = (ph - 1) / PH_PER_LAYER, sub = (ph - 1) % PH_PER_LAYER;
            const bool even = (L & 1) == 0;
            float* ssq_in = ssqA;
            if (sub == 0 || sub == 11) {
                pg8::Gemm g{(const pg8::bf16_t*)HB, (const pg8::bf16_t*)(Wr + (sub == 0 ? W_FFN1_IN : W_FFN2_IN)), S, FF2, DM, DM};
                pg8::StaticOrder So; So.init(S, FF2, G, (int)blockIdx.x);
                pg8::EpiSwiGLU E{(pg8::bf16_t*)(BIG + B_U), ssq_in, FF};
#ifdef PROBE_GEMM2
                pg8::gemm_phase<pg8::EpiSwiGLU, pg8::StaticOrder, true, true>(lds, g, So, E, tid); __syncthreads();
#endif
                pg8::gemm_phase<pg8::EpiSwiGLU, pg8::StaticOrder, true, true>(lds, g, So, E, tid);
            } else if (sub == 1 || sub == 7 || sub == 10 || sub == 12) {
                pg8::Gemm g; float scale; int so;
                if (sub == 1)       { g = pg8::Gemm{(const pg8::bf16_t*)(BIG + B_U), (const pg8::bf16_t*)(Wr + W_FFN1_OUT), S, DM, FF, FF}; scale = 0.5f; so = 1; }
                else if (sub == 7)  { g = pg8::Gemm{(const pg8::bf16_t*)(BIG + B_PROJ), (const pg8::bf16_t*)(Wr + W_MIX_OUT), S, DM, DM, even ? EVEN_NP : DM}; scale = 1.0f; so = 2; }
                else if (sub == 10)  { g = pg8::Gemm{(const pg8::bf16_t*)(BIG + B_OM), (const pg8::bf16_t*)(Wr + W_MEMO), S, DM, MEMW, MEMW}; scale = 1.0f; so = 3; }
                else                { g = pg8::Gemm{(const pg8::bf16_t*)(BIG + B_U), (const pg8::bf16_t*)(Wr + W_FFN2_OUT), S, DM, FF, FF}; scale = 0.5f; so = 4; }
                const bool last = (sub == 12 && L == NLAYER - 1);
                pg8::StaticOrder So; So.init(S, DM, G, (int)blockIdx.x);
                pg8::EpiResid E{args.out, last ? nullptr : (pg8::bf16_t*)HB, last ? nullptr : ssqA, scale};
                pg8::gemm_phase<pg8::EpiResid, pg8::StaticOrder, true, true>(lds, g, So, E, tid);
#ifdef PROBE_GEMM2
                { __syncthreads(); pg8::EpiResid E0 = E; E0.scale = 0.f; pg8::gemm_phase<pg8::EpiResid, pg8::StaticOrder, true, true>(lds, g, So, E0, tid); }
#endif
            } else if (sub == 2) {
                const int N = even ? EVEN_NP : ODD_N;
                pg8::Gemm g{(const pg8::bf16_t*)HB, (const pg8::bf16_t*)(Wr + W_MIX_IN), S, N, DM, DM};
                pg8::EpiProj E;
                E.O = (pg8::bf16_t*)(BIG + B_PROJ); E.ldc = even ? EVEN_NP : DM; E.ssq = ssq_in; E.split_cols = even ? 0 : DM; E.split_stride = (size_t)S * DM; E.even = even ? 1 : 0;
                E.gtab = (const float*)(ws + WS_GT);
                E.cosT = (const float*)(ws + WS_ROPE); E.sinT = E.cosT + S * 8;
                E.Vt = (pg8::bf16_t*)(BIG + (even ? B_VTF : B_VTM)); E.IKf = (pg8::bf16_t*)(BIG + B_IKC);
                E.xch = (LAS float*)(lds + 131072);
                pg8::StaticOrder So; So.init(S, N, G, (int)blockIdx.x);
                pg8::gemm_phase<pg8::EpiProj, pg8::StaticOrder, true, true>(lds, g, So, E, tid);
            } else if (sub == 8) {
                pg8::Gemm g{(const pg8::bf16_t*)HB, (const pg8::bf16_t*)(Wr + W_MEMQ), S, MEMW, DM, DM};
                pg8::EpiScale E{(pg8::bf16_t*)(BIG + B_QM), MEMW, ssq_in, 0, 0};
                pg8::StaticOrder So; So.init(S, g.N, G, (int)blockIdx.x);
#ifdef PROBE_GEMM2
                pg8::gemm_phase<pg8::EpiScale, pg8::StaticOrder, true, true>(lds, g, So, E, tid); __syncthreads();
#endif
                pg8::gemm_phase<pg8::EpiScale, pg8::StaticOrder, true, true>(lds, g, So, E, tid);
            } else if (sub == 3) {
                if (even) post_even(args.in, ws, args.out, ssq_in, lds, G, tid, wave, lane);
                else post_odd(ws, lds, G, tid);
            } else if (sub == 4) {
                if (even) {
                    int nrep = 1;
#ifdef PROBE_DSA2
                    nrep = 2;
#endif
                    asm volatile("" : "+s"(nrep));
#ifdef PROBE_SELNC
                    dsa_select_phase<true>(ws, lds, G, tid, wave, lane); __syncthreads();
#endif
                    for (int rep = 0; rep < nrep; ++rep) { dsa_select_phase<false>(ws, lds, G, tid, wave, lane); __syncthreads(); }
                } else {
                    moba_gate_phase(ws, G, wave, lane);
                }
            } else if (sub == 5) {
                if (even) {
                    bf16* projb = (bf16*)(BIG + B_PROJ);
#ifdef PROBE_FOX2
                    fox_phase(args.in, ws, lds, G, tid, wave, lane, HB, 512, CW_FOXQ + 64); __syncthreads();
#endif
#ifdef PROBE_SPARSE2
                    dsa_sparse_phase(ws, G, wave, lane, HB, 512);
#endif
                    fox_phase(args.in, ws, lds, G, tid, wave, lane, projb + EC_FQ, EVEN_NP, CW_FOXQ);
                    dsa_sparse_phase(ws, G, wave, lane, projb + EC_DQ, EVEN_NP);
                } else {
#ifdef PROBE_MOBA2
                    moba_route_phase(ws, lds, G, tid, wave, lane, CW_MOBAQ + 64); __syncthreads();
#endif
                    moba_route_phase(ws, lds, G, tid, wave, lane, CW_MOBAQ);
                }
            } else if (sub == 6) {
                if (!even) moba_own_phase(ws, lds, G, tid, wave, lane);
            } else if (sub == 9) {
#ifdef PROBE_MEM2
                memattn_phase(args.in, ws, L, lds, G, tid, wave, lane); __syncthreads();
#endif
                memattn_phase(args.in, ws, L, lds, G, tid, wave, lane);
            } else if (sub == 13) {
#ifdef PROBE_P02
                conv_weights(args.in, ws, L + 1, lds, gw, NGW, wave, lane); __syncthreads();
#endif
                conv_weights(args.in, ws, L + 1, lds, gw, NGW, wave, lane);
            }
        }
        if (ph + 1 < args.ph_hi) xcd_barrier(bar);
#ifdef PROBE_BAR2
        if (ph + 1 < args.ph_hi) xcd_barrier(bar);
#endif
    }
}

#ifndef MK_N_LAUNCHES
#define MK_N_LAUNCHES 1
#endif
extern "C" void kernel_launch(void* const* d_in, const int* in_sizes, int n_in, void* d_out, int out_size, void* d_ws, size_t ws_size, hipStream_t stream) {
    static int grid = 0;
    if (grid == 0) {
        if (n_in != 26 || in_sizes[0] != S * DM || out_size != S * DM || ws_size < WS_END) {
            fprintf(stderr, "kernel_launch: unexpected problem (n_in %d, in0 %d, out %d, ws %zu); nothing launched\n", n_in, n_in > 0 ? in_sizes[0] : -1, out_size, ws_size); grid = -1; return; }
        int dev = 0, cus = 0, per_cu = 0;
        if (hipGetDevice(&dev) != hipSuccess || hipDeviceGetAttribute(&cus, hipDeviceAttributeMultiprocessorCount, dev) != hipSuccess) { grid = -1; return; }
        if (hipFuncSetAttribute((const void*)hyb_fwd, hipFuncAttributeMaxDynamicSharedMemorySize, LDS_BYTES) != hipSuccess) { fprintf(stderr, "kernel_launch: hipFuncSetAttribute failed\n"); grid = -1; return; }
        if (hipOccupancyMaxActiveBlocksPerMultiprocessor(&per_cu, (const void*)hyb_fwd, NTHREADS, LDS_BYTES) != hipSuccess || per_cu < 1)
            fprintf(stderr, "kernel_launch: note: occupancy query reports %d workgroups per CU\n", per_cu);
        (void)hipGetLastError();
        grid = cus;
    }
    if (grid < 0) return;
    if (hipMemsetAsync((char*)d_ws + WS_CTL, 0, CTL_ZERO_BYTES, stream) != hipSuccess) { fprintf(stderr, "kernel_launch: hipMemsetAsync failed\n"); return; }
    Args a{};
    for (int i = 0; i < 26; ++i) a.in.p[i] = (const float*)d_in[i];
    a.out = (float*)d_out; a.ws = (unsigned char*)d_ws;
#if MK_N_LAUNCHES == 1
    a.ph_lo = 0; a.ph_hi = N_PHASES; a.li = 0;
    hipLaunchKernelGGL(hyb_fwd, dim3(grid), dim3(NTHREADS), LDS_BYTES, stream, a);
#else
    for (int ph = 0; ph < N_PHASES; ++ph) { a.ph_lo = ph; a.ph_hi = ph + 1; a.li = 0; hipLaunchKernelGGL(hyb_fwd, dim3(grid), dim3(NTHREADS), LDS_BYTES, stream, a); }
#endif
    const hipError_t le = hipPeekAtLastError();
    if (le != hipSuccess) fprintf(stderr, "kernel_launch: launch failed: %s\n", hipGetErrorName(le));
}
```

```cpp
#include <hip/hip_runtime.h>
#include <cstdio>
#include <cstdint>

template <int M> __device__ __forceinline__ int shx_i(int v) {
    if constexpr (M == 1) return __builtin_amdgcn_mov_dpp(v, 0xB1, 0xF, 0xF, true);
    else if constexpr (M == 2) return __builtin_amdgcn_mov_dpp(v, 0x4E, 0xF, 0xF, true);
    else return __builtin_amdgcn_ds_swizzle(v, (M << 10) | 0x1f);
}
template <int M> __device__ __forceinline__ float shx(float v) { return __int_as_float(shx_i<M>(__float_as_int(v))); }
__device__ __forceinline__ float sh32_sum(float v) { auto r = __builtin_amdgcn_permlane32_swap(__float_as_uint(v), __float_as_uint(v), false, false); return __uint_as_float(r[0]) + __uint_as_float(r[1]); }
__device__ __forceinline__ float sh32_max(float v) { auto r = __builtin_amdgcn_permlane32_swap(__float_as_uint(v), __float_as_uint(v), false, false); return fmaxf(__uint_as_float(r[0]), __uint_as_float(r[1])); }
__device__ __forceinline__ int sum32_i(int c) { c += shx_i<1>(c); c += shx_i<2>(c); c += shx_i<4>(c); c += shx_i<8>(c); c += shx_i<16>(c); return c; }
namespace pg8 {
#define PG8_LAS __attribute__((address_space(3)))
typedef unsigned short bf16_t;
typedef short bf16x8 __attribute__((ext_vector_type(8)));
typedef float f32x4 __attribute__((ext_vector_type(4)));
typedef unsigned u32x4 __attribute__((ext_vector_type(4)));
constexpr int BM = 256, BK = 64, HALF = 128, HTB = HALF * BK * 2  , STAGE_BYTES = 8 * HTB, NXCD = 8, WGM = 8;

__host__ __device__ __forceinline__ int lds_byte(int r, int c) { const int st = (r >> 4) * 2 + (c >> 5), rr = r & 15, cc = c & 31, ob = rr * 64 + cc * 2; return st * 1024 + (ob ^ (((ob >> 9) & 1) << 5)); }
__host__ __device__ __forceinline__ void stage_rc(int b, int& R, int& C) { const int st = b / 1024, sb = b % 1024, swz = sb ^ (((sb >> 9) & 1) << 5); R = (st >> 1) * 16 + swz / 64; C = (st & 1) * 32 + (swz % 64) / 2; }
__host__ __device__ __forceinline__ int perm32(int rho) { const int n = rho >> 4, i = rho & 15; return 8 * (i >> 2) + 4 * n + (i & 3); }

struct Unit { int pm, pn; };
struct Gemm { const bf16_t* A; const bf16_t* Bt; int M, N, K, lda; };

struct StaticOrder {
    int nM, nN, nwg, G, c;
    __host__ __device__ __forceinline__ void init(int M, int N, int G_, int c_) { nM = M / BM; nN = N / BM; nwg = nM * nN; G = G_; c = c_; }
    __host__ __device__ __forceinline__ bool next(int i, Unit& u) const {
        const long L = (long)i * G + c; if (L >= nwg) return false;
        int wgid = (int)L; { const int q = nwg / NXCD, r = nwg % NXCD, xcd = wgid % NXCD, off = wgid / NXCD; wgid = (xcd < r ? xcd * (q + 1) : r * (q + 1) + (xcd - r) * q) + off; }
        const int nig = WGM * nN, gid = wgid / nig, fm = gid * WGM, gsz = (nM - fm) < WGM ? (nM - fm) : WGM;
        u.pm = fm + ((wgid % nig) % gsz); u.pn = (wgid % nig) / gsz; return true;
    }
    __device__ __forceinline__ void a_ready(const Unit&) const {}
    __device__ __forceinline__ void done(const Unit&) const {}
};

__device__ __forceinline__ unsigned cvt_pk_bf16(float lo, float hi) { unsigned r; asm volatile("v_cvt_pk_bf16_f32 %0, %1, %2" : "=v"(r) : "v"(lo), "v"(hi)); return r; }
typedef float f32x2 __attribute__((ext_vector_type(2)));
constexpr float RMS_EPS_F = 1e-6f;
__device__ __forceinline__ float silu_f(float x) { return x * __builtin_amdgcn_rcpf(1.0f + __builtin_amdgcn_exp2f(-1.4426950408889634f * x)); }
__device__ __forceinline__ float row_rstd(const float* ssq, int row) {
    const f32x4* p = (const f32x4*)(ssq + (size_t)row * 16); const f32x4 a = p[0], b = p[1], c = p[2], d = p[3];
    const float s = ((a[0] + a[1]) + (a[2] + a[3])) + ((b[0] + b[1]) + (b[2] + b[3])) + ((c[0] + c[1]) + (c[2] + c[3])) + ((d[0] + d[1]) + (d[2] + d[3]));
    return rsqrtf(s * (1.0f / 1024.0f) + RMS_EPS_F); }

struct EpiSwiGLU {
    static constexpr bool PERM = true, AFTER_DRAIN = false;
    bf16_t* U; const float* ssq; int ldu;
    __device__ __forceinline__ void operator()(const f32x4 (&acc)[2][2][4][2], const Unit& u, int wr, int wc, int fr, int fq) const {
        const int row0 = u.pm * BM + wr * 64 + fr, col0 = u.pn * HALF + wc * 32 + 8 * fq;
#pragma unroll
        for (int ai = 0; ai < 2; ++ai)
#pragma unroll
            for (int m = 0; m < 4; ++m) {
                const int row = row0 + ai * HALF + m * 16; const float r = row_rstd(ssq, row);
                const f32x4 a0 = acc[ai][0][m][0] * r, a1 = acc[ai][0][m][1] * r, b0 = acc[ai][1][m][0] * r, b1 = acc[ai][1][m][1] * r;
                u32x4 w;
                w.x = cvt_pk_bf16(silu_f(a0[0]) * b0[0], silu_f(a0[1]) * b0[1]); w.y = cvt_pk_bf16(silu_f(a0[2]) * b0[2], silu_f(a0[3]) * b0[3]);
                w.z = cvt_pk_bf16(silu_f(a1[0]) * b1[0], silu_f(a1[1]) * b1[1]); w.w = cvt_pk_bf16(silu_f(a1[2]) * b1[2], silu_f(a1[3]) * b1[3]);
                *(u32x4*)(U + (size_t)row * ldu + col0) = w;
            }
    }
};
struct EpiResid {
    static constexpr bool PERM = true, AFTER_DRAIN = false;
    float* H; bf16_t* HB; float* ssq_out; float scale;
    __device__ __forceinline__ void operator()(const f32x4 (&acc)[2][2][4][2], const Unit& u, int wr, int wc, int fr, int fq) const {
        const int row0 = u.pm * BM + wr * 64 + fr, col0 = u.pn * BM + wc * 32 + 8 * fq;
#pragma unroll
        for (int ai = 0; ai < 2; ++ai)
#pragma unroll
            for (int m = 0; m < 4; ++m) {
                const int row = row0 + ai * HALF + m * 16; float sq = 0.f;
#pragma unroll
                for (int bj = 0; bj < 2; ++bj) {
                    float* hp = H + (size_t)row * 1024 + col0 + bj * HALF;
                    f32x4 h0 = *(const f32x4*)hp, h1 = *(const f32x4*)(hp + 4);
                    h0 = h0 + acc[ai][bj][m][0] * scale; h1 = h1 + acc[ai][bj][m][1] * scale;
                    *(f32x4*)hp = h0; *(f32x4*)(hp + 4) = h1;
                    sq += (h0[0] * h0[0] + h0[1] * h0[1]) + (h0[2] * h0[2] + h0[3] * h0[3]) + (h1[0] * h1[0] + h1[1] * h1[1]) + (h1[2] * h1[2] + h1[3] * h1[3]);
                    if (HB) { u32x4 w; w.x = cvt_pk_bf16(h0[0], h0[1]); w.y = cvt_pk_bf16(h0[2], h0[3]); w.z = cvt_pk_bf16(h1[0], h1[1]); w.w = cvt_pk_bf16(h1[2], h1[3]);
                        *(u32x4*)(HB + (size_t)row * 1024 + col0 + bj * HALF) = w; }
                }
                if (ssq_out) { sq += shx<16>(sq); sq = sh32_sum(sq); if (fq == 0) ssq_out[(size_t)row * 16 + u.pn * 4 + wc] = sq; }
            }
    }
};
struct EpiScale {
    static constexpr bool PERM = true, AFTER_DRAIN = false;
    bf16_t* O; int ldc; const float* ssq; int split_cols; size_t split_stride;
    __device__ __forceinline__ void operator()(const f32x4 (&acc)[2][2][4][2], const Unit& u, int wr, int wc, int fr, int fq) const {
        const int row0 = u.pm * BM + wr * 64 + fr; int colt = u.pn * BM; bf16_t* base = O;
        if (split_cols) { const int t = colt / split_cols; base += (size_t)t * split_stride; colt -= t * split_cols; }
        const int col0 = colt + wc * 32 + 8 * fq;
#pragma unroll
        for (int ai = 0; ai < 2; ++ai)
#pragma unroll
            for (int m = 0; m < 4; ++m) {
                const int row = row0 + ai * HALF + m * 16; const float r = row_rstd(ssq, row);
                bf16_t* rowp = base + (size_t)row * ldc + col0;
#pragma unroll
                for (int bj = 0; bj < 2; ++bj) { const f32x4 v0 = acc[ai][bj][m][0] * r, v1 = acc[ai][bj][m][1] * r;
                    u32x4 w; w.x = cvt_pk_bf16(v0[0], v0[1]); w.y = cvt_pk_bf16(v0[2], v0[3]); w.z = cvt_pk_bf16(v1[0], v1[1]); w.w = cvt_pk_bf16(v1[2], v1[3]);
                    *(u32x4*)(rowp + bj * HALF) = w; }
            }
    }
};

enum { KIND_PLAIN = 0, KIND_NORM = 1, KIND_NORM_ROPE = 2, KIND_ROPE = 3, KIND_VT = 4, KIND_NORM_ROPE_KSUM = 5, KIND_IK = 6, KIND_SKIP = 7 };
struct EpiProj {
    static constexpr bool PERM = true, AFTER_DRAIN = false;
    bf16_t* O; int ldc; const float* ssq; int split_cols; size_t split_stride;
    int even;
    const float* gtab;
    const float* cosT; const float* sinT;
    bf16_t* Vt;
    bf16_t* IKf;
    PG8_LAS float* xch;
    __device__ __forceinline__ void operator()(const f32x4 (&acc)[2][2][4][2], const Unit& u, int wr, int wc, int fr, int fq) const {
        const int S_ = 16384;
        int kind; int gsel = 0; int vcol0 = 0;
        if (even) { const int p = u.pn;
            kind = (p < 2) ? KIND_NORM : (p < 4) ? KIND_NORM_ROPE : (p < 6) ? KIND_NORM : (p < 8) ? KIND_NORM_ROPE : (p < 10) ? KIND_VT : (p < 12) ? KIND_PLAIN : (p < 14) ? KIND_ROPE : KIND_IK;
            gsel = (p < 8) ? (p >> 1) : 0; vcol0 = (p - 8) * 256;
        } else { const int p = u.pn; kind = (p < 8) ? KIND_NORM_ROPE : KIND_VT; gsel = (p < 8) ? 4 + (p >> 2) : 0; vcol0 = (p - 8) * 256; }
        const float* gn = gtab + gsel * 64;
        const int row0 = u.pm * BM + wr * 64 + fr; int colt = u.pn * BM; bf16_t* base = O;
        if (split_cols) { const int t = colt / split_cols; base += (size_t)t * split_stride; colt -= t * split_cols; }
        const int co0 = wc * 32 + 8 * fq;
        const int hd0 = 32 * (wc & 1) + 8 * fq;
        int xo = ((wr * 64 + fr) * 2) * 4 + wc, xp = ((wr * 64 + fr) * 2) * 4 + (wc ^ 1);
        asm volatile("" : "+v"(xo), "+v"(xp));
        const bool normk = (kind == KIND_NORM || kind == KIND_NORM_ROPE || kind == KIND_NORM_ROPE_KSUM);
        const bool ropek = (kind == KIND_NORM_ROPE || kind == KIND_ROPE || kind == KIND_NORM_ROPE_KSUM || kind == KIND_IK);
        float gv[8];
#pragma unroll
        for (int e2 = 0; e2 < 8; ++e2) gv[e2] = normk ? gn[hd0 + e2] : 1.0f;
        if (normk) {
#pragma unroll
            for (int ai = 0; ai < 2; ++ai)
#pragma unroll
                for (int m = 0; m < 4; ++m)
#pragma unroll
                    for (int bj = 0; bj < 2; ++bj) { const f32x4 v0 = acc[ai][bj][m][0], v1 = acc[ai][bj][m][1];
                        float ss = (v0[0] * v0[0] + v0[1] * v0[1]) + (v0[2] * v0[2] + v0[3] * v0[3]) + (v1[0] * v1[0] + v1[1] * v1[1]) + (v1[2] * v1[2] + v1[3] * v1[3]);
                        ss += shx<16>(ss); ss = sh32_sum(ss);
                        if (fq == 0) xch[xo + (ai * 128 + m * 16) * 8 + bj * 4] = ss; }
            asm volatile("s_waitcnt lgkmcnt(0)" ::: "memory"); __builtin_amdgcn_s_barrier(); asm volatile("" ::: "memory");
        }
        if (kind != KIND_SKIP) {
#pragma unroll
        for (int ai = 0; ai < 2; ++ai)
#pragma unroll
            for (int m = 0; m < 4; ++m) {
                const int row = row0 + ai * HALF + m * 16; const float r = row_rstd(ssq, row);
                float cs[8], sn[8];
                if (ropek) { const f32x4 c0 = *(const f32x4*)(cosT + (unsigned)(row * 8)), c1 = *(const f32x4*)(cosT + (unsigned)(row * 8 + 4)), s0 = *(const f32x4*)(sinT + (unsigned)(row * 8)), s1 = *(const f32x4*)(sinT + (unsigned)(row * 8 + 4));
#pragma unroll
                    for (int e2 = 0; e2 < 4; ++e2) { cs[e2] = c0[e2]; cs[4 + e2] = c1[e2]; sn[e2] = s0[e2]; sn[4 + e2] = s1[e2]; } }
#pragma unroll
                for (int bj = 0; bj < 2; ++bj) {
                    if (kind == KIND_IK && (bj == 1 || wc >= 2)) continue;
                    float x[8];
                    { const f32x4 v0 = acc[ai][bj][m][0], v1 = acc[ai][bj][m][1];
#pragma unroll
                      for (int e2 = 0; e2 < 4; ++e2) { x[e2] = v0[e2]; x[4 + e2] = v1[e2]; } }
                    float sc = r;
                    if (normk) { const float tot = xch[xo + (ai * 128 + m * 16) * 8 + bj * 4] + xch[xp + (ai * 128 + m * 16) * 8 + bj * 4];
                        sc = r * rsqrtf(tot * (r * r) * (1.0f / 64.0f) + RMS_EPS_F); }
#pragma unroll
                    for (int e2 = 0; e2 < 8; ++e2) x[e2] = x[e2] * sc * gv[e2];
                    if (ropek) {
#pragma unroll
                        for (int e2 = 0; e2 < 8; ++e2) { const float other = shx<16>(x[e2]);
                            if ((wc & 1) == 0 && fq == 0) x[e2] = x[e2] * cs[e2] - other * sn[e2];
                            else if ((wc & 1) == 0 && fq == 1) x[e2] = x[e2] * cs[e2] + other * sn[e2]; }
                    }
                    if (kind == KIND_VT) {
                        bf16_t* vp = Vt + (unsigned)((vcol0 + bj * HALF + co0) * S_ + (row & ~1));
#pragma unroll
                        for (int e2 = 0; e2 < 8; ++e2) { const float other = shx<1>(x[e2]);
                            const unsigned w = (fr & 1) ? cvt_pk_bf16(other, x[e2]) : cvt_pk_bf16(x[e2], other);
                            if (((e2 >> 2) & 1) == (fr & 1)) *(unsigned*)(vp + (unsigned)(e2 * S_)) = w; }
                    } else if (kind == KIND_IK) {
                        const int c8 = 4 * wc + fq;
                        u32x4 w; w.x = cvt_pk_bf16(x[0], x[1]); w.y = cvt_pk_bf16(x[2], x[3]); w.z = cvt_pk_bf16(x[4], x[5]); w.w = cvt_pk_bf16(x[6], x[7]);
                        *(u32x4*)(IKf + (unsigned)((((row >> 5) * 4 + (c8 >> 1)) * 64 + (c8 & 1) * 32 + (row & 31)) * 8)) = w;
                    } else {
                        u32x4 w; w.x = cvt_pk_bf16(x[0], x[1]); w.y = cvt_pk_bf16(x[2], x[3]); w.z = cvt_pk_bf16(x[4], x[5]); w.w = cvt_pk_bf16(x[6], x[7]);
                        *(u32x4*)(base + (unsigned)(row * ldc + colt + bj * HALF + co0)) = w;
                    }
                }
            }
        }
        if (normk) { asm volatile("s_waitcnt lgkmcnt(0)" ::: "memory"); __builtin_amdgcn_s_barrier(); asm volatile("" ::: "memory"); }
    }
};

struct EpiPartial {
    static constexpr bool PERM = true, AFTER_DRAIN = false;
    float* P; int M;
    __device__ __forceinline__ void operator()(const f32x4 (&acc)[2][2][4][2], const Unit& u, int wr, int wc, int fr, int fq) const {
        const int row0 = u.pm * BM + wr * 64 + fr; float* base = P + (size_t)u.pn * M * 256 + wc * 32 + 8 * fq;
#pragma unroll
        for (int ai = 0; ai < 2; ++ai)
#pragma unroll
            for (int m = 0; m < 4; ++m) { float* rp = base + (unsigned)((row0 + ai * HALF + m * 16) * 256);
#pragma unroll
                for (int bj = 0; bj < 2; ++bj) { *(f32x4*)(rp + bj * HALF) = acc[ai][bj][m][0]; *(f32x4*)(rp + bj * HALF + 4) = acc[ai][bj][m][1]; } }
    }
};
template <class Epi, class Sched, bool ALIGN_EPI = false, bool SP2 = false, int KSPLIT = 0, int LDB = 0>
__device__ __forceinline__ void gemm_phase(PG8_LAS unsigned char* lds, const Gemm g, const Sched& S, const Epi& E, const int tid) {
    const int wid = __builtin_amdgcn_readfirstlane(tid >> 6), lane = tid & 63, wr = wid >> 2, wc = wid & 3, fr = lane & 15, fq = lane >> 4;
    const int K = g.K, nt = K / BK;
    unsigned voffA[2], voffB[2];
#pragma unroll
    for (int i = 0; i < 2; ++i) { int R, C; stage_rc(tid * 16 + i * 8192, R, C); const int Rb = Epi::PERM ? ((R & ~31) + perm32(R & 31)) : R;
        voffA[i] = (unsigned)(R * g.lda + C) * 2u; voffB[i] = (unsigned)(Rb * (LDB ? LDB : K) + C) * 2u; }
    const size_t kstep = (size_t)(BK * 2);
    const size_t hstepA = (size_t)HALF * g.lda * 2, hstepB = (size_t)HALF * (LDB ? LDB : K) * 2;
    const size_t tstepA = 2 * hstepA, tstepB = 2 * hstepB;
    const unsigned ldsw = (unsigned)wid * 1024u;
    const int aoff = lds_byte(wr * 64 + fr, fq * 8), boff = lds_byte(wc * 32 + fr, fq * 8);
#define PG8_SA(b, h) (((b) * 2 + (h)) * HTB)
#define PG8_SB(b, h) ((4 + (b) * 2 + (h)) * HTB)
#define PG8_STAGE(bufoff, gbase, voff) do { _Pragma("unroll") for (int _i = 0; _i < 2; ++_i) \
        __builtin_amdgcn_global_load_lds((const unsigned*)((const char*)(gbase) + (voff)[_i]), (PG8_LAS unsigned*)(lds + (bufoff) + ldsw + _i * 8192), 16, 0, 0); } while (0)
#define PG8_LDA(dst, b, h) do { _Pragma("unroll") for (int m = 0; m < 4; ++m) _Pragma("unroll") for (int k = 0; k < 2; ++k) dst[m][k] = *(const PG8_LAS bf16x8*)(lds + PG8_SA(b, h) + aoff + m * 2048 + k * 1024); } while (0)
#define PG8_LDB(dst, b, h) do { _Pragma("unroll") for (int n = 0; n < 2; ++n) _Pragma("unroll") for (int k = 0; k < 2; ++k) dst[n][k] = *(const PG8_LAS bf16x8*)(lds + PG8_SB(b, h) + boff + n * 2048 + k * 1024); } while (0)
#define PG8_MMA(ai, bj, At, Bt) do { __builtin_amdgcn_s_setprio(1); _Pragma("unroll") for (int m = 0; m < 4; ++m) _Pragma("unroll") for (int n = 0; n < 2; ++n) _Pragma("unroll") for (int k = 0; k < 2; ++k) \
        acc[ai][bj][m][n] = __builtin_amdgcn_mfma_f32_16x16x32_bf16(Bt[n][k], At[m][k], acc[ai][bj][m][n], 0, 0, 0); __builtin_amdgcn_s_setprio(0); } while (0)
#define PG8_WAIT_V(n) asm volatile("s_waitcnt vmcnt(" #n ")" ::: "memory")
#define PG8_WAIT_L(n) asm volatile("s_waitcnt lgkmcnt(" #n ")" ::: "memory")
#define PG8_BAR __builtin_amdgcn_s_barrier()
#define PG8_SCHED __builtin_amdgcn_sched_barrier(0)
    Unit cur, nxt; int ui = 0;
    if (!S.next(0, cur)) return;
    f32x4 acc[2][2][4][2];
#pragma unroll
    for (int a = 0; a < 2; ++a)
#pragma unroll
        for (int b = 0; b < 2; ++b)
#pragma unroll
            for (int m = 0; m < 4; ++m)
#pragma unroll
                for (int n = 0; n < 2; ++n) acc[a][b][m][n] = (f32x4){0.f, 0.f, 0.f, 0.f};
    bf16x8 At[4][2], B0[2][2], B1[2][2];
    const char* cA = (const char*)g.A + (size_t)cur.pm * tstepA + (KSPLIT ? (size_t)cur.pn * KSPLIT : (size_t)0); const char* cB = (const char*)g.Bt + (KSPLIT ? (size_t)cur.pn * KSPLIT : (size_t)cur.pn * tstepB);
    S.a_ready(cur);
    if constexpr (SP2) {
        PG8_STAGE(PG8_SB(0, 0), cB, voffB); PG8_STAGE(PG8_SB(0, 1), cB + hstepB, voffB); PG8_STAGE(PG8_SA(0, 0), cA, voffA); PG8_STAGE(PG8_SA(0, 1), cA + hstepA, voffA);
        if (wr == 1) PG8_BAR;
        PG8_WAIT_V(2); PG8_BAR;
        PG8_STAGE(PG8_SB(1, 0), cB + kstep, voffB); PG8_STAGE(PG8_SA(1, 0), cA + kstep, voffA); PG8_STAGE(PG8_SB(1, 1), cB + hstepB + kstep, voffB);
        PG8_WAIT_V(6); PG8_BAR;
    } else {
        PG8_STAGE(PG8_SB(0, 0), cB, voffB); PG8_STAGE(PG8_SA(0, 0), cA, voffA); PG8_STAGE(PG8_SB(0, 1), cB + hstepB, voffB); PG8_STAGE(PG8_SA(0, 1), cA + hstepA, voffA);
        if (wr == 1) PG8_BAR;
        PG8_WAIT_V(4); PG8_BAR;
        PG8_STAGE(PG8_SB(1, 0), cB + kstep, voffB); PG8_STAGE(PG8_SA(1, 0), cA + kstep, voffA); PG8_STAGE(PG8_SB(1, 1), cB + hstepB + kstep, voffB);
        PG8_WAIT_V(6); PG8_BAR;
    }
    for (;;) {
        const bool has_next = S.next(ui + 1, nxt);
        const char* nA = has_next ? (const char*)g.A + (size_t)nxt.pm * tstepA + (KSPLIT ? (size_t)nxt.pn * KSPLIT : (size_t)0) : cA; const char* nB = has_next ? (const char*)g.Bt + (KSPLIT ? (size_t)nxt.pn * KSPLIT : (size_t)nxt.pn * tstepB) : cB;
        for (int t = 0; t < nt; t += 2) {
            const bool last = (t == nt - 2);
            const char* a1 = cA + (size_t)(t + 1) * kstep;
            const char* a2 = last ? nA : cA + (size_t)(t + 2) * kstep; const char* b2 = last ? nB : cB + (size_t)(t + 2) * kstep;
            const char* a3 = a2 + kstep; const char* b3 = b2 + kstep;
            if (last && has_next) S.a_ready(nxt);
            if constexpr (SP2) {
            PG8_LDB(B0, 0, 0); PG8_LDB(B1, 0, 1); PG8_SCHED; PG8_LDA(At, 0, 0); PG8_STAGE(PG8_SA(1, 1), a1 + hstepA, voffA);
            PG8_WAIT_V(8); PG8_WAIT_L(0); PG8_BAR; PG8_MMA(0, 0, At, B0); PG8_MMA(0, 1, At, B1); PG8_BAR; PG8_SCHED;
            PG8_LDA(At, 0, 1); PG8_STAGE(PG8_SB(0, 0), b2, voffB); PG8_STAGE(PG8_SB(0, 1), b2 + hstepB, voffB); PG8_STAGE(PG8_SA(0, 0), a2, voffA);
            PG8_WAIT_V(8); PG8_WAIT_L(0); PG8_BAR; PG8_MMA(1, 0, At, B0); PG8_MMA(1, 1, At, B1); PG8_BAR; PG8_SCHED;
            PG8_LDB(B0, 1, 0); PG8_LDB(B1, 1, 1); PG8_SCHED; PG8_LDA(At, 1, 0); PG8_STAGE(PG8_SA(0, 1), a2 + hstepA, voffA);
            PG8_WAIT_V(8); PG8_WAIT_L(0); PG8_BAR; PG8_MMA(0, 0, At, B0); PG8_MMA(0, 1, At, B1); PG8_BAR; PG8_SCHED;
            PG8_LDA(At, 1, 1); PG8_STAGE(PG8_SB(1, 0), b3, voffB); PG8_STAGE(PG8_SB(1, 1), b3 + hstepB, voffB); PG8_STAGE(PG8_SA(1, 0), a3, voffA);
            PG8_WAIT_V(8); PG8_WAIT_L(0); PG8_BAR; PG8_MMA(1, 0, At, B0); PG8_MMA(1, 1, At, B1); PG8_BAR; PG8_SCHED;
            } else {
            PG8_LDB(B0, 0, 0); PG8_SCHED; PG8_LDA(At, 0, 0); PG8_STAGE(PG8_SA(1, 1), a1 + hstepA, voffA);
            PG8_WAIT_L(8); PG8_BAR; PG8_WAIT_L(0); PG8_MMA(0, 0, At, B0); PG8_BAR; PG8_SCHED;
            PG8_LDB(B1, 0, 1); PG8_STAGE(PG8_SB(0, 0), b2, voffB);
            PG8_BAR; PG8_WAIT_L(0); PG8_MMA(0, 1, At, B1); PG8_BAR;
            PG8_LDA(At, 0, 1); PG8_STAGE(PG8_SA(0, 0), a2, voffA);
            PG8_BAR; PG8_WAIT_L(0); PG8_MMA(1, 0, At, B0); PG8_BAR; PG8_SCHED;
            PG8_STAGE(PG8_SB(0, 1), b2 + hstepB, voffB);
            PG8_WAIT_V(6); PG8_BAR; PG8_MMA(1, 1, At, B1); PG8_BAR;
            PG8_LDB(B0, 1, 0); PG8_SCHED; PG8_LDA(At, 1, 0); PG8_STAGE(PG8_SA(0, 1), a2 + hstepA, voffA);
            PG8_WAIT_L(8); PG8_BAR; PG8_WAIT_L(0); PG8_MMA(0, 0, At, B0); PG8_BAR; PG8_SCHED;
            PG8_LDB(B1, 1, 1); PG8_STAGE(PG8_SB(1, 0), b3, voffB);
            PG8_BAR; PG8_WAIT_L(0); PG8_MMA(0, 1, At, B1); PG8_BAR;
            PG8_LDA(At, 1, 1); PG8_STAGE(PG8_SA(1, 0), a3, voffA);
            PG8_BAR; PG8_WAIT_L(0); PG8_MMA(1, 0, At, B0); PG8_BAR; PG8_SCHED;
            PG8_STAGE(PG8_SB(1, 1), b3 + hstepB, voffB);
            PG8_WAIT_V(6); PG8_BAR; PG8_MMA(1, 1, At, B1); PG8_BAR;
            }
        }
        if constexpr (ALIGN_EPI) { if (wr == 0) PG8_BAR; }
        if constexpr (!Epi::AFTER_DRAIN) { E(acc, cur, wr, wc, fr, fq); S.done(cur); }
        if (!has_next) break;
#pragma unroll
        for (int a = 0; a < 2; ++a)
#pragma unroll
            for (int b = 0; b < 2; ++b)
#pragma unroll
                for (int m = 0; m < 4; ++m)
#pragma unroll
                    for (int n = 0; n < 2; ++n) acc[a][b][m][n] = (f32x4){0.f, 0.f, 0.f, 0.f};
        cur = nxt; cA = nA; cB = nB; ++ui;
        if constexpr (ALIGN_EPI) { if (wr == 1) PG8_BAR; }
    }
    PG8_WAIT_V(0);
    if constexpr (!ALIGN_EPI) { if (wr == 0) PG8_BAR; }
    PG8_BAR;
    if constexpr (Epi::AFTER_DRAIN) { E.fused(acc, cur, wr, wc, fr, fq, lds, wid, lane); S.done(cur); }
#undef PG8_SA
#undef PG8_SB
#undef PG8_STAGE
#undef PG8_LDA
#undef PG8_LDB
#undef PG8_MMA
#undef PG8_WAIT_V
#undef PG8_WAIT_L
#undef PG8_BAR
#undef PG8_SCHED
}
}

constexpr int S = 16384, DM = 1024, FF = 2816, FF2 = 5632, EVEN_SRC = 3664, EVEN_NP = 3840, ODD_N = 3072, NLAYER = 2, MEMT = 256, MEMW = 256;
constexpr float RMS_EPS = 1e-6f;
constexpr float LOG2E = 1.4426950408889634f;
constexpr float C2 = 0.125f * LOG2E;
constexpr int NWAVES = 8, NTHREADS = 512;
constexpr int EC_FQ = 0, EC_DQ = 512, EC_FK = 1024, EC_DK = 1536, EC_FV = 2048, EC_DV = 2560, EC_IQ = 3072, EC_IK = 3584;
constexpr int ES_FQ = 0, ES_FK = 512, ES_FV = 1024, ES_FL = 1536, ES_DQ = 1544, ES_DK = 2056, ES_DV = 2568, ES_IQ = 3080, ES_IK = 3592, ES_IW = 3656;

constexpr size_t MiB = 1u << 20;
constexpr size_t WS_CTL = 0, CTL_ZERO_BYTES = 1 * MiB;
constexpr size_t WS_SSQ = 1 * MiB;
constexpr size_t WS_KSUM = 6 * MiB;
constexpr size_t WS_GT = 11 * MiB + 131072;
constexpr size_t WS_TW = 11 * MiB;
constexpr size_t WS_ROPE = 2 * MiB;
constexpr size_t WS_FL = 3 * MiB;
constexpr size_t WS_MEMK = 4 * MiB;
constexpr size_t WS_IW = 5 * MiB;
constexpr size_t WS_W = 12 * MiB;
constexpr size_t WS_BIG = 60 * MiB;
constexpr size_t WS_HB = 224 * MiB;
constexpr size_t WS_END = 256 * MiB;
constexpr size_t W_FFN1_IN = 0, W_FFN1_OUT = 11 * MiB, W_MIX_IN = 17 * MiB, W_MIX_OUT = 25 * MiB, W_MEMQ = 27 * MiB, W_MEMO = 28 * MiB, W_FFN2_IN = 29 * MiB, W_FFN2_OUT = 40 * MiB, W_MEMQ2 = 46 * MiB, W_MEMO2 = 47 * MiB;
constexpr size_t B_U = 0;
constexpr size_t B_PROJ = 0;
constexpr size_t B_VTF = 120 * MiB;
constexpr size_t B_IKC = 136 * MiB;
constexpr size_t B_VTM = 96 * MiB;
constexpr size_t B_SEL = 156 * MiB;
constexpr size_t B_QP = 0;
constexpr size_t B_QM = 140 * MiB, B_OM = 148 * MiB;
constexpr int CW_TMO = 0, CW_CODE = 1, CW_BAR = 4096;

constexpr int RING_BYTES = 147456;
constexpr int LDSCTL_OFF = RING_BYTES, MISC_OFF = LDSCTL_OFF + 320;
constexpr int LDS_BYTES = 163840;

#define GAS __attribute__((address_space(1)))
#define LAS __attribute__((address_space(3)))
typedef unsigned short bf16;
typedef unsigned v4u __attribute__((ext_vector_type(4)));
typedef float f32x4 __attribute__((ext_vector_type(4)));
typedef short bf16x8 __attribute__((ext_vector_type(8)));
typedef GAS unsigned gu32;
typedef GAS unsigned long long gu64;
#define RLX_AGENT __ATOMIC_RELAXED, __HIP_MEMORY_SCOPE_AGENT
#define LDS_WAIT() asm volatile("s_waitcnt lgkmcnt(0)" ::: "memory")
#define VM_WAIT() asm volatile("s_waitcnt vmcnt(0)" ::: "memory")
__device__ __forceinline__ unsigned long long rt() { return __builtin_amdgcn_s_memrealtime(); }
__device__ __forceinline__ unsigned f2bf(float f) { unsigned u = __builtin_bit_cast(unsigned, f); return (u + 0x7fffu + ((u >> 16) & 1u)) >> 16; }
__device__ __forceinline__ unsigned pk2(float lo, float hi) { return f2bf(lo) | (f2bf(hi) << 16); }

#define XB_TMO      128
#define XB_XCNT(j)  (256  + 64 * (j))
#define XB_XSUB(j)  (1280 + 64 * (j))
#define XB_XGEN(j)  (2304 + 64 * (j))
#define XB_TOP      3328
#define XB_TOPGEN   3392
#define XCD_BAR_WORDS 3456
#define XB_SPIN_CAP (1u << 18)

__device__ __forceinline__ unsigned xb_ld(unsigned* p)              { return __hip_atomic_load(p, __ATOMIC_RELAXED, __HIP_MEMORY_SCOPE_AGENT); }
__device__ __forceinline__ unsigned xb_add(unsigned* p, unsigned v) { return __hip_atomic_fetch_add(p, v, __ATOMIC_RELAXED, __HIP_MEMORY_SCOPE_AGENT); }
__device__ __forceinline__ unsigned xb_xcc_id() { return (unsigned)__builtin_amdgcn_s_getreg((3 << 11) | 20) & 0xFu; }
#define XB_SPIN(cond, bar) do { unsigned _sp = 0; while (cond) { __builtin_amdgcn_s_sleep(1); \
    if ((++_sp & 255u) == 0u) { if (xb_ld(&(bar)[XB_TMO])) break; if (_sp > XB_SPIN_CAP) { atomicAdd(&(bar)[XB_TMO], 1u); break; } } } } while (0)

struct XcdBarrier {
    unsigned* bar; unsigned x;
    volatile LAS unsigned* st;
};

__device__ __forceinline__ XcdBarrier xcd_barrier_post(unsigned* bar, volatile LAS unsigned* st) {
    XcdBarrier b; b.bar = bar; b.x = xb_xcc_id(); b.st = st;
    if (threadIdx.x == 0) (void)xb_add(&bar[XB_XCNT(b.x)], 1u);
    return b;
}
__device__ __forceinline__ void xcd_barrier_complete(unsigned* bar, unsigned x, unsigned& nloc, unsigned& nx) {
    const unsigned G = gridDim.x * gridDim.y * gridDim.z;
    unsigned sum, cnt, mine, sp = 0u;
    for (;;) {
        sum = 0u; cnt = 0u; mine = 0u;
#pragma unroll
        for (unsigned j = 0; j < 16; ++j) { const unsigned c = xb_ld(&bar[XB_XCNT(j)]); sum += c; cnt += (c > 0u) ? 1u : 0u; mine = (j == x) ? c : mine; }
        if (sum == G) break;
        __builtin_amdgcn_s_sleep(1);
        if ((++sp & 255u) == 0u) { if (xb_ld(&bar[XB_TMO])) break; if (sp > XB_SPIN_CAP) { atomicAdd(&bar[XB_TMO], 1u); break; } }
    }
    nloc = mine > 0u ? mine : 1u; nx = cnt > 0u ? cnt : 1u;
}

__device__ __forceinline__ void xcd_barrier(const XcdBarrier& b) {
    asm volatile("s_waitcnt vmcnt(0)" ::: "memory");
    __syncthreads();
    if (threadIdx.x == 0) {
        unsigned* bar = b.bar;
        __builtin_amdgcn_s_waitcnt(0);
        unsigned nloc = b.st[0], nx = b.st[1];
        if (nloc == 0u) { unsigned x_ = b.x; asm volatile("" : "+s"(x_)); xcd_barrier_complete(bar, x_, nloc, nx); b.st[0] = nloc; b.st[1] = nx; }
        const unsigned old = xb_add(&bar[XB_XSUB(b.x)], 1u);
        const unsigned gen = old / nloc;
        if (old + 1u == (gen + 1u) * nloc) {
            __builtin_amdgcn_fence(__ATOMIC_RELEASE, "agent");
            asm volatile("s_waitcnt vmcnt(0)" ::: "memory");
            const unsigned og = xb_add(&bar[XB_TOP], 1u);
            const unsigned tg = og / nx;
            if (og + 1u == (tg + 1u) * nx) xb_add(&bar[XB_TOPGEN], 1u);
            else XB_SPIN(xb_ld(&bar[XB_TOPGEN]) == tg, bar);
            __builtin_amdgcn_fence(__ATOMIC_ACQUIRE, "agent");
            xb_add(&bar[XB_XGEN(b.x)], 1u);
            asm volatile("s_waitcnt vmcnt(0)" ::: "memory");
        } else {
            XB_SPIN(xb_ld(&bar[XB_XGEN(b.x)]) == gen, bar);
            __builtin_amdgcn_fence(__ATOMIC_ACQUIRE, "agent");
            asm volatile("s_waitcnt vmcnt(0)" ::: "memory");
        }
    }
    __syncthreads();
}

typedef float f32x16 __attribute__((ext_vector_type(16)));
typedef float f32x2_t __attribute__((ext_vector_type(2)));
typedef __bf16 bf16x2_t __attribute__((ext_vector_type(2)));
typedef unsigned u32x2 __attribute__((ext_vector_type(2)));
__device__ __forceinline__ unsigned cvtpk(float lo, float hi) { f32x2_t v = {lo, hi}; bf16x2_t b = __builtin_convertvector(v, bf16x2_t); return __builtin_bit_cast(unsigned, b); }
__device__ __forceinline__ float bflo(unsigned w) { return __uint_as_float(w << 16); }
__device__ __forceinline__ float bfhi(unsigned w) { return __uint_as_float(w & 0xffff0000u); }
__device__ __forceinline__ void unpack8(const v4u& w, float (&x)[8]) { x[0] = bflo(w.x); x[1] = bfhi(w.x); x[2] = bflo(w.y); x[3] = bfhi(w.y); x[4] = bflo(w.z); x[5] = bfhi(w.z); x[6] = bflo(w.w); x[7] = bfhi(w.w); }
__device__ __forceinline__ v4u pack8(const float (&x)[8]) { v4u w; w.x = cvtpk(x[0], x[1]); w.y = cvtpk(x[2], x[3]); w.z = cvtpk(x[4], x[5]); w.w = cvtpk(x[6], x[7]); return w; }
__device__ __forceinline__ float wave_sum(float v) { v += shx<1>(v); v += shx<2>(v); v += shx<4>(v); v += shx<8>(v); v += shx<16>(v); return sh32_sum(v); }
__device__ __forceinline__ float wave_max(float v) { v = fmaxf(v, shx<1>(v)); v = fmaxf(v, shx<2>(v)); v = fmaxf(v, shx<4>(v)); v = fmaxf(v, shx<8>(v)); v = fmaxf(v, shx<16>(v)); return sh32_max(v); }
__device__ __forceinline__ int crow(int r, int hi) { return (r & 3) + 8 * (r >> 2) + 4 * hi; }

__device__ __forceinline__ int even_map(int n) {
    if (n < 512) return ES_FQ + n;
    if (n < 1024) return ES_DQ + (n - 512);
    if (n < 1536) return ES_FK + (n - 1024);
    if (n < 2048) return ES_DK + (n - 1536);
    if (n < 2560) return ES_FV + (n - 2048);
    if (n < 3072) return ES_DV + (n - 2560);
    if (n < 3584) return ES_IQ + (n - 3072);
    if (n < 3648) return ES_IK + (n - 3584);
    return -1;
}
__device__ __forceinline__ void conv_item(const float* W, int K, int Nsrc, int nblk, const float* gain, bf16* WT, int mode, LAS float* scr, int item, int lane) {
    const int kb = item / nblk, nb = item % nblk, k0 = 32 * kb, n0 = 128 * nb;
    const int n = n0 + 4 * (lane & 31);
    int sc;
    if (mode == 0) sc = n; else if (mode == 1) { const int T = n >> 8, hf = (n >> 7) & 1, j = n & 127; sc = hf * FF + 128 * T + j; } else sc = even_map(n);
    f32x4 v[16];
#pragma unroll
    for (int i = 0; i < 16; ++i) { const int kk = 2 * i + (lane >> 5); v[i] = (f32x4){0.f, 0.f, 0.f, 0.f};
        if (sc >= 0) v[i] = *(const GAS f32x4*)(W + (size_t)(k0 + kk) * Nsrc + sc); }
#pragma unroll
    for (int i = 0; i < 16; ++i) { const int kk = 2 * i + (lane >> 5); const float g = gain ? gain[k0 + kk] : 1.0f;
        *(LAS f32x4*)(scr + kk * 132 + 4 * (lane & 31)) = v[i] * g; }
    LDS_WAIT(); asm volatile("" ::: "memory");
    const int c = lane & 3;
#pragma unroll
    for (int j = 0; j < 8; ++j) { const int nn = (lane >> 2) + 16 * j; const LAS float* s = scr + (8 * c) * 132 + nn;
        v4u o; o.x = cvtpk(s[0 * 132], s[1 * 132]); o.y = cvtpk(s[2 * 132], s[3 * 132]); o.z = cvtpk(s[4 * 132], s[5 * 132]); o.w = cvtpk(s[6 * 132], s[7 * 132]);
        *(GAS v4u*)(WT + (size_t)(n0 + nn) * K + k0 + 8 * c) = o; }
    LDS_WAIT(); asm volatile("" ::: "memory");
}
struct InPtrs { const float* p[26]; };
constexpr int INTAB_OFF = LDSCTL_OFF + 1024;
struct InTab { LAS unsigned char* ldsbase;
    __device__ __forceinline__ const float* get(int k) const { const u32x2 v = *(const LAS u32x2*)(ldsbase + INTAB_OFF + 8 * k);
        const unsigned lo = (unsigned)__builtin_amdgcn_readfirstlane((int)v.x), hi = (unsigned)__builtin_amdgcn_readfirstlane((int)v.y);
        return (const float*)(((unsigned long long)hi << 32) | lo); } };
__device__ __forceinline__ void conv_weights(const InTab& in, unsigned char* ws, int L, int mask, LAS unsigned char* lds, int gw, int NGW, int wave, int lane) {
    LAS float* scr = (LAS float*)(lds + wave * 17408);
    unsigned char* Wr = ws + WS_W;
    const bool even = (L & 1) == 0;
    const int mixN = even ? EVEN_NP : ODD_N, mixSrc = even ? EVEN_SRC : ODD_N;
    const int I_FIN = (DM / 32) * (FF2 / 128), I_FOUT = (FF / 32) * (DM / 128), I_MIN = (DM / 32) * (mixN / 128), I_MOUT = (DM / 32) * (DM / 128), I_MQ = (DM / 32) * (MEMW / 128), I_MO = (MEMW / 32) * (DM / 128);
    const int n0 = (mask & 1) ? I_FIN : 0, n1 = (mask & 2) ? I_FOUT : 0, n2 = (mask & 4) ? I_MIN : 0, n3 = (mask & 8) ? I_MOUT : 0, n4 = (mask & 16) ? I_MQ : 0, n5 = (mask & 32) ? I_MO : 0,
              n6 = (mask & 64) ? I_FIN : 0, n7 = (mask & 128) ? I_FOUT : 0;
    const int NITEMS = n0 + n1 + n2 + n3 + n4 + n5 + n6 + n7;
    for (int it = gw; it < NITEMS; it += NGW) {
        int r = it;
        if (r < n0) { conv_item(in.get(3) + (size_t)L * DM * FF2, DM, FF2, FF2 / 128, in.get(2) + (size_t)L * DM, (bf16*)(Wr + W_FFN1_IN), 1, scr, r, lane); continue; } r -= n0;
        if (r < n6) { conv_item(in.get(24) + (size_t)L * DM * FF2, DM, FF2, FF2 / 128, in.get(23) + (size_t)L * DM, (bf16*)(Wr + W_FFN2_IN), 1, scr, r, lane); continue; } r -= n6;
        if (r < n1) { conv_item(in.get(4) + (size_t)L * FF * DM, FF, DM, DM / 128, nullptr, (bf16*)(Wr + W_FFN1_OUT), 0, scr, r, lane); continue; } r -= n1;
        if (r < n7) { conv_item(in.get(25) + (size_t)L * FF * DM, FF, DM, DM / 128, nullptr, (bf16*)(Wr + W_FFN2_OUT), 0, scr, r, lane); continue; } r -= n7;
        if (r < n2) { conv_item(even ? in.get(6) : in.get(12), DM, mixSrc, mixN / 128, in.get(5) + (size_t)L * DM, (bf16*)(Wr + W_MIX_IN), even ? 2 : 0, scr, r, lane); continue; } r -= n2;
        if (r < n3) { conv_item(in.get(15) + (size_t)L * DM * DM, DM, DM, DM / 128, nullptr, (bf16*)(Wr + W_MIX_OUT), 0, scr, r, lane); continue; } r -= n3;
        if (r < n4) { conv_item(in.get(18) + (size_t)L * DM * MEMW, DM, MEMW, MEMW / 128, in.get(16) + (size_t)L * DM, (bf16*)(Wr + (L ? W_MEMQ2 : W_MEMQ)), 0, scr, r, lane); continue; } r -= n4;
        conv_item(in.get(22) + (size_t)L * MEMW * DM, MEMW, DM, DM / 128, nullptr, (bf16*)(Wr + (L ? W_MEMO2 : W_MEMO)), 0, scr, r, lane);
    }
}
__device__ __forceinline__ void copy_x(const float* x, float* out, bf16* HB, float* ssq0, int gw, int NGW, int lane) {
    for (int m = gw; m < S; m += NGW) {
        const GAS f32x4* xr = (const GAS f32x4*)(x + (size_t)m * DM) + lane; GAS f32x4* orow = (GAS f32x4*)(out + (size_t)m * DM) + lane;
        GAS u32x2* hb = (GAS u32x2*)(HB + (size_t)m * DM) + lane;
        float s = 0.f;
#pragma unroll
        for (int j = 0; j < 4; ++j) { const f32x4 v = xr[64 * j]; orow[64 * j] = v; s += (v.x * v.x + v.y * v.y) + (v.z * v.z + v.w * v.w);
            u32x2 w; w.x = cvtpk(v.x, v.y); w.y = cvtpk(v.z, v.w); hb[64 * j] = w; }
        s = wave_sum(s);
        if (lane < 16) ssq0[(size_t)m * 16 + lane] = (lane == 0) ? s : 0.f;
    }
}
__device__ __forceinline__ void rope_tables(float* cosT, float* sinT, int gtid, int nthreads) {
    for (int idx = gtid; idx < S * 8; idx += nthreads) {
        const int t = idx >> 3, j = idx & 7;
        float inv;
        switch (j) { case 0: inv = 1.0f; break; case 1: inv = 0.193922743f; break; case 2: inv = 0.0376060307f; break; case 3: inv = 0.00729266461f; break;
                     case 4: inv = 0.00141421356f; break; case 5: inv = 0.000274248188f; break; case 6: inv = 5.3182961e-05f; break; default: inv = 1.03133862e-05f; break; }
        const float ang = (float)t * inv;
        const float kq = __builtin_rintf(ang * 0.63661977236758134f);
        float r = ang - kq * 1.5703125f; r = r - kq * 0.00048351287841796875f; r = r - kq * 3.1391647326017846e-07f;
        const float r2 = r * r;
        float sp = 2.7557319e-6f; sp = sp * r2 - 1.9841270e-4f; sp = sp * r2 + 8.3333333e-3f; sp = sp * r2 - 1.6666667e-1f; const float sn = r + r * r2 * sp;
        float cp = -2.7557319e-7f; cp = cp * r2 + 2.4801587e-5f; cp = cp * r2 - 1.3888889e-3f; cp = cp * r2 + 4.1666667e-2f; cp = cp * r2 - 0.5f; const float cs = 1.0f + r2 * cp;
        const int q = ((int)kq) & 3;
        const float sv = (q == 0) ? sn : (q == 1) ? cs : (q == 2) ? -sn : -cs;
        const float cv = (q == 0) ? cs : (q == 1) ? -sn : (q == 2) ? -cs : sn;
        cosT[idx] = cv; sinT[idx] = sv;
    }
}
__device__ __forceinline__ void mem_kv(const InTab& in, unsigned char* ws, LAS unsigned char* lds, int unit, int tid, int wave, int lane) {
    LAS float* memn = (LAS float*)lds;
    bf16* memK = (bf16*)(ws + WS_MEMK); bf16* memVt = (bf16*)(ws + WS_MEMK + 256 * 1024);
    const int L = unit >> 6, rb = (unit >> 3) & 7, cb = unit & 7;
    const float* gm = in.get(17) + (size_t)L * DM; const float* wkv = in.get(19) + (size_t)L * DM * 512; const float* kn = in.get(21) + (size_t)L * 64;
    __syncthreads();
    for (int i = 0; i < 4; ++i) { const int r = wave * 4 + i; const float* mrow = in.get(1) + (size_t)(rb * 32 + r) * DM;
        f32x4 v[4]; float s = 0.f;
#pragma unroll
        for (int j = 0; j < 4; ++j) { v[j] = *((const GAS f32x4*)mrow + lane + 64 * j); s += (v[j].x * v[j].x + v[j].y * v[j].y) + (v[j].z * v[j].z + v[j].w * v[j].w); }
        const float rstd = rsqrtf(wave_sum(s) * (1.0f / DM) + RMS_EPS);
#pragma unroll
        for (int j = 0; j < 4; ++j) { const f32x4 g = *((const GAS f32x4*)gm + lane + 64 * j); *(LAS f32x4*)(memn + r * 1028 + 4 * (lane + 64 * j)) = v[j] * rstd * g; } }
    __syncthreads();
    const int r = tid >> 4, c4 = (tid & 15) * 4;
    f32x4 acc = (f32x4){0.f, 0.f, 0.f, 0.f};
    const float* wp = wkv + cb * 64 + c4; const LAS float* mp = memn + r * 1028;
#pragma unroll 8
    for (int k = 0; k < DM; ++k) acc = acc + *(const GAS f32x4*)(wp + (size_t)k * 512) * mp[k];
    const int tok = rb * 32 + r;
    if (cb < 4) {
        float ss = (acc.x * acc.x + acc.y * acc.y) + (acc.z * acc.z + acc.w * acc.w);
        ss += shx<1>(ss); ss += shx<2>(ss); ss += shx<4>(ss); ss += shx<8>(ss);
        const float rs = rsqrtf(ss * (1.0f / 64.0f) + RMS_EPS);
        u32x2 w; w.x = cvtpk(acc.x * rs * kn[c4], acc.y * rs * kn[c4 + 1]); w.y = cvtpk(acc.z * rs * kn[c4 + 2], acc.w * rs * kn[c4 + 3]);
        *(GAS u32x2*)(memK + (size_t)L * 65536 + (size_t)tok * 256 + cb * 64 + c4) = w;
    } else {
        const int c = (cb - 4) * 64 + c4; bf16* vp = memVt + (size_t)L * 65536 + (size_t)c * 256 + tok;
        vp[0] = (bf16)(cvtpk(acc.x, 0.f) & 0xffffu); vp[256] = (bf16)(cvtpk(acc.y, 0.f) & 0xffffu); vp[512] = (bf16)(cvtpk(acc.z, 0.f) & 0xffffu); vp[768] = (bf16)(cvtpk(acc.w, 0.f) & 0xffffu);
    }
}

__device__ __forceinline__ void head_norm8(float (&x)[8], const float* gain, int lane) {
    float ss = 0.f;
#pragma unroll
    for (int j = 0; j < 8; ++j) ss += x[j] * x[j];
    ss += shx<1>(ss); ss += shx<2>(ss); ss += shx<4>(ss);
    const float r = rsqrtf(ss * (1.0f / 64.0f) + RMS_EPS);
    const int d0 = 8 * (lane & 7);
#pragma unroll
    for (int j = 0; j < 8; ++j) x[j] = x[j] * r * gain[d0 + j];
}
__device__ __forceinline__ void rope8(float (&x)[8], const float (&cs)[8], const float (&sn)[8], int lane) {
    const int sub = lane & 7;
#pragma unroll
    for (int j = 0; j < 8; ++j) {
        const float other = shx<1>(x[j]);
        if (sub == 0) x[j] = x[j] * cs[j] - other * sn[j];
        else if (sub == 1) x[j] = x[j] * cs[j] + other * sn[j];
    }
}
__device__ __forceinline__ float sh32_get(float v, int lane) { auto r = __builtin_amdgcn_permlane32_swap(__float_as_uint(v), __float_as_uint(v), false, false); return __uint_as_float((lane < 32) ? r[1] : r[0]); }
__device__ __forceinline__ float reduce_scatter64(float (&v)[64], int lane) {
    { const bool up = (lane & 32) != 0;
#pragma unroll
      for (int j = 0; j < 32; ++j) { const float send = up ? v[j] : v[j + 32], keep = up ? v[j + 32] : v[j]; v[j] = keep + sh32_get(send, lane); } }
    { const bool up = (lane & 16) != 0;
#pragma unroll
      for (int j = 0; j < 16; ++j) { const float send = up ? v[j] : v[j + 16], keep = up ? v[j + 16] : v[j]; v[j] = keep + shx<16>(send); } }
    { const bool up = (lane & 8) != 0;
#pragma unroll
      for (int j = 0; j < 8; ++j) { const float send = up ? v[j] : v[j + 8], keep = up ? v[j + 8] : v[j]; v[j] = keep + shx<8>(send); } }
    { const bool up = (lane & 4) != 0;
#pragma unroll
      for (int j = 0; j < 4; ++j) { const float send = up ? v[j] : v[j + 4], keep = up ? v[j + 4] : v[j]; v[j] = keep + shx<4>(send); } }
    { const bool up = (lane & 2) != 0;
#pragma unroll
      for (int j = 0; j < 2; ++j) { const float send = up ? v[j] : v[j + 2], keep = up ? v[j + 2] : v[j]; v[j] = keep + shx<2>(send); } }
    { const bool up = (lane & 1) != 0; const float send = up ? v[0] : v[1], keep = up ? v[1] : v[0]; v[0] = keep + shx<1>(send); }
    return v[0];
}
__device__ __forceinline__ void post_even(const InTab& in, unsigned char* ws, const float* H, const float* ssq, LAS unsigned char* lds, int G, int tid, int wave, int lane) {
    float* Flocal = (float*)(ws + WS_FL); float* Btot = Flocal + S * 8; float* IW = (float*)(ws + WS_IW);
    const float* bfg = in.get(7);
    LAS f32x4* Tw = (LAS f32x4*)lds;
    LAS float* lf = (LAS float*)(lds + 65536);
    { const GAS f32x4* src = (const GAS f32x4*)(ws + WS_TW);
#pragma unroll
      for (int i = 0; i < 8; ++i) Tw[tid + 512 * i] = src[tid + 512 * i]; }
    __syncthreads();
    for (int u = blockIdx.x; u < S / 64; u += G) {
        const int t0 = u * 64, tw0 = t0 + wave * 8;
#pragma unroll 1
        for (int rb = 0; rb < 2; ++rb) {
            float acc[64];
#pragma unroll
            for (int j = 0; j < 64; ++j) acc[j] = 0.f;
#pragma unroll
            for (int q = 0; q < 4; ++q) {
                f32x4 hv[4];
#pragma unroll
                for (int r = 0; r < 4; ++r) hv[r] = *((const GAS f32x4*)(H + (size_t)(tw0 + rb * 4 + r) * DM) + lane + 64 * q);
#pragma unroll
                for (int e = 0; e < 4; ++e)
#pragma unroll
                    for (int c = 0; c < 4; ++c) { const f32x4 w = Tw[((q * 4 + e) * 4 + c) * 64 + lane];
#pragma unroll
                        for (int r = 0; r < 4; ++r) { acc[r * 16 + 4 * c + 0] += hv[r][e] * w[0]; acc[r * 16 + 4 * c + 1] += hv[r][e] * w[1]; acc[r * 16 + 4 * c + 2] += hv[r][e] * w[2]; acc[r * 16 + 4 * c + 3] += hv[r][e] * w[3]; } }
            }
            const float zs = reduce_scatter64(acc, lane);
            const int rl = wave * 8 + rb * 4 + (lane >> 4), t = t0 + rl, j = lane & 15;
            const float z = zs * pg8::row_rstd(ssq, t);
            if (j < 8) { const float zz = z + bfg[j]; lf[rl * 8 + j] = (zz > 15.f) ? -expf(-zz) : -log1pf(expf(-zz)); }
            else IW[(size_t)t * 8 + (j - 8)] = z * 0.044194173824159216f;
        }
        __syncthreads();
        {
            float v = lf[lane * 8 + wave];
#pragma unroll
            for (int o = 1; o < 64; o <<= 1) { const float up = __int_as_float(__builtin_amdgcn_ds_bpermute(((lane - o) & 63) << 2, __float_as_int(v))); if (lane >= o) v += up; }
            Flocal[(size_t)(t0 + lane) * 8 + wave] = v;
            if (lane == 63) Btot[u * 8 + wave] = v;
        }
        __syncthreads();
    }
}

__device__ __forceinline__ void post_odd(unsigned char* ws, LAS unsigned char* lds, int G, int tid) {
    const bf16* Kb = (const bf16*)(ws + WS_BIG + B_PROJ) + (size_t)S * DM; float* ksum = (float*)(ws + WS_KSUM);
    LAS float* red = (LAS float*)lds;
    for (int u = blockIdx.x; u < 256; u += G) {
        const int n = u >> 2, cg = u & 3, c2 = tid & 127, rg = tid >> 7;
        const bf16* kp = Kb + (size_t)(n * 256 + rg * 64) * DM + cg * 256 + c2 * 2;
        float s0 = 0.f, s1 = 0.f;
#pragma unroll 16
        for (int r = 0; r < 64; ++r) { const unsigned w = *(const GAS unsigned*)(kp + (size_t)r * DM); s0 += bflo(w); s1 += bfhi(w); }
        __syncthreads();
        red[rg * 256 + c2 * 2] = s0; red[rg * 256 + c2 * 2 + 1] = s1;
        __syncthreads();
        if (tid < 256) ksum[(size_t)n * 1024 + cg * 256 + tid] = (red[tid] + red[256 + tid]) + (red[512 + tid] + red[768 + tid]);
    }
}

constexpr int KV_K_BYTES = 8192, KV_VT_PITCH = 136, KV_BUF_BYTES = KV_K_BYTES + 64 * KV_VT_PITCH;
struct KVRegs { v4u k, v; };
__device__ __forceinline__ void kv_load(KVRegs& r, const bf16* Kp, size_t kpitch, const bf16* Vtp, size_t vtpitch, int key0, int tid) {
    r.k = *(const GAS v4u*)(Kp + (size_t)(key0 + (tid & 63)) * kpitch + (tid >> 6) * 8);
    r.v = *(const GAS v4u*)(Vtp + (size_t)(tid >> 3) * vtpitch + key0 + (tid & 7) * 8);
}
__device__ __forceinline__ void kv_store(const KVRegs& r, LAS unsigned char* buf, int tid) {
    *(LAS v4u*)(buf + ((tid >> 6) * 64 + (tid & 63)) * 16) = r.k;
    LAS unsigned char* vp = buf + KV_K_BYTES + (tid >> 3) * KV_VT_PITCH + (tid & 7) * 16;
    *(LAS u32x2*)vp = (u32x2){r.v.x, r.v.y}; *(LAS u32x2*)(vp + 8) = (u32x2){r.v.z, r.v.w};
}
struct AttnAcc { float m, l; f32x16 o0, o1; };
__device__ __forceinline__ void attn_init(AttnAcc& a) { a.m = -INFINITY; a.l = 0.f;
#pragma unroll
    for (int r = 0; r < 16; ++r) { a.o0[r] = 0.f; a.o1[r] = 0.f; } }
template <int CHS = 1024>
__device__ __forceinline__ void attn_scores(f32x16& p0, f32x16& p1, const LAS unsigned char* buf, const bf16x8 (&qf)[4], int lane) {
    const int r32 = lane & 31, hi = lane >> 5;
#pragma unroll
    for (int r = 0; r < 16; ++r) { p0[r] = 0.f; p1[r] = 0.f; }
#pragma unroll
    for (int ks = 0; ks < 4; ++ks) {
        const bf16x8 k0 = *(const LAS bf16x8*)(buf + (2 * ks + hi) * CHS + r32 * 16);
        const bf16x8 k1 = *(const LAS bf16x8*)(buf + (2 * ks + hi) * CHS + (32 + r32) * 16);
        p0 = __builtin_amdgcn_mfma_f32_32x32x16_bf16(k0, qf[ks], p0, 0, 0, 0);
        p1 = __builtin_amdgcn_mfma_f32_32x32x16_bf16(k1, qf[ks], p1, 0, 0, 0);
    }
}
template <int VTP = KV_VT_PITCH, int VOFF = KV_K_BYTES>
__device__ __forceinline__ void attn_update(AttnAcc& a, f32x16& p0, f32x16& p1, const LAS unsigned char* buf, int lane) {
    const int r32 = lane & 31, hi = lane >> 5;
    float mx = fmaxf(p0[0], p1[0]);
#pragma unroll
    for (int r = 1; r < 16; ++r) mx = fmaxf(mx, fmaxf(p0[r], p1[r]));
    mx = sh32_max(mx);
    const float mnew = fmaxf(a.m, mx);
    const float msafe = (mnew == -INFINITY) ? 0.f : mnew;
    const float alpha = __builtin_amdgcn_exp2f(a.m - msafe);
    float sum = 0.f;
#pragma unroll
    for (int r = 0; r < 16; ++r) { p0[r] = __builtin_amdgcn_exp2f(p0[r] - msafe); p1[r] = __builtin_amdgcn_exp2f(p1[r] - msafe); sum += p0[r] + p1[r]; }
    a.l = a.l * alpha + sum; a.m = mnew;
#pragma unroll
    for (int r = 0; r < 16; ++r) { a.o0[r] *= alpha; a.o1[r] *= alpha; }
    const LAS unsigned char* vt = buf + VOFF + r32 * VTP + hi * 8;
#pragma unroll
    for (int half = 0; half < 2; ++half) {
#pragma unroll
        for (int s = 0; s < 2; ++s) {
            v4u pw;
            if (half == 0) { pw.x = cvtpk(p0[8 * s + 0], p0[8 * s + 1]); pw.y = cvtpk(p0[8 * s + 2], p0[8 * s + 3]); pw.z = cvtpk(p0[8 * s + 4], p0[8 * s + 5]); pw.w = cvtpk(p0[8 * s + 6], p0[8 * s + 7]); }
            else           { pw.x = cvtpk(p1[8 * s + 0], p1[8 * s + 1]); pw.y = cvtpk(p1[8 * s + 2], p1[8 * s + 3]); pw.z = cvtpk(p1[8 * s + 4], p1[8 * s + 5]); pw.w = cvtpk(p1[8 * s + 6], p1[8 * s + 7]); }
            const bf16x8 pb = __builtin_bit_cast(bf16x8, pw);
            const int kb = (32 * half + 16 * s) * 2;
#pragma unroll
            for (int d0 = 0; d0 < 2; ++d0) {
                const u32x2 lo = *(const LAS u32x2*)(vt + d0 * 32 * VTP + kb), hi2 = *(const LAS u32x2*)(vt + d0 * 32 * VTP + kb + 16);
                const bf16x8 va = __builtin_bit_cast(bf16x8, (v4u){lo.x, lo.y, hi2.x, hi2.y});
                if (d0 == 0) a.o0 = __builtin_amdgcn_mfma_f32_32x32x16_bf16(va, pb, a.o0, 0, 0, 0);
                else         a.o1 = __builtin_amdgcn_mfma_f32_32x32x16_bf16(va, pb, a.o1, 0, 0, 0);
            }
        }
    }
}
__device__ __forceinline__ void attn_store(const AttnAcc& a, bf16* orow, int lane) {
    const int hi = lane >> 5;
    float l = sh32_sum(a.l);
    const float inv = (l > 0.f) ? 1.0f / l : 0.f;
#pragma unroll
    for (int g = 0; g < 4; ++g) {
        u32x2 w0, w1;
        w0.x = cvtpk(a.o0[4 * g] * inv, a.o0[4 * g + 1] * inv); w0.y = cvtpk(a.o0[4 * g + 2] * inv, a.o0[4 * g + 3] * inv);
        w1.x = cvtpk(a.o1[4 * g] * inv, a.o1[4 * g + 1] * inv); w1.y = cvtpk(a.o1[4 * g + 2] * inv, a.o1[4 * g + 3] * inv);
        *(GAS u32x2*)(orow + 8 * g + 4 * hi) = w0; *(GAS u32x2*)(orow + 32 + 8 * g + 4 * hi) = w1;
    }
}
__device__ __forceinline__ void load_q(bf16x8 (&qf)[4], const bf16* qrow, int lane) {
    const int hi = lane >> 5;
#pragma unroll
    for (int ks = 0; ks < 4; ++ks) qf[ks] = *(const GAS bf16x8*)(qrow + 16 * ks + 8 * hi);
}

constexpr int CW_FOXQ = 64;
__device__ __forceinline__ void fox_phase(const InTab& in, unsigned char* ws, LAS unsigned char* lds, int G, int tid, int wave, int lane, bf16* obase, size_t opitch, int qword) {
    bf16* proj = (bf16*)(ws + WS_BIG + B_PROJ); const bf16* VtF = (const bf16*)(ws + WS_BIG + B_VTF);
    const float* Flocal = (const float*)(ws + WS_FL); const float* Btot = Flocal + S * 8;
    unsigned* qctr = (unsigned*)(ws + WS_CTL) + qword;
    LAS unsigned char* kvb = lds; LAS float* kbt = (LAS float*)(lds + 2 * KV_BUF_BYTES); LAS float* bt = (LAS float*)(lds + 2 * KV_BUF_BYTES + 65536); LAS float* Et = bt + 272;
    LAS int* misc = (LAS int*)(Et + 272);
    const int r32 = lane & 31, hi = lane >> 5;
    if (wave == 0) { const float gq = wave_max(fabsf(in.get(8)[lane])), gk = wave_max(fabsf(in.get(9)[lane])); if (lane == 0) { ((LAS float*)misc)[2] = gq; ((LAS float*)misc)[3] = gk; } }
    __syncthreads();
    const float THR = 2.0f * (0.125f * LOG2E * 64.0f * 1.02f) * ((LAS float*)misc)[2] * ((LAS float*)misc)[3] + 32.0f;
    for (;;) {
        __syncthreads();
        if (tid == 0) misc[0] = (int)atomicAdd(qctr, 1u);
        __syncthreads();
        const int u = misc[0];
        if (u >= 512) break;
        const int QB = 63 - (u >> 3), h = u & 7, q0 = QB * 256, nt = 4 * (QB + 1);
        for (int j = tid; j < nt; j += NTHREADS) bt[j] = Btot[j * 8 + h];
        if (tid == 0) misc[1] = 4 * QB;
        __syncthreads();
        for (int j = tid; j <= nt; j += NTHREADS) { float e = 0.f;
            if (j <= 4 * QB) { for (int i = 4 * QB - 1; i >= j; --i) e -= bt[i]; } else { for (int i = 4 * QB; i < j; ++i) e += bt[i]; }
            Et[j] = e; }
        __syncthreads();
        for (int j = tid; j < 4 * QB; j += NTHREADS) if (Et[j + 1] * LOG2E <= THR) atomicMin((int*)&misc[1], j);
        __syncthreads();
        const int t_start = misc[1], s0 = 64 * t_start;
        for (int s = s0 + tid; s < q0 + 256; s += NTHREADS) kbt[s - s0] = -(Et[s >> 6] + Flocal[(size_t)s * 8 + h]) * LOG2E;
        const int qrow = q0 + wave * 32 + r32;
        bf16x8 qf[4]; load_q(qf, proj + (size_t)qrow * EVEN_NP + EC_FQ + h * 64, lane);
        AttnAcc a; attn_init(a);
        const bf16* Kp = proj + EC_FK + h * 64; const bf16* Vtp = VtF + (size_t)h * 64 * S;
        KVRegs kr; kv_load(kr, Kp, EVEN_NP, Vtp, S, s0, tid); kv_store(kr, kvb, tid);
        __syncthreads();
        const float kbw = kbt[q0 + wave * 32 - s0];
        for (int t = t_start; t < nt; ++t) {
            LAS unsigned char* cur = kvb + ((t - t_start) & 1) * KV_BUF_BYTES;
            if (t + 1 < nt) kv_load(kr, Kp, EVEN_NP, Vtp, S, (t + 1) * 64, tid);
            const int key0 = t * 64;
            const bool vis = key0 <= q0 + wave * 32 + 31;
            const bool live = (key0 + 63 >= q0) || (kbw - kbt[key0 + 63 - s0] <= THR);
            if (vis && __builtin_amdgcn_readfirstlane((int)live)) {
                f32x16 p0, p1; attn_scores(p0, p1, cur, qf, lane);
#pragma unroll
                for (int g = 0; g < 4; ++g) {
                    const f32x4 b0 = *(const LAS f32x4*)(kbt + key0 - s0 + 8 * g + 4 * hi), b1 = *(const LAS f32x4*)(kbt + key0 - s0 + 32 + 8 * g + 4 * hi);
#pragma unroll
                    for (int e = 0; e < 4; ++e) { p0[4 * g + e] = p0[4 * g + e] * C2 + b0[e]; p1[4 * g + e] = p1[4 * g + e] * C2 + b1[e]; }
                }
                if (key0 + 63 > q0 + wave * 32) {
#pragma unroll
                    for (int r = 0; r < 16; ++r) { const int kv = key0 + crow(r, hi); if (kv > qrow) p0[r] = -INFINITY; if (kv + 32 > qrow) p1[r] = -INFINITY; }
                }
                attn_update(a, p0, p1, cur, lane);
            }
            if (t + 1 < nt) kv_store(kr, kvb + ((t + 1 - t_start) & 1) * KV_BUF_BYTES, tid);
            __syncthreads();
        }
        attn_store(a, obase + (size_t)qrow * opitch + h * 64, lane);
    }
}

__device__ __forceinline__ void memattn_phase(const InTab& in, unsigned char* ws, int L, LAS unsigned char* lds, int G, int tid, int wave, int lane) {
    const bf16* QM = (const bf16*)(ws + WS_BIG + B_QM); bf16* OM = (bf16*)(ws + WS_BIG + B_OM);
    const bf16* memK = (const bf16*)(ws + WS_MEMK) + (size_t)L * 256 * 256; const bf16* memVt = (const bf16*)(ws + WS_MEMK + 256 * 1024) + (size_t)L * 256 * 256;
    const float* qn = in.get(20) + (size_t)L * 64;
    LAS unsigned char* kvb = lds;
    const int r32 = lane & 31, hi = lane >> 5;
    for (int un = blockIdx.x; un < 256; un += G) {
        const int QB = un >> 2, hm = un & 3, qrow = QB * 256 + wave * 32 + r32;
        bf16x8 qf[4];
        {
            const bf16* qp = QM + (size_t)qrow * MEMW + hm * 64; float x[4][8]; float ss = 0.f;
#pragma unroll
            for (int ks = 0; ks < 4; ++ks) { const v4u w = *(const GAS v4u*)(qp + 16 * ks + 8 * hi); unpack8(w, x[ks]);
#pragma unroll
                for (int j = 0; j < 8; ++j) ss += x[ks][j] * x[ks][j]; }
            ss = sh32_sum(ss);
            const float r = rsqrtf(ss * (1.0f / 64.0f) + RMS_EPS);
#pragma unroll
            for (int ks = 0; ks < 4; ++ks) {
#pragma unroll
                for (int j = 0; j < 8; ++j) x[ks][j] = x[ks][j] * r * qn[16 * ks + 8 * hi + j];
                qf[ks] = __builtin_bit_cast(bf16x8, pack8(x[ks])); }
        }
        AttnAcc a; attn_init(a);
        const bf16* Kp = memK + hm * 64; const bf16* Vtp = memVt + (size_t)hm * 64 * 256;
        __syncthreads();
        KVRegs kr; kv_load(kr, Kp, 256, Vtp, 256, 0, tid); kv_store(kr, kvb, tid);
        __syncthreads();
        for (int t = 0; t < 4; ++t) {
            LAS unsigned char* cur = kvb + (t & 1) * KV_BUF_BYTES;
            if (t + 1 < 4) kv_load(kr, Kp, 256, Vtp, 256, (t + 1) * 64, tid);
            f32x16 p0, p1; attn_scores(p0, p1, cur, qf, lane);
#pragma unroll
            for (int r = 0; r < 16; ++r) { p0[r] *= C2; p1[r] *= C2; }
            attn_update(a, p0, p1, cur, lane);
            if (t + 1 < 4) kv_store(kr, kvb + ((t + 1) & 1) * KV_BUF_BYTES, tid);
            __syncthreads();
        }
        attn_store(a, OM + (size_t)qrow * MEMW + hm * 64, lane);
    }
}

constexpr size_t WS_MSEL = 7 * MiB;
constexpr size_t WS_MLSE = 8 * MiB;
constexpr size_t B_OP0 = 64 * MiB, B_OP1 = 128 * MiB;
__device__ __forceinline__ bool gate_better(float g1, int n1, float g2, int n2) { return g1 > g2 || (g1 == g2 && n1 < n2); }
__device__ __forceinline__ void moba_gate_phase(unsigned char* ws, int G, int wave, int lane) {
    const bf16* Q = (const bf16*)(ws + WS_BIG + B_PROJ); const float* ksum = (const float*)(ws + WS_KSUM); unsigned* selg = (unsigned*)(ws + WS_MSEL);
    const int r32 = lane & 31, hi = lane >> 5;
    const int NW = G * NWAVES;
    const int gwid = (int)blockIdx.x * NWAVES + wave;
    const int per_head = NW / 16;
    if (per_head == 0) return;
    const int h = gwid / per_head, wi = gwid % per_head;
    if (h >= 16) return;
    float af[2][32];
#pragma unroll
    for (int g = 0; g < 2; ++g)
#pragma unroll
        for (int kk = 0; kk < 32; ++kk) af[g][kk] = ksum[(size_t)(32 * g + r32) * 1024 + h * 64 + 2 * kk + hi] * (1.0f / 256.0f);
    for (int tile = wi; tile < S / 32; tile += per_head) {
        const int t = tile * 32 + r32, own = (tile * 32) >> 8;
        float bq[32];
        { const bf16* qp = Q + (size_t)t * DM + h * 64;
#pragma unroll
          for (int c = 0; c < 8; ++c) { const unsigned sh = hi ? 0u : 16u;   const v4u w = *(const GAS v4u*)(qp + 8 * c);
              bq[4 * c + 0] = __uint_as_float((w.x << sh) & 0xffff0000u); bq[4 * c + 1] = __uint_as_float((w.y << sh) & 0xffff0000u);
              bq[4 * c + 2] = __uint_as_float((w.z << sh) & 0xffff0000u); bq[4 * c + 3] = __uint_as_float((w.w << sh) & 0xffff0000u); } }
        float g0 = -INFINITY, g1 = -INFINITY, g2 = -INFINITY; int n0 = 255, n1 = 255, n2 = 255;
#pragma unroll
        for (int g = 0; g < 2; ++g) {
            if (32 * g < own) {
                f32x16 c;
#pragma unroll
                for (int r = 0; r < 16; ++r) c[r] = 0.f;
#pragma unroll
                for (int kk = 0; kk < 32; ++kk) c = __builtin_amdgcn_mfma_f32_32x32x2f32(af[g][kk], bq[kk], c, 0, 0, 0);
#pragma unroll
                for (int r = 0; r < 16; ++r) { const int n = 32 * g + crow(r, hi); const float gv = (n < own) ? c[r] : -INFINITY;
                    if (n < own) {
                        if (gate_better(gv, n, g0, n0)) { g2 = g1; n2 = n1; g1 = g0; n1 = n0; g0 = gv; n0 = n; }
                        else if (gate_better(gv, n, g1, n1)) { g2 = g1; n2 = n1; g1 = gv; n1 = n; }
                        else if (gate_better(gv, n, g2, n2)) { g2 = gv; n2 = n; } } }
            }
        }
        const float p0 = sh32_get(g0, lane), p1 = sh32_get(g1, lane), p2 = sh32_get(g2, lane);
        const int pn0 = __float_as_int(sh32_get(__int_as_float(n0), lane)), pn1 = __float_as_int(sh32_get(__int_as_float(n1), lane)), pn2 = __float_as_int(sh32_get(__int_as_float(n2), lane));
        float fg[3]; int fn[3]; int ia = 0, ib = 0;
#pragma unroll
        for (int k = 0; k < 3; ++k) {
            const float ga = (ia == 0) ? g0 : (ia == 1) ? g1 : (ia == 2) ? g2 : -INFINITY; const int na = (ia == 0) ? n0 : (ia == 1) ? n1 : (ia == 2) ? n2 : 255;
            const float gb = (ib == 0) ? p0 : (ib == 1) ? p1 : (ib == 2) ? p2 : -INFINITY; const int nb = (ib == 0) ? pn0 : (ib == 1) ? pn1 : (ib == 2) ? pn2 : 255;
            const bool ta = (na != 255) && (nb == 255 || gate_better(ga, na, gb, nb));
            if (ta) { fg[k] = ga; fn[k] = na; ++ia; } else { fg[k] = gb; fn[k] = nb; ++ib; }
        }
        (void)fg;
        if (hi == 0) selg[(size_t)h * S + t] = (unsigned)(fn[0] & 255) | ((unsigned)(fn[1] & 255) << 8) | ((unsigned)(fn[2] & 255) << 16);
    }
}
constexpr int MR_KIMG = 32768, MR_VTP = 520, MR_VIMG = 64 * MR_VTP;
constexpr int CW_MOBAQ = 192;
__device__ __forceinline__ void moba_route_phase(unsigned char* ws, LAS unsigned char* lds, int G, int tid, int wave, int lane, int qword) {
    const bf16* Q = (const bf16*)(ws + WS_BIG + B_PROJ); const bf16* Kb = Q + (size_t)S * DM; const bf16* Vt = (const bf16*)(ws + WS_BIG + B_VTM);
    const unsigned* selg = (const unsigned*)(ws + WS_MSEL); float* lse = (float*)(ws + WS_MLSE);
    unsigned* qctr = (unsigned*)(ws + WS_CTL) + qword;
    LAS unsigned char* kimg = lds; LAS unsigned char* vimg = lds + MR_KIMG;
    LAS int* list = (LAS int*)(lds + MR_KIMG + MR_VIMG);
    LAS int* wtot = list + 4096;
    LAS int* ubox = wtot + 64;
    const int r32 = lane & 31, hi = lane >> 5;
    const int NUNITS = 16 * 156;
    for (;;) {
        __syncthreads();
        if (tid == 0) ubox[0] = (int)atomicAdd(qctr, 1u);
        __syncthreads();
        const int u = ubox[0];
        if (u >= NUNITS) break;
        int c = 0, rem = u;
        while (rem >= 16 * min(63, 16 * c + 15)) { rem -= 16 * min(63, 16 * c + 15); ++c; }
        const int n = rem >> 4, h = rem & 15;
        const int tlo = max(4096 * c, 256 * (n + 1));
        v4u kst[4], vst[4];
        { const bf16* Kp = Kb + (size_t)(256 * n) * DM + h * 64; const bf16* Vp = Vt + (size_t)h * 64 * S + 256 * n;
#pragma unroll
          for (int i = 0; i < 4; ++i) { const int piece = tid + 512 * i;
              kst[i] = *(const GAS v4u*)(Kp + (size_t)(piece >> 3) * DM + (piece & 7) * 8);
              vst[i] = *(const GAS v4u*)(Vp + (size_t)(piece >> 5) * S + (piece & 31) * 8); } }
        int myent[8]; bool mysel[8];
#pragma unroll
        for (int i = 0; i < 8; ++i) { const int t = 4096 * c + 512 * i + tid; mysel[i] = false; myent[i] = 0;
            if (t >= tlo) { const unsigned w = selg[(size_t)h * S + t];
                const int slot = ((w & 255u) == (unsigned)n) ? 0 : (((w >> 8) & 255u) == (unsigned)n) ? 1 : (((w >> 16) & 255u) == (unsigned)n) ? 2 : -1;
                if (slot >= 0) { mysel[i] = true; myent[i] = t | (slot << 16); } }
            const unsigned long long mk = __ballot(mysel[i]);
            if (lane == 0) wtot[i * 8 + wave] = __popcll(mk); }
        __syncthreads();
        int cnt = 0;
#pragma unroll
        for (int i = 0; i < 8; ++i) { int base = cnt;
#pragma unroll
            for (int w8 = 0; w8 < 8; ++w8) { const int v = wtot[i * 8 + w8]; if (w8 < wave) base += v; cnt += v; }
            const unsigned long long mk = __ballot(mysel[i]);
            if (mysel[i]) list[base + __popcll(mk & ((1ull << lane) - 1ull))] = myent[i]; }
#pragma unroll
        for (int i = 0; i < 4; ++i) { const int piece = tid + 512 * i;
            *(LAS v4u*)(kimg + ((piece & 7) * 256 + (piece >> 3)) * 16) = kst[i];
            LAS unsigned char* vp = vimg + (piece >> 5) * MR_VTP + (piece & 31) * 16;
            *(LAS u32x2*)vp = (u32x2){vst[i].x, vst[i].y}; *(LAS u32x2*)(vp + 8) = (u32x2){vst[i].z, vst[i].w}; }
        __syncthreads();
        if (cnt == 0) continue;
        const int ntile = (cnt + 31) >> 5;
        for (int ti = wave; ti < ntile; ti += NWAVES) {
            const int e = ti * 32 + r32; const bool live = e < cnt;
            const int ent = list[live ? e : 0]; const int t = ent & 0xffff, slot = ent >> 16;
            bf16x8 qf[4]; load_q(qf, Q + (size_t)t * DM + h * 64, lane);
            AttnAcc a; attn_init(a);
#pragma unroll 1
            for (int j = 0; j < 4; ++j) {
                f32x16 p0, p1; attn_scores<4096>(p0, p1, kimg + j * 64 * 16, qf, lane);
#pragma unroll
                for (int r = 0; r < 16; ++r) { p0[r] *= C2; p1[r] *= C2; }
                attn_update<MR_VTP, 0>(a, p0, p1, vimg + j * 128, lane);
            }
            const float l = sh32_sum(a.l); const float inv = 1.0f / l;
            if (live) {
                bf16* orow = (bf16*)(ws + (slot == 0 ? WS_BIG + B_OP0 : slot == 1 ? WS_BIG + B_OP1 : WS_HB)) + ((size_t)t * 16 + h) * 64;
#pragma unroll
                for (int g = 0; g < 4; ++g) { u32x2 w0, w1;
                    w0.x = cvtpk(a.o0[4 * g] * inv, a.o0[4 * g + 1] * inv); w0.y = cvtpk(a.o0[4 * g + 2] * inv, a.o0[4 * g + 3] * inv);
                    w1.x = cvtpk(a.o1[4 * g] * inv, a.o1[4 * g + 1] * inv); w1.y = cvtpk(a.o1[4 * g + 2] * inv, a.o1[4 * g + 3] * inv);
                    *(GAS u32x2*)(orow + 8 * g + 4 * hi) = w0; *(GAS u32x2*)(orow + 32 + 8 * g + 4 * hi) = w1; }
                if (hi == 0) lse[((size_t)slot * S + t) * 16 + h] = a.m + __builtin_amdgcn_logf(l);
            }
        }
    }
}
__device__ __forceinline__ void moba_own_phase(unsigned char* ws, LAS unsigned char* lds, int G, int tid, int wave, int lane, bf16* obase, size_t opitch) {
    bf16* Q = (bf16*)(ws + WS_BIG + B_PROJ); const bf16* Kb = Q + (size_t)S * DM; const bf16* Vt = (const bf16*)(ws + WS_BIG + B_VTM);
    const unsigned* selg = (const unsigned*)(ws + WS_MSEL); const float* lse = (const float*)(ws + WS_MLSE);
    LAS unsigned char* kvb = lds;
    const int r32 = lane & 31, hi = lane >> 5;
    for (int un = blockIdx.x; un < 1024; un += G) {
        const int h = un & 15, QB = un >> 4, q0 = QB * 256, qrow = q0 + wave * 32 + r32;
        bf16x8 qf[4]; load_q(qf, Q + (size_t)qrow * DM + h * 64, lane);
        AttnAcc a; attn_init(a);
        const bf16* Kp = Kb + h * 64; const bf16* Vtp = Vt + (size_t)h * 64 * S;
        __syncthreads();
        KVRegs kr; kv_load(kr, Kp, DM, Vtp, S, q0, tid); kv_store(kr, kvb, tid);
        __syncthreads();
        for (int t = 0; t < 4; ++t) {
            LAS unsigned char* cur = kvb + (t & 1) * KV_BUF_BYTES;
            const int key0 = q0 + t * 64;
            if (t + 1 < 4) kv_load(kr, Kp, DM, Vtp, S, key0 + 64, tid);
            if (key0 <= q0 + wave * 32 + 31) {
                f32x16 p0, p1; attn_scores(p0, p1, cur, qf, lane);
#pragma unroll
                for (int r = 0; r < 16; ++r) { const int kv = key0 + crow(r, hi); p0[r] = (kv > qrow) ? -INFINITY : p0[r] * C2; p1[r] = (kv + 32 > qrow) ? -INFINITY : p1[r] * C2; }
                attn_update(a, p0, p1, cur, lane);
            }
            if (t + 1 < 4) kv_store(kr, kvb + ((t + 1) & 1) * KV_BUF_BYTES, tid);
            __syncthreads();
        }
        const unsigned sw = selg[(size_t)h * S + qrow];
        float L[3];
#pragma unroll
        for (int j = 0; j < 3; ++j) L[j] = (((sw >> (8 * j)) & 255u) != 255u) ? lse[((size_t)j * S + qrow) * 16 + h] : -INFINITY;
        const float M = fmaxf(fmaxf(a.m, L[0]), fmaxf(L[1], L[2]));
        const float so = __builtin_amdgcn_exp2f(a.m - M);
        float W = sh32_sum(a.l) * so;
#pragma unroll
        for (int r = 0; r < 16; ++r) { a.o0[r] *= so; a.o1[r] *= so; }
#pragma unroll
        for (int j = 0; j < 3; ++j) {
            if (L[j] != -INFINITY) {
                const float wj = __builtin_amdgcn_exp2f(L[j] - M); W += wj;
                const bf16* orow = (const bf16*)(ws + (j == 0 ? WS_BIG + B_OP0 : j == 1 ? WS_BIG + B_OP1 : WS_HB)) + ((size_t)qrow * 16 + h) * 64;
#pragma unroll
                for (int g = 0; g < 4; ++g) { const u32x2 w0 = *(const GAS u32x2*)(orow + 8 * g + 4 * hi), w1 = *(const GAS u32x2*)(orow + 32 + 8 * g + 4 * hi);
                    a.o0[4 * g] += wj * bflo(w0.x); a.o0[4 * g + 1] += wj * bfhi(w0.x); a.o0[4 * g + 2] += wj * bflo(w0.y); a.o0[4 * g + 3] += wj * bfhi(w0.y);
                    a.o1[4 * g] += wj * bflo(w1.x); a.o1[4 * g + 1] += wj * bfhi(w1.x); a.o1[4 * g + 2] += wj * bflo(w1.y); a.o1[4 * g + 3] += wj * bfhi(w1.y); }
            }
        }
        const float inv = 1.0f / W;
        bf16* orow = obase + (size_t)qrow * opitch + h * 64;
#pragma unroll
        for (int g = 0; g < 4; ++g) { u32x2 w0, w1;
            w0.x = cvtpk(a.o0[4 * g] * inv, a.o0[4 * g + 1] * inv); w0.y = cvtpk(a.o0[4 * g + 2] * inv, a.o0[4 * g + 3] * inv);
            w1.x = cvtpk(a.o1[4 * g] * inv, a.o1[4 * g + 1] * inv); w1.y = cvtpk(a.o1[4 * g + 2] * inv, a.o1[4 * g + 3] * inv);
            *(GAS u32x2*)(orow + 8 * g + 4 * hi) = w0; *(GAS u32x2*)(orow + 32 + 8 * g + 4 * hi) = w1; }
    }
}

typedef float f32x4v __attribute__((ext_vector_type(4)));
__device__ __forceinline__ unsigned mono_key(float s) { if (s == 0.f) s = 0.f; const unsigned u = __float_as_uint(s); return (u & 0x80000000u) ? ~u : (u | 0x80000000u); }
constexpr int DS_CAP = 512;
__device__ __forceinline__ unsigned wave_or(unsigned v) { v |= (unsigned)shx_i<1>((int)v); v |= (unsigned)shx_i<2>((int)v); v |= (unsigned)shx_i<4>((int)v); v |= (unsigned)shx_i<8>((int)v); v |= (unsigned)shx_i<16>((int)v);
    auto r = __builtin_amdgcn_permlane32_swap(v, v, false, false); return r[0] | r[1]; }
template <bool EXACT>
__device__ __forceinline__ unsigned dsa_compact(LAS u32x2* ent, int n, int& nkeep, int lane) {
    unsigned k[8]; unsigned ix[8]; unsigned orv = 0u, nandv = 0u;
#pragma unroll
    for (int j = 0; j < 8; ++j) { const int e = lane + 64 * j; const bool in = e < n; const u32x2 v = ent[in ? e : 0]; k[j] = in ? v.x : 0u; ix[j] = v.y; orv |= k[j]; nandv |= in ? ~v.x : 0u; }
    unsigned T = 0u; int cntT = n; int bit0 = 31;
    if (!EXACT) {
        const unsigned diff = (unsigned)__builtin_amdgcn_readfirstlane((int)(wave_or(orv) & wave_or(nandv)));
        if (diff != 0u) { bit0 = 31 - __builtin_clz(diff); const unsigned anyk = (unsigned)__builtin_amdgcn_readfirstlane((int)k[0]);
            T = (bit0 == 31) ? 0u : (anyk & ~((2u << bit0) - 1u)); }
    }
    for (int bit = bit0; bit >= 0; --bit) {
        const unsigned cand = T | (1u << bit); int c = 0;
#pragma unroll
        for (int j = 0; j < 8; ++j) c += __popcll(__ballot(k[j] >= cand));
        if (c >= 256) { T = cand; cntT = c; if (!EXACT && c <= 320) break; }
    }
    int Jstar = 0x10000;
    if (cntT > (EXACT ? 256 : 320)) {
        int gt = 0;
#pragma unroll
        for (int j = 0; j < 8; ++j) gt += __popcll(__ballot(k[j] > T));
        const int need = 256 - gt; int Jm = 0;
        for (int bit = 14; bit >= 0; --bit) { const int cand = Jm | (1 << bit); int c = 0;
#pragma unroll
            for (int j = 0; j < 8; ++j) c += __popcll(__ballot(k[j] == T && (int)ix[j] < cand));
            if (c < need) Jm = cand; }
        Jstar = Jm + 1;
    }
    int base = 0;
    const unsigned long long lt = (1ull << lane) - 1ull;
#pragma unroll
    for (int j = 0; j < 8; ++j) { const bool pred = (k[j] > T) || (k[j] == T && T != 0u && (int)ix[j] < Jstar);
        const unsigned long long mask = __ballot(pred); const int pos = base + __popcll(mask & lt);
        if (pred) ent[pos] = (u32x2){k[j], ix[j]};
        base += __popcll(mask); }
    nkeep = base;
    return T;
}
#define DSA_HEADSUM(s, P, B, W) asm("v_max_f32_e32 %1, 0, %2\n\tv_mul_f32_e32 %0, %10, %1\n\tv_max_f32_e32 %1, 0, %3\n\tv_fmac_f32_e32 %0, %11, %1\n\tv_max_f32_e32 %1, 0, %4\n\tv_fmac_f32_e32 %0, %12, %1\n\t" \
        "v_max_f32_e32 %1, 0, %5\n\tv_fmac_f32_e32 %0, %13, %1\n\tv_max_f32_e32 %1, 0, %6\n\tv_fmac_f32_e32 %0, %14, %1\n\tv_max_f32_e32 %1, 0, %7\n\tv_fmac_f32_e32 %0, %15, %1\n\t" \
        "v_max_f32_e32 %1, 0, %8\n\tv_fmac_f32_e32 %0, %16, %1\n\tv_max_f32_e32 %1, 0, %9\n\tv_fmac_f32_e32 %0, %17, %1" \
        : "=&v"(s), "=&v"(tmp_) : "v"(P[B + 0]), "v"(P[B + 1]), "v"(P[B + 2]), "v"(P[B + 3]), "v"(P[B + 4]), "v"(P[B + 5]), "v"(P[B + 6]), "v"(P[B + 7]), \
          "v"(W[0]), "v"(W[1]), "v"(W[2]), "v"(W[3]), "v"(W[4]), "v"(W[5]), "v"(W[6]), "v"(W[7]))
__device__ __forceinline__ float unmono_f(unsigned u) { return __uint_as_float((u & 0x80000000u) ? (u ^ 0x80000000u) : ~u); }
struct DsaState { float tf0, tf1; int cnt0, cnt1; };
template <bool NOCOMPACT = false>
__device__ __forceinline__ void dsa_tile(const bf16x8 (&af)[4], const bf16x8 (&bc)[4], const float (&w0)[8], const float (&w1)[8], int key0, int q0t, int q1t, DsaState& st,
                                         LAS u32x2* ents, int lane) {
    const int r32 = lane & 31, hi = lane >> 5;
    f32x16 p;
#pragma unroll
    for (int r = 0; r < 16; ++r) p[r] = 0.f;
#pragma unroll
    for (int ks = 0; ks < 4; ++ks) p = __builtin_amdgcn_mfma_f32_32x32x16_bf16(af[ks], bc[ks], p, 0, 0, 0);
    asm volatile("s_nop 15\n\ts_nop 7" : "+v"(p));
    float s0, s1, tmp_;
    DSA_HEADSUM(s0, p, 0, w0); DSA_HEADSUM(s1, p, 8, w1);
    const int key = key0 + r32;
    const bool pr0 = (key <= q0t) && (s0 >= st.tf0), pr1 = (key <= q1t) && (s1 >= st.tf1);
    const unsigned long long m0 = __ballot(pr0), m1 = __ballot(pr1);
    if (m0 | m1) {
        const unsigned h0 = hi ? (unsigned)(m0 >> 32) : (unsigned)m0, h1 = hi ? (unsigned)(m1 >> 32) : (unsigned)m1;
        const unsigned lowmask = (1u << r32) - 1u;
        if (pr0) ents[hi * DS_CAP + st.cnt0 + __popc(h0 & lowmask)] = (u32x2){mono_key(s0), (unsigned)key};
        if (pr1) ents[(2 + hi) * DS_CAP + st.cnt1 + __popc(h1 & lowmask)] = (u32x2){mono_key(s1), (unsigned)key};
        st.cnt0 += __popc(h0); st.cnt1 += __popc(h1);
        const unsigned long long need = __ballot(max(st.cnt0, st.cnt1) > DS_CAP - 32);
        if (need) {
#pragma unroll 1
            for (int hh = 0; hh < 2; ++hh) {
                const int c0 = __builtin_amdgcn_readlane(st.cnt0, 0), c0b = __builtin_amdgcn_readlane(st.cnt0, 32);
                const int c1 = __builtin_amdgcn_readlane(st.cnt1, 0), c1b = __builtin_amdgcn_readlane(st.cnt1, 32);
                const int n0 = hh ? c0b : c0, n1 = hh ? c1b : c1;
                if (NOCOMPACT) { if (n0 > DS_CAP - 32 && hi == hh) st.cnt0 = 256; if (n1 > DS_CAP - 32 && hi == hh) st.cnt1 = 256; continue; }
                if (n0 > DS_CAP - 32) { int nk; const unsigned T = dsa_compact<false>(ents + hh * DS_CAP, n0, nk, lane); if (hi == hh) { st.tf0 = unmono_f(T + 1u); st.cnt0 = nk; } }
                if (n1 > DS_CAP - 32) { int nk; const unsigned T = dsa_compact<false>(ents + (2 + hh) * DS_CAP, n1, nk, lane); if (hi == hh) { st.tf1 = unmono_f(T + 1u); st.cnt1 = nk; } }
            }
        }
    }
}
template <bool NOCOMPACT = false>
__device__ __forceinline__ void dsa_select_phase(unsigned char* ws, LAS unsigned char* lds, int G, int tid, int wave, int lane) {
    const bf16* proj = (const bf16*)(ws + WS_BIG + B_PROJ); const bf16* IKc = (const bf16*)(ws + WS_BIG + B_IKC); const float* IW = (const float*)(ws + WS_IW);
    unsigned short* selg = (unsigned short*)(ws + WS_BIG + B_SEL);
    LAS u32x2* ents = (LAS u32x2*)lds + wave * 4 * DS_CAP;
    const int r32 = lane & 31, hi = lane >> 5;
    const int NWG = G * NWAVES, gw = (int)blockIdx.x * NWAVES + wave;
    for (int pu = gw; pu < 2048; pu += NWG) {
        for (int uu = 0; uu < 2; ++uu) {
            const int unit = uu ? 4095 - pu : pu, tw = unit * 4;
            bf16x8 af[4];
            { const int i = r32, qi = 2 * (i >> 4) + ((i >> 2) & 1), hd = 4 * ((i >> 3) & 1) + (i & 3);
              const bf16* ap = proj + (size_t)(tw + qi) * EVEN_NP + EC_IQ + hd * 64 + 8 * hi;
#pragma unroll
              for (int ks = 0; ks < 4; ++ks) af[ks] = *(const GAS bf16x8*)(ap + 16 * ks); }
            float w0[8], w1[8];
            { const f32x4 a = *(const GAS f32x4*)(IW + (size_t)(tw + hi) * 8), b = *(const GAS f32x4*)(IW + (size_t)(tw + hi) * 8 + 4);
              const f32x4 c = *(const GAS f32x4*)(IW + (size_t)(tw + 2 + hi) * 8), d = *(const GAS f32x4*)(IW + (size_t)(tw + 2 + hi) * 8 + 4);
#pragma unroll
              for (int j = 0; j < 4; ++j) { w0[j] = a[j]; w0[4 + j] = b[j]; w1[j] = c[j]; w1[4 + j] = d[j]; } }
            const int q0t = tw + hi, q1t = tw + 2 + hi;
            DsaState st; st.tf0 = -INFINITY; st.tf1 = -INFINITY; st.cnt0 = 0; st.cnt1 = 0;
            const int ntile = ((tw + 3) >> 5) + 1;
            const bf16* kp = IKc + (size_t)lane * 8; asm volatile("" : "+v"(kp));
            bf16x8 bA[4], bB[4], bC[4];
#define DSA_LOADB(dst, jj) do { const bf16* p_ = kp + (size_t)(jj) * 2048; \
                asm volatile("global_load_dwordx4 %0, %4, off\n\tglobal_load_dwordx4 %1, %4, off offset:1024\n\tglobal_load_dwordx4 %2, %4, off offset:2048\n\tglobal_load_dwordx4 %3, %4, off offset:3072" \
                             : "=&v"(dst[0]), "=&v"(dst[1]), "=&v"(dst[2]), "=&v"(dst[3]) : "v"(p_) : "memory"); } while (0)
#define DSA_WAITB(dst, n) asm volatile("s_waitcnt vmcnt(" #n ")" : "+v"(dst[0]), "+v"(dst[1]), "+v"(dst[2]), "+v"(dst[3]) :: "memory")
            asm volatile("" : "+v"(af[0]), "+v"(af[1]), "+v"(af[2]), "+v"(af[3]));
#pragma unroll
            for (int r = 0; r < 8; ++r) asm volatile("" : "+v"(w0[r]), "+v"(w1[r]));
            DSA_LOADB(bA, 0); DSA_LOADB(bB, min(1, ntile - 1));
#pragma unroll 1
            for (int j = 0; j < ntile; j += 3) {
                DSA_LOADB(bC, min(j + 2, ntile - 1));
                DSA_WAITB(bA, 8);
                dsa_tile<NOCOMPACT>(af, bA, w0, w1, 32 * j, q0t, q1t, st, ents, lane);
                DSA_LOADB(bA, min(j + 3, ntile - 1));
                DSA_WAITB(bB, 8);
                if (j + 1 < ntile) dsa_tile<NOCOMPACT>(af, bB, w0, w1, 32 * (j + 1), q0t, q1t, st, ents, lane);
                DSA_LOADB(bB, min(j + 4, ntile - 1));
                DSA_WAITB(bC, 8);
                if (j + 2 < ntile) dsa_tile<NOCOMPACT>(af, bC, w0, w1, 32 * (j + 2), q0t, q1t, st, ents, lane);
            }
            DSA_WAITB(bA, 0);
#undef DSA_LOADB
#undef DSA_WAITB
            const int cnt0 = st.cnt0, cnt1 = st.cnt1;
#pragma unroll 1
            for (int qq = 0; qq < 4; ++qq) {
                const int hh = qq & 1, sl = qq >> 1;
                int n = sl ? __builtin_amdgcn_readlane(cnt1, 32 * hh) : __builtin_amdgcn_readlane(cnt0, 32 * hh);
                LAS u32x2* ee = ents + qq * DS_CAP;
                if (n > 256) { int nk = 256; if (!NOCOMPACT) (void)dsa_compact<true>(ee, n, nk, lane); n = 256; }
                unsigned short* row = selg + (size_t)(tw + qq) * 256;
#pragma unroll
                for (int e4 = 0; e4 < 4; ++e4) { const int e = lane + 64 * e4; row[e] = (e < n) ? (unsigned short)ee[e].y : (unsigned short)0xFFFFu; }
            }
        }
    }
}

typedef __bf16 bf16x2v __attribute__((ext_vector_type(2)));
__device__ __forceinline__ float dot2bf(unsigned a, unsigned b, float acc) { return __builtin_amdgcn_fdot2_f32_bf16(__builtin_bit_cast(bf16x2v, a), __builtin_bit_cast(bf16x2v, b), acc, false); }
#define SP_IDX(i) (((i) & 1) ? (iw[(i) >> 3][((i) >> 1) & 3] >> 16) : (iw[(i) >> 3][((i) >> 1) & 3] & 0xffffu))
__device__ __forceinline__ void dsa_sparse_phase(unsigned char* ws, int G, int wave, int lane, bf16* obase, size_t opitch) {
    const bf16* proj = (const bf16*)(ws + WS_BIG + B_PROJ); const unsigned short* selg = (const unsigned short*)(ws + WS_BIG + B_SEL);
    const int h = (int)blockIdx.x & 7, wg = (int)blockIdx.x >> 3, nwg = G >> 3;
    const int kg = lane >> 3, ds8 = (lane & 7) * 8;
    const bf16* kbase = proj + EC_DK + h * 64 + ds8; const bf16* vbase = proj + EC_DV + h * 64 + ds8;
    for (int t = wg * NWAVES + wave; t < S; t += nwg * NWAVES) {
        v4u iw[4];
#pragma unroll
        for (int c = 0; c < 4; ++c) iw[c] = *(const GAS v4u*)(selg + (size_t)t * 256 + 32 * kg + 8 * c);
        const v4u qw = *(const GAS v4u*)(proj + (size_t)t * EVEN_NP + EC_DQ + h * 64 + ds8);
        float sc[32];
        v4u ka[8], kb[8];
#define SP_LOAD(dst, base, i0) _Pragma("unroll") for (int j = 0; j < 8; ++j) { const unsigned wd = SP_IDX((i0) + j); const unsigned idx = (wd == 0xffffu) ? 0u : wd; dst[j] = *(const GAS v4u*)(base + (size_t)idx * EVEN_NP); }
#define SP_QK(src, i0) _Pragma("unroll") for (int j = 0; j < 8; ++j) { const unsigned wd = SP_IDX((i0) + j); \
            float d = dot2bf(qw.x, src[j].x, 0.f); d = dot2bf(qw.y, src[j].y, d); d = dot2bf(qw.z, src[j].z, d); d = dot2bf(qw.w, src[j].w, d); \
            d += shx<1>(d); d += shx<2>(d); d += shx<4>(d); sc[(i0) + j] = (wd == 0xffffu) ? -INFINITY : d * C2; }
        SP_LOAD(ka, kbase, 0); SP_LOAD(kb, kbase, 8);
        SP_QK(ka, 0);  SP_LOAD(ka, kbase, 16);
        SP_QK(kb, 8);  SP_LOAD(kb, kbase, 24);
        SP_QK(ka, 16); SP_LOAD(ka, vbase, 0);
        SP_QK(kb, 24); SP_LOAD(kb, vbase, 8);
        float mx = sc[0];
#pragma unroll
        for (int i = 1; i < 32; ++i) mx = fmaxf(mx, sc[i]);
        mx = fmaxf(mx, shx<8>(mx)); mx = fmaxf(mx, shx<16>(mx)); mx = sh32_max(mx);
        float l = 0.f;
#pragma unroll
        for (int i = 0; i < 32; ++i) { sc[i] = __builtin_amdgcn_exp2f(sc[i] - mx); l += sc[i]; }
        l += shx<8>(l); l += shx<16>(l); l = sh32_sum(l);
        float acc[8];
#pragma unroll
        for (int e = 0; e < 8; ++e) acc[e] = 0.f;
#define SP_PV(src, i0) _Pragma("unroll") for (int j = 0; j < 8; j += 2) { const unsigned pp = cvtpk(sc[(i0) + j], sc[(i0) + j + 1]); const v4u a = src[j], b = src[j + 1]; \
            acc[0] = dot2bf(pp, __builtin_amdgcn_perm(b.x, a.x, 0x05040100u), acc[0]); acc[1] = dot2bf(pp, __builtin_amdgcn_perm(b.x, a.x, 0x07060302u), acc[1]); \
            acc[2] = dot2bf(pp, __builtin_amdgcn_perm(b.y, a.y, 0x05040100u), acc[2]); acc[3] = dot2bf(pp, __builtin_amdgcn_perm(b.y, a.y, 0x07060302u), acc[3]); \
            acc[4] = dot2bf(pp, __builtin_amdgcn_perm(b.z, a.z, 0x05040100u), acc[4]); acc[5] = dot2bf(pp, __builtin_amdgcn_perm(b.z, a.z, 0x07060302u), acc[5]); \
            acc[6] = dot2bf(pp, __builtin_amdgcn_perm(b.w, a.w, 0x05040100u), acc[6]); acc[7] = dot2bf(pp, __builtin_amdgcn_perm(b.w, a.w, 0x07060302u), acc[7]); }
        SP_PV(ka, 0);  SP_LOAD(ka, vbase, 16);
        SP_PV(kb, 8);  SP_LOAD(kb, vbase, 24);
        SP_PV(ka, 16);
        SP_PV(kb, 24);
#undef SP_LOAD
#undef SP_QK
#undef SP_PV
        const float inv = 1.0f / l;
#pragma unroll
        for (int e = 0; e < 8; ++e) { float a = acc[e]; a += shx<8>(a); a += shx<16>(a); a = sh32_sum(a); acc[e] = a * inv; }
        if (kg == 0) *(GAS v4u*)(obase + (size_t)t * opitch + h * 64 + ds8) = pack8(acc);
    }
}
#undef SP_IDX

struct Args { InPtrs in; float* out; unsigned char* ws; int ph_lo, ph_hi, li, pad; };
constexpr int PH_PER_LAYER = 13, N_PHASES = 1 + 2 * PH_PER_LAYER;

__global__ void __launch_bounds__(NTHREADS, 2) hyb_fwd(Args args) {
    extern __shared__ __attribute__((aligned(16))) unsigned char lds_raw[];
    LAS unsigned char* lds = (LAS unsigned char*)lds_raw;
    volatile LAS unsigned* MISC = (volatile LAS unsigned*)(lds + MISC_OFF);
    const int tid = threadIdx.x, lane = tid & 63, wave = __builtin_amdgcn_readfirstlane(tid >> 6);
    const int G = gridDim.x;
    const int vcu = (G % 8 == 0) ? ((int)blockIdx.x % 8) * (G / 8) + (int)blockIdx.x / 8 : (int)blockIdx.x;
    unsigned char* ws = args.ws;
    gu32* ctl = (gu32*)(ws + WS_CTL);
    for (int u = tid; u < (LDS_BYTES - LDSCTL_OFF) / 4; u += NTHREADS) ((LAS unsigned*)(lds + LDSCTL_OFF))[u] = 0u;
    __syncthreads();
    if (tid == 0) {
#pragma unroll
        for (int i = 0; i < 26; ++i) *(LAS unsigned long long*)(lds + INTAB_OFF + 8 * i) = (unsigned long long)args.in.p[i]; }
    __syncthreads();
    XcdBarrier bar = xcd_barrier_post((unsigned*)(ctl + CW_BAR) + args.li * XCD_BAR_WORDS, MISC + 8);
    const int tid0 = tid; unsigned char* const ws0 = ws;
    for (int ph = args.ph_lo; ph < args.ph_hi; ++ph) {
        int tid = tid0; asm volatile("" : "+v"(tid));
        unsigned char* ws = ws0; asm volatile("" : "+s"(ws));
        const int lane = tid & 63, wave = __builtin_amdgcn_readfirstlane(tid >> 6);
        LAS unsigned char* lds = (LAS unsigned char*)lds_raw; { unsigned lo_ = (unsigned)(uintptr_t)lds; asm volatile("" : "+s"(lo_)); lds = (LAS unsigned char*)(uintptr_t)lo_; }
        InTab inl; inl.ldsbase = lds;
        float* ssqA = (float*)(ws + WS_SSQ);
        bf16* HB = (bf16*)(ws + WS_HB);
        unsigned char* Wr = ws + WS_W;
        unsigned char* BIG = ws + WS_BIG;
        const int gw = vcu * NWAVES + wave, NGW = G * NWAVES;
        if (ph == 0) {
#ifdef PROBE_P02
            conv_weights(inl, ws, 0, 1 | 2 | 4, lds, gw, NGW, wave, lane);
            copy_x(inl.get(0), args.out, HB, ssqA, gw, NGW, lane);
            rope_tables((float*)(ws + WS_ROPE), (float*)(ws + WS_ROPE) + S * 8, (int)blockIdx.x * NTHREADS + tid, G * NTHREADS);
            __syncthreads();
            for (int un = blockIdx.x; un < 128; un += G) mem_kv(inl, ws, lds, un, tid, wave, lane);
            for (int idx = (int)blockIdx.x * NTHREADS + tid; idx < 1024 * 16; idx += G * NTHREADS) {
                const int k = idx >> 4, col = idx & 15;
                const float v = inl.get(5)[k] * inl.get(6)[(size_t)k * EVEN_SRC + (col < 8 ? ES_FL + col : ES_IW + col - 8)];
                const int ln = (k & 255) >> 2, e = k & 3, q = k >> 8, c = col >> 2;
                ((float*)(ws + WS_TW))[((((q * 4 + e) * 4 + c) * 64 + ln) << 2) + (col & 3)] = v; }
            __syncthreads();
#endif
#ifndef NO_P0
            conv_weights(inl, ws, 0, 1 | 2 | 4, lds, gw, NGW, wave, lane);
            copy_x(inl.get(0), args.out, HB, ssqA, gw, NGW, lane);
            if (blockIdx.x == 0 && tid < 384) { const int gi = tid >> 6, d = tid & 63;
                float v;
                if (gi == 0) v = inl.get(8)[d]; else if (gi == 1) v = inl.get(10)[d]; else if (gi == 2) v = inl.get(9)[d]; else if (gi == 3) v = inl.get(11)[d]; else if (gi == 4) v = inl.get(13)[d]; else v = inl.get(14)[d];
                ((float*)(ws + WS_GT))[tid] = v; }
            rope_tables((float*)(ws + WS_ROPE), (float*)(ws + WS_ROPE) + S * 8, (int)blockIdx.x * NTHREADS + tid, G * NTHREADS);
            __syncthreads();
            for (int un = blockIdx.x; un < 128; un += G) mem_kv(inl, ws, lds, un, tid, wave, lane);
            for (int idx = (int)blockIdx.x * NTHREADS + tid; idx < 1024 * 16; idx += G * NTHREADS) {
                const int k = idx >> 4, col = idx & 15;
                const float v = inl.get(5)[k] * inl.get(6)[(size_t)k * EVEN_SRC + (col < 8 ? ES_FL + col : ES_IW + col - 8)];
                const int ln = (k & 255) >> 2, e = k & 3, q = k >> 8, c = col >> 2;
                ((float*)(ws + WS_TW))[((((q * 4 + e) * 4 + c) * 64 + ln) << 2) + (col & 3)] = v; }
#endif
        } else {
            const int L = (ph - 1) / PH_PER_LAYER, sub = (ph - 1) % PH_PER_LAYER;
            const bool even = (L & 1) == 0;
            float* ssq_in = ssqA;
            if (sub == 0 || sub == 11) {
                pg8::Gemm g{(const pg8::bf16_t*)HB, (const pg8::bf16_t*)(Wr + (sub == 0 ? W_FFN1_IN : W_FFN2_IN)), S, FF2, DM, DM};
                pg8::StaticOrder So; So.init(S, FF2, G, (int)blockIdx.x);
                pg8::EpiSwiGLU E{(pg8::bf16_t*)(BIG + B_U), ssq_in, FF};
#ifdef PROBE_GEMM2
                pg8::gemm_phase<pg8::EpiSwiGLU, pg8::StaticOrder, true, true>(lds, g, So, E, tid); __syncthreads();
#endif
                pg8::gemm_phase<pg8::EpiSwiGLU, pg8::StaticOrder, true, true>(lds, g, So, E, tid);
            } else if (sub == 1 || sub == 7 || sub == 10 || sub == 12) {
                pg8::Gemm g; float scale; int so;
                if (sub == 1)       { g = pg8::Gemm{(const pg8::bf16_t*)(BIG + B_U), (const pg8::bf16_t*)(Wr + W_FFN1_OUT), S, DM, FF, FF}; scale = 0.5f; so = 1; }
                else if (sub == 7)  { g = pg8::Gemm{(const pg8::bf16_t*)(BIG + B_PROJ), (const pg8::bf16_t*)(Wr + W_MIX_OUT), S, DM, DM, even ? EVEN_NP : DM}; scale = 1.0f; so = 2; }
                else if (sub == 10)  { g = pg8::Gemm{(const pg8::bf16_t*)(BIG + B_OM), (const pg8::bf16_t*)(Wr + (L ? W_MEMO2 : W_MEMO)), S, DM, MEMW, MEMW}; scale = 1.0f; so = 3; }
                else                { g = pg8::Gemm{(const pg8::bf16_t*)(BIG + B_U), (const pg8::bf16_t*)(Wr + W_FFN2_OUT), S, DM, FF, FF}; scale = 0.5f; so = 4; }
                const bool last = (sub == 12 && L == NLAYER - 1);
                pg8::StaticOrder So; So.init(S, DM, G, (int)blockIdx.x);
                pg8::EpiResid E{args.out, last ? nullptr : (pg8::bf16_t*)HB, last ? nullptr : ssqA, scale};
                pg8::gemm_phase<pg8::EpiResid, pg8::StaticOrder, true, true>(lds, g, So, E, tid);
#ifdef PROBE_GEMM2
                { __syncthreads(); pg8::EpiResid E0 = E; E0.scale = 0.f; pg8::gemm_phase<pg8::EpiResid, pg8::StaticOrder, true, true>(lds, g, So, E0, tid); }
#endif
            } else if (sub == 2) {
                const int N = even ? EVEN_NP : ODD_N;
                pg8::Gemm g{(const pg8::bf16_t*)HB, (const pg8::bf16_t*)(Wr + W_MIX_IN), S, N, DM, DM};
                pg8::EpiProj E;
                E.O = (pg8::bf16_t*)(BIG + B_PROJ); E.ldc = even ? EVEN_NP : DM; E.ssq = ssq_in; E.split_cols = even ? 0 : DM; E.split_stride = (size_t)S * DM; E.even = even ? 1 : 0;
                E.gtab = (const float*)(ws + WS_GT);
                E.cosT = (const float*)(ws + WS_ROPE); E.sinT = E.cosT + S * 8;
                E.Vt = (pg8::bf16_t*)(BIG + (even ? B_VTF : B_VTM)); E.IKf = (pg8::bf16_t*)(BIG + B_IKC);
                E.xch = (LAS float*)(lds + 131072);
                pg8::StaticOrder So; So.init(S, N, G, (int)blockIdx.x);
#ifdef PROBE_MIXIN2
                pg8::gemm_phase<pg8::EpiProj, pg8::StaticOrder, true, true>(lds, g, So, E, tid); __syncthreads();
#endif
                pg8::gemm_phase<pg8::EpiProj, pg8::StaticOrder, true, true>(lds, g, So, E, tid);
            } else if (sub == 8) {
                if ((int)blockIdx.x >= 64 && G > 64) {
                    const int cw = ((int)blockIdx.x - 64) * NWAVES + wave, ncw = (G - 64) * NWAVES;
                    if (L == 0) conv_weights(inl, ws, 1, 1 | 2 | 4 | 8 | 16 | 32, lds, cw, ncw, wave, lane);
                    else        conv_weights(inl, ws, 1, 64 | 128, lds, cw, ncw, wave, lane);
                }
                pg8::Gemm g{(const pg8::bf16_t*)HB, (const pg8::bf16_t*)(Wr + (L ? W_MEMQ2 : W_MEMQ)), S, MEMW, DM, DM};
                pg8::EpiScale E{(pg8::bf16_t*)(BIG + B_QM), MEMW, ssq_in, 0, 0};
                pg8::StaticOrder So; So.init(S, g.N, G, (int)blockIdx.x);
                pg8::gemm_phase<pg8::EpiScale, pg8::StaticOrder, true, true>(lds, g, So, E, tid);
            } else if (sub == 3) {
                if (even) post_even(inl, ws, args.out, ssq_in, lds, G, tid, wave, lane);
                else post_odd(ws, lds, G, tid);
                if (L == 0) { __syncthreads(); conv_weights(inl, ws, 0, 8 | 16 | 32 | 64 | 128, lds, gw, NGW, wave, lane); }
            } else if (sub == 4) {
                if (even) {
                    int nrep = 1;
#ifdef PROBE_DSA2
                    nrep = 2;
#endif
                    asm volatile("" : "+s"(nrep));
#ifdef PROBE_SELNC
                    dsa_select_phase<true>(ws, lds, G, tid, wave, lane); __syncthreads();
#endif
                    for (int rep = 0; rep < nrep; ++rep) { dsa_select_phase<false>(ws, lds, G, tid, wave, lane); __syncthreads(); }
                } else {
                    moba_gate_phase(ws, G, wave, lane);
                }
            } else if (sub == 5) {
                if (even) {
                    bf16* projb = (bf16*)(BIG + B_PROJ);
#ifdef PROBE_FOX2
                    fox_phase(inl, ws, lds, G, tid, wave, lane, HB, 512, CW_FOXQ + 64); __syncthreads();
#endif
#ifdef PROBE_SPARSE2
                    dsa_sparse_phase(ws, G, wave, lane, HB, 512);
#endif
                    fox_phase(inl, ws, lds, G, tid, wave, lane, projb + EC_FQ, EVEN_NP, CW_FOXQ);
                    dsa_sparse_phase(ws, G, wave, lane, projb + EC_DQ, EVEN_NP);
                } else {
#ifdef PROBE_MOBA2
                    moba_route_phase(ws, lds, G, tid, wave, lane, CW_MOBAQ + 64); __syncthreads();
#endif
                    moba_route_phase(ws, lds, G, tid, wave, lane, CW_MOBAQ);
                }
            } else if (sub == 6) {
#ifdef PROBE_OWN2
                if (!even) { moba_own_phase(ws, lds, G, tid, wave, lane, (bf16*)(BIG + 160 * MiB), 0); __syncthreads(); }
#endif
                if (!even) moba_own_phase(ws, lds, G, tid, wave, lane, (bf16*)(BIG + B_PROJ), DM);
            } else if (sub == 9) {
#ifdef PROBE_MEM2
                memattn_phase(inl, ws, L, lds, G, tid, wave, lane); __syncthreads();
#endif
                memattn_phase(inl, ws, L, lds, G, tid, wave, lane);
            }
        }
        if (ph + 1 < args.ph_hi) xcd_barrier(bar);
#ifdef PROBE_BAR2
        if (ph + 1 < args.ph_hi) xcd_barrier(bar);
#endif
    }
}

#ifndef MK_N_LAUNCHES
#define MK_N_LAUNCHES 1
#endif
extern "C" void kernel_launch(void* const* d_in, const int* in_sizes, int n_in, void* d_out, int out_size, void* d_ws, size_t ws_size, hipStream_t stream) {
    static int grid = 0;
    if (grid == 0) {
        if (n_in != 26 || in_sizes[0] != S * DM || out_size != S * DM || ws_size < WS_END) {
            fprintf(stderr, "kernel_launch: unexpected problem (n_in %d, in0 %d, out %d, ws %zu); nothing launched\n", n_in, n_in > 0 ? in_sizes[0] : -1, out_size, ws_size); grid = -1; return; }
        int dev = 0, cus = 0, per_cu = 0;
        if (hipGetDevice(&dev) != hipSuccess || hipDeviceGetAttribute(&cus, hipDeviceAttributeMultiprocessorCount, dev) != hipSuccess) { grid = -1; return; }
        if (hipFuncSetAttribute((const void*)hyb_fwd, hipFuncAttributeMaxDynamicSharedMemorySize, LDS_BYTES) != hipSuccess) { fprintf(stderr, "kernel_launch: hipFuncSetAttribute failed\n"); grid = -1; return; }
        if (hipOccupancyMaxActiveBlocksPerMultiprocessor(&per_cu, (const void*)hyb_fwd, NTHREADS, LDS_BYTES) != hipSuccess || per_cu < 1)
            fprintf(stderr, "kernel_launch: note: occupancy query reports %d workgroups per CU\n", per_cu);
        (void)hipGetLastError();
        grid = cus;
    }
    if (grid < 0) return;
    if (hipMemsetAsync((char*)d_ws + WS_CTL, 0, CTL_ZERO_BYTES, stream) != hipSuccess) { fprintf(stderr, "kernel_launch: hipMemsetAsync failed\n"); return; }
    Args a{};
    for (int i = 0; i < 26; ++i) a.in.p[i] = (const float*)d_in[i];
    a.out = (float*)d_out; a.ws = (unsigned char*)d_ws;
#if MK_N_LAUNCHES == 1
    a.ph_lo = 0; a.ph_hi = N_PHASES; a.li = 0;
    hipLaunchKernelGGL(hyb_fwd, dim3(grid), dim3(NTHREADS), LDS_BYTES, stream, a);
#else
    for (int ph = 0; ph < N_PHASES; ++ph) { a.ph_lo = ph; a.ph_hi = ph + 1; a.li = 0; hipLaunchKernelGGL(hyb_fwd, dim3(grid), dim3(NTHREADS), LDS_BYTES, stream, a); }
#endif
    const hipError_t le = hipPeekAtLastError();
    if (le != hipSuccess) fprintf(stderr, "kernel_launch: launch failed: %s\n", hipGetErrorName(le));
}
```

```cpp
#include <hip/hip_runtime.h>
#include <cstdio>
#include <cstdint>

template <int M> __device__ __forceinline__ int shx_i(int v) {
    if constexpr (M == 1) return __builtin_amdgcn_mov_dpp(v, 0xB1, 0xF, 0xF, true);
    else if constexpr (M == 2) return __builtin_amdgcn_mov_dpp(v, 0x4E, 0xF, 0xF, true);
    else return __builtin_amdgcn_ds_swizzle(v, (M << 10) | 0x1f);
}
template <int M> __device__ __forceinline__ float shx(float v) { return __int_as_float(shx_i<M>(__float_as_int(v))); }
__device__ __forceinline__ float sh32_sum(float v) { auto r = __builtin_amdgcn_permlane32_swap(__float_as_uint(v), __float_as_uint(v), false, false); return __uint_as_float(r[0]) + __uint_as_float(r[1]); }
__device__ __forceinline__ float sh32_max(float v) { auto r = __builtin_amdgcn_permlane32_swap(__float_as_uint(v), __float_as_uint(v), false, false); return fmaxf(__uint_as_float(r[0]), __uint_as_float(r[1])); }
__device__ __forceinline__ int sum32_i(int c) { c += shx_i<1>(c); c += shx_i<2>(c); c += shx_i<4>(c); c += shx_i<8>(c); c += shx_i<16>(c); return c; }
namespace pg8 {
#define PG8_LAS __attribute__((address_space(3)))
typedef unsigned short bf16_t;
typedef short bf16x8 __attribute__((ext_vector_type(8)));
typedef float f32x4 __attribute__((ext_vector_type(4)));
typedef unsigned u32x4 __attribute__((ext_vector_type(4)));
constexpr int BM = 256, BK = 64, HALF = 128, HTB = HALF * BK * 2  , STAGE_BYTES = 8 * HTB, NXCD = 8, WGM = 8;

__host__ __device__ __forceinline__ int lds_byte(int r, int c) { const int st = (r >> 4) * 2 + (c >> 5), rr = r & 15, cc = c & 31, ob = rr * 64 + cc * 2; return st * 1024 + (ob ^ (((ob >> 9) & 1) << 5)); }
__host__ __device__ __forceinline__ void stage_rc(int b, int& R, int& C) { const int st = b / 1024, sb = b % 1024, swz = sb ^ (((sb >> 9) & 1) << 5); R = (st >> 1) * 16 + swz / 64; C = (st & 1) * 32 + (swz % 64) / 2; }
__host__ __device__ __forceinline__ int perm32(int rho) { const int n = rho >> 4, i = rho & 15; return 8 * (i >> 2) + 4 * n + (i & 3); }

struct Unit { int pm, pn; };
struct Gemm { const bf16_t* A; const bf16_t* Bt; int M, N, K, lda; };

struct StaticOrder {
    int nM, nN, nwg, G, c;
    __host__ __device__ __forceinline__ void init(int M, int N, int G_, int c_) { nM = M / BM; nN = N / BM; nwg = nM * nN; G = G_; c = c_; }
    __host__ __device__ __forceinline__ bool next(int i, Unit& u) const {
        const long L = (long)i * G + c; if (L >= nwg) return false;
        int wgid = (int)L; { const int q = nwg / NXCD, r = nwg % NXCD, xcd = wgid % NXCD, off = wgid / NXCD; wgid = (xcd < r ? xcd * (q + 1) : r * (q + 1) + (xcd - r) * q) + off; }
        const int nig = WGM * nN, gid = wgid / nig, fm = gid * WGM, gsz = (nM - fm) < WGM ? (nM - fm) : WGM;
        u.pm = fm + ((wgid % nig) % gsz); u.pn = (wgid % nig) / gsz; return true;
    }
    __device__ __forceinline__ void a_ready(const Unit&) const {}
    __device__ __forceinline__ void done(const Unit&) const {}
};

__device__ __forceinline__ unsigned cvt_pk_bf16(float lo, float hi) { unsigned r; asm volatile("v_cvt_pk_bf16_f32 %0, %1, %2" : "=v"(r) : "v"(lo), "v"(hi)); return r; }
typedef float f32x2 __attribute__((ext_vector_type(2)));
constexpr float RMS_EPS_F = 1e-6f;
__device__ __forceinline__ float silu_f(float x) { return x * __builtin_amdgcn_rcpf(1.0f + __builtin_amdgcn_exp2f(-1.4426950408889634f * x)); }
__device__ __forceinline__ float row_rstd(const float* ssq, int row) {
    const f32x4* p = (const f32x4*)(ssq + (size_t)row * 16); const f32x4 a = p[0], b = p[1], c = p[2], d = p[3];
    const float s = ((a[0] + a[1]) + (a[2] + a[3])) + ((b[0] + b[1]) + (b[2] + b[3])) + ((c[0] + c[1]) + (c[2] + c[3])) + ((d[0] + d[1]) + (d[2] + d[3]));
    return rsqrtf(s * (1.0f / 1024.0f) + RMS_EPS_F); }

struct EpiSwiGLU {
    static constexpr bool PERM = true, AFTER_DRAIN = false;
    bf16_t* U; const float* ssq; int ldu;
    __device__ __forceinline__ void operator()(const f32x4 (&acc)[2][2][4][2], const Unit& u, int wr, int wc, int fr, int fq) const {
        const int row0 = u.pm * BM + wr * 64 + fr, col0 = u.pn * HALF + wc * 32 + 8 * fq;
#pragma unroll
        for (int ai = 0; ai < 2; ++ai)
#pragma unroll
            for (int m = 0; m < 4; ++m) {
                const int row = row0 + ai * HALF + m * 16; const float r = row_rstd(ssq, row);
                const f32x4 a0 = acc[ai][0][m][0] * r, a1 = acc[ai][0][m][1] * r, b0 = acc[ai][1][m][0] * r, b1 = acc[ai][1][m][1] * r;
                u32x4 w;
                w.x = cvt_pk_bf16(silu_f(a0[0]) * b0[0], silu_f(a0[1]) * b0[1]); w.y = cvt_pk_bf16(silu_f(a0[2]) * b0[2], silu_f(a0[3]) * b0[3]);
                w.z = cvt_pk_bf16(silu_f(a1[0]) * b1[0], silu_f(a1[1]) * b1[1]); w.w = cvt_pk_bf16(silu_f(a1[2]) * b1[2], silu_f(a1[3]) * b1[3]);
                *(u32x4*)(U + (size_t)row * ldu + col0) = w;
            }
    }
};
struct EpiResid {
    static constexpr bool PERM = true, AFTER_DRAIN = false;
    const float* Hin; float* H; bf16_t* HB; float* ssq_out; float scale;
    __device__ __forceinline__ void operator()(const f32x4 (&acc)[2][2][4][2], const Unit& u, int wr, int wc, int fr, int fq) const {
        const int row0 = u.pm * BM + wr * 64 + fr, col0 = u.pn * BM + wc * 32 + 8 * fq;
#pragma unroll
        for (int ai = 0; ai < 2; ++ai)
#pragma unroll
            for (int m = 0; m < 4; ++m) {
                const int row = row0 + ai * HALF + m * 16; float sq = 0.f;
#pragma unroll
                for (int bj = 0; bj < 2; ++bj) {
                    float* hp = H + (size_t)row * 1024 + col0 + bj * HALF; const float* hi_ = Hin + (size_t)row * 1024 + col0 + bj * HALF;
                    f32x4 h0 = *(const f32x4*)hi_, h1 = *(const f32x4*)(hi_ + 4);
                    h0 = h0 + acc[ai][bj][m][0] * scale; h1 = h1 + acc[ai][bj][m][1] * scale;
                    *(f32x4*)hp = h0; *(f32x4*)(hp + 4) = h1;
                    sq += (h0[0] * h0[0] + h0[1] * h0[1]) + (h0[2] * h0[2] + h0[3] * h0[3]) + (h1[0] * h1[0] + h1[1] * h1[1]) + (h1[2] * h1[2] + h1[3] * h1[3]);
                    if (HB) { u32x4 w; w.x = cvt_pk_bf16(h0[0], h0[1]); w.y = cvt_pk_bf16(h0[2], h0[3]); w.z = cvt_pk_bf16(h1[0], h1[1]); w.w = cvt_pk_bf16(h1[2], h1[3]);
                        *(u32x4*)(HB + (size_t)row * 1024 + col0 + bj * HALF) = w; }
                }
                if (ssq_out) { sq += shx<16>(sq); sq = sh32_sum(sq); if (fq == 0) ssq_out[(size_t)row * 16 + u.pn * 4 + wc] = sq; }
            }
    }
};
struct EpiScale {
    static constexpr bool PERM = true, AFTER_DRAIN = false;
    bf16_t* O; int ldc; const float* ssq; int split_cols; size_t split_stride;
    __device__ __forceinline__ void operator()(const f32x4 (&acc)[2][2][4][2], const Unit& u, int wr, int wc, int fr, int fq) const {
        const int row0 = u.pm * BM + wr * 64 + fr; int colt = u.pn * BM; bf16_t* base = O;
        if (split_cols) { const int t = colt / split_cols; base += (size_t)t * split_stride; colt -= t * split_cols; }
        const int col0 = colt + wc * 32 + 8 * fq;
#pragma unroll
        for (int ai = 0; ai < 2; ++ai)
#pragma unroll
            for (int m = 0; m < 4; ++m) {
                const int row = row0 + ai * HALF + m * 16; const float r = row_rstd(ssq, row);
                bf16_t* rowp = base + (size_t)row * ldc + col0;
#pragma unroll
                for (int bj = 0; bj < 2; ++bj) { const f32x4 v0 = acc[ai][bj][m][0] * r, v1 = acc[ai][bj][m][1] * r;
                    u32x4 w; w.x = cvt_pk_bf16(v0[0], v0[1]); w.y = cvt_pk_bf16(v0[2], v0[3]); w.z = cvt_pk_bf16(v1[0], v1[1]); w.w = cvt_pk_bf16(v1[2], v1[3]);
                    *(u32x4*)(rowp + bj * HALF) = w; }
            }
    }
};

enum { KIND_PLAIN = 0, KIND_NORM = 1, KIND_NORM_ROPE = 2, KIND_ROPE = 3, KIND_VT = 4, KIND_NORM_ROPE_KSUM = 5, KIND_IK = 6, KIND_SKIP = 7 };
struct EpiProj {
    static constexpr bool PERM = true, AFTER_DRAIN = false;
    bf16_t* O; int ldc; const float* ssq; int split_cols; size_t split_stride;
    int even;
    const float* gtab;
    const float* cosT; const float* sinT;
    bf16_t* Vt;
    bf16_t* IKf;
    PG8_LAS float* xch;
    __device__ __forceinline__ void operator()(const f32x4 (&acc)[2][2][4][2], const Unit& u, int wr, int wc, int fr, int fq) const {
        const int S_ = 16384;
        int kind; int gsel = 0; int vcol0 = 0;
        if (even) { const int p = u.pn;
            kind = (p < 2) ? KIND_NORM : (p < 4) ? KIND_NORM_ROPE : (p < 6) ? KIND_NORM : (p < 8) ? KIND_NORM_ROPE : (p < 10) ? KIND_VT : (p < 12) ? KIND_PLAIN : (p < 14) ? KIND_ROPE : KIND_IK;
            gsel = (p < 8) ? (p >> 1) : 0; vcol0 = (p - 8) * 256;
        } else { const int p = u.pn; kind = (p < 8) ? KIND_NORM_ROPE : KIND_VT; gsel = (p < 8) ? 4 + (p >> 2) : 0; vcol0 = (p - 8) * 256; }
        const float* gn = gtab + gsel * 64;
        const int row0 = u.pm * BM + wr * 64 + fr; int colt = u.pn * BM; bf16_t* base = O;
        if (split_cols) { const int t = colt / split_cols; base += (size_t)t * split_stride; colt -= t * split_cols; }
        const int co0 = wc * 32 + 8 * fq;
        const int hd0 = 32 * (wc & 1) + 8 * fq;
        int xo = ((wr * 64 + fr) * 2) * 4 + wc, xp = ((wr * 64 + fr) * 2) * 4 + (wc ^ 1);
        asm volatile("" : "+v"(xo), "+v"(xp));
        const bool normk = (kind == KIND_NORM || kind == KIND_NORM_ROPE || kind == KIND_NORM_ROPE_KSUM);
        const bool ropek = (kind == KIND_NORM_ROPE || kind == KIND_ROPE || kind == KIND_NORM_ROPE_KSUM || kind == KIND_IK);
        float gv[8];
#pragma unroll
        for (int e2 = 0; e2 < 8; ++e2) gv[e2] = normk ? gn[hd0 + e2] : 1.0f;
        if (normk) {
#pragma unroll
            for (int ai = 0; ai < 2; ++ai)
#pragma unroll
                for (int m = 0; m < 4; ++m)
#pragma unroll
                    for (int bj = 0; bj < 2; ++bj) { const f32x4 v0 = acc[ai][bj][m][0], v1 = acc[ai][bj][m][1];
                        float ss = (v0[0] * v0[0] + v0[1] * v0[1]) + (v0[2] * v0[2] + v0[3] * v0[3]) + (v1[0] * v1[0] + v1[1] * v1[1]) + (v1[2] * v1[2] + v1[3] * v1[3]);
                        ss += shx<16>(ss); ss = sh32_sum(ss);
                        if (fq == 0) xch[xo + (ai * 128 + m * 16) * 8 + bj * 4] = ss; }
            asm volatile("s_waitcnt lgkmcnt(0)" ::: "memory"); __builtin_amdgcn_s_barrier(); asm volatile("" ::: "memory");
        }
        if (kind != KIND_SKIP) {
#pragma unroll
        for (int ai = 0; ai < 2; ++ai)
#pragma unroll
            for (int m = 0; m < 4; ++m) {
                const int row = row0 + ai * HALF + m * 16; const float r = row_rstd(ssq, row);
                float cs[8], sn[8];
                if (ropek) { const f32x4 c0 = *(const f32x4*)(cosT + (unsigned)(row * 8)), c1 = *(const f32x4*)(cosT + (unsigned)(row * 8 + 4)), s0 = *(const f32x4*)(sinT + (unsigned)(row * 8)), s1 = *(const f32x4*)(sinT + (unsigned)(row * 8 + 4));
#pragma unroll
                    for (int e2 = 0; e2 < 4; ++e2) { cs[e2] = c0[e2]; cs[4 + e2] = c1[e2]; sn[e2] = s0[e2]; sn[4 + e2] = s1[e2]; } }
#pragma unroll
                for (int bj = 0; bj < 2; ++bj) {
                    if (kind == KIND_IK && (bj == 1 || wc >= 2)) continue;
                    float x[8];
                    { const f32x4 v0 = acc[ai][bj][m][0], v1 = acc[ai][bj][m][1];
#pragma unroll
                      for (int e2 = 0; e2 < 4; ++e2) { x[e2] = v0[e2]; x[4 + e2] = v1[e2]; } }
                    float sc = r;
                    if (normk) { const float tot = xch[xo + (ai * 128 + m * 16) * 8 + bj * 4] + xch[xp + (ai * 128 + m * 16) * 8 + bj * 4];
                        sc = r * rsqrtf(tot * (r * r) * (1.0f / 64.0f) + RMS_EPS_F); }
#pragma unroll
                    for (int e2 = 0; e2 < 8; ++e2) x[e2] = x[e2] * sc * gv[e2];
                    if (ropek) {
#pragma unroll
                        for (int e2 = 0; e2 < 8; ++e2) { const float other = shx<16>(x[e2]);
                            if ((wc & 1) == 0 && fq == 0) x[e2] = x[e2] * cs[e2] - other * sn[e2];
                            else if ((wc & 1) == 0 && fq == 1) x[e2] = x[e2] * cs[e2] + other * sn[e2]; }
                    }
                    if (kind == KIND_VT) {
                        bf16_t* vp = Vt + (unsigned)((vcol0 + bj * HALF + co0) * S_ + (row & ~1));
#pragma unroll
                        for (int e2 = 0; e2 < 8; ++e2) { const float other = shx<1>(x[e2]);
                            const unsigned w = (fr & 1) ? cvt_pk_bf16(other, x[e2]) : cvt_pk_bf16(x[e2], other);
                            if (((e2 >> 2) & 1) == (fr & 1)) *(unsigned*)(vp + (unsigned)(e2 * S_)) = w; }
                    } else if (kind == KIND_IK) {
                        const int c8 = 4 * wc + fq;
                        u32x4 w; w.x = cvt_pk_bf16(x[0], x[1]); w.y = cvt_pk_bf16(x[2], x[3]); w.z = cvt_pk_bf16(x[4], x[5]); w.w = cvt_pk_bf16(x[6], x[7]);
                        *(u32x4*)(IKf + (unsigned)((((row >> 5) * 4 + (c8 >> 1)) * 64 + (c8 & 1) * 32 + (row & 31)) * 8)) = w;
                    } else {
                        u32x4 w; w.x = cvt_pk_bf16(x[0], x[1]); w.y = cvt_pk_bf16(x[2], x[3]); w.z = cvt_pk_bf16(x[4], x[5]); w.w = cvt_pk_bf16(x[6], x[7]);
                        *(u32x4*)(base + (unsigned)(row * ldc + colt + bj * HALF + co0)) = w;
                    }
                }
            }
        }
        if (normk) { asm volatile("s_waitcnt lgkmcnt(0)" ::: "memory"); __builtin_amdgcn_s_barrier(); asm volatile("" ::: "memory"); }
    }
};

struct EpiPartial {
    static constexpr bool PERM = true, AFTER_DRAIN = false;
    float* P; int M;
    __device__ __forceinline__ void operator()(const f32x4 (&acc)[2][2][4][2], const Unit& u, int wr, int wc, int fr, int fq) const {
        const int row0 = u.pm * BM + wr * 64 + fr; float* base = P + (size_t)u.pn * M * 256 + wc * 32 + 8 * fq;
#pragma unroll
        for (int ai = 0; ai < 2; ++ai)
#pragma unroll
            for (int m = 0; m < 4; ++m) { float* rp = base + (unsigned)((row0 + ai * HALF + m * 16) * 256);
#pragma unroll
                for (int bj = 0; bj < 2; ++bj) { *(f32x4*)(rp + bj * HALF) = acc[ai][bj][m][0]; *(f32x4*)(rp + bj * HALF + 4) = acc[ai][bj][m][1]; } }
    }
};
template <class Epi, class Sched, bool ALIGN_EPI = false, bool SP2 = false, int KSPLIT = 0, int LDB = 0>
__device__ __forceinline__ void gemm_phase(PG8_LAS unsigned char* lds, const Gemm g, const Sched& S, const Epi& E, const int tid) {
    const int wid = __builtin_amdgcn_readfirstlane(tid >> 6), lane = tid & 63, wr = wid >> 2, wc = wid & 3, fr = lane & 15, fq = lane >> 4;
    const int K = g.K, nt = K / BK;
    unsigned voffA[2], voffB[2];
#pragma unroll
    for (int i = 0; i < 2; ++i) { int R, C; stage_rc(tid * 16 + i * 8192, R, C); const int Rb = Epi::PERM ? ((R & ~31) + perm32(R & 31)) : R;
        voffA[i] = (unsigned)(R * g.lda + C) * 2u; voffB[i] = (unsigned)(Rb * (LDB ? LDB : K) + C) * 2u; }
    const size_t kstep = (size_t)(BK * 2);
    const size_t hstepA = (size_t)HALF * g.lda * 2, hstepB = (size_t)HALF * (LDB ? LDB : K) * 2;
    const size_t tstepA = 2 * hstepA, tstepB = 2 * hstepB;
    const unsigned ldsw = (unsigned)wid * 1024u;
    const int aoff = lds_byte(wr * 64 + fr, fq * 8), boff = lds_byte(wc * 32 + fr, fq * 8);
#define PG8_SA(b, h) (((b) * 2 + (h)) * HTB)
#define PG8_SB(b, h) ((4 + (b) * 2 + (h)) * HTB)
#define PG8_STAGE(bufoff, gbase, voff) do { _Pragma("unroll") for (int _i = 0; _i < 2; ++_i) \
        __builtin_amdgcn_global_load_lds((const unsigned*)((const char*)(gbase) + (voff)[_i]), (PG8_LAS unsigned*)(lds + (bufoff) + ldsw + _i * 8192), 16, 0, 0); } while (0)
#define PG8_LDA(dst, b, h) do { _Pragma("unroll") for (int m = 0; m < 4; ++m) _Pragma("unroll") for (int k = 0; k < 2; ++k) dst[m][k] = *(const PG8_LAS bf16x8*)(lds + PG8_SA(b, h) + aoff + m * 2048 + k * 1024); } while (0)
#define PG8_LDB(dst, b, h) do { _Pragma("unroll") for (int n = 0; n < 2; ++n) _Pragma("unroll") for (int k = 0; k < 2; ++k) dst[n][k] = *(const PG8_LAS bf16x8*)(lds + PG8_SB(b, h) + boff + n * 2048 + k * 1024); } while (0)
#define PG8_MMA(ai, bj, At, Bt) do { __builtin_amdgcn_s_setprio(1); _Pragma("unroll") for (int m = 0; m < 4; ++m) _Pragma("unroll") for (int n = 0; n < 2; ++n) _Pragma("unroll") for (int k = 0; k < 2; ++k) \
        acc[ai][bj][m][n] = __builtin_amdgcn_mfma_f32_16x16x32_bf16(Bt[n][k], At[m][k], acc[ai][bj][m][n], 0, 0, 0); __builtin_amdgcn_s_setprio(0); } while (0)
#define PG8_WAIT_V(n) asm volatile("s_waitcnt vmcnt(" #n ")" ::: "memory")
#define PG8_WAIT_L(n) asm volatile("s_waitcnt lgkmcnt(" #n ")" ::: "memory")
#define PG8_BAR __builtin_amdgcn_s_barrier()
#define PG8_SCHED __builtin_amdgcn_sched_barrier(0)
    Unit cur, nxt; int ui = 0;
    if (!S.next(0, cur)) return;
    f32x4 acc[2][2][4][2];
#pragma unroll
    for (int a = 0; a < 2; ++a)
#pragma unroll
        for (int b = 0; b < 2; ++b)
#pragma unroll
            for (int m = 0; m < 4; ++m)
#pragma unroll
                for (int n = 0; n < 2; ++n) acc[a][b][m][n] = (f32x4){0.f, 0.f, 0.f, 0.f};
    bf16x8 At[4][2], B0[2][2], B1[2][2];
    const char* cA = (const char*)g.A + (size_t)cur.pm * tstepA + (KSPLIT ? (size_t)cur.pn * KSPLIT : (size_t)0); const char* cB = (const char*)g.Bt + (KSPLIT ? (size_t)cur.pn * KSPLIT : (size_t)cur.pn * tstepB);
    S.a_ready(cur);
    if constexpr (SP2) {
        PG8_STAGE(PG8_SB(0, 0), cB, voffB); PG8_STAGE(PG8_SB(0, 1), cB + hstepB, voffB); PG8_STAGE(PG8_SA(0, 0), cA, voffA); PG8_STAGE(PG8_SA(0, 1), cA + hstepA, voffA);
        if (wr == 1) PG8_BAR;
        PG8_WAIT_V(2); PG8_BAR;
        PG8_STAGE(PG8_SB(1, 0), cB + kstep, voffB); PG8_STAGE(PG8_SA(1, 0), cA + kstep, voffA); PG8_STAGE(PG8_SB(1, 1), cB + hstepB + kstep, voffB);
        PG8_WAIT_V(6); PG8_BAR;
    } else {
        PG8_STAGE(PG8_SB(0, 0), cB, voffB); PG8_STAGE(PG8_SA(0, 0), cA, voffA); PG8_STAGE(PG8_SB(0, 1), cB + hstepB, voffB); PG8_STAGE(PG8_SA(0, 1), cA + hstepA, voffA);
        if (wr == 1) PG8_BAR;
        PG8_WAIT_V(4); PG8_BAR;
        PG8_STAGE(PG8_SB(1, 0), cB + kstep, voffB); PG8_STAGE(PG8_SA(1, 0), cA + kstep, voffA); PG8_STAGE(PG8_SB(1, 1), cB + hstepB + kstep, voffB);
        PG8_WAIT_V(6); PG8_BAR;
    }
    for (;;) {
        const bool has_next = S.next(ui + 1, nxt);
        const char* nA = has_next ? (const char*)g.A + (size_t)nxt.pm * tstepA + (KSPLIT ? (size_t)nxt.pn * KSPLIT : (size_t)0) : cA; const char* nB = has_next ? (const char*)g.Bt + (KSPLIT ? (size_t)nxt.pn * KSPLIT : (size_t)nxt.pn * tstepB) : cB;
        for (int t = 0; t < nt; t += 2) {
            const bool last = (t == nt - 2);
            const char* a1 = cA + (size_t)(t + 1) * kstep;
            const char* a2 = last ? nA : cA + (size_t)(t + 2) * kstep; const char* b2 = last ? nB : cB + (size_t)(t + 2) * kstep;
            const char* a3 = a2 + kstep; const char* b3 = b2 + kstep;
            if (last && has_next) S.a_ready(nxt);
            if constexpr (SP2) {
            PG8_LDB(B0, 0, 0); PG8_LDB(B1, 0, 1); PG8_SCHED; PG8_LDA(At, 0, 0); PG8_STAGE(PG8_SA(1, 1), a1 + hstepA, voffA);
            PG8_WAIT_V(8); PG8_WAIT_L(0); PG8_BAR; PG8_MMA(0, 0, At, B0); PG8_MMA(0, 1, At, B1); PG8_BAR; PG8_SCHED;
            PG8_LDA(At, 0, 1); PG8_STAGE(PG8_SB(0, 0), b2, voffB); PG8_STAGE(PG8_SB(0, 1), b2 + hstepB, voffB); PG8_STAGE(PG8_SA(0, 0), a2, voffA);
            PG8_WAIT_V(8); PG8_WAIT_L(0); PG8_BAR; PG8_MMA(1, 0, At, B0); PG8_MMA(1, 1, At, B1); PG8_BAR; PG8_SCHED;
            PG8_LDB(B0, 1, 0); PG8_LDB(B1, 1, 1); PG8_SCHED; PG8_LDA(At, 1, 0); PG8_STAGE(PG8_SA(0, 1), a2 + hstepA, voffA);
            PG8_WAIT_V(8); PG8_WAIT_L(0); PG8_BAR; PG8_MMA(0, 0, At, B0); PG8_MMA(0, 1, At, B1); PG8_BAR; PG8_SCHED;
            PG8_LDA(At, 1, 1); PG8_STAGE(PG8_SB(1, 0), b3, voffB); PG8_STAGE(PG8_SB(1, 1), b3 + hstepB, voffB); PG8_STAGE(PG8_SA(1, 0), a3, voffA);
            PG8_WAIT_V(8); PG8_WAIT_L(0); PG8_BAR; PG8_MMA(1, 0, At, B0); PG8_MMA(1, 1, At, B1); PG8_BAR; PG8_SCHED;
            } else {
            PG8_LDB(B0, 0, 0); PG8_SCHED; PG8_LDA(At, 0, 0); PG8_STAGE(PG8_SA(1, 1), a1 + hstepA, voffA);
            PG8_WAIT_L(8); PG8_BAR; PG8_WAIT_L(0); PG8_MMA(0, 0, At, B0); PG8_BAR; PG8_SCHED;
            PG8_LDB(B1, 0, 1); PG8_STAGE(PG8_SB(0, 0), b2, voffB);
            PG8_BAR; PG8_WAIT_L(0); PG8_MMA(0, 1, At, B1); PG8_BAR;
            PG8_LDA(At, 0, 1); PG8_STAGE(PG8_SA(0, 0), a2, voffA);
            PG8_BAR; PG8_WAIT_L(0); PG8_MMA(1, 0, At, B0); PG8_BAR; PG8_SCHED;
            PG8_STAGE(PG8_SB(0, 1), b2 + hstepB, voffB);
            PG8_WAIT_V(6); PG8_BAR; PG8_MMA(1, 1, At, B1); PG8_BAR;
            PG8_LDB(B0, 1, 0); PG8_SCHED; PG8_LDA(At, 1, 0); PG8_STAGE(PG8_SA(0, 1), a2 + hstepA, voffA);
            PG8_WAIT_L(8); PG8_BAR; PG8_WAIT_L(0); PG8_MMA(0, 0, At, B0); PG8_BAR; PG8_SCHED;
            PG8_LDB(B1, 1, 1); PG8_STAGE(PG8_SB(1, 0), b3, voffB);
            PG8_BAR; PG8_WAIT_L(0); PG8_MMA(0, 1, At, B1); PG8_BAR;
            PG8_LDA(At, 1, 1); PG8_STAGE(PG8_SA(1, 0), a3, voffA);
            PG8_BAR; PG8_WAIT_L(0); PG8_MMA(1, 0, At, B0); PG8_BAR; PG8_SCHED;
            PG8_STAGE(PG8_SB(1, 1), b3 + hstepB, voffB);
            PG8_WAIT_V(6); PG8_BAR; PG8_MMA(1, 1, At, B1); PG8_BAR;
            }
        }
        if constexpr (ALIGN_EPI) { if (wr == 0) PG8_BAR; }
        if constexpr (!Epi::AFTER_DRAIN) { E(acc, cur, wr, wc, fr, fq); S.done(cur); }
        if (!has_next) break;
#pragma unroll
        for (int a = 0; a < 2; ++a)
#pragma unroll
            for (int b = 0; b < 2; ++b)
#pragma unroll
                for (int m = 0; m < 4; ++m)
#pragma unroll
                    for (int n = 0; n < 2; ++n) acc[a][b][m][n] = (f32x4){0.f, 0.f, 0.f, 0.f};
        cur = nxt; cA = nA; cB = nB; ++ui;
        if constexpr (ALIGN_EPI) { if (wr == 1) PG8_BAR; }
    }
    PG8_WAIT_V(0);
    if constexpr (!ALIGN_EPI) { if (wr == 0) PG8_BAR; }
    PG8_BAR;
    if constexpr (Epi::AFTER_DRAIN) { E.fused(acc, cur, wr, wc, fr, fq, lds, wid, lane); S.done(cur); }
#undef PG8_SA
#undef PG8_SB
#undef PG8_STAGE
#undef PG8_LDA
#undef PG8_LDB
#undef PG8_MMA
#undef PG8_WAIT_V
#undef PG8_WAIT_L
#undef PG8_BAR
#undef PG8_SCHED
}
}

constexpr int S = 16384, DM = 1024, FF = 2816, FF2 = 5632, EVEN_SRC = 3664, EVEN_NP = 3840, ODD_N = 3072, NLAYER = 2, MEMT = 256, MEMW = 256;
constexpr float RMS_EPS = 1e-6f;
constexpr float LOG2E = 1.4426950408889634f;
constexpr float C2 = 0.125f * LOG2E;
constexpr int NWAVES = 8, NTHREADS = 512;
constexpr int EC_FQ = 0, EC_DQ = 512, EC_FK = 1024, EC_DK = 1536, EC_FV = 2048, EC_DV = 2560, EC_IQ = 3072, EC_IK = 3584;
constexpr int ES_FQ = 0, ES_FK = 512, ES_FV = 1024, ES_FL = 1536, ES_DQ = 1544, ES_DK = 2056, ES_DV = 2568, ES_IQ = 3080, ES_IK = 3592, ES_IW = 3656;

constexpr size_t MiB = 1u << 20;
constexpr size_t WS_CTL = 0, CTL_ZERO_BYTES = 1 * MiB;
constexpr size_t WS_SSQ = 1 * MiB;
constexpr size_t WS_KSUM = 6 * MiB;
constexpr size_t WS_GT = 11 * MiB + 131072;
constexpr size_t WS_TW = 11 * MiB;
constexpr size_t WS_ROPE = 2 * MiB;
constexpr size_t WS_FL = 3 * MiB;
constexpr size_t WS_MEMK = 4 * MiB;
constexpr size_t WS_IW = 5 * MiB;
constexpr size_t WS_W = 12 * MiB;
constexpr size_t WS_BIG = 60 * MiB;
constexpr size_t WS_HB = 224 * MiB;
constexpr size_t WS_END = 256 * MiB;
constexpr size_t W_FFN1_IN = 0, W_FFN1_OUT = 11 * MiB, W_MIX_IN = 17 * MiB, W_MIX_OUT = 25 * MiB, W_MEMQ = 27 * MiB, W_MEMO = 28 * MiB, W_FFN2_IN = 29 * MiB, W_FFN2_OUT = 40 * MiB, W_MEMQ2 = 46 * MiB, W_MEMO2 = 47 * MiB;
constexpr size_t B_U = 0;
constexpr size_t B_PROJ = 0;
constexpr size_t B_VTF = 120 * MiB;
constexpr size_t B_IKC = 136 * MiB;
constexpr size_t B_VTM = 96 * MiB;
constexpr size_t B_SEL = 156 * MiB;
constexpr size_t B_QP = 0;
constexpr size_t B_QM = 140 * MiB, B_OM = 148 * MiB;
constexpr int CW_TMO = 0, CW_CODE = 1, CW_BAR = 4096;

constexpr int RING_BYTES = 147456;
constexpr int LDSCTL_OFF = RING_BYTES, MISC_OFF = LDSCTL_OFF + 320;
constexpr int LDS_BYTES = 163840;

#define GAS __attribute__((address_space(1)))
#define LAS __attribute__((address_space(3)))
typedef unsigned short bf16;
typedef unsigned v4u __attribute__((ext_vector_type(4)));
typedef float f32x4 __attribute__((ext_vector_type(4)));
typedef short bf16x8 __attribute__((ext_vector_type(8)));
typedef GAS unsigned gu32;
typedef GAS unsigned long long gu64;
#define RLX_AGENT __ATOMIC_RELAXED, __HIP_MEMORY_SCOPE_AGENT
#define LDS_WAIT() asm volatile("s_waitcnt lgkmcnt(0)" ::: "memory")
#define VM_WAIT() asm volatile("s_waitcnt vmcnt(0)" ::: "memory")
__device__ __forceinline__ unsigned long long rt() { return __builtin_amdgcn_s_memrealtime(); }
__device__ __forceinline__ unsigned f2bf(float f) { unsigned u = __builtin_bit_cast(unsigned, f); return (u + 0x7fffu + ((u >> 16) & 1u)) >> 16; }
__device__ __forceinline__ unsigned pk2(float lo, float hi) { return f2bf(lo) | (f2bf(hi) << 16); }

#define XB_TMO      128
#define XB_XCNT(j)  (256  + 64 * (j))
#define XB_XSUB(j)  (1280 + 64 * (j))
#define XB_XGEN(j)  (2304 + 64 * (j))
#define XB_TOP      3328
#define XB_TOPGEN   3392
#define XCD_BAR_WORDS 3456
#define XB_SPIN_CAP (1u << 18)

__device__ __forceinline__ unsigned xb_ld(unsigned* p)              { return __hip_atomic_load(p, __ATOMIC_RELAXED, __HIP_MEMORY_SCOPE_AGENT); }
__device__ __forceinline__ unsigned xb_add(unsigned* p, unsigned v) { return __hip_atomic_fetch_add(p, v, __ATOMIC_RELAXED, __HIP_MEMORY_SCOPE_AGENT); }
__device__ __forceinline__ unsigned xb_xcc_id() { return (unsigned)__builtin_amdgcn_s_getreg((3 << 11) | 20) & 0xFu; }
#define XB_SPIN(cond, bar) do { unsigned _sp = 0; while (cond) { __builtin_amdgcn_s_sleep(1); \
    if ((++_sp & 255u) == 0u) { if (xb_ld(&(bar)[XB_TMO])) break; if (_sp > XB_SPIN_CAP) { atomicAdd(&(bar)[XB_TMO], 1u); break; } } } } while (0)

struct XcdBarrier {
    unsigned* bar; unsigned x;
    volatile LAS unsigned* st;
};

__device__ __forceinline__ XcdBarrier xcd_barrier_post(unsigned* bar, volatile LAS unsigned* st) {
    XcdBarrier b; b.bar = bar; b.x = xb_xcc_id(); b.st = st;
    if (threadIdx.x == 0) (void)xb_add(&bar[XB_XCNT(b.x)], 1u);
    return b;
}
__device__ __forceinline__ void xcd_barrier_complete(unsigned* bar, unsigned x, unsigned& nloc, unsigned& nx) {
    const unsigned G = gridDim.x * gridDim.y * gridDim.z;
    unsigned sum, cnt, mine, sp = 0u;
    for (;;) {
        sum = 0u; cnt = 0u; mine = 0u;
#pragma unroll
        for (unsigned j = 0; j < 16; ++j) { const unsigned c = xb_ld(&bar[XB_XCNT(j)]); sum += c; cnt += (c > 0u) ? 1u : 0u; mine = (j == x) ? c : mine; }
        if (sum == G) break;
        __builtin_amdgcn_s_sleep(1);
        if ((++sp & 255u) == 0u) { if (xb_ld(&bar[XB_TMO])) break; if (sp > XB_SPIN_CAP) { atomicAdd(&bar[XB_TMO], 1u); break; } }
    }
    nloc = mine > 0u ? mine : 1u; nx = cnt > 0u ? cnt : 1u;
}

__device__ __forceinline__ void xcd_barrier(const XcdBarrier& b) {
    asm volatile("s_waitcnt vmcnt(0)" ::: "memory");
    __syncthreads();
    if (threadIdx.x == 0) {
        unsigned* bar = b.bar;
        __builtin_amdgcn_s_waitcnt(0);
        unsigned nloc = b.st[0], nx = b.st[1];
        if (nloc == 0u) { unsigned x_ = b.x; asm volatile("" : "+s"(x_)); xcd_barrier_complete(bar, x_, nloc, nx); b.st[0] = nloc; b.st[1] = nx; }
        const unsigned old = xb_add(&bar[XB_XSUB(b.x)], 1u);
        const unsigned gen = old / nloc;
        if (old + 1u == (gen + 1u) * nloc) {
            __builtin_amdgcn_fence(__ATOMIC_RELEASE, "agent");
            asm volatile("s_waitcnt vmcnt(0)" ::: "memory");
            const unsigned og = xb_add(&bar[XB_TOP], 1u);
            const unsigned tg = og / nx;
            if (og + 1u == (tg + 1u) * nx) xb_add(&bar[XB_TOPGEN], 1u);
            else XB_SPIN(xb_ld(&bar[XB_TOPGEN]) == tg, bar);
            __builtin_amdgcn_fence(__ATOMIC_ACQUIRE, "agent");
            xb_add(&bar[XB_XGEN(b.x)], 1u);
            asm volatile("s_waitcnt vmcnt(0)" ::: "memory");
        } else {
            XB_SPIN(xb_ld(&bar[XB_XGEN(b.x)]) == gen, bar);
            __builtin_amdgcn_fence(__ATOMIC_ACQUIRE, "agent");
            asm volatile("s_waitcnt vmcnt(0)" ::: "memory");
        }
    }
    __syncthreads();
}

typedef float f32x16 __attribute__((ext_vector_type(16)));
typedef float f32x2_t __attribute__((ext_vector_type(2)));
typedef __bf16 bf16x2_t __attribute__((ext_vector_type(2)));
typedef unsigned u32x2 __attribute__((ext_vector_type(2)));
__device__ __forceinline__ unsigned cvtpk(float lo, float hi) { f32x2_t v = {lo, hi}; bf16x2_t b = __builtin_convertvector(v, bf16x2_t); return __builtin_bit_cast(unsigned, b); }
__device__ __forceinline__ float bflo(unsigned w) { return __uint_as_float(w << 16); }
__device__ __forceinline__ float bfhi(unsigned w) { return __uint_as_float(w & 0xffff0000u); }
__device__ __forceinline__ void unpack8(const v4u& w, float (&x)[8]) { x[0] = bflo(w.x); x[1] = bfhi(w.x); x[2] = bflo(w.y); x[3] = bfhi(w.y); x[4] = bflo(w.z); x[5] = bfhi(w.z); x[6] = bflo(w.w); x[7] = bfhi(w.w); }
__device__ __forceinline__ v4u pack8(const float (&x)[8]) { v4u w; w.x = cvtpk(x[0], x[1]); w.y = cvtpk(x[2], x[3]); w.z = cvtpk(x[4], x[5]); w.w = cvtpk(x[6], x[7]); return w; }
__device__ __forceinline__ float wave_sum(float v) { v += shx<1>(v); v += shx<2>(v); v += shx<4>(v); v += shx<8>(v); v += shx<16>(v); return sh32_sum(v); }
__device__ __forceinline__ float wave_max(float v) { v = fmaxf(v, shx<1>(v)); v = fmaxf(v, shx<2>(v)); v = fmaxf(v, shx<4>(v)); v = fmaxf(v, shx<8>(v)); v = fmaxf(v, shx<16>(v)); return sh32_max(v); }
__device__ __forceinline__ int crow(int r, int hi) { return (r & 3) + 8 * (r >> 2) + 4 * hi; }

__device__ __forceinline__ int even_map(int n) {
    if (n < 512) return ES_FQ + n;
    if (n < 1024) return ES_DQ + (n - 512);
    if (n < 1536) return ES_FK + (n - 1024);
    if (n < 2048) return ES_DK + (n - 1536);
    if (n < 2560) return ES_FV + (n - 2048);
    if (n < 3072) return ES_DV + (n - 2560);
    if (n < 3584) return ES_IQ + (n - 3072);
    if (n < 3648) return ES_IK + (n - 3584);
    return -1;
}
__device__ __forceinline__ void conv_item(const float* W, int K, int Nsrc, int nblk, const float* gain, bf16* WT, int mode, LAS float* scr, int item, int lane) {
    const int kb = item / nblk, nb = item % nblk, k0 = 32 * kb, n0 = 128 * nb;
    const int n = n0 + 4 * (lane & 31);
    int sc;
    if (mode == 0) sc = n; else if (mode == 1) { const int T = n >> 8, hf = (n >> 7) & 1, j = n & 127; sc = hf * FF + 128 * T + j; } else sc = even_map(n);
    f32x4 v[16];
#pragma unroll
    for (int i = 0; i < 16; ++i) { const int kk = 2 * i + (lane >> 5); v[i] = (f32x4){0.f, 0.f, 0.f, 0.f};
        if (sc >= 0) v[i] = *(const GAS f32x4*)(W + (size_t)(k0 + kk) * Nsrc + sc); }
#pragma unroll
    for (int i = 0; i < 16; ++i) { const int kk = 2 * i + (lane >> 5); const float g = gain ? gain[k0 + kk] : 1.0f;
        *(LAS f32x4*)(scr + kk * 132 + 4 * (lane & 31)) = v[i] * g; }
    LDS_WAIT(); asm volatile("" ::: "memory");
    const int c = lane & 3;
#pragma unroll
    for (int j = 0; j < 8; ++j) { const int nn = (lane >> 2) + 16 * j; const LAS float* s = scr + (8 * c) * 132 + nn;
        v4u o; o.x = cvtpk(s[0 * 132], s[1 * 132]); o.y = cvtpk(s[2 * 132], s[3 * 132]); o.z = cvtpk(s[4 * 132], s[5 * 132]); o.w = cvtpk(s[6 * 132], s[7 * 132]);
        *(GAS v4u*)(WT + (size_t)(n0 + nn) * K + k0 + 8 * c) = o; }
    LDS_WAIT(); asm volatile("" ::: "memory");
}
struct InPtrs { const float* p[26]; };
constexpr int INTAB_OFF = LDSCTL_OFF + 1024;
struct InTab { LAS unsigned char* ldsbase;
    __device__ __forceinline__ const float* get(int k) const { const u32x2 v = *(const LAS u32x2*)(ldsbase + INTAB_OFF + 8 * k);
        const unsigned lo = (unsigned)__builtin_amdgcn_readfirstlane((int)v.x), hi = (unsigned)__builtin_amdgcn_readfirstlane((int)v.y);
        return (const float*)(((unsigned long long)hi << 32) | lo); } };
__device__ __forceinline__ void conv_weights(const InTab& in, unsigned char* ws, int L, int mask, LAS unsigned char* lds, int gw, int NGW, int wave, int lane) {
    LAS float* scr = (LAS float*)(lds + wave * 17408);
    unsigned char* Wr = ws + WS_W;
    const bool even = (L & 1) == 0;
    const int mixN = even ? EVEN_NP : ODD_N, mixSrc = even ? EVEN_SRC : ODD_N;
    const int I_FIN = (DM / 32) * (FF2 / 128), I_FOUT = (FF / 32) * (DM / 128), I_MIN = (DM / 32) * (mixN / 128), I_MOUT = (DM / 32) * (DM / 128), I_MQ = (DM / 32) * (MEMW / 128), I_MO = (MEMW / 32) * (DM / 128);
    const int n0 = (mask & 1) ? I_FIN : 0, n1 = (mask & 2) ? I_FOUT : 0, n2 = (mask & 4) ? I_MIN : 0, n3 = (mask & 8) ? I_MOUT : 0, n4 = (mask & 16) ? I_MQ : 0, n5 = (mask & 32) ? I_MO : 0,
              n6 = (mask & 64) ? I_FIN : 0, n7 = (mask & 128) ? I_FOUT : 0;
    const int NITEMS = n0 + n1 + n2 + n3 + n4 + n5 + n6 + n7;
    for (int it = gw; it < NITEMS; it += NGW) {
        int r = it;
        if (r < n0) { conv_item(in.get(3) + (size_t)L * DM * FF2, DM, FF2, FF2 / 128, in.get(2) + (size_t)L * DM, (bf16*)(Wr + W_FFN1_IN), 1, scr, r, lane); continue; } r -= n0;
        if (r < n6) { conv_item(in.get(24) + (size_t)L * DM * FF2, DM, FF2, FF2 / 128, in.get(23) + (size_t)L * DM, (bf16*)(Wr + W_FFN2_IN), 1, scr, r, lane); continue; } r -= n6;
        if (r < n1) { conv_item(in.get(4) + (size_t)L * FF * DM, FF, DM, DM / 128, nullptr, (bf16*)(Wr + W_FFN1_OUT), 0, scr, r, lane); continue; } r -= n1;
        if (r < n7) { conv_item(in.get(25) + (size_t)L * FF * DM, FF, DM, DM / 128, nullptr, (bf16*)(Wr + W_FFN2_OUT), 0, scr, r, lane); continue; } r -= n7;
        if (r < n2) { conv_item(even ? in.get(6) : in.get(12), DM, mixSrc, mixN / 128, in.get(5) + (size_t)L * DM, (bf16*)(Wr + W_MIX_IN), even ? 2 : 0, scr, r, lane); continue; } r -= n2;
        if (r < n3) { conv_item(in.get(15) + (size_t)L * DM * DM, DM, DM, DM / 128, nullptr, (bf16*)(Wr + W_MIX_OUT), 0, scr, r, lane); continue; } r -= n3;
        if (r < n4) { conv_item(in.get(18) + (size_t)L * DM * MEMW, DM, MEMW, MEMW / 128, in.get(16) + (size_t)L * DM, (bf16*)(Wr + (L ? W_MEMQ2 : W_MEMQ)), 0, scr, r, lane); continue; } r -= n4;
        conv_item(in.get(22) + (size_t)L * MEMW * DM, MEMW, DM, DM / 128, nullptr, (bf16*)(Wr + (L ? W_MEMO2 : W_MEMO)), 0, scr, r, lane);
    }
}
__device__ __forceinline__ void copy_x(const float* x, float* out, bf16* HB, float* ssq0, int gw, int NGW, int lane) {
    for (int m = gw; m < S; m += NGW) {
        const GAS f32x4* xr = (const GAS f32x4*)(x + (size_t)m * DM) + lane;
        GAS u32x2* hb = (GAS u32x2*)(HB + (size_t)m * DM) + lane;
        float s = 0.f;
#pragma unroll
        for (int j = 0; j < 4; ++j) { const f32x4 v = xr[64 * j]; s += (v.x * v.x + v.y * v.y) + (v.z * v.z + v.w * v.w);
            u32x2 w; w.x = cvtpk(v.x, v.y); w.y = cvtpk(v.z, v.w); hb[64 * j] = w; }
        s = wave_sum(s);
        if (lane < 16) ssq0[(size_t)m * 16 + lane] = (lane == 0) ? s : 0.f;
    }
}
__device__ __forceinline__ void rope_tables(float* cosT, float* sinT, int gtid, int nthreads) {
    for (int idx = gtid; idx < S * 8; idx += nthreads) {
        const int t = idx >> 3, j = idx & 7;
        float inv;
        switch (j) { case 0: inv = 1.0f; break; case 1: inv = 0.193922743f; break; case 2: inv = 0.0376060307f; break; case 3: inv = 0.00729266461f; break;
                     case 4: inv = 0.00141421356f; break; case 5: inv = 0.000274248188f; break; case 6: inv = 5.3182961e-05f; break; default: inv = 1.03133862e-05f; break; }
        const float ang = (float)t * inv;
        const float kq = __builtin_rintf(ang * 0.63661977236758134f);
        float r = ang - kq * 1.5703125f; r = r - kq * 0.00048351287841796875f; r = r - kq * 3.1391647326017846e-07f;
        const float r2 = r * r;
        float sp = 2.7557319e-6f; sp = sp * r2 - 1.9841270e-4f; sp = sp * r2 + 8.3333333e-3f; sp = sp * r2 - 1.6666667e-1f; const float sn = r + r * r2 * sp;
        float cp = -2.7557319e-7f; cp = cp * r2 + 2.4801587e-5f; cp = cp * r2 - 1.3888889e-3f; cp = cp * r2 + 4.1666667e-2f; cp = cp * r2 - 0.5f; const float cs = 1.0f + r2 * cp;
        const int q = ((int)kq) & 3;
        const float sv = (q == 0) ? sn : (q == 1) ? cs : (q == 2) ? -sn : -cs;
        const float cv = (q == 0) ? cs : (q == 1) ? -sn : (q == 2) ? -cs : sn;
        cosT[idx] = cv; sinT[idx] = sv;
    }
}
__device__ __forceinline__ void mem_kv(const InTab& in, unsigned char* ws, LAS unsigned char* lds, int unit, int tid, int wave, int lane) {
    LAS float* memn = (LAS float*)lds;
    bf16* memK = (bf16*)(ws + WS_MEMK); bf16* memVt = (bf16*)(ws + WS_MEMK + 256 * 1024);
    const int L = unit >> 6, rb = (unit >> 3) & 7, cb = unit & 7;
    const float* gm = in.get(17) + (size_t)L * DM; const float* wkv = in.get(19) + (size_t)L * DM * 512; const float* kn = in.get(21) + (size_t)L * 64;
    __syncthreads();
    for (int i = 0; i < 4; ++i) { const int r = wave * 4 + i; const float* mrow = in.get(1) + (size_t)(rb * 32 + r) * DM;
        f32x4 v[4]; float s = 0.f;
#pragma unroll
        for (int j = 0; j < 4; ++j) { v[j] = *((const GAS f32x4*)mrow + lane + 64 * j); s += (v[j].x * v[j].x + v[j].y * v[j].y) + (v[j].z * v[j].z + v[j].w * v[j].w); }
        const float rstd = rsqrtf(wave_sum(s) * (1.0f / DM) + RMS_EPS);
#pragma unroll
        for (int j = 0; j < 4; ++j) { const f32x4 g = *((const GAS f32x4*)gm + lane + 64 * j); *(LAS f32x4*)(memn + r * 1028 + 4 * (lane + 64 * j)) = v[j] * rstd * g; } }
    __syncthreads();
    const int r = tid >> 4, c4 = (tid & 15) * 4;
    f32x4 acc = (f32x4){0.f, 0.f, 0.f, 0.f};
    const float* wp = wkv + cb * 64 + c4; const LAS float* mp = memn + r * 1028;
#pragma unroll 8
    for (int k = 0; k < DM; ++k) acc = acc + *(const GAS f32x4*)(wp + (size_t)k * 512) * mp[k];
    const int tok = rb * 32 + r;
    if (cb < 4) {
        float ss = (acc.x * acc.x + acc.y * acc.y) + (acc.z * acc.z + acc.w * acc.w);
        ss += shx<1>(ss); ss += shx<2>(ss); ss += shx<4>(ss); ss += shx<8>(ss);
        const float rs = rsqrtf(ss * (1.0f / 64.0f) + RMS_EPS);
        u32x2 w; w.x = cvtpk(acc.x * rs * kn[c4], acc.y * rs * kn[c4 + 1]); w.y = cvtpk(acc.z * rs * kn[c4 + 2], acc.w * rs * kn[c4 + 3]);
        *(GAS u32x2*)(memK + (size_t)L * 65536 + (size_t)tok * 256 + cb * 64 + c4) = w;
    } else {
        const int c = (cb - 4) * 64 + c4; bf16* vp = memVt + (size_t)L * 65536 + (size_t)c * 256 + tok;
        vp[0] = (bf16)(cvtpk(acc.x, 0.f) & 0xffffu); vp[256] = (bf16)(cvtpk(acc.y, 0.f) & 0xffffu); vp[512] = (bf16)(cvtpk(acc.z, 0.f) & 0xffffu); vp[768] = (bf16)(cvtpk(acc.w, 0.f) & 0xffffu);
    }
}

__device__ __forceinline__ void head_norm8(float (&x)[8], const float* gain, int lane) {
    float ss = 0.f;
#pragma unroll
    for (int j = 0; j < 8; ++j) ss += x[j] * x[j];
    ss += shx<1>(ss); ss += shx<2>(ss); ss += shx<4>(ss);
    const float r = rsqrtf(ss * (1.0f / 64.0f) + RMS_EPS);
    const int d0 = 8 * (lane & 7);
#pragma unroll
    for (int j = 0; j < 8; ++j) x[j] = x[j] * r * gain[d0 + j];
}
__device__ __forceinline__ void rope8(float (&x)[8], const float (&cs)[8], const float (&sn)[8], int lane) {
    const int sub = lane & 7;
#pragma unroll
    for (int j = 0; j < 8; ++j) {
        const float other = shx<1>(x[j]);
        if (sub == 0) x[j] = x[j] * cs[j] - other * sn[j];
        else if (sub == 1) x[j] = x[j] * cs[j] + other * sn[j];
    }
}
__device__ __forceinline__ float sh32_get(float v, int lane) { auto r = __builtin_amdgcn_permlane32_swap(__float_as_uint(v), __float_as_uint(v), false, false); return __uint_as_float((lane < 32) ? r[1] : r[0]); }
__device__ __forceinline__ float reduce_scatter64(float (&v)[64], int lane) {
    { const bool up = (lane & 32) != 0;
#pragma unroll
      for (int j = 0; j < 32; ++j) { const float send = up ? v[j] : v[j + 32], keep = up ? v[j + 32] : v[j]; v[j] = keep + sh32_get(send, lane); } }
    { const bool up = (lane & 16) != 0;
#pragma unroll
      for (int j = 0; j < 16; ++j) { const float send = up ? v[j] : v[j + 16], keep = up ? v[j + 16] : v[j]; v[j] = keep + shx<16>(send); } }
    { const bool up = (lane & 8) != 0;
#pragma unroll
      for (int j = 0; j < 8; ++j) { const float send = up ? v[j] : v[j + 8], keep = up ? v[j + 8] : v[j]; v[j] = keep + shx<8>(send); } }
    { const bool up = (lane & 4) != 0;
#pragma unroll
      for (int j = 0; j < 4; ++j) { const float send = up ? v[j] : v[j + 4], keep = up ? v[j + 4] : v[j]; v[j] = keep + shx<4>(send); } }
    { const bool up = (lane & 2) != 0;
#pragma unroll
      for (int j = 0; j < 2; ++j) { const float send = up ? v[j] : v[j + 2], keep = up ? v[j + 2] : v[j]; v[j] = keep + shx<2>(send); } }
    { const bool up = (lane & 1) != 0; const float send = up ? v[0] : v[1], keep = up ? v[1] : v[0]; v[0] = keep + shx<1>(send); }
    return v[0];
}
__device__ __forceinline__ void post_even(const InTab& in, unsigned char* ws, const float* H, const float* ssq, LAS unsigned char* lds, int G, int tid, int wave, int lane) {
    float* Flocal = (float*)(ws + WS_FL); float* Btot = Flocal + S * 8; float* IW = (float*)(ws + WS_IW);
    const float* bfg = in.get(7);
    LAS f32x4* Tw = (LAS f32x4*)lds;
    LAS float* lf = (LAS float*)(lds + 65536);
    { const GAS f32x4* src = (const GAS f32x4*)(ws + WS_TW);
#pragma unroll
      for (int i = 0; i < 8; ++i) Tw[tid + 512 * i] = src[tid + 512 * i]; }
    __syncthreads();
    for (int u = blockIdx.x; u < S / 64; u += G) {
        const int t0 = u * 64, tw0 = t0 + wave * 8;
#pragma unroll 1
        for (int rb = 0; rb < 2; ++rb) {
            float acc[64];
#pragma unroll
            for (int j = 0; j < 64; ++j) acc[j] = 0.f;
#pragma unroll
            for (int q = 0; q < 4; ++q) {
                f32x4 hv[4];
#pragma unroll
                for (int r = 0; r < 4; ++r) hv[r] = *((const GAS f32x4*)(H + (size_t)(tw0 + rb * 4 + r) * DM) + lane + 64 * q);
#pragma unroll
                for (int e = 0; e < 4; ++e)
#pragma unroll
                    for (int c = 0; c < 4; ++c) { const f32x4 w = Tw[((q * 4 + e) * 4 + c) * 64 + lane];
#pragma unroll
                        for (int r = 0; r < 4; ++r) { acc[r * 16 + 4 * c + 0] += hv[r][e] * w[0]; acc[r * 16 + 4 * c + 1] += hv[r][e] * w[1]; acc[r * 16 + 4 * c + 2] += hv[r][e] * w[2]; acc[r * 16 + 4 * c + 3] += hv[r][e] * w[3]; } }
            }
            const float zs = reduce_scatter64(acc, lane);
            const int rl = wave * 8 + rb * 4 + (lane >> 4), t = t0 + rl, j = lane & 15;
            const float z = zs * pg8::row_rstd(ssq, t);
            if (j < 8) { const float zz = z + bfg[j]; lf[rl * 8 + j] = (zz > 15.f) ? -expf(-zz) : -log1pf(expf(-zz)); }
            else IW[(size_t)t * 8 + (j - 8)] = z * 0.044194173824159216f;
        }
        __syncthreads();
        {
            float v = lf[lane * 8 + wave];
#pragma unroll
            for (int o = 1; o < 64; o <<= 1) { const float up = __int_as_float(__builtin_amdgcn_ds_bpermute(((lane - o) & 63) << 2, __float_as_int(v))); if (lane >= o) v += up; }
            Flocal[(size_t)(t0 + lane) * 8 + wave] = v;
            if (lane == 63) Btot[u * 8 + wave] = v;
        }
        __syncthreads();
    }
}

__device__ __forceinline__ void post_odd(unsigned char* ws, LAS unsigned char* lds, int G, int tid) {
    const bf16* Kb = (const bf16*)(ws + WS_BIG + B_PROJ) + (size_t)S * DM; float* ksum = (float*)(ws + WS_KSUM);
    LAS float* red = (LAS float*)lds;
    for (int u = blockIdx.x; u < 256; u += G) {
        const int n = u >> 2, cg = u & 3, c2 = tid & 127, rg = tid >> 7;
        const bf16* kp = Kb + (size_t)(n * 256 + rg * 64) * DM + cg * 256 + c2 * 2;
        float s0 = 0.f, s1 = 0.f;
#pragma unroll 16
        for (int r = 0; r < 64; ++r) { const unsigned w = *(const GAS unsigned*)(kp + (size_t)r * DM); s0 += bflo(w); s1 += bfhi(w); }
        __syncthreads();
        red[rg * 256 + c2 * 2] = s0; red[rg * 256 + c2 * 2 + 1] = s1;
        __syncthreads();
        if (tid < 256) ksum[(size_t)n * 1024 + cg * 256 + tid] = (red[tid] + red[256 + tid]) + (red[512 + tid] + red[768 + tid]);
    }
}

constexpr int KV_K_BYTES = 8192, KV_VT_PITCH = 136, KV_BUF_BYTES = KV_K_BYTES + 64 * KV_VT_PITCH;
struct KVRegs { v4u k, v; };
__device__ __forceinline__ void kv_load(KVRegs& r, const bf16* Kp, size_t kpitch, const bf16* Vtp, size_t vtpitch, int key0, int tid) {
    r.k = *(const GAS v4u*)(Kp + (size_t)(key0 + (tid & 63)) * kpitch + (tid >> 6) * 8);
    r.v = *(const GAS v4u*)(Vtp + (size_t)(tid >> 3) * vtpitch + key0 + (tid & 7) * 8);
}
__device__ __forceinline__ void kv_store(const KVRegs& r, LAS unsigned char* buf, int tid) {
    *(LAS v4u*)(buf + ((tid >> 6) * 64 + (tid & 63)) * 16) = r.k;
    LAS unsigned char* vp = buf + KV_K_BYTES + (tid >> 3) * KV_VT_PITCH + (tid & 7) * 16;
    *(LAS u32x2*)vp = (u32x2){r.v.x, r.v.y}; *(LAS u32x2*)(vp + 8) = (u32x2){r.v.z, r.v.w};
}
struct AttnAcc { float m, l; f32x16 o0, o1; };
__device__ __forceinline__ void attn_init(AttnAcc& a) { a.m = -INFINITY; a.l = 0.f;
#pragma unroll
    for (int r = 0; r < 16; ++r) { a.o0[r] = 0.f; a.o1[r] = 0.f; } }
template <int CHS = 1024>
__device__ __forceinline__ void attn_scores(f32x16& p0, f32x16& p1, const LAS unsigned char* buf, const bf16x8 (&qf)[4], int lane) {
    const int r32 = lane & 31, hi = lane >> 5;
#pragma unroll
    for (int r = 0; r < 16; ++r) { p0[r] = 0.f; p1[r] = 0.f; }
#pragma unroll
    for (int ks = 0; ks < 4; ++ks) {
        const bf16x8 k0 = *(const LAS bf16x8*)(buf + (2 * ks + hi) * CHS + r32 * 16);
        const bf16x8 k1 = *(const LAS bf16x8*)(buf + (2 * ks + hi) * CHS + (32 + r32) * 16);
        p0 = __builtin_amdgcn_mfma_f32_32x32x16_bf16(k0, qf[ks], p0, 0, 0, 0);
        p1 = __builtin_amdgcn_mfma_f32_32x32x16_bf16(k1, qf[ks], p1, 0, 0, 0);
    }
}
template <int VTP = KV_VT_PITCH, int VOFF = KV_K_BYTES>
__device__ __forceinline__ void attn_update(AttnAcc& a, f32x16& p0, f32x16& p1, const LAS unsigned char* buf, int lane) {
    const int r32 = lane & 31, hi = lane >> 5;
    float mx = fmaxf(p0[0], p1[0]);
#pragma unroll
    for (int r = 1; r < 16; ++r) mx = fmaxf(mx, fmaxf(p0[r], p1[r]));
    mx = sh32_max(mx);
    const float mnew = fmaxf(a.m, mx);
    const float msafe = (mnew == -INFINITY) ? 0.f : mnew;
    const float alpha = __builtin_amdgcn_exp2f(a.m - msafe);
    float sum = 0.f;
#pragma unroll
    for (int r = 0; r < 16; ++r) { p0[r] = __builtin_amdgcn_exp2f(p0[r] - msafe); p1[r] = __builtin_amdgcn_exp2f(p1[r] - msafe); sum += p0[r] + p1[r]; }
    a.l = a.l * alpha + sum; a.m = mnew;
#pragma unroll
    for (int r = 0; r < 16; ++r) { a.o0[r] *= alpha; a.o1[r] *= alpha; }
    const LAS unsigned char* vt = buf + VOFF + r32 * VTP + hi * 8;
#pragma unroll
    for (int half = 0; half < 2; ++half) {
#pragma unroll
        for (int s = 0; s < 2; ++s) {
            v4u pw;
            if (half == 0) { pw.x = cvtpk(p0[8 * s + 0], p0[8 * s + 1]); pw.y = cvtpk(p0[8 * s + 2], p0[8 * s + 3]); pw.z = cvtpk(p0[8 * s + 4], p0[8 * s + 5]); pw.w = cvtpk(p0[8 * s + 6], p0[8 * s + 7]); }
            else           { pw.x = cvtpk(p1[8 * s + 0], p1[8 * s + 1]); pw.y = cvtpk(p1[8 * s + 2], p1[8 * s + 3]); pw.z = cvtpk(p1[8 * s + 4], p1[8 * s + 5]); pw.w = cvtpk(p1[8 * s + 6], p1[8 * s + 7]); }
            const bf16x8 pb = __builtin_bit_cast(bf16x8, pw);
            const int kb = (32 * half + 16 * s) * 2;
#pragma unroll
            for (int d0 = 0; d0 < 2; ++d0) {
                const u32x2 lo = *(const LAS u32x2*)(vt + d0 * 32 * VTP + kb), hi2 = *(const LAS u32x2*)(vt + d0 * 32 * VTP + kb + 16);
                const bf16x8 va = __builtin_bit_cast(bf16x8, (v4u){lo.x, lo.y, hi2.x, hi2.y});
                if (d0 == 0) a.o0 = __builtin_amdgcn_mfma_f32_32x32x16_bf16(va, pb, a.o0, 0, 0, 0);
                else         a.o1 = __builtin_amdgcn_mfma_f32_32x32x16_bf16(va, pb, a.o1, 0, 0, 0);
            }
        }
    }
}
__device__ __forceinline__ void attn_store(const AttnAcc& a, bf16* orow, int lane) {
    const int hi = lane >> 5;
    float l = sh32_sum(a.l);
    const float inv = (l > 0.f) ? 1.0f / l : 0.f;
#pragma unroll
    for (int g = 0; g < 4; ++g) {
        u32x2 w0, w1;
        w0.x = cvtpk(a.o0[4 * g] * inv, a.o0[4 * g + 1] * inv); w0.y = cvtpk(a.o0[4 * g + 2] * inv, a.o0[4 * g + 3] * inv);
        w1.x = cvtpk(a.o1[4 * g] * inv, a.o1[4 * g + 1] * inv); w1.y = cvtpk(a.o1[4 * g + 2] * inv, a.o1[4 * g + 3] * inv);
        *(GAS u32x2*)(orow + 8 * g + 4 * hi) = w0; *(GAS u32x2*)(orow + 32 + 8 * g + 4 * hi) = w1;
    }
}
__device__ __forceinline__ void load_q(bf16x8 (&qf)[4], const bf16* qrow, int lane) {
    const int hi = lane >> 5;
#pragma unroll
    for (int ks = 0; ks < 4; ++ks) qf[ks] = *(const GAS bf16x8*)(qrow + 16 * ks + 8 * hi);
}

constexpr int CW_FOXQ = 64;
__device__ __forceinline__ void fox_phase(const InTab& in, unsigned char* ws, LAS unsigned char* lds, int G, int tid, int wave, int lane, bf16* obase, size_t opitch, int qword) {
    bf16* proj = (bf16*)(ws + WS_BIG + B_PROJ); const bf16* VtF = (const bf16*)(ws + WS_BIG + B_VTF);
    const float* Flocal = (const float*)(ws + WS_FL); const float* Btot = Flocal + S * 8;
    unsigned* qctr = (unsigned*)(ws + WS_CTL) + qword;
    LAS unsigned char* kvb = lds; LAS float* kbt = (LAS float*)(lds + 2 * KV_BUF_BYTES); LAS float* bt = (LAS float*)(lds + 2 * KV_BUF_BYTES + 65536); LAS float* Et = bt + 272;
    LAS int* misc = (LAS int*)(Et + 272);
    const int r32 = lane & 31, hi = lane >> 5;
    if (wave == 0) { const float gq = wave_max(fabsf(in.get(8)[lane])), gk = wave_max(fabsf(in.get(9)[lane])); if (lane == 0) { ((LAS float*)misc)[2] = gq; ((LAS float*)misc)[3] = gk; } }
    __syncthreads();
    const float THR = 2.0f * (0.125f * LOG2E * 64.0f * 1.02f) * ((LAS float*)misc)[2] * ((LAS float*)misc)[3] + 32.0f;
    for (;;) {
        __syncthreads();
        if (tid == 0) misc[0] = (int)atomicAdd(qctr, 1u);
        __syncthreads();
        const int u = misc[0];
        if (u >= 512) break;
        const int QB = 63 - (u >> 3), h = u & 7, q0 = QB * 256, nt = 4 * (QB + 1);
        for (int j = tid; j < nt; j += NTHREADS) bt[j] = Btot[j * 8 + h];
        if (tid == 0) misc[1] = 4 * QB;
        __syncthreads();
        for (int j = tid; j <= nt; j += NTHREADS) { float e = 0.f;
            if (j <= 4 * QB) { for (int i = 4 * QB - 1; i >= j; --i) e -= bt[i]; } else { for (int i = 4 * QB; i < j; ++i) e += bt[i]; }
            Et[j] = e; }
        __syncthreads();
        for (int j = tid; j < 4 * QB; j += NTHREADS) if (Et[j + 1] * LOG2E <= THR) atomicMin((int*)&misc[1], j);
        __syncthreads();
        const int t_start = misc[1], s0 = 64 * t_start;
        for (int s = s0 + tid; s < q0 + 256; s += NTHREADS) kbt[s - s0] = -(Et[s >> 6] + Flocal[(size_t)s * 8 + h]) * LOG2E;
        const int qrow = q0 + wave * 32 + r32;
        bf16x8 qf[4]; load_q(qf, proj + (size_t)qrow * EVEN_NP + EC_FQ + h * 64, lane);
        AttnAcc a; attn_init(a);
        const bf16* Kp = proj + EC_FK + h * 64; const bf16* Vtp = VtF + (size_t)h * 64 * S;
        KVRegs kr; kv_load(kr, Kp, EVEN_NP, Vtp, S, s0, tid); kv_store(kr, kvb, tid);
        __syncthreads();
        const float kbw = kbt[q0 + wave * 32 - s0];
        for (int t = t_start; t < nt; ++t) {
            LAS unsigned char* cur = kvb + ((t - t_start) & 1) * KV_BUF_BYTES;
            if (t + 1 < nt) kv_load(kr, Kp, EVEN_NP, Vtp, S, (t + 1) * 64, tid);
            const int key0 = t * 64;
            const bool vis = key0 <= q0 + wave * 32 + 31;
            const bool live = (key0 + 63 >= q0) || (kbw - kbt[key0 + 63 - s0] <= THR);
            if (vis && __builtin_amdgcn_readfirstlane((int)live)) {
                f32x16 p0, p1; attn_scores(p0, p1, cur, qf, lane);
#pragma unroll
                for (int g = 0; g < 4; ++g) {
                    const f32x4 b0 = *(const LAS f32x4*)(kbt + key0 - s0 + 8 * g + 4 * hi), b1 = *(const LAS f32x4*)(kbt + key0 - s0 + 32 + 8 * g + 4 * hi);
#pragma unroll
                    for (int e = 0; e < 4; ++e) { p0[4 * g + e] = p0[4 * g + e] * C2 + b0[e]; p1[4 * g + e] = p1[4 * g + e] * C2 + b1[e]; }
                }
                if (key0 + 63 > q0 + wave * 32) {
#pragma unroll
                    for (int r = 0; r < 16; ++r) { const int kv = key0 + crow(r, hi); if (kv > qrow) p0[r] = -INFINITY; if (kv + 32 > qrow) p1[r] = -INFINITY; }
                }
                attn_update(a, p0, p1, cur, lane);
            }
            if (t + 1 < nt) kv_store(kr, kvb + ((t + 1 - t_start) & 1) * KV_BUF_BYTES, tid);
            __syncthreads();
        }
        attn_store(a, obase + (size_t)qrow * opitch + h * 64, lane);
    }
}

__device__ __forceinline__ void memattn_phase(const InTab& in, unsigned char* ws, int L, LAS unsigned char* lds, int G, int tid, int wave, int lane) {
    const bf16* QM = (const bf16*)(ws + WS_BIG + B_QM); bf16* OM = (bf16*)(ws + WS_BIG + B_OM);
    const bf16* memK = (const bf16*)(ws + WS_MEMK) + (size_t)L * 256 * 256; const bf16* memVt = (const bf16*)(ws + WS_MEMK + 256 * 1024) + (size_t)L * 256 * 256;
    const float* qn = in.get(20) + (size_t)L * 64;
    LAS unsigned char* kvb = lds;
    const int r32 = lane & 31, hi = lane >> 5;
    for (int un = blockIdx.x; un < 256; un += G) {
        const int QB = un >> 2, hm = un & 3, qrow = QB * 256 + wave * 32 + r32;
        bf16x8 qf[4];
        {
            const bf16* qp = QM + (size_t)qrow * MEMW + hm * 64; float x[4][8]; float ss = 0.f;
#pragma unroll
            for (int ks = 0; ks < 4; ++ks) { const v4u w = *(const GAS v4u*)(qp + 16 * ks + 8 * hi); unpack8(w, x[ks]);
#pragma unroll
                for (int j = 0; j < 8; ++j) ss += x[ks][j] * x[ks][j]; }
            ss = sh32_sum(ss);
            const float r = rsqrtf(ss * (1.0f / 64.0f) + RMS_EPS);
#pragma unroll
            for (int ks = 0; ks < 4; ++ks) {
#pragma unroll
                for (int j = 0; j < 8; ++j) x[ks][j] = x[ks][j] * r * qn[16 * ks + 8 * hi + j];
                qf[ks] = __builtin_bit_cast(bf16x8, pack8(x[ks])); }
        }
        AttnAcc a; attn_init(a);
        const bf16* Kp = memK + hm * 64; const bf16* Vtp = memVt + (size_t)hm * 64 * 256;
        __syncthreads();
        KVRegs kr; kv_load(kr, Kp, 256, Vtp, 256, 0, tid); kv_store(kr, kvb, tid);
        __syncthreads();
        for (int t = 0; t < 4; ++t) {
            LAS unsigned char* cur = kvb + (t & 1) * KV_BUF_BYTES;
            if (t + 1 < 4) kv_load(kr, Kp, 256, Vtp, 256, (t + 1) * 64, tid);
            f32x16 p0, p1; attn_scores(p0, p1, cur, qf, lane);
#pragma unroll
            for (int r = 0; r < 16; ++r) { p0[r] *= C2; p1[r] *= C2; }
            attn_update(a, p0, p1, cur, lane);
            if (t + 1 < 4) kv_store(kr, kvb + ((t + 1) & 1) * KV_BUF_BYTES, tid);
            __syncthreads();
        }
        attn_store(a, OM + (size_t)qrow * MEMW + hm * 64, lane);
    }
}

constexpr size_t WS_MSEL = 7 * MiB;
constexpr size_t WS_MLSE = 8 * MiB;
constexpr size_t B_OP0 = 64 * MiB, B_OP1 = 128 * MiB;
__device__ __forceinline__ bool gate_better(float g1, int n1, float g2, int n2) { return g1 > g2 || (g1 == g2 && n1 < n2); }
__device__ __forceinline__ void moba_gate_phase(unsigned char* ws, int G, int wave, int lane) {
    const bf16* Q = (const bf16*)(ws + WS_BIG + B_PROJ); const float* ksum = (const float*)(ws + WS_KSUM); unsigned* selg = (unsigned*)(ws + WS_MSEL);
    const int r32 = lane & 31, hi = lane >> 5;
    const int NW = G * NWAVES;
    const int gwid = (int)blockIdx.x * NWAVES + wave;
    const int per_head = NW / 16;
    if (per_head == 0) return;
    const int h = gwid / per_head, wi = gwid % per_head;
    if (h >= 16) return;
    float af[2][32];
#pragma unroll
    for (int g = 0; g < 2; ++g)
#pragma unroll
        for (int kk = 0; kk < 32; ++kk) af[g][kk] = ksum[(size_t)(32 * g + r32) * 1024 + h * 64 + 2 * kk + hi] * (1.0f / 256.0f);
    for (int tile = wi; tile < S / 32; tile += per_head) {
        const int t = tile * 32 + r32, own = (tile * 32) >> 8;
        float bq[32];
        { const bf16* qp = Q + (size_t)t * DM + h * 64;
#pragma unroll
          for (int c = 0; c < 8; ++c) { const unsigned sh = hi ? 0u : 16u;   const v4u w = *(const GAS v4u*)(qp + 8 * c);
              bq[4 * c + 0] = __uint_as_float((w.x << sh) & 0xffff0000u); bq[4 * c + 1] = __uint_as_float((w.y << sh) & 0xffff0000u);
              bq[4 * c + 2] = __uint_as_float((w.z << sh) & 0xffff0000u); bq[4 * c + 3] = __uint_as_float((w.w << sh) & 0xffff0000u); } }
        float g0 = -INFINITY, g1 = -INFINITY, g2 = -INFINITY; int n0 = 255, n1 = 255, n2 = 255;
#pragma unroll
        for (int g = 0; g < 2; ++g) {
            if (32 * g < own) {
                f32x16 c;
#pragma unroll
                for (int r = 0; r < 16; ++r) c[r] = 0.f;
#pragma unroll
                for (int kk = 0; kk < 32; ++kk) c = __builtin_amdgcn_mfma_f32_32x32x2f32(af[g][kk], bq[kk], c, 0, 0, 0);
#pragma unroll
                for (int r = 0; r < 16; ++r) { const int n = 32 * g + crow(r, hi); const float gv = (n < own) ? c[r] : -INFINITY;
                    if (n < own) {
                        if (gate_better(gv, n, g0, n0)) { g2 = g1; n2 = n1; g1 = g0; n1 = n0; g0 = gv; n0 = n; }
                        else if (gate_better(gv, n, g1, n1)) { g2 = g1; n2 = n1; g1 = gv; n1 = n; }
                        else if (gate_better(gv, n, g2, n2)) { g2 = gv; n2 = n; } } }
            }
        }
        const float p0 = sh32_get(g0, lane), p1 = sh32_get(g1, lane), p2 = sh32_get(g2, lane);
        const int pn0 = __float_as_int(sh32_get(__int_as_float(n0), lane)), pn1 = __float_as_int(sh32_get(__int_as_float(n1), lane)), pn2 = __float_as_int(sh32_get(__int_as_float(n2), lane));
        float fg[3]; int fn[3]; int ia = 0, ib = 0;
#pragma unroll
        for (int k = 0; k < 3; ++k) {
            const float ga = (ia == 0) ? g0 : (ia == 1) ? g1 : (ia == 2) ? g2 : -INFINITY; const int na = (ia == 0) ? n0 : (ia == 1) ? n1 : (ia == 2) ? n2 : 255;
            const float gb = (ib == 0) ? p0 : (ib == 1) ? p1 : (ib == 2) ? p2 : -INFINITY; const int nb = (ib == 0) ? pn0 : (ib == 1) ? pn1 : (ib == 2) ? pn2 : 255;
            const bool ta = (na != 255) && (nb == 255 || gate_better(ga, na, gb, nb));
            if (ta) { fg[k] = ga; fn[k] = na; ++ia; } else { fg[k] = gb; fn[k] = nb; ++ib; }
        }
        (void)fg;
        if (hi == 0) selg[(size_t)h * S + t] = (unsigned)(fn[0] & 255) | ((unsigned)(fn[1] & 255) << 8) | ((unsigned)(fn[2] & 255) << 16);
    }
}
constexpr int MR_KIMG = 32768, MR_VTP = 520, MR_VIMG = 64 * MR_VTP;
constexpr int CW_MOBAQ = 192;
__device__ __forceinline__ void moba_route_phase(unsigned char* ws, LAS unsigned char* lds, int G, int tid, int wave, int lane, int qword) {
    const bf16* Q = (const bf16*)(ws + WS_BIG + B_PROJ); const bf16* Kb = Q + (size_t)S * DM; const bf16* Vt = (const bf16*)(ws + WS_BIG + B_VTM);
    const unsigned* selg = (const unsigned*)(ws + WS_MSEL); float* lse = (float*)(ws + WS_MLSE);
    unsigned* qctr = (unsigned*)(ws + WS_CTL) + qword;
    LAS unsigned char* kimg = lds; LAS unsigned char* vimg = lds + MR_KIMG;
    LAS int* list = (LAS int*)(lds + MR_KIMG + MR_VIMG);
    LAS int* wtot = list + 4096;
    LAS int* ubox = wtot + 64;
    const int r32 = lane & 31, hi = lane >> 5;
    const int NUNITS = 16 * 156;
    for (;;) {
        __syncthreads();
        if (tid == 0) ubox[0] = (int)atomicAdd(qctr, 1u);
        __syncthreads();
        const int u = ubox[0];
        if (u >= NUNITS) break;
        int c = 0, rem = u;
        while (rem >= 16 * min(63, 16 * c + 15)) { rem -= 16 * min(63, 16 * c + 15); ++c; }
        const int n = rem >> 4, h = rem & 15;
        const int tlo = max(4096 * c, 256 * (n + 1));
        v4u kst[4], vst[4];
        { const bf16* Kp = Kb + (size_t)(256 * n) * DM + h * 64; const bf16* Vp = Vt + (size_t)h * 64 * S + 256 * n;
#pragma unroll
          for (int i = 0; i < 4; ++i) { const int piece = tid + 512 * i;
              kst[i] = *(const GAS v4u*)(Kp + (size_t)(piece >> 3) * DM + (piece & 7) * 8);
              vst[i] = *(const GAS v4u*)(Vp + (size_t)(piece >> 5) * S + (piece & 31) * 8); } }
        int myent[8]; bool mysel[8];
#pragma unroll
        for (int i = 0; i < 8; ++i) { const int t = 4096 * c + 512 * i + tid; mysel[i] = false; myent[i] = 0;
            if (t >= tlo) { const unsigned w = selg[(size_t)h * S + t];
                const int slot = ((w & 255u) == (unsigned)n) ? 0 : (((w >> 8) & 255u) == (unsigned)n) ? 1 : (((w >> 16) & 255u) == (unsigned)n) ? 2 : -1;
                if (slot >= 0) { mysel[i] = true; myent[i] = t | (slot << 16); } }
            const unsigned long long mk = __ballot(mysel[i]);
            if (lane == 0) wtot[i * 8 + wave] = __popcll(mk); }
        __syncthreads();
        int cnt = 0;
#pragma unroll
        for (int i = 0; i < 8; ++i) { int base = cnt;
#pragma unroll
            for (int w8 = 0; w8 < 8; ++w8) { const int v = wtot[i * 8 + w8]; if (w8 < wave) base += v; cnt += v; }
            const unsigned long long mk = __ballot(mysel[i]);
            if (mysel[i]) list[base + __popcll(mk & ((1ull << lane) - 1ull))] = myent[i]; }
#pragma unroll
        for (int i = 0; i < 4; ++i) { const int piece = tid + 512 * i;
            *(LAS v4u*)(kimg + ((piece & 7) * 256 + (piece >> 3)) * 16) = kst[i];
            LAS unsigned char* vp = vimg + (piece >> 5) * MR_VTP + (piece & 31) * 16;
            *(LAS u32x2*)vp = (u32x2){vst[i].x, vst[i].y}; *(LAS u32x2*)(vp + 8) = (u32x2){vst[i].z, vst[i].w}; }
        __syncthreads();
        if (cnt == 0) continue;
        const int ntile = (cnt + 31) >> 5;
        for (int ti = wave; ti < ntile; ti += NWAVES) {
            const int e = ti * 32 + r32; const bool live = e < cnt;
            const int ent = list[live ? e : 0]; const int t = ent & 0xffff, slot = ent >> 16;
            bf16x8 qf[4]; load_q(qf, Q + (size_t)t * DM + h * 64, lane);
            AttnAcc a; attn_init(a);
#pragma unroll 1
            for (int j = 0; j < 4; ++j) {
                f32x16 p0, p1; attn_scores<4096>(p0, p1, kimg + j * 64 * 16, qf, lane);
#pragma unroll
                for (int r = 0; r < 16; ++r) { p0[r] *= C2; p1[r] *= C2; }
                attn_update<MR_VTP, 0>(a, p0, p1, vimg + j * 128, lane);
            }
            const float l = sh32_sum(a.l); const float inv = 1.0f / l;
            if (live) {
                bf16* orow = (bf16*)(ws + (slot == 0 ? WS_BIG + B_OP0 : slot == 1 ? WS_BIG + B_OP1 : WS_HB)) + ((size_t)t * 16 + h) * 64;
#pragma unroll
                for (int g = 0; g < 4; ++g) { u32x2 w0, w1;
                    w0.x = cvtpk(a.o0[4 * g] * inv, a.o0[4 * g + 1] * inv); w0.y = cvtpk(a.o0[4 * g + 2] * inv, a.o0[4 * g + 3] * inv);
                    w1.x = cvtpk(a.o1[4 * g] * inv, a.o1[4 * g + 1] * inv); w1.y = cvtpk(a.o1[4 * g + 2] * inv, a.o1[4 * g + 3] * inv);
                    *(GAS u32x2*)(orow + 8 * g + 4 * hi) = w0; *(GAS u32x2*)(orow + 32 + 8 * g + 4 * hi) = w1; }
                if (hi == 0) lse[((size_t)slot * S + t) * 16 + h] = a.m + __builtin_amdgcn_logf(l);
            }
        }
    }
}
__device__ __forceinline__ void moba_own_phase(unsigned char* ws, LAS unsigned char* lds, int G, int tid, int wave, int lane, bf16* obase, size_t opitch) {
    bf16* Q = (bf16*)(ws + WS_BIG + B_PROJ); const bf16* Kb = Q + (size_t)S * DM; const bf16* Vt = (const bf16*)(ws + WS_BIG + B_VTM);
    const unsigned* selg = (const unsigned*)(ws + WS_MSEL); const float* lse = (const float*)(ws + WS_MLSE);
    LAS unsigned char* kvb = lds;
    const int r32 = lane & 31, hi = lane >> 5;
    for (int un = blockIdx.x; un < 1024; un += G) {
        const int h = un & 15, QB = un >> 4, q0 = QB * 256, qrow = q0 + wave * 32 + r32;
        bf16x8 qf[4]; load_q(qf, Q + (size_t)qrow * DM + h * 64, lane);
        AttnAcc a; attn_init(a);
        const bf16* Kp = Kb + h * 64; const bf16* Vtp = Vt + (size_t)h * 64 * S;
        __syncthreads();
        KVRegs kr; kv_load(kr, Kp, DM, Vtp, S, q0, tid); kv_store(kr, kvb, tid);
        __syncthreads();
        for (int t = 0; t < 4; ++t) {
            LAS unsigned char* cur = kvb + (t & 1) * KV_BUF_BYTES;
            const int key0 = q0 + t * 64;
            if (t + 1 < 4) kv_load(kr, Kp, DM, Vtp, S, key0 + 64, tid);
            if (key0 <= q0 + wave * 32 + 31) {
                f32x16 p0, p1; attn_scores(p0, p1, cur, qf, lane);
#pragma unroll
                for (int r = 0; r < 16; ++r) { const int kv = key0 + crow(r, hi); p0[r] = (kv > qrow) ? -INFINITY : p0[r] * C2; p1[r] = (kv + 32 > qrow) ? -INFINITY : p1[r] * C2; }
                attn_update(a, p0, p1, cur, lane);
            }
            if (t + 1 < 4) kv_store(kr, kvb + ((t + 1) & 1) * KV_BUF_BYTES, tid);
            __syncthreads();
        }
        const unsigned sw = selg[(size_t)h * S + qrow];
        float L[3];
#pragma unroll
        for (int j = 0; j < 3; ++j) L[j] = (((sw >> (8 * j)) & 255u) != 255u) ? lse[((size_t)j * S + qrow) * 16 + h] : -INFINITY;
        const float M = fmaxf(fmaxf(a.m, L[0]), fmaxf(L[1], L[2]));
        const float so = __builtin_amdgcn_exp2f(a.m - M);
        float W = sh32_sum(a.l) * so;
#pragma unroll
        for (int r = 0; r < 16; ++r) { a.o0[r] *= so; a.o1[r] *= so; }
#pragma unroll
        for (int j = 0; j < 3; ++j) {
            if (L[j] != -INFINITY) {
                const float wj = __builtin_amdgcn_exp2f(L[j] - M); W += wj;
                const bf16* orow = (const bf16*)(ws + (j == 0 ? WS_BIG + B_OP0 : j == 1 ? WS_BIG + B_OP1 : WS_HB)) + ((size_t)qrow * 16 + h) * 64;
#pragma unroll
                for (int g = 0; g < 4; ++g) { const u32x2 w0 = *(const GAS u32x2*)(orow + 8 * g + 4 * hi), w1 = *(const GAS u32x2*)(orow + 32 + 8 * g + 4 * hi);
                    a.o0[4 * g] += wj * bflo(w0.x); a.o0[4 * g + 1] += wj * bfhi(w0.x); a.o0[4 * g + 2] += wj * bflo(w0.y); a.o0[4 * g + 3] += wj * bfhi(w0.y);
                    a.o1[4 * g] += wj * bflo(w1.x); a.o1[4 * g + 1] += wj * bfhi(w1.x); a.o1[4 * g + 2] += wj * bflo(w1.y); a.o1[4 * g + 3] += wj * bfhi(w1.y); }
            }
        }
        const float inv = 1.0f / W;
        bf16* orow = obase + (size_t)qrow * opitch + h * 64;
#pragma unroll
        for (int g = 0; g < 4; ++g) { u32x2 w0, w1;
            w0.x = cvtpk(a.o0[4 * g] * inv, a.o0[4 * g + 1] * inv); w0.y = cvtpk(a.o0[4 * g + 2] * inv, a.o0[4 * g + 3] * inv);
            w1.x = cvtpk(a.o1[4 * g] * inv, a.o1[4 * g + 1] * inv); w1.y = cvtpk(a.o1[4 * g + 2] * inv, a.o1[4 * g + 3] * inv);
            *(GAS u32x2*)(orow + 8 * g + 4 * hi) = w0; *(GAS u32x2*)(orow + 32 + 8 * g + 4 * hi) = w1; }
    }
}

typedef float f32x4v __attribute__((ext_vector_type(4)));
__device__ __forceinline__ unsigned mono_key(float s) { if (s == 0.f) s = 0.f; const unsigned u = __float_as_uint(s); return (u & 0x80000000u) ? ~u : (u | 0x80000000u); }
constexpr int DS_CAP = 512;
__device__ __forceinline__ unsigned wave_or(unsigned v) { v |= (unsigned)shx_i<1>((int)v); v |= (unsigned)shx_i<2>((int)v); v |= (unsigned)shx_i<4>((int)v); v |= (unsigned)shx_i<8>((int)v); v |= (unsigned)shx_i<16>((int)v);
    auto r = __builtin_amdgcn_permlane32_swap(v, v, false, false); return r[0] | r[1]; }
template <bool EXACT>
__device__ __forceinline__ unsigned dsa_compact(LAS u32x2* ent, int n, int& nkeep, int lane) {
    unsigned k[8]; unsigned ix[8]; unsigned orv = 0u, nandv = 0u;
#pragma unroll
    for (int j = 0; j < 8; ++j) { const int e = lane + 64 * j; const bool in = e < n; const u32x2 v = ent[in ? e : 0]; k[j] = in ? v.x : 0u; ix[j] = v.y; orv |= k[j]; nandv |= in ? ~v.x : 0u; }
    unsigned T = 0u; int cntT = n; int bit0 = 31;
    if (!EXACT) {
        const unsigned diff = (unsigned)__builtin_amdgcn_readfirstlane((int)(wave_or(orv) & wave_or(nandv)));
        if (diff != 0u) { bit0 = 31 - __builtin_clz(diff); const unsigned anyk = (unsigned)__builtin_amdgcn_readfirstlane((int)k[0]);
            T = (bit0 == 31) ? 0u : (anyk & ~((2u << bit0) - 1u)); }
    }
    for (int bit = bit0; bit >= 0; --bit) {
        const unsigned cand = T | (1u << bit); int c = 0;
#pragma unroll
        for (int j = 0; j < 8; ++j) c += __popcll(__ballot(k[j] >= cand));
        if (c >= 256) { T = cand; cntT = c; if (!EXACT && c <= 320) break; }
    }
    int Jstar = 0x10000;
    if (cntT > (EXACT ? 256 : 320)) {
        int gt = 0;
#pragma unroll
        for (int j = 0; j < 8; ++j) gt += __popcll(__ballot(k[j] > T));
        const int need = 256 - gt; int Jm = 0;
        for (int bit = 14; bit >= 0; --bit) { const int cand = Jm | (1 << bit); int c = 0;
#pragma unroll
            for (int j = 0; j < 8; ++j) c += __popcll(__ballot(k[j] == T && (int)ix[j] < cand));
            if (c < need) Jm = cand; }
        Jstar = Jm + 1;
    }
    int base = 0;
    const unsigned long long lt = (1ull << lane) - 1ull;
#pragma unroll
    for (int j = 0; j < 8; ++j) { const bool pred = (k[j] > T) || (k[j] == T && T != 0u && (int)ix[j] < Jstar);
        const unsigned long long mask = __ballot(pred); const int pos = base + __popcll(mask & lt);
        if (pred) ent[pos] = (u32x2){k[j], ix[j]};
        base += __popcll(mask); }
    nkeep = base;
    return T;
}
#define DSA_HEADSUM(s, P, B, W) asm("v_max_f32_e32 %1, 0, %2\n\tv_mul_f32_e32 %0, %10, %1\n\tv_max_f32_e32 %1, 0, %3\n\tv_fmac_f32_e32 %0, %11, %1\n\tv_max_f32_e32 %1, 0, %4\n\tv_fmac_f32_e32 %0, %12, %1\n\t" \
        "v_max_f32_e32 %1, 0, %5\n\tv_fmac_f32_e32 %0, %13, %1\n\tv_max_f32_e32 %1, 0, %6\n\tv_fmac_f32_e32 %0, %14, %1\n\tv_max_f32_e32 %1, 0, %7\n\tv_fmac_f32_e32 %0, %15, %1\n\t" \
        "v_max_f32_e32 %1, 0, %8\n\tv_fmac_f32_e32 %0, %16, %1\n\tv_max_f32_e32 %1, 0, %9\n\tv_fmac_f32_e32 %0, %17, %1" \
        : "=&v"(s), "=&v"(tmp_) : "v"(P[B + 0]), "v"(P[B + 1]), "v"(P[B + 2]), "v"(P[B + 3]), "v"(P[B + 4]), "v"(P[B + 5]), "v"(P[B + 6]), "v"(P[B + 7]), \
          "v"(W[0]), "v"(W[1]), "v"(W[2]), "v"(W[3]), "v"(W[4]), "v"(W[5]), "v"(W[6]), "v"(W[7]))
__device__ __forceinline__ float unmono_f(unsigned u) { return __uint_as_float((u & 0x80000000u) ? (u ^ 0x80000000u) : ~u); }
struct DsaState { float tf0, tf1; int cnt0, cnt1; };
template <bool NOCOMPACT = false>
__device__ __forceinline__ void dsa_tile(const bf16x8 (&af)[4], const bf16x8 (&bc)[4], const float (&w0)[8], const float (&w1)[8], int key0, int q0t, int q1t, DsaState& st,
                                         LAS u32x2* ents, int lane) {
    const int r32 = lane & 31, hi = lane >> 5;
    f32x16 p;
#pragma unroll
    for (int r = 0; r < 16; ++r) p[r] = 0.f;
#pragma unroll
    for (int ks = 0; ks < 4; ++ks) p = __builtin_amdgcn_mfma_f32_32x32x16_bf16(af[ks], bc[ks], p, 0, 0, 0);
    asm volatile("s_nop 15\n\ts_nop 7" : "+v"(p));
    float s0, s1, tmp_;
    DSA_HEADSUM(s0, p, 0, w0); DSA_HEADSUM(s1, p, 8, w1);
    const int key = key0 + r32;
    const bool pr0 = (key <= q0t) && (s0 >= st.tf0), pr1 = (key <= q1t) && (s1 >= st.tf1);
    const unsigned long long m0 = __ballot(pr0), m1 = __ballot(pr1);
    if (m0 | m1) {
        const unsigned h0 = hi ? (unsigned)(m0 >> 32) : (unsigned)m0, h1 = hi ? (unsigned)(m1 >> 32) : (unsigned)m1;
        const unsigned lowmask = (1u << r32) - 1u;
        if (pr0) ents[hi * DS_CAP + st.cnt0 + __popc(h0 & lowmask)] = (u32x2){mono_key(s0), (unsigned)key};
        if (pr1) ents[(2 + hi) * DS_CAP + st.cnt1 + __popc(h1 & lowmask)] = (u32x2){mono_key(s1), (unsigned)key};
        st.cnt0 += __popc(h0); st.cnt1 += __popc(h1);
        const unsigned long long need = __ballot(max(st.cnt0, st.cnt1) > DS_CAP - 32);
        if (need) {
#pragma unroll 1
            for (int hh = 0; hh < 2; ++hh) {
                const int c0 = __builtin_amdgcn_readlane(st.cnt0, 0), c0b = __builtin_amdgcn_readlane(st.cnt0, 32);
                const int c1 = __builtin_amdgcn_readlane(st.cnt1, 0), c1b = __builtin_amdgcn_readlane(st.cnt1, 32);
                const int n0 = hh ? c0b : c0, n1 = hh ? c1b : c1;
                if (NOCOMPACT) { if (n0 > DS_CAP - 32 && hi == hh) st.cnt0 = 256; if (n1 > DS_CAP - 32 && hi == hh) st.cnt1 = 256; continue; }
                if (n0 > DS_CAP - 32) { int nk; const unsigned T = dsa_compact<false>(ents + hh * DS_CAP, n0, nk, lane); if (hi == hh) { st.tf0 = unmono_f(T + 1u); st.cnt0 = nk; } }
                if (n1 > DS_CAP - 32) { int nk; const unsigned T = dsa_compact<false>(ents + (2 + hh) * DS_CAP, n1, nk, lane); if (hi == hh) { st.tf1 = unmono_f(T + 1u); st.cnt1 = nk; } }
            }
        }
    }
}
template <bool NOCOMPACT = false>
__device__ __forceinline__ void dsa_select_phase(unsigned char* ws, LAS unsigned char* lds, int G, int tid, int wave, int lane) {
    const bf16* proj = (const bf16*)(ws + WS_BIG + B_PROJ); const bf16* IKc = (const bf16*)(ws + WS_BIG + B_IKC); const float* IW = (const float*)(ws + WS_IW);
    unsigned short* selg = (unsigned short*)(ws + WS_BIG + B_SEL);
    LAS u32x2* ents = (LAS u32x2*)lds + wave * 4 * DS_CAP;
    const int r32 = lane & 31, hi = lane >> 5;
    const int NWG = G * NWAVES, gw = (int)blockIdx.x * NWAVES + wave;
    for (int pu = gw; pu < 2048; pu += NWG) {
        for (int uu = 0; uu < 2; ++uu) {
            const int unit = uu ? 4095 - pu : pu, tw = unit * 4;
            bf16x8 af[4];
            { const int i = r32, qi = 2 * (i >> 4) + ((i >> 2) & 1), hd = 4 * ((i >> 3) & 1) + (i & 3);
              const bf16* ap = proj + (size_t)(tw + qi) * EVEN_NP + EC_IQ + hd * 64 + 8 * hi;
#pragma unroll
              for (int ks = 0; ks < 4; ++ks) af[ks] = *(const GAS bf16x8*)(ap + 16 * ks); }
            float w0[8], w1[8];
            { const f32x4 a = *(const GAS f32x4*)(IW + (size_t)(tw + hi) * 8), b = *(const GAS f32x4*)(IW + (size_t)(tw + hi) * 8 + 4);
              const f32x4 c = *(const GAS f32x4*)(IW + (size_t)(tw + 2 + hi) * 8), d = *(const GAS f32x4*)(IW + (size_t)(tw + 2 + hi) * 8 + 4);
#pragma unroll
              for (int j = 0; j < 4; ++j) { w0[j] = a[j]; w0[4 + j] = b[j]; w1[j] = c[j]; w1[4 + j] = d[j]; } }
            const int q0t = tw + hi, q1t = tw + 2 + hi;
            DsaState st; st.tf0 = -INFINITY; st.tf1 = -INFINITY; st.cnt0 = 0; st.cnt1 = 0;
            const int ntile = ((tw + 3) >> 5) + 1;
            const bf16* kp = IKc + (size_t)lane * 8; asm volatile("" : "+v"(kp));
            bf16x8 bA[4], bB[4], bC[4];
#define DSA_LOADB(dst, jj) do { const bf16* p_ = kp + (size_t)(jj) * 2048; \
                asm volatile("global_load_dwordx4 %0, %4, off\n\tglobal_load_dwordx4 %1, %4, off offset:1024\n\tglobal_load_dwordx4 %2, %4, off offset:2048\n\tglobal_load_dwordx4 %3, %4, off offset:3072" \
                             : "=&v"(dst[0]), "=&v"(dst[1]), "=&v"(dst[2]), "=&v"(dst[3]) : "v"(p_) : "memory"); } while (0)
#define DSA_WAITB(dst, n) asm volatile("s_waitcnt vmcnt(" #n ")" : "+v"(dst[0]), "+v"(dst[1]), "+v"(dst[2]), "+v"(dst[3]) :: "memory")
            asm volatile("" : "+v"(af[0]), "+v"(af[1]), "+v"(af[2]), "+v"(af[3]));
#pragma unroll
            for (int r = 0; r < 8; ++r) asm volatile("" : "+v"(w0[r]), "+v"(w1[r]));
            DSA_LOADB(bA, 0); DSA_LOADB(bB, min(1, ntile - 1));
#pragma unroll 1
            for (int j = 0; j < ntile; j += 3) {
                DSA_LOADB(bC, min(j + 2, ntile - 1));
                DSA_WAITB(bA, 8);
                dsa_tile<NOCOMPACT>(af, bA, w0, w1, 32 * j, q0t, q1t, st, ents, lane);
                DSA_LOADB(bA, min(j + 3, ntile - 1));
                DSA_WAITB(bB, 8);
                if (j + 1 < ntile) dsa_tile<NOCOMPACT>(af, bB, w0, w1, 32 * (j + 1), q0t, q1t, st, ents, lane);
                DSA_LOADB(bB, min(j + 4, ntile - 1));
                DSA_WAITB(bC, 8);
                if (j + 2 < ntile) dsa_tile<NOCOMPACT>(af, bC, w0, w1, 32 * (j + 2), q0t, q1t, st, ents, lane);
            }
            DSA_WAITB(bA, 0);
#undef DSA_LOADB
#undef DSA_WAITB
            const int cnt0 = st.cnt0, cnt1 = st.cnt1;
#pragma unroll 1
            for (int qq = 0; qq < 4; ++qq) {
                const int hh = qq & 1, sl = qq >> 1;
                int n = sl ? __builtin_amdgcn_readlane(cnt1, 32 * hh) : __builtin_amdgcn_readlane(cnt0, 32 * hh);
                LAS u32x2* ee = ents + qq * DS_CAP;
                if (n > 256) { int nk = 256; if (!NOCOMPACT) (void)dsa_compact<true>(ee, n, nk, lane); n = 256; }
                unsigned short* row = selg + (size_t)(tw + qq) * 256;
#pragma unroll
                for (int e4 = 0; e4 < 4; ++e4) { const int e = lane + 64 * e4; row[e] = (e < n) ? (unsigned short)ee[e].y : (unsigned short)0xFFFFu; }
            }
        }
    }
}

typedef __bf16 bf16x2v __attribute__((ext_vector_type(2)));
__device__ __forceinline__ float dot2bf(unsigned a, unsigned b, float acc) { return __builtin_amdgcn_fdot2_f32_bf16(__builtin_bit_cast(bf16x2v, a), __builtin_bit_cast(bf16x2v, b), acc, false); }
#define SP_IDX(i) (((i) & 1) ? (iw[(i) >> 3][((i) >> 1) & 3] >> 16) : (iw[(i) >> 3][((i) >> 1) & 3] & 0xffffu))
__device__ __forceinline__ void dsa_sparse_phase(unsigned char* ws, int G, int wave, int lane, bf16* obase, size_t opitch) {
    const bf16* proj = (const bf16*)(ws + WS_BIG + B_PROJ); const unsigned short* selg = (const unsigned short*)(ws + WS_BIG + B_SEL);
    const int h = (int)blockIdx.x & 7, wg = (int)blockIdx.x >> 3, nwg = G >> 3;
    const int kg = lane >> 3, ds8 = (lane & 7) * 8;
    const bf16* kbase = proj + EC_DK + h * 64 + ds8; const bf16* vbase = proj + EC_DV + h * 64 + ds8;
    const int tstep = nwg * NWAVES;
    v4u iwn[4], qwn, kan[8], kbn[8];
    { const int t0_ = wg * NWAVES + wave;
#pragma unroll
      for (int c = 0; c < 4; ++c) iwn[c] = *(const GAS v4u*)(selg + (size_t)t0_ * 256 + 32 * kg + 8 * c);
      qwn = *(const GAS v4u*)(proj + (size_t)t0_ * EVEN_NP + EC_DQ + h * 64 + ds8);
#define SP_IDXN(i) (((i) & 1) ? (iwn[(i) >> 3][((i) >> 1) & 3] >> 16) : (iwn[(i) >> 3][((i) >> 1) & 3] & 0xffffu))
#define SP_LOADN(dst, i0) _Pragma("unroll") for (int j = 0; j < 8; ++j) { const unsigned wd = SP_IDXN((i0) + j); const unsigned idx = (wd == 0xffffu) ? 0u : wd; dst[j] = *(const GAS v4u*)(kbase + (size_t)idx * EVEN_NP); }
      SP_LOADN(kan, 0); SP_LOADN(kbn, 8); }
    for (int t = wg * NWAVES + wave; t < S; t += tstep) {
        v4u iw[4];
#pragma unroll
        for (int c = 0; c < 4; ++c) iw[c] = iwn[c];
        const v4u qw = qwn;
        const int tn = (t + tstep < S) ? t + tstep : t;
#pragma unroll
        for (int c = 0; c < 4; ++c) iwn[c] = *(const GAS v4u*)(selg + (size_t)tn * 256 + 32 * kg + 8 * c);
        qwn = *(const GAS v4u*)(proj + (size_t)tn * EVEN_NP + EC_DQ + h * 64 + ds8);
        float sc[32];
        v4u ka[8], kb[8];
#define SP_LOAD(dst, base, i0) _Pragma("unroll") for (int j = 0; j < 8; ++j) { const unsigned wd = SP_IDX((i0) + j); const unsigned idx = (wd == 0xffffu) ? 0u : wd; dst[j] = *(const GAS v4u*)(base + (size_t)idx * EVEN_NP); }
#define SP_QK(src, i0) _Pragma("unroll") for (int j = 0; j < 8; ++j) { const unsigned wd = SP_IDX((i0) + j); \
            float d = dot2bf(qw.x, src[j].x, 0.f); d = dot2bf(qw.y, src[j].y, d); d = dot2bf(qw.z, src[j].z, d); d = dot2bf(qw.w, src[j].w, d); \
            d += shx<1>(d); d += shx<2>(d); d += shx<4>(d); sc[(i0) + j] = (wd == 0xffffu) ? -INFINITY : d * C2; }
#pragma unroll
        for (int j = 0; j < 8; ++j) { ka[j] = kan[j]; kb[j] = kbn[j]; }
        SP_QK(ka, 0);  SP_LOAD(ka, kbase, 16);
        SP_QK(kb, 8);  SP_LOAD(kb, kbase, 24);
        SP_QK(ka, 16); SP_LOAD(ka, vbase, 0);
        SP_QK(kb, 24); SP_LOAD(kb, vbase, 8);
        float mx = sc[0];
#pragma unroll
        for (int i = 1; i < 32; ++i) mx = fmaxf(mx, sc[i]);
        mx = fmaxf(mx, shx<8>(mx)); mx = fmaxf(mx, shx<16>(mx)); mx = sh32_max(mx);
        float l = 0.f;
#pragma unroll
        for (int i = 0; i < 32; ++i) { sc[i] = __builtin_amdgcn_exp2f(sc[i] - mx); l += sc[i]; }
        l += shx<8>(l); l += shx<16>(l); l = sh32_sum(l);
        float acc[8];
#pragma unroll
        for (int e = 0; e < 8; ++e) acc[e] = 0.f;
#define SP_PV(src, i0) _Pragma("unroll") for (int j = 0; j < 8; j += 2) { const unsigned pp = cvtpk(sc[(i0) + j], sc[(i0) + j + 1]); const v4u a = src[j], b = src[j + 1]; \
            acc[0] = dot2bf(pp, __builtin_amdgcn_perm(b.x, a.x, 0x05040100u), acc[0]); acc[1] = dot2bf(pp, __builtin_amdgcn_perm(b.x, a.x, 0x07060302u), acc[1]); \
            acc[2] = dot2bf(pp, __builtin_amdgcn_perm(b.y, a.y, 0x05040100u), acc[2]); acc[3] = dot2bf(pp, __builtin_amdgcn_perm(b.y, a.y, 0x07060302u), acc[3]); \
            acc[4] = dot2bf(pp, __builtin_amdgcn_perm(b.z, a.z, 0x05040100u), acc[4]); acc[5] = dot2bf(pp, __builtin_amdgcn_perm(b.z, a.z, 0x07060302u), acc[5]); \
            acc[6] = dot2bf(pp, __builtin_amdgcn_perm(b.w, a.w, 0x05040100u), acc[6]); acc[7] = dot2bf(pp, __builtin_amdgcn_perm(b.w, a.w, 0x07060302u), acc[7]); }
        SP_PV(ka, 0);  SP_LOAD(ka, vbase, 16);
        SP_PV(kb, 8);  SP_LOAD(kb, vbase, 24);
        SP_LOADN(kan, 0);
        SP_PV(ka, 16);
        SP_LOADN(kbn, 8);
        SP_PV(kb, 24);
#undef SP_LOAD
#undef SP_QK
#undef SP_PV
        const float inv = 1.0f / l;
#pragma unroll
        for (int e = 0; e < 8; ++e) { float a = acc[e]; a += shx<8>(a); a += shx<16>(a); a = sh32_sum(a); acc[e] = a * inv; }
        if (kg == 0) *(GAS v4u*)(obase + (size_t)t * opitch + h * 64 + ds8) = pack8(acc);
    }
}
#undef SP_IDX
#undef SP_IDXN
#undef SP_LOADN

struct Args { InPtrs in; float* out; unsigned char* ws; int ph_lo, ph_hi, li, pad; };
constexpr int PH_PER_LAYER = 13, N_PHASES = 1 + 2 * PH_PER_LAYER;

__global__ void __launch_bounds__(NTHREADS, 2) hyb_fwd(Args args) {
    extern __shared__ __attribute__((aligned(16))) unsigned char lds_raw[];
    LAS unsigned char* lds = (LAS unsigned char*)lds_raw;
    volatile LAS unsigned* MISC = (volatile LAS unsigned*)(lds + MISC_OFF);
    const int tid = threadIdx.x, lane = tid & 63, wave = __builtin_amdgcn_readfirstlane(tid >> 6);
    const int G = gridDim.x;
    const int vcu = (G % 8 == 0) ? ((int)blockIdx.x % 8) * (G / 8) + (int)blockIdx.x / 8 : (int)blockIdx.x;
    unsigned char* ws = args.ws;
    gu32* ctl = (gu32*)(ws + WS_CTL);
    for (int u = tid; u < (LDS_BYTES - LDSCTL_OFF) / 4; u += NTHREADS) ((LAS unsigned*)(lds + LDSCTL_OFF))[u] = 0u;
    __syncthreads();
    if (tid == 0) {
#pragma unroll
        for (int i = 0; i < 26; ++i) *(LAS unsigned long long*)(lds + INTAB_OFF + 8 * i) = (unsigned long long)args.in.p[i]; }
    __syncthreads();
    XcdBarrier bar = xcd_barrier_post((unsigned*)(ctl + CW_BAR) + args.li * XCD_BAR_WORDS, MISC + 8);
    const int tid0 = tid; unsigned char* const ws0 = ws;
    for (int ph = args.ph_lo; ph < args.ph_hi; ++ph) {
        int tid = tid0; asm volatile("" : "+v"(tid));
        unsigned char* ws = ws0; asm volatile("" : "+s"(ws));
        const int lane = tid & 63, wave = __builtin_amdgcn_readfirstlane(tid >> 6);
        LAS unsigned char* lds = (LAS unsigned char*)lds_raw; { unsigned lo_ = (unsigned)(uintptr_t)lds; asm volatile("" : "+s"(lo_)); lds = (LAS unsigned char*)(uintptr_t)lo_; }
        InTab inl; inl.ldsbase = lds;
        float* ssqA = (float*)(ws + WS_SSQ);
        bf16* HB = (bf16*)(ws + WS_HB);
        unsigned char* Wr = ws + WS_W;
        unsigned char* BIG = ws + WS_BIG;
        const int gw = vcu * NWAVES + wave, NGW = G * NWAVES;
        if (ph == 0) {
#ifdef PROBE_P02
            conv_weights(inl, ws, 0, 1 | 2 | 4, lds, gw, NGW, wave, lane);
            copy_x(inl.get(0), args.out, HB, ssqA, gw, NGW, lane);
            rope_tables((float*)(ws + WS_ROPE), (float*)(ws + WS_ROPE) + S * 8, (int)blockIdx.x * NTHREADS + tid, G * NTHREADS);
            __syncthreads();
            for (int un = blockIdx.x; un < 128; un += G) mem_kv(inl, ws, lds, un, tid, wave, lane);
            for (int idx = (int)blockIdx.x * NTHREADS + tid; idx < 1024 * 16; idx += G * NTHREADS) {
                const int k = idx >> 4, col = idx & 15;
                const float v = inl.get(5)[k] * inl.get(6)[(size_t)k * EVEN_SRC + (col < 8 ? ES_FL + col : ES_IW + col - 8)];
                const int ln = (k & 255) >> 2, e = k & 3, q = k >> 8, c = col >> 2;
                ((float*)(ws + WS_TW))[((((q * 4 + e) * 4 + c) * 64 + ln) << 2) + (col & 3)] = v; }
            __syncthreads();
#endif
#ifndef NO_P0
            conv_weights(inl, ws, 0, 1 | 2 | 4, lds, gw, NGW, wave, lane);
            copy_x(inl.get(0), args.out, HB, ssqA, gw, NGW, lane);
            if (blockIdx.x == 0 && tid < 384) { const int gi = tid >> 6, d = tid & 63;
                float v;
                if (gi == 0) v = inl.get(8)[d]; else if (gi == 1) v = inl.get(10)[d]; else if (gi == 2) v = inl.get(9)[d]; else if (gi == 3) v = inl.get(11)[d]; else if (gi == 4) v = inl.get(13)[d]; else v = inl.get(14)[d];
                ((float*)(ws + WS_GT))[tid] = v; }
            rope_tables((float*)(ws + WS_ROPE), (float*)(ws + WS_ROPE) + S * 8, (int)blockIdx.x * NTHREADS + tid, G * NTHREADS);
            __syncthreads();
            for (int un = blockIdx.x; un < 128; un += G) mem_kv(inl, ws, lds, un, tid, wave, lane);
            for (int idx = (int)blockIdx.x * NTHREADS + tid; idx < 1024 * 16; idx += G * NTHREADS) {
                const int k = idx >> 4, col = idx & 15;
                const float v = inl.get(5)[k] * inl.get(6)[(size_t)k * EVEN_SRC + (col < 8 ? ES_FL + col : ES_IW + col - 8)];
                const int ln = (k & 255) >> 2, e = k & 3, q = k >> 8, c = col >> 2;
                ((float*)(ws + WS_TW))[((((q * 4 + e) * 4 + c) * 64 + ln) << 2) + (col & 3)] = v; }
#endif
        } else {
            const int L = (ph - 1) / PH_PER_LAYER, sub = (ph - 1) % PH_PER_LAYER;
            const bool even = (L & 1) == 0;
            if (even && sub == 6) continue;
            float* ssq_in = ssqA;
            if (sub == 0 || sub == 11) {
                pg8::Gemm g{(const pg8::bf16_t*)HB, (const pg8::bf16_t*)(Wr + (sub == 0 ? W_FFN1_IN : W_FFN2_IN)), S, FF2, DM, DM};
                pg8::StaticOrder So; So.init(S, FF2, G, (int)blockIdx.x);
                pg8::EpiSwiGLU E{(pg8::bf16_t*)(BIG + B_U), ssq_in, FF};
#ifdef PROBE_GEMM2
                pg8::gemm_phase<pg8::EpiSwiGLU, pg8::StaticOrder, true, true>(lds, g, So, E, tid); __syncthreads();
#endif
                pg8::gemm_phase<pg8::EpiSwiGLU, pg8::StaticOrder, true, true>(lds, g, So, E, tid);
            } else if (sub == 1 || sub == 7 || sub == 10 || sub == 12) {
                pg8::Gemm g; float scale; int so;
                if (sub == 1)       { g = pg8::Gemm{(const pg8::bf16_t*)(BIG + B_U), (const pg8::bf16_t*)(Wr + W_FFN1_OUT), S, DM, FF, FF}; scale = 0.5f; so = 1; }
                else if (sub == 7)  { g = pg8::Gemm{(const pg8::bf16_t*)(BIG + B_PROJ), (const pg8::bf16_t*)(Wr + W_MIX_OUT), S, DM, DM, even ? EVEN_NP : DM}; scale = 1.0f; so = 2; }
                else if (sub == 10)  { g = pg8::Gemm{(const pg8::bf16_t*)(BIG + B_OM), (const pg8::bf16_t*)(Wr + (L ? W_MEMO2 : W_MEMO)), S, DM, MEMW, MEMW}; scale = 1.0f; so = 3; }
                else                { g = pg8::Gemm{(const pg8::bf16_t*)(BIG + B_U), (const pg8::bf16_t*)(Wr + W_FFN2_OUT), S, DM, FF, FF}; scale = 0.5f; so = 4; }
                const bool last = (sub == 12 && L == NLAYER - 1);
                pg8::StaticOrder So; So.init(S, DM, G, (int)blockIdx.x);
                pg8::EpiResid E{(L == 0 && sub == 1) ? inl.get(0) : (const float*)args.out, args.out, last ? nullptr : (pg8::bf16_t*)HB, last ? nullptr : ssqA, scale};
                pg8::gemm_phase<pg8::EpiResid, pg8::StaticOrder, true, true>(lds, g, So, E, tid);
#ifdef PROBE_GEMM2
                { __syncthreads(); pg8::EpiResid E0 = E; E0.scale = 0.f; E0.Hin = args.out; pg8::gemm_phase<pg8::EpiResid, pg8::StaticOrder, true, true>(lds, g, So, E0, tid); }
#endif
            } else if (sub == 2) {
                const int N = even ? EVEN_NP : ODD_N;
                pg8::Gemm g{(const pg8::bf16_t*)HB, (const pg8::bf16_t*)(Wr + W_MIX_IN), S, N, DM, DM};
                pg8::EpiProj E;
                E.O = (pg8::bf16_t*)(BIG + B_PROJ); E.ldc = even ? EVEN_NP : DM; E.ssq = ssq_in; E.split_cols = even ? 0 : DM; E.split_stride = (size_t)S * DM; E.even = even ? 1 : 0;
                E.gtab = (const float*)(ws + WS_GT);
                E.cosT = (const float*)(ws + WS_ROPE); E.sinT = E.cosT + S * 8;
                E.Vt = (pg8::bf16_t*)(BIG + (even ? B_VTF : B_VTM)); E.IKf = (pg8::bf16_t*)(BIG + B_IKC);
                E.xch = (LAS float*)(lds + 131072);
                pg8::StaticOrder So; So.init(S, N, G, (int)blockIdx.x);
#ifdef PROBE_MIXIN2
                pg8::gemm_phase<pg8::EpiProj, pg8::StaticOrder, true, true>(lds, g, So, E, tid); __syncthreads();
#endif
                pg8::gemm_phase<pg8::EpiProj, pg8::StaticOrder, true, true>(lds, g, So, E, tid);
            } else if (sub == 8) {
                if ((int)blockIdx.x >= 64 && G > 64) {
                    const int cw = ((int)blockIdx.x - 64) * NWAVES + wave, ncw = (G - 64) * NWAVES;
                    if (L == 0) conv_weights(inl, ws, 1, 1 | 2 | 4 | 8 | 16 | 32, lds, cw, ncw, wave, lane);
                    else        conv_weights(inl, ws, 1, 64 | 128, lds, cw, ncw, wave, lane);
                }
                pg8::Gemm g{(const pg8::bf16_t*)HB, (const pg8::bf16_t*)(Wr + (L ? W_MEMQ2 : W_MEMQ)), S, MEMW, DM, DM};
                pg8::EpiScale E{(pg8::bf16_t*)(BIG + B_QM), MEMW, ssq_in, 0, 0};
                pg8::StaticOrder So; So.init(S, g.N, G, (int)blockIdx.x);
                pg8::gemm_phase<pg8::EpiScale, pg8::StaticOrder, true, true>(lds, g, So, E, tid);
            } else if (sub == 3) {
                if (even) post_even(inl, ws, args.out, ssq_in, lds, G, tid, wave, lane);
                else post_odd(ws, lds, G, tid);
                if (L == 0) { __syncthreads(); conv_weights(inl, ws, 0, 8 | 16 | 32 | 64 | 128, lds, gw, NGW, wave, lane); }
            } else if (sub == 4) {
                if (even) {
                    int nrep = 1;
#ifdef PROBE_DSA2
                    nrep = 2;
#endif
                    asm volatile("" : "+s"(nrep));
#ifdef PROBE_SELNC
                    dsa_select_phase<true>(ws, lds, G, tid, wave, lane); __syncthreads();
#endif
                    for (int rep = 0; rep < nrep; ++rep) { dsa_select_phase<false>(ws, lds, G, tid, wave, lane); __syncthreads(); }
                } else {
                    moba_gate_phase(ws, G, wave, lane);
                }
            } else if (sub == 5) {
                if (even) {
                    bf16* projb = (bf16*)(BIG + B_PROJ);
#ifdef PROBE_FOX2
                    fox_phase(inl, ws, lds, G, tid, wave, lane, HB + (size_t)S * 512, 512, CW_FOXQ + 64); __syncthreads();
#endif
#ifdef PROBE_SPARSE2
                    dsa_sparse_phase(ws, G, wave, lane, HB + (size_t)S * 512, 512);
#endif
                    fox_phase(inl, ws, lds, G, tid, wave, lane, projb + EC_FQ, EVEN_NP, CW_FOXQ);
                    dsa_sparse_phase(ws, G, wave, lane, projb + EC_DQ, EVEN_NP);
                } else {
#ifdef PROBE_MOBA2
                    moba_route_phase(ws, lds, G, tid, wave, lane, CW_MOBAQ + 64); __syncthreads();
#endif
                    moba_route_phase(ws, lds, G, tid, wave, lane, CW_MOBAQ);
                }
            } else if (sub == 6) {
#ifdef PROBE_OWN2
                if (!even) { moba_own_phase(ws, lds, G, tid, wave, lane, (bf16*)(BIG + 160 * MiB), 0); __syncthreads(); }
#endif
                if (!even) moba_own_phase(ws, lds, G, tid, wave, lane, (bf16*)(BIG + B_PROJ), DM);
            } else if (sub == 9) {
#ifdef PROBE_MEM2
                memattn_phase(inl, ws, L, lds, G, tid, wave, lane); __syncthreads();
#endif
                memattn_phase(inl, ws, L, lds, G, tid, wave, lane);
            }
        }
        if (ph + 1 < args.ph_hi) xcd_barrier(bar);
#ifdef PROBE_BAR2
        if (ph + 1 < args.ph_hi) xcd_barrier(bar);
#endif
    }
}

#ifndef MK_N_LAUNCHES
#define MK_N_LAUNCHES 1
#endif
extern "C" void kernel_launch(void* const* d_in, const int* in_sizes, int n_in, void* d_out, int out_size, void* d_ws, size_t ws_size, hipStream_t stream) {
    static int grid = 0;
    if (grid == 0) {
        if (n_in != 26 || in_sizes[0] != S * DM || out_size != S * DM || ws_size < WS_END) {
            fprintf(stderr, "kernel_launch: unexpected problem (n_in %d, in0 %d, out %d, ws %zu); nothing launched\n", n_in, n_in > 0 ? in_sizes[0] : -1, out_size, ws_size); grid = -1; return; }
        int dev = 0, cus = 0, per_cu = 0;
        if (hipGetDevice(&dev) != hipSuccess || hipDeviceGetAttribute(&cus, hipDeviceAttributeMultiprocessorCount, dev) != hipSuccess) { grid = -1; return; }
        if (hipFuncSetAttribute((const void*)hyb_fwd, hipFuncAttributeMaxDynamicSharedMemorySize, LDS_BYTES) != hipSuccess) { fprintf(stderr, "kernel_launch: hipFuncSetAttribute failed\n"); grid = -1; return; }
        if (hipOccupancyMaxActiveBlocksPerMultiprocessor(&per_cu, (const void*)hyb_fwd, NTHREADS, LDS_BYTES) != hipSuccess || per_cu < 1)
            fprintf(stderr, "kernel_launch: note: occupancy query reports %d workgroups per CU\n", per_cu);
        (void)hipGetLastError();
        grid = cus;
    }
    if (grid < 0) return;
    if (hipMemsetAsync((char*)d_ws + WS_CTL, 0, CTL_ZERO_BYTES, stream) != hipSuccess) { fprintf(stderr, "kernel_launch: hipMemsetAsync failed\n"); return; }
    Args a{};
    for (int i = 0; i < 26; ++i) a.in.p[i] = (const float*)d_in[i];
    a.out = (float*)d_out; a.ws = (unsigned char*)d_ws;
#if MK_N_LAUNCHES == 1
    a.ph_lo = 0; a.ph_hi = N_PHASES; a.li = 0;
    hipLaunchKernelGGL(hyb_fwd, dim3(grid), dim3(NTHREADS), LDS_BYTES, stream, a);
#else
    for (int ph = 0; ph < N_PHASES; ++ph) { a.ph_lo = ph; a.ph_hi = ph + 1; a.li = 0; hipLaunchKernelGGL(hyb_fwd, dim3(grid), dim3(NTHREADS), LDS_BYTES, stream, a); }
#endif
    const hipError_t le = hipPeekAtLastError();
    if (le != hipSuccess) fprintf(stderr, "kernel_launch: launch failed: %s\n", hipGetErrorName(le));
}
```

```cpp
#include <hip/hip_runtime.h>
#include <cstdio>
#include <cstdint>

template <int M> __device__ __forceinline__ int shx_i(int v) {
    if constexpr (M == 1) return __builtin_amdgcn_mov_dpp(v, 0xB1, 0xF, 0xF, true);
    else if constexpr (M == 2) return __builtin_amdgcn_mov_dpp(v, 0x4E, 0xF, 0xF, true);
    else return __builtin_amdgcn_ds_swizzle(v, (M << 10) | 0x1f);
}
template <int M> __device__ __forceinline__ float shx(float v) { return __int_as_float(shx_i<M>(__float_as_int(v))); }
__device__ __forceinline__ float sh32_sum(float v) { auto r = __builtin_amdgcn_permlane32_swap(__float_as_uint(v), __float_as_uint(v), false, false); return __uint_as_float(r[0]) + __uint_as_float(r[1]); }
__device__ __forceinline__ float sh32_max(float v) { auto r = __builtin_amdgcn_permlane32_swap(__float_as_uint(v), __float_as_uint(v), false, false); return fmaxf(__uint_as_float(r[0]), __uint_as_float(r[1])); }
__device__ __forceinline__ int sum32_i(int c) { c += shx_i<1>(c); c += shx_i<2>(c); c += shx_i<4>(c); c += shx_i<8>(c); c += shx_i<16>(c); return c; }
namespace pg8 {
#define PG8_LAS __attribute__((address_space(3)))
typedef unsigned short bf16_t;
typedef short bf16x8 __attribute__((ext_vector_type(8)));
typedef float f32x4 __attribute__((ext_vector_type(4)));
typedef unsigned u32x4 __attribute__((ext_vector_type(4)));
constexpr int BM = 256, BK = 64, HALF = 128, HTB = HALF * BK * 2  , STAGE_BYTES = 8 * HTB, NXCD = 8, WGM = 8;

__host__ __device__ __forceinline__ int lds_byte(int r, int c) { const int st = (r >> 4) * 2 + (c >> 5), rr = r & 15, cc = c & 31, ob = rr * 64 + cc * 2; return st * 1024 + (ob ^ (((ob >> 9) & 1) << 5)); }
__host__ __device__ __forceinline__ void stage_rc(int b, int& R, int& C) { const int st = b / 1024, sb = b % 1024, swz = sb ^ (((sb >> 9) & 1) << 5); R = (st >> 1) * 16 + swz / 64; C = (st & 1) * 32 + (swz % 64) / 2; }
__host__ __device__ __forceinline__ int perm32(int rho) { const int n = rho >> 4, i = rho & 15; return 8 * (i >> 2) + 4 * n + (i & 3); }

struct Unit { int pm, pn; };
struct Gemm { const bf16_t* A; const bf16_t* Bt; int M, N, K, lda; };

struct StaticOrder {
    int nM, nN, nwg, G, c;
    __host__ __device__ __forceinline__ void init(int M, int N, int G_, int c_) { nM = M / BM; nN = N / BM; nwg = nM * nN; G = G_; c = c_; }
    __host__ __device__ __forceinline__ bool next(int i, Unit& u) const {
        const long L = (long)i * G + c; if (L >= nwg) return false;
        int wgid = (int)L; { const int q = nwg / NXCD, r = nwg % NXCD, xcd = wgid % NXCD, off = wgid / NXCD; wgid = (xcd < r ? xcd * (q + 1) : r * (q + 1) + (xcd - r) * q) + off; }
        const int nig = WGM * nN, gid = wgid / nig, fm = gid * WGM, gsz = (nM - fm) < WGM ? (nM - fm) : WGM;
        u.pm = fm + ((wgid % nig) % gsz); u.pn = (wgid % nig) / gsz; return true;
    }
    __device__ __forceinline__ void a_ready(const Unit&) const {}
    __device__ __forceinline__ void done(const Unit&) const {}
};

__device__ __forceinline__ unsigned cvt_pk_bf16(float lo, float hi) { unsigned r; asm volatile("v_cvt_pk_bf16_f32 %0, %1, %2" : "=v"(r) : "v"(lo), "v"(hi)); return r; }
typedef float f32x2 __attribute__((ext_vector_type(2)));
constexpr float RMS_EPS_F = 1e-6f;
__device__ __forceinline__ float silu_f(float x) { return x * __builtin_amdgcn_rcpf(1.0f + __builtin_amdgcn_exp2f(-1.4426950408889634f * x)); }
__device__ __forceinline__ float row_rstd(const float* ssq, int row) {
    const f32x4* p = (const f32x4*)(ssq + (size_t)row * 16); const f32x4 a = p[0], b = p[1], c = p[2], d = p[3];
    const float s = ((a[0] + a[1]) + (a[2] + a[3])) + ((b[0] + b[1]) + (b[2] + b[3])) + ((c[0] + c[1]) + (c[2] + c[3])) + ((d[0] + d[1]) + (d[2] + d[3]));
    return rsqrtf(s * (1.0f / 1024.0f) + RMS_EPS_F); }

struct EpiSwiGLU {
    static constexpr bool PERM = true, AFTER_DRAIN = false;
    bf16_t* U; const float* ssq; int ldu;
    __device__ __forceinline__ void operator()(const f32x4 (&acc)[2][2][4][2], const Unit& u, int wr, int wc, int fr, int fq) const {
        const int row0 = u.pm * BM + wr * 64 + fr, col0 = u.pn * HALF + wc * 32 + 8 * fq;
#pragma unroll
        for (int ai = 0; ai < 2; ++ai)
#pragma unroll
            for (int m = 0; m < 4; ++m) {
                const int row = row0 + ai * HALF + m * 16; const float r = row_rstd(ssq, row);
                const f32x4 a0 = acc[ai][0][m][0] * r, a1 = acc[ai][0][m][1] * r, b0 = acc[ai][1][m][0] * r, b1 = acc[ai][1][m][1] * r;
                u32x4 w;
                w.x = cvt_pk_bf16(silu_f(a0[0]) * b0[0], silu_f(a0[1]) * b0[1]); w.y = cvt_pk_bf16(silu_f(a0[2]) * b0[2], silu_f(a0[3]) * b0[3]);
                w.z = cvt_pk_bf16(silu_f(a1[0]) * b1[0], silu_f(a1[1]) * b1[1]); w.w = cvt_pk_bf16(silu_f(a1[2]) * b1[2], silu_f(a1[3]) * b1[3]);
                *(u32x4*)(U + (size_t)row * ldu + col0) = w;
            }
    }
};
struct EpiResid {
    static constexpr bool PERM = true, AFTER_DRAIN = false;
    const float* Hin; float* H; bf16_t* HB; float* ssq_out; float scale;
    __device__ __forceinline__ void operator()(const f32x4 (&acc)[2][2][4][2], const Unit& u, int wr, int wc, int fr, int fq) const {
        const int row0 = u.pm * BM + wr * 64 + fr, col0 = u.pn * BM + wc * 32 + 8 * fq;
#pragma unroll
        for (int ai = 0; ai < 2; ++ai)
#pragma unroll
            for (int m = 0; m < 4; ++m) {
                const int row = row0 + ai * HALF + m * 16; float sq = 0.f;
#pragma unroll
                for (int bj = 0; bj < 2; ++bj) {
                    float* hp = H + (size_t)row * 1024 + col0 + bj * HALF; const float* hi_ = Hin + (size_t)row * 1024 + col0 + bj * HALF;
                    f32x4 h0 = *(const f32x4*)hi_, h1 = *(const f32x4*)(hi_ + 4);
                    h0 = h0 + acc[ai][bj][m][0] * scale; h1 = h1 + acc[ai][bj][m][1] * scale;
                    *(f32x4*)hp = h0; *(f32x4*)(hp + 4) = h1;
                    sq += (h0[0] * h0[0] + h0[1] * h0[1]) + (h0[2] * h0[2] + h0[3] * h0[3]) + (h1[0] * h1[0] + h1[1] * h1[1]) + (h1[2] * h1[2] + h1[3] * h1[3]);
                    if (HB) { u32x4 w; w.x = cvt_pk_bf16(h0[0], h0[1]); w.y = cvt_pk_bf16(h0[2], h0[3]); w.z = cvt_pk_bf16(h1[0], h1[1]); w.w = cvt_pk_bf16(h1[2], h1[3]);
                        *(u32x4*)(HB + (size_t)row * 1024 + col0 + bj * HALF) = w; }
                }
                if (ssq_out) { sq += shx<16>(sq); sq = sh32_sum(sq); if (fq == 0) ssq_out[(size_t)row * 16 + u.pn * 4 + wc] = sq; }
            }
    }
};
struct EpiScale {
    static constexpr bool PERM = true, AFTER_DRAIN = false;
    bf16_t* O; int ldc; const float* ssq; int split_cols; size_t split_stride;
    __device__ __forceinline__ void operator()(const f32x4 (&acc)[2][2][4][2], const Unit& u, int wr, int wc, int fr, int fq) const {
        const int row0 = u.pm * BM + wr * 64 + fr; int colt = u.pn * BM; bf16_t* base = O;
        if (split_cols) { const int t = colt / split_cols; base += (size_t)t * split_stride; colt -= t * split_cols; }
        const int col0 = colt + wc * 32 + 8 * fq;
#pragma unroll
        for (int ai = 0; ai < 2; ++ai)
#pragma unroll
            for (int m = 0; m < 4; ++m) {
                const int row = row0 + ai * HALF + m * 16; const float r = row_rstd(ssq, row);
                bf16_t* rowp = base + (size_t)row * ldc + col0;
#pragma unroll
                for (int bj = 0; bj < 2; ++bj) { const f32x4 v0 = acc[ai][bj][m][0] * r, v1 = acc[ai][bj][m][1] * r;
                    u32x4 w; w.x = cvt_pk_bf16(v0[0], v0[1]); w.y = cvt_pk_bf16(v0[2], v0[3]); w.z = cvt_pk_bf16(v1[0], v1[1]); w.w = cvt_pk_bf16(v1[2], v1[3]);
                    *(u32x4*)(rowp + bj * HALF) = w; }
            }
    }
};

enum { KIND_PLAIN = 0, KIND_NORM = 1, KIND_NORM_ROPE = 2, KIND_ROPE = 3, KIND_VT = 4, KIND_NORM_ROPE_KSUM = 5, KIND_IK = 6, KIND_SKIP = 7 };
struct EpiProj {
    static constexpr bool PERM = true, AFTER_DRAIN = false;
    bf16_t* O; int ldc; const float* ssq; int split_cols; size_t split_stride;
    int even;
    const float* gtab;
    const float* cosT; const float* sinT;
    bf16_t* Vt;
    bf16_t* IKf;
    PG8_LAS float* xch;
    __device__ __forceinline__ void operator()(const f32x4 (&acc)[2][2][4][2], const Unit& u, int wr, int wc, int fr, int fq) const {
        const int S_ = 16384;
        int kind; int gsel = 0; int vcol0 = 0;
        if (even) { const int p = u.pn;
            kind = (p < 2) ? KIND_NORM : (p < 4) ? KIND_NORM_ROPE : (p < 6) ? KIND_NORM : (p < 8) ? KIND_NORM_ROPE : (p < 10) ? KIND_VT : (p < 12) ? KIND_PLAIN : (p < 14) ? KIND_ROPE : KIND_IK;
            gsel = (p < 8) ? (p >> 1) : 0; vcol0 = (p - 8) * 256;
        } else { const int p = u.pn; kind = (p < 8) ? KIND_NORM_ROPE : KIND_VT; gsel = (p < 8) ? 4 + (p >> 2) : 0; vcol0 = (p - 8) * 256; }
        const float* gn = gtab + gsel * 64;
        const int row0 = u.pm * BM + wr * 64 + fr; int colt = u.pn * BM; bf16_t* base = O;
        if (split_cols) { const int t = colt / split_cols; base += (size_t)t * split_stride; colt -= t * split_cols; }
        const int co0 = wc * 32 + 8 * fq;
        const int hd0 = 32 * (wc & 1) + 8 * fq;
        int xo = ((wr * 64 + fr) * 2) * 4 + wc, xp = ((wr * 64 + fr) * 2) * 4 + (wc ^ 1);
        asm volatile("" : "+v"(xo), "+v"(xp));
        const bool normk = (kind == KIND_NORM || kind == KIND_NORM_ROPE || kind == KIND_NORM_ROPE_KSUM);
        const bool ropek = (kind == KIND_NORM_ROPE || kind == KIND_ROPE || kind == KIND_NORM_ROPE_KSUM || kind == KIND_IK);
        float gv[8];
#pragma unroll
        for (int e2 = 0; e2 < 8; ++e2) gv[e2] = normk ? gn[hd0 + e2] : 1.0f;
        if (normk) {
#pragma unroll
            for (int ai = 0; ai < 2; ++ai)
#pragma unroll
                for (int m = 0; m < 4; ++m)
#pragma unroll
                    for (int bj = 0; bj < 2; ++bj) { const f32x4 v0 = acc[ai][bj][m][0], v1 = acc[ai][bj][m][1];
                        float ss = (v0[0] * v0[0] + v0[1] * v0[1]) + (v0[2] * v0[2] + v0[3] * v0[3]) + (v1[0] * v1[0] + v1[1] * v1[1]) + (v1[2] * v1[2] + v1[3] * v1[3]);
                        ss += shx<16>(ss); ss = sh32_sum(ss);
                        if (fq == 0) xch[xo + (ai * 128 + m * 16) * 8 + bj * 4] = ss; }
            asm volatile("s_waitcnt lgkmcnt(0)" ::: "memory"); __builtin_amdgcn_s_barrier(); asm volatile("" ::: "memory");
        }
        if (kind != KIND_SKIP) {
#pragma unroll
        for (int ai = 0; ai < 2; ++ai)
#pragma unroll
            for (int m = 0; m < 4; ++m) {
                const int row = row0 + ai * HALF + m * 16; const float r = row_rstd(ssq, row);
                float cs[8], sn[8];
                if (ropek) { const f32x4 c0 = *(const f32x4*)(cosT + (unsigned)(row * 8)), c1 = *(const f32x4*)(cosT + (unsigned)(row * 8 + 4)), s0 = *(const f32x4*)(sinT + (unsigned)(row * 8)), s1 = *(const f32x4*)(sinT + (unsigned)(row * 8 + 4));
#pragma unroll
                    for (int e2 = 0; e2 < 4; ++e2) { cs[e2] = c0[e2]; cs[4 + e2] = c1[e2]; sn[e2] = s0[e2]; sn[4 + e2] = s1[e2]; } }
#pragma unroll
                for (int bj = 0; bj < 2; ++bj) {
                    if (kind == KIND_IK && (bj == 1 || wc >= 2)) continue;
                    float x[8];
                    { const f32x4 v0 = acc[ai][bj][m][0], v1 = acc[ai][bj][m][1];
#pragma unroll
                      for (int e2 = 0; e2 < 4; ++e2) { x[e2] = v0[e2]; x[4 + e2] = v1[e2]; } }
                    float sc = r;
                    if (normk) { const float tot = xch[xo + (ai * 128 + m * 16) * 8 + bj * 4] + xch[xp + (ai * 128 + m * 16) * 8 + bj * 4];
                        sc = r * rsqrtf(tot * (r * r) * (1.0f / 64.0f) + RMS_EPS_F); }
#pragma unroll
                    for (int e2 = 0; e2 < 8; ++e2) x[e2] = x[e2] * sc * gv[e2];
                    if (ropek) {
#pragma unroll
                        for (int e2 = 0; e2 < 8; ++e2) { const float other = shx<16>(x[e2]);
                            if ((wc & 1) == 0 && fq == 0) x[e2] = x[e2] * cs[e2] - other * sn[e2];
                            else if ((wc & 1) == 0 && fq == 1) x[e2] = x[e2] * cs[e2] + other * sn[e2]; }
                    }
                    if (kind == KIND_VT) {
                        bf16_t* vp = Vt + (unsigned)((vcol0 + bj * HALF + co0) * S_ + (row & ~1));
#pragma unroll
                        for (int e2 = 0; e2 < 8; ++e2) { const float other = shx<1>(x[e2]);
                            const unsigned w = (fr & 1) ? cvt_pk_bf16(other, x[e2]) : cvt_pk_bf16(x[e2], other);
                            if (((e2 >> 2) & 1) == (fr & 1)) *(unsigned*)(vp + (unsigned)(e2 * S_)) = w; }
                    } else if (kind == KIND_IK) {
                        const int c8 = 4 * wc + fq;
                        u32x4 w; w.x = cvt_pk_bf16(x[0], x[1]); w.y = cvt_pk_bf16(x[2], x[3]); w.z = cvt_pk_bf16(x[4], x[5]); w.w = cvt_pk_bf16(x[6], x[7]);
                        *(u32x4*)(IKf + (unsigned)((((row >> 5) * 4 + (c8 >> 1)) * 64 + (c8 & 1) * 32 + (row & 31)) * 8)) = w;
                    } else {
                        u32x4 w; w.x = cvt_pk_bf16(x[0], x[1]); w.y = cvt_pk_bf16(x[2], x[3]); w.z = cvt_pk_bf16(x[4], x[5]); w.w = cvt_pk_bf16(x[6], x[7]);
                        *(u32x4*)(base + (unsigned)(row * ldc + colt + bj * HALF + co0)) = w;
                    }
                }
            }
        }
        if (normk) { asm volatile("s_waitcnt lgkmcnt(0)" ::: "memory"); __builtin_amdgcn_s_barrier(); asm volatile("" ::: "memory"); }
    }
};

struct EpiPartial {
    static constexpr bool PERM = true, AFTER_DRAIN = false;
    float* P; int M;
    __device__ __forceinline__ void operator()(const f32x4 (&acc)[2][2][4][2], const Unit& u, int wr, int wc, int fr, int fq) const {
        const int row0 = u.pm * BM + wr * 64 + fr; float* base = P + (size_t)u.pn * M * 256 + wc * 32 + 8 * fq;
#pragma unroll
        for (int ai = 0; ai < 2; ++ai)
#pragma unroll
            for (int m = 0; m < 4; ++m) { float* rp = base + (unsigned)((row0 + ai * HALF + m * 16) * 256);
#pragma unroll
                for (int bj = 0; bj < 2; ++bj) { *(f32x4*)(rp + bj * HALF) = acc[ai][bj][m][0]; *(f32x4*)(rp + bj * HALF + 4) = acc[ai][bj][m][1]; } }
    }
};
template <class Epi, class Sched, bool ALIGN_EPI = false, bool SP2 = false, int KSPLIT = 0, int LDB = 0>
__device__ __forceinline__ void gemm_phase(PG8_LAS unsigned char* lds, const Gemm g, const Sched& S, const Epi& E, const int tid) {
    const int wid = __builtin_amdgcn_readfirstlane(tid >> 6), lane = tid & 63, wr = wid >> 2, wc = wid & 3, fr = lane & 15, fq = lane >> 4;
    const int K = g.K, nt = K / BK;
    unsigned voffA[2], voffB[2];
#pragma unroll
    for (int i = 0; i < 2; ++i) { int R, C; stage_rc(tid * 16 + i * 8192, R, C); const int Rb = Epi::PERM ? ((R & ~31) + perm32(R & 31)) : R;
        voffA[i] = (unsigned)(R * g.lda + C) * 2u; voffB[i] = (unsigned)(Rb * (LDB ? LDB : K) + C) * 2u; }
    const size_t kstep = (size_t)(BK * 2);
    const size_t hstepA = (size_t)HALF * g.lda * 2, hstepB = (size_t)HALF * (LDB ? LDB : K) * 2;
    const size_t tstepA = 2 * hstepA, tstepB = 2 * hstepB;
    const unsigned ldsw = (unsigned)wid * 1024u;
    const int aoff = lds_byte(wr * 64 + fr, fq * 8), boff = lds_byte(wc * 32 + fr, fq * 8);
#define PG8_SA(b, h) (((b) * 2 + (h)) * HTB)
#define PG8_SB(b, h) ((4 + (b) * 2 + (h)) * HTB)
#define PG8_STAGE(bufoff, gbase, voff) do { _Pragma("unroll") for (int _i = 0; _i < 2; ++_i) \
        __builtin_amdgcn_global_load_lds((const unsigned*)((const char*)(gbase) + (voff)[_i]), (PG8_LAS unsigned*)(lds + (bufoff) + ldsw + _i * 8192), 16, 0, 0); } while (0)
#define PG8_LDA(dst, b, h) do { _Pragma("unroll") for (int m = 0; m < 4; ++m) _Pragma("unroll") for (int k = 0; k < 2; ++k) dst[m][k] = *(const PG8_LAS bf16x8*)(lds + PG8_SA(b, h) + aoff + m * 2048 + k * 1024); } while (0)
#define PG8_LDB(dst, b, h) do { _Pragma("unroll") for (int n = 0; n < 2; ++n) _Pragma("unroll") for (int k = 0; k < 2; ++k) dst[n][k] = *(const PG8_LAS bf16x8*)(lds + PG8_SB(b, h) + boff + n * 2048 + k * 1024); } while (0)
#define PG8_MMA(ai, bj, At, Bt) do { __builtin_amdgcn_s_setprio(1); _Pragma("unroll") for (int m = 0; m < 4; ++m) _Pragma("unroll") for (int n = 0; n < 2; ++n) _Pragma("unroll") for (int k = 0; k < 2; ++k) \
        acc[ai][bj][m][n] = __builtin_amdgcn_mfma_f32_16x16x32_bf16(Bt[n][k], At[m][k], acc[ai][bj][m][n], 0, 0, 0); __builtin_amdgcn_s_setprio(0); } while (0)
#define PG8_WAIT_V(n) asm volatile("s_waitcnt vmcnt(" #n ")" ::: "memory")
#define PG8_WAIT_L(n) asm volatile("s_waitcnt lgkmcnt(" #n ")" ::: "memory")
#define PG8_BAR __builtin_amdgcn_s_barrier()
#define PG8_SCHED __builtin_amdgcn_sched_barrier(0)
    Unit cur, nxt; int ui = 0;
    if (!S.next(0, cur)) return;
    f32x4 acc[2][2][4][2];
#pragma unroll
    for (int a = 0; a < 2; ++a)
#pragma unroll
        for (int b = 0; b < 2; ++b)
#pragma unroll
            for (int m = 0; m < 4; ++m)
#pragma unroll
                for (int n = 0; n < 2; ++n) acc[a][b][m][n] = (f32x4){0.f, 0.f, 0.f, 0.f};
    bf16x8 At[4][2], B0[2][2], B1[2][2];
    const char* cA = (const char*)g.A + (size_t)cur.pm * tstepA + (KSPLIT ? (size_t)cur.pn * KSPLIT : (size_t)0); const char* cB = (const char*)g.Bt + (KSPLIT ? (size_t)cur.pn * KSPLIT : (size_t)cur.pn * tstepB);
    S.a_ready(cur);
    if constexpr (SP2) {
        PG8_STAGE(PG8_SB(0, 0), cB, voffB); PG8_STAGE(PG8_SB(0, 1), cB + hstepB, voffB); PG8_STAGE(PG8_SA(0, 0), cA, voffA); PG8_STAGE(PG8_SA(0, 1), cA + hstepA, voffA);
        if (wr == 1) PG8_BAR;
        PG8_WAIT_V(2); PG8_BAR;
        PG8_STAGE(PG8_SB(1, 0), cB + kstep, voffB); PG8_STAGE(PG8_SA(1, 0), cA + kstep, voffA); PG8_STAGE(PG8_SB(1, 1), cB + hstepB + kstep, voffB);
        PG8_WAIT_V(6); PG8_BAR;
    } else {
        PG8_STAGE(PG8_SB(0, 0), cB, voffB); PG8_STAGE(PG8_SA(0, 0), cA, voffA); PG8_STAGE(PG8_SB(0, 1), cB + hstepB, voffB); PG8_STAGE(PG8_SA(0, 1), cA + hstepA, voffA);
        if (wr == 1) PG8_BAR;
        PG8_WAIT_V(4); PG8_BAR;
        PG8_STAGE(PG8_SB(1, 0), cB + kstep, voffB); PG8_STAGE(PG8_SA(1, 0), cA + kstep, voffA); PG8_STAGE(PG8_SB(1, 1), cB + hstepB + kstep, voffB);
        PG8_WAIT_V(6); PG8_BAR;
    }
    for (;;) {
        const bool has_next = S.next(ui + 1, nxt);
        const char* nA = has_next ? (const char*)g.A + (size_t)nxt.pm * tstepA + (KSPLIT ? (size_t)nxt.pn * KSPLIT : (size_t)0) : cA; const char* nB = has_next ? (const char*)g.Bt + (KSPLIT ? (size_t)nxt.pn * KSPLIT : (size_t)nxt.pn * tstepB) : cB;
        for (int t = 0; t < nt; t += 2) {
            const bool last = (t == nt - 2);
            const char* a1 = cA + (size_t)(t + 1) * kstep;
            const char* a2 = last ? nA : cA + (size_t)(t + 2) * kstep; const char* b2 = last ? nB : cB + (size_t)(t + 2) * kstep;
            const char* a3 = a2 + kstep; const char* b3 = b2 + kstep;
            if (last && has_next) S.a_ready(nxt);
            if constexpr (SP2) {
            PG8_LDB(B0, 0, 0); PG8_LDB(B1, 0, 1); PG8_SCHED; PG8_LDA(At, 0, 0); PG8_STAGE(PG8_SA(1, 1), a1 + hstepA, voffA);
            PG8_WAIT_V(8); PG8_WAIT_L(0); PG8_BAR; PG8_MMA(0, 0, At, B0); PG8_MMA(0, 1, At, B1); PG8_BAR; PG8_SCHED;
            PG8_LDA(At, 0, 1); PG8_STAGE(PG8_SB(0, 0), b2, voffB); PG8_STAGE(PG8_SB(0, 1), b2 + hstepB, voffB); PG8_STAGE(PG8_SA(0, 0), a2, voffA);
            PG8_WAIT_V(8); PG8_WAIT_L(0); PG8_BAR; PG8_MMA(1, 0, At, B0); PG8_MMA(1, 1, At, B1); PG8_BAR; PG8_SCHED;
            PG8_LDB(B0, 1, 0); PG8_LDB(B1, 1, 1); PG8_SCHED; PG8_LDA(At, 1, 0); PG8_STAGE(PG8_SA(0, 1), a2 + hstepA, voffA);
            PG8_WAIT_V(8); PG8_WAIT_L(0); PG8_BAR; PG8_MMA(0, 0, At, B0); PG8_MMA(0, 1, At, B1); PG8_BAR; PG8_SCHED;
            PG8_LDA(At, 1, 1); PG8_STAGE(PG8_SB(1, 0), b3, voffB); PG8_STAGE(PG8_SB(1, 1), b3 + hstepB, voffB); PG8_STAGE(PG8_SA(1, 0), a3, voffA);
            PG8_WAIT_V(8); PG8_WAIT_L(0); PG8_BAR; PG8_MMA(1, 0, At, B0); PG8_MMA(1, 1, At, B1); PG8_BAR; PG8_SCHED;
            } else {
            PG8_LDB(B0, 0, 0); PG8_SCHED; PG8_LDA(At, 0, 0); PG8_STAGE(PG8_SA(1, 1), a1 + hstepA, voffA);
            PG8_WAIT_L(8); PG8_BAR; PG8_WAIT_L(0); PG8_MMA(0, 0, At, B0); PG8_BAR; PG8_SCHED;
            PG8_LDB(B1, 0, 1); PG8_STAGE(PG8_SB(0, 0), b2, voffB);
            PG8_BAR; PG8_WAIT_L(0); PG8_MMA(0, 1, At, B1); PG8_BAR;
            PG8_LDA(At, 0, 1); PG8_STAGE(PG8_SA(0, 0), a2, voffA);
            PG8_BAR; PG8_WAIT_L(0); PG8_MMA(1, 0, At, B0); PG8_BAR; PG8_SCHED;
            PG8_STAGE(PG8_SB(0, 1), b2 + hstepB, voffB);
            PG8_WAIT_V(6); PG8_BAR; PG8_MMA(1, 1, At, B1); PG8_BAR;
            PG8_LDB(B0, 1, 0); PG8_SCHED; PG8_LDA(At, 1, 0); PG8_STAGE(PG8_SA(0, 1), a2 + hstepA, voffA);
            PG8_WAIT_L(8); PG8_BAR; PG8_WAIT_L(0); PG8_MMA(0, 0, At, B0); PG8_BAR; PG8_SCHED;
            PG8_LDB(B1, 1, 1); PG8_STAGE(PG8_SB(1, 0), b3, voffB);
            PG8_BAR; PG8_WAIT_L(0); PG8_MMA(0, 1, At, B1); PG8_BAR;
            PG8_LDA(At, 1, 1); PG8_STAGE(PG8_SA(1, 0), a3, voffA);
            PG8_BAR; PG8_WAIT_L(0); PG8_MMA(1, 0, At, B0); PG8_BAR; PG8_SCHED;
            PG8_STAGE(PG8_SB(1, 1), b3 + hstepB, voffB);
            PG8_WAIT_V(6); PG8_BAR; PG8_MMA(1, 1, At, B1); PG8_BAR;
            }
        }
        if constexpr (ALIGN_EPI) { if (wr == 0) PG8_BAR; }
        if constexpr (!Epi::AFTER_DRAIN) { E(acc, cur, wr, wc, fr, fq); S.done(cur); }
        if (!has_next) break;
#pragma unroll
        for (int a = 0; a < 2; ++a)
#pragma unroll
            for (int b = 0; b < 2; ++b)
#pragma unroll
                for (int m = 0; m < 4; ++m)
#pragma unroll
                    for (int n = 0; n < 2; ++n) acc[a][b][m][n] = (f32x4){0.f, 0.f, 0.f, 0.f};
        cur = nxt; cA = nA; cB = nB; ++ui;
        if constexpr (ALIGN_EPI) { if (wr == 1) PG8_BAR; }
    }
    PG8_WAIT_V(0);
    if constexpr (!ALIGN_EPI) { if (wr == 0) PG8_BAR; }
    PG8_BAR;
    if constexpr (Epi::AFTER_DRAIN) { E.fused(acc, cur, wr, wc, fr, fq, lds, wid, lane); S.done(cur); }
#undef PG8_SA
#undef PG8_SB
#undef PG8_STAGE
#undef PG8_LDA
#undef PG8_LDB
#undef PG8_MMA
#undef PG8_WAIT_V
#undef PG8_WAIT_L
#undef PG8_BAR
#undef PG8_SCHED
}
}

constexpr int S = 16384, DM = 1024, FF = 2816, FF2 = 5632, EVEN_SRC = 3664, EVEN_NP = 3840, ODD_N = 3072, NLAYER = 2, MEMT = 256, MEMW = 256;
constexpr float RMS_EPS = 1e-6f;
constexpr float LOG2E = 1.4426950408889634f;
constexpr float C2 = 0.125f * LOG2E;
constexpr int NWAVES = 8, NTHREADS = 512;
constexpr int EC_FQ = 0, EC_DQ = 512, EC_FK = 1024, EC_DK = 1536, EC_FV = 2048, EC_DV = 2560, EC_IQ = 3072, EC_IK = 3584;
constexpr int ES_FQ = 0, ES_FK = 512, ES_FV = 1024, ES_FL = 1536, ES_DQ = 1544, ES_DK = 2056, ES_DV = 2568, ES_IQ = 3080, ES_IK = 3592, ES_IW = 3656;

constexpr size_t MiB = 1u << 20;
constexpr size_t WS_CTL = 0, CTL_ZERO_BYTES = 1 * MiB;
constexpr size_t WS_SSQ = 1 * MiB;
constexpr size_t WS_KSUM = 6 * MiB;
constexpr size_t WS_GT = 11 * MiB + 131072;
constexpr size_t WS_TW = 11 * MiB;
constexpr size_t WS_ROPE = 2 * MiB;
constexpr size_t WS_FL = 3 * MiB;
constexpr size_t WS_MEMK = 4 * MiB;
constexpr size_t WS_IW = 5 * MiB;
constexpr size_t WS_W = 12 * MiB;
constexpr size_t WS_BIG = 60 * MiB;
constexpr size_t WS_HB = 224 * MiB;
constexpr size_t WS_END = 256 * MiB;
constexpr size_t W_FFN1_IN = 0, W_FFN1_OUT = 11 * MiB, W_MIX_IN = 17 * MiB, W_MIX_OUT = 25 * MiB, W_MEMQ = 27 * MiB, W_MEMO = 28 * MiB, W_FFN2_IN = 29 * MiB, W_FFN2_OUT = 40 * MiB, W_MEMQ2 = 46 * MiB, W_MEMO2 = 47 * MiB;
constexpr size_t B_U = 0;
constexpr size_t B_PROJ = 0;
constexpr size_t B_VTF = 120 * MiB;
constexpr size_t B_IKC = 136 * MiB;
constexpr size_t B_VTM = 96 * MiB;
constexpr size_t B_SEL = 156 * MiB;
constexpr size_t B_QP = 0;
constexpr size_t B_QM = 140 * MiB, B_OM = 148 * MiB;
constexpr int CW_TMO = 0, CW_CODE = 1, CW_BAR = 4096;

constexpr int RING_BYTES = 147456;
constexpr int LDSCTL_OFF = RING_BYTES, MISC_OFF = LDSCTL_OFF + 320;
constexpr int LDS_BYTES = 163840;

#define GAS __attribute__((address_space(1)))
#define LAS __attribute__((address_space(3)))
typedef unsigned short bf16;
typedef unsigned v4u __attribute__((ext_vector_type(4)));
typedef float f32x4 __attribute__((ext_vector_type(4)));
typedef short bf16x8 __attribute__((ext_vector_type(8)));
typedef GAS unsigned gu32;
typedef GAS unsigned long long gu64;
#define RLX_AGENT __ATOMIC_RELAXED, __HIP_MEMORY_SCOPE_AGENT
#define LDS_WAIT() asm volatile("s_waitcnt lgkmcnt(0)" ::: "memory")
#define VM_WAIT() asm volatile("s_waitcnt vmcnt(0)" ::: "memory")
__device__ __forceinline__ unsigned long long rt() { return __builtin_amdgcn_s_memrealtime(); }
__device__ __forceinline__ unsigned f2bf(float f) { unsigned u = __builtin_bit_cast(unsigned, f); return (u + 0x7fffu + ((u >> 16) & 1u)) >> 16; }
__device__ __forceinline__ unsigned pk2(float lo, float hi) { return f2bf(lo) | (f2bf(hi) << 16); }

#define XB_TMO      128
#define XB_XCNT(j)  (256  + 64 * (j))
#define XB_XSUB(j)  (1280 + 64 * (j))
#define XB_XGEN(j)  (2304 + 64 * (j))
#define XB_TOP      3328
#define XB_TOPGEN   3392
#define XCD_BAR_WORDS 3456
#define XB_SPIN_CAP (1u << 18)

__device__ __forceinline__ unsigned xb_ld(unsigned* p)              { return __hip_atomic_load(p, __ATOMIC_RELAXED, __HIP_MEMORY_SCOPE_AGENT); }
__device__ __forceinline__ unsigned xb_add(unsigned* p, unsigned v) { return __hip_atomic_fetch_add(p, v, __ATOMIC_RELAXED, __HIP_MEMORY_SCOPE_AGENT); }
__device__ __forceinline__ unsigned xb_xcc_id() { return (unsigned)__builtin_amdgcn_s_getreg((3 << 11) | 20) & 0xFu; }
#define XB_SPIN(cond, bar) do { unsigned _sp = 0; while (cond) { __builtin_amdgcn_s_sleep(1); \
    if ((++_sp & 255u) == 0u) { if (xb_ld(&(bar)[XB_TMO])) break; if (_sp > XB_SPIN_CAP) { atomicAdd(&(bar)[XB_TMO], 1u); break; } } } } while (0)

struct XcdBarrier {
    unsigned* bar; unsigned x;
    volatile LAS unsigned* st;
};

__device__ __forceinline__ XcdBarrier xcd_barrier_post(unsigned* bar, volatile LAS unsigned* st) {
    XcdBarrier b; b.bar = bar; b.x = xb_xcc_id(); b.st = st;
    if (threadIdx.x == 0) (void)xb_add(&bar[XB_XCNT(b.x)], 1u);
    return b;
}
__device__ __forceinline__ void xcd_barrier_complete(unsigned* bar, unsigned x, unsigned& nloc, unsigned& nx) {
    const unsigned G = gridDim.x * gridDim.y * gridDim.z;
    unsigned sum, cnt, mine, sp = 0u;
    for (;;) {
        sum = 0u; cnt = 0u; mine = 0u;
#pragma unroll
        for (unsigned j = 0; j < 16; ++j) { const unsigned c = xb_ld(&bar[XB_XCNT(j)]); sum += c; cnt += (c > 0u) ? 1u : 0u; mine = (j == x) ? c : mine; }
        if (sum == G) break;
        __builtin_amdgcn_s_sleep(1);
        if ((++sp & 255u) == 0u) { if (xb_ld(&bar[XB_TMO])) break; if (sp > XB_SPIN_CAP) { atomicAdd(&bar[XB_TMO], 1u); break; } }
    }
    nloc = mine > 0u ? mine : 1u; nx = cnt > 0u ? cnt : 1u;
}

__device__ __forceinline__ void xcd_barrier(const XcdBarrier& b) {
    asm volatile("s_waitcnt vmcnt(0)" ::: "memory");
    __syncthreads();
    if (threadIdx.x == 0) {
        unsigned* bar = b.bar;
        __builtin_amdgcn_s_waitcnt(0);
        unsigned nloc = b.st[0], nx = b.st[1];
        if (nloc == 0u) { unsigned x_ = b.x; asm volatile("" : "+s"(x_)); xcd_barrier_complete(bar, x_, nloc, nx); b.st[0] = nloc; b.st[1] = nx; }
        const unsigned old = xb_add(&bar[XB_XSUB(b.x)], 1u);
        const unsigned gen = old / nloc;
        if (old + 1u == (gen + 1u) * nloc) {
            __builtin_amdgcn_fence(__ATOMIC_RELEASE, "agent");
            asm volatile("s_waitcnt vmcnt(0)" ::: "memory");
            const unsigned og = xb_add(&bar[XB_TOP], 1u);
            const unsigned tg = og / nx;
            if (og + 1u == (tg + 1u) * nx) xb_add(&bar[XB_TOPGEN], 1u);
            else XB_SPIN(xb_ld(&bar[XB_TOPGEN]) == tg, bar);
            __builtin_amdgcn_fence(__ATOMIC_ACQUIRE, "agent");
            xb_add(&bar[XB_XGEN(b.x)], 1u);
            asm volatile("s_waitcnt vmcnt(0)" ::: "memory");
        } else {
            XB_SPIN(xb_ld(&bar[XB_XGEN(b.x)]) == gen, bar);
            __builtin_amdgcn_fence(__ATOMIC_ACQUIRE, "agent");
            asm volatile("s_waitcnt vmcnt(0)" ::: "memory");
        }
    }
    __syncthreads();
}

typedef float f32x16 __attribute__((ext_vector_type(16)));
typedef float f32x2_t __attribute__((ext_vector_type(2)));
typedef __bf16 bf16x2_t __attribute__((ext_vector_type(2)));
typedef unsigned u32x2 __attribute__((ext_vector_type(2)));
__device__ __forceinline__ unsigned cvtpk(float lo, float hi) { f32x2_t v = {lo, hi}; bf16x2_t b = __builtin_convertvector(v, bf16x2_t); return __builtin_bit_cast(unsigned, b); }
__device__ __forceinline__ float bflo(unsigned w) { return __uint_as_float(w << 16); }
__device__ __forceinline__ float bfhi(unsigned w) { return __uint_as_float(w & 0xffff0000u); }
__device__ __forceinline__ void unpack8(const v4u& w, float (&x)[8]) { x[0] = bflo(w.x); x[1] = bfhi(w.x); x[2] = bflo(w.y); x[3] = bfhi(w.y); x[4] = bflo(w.z); x[5] = bfhi(w.z); x[6] = bflo(w.w); x[7] = bfhi(w.w); }
__device__ __forceinline__ v4u pack8(const float (&x)[8]) { v4u w; w.x = cvtpk(x[0], x[1]); w.y = cvtpk(x[2], x[3]); w.z = cvtpk(x[4], x[5]); w.w = cvtpk(x[6], x[7]); return w; }
__device__ __forceinline__ float wave_sum(float v) { v += shx<1>(v); v += shx<2>(v); v += shx<4>(v); v += shx<8>(v); v += shx<16>(v); return sh32_sum(v); }
__device__ __forceinline__ float wave_max(float v) { v = fmaxf(v, shx<1>(v)); v = fmaxf(v, shx<2>(v)); v = fmaxf(v, shx<4>(v)); v = fmaxf(v, shx<8>(v)); v = fmaxf(v, shx<16>(v)); return sh32_max(v); }
__device__ __forceinline__ int crow(int r, int hi) { return (r & 3) + 8 * (r >> 2) + 4 * hi; }

__device__ __forceinline__ int even_map(int n) {
    if (n < 512) return ES_FQ + n;
    if (n < 1024) return ES_DQ + (n - 512);
    if (n < 1536) return ES_FK + (n - 1024);
    if (n < 2048) return ES_DK + (n - 1536);
    if (n < 2560) return ES_FV + (n - 2048);
    if (n < 3072) return ES_DV + (n - 2560);
    if (n < 3584) return ES_IQ + (n - 3072);
    if (n < 3648) return ES_IK + (n - 3584);
    return -1;
}
__device__ __forceinline__ void conv_item(const float* W, int K, int Nsrc, int nblk, const float* gain, bf16* WT, int mode, LAS float* scr, int item, int lane) {
    const int kb = item / nblk, nb = item % nblk, k0 = 32 * kb, n0 = 128 * nb;
    const int n = n0 + 4 * (lane & 31);
    int sc;
    if (mode == 0) sc = n; else if (mode == 1) { const int T = n >> 8, hf = (n >> 7) & 1, j = n & 127; sc = hf * FF + 128 * T + j; } else sc = even_map(n);
    f32x4 v[16];
#pragma unroll
    for (int i = 0; i < 16; ++i) { const int kk = 2 * i + (lane >> 5); v[i] = (f32x4){0.f, 0.f, 0.f, 0.f};
        if (sc >= 0) v[i] = *(const GAS f32x4*)(W + (size_t)(k0 + kk) * Nsrc + sc); }
#pragma unroll
    for (int i = 0; i < 16; ++i) { const int kk = 2 * i + (lane >> 5); const float g = gain ? gain[k0 + kk] : 1.0f;
        *(LAS f32x4*)(scr + kk * 132 + 4 * (lane & 31)) = v[i] * g; }
    LDS_WAIT(); asm volatile("" ::: "memory");
    const int c = lane & 3;
#pragma unroll
    for (int j = 0; j < 8; ++j) { const int nn = (lane >> 2) + 16 * j; const LAS float* s = scr + (8 * c) * 132 + nn;
        v4u o; o.x = cvtpk(s[0 * 132], s[1 * 132]); o.y = cvtpk(s[2 * 132], s[3 * 132]); o.z = cvtpk(s[4 * 132], s[5 * 132]); o.w = cvtpk(s[6 * 132], s[7 * 132]);
        *(GAS v4u*)(WT + (size_t)(n0 + nn) * K + k0 + 8 * c) = o; }
    LDS_WAIT(); asm volatile("" ::: "memory");
}
struct InPtrs { const float* p[26]; };
constexpr int INTAB_OFF = LDSCTL_OFF + 1024;
struct InTab { LAS unsigned char* ldsbase;
    __device__ __forceinline__ const float* get(int k) const { const u32x2 v = *(const LAS u32x2*)(ldsbase + INTAB_OFF + 8 * k);
        const unsigned lo = (unsigned)__builtin_amdgcn_readfirstlane((int)v.x), hi = (unsigned)__builtin_amdgcn_readfirstlane((int)v.y);
        return (const float*)(((unsigned long long)hi << 32) | lo); } };
__device__ __forceinline__ void conv_weights(const InTab& in, unsigned char* ws, int L, int mask, LAS unsigned char* lds, int gw, int NGW, int wave, int lane) {
    LAS float* scr = (LAS float*)(lds + wave * 17408);
    unsigned char* Wr = ws + WS_W;
    const bool even = (L & 1) == 0;
    const int mixN = even ? EVEN_NP : ODD_N, mixSrc = even ? EVEN_SRC : ODD_N;
    const int I_FIN = (DM / 32) * (FF2 / 128), I_FOUT = (FF / 32) * (DM / 128), I_MIN = (DM / 32) * (mixN / 128), I_MOUT = (DM / 32) * (DM / 128), I_MQ = (DM / 32) * (MEMW / 128), I_MO = (MEMW / 32) * (DM / 128);
    const int n0 = (mask & 1) ? I_FIN : 0, n1 = (mask & 2) ? I_FOUT : 0, n2 = (mask & 4) ? I_MIN : 0, n3 = (mask & 8) ? I_MOUT : 0, n4 = (mask & 16) ? I_MQ : 0, n5 = (mask & 32) ? I_MO : 0,
              n6 = (mask & 64) ? I_FIN : 0, n7 = (mask & 128) ? I_FOUT : 0;
    const int NITEMS = n0 + n1 + n2 + n3 + n4 + n5 + n6 + n7;
    for (int it = gw; it < NITEMS; it += NGW) {
        int r = it;
        if (r < n0) { conv_item(in.get(3) + (size_t)L * DM * FF2, DM, FF2, FF2 / 128, in.get(2) + (size_t)L * DM, (bf16*)(Wr + W_FFN1_IN), 1, scr, r, lane); continue; } r -= n0;
        if (r < n6) { conv_item(in.get(24) + (size_t)L * DM * FF2, DM, FF2, FF2 / 128, in.get(23) + (size_t)L * DM, (bf16*)(Wr + W_FFN2_IN), 1, scr, r, lane); continue; } r -= n6;
        if (r < n1) { conv_item(in.get(4) + (size_t)L * FF * DM, FF, DM, DM / 128, nullptr, (bf16*)(Wr + W_FFN1_OUT), 0, scr, r, lane); continue; } r -= n1;
        if (r < n7) { conv_item(in.get(25) + (size_t)L * FF * DM, FF, DM, DM / 128, nullptr, (bf16*)(Wr + W_FFN2_OUT), 0, scr, r, lane); continue; } r -= n7;
        if (r < n2) { conv_item(even ? in.get(6) : in.get(12), DM, mixSrc, mixN / 128, in.get(5) + (size_t)L * DM, (bf16*)(Wr + W_MIX_IN), even ? 2 : 0, scr, r, lane); continue; } r -= n2;
        if (r < n3) { conv_item(in.get(15) + (size_t)L * DM * DM, DM, DM, DM / 128, nullptr, (bf16*)(Wr + W_MIX_OUT), 0, scr, r, lane); continue; } r -= n3;
        if (r < n4) { conv_item(in.get(18) + (size_t)L * DM * MEMW, DM, MEMW, MEMW / 128, in.get(16) + (size_t)L * DM, (bf16*)(Wr + (L ? W_MEMQ2 : W_MEMQ)), 0, scr, r, lane); continue; } r -= n4;
        conv_item(in.get(22) + (size_t)L * MEMW * DM, MEMW, DM, DM / 128, nullptr, (bf16*)(Wr + (L ? W_MEMO2 : W_MEMO)), 0, scr, r, lane);
    }
}
__device__ __forceinline__ void copy_x(const float* x, float* out, bf16* HB, float* ssq0, int gw, int NGW, int lane) {
    for (int m = gw; m < S; m += NGW) {
        const GAS f32x4* xr = (const GAS f32x4*)(x + (size_t)m * DM) + lane;
        GAS u32x2* hb = (GAS u32x2*)(HB + (size_t)m * DM) + lane;
        float s = 0.f;
#pragma unroll
        for (int j = 0; j < 4; ++j) { const f32x4 v = xr[64 * j]; s += (v.x * v.x + v.y * v.y) + (v.z * v.z + v.w * v.w);
            u32x2 w; w.x = cvtpk(v.x, v.y); w.y = cvtpk(v.z, v.w); hb[64 * j] = w; }
        s = wave_sum(s);
        if (lane < 16) ssq0[(size_t)m * 16 + lane] = (lane == 0) ? s : 0.f;
    }
}
__device__ __forceinline__ void rope_tables(float* cosT, float* sinT, int gtid, int nthreads) {
    for (int idx = gtid; idx < S * 8; idx += nthreads) {
        const int t = idx >> 3, j = idx & 7;
        float inv;
        switch (j) { case 0: inv = 1.0f; break; case 1: inv = 0.193922743f; break; case 2: inv = 0.0376060307f; break; case 3: inv = 0.00729266461f; break;
                     case 4: inv = 0.00141421356f; break; case 5: inv = 0.000274248188f; break; case 6: inv = 5.3182961e-05f; break; default: inv = 1.03133862e-05f; break; }
        const float ang = (float)t * inv;
        const float kq = __builtin_rintf(ang * 0.63661977236758134f);
        float r = ang - kq * 1.5703125f; r = r - kq * 0.00048351287841796875f; r = r - kq * 3.1391647326017846e-07f;
        const float r2 = r * r;
        float sp = 2.7557319e-6f; sp = sp * r2 - 1.9841270e-4f; sp = sp * r2 + 8.3333333e-3f; sp = sp * r2 - 1.6666667e-1f; const float sn = r + r * r2 * sp;
        float cp = -2.7557319e-7f; cp = cp * r2 + 2.4801587e-5f; cp = cp * r2 - 1.3888889e-3f; cp = cp * r2 + 4.1666667e-2f; cp = cp * r2 - 0.5f; const float cs = 1.0f + r2 * cp;
        const int q = ((int)kq) & 3;
        const float sv = (q == 0) ? sn : (q == 1) ? cs : (q == 2) ? -sn : -cs;
        const float cv = (q == 0) ? cs : (q == 1) ? -sn : (q == 2) ? -cs : sn;
        cosT[idx] = cv; sinT[idx] = sv;
    }
}
__device__ __forceinline__ void mem_kv(const InTab& in, unsigned char* ws, LAS unsigned char* lds, int unit, int tid, int wave, int lane) {
    LAS float* memn = (LAS float*)lds;
    bf16* memK = (bf16*)(ws + WS_MEMK); bf16* memVt = (bf16*)(ws + WS_MEMK + 256 * 1024);
    const int L = unit >> 6, rb = (unit >> 3) & 7, cb = unit & 7;
    const float* gm = in.get(17) + (size_t)L * DM; const float* wkv = in.get(19) + (size_t)L * DM * 512; const float* kn = in.get(21) + (size_t)L * 64;
    __syncthreads();
    for (int i = 0; i < 4; ++i) { const int r = wave * 4 + i; const float* mrow = in.get(1) + (size_t)(rb * 32 + r) * DM;
        f32x4 v[4]; float s = 0.f;
#pragma unroll
        for (int j = 0; j < 4; ++j) { v[j] = *((const GAS f32x4*)mrow + lane + 64 * j); s += (v[j].x * v[j].x + v[j].y * v[j].y) + (v[j].z * v[j].z + v[j].w * v[j].w); }
        const float rstd = rsqrtf(wave_sum(s) * (1.0f / DM) + RMS_EPS);
#pragma unroll
        for (int j = 0; j < 4; ++j) { const f32x4 g = *((const GAS f32x4*)gm + lane + 64 * j); *(LAS f32x4*)(memn + r * 1028 + 4 * (lane + 64 * j)) = v[j] * rstd * g; } }
    __syncthreads();
    const int r = tid >> 4, c4 = (tid & 15) * 4;
    f32x4 acc = (f32x4){0.f, 0.f, 0.f, 0.f};
    const float* wp = wkv + cb * 64 + c4; const LAS float* mp = memn + r * 1028;
#pragma unroll 8
    for (int k = 0; k < DM; ++k) acc = acc + *(const GAS f32x4*)(wp + (size_t)k * 512) * mp[k];
    const int tok = rb * 32 + r;
    if (cb < 4) {
        float ss = (acc.x * acc.x + acc.y * acc.y) + (acc.z * acc.z + acc.w * acc.w);
        ss += shx<1>(ss); ss += shx<2>(ss); ss += shx<4>(ss); ss += shx<8>(ss);
        const float rs = rsqrtf(ss * (1.0f / 64.0f) + RMS_EPS);
        u32x2 w; w.x = cvtpk(acc.x * rs * kn[c4], acc.y * rs * kn[c4 + 1]); w.y = cvtpk(acc.z * rs * kn[c4 + 2], acc.w * rs * kn[c4 + 3]);
        *(GAS u32x2*)(memK + (size_t)L * 65536 + (size_t)tok * 256 + cb * 64 + c4) = w;
    } else {
        const int c = (cb - 4) * 64 + c4; bf16* vp = memVt + (size_t)L * 65536 + (size_t)c * 256 + tok;
        vp[0] = (bf16)(cvtpk(acc.x, 0.f) & 0xffffu); vp[256] = (bf16)(cvtpk(acc.y, 0.f) & 0xffffu); vp[512] = (bf16)(cvtpk(acc.z, 0.f) & 0xffffu); vp[768] = (bf16)(cvtpk(acc.w, 0.f) & 0xffffu);
    }
}

__device__ __forceinline__ void head_norm8(float (&x)[8], const float* gain, int lane) {
    float ss = 0.f;
#pragma unroll
    for (int j = 0; j < 8; ++j) ss += x[j] * x[j];
    ss += shx<1>(ss); ss += shx<2>(ss); ss += shx<4>(ss);
    const float r = rsqrtf(ss * (1.0f / 64.0f) + RMS_EPS);
    const int d0 = 8 * (lane & 7);
#pragma unroll
    for (int j = 0; j < 8; ++j) x[j] = x[j] * r * gain[d0 + j];
}
__device__ __forceinline__ void rope8(float (&x)[8], const float (&cs)[8], const float (&sn)[8], int lane) {
    const int sub = lane & 7;
#pragma unroll
    for (int j = 0; j < 8; ++j) {
        const float other = shx<1>(x[j]);
        if (sub == 0) x[j] = x[j] * cs[j] - other * sn[j];
        else if (sub == 1) x[j] = x[j] * cs[j] + other * sn[j];
    }
}
__device__ __forceinline__ float sh32_get(float v, int lane) { auto r = __builtin_amdgcn_permlane32_swap(__float_as_uint(v), __float_as_uint(v), false, false); return __uint_as_float((lane < 32) ? r[1] : r[0]); }
__device__ __forceinline__ float reduce_scatter64(float (&v)[64], int lane) {
    { const bool up = (lane & 32) != 0;
#pragma unroll
      for (int j = 0; j < 32; ++j) { const float send = up ? v[j] : v[j + 32], keep = up ? v[j + 32] : v[j]; v[j] = keep + sh32_get(send, lane); } }
    { const bool up = (lane & 16) != 0;
#pragma unroll
      for (int j = 0; j < 16; ++j) { const float send = up ? v[j] : v[j + 16], keep = up ? v[j + 16] : v[j]; v[j] = keep + shx<16>(send); } }
    { const bool up = (lane & 8) != 0;
#pragma unroll
      for (int j = 0; j < 8; ++j) { const float send = up ? v[j] : v[j + 8], keep = up ? v[j + 8] : v[j]; v[j] = keep + shx<8>(send); } }
    { const bool up = (lane & 4) != 0;
#pragma unroll
      for (int j = 0; j < 4; ++j) { const float send = up ? v[j] : v[j + 4], keep = up ? v[j + 4] : v[j]; v[j] = keep + shx<4>(send); } }
    { const bool up = (lane & 2) != 0;
#pragma unroll
      for (int j = 0; j < 2; ++j) { const float send = up ? v[j] : v[j + 2], keep = up ? v[j + 2] : v[j]; v[j] = keep + shx<2>(send); } }
    { const bool up = (lane & 1) != 0; const float send = up ? v[0] : v[1], keep = up ? v[1] : v[0]; v[0] = keep + shx<1>(send); }
    return v[0];
}
__device__ __forceinline__ void post_even(const InTab& in, unsigned char* ws, const float* H, const float* ssq, LAS unsigned char* lds, int G, int tid, int wave, int lane) {
    float* Flocal = (float*)(ws + WS_FL); float* Btot = Flocal + S * 8; float* IW = (float*)(ws + WS_IW);
    const float* bfg = in.get(7);
    LAS f32x4* Tw = (LAS f32x4*)lds;
    LAS float* lf = (LAS float*)(lds + 65536);
    { const GAS f32x4* src = (const GAS f32x4*)(ws + WS_TW);
#pragma unroll
      for (int i = 0; i < 8; ++i) Tw[tid + 512 * i] = src[tid + 512 * i]; }
    __syncthreads();
    for (int u = blockIdx.x; u < S / 64; u += G) {
        const int t0 = u * 64, tw0 = t0 + wave * 8;
#pragma unroll 1
        for (int rb = 0; rb < 2; ++rb) {
            float acc[64];
#pragma unroll
            for (int j = 0; j < 64; ++j) acc[j] = 0.f;
#pragma unroll
            for (int q = 0; q < 4; ++q) {
                f32x4 hv[4];
#pragma unroll
                for (int r = 0; r < 4; ++r) hv[r] = *((const GAS f32x4*)(H + (size_t)(tw0 + rb * 4 + r) * DM) + lane + 64 * q);
#pragma unroll
                for (int e = 0; e < 4; ++e)
#pragma unroll
                    for (int c = 0; c < 4; ++c) { const f32x4 w = Tw[((q * 4 + e) * 4 + c) * 64 + lane];
#pragma unroll
                        for (int r = 0; r < 4; ++r) { acc[r * 16 + 4 * c + 0] += hv[r][e] * w[0]; acc[r * 16 + 4 * c + 1] += hv[r][e] * w[1]; acc[r * 16 + 4 * c + 2] += hv[r][e] * w[2]; acc[r * 16 + 4 * c + 3] += hv[r][e] * w[3]; } }
            }
            const float zs = reduce_scatter64(acc, lane);
            const int rl = wave * 8 + rb * 4 + (lane >> 4), t = t0 + rl, j = lane & 15;
            const float z = zs * pg8::row_rstd(ssq, t);
            if (j < 8) { const float zz = z + bfg[j]; lf[rl * 8 + j] = (zz > 15.f) ? -expf(-zz) : -log1pf(expf(-zz)); }
            else IW[(size_t)t * 8 + (j - 8)] = z * 0.044194173824159216f;
        }
        __syncthreads();
        {
            float v = lf[lane * 8 + wave];
#pragma unroll
            for (int o = 1; o < 64; o <<= 1) { const float up = __int_as_float(__builtin_amdgcn_ds_bpermute(((lane - o) & 63) << 2, __float_as_int(v))); if (lane >= o) v += up; }
            Flocal[(size_t)(t0 + lane) * 8 + wave] = v;
            if (lane == 63) Btot[u * 8 + wave] = v;
        }
        __syncthreads();
    }
}

__device__ __forceinline__ void post_odd(unsigned char* ws, LAS unsigned char* lds, int G, int tid) {
    const bf16* Kb = (const bf16*)(ws + WS_BIG + B_PROJ) + (size_t)S * DM; float* ksum = (float*)(ws + WS_KSUM);
    LAS float* red = (LAS float*)lds;
    for (int u = blockIdx.x; u < 256; u += G) {
        const int n = u >> 2, cg = u & 3, c2 = tid & 127, rg = tid >> 7;
        const bf16* kp = Kb + (size_t)(n * 256 + rg * 64) * DM + cg * 256 + c2 * 2;
        float s0 = 0.f, s1 = 0.f;
#pragma unroll 16
        for (int r = 0; r < 64; ++r) { const unsigned w = *(const GAS unsigned*)(kp + (size_t)r * DM); s0 += bflo(w); s1 += bfhi(w); }
        __syncthreads();
        red[rg * 256 + c2 * 2] = s0; red[rg * 256 + c2 * 2 + 1] = s1;
        __syncthreads();
        if (tid < 256) ksum[(size_t)n * 1024 + cg * 256 + tid] = (red[tid] + red[256 + tid]) + (red[512 + tid] + red[768 + tid]);
    }
}

constexpr int KV_K_BYTES = 8192, KV_VT_PITCH = 136, KV_BUF_BYTES = KV_K_BYTES + 64 * KV_VT_PITCH;
struct KVRegs { v4u k, v; };
__device__ __forceinline__ void kv_load(KVRegs& r, const bf16* Kp, size_t kpitch, const bf16* Vtp, size_t vtpitch, int key0, int tid) {
    r.k = *(const GAS v4u*)(Kp + (size_t)(key0 + (tid & 63)) * kpitch + (tid >> 6) * 8);
    r.v = *(const GAS v4u*)(Vtp + (size_t)(tid >> 3) * vtpitch + key0 + (tid & 7) * 8);
}
__device__ __forceinline__ void kv_store(const KVRegs& r, LAS unsigned char* buf, int tid) {
    *(LAS v4u*)(buf + ((tid >> 6) * 64 + (tid & 63)) * 16) = r.k;
    LAS unsigned char* vp = buf + KV_K_BYTES + (tid >> 3) * KV_VT_PITCH + (tid & 7) * 16;
    *(LAS u32x2*)vp = (u32x2){r.v.x, r.v.y}; *(LAS u32x2*)(vp + 8) = (u32x2){r.v.z, r.v.w};
}
struct AttnAcc { float m, l; f32x16 o0, o1; };
__device__ __forceinline__ void attn_init(AttnAcc& a) { a.m = -INFINITY; a.l = 0.f;
#pragma unroll
    for (int r = 0; r < 16; ++r) { a.o0[r] = 0.f; a.o1[r] = 0.f; } }
template <int CHS = 1024>
__device__ __forceinline__ void attn_scores(f32x16& p0, f32x16& p1, const LAS unsigned char* buf, const bf16x8 (&qf)[4], int lane) {
    const int r32 = lane & 31, hi = lane >> 5;
#pragma unroll
    for (int r = 0; r < 16; ++r) { p0[r] = 0.f; p1[r] = 0.f; }
#pragma unroll
    for (int ks = 0; ks < 4; ++ks) {
        const bf16x8 k0 = *(const LAS bf16x8*)(buf + (2 * ks + hi) * CHS + r32 * 16);
        const bf16x8 k1 = *(const LAS bf16x8*)(buf + (2 * ks + hi) * CHS + (32 + r32) * 16);
        p0 = __builtin_amdgcn_mfma_f32_32x32x16_bf16(k0, qf[ks], p0, 0, 0, 0);
        p1 = __builtin_amdgcn_mfma_f32_32x32x16_bf16(k1, qf[ks], p1, 0, 0, 0);
    }
}
template <int VTP = KV_VT_PITCH, int VOFF = KV_K_BYTES>
__device__ __forceinline__ void attn_update(AttnAcc& a, f32x16& p0, f32x16& p1, const LAS unsigned char* buf, int lane) {
    const int r32 = lane & 31, hi = lane >> 5;
    float mx = fmaxf(p0[0], p1[0]);
#pragma unroll
    for (int r = 1; r < 16; ++r) mx = fmaxf(mx, fmaxf(p0[r], p1[r]));
    mx = sh32_max(mx);
    const float mnew = fmaxf(a.m, mx);
    const float msafe = (mnew == -INFINITY) ? 0.f : mnew;
    const float alpha = __builtin_amdgcn_exp2f(a.m - msafe);
    float sum = 0.f;
#pragma unroll
    for (int r = 0; r < 16; ++r) { p0[r] = __builtin_amdgcn_exp2f(p0[r] - msafe); p1[r] = __builtin_amdgcn_exp2f(p1[r] - msafe); sum += p0[r] + p1[r]; }
    a.l = a.l * alpha + sum; a.m = mnew;
#pragma unroll
    for (int r = 0; r < 16; ++r) { a.o0[r] *= alpha; a.o1[r] *= alpha; }
    const LAS unsigned char* vt = buf + VOFF + r32 * VTP + hi * 8;
#pragma unroll
    for (int half = 0; half < 2; ++half) {
#pragma unroll
        for (int s = 0; s < 2; ++s) {
            v4u pw;
            if (half == 0) { pw.x = cvtpk(p0[8 * s + 0], p0[8 * s + 1]); pw.y = cvtpk(p0[8 * s + 2], p0[8 * s + 3]); pw.z = cvtpk(p0[8 * s + 4], p0[8 * s + 5]); pw.w = cvtpk(p0[8 * s + 6], p0[8 * s + 7]); }
            else           { pw.x = cvtpk(p1[8 * s + 0], p1[8 * s + 1]); pw.y = cvtpk(p1[8 * s + 2], p1[8 * s + 3]); pw.z = cvtpk(p1[8 * s + 4], p1[8 * s + 5]); pw.w = cvtpk(p1[8 * s + 6], p1[8 * s + 7]); }
            const bf16x8 pb = __builtin_bit_cast(bf16x8, pw);
            const int kb = (32 * half + 16 * s) * 2;
#pragma unroll
            for (int d0 = 0; d0 < 2; ++d0) {
                const u32x2 lo = *(const LAS u32x2*)(vt + d0 * 32 * VTP + kb), hi2 = *(const LAS u32x2*)(vt + d0 * 32 * VTP + kb + 16);
                const bf16x8 va = __builtin_bit_cast(bf16x8, (v4u){lo.x, lo.y, hi2.x, hi2.y});
                if (d0 == 0) a.o0 = __builtin_amdgcn_mfma_f32_32x32x16_bf16(va, pb, a.o0, 0, 0, 0);
                else         a.o1 = __builtin_amdgcn_mfma_f32_32x32x16_bf16(va, pb, a.o1, 0, 0, 0);
            }
        }
    }
}
__device__ __forceinline__ void attn_store(const AttnAcc& a, bf16* orow, int lane) {
    const int hi = lane >> 5;
    float l = sh32_sum(a.l);
    const float inv = (l > 0.f) ? 1.0f / l : 0.f;
#pragma unroll
    for (int g = 0; g < 4; ++g) {
        u32x2 w0, w1;
        w0.x = cvtpk(a.o0[4 * g] * inv, a.o0[4 * g + 1] * inv); w0.y = cvtpk(a.o0[4 * g + 2] * inv, a.o0[4 * g + 3] * inv);
        w1.x = cvtpk(a.o1[4 * g] * inv, a.o1[4 * g + 1] * inv); w1.y = cvtpk(a.o1[4 * g + 2] * inv, a.o1[4 * g + 3] * inv);
        *(GAS u32x2*)(orow + 8 * g + 4 * hi) = w0; *(GAS u32x2*)(orow + 32 + 8 * g + 4 * hi) = w1;
    }
}
__device__ __forceinline__ void load_q(bf16x8 (&qf)[4], const bf16* qrow, int lane) {
    const int hi = lane >> 5;
#pragma unroll
    for (int ks = 0; ks < 4; ++ks) qf[ks] = *(const GAS bf16x8*)(qrow + 16 * ks + 8 * hi);
}

constexpr int CW_FOXQ = 64;
__device__ __forceinline__ void fox_phase(const InTab& in, unsigned char* ws, LAS unsigned char* lds, int G, int tid, int wave, int lane, bf16* obase, size_t opitch, int qword) {
    bf16* proj = (bf16*)(ws + WS_BIG + B_PROJ); const bf16* VtF = (const bf16*)(ws + WS_BIG + B_VTF);
    const float* Flocal = (const float*)(ws + WS_FL); const float* Btot = Flocal + S * 8;
    unsigned* qctr = (unsigned*)(ws + WS_CTL) + qword;
    LAS unsigned char* kvb = lds; LAS float* kbt = (LAS float*)(lds + 2 * KV_BUF_BYTES); LAS float* bt = (LAS float*)(lds + 2 * KV_BUF_BYTES + 65536); LAS float* Et = bt + 272;
    LAS int* misc = (LAS int*)(Et + 272);
    const int r32 = lane & 31, hi = lane >> 5;
    if (wave == 0) { const float gq = wave_max(fabsf(in.get(8)[lane])), gk = wave_max(fabsf(in.get(9)[lane])); if (lane == 0) { ((LAS float*)misc)[2] = gq; ((LAS float*)misc)[3] = gk; } }
    __syncthreads();
    const float THR = 2.0f * (0.125f * LOG2E * 64.0f * 1.02f) * ((LAS float*)misc)[2] * ((LAS float*)misc)[3] + 32.0f;
    for (;;) {
        __syncthreads();
        if (tid == 0) misc[0] = (int)atomicAdd(qctr, 1u);
        __syncthreads();
        const int u = misc[0];
        if (u >= 512) break;
        const int QB = 63 - (u >> 3), h = u & 7, q0 = QB * 256, nt = 4 * (QB + 1);
        for (int j = tid; j < nt; j += NTHREADS) bt[j] = Btot[j * 8 + h];
        if (tid == 0) misc[1] = 4 * QB;
        __syncthreads();
        for (int j = tid; j <= nt; j += NTHREADS) { float e = 0.f;
            if (j <= 4 * QB) { for (int i = 4 * QB - 1; i >= j; --i) e -= bt[i]; } else { for (int i = 4 * QB; i < j; ++i) e += bt[i]; }
            Et[j] = e; }
        __syncthreads();
        for (int j = tid; j < 4 * QB; j += NTHREADS) if (Et[j + 1] * LOG2E <= THR) atomicMin((int*)&misc[1], j);
        __syncthreads();
        const int t_start = misc[1], s0 = 64 * t_start;
        for (int s = s0 + tid; s < q0 + 256; s += NTHREADS) kbt[s - s0] = -(Et[s >> 6] + Flocal[(size_t)s * 8 + h]) * LOG2E;
        const int qrow = q0 + wave * 32 + r32;
        bf16x8 qf[4]; load_q(qf, proj + (size_t)qrow * EVEN_NP + EC_FQ + h * 64, lane);
        AttnAcc a; attn_init(a);
        const bf16* Kp = proj + EC_FK + h * 64; const bf16* Vtp = VtF + (size_t)h * 64 * S;
        KVRegs kr; kv_load(kr, Kp, EVEN_NP, Vtp, S, s0, tid); kv_store(kr, kvb, tid);
        __syncthreads();
        const float kbw = kbt[q0 + wave * 32 - s0];
        for (int t = t_start; t < nt; ++t) {
            LAS unsigned char* cur = kvb + ((t - t_start) & 1) * KV_BUF_BYTES;
            if (t + 1 < nt) kv_load(kr, Kp, EVEN_NP, Vtp, S, (t + 1) * 64, tid);
            const int key0 = t * 64;
            const bool vis = key0 <= q0 + wave * 32 + 31;
            const bool live = (key0 + 63 >= q0) || (kbw - kbt[key0 + 63 - s0] <= THR);
            if (vis && __builtin_amdgcn_readfirstlane((int)live)) {
                f32x16 p0, p1; attn_scores(p0, p1, cur, qf, lane);
#pragma unroll
                for (int g = 0; g < 4; ++g) {
                    const f32x4 b0 = *(const LAS f32x4*)(kbt + key0 - s0 + 8 * g + 4 * hi), b1 = *(const LAS f32x4*)(kbt + key0 - s0 + 32 + 8 * g + 4 * hi);
#pragma unroll
                    for (int e = 0; e < 4; ++e) { p0[4 * g + e] = p0[4 * g + e] * C2 + b0[e]; p1[4 * g + e] = p1[4 * g + e] * C2 + b1[e]; }
                }
                if (key0 + 63 > q0 + wave * 32) {
#pragma unroll
                    for (int r = 0; r < 16; ++r) { const int kv = key0 + crow(r, hi); if (kv > qrow) p0[r] = -INFINITY; if (kv + 32 > qrow) p1[r] = -INFINITY; }
                }
                attn_update(a, p0, p1, cur, lane);
            }
            if (t + 1 < nt) kv_store(kr, kvb + ((t + 1 - t_start) & 1) * KV_BUF_BYTES, tid);
            __syncthreads();
        }
        attn_store(a, obase + (size_t)qrow * opitch + h * 64, lane);
    }
}

__device__ __forceinline__ void memattn_phase(const InTab& in, unsigned char* ws, int L, LAS unsigned char* lds, int G, int tid, int wave, int lane) {
    const bf16* QM = (const bf16*)(ws + WS_BIG + B_QM); bf16* OM = (bf16*)(ws + WS_BIG + B_OM);
    const bf16* memK = (const bf16*)(ws + WS_MEMK) + (size_t)L * 256 * 256; const bf16* memVt = (const bf16*)(ws + WS_MEMK + 256 * 1024) + (size_t)L * 256 * 256;
    const float* qn = in.get(20) + (size_t)L * 64;
    LAS unsigned char* kvb = lds;
    const int r32 = lane & 31, hi = lane >> 5;
    for (int un = blockIdx.x; un < 256; un += G) {
        const int QB = un >> 2, hm = un & 3, qrow = QB * 256 + wave * 32 + r32;
        bf16x8 qf[4];
        {
            const bf16* qp = QM + (size_t)qrow * MEMW + hm * 64; float x[4][8]; float ss = 0.f;
#pragma unroll
            for (int ks = 0; ks < 4; ++ks) { const v4u w = *(const GAS v4u*)(qp + 16 * ks + 8 * hi); unpack8(w, x[ks]);
#pragma unroll
                for (int j = 0; j < 8; ++j) ss += x[ks][j] * x[ks][j]; }
            ss = sh32_sum(ss);
            const float r = rsqrtf(ss * (1.0f / 64.0f) + RMS_EPS);
#pragma unroll
            for (int ks = 0; ks < 4; ++ks) {
#pragma unroll
                for (int j = 0; j < 8; ++j) x[ks][j] = x[ks][j] * r * qn[16 * ks + 8 * hi + j];
                qf[ks] = __builtin_bit_cast(bf16x8, pack8(x[ks])); }
        }
        AttnAcc a; attn_init(a);
        const bf16* Kp = memK + hm * 64; const bf16* Vtp = memVt + (size_t)hm * 64 * 256;
        __syncthreads();
        KVRegs kr; kv_load(kr, Kp, 256, Vtp, 256, 0, tid); kv_store(kr, kvb, tid);
        __syncthreads();
        for (int t = 0; t < 4; ++t) {
            LAS unsigned char* cur = kvb + (t & 1) * KV_BUF_BYTES;
            if (t + 1 < 4) kv_load(kr, Kp, 256, Vtp, 256, (t + 1) * 64, tid);
            f32x16 p0, p1; attn_scores(p0, p1, cur, qf, lane);
#pragma unroll
            for (int r = 0; r < 16; ++r) { p0[r] *= C2; p1[r] *= C2; }
            attn_update(a, p0, p1, cur, lane);
            if (t + 1 < 4) kv_store(kr, kvb + ((t + 1) & 1) * KV_BUF_BYTES, tid);
            __syncthreads();
        }
        attn_store(a, OM + (size_t)qrow * MEMW + hm * 64, lane);
    }
}

constexpr size_t WS_MSEL = 7 * MiB;
constexpr size_t WS_MLSE = 8 * MiB;
constexpr size_t B_OP0 = 64 * MiB, B_OP1 = 128 * MiB;
__device__ __forceinline__ bool gate_better(float g1, int n1, float g2, int n2) { return g1 > g2 || (g1 == g2 && n1 < n2); }
__device__ __forceinline__ void moba_gate_phase(unsigned char* ws, int G, int wave, int lane) {
    const bf16* Q = (const bf16*)(ws + WS_BIG + B_PROJ); const float* ksum = (const float*)(ws + WS_KSUM); unsigned* selg = (unsigned*)(ws + WS_MSEL);
    const int r32 = lane & 31, hi = lane >> 5;
    const int NW = G * NWAVES;
    const int gwid = (int)blockIdx.x * NWAVES + wave;
    const int per_head = NW / 16;
    if (per_head == 0) return;
    const int h = gwid / per_head, wi = gwid % per_head;
    if (h >= 16) return;
    float af[2][32];
#pragma unroll
    for (int g = 0; g < 2; ++g)
#pragma unroll
        for (int kk = 0; kk < 32; ++kk) af[g][kk] = ksum[(size_t)(32 * g + r32) * 1024 + h * 64 + 2 * kk + hi] * (1.0f / 256.0f);
    for (int tile = wi; tile < S / 32; tile += per_head) {
        const int t = tile * 32 + r32, own = (tile * 32) >> 8;
        float bq[32];
        { const bf16* qp = Q + (size_t)t * DM + h * 64;
#pragma unroll
          for (int c = 0; c < 8; ++c) { const unsigned sh = hi ? 0u : 16u;   const v4u w = *(const GAS v4u*)(qp + 8 * c);
              bq[4 * c + 0] = __uint_as_float((w.x << sh) & 0xffff0000u); bq[4 * c + 1] = __uint_as_float((w.y << sh) & 0xffff0000u);
              bq[4 * c + 2] = __uint_as_float((w.z << sh) & 0xffff0000u); bq[4 * c + 3] = __uint_as_float((w.w << sh) & 0xffff0000u); } }
        float g0 = -INFINITY, g1 = -INFINITY, g2 = -INFINITY; int n0 = 255, n1 = 255, n2 = 255;
#pragma unroll
        for (int g = 0; g < 2; ++g) {
            if (32 * g < own) {
                f32x16 c;
#pragma unroll
                for (int r = 0; r < 16; ++r) c[r] = 0.f;
#pragma unroll
                for (int kk = 0; kk < 32; ++kk) c = __builtin_amdgcn_mfma_f32_32x32x2f32(af[g][kk], bq[kk], c, 0, 0, 0);
#pragma unroll
                for (int r = 0; r < 16; ++r) { const int n = 32 * g + crow(r, hi); const float gv = (n < own) ? c[r] : -INFINITY;
                    if (n < own) {
                        if (gate_better(gv, n, g0, n0)) { g2 = g1; n2 = n1; g1 = g0; n1 = n0; g0 = gv; n0 = n; }
                        else if (gate_better(gv, n, g1, n1)) { g2 = g1; n2 = n1; g1 = gv; n1 = n; }
                        else if (gate_better(gv, n, g2, n2)) { g2 = gv; n2 = n; } } }
            }
        }
        const float p0 = sh32_get(g0, lane), p1 = sh32_get(g1, lane), p2 = sh32_get(g2, lane);
        const int pn0 = __float_as_int(sh32_get(__int_as_float(n0), lane)), pn1 = __float_as_int(sh32_get(__int_as_float(n1), lane)), pn2 = __float_as_int(sh32_get(__int_as_float(n2), lane));
        float fg[3]; int fn[3]; int ia = 0, ib = 0;
#pragma unroll
        for (int k = 0; k < 3; ++k) {
            const float ga = (ia == 0) ? g0 : (ia == 1) ? g1 : (ia == 2) ? g2 : -INFINITY; const int na = (ia == 0) ? n0 : (ia == 1) ? n1 : (ia == 2) ? n2 : 255;
            const float gb = (ib == 0) ? p0 : (ib == 1) ? p1 : (ib == 2) ? p2 : -INFINITY; const int nb = (ib == 0) ? pn0 : (ib == 1) ? pn1 : (ib == 2) ? pn2 : 255;
            const bool ta = (na != 255) && (nb == 255 || gate_better(ga, na, gb, nb));
            if (ta) { fg[k] = ga; fn[k] = na; ++ia; } else { fg[k] = gb; fn[k] = nb; ++ib; }
        }
        (void)fg;
        if (hi == 0) selg[(size_t)h * S + t] = (unsigned)(fn[0] & 255) | ((unsigned)(fn[1] & 255) << 8) | ((unsigned)(fn[2] & 255) << 16);
    }
}
constexpr int MR_KIMG = 32768, MR_VTP = 520, MR_VIMG = 64 * MR_VTP;
constexpr int CW_MOBAQ = 192;
__device__ __forceinline__ void moba_route_phase(unsigned char* ws, LAS unsigned char* lds, int G, int tid, int wave, int lane, int qword) {
    const bf16* Q = (const bf16*)(ws + WS_BIG + B_PROJ); const bf16* Kb = Q + (size_t)S * DM; const bf16* Vt = (const bf16*)(ws + WS_BIG + B_VTM);
    const unsigned* selg = (const unsigned*)(ws + WS_MSEL); float* lse = (float*)(ws + WS_MLSE);
    unsigned* qctr = (unsigned*)(ws + WS_CTL) + qword;
    LAS unsigned char* kimg = lds; LAS unsigned char* vimg = lds + MR_KIMG;
    LAS int* list = (LAS int*)(lds + MR_KIMG + MR_VIMG);
    LAS int* wtot = list + 16384;
    LAS int* ubox = wtot + 256;
    const int r32 = lane & 31, hi = lane >> 5;
    const int NUNITS = 16 * 63;
    for (;;) {
        __syncthreads();
        if (tid == 0) ubox[0] = (int)atomicAdd(qctr, 1u);
        __syncthreads();
        const int u = ubox[0];
        if (u >= NUNITS) break;
        const int c = 0, rem = u;
        const int n = rem >> 4, h = rem & 15;
        const int tlo = 256 * (n + 1);
        v4u kst[4], vst[4];
        { const bf16* Kp = Kb + (size_t)(256 * n) * DM + h * 64; const bf16* Vp = Vt + (size_t)h * 64 * S + 256 * n;
#pragma unroll
          for (int i = 0; i < 4; ++i) { const int piece = tid + 512 * i;
              kst[i] = *(const GAS v4u*)(Kp + (size_t)(piece >> 3) * DM + (piece & 7) * 8);
              vst[i] = *(const GAS v4u*)(Vp + (size_t)(piece >> 5) * S + (piece & 31) * 8); } }
        int myent[32]; bool mysel[32];
#pragma unroll
        for (int i = 0; i < 32; ++i) { const int t = 512 * i + tid; mysel[i] = false; myent[i] = 0;
            if (t >= tlo) { const unsigned w = selg[(size_t)h * S + t];
                const int slot = ((w & 255u) == (unsigned)n) ? 0 : (((w >> 8) & 255u) == (unsigned)n) ? 1 : (((w >> 16) & 255u) == (unsigned)n) ? 2 : -1;
                if (slot >= 0) { mysel[i] = true; myent[i] = t | (slot << 16); } }
            const unsigned long long mk = __ballot(mysel[i]);
            if (lane == 0) wtot[i * 8 + wave] = __popcll(mk); }
        __syncthreads();
        int cnt = 0;
#pragma unroll
        for (int i = 0; i < 32; ++i) { int base = cnt;
#pragma unroll
            for (int w8 = 0; w8 < 8; ++w8) { const int v = wtot[i * 8 + w8]; if (w8 < wave) base += v; cnt += v; }
            const unsigned long long mk = __ballot(mysel[i]);
            if (mysel[i]) list[base + __popcll(mk & ((1ull << lane) - 1ull))] = myent[i]; }
#pragma unroll
        for (int i = 0; i < 4; ++i) { const int piece = tid + 512 * i;
            *(LAS v4u*)(kimg + ((piece & 7) * 256 + (piece >> 3)) * 16) = kst[i];
            LAS unsigned char* vp = vimg + (piece >> 5) * MR_VTP + (piece & 31) * 16;
            *(LAS u32x2*)vp = (u32x2){vst[i].x, vst[i].y}; *(LAS u32x2*)(vp + 8) = (u32x2){vst[i].z, vst[i].w}; }
        __syncthreads();
        if (cnt == 0) continue;
        const int ntile = (cnt + 31) >> 5;
        for (int ti = wave; ti < ntile; ti += NWAVES) {
            const int e = ti * 32 + r32; const bool live = e < cnt;
            const int ent = list[live ? e : 0]; const int t = ent & 0xffff, slot = ent >> 16;
            bf16x8 qf[4]; load_q(qf, Q + (size_t)t * DM + h * 64, lane);
            AttnAcc a; attn_init(a);
#pragma unroll 1
            for (int j = 0; j < 4; ++j) {
                f32x16 p0, p1; attn_scores<4096>(p0, p1, kimg + j * 64 * 16, qf, lane);
#pragma unroll
                for (int r = 0; r < 16; ++r) { p0[r] *= C2; p1[r] *= C2; }
                attn_update<MR_VTP, 0>(a, p0, p1, vimg + j * 128, lane);
            }
            const float l = sh32_sum(a.l); const float inv = 1.0f / l;
            if (live) {
                bf16* orow = (bf16*)(ws + (slot == 0 ? WS_BIG + B_OP0 : slot == 1 ? WS_BIG + B_OP1 : WS_HB)) + ((size_t)t * 16 + h) * 64;
#pragma unroll
                for (int g = 0; g < 4; ++g) { u32x2 w0, w1;
                    w0.x = cvtpk(a.o0[4 * g] * inv, a.o0[4 * g + 1] * inv); w0.y = cvtpk(a.o0[4 * g + 2] * inv, a.o0[4 * g + 3] * inv);
                    w1.x = cvtpk(a.o1[4 * g] * inv, a.o1[4 * g + 1] * inv); w1.y = cvtpk(a.o1[4 * g + 2] * inv, a.o1[4 * g + 3] * inv);
                    *(GAS u32x2*)(orow + 8 * g + 4 * hi) = w0; *(GAS u32x2*)(orow + 32 + 8 * g + 4 * hi) = w1; }
                if (hi == 0) lse[((size_t)slot * S + t) * 16 + h] = a.m + __builtin_amdgcn_logf(l);
            }
        }
    }
}
__device__ __forceinline__ void moba_own_phase(unsigned char* ws, LAS unsigned char* lds, int G, int tid, int wave, int lane, bf16* obase, size_t opitch) {
    bf16* Q = (bf16*)(ws + WS_BIG + B_PROJ); const bf16* Kb = Q + (size_t)S * DM; const bf16* Vt = (const bf16*)(ws + WS_BIG + B_VTM);
    const unsigned* selg = (const unsigned*)(ws + WS_MSEL); const float* lse = (const float*)(ws + WS_MLSE);
    LAS unsigned char* kvb = lds;
    const int r32 = lane & 31, hi = lane >> 5;
    for (int un = blockIdx.x; un < 1024; un += G) {
        const int h = un & 15, QB = un >> 4, q0 = QB * 256, qrow = q0 + wave * 32 + r32;
        bf16x8 qf[4]; load_q(qf, Q + (size_t)qrow * DM + h * 64, lane);
        AttnAcc a; attn_init(a);
        const bf16* Kp = Kb + h * 64; const bf16* Vtp = Vt + (size_t)h * 64 * S;
        __syncthreads();
        KVRegs kr; kv_load(kr, Kp, DM, Vtp, S, q0, tid); kv_store(kr, kvb, tid);
        __syncthreads();
        for (int t = 0; t < 4; ++t) {
            LAS unsigned char* cur = kvb + (t & 1) * KV_BUF_BYTES;
            const int key0 = q0 + t * 64;
            if (t + 1 < 4) kv_load(kr, Kp, DM, Vtp, S, key0 + 64, tid);
            if (key0 <= q0 + wave * 32 + 31) {
                f32x16 p0, p1; attn_scores(p0, p1, cur, qf, lane);
#pragma unroll
                for (int r = 0; r < 16; ++r) { const int kv = key0 + crow(r, hi); p0[r] = (kv > qrow) ? -INFINITY : p0[r] * C2; p1[r] = (kv + 32 > qrow) ? -INFINITY : p1[r] * C2; }
                attn_update(a, p0, p1, cur, lane);
            }
            if (t + 1 < 4) kv_store(kr, kvb + ((t + 1) & 1) * KV_BUF_BYTES, tid);
            __syncthreads();
        }
        const unsigned sw = selg[(size_t)h * S + qrow];
        float L[3];
#pragma unroll
        for (int j = 0; j < 3; ++j) L[j] = (((sw >> (8 * j)) & 255u) != 255u) ? lse[((size_t)j * S + qrow) * 16 + h] : -INFINITY;
        const float M = fmaxf(fmaxf(a.m, L[0]), fmaxf(L[1], L[2]));
        const float so = __builtin_amdgcn_exp2f(a.m - M);
        float W = sh32_sum(a.l) * so;
#pragma unroll
        for (int r = 0; r < 16; ++r) { a.o0[r] *= so; a.o1[r] *= so; }
#pragma unroll
        for (int j = 0; j < 3; ++j) {
            if (L[j] != -INFINITY) {
                const float wj = __builtin_amdgcn_exp2f(L[j] - M); W += wj;
                const bf16* orow = (const bf16*)(ws + (j == 0 ? WS_BIG + B_OP0 : j == 1 ? WS_BIG + B_OP1 : WS_HB)) + ((size_t)qrow * 16 + h) * 64;
#pragma unroll
                for (int g = 0; g < 4; ++g) { const u32x2 w0 = *(const GAS u32x2*)(orow + 8 * g + 4 * hi), w1 = *(const GAS u32x2*)(orow + 32 + 8 * g + 4 * hi);
                    a.o0[4 * g] += wj * bflo(w0.x); a.o0[4 * g + 1] += wj * bfhi(w0.x); a.o0[4 * g + 2] += wj * bflo(w0.y); a.o0[4 * g + 3] += wj * bfhi(w0.y);
                    a.o1[4 * g] += wj * bflo(w1.x); a.o1[4 * g + 1] += wj * bfhi(w1.x); a.o1[4 * g + 2] += wj * bflo(w1.y); a.o1[4 * g + 3] += wj * bfhi(w1.y); }
            }
        }
        const float inv = 1.0f / W;
        bf16* orow = obase + (size_t)qrow * opitch + h * 64;
#pragma unroll
        for (int g = 0; g < 4; ++g) { u32x2 w0, w1;
            w0.x = cvtpk(a.o0[4 * g] * inv, a.o0[4 * g + 1] * inv); w0.y = cvtpk(a.o0[4 * g + 2] * inv, a.o0[4 * g + 3] * inv);
            w1.x = cvtpk(a.o1[4 * g] * inv, a.o1[4 * g + 1] * inv); w1.y = cvtpk(a.o1[4 * g + 2] * inv, a.o1[4 * g + 3] * inv);
            *(GAS u32x2*)(orow + 8 * g + 4 * hi) = w0; *(GAS u32x2*)(orow + 32 + 8 * g + 4 * hi) = w1; }
    }
}

typedef float f32x4v __attribute__((ext_vector_type(4)));
__device__ __forceinline__ unsigned mono_key(float s) { if (s == 0.f) s = 0.f; const unsigned u = __float_as_uint(s); return (u & 0x80000000u) ? ~u : (u | 0x80000000u); }
constexpr int DS_CAP = 512;
__device__ __forceinline__ unsigned wave_or(unsigned v) { v |= (unsigned)shx_i<1>((int)v); v |= (unsigned)shx_i<2>((int)v); v |= (unsigned)shx_i<4>((int)v); v |= (unsigned)shx_i<8>((int)v); v |= (unsigned)shx_i<16>((int)v);
    auto r = __builtin_amdgcn_permlane32_swap(v, v, false, false); return r[0] | r[1]; }
template <bool EXACT>
__device__ __forceinline__ unsigned dsa_compact(LAS u32x2* ent, int n, int& nkeep, int lane) {
    unsigned k[8]; unsigned ix[8]; unsigned orv = 0u, nandv = 0u;
#pragma unroll
    for (int j = 0; j < 8; ++j) { const int e = lane + 64 * j; const bool in = e < n; const u32x2 v = ent[in ? e : 0]; k[j] = in ? v.x : 0u; ix[j] = v.y; orv |= k[j]; nandv |= in ? ~v.x : 0u; }
    unsigned T = 0u; int cntT = n; int bit0 = 31;
    if (!EXACT) {
        const unsigned diff = (unsigned)__builtin_amdgcn_readfirstlane((int)(wave_or(orv) & wave_or(nandv)));
        if (diff != 0u) { bit0 = 31 - __builtin_clz(diff); const unsigned anyk = (unsigned)__builtin_amdgcn_readfirstlane((int)k[0]);
            T = (bit0 == 31) ? 0u : (anyk & ~((2u << bit0) - 1u)); }
    }
    for (int bit = bit0; bit >= 0; --bit) {
        const unsigned cand = T | (1u << bit); int c = 0;
#pragma unroll
        for (int j = 0; j < 8; ++j) c += __popcll(__ballot(k[j] >= cand));
        if (c >= 256) { T = cand; cntT = c; if (!EXACT && c <= 320) break; }
    }
    int Jstar = 0x10000;
    if (cntT > (EXACT ? 256 : 320)) {
        int gt = 0;
#pragma unroll
        for (int j = 0; j < 8; ++j) gt += __popcll(__ballot(k[j] > T));
        const int need = 256 - gt; int Jm = 0;
        for (int bit = 14; bit >= 0; --bit) { const int cand = Jm | (1 << bit); int c = 0;
#pragma unroll
            for (int j = 0; j < 8; ++j) c += __popcll(__ballot(k[j] == T && (int)ix[j] < cand));
            if (c < need) Jm = cand; }
        Jstar = Jm + 1;
    }
    int base = 0;
    const unsigned long long lt = (1ull << lane) - 1ull;
#pragma unroll
    for (int j = 0; j < 8; ++j) { const bool pred = (k[j] > T) || (k[j] == T && T != 0u && (int)ix[j] < Jstar);
        const unsigned long long mask = __ballot(pred); const int pos = base + __popcll(mask & lt);
        if (pred) ent[pos] = (u32x2){k[j], ix[j]};
        base += __popcll(mask); }
    nkeep = base;
    return T;
}
#define DSA_HEADSUM(s, P, B, W) asm("v_max_f32_e32 %1, 0, %2\n\tv_mul_f32_e32 %0, %10, %1\n\tv_max_f32_e32 %1, 0, %3\n\tv_fmac_f32_e32 %0, %11, %1\n\tv_max_f32_e32 %1, 0, %4\n\tv_fmac_f32_e32 %0, %12, %1\n\t" \
        "v_max_f32_e32 %1, 0, %5\n\tv_fmac_f32_e32 %0, %13, %1\n\tv_max_f32_e32 %1, 0, %6\n\tv_fmac_f32_e32 %0, %14, %1\n\tv_max_f32_e32 %1, 0, %7\n\tv_fmac_f32_e32 %0, %15, %1\n\t" \
        "v_max_f32_e32 %1, 0, %8\n\tv_fmac_f32_e32 %0, %16, %1\n\tv_max_f32_e32 %1, 0, %9\n\tv_fmac_f32_e32 %0, %17, %1" \
        : "=&v"(s), "=&v"(tmp_) : "v"(P[B + 0]), "v"(P[B + 1]), "v"(P[B + 2]), "v"(P[B + 3]), "v"(P[B + 4]), "v"(P[B + 5]), "v"(P[B + 6]), "v"(P[B + 7]), \
          "v"(W[0]), "v"(W[1]), "v"(W[2]), "v"(W[3]), "v"(W[4]), "v"(W[5]), "v"(W[6]), "v"(W[7]))
__device__ __forceinline__ float unmono_f(unsigned u) { return __uint_as_float((u & 0x80000000u) ? (u ^ 0x80000000u) : ~u); }
struct DsaState { float tf0, tf1; int cnt0, cnt1; };
template <bool NOCOMPACT = false>
__device__ __forceinline__ void dsa_tile(const bf16x8 (&af)[4], const bf16x8 (&bc)[4], const float (&w0)[8], const float (&w1)[8], int key0, int q0t, int q1t, DsaState& st,
                                         LAS u32x2* ents, int lane) {
    const int r32 = lane & 31, hi = lane >> 5;
    f32x16 p;
#pragma unroll
    for (int r = 0; r < 16; ++r) p[r] = 0.f;
#pragma unroll
    for (int ks = 0; ks < 4; ++ks) p = __builtin_amdgcn_mfma_f32_32x32x16_bf16(af[ks], bc[ks], p, 0, 0, 0);
    asm volatile("s_nop 15\n\ts_nop 7" : "+v"(p));
    float s0, s1, tmp_;
    DSA_HEADSUM(s0, p, 0, w0); DSA_HEADSUM(s1, p, 8, w1);
    const int key = key0 + r32;
    const bool pr0 = (key <= q0t) && (s0 >= st.tf0), pr1 = (key <= q1t) && (s1 >= st.tf1);
    const unsigned long long m0 = __ballot(pr0), m1 = __ballot(pr1);
    if (m0 | m1) {
        const unsigned h0 = hi ? (unsigned)(m0 >> 32) : (unsigned)m0, h1 = hi ? (unsigned)(m1 >> 32) : (unsigned)m1;
        const unsigned lowmask = (1u << r32) - 1u;
        if (pr0) ents[hi * DS_CAP + st.cnt0 + __popc(h0 & lowmask)] = (u32x2){mono_key(s0), (unsigned)key};
        if (pr1) ents[(2 + hi) * DS_CAP + st.cnt1 + __popc(h1 & lowmask)] = (u32x2){mono_key(s1), (unsigned)key};
        st.cnt0 += __popc(h0); st.cnt1 += __popc(h1);
        const unsigned long long need = __ballot(max(st.cnt0, st.cnt1) > DS_CAP - 32);
        if (need) {
#pragma unroll 1
            for (int hh = 0; hh < 2; ++hh) {
                const int c0 = __builtin_amdgcn_readlane(st.cnt0, 0), c0b = __builtin_amdgcn_readlane(st.cnt0, 32);
                const int c1 = __builtin_amdgcn_readlane(st.cnt1, 0), c1b = __builtin_amdgcn_readlane(st.cnt1, 32);
                const int n0 = hh ? c0b : c0, n1 = hh ? c1b : c1;
                if (NOCOMPACT) { if (n0 > DS_CAP - 32 && hi == hh) st.cnt0 = 256; if (n1 > DS_CAP - 32 && hi == hh) st.cnt1 = 256; continue; }
                if (n0 > DS_CAP - 32) { int nk; const unsigned T = dsa_compact<false>(ents + hh * DS_CAP, n0, nk, lane); if (hi == hh) { st.tf0 = unmono_f(T + 1u); st.cnt0 = nk; } }
                if (n1 > DS_CAP - 32) { int nk; const unsigned T = dsa_compact<false>(ents + (2 + hh) * DS_CAP, n1, nk, lane); if (hi == hh) { st.tf1 = unmono_f(T + 1u); st.cnt1 = nk; } }
            }
        }
    }
}
template <bool NOCOMPACT = false>
__device__ __forceinline__ void dsa_select_phase(unsigned char* ws, LAS unsigned char* lds, int G, int tid, int wave, int lane) {
    const bf16* proj = (const bf16*)(ws + WS_BIG + B_PROJ); const bf16* IKc = (const bf16*)(ws + WS_BIG + B_IKC); const float* IW = (const float*)(ws + WS_IW);
    unsigned short* selg = (unsigned short*)(ws + WS_BIG + B_SEL);
    LAS u32x2* ents = (LAS u32x2*)lds + wave * 4 * DS_CAP;
    const int r32 = lane & 31, hi = lane >> 5;
    const int NWG = G * NWAVES, gw = (int)blockIdx.x * NWAVES + wave;
    for (int pu = gw; pu < 2048; pu += NWG) {
        for (int uu = 0; uu < 2; ++uu) {
            const int unit = uu ? 4095 - pu : pu, tw = unit * 4;
            bf16x8 af[4];
            { const int i = r32, qi = 2 * (i >> 4) + ((i >> 2) & 1), hd = 4 * ((i >> 3) & 1) + (i & 3);
              const bf16* ap = proj + (size_t)(tw + qi) * EVEN_NP + EC_IQ + hd * 64 + 8 * hi;
#pragma unroll
              for (int ks = 0; ks < 4; ++ks) af[ks] = *(const GAS bf16x8*)(ap + 16 * ks); }
            float w0[8], w1[8];
            { const f32x4 a = *(const GAS f32x4*)(IW + (size_t)(tw + hi) * 8), b = *(const GAS f32x4*)(IW + (size_t)(tw + hi) * 8 + 4);
              const f32x4 c = *(const GAS f32x4*)(IW + (size_t)(tw + 2 + hi) * 8), d = *(const GAS f32x4*)(IW + (size_t)(tw + 2 + hi) * 8 + 4);
#pragma unroll
              for (int j = 0; j < 4; ++j) { w0[j] = a[j]; w0[4 + j] = b[j]; w1[j] = c[j]; w1[4 + j] = d[j]; } }
            const int q0t = tw + hi, q1t = tw + 2 + hi;
            DsaState st; st.tf0 = -INFINITY; st.tf1 = -INFINITY; st.cnt0 = 0; st.cnt1 = 0;
            const int ntile = ((tw + 3) >> 5) + 1;
            const bf16* kp = IKc + (size_t)lane * 8; asm volatile("" : "+v"(kp));
            bf16x8 bA[4], bB[4], bC[4];
#define DSA_LOADB(dst, jj) do { const bf16* p_ = kp + (size_t)(jj) * 2048; \
                asm volatile("global_load_dwordx4 %0, %4, off\n\tglobal_load_dwordx4 %1, %4, off offset:1024\n\tglobal_load_dwordx4 %2, %4, off offset:2048\n\tglobal_load_dwordx4 %3, %4, off offset:3072" \
                             : "=&v"(dst[0]), "=&v"(dst[1]), "=&v"(dst[2]), "=&v"(dst[3]) : "v"(p_) : "memory"); } while (0)
#define DSA_WAITB(dst, n) asm volatile("s_waitcnt vmcnt(" #n ")" : "+v"(dst[0]), "+v"(dst[1]), "+v"(dst[2]), "+v"(dst[3]) :: "memory")
            asm volatile("" : "+v"(af[0]), "+v"(af[1]), "+v"(af[2]), "+v"(af[3]));
#pragma unroll
            for (int r = 0; r < 8; ++r) asm volatile("" : "+v"(w0[r]), "+v"(w1[r]));
            DSA_LOADB(bA, 0); DSA_LOADB(bB, min(1, ntile - 1));
#pragma unroll 1
            for (int j = 0; j < ntile; j += 3) {
                DSA_LOADB(bC, min(j + 2, ntile - 1));
                DSA_WAITB(bA, 8);
                dsa_tile<NOCOMPACT>(af, bA, w0, w1, 32 * j, q0t, q1t, st, ents, lane);
                DSA_LOADB(bA, min(j + 3, ntile - 1));
                DSA_WAITB(bB, 8);
                if (j + 1 < ntile) dsa_tile<NOCOMPACT>(af, bB, w0, w1, 32 * (j + 1), q0t, q1t, st, ents, lane);
                DSA_LOADB(bB, min(j + 4, ntile - 1));
                DSA_WAITB(bC, 8);
                if (j + 2 < ntile) dsa_tile<NOCOMPACT>(af, bC, w0, w1, 32 * (j + 2), q0t, q1t, st, ents, lane);
            }
            DSA_WAITB(bA, 0);
#undef DSA_LOADB
#undef DSA_WAITB
            const int cnt0 = st.cnt0, cnt1 = st.cnt1;
#pragma unroll 1
            for (int qq = 0; qq < 4; ++qq) {
                const int hh = qq & 1, sl = qq >> 1;
                int n = sl ? __builtin_amdgcn_readlane(cnt1, 32 * hh) : __builtin_amdgcn_readlane(cnt0, 32 * hh);
                LAS u32x2* ee = ents + qq * DS_CAP;
                if (n > 256) { int nk = 256; if (!NOCOMPACT) (void)dsa_compact<true>(ee, n, nk, lane); n = 256; }
                unsigned short* row = selg + (size_t)(tw + qq) * 256;
#pragma unroll
                for (int e4 = 0; e4 < 4; ++e4) { const int e = lane + 64 * e4; row[e] = (e < n) ? (unsigned short)ee[e].y : (unsigned short)0xFFFFu; }
            }
        }
    }
}

typedef __bf16 bf16x2v __attribute__((ext_vector_type(2)));
__device__ __forceinline__ float dot2bf(unsigned a, unsigned b, float acc) { return __builtin_amdgcn_fdot2_f32_bf16(__builtin_bit_cast(bf16x2v, a), __builtin_bit_cast(bf16x2v, b), acc, false); }
#define SP_IDX(i) (((i) & 1) ? (iw[(i) >> 3][((i) >> 1) & 3] >> 16) : (iw[(i) >> 3][((i) >> 1) & 3] & 0xffffu))
__device__ __forceinline__ void dsa_sparse_phase(unsigned char* ws, int G, int wave, int lane, bf16* obase, size_t opitch) {
    const bf16* proj = (const bf16*)(ws + WS_BIG + B_PROJ); const unsigned short* selg = (const unsigned short*)(ws + WS_BIG + B_SEL);
    const int h = (int)blockIdx.x & 7, wg = (int)blockIdx.x >> 3, nwg = G >> 3;
    const int kg = lane >> 3, ds8 = (lane & 7) * 8;
    const bf16* kbase = proj + EC_DK + h * 64 + ds8; const bf16* vbase = proj + EC_DV + h * 64 + ds8;
    const int tstep = nwg * NWAVES;
    v4u iwn[4], qwn, kan[8], kbn[8];
    { const int t0_ = wg * NWAVES + wave;
#pragma unroll
      for (int c = 0; c < 4; ++c) iwn[c] = *(const GAS v4u*)(selg + (size_t)t0_ * 256 + 32 * kg + 8 * c);
      qwn = *(const GAS v4u*)(proj + (size_t)t0_ * EVEN_NP + EC_DQ + h * 64 + ds8);
#define SP_IDXN(i) (((i) & 1) ? (iwn[(i) >> 3][((i) >> 1) & 3] >> 16) : (iwn[(i) >> 3][((i) >> 1) & 3] & 0xffffu))
#define SP_LOADN(dst, i0) _Pragma("unroll") for (int j = 0; j < 8; ++j) { const unsigned wd = SP_IDXN((i0) + j); const unsigned idx = (wd == 0xffffu) ? 0u : wd; dst[j] = *(const GAS v4u*)(kbase + (size_t)idx * EVEN_NP); }
      SP_LOADN(kan, 0); SP_LOADN(kbn, 8); }
    for (int t = wg * NWAVES + wave; t < S; t += tstep) {
        v4u iw[4];
#pragma unroll
        for (int c = 0; c < 4; ++c) iw[c] = iwn[c];
        const v4u qw = qwn;
        const int tn = (t + tstep < S) ? t + tstep : t;
#pragma unroll
        for (int c = 0; c < 4; ++c) iwn[c] = *(const GAS v4u*)(selg + (size_t)tn * 256 + 32 * kg + 8 * c);
        qwn = *(const GAS v4u*)(proj + (size_t)tn * EVEN_NP + EC_DQ + h * 64 + ds8);
        float sc[32];
        v4u ka[8], kb[8];
#define SP_LOAD(dst, base, i0) _Pragma("unroll") for (int j = 0; j < 8; ++j) { const unsigned wd = SP_IDX((i0) + j); const unsigned idx = (wd == 0xffffu) ? 0u : wd; dst[j] = *(const GAS v4u*)(base + (size_t)idx * EVEN_NP); }
#define SP_QK(src, i0) _Pragma("unroll") for (int j = 0; j < 8; ++j) { const unsigned wd = SP_IDX((i0) + j); \
            float d = dot2bf(qw.x, src[j].x, 0.f); d = dot2bf(qw.y, src[j].y, d); d = dot2bf(qw.z, src[j].z, d); d = dot2bf(qw.w, src[j].w, d); \
            d += shx<1>(d); d += shx<2>(d); d += shx<4>(d); sc[(i0) + j] = (wd == 0xffffu) ? -INFINITY : d * C2; }
#pragma unroll
        for (int j = 0; j < 8; ++j) { ka[j] = kan[j]; kb[j] = kbn[j]; }
        SP_QK(ka, 0);  SP_LOAD(ka, kbase, 16);
        SP_QK(kb, 8);  SP_LOAD(kb, kbase, 24);
        SP_QK(ka, 16); SP_LOAD(ka, vbase, 0);
        SP_QK(kb, 24); SP_LOAD(kb, vbase, 8);
        float mx = sc[0];
#pragma unroll
        for (int i = 1; i < 32; ++i) mx = fmaxf(mx, sc[i]);
        mx = fmaxf(mx, shx<8>(mx)); mx = fmaxf(mx, shx<16>(mx)); mx = sh32_max(mx);
        float l = 0.f;
#pragma unroll
        for (int i = 0; i < 32; ++i) { sc[i] = __builtin_amdgcn_exp2f(sc[i] - mx); l += sc[i]; }
        l += shx<8>(l); l += shx<16>(l); l = sh32_sum(l);
        float acc[8];
#pragma unroll
        for (int e = 0; e < 8; ++e) acc[e] = 0.f;
#define SP_PV(src, i0) _Pragma("unroll") for (int j = 0; j < 8; j += 2) { const unsigned pp = cvtpk(sc[(i0) + j], sc[(i0) + j + 1]); const v4u a = src[j], b = src[j + 1]; \
            acc[0] = dot2bf(pp, __builtin_amdgcn_perm(b.x, a.x, 0x05040100u), acc[0]); acc[1] = dot2bf(pp, __builtin_amdgcn_perm(b.x, a.x, 0x07060302u), acc[1]); \
            acc[2] = dot2bf(pp, __builtin_amdgcn_perm(b.y, a.y, 0x05040100u), acc[2]); acc[3] = dot2bf(pp, __builtin_amdgcn_perm(b.y, a.y, 0x07060302u), acc[3]); \
            acc[4] = dot2bf(pp, __builtin_amdgcn_perm(b.z, a.z, 0x05040100u), acc[4]); acc[5] = dot2bf(pp, __builtin_amdgcn_perm(b.z, a.z, 0x07060302u), acc[5]); \
            acc[6] = dot2bf(pp, __builtin_amdgcn_perm(b.w, a.w, 0x05040100u), acc[6]); acc[7] = dot2bf(pp, __builtin_amdgcn_perm(b.w, a.w, 0x07060302u), acc[7]); }
        SP_PV(ka, 0);  SP_LOAD(ka, vbase, 16);
        SP_PV(kb, 8);  SP_LOAD(kb, vbase, 24);
        SP_LOADN(kan, 0);
        SP_PV(ka, 16);
        SP_LOADN(kbn, 8);
        SP_PV(kb, 24);
#undef SP_LOAD
#undef SP_QK
#undef SP_PV
        const float inv = 1.0f / l;
#pragma unroll
        for (int e = 0; e < 8; ++e) { float a = acc[e]; a += shx<8>(a); a += shx<16>(a); a = sh32_sum(a); acc[e] = a * inv; }
        if (kg == 0) *(GAS v4u*)(obase + (size_t)t * opitch + h * 64 + ds8) = pack8(acc);
    }
}
#undef SP_IDX
#undef SP_IDXN
#undef SP_LOADN

struct Args { InPtrs in; float* out; unsigned char* ws; int ph_lo, ph_hi, li, pad; };
constexpr int PH_PER_LAYER = 13, N_PHASES = 1 + 2 * PH_PER_LAYER;

__global__ void __launch_bounds__(NTHREADS, 2) hyb_fwd(Args args) {
    extern __shared__ __attribute__((aligned(16))) unsigned char lds_raw[];
    LAS unsigned char* lds = (LAS unsigned char*)lds_raw;
    volatile LAS unsigned* MISC = (volatile LAS unsigned*)(lds + MISC_OFF);
    const int tid = threadIdx.x, lane = tid & 63, wave = __builtin_amdgcn_readfirstlane(tid >> 6);
    const int G = gridDim.x;
    const int vcu = (G % 8 == 0) ? ((int)blockIdx.x % 8) * (G / 8) + (int)blockIdx.x / 8 : (int)blockIdx.x;
    unsigned char* ws = args.ws;
    gu32* ctl = (gu32*)(ws + WS_CTL);
    for (int u = tid; u < (LDS_BYTES - LDSCTL_OFF) / 4; u += NTHREADS) ((LAS unsigned*)(lds + LDSCTL_OFF))[u] = 0u;
    __syncthreads();
    if (tid == 0) {
#pragma unroll
        for (int i = 0; i < 26; ++i) *(LAS unsigned long long*)(lds + INTAB_OFF + 8 * i) = (unsigned long long)args.in.p[i]; }
    __syncthreads();
    XcdBarrier bar = xcd_barrier_post((unsigned*)(ctl + CW_BAR) + args.li * XCD_BAR_WORDS, MISC + 8);
    const int tid0 = tid; unsigned char* const ws0 = ws;
    for (int ph = args.ph_lo; ph < args.ph_hi; ++ph) {
        int tid = tid0; asm volatile("" : "+v"(tid));
        unsigned char* ws = ws0; asm volatile("" : "+s"(ws));
        const int lane = tid & 63, wave = __builtin_amdgcn_readfirstlane(tid >> 6);
        LAS unsigned char* lds = (LAS unsigned char*)lds_raw; { unsigned lo_ = (unsigned)(uintptr_t)lds; asm volatile("" : "+s"(lo_)); lds = (LAS unsigned char*)(uintptr_t)lo_; }
        InTab inl; inl.ldsbase = lds;
        float* ssqA = (float*)(ws + WS_SSQ);
        bf16* HB = (bf16*)(ws + WS_HB);
        unsigned char* Wr = ws + WS_W;
        unsigned char* BIG = ws + WS_BIG;
        const int gw = vcu * NWAVES + wave, NGW = G * NWAVES;
        if (ph == 0) {
#ifdef PROBE_P02
            conv_weights(inl, ws, 0, 1 | 2 | 4, lds, gw, NGW, wave, lane);
            copy_x(inl.get(0), args.out, HB, ssqA, gw, NGW, lane);
            rope_tables((float*)(ws + WS_ROPE), (float*)(ws + WS_ROPE) + S * 8, (int)blockIdx.x * NTHREADS + tid, G * NTHREADS);
            __syncthreads();
            for (int un = blockIdx.x; un < 128; un += G) mem_kv(inl, ws, lds, un, tid, wave, lane);
            for (int idx = (int)blockIdx.x * NTHREADS + tid; idx < 1024 * 16; idx += G * NTHREADS) {
                const int k = idx >> 4, col = idx & 15;
                const float v = inl.get(5)[k] * inl.get(6)[(size_t)k * EVEN_SRC + (col < 8 ? ES_FL + col : ES_IW + col - 8)];
                const int ln = (k & 255) >> 2, e = k & 3, q = k >> 8, c = col >> 2;
                ((float*)(ws + WS_TW))[((((q * 4 + e) * 4 + c) * 64 + ln) << 2) + (col & 3)] = v; }
            __syncthreads();
#endif
#ifndef NO_P0
            conv_weights(inl, ws, 0, 1 | 2 | 4, lds, gw, NGW, wave, lane);
            copy_x(inl.get(0), args.out, HB, ssqA, gw, NGW, lane);
            if (blockIdx.x == 0 && tid < 384) { const int gi = tid >> 6, d = tid & 63;
                float v;
                if (gi == 0) v = inl.get(8)[d]; else if (gi == 1) v = inl.get(10)[d]; else if (gi == 2) v = inl.get(9)[d]; else if (gi == 3) v = inl.get(11)[d]; else if (gi == 4) v = inl.get(13)[d]; else v = inl.get(14)[d];
                ((float*)(ws + WS_GT))[tid] = v; }
            rope_tables((float*)(ws + WS_ROPE), (float*)(ws + WS_ROPE) + S * 8, (int)blockIdx.x * NTHREADS + tid, G * NTHREADS);
            __syncthreads();
            for (int un = blockIdx.x; un < 128; un += G) mem_kv(inl, ws, lds, un, tid, wave, lane);
            for (int idx = (int)blockIdx.x * NTHREADS + tid; idx < 1024 * 16; idx += G * NTHREADS) {
                const int k = idx >> 4, col = idx & 15;
                const float v = inl.get(5)[k] * inl.get(6)[(size_t)k * EVEN_SRC + (col < 8 ? ES_FL + col : ES_IW + col - 8)];
                const int ln = (k & 255) >> 2, e = k & 3, q = k >> 8, c = col >> 2;
                ((float*)(ws + WS_TW))[((((q * 4 + e) * 4 + c) * 64 + ln) << 2) + (col & 3)] = v; }
#endif
        } else {
            const int L = (ph - 1) / PH_PER_LAYER, sub = (ph - 1) % PH_PER_LAYER;
            const bool even = (L & 1) == 0;
            if (even && sub == 6) continue;
            float* ssq_in = ssqA;
            if (sub == 0 || sub == 11) {
                pg8::Gemm g{(const pg8::bf16_t*)HB, (const pg8::bf16_t*)(Wr + (sub == 0 ? W_FFN1_IN : W_FFN2_IN)), S, FF2, DM, DM};
                pg8::StaticOrder So; So.init(S, FF2, G, (int)blockIdx.x);
                pg8::EpiSwiGLU E{(pg8::bf16_t*)(BIG + B_U), ssq_in, FF};
#ifdef PROBE_GEMM2
                pg8::gemm_phase<pg8::EpiSwiGLU, pg8::StaticOrder, true, true>(lds, g, So, E, tid); __syncthreads();
#endif
                pg8::gemm_phase<pg8::EpiSwiGLU, pg8::StaticOrder, true, true>(lds, g, So, E, tid);
            } else if (sub == 1 || sub == 7 || sub == 10 || sub == 12) {
                pg8::Gemm g; float scale; int so;
                if (sub == 1)       { g = pg8::Gemm{(const pg8::bf16_t*)(BIG + B_U), (const pg8::bf16_t*)(Wr + W_FFN1_OUT), S, DM, FF, FF}; scale = 0.5f; so = 1; }
                else if (sub == 7)  { g = pg8::Gemm{(const pg8::bf16_t*)(BIG + B_PROJ), (const pg8::bf16_t*)(Wr + W_MIX_OUT), S, DM, DM, even ? EVEN_NP : DM}; scale = 1.0f; so = 2; }
                else if (sub == 10)  { g = pg8::Gemm{(const pg8::bf16_t*)(BIG + B_OM), (const pg8::bf16_t*)(Wr + (L ? W_MEMO2 : W_MEMO)), S, DM, MEMW, MEMW}; scale = 1.0f; so = 3; }
                else                { g = pg8::Gemm{(const pg8::bf16_t*)(BIG + B_U), (const pg8::bf16_t*)(Wr + W_FFN2_OUT), S, DM, FF, FF}; scale = 0.5f; so = 4; }
                const bool last = (sub == 12 && L == NLAYER - 1);
                pg8::StaticOrder So; So.init(S, DM, G, (int)blockIdx.x);
                pg8::EpiResid E{(L == 0 && sub == 1) ? inl.get(0) : (const float*)args.out, args.out, last ? nullptr : (pg8::bf16_t*)HB, last ? nullptr : ssqA, scale};
                pg8::gemm_phase<pg8::EpiResid, pg8::StaticOrder, true, true>(lds, g, So, E, tid);
#ifdef PROBE_GEMM2
                { __syncthreads(); pg8::EpiResid E0 = E; E0.scale = 0.f; E0.Hin = args.out; pg8::gemm_phase<pg8::EpiResid, pg8::StaticOrder, true, true>(lds, g, So, E0, tid); }
#endif
            } else if (sub == 2) {
                const int N = even ? EVEN_NP : ODD_N;
                pg8::Gemm g{(const pg8::bf16_t*)HB, (const pg8::bf16_t*)(Wr + W_MIX_IN), S, N, DM, DM};
                pg8::EpiProj E;
                E.O = (pg8::bf16_t*)(BIG + B_PROJ); E.ldc = even ? EVEN_NP : DM; E.ssq = ssq_in; E.split_cols = even ? 0 : DM; E.split_stride = (size_t)S * DM; E.even = even ? 1 : 0;
                E.gtab = (const float*)(ws + WS_GT);
                E.cosT = (const float*)(ws + WS_ROPE); E.sinT = E.cosT + S * 8;
                E.Vt = (pg8::bf16_t*)(BIG + (even ? B_VTF : B_VTM)); E.IKf = (pg8::bf16_t*)(BIG + B_IKC);
                E.xch = (LAS float*)(lds + 131072);
                pg8::StaticOrder So; So.init(S, N, G, (int)blockIdx.x);
#ifdef PROBE_MIXIN2
                pg8::gemm_phase<pg8::EpiProj, pg8::StaticOrder, true, true>(lds, g, So, E, tid); __syncthreads();
#endif
                pg8::gemm_phase<pg8::EpiProj, pg8::StaticOrder, true, true>(lds, g, So, E, tid);
            } else if (sub == 8) {
                if ((int)blockIdx.x >= 64 && G > 64) {
                    const int cw = ((int)blockIdx.x - 64) * NWAVES + wave, ncw = (G - 64) * NWAVES;
                    if (L == 0) conv_weights(inl, ws, 1, 1 | 2 | 4 | 8 | 16 | 32, lds, cw, ncw, wave, lane);
                    else        conv_weights(inl, ws, 1, 64 | 128, lds, cw, ncw, wave, lane);
                }
                pg8::Gemm g{(const pg8::bf16_t*)HB, (const pg8::bf16_t*)(Wr + (L ? W_MEMQ2 : W_MEMQ)), S, MEMW, DM, DM};
                pg8::EpiScale E{(pg8::bf16_t*)(BIG + B_QM), MEMW, ssq_in, 0, 0};
                pg8::StaticOrder So; So.init(S, g.N, G, (int)blockIdx.x);
                pg8::gemm_phase<pg8::EpiScale, pg8::StaticOrder, true, true>(lds, g, So, E, tid);
            } else if (sub == 3) {
                if (even) post_even(inl, ws, args.out, ssq_in, lds, G, tid, wave, lane);
                else post_odd(ws, lds, G, tid);
                if (L == 0) { __syncthreads(); conv_weights(inl, ws, 0, 8 | 16 | 32 | 64 | 128, lds, gw, NGW, wave, lane); }
            } else if (sub == 4) {
                if (even) {
                    int nrep = 1;
#ifdef PROBE_DSA2
                    nrep = 2;
#endif
                    asm volatile("" : "+s"(nrep));
#ifdef PROBE_SELNC
                    dsa_select_phase<true>(ws, lds, G, tid, wave, lane); __syncthreads();
#endif
                    for (int rep = 0; rep < nrep; ++rep) { dsa_select_phase<false>(ws, lds, G, tid, wave, lane); __syncthreads(); }
                } else {
                    moba_gate_phase(ws, G, wave, lane);
                }
            } else if (sub == 5) {
                if (even) {
                    bf16* projb = (bf16*)(BIG + B_PROJ);
#ifdef PROBE_FOX2
                    fox_phase(inl, ws, lds, G, tid, wave, lane, HB + (size_t)S * 512, 512, CW_FOXQ + 64); __syncthreads();
#endif
#ifdef PROBE_SPARSE2
                    dsa_sparse_phase(ws, G, wave, lane, HB + (size_t)S * 512, 512);
#endif
                    fox_phase(inl, ws, lds, G, tid, wave, lane, projb + EC_FQ, EVEN_NP, CW_FOXQ);
                    dsa_sparse_phase(ws, G, wave, lane, projb + EC_DQ, EVEN_NP);
                } else {
#ifdef PROBE_MOBA2
                    moba_route_phase(ws, lds, G, tid, wave, lane, CW_MOBAQ + 64); __syncthreads();
#endif
                    moba_route_phase(ws, lds, G, tid, wave, lane, CW_MOBAQ);
                }
            } else if (sub == 6) {
#ifdef PROBE_OWN2
                if (!even) { moba_own_phase(ws, lds, G, tid, wave, lane, (bf16*)(BIG + 160 * MiB), 0); __syncthreads(); }
#endif
                if (!even) moba_own_phase(ws, lds, G, tid, wave, lane, (bf16*)(BIG + B_PROJ), DM);
            } else if (sub == 9) {
#ifdef PROBE_MEM2
                memattn_phase(inl, ws, L, lds, G, tid, wave, lane); __syncthreads();
#endif
                memattn_phase(inl, ws, L, lds, G, tid, wave, lane);
            }
        }
        if (ph + 1 < args.ph_hi) xcd_barrier(bar);
#ifdef PROBE_BAR2
        if (ph + 1 < args.ph_hi) xcd_barrier(bar);
#endif
    }
}

#ifndef MK_N_LAUNCHES
#define MK_N_LAUNCHES 1
#endif
extern "C" void kernel_launch(void* const* d_in, const int* in_sizes, int n_in, void* d_out, int out_size, void* d_ws, size_t ws_size, hipStream_t stream) {
    static int grid = 0;
    if (grid == 0) {
        if (n_in != 26 || in_sizes[0] != S * DM || out_size != S * DM || ws_size < WS_END) {
            fprintf(stderr, "kernel_launch: unexpected problem (n_in %d, in0 %d, out %d, ws %zu); nothing launched\n", n_in, n_in > 0 ? in_sizes[0] : -1, out_size, ws_size); grid = -1; return; }
        int dev = 0, cus = 0, per_cu = 0;
        if (hipGetDevice(&dev) != hipSuccess || hipDeviceGetAttribute(&cus, hipDeviceAttributeMultiprocessorCount, dev) != hipSuccess) { grid = -1; return; }
        if (hipFuncSetAttribute((const void*)hyb_fwd, hipFuncAttributeMaxDynamicSharedMemorySize, LDS_BYTES) != hipSuccess) { fprintf(stderr, "kernel_launch: hipFuncSetAttribute failed\n"); grid = -1; return; }
        if (hipOccupancyMaxActiveBlocksPerMultiprocessor(&per_cu, (const void*)hyb_fwd, NTHREADS, LDS_BYTES) != hipSuccess || per_cu < 1)
            fprintf(stderr, "kernel_launch: note: occupancy query reports %d workgroups per CU\n", per_cu);
        (void)hipGetLastError();
        grid = cus;
    }
    if (grid < 0) return;
    if (hipMemsetAsync((char*)d_ws + WS_CTL, 0, CTL_ZERO_BYTES, stream) != hipSuccess) { fprintf(stderr, "kernel_launch: hipMemsetAsync failed\n"); return; }
    Args a{};
    for (int i = 0; i < 26; ++i) a.in.p[i] = (const float*)d_in[i];
    a.out = (float*)d_out; a.ws = (unsigned char*)d_ws;
#if MK_N_LAUNCHES == 1
    a.ph_lo = 0; a.ph_hi = N_PHASES; a.li = 0;
    hipLaunchKernelGGL(hyb_fwd, dim3(grid), dim3(NTHREADS), LDS_BYTES, stream, a);
#else
    for (int ph = 0; ph < N_PHASES; ++ph) { a.ph_lo = ph; a.ph_hi = ph + 1; a.li = 0; hipLaunchKernelGGL(hyb_fwd, dim3(grid), dim3(NTHREADS), LDS_BYTES, stream, a); }
#endif
    const hipError_t le = hipPeekAtLastError();
    if (le != hipSuccess) fprintf(stderr, "kernel_launch: launch failed: %s\n", hipGetErrorName(le));
}
```

```cpp
#include <hip/hip_runtime.h>
#include <cstdio>
#include <cstdint>
#define MEM_UNFUSED 1

template <int M> __device__ __forceinline__ int shx_i(int v) {
    if constexpr (M == 1) return __builtin_amdgcn_mov_dpp(v, 0xB1, 0xF, 0xF, true);
    else if constexpr (M == 2) return __builtin_amdgcn_mov_dpp(v, 0x4E, 0xF, 0xF, true);
    else if constexpr (M == 8) return __builtin_amdgcn_mov_dpp(v, 0x128, 0xF, 0xF, true);
    else return __builtin_amdgcn_ds_swizzle(v, (M << 10) | 0x1f);
}
__device__ __forceinline__ int dpp_hmirror_i(int v) { return __builtin_amdgcn_mov_dpp(v, 0x141, 0xF, 0xF, true); }
template <int M> __device__ __forceinline__ float shx(float v) { return __int_as_float(shx_i<M>(__float_as_int(v))); }
__device__ __forceinline__ float sh32_sum(float v) { auto r = __builtin_amdgcn_permlane32_swap(__float_as_uint(v), __float_as_uint(v), false, false); return __uint_as_float(r[0]) + __uint_as_float(r[1]); }
__device__ __forceinline__ float sh32_max(float v) { auto r = __builtin_amdgcn_permlane32_swap(__float_as_uint(v), __float_as_uint(v), false, false); return fmaxf(__uint_as_float(r[0]), __uint_as_float(r[1])); }
__device__ __forceinline__ int sum32_i(int c) { c += shx_i<1>(c); c += shx_i<2>(c); c += shx_i<4>(c); c += shx_i<8>(c); c += shx_i<16>(c); return c; }
namespace pg8 {
#define PG8_LAS __attribute__((address_space(3)))
typedef unsigned short bf16_t;
typedef short bf16x8 __attribute__((ext_vector_type(8)));
typedef float f32x4 __attribute__((ext_vector_type(4)));
typedef unsigned u32x4 __attribute__((ext_vector_type(4)));
constexpr int BM = 256, BK = 64, HALF = 128, HTB = HALF * BK * 2  , STAGE_BYTES = 8 * HTB, NXCD = 8, WGM = 8;

__host__ __device__ __forceinline__ int lds_byte(int r, int c) { const int st = (r >> 4) * 2 + (c >> 5), rr = r & 15, cc = c & 31, ob = rr * 64 + cc * 2; return st * 1024 + (ob ^ (((ob >> 9) & 1) << 5)); }
__host__ __device__ __forceinline__ void stage_rc(int b, int& R, int& C) { const int st = b / 1024, sb = b % 1024, swz = sb ^ (((sb >> 9) & 1) << 5); R = (st >> 1) * 16 + swz / 64; C = (st & 1) * 32 + (swz % 64) / 2; }
__host__ __device__ __forceinline__ int perm32(int rho) { const int n = rho >> 4, i = rho & 15; return 8 * (i >> 2) + 4 * n + (i & 3); }

struct Unit { int pm, pn; };
struct Gemm { const bf16_t* A; const bf16_t* Bt; int M, N, K, lda; };

struct StaticOrder {
    int nM, nN, nwg, G, c;
    __host__ __device__ __forceinline__ void init(int M, int N, int G_, int c_) { nM = M / BM; nN = N / BM; nwg = nM * nN; G = G_; c = c_; }
    __host__ __device__ __forceinline__ bool next(int i, Unit& u) const {
        const long L = (long)i * G + c; if (L >= nwg) return false;
        int wgid = (int)L; { const int q = nwg / NXCD, r = nwg % NXCD, xcd = wgid % NXCD, off = wgid / NXCD; wgid = (xcd < r ? xcd * (q + 1) : r * (q + 1) + (xcd - r) * q) + off; }
        const int nig = WGM * nN, gid = wgid / nig, fm = gid * WGM, gsz = (nM - fm) < WGM ? (nM - fm) : WGM;
        u.pm = fm + ((wgid % nig) % gsz); u.pn = (wgid % nig) / gsz; return true;
    }
    __device__ __forceinline__ void a_ready(const Unit&) const {}
    __device__ __forceinline__ void done(const Unit&) const {}
};

__device__ __forceinline__ unsigned cvt_pk_bf16(float lo, float hi) { unsigned r; asm volatile("v_cvt_pk_bf16_f32 %0, %1, %2" : "=v"(r) : "v"(lo), "v"(hi)); return r; }
typedef float f32x2 __attribute__((ext_vector_type(2)));
constexpr float RMS_EPS_F = 1e-6f;
__device__ __forceinline__ float silu_f(float x) { return x * __builtin_amdgcn_rcpf(1.0f + __builtin_amdgcn_exp2f(-1.4426950408889634f * x)); }
__device__ __forceinline__ float row_rstd(const float* ssq, int row) {
    const f32x4* p = (const f32x4*)(ssq + (size_t)row * 16); const f32x4 a = p[0], b = p[1], c = p[2], d = p[3];
    const float s = ((a[0] + a[1]) + (a[2] + a[3])) + ((b[0] + b[1]) + (b[2] + b[3])) + ((c[0] + c[1]) + (c[2] + c[3])) + ((d[0] + d[1]) + (d[2] + d[3]));
    return rsqrtf(s * (1.0f / 1024.0f) + RMS_EPS_F); }

struct EpiSwiGLU {
    static constexpr bool PERM = true, AFTER_DRAIN = false;
    bf16_t* U; const float* ssq; int ldu;
    __device__ __forceinline__ void operator()(const f32x4 (&acc)[2][2][4][2], const Unit& u, int wr, int wc, int fr, int fq) const {
        const int row0 = u.pm * BM + wr * 64 + fr, col0 = u.pn * HALF + wc * 32 + 8 * fq;
#pragma unroll
        for (int ai = 0; ai < 2; ++ai)
#pragma unroll
            for (int m = 0; m < 4; ++m) {
                const int row = row0 + ai * HALF + m * 16; const float r = row_rstd(ssq, row);
                const f32x4 a0 = acc[ai][0][m][0] * r, a1 = acc[ai][0][m][1] * r, b0 = acc[ai][1][m][0] * r, b1 = acc[ai][1][m][1] * r;
                u32x4 w;
                w.x = cvt_pk_bf16(silu_f(a0[0]) * b0[0], silu_f(a0[1]) * b0[1]); w.y = cvt_pk_bf16(silu_f(a0[2]) * b0[2], silu_f(a0[3]) * b0[3]);
                w.z = cvt_pk_bf16(silu_f(a1[0]) * b1[0], silu_f(a1[1]) * b1[1]); w.w = cvt_pk_bf16(silu_f(a1[2]) * b1[2], silu_f(a1[3]) * b1[3]);
                *(u32x4*)(U + (size_t)row * ldu + col0) = w;
            }
    }
};
typedef int i32x4 __attribute__((ext_vector_type(4)));
struct EpiSwiGLU8 {
    static constexpr bool PERM = true, AFTER_DRAIN = false, I8 = true;
    bf16_t* U; const float* ssq; int ldu; const float* sa; const float* sb;
    __device__ __forceinline__ void operator()(const i32x4 (&acc)[2][2][4][2], const Unit& u, int wr, int wc, int fr, int fq) const {
        const int row0 = u.pm * BM + wr * 64 + fr, col0 = u.pn * HALF + wc * 32 + 8 * fq, wrow = u.pn * BM + wc * 32 + 8 * fq;
        const f32x4 sA0 = *(const f32x4*)(sb + wrow), sA1 = *(const f32x4*)(sb + wrow + 4), sB0 = *(const f32x4*)(sb + wrow + HALF), sB1 = *(const f32x4*)(sb + wrow + HALF + 4);
#pragma unroll
        for (int ai = 0; ai < 2; ++ai)
#pragma unroll
            for (int m = 0; m < 4; ++m) {
                const int row = row0 + ai * HALF + m * 16; const float r = sa[row];
                const float nr = -1.4426950408889634f * r, ir2 = __builtin_amdgcn_rcpf(r * r);
                u32x4 w; float o[8];
#pragma unroll
                for (int h2 = 0; h2 < 2; ++h2) {
                    const f32x4 z = __builtin_convertvector(acc[ai][0][m][h2], f32x4) * (h2 ? sA1 : sA0), ww = __builtin_convertvector(acc[ai][1][m][h2], f32x4) * (h2 ? sB1 : sB0);
                    const f32x4 zw = z * ww, t = z * nr;
#pragma unroll
                    for (int e2 = 0; e2 < 4; ++e2) { const float ex = __builtin_amdgcn_exp2f(t[e2]); o[4 * h2 + e2] = zw[e2] * __builtin_amdgcn_rcpf(__builtin_fmaf(ex, ir2, ir2)); }
                }
                w.x = cvt_pk_bf16(o[0], o[1]); w.y = cvt_pk_bf16(o[2], o[3]); w.z = cvt_pk_bf16(o[4], o[5]); w.w = cvt_pk_bf16(o[6], o[7]);
                *(u32x4*)(U + (size_t)row * ldu + col0) = w;
            }
    }
};
struct EpiResid {
    static constexpr bool PERM = true, AFTER_DRAIN = false;
    bf16_t* HB; float* Hout; float* ssq_out; float scale;
    __device__ __forceinline__ void operator()(const f32x4 (&acc)[2][2][4][2], const Unit& u, int wr, int wc, int fr, int fq) const {
        const int row0 = u.pm * BM + wr * 64 + fr, col0 = u.pn * BM + wc * 32 + 8 * fq;
#pragma unroll
        for (int ai = 0; ai < 2; ++ai)
#pragma unroll
            for (int m = 0; m < 4; ++m) {
                const int row = row0 + ai * HALF + m * 16; float sq = 0.f;
#pragma unroll
                for (int bj = 0; bj < 2; ++bj) {
                    bf16_t* hbp = HB + (size_t)row * 1024 + col0 + bj * HALF;
                    const u32x4 wi = *(const u32x4*)hbp;
                    f32x4 h0, h1;
                    h0[0] = __uint_as_float(wi.x << 16); h0[1] = __uint_as_float(wi.x & 0xffff0000u); h0[2] = __uint_as_float(wi.y << 16); h0[3] = __uint_as_float(wi.y & 0xffff0000u);
                    h1[0] = __uint_as_float(wi.z << 16); h1[1] = __uint_as_float(wi.z & 0xffff0000u); h1[2] = __uint_as_float(wi.w << 16); h1[3] = __uint_as_float(wi.w & 0xffff0000u);
                    h0 = h0 + acc[ai][bj][m][0] * scale; h1 = h1 + acc[ai][bj][m][1] * scale;
                    if (Hout) { float* hp = Hout + (size_t)row * 1024 + col0 + bj * HALF; *(f32x4*)hp = h0; *(f32x4*)(hp + 4) = h1; }
                    else {
                        sq += (h0[0] * h0[0] + h0[1] * h0[1]) + (h0[2] * h0[2] + h0[3] * h0[3]) + (h1[0] * h1[0] + h1[1] * h1[1]) + (h1[2] * h1[2] + h1[3] * h1[3]);
                        u32x4 w; w.x = cvt_pk_bf16(h0[0], h0[1]); w.y = cvt_pk_bf16(h0[2], h0[3]); w.z = cvt_pk_bf16(h1[0], h1[1]); w.w = cvt_pk_bf16(h1[2], h1[3]);
                        *(u32x4*)hbp = w; }
                }
                if (!Hout) { sq += shx<16>(sq); sq = sh32_sum(sq); if (fq == 0) ssq_out[(size_t)row * 16 + u.pn * 4 + wc] = sq; }
            }
    }
};
struct EpiScale {
    static constexpr bool PERM = true, AFTER_DRAIN = false;
    bf16_t* O; int ldc; const float* ssq; int split_cols; size_t split_stride;
    __device__ __forceinline__ void operator()(const f32x4 (&acc)[2][2][4][2], const Unit& u, int wr, int wc, int fr, int fq) const {
        const int row0 = u.pm * BM + wr * 64 + fr; int colt = u.pn * BM; bf16_t* base = O;
        if (split_cols) { const int t = colt / split_cols; base += (size_t)t * split_stride; colt -= t * split_cols; }
        const int col0 = colt + wc * 32 + 8 * fq;
#pragma unroll
        for (int ai = 0; ai < 2; ++ai)
#pragma unroll
            for (int m = 0; m < 4; ++m) {
                const int row = row0 + ai * HALF + m * 16; const float r = row_rstd(ssq, row);
                bf16_t* rowp = base + (size_t)row * ldc + col0;
#pragma unroll
                for (int bj = 0; bj < 2; ++bj) { const f32x4 v0 = acc[ai][bj][m][0] * r, v1 = acc[ai][bj][m][1] * r;
                    u32x4 w; w.x = cvt_pk_bf16(v0[0], v0[1]); w.y = cvt_pk_bf16(v0[2], v0[3]); w.z = cvt_pk_bf16(v1[0], v1[1]); w.w = cvt_pk_bf16(v1[2], v1[3]);
                    *(u32x4*)(rowp + bj * HALF) = w; }
            }
    }
};

enum { KIND_PLAIN = 0, KIND_NORM = 1, KIND_NORM_ROPE = 2, KIND_ROPE = 3, KIND_VT = 4, KIND_NORM_ROPE_KSUM = 5, KIND_IK = 6, KIND_SKIP = 7 };
struct EpiProj {
    static constexpr bool PERM = true, AFTER_DRAIN = false;
    bf16_t* O; int ldc; const float* ssq; int split_cols; size_t split_stride;
    int even;
    const float* gtab;
    const float* cosT; const float* sinT;
    bf16_t* Vt;
    bf16_t* IKf;
    PG8_LAS float* xch;
    float* ksum;
    __device__ __forceinline__ void operator()(const f32x4 (&acc)[2][2][4][2], const Unit& u, int wr, int wc, int fr, int fq) const {
        const int S_ = 16384;
        int kind; int gsel = 0; int vcol0 = 0;
        if (even) { const int p = u.pn;
            kind = (p < 2) ? KIND_NORM : (p < 4) ? KIND_NORM_ROPE : (p < 6) ? KIND_NORM : (p < 8) ? KIND_NORM_ROPE : (p < 10) ? KIND_VT : (p < 12) ? KIND_PLAIN : (p < 14) ? KIND_ROPE : KIND_IK;
            gsel = (p < 8) ? (p >> 1) : 0; vcol0 = (p - 8) * 256;
        } else { const int p = u.pn; kind = (p < 4) ? KIND_NORM_ROPE : (p < 8) ? KIND_NORM_ROPE_KSUM : KIND_VT; gsel = (p < 8) ? 4 + (p >> 2) : 0; vcol0 = (p - 8) * 256; }
        const float* gn = gtab + gsel * 64;
        const int row0 = u.pm * BM + wr * 64 + fr; int colt = u.pn * BM; bf16_t* base = O;
        if (split_cols) { const int t = colt / split_cols; base += (size_t)t * split_stride; colt -= t * split_cols; }
        const int co0 = wc * 32 + 8 * fq;
        const int hd0 = 32 * (wc & 1) + 8 * fq;
        int xo = ((wr * 64 + fr) * 2) * 4 + wc, xp = ((wr * 64 + fr) * 2) * 4 + (wc ^ 1);
        asm volatile("" : "+v"(xo), "+v"(xp));
        const bool normk = (kind == KIND_NORM || kind == KIND_NORM_ROPE || kind == KIND_NORM_ROPE_KSUM);
        const bool ropek = (kind == KIND_NORM_ROPE || kind == KIND_ROPE || kind == KIND_NORM_ROPE_KSUM || kind == KIND_IK);
        float gv[8];
#pragma unroll
        for (int e2 = 0; e2 < 8; ++e2) gv[e2] = normk ? gn[hd0 + e2] : 1.0f;
        if (normk) {
#pragma unroll
            for (int ai = 0; ai < 2; ++ai)
#pragma unroll
                for (int m = 0; m < 4; ++m)
#pragma unroll
                    for (int bj = 0; bj < 2; ++bj) { const f32x4 v0 = acc[ai][bj][m][0], v1 = acc[ai][bj][m][1];
                        float ss = (v0[0] * v0[0] + v0[1] * v0[1]) + (v0[2] * v0[2] + v0[3] * v0[3]) + (v1[0] * v1[0] + v1[1] * v1[1]) + (v1[2] * v1[2] + v1[3] * v1[3]);
                        ss += shx<16>(ss); ss = sh32_sum(ss);
                        if (fq == 0) xch[xo + (ai * 128 + m * 16) * 8 + bj * 4] = ss; }
            asm volatile("s_waitcnt lgkmcnt(0)" ::: "memory"); __builtin_amdgcn_s_barrier(); asm volatile("" ::: "memory");
        }
        float csum[2][8];
#pragma unroll
        for (int b2 = 0; b2 < 2; ++b2)
#pragma unroll
            for (int e2 = 0; e2 < 8; ++e2) csum[b2][e2] = 0.f;
        if (kind != KIND_SKIP) {
#pragma unroll
        for (int ai = 0; ai < 2; ++ai)
#pragma unroll
            for (int m = 0; m < 4; ++m) {
                const int row = row0 + ai * HALF + m * 16; const float r = row_rstd(ssq, row);
                float cs[8], sn[8];
                if (ropek) { const f32x4 c0 = *(const f32x4*)(cosT + (unsigned)(row * 8)), c1 = *(const f32x4*)(cosT + (unsigned)(row * 8 + 4)), s0 = *(const f32x4*)(sinT + (unsigned)(row * 8)), s1 = *(const f32x4*)(sinT + (unsigned)(row * 8 + 4));
#pragma unroll
                    for (int e2 = 0; e2 < 4; ++e2) { cs[e2] = c0[e2]; cs[4 + e2] = c1[e2]; sn[e2] = s0[e2]; sn[4 + e2] = s1[e2]; } }
#pragma unroll
                for (int bj = 0; bj < 2; ++bj) {
                    if (kind == KIND_IK && (bj == 1 || wc >= 2)) continue;
                    float x[8];
                    { const f32x4 v0 = acc[ai][bj][m][0], v1 = acc[ai][bj][m][1];
#pragma unroll
                      for (int e2 = 0; e2 < 4; ++e2) { x[e2] = v0[e2]; x[4 + e2] = v1[e2]; } }
                    float sc = r;
                    if (normk) { const float tot = xch[xo + (ai * 128 + m * 16) * 8 + bj * 4] + xch[xp + (ai * 128 + m * 16) * 8 + bj * 4];
                        sc = r * rsqrtf(tot * (r * r) * (1.0f / 64.0f) + RMS_EPS_F); }
#pragma unroll
                    for (int e2 = 0; e2 < 8; ++e2) x[e2] = x[e2] * sc * gv[e2];
                    if (ropek) {
#pragma unroll
                        for (int e2 = 0; e2 < 8; ++e2) { const float other = shx<16>(x[e2]);
                            if ((wc & 1) == 0 && fq == 0) x[e2] = x[e2] * cs[e2] - other * sn[e2];
                            else if ((wc & 1) == 0 && fq == 1) x[e2] = x[e2] * cs[e2] + other * sn[e2]; }
                    }
                    if (kind == KIND_VT) {
                        bf16_t* vp = Vt + (unsigned)((vcol0 + bj * HALF + co0) * S_ + (row & ~1));
#pragma unroll
                        for (int e2 = 0; e2 < 8; ++e2) { const float other = shx<1>(x[e2]);
                            const unsigned w = (fr & 1) ? cvt_pk_bf16(other, x[e2]) : cvt_pk_bf16(x[e2], other);
                            if (((e2 >> 2) & 1) == (fr & 1)) *(unsigned*)(vp + (unsigned)(e2 * S_)) = w; }
                    } else if (kind == KIND_IK) {
                        const int c8 = 4 * wc + fq;
                        u32x4 w; w.x = cvt_pk_bf16(x[0], x[1]); w.y = cvt_pk_bf16(x[2], x[3]); w.z = cvt_pk_bf16(x[4], x[5]); w.w = cvt_pk_bf16(x[6], x[7]);
                        *(u32x4*)(IKf + (unsigned)((((row >> 5) * 4 + (c8 >> 1)) * 64 + (c8 & 1) * 32 + (row & 31)) * 8)) = w;
                    } else {
                        u32x4 w; w.x = cvt_pk_bf16(x[0], x[1]); w.y = cvt_pk_bf16(x[2], x[3]); w.z = cvt_pk_bf16(x[4], x[5]); w.w = cvt_pk_bf16(x[6], x[7]);
                        *(u32x4*)(base + (unsigned)(row * ldc + colt + bj * HALF + co0)) = w;
                        if (kind == KIND_NORM_ROPE_KSUM) {
                            csum[bj][0] += __uint_as_float(w.x << 16); csum[bj][1] += __uint_as_float(w.x & 0xffff0000u); csum[bj][2] += __uint_as_float(w.y << 16); csum[bj][3] += __uint_as_float(w.y & 0xffff0000u);
                            csum[bj][4] += __uint_as_float(w.z << 16); csum[bj][5] += __uint_as_float(w.z & 0xffff0000u); csum[bj][6] += __uint_as_float(w.w << 16); csum[bj][7] += __uint_as_float(w.w & 0xffff0000u); }
                    }
                }
            }
        }
        if (kind == KIND_NORM_ROPE_KSUM) {
#pragma unroll
            for (int b2 = 0; b2 < 2; ++b2)
#pragma unroll
                for (int e2 = 0; e2 < 8; ++e2) { float v = csum[b2][e2]; v += shx<1>(v); v += shx<2>(v); v += __int_as_float(dpp_hmirror_i(__float_as_int(v))); v += shx<8>(v);
                    if (fr == 0) xch[2816 + wr * 256 + b2 * HALF + wc * 32 + 8 * fq + e2] = v; }
        }
        if (normk) { asm volatile("s_waitcnt lgkmcnt(0)" ::: "memory"); __builtin_amdgcn_s_barrier(); asm volatile("" ::: "memory"); }
        if (kind == KIND_NORM_ROPE_KSUM) { int t2 = (wr * 4 + wc) * 64 + fq * 16 + fr; asm volatile("" : "+v"(t2));
            if (t2 < BM) ksum[(unsigned)(u.pm * 1024 + (u.pn - 4) * BM + t2)] = xch[2816 + t2] + xch[2816 + 256 + t2]; }
    }
};

struct EpiPartial {
    static constexpr bool PERM = true, AFTER_DRAIN = false;
    float* P; int M;
    __device__ __forceinline__ void operator()(const f32x4 (&acc)[2][2][4][2], const Unit& u, int wr, int wc, int fr, int fq) const {
        const int row0 = u.pm * BM + wr * 64 + fr; float* base = P + (size_t)u.pn * M * 256 + wc * 32 + 8 * fq;
#pragma unroll
        for (int ai = 0; ai < 2; ++ai)
#pragma unroll
            for (int m = 0; m < 4; ++m) { float* rp = base + (unsigned)((row0 + ai * HALF + m * 16) * 256);
#pragma unroll
                for (int bj = 0; bj < 2; ++bj) { *(f32x4*)(rp + bj * HALF) = acc[ai][bj][m][0]; *(f32x4*)(rp + bj * HALF + 4) = acc[ai][bj][m][1]; } }
    }
};
typedef int i32x4 __attribute__((ext_vector_type(4)));
template <class E, class = void> struct epi_i8 { static constexpr bool value = false; };
template <class E> struct epi_i8<E, decltype((void)E::I8)> { static constexpr bool value = E::I8; };
template <bool I8> struct acc_sel { typedef f32x4 type; };
template <> struct acc_sel<true> { typedef i32x4 type; };
template <class Epi, class Sched, bool ALIGN_EPI = false, bool SP2 = false, int KSPLIT = 0, int LDB = 0>
__device__ __forceinline__ void gemm_phase(PG8_LAS unsigned char* lds, const Gemm g, const Sched& S, const Epi& E, const int tid) {
    const int wid = __builtin_amdgcn_readfirstlane(tid >> 6), lane = tid & 63, wr = wid >> 2, wc = wid & 3, fr = lane & 15, fq = lane >> 4;
    const int K = g.K, nt = K / BK;
    unsigned voffA[2], voffB[2];
#pragma unroll
    for (int i = 0; i < 2; ++i) { int R, C; stage_rc(tid * 16 + i * 8192, R, C); const int Rb = Epi::PERM ? ((R & ~31) + perm32(R & 31)) : R;
        voffA[i] = (unsigned)(R * g.lda + C) * 2u; voffB[i] = (unsigned)(Rb * (LDB ? LDB : K) + C) * 2u; }
    const size_t kstep = (size_t)(BK * 2);
    const size_t hstepA = (size_t)HALF * g.lda * 2, hstepB = (size_t)HALF * (LDB ? LDB : K) * 2;
    const size_t tstepA = 2 * hstepA, tstepB = 2 * hstepB;
    const unsigned ldsw = (unsigned)wid * 1024u;
    const int aoff = lds_byte(wr * 64 + fr, fq * 8), boff = lds_byte(wc * 32 + fr, fq * 8);
#define PG8_SA(b, h) (((b) * 2 + (h)) * HTB)
#define PG8_SB(b, h) ((4 + (b) * 2 + (h)) * HTB)
#define PG8_STAGE(bufoff, gbase, voff) do { _Pragma("unroll") for (int _i = 0; _i < 2; ++_i) \
        __builtin_amdgcn_global_load_lds((const unsigned*)((const char*)(gbase) + (voff)[_i]), (PG8_LAS unsigned*)(lds + (bufoff) + ldsw + _i * 8192), 16, 0, 0); } while (0)
#define PG8_LDA(dst, b, h) do { _Pragma("unroll") for (int m = 0; m < 4; ++m) _Pragma("unroll") for (int k = 0; k < 2; ++k) dst[m][k] = *(const PG8_LAS bf16x8*)(lds + PG8_SA(b, h) + aoff + m * 2048 + k * 1024); } while (0)
#define PG8_LDB(dst, b, h) do { _Pragma("unroll") for (int n = 0; n < 2; ++n) _Pragma("unroll") for (int k = 0; k < 2; ++k) dst[n][k] = *(const PG8_LAS bf16x8*)(lds + PG8_SB(b, h) + boff + n * 2048 + k * 1024); } while (0)
#define PG8_MMA(ai, bj, At, Bt) do { __builtin_amdgcn_s_setprio(1); _Pragma("unroll") for (int m = 0; m < 4; ++m) _Pragma("unroll") for (int n = 0; n < 2; ++n) _Pragma("unroll") for (int k = 0; k < 2; ++k) \
        { if constexpr (I8) acc[ai][bj][m][n] = __builtin_amdgcn_mfma_i32_16x16x64_i8(__builtin_bit_cast(i32x4, Bt[n][k]), __builtin_bit_cast(i32x4, At[m][k]), acc[ai][bj][m][n], 0, 0, 0); \
          else acc[ai][bj][m][n] = __builtin_amdgcn_mfma_f32_16x16x32_bf16(Bt[n][k], At[m][k], acc[ai][bj][m][n], 0, 0, 0); } __builtin_amdgcn_s_setprio(0); } while (0)
#define PG8_WAIT_V(n) asm volatile("s_waitcnt vmcnt(" #n ")" ::: "memory")
#define PG8_WAIT_L(n) asm volatile("s_waitcnt lgkmcnt(" #n ")" ::: "memory")
#define PG8_BAR __builtin_amdgcn_s_barrier()
#define PG8_SCHED __builtin_amdgcn_sched_barrier(0)
    Unit cur, nxt; int ui = 0;
    if (!S.next(0, cur)) return;
    constexpr bool I8 = epi_i8<Epi>::value; typedef typename acc_sel<I8>::type acc_t;
    acc_t acc[2][2][4][2]; acc_t zacc; zacc[0] = 0; zacc[1] = 0; zacc[2] = 0; zacc[3] = 0;
#pragma unroll
    for (int a = 0; a < 2; ++a)
#pragma unroll
        for (int b = 0; b < 2; ++b)
#pragma unroll
            for (int m = 0; m < 4; ++m)
#pragma unroll
                for (int n = 0; n < 2; ++n) acc[a][b][m][n] = zacc;
    bf16x8 At[4][2], B0[2][2], B1[2][2];
    const char* cA = (const char*)g.A + (size_t)cur.pm * tstepA + (KSPLIT ? (size_t)cur.pn * KSPLIT : (size_t)0); const char* cB = (const char*)g.Bt + (KSPLIT ? (size_t)cur.pn * KSPLIT : (size_t)cur.pn * tstepB);
    S.a_ready(cur);
    if constexpr (SP2) {
        PG8_STAGE(PG8_SB(0, 0), cB, voffB); PG8_STAGE(PG8_SB(0, 1), cB + hstepB, voffB); PG8_STAGE(PG8_SA(0, 0), cA, voffA); PG8_STAGE(PG8_SA(0, 1), cA + hstepA, voffA);
        if (wr == 1) PG8_BAR;
        PG8_WAIT_V(2); PG8_BAR;
        PG8_STAGE(PG8_SB(1, 0), cB + kstep, voffB); PG8_STAGE(PG8_SA(1, 0), cA + kstep, voffA); PG8_STAGE(PG8_SB(1, 1), cB + hstepB + kstep, voffB);
        PG8_WAIT_V(6); PG8_BAR;
    } else {
        PG8_STAGE(PG8_SB(0, 0), cB, voffB); PG8_STAGE(PG8_SA(0, 0), cA, voffA); PG8_STAGE(PG8_SB(0, 1), cB + hstepB, voffB); PG8_STAGE(PG8_SA(0, 1), cA + hstepA, voffA);
        if (wr == 1) PG8_BAR;
        PG8_WAIT_V(4); PG8_BAR;
        PG8_STAGE(PG8_SB(1, 0), cB + kstep, voffB); PG8_STAGE(PG8_SA(1, 0), cA + kstep, voffA); PG8_STAGE(PG8_SB(1, 1), cB + hstepB + kstep, voffB);
        PG8_WAIT_V(6); PG8_BAR;
    }
    for (;;) {
        const bool has_next = S.next(ui + 1, nxt);
        const char* nA = has_next ? (const char*)g.A + (size_t)nxt.pm * tstepA + (KSPLIT ? (size_t)nxt.pn * KSPLIT : (size_t)0) : cA; const char* nB = has_next ? (const char*)g.Bt + (KSPLIT ? (size_t)nxt.pn * KSPLIT : (size_t)nxt.pn * tstepB) : cB;
        for (int t = 0; t < nt; t += 2) {
            const bool last = (t == nt - 2);
            const char* a1 = cA + (size_t)(t + 1) * kstep;
            const char* a2 = last ? nA : cA + (size_t)(t + 2) * kstep; const char* b2 = last ? nB : cB + (size_t)(t + 2) * kstep;
            const char* a3 = a2 + kstep; const char* b3 = b2 + kstep;
            if (last && has_next) S.a_ready(nxt);
            if constexpr (SP2) {
            PG8_LDB(B0, 0, 0); PG8_LDB(B1, 0, 1); PG8_SCHED; PG8_LDA(At, 0, 0); PG8_STAGE(PG8_SA(1, 1), a1 + hstepA, voffA);
            PG8_WAIT_V(8); PG8_WAIT_L(0); PG8_BAR; PG8_MMA(0, 0, At, B0); PG8_MMA(0, 1, At, B1); PG8_BAR; PG8_SCHED;
            PG8_LDA(At, 0, 1); PG8_STAGE(PG8_SB(0, 0), b2, voffB); PG8_STAGE(PG8_SB(0, 1), b2 + hstepB, voffB); PG8_STAGE(PG8_SA(0, 0), a2, voffA);
            PG8_WAIT_V(8); PG8_WAIT_L(0); PG8_BAR; PG8_MMA(1, 0, At, B0); PG8_MMA(1, 1, At, B1); PG8_BAR; PG8_SCHED;
            PG8_LDB(B0, 1, 0); PG8_LDB(B1, 1, 1); PG8_SCHED; PG8_LDA(At, 1, 0); PG8_STAGE(PG8_SA(0, 1), a2 + hstepA, voffA);
            PG8_WAIT_V(8); PG8_WAIT_L(0); PG8_BAR; PG8_MMA(0, 0, At, B0); PG8_MMA(0, 1, At, B1); PG8_BAR; PG8_SCHED;
            PG8_LDA(At, 1, 1); PG8_STAGE(PG8_SB(1, 0), b3, voffB); PG8_STAGE(PG8_SB(1, 1), b3 + hstepB, voffB); PG8_STAGE(PG8_SA(1, 0), a3, voffA);
            PG8_WAIT_V(8); PG8_WAIT_L(0); PG8_BAR; PG8_MMA(1, 0, At, B0); PG8_MMA(1, 1, At, B1); PG8_BAR; PG8_SCHED;
            } else {
            PG8_LDB(B0, 0, 0); PG8_SCHED; PG8_LDA(At, 0, 0); PG8_STAGE(PG8_SA(1, 1), a1 + hstepA, voffA);
            PG8_WAIT_L(8); PG8_BAR; PG8_WAIT_L(0); PG8_MMA(0, 0, At, B0); PG8_BAR; PG8_SCHED;
            PG8_LDB(B1, 0, 1); PG8_STAGE(PG8_SB(0, 0), b2, voffB);
            PG8_BAR; PG8_WAIT_L(0); PG8_MMA(0, 1, At, B1); PG8_BAR;
            PG8_LDA(At, 0, 1); PG8_STAGE(PG8_SA(0, 0), a2, voffA);
            PG8_BAR; PG8_WAIT_L(0); PG8_MMA(1, 0, At, B0); PG8_BAR; PG8_SCHED;
            PG8_STAGE(PG8_SB(0, 1), b2 + hstepB, voffB);
            PG8_WAIT_V(6); PG8_BAR; PG8_MMA(1, 1, At, B1); PG8_BAR;
            PG8_LDB(B0, 1, 0); PG8_SCHED; PG8_LDA(At, 1, 0); PG8_STAGE(PG8_SA(0, 1), a2 + hstepA, voffA);
            PG8_WAIT_L(8); PG8_BAR; PG8_WAIT_L(0); PG8_MMA(0, 0, At, B0); PG8_BAR; PG8_SCHED;
            PG8_LDB(B1, 1, 1); PG8_STAGE(PG8_SB(1, 0), b3, voffB);
            PG8_BAR; PG8_WAIT_L(0); PG8_MMA(0, 1, At, B1); PG8_BAR;
            PG8_LDA(At, 1, 1); PG8_STAGE(PG8_SA(1, 0), a3, voffA);
            PG8_BAR; PG8_WAIT_L(0); PG8_MMA(1, 0, At, B0); PG8_BAR; PG8_SCHED;
            PG8_STAGE(PG8_SB(1, 1), b3 + hstepB, voffB);
            PG8_WAIT_V(6); PG8_BAR; PG8_MMA(1, 1, At, B1); PG8_BAR;
            }
        }
        if constexpr (ALIGN_EPI) { if (wr == 0) PG8_BAR; }
        if constexpr (!Epi::AFTER_DRAIN) { E(acc, cur, wr, wc, fr, fq); S.done(cur); }
        if (!has_next) break;
#pragma unroll
        for (int a = 0; a < 2; ++a)
#pragma unroll
            for (int b = 0; b < 2; ++b)
#pragma unroll
                for (int m = 0; m < 4; ++m)
#pragma unroll
                    for (int n = 0; n < 2; ++n) acc[a][b][m][n] = zacc;
        cur = nxt; cA = nA; cB = nB; ++ui;
        if constexpr (ALIGN_EPI) { if (wr == 1) PG8_BAR; }
    }
    PG8_WAIT_V(0);
    if constexpr (!ALIGN_EPI) { if (wr == 0) PG8_BAR; }
    PG8_BAR;
    if constexpr (Epi::AFTER_DRAIN) { E.fused(acc, cur, wr, wc, fr, fq, lds, wid, lane); S.done(cur); }
#undef PG8_SA
#undef PG8_SB
#undef PG8_STAGE
#undef PG8_LDA
#undef PG8_LDB
#undef PG8_MMA
#undef PG8_WAIT_V
#undef PG8_WAIT_L
#undef PG8_BAR
#undef PG8_SCHED
}
}

constexpr int S = 16384, DM = 1024, FF = 2816, FF2 = 5632, EVEN_SRC = 3664, EVEN_NP = 3840, ODD_N = 3072, NLAYER = 2, MEMT = 256, MEMW = 256;
constexpr float RMS_EPS = 1e-6f;
constexpr float LOG2E = 1.4426950408889634f;
constexpr float C2 = 0.125f * LOG2E;
constexpr int NWAVES = 8, NTHREADS = 512;
constexpr int EC_FQ = 0, EC_DQ = 512, EC_FK = 1024, EC_DK = 1536, EC_FV = 2048, EC_DV = 2560, EC_IQ = 3072, EC_IK = 3584;
constexpr int ES_FQ = 0, ES_FK = 512, ES_FV = 1024, ES_FL = 1536, ES_DQ = 1544, ES_DK = 2056, ES_DV = 2568, ES_IQ = 3080, ES_IK = 3592, ES_IW = 3656;

constexpr size_t MiB = 1u << 20;
constexpr size_t WS_CTL = 0, CTL_ZERO_BYTES = 1 * MiB;
constexpr size_t WS_SSQ = 1 * MiB;
constexpr size_t WS_KSUM = 6 * MiB;
constexpr size_t WS_GT = 11 * MiB + 131072;
constexpr size_t WS_TW = 11 * MiB;
constexpr size_t WS_ROPE = 2 * MiB;
constexpr size_t WS_FL = 3 * MiB;
constexpr size_t WS_MEMK = 4 * MiB;
constexpr size_t WS_IW = 5 * MiB;
constexpr size_t WS_SB = 5 * MiB + 512 * 1024;
constexpr size_t WS_W = 12 * MiB;
constexpr size_t WS_BIG = 60 * MiB;
constexpr size_t WS_HB = 224 * MiB;
constexpr size_t WS_END = 256 * MiB;
constexpr size_t W_FFN1_IN = 0, W_FFN1_OUT = 11 * MiB, W_MIX_IN = 17 * MiB, W_MIX_OUT = 25 * MiB, W_MEMQ = 27 * MiB, W_MEMO = 28 * MiB, W_FFN2_IN = 29 * MiB, W_FFN2_OUT = 40 * MiB, W_MEMQ2 = 46 * MiB, W_MEMO2 = 47 * MiB;
constexpr size_t B_U = 0;
constexpr size_t B_PROJ = 0;
constexpr size_t B_VTF = 120 * MiB;
constexpr size_t B_IKC = 136 * MiB;
constexpr size_t B_VTM = 96 * MiB;
constexpr size_t B_SEL = 156 * MiB;
constexpr size_t B_QP = 0;
constexpr size_t B_QM = 140 * MiB, B_OM = 148 * MiB;
constexpr int CW_TMO = 0, CW_CODE = 1, CW_BAR = 4096;
constexpr int CW_SELQ = 336;
constexpr int CW_VMAX = 320;

constexpr int RING_BYTES = 147456;
constexpr int LDSCTL_OFF = RING_BYTES, MISC_OFF = LDSCTL_OFF + 320;
constexpr int LDS_BYTES = 163840;

#define GAS __attribute__((address_space(1)))
#define LAS __attribute__((address_space(3)))
typedef unsigned short bf16;
typedef unsigned v4u __attribute__((ext_vector_type(4)));
typedef float f32x4 __attribute__((ext_vector_type(4)));
typedef short bf16x8 __attribute__((ext_vector_type(8)));
typedef GAS unsigned gu32;
typedef GAS unsigned long long gu64;
#define RLX_AGENT __ATOMIC_RELAXED, __HIP_MEMORY_SCOPE_AGENT
#define LDS_WAIT() asm volatile("s_waitcnt lgkmcnt(0)" ::: "memory")
#define VM_WAIT() asm volatile("s_waitcnt vmcnt(0)" ::: "memory")
__device__ __forceinline__ unsigned long long rt() { return __builtin_amdgcn_s_memrealtime(); }
__device__ __forceinline__ unsigned f2bf(float f) { unsigned u = __builtin_bit_cast(unsigned, f); return (u + 0x7fffu + ((u >> 16) & 1u)) >> 16; }
__device__ __forceinline__ unsigned pk2(float lo, float hi) { return f2bf(lo) | (f2bf(hi) << 16); }

#define XB_TMO      128
#define XB_XCNT(j)  (256  + 64 * (j))
#define XB_XSUB(j)  (1280 + 64 * (j))
#define XB_XGEN(j)  (2304 + 64 * (j))
#define XB_TOP      3328
#define XB_TOPGEN   3392
#define XCD_BAR_WORDS 3456
#define XB_SPIN_CAP (1u << 18)

__device__ __forceinline__ unsigned xb_ld(unsigned* p)              { return __hip_atomic_load(p, __ATOMIC_RELAXED, __HIP_MEMORY_SCOPE_AGENT); }
__device__ __forceinline__ unsigned xb_add(unsigned* p, unsigned v) { return __hip_atomic_fetch_add(p, v, __ATOMIC_RELAXED, __HIP_MEMORY_SCOPE_AGENT); }
__device__ __forceinline__ unsigned xb_xcc_id() { return (unsigned)__builtin_amdgcn_s_getreg((3 << 11) | 20) & 0xFu; }
#define XB_SPIN(cond, bar) do { unsigned _sp = 0; while (cond) { __builtin_amdgcn_s_sleep(1); \
    if ((++_sp & 255u) == 0u) { if (xb_ld(&(bar)[XB_TMO])) break; if (_sp > XB_SPIN_CAP) { atomicAdd(&(bar)[XB_TMO], 1u); break; } } } } while (0)

struct XcdBarrier {
    unsigned* bar; unsigned x;
    volatile LAS unsigned* st;
};

__device__ __forceinline__ XcdBarrier xcd_barrier_post(unsigned* bar, volatile LAS unsigned* st) {
    XcdBarrier b; b.bar = bar; b.x = xb_xcc_id(); b.st = st;
    if (threadIdx.x == 0) (void)xb_add(&bar[XB_XCNT(b.x)], 1u);
    return b;
}
__device__ __forceinline__ void xcd_barrier_complete(unsigned* bar, unsigned x, unsigned& nloc, unsigned& nx) {
    const unsigned G = gridDim.x * gridDim.y * gridDim.z;
    unsigned sum, cnt, mine, sp = 0u;
    for (;;) {
        sum = 0u; cnt = 0u; mine = 0u;
#pragma unroll
        for (unsigned j = 0; j < 16; ++j) { const unsigned c = xb_ld(&bar[XB_XCNT(j)]); sum += c; cnt += (c > 0u) ? 1u : 0u; mine = (j == x) ? c : mine; }
        if (sum == G) break;
        __builtin_amdgcn_s_sleep(1);
        if ((++sp & 255u) == 0u) { if (xb_ld(&bar[XB_TMO])) break; if (sp > XB_SPIN_CAP) { atomicAdd(&bar[XB_TMO], 1u); break; } }
    }
    nloc = mine > 0u ? mine : 1u; nx = cnt > 0u ? cnt : 1u;
}

__device__ __forceinline__ void xcd_barrier(const XcdBarrier& b) {
    asm volatile("s_waitcnt vmcnt(0)" ::: "memory");
    __syncthreads();
    if (threadIdx.x == 0) {
        unsigned* bar = b.bar;
        __builtin_amdgcn_s_waitcnt(0);
        unsigned nloc = b.st[0], nx = b.st[1];
        if (nloc == 0u) { unsigned x_ = b.x; asm volatile("" : "+s"(x_)); xcd_barrier_complete(bar, x_, nloc, nx); b.st[0] = nloc; b.st[1] = nx; }
        const unsigned old = xb_add(&bar[XB_XSUB(b.x)], 1u);
        const unsigned gen = old / nloc;
        if (old + 1u == (gen + 1u) * nloc) {
            __builtin_amdgcn_fence(__ATOMIC_RELEASE, "agent");
            asm volatile("s_waitcnt vmcnt(0)" ::: "memory");
            const unsigned og = xb_add(&bar[XB_TOP], 1u);
            const unsigned tg = og / nx;
            if (og + 1u == (tg + 1u) * nx) xb_add(&bar[XB_TOPGEN], 1u);
            else XB_SPIN(xb_ld(&bar[XB_TOPGEN]) == tg, bar);
            __builtin_amdgcn_fence(__ATOMIC_ACQUIRE, "agent");
            xb_add(&bar[XB_XGEN(b.x)], 1u);
            asm volatile("s_waitcnt vmcnt(0)" ::: "memory");
        } else {
            XB_SPIN(xb_ld(&bar[XB_XGEN(b.x)]) == gen, bar);
            __builtin_amdgcn_fence(__ATOMIC_ACQUIRE, "agent");
            asm volatile("s_waitcnt vmcnt(0)" ::: "memory");
        }
    }
    __syncthreads();
}

typedef float f32x16 __attribute__((ext_vector_type(16)));
typedef float f32x2_t __attribute__((ext_vector_type(2)));
typedef __bf16 bf16x2_t __attribute__((ext_vector_type(2)));
typedef unsigned u32x2 __attribute__((ext_vector_type(2)));
__device__ __forceinline__ unsigned cvtpk(float lo, float hi) { f32x2_t v = {lo, hi}; bf16x2_t b = __builtin_convertvector(v, bf16x2_t); return __builtin_bit_cast(unsigned, b); }
__device__ __forceinline__ float bflo(unsigned w) { return __uint_as_float(w << 16); }
__device__ __forceinline__ float bfhi(unsigned w) { return __uint_as_float(w & 0xffff0000u); }
__device__ __forceinline__ void unpack8(const v4u& w, float (&x)[8]) { x[0] = bflo(w.x); x[1] = bfhi(w.x); x[2] = bflo(w.y); x[3] = bfhi(w.y); x[4] = bflo(w.z); x[5] = bfhi(w.z); x[6] = bflo(w.w); x[7] = bfhi(w.w); }
__device__ __forceinline__ v4u pack8(const float (&x)[8]) { v4u w; w.x = cvtpk(x[0], x[1]); w.y = cvtpk(x[2], x[3]); w.z = cvtpk(x[4], x[5]); w.w = cvtpk(x[6], x[7]); return w; }
__device__ __forceinline__ unsigned q8pack4(float a, float b, float c, float d) {
    const int ia = (int)__builtin_rintf(a), ib = (int)__builtin_rintf(b), ic = (int)__builtin_rintf(c), id = (int)__builtin_rintf(d);
    return (unsigned)(ia & 255) | ((unsigned)(ib & 255) << 8) | ((unsigned)(ic & 255) << 16) | ((unsigned)(id & 255) << 24); }
__device__ __forceinline__ float wave_sum(float v) { v += shx<1>(v); v += shx<2>(v); v += shx<4>(v); v += shx<8>(v); v += shx<16>(v); return sh32_sum(v); }
__device__ __forceinline__ float wave_max(float v) { v = fmaxf(v, shx<1>(v)); v = fmaxf(v, shx<2>(v)); v = fmaxf(v, shx<4>(v)); v = fmaxf(v, shx<8>(v)); v = fmaxf(v, shx<16>(v)); return sh32_max(v); }
__device__ __forceinline__ int crow(int r, int hi) { return (r & 3) + 8 * (r >> 2) + 4 * hi; }

__device__ __forceinline__ int even_map(int n) {
    if (n < 512) return ES_FQ + n;
    if (n < 1024) return ES_DQ + (n - 512);
    if (n < 1536) return ES_FK + (n - 1024);
    if (n < 2048) return ES_DK + (n - 1536);
    if (n < 2560) return ES_FV + (n - 2048);
    if (n < 3072) return ES_DV + (n - 2560);
    if (n < 3584) return ES_IQ + (n - 3072);
    if (n < 3648) return ES_IK + (n - 3584);
    return -1;
}
__device__ __forceinline__ void conv_item(const float* W, int K, int Nsrc, int nblk, const float* gain, bf16* WT, int mode, LAS float* scr, int item, int lane) {
    const int kb = item / nblk, nb = item % nblk, k0 = 32 * kb, n0 = 128 * nb;
    const int n = n0 + 4 * (lane & 31);
    int sc;
    if (mode == 0) sc = n; else if (mode == 1) { const int T = n >> 8, hf = (n >> 7) & 1, j = n & 127; sc = hf * FF + 128 * T + j; } else sc = even_map(n);
    f32x4 v[16];
#pragma unroll
    for (int i = 0; i < 16; ++i) { const int kk = 2 * i + (lane >> 5); v[i] = (f32x4){0.f, 0.f, 0.f, 0.f};
        if (sc >= 0) v[i] = *(const GAS f32x4*)(W + (size_t)(k0 + kk) * Nsrc + sc); }
#pragma unroll
    for (int i = 0; i < 16; ++i) { const int kk = 2 * i + (lane >> 5); const float g = gain ? gain[k0 + kk] : 1.0f;
        *(LAS f32x4*)(scr + kk * 132 + 4 * (lane & 31)) = v[i] * g; }
    LDS_WAIT(); asm volatile("" ::: "memory");
    const int c = lane & 3;
#pragma unroll
    for (int j = 0; j < 8; ++j) { const int nn = (lane >> 2) + 16 * j; const LAS float* s = scr + (8 * c) * 132 + nn;
        v4u o; o.x = cvtpk(s[0 * 132], s[1 * 132]); o.y = cvtpk(s[2 * 132], s[3 * 132]); o.z = cvtpk(s[4 * 132], s[5 * 132]); o.w = cvtpk(s[6 * 132], s[7 * 132]);
        *(GAS v4u*)(WT + (size_t)(n0 + nn) * K + k0 + 8 * c) = o; }
    LDS_WAIT(); asm volatile("" ::: "memory");
}
__device__ __forceinline__ void conv_q8_item(const float* W, const float* gain, unsigned char* W8, float* sb, LAS float* red, int item, int wave, int lane) {
    const int n = 32 * item + (lane & 31), kq = 2 * wave + (lane >> 5);
    const int T = n >> 8, hf = (n >> 7) & 1, jn = n & 127, sc = hf * FF + 128 * T + jn;
    const float* wp = W + (size_t)(64 * kq) * FF2 + sc; const float* gp = gain + 64 * kq;
    float v[64]; float mx = 0.f;
#pragma unroll
    for (int k = 0; k < 64; ++k) v[k] = *(const GAS float*)(wp + (size_t)k * FF2);
#pragma unroll
    for (int k = 0; k < 64; ++k) { v[k] *= gp[k]; mx = fmaxf(mx, fabsf(v[k])); }
    mx = sh32_max(mx);
    __syncthreads();
    if (lane < 32) red[wave * 32 + lane] = mx;
    __syncthreads();
    mx = red[lane & 31];
#pragma unroll
    for (int w = 1; w < 8; ++w) mx = fmaxf(mx, red[w * 32 + (lane & 31)]);
    mx = fmaxf(mx, 1e-30f);
    const float inv = 127.0f / mx;
    unsigned char* op = W8 + (size_t)n * DM + 64 * kq;
#pragma unroll
    for (int k0 = 0; k0 < 64; k0 += 16) {
        v4u o; o.x = q8pack4(v[k0] * inv, v[k0 + 1] * inv, v[k0 + 2] * inv, v[k0 + 3] * inv); o.y = q8pack4(v[k0 + 4] * inv, v[k0 + 5] * inv, v[k0 + 6] * inv, v[k0 + 7] * inv);
        o.z = q8pack4(v[k0 + 8] * inv, v[k0 + 9] * inv, v[k0 + 10] * inv, v[k0 + 11] * inv); o.w = q8pack4(v[k0 + 12] * inv, v[k0 + 13] * inv, v[k0 + 14] * inv, v[k0 + 15] * inv);
        *(GAS v4u*)(op + k0) = o; }
    if (wave == 0 && lane < 32) sb[n] = mx * (1.0f / 127.0f);
}
struct InPtrs { const float* p[26]; };
constexpr int INTAB_OFF = LDSCTL_OFF + 1024;
struct InTab { LAS unsigned char* ldsbase;
    __device__ __forceinline__ const float* get(int k) const { const u32x2 v = *(const LAS u32x2*)(ldsbase + INTAB_OFF + 8 * k);
        const unsigned lo = (unsigned)__builtin_amdgcn_readfirstlane((int)v.x), hi = (unsigned)__builtin_amdgcn_readfirstlane((int)v.y);
        return (const float*)(((unsigned long long)hi << 32) | lo); } };
__device__ __forceinline__ void conv_weights(const InTab& in, unsigned char* ws, int L, int mask, LAS unsigned char* lds, int gw, int NGW, int wave, int lane) {
    LAS float* scr = (LAS float*)(lds + wave * 17408);
    unsigned char* Wr = ws + WS_W;
    const bool even = (L & 1) == 0;
    const int mixN = even ? EVEN_NP : ODD_N, mixSrc = even ? EVEN_SRC : ODD_N;
    const int I_FIN = (DM / 32) * (FF2 / 128), I_FOUT = (FF / 32) * (DM / 128), I_MIN = (DM / 32) * (mixN / 128), I_MOUT = (DM / 32) * (DM / 128), I_MQ = (DM / 32) * (MEMW / 128), I_MO = (MEMW / 32) * (DM / 128);
    const int n0 = 0, n1 = (mask & 2) ? I_FOUT : 0,   n2 = (mask & 4) ? I_MIN : 0, n3 = (mask & 8) ? I_MOUT : 0, n4 = (mask & 16) ? I_MQ : 0, n5 = (mask & 32) ? I_MO : 0,
              n6 = 0, n7 = (mask & 128) ? I_FOUT : 0;
    const int NITEMS = n0 + n1 + n2 + n3 + n4 + n5 + n6 + n7;
    for (int it = gw; it < NITEMS; it += NGW) {
        int r = it;
        if (r < n1) { conv_item(in.get(4) + (size_t)L * FF * DM, FF, DM, DM / 128, nullptr, (bf16*)(Wr + W_FFN1_OUT), 0, scr, r, lane); continue; } r -= n1;
        if (r < n7) { conv_item(in.get(25) + (size_t)L * FF * DM, FF, DM, DM / 128, nullptr, (bf16*)(Wr + W_FFN2_OUT), 0, scr, r, lane); continue; } r -= n7;
        if (r < n2) { conv_item(even ? in.get(6) : in.get(12), DM, mixSrc, mixN / 128, in.get(5) + (size_t)L * DM, (bf16*)(Wr + W_MIX_IN), even ? 2 : 0, scr, r, lane); continue; } r -= n2;
        if (r < n3) { conv_item(in.get(15) + (size_t)L * DM * DM, DM, DM, DM / 128, nullptr, (bf16*)(Wr + W_MIX_OUT), 0, scr, r, lane); continue; } r -= n3;
        if (r < n4) { conv_item(in.get(18) + (size_t)L * DM * MEMW, DM, MEMW, MEMW / 128, in.get(16) + (size_t)L * DM, (bf16*)(Wr + (L ? W_MEMQ2 : W_MEMQ)), 0, scr, r, lane); continue; } r -= n4;
        conv_item(in.get(22) + (size_t)L * MEMW * DM, MEMW, DM, DM / 128, nullptr, (bf16*)(Wr + (L ? W_MEMO2 : W_MEMO)), 0, scr, r, lane);
    }
}
__device__ __forceinline__ void conv_q8_weights(const InTab& in, unsigned char* ws, int L, int mask, LAS unsigned char* lds, int wg, int nwg, int wave, int lane) {
    unsigned char* Wr = ws + WS_W; float* sb1 = (float*)(ws + WS_SB); float* sb2 = sb1 + 8192;
    const int NI = FF2 / 32;
    const int n0 = (mask & 1) ? NI : 0, n6 = (mask & 64) ? NI : 0;
    for (int it = wg; it < n0 + n6; it += nwg) {
        if (it < n0) conv_q8_item(in.get(3) + (size_t)L * DM * FF2, in.get(2) + (size_t)L * DM, Wr + W_FFN1_IN, sb1, (LAS float*)lds, it, wave, lane);
        else         conv_q8_item(in.get(24) + (size_t)L * DM * FF2, in.get(23) + (size_t)L * DM, Wr + W_FFN2_IN, sb2, (LAS float*)lds, it - n0, wave, lane);
    }
    __syncthreads();
}
__device__ __forceinline__ void copy_x(const float* x, unsigned char* HQ, float* sa, bf16* HB, float* ssq0, int gw, int NGW, int lane) {
    for (int m = gw; m < S; m += NGW) {
        const GAS f32x4* xr = (const GAS f32x4*)(x + (size_t)m * DM) + lane;
        GAS u32x2* hb = (GAS u32x2*)(HB + (size_t)m * DM) + lane;
        float s = 0.f, am = 0.f; f32x4 v[4];
#pragma unroll
        for (int j = 0; j < 4; ++j) { v[j] = xr[64 * j]; s += (v[j].x * v[j].x + v[j].y * v[j].y) + (v[j].z * v[j].z + v[j].w * v[j].w);
            am = fmaxf(fmaxf(am, fmaxf(fabsf(v[j].x), fabsf(v[j].y))), fmaxf(fabsf(v[j].z), fabsf(v[j].w)));
            u32x2 w; w.x = cvtpk(v[j].x, v[j].y); w.y = cvtpk(v[j].z, v[j].w); hb[64 * j] = w; }
        s = wave_sum(s); am = fmaxf(wave_max(am), 1e-30f);
        const float inv = 127.0f / am;
#pragma unroll
        for (int j = 0; j < 4; ++j) *(GAS unsigned*)(HQ + (size_t)m * DM + 4 * (lane + 64 * j)) = q8pack4(v[j].x * inv, v[j].y * inv, v[j].z * inv, v[j].w * inv);
        if (lane < 16) ssq0[(size_t)m * 16 + lane] = (lane == 0) ? s : 0.f;
        if (lane == 0) sa[m] = am * (1.0f / 127.0f) * rsqrtf(s * (1.0f / DM) + RMS_EPS);
    }
}
__device__ __forceinline__ void quant_rows(const bf16* HB, unsigned char* HQ, float* sa, int gw, int NGW, int lane) {
    for (int m = gw; m < S; m += NGW) {
        const GAS u32x2* hb = (const GAS u32x2*)(HB + (size_t)m * DM) + lane;
        float v[16]; float am = 0.f, s = 0.f;
#pragma unroll
        for (int j = 0; j < 4; ++j) { const u32x2 w = hb[64 * j]; v[4 * j] = bflo(w.x); v[4 * j + 1] = bfhi(w.x); v[4 * j + 2] = bflo(w.y); v[4 * j + 3] = bfhi(w.y);
            s += (v[4 * j] * v[4 * j] + v[4 * j + 1] * v[4 * j + 1]) + (v[4 * j + 2] * v[4 * j + 2] + v[4 * j + 3] * v[4 * j + 3]);
            am = fmaxf(fmaxf(am, fmaxf(fabsf(v[4 * j]), fabsf(v[4 * j + 1]))), fmaxf(fabsf(v[4 * j + 2]), fabsf(v[4 * j + 3]))); }
        am = fmaxf(wave_max(am), 1e-30f); s = wave_sum(s);
        const float inv = 127.0f / am;
#pragma unroll
        for (int j = 0; j < 4; ++j) *(GAS unsigned*)(HQ + (size_t)m * DM + 4 * (lane + 64 * j)) = q8pack4(v[4 * j] * inv, v[4 * j + 1] * inv, v[4 * j + 2] * inv, v[4 * j + 3] * inv);
        if (lane == 0) sa[m] = am * (1.0f / 127.0f) * rsqrtf(s * (1.0f / DM) + RMS_EPS);
    }
}
__device__ __forceinline__ void rope_tables(float* cosT, float* sinT, int gtid, int nthreads) {
    for (int idx = gtid; idx < S * 8; idx += nthreads) {
        const int t = idx >> 3, j = idx & 7;
        float inv;
        switch (j) { case 0: inv = 1.0f; break; case 1: inv = 0.193922743f; break; case 2: inv = 0.0376060307f; break; case 3: inv = 0.00729266461f; break;
                     case 4: inv = 0.00141421356f; break; case 5: inv = 0.000274248188f; break; case 6: inv = 5.3182961e-05f; break; default: inv = 1.03133862e-05f; break; }
        const float ang = (float)t * inv;
        const float kq = __builtin_rintf(ang * 0.63661977236758134f);
        float r = ang - kq * 1.5703125f; r = r - kq * 0.00048351287841796875f; r = r - kq * 3.1391647326017846e-07f;
        const float r2 = r * r;
        float sp = 2.7557319e-6f; sp = sp * r2 - 1.9841270e-4f; sp = sp * r2 + 8.3333333e-3f; sp = sp * r2 - 1.6666667e-1f; const float sn = r + r * r2 * sp;
        float cp = -2.7557319e-7f; cp = cp * r2 + 2.4801587e-5f; cp = cp * r2 - 1.3888889e-3f; cp = cp * r2 + 4.1666667e-2f; cp = cp * r2 - 0.5f; const float cs = 1.0f + r2 * cp;
        const int q = ((int)kq) & 3;
        const float sv = (q == 0) ? sn : (q == 1) ? cs : (q == 2) ? -sn : -cs;
        const float cv = (q == 0) ? cs : (q == 1) ? -sn : (q == 2) ? -cs : sn;
        cosT[idx] = cv; sinT[idx] = sv;
    }
}
__device__ __forceinline__ void mem_kv(const InTab& in, unsigned char* ws, LAS unsigned char* lds, int unit, int tid, int wave, int lane) {
    LAS float* memn = (LAS float*)lds;
    LAS f32x4* part = (LAS f32x4*)(lds + 16 * 1028 * 4);
    bf16* memK = (bf16*)(ws + WS_MEMK); bf16* memVt = (bf16*)(ws + WS_MEMK + 256 * 1024);
    const int L = unit >> 7, rb = (unit >> 3) & 15, cb = unit & 7;
    const float* gm = in.get(17) + (size_t)L * DM; const float* wkv = in.get(19) + (size_t)L * DM * 512; const float* kn = in.get(21) + (size_t)L * 64;
    __syncthreads();
    for (int i = 0; i < 2; ++i) { const int r = wave * 2 + i; const float* mrow = in.get(1) + (size_t)(rb * 16 + r) * DM;
        f32x4 v[4]; float s = 0.f;
#pragma unroll
        for (int j = 0; j < 4; ++j) { v[j] = *((const GAS f32x4*)mrow + lane + 64 * j); s += (v[j].x * v[j].x + v[j].y * v[j].y) + (v[j].z * v[j].z + v[j].w * v[j].w); }
        const float rstd = rsqrtf(wave_sum(s) * (1.0f / DM) + RMS_EPS);
#pragma unroll
        for (int j = 0; j < 4; ++j) { const f32x4 g = *((const GAS f32x4*)gm + lane + 64 * j); *(LAS f32x4*)(memn + r * 1028 + 4 * (lane + 64 * j)) = v[j] * rstd * g; } }
    __syncthreads();
    {
        const int cl = lane & 15, sl = wave * 4 + (lane >> 4);
        const float* wp = wkv + (size_t)(4 * sl) * 512 + cb * 64 + cl * 4;
        f32x4 acc[16];
#pragma unroll
        for (int r = 0; r < 16; ++r) acc[r] = (f32x4){0.f, 0.f, 0.f, 0.f};
#pragma unroll 2
        for (int j = 0; j < 8; ++j) {
            const f32x4 w0 = *(const GAS f32x4*)(wp + (size_t)(128 * j) * 512), w1 = *(const GAS f32x4*)(wp + (size_t)(128 * j + 1) * 512),
                        w2 = *(const GAS f32x4*)(wp + (size_t)(128 * j + 2) * 512), w3 = *(const GAS f32x4*)(wp + (size_t)(128 * j + 3) * 512);
#pragma unroll
            for (int r = 0; r < 16; ++r) { const f32x4 mv = *(const LAS f32x4*)(memn + r * 1028 + 4 * (sl + 32 * j));
                acc[r] = acc[r] + w0 * mv.x + w1 * mv.y + w2 * mv.z + w3 * mv.w; }
        }
#pragma unroll
        for (int r = 0; r < 16; ++r) {
#pragma unroll
            for (int c = 0; c < 4; ++c) { float v = acc[r][c]; v += shx<16>(v); v = sh32_sum(v); acc[r][c] = v; }
            if (lane < 16) part[(wave * 16 + r) * 16 + cl] = acc[r]; }
    }
    __syncthreads();
    if (tid < 256) {
        const int r = tid >> 4, c4 = (tid & 15) * 4;
        f32x4 acc = part[tid];
#pragma unroll
        for (int w = 1; w < 8; ++w) acc = acc + part[w * 256 + tid];
        const int tok = rb * 16 + r;
        if (cb < 4) {
            float ss = (acc.x * acc.x + acc.y * acc.y) + (acc.z * acc.z + acc.w * acc.w);
            ss += shx<1>(ss); ss += shx<2>(ss); ss += shx<4>(ss); ss += shx<8>(ss);
            const float rs = rsqrtf(ss * (1.0f / 64.0f) + RMS_EPS);
            u32x2 w; w.x = cvtpk(acc.x * rs * kn[c4], acc.y * rs * kn[c4 + 1]); w.y = cvtpk(acc.z * rs * kn[c4 + 2], acc.w * rs * kn[c4 + 3]);
            *(GAS u32x2*)(memK + (size_t)L * 65536 + (size_t)tok * 256 + cb * 64 + c4) = w;
        } else {
            const int c = (cb - 4) * 64 + c4; bf16* vp = memVt + (size_t)L * 65536 + (size_t)c * 256 + tok;
            vp[0] = (bf16)(cvtpk(acc.x, 0.f) & 0xffffu); vp[256] = (bf16)(cvtpk(acc.y, 0.f) & 0xffffu); vp[512] = (bf16)(cvtpk(acc.z, 0.f) & 0xffffu); vp[768] = (bf16)(cvtpk(acc.w, 0.f) & 0xffffu);
        }
    }
}

__device__ __forceinline__ void head_norm8(float (&x)[8], const float* gain, int lane) {
    float ss = 0.f;
#pragma unroll
    for (int j = 0; j < 8; ++j) ss += x[j] * x[j];
    ss += shx<1>(ss); ss += shx<2>(ss); ss += shx<4>(ss);
    const float r = rsqrtf(ss * (1.0f / 64.0f) + RMS_EPS);
    const int d0 = 8 * (lane & 7);
#pragma unroll
    for (int j = 0; j < 8; ++j) x[j] = x[j] * r * gain[d0 + j];
}
__device__ __forceinline__ void rope8(float (&x)[8], const float (&cs)[8], const float (&sn)[8], int lane) {
    const int sub = lane & 7;
#pragma unroll
    for (int j = 0; j < 8; ++j) {
        const float other = shx<1>(x[j]);
        if (sub == 0) x[j] = x[j] * cs[j] - other * sn[j];
        else if (sub == 1) x[j] = x[j] * cs[j] + other * sn[j];
    }
}
__device__ __forceinline__ float sh32_get(float v, int lane) { auto r = __builtin_amdgcn_permlane32_swap(__float_as_uint(v), __float_as_uint(v), false, false); return __uint_as_float((lane < 32) ? r[1] : r[0]); }
__device__ __forceinline__ float reduce_scatter64(float (&v)[64], int lane) {
    { const bool up = (lane & 32) != 0;
#pragma unroll
      for (int j = 0; j < 32; ++j) { const float send = up ? v[j] : v[j + 32], keep = up ? v[j + 32] : v[j]; v[j] = keep + sh32_get(send, lane); } }
    { const bool up = (lane & 16) != 0;
#pragma unroll
      for (int j = 0; j < 16; ++j) { const float send = up ? v[j] : v[j + 16], keep = up ? v[j + 16] : v[j]; v[j] = keep + shx<16>(send); } }
    { const bool up = (lane & 8) != 0;
#pragma unroll
      for (int j = 0; j < 8; ++j) { const float send = up ? v[j] : v[j + 8], keep = up ? v[j + 8] : v[j]; v[j] = keep + shx<8>(send); } }
    { const bool up = (lane & 4) != 0;
#pragma unroll
      for (int j = 0; j < 4; ++j) { const float send = up ? v[j] : v[j + 4], keep = up ? v[j + 4] : v[j]; v[j] = keep + shx<4>(send); } }
    { const bool up = (lane & 2) != 0;
#pragma unroll
      for (int j = 0; j < 2; ++j) { const float send = up ? v[j] : v[j + 2], keep = up ? v[j + 2] : v[j]; v[j] = keep + shx<2>(send); } }
    { const bool up = (lane & 1) != 0; const float send = up ? v[0] : v[1], keep = up ? v[1] : v[0]; v[0] = keep + shx<1>(send); }
    return v[0];
}
__device__ __forceinline__ void post_even(const InTab& in, unsigned char* ws, const bf16* HBp, const float* ssq, LAS unsigned char* lds, int G, int tid, int wave, int lane) {
    float* Flocal = (float*)(ws + WS_FL); float* Btot = Flocal + S * 8; float* IW = (float*)(ws + WS_IW);
    const float* bfg = in.get(7);
    LAS f32x4* Tw = (LAS f32x4*)lds;
    LAS float* lf = (LAS float*)(lds + 65536);
    { const GAS f32x4* src = (const GAS f32x4*)(ws + WS_TW);
#pragma unroll
      for (int i = 0; i < 8; ++i) Tw[tid + 512 * i] = src[tid + 512 * i]; }
    __syncthreads();
    for (int u = blockIdx.x; u < S / 64; u += G) {
        const int t0 = u * 64, tw0 = t0 + wave * 8;
        { const bf16* vr = (const bf16*)(ws + WS_BIG + B_PROJ) + (size_t)tw0 * EVEN_NP + EC_DV + lane * 8; float vm = 0.f;
#pragma unroll
          for (int i = 0; i < 8; ++i) { const v4u w = *(const GAS v4u*)(vr + (size_t)i * EVEN_NP); float x[8]; unpack8(w, x);
#pragma unroll
              for (int j = 0; j < 8; ++j) vm = fmaxf(vm, fabsf(x[j])); }
          vm = fmaxf(vm, shx<1>(vm)); vm = fmaxf(vm, shx<2>(vm)); vm = fmaxf(vm, shx<4>(vm));
          if ((lane & 7) == 0) atomicMax((unsigned*)(ws + WS_CTL) + CW_VMAX + (lane >> 3), __float_as_uint(vm)); }
#pragma unroll 1
        for (int rb = 0; rb < 2; ++rb) {
            float acc[64];
#pragma unroll
            for (int j = 0; j < 64; ++j) acc[j] = 0.f;
#pragma unroll
            for (int q = 0; q < 4; ++q) {
                f32x4 hv[4];
#pragma unroll
                for (int r = 0; r < 4; ++r) { const u32x2 w = *((const GAS u32x2*)(HBp + (size_t)(tw0 + rb * 4 + r) * DM) + lane + 64 * q); hv[r][0] = bflo(w.x); hv[r][1] = bfhi(w.x); hv[r][2] = bflo(w.y); hv[r][3] = bfhi(w.y); }
#pragma unroll
                for (int e = 0; e < 4; ++e)
#pragma unroll
                    for (int c = 0; c < 4; ++c) { const f32x4 w = Tw[((q * 4 + e) * 4 + c) * 64 + lane];
#pragma unroll
                        for (int r = 0; r < 4; ++r) { acc[r * 16 + 4 * c + 0] += hv[r][e] * w[0]; acc[r * 16 + 4 * c + 1] += hv[r][e] * w[1]; acc[r * 16 + 4 * c + 2] += hv[r][e] * w[2]; acc[r * 16 + 4 * c + 3] += hv[r][e] * w[3]; } }
            }
            const float zs = reduce_scatter64(acc, lane);
            const int rl = wave * 8 + rb * 4 + (lane >> 4), t = t0 + rl, j = lane & 15;
            const float z = zs * pg8::row_rstd(ssq, t);
            if (j < 8) { const float zz = z + bfg[j]; lf[rl * 8 + j] = (zz > 15.f) ? -expf(-zz) : -log1pf(expf(-zz)); }
            else IW[(size_t)t * 8 + (j - 8)] = z * 0.044194173824159216f;
        }
        __syncthreads();
        {
            float v = lf[lane * 8 + wave];
#pragma unroll
            for (int o = 1; o < 64; o <<= 1) { const float up = __int_as_float(__builtin_amdgcn_ds_bpermute(((lane - o) & 63) << 2, __float_as_int(v))); if (lane >= o) v += up; }
            Flocal[(size_t)(t0 + lane) * 8 + wave] = v;
            if (lane == 63) Btot[u * 8 + wave] = v;
        }
        __syncthreads();
    }
}

__device__ __forceinline__ void post_odd(unsigned char* ws, LAS unsigned char* lds, int G, int tid) {
    const bf16* Kb = (const bf16*)(ws + WS_BIG + B_PROJ) + (size_t)S * DM; float* ksum = (float*)(ws + WS_KSUM);
    LAS float* red = (LAS float*)lds;
    for (int u = blockIdx.x; u < 256; u += G) {
        const int n = u >> 2, cg = u & 3, c2 = tid & 127, rg = tid >> 7;
        const bf16* kp = Kb + (size_t)(n * 256 + rg * 64) * DM + cg * 256 + c2 * 2;
        float s0 = 0.f, s1 = 0.f;
#pragma unroll 16
        for (int r = 0; r < 64; ++r) { const unsigned w = *(const GAS unsigned*)(kp + (size_t)r * DM); s0 += bflo(w); s1 += bfhi(w); }
        __syncthreads();
        red[rg * 256 + c2 * 2] = s0; red[rg * 256 + c2 * 2 + 1] = s1;
        __syncthreads();
        if (tid < 256) ksum[(size_t)n * 1024 + cg * 256 + tid] = (red[tid] + red[256 + tid]) + (red[512 + tid] + red[768 + tid]);
    }
}

constexpr int KV_K_BYTES = 8192, KV_VT_PITCH = 136, KV_BUF_BYTES = KV_K_BYTES + 64 * KV_VT_PITCH;
struct KVRegs { v4u k, v; };
__device__ __forceinline__ void kv_load(KVRegs& r, const bf16* Kp, size_t kpitch, const bf16* Vtp, size_t vtpitch, int key0, int tid) {
    r.k = *(const GAS v4u*)(Kp + (size_t)(key0 + (tid & 63)) * kpitch + (tid >> 6) * 8);
    r.v = *(const GAS v4u*)(Vtp + (size_t)(tid >> 3) * vtpitch + key0 + (tid & 7) * 8);
}
__device__ __forceinline__ void kv_store(const KVRegs& r, LAS unsigned char* buf, int tid) {
    *(LAS v4u*)(buf + ((tid >> 6) * 64 + (tid & 63)) * 16) = r.k;
    LAS unsigned char* vp = buf + KV_K_BYTES + (tid >> 3) * KV_VT_PITCH + (tid & 7) * 16;
    *(LAS u32x2*)vp = (u32x2){r.v.x, r.v.y}; *(LAS u32x2*)(vp + 8) = (u32x2){r.v.z, r.v.w};
}
struct AttnAcc { float m, l; f32x16 o0, o1; };
__device__ __forceinline__ void attn_init(AttnAcc& a) { a.m = -INFINITY; a.l = 0.f;
#pragma unroll
    for (int r = 0; r < 16; ++r) { a.o0[r] = 0.f; a.o1[r] = 0.f; } }
template <int CHS = 1024>
__device__ __forceinline__ void attn_scores(f32x16& p0, f32x16& p1, const LAS unsigned char* buf, const bf16x8 (&qf)[4], int lane) {
    const int r32 = lane & 31, hi = lane >> 5;
#pragma unroll
    for (int r = 0; r < 16; ++r) { p0[r] = 0.f; p1[r] = 0.f; }
#pragma unroll
    for (int ks = 0; ks < 4; ++ks) {
        const bf16x8 k0 = *(const LAS bf16x8*)(buf + (2 * ks + hi) * CHS + r32 * 16);
        const bf16x8 k1 = *(const LAS bf16x8*)(buf + (2 * ks + hi) * CHS + (32 + r32) * 16);
        p0 = __builtin_amdgcn_mfma_f32_32x32x16_bf16(k0, qf[ks], p0, 0, 0, 0);
        p1 = __builtin_amdgcn_mfma_f32_32x32x16_bf16(k1, qf[ks], p1, 0, 0, 0);
    }
}
template <int VTP = KV_VT_PITCH, int VOFF = KV_K_BYTES>
__device__ __forceinline__ void attn_update(AttnAcc& a, f32x16& p0, f32x16& p1, const LAS unsigned char* buf, int lane, const float sc = 1.0f) {
    const int r32 = lane & 31, hi = lane >> 5;
    float mx = fmaxf(p0[0], p1[0]);
#pragma unroll
    for (int r = 1; r < 16; ++r) mx = fmaxf(mx, fmaxf(p0[r], p1[r]));
    mx = sh32_max(mx) * sc;
    if (__builtin_amdgcn_ballot_w64(!(mx - a.m <= 8.0f)) != 0ull) {
        const float mnew = fmaxf(a.m, mx);
        const float msafe = (mnew == -INFINITY) ? 0.f : mnew;
        const float alpha = __builtin_amdgcn_exp2f(a.m - msafe);
        a.l *= alpha; a.m = mnew;
#pragma unroll
        for (int r = 0; r < 16; ++r) { a.o0[r] *= alpha; a.o1[r] *= alpha; }
    }
    const float msafe = (a.m == -INFINITY) ? 0.f : a.m;
    float sum = 0.f;
#pragma unroll
    for (int r = 0; r < 16; ++r) { p0[r] = __builtin_amdgcn_exp2f(__builtin_fmaf(p0[r], sc, -msafe)); p1[r] = __builtin_amdgcn_exp2f(__builtin_fmaf(p1[r], sc, -msafe)); sum += p0[r] + p1[r]; }
    a.l += sum;
    const LAS unsigned char* vt = buf + VOFF + r32 * VTP + hi * 8;
#pragma unroll
    for (int half = 0; half < 2; ++half) {
#pragma unroll
        for (int s = 0; s < 2; ++s) {
            v4u pw;
            if (half == 0) { pw.x = cvtpk(p0[8 * s + 0], p0[8 * s + 1]); pw.y = cvtpk(p0[8 * s + 2], p0[8 * s + 3]); pw.z = cvtpk(p0[8 * s + 4], p0[8 * s + 5]); pw.w = cvtpk(p0[8 * s + 6], p0[8 * s + 7]); }
            else           { pw.x = cvtpk(p1[8 * s + 0], p1[8 * s + 1]); pw.y = cvtpk(p1[8 * s + 2], p1[8 * s + 3]); pw.z = cvtpk(p1[8 * s + 4], p1[8 * s + 5]); pw.w = cvtpk(p1[8 * s + 6], p1[8 * s + 7]); }
            const bf16x8 pb = __builtin_bit_cast(bf16x8, pw);
            const int kb = (32 * half + 16 * s) * 2;
#pragma unroll
            for (int d0 = 0; d0 < 2; ++d0) {
                const u32x2 lo = *(const LAS u32x2*)(vt + d0 * 32 * VTP + kb), hi2 = *(const LAS u32x2*)(vt + d0 * 32 * VTP + kb + 16);
                const bf16x8 va = __builtin_bit_cast(bf16x8, (v4u){lo.x, lo.y, hi2.x, hi2.y});
                if (d0 == 0) a.o0 = __builtin_amdgcn_mfma_f32_32x32x16_bf16(va, pb, a.o0, 0, 0, 0);
                else         a.o1 = __builtin_amdgcn_mfma_f32_32x32x16_bf16(va, pb, a.o1, 0, 0, 0);
            }
        }
    }
}
__device__ __forceinline__ void attn_store(const AttnAcc& a, bf16* orow, int lane) {
    const int hi = lane >> 5;
    float l = sh32_sum(a.l);
    const float inv = (l > 0.f) ? 1.0f / l : 0.f;
#pragma unroll
    for (int g = 0; g < 4; ++g) {
        u32x2 w0, w1;
        w0.x = cvtpk(a.o0[4 * g] * inv, a.o0[4 * g + 1] * inv); w0.y = cvtpk(a.o0[4 * g + 2] * inv, a.o0[4 * g + 3] * inv);
        w1.x = cvtpk(a.o1[4 * g] * inv, a.o1[4 * g + 1] * inv); w1.y = cvtpk(a.o1[4 * g + 2] * inv, a.o1[4 * g + 3] * inv);
        *(GAS u32x2*)(orow + 8 * g + 4 * hi) = w0; *(GAS u32x2*)(orow + 32 + 8 * g + 4 * hi) = w1;
    }
}
__device__ __forceinline__ void load_q(bf16x8 (&qf)[4], const bf16* qrow, int lane) {
    const int hi = lane >> 5;
#pragma unroll
    for (int ks = 0; ks < 4; ++ks) qf[ks] = *(const GAS bf16x8*)(qrow + 16 * ks + 8 * hi);
}

constexpr int CW_FOXQ = 64;
__device__ __forceinline__ void fox_phase(const InTab& in, unsigned char* ws, LAS unsigned char* lds, int G, int tid, int wave, int lane, bf16* obase, size_t opitch, int qword) {
    bf16* proj = (bf16*)(ws + WS_BIG + B_PROJ); const bf16* VtF = (const bf16*)(ws + WS_BIG + B_VTF);
    const float* Flocal = (const float*)(ws + WS_FL); const float* Btot = Flocal + S * 8;
    unsigned* qctr = (unsigned*)(ws + WS_CTL) + qword;
    LAS unsigned char* kvb = lds; LAS float* kbt = (LAS float*)(lds + 2 * KV_BUF_BYTES); LAS float* bt = (LAS float*)(lds + 2 * KV_BUF_BYTES + 65536); LAS float* Et = bt + 272;
    LAS int* misc = (LAS int*)(Et + 272);
    const int r32 = lane & 31, hi = lane >> 5;
    if (wave == 0) { const float gq = wave_max(fabsf(in.get(8)[lane])), gk = wave_max(fabsf(in.get(9)[lane])); if (lane == 0) { ((LAS float*)misc)[2] = gq; ((LAS float*)misc)[3] = gk; } }
    __syncthreads();
    const float THR = 2.0f * (0.125f * LOG2E * 64.0f * 1.02f) * ((LAS float*)misc)[2] * ((LAS float*)misc)[3] + 32.0f;
    for (;;) {
        __syncthreads();
        if (tid == 0) misc[0] = (int)atomicAdd(qctr, 1u);
        __syncthreads();
        const int u = misc[0];
        if (u >= 512) break;
        const int QB = 63 - (u >> 3), h = u & 7, q0 = QB * 256, nt = 4 * (QB + 1);
        for (int j = tid; j < nt; j += NTHREADS) bt[j] = Btot[j * 8 + h];
        if (tid == 0) misc[1] = 4 * QB;
        __syncthreads();
        for (int j = tid; j <= nt; j += NTHREADS) { float e = 0.f;
            if (j <= 4 * QB) { for (int i = 4 * QB - 1; i >= j; --i) e -= bt[i]; } else { for (int i = 4 * QB; i < j; ++i) e += bt[i]; }
            Et[j] = e; }
        __syncthreads();
        for (int j = tid; j < 4 * QB; j += NTHREADS) if (Et[j + 1] * LOG2E <= THR) atomicMin((int*)&misc[1], j);
        __syncthreads();
        const int t_start = misc[1], s0 = 64 * t_start;
        for (int s = s0 + tid; s < q0 + 256; s += NTHREADS) kbt[s - s0] = -(Et[s >> 6] + Flocal[(size_t)s * 8 + h]) * LOG2E;
        const int qrow = q0 + wave * 32 + r32;
        bf16x8 qf[4]; load_q(qf, proj + (size_t)qrow * EVEN_NP + EC_FQ + h * 64, lane);
        AttnAcc a; attn_init(a);
        const bf16* Kp = proj + EC_FK + h * 64; const bf16* Vtp = VtF + (size_t)h * 64 * S;
        KVRegs kr; kv_load(kr, Kp, EVEN_NP, Vtp, S, s0, tid); kv_store(kr, kvb, tid);
        __syncthreads();
        const float kbw = kbt[q0 + wave * 32 - s0];
        for (int t = t_start; t < nt; ++t) {
            LAS unsigned char* cur = kvb + ((t - t_start) & 1) * KV_BUF_BYTES;
            if (t + 1 < nt) kv_load(kr, Kp, EVEN_NP, Vtp, S, (t + 1) * 64, tid);
            const int key0 = t * 64;
            const bool vis = key0 <= q0 + wave * 32 + 31;
            const bool live = (key0 + 63 >= q0) || (kbw - kbt[key0 + 63 - s0] <= THR);
            if (vis && __builtin_amdgcn_readfirstlane((int)live)) {
                f32x16 p0, p1; attn_scores(p0, p1, cur, qf, lane);
#pragma unroll
                for (int g = 0; g < 4; ++g) {
                    const f32x4 b0 = *(const LAS f32x4*)(kbt + key0 - s0 + 8 * g + 4 * hi), b1 = *(const LAS f32x4*)(kbt + key0 - s0 + 32 + 8 * g + 4 * hi);
#pragma unroll
                    for (int e = 0; e < 4; ++e) { p0[4 * g + e] = p0[4 * g + e] * C2 + b0[e]; p1[4 * g + e] = p1[4 * g + e] * C2 + b1[e]; }
                }
                if (key0 + 63 > q0 + wave * 32) {
#pragma unroll
                    for (int r = 0; r < 16; ++r) { const int kv = key0 + crow(r, hi); if (kv > qrow) p0[r] = -INFINITY; if (kv + 32 > qrow) p1[r] = -INFINITY; }
                }
                attn_update(a, p0, p1, cur, lane);
            }
            if (t + 1 < nt) kv_store(kr, kvb + ((t + 1 - t_start) & 1) * KV_BUF_BYTES, tid);
            __syncthreads();
        }
        attn_store(a, obase + (size_t)qrow * opitch + h * 64, lane);
    }
}

constexpr int MR_KIMG = 32768, MR_VTP = 520, MR_VIMG = 64 * MR_VTP;
__device__ __forceinline__ void kv256_load(v4u (&rk)[4], v4u (&rv)[4], const bf16* Kp, size_t kpitch, const bf16* Vp, size_t vpitch, int tid) {
#pragma unroll
    for (int i = 0; i < 4; ++i) { const int piece = tid + 512 * i;
        rk[i] = *(const GAS v4u*)(Kp + (size_t)(piece >> 3) * kpitch + (piece & 7) * 8);
        rv[i] = *(const GAS v4u*)(Vp + (size_t)(piece >> 5) * vpitch + (piece & 31) * 8); }
}
__device__ __forceinline__ void kv256_store(const v4u (&rk)[4], const v4u (&rv)[4], LAS unsigned char* kimg, LAS unsigned char* vimg, int tid) {
#pragma unroll
    for (int i = 0; i < 4; ++i) { const int piece = tid + 512 * i;
        *(LAS v4u*)(kimg + ((piece & 7) * 256 + (piece >> 3)) * 16) = rk[i];
        LAS unsigned char* vp = vimg + (piece >> 5) * MR_VTP + (piece & 31) * 16;
        *(LAS u32x2*)vp = (u32x2){rv[i].x, rv[i].y}; *(LAS u32x2*)(vp + 8) = (u32x2){rv[i].z, rv[i].w}; }
}
__device__ __forceinline__ void memattn_phase(const InTab& in, unsigned char* ws, int L, LAS unsigned char* lds, int G, int tid, int wave, int lane) {
    const bf16* QM = (const bf16*)(ws + WS_BIG + B_QM); bf16* OM = (bf16*)(ws + WS_BIG + B_OM);
    const bf16* memK = (const bf16*)(ws + WS_MEMK) + (size_t)L * 256 * 256; const bf16* memVt = (const bf16*)(ws + WS_MEMK + 256 * 1024) + (size_t)L * 256 * 256;
    const float* qn = in.get(20) + (size_t)L * 64;
    LAS unsigned char* kvb = lds;
    const int r32 = lane & 31, hi = lane >> 5;
    for (int un = blockIdx.x; un < 256; un += G) {
        const int QB = un >> 2, hm = un & 3, qrow = QB * 256 + wave * 32 + r32;
        bf16x8 qf[4];
        {
            const bf16* qp = QM + (size_t)qrow * MEMW + hm * 64; float x[4][8]; float ss = 0.f;
#pragma unroll
            for (int ks = 0; ks < 4; ++ks) { const v4u w = *(const GAS v4u*)(qp + 16 * ks + 8 * hi); unpack8(w, x[ks]);
#pragma unroll
                for (int j = 0; j < 8; ++j) ss += x[ks][j] * x[ks][j]; }
            ss = sh32_sum(ss);
            const float r = rsqrtf(ss * (1.0f / 64.0f) + RMS_EPS);
#pragma unroll
            for (int ks = 0; ks < 4; ++ks) {
#pragma unroll
                for (int j = 0; j < 8; ++j) x[ks][j] = x[ks][j] * r * qn[16 * ks + 8 * hi + j];
                qf[ks] = __builtin_bit_cast(bf16x8, pack8(x[ks])); }
        }
        AttnAcc a; attn_init(a);
        const bf16* Kp = memK + hm * 64; const bf16* Vtp = memVt + (size_t)hm * 64 * 256;
        __syncthreads();
        { v4u rk[4], rv[4]; kv256_load(rk, rv, Kp, 256, Vtp, 256, tid); kv256_store(rk, rv, kvb, kvb + MR_KIMG, tid); }
        __syncthreads();
#pragma unroll 1
        for (int t = 0; t < 4; ++t) {
            f32x16 p0, p1; attn_scores<4096>(p0, p1, kvb + t * 64 * 16, qf, lane);
            attn_update<MR_VTP, 0>(a, p0, p1, kvb + MR_KIMG + t * 128, lane, C2);
        }
        attn_store(a, OM + (size_t)qrow * MEMW + hm * 64, lane);
    }
}

constexpr int MF_QP = 528;
__device__ __forceinline__ void memfused_phase(const InTab& in, unsigned char* ws, int L, const float* ssq, float* H, bf16* HBo, float* ssq_out, LAS unsigned char* lds, int G, int tid, int wave, int lane) {
    const bf16* HBi = (const bf16*)(ws + WS_HB);
    const bf16* Wq = (const bf16*)(ws + WS_W + (L ? W_MEMQ2 : W_MEMQ)); const bf16* Wo = (const bf16*)(ws + WS_W + (L ? W_MEMO2 : W_MEMO));
    const bf16* memK = (const bf16*)(ws + WS_MEMK) + (size_t)L * 256 * 256; const bf16* memVt = (const bf16*)(ws + WS_MEMK + 256 * 1024) + (size_t)L * 256 * 256;
    const float* qn = in.get(20) + (size_t)L * 64;
    LAS unsigned char* qs = lds; LAS unsigned char* os = lds + 64 * MF_QP; LAS float* xq = (LAS float*)(lds + 2 * 64 * MF_QP); LAS float* xs = xq + 512;
    const int r32 = lane & 31, hi = lane >> 5;
    for (int un = blockIdx.x; un < S / 64; un += G) {
        const int r0 = un * 64;
        f32x16 qa[2];
#pragma unroll
        for (int r = 0; r < 16; ++r) { qa[0][r] = 0.f; qa[1][r] = 0.f; }
        { const bf16* ap = Wq + (size_t)(32 * wave + r32) * DM + 8 * hi; const bf16* bp0 = HBi + (size_t)(r0 + r32) * DM + 8 * hi; const bf16* bp1 = bp0 + (size_t)32 * DM;
#pragma unroll 1
          for (int k8 = 0; k8 < 64; k8 += 8) {
              bf16x8 a[8], b0[8], b1[8];
#pragma unroll
              for (int j = 0; j < 8; ++j) { a[j] = *(const GAS bf16x8*)(ap + 16 * (k8 + j)); b0[j] = *(const GAS bf16x8*)(bp0 + 16 * (k8 + j)); b1[j] = *(const GAS bf16x8*)(bp1 + 16 * (k8 + j)); }
#pragma unroll
              for (int j = 0; j < 8; ++j) { qa[0] = __builtin_amdgcn_mfma_f32_32x32x16_bf16(a[j], b0[j], qa[0], 0, 0, 0); qa[1] = __builtin_amdgcn_mfma_f32_32x32x16_bf16(a[j], b1[j], qa[1], 0, 0, 0); } } }
        __syncthreads();
#pragma unroll
        for (int rt = 0; rt < 2; ++rt) { const float rr = pg8::row_rstd(ssq, r0 + 32 * rt + r32); float ss = 0.f;
#pragma unroll
            for (int r = 0; r < 16; ++r) { qa[rt][r] *= rr; ss += qa[rt][r] * qa[rt][r]; }
            ss = sh32_sum(ss);
            if (hi == 0) xq[wave * 64 + 32 * rt + r32] = ss; }
        __syncthreads();
#pragma unroll
        for (int rt = 0; rt < 2; ++rt) { const float tot = xq[wave * 64 + 32 * rt + r32] + xq[(wave ^ 1) * 64 + 32 * rt + r32];
            const float rh = rsqrtf(tot * (1.0f / 64.0f) + RMS_EPS);
            LAS unsigned char* qrow = qs + (32 * rt + r32) * MF_QP + (32 * wave) * 2;
#pragma unroll
            for (int g = 0; g < 4; ++g) { const int d = 32 * (wave & 1) + 8 * g + 4 * hi;
                u32x2 w; w.x = cvtpk(qa[rt][4 * g] * rh * qn[d], qa[rt][4 * g + 1] * rh * qn[d + 1]); w.y = cvtpk(qa[rt][4 * g + 2] * rh * qn[d + 2], qa[rt][4 * g + 3] * rh * qn[d + 3]);
                *(LAS u32x2*)(qrow + (8 * g + 4 * hi) * 2) = w; } }
        __syncthreads();
        { const int rt = wave & 1, hm = wave >> 1;
          bf16x8 qf[4];
#pragma unroll
          for (int ks = 0; ks < 4; ++ks) qf[ks] = *(const LAS bf16x8*)(qs + (32 * rt + r32) * MF_QP + (hm * 64 + 16 * ks + 8 * hi) * 2);
          AttnAcc a; attn_init(a);
          const bf16* kp = memK + hm * 64 + 8 * hi; const bf16* vp = memVt + (size_t)(hm * 64 + r32) * 256 + 4 * hi;
#pragma unroll 1
          for (int t = 0; t < 4; ++t) {
              f32x16 p0, p1;
#pragma unroll
              for (int r = 0; r < 16; ++r) { p0[r] = 0.f; p1[r] = 0.f; }
#pragma unroll
              for (int ks = 0; ks < 4; ++ks) { const bf16x8 k0 = *(const GAS bf16x8*)(kp + (size_t)(64 * t + r32) * 256 + 16 * ks), k1 = *(const GAS bf16x8*)(kp + (size_t)(64 * t + 32 + r32) * 256 + 16 * ks);
                  p0 = __builtin_amdgcn_mfma_f32_32x32x16_bf16(k0, qf[ks], p0, 0, 0, 0); p1 = __builtin_amdgcn_mfma_f32_32x32x16_bf16(k1, qf[ks], p1, 0, 0, 0); }
              float mx = fmaxf(p0[0], p1[0]);
#pragma unroll
              for (int r = 0; r < 16; ++r) { p0[r] *= C2; p1[r] *= C2; }
              mx = fmaxf(p0[0], p1[0]);
#pragma unroll
              for (int r = 1; r < 16; ++r) mx = fmaxf(mx, fmaxf(p0[r], p1[r]));
              mx = sh32_max(mx);
              const float mnew = fmaxf(a.m, mx); const float alpha = __builtin_amdgcn_exp2f(a.m - mnew); float sum = 0.f;
#pragma unroll
              for (int r = 0; r < 16; ++r) { p0[r] = __builtin_amdgcn_exp2f(p0[r] - mnew); p1[r] = __builtin_amdgcn_exp2f(p1[r] - mnew); sum += p0[r] + p1[r]; }
              a.l = a.l * alpha + sum; a.m = mnew;
#pragma unroll
              for (int r = 0; r < 16; ++r) { a.o0[r] *= alpha; a.o1[r] *= alpha; }
#pragma unroll
              for (int half = 0; half < 2; ++half)
#pragma unroll
                  for (int s2 = 0; s2 < 2; ++s2) { v4u pw;
                      if (half == 0) { pw.x = cvtpk(p0[8 * s2 + 0], p0[8 * s2 + 1]); pw.y = cvtpk(p0[8 * s2 + 2], p0[8 * s2 + 3]); pw.z = cvtpk(p0[8 * s2 + 4], p0[8 * s2 + 5]); pw.w = cvtpk(p0[8 * s2 + 6], p0[8 * s2 + 7]); }
                      else           { pw.x = cvtpk(p1[8 * s2 + 0], p1[8 * s2 + 1]); pw.y = cvtpk(p1[8 * s2 + 2], p1[8 * s2 + 3]); pw.z = cvtpk(p1[8 * s2 + 4], p1[8 * s2 + 5]); pw.w = cvtpk(p1[8 * s2 + 6], p1[8 * s2 + 7]); }
                      const bf16x8 pb = __builtin_bit_cast(bf16x8, pw);
                      const int key = 64 * t + 32 * half + 16 * s2;
#pragma unroll
                      for (int d0 = 0; d0 < 2; ++d0) { const u32x2 lo = *(const GAS u32x2*)(vp + (size_t)(32 * d0) * 256 + key), h2 = *(const GAS u32x2*)(vp + (size_t)(32 * d0) * 256 + key + 8);
                          const bf16x8 va = __builtin_bit_cast(bf16x8, (v4u){lo.x, lo.y, h2.x, h2.y});
                          if (d0 == 0) a.o0 = __builtin_amdgcn_mfma_f32_32x32x16_bf16(va, pb, a.o0, 0, 0, 0); else a.o1 = __builtin_amdgcn_mfma_f32_32x32x16_bf16(va, pb, a.o1, 0, 0, 0); } }
          }
          const float inv = 1.0f / sh32_sum(a.l);
          LAS unsigned char* orow = os + (32 * rt + r32) * MF_QP + (hm * 64) * 2;
#pragma unroll
          for (int g = 0; g < 4; ++g) { u32x2 w0, w1;
              w0.x = cvtpk(a.o0[4 * g] * inv, a.o0[4 * g + 1] * inv); w0.y = cvtpk(a.o0[4 * g + 2] * inv, a.o0[4 * g + 3] * inv);
              w1.x = cvtpk(a.o1[4 * g] * inv, a.o1[4 * g + 1] * inv); w1.y = cvtpk(a.o1[4 * g + 2] * inv, a.o1[4 * g + 3] * inv);
              *(LAS u32x2*)(orow + (8 * g + 4 * hi) * 2) = w0; *(LAS u32x2*)(orow + (32 + 8 * g + 4 * hi) * 2) = w1; } }
        __syncthreads();
        float rowsq[2];
#pragma unroll 1
        for (int rt = 0; rt < 2; ++rt) {
            f32x16 oc[4];
#pragma unroll
            for (int ct = 0; ct < 4; ++ct)
#pragma unroll
                for (int r = 0; r < 16; ++r) oc[ct][r] = 0.f;
            const bf16* ap = Wo + (size_t)(128 * wave + r32) * MEMW + 8 * hi;
#pragma unroll 4
            for (int ks = 0; ks < 16; ++ks) { const bf16x8 b = *(const LAS bf16x8*)(os + (32 * rt + r32) * MF_QP + (16 * ks + 8 * hi) * 2);
#pragma unroll
                for (int ct = 0; ct < 4; ++ct) { const bf16x8 a = *(const GAS bf16x8*)(ap + (size_t)(32 * ct) * MEMW + 16 * ks); oc[ct] = __builtin_amdgcn_mfma_f32_32x32x16_bf16(a, b, oc[ct], 0, 0, 0); } }
            const int row = r0 + 32 * rt + r32; float sq = 0.f;
#pragma unroll
            for (int ct = 0; ct < 4; ++ct)
#pragma unroll
                for (int g = 0; g < 4; ++g) { const int col = 128 * wave + 32 * ct + 8 * g + 4 * hi;
                    float* hp = H + (size_t)row * DM + col; f32x4 hv = *(const GAS f32x4*)hp;
                    hv[0] += oc[ct][4 * g]; hv[1] += oc[ct][4 * g + 1]; hv[2] += oc[ct][4 * g + 2]; hv[3] += oc[ct][4 * g + 3];
                    *(GAS f32x4*)hp = hv; sq += (hv[0] * hv[0] + hv[1] * hv[1]) + (hv[2] * hv[2] + hv[3] * hv[3]);
                    u32x2 w; w.x = cvtpk(hv[0], hv[1]); w.y = cvtpk(hv[2], hv[3]); *(GAS u32x2*)(HBo + (size_t)row * DM + col) = w; }
            rowsq[rt] = sh32_sum(sq);
        }
        if (hi == 0) { xs[wave * 64 + r32] = rowsq[0]; xs[wave * 64 + 32 + r32] = rowsq[1]; }
        __syncthreads();
        if (tid < 64) { float t2 = 0.f;
#pragma unroll
            for (int w8 = 0; w8 < 8; ++w8) t2 += xs[w8 * 64 + tid];
            float* sp = ssq_out + (size_t)(r0 + tid) * 16; *(GAS f32x4*)sp = (f32x4){t2, 0.f, 0.f, 0.f};
            *(GAS f32x4*)(sp + 4) = (f32x4){0.f, 0.f, 0.f, 0.f}; *(GAS f32x4*)(sp + 8) = (f32x4){0.f, 0.f, 0.f, 0.f}; *(GAS f32x4*)(sp + 12) = (f32x4){0.f, 0.f, 0.f, 0.f}; }
    }
}

constexpr size_t WS_MSEL = 7 * MiB;
constexpr size_t WS_MLSE = 8 * MiB;
constexpr size_t B_OP0 = 64 * MiB, B_OP1 = 128 * MiB;
__device__ __forceinline__ bool gate_better(float g1, int n1, float g2, int n2) { return g1 > g2 || (g1 == g2 && n1 < n2); }
__device__ __forceinline__ void moba_gate_phase(unsigned char* ws, int G, int wave, int lane) {
    const bf16* Q = (const bf16*)(ws + WS_BIG + B_PROJ); const float* ksum = (const float*)(ws + WS_KSUM); unsigned* selg = (unsigned*)(ws + WS_MSEL);
    const int r32 = lane & 31, hi = lane >> 5;
    const int NW = G * NWAVES;
    const int gwid = (int)blockIdx.x * NWAVES + wave;
    const int per_head = NW / 16;
    if (per_head == 0) return;
    const int h = gwid / per_head, wi = gwid % per_head;
    if (h >= 16) return;
    float af[2][32];
#pragma unroll
    for (int g = 0; g < 2; ++g)
#pragma unroll
        for (int kk = 0; kk < 32; ++kk) af[g][kk] = ksum[(size_t)(32 * g + r32) * 1024 + h * 64 + 2 * kk + hi] * (1.0f / 256.0f);
    for (int tile = wi; tile < S / 32; tile += per_head) {
        const int t = tile * 32 + r32, own = (tile * 32) >> 8;
        float bq[32];
        { const bf16* qp = Q + (size_t)t * DM + h * 64;
#pragma unroll
          for (int c = 0; c < 8; ++c) { const unsigned sh = hi ? 0u : 16u;   const v4u w = *(const GAS v4u*)(qp + 8 * c);
              bq[4 * c + 0] = __uint_as_float((w.x << sh) & 0xffff0000u); bq[4 * c + 1] = __uint_as_float((w.y << sh) & 0xffff0000u);
              bq[4 * c + 2] = __uint_as_float((w.z << sh) & 0xffff0000u); bq[4 * c + 3] = __uint_as_float((w.w << sh) & 0xffff0000u); } }
        float g0 = -INFINITY, g1 = -INFINITY, g2 = -INFINITY; int n0 = 255, n1 = 255, n2 = 255;
#pragma unroll
        for (int g = 0; g < 2; ++g) {
            if (32 * g < own) {
                f32x16 c;
#pragma unroll
                for (int r = 0; r < 16; ++r) c[r] = 0.f;
#pragma unroll
                for (int kk = 0; kk < 32; ++kk) c = __builtin_amdgcn_mfma_f32_32x32x2f32(af[g][kk], bq[kk], c, 0, 0, 0);
#pragma unroll
                for (int r = 0; r < 16; ++r) { const int n = 32 * g + crow(r, hi); const float gv = (n < own) ? c[r] : -INFINITY;
                    if (n < own) {
                        if (gate_better(gv, n, g0, n0)) { g2 = g1; n2 = n1; g1 = g0; n1 = n0; g0 = gv; n0 = n; }
                        else if (gate_better(gv, n, g1, n1)) { g2 = g1; n2 = n1; g1 = gv; n1 = n; }
                        else if (gate_better(gv, n, g2, n2)) { g2 = gv; n2 = n; } } }
            }
        }
        const float p0 = sh32_get(g0, lane), p1 = sh32_get(g1, lane), p2 = sh32_get(g2, lane);
        const int pn0 = __float_as_int(sh32_get(__int_as_float(n0), lane)), pn1 = __float_as_int(sh32_get(__int_as_float(n1), lane)), pn2 = __float_as_int(sh32_get(__int_as_float(n2), lane));
        float fg[3]; int fn[3]; int ia = 0, ib = 0;
#pragma unroll
        for (int k = 0; k < 3; ++k) {
            const float ga = (ia == 0) ? g0 : (ia == 1) ? g1 : (ia == 2) ? g2 : -INFINITY; const int na = (ia == 0) ? n0 : (ia == 1) ? n1 : (ia == 2) ? n2 : 255;
            const float gb = (ib == 0) ? p0 : (ib == 1) ? p1 : (ib == 2) ? p2 : -INFINITY; const int nb = (ib == 0) ? pn0 : (ib == 1) ? pn1 : (ib == 2) ? pn2 : 255;
            const bool ta = (na != 255) && (nb == 255 || gate_better(ga, na, gb, nb));
            if (ta) { fg[k] = ga; fn[k] = na; ++ia; } else { fg[k] = gb; fn[k] = nb; ++ib; }
        }
        (void)fg;
        if (hi == 0) selg[(size_t)h * S + t] = (unsigned)(fn[0] & 255) | ((unsigned)(fn[1] & 255) << 8) | ((unsigned)(fn[2] & 255) << 16);
    }
}
constexpr int CW_MOBAQ = 192;
__device__ __forceinline__ void moba_route_phase(unsigned char* ws, unsigned char* spare, LAS unsigned char* lds, int G, int tid, int wave, int lane, int qword) {
    const bf16* Q = (const bf16*)(ws + WS_BIG + B_PROJ); const bf16* Kb = Q + (size_t)S * DM; const bf16* Vt = (const bf16*)(ws + WS_BIG + B_VTM);
    const unsigned* selg = (const unsigned*)(ws + WS_MSEL); float* lse = (float*)(ws + WS_MLSE);
    unsigned* qctr = (unsigned*)(ws + WS_CTL) + qword;
    LAS unsigned char* kimg = lds; LAS unsigned char* vimg = lds + MR_KIMG;
    LAS int* list = (LAS int*)(lds + MR_KIMG + MR_VIMG);
    LAS int* wtot = list + 16384;
    LAS int* ubox = wtot + 256;
    const int r32 = lane & 31, hi = lane >> 5;
    const int NUNITS = 16 * 63;
    for (;;) {
        __syncthreads();
        if (tid == 0) ubox[0] = (int)atomicAdd(qctr, 1u);
        __syncthreads();
        const int u = ubox[0];
        if (u >= NUNITS) break;
        const int c = 0, rem = u;
        const int n = rem >> 4, h = rem & 15;
        const int tlo = 256 * (n + 1);
        v4u kst[4], vst[4];
        { const bf16* Kp = Kb + (size_t)(256 * n) * DM + h * 64; const bf16* Vp = Vt + (size_t)h * 64 * S + 256 * n;
#pragma unroll
          for (int i = 0; i < 4; ++i) { const int piece = tid + 512 * i;
              kst[i] = *(const GAS v4u*)(Kp + (size_t)(piece >> 3) * DM + (piece & 7) * 8);
              vst[i] = *(const GAS v4u*)(Vp + (size_t)(piece >> 5) * S + (piece & 31) * 8); } }
        int myent[32]; bool mysel[32];
#pragma unroll
        for (int i = 0; i < 32; ++i) { const int t = 512 * i + tid; mysel[i] = false; myent[i] = 0;
            if (t >= tlo) { const unsigned w = selg[(size_t)h * S + t];
                const int slot = ((w & 255u) == (unsigned)n) ? 0 : (((w >> 8) & 255u) == (unsigned)n) ? 1 : (((w >> 16) & 255u) == (unsigned)n) ? 2 : -1;
                if (slot >= 0) { mysel[i] = true; myent[i] = t | (slot << 16); } }
            const unsigned long long mk = __ballot(mysel[i]);
            if (lane == 0) wtot[i * 8 + wave] = __popcll(mk); }
        __syncthreads();
        int cnt = 0;
#pragma unroll
        for (int i = 0; i < 32; ++i) { int base = cnt;
#pragma unroll
            for (int w8 = 0; w8 < 8; ++w8) { const int v = wtot[i * 8 + w8]; if (w8 < wave) base += v; cnt += v; }
            const unsigned long long mk = __ballot(mysel[i]);
            if (mysel[i]) list[base + __popcll(mk & ((1ull << lane) - 1ull))] = myent[i]; }
#pragma unroll
        for (int i = 0; i < 4; ++i) { const int piece = tid + 512 * i;
            *(LAS v4u*)(kimg + ((piece & 7) * 256 + (piece >> 3)) * 16) = kst[i];
            LAS unsigned char* vp = vimg + (piece >> 5) * MR_VTP + (piece & 31) * 16;
            *(LAS u32x2*)vp = (u32x2){vst[i].x, vst[i].y}; *(LAS u32x2*)(vp + 8) = (u32x2){vst[i].z, vst[i].w}; }
        __syncthreads();
        if (cnt == 0) continue;
        const int ntile = (cnt + 31) >> 5;
        for (int ti = wave; ti < ntile; ti += NWAVES) {
            const int e = ti * 32 + r32; const bool live = e < cnt;
            const int ent = list[live ? e : 0]; const int t = ent & 0xffff, slot = ent >> 16;
            bf16x8 qf[4]; load_q(qf, Q + (size_t)t * DM + h * 64, lane);
            AttnAcc a; attn_init(a);
#pragma unroll 1
            for (int j = 0; j < 4; ++j) {
                f32x16 p0, p1; attn_scores<4096>(p0, p1, kimg + j * 64 * 16, qf, lane);
                attn_update<MR_VTP, 0>(a, p0, p1, vimg + j * 128, lane, C2);
            }
            const float l = sh32_sum(a.l); const float inv = 1.0f / l;
            if (live) {
                bf16* orow = (bf16*)(slot == 0 ? ws + WS_BIG + B_OP0 : slot == 1 ? ws + WS_BIG + B_OP1 : spare) + ((size_t)t * 16 + h) * 64;
#pragma unroll
                for (int g = 0; g < 4; g += 2) {
#pragma unroll
                    for (int d0 = 0; d0 < 2; ++d0) {
                        u32x2 wa, wb;
                        if (d0 == 0) { wa.x = cvtpk(a.o0[4 * g] * inv, a.o0[4 * g + 1] * inv); wa.y = cvtpk(a.o0[4 * g + 2] * inv, a.o0[4 * g + 3] * inv);
                                       wb.x = cvtpk(a.o0[4 * g + 4] * inv, a.o0[4 * g + 5] * inv); wb.y = cvtpk(a.o0[4 * g + 6] * inv, a.o0[4 * g + 7] * inv); }
                        else         { wa.x = cvtpk(a.o1[4 * g] * inv, a.o1[4 * g + 1] * inv); wa.y = cvtpk(a.o1[4 * g + 2] * inv, a.o1[4 * g + 3] * inv);
                                       wb.x = cvtpk(a.o1[4 * g + 4] * inv, a.o1[4 * g + 5] * inv); wb.y = cvtpk(a.o1[4 * g + 6] * inv, a.o1[4 * g + 7] * inv); }
                        { auto rx = __builtin_amdgcn_permlane32_swap(wa.x, wb.x, false, false); wa.x = rx[0]; wb.x = rx[1]; }
                        { auto ry = __builtin_amdgcn_permlane32_swap(wa.y, wb.y, false, false); wa.y = ry[0]; wb.y = ry[1]; }
                        *(GAS v4u*)(orow + 32 * d0 + 8 * g + 8 * hi) = (v4u){wa.x, wa.y, wb.x, wb.y};
                    } }
                if (hi == 0) lse[((size_t)slot * S + t) * 16 + h] = a.m + __builtin_amdgcn_logf(l);
            }
        }
    }
}
__device__ __forceinline__ void moba_own_phase(unsigned char* ws, unsigned char* spare, LAS unsigned char* lds, int G, int tid, int wave, int lane, bf16* obase, size_t opitch) {
    bf16* Q = (bf16*)(ws + WS_BIG + B_PROJ); const bf16* Kb = Q + (size_t)S * DM; const bf16* Vt = (const bf16*)(ws + WS_BIG + B_VTM);
    const unsigned* selg = (const unsigned*)(ws + WS_MSEL); const float* lse = (const float*)(ws + WS_MLSE);
    LAS unsigned char* kvb = lds;
    const int r32 = lane & 31, hi = lane >> 5;
    LAS unsigned char* vimg = lds + MR_KIMG;
    v4u rk[4], rv[4];
    if ((int)blockIdx.x < 1024) { const int h0 = (int)blockIdx.x & 15, q00 = ((int)blockIdx.x >> 4) * 256; kv256_load(rk, rv, Kb + (size_t)q00 * DM + h0 * 64, DM, Vt + (size_t)h0 * 64 * S + q00, S, tid); }
    for (int un = blockIdx.x; un < 1024; un += G) {
        const int h = un & 15, QB = un >> 4, q0 = QB * 256, qrow = q0 + wave * 32 + r32;
        bf16x8 qf[4]; load_q(qf, Q + (size_t)qrow * DM + h * 64, lane);
        AttnAcc a; attn_init(a);
        __syncthreads();
        kv256_store(rk, rv, kvb, vimg, tid);
        __syncthreads();
        { const int un2 = un + G; if (un2 < 1024) { const int h2 = un2 & 15, q02 = (un2 >> 4) * 256; kv256_load(rk, rv, Kb + (size_t)q02 * DM + h2 * 64, DM, Vt + (size_t)h2 * 64 * S + q02, S, tid); } }
#pragma unroll 1
        for (int t = 0; t < 4; ++t) {
            const int key0 = q0 + t * 64;
            if (key0 <= q0 + wave * 32 + 31) {
                f32x16 p0, p1; attn_scores<4096>(p0, p1, kvb + t * 64 * 16, qf, lane);
#pragma unroll
                for (int r = 0; r < 16; ++r) { const int kv = key0 + crow(r, hi); p0[r] = (kv > qrow) ? -INFINITY : p0[r]; p1[r] = (kv + 32 > qrow) ? -INFINITY : p1[r]; }
                attn_update<MR_VTP, 0>(a, p0, p1, vimg + t * 128, lane, C2);
            }
        }
        const unsigned sw = selg[(size_t)h * S + qrow];
        float L[3];
#pragma unroll
        for (int j = 0; j < 3; ++j) L[j] = (((sw >> (8 * j)) & 255u) != 255u) ? lse[((size_t)j * S + qrow) * 16 + h] : -INFINITY;
        const float M = fmaxf(fmaxf(a.m, L[0]), fmaxf(L[1], L[2]));
        const float so = __builtin_amdgcn_exp2f(a.m - M);
        float W = sh32_sum(a.l) * so;
#pragma unroll
        for (int r = 0; r < 16; ++r) { a.o0[r] *= so; a.o1[r] *= so; }
#pragma unroll
        for (int j = 0; j < 3; ++j) {
            if (L[j] != -INFINITY) {
                const float wj = __builtin_amdgcn_exp2f(L[j] - M); W += wj;
                const bf16* orow = (const bf16*)(j == 0 ? ws + WS_BIG + B_OP0 : j == 1 ? ws + WS_BIG + B_OP1 : spare) + ((size_t)qrow * 16 + h) * 64;
#pragma unroll
                for (int g = 0; g < 4; ++g) { const u32x2 w0 = *(const GAS u32x2*)(orow + 8 * g + 4 * hi), w1 = *(const GAS u32x2*)(orow + 32 + 8 * g + 4 * hi);
                    a.o0[4 * g] += wj * bflo(w0.x); a.o0[4 * g + 1] += wj * bfhi(w0.x); a.o0[4 * g + 2] += wj * bflo(w0.y); a.o0[4 * g + 3] += wj * bfhi(w0.y);
                    a.o1[4 * g] += wj * bflo(w1.x); a.o1[4 * g + 1] += wj * bfhi(w1.x); a.o1[4 * g + 2] += wj * bflo(w1.y); a.o1[4 * g + 3] += wj * bfhi(w1.y); }
            }
        }
        const float inv = 1.0f / W;
        bf16* orow = obase + (size_t)qrow * opitch + h * 64;
#pragma unroll
        for (int g = 0; g < 4; ++g) { u32x2 w0, w1;
            w0.x = cvtpk(a.o0[4 * g] * inv, a.o0[4 * g + 1] * inv); w0.y = cvtpk(a.o0[4 * g + 2] * inv, a.o0[4 * g + 3] * inv);
            w1.x = cvtpk(a.o1[4 * g] * inv, a.o1[4 * g + 1] * inv); w1.y = cvtpk(a.o1[4 * g + 2] * inv, a.o1[4 * g + 3] * inv);
            *(GAS u32x2*)(orow + 8 * g + 4 * hi) = w0; *(GAS u32x2*)(orow + 32 + 8 * g + 4 * hi) = w1; }
    }
}

typedef float f32x4v __attribute__((ext_vector_type(4)));
__device__ __forceinline__ unsigned mono_key(float s) { if (s == 0.f) s = 0.f; const unsigned u = __float_as_uint(s); return (u & 0x80000000u) ? ~u : (u | 0x80000000u); }
__device__ __forceinline__ float unmono_f(unsigned u) { return __uint_as_float((u & 0x80000000u) ? (u ^ 0x80000000u) : ~u); }
constexpr int DS_CAP = 512;
__device__ __forceinline__ int wave_sum_dpp(int v) {
    v += __builtin_amdgcn_update_dpp(0, v, 0xB1, 0xF, 0xF, true); v += __builtin_amdgcn_update_dpp(0, v, 0x4E, 0xF, 0xF, true);
    v += __builtin_amdgcn_update_dpp(0, v, 0x141, 0xF, 0xF, true); v += __builtin_amdgcn_update_dpp(0, v, 0x140, 0xF, 0xF, true);
    v += __builtin_amdgcn_update_dpp(0, v, 0x142, 0xA, 0xF, false); v += __builtin_amdgcn_update_dpp(0, v, 0x143, 0xC, 0xF, false);
    return __builtin_amdgcn_readlane(v, 63); }
__device__ __forceinline__ unsigned wave_or(unsigned u) { int v = (int)u;
    v |= __builtin_amdgcn_update_dpp(0, v, 0xB1, 0xF, 0xF, true); v |= __builtin_amdgcn_update_dpp(0, v, 0x4E, 0xF, 0xF, true);
    v |= __builtin_amdgcn_update_dpp(0, v, 0x141, 0xF, 0xF, true); v |= __builtin_amdgcn_update_dpp(0, v, 0x140, 0xF, 0xF, true);
    v |= __builtin_amdgcn_update_dpp(0, v, 0x142, 0xA, 0xF, false); v |= __builtin_amdgcn_update_dpp(0, v, 0x143, 0xC, 0xF, false);
    return (unsigned)__builtin_amdgcn_readlane(v, 63); }
template <bool EXACT>
__device__ __forceinline__ unsigned dsa_compact(LAS u32x2* ent, int n, int& nkeep, int lane) {
    unsigned k[8]; unsigned ix[8]; unsigned orv = 0u, nandv = 0u;
#pragma unroll
    for (int j = 0; j < 8; ++j) { const int e = lane + 64 * j; const bool in = e < n; const u32x2 v = ent[in ? e : 0]; const unsigned mk = mono_key(__uint_as_float(v.x)); k[j] = in ? mk : 0u; ix[j] = v.y; orv |= k[j]; nandv |= in ? ~mk : 0u; }
    unsigned T = 0u; int cntT = n; int bit0 = 31;
    if (!EXACT) {
        const unsigned diff = (unsigned)__builtin_amdgcn_readfirstlane((int)(wave_or(orv) & wave_or(nandv)));
        if (diff != 0u) { bit0 = 31 - __builtin_clz(diff); const unsigned anyk = (unsigned)__builtin_amdgcn_readfirstlane((int)k[0]);
            T = (bit0 == 31) ? 0u : (anyk & ~((2u << bit0) - 1u)); }
    }
    for (int bit = bit0; bit >= 0; --bit) {
        const unsigned cand = T | (1u << bit); int cl = 0;
#pragma unroll
        for (int j = 0; j < 8; ++j) cl += (k[j] >= cand) ? 1 : 0;
        const int c = wave_sum_dpp(cl);
        if (c >= 256) { T = cand; cntT = c; if (!EXACT && c <= 320) break; }
    }
    int Jstar = 0x10000;
    if (cntT > (EXACT ? 256 : 320)) {
        int gl = 0;
#pragma unroll
        for (int j = 0; j < 8; ++j) gl += (k[j] > T) ? 1 : 0;
        const int gt = wave_sum_dpp(gl);
        const int need = 256 - gt; int Jm = 0;
        for (int bit = 14; bit >= 0; --bit) { const int cand = Jm | (1 << bit); int cl = 0;
#pragma unroll
            for (int j = 0; j < 8; ++j) cl += (k[j] == T && (int)ix[j] < cand) ? 1 : 0;
            if (wave_sum_dpp(cl) < need) Jm = cand; }
        Jstar = Jm + 1;
    }
    int base = 0;
    const unsigned long long lt = (1ull << lane) - 1ull;
#pragma unroll
    for (int j = 0; j < 8; ++j) { const bool pred = (k[j] > T) || (k[j] == T && T != 0u && (int)ix[j] < Jstar);
        const unsigned long long mask = __builtin_amdgcn_ballot_w64(pred); const int pos = base + __popcll(mask & lt);
        if (pred) ent[pos] = (u32x2){__float_as_uint(unmono_f(k[j])), ix[j]};
        base += __popcll(mask); }
    nkeep = base;
    return T;
}
#define DSA_HEADSUM(s, msk, P, B, W, tf) asm("v_max_f32_e32 %1, 0, %3\n\tv_mul_f32_e32 %0, %11, %1\n\tv_max_f32_e32 %1, 0, %4\n\tv_fmac_f32_e32 %0, %12, %1\n\tv_max_f32_e32 %1, 0, %5\n\tv_fmac_f32_e32 %0, %13, %1\n\t" \
        "v_max_f32_e32 %1, 0, %6\n\tv_fmac_f32_e32 %0, %14, %1\n\tv_max_f32_e32 %1, 0, %7\n\tv_fmac_f32_e32 %0, %15, %1\n\tv_max_f32_e32 %1, 0, %8\n\tv_fmac_f32_e32 %0, %16, %1\n\t" \
        "v_max_f32_e32 %1, 0, %9\n\tv_fmac_f32_e32 %0, %17, %1\n\tv_max_f32_e32 %1, 0, %10\n\tv_fmac_f32_e32 %0, %18, %1\n\tv_cmp_ge_f32_e64 %2, %0, %19" \
        : "=&v"(s), "=&v"(tmp_), "=s"(msk) : "v"(P[B + 0]), "v"(P[B + 1]), "v"(P[B + 2]), "v"(P[B + 3]), "v"(P[B + 4]), "v"(P[B + 5]), "v"(P[B + 6]), "v"(P[B + 7]), \
          "v"(W[0]), "v"(W[1]), "v"(W[2]), "v"(W[3]), "v"(W[4]), "v"(W[5]), "v"(W[6]), "v"(W[7]), "v"(tf))
struct DsaState { float tf0, tf1; int cnt0, cnt1; };
template <bool NOCOMPACT = false, bool NOINSERT = false>
__device__ __forceinline__ void dsa_tile(const bf16x8 (&af)[4], const bf16x8 (&bc)[4], const float (&w0)[8], const float (&w1)[8], int key0, int q0t, int q1t, bool lastt, DsaState& st,
                                         LAS u32x2* ents, int lane) {
    const int r32 = lane & 31, hi = lane >> 5;
    f32x16 p;
#pragma unroll
    for (int r = 0; r < 16; ++r) p[r] = 0.f;
#pragma unroll
    for (int ks = 0; ks < 4; ++ks) p = __builtin_amdgcn_mfma_f32_32x32x16_bf16(af[ks], bc[ks], p, 0, 0, 0);
    asm volatile("s_nop 15\n\ts_nop 7" : "+v"(p));
    float s0, s1, tmp_; unsigned long long m0, m1;
    DSA_HEADSUM(s0, m0, p, 0, w0, st.tf0); DSA_HEADSUM(s1, m1, p, 8, w1, st.tf1);
    const int key = key0 + r32;
    if (lastt) { m0 &= __builtin_amdgcn_ballot_w64(key <= q0t); m1 &= __builtin_amdgcn_ballot_w64(key <= q1t); }
    if (NOINSERT) { st.cnt0 ^= (int)__popcll(m0 ^ m1); return; }
    if (m0 | m1) {
        const bool pr0 = __builtin_amdgcn_inverse_ballot_w64(m0), pr1 = __builtin_amdgcn_inverse_ballot_w64(m1);
        const unsigned h0 = hi ? (unsigned)(m0 >> 32) : (unsigned)m0, h1 = hi ? (unsigned)(m1 >> 32) : (unsigned)m1;
        const unsigned lowmask = (1u << r32) - 1u;
        if (pr0) ents[hi * DS_CAP + st.cnt0 + __popc(h0 & lowmask)] = (u32x2){__float_as_uint(s0), (unsigned)key};
        if (pr1) ents[(2 + hi) * DS_CAP + st.cnt1 + __popc(h1 & lowmask)] = (u32x2){__float_as_uint(s1), (unsigned)key};
        st.cnt0 += __popc(h0); st.cnt1 += __popc(h1);
        const unsigned long long need = __builtin_amdgcn_ballot_w64(max(st.cnt0, st.cnt1) > DS_CAP - 32);
        if (need) {
#pragma unroll 1
            for (int hh = 0; hh < 2; ++hh) {
                const int c0 = __builtin_amdgcn_readlane(st.cnt0, 0), c0b = __builtin_amdgcn_readlane(st.cnt0, 32);
                const int c1 = __builtin_amdgcn_readlane(st.cnt1, 0), c1b = __builtin_amdgcn_readlane(st.cnt1, 32);
                const int n0 = hh ? c0b : c0, n1 = hh ? c1b : c1;
                if (NOCOMPACT) { if (n0 > DS_CAP - 32 && hi == hh) st.cnt0 = 256; if (n1 > DS_CAP - 32 && hi == hh) st.cnt1 = 256; continue; }
                if (n0 > DS_CAP - 32) { int nk; const unsigned T = dsa_compact<false>(ents + hh * DS_CAP, n0, nk, lane); if (hi == hh) { st.tf0 = unmono_f(T + 1u); st.cnt0 = nk; } }
                if (n1 > DS_CAP - 32) { int nk; const unsigned T = dsa_compact<false>(ents + (2 + hh) * DS_CAP, n1, nk, lane); if (hi == hh) { st.tf1 = unmono_f(T + 1u); st.cnt1 = nk; } }
            }
        }
    }
}
template <bool NOCOMPACT = false, bool NOINSERT = false, bool HALFLD = false>
__device__ __forceinline__ void dsa_select_phase(unsigned char* ws, LAS unsigned char* lds, int G, int tid, int wave, int lane, int jm = -1) {
    const bf16* proj = (const bf16*)(ws + WS_BIG + B_PROJ); const bf16* IKc = (const bf16*)(ws + WS_BIG + B_IKC); const float* IW = (const float*)(ws + WS_IW);
    unsigned short* selg = (unsigned short*)(ws + WS_BIG + B_SEL);
    LAS u32x2* ents = (LAS u32x2*)lds + wave * 4 * DS_CAP;
    const int r32 = lane & 31, hi = lane >> 5;
    const int NWG = G * NWAVES, gw = (int)blockIdx.x * NWAVES + wave;
    for (int pu = gw; pu < 2048; pu += NWG) {
        for (int uu = 0; uu < 2; ++uu) {
            const int unit = uu ? 4095 - pu : pu, tw = unit * 4;
            bf16x8 af[4];
            { const int i = r32, qi = 2 * (i >> 4) + ((i >> 2) & 1), hd = 4 * ((i >> 3) & 1) + (i & 3);
              const bf16* ap = proj + (size_t)(tw + qi) * EVEN_NP + EC_IQ + hd * 64 + 8 * hi;
#pragma unroll
              for (int ks = 0; ks < 4; ++ks) af[ks] = *(const GAS bf16x8*)(ap + 16 * ks); }
            float w0[8], w1[8];
            { const f32x4 a = *(const GAS f32x4*)(IW + (size_t)(tw + hi) * 8), b = *(const GAS f32x4*)(IW + (size_t)(tw + hi) * 8 + 4);
              const f32x4 c = *(const GAS f32x4*)(IW + (size_t)(tw + 2 + hi) * 8), d = *(const GAS f32x4*)(IW + (size_t)(tw + 2 + hi) * 8 + 4);
#pragma unroll
              for (int j = 0; j < 4; ++j) { w0[j] = a[j]; w0[4 + j] = b[j]; w1[j] = c[j]; w1[4 + j] = d[j]; } }
            const int q0t = tw + hi, q1t = tw + 2 + hi;
            DsaState st; st.tf0 = -INFINITY; st.tf1 = -INFINITY; st.cnt0 = 0; st.cnt1 = 0;
            const int ntile = ((tw + 3) >> 5) + 1;
            const bf16* kp = IKc + (size_t)lane * 8; asm volatile("" : "+v"(kp));
            bf16x8 bA[4], bB[4], bC[4];
#define DSA_LOADB(dst, jj) do { const bf16* p_ = kp + (size_t)((jj) & jm) * 2048; \
                if (HALFLD) { asm volatile("global_load_dwordx4 %0, %2, off\n\tglobal_load_dwordx4 %1, %2, off offset:1024" : "=&v"(dst[0]), "=&v"(dst[1]) : "v"(p_) : "memory"); } else \
                asm volatile("global_load_dwordx4 %0, %4, off\n\tglobal_load_dwordx4 %1, %4, off offset:1024\n\tglobal_load_dwordx4 %2, %4, off offset:2048\n\tglobal_load_dwordx4 %3, %4, off offset:3072" \
                             : "=&v"(dst[0]), "=&v"(dst[1]), "=&v"(dst[2]), "=&v"(dst[3]) : "v"(p_) : "memory"); } while (0)
#define DSA_WAITB(dst, n) do { if (HALFLD) { if ((n) == 0) asm volatile("s_waitcnt vmcnt(0)" : "+v"(dst[0]), "+v"(dst[1]) :: "memory"); else asm volatile("s_waitcnt vmcnt(4)" : "+v"(dst[0]), "+v"(dst[1]) :: "memory"); dst[2] = dst[0]; dst[3] = dst[1]; } else asm volatile("s_waitcnt vmcnt(" #n ")" : "+v"(dst[0]), "+v"(dst[1]), "+v"(dst[2]), "+v"(dst[3]) :: "memory"); } while (0)
            asm volatile("" : "+v"(af[0]), "+v"(af[1]), "+v"(af[2]), "+v"(af[3]));
#pragma unroll
            for (int r = 0; r < 8; ++r) asm volatile("" : "+v"(w0[r]), "+v"(w1[r]));
            DSA_LOADB(bA, 0); DSA_LOADB(bB, min(1, ntile - 1));
#pragma unroll 1
            for (int j = 0; j < ntile; j += 3) {
                DSA_LOADB(bC, min(j + 2, ntile - 1));
                DSA_WAITB(bA, 8);
                dsa_tile<NOCOMPACT, NOINSERT>(af, bA, w0, w1, 32 * j, q0t, q1t, j == ntile - 1, st, ents, lane);
                DSA_LOADB(bA, min(j + 3, ntile - 1));
                DSA_WAITB(bB, 8);
                if (j + 1 < ntile) dsa_tile<NOCOMPACT, NOINSERT>(af, bB, w0, w1, 32 * (j + 1), q0t, q1t, j + 1 == ntile - 1, st, ents, lane);
                DSA_LOADB(bB, min(j + 4, ntile - 1));
                DSA_WAITB(bC, 8);
                if (j + 2 < ntile) dsa_tile<NOCOMPACT, NOINSERT>(af, bC, w0, w1, 32 * (j + 2), q0t, q1t, j + 2 == ntile - 1, st, ents, lane);
            }
            DSA_WAITB(bA, 0);
#undef DSA_LOADB
#undef DSA_WAITB
            const int cnt0 = st.cnt0, cnt1 = st.cnt1;
#pragma unroll 1
            for (int qq = 0; qq < 4; ++qq) {
                const int hh = qq & 1, sl = qq >> 1;
                int n = sl ? __builtin_amdgcn_readlane(cnt1, 32 * hh) : __builtin_amdgcn_readlane(cnt0, 32 * hh);
                LAS u32x2* ee = ents + qq * DS_CAP;
                if (n > 256) { int nk = 256; if (!NOCOMPACT) (void)dsa_compact<true>(ee, n, nk, lane); n = 256; }
                unsigned short* row = selg + (size_t)(tw + qq) * 256;
#pragma unroll
                for (int e4 = 0; e4 < 4; ++e4) { const int e = lane + 64 * e4; row[e] = (e < n) ? (unsigned short)ee[e].y : (unsigned short)0u; }
            }
        }
    }
}

typedef __bf16 bf16x2v __attribute__((ext_vector_type(2)));
__device__ __forceinline__ float dot2bf(unsigned a, unsigned b, float acc) { return __builtin_amdgcn_fdot2_f32_bf16(__builtin_bit_cast(bf16x2v, a), __builtin_bit_cast(bf16x2v, b), acc, false); }
__device__ __forceinline__ float dsa_kscale(const InTab& in, int lane) { const float g = wave_max(fabsf(in.get(11)[lane])); return 127.0f / (8.2f * g); }
__device__ __forceinline__ void dsa_quant_phase(const InTab& in, unsigned char* ws, unsigned char* spare, int G, int wave, int lane) {
    const bf16* proj = (const bf16*)(ws + WS_BIG + B_PROJ);
    const float SK = dsa_kscale(in, lane);
    const float SV = 127.0f / fmaxf(__uint_as_float(((const unsigned*)(ws + WS_CTL))[CW_VMAX + (lane >> 3)]), 1e-20f);
    for (int u = blockIdx.x; u < S / 64; u += G) {
        const int tw0 = u * 64 + wave * 8;
        const bf16* pr = proj + (size_t)tw0 * EVEN_NP + lane * 8; unsigned char* dst = spare + (size_t)tw0 * 1024 + lane * 16;
        v4u kr[8], vr[8];
#pragma unroll
        for (int i = 0; i < 8; ++i) { kr[i] = *(const GAS v4u*)(pr + (size_t)i * EVEN_NP + EC_DK); vr[i] = *(const GAS v4u*)(pr + (size_t)i * EVEN_NP + EC_DV); }
#pragma unroll
        for (int i = 0; i < 8; ++i) { float a[8], b[8]; unpack8(kr[i], a); unpack8(vr[i], b); v4u o;
#pragma unroll
            for (int j = 0; j < 8; ++j) { a[j] = fminf(fmaxf(a[j] * SK, -127.f), 127.f); b[j] = fminf(fmaxf(b[j] * SV, -127.f), 127.f); }
            o.x = q8pack4(a[0], a[1], a[2], a[3]); o.y = q8pack4(a[4], a[5], a[6], a[7]); o.z = q8pack4(b[0], b[1], b[2], b[3]); o.w = q8pack4(b[4], b[5], b[6], b[7]);
            *(GAS v4u*)(dst + (size_t)i * 1024) = o; }
    }
}
#define SP_IDXA(A, i) (((i) & 1) ? (A[(i) >> 3][((i) >> 1) & 3] >> 16) : (A[(i) >> 3][((i) >> 1) & 3] & 0xffffu))
__device__ __forceinline__ void dsa_sparse_phase(const InTab& in, unsigned char* ws, const unsigned char* spare, int G, int wave, int lane, bf16* obase, size_t opitch) {
    const bf16* proj = (const bf16*)(ws + WS_BIG + B_PROJ); const unsigned short* selg = (const unsigned short*)(ws + WS_BIG + B_SEL);
    const int h = (int)blockIdx.x & 7, wg = (int)blockIdx.x >> 3, nwg = G >> 3;
    const int kg = lane >> 3, ds8 = (lane & 7) * 8;
    const unsigned char* kvu = spare + h * 128;
    const unsigned lpart = (unsigned)(lane & 7) * 16u;
    const float SK = dsa_kscale(in, lane);
    const float vmaxh = fmaxf(__uint_as_float(((const unsigned*)(ws + WS_CTL))[CW_VMAX + h]), 1e-20f);
    const int stride = nwg * NWAVES;
    int t = wg * NWAVES + wave;
    if (t >= S) return;
    v4u iw[4], qw;
#pragma unroll
    for (int c = 0; c < 4; ++c) iw[c] = *(const GAS v4u*)(selg + (size_t)t * 256 + 32 * kg + 8 * c);
    qw = *(const GAS v4u*)(proj + (size_t)t * EVEN_NP + EC_DQ + h * 64 + ds8);
    v4u ka[8], kb[8];
#define SP_LOAD(A, dst, i0) _Pragma("unroll") for (int j = 0; j < 8; ++j) { const unsigned off = (SP_IDXA(A, (i0) + j) << 10) + lpart; dst[j] = *(const GAS v4u*)(kvu + off); }
#define SP_QK(src, i0) _Pragma("unroll") for (int j = 0; j < 8; ++j) { \
            int d = __builtin_amdgcn_sdot4((int)q0, (int)src[j].x, 0, false); d = __builtin_amdgcn_sdot4((int)q1, (int)src[j].y, d, false); \
            d += shx_i<1>(d); d += shx_i<2>(d); d += dpp_hmirror_i(d); sc[(i0) + j] = (float)d * qsc; vw[(i0) + j] = (u32x2){src[j].z, src[j].w}; }
    SP_LOAD(iw, ka, 0); SP_LOAD(iw, kb, 8);
#pragma unroll 1
    for (; t < S; t += stride) {
        unsigned q0, q1; float qsc;
        { float qv[8]; unpack8(qw, qv); float qm = 0.f;
#pragma unroll
          for (int j = 0; j < 8; ++j) qm = fmaxf(qm, fabsf(qv[j]));
          qm = fmaxf(qm, shx<1>(qm)); qm = fmaxf(qm, shx<2>(qm)); qm = fmaxf(qm, __int_as_float(dpp_hmirror_i(__float_as_int(qm)))); qm = fmaxf(qm, 1e-20f);
          const float sq = 127.0f / qm;
          q0 = q8pack4(qv[0] * sq, qv[1] * sq, qv[2] * sq, qv[3] * sq); q1 = q8pack4(qv[4] * sq, qv[5] * sq, qv[6] * sq, qv[7] * sq);
          qsc = C2 / (sq * SK); }
        float sc[32]; u32x2 vw[32];
        SP_QK(ka, 0);  SP_LOAD(iw, ka, 16);
        SP_QK(kb, 8);  SP_LOAD(iw, kb, 24);
        { const int tn = (t + stride < S) ? t + stride : t;
#pragma unroll
          for (int c = 0; c < 4; ++c) iw[c] = *(const GAS v4u*)(selg + (size_t)tn * 256 + 32 * kg + 8 * c);
          qw = *(const GAS v4u*)(proj + (size_t)tn * EVEN_NP + EC_DQ + h * 64 + ds8); }
        SP_QK(ka, 16);
        SP_QK(kb, 24);
        if (t < 255) {
#pragma unroll
            for (int i = 0; i < 32; ++i) if (32 * kg + i > t) sc[i] = -INFINITY;
        }
        float mx = sc[0];
#pragma unroll
        for (int i = 1; i < 32; ++i) mx = fmaxf(mx, sc[i]);
        mx = fmaxf(mx, shx<8>(mx)); mx = fmaxf(mx, shx<16>(mx)); mx = sh32_max(mx);
        mx -= 6.988684686772166f;
        SP_LOAD(iw, ka, 0);
        int acc[8]; unsigned lsum = 0u;
#pragma unroll
        for (int e = 0; e < 8; ++e) acc[e] = 0;
#pragma unroll
        for (int i = 0; i < 32; i += 4) {
            if (i == 16) { SP_LOAD(iw, kb, 8); }
            unsigned pw = __builtin_amdgcn_cvt_pk_u8_f32(__builtin_amdgcn_exp2f(sc[i] - mx), 0u, 0u);
            pw = __builtin_amdgcn_cvt_pk_u8_f32(__builtin_amdgcn_exp2f(sc[i + 1] - mx), 1u, pw);
            pw = __builtin_amdgcn_cvt_pk_u8_f32(__builtin_amdgcn_exp2f(sc[i + 2] - mx), 2u, pw);
            pw = __builtin_amdgcn_cvt_pk_u8_f32(__builtin_amdgcn_exp2f(sc[i + 3] - mx), 3u, pw);
            lsum = __builtin_amdgcn_udot4(pw, 0x01010101u, lsum, false);
#pragma unroll
            for (int hw = 0; hw < 2; ++hw) {
                const unsigned A = hw ? vw[i].y : vw[i].x, B = hw ? vw[i + 1].y : vw[i + 1].x, C = hw ? vw[i + 2].y : vw[i + 2].x, D = hw ? vw[i + 3].y : vw[i + 3].x;
                const unsigned ablo = __builtin_amdgcn_perm(B, A, 0x05010400u), abhi = __builtin_amdgcn_perm(B, A, 0x07030602u);
                const unsigned cdlo = __builtin_amdgcn_perm(D, C, 0x05010400u), cdhi = __builtin_amdgcn_perm(D, C, 0x07030602u);
                const unsigned t0_ = __builtin_amdgcn_perm(cdlo, ablo, 0x05040100u), t1_ = __builtin_amdgcn_perm(cdlo, ablo, 0x07060302u);
                const unsigned t2_ = __builtin_amdgcn_perm(cdhi, abhi, 0x05040100u), t3_ = __builtin_amdgcn_perm(cdhi, abhi, 0x07060302u);
                acc[4 * hw + 0] = __builtin_amdgcn_sdot4((int)pw, (int)t0_, acc[4 * hw + 0], false); acc[4 * hw + 1] = __builtin_amdgcn_sdot4((int)pw, (int)t1_, acc[4 * hw + 1], false);
                acc[4 * hw + 2] = __builtin_amdgcn_sdot4((int)pw, (int)t2_, acc[4 * hw + 2], false); acc[4 * hw + 3] = __builtin_amdgcn_sdot4((int)pw, (int)t3_, acc[4 * hw + 3], false);
            }
        }
        int ls = (int)lsum; ls += shx_i<8>(ls); ls += shx_i<16>(ls); { auto r = __builtin_amdgcn_permlane32_swap((unsigned)ls, (unsigned)ls, false, false); ls = (int)r[0] + (int)r[1]; }
        const float inv = (vmaxh * (1.0f / 127.0f)) / (float)ls;
        float o[8];
#pragma unroll
        for (int e = 0; e < 8; ++e) { int a = acc[e]; a += shx_i<8>(a); a += shx_i<16>(a); { auto r = __builtin_amdgcn_permlane32_swap((unsigned)a, (unsigned)a, false, false); a = (int)r[0] + (int)r[1]; } o[e] = (float)a * inv; }
        if (kg == 0) *(GAS v4u*)(obase + (size_t)t * opitch + h * 64 + ds8) = pack8(o);
    }
#undef SP_LOAD
#undef SP_QK
}
#undef SP_IDXA

struct Args { InPtrs in; float* out; unsigned char* ws; int ph_lo, ph_hi, li, pad; };
constexpr int PH_PER_LAYER = 13, N_PHASES = 1 + 2 * PH_PER_LAYER;

__global__ void __launch_bounds__(NTHREADS, 2) hyb_fwd(Args args) {
    extern __shared__ __attribute__((aligned(16))) unsigned char lds_raw[];
    LAS unsigned char* lds = (LAS unsigned char*)lds_raw;
    volatile LAS unsigned* MISC = (volatile LAS unsigned*)(lds + MISC_OFF);
    const int tid = threadIdx.x, lane = tid & 63, wave = __builtin_amdgcn_readfirstlane(tid >> 6);
    const int G = gridDim.x;
    const int vcu = (G % 8 == 0) ? ((int)blockIdx.x % 8) * (G / 8) + (int)blockIdx.x / 8 : (int)blockIdx.x;
    unsigned char* ws = args.ws;
    gu32* ctl = (gu32*)(ws + WS_CTL);
    for (int u = tid; u < (LDS_BYTES - LDSCTL_OFF) / 4; u += NTHREADS) ((LAS unsigned*)(lds + LDSCTL_OFF))[u] = 0u;
    __syncthreads();
    if (tid == 0) {
#pragma unroll
        for (int i = 0; i < 26; ++i) *(LAS unsigned long long*)(lds + INTAB_OFF + 8 * i) = (unsigned long long)args.in.p[i]; }
    __syncthreads();
    XcdBarrier bar = xcd_barrier_post((unsigned*)(ctl + CW_BAR) + args.li * XCD_BAR_WORDS, MISC + 8);
    const int tid0 = tid; unsigned char* const ws0 = ws;
    for (int ph = args.ph_lo; ph < args.ph_hi; ++ph) {
        int tid = tid0; asm volatile("" : "+v"(tid));
        unsigned char* ws = ws0; asm volatile("" : "+s"(ws));
        const int lane = tid & 63, wave = __builtin_amdgcn_readfirstlane(tid >> 6);
        LAS unsigned char* lds = (LAS unsigned char*)lds_raw; { unsigned lo_ = (unsigned)(uintptr_t)lds; asm volatile("" : "+s"(lo_)); lds = (LAS unsigned char*)(uintptr_t)lo_; }
        InTab inl; inl.ldsbase = lds;
        float* ssqA = (float*)(ws + WS_SSQ);
        bf16* HB = (bf16*)(ws + WS_HB);
        unsigned char* spare = (unsigned char*)args.out;
        unsigned char* Wr = ws + WS_W;
        unsigned char* BIG = ws + WS_BIG;
        const int gw = vcu * NWAVES + wave, NGW = G * NWAVES;
        if (ph == 0) {
#ifdef PROBE_P02
            conv_weights(inl, ws, 0, 1 | 2 | 4, lds, gw, NGW, wave, lane);
            copy_x(inl.get(0), spare + 32 * MiB, (float*)(spare + 48 * MiB), HB, ssqA, gw, NGW, lane);
            rope_tables((float*)(ws + WS_ROPE), (float*)(ws + WS_ROPE) + S * 8, (int)blockIdx.x * NTHREADS + tid, G * NTHREADS);
            __syncthreads();
            for (int un = blockIdx.x; un < 256; un += G) mem_kv(inl, ws, lds, un, tid, wave, lane);
            for (int idx = (int)blockIdx.x * NTHREADS + tid; idx < 1024 * 16; idx += G * NTHREADS) {
                const int k = idx >> 4, col = idx & 15;
                const float v = inl.get(5)[k] * inl.get(6)[(size_t)k * EVEN_SRC + (col < 8 ? ES_FL + col : ES_IW + col - 8)];
                const int ln = (k & 255) >> 2, e = k & 3, q = k >> 8, c = col >> 2;
                ((float*)(ws + WS_TW))[((((q * 4 + e) * 4 + c) * 64 + ln) << 2) + (col & 3)] = v; }
            __syncthreads();
#endif
#ifndef NO_P0
            conv_weights(inl, ws, 0, 1 | 2 | 4, lds, gw, NGW, wave, lane);
            conv_q8_weights(inl, ws, 0, 1, lds, (int)blockIdx.x, G, wave, lane);
            copy_x(inl.get(0), spare + 32 * MiB, (float*)(spare + 48 * MiB), HB, ssqA, gw, NGW, lane);
            if (blockIdx.x == 0 && tid < 384) { const int gi = tid >> 6, d = tid & 63;
                float v;
                if (gi == 0) v = inl.get(8)[d]; else if (gi == 1) v = inl.get(10)[d]; else if (gi == 2) v = inl.get(9)[d]; else if (gi == 3) v = inl.get(11)[d]; else if (gi == 4) v = inl.get(13)[d]; else v = inl.get(14)[d];
                ((float*)(ws + WS_GT))[tid] = v; }
            rope_tables((float*)(ws + WS_ROPE), (float*)(ws + WS_ROPE) + S * 8, (int)blockIdx.x * NTHREADS + tid, G * NTHREADS);
            __syncthreads();
            for (int un = blockIdx.x; un < 256; un += G) mem_kv(inl, ws, lds, un, tid, wave, lane);
            for (int idx = (int)blockIdx.x * NTHREADS + tid; idx < 1024 * 16; idx += G * NTHREADS) {
                const int k = idx >> 4, col = idx & 15;
                const float v = inl.get(5)[k] * inl.get(6)[(size_t)k * EVEN_SRC + (col < 8 ? ES_FL + col : ES_IW + col - 8)];
                const int ln = (k & 255) >> 2, e = k & 3, q = k >> 8, c = col >> 2;
                ((float*)(ws + WS_TW))[((((q * 4 + e) * 4 + c) * 64 + ln) << 2) + (col & 3)] = v; }
#endif
        } else {
            const int L = (ph - 1) / PH_PER_LAYER, sub = (ph - 1) % PH_PER_LAYER;
            const bool even = (L & 1) == 0;
            if (even && sub == 6) continue;
            if (!even && sub == 3) continue;
#ifndef MEM_UNFUSED
            if (sub == 9 || sub == 10) continue;
#endif
            float* ssq_in = ssqA;
            if (sub == 0 || sub == 11) {
                unsigned char* HQ = spare + 32 * MiB; float* sa = (float*)(spare + 48 * MiB);
                if (!(L == 0 && sub == 0)) { quant_rows(HB, HQ, sa, gw, NGW, lane); xcd_barrier(bar); }
                pg8::Gemm g{(const pg8::bf16_t*)HQ, (const pg8::bf16_t*)(Wr + (sub == 0 ? W_FFN1_IN : W_FFN2_IN)), S, FF2, DM / 2, DM / 2};
                pg8::StaticOrder So; So.init(S, FF2, G, (int)blockIdx.x);
                pg8::EpiSwiGLU8 E{(pg8::bf16_t*)(BIG + B_U), ssq_in, FF, sa, (const float*)(ws + WS_SB) + (sub == 0 ? 0 : 8192)};
#ifdef PROBE_GEMM8
                pg8::gemm_phase<pg8::EpiSwiGLU8, pg8::StaticOrder, true, true>(lds, g, So, E, tid); __syncthreads();
#endif
                pg8::gemm_phase<pg8::EpiSwiGLU8, pg8::StaticOrder, true, true>(lds, g, So, E, tid);
            } else if (sub == 1 || sub == 7 || sub == 10 || sub == 12) {
                pg8::Gemm g; float scale; int so;
                if (sub == 1)       { g = pg8::Gemm{(const pg8::bf16_t*)(BIG + B_U), (const pg8::bf16_t*)(Wr + W_FFN1_OUT), S, DM, FF, FF}; scale = 0.5f; so = 1; }
                else if (sub == 7)  { g = pg8::Gemm{(const pg8::bf16_t*)(BIG + B_PROJ), (const pg8::bf16_t*)(Wr + W_MIX_OUT), S, DM, DM, even ? EVEN_NP : DM}; scale = 1.0f; so = 2; }
                else if (sub == 10)  { g = pg8::Gemm{(const pg8::bf16_t*)(BIG + B_OM), (const pg8::bf16_t*)(Wr + (L ? W_MEMO2 : W_MEMO)), S, DM, MEMW, MEMW}; scale = 1.0f; so = 3; }
                else                { g = pg8::Gemm{(const pg8::bf16_t*)(BIG + B_U), (const pg8::bf16_t*)(Wr + W_FFN2_OUT), S, DM, FF, FF}; scale = 0.5f; so = 4; }
                const bool last = (sub == 12 && L == NLAYER - 1);
                pg8::StaticOrder So; So.init(S, DM, G, (int)blockIdx.x);
                pg8::EpiResid E{(pg8::bf16_t*)HB, last ? args.out : nullptr, ssqA, scale};
                pg8::gemm_phase<pg8::EpiResid, pg8::StaticOrder, true, true>(lds, g, So, E, tid);
#ifdef PROBE_GEMM2
                if (!last) { __syncthreads(); pg8::EpiResid E0 = E; E0.scale = 0.f; pg8::gemm_phase<pg8::EpiResid, pg8::StaticOrder, true, true>(lds, g, So, E0, tid); }
#endif
            } else if (sub == 2) {
                const int N = even ? EVEN_NP : ODD_N;
                pg8::Gemm g{(const pg8::bf16_t*)HB, (const pg8::bf16_t*)(Wr + W_MIX_IN), S, N, DM, DM};
                pg8::EpiProj E;
                E.O = (pg8::bf16_t*)(BIG + B_PROJ); E.ldc = even ? EVEN_NP : DM; E.ssq = ssq_in; E.split_cols = even ? 0 : DM; E.split_stride = (size_t)S * DM; E.even = even ? 1 : 0;
                E.gtab = (const float*)(ws + WS_GT);
                E.cosT = (const float*)(ws + WS_ROPE); E.sinT = E.cosT + S * 8;
                E.Vt = (pg8::bf16_t*)(BIG + (even ? B_VTF : B_VTM)); E.IKf = (pg8::bf16_t*)(BIG + B_IKC);
                E.xch = (LAS float*)(lds + 131072);
                E.ksum = (float*)(ws + WS_KSUM);
                pg8::StaticOrder So; So.init(S, N, G, (int)blockIdx.x);
#ifdef PROBE_MIXIN2
                pg8::gemm_phase<pg8::EpiProj, pg8::StaticOrder, true, true>(lds, g, So, E, tid); __syncthreads();
#endif
                pg8::gemm_phase<pg8::EpiProj, pg8::StaticOrder, true, true>(lds, g, So, E, tid);
#ifndef MEM_UNFUSED
            } else if (sub == 8) {
                memfused_phase(inl, ws, L, ssq_in, args.out, HB, ssqA, lds, G, tid, wave, lane);
                {
                    __syncthreads();
                    if (L == 0) conv_weights(inl, ws, 1, 1 | 2 | 4 | 8 | 16 | 32, lds, gw, NGW, wave, lane);
                    else        conv_weights(inl, ws, 1, 64 | 128, lds, gw, NGW, wave, lane);
                }
#endif
            } else if (sub == 8) {
                if ((int)blockIdx.x >= 64 && G > 64) {
                    const int cw = ((int)blockIdx.x - 64) * NWAVES + wave, ncw = (G - 64) * NWAVES;
                    if (L == 0) conv_weights(inl, ws, 1, 1 | 2 | 4 | 8 | 16 | 32, lds, cw, ncw, wave, lane);
                    else        conv_weights(inl, ws, 1, 64 | 128, lds, cw, ncw, wave, lane);
                    conv_q8_weights(inl, ws, 1, L == 0 ? 1 : 64, lds, (int)blockIdx.x - 64, G - 64, wave, lane);
                }
                pg8::Gemm g{(const pg8::bf16_t*)HB, (const pg8::bf16_t*)(Wr + (L ? W_MEMQ2 : W_MEMQ)), S, MEMW, DM, DM};
                pg8::EpiScale E{(pg8::bf16_t*)(BIG + B_QM), MEMW, ssq_in, 0, 0};
                pg8::StaticOrder So; So.init(S, g.N, G, (int)blockIdx.x);
                pg8::gemm_phase<pg8::EpiScale, pg8::StaticOrder, true, true>(lds, g, So, E, tid);
            } else if (sub == 3) {
                if (even) post_even(inl, ws, HB, ssq_in, lds, G, tid, wave, lane);
                if (L == 0) { __syncthreads(); conv_weights(inl, ws, 0, 8 | 16 | 32 | 64 | 128, lds, gw, NGW, wave, lane); conv_q8_weights(inl, ws, 0, 64, lds, (int)blockIdx.x, G, wave, lane); }
            } else if (sub == 4) {
                if (even) {
                    int nrep = 1;
#ifdef PROBE_DSA2
                    nrep = 2;
#endif
                    asm volatile("" : "+s"(nrep));
#ifdef PROBE_SELHL
                    dsa_select_phase<true, true, true>(ws, lds, G, tid, wave, lane); __syncthreads();
#endif
#ifdef PROBE_SELNI
                    dsa_select_phase<true, true>(ws, lds, G, tid, wave, lane); __syncthreads();
#endif
#ifdef PROBE_SELL1
                    { int jm0 = 0; asm volatile("" : "+s"(jm0)); dsa_select_phase<true>(ws, lds, G, tid, wave, lane, jm0); __syncthreads(); }
#endif
#ifdef PROBE_SELNC
                    dsa_select_phase<true>(ws, lds, G, tid, wave, lane); __syncthreads();
#endif
                    dsa_quant_phase(inl, ws, spare, G, wave, lane);
                    for (int rep = 0; rep < nrep; ++rep) { dsa_select_phase<false>(ws, lds, G, tid, wave, lane); __syncthreads(); }
                } else {
                    moba_gate_phase(ws, G, wave, lane);
                }
            } else if (sub == 5) {
                if (even) {
                    bf16* projb = (bf16*)(BIG + B_PROJ);
#ifdef PROBE_FOX2
                    fox_phase(inl, ws, lds, G, tid, wave, lane, (bf16*)(spare + 32 * MiB), 512, CW_FOXQ + 64); __syncthreads();
#endif
#ifdef PROBE_SPARSE2
                    dsa_sparse_phase(inl, ws, spare, G, wave, lane, (bf16*)(spare + 48 * MiB), 512);
#endif
                    fox_phase(inl, ws, lds, G, tid, wave, lane, projb + EC_FQ, EVEN_NP, CW_FOXQ);
                    dsa_sparse_phase(inl, ws, spare, G, wave, lane, projb + EC_DQ, EVEN_NP);
                } else {
#ifdef PROBE_MOBA2
                    moba_route_phase(ws, spare, lds, G, tid, wave, lane, CW_MOBAQ + 64); __syncthreads();
#endif
                    moba_route_phase(ws, spare, lds, G, tid, wave, lane, CW_MOBAQ);
                }
            } else if (sub == 6) {
#ifdef PROBE_OWN2
                if (!even) { moba_own_phase(ws, spare, lds, G, tid, wave, lane, (bf16*)(BIG + 160 * MiB), 0); __syncthreads(); }
#endif
                if (!even) moba_own_phase(ws, spare, lds, G, tid, wave, lane, (bf16*)(BIG + B_PROJ), DM);
            } else if (sub == 9) {
#ifdef PROBE_MEM2
                memattn_phase(inl, ws, L, lds, G, tid, wave, lane); __syncthreads();
#endif
                memattn_phase(inl, ws, L, lds, G, tid, wave, lane);
            }
        }
        if (ph + 1 < args.ph_hi) xcd_barrier(bar);
#ifdef PROBE_BAR2
        if (ph + 1 < args.ph_hi) xcd_barrier(bar);
#endif
    }
}

#ifndef MK_N_LAUNCHES
#define MK_N_LAUNCHES 1
#endif
extern "C" void kernel_launch(void* const* d_in, const int* in_sizes, int n_in, void* d_out, int out_size, void* d_ws, size_t ws_size, hipStream_t stream) {
    static int grid = 0;
    if (grid == 0) {
        if (n_in != 26 || in_sizes[0] != S * DM || out_size != S * DM || ws_size < WS_END) {
            fprintf(stderr, "kernel_launch: unexpected problem (n_in %d, in0 %d, out %d, ws %zu); nothing launched\n", n_in, n_in > 0 ? in_sizes[0] : -1, out_size, ws_size); grid = -1; return; }
        int dev = 0, cus = 0, per_cu = 0;
        if (hipGetDevice(&dev) != hipSuccess || hipDeviceGetAttribute(&cus, hipDeviceAttributeMultiprocessorCount, dev) != hipSuccess) { grid = -1; return; }
        if (hipFuncSetAttribute((const void*)hyb_fwd, hipFuncAttributeMaxDynamicSharedMemorySize, LDS_BYTES) != hipSuccess) { fprintf(stderr, "kernel_launch: hipFuncSetAttribute failed\n"); grid = -1; return; }
        if (hipOccupancyMaxActiveBlocksPerMultiprocessor(&per_cu, (const void*)hyb_fwd, NTHREADS, LDS_BYTES) != hipSuccess || per_cu < 1)
            fprintf(stderr, "kernel_launch: note: occupancy query reports %d workgroups per CU\n", per_cu);
        (void)hipGetLastError();
        grid = cus;
    }
    if (grid < 0) return;
    if (hipMemsetAsync((char*)d_ws + WS_CTL, 0, CTL_ZERO_BYTES, stream) != hipSuccess) { fprintf(stderr, "kernel_launch: hipMemsetAsync failed\n"); return; }
    Args a{};
    for (int i = 0; i < 26; ++i) a.in.p[i] = (const float*)d_in[i];
    a.out = (float*)d_out; a.ws = (unsigned char*)d_ws;
#if MK_N_LAUNCHES == 1
    a.ph_lo = 0; a.ph_hi = N_PHASES; a.li = 0;
    hipLaunchKernelGGL(hyb_fwd, dim3(grid), dim3(NTHREADS), LDS_BYTES, stream, a);
#else
    for (int ph = 0; ph < N_PHASES; ++ph) { a.ph_lo = ph; a.ph_hi = ph + 1; a.li = 0; hipLaunchKernelGGL(hyb_fwd, dim3(grid), dim3(NTHREADS), LDS_BYTES, stream, a); }
#endif
    const hipError_t le = hipPeekAtLastError();
    if (le != hipSuccess) fprintf(stderr, "kernel_launch: launch failed: %s\n", hipGetErrorName(le));
}
```

```cpp
#include <hip/hip_runtime.h>
#include <cstdio>
#include <cstdint>
#define MEM_UNFUSED 1

template <int M> __device__ __forceinline__ int shx_i(int v) {
    if constexpr (M == 1) return __builtin_amdgcn_mov_dpp(v, 0xB1, 0xF, 0xF, true);
    else if constexpr (M == 2) return __builtin_amdgcn_mov_dpp(v, 0x4E, 0xF, 0xF, true);
    else if constexpr (M == 8) return __builtin_amdgcn_mov_dpp(v, 0x128, 0xF, 0xF, true);
    else return __builtin_amdgcn_ds_swizzle(v, (M << 10) | 0x1f);
}
__device__ __forceinline__ int dpp_hmirror_i(int v) { return __builtin_amdgcn_mov_dpp(v, 0x141, 0xF, 0xF, true); }
template <int M> __device__ __forceinline__ float shx(float v) { return __int_as_float(shx_i<M>(__float_as_int(v))); }
__device__ __forceinline__ float sh32_sum(float v) { auto r = __builtin_amdgcn_permlane32_swap(__float_as_uint(v), __float_as_uint(v), false, false); return __uint_as_float(r[0]) + __uint_as_float(r[1]); }
__device__ __forceinline__ float sh32_max(float v) { auto r = __builtin_amdgcn_permlane32_swap(__float_as_uint(v), __float_as_uint(v), false, false); return fmaxf(__uint_as_float(r[0]), __uint_as_float(r[1])); }
__device__ __forceinline__ int sum32_i(int c) { c += shx_i<1>(c); c += shx_i<2>(c); c += shx_i<4>(c); c += shx_i<8>(c); c += shx_i<16>(c); return c; }
namespace pg8 {
#define PG8_LAS __attribute__((address_space(3)))
typedef unsigned short bf16_t;
typedef short bf16x8 __attribute__((ext_vector_type(8)));
typedef float f32x4 __attribute__((ext_vector_type(4)));
typedef unsigned u32x4 __attribute__((ext_vector_type(4)));
constexpr int BM = 256, BK = 64, HALF = 128, HTB = HALF * BK * 2  , STAGE_BYTES = 8 * HTB, NXCD = 8, WGM = 8;

__host__ __device__ __forceinline__ int lds_byte(int r, int c) { const int st = (r >> 4) * 2 + (c >> 5), rr = r & 15, cc = c & 31, ob = rr * 64 + cc * 2; return st * 1024 + (ob ^ (((ob >> 9) & 1) << 5)); }
__host__ __device__ __forceinline__ void stage_rc(int b, int& R, int& C) { const int st = b / 1024, sb = b % 1024, swz = sb ^ (((sb >> 9) & 1) << 5); R = (st >> 1) * 16 + swz / 64; C = (st & 1) * 32 + (swz % 64) / 2; }
__host__ __device__ __forceinline__ int perm32(int rho) { const int n = rho >> 4, i = rho & 15; return 8 * (i >> 2) + 4 * n + (i & 3); }

struct Unit { int pm, pn; };
struct Gemm { const bf16_t* A; const bf16_t* Bt; int M, N, K, lda; };

struct StaticOrder {
    int nM, nN, nwg, G, c;
    __host__ __device__ __forceinline__ void init(int M, int N, int G_, int c_) { nM = M / BM; nN = N / BM; nwg = nM * nN; G = G_; c = c_; }
    __host__ __device__ __forceinline__ bool next(int i, Unit& u) const {
        const long L = (long)i * G + c; if (L >= nwg) return false;
        int wgid = (int)L; { const int q = nwg / NXCD, r = nwg % NXCD, xcd = wgid % NXCD, off = wgid / NXCD; wgid = (xcd < r ? xcd * (q + 1) : r * (q + 1) + (xcd - r) * q) + off; }
        const int nig = WGM * nN, gid = wgid / nig, fm = gid * WGM, gsz = (nM - fm) < WGM ? (nM - fm) : WGM;
        u.pm = fm + ((wgid % nig) % gsz); u.pn = (wgid % nig) / gsz; return true;
    }
    __device__ __forceinline__ void a_ready(const Unit&) const {}
    __device__ __forceinline__ void done(const Unit&) const {}
};

__device__ __forceinline__ unsigned cvt_pk_bf16(float lo, float hi) { unsigned r; asm volatile("v_cvt_pk_bf16_f32 %0, %1, %2" : "=v"(r) : "v"(lo), "v"(hi)); return r; }
typedef float f32x2 __attribute__((ext_vector_type(2)));
constexpr float RMS_EPS_F = 1e-6f;
__device__ __forceinline__ float silu_f(float x) { return x * __builtin_amdgcn_rcpf(1.0f + __builtin_amdgcn_exp2f(-1.4426950408889634f * x)); }
__device__ __forceinline__ float row_rstd(const float* ssq, int row) {
    const f32x4* p = (const f32x4*)(ssq + (size_t)row * 16); const f32x4 a = p[0], b = p[1], c = p[2], d = p[3];
    const float s = ((a[0] + a[1]) + (a[2] + a[3])) + ((b[0] + b[1]) + (b[2] + b[3])) + ((c[0] + c[1]) + (c[2] + c[3])) + ((d[0] + d[1]) + (d[2] + d[3]));
    return rsqrtf(s * (1.0f / 1024.0f) + RMS_EPS_F); }

struct EpiSwiGLU {
    static constexpr bool PERM = true, AFTER_DRAIN = false;
    bf16_t* U; const float* ssq; int ldu;
    __device__ __forceinline__ void operator()(const f32x4 (&acc)[2][2][4][2], const Unit& u, int wr, int wc, int fr, int fq) const {
        const int row0 = u.pm * BM + wr * 64 + fr, col0 = u.pn * HALF + wc * 32 + 8 * fq;
#pragma unroll
        for (int ai = 0; ai < 2; ++ai)
#pragma unroll
            for (int m = 0; m < 4; ++m) {
                const int row = row0 + ai * HALF + m * 16; const float r = row_rstd(ssq, row);
                const f32x4 a0 = acc[ai][0][m][0] * r, a1 = acc[ai][0][m][1] * r, b0 = acc[ai][1][m][0] * r, b1 = acc[ai][1][m][1] * r;
                u32x4 w;
                w.x = cvt_pk_bf16(silu_f(a0[0]) * b0[0], silu_f(a0[1]) * b0[1]); w.y = cvt_pk_bf16(silu_f(a0[2]) * b0[2], silu_f(a0[3]) * b0[3]);
                w.z = cvt_pk_bf16(silu_f(a1[0]) * b1[0], silu_f(a1[1]) * b1[1]); w.w = cvt_pk_bf16(silu_f(a1[2]) * b1[2], silu_f(a1[3]) * b1[3]);
                *(u32x4*)(U + (size_t)row * ldu + col0) = w;
            }
    }
};
typedef int i32x4 __attribute__((ext_vector_type(4)));
struct EpiSwiGLU8 {
    static constexpr bool PERM = true, AFTER_DRAIN = false, I8 = true;
    bf16_t* U; const float* ssq; int ldu; const float* sa; const float* sb;
    __device__ __forceinline__ void operator()(const i32x4 (&acc)[2][2][4][2], const Unit& u, int wr, int wc, int fr, int fq) const {
        const int row0 = u.pm * BM + wr * 64 + fr, col0 = u.pn * HALF + wc * 32 + 8 * fq, wrow = u.pn * BM + wc * 32 + 8 * fq;
        const f32x4 sA0 = *(const f32x4*)(sb + wrow), sA1 = *(const f32x4*)(sb + wrow + 4), sB0 = *(const f32x4*)(sb + wrow + HALF), sB1 = *(const f32x4*)(sb + wrow + HALF + 4);
#pragma unroll
        for (int ai = 0; ai < 2; ++ai)
#pragma unroll
            for (int m = 0; m < 4; ++m) {
                const int row = row0 + ai * HALF + m * 16; const float r = sa[row];
                const float nr = -1.4426950408889634f * r, ir2 = __builtin_amdgcn_rcpf(r * r);
                u32x4 w; float o[8];
#pragma unroll
                for (int h2 = 0; h2 < 2; ++h2) {
                    const f32x4 z = __builtin_convertvector(acc[ai][0][m][h2], f32x4) * (h2 ? sA1 : sA0), ww = __builtin_convertvector(acc[ai][1][m][h2], f32x4) * (h2 ? sB1 : sB0);
                    const f32x4 zw = z * ww, t = z * nr;
#pragma unroll
                    for (int e2 = 0; e2 < 4; ++e2) { const float ex = __builtin_amdgcn_exp2f(t[e2]); o[4 * h2 + e2] = zw[e2] * __builtin_amdgcn_rcpf(__builtin_fmaf(ex, ir2, ir2)); }
                }
                w.x = cvt_pk_bf16(o[0], o[1]); w.y = cvt_pk_bf16(o[2], o[3]); w.z = cvt_pk_bf16(o[4], o[5]); w.w = cvt_pk_bf16(o[6], o[7]);
                *(u32x4*)(U + (size_t)row * ldu + col0) = w;
            }
    }
};
struct EpiResid {
    static constexpr bool PERM = true, AFTER_DRAIN = false;
    bf16_t* HB; float* Hout; float* ssq_out; float scale;
    __device__ __forceinline__ void operator()(const f32x4 (&acc)[2][2][4][2], const Unit& u, int wr, int wc, int fr, int fq) const {
        const int row0 = u.pm * BM + wr * 64 + fr, col0 = u.pn * BM + wc * 32 + 8 * fq;
#pragma unroll
        for (int ai = 0; ai < 2; ++ai)
#pragma unroll
            for (int m = 0; m < 4; ++m) {
                const int row = row0 + ai * HALF + m * 16; float sq = 0.f;
#pragma unroll
                for (int bj = 0; bj < 2; ++bj) {
                    bf16_t* hbp = HB + (size_t)row * 1024 + col0 + bj * HALF;
                    const u32x4 wi = *(const u32x4*)hbp;
                    f32x4 h0, h1;
                    h0[0] = __uint_as_float(wi.x << 16); h0[1] = __uint_as_float(wi.x & 0xffff0000u); h0[2] = __uint_as_float(wi.y << 16); h0[3] = __uint_as_float(wi.y & 0xffff0000u);
                    h1[0] = __uint_as_float(wi.z << 16); h1[1] = __uint_as_float(wi.z & 0xffff0000u); h1[2] = __uint_as_float(wi.w << 16); h1[3] = __uint_as_float(wi.w & 0xffff0000u);
                    h0 = h0 + acc[ai][bj][m][0] * scale; h1 = h1 + acc[ai][bj][m][1] * scale;
                    if (Hout) { float* hp = Hout + (size_t)row * 1024 + col0 + bj * HALF; *(f32x4*)hp = h0; *(f32x4*)(hp + 4) = h1; }
                    else {
                        sq += (h0[0] * h0[0] + h0[1] * h0[1]) + (h0[2] * h0[2] + h0[3] * h0[3]) + (h1[0] * h1[0] + h1[1] * h1[1]) + (h1[2] * h1[2] + h1[3] * h1[3]);
                        u32x4 w; w.x = cvt_pk_bf16(h0[0], h0[1]); w.y = cvt_pk_bf16(h0[2], h0[3]); w.z = cvt_pk_bf16(h1[0], h1[1]); w.w = cvt_pk_bf16(h1[2], h1[3]);
                        *(u32x4*)hbp = w; }
                }
                if (!Hout) { sq += shx<16>(sq); sq = sh32_sum(sq); if (fq == 0) ssq_out[(size_t)row * 16 + u.pn * 4 + wc] = sq; }
            }
    }
};
struct EpiScale {
    static constexpr bool PERM = true, AFTER_DRAIN = false;
    bf16_t* O; int ldc; const float* ssq; int split_cols; size_t split_stride;
    __device__ __forceinline__ void operator()(const f32x4 (&acc)[2][2][4][2], const Unit& u, int wr, int wc, int fr, int fq) const {
        const int row0 = u.pm * BM + wr * 64 + fr; int colt = u.pn * BM; bf16_t* base = O;
        if (split_cols) { const int t = colt / split_cols; base += (size_t)t * split_stride; colt -= t * split_cols; }
        const int col0 = colt + wc * 32 + 8 * fq;
#pragma unroll
        for (int ai = 0; ai < 2; ++ai)
#pragma unroll
            for (int m = 0; m < 4; ++m) {
                const int row = row0 + ai * HALF + m * 16; const float r = row_rstd(ssq, row);
                bf16_t* rowp = base + (size_t)row * ldc + col0;
#pragma unroll
                for (int bj = 0; bj < 2; ++bj) { const f32x4 v0 = acc[ai][bj][m][0] * r, v1 = acc[ai][bj][m][1] * r;
                    u32x4 w; w.x = cvt_pk_bf16(v0[0], v0[1]); w.y = cvt_pk_bf16(v0[2], v0[3]); w.z = cvt_pk_bf16(v1[0], v1[1]); w.w = cvt_pk_bf16(v1[2], v1[3]);
                    *(u32x4*)(rowp + bj * HALF) = w; }
            }
    }
};

enum { KIND_PLAIN = 0, KIND_NORM = 1, KIND_NORM_ROPE = 2, KIND_ROPE = 3, KIND_VT = 4, KIND_NORM_ROPE_KSUM = 5, KIND_IK = 6, KIND_SKIP = 7 };
struct EpiProj {
    static constexpr bool PERM = true, AFTER_DRAIN = false;
    bf16_t* O; int ldc; const float* ssq; int split_cols; size_t split_stride;
    int even;
    const float* gtab;
    const float* cosT; const float* sinT;
    bf16_t* Vt;
    bf16_t* IKf;
    PG8_LAS float* xch;
    float* ksum;
    __device__ __forceinline__ void operator()(const f32x4 (&acc)[2][2][4][2], const Unit& u, int wr, int wc, int fr, int fq) const {
        const int S_ = 16384;
        int kind; int gsel = 0; int vcol0 = 0;
        if (even) { const int p = u.pn;
            kind = (p < 2) ? KIND_NORM : (p < 4) ? KIND_NORM_ROPE : (p < 6) ? KIND_NORM : (p < 8) ? KIND_NORM_ROPE : (p < 10) ? KIND_VT : (p < 12) ? KIND_PLAIN : (p < 14) ? KIND_ROPE : KIND_IK;
            gsel = (p < 8) ? (p >> 1) : 0; vcol0 = (p - 8) * 256;
        } else { const int p = u.pn; kind = (p < 4) ? KIND_NORM_ROPE : (p < 8) ? KIND_NORM_ROPE_KSUM : KIND_VT; gsel = (p < 8) ? 4 + (p >> 2) : 0; vcol0 = (p - 8) * 256; }
        const float* gn = gtab + gsel * 64;
        const int row0 = u.pm * BM + wr * 64 + fr; int colt = u.pn * BM; bf16_t* base = O;
        if (split_cols) { const int t = colt / split_cols; base += (size_t)t * split_stride; colt -= t * split_cols; }
        const int co0 = wc * 32 + 8 * fq;
        const int hd0 = 32 * (wc & 1) + 8 * fq;
        int xo = ((wr * 64 + fr) * 2) * 4 + wc, xp = ((wr * 64 + fr) * 2) * 4 + (wc ^ 1);
        asm volatile("" : "+v"(xo), "+v"(xp));
        const bool normk = (kind == KIND_NORM || kind == KIND_NORM_ROPE || kind == KIND_NORM_ROPE_KSUM);
        const bool ropek = (kind == KIND_NORM_ROPE || kind == KIND_ROPE || kind == KIND_NORM_ROPE_KSUM || kind == KIND_IK);
        float gv[8];
#pragma unroll
        for (int e2 = 0; e2 < 8; ++e2) gv[e2] = normk ? gn[hd0 + e2] : 1.0f;
        if (normk) {
#pragma unroll
            for (int ai = 0; ai < 2; ++ai)
#pragma unroll
                for (int m = 0; m < 4; ++m)
#pragma unroll
                    for (int bj = 0; bj < 2; ++bj) { const f32x4 v0 = acc[ai][bj][m][0], v1 = acc[ai][bj][m][1];
                        float ss = (v0[0] * v0[0] + v0[1] * v0[1]) + (v0[2] * v0[2] + v0[3] * v0[3]) + (v1[0] * v1[0] + v1[1] * v1[1]) + (v1[2] * v1[2] + v1[3] * v1[3]);
                        ss += shx<16>(ss); ss = sh32_sum(ss);
                        if (fq == 0) xch[xo + (ai * 128 + m * 16) * 8 + bj * 4] = ss; }
            asm volatile("s_waitcnt lgkmcnt(0)" ::: "memory"); __builtin_amdgcn_s_barrier(); asm volatile("" ::: "memory");
        }
        float csum[2][8];
#pragma unroll
        for (int b2 = 0; b2 < 2; ++b2)
#pragma unroll
            for (int e2 = 0; e2 < 8; ++e2) csum[b2][e2] = 0.f;
        if (kind != KIND_SKIP) {
#pragma unroll
        for (int ai = 0; ai < 2; ++ai)
#pragma unroll
            for (int m = 0; m < 4; ++m) {
                const int row = row0 + ai * HALF + m * 16; const float r = row_rstd(ssq, row);
                float cs[8], sn[8];
                if (ropek) { const f32x4 c0 = *(const f32x4*)(cosT + (unsigned)(row * 8)), c1 = *(const f32x4*)(cosT + (unsigned)(row * 8 + 4)), s0 = *(const f32x4*)(sinT + (unsigned)(row * 8)), s1 = *(const f32x4*)(sinT + (unsigned)(row * 8 + 4));
#pragma unroll
                    for (int e2 = 0; e2 < 4; ++e2) { cs[e2] = c0[e2]; cs[4 + e2] = c1[e2]; sn[e2] = s0[e2]; sn[4 + e2] = s1[e2]; } }
#pragma unroll
                for (int bj = 0; bj < 2; ++bj) {
                    if (kind == KIND_IK && (bj == 1 || wc >= 2)) continue;
                    float x[8];
                    { const f32x4 v0 = acc[ai][bj][m][0], v1 = acc[ai][bj][m][1];
#pragma unroll
                      for (int e2 = 0; e2 < 4; ++e2) { x[e2] = v0[e2]; x[4 + e2] = v1[e2]; } }
                    float sc = r;
                    if (normk) { const float tot = xch[xo + (ai * 128 + m * 16) * 8 + bj * 4] + xch[xp + (ai * 128 + m * 16) * 8 + bj * 4];
                        sc = r * rsqrtf(tot * (r * r) * (1.0f / 64.0f) + RMS_EPS_F); }
#pragma unroll
                    for (int e2 = 0; e2 < 8; ++e2) x[e2] = x[e2] * sc * gv[e2];
                    if (ropek) {
#pragma unroll
                        for (int e2 = 0; e2 < 8; ++e2) { const float other = shx<16>(x[e2]);
                            if ((wc & 1) == 0 && fq == 0) x[e2] = x[e2] * cs[e2] - other * sn[e2];
                            else if ((wc & 1) == 0 && fq == 1) x[e2] = x[e2] * cs[e2] + other * sn[e2]; }
                    }
                    if (kind == KIND_VT) {
                        bf16_t* vp = Vt + (unsigned)((vcol0 + bj * HALF + co0) * S_ + (row & ~1));
#pragma unroll
                        for (int e2 = 0; e2 < 8; ++e2) { const float other = shx<1>(x[e2]);
                            const unsigned w = (fr & 1) ? cvt_pk_bf16(other, x[e2]) : cvt_pk_bf16(x[e2], other);
                            if (((e2 >> 2) & 1) == (fr & 1)) *(unsigned*)(vp + (unsigned)(e2 * S_)) = w; }
                    } else if (kind == KIND_IK) {
                        const int c8 = 4 * wc + fq;
                        u32x4 w; w.x = cvt_pk_bf16(x[0], x[1]); w.y = cvt_pk_bf16(x[2], x[3]); w.z = cvt_pk_bf16(x[4], x[5]); w.w = cvt_pk_bf16(x[6], x[7]);
                        *(u32x4*)(IKf + (unsigned)((((row >> 5) * 4 + (c8 >> 1)) * 64 + (c8 & 1) * 32 + (row & 31)) * 8)) = w;
                    } else {
                        u32x4 w; w.x = cvt_pk_bf16(x[0], x[1]); w.y = cvt_pk_bf16(x[2], x[3]); w.z = cvt_pk_bf16(x[4], x[5]); w.w = cvt_pk_bf16(x[6], x[7]);
                        *(u32x4*)(base + (unsigned)(row * ldc + colt + bj * HALF + co0)) = w;
                        if (kind == KIND_NORM_ROPE_KSUM) {
                            csum[bj][0] += __uint_as_float(w.x << 16); csum[bj][1] += __uint_as_float(w.x & 0xffff0000u); csum[bj][2] += __uint_as_float(w.y << 16); csum[bj][3] += __uint_as_float(w.y & 0xffff0000u);
                            csum[bj][4] += __uint_as_float(w.z << 16); csum[bj][5] += __uint_as_float(w.z & 0xffff0000u); csum[bj][6] += __uint_as_float(w.w << 16); csum[bj][7] += __uint_as_float(w.w & 0xffff0000u); }
                    }
                }
            }
        }
        if (kind == KIND_NORM_ROPE_KSUM) {
#pragma unroll
            for (int b2 = 0; b2 < 2; ++b2)
#pragma unroll
                for (int e2 = 0; e2 < 8; ++e2) { float v = csum[b2][e2]; v += shx<1>(v); v += shx<2>(v); v += __int_as_float(dpp_hmirror_i(__float_as_int(v))); v += shx<8>(v);
                    if (fr == 0) xch[2816 + wr * 256 + b2 * HALF + wc * 32 + 8 * fq + e2] = v; }
        }
        if (normk) { asm volatile("s_waitcnt lgkmcnt(0)" ::: "memory"); __builtin_amdgcn_s_barrier(); asm volatile("" ::: "memory"); }
        if (kind == KIND_NORM_ROPE_KSUM) { int t2 = (wr * 4 + wc) * 64 + fq * 16 + fr; asm volatile("" : "+v"(t2));
            if (t2 < BM) ksum[(unsigned)(u.pm * 1024 + (u.pn - 4) * BM + t2)] = xch[2816 + t2] + xch[2816 + 256 + t2]; }
    }
};

struct EpiPartial {
    static constexpr bool PERM = true, AFTER_DRAIN = false;
    float* P; int M;
    __device__ __forceinline__ void operator()(const f32x4 (&acc)[2][2][4][2], const Unit& u, int wr, int wc, int fr, int fq) const {
        const int row0 = u.pm * BM + wr * 64 + fr; float* base = P + (size_t)u.pn * M * 256 + wc * 32 + 8 * fq;
#pragma unroll
        for (int ai = 0; ai < 2; ++ai)
#pragma unroll
            for (int m = 0; m < 4; ++m) { float* rp = base + (unsigned)((row0 + ai * HALF + m * 16) * 256);
#pragma unroll
                for (int bj = 0; bj < 2; ++bj) { *(f32x4*)(rp + bj * HALF) = acc[ai][bj][m][0]; *(f32x4*)(rp + bj * HALF + 4) = acc[ai][bj][m][1]; } }
    }
};
typedef int i32x4 __attribute__((ext_vector_type(4)));
template <class E, class = void> struct epi_i8 { static constexpr bool value = false; };
template <class E> struct epi_i8<E, decltype((void)E::I8)> { static constexpr bool value = E::I8; };
template <bool I8> struct acc_sel { typedef f32x4 type; };
template <> struct acc_sel<true> { typedef i32x4 type; };
template <class Epi, class Sched, bool ALIGN_EPI = false, bool SP2 = false, int KSPLIT = 0, int LDB = 0>
__device__ __forceinline__ void gemm_phase(PG8_LAS unsigned char* lds, const Gemm g, const Sched& S, const Epi& E, const int tid) {
    const int wid = __builtin_amdgcn_readfirstlane(tid >> 6), lane = tid & 63, wr = wid >> 2, wc = wid & 3, fr = lane & 15, fq = lane >> 4;
    const int K = g.K, nt = K / BK;
    unsigned voffA[2], voffB[2];
#pragma unroll
    for (int i = 0; i < 2; ++i) { int R, C; stage_rc(tid * 16 + i * 8192, R, C); const int Rb = Epi::PERM ? ((R & ~31) + perm32(R & 31)) : R;
        voffA[i] = (unsigned)(R * g.lda + C) * 2u; voffB[i] = (unsigned)(Rb * (LDB ? LDB : K) + C) * 2u; }
    const size_t kstep = (size_t)(BK * 2);
    const size_t hstepA = (size_t)HALF * g.lda * 2, hstepB = (size_t)HALF * (LDB ? LDB : K) * 2;
    const size_t tstepA = 2 * hstepA, tstepB = 2 * hstepB;
    const unsigned ldsw = (unsigned)wid * 1024u;
    const int aoff = lds_byte(wr * 64 + fr, fq * 8), boff = lds_byte(wc * 32 + fr, fq * 8);
#define PG8_SA(b, h) (((b) * 2 + (h)) * HTB)
#define PG8_SB(b, h) ((4 + (b) * 2 + (h)) * HTB)
#define PG8_STAGE(bufoff, gbase, voff) do { _Pragma("unroll") for (int _i = 0; _i < 2; ++_i) \
        __builtin_amdgcn_global_load_lds((const unsigned*)((const char*)(gbase) + (voff)[_i]), (PG8_LAS unsigned*)(lds + (bufoff) + ldsw + _i * 8192), 16, 0, 0); } while (0)
#define PG8_LDA(dst, b, h) do { _Pragma("unroll") for (int m = 0; m < 4; ++m) _Pragma("unroll") for (int k = 0; k < 2; ++k) dst[m][k] = *(const PG8_LAS bf16x8*)(lds + PG8_SA(b, h) + aoff + m * 2048 + k * 1024); } while (0)
#define PG8_LDB(dst, b, h) do { _Pragma("unroll") for (int n = 0; n < 2; ++n) _Pragma("unroll") for (int k = 0; k < 2; ++k) dst[n][k] = *(const PG8_LAS bf16x8*)(lds + PG8_SB(b, h) + boff + n * 2048 + k * 1024); } while (0)
#define PG8_MMA(ai, bj, At, Bt) do { __builtin_amdgcn_s_setprio(1); _Pragma("unroll") for (int m = 0; m < 4; ++m) _Pragma("unroll") for (int n = 0; n < 2; ++n) _Pragma("unroll") for (int k = 0; k < 2; ++k) \
        { if constexpr (I8) acc[ai][bj][m][n] = __builtin_amdgcn_mfma_i32_16x16x64_i8(__builtin_bit_cast(i32x4, Bt[n][k]), __builtin_bit_cast(i32x4, At[m][k]), acc[ai][bj][m][n], 0, 0, 0); \
          else acc[ai][bj][m][n] = __builtin_amdgcn_mfma_f32_16x16x32_bf16(Bt[n][k], At[m][k], acc[ai][bj][m][n], 0, 0, 0); } __builtin_amdgcn_s_setprio(0); } while (0)
#define PG8_WAIT_V(n) asm volatile("s_waitcnt vmcnt(" #n ")" ::: "memory")
#define PG8_WAIT_L(n) asm volatile("s_waitcnt lgkmcnt(" #n ")" ::: "memory")
#define PG8_BAR __builtin_amdgcn_s_barrier()
#define PG8_SCHED __builtin_amdgcn_sched_barrier(0)
    Unit cur, nxt; int ui = 0;
    if (!S.next(0, cur)) return;
    constexpr bool I8 = epi_i8<Epi>::value; typedef typename acc_sel<I8>::type acc_t;
    acc_t acc[2][2][4][2]; acc_t zacc; zacc[0] = 0; zacc[1] = 0; zacc[2] = 0; zacc[3] = 0;
#pragma unroll
    for (int a = 0; a < 2; ++a)
#pragma unroll
        for (int b = 0; b < 2; ++b)
#pragma unroll
            for (int m = 0; m < 4; ++m)
#pragma unroll
                for (int n = 0; n < 2; ++n) acc[a][b][m][n] = zacc;
    bf16x8 At[4][2], B0[2][2], B1[2][2];
    const char* cA = (const char*)g.A + (size_t)cur.pm * tstepA + (KSPLIT ? (size_t)cur.pn * KSPLIT : (size_t)0); const char* cB = (const char*)g.Bt + (KSPLIT ? (size_t)cur.pn * KSPLIT : (size_t)cur.pn * tstepB);
    S.a_ready(cur);
    if constexpr (SP2) {
        PG8_STAGE(PG8_SB(0, 0), cB, voffB); PG8_STAGE(PG8_SB(0, 1), cB + hstepB, voffB); PG8_STAGE(PG8_SA(0, 0), cA, voffA); PG8_STAGE(PG8_SA(0, 1), cA + hstepA, voffA);
        if (wr == 1) PG8_BAR;
        PG8_WAIT_V(2); PG8_BAR;
        PG8_STAGE(PG8_SB(1, 0), cB + kstep, voffB); PG8_STAGE(PG8_SA(1, 0), cA + kstep, voffA); PG8_STAGE(PG8_SB(1, 1), cB + hstepB + kstep, voffB);
        PG8_WAIT_V(6); PG8_BAR;
    } else {
        PG8_STAGE(PG8_SB(0, 0), cB, voffB); PG8_STAGE(PG8_SA(0, 0), cA, voffA); PG8_STAGE(PG8_SB(0, 1), cB + hstepB, voffB); PG8_STAGE(PG8_SA(0, 1), cA + hstepA, voffA);
        if (wr == 1) PG8_BAR;
        PG8_WAIT_V(4); PG8_BAR;
        PG8_STAGE(PG8_SB(1, 0), cB + kstep, voffB); PG8_STAGE(PG8_SA(1, 0), cA + kstep, voffA); PG8_STAGE(PG8_SB(1, 1), cB + hstepB + kstep, voffB);
        PG8_WAIT_V(6); PG8_BAR;
    }
    for (;;) {
        const bool has_next = S.next(ui + 1, nxt);
        const char* nA = has_next ? (const char*)g.A + (size_t)nxt.pm * tstepA + (KSPLIT ? (size_t)nxt.pn * KSPLIT : (size_t)0) : cA; const char* nB = has_next ? (const char*)g.Bt + (KSPLIT ? (size_t)nxt.pn * KSPLIT : (size_t)nxt.pn * tstepB) : cB;
        for (int t = 0; t < nt; t += 2) {
            const bool last = (t == nt - 2);
            const char* a1 = cA + (size_t)(t + 1) * kstep;
            const char* a2 = last ? nA : cA + (size_t)(t + 2) * kstep; const char* b2 = last ? nB : cB + (size_t)(t + 2) * kstep;
            const char* a3 = a2 + kstep; const char* b3 = b2 + kstep;
            if (last && has_next) S.a_ready(nxt);
            if constexpr (SP2) {
            PG8_LDB(B0, 0, 0); PG8_LDB(B1, 0, 1); PG8_SCHED; PG8_LDA(At, 0, 0); PG8_STAGE(PG8_SA(1, 1), a1 + hstepA, voffA);
            PG8_WAIT_V(8); PG8_WAIT_L(0); PG8_BAR; PG8_MMA(0, 0, At, B0); PG8_MMA(0, 1, At, B1); PG8_BAR; PG8_SCHED;
            PG8_LDA(At, 0, 1); PG8_STAGE(PG8_SB(0, 0), b2, voffB); PG8_STAGE(PG8_SB(0, 1), b2 + hstepB, voffB); PG8_STAGE(PG8_SA(0, 0), a2, voffA);
            PG8_WAIT_V(8); PG8_WAIT_L(0); PG8_BAR; PG8_MMA(1, 0, At, B0); PG8_MMA(1, 1, At, B1); PG8_BAR; PG8_SCHED;
            PG8_LDB(B0, 1, 0); PG8_LDB(B1, 1, 1); PG8_SCHED; PG8_LDA(At, 1, 0); PG8_STAGE(PG8_SA(0, 1), a2 + hstepA, voffA);
            PG8_WAIT_V(8); PG8_WAIT_L(0); PG8_BAR; PG8_MMA(0, 0, At, B0); PG8_MMA(0, 1, At, B1); PG8_BAR; PG8_SCHED;
            PG8_LDA(At, 1, 1); PG8_STAGE(PG8_SB(1, 0), b3, voffB); PG8_STAGE(PG8_SB(1, 1), b3 + hstepB, voffB); PG8_STAGE(PG8_SA(1, 0), a3, voffA);
            PG8_WAIT_V(8); PG8_WAIT_L(0); PG8_BAR; PG8_MMA(1, 0, At, B0); PG8_MMA(1, 1, At, B1); PG8_BAR; PG8_SCHED;
            } else {
            PG8_LDB(B0, 0, 0); PG8_SCHED; PG8_LDA(At, 0, 0); PG8_STAGE(PG8_SA(1, 1), a1 + hstepA, voffA);
            PG8_WAIT_L(8); PG8_BAR; PG8_WAIT_L(0); PG8_MMA(0, 0, At, B0); PG8_BAR; PG8_SCHED;
            PG8_LDB(B1, 0, 1); PG8_STAGE(PG8_SB(0, 0), b2, voffB);
            PG8_BAR; PG8_WAIT_L(0); PG8_MMA(0, 1, At, B1); PG8_BAR;
            PG8_LDA(At, 0, 1); PG8_STAGE(PG8_SA(0, 0), a2, voffA);
            PG8_BAR; PG8_WAIT_L(0); PG8_MMA(1, 0, At, B0); PG8_BAR; PG8_SCHED;
            PG8_STAGE(PG8_SB(0, 1), b2 + hstepB, voffB);
            PG8_WAIT_V(6); PG8_BAR; PG8_MMA(1, 1, At, B1); PG8_BAR;
            PG8_LDB(B0, 1, 0); PG8_SCHED; PG8_LDA(At, 1, 0); PG8_STAGE(PG8_SA(0, 1), a2 + hstepA, voffA);
            PG8_WAIT_L(8); PG8_BAR; PG8_WAIT_L(0); PG8_MMA(0, 0, At, B0); PG8_BAR; PG8_SCHED;
            PG8_LDB(B1, 1, 1); PG8_STAGE(PG8_SB(1, 0), b3, voffB);
            PG8_BAR; PG8_WAIT_L(0); PG8_MMA(0, 1, At, B1); PG8_BAR;
            PG8_LDA(At, 1, 1); PG8_STAGE(PG8_SA(1, 0), a3, voffA);
            PG8_BAR; PG8_WAIT_L(0); PG8_MMA(1, 0, At, B0); PG8_BAR; PG8_SCHED;
            PG8_STAGE(PG8_SB(1, 1), b3 + hstepB, voffB);
            PG8_WAIT_V(6); PG8_BAR; PG8_MMA(1, 1, At, B1); PG8_BAR;
            }
        }
        if constexpr (ALIGN_EPI) { if (wr == 0) PG8_BAR; }
        if constexpr (!Epi::AFTER_DRAIN) { E(acc, cur, wr, wc, fr, fq); S.done(cur); }
        if (!has_next) break;
#pragma unroll
        for (int a = 0; a < 2; ++a)
#pragma unroll
            for (int b = 0; b < 2; ++b)
#pragma unroll
                for (int m = 0; m < 4; ++m)
#pragma unroll
                    for (int n = 0; n < 2; ++n) acc[a][b][m][n] = zacc;
        cur = nxt; cA = nA; cB = nB; ++ui;
        if constexpr (ALIGN_EPI) { if (wr == 1) PG8_BAR; }
    }
    PG8_WAIT_V(0);
    if constexpr (!ALIGN_EPI) { if (wr == 0) PG8_BAR; }
    PG8_BAR;
    if constexpr (Epi::AFTER_DRAIN) { E.fused(acc, cur, wr, wc, fr, fq, lds, wid, lane); S.done(cur); }
#undef PG8_SA
#undef PG8_SB
#undef PG8_STAGE
#undef PG8_LDA
#undef PG8_LDB
#undef PG8_MMA
#undef PG8_WAIT_V
#undef PG8_WAIT_L
#undef PG8_BAR
#undef PG8_SCHED
}
}

constexpr int S = 16384, DM = 1024, FF = 2816, FF2 = 5632, EVEN_SRC = 3664, EVEN_NP = 3840, ODD_N = 3072, NLAYER = 2, MEMT = 256, MEMW = 256;
constexpr float RMS_EPS = 1e-6f;
constexpr float LOG2E = 1.4426950408889634f;
constexpr float C2 = 0.125f * LOG2E;
constexpr int NWAVES = 8, NTHREADS = 512;
constexpr int EC_FQ = 0, EC_DQ = 512, EC_FK = 1024, EC_DK = 1536, EC_FV = 2048, EC_DV = 2560, EC_IQ = 3072, EC_IK = 3584;
constexpr int ES_FQ = 0, ES_FK = 512, ES_FV = 1024, ES_FL = 1536, ES_DQ = 1544, ES_DK = 2056, ES_DV = 2568, ES_IQ = 3080, ES_IK = 3592, ES_IW = 3656;

constexpr size_t MiB = 1u << 20;
constexpr size_t WS_CTL = 0, CTL_ZERO_BYTES = 1 * MiB;
constexpr size_t WS_SSQ = 1 * MiB;
constexpr size_t WS_KSUM = 6 * MiB;
constexpr size_t WS_GT = 11 * MiB + 131072;
constexpr size_t WS_TW = 11 * MiB;
constexpr size_t WS_ROPE = 2 * MiB;
constexpr size_t WS_FL = 3 * MiB;
constexpr size_t WS_MEMK = 4 * MiB;
constexpr size_t WS_IW = 5 * MiB;
constexpr size_t WS_SB = 5 * MiB + 512 * 1024;
constexpr size_t WS_W = 12 * MiB;
constexpr size_t WS_BIG = 60 * MiB;
constexpr size_t WS_HB = 224 * MiB;
constexpr size_t WS_END = 256 * MiB;
constexpr size_t W_FFN1_IN = 0, W_FFN1_OUT = 11 * MiB, W_MIX_IN = 17 * MiB, W_MIX_OUT = 25 * MiB, W_MEMQ = 27 * MiB, W_MEMO = 28 * MiB, W_FFN2_IN = 29 * MiB, W_FFN2_OUT = 40 * MiB, W_MEMQ2 = 46 * MiB, W_MEMO2 = 47 * MiB;
constexpr size_t B_U = 0;
constexpr size_t B_PROJ = 0;
constexpr size_t B_VTF = 120 * MiB;
constexpr size_t B_IKC = 136 * MiB;
constexpr size_t B_VTM = 96 * MiB;
constexpr size_t B_SEL = 156 * MiB;
constexpr size_t B_QP = 0;
constexpr size_t B_QM = 140 * MiB, B_OM = 148 * MiB;
constexpr int CW_TMO = 0, CW_CODE = 1, CW_BAR = 4096;
constexpr int CW_SELQ = 336;
constexpr int CW_VMAX = 320;

constexpr int RING_BYTES = 147456;
constexpr int LDSCTL_OFF = RING_BYTES, MISC_OFF = LDSCTL_OFF + 320;
constexpr int LDS_BYTES = 163840;

#define GAS __attribute__((address_space(1)))
#define LAS __attribute__((address_space(3)))
typedef unsigned short bf16;
typedef unsigned v4u __attribute__((ext_vector_type(4)));
typedef float f32x4 __attribute__((ext_vector_type(4)));
typedef short bf16x8 __attribute__((ext_vector_type(8)));
typedef GAS unsigned gu32;
typedef GAS unsigned long long gu64;
#define RLX_AGENT __ATOMIC_RELAXED, __HIP_MEMORY_SCOPE_AGENT
#define LDS_WAIT() asm volatile("s_waitcnt lgkmcnt(0)" ::: "memory")
#define VM_WAIT() asm volatile("s_waitcnt vmcnt(0)" ::: "memory")
__device__ __forceinline__ unsigned long long rt() { return __builtin_amdgcn_s_memrealtime(); }
__device__ __forceinline__ unsigned f2bf(float f) { unsigned u = __builtin_bit_cast(unsigned, f); return (u + 0x7fffu + ((u >> 16) & 1u)) >> 16; }
__device__ __forceinline__ unsigned pk2(float lo, float hi) { return f2bf(lo) | (f2bf(hi) << 16); }

#define XB_TMO      128
#define XB_XCNT(j)  (256  + 64 * (j))
#define XB_XSUB(j)  (1280 + 64 * (j))
#define XB_XGEN(j)  (2304 + 64 * (j))
#define XB_TOP      3328
#define XB_TOPGEN   3392
#define XCD_BAR_WORDS 3456
#define XB_SPIN_CAP (1u << 18)

__device__ __forceinline__ unsigned xb_ld(unsigned* p)              { return __hip_atomic_load(p, __ATOMIC_RELAXED, __HIP_MEMORY_SCOPE_AGENT); }
__device__ __forceinline__ unsigned xb_add(unsigned* p, unsigned v) { return __hip_atomic_fetch_add(p, v, __ATOMIC_RELAXED, __HIP_MEMORY_SCOPE_AGENT); }
__device__ __forceinline__ unsigned xb_xcc_id() { return (unsigned)__builtin_amdgcn_s_getreg((3 << 11) | 20) & 0xFu; }
#define XB_SPIN(cond, bar) do { unsigned _sp = 0; while (cond) { __builtin_amdgcn_s_sleep(1); \
    if ((++_sp & 255u) == 0u) { if (xb_ld(&(bar)[XB_TMO])) break; if (_sp > XB_SPIN_CAP) { atomicAdd(&(bar)[XB_TMO], 1u); break; } } } } while (0)

struct XcdBarrier {
    unsigned* bar; unsigned x;
    volatile LAS unsigned* st;
};

__device__ __forceinline__ XcdBarrier xcd_barrier_post(unsigned* bar, volatile LAS unsigned* st) {
    XcdBarrier b; b.bar = bar; b.x = xb_xcc_id(); b.st = st;
    if (threadIdx.x == 0) (void)xb_add(&bar[XB_XCNT(b.x)], 1u);
    return b;
}
__device__ __forceinline__ void xcd_barrier_complete(unsigned* bar, unsigned x, unsigned& nloc, unsigned& nx) {
    const unsigned G = gridDim.x * gridDim.y * gridDim.z;
    unsigned sum, cnt, mine, sp = 0u;
    for (;;) {
        sum = 0u; cnt = 0u; mine = 0u;
#pragma unroll
        for (unsigned j = 0; j < 16; ++j) { const unsigned c = xb_ld(&bar[XB_XCNT(j)]); sum += c; cnt += (c > 0u) ? 1u : 0u; mine = (j == x) ? c : mine; }
        if (sum == G) break;
        __builtin_amdgcn_s_sleep(1);
        if ((++sp & 255u) == 0u) { if (xb_ld(&bar[XB_TMO])) break; if (sp > XB_SPIN_CAP) { atomicAdd(&bar[XB_TMO], 1u); break; } }
    }
    nloc = mine > 0u ? mine : 1u; nx = cnt > 0u ? cnt : 1u;
}

__device__ __forceinline__ void xcd_barrier(const XcdBarrier& b) {
    asm volatile("s_waitcnt vmcnt(0)" ::: "memory");
    __syncthreads();
    if (threadIdx.x == 0) {
        unsigned* bar = b.bar;
        __builtin_amdgcn_s_waitcnt(0);
        unsigned nloc = b.st[0], nx = b.st[1];
        if (nloc == 0u) { unsigned x_ = b.x; asm volatile("" : "+s"(x_)); xcd_barrier_complete(bar, x_, nloc, nx); b.st[0] = nloc; b.st[1] = nx; }
        const unsigned old = xb_add(&bar[XB_XSUB(b.x)], 1u);
        const unsigned gen = old / nloc;
        if (old + 1u == (gen + 1u) * nloc) {
            __builtin_amdgcn_fence(__ATOMIC_RELEASE, "agent");
            asm volatile("s_waitcnt vmcnt(0)" ::: "memory");
            const unsigned og = xb_add(&bar[XB_TOP], 1u);
            const unsigned tg = og / nx;
            if (og + 1u == (tg + 1u) * nx) xb_add(&bar[XB_TOPGEN], 1u);
            else XB_SPIN(xb_ld(&bar[XB_TOPGEN]) == tg, bar);
            __builtin_amdgcn_fence(__ATOMIC_ACQUIRE, "agent");
            xb_add(&bar[XB_XGEN(b.x)], 1u);
            asm volatile("s_waitcnt vmcnt(0)" ::: "memory");
        } else {
            XB_SPIN(xb_ld(&bar[XB_XGEN(b.x)]) == gen, bar);
            __builtin_amdgcn_fence(__ATOMIC_ACQUIRE, "agent");
            asm volatile("s_waitcnt vmcnt(0)" ::: "memory");
        }
    }
    __syncthreads();
}

typedef float f32x16 __attribute__((ext_vector_type(16)));
typedef float f32x2_t __attribute__((ext_vector_type(2)));
typedef __bf16 bf16x2_t __attribute__((ext_vector_type(2)));
typedef unsigned u32x2 __attribute__((ext_vector_type(2)));
__device__ __forceinline__ unsigned cvtpk(float lo, float hi) { f32x2_t v = {lo, hi}; bf16x2_t b = __builtin_convertvector(v, bf16x2_t); return __builtin_bit_cast(unsigned, b); }
__device__ __forceinline__ float bflo(unsigned w) { return __uint_as_float(w << 16); }
__device__ __forceinline__ float bfhi(unsigned w) { return __uint_as_float(w & 0xffff0000u); }
__device__ __forceinline__ void unpack8(const v4u& w, float (&x)[8]) { x[0] = bflo(w.x); x[1] = bfhi(w.x); x[2] = bflo(w.y); x[3] = bfhi(w.y); x[4] = bflo(w.z); x[5] = bfhi(w.z); x[6] = bflo(w.w); x[7] = bfhi(w.w); }
__device__ __forceinline__ v4u pack8(const float (&x)[8]) { v4u w; w.x = cvtpk(x[0], x[1]); w.y = cvtpk(x[2], x[3]); w.z = cvtpk(x[4], x[5]); w.w = cvtpk(x[6], x[7]); return w; }
__device__ __forceinline__ unsigned q8pack4(float a, float b, float c, float d) {
    const int ia = (int)__builtin_rintf(a), ib = (int)__builtin_rintf(b), ic = (int)__builtin_rintf(c), id = (int)__builtin_rintf(d);
    return (unsigned)(ia & 255) | ((unsigned)(ib & 255) << 8) | ((unsigned)(ic & 255) << 16) | ((unsigned)(id & 255) << 24); }
__device__ __forceinline__ float wave_sum(float v) { v += shx<1>(v); v += shx<2>(v); v += shx<4>(v); v += shx<8>(v); v += shx<16>(v); return sh32_sum(v); }
__device__ __forceinline__ float wave_max(float v) { v = fmaxf(v, shx<1>(v)); v = fmaxf(v, shx<2>(v)); v = fmaxf(v, shx<4>(v)); v = fmaxf(v, shx<8>(v)); v = fmaxf(v, shx<16>(v)); return sh32_max(v); }
__device__ __forceinline__ int crow(int r, int hi) { return (r & 3) + 8 * (r >> 2) + 4 * hi; }

__device__ __forceinline__ int even_map(int n) {
    if (n < 512) return ES_FQ + n;
    if (n < 1024) return ES_DQ + (n - 512);
    if (n < 1536) return ES_FK + (n - 1024);
    if (n < 2048) return ES_DK + (n - 1536);
    if (n < 2560) return ES_FV + (n - 2048);
    if (n < 3072) return ES_DV + (n - 2560);
    if (n < 3584) return ES_IQ + (n - 3072);
    if (n < 3648) return ES_IK + (n - 3584);
    return -1;
}
__device__ __forceinline__ void conv_item(const float* W, int K, int Nsrc, int nblk, const float* gain, bf16* WT, int mode, LAS float* scr, int item, int lane) {
    const int kb = item / nblk, nb = item % nblk, k0 = 32 * kb, n0 = 128 * nb;
    const int n = n0 + 4 * (lane & 31);
    int sc;
    if (mode == 0) sc = n; else if (mode == 1) { const int T = n >> 8, hf = (n >> 7) & 1, j = n & 127; sc = hf * FF + 128 * T + j; } else sc = even_map(n);
    f32x4 v[16];
#pragma unroll
    for (int i = 0; i < 16; ++i) { const int kk = 2 * i + (lane >> 5); v[i] = (f32x4){0.f, 0.f, 0.f, 0.f};
        if (sc >= 0) v[i] = *(const GAS f32x4*)(W + (size_t)(k0 + kk) * Nsrc + sc); }
#pragma unroll
    for (int i = 0; i < 16; ++i) { const int kk = 2 * i + (lane >> 5); const float g = gain ? gain[k0 + kk] : 1.0f;
        *(LAS f32x4*)(scr + kk * 132 + 4 * (lane & 31)) = v[i] * g; }
    LDS_WAIT(); asm volatile("" ::: "memory");
    const int c = lane & 3;
#pragma unroll
    for (int j = 0; j < 8; ++j) { const int nn = (lane >> 2) + 16 * j; const LAS float* s = scr + (8 * c) * 132 + nn;
        v4u o; o.x = cvtpk(s[0 * 132], s[1 * 132]); o.y = cvtpk(s[2 * 132], s[3 * 132]); o.z = cvtpk(s[4 * 132], s[5 * 132]); o.w = cvtpk(s[6 * 132], s[7 * 132]);
        *(GAS v4u*)(WT + (size_t)(n0 + nn) * K + k0 + 8 * c) = o; }
    LDS_WAIT(); asm volatile("" ::: "memory");
}
__device__ __forceinline__ void conv_q8_item(const float* W, const float* gain, unsigned char* W8, float* sb, LAS float* red, int item, int wave, int lane) {
    const int n = 32 * item + (lane & 31), kq = 2 * wave + (lane >> 5);
    const int T = n >> 8, hf = (n >> 7) & 1, jn = n & 127, sc = hf * FF + 128 * T + jn;
    const float* wp = W + (size_t)(64 * kq) * FF2 + sc; const float* gp = gain + 64 * kq;
    float v[64]; float mx = 0.f;
#pragma unroll
    for (int k = 0; k < 64; ++k) v[k] = *(const GAS float*)(wp + (size_t)k * FF2);
#pragma unroll
    for (int k = 0; k < 64; ++k) { v[k] *= gp[k]; mx = fmaxf(mx, fabsf(v[k])); }
    mx = sh32_max(mx);
    __syncthreads();
    if (lane < 32) red[wave * 32 + lane] = mx;
    __syncthreads();
    mx = red[lane & 31];
#pragma unroll
    for (int w = 1; w < 8; ++w) mx = fmaxf(mx, red[w * 32 + (lane & 31)]);
    mx = fmaxf(mx, 1e-30f);
    const float inv = 127.0f / mx;
    unsigned char* op = W8 + (size_t)n * DM + 64 * kq;
#pragma unroll
    for (int k0 = 0; k0 < 64; k0 += 16) {
        v4u o; o.x = q8pack4(v[k0] * inv, v[k0 + 1] * inv, v[k0 + 2] * inv, v[k0 + 3] * inv); o.y = q8pack4(v[k0 + 4] * inv, v[k0 + 5] * inv, v[k0 + 6] * inv, v[k0 + 7] * inv);
        o.z = q8pack4(v[k0 + 8] * inv, v[k0 + 9] * inv, v[k0 + 10] * inv, v[k0 + 11] * inv); o.w = q8pack4(v[k0 + 12] * inv, v[k0 + 13] * inv, v[k0 + 14] * inv, v[k0 + 15] * inv);
        *(GAS v4u*)(op + k0) = o; }
    if (wave == 0 && lane < 32) sb[n] = mx * (1.0f / 127.0f);
}
struct InPtrs { const float* p[26]; };
constexpr int INTAB_OFF = LDSCTL_OFF + 1024;
struct InTab { LAS unsigned char* ldsbase;
    __device__ __forceinline__ const float* get(int k) const { const u32x2 v = *(const LAS u32x2*)(ldsbase + INTAB_OFF + 8 * k);
        const unsigned lo = (unsigned)__builtin_amdgcn_readfirstlane((int)v.x), hi = (unsigned)__builtin_amdgcn_readfirstlane((int)v.y);
        return (const float*)(((unsigned long long)hi << 32) | lo); } };
__device__ __forceinline__ void conv_weights(const InTab& in, unsigned char* ws, int L, int mask, LAS unsigned char* lds, int gw, int NGW, int wave, int lane) {
    LAS float* scr = (LAS float*)(lds + wave * 17408);
    unsigned char* Wr = ws + WS_W;
    const bool even = (L & 1) == 0;
    const int mixN = even ? EVEN_NP : ODD_N, mixSrc = even ? EVEN_SRC : ODD_N;
    const int I_FIN = (DM / 32) * (FF2 / 128), I_FOUT = (FF / 32) * (DM / 128), I_MIN = (DM / 32) * (mixN / 128), I_MOUT = (DM / 32) * (DM / 128), I_MQ = (DM / 32) * (MEMW / 128), I_MO = (MEMW / 32) * (DM / 128);
    const int n0 = 0, n1 = (mask & 2) ? I_FOUT : 0,   n2 = (mask & 4) ? I_MIN : 0, n3 = (mask & 8) ? I_MOUT : 0, n4 = (mask & 16) ? I_MQ : 0, n5 = (mask & 32) ? I_MO : 0,
              n6 = 0, n7 = (mask & 128) ? I_FOUT : 0;
    const int NITEMS = n0 + n1 + n2 + n3 + n4 + n5 + n6 + n7;
    for (int it = gw; it < NITEMS; it += NGW) {
        int r = it;
        if (r < n1) { conv_item(in.get(4) + (size_t)L * FF * DM, FF, DM, DM / 128, nullptr, (bf16*)(Wr + W_FFN1_OUT), 0, scr, r, lane); continue; } r -= n1;
        if (r < n7) { conv_item(in.get(25) + (size_t)L * FF * DM, FF, DM, DM / 128, nullptr, (bf16*)(Wr + W_FFN2_OUT), 0, scr, r, lane); continue; } r -= n7;
        if (r < n2) { conv_item(even ? in.get(6) : in.get(12), DM, mixSrc, mixN / 128, in.get(5) + (size_t)L * DM, (bf16*)(Wr + W_MIX_IN), even ? 2 : 0, scr, r, lane); continue; } r -= n2;
        if (r < n3) { conv_item(in.get(15) + (size_t)L * DM * DM, DM, DM, DM / 128, nullptr, (bf16*)(Wr + W_MIX_OUT), 0, scr, r, lane); continue; } r -= n3;
        if (r < n4) { conv_item(in.get(18) + (size_t)L * DM * MEMW, DM, MEMW, MEMW / 128, in.get(16) + (size_t)L * DM, (bf16*)(Wr + (L ? W_MEMQ2 : W_MEMQ)), 0, scr, r, lane); continue; } r -= n4;
        conv_item(in.get(22) + (size_t)L * MEMW * DM, MEMW, DM, DM / 128, nullptr, (bf16*)(Wr + (L ? W_MEMO2 : W_MEMO)), 0, scr, r, lane);
    }
}
__device__ __forceinline__ void conv_q8_weights(const InTab& in, unsigned char* ws, int L, int mask, LAS unsigned char* lds, int wg, int nwg, int wave, int lane) {
    unsigned char* Wr = ws + WS_W; float* sb1 = (float*)(ws + WS_SB); float* sb2 = sb1 + 8192;
    const int NI = FF2 / 32;
    const int n0 = (mask & 1) ? NI : 0, n6 = (mask & 64) ? NI : 0;
    for (int it = wg; it < n0 + n6; it += nwg) {
        if (it < n0) conv_q8_item(in.get(3) + (size_t)L * DM * FF2, in.get(2) + (size_t)L * DM, Wr + W_FFN1_IN, sb1, (LAS float*)lds, it, wave, lane);
        else         conv_q8_item(in.get(24) + (size_t)L * DM * FF2, in.get(23) + (size_t)L * DM, Wr + W_FFN2_IN, sb2, (LAS float*)lds, it - n0, wave, lane);
    }
    __syncthreads();
}
__device__ __forceinline__ void copy_x(const float* x, unsigned char* HQ, float* sa, bf16* HB, float* ssq0, int gw, int NGW, int lane) {
    for (int m = gw; m < S; m += NGW) {
        const GAS f32x4* xr = (const GAS f32x4*)(x + (size_t)m * DM) + lane;
        GAS u32x2* hb = (GAS u32x2*)(HB + (size_t)m * DM) + lane;
        float s = 0.f, am = 0.f; f32x4 v[4];
#pragma unroll
        for (int j = 0; j < 4; ++j) { v[j] = xr[64 * j]; s += (v[j].x * v[j].x + v[j].y * v[j].y) + (v[j].z * v[j].z + v[j].w * v[j].w);
            am = fmaxf(fmaxf(am, fmaxf(fabsf(v[j].x), fabsf(v[j].y))), fmaxf(fabsf(v[j].z), fabsf(v[j].w)));
            u32x2 w; w.x = cvtpk(v[j].x, v[j].y); w.y = cvtpk(v[j].z, v[j].w); hb[64 * j] = w; }
        s = wave_sum(s); am = fmaxf(wave_max(am), 1e-30f);
        const float inv = 127.0f / am;
#pragma unroll
        for (int j = 0; j < 4; ++j) *(GAS unsigned*)(HQ + (size_t)m * DM + 4 * (lane + 64 * j)) = q8pack4(v[j].x * inv, v[j].y * inv, v[j].z * inv, v[j].w * inv);
        if (lane < 16) ssq0[(size_t)m * 16 + lane] = (lane == 0) ? s : 0.f;
        if (lane == 0) sa[m] = am * (1.0f / 127.0f) * rsqrtf(s * (1.0f / DM) + RMS_EPS);
    }
}
__device__ __forceinline__ void quant_rows(const bf16* HB, unsigned char* HQ, float* sa, int gw, int NGW, int lane) {
    for (int m = gw; m < S; m += NGW) {
        const GAS u32x2* hb = (const GAS u32x2*)(HB + (size_t)m * DM) + lane;
        float v[16]; float am = 0.f, s = 0.f;
#pragma unroll
        for (int j = 0; j < 4; ++j) { const u32x2 w = hb[64 * j]; v[4 * j] = bflo(w.x); v[4 * j + 1] = bfhi(w.x); v[4 * j + 2] = bflo(w.y); v[4 * j + 3] = bfhi(w.y);
            s += (v[4 * j] * v[4 * j] + v[4 * j + 1] * v[4 * j + 1]) + (v[4 * j + 2] * v[4 * j + 2] + v[4 * j + 3] * v[4 * j + 3]);
            am = fmaxf(fmaxf(am, fmaxf(fabsf(v[4 * j]), fabsf(v[4 * j + 1]))), fmaxf(fabsf(v[4 * j + 2]), fabsf(v[4 * j + 3]))); }
        am = fmaxf(wave_max(am), 1e-30f); s = wave_sum(s);
        const float inv = 127.0f / am;
#pragma unroll
        for (int j = 0; j < 4; ++j) *(GAS unsigned*)(HQ + (size_t)m * DM + 4 * (lane + 64 * j)) = q8pack4(v[4 * j] * inv, v[4 * j + 1] * inv, v[4 * j + 2] * inv, v[4 * j + 3] * inv);
        if (lane == 0) sa[m] = am * (1.0f / 127.0f) * rsqrtf(s * (1.0f / DM) + RMS_EPS);
    }
}
__device__ __forceinline__ void rope_tables(float* cosT, float* sinT, int gtid, int nthreads) {
    for (int idx = gtid; idx < S * 8; idx += nthreads) {
        const int t = idx >> 3, j = idx & 7;
        float inv;
        switch (j) { case 0: inv = 1.0f; break; case 1: inv = 0.193922743f; break; case 2: inv = 0.0376060307f; break; case 3: inv = 0.00729266461f; break;
                     case 4: inv = 0.00141421356f; break; case 5: inv = 0.000274248188f; break; case 6: inv = 5.3182961e-05f; break; default: inv = 1.03133862e-05f; break; }
        const float ang = (float)t * inv;
        const float kq = __builtin_rintf(ang * 0.63661977236758134f);
        float r = ang - kq * 1.5703125f; r = r - kq * 0.00048351287841796875f; r = r - kq * 3.1391647326017846e-07f;
        const float r2 = r * r;
        float sp = 2.7557319e-6f; sp = sp * r2 - 1.9841270e-4f; sp = sp * r2 + 8.3333333e-3f; sp = sp * r2 - 1.6666667e-1f; const float sn = r + r * r2 * sp;
        float cp = -2.7557319e-7f; cp = cp * r2 + 2.4801587e-5f; cp = cp * r2 - 1.3888889e-3f; cp = cp * r2 + 4.1666667e-2f; cp = cp * r2 - 0.5f; const float cs = 1.0f + r2 * cp;
        const int q = ((int)kq) & 3;
        const float sv = (q == 0) ? sn : (q == 1) ? cs : (q == 2) ? -sn : -cs;
        const float cv = (q == 0) ? cs : (q == 1) ? -sn : (q == 2) ? -cs : sn;
        cosT[idx] = cv; sinT[idx] = sv;
    }
}
__device__ __forceinline__ void mem_kv(const InTab& in, unsigned char* ws, LAS unsigned char* lds, int unit, int tid, int wave, int lane) {
    LAS float* memn = (LAS float*)lds;
    LAS f32x4* part = (LAS f32x4*)(lds + 16 * 1028 * 4);
    bf16* memK = (bf16*)(ws + WS_MEMK); bf16* memVt = (bf16*)(ws + WS_MEMK + 256 * 1024);
    const int L = unit >> 7, rb = (unit >> 3) & 15, cb = unit & 7;
    const float* gm = in.get(17) + (size_t)L * DM; const float* wkv = in.get(19) + (size_t)L * DM * 512; const float* kn = in.get(21) + (size_t)L * 64;
    __syncthreads();
    for (int i = 0; i < 2; ++i) { const int r = wave * 2 + i; const float* mrow = in.get(1) + (size_t)(rb * 16 + r) * DM;
        f32x4 v[4]; float s = 0.f;
#pragma unroll
        for (int j = 0; j < 4; ++j) { v[j] = *((const GAS f32x4*)mrow + lane + 64 * j); s += (v[j].x * v[j].x + v[j].y * v[j].y) + (v[j].z * v[j].z + v[j].w * v[j].w); }
        const float rstd = rsqrtf(wave_sum(s) * (1.0f / DM) + RMS_EPS);
#pragma unroll
        for (int j = 0; j < 4; ++j) { const f32x4 g = *((const GAS f32x4*)gm + lane + 64 * j); *(LAS f32x4*)(memn + r * 1028 + 4 * (lane + 64 * j)) = v[j] * rstd * g; } }
    __syncthreads();
    {
        const int cl = lane & 15, sl = wave * 4 + (lane >> 4);
        const float* wp = wkv + (size_t)(4 * sl) * 512 + cb * 64 + cl * 4;
        f32x4 acc[16];
#pragma unroll
        for (int r = 0; r < 16; ++r) acc[r] = (f32x4){0.f, 0.f, 0.f, 0.f};
#pragma unroll 2
        for (int j = 0; j < 8; ++j) {
            const f32x4 w0 = *(const GAS f32x4*)(wp + (size_t)(128 * j) * 512), w1 = *(const GAS f32x4*)(wp + (size_t)(128 * j + 1) * 512),
                        w2 = *(const GAS f32x4*)(wp + (size_t)(128 * j + 2) * 512), w3 = *(const GAS f32x4*)(wp + (size_t)(128 * j + 3) * 512);
#pragma unroll
            for (int r = 0; r < 16; ++r) { const f32x4 mv = *(const LAS f32x4*)(memn + r * 1028 + 4 * (sl + 32 * j));
                acc[r] = acc[r] + w0 * mv.x + w1 * mv.y + w2 * mv.z + w3 * mv.w; }
        }
#pragma unroll
        for (int r = 0; r < 16; ++r) {
#pragma unroll
            for (int c = 0; c < 4; ++c) { float v = acc[r][c]; v += shx<16>(v); v = sh32_sum(v); acc[r][c] = v; }
            if (lane < 16) part[(wave * 16 + r) * 16 + cl] = acc[r]; }
    }
    __syncthreads();
    if (tid < 256) {
        const int r = tid >> 4, c4 = (tid & 15) * 4;
        f32x4 acc = part[tid];
#pragma unroll
        for (int w = 1; w < 8; ++w) acc = acc + part[w * 256 + tid];
        const int tok = rb * 16 + r;
        if (cb < 4) {
            float ss = (acc.x * acc.x + acc.y * acc.y) + (acc.z * acc.z + acc.w * acc.w);
            ss += shx<1>(ss); ss += shx<2>(ss); ss += shx<4>(ss); ss += shx<8>(ss);
            const float rs = rsqrtf(ss * (1.0f / 64.0f) + RMS_EPS);
            u32x2 w; w.x = cvtpk(acc.x * rs * kn[c4], acc.y * rs * kn[c4 + 1]); w.y = cvtpk(acc.z * rs * kn[c4 + 2], acc.w * rs * kn[c4 + 3]);
            *(GAS u32x2*)(memK + (size_t)L * 65536 + (size_t)tok * 256 + cb * 64 + c4) = w;
        } else {
            const int c = (cb - 4) * 64 + c4; bf16* vp = memVt + (size_t)L * 65536 + (size_t)c * 256 + tok;
            vp[0] = (bf16)(cvtpk(acc.x, 0.f) & 0xffffu); vp[256] = (bf16)(cvtpk(acc.y, 0.f) & 0xffffu); vp[512] = (bf16)(cvtpk(acc.z, 0.f) & 0xffffu); vp[768] = (bf16)(cvtpk(acc.w, 0.f) & 0xffffu);
        }
    }
}

__device__ __forceinline__ void head_norm8(float (&x)[8], const float* gain, int lane) {
    float ss = 0.f;
#pragma unroll
    for (int j = 0; j < 8; ++j) ss += x[j] * x[j];
    ss += shx<1>(ss); ss += shx<2>(ss); ss += shx<4>(ss);
    const float r = rsqrtf(ss * (1.0f / 64.0f) + RMS_EPS);
    const int d0 = 8 * (lane & 7);
#pragma unroll
    for (int j = 0; j < 8; ++j) x[j] = x[j] * r * gain[d0 + j];
}
__device__ __forceinline__ void rope8(float (&x)[8], const float (&cs)[8], const float (&sn)[8], int lane) {
    const int sub = lane & 7;
#pragma unroll
    for (int j = 0; j < 8; ++j) {
        const float other = shx<1>(x[j]);
        if (sub == 0) x[j] = x[j] * cs[j] - other * sn[j];
        else if (sub == 1) x[j] = x[j] * cs[j] + other * sn[j];
    }
}
__device__ __forceinline__ float sh32_get(float v, int lane) { auto r = __builtin_amdgcn_permlane32_swap(__float_as_uint(v), __float_as_uint(v), false, false); return __uint_as_float((lane < 32) ? r[1] : r[0]); }
__device__ __forceinline__ float reduce_scatter64(float (&v)[64], int lane) {
    { const bool up = (lane & 32) != 0;
#pragma unroll
      for (int j = 0; j < 32; ++j) { const float send = up ? v[j] : v[j + 32], keep = up ? v[j + 32] : v[j]; v[j] = keep + sh32_get(send, lane); } }
    { const bool up = (lane & 16) != 0;
#pragma unroll
      for (int j = 0; j < 16; ++j) { const float send = up ? v[j] : v[j + 16], keep = up ? v[j + 16] : v[j]; v[j] = keep + shx<16>(send); } }
    { const bool up = (lane & 8) != 0;
#pragma unroll
      for (int j = 0; j < 8; ++j) { const float send = up ? v[j] : v[j + 8], keep = up ? v[j + 8] : v[j]; v[j] = keep + shx<8>(send); } }
    { const bool up = (lane & 4) != 0;
#pragma unroll
      for (int j = 0; j < 4; ++j) { const float send = up ? v[j] : v[j + 4], keep = up ? v[j + 4] : v[j]; v[j] = keep + shx<4>(send); } }
    { const bool up = (lane & 2) != 0;
#pragma unroll
      for (int j = 0; j < 2; ++j) { const float send = up ? v[j] : v[j + 2], keep = up ? v[j + 2] : v[j]; v[j] = keep + shx<2>(send); } }
    { const bool up = (lane & 1) != 0; const float send = up ? v[0] : v[1], keep = up ? v[1] : v[0]; v[0] = keep + shx<1>(send); }
    return v[0];
}
__device__ __forceinline__ void post_even(const InTab& in, unsigned char* ws, const bf16* HBp, const float* ssq, LAS unsigned char* lds, int G, int tid, int wave, int lane) {
    float* Flocal = (float*)(ws + WS_FL); float* Btot = Flocal + S * 8; float* IW = (float*)(ws + WS_IW);
    const float* bfg = in.get(7);
    LAS f32x4* Tw = (LAS f32x4*)lds;
    LAS float* lf = (LAS float*)(lds + 65536);
    { const GAS f32x4* src = (const GAS f32x4*)(ws + WS_TW);
#pragma unroll
      for (int i = 0; i < 8; ++i) Tw[tid + 512 * i] = src[tid + 512 * i]; }
    __syncthreads();
    for (int u = blockIdx.x; u < S / 64; u += G) {
        const int t0 = u * 64, tw0 = t0 + wave * 8;
        { const bf16* vr = (const bf16*)(ws + WS_BIG + B_PROJ) + (size_t)tw0 * EVEN_NP + EC_DV + lane * 8; float vm = 0.f;
#pragma unroll
          for (int i = 0; i < 8; ++i) { const v4u w = *(const GAS v4u*)(vr + (size_t)i * EVEN_NP); float x[8]; unpack8(w, x);
#pragma unroll
              for (int j = 0; j < 8; ++j) vm = fmaxf(vm, fabsf(x[j])); }
          vm = fmaxf(vm, shx<1>(vm)); vm = fmaxf(vm, shx<2>(vm)); vm = fmaxf(vm, shx<4>(vm));
          if ((lane & 7) == 0) atomicMax((unsigned*)(ws + WS_CTL) + CW_VMAX + (lane >> 3), __float_as_uint(vm)); }
#pragma unroll 1
        for (int rb = 0; rb < 2; ++rb) {
            float acc[64];
#pragma unroll
            for (int j = 0; j < 64; ++j) acc[j] = 0.f;
#pragma unroll
            for (int q = 0; q < 4; ++q) {
                f32x4 hv[4];
#pragma unroll
                for (int r = 0; r < 4; ++r) { const u32x2 w = *((const GAS u32x2*)(HBp + (size_t)(tw0 + rb * 4 + r) * DM) + lane + 64 * q); hv[r][0] = bflo(w.x); hv[r][1] = bfhi(w.x); hv[r][2] = bflo(w.y); hv[r][3] = bfhi(w.y); }
#pragma unroll
                for (int e = 0; e < 4; ++e)
#pragma unroll
                    for (int c = 0; c < 4; ++c) { const f32x4 w = Tw[((q * 4 + e) * 4 + c) * 64 + lane];
#pragma unroll
                        for (int r = 0; r < 4; ++r) { acc[r * 16 + 4 * c + 0] += hv[r][e] * w[0]; acc[r * 16 + 4 * c + 1] += hv[r][e] * w[1]; acc[r * 16 + 4 * c + 2] += hv[r][e] * w[2]; acc[r * 16 + 4 * c + 3] += hv[r][e] * w[3]; } }
            }
            const float zs = reduce_scatter64(acc, lane);
            const int rl = wave * 8 + rb * 4 + (lane >> 4), t = t0 + rl, j = lane & 15;
            const float z = zs * pg8::row_rstd(ssq, t);
            if (j < 8) { const float zz = z + bfg[j]; lf[rl * 8 + j] = (zz > 15.f) ? -expf(-zz) : -log1pf(expf(-zz)); }
            else IW[(size_t)t * 8 + (j - 8)] = z * 0.044194173824159216f;
        }
        __syncthreads();
        {
            float v = lf[lane * 8 + wave];
#pragma unroll
            for (int o = 1; o < 64; o <<= 1) { const float up = __int_as_float(__builtin_amdgcn_ds_bpermute(((lane - o) & 63) << 2, __float_as_int(v))); if (lane >= o) v += up; }
            Flocal[(size_t)(t0 + lane) * 8 + wave] = v;
            if (lane == 63) Btot[u * 8 + wave] = v;
        }
        __syncthreads();
    }
}

__device__ __forceinline__ void post_odd(unsigned char* ws, LAS unsigned char* lds, int G, int tid) {
    const bf16* Kb = (const bf16*)(ws + WS_BIG + B_PROJ) + (size_t)S * DM; float* ksum = (float*)(ws + WS_KSUM);
    LAS float* red = (LAS float*)lds;
    for (int u = blockIdx.x; u < 256; u += G) {
        const int n = u >> 2, cg = u & 3, c2 = tid & 127, rg = tid >> 7;
        const bf16* kp = Kb + (size_t)(n * 256 + rg * 64) * DM + cg * 256 + c2 * 2;
        float s0 = 0.f, s1 = 0.f;
#pragma unroll 16
        for (int r = 0; r < 64; ++r) { const unsigned w = *(const GAS unsigned*)(kp + (size_t)r * DM); s0 += bflo(w); s1 += bfhi(w); }
        __syncthreads();
        red[rg * 256 + c2 * 2] = s0; red[rg * 256 + c2 * 2 + 1] = s1;
        __syncthreads();
        if (tid < 256) ksum[(size_t)n * 1024 + cg * 256 + tid] = (red[tid] + red[256 + tid]) + (red[512 + tid] + red[768 + tid]);
    }
}

constexpr int KV_K_BYTES = 8192, KV_VT_PITCH = 136, KV_BUF_BYTES = KV_K_BYTES + 64 * KV_VT_PITCH;
struct KVRegs { v4u k, v; };
__device__ __forceinline__ void kv_load(KVRegs& r, const bf16* Kp, size_t kpitch, const bf16* Vtp, size_t vtpitch, int key0, int tid) {
    r.k = *(const GAS v4u*)(Kp + (size_t)(key0 + (tid & 63)) * kpitch + (tid >> 6) * 8);
    r.v = *(const GAS v4u*)(Vtp + (size_t)(tid >> 3) * vtpitch + key0 + (tid & 7) * 8);
}
__device__ __forceinline__ void kv_store(const KVRegs& r, LAS unsigned char* buf, int tid) {
    *(LAS v4u*)(buf + ((tid >> 6) * 64 + (tid & 63)) * 16) = r.k;
    LAS unsigned char* vp = buf + KV_K_BYTES + (tid >> 3) * KV_VT_PITCH + (tid & 7) * 16;
    *(LAS u32x2*)vp = (u32x2){r.v.x, r.v.y}; *(LAS u32x2*)(vp + 8) = (u32x2){r.v.z, r.v.w};
}
struct AttnAcc { float m, l; f32x16 o0, o1; };
__device__ __forceinline__ void attn_init(AttnAcc& a) { a.m = -INFINITY; a.l = 0.f;
#pragma unroll
    for (int r = 0; r < 16; ++r) { a.o0[r] = 0.f; a.o1[r] = 0.f; } }
template <int CHS = 1024>
__device__ __forceinline__ void attn_scores(f32x16& p0, f32x16& p1, const LAS unsigned char* buf, const bf16x8 (&qf)[4], int lane) {
    const int r32 = lane & 31, hi = lane >> 5;
#pragma unroll
    for (int r = 0; r < 16; ++r) { p0[r] = 0.f; p1[r] = 0.f; }
#pragma unroll
    for (int ks = 0; ks < 4; ++ks) {
        const bf16x8 k0 = *(const LAS bf16x8*)(buf + (2 * ks + hi) * CHS + r32 * 16);
        const bf16x8 k1 = *(const LAS bf16x8*)(buf + (2 * ks + hi) * CHS + (32 + r32) * 16);
        p0 = __builtin_amdgcn_mfma_f32_32x32x16_bf16(k0, qf[ks], p0, 0, 0, 0);
        p1 = __builtin_amdgcn_mfma_f32_32x32x16_bf16(k1, qf[ks], p1, 0, 0, 0);
    }
}
template <int VTP = KV_VT_PITCH, int VOFF = KV_K_BYTES>
__device__ __forceinline__ void attn_update(AttnAcc& a, f32x16& p0, f32x16& p1, const LAS unsigned char* buf, int lane, const float sc = 1.0f) {
    const int r32 = lane & 31, hi = lane >> 5;
    float mx = fmaxf(p0[0], p1[0]);
#pragma unroll
    for (int r = 1; r < 16; ++r) mx = fmaxf(mx, fmaxf(p0[r], p1[r]));
    mx = sh32_max(mx) * sc;
    if (__builtin_amdgcn_ballot_w64(!(mx - a.m <= 8.0f)) != 0ull) {
        const float mnew = fmaxf(a.m, mx);
        const float msafe = (mnew == -INFINITY) ? 0.f : mnew;
        const float alpha = __builtin_amdgcn_exp2f(a.m - msafe);
        a.l *= alpha; a.m = mnew;
#pragma unroll
        for (int r = 0; r < 16; ++r) { a.o0[r] *= alpha; a.o1[r] *= alpha; }
    }
    const float msafe = (a.m == -INFINITY) ? 0.f : a.m;
    float sum = 0.f;
#pragma unroll
    for (int r = 0; r < 16; ++r) { p0[r] = __builtin_amdgcn_exp2f(__builtin_fmaf(p0[r], sc, -msafe)); p1[r] = __builtin_amdgcn_exp2f(__builtin_fmaf(p1[r], sc, -msafe)); sum += p0[r] + p1[r]; }
    a.l += sum;
    const LAS unsigned char* vt = buf + VOFF + r32 * VTP + hi * 8;
#pragma unroll
    for (int half = 0; half < 2; ++half) {
#pragma unroll
        for (int s = 0; s < 2; ++s) {
            v4u pw;
            if (half == 0) { pw.x = cvtpk(p0[8 * s + 0], p0[8 * s + 1]); pw.y = cvtpk(p0[8 * s + 2], p0[8 * s + 3]); pw.z = cvtpk(p0[8 * s + 4], p0[8 * s + 5]); pw.w = cvtpk(p0[8 * s + 6], p0[8 * s + 7]); }
            else           { pw.x = cvtpk(p1[8 * s + 0], p1[8 * s + 1]); pw.y = cvtpk(p1[8 * s + 2], p1[8 * s + 3]); pw.z = cvtpk(p1[8 * s + 4], p1[8 * s + 5]); pw.w = cvtpk(p1[8 * s + 6], p1[8 * s + 7]); }
            const bf16x8 pb = __builtin_bit_cast(bf16x8, pw);
            const int kb = (32 * half + 16 * s) * 2;
#pragma unroll
            for (int d0 = 0; d0 < 2; ++d0) {
                const u32x2 lo = *(const LAS u32x2*)(vt + d0 * 32 * VTP + kb), hi2 = *(const LAS u32x2*)(vt + d0 * 32 * VTP + kb + 16);
                const bf16x8 va = __builtin_bit_cast(bf16x8, (v4u){lo.x, lo.y, hi2.x, hi2.y});
                if (d0 == 0) a.o0 = __builtin_amdgcn_mfma_f32_32x32x16_bf16(va, pb, a.o0, 0, 0, 0);
                else         a.o1 = __builtin_amdgcn_mfma_f32_32x32x16_bf16(va, pb, a.o1, 0, 0, 0);
            }
        }
    }
}
__device__ __forceinline__ void attn_store(const AttnAcc& a, bf16* orow, int lane) {
    const int hi = lane >> 5;
    float l = sh32_sum(a.l);
    const float inv = (l > 0.f) ? 1.0f / l : 0.f;
#pragma unroll
    for (int g = 0; g < 4; ++g) {
        u32x2 w0, w1;
        w0.x = cvtpk(a.o0[4 * g] * inv, a.o0[4 * g + 1] * inv); w0.y = cvtpk(a.o0[4 * g + 2] * inv, a.o0[4 * g + 3] * inv);
        w1.x = cvtpk(a.o1[4 * g] * inv, a.o1[4 * g + 1] * inv); w1.y = cvtpk(a.o1[4 * g + 2] * inv, a.o1[4 * g + 3] * inv);
        *(GAS u32x2*)(orow + 8 * g + 4 * hi) = w0; *(GAS u32x2*)(orow + 32 + 8 * g + 4 * hi) = w1;
    }
}
__device__ __forceinline__ void load_q(bf16x8 (&qf)[4], const bf16* qrow, int lane) {
    const int hi = lane >> 5;
#pragma unroll
    for (int ks = 0; ks < 4; ++ks) qf[ks] = *(const GAS bf16x8*)(qrow + 16 * ks + 8 * hi);
}

constexpr int CW_FOXQ = 64;
__device__ __forceinline__ void fox_phase(const InTab& in, unsigned char* ws, LAS unsigned char* lds, int G, int tid, int wave, int lane, bf16* obase, size_t opitch, int qword) {
    bf16* proj = (bf16*)(ws + WS_BIG + B_PROJ); const bf16* VtF = (const bf16*)(ws + WS_BIG + B_VTF);
    const float* Flocal = (const float*)(ws + WS_FL); const float* Btot = Flocal + S * 8;
    unsigned* qctr = (unsigned*)(ws + WS_CTL) + qword;
    LAS unsigned char* kvb = lds; LAS float* kbt = (LAS float*)(lds + 2 * KV_BUF_BYTES); LAS float* bt = (LAS float*)(lds + 2 * KV_BUF_BYTES + 65536); LAS float* Et = bt + 272;
    LAS int* misc = (LAS int*)(Et + 272);
    const int r32 = lane & 31, hi = lane >> 5;
    if (wave == 0) { const float gq = wave_max(fabsf(in.get(8)[lane])), gk = wave_max(fabsf(in.get(9)[lane])); if (lane == 0) { ((LAS float*)misc)[2] = gq; ((LAS float*)misc)[3] = gk; } }
    __syncthreads();
    const float THR = 2.0f * (0.125f * LOG2E * 64.0f * 1.02f) * ((LAS float*)misc)[2] * ((LAS float*)misc)[3] + 32.0f;
    for (;;) {
        __syncthreads();
        if (tid == 0) misc[0] = (int)atomicAdd(qctr, 1u);
        __syncthreads();
        const int u = misc[0];
        if (u >= 512) break;
        const int QB = 63 - (u >> 3), h = u & 7, q0 = QB * 256, nt = 4 * (QB + 1);
        for (int j = tid; j < nt; j += NTHREADS) bt[j] = Btot[j * 8 + h];
        if (tid == 0) misc[1] = 4 * QB;
        __syncthreads();
        for (int j = tid; j <= nt; j += NTHREADS) { float e = 0.f;
            if (j <= 4 * QB) { for (int i = 4 * QB - 1; i >= j; --i) e -= bt[i]; } else { for (int i = 4 * QB; i < j; ++i) e += bt[i]; }
            Et[j] = e; }
        __syncthreads();
        for (int j = tid; j < 4 * QB; j += NTHREADS) if (Et[j + 1] * LOG2E <= THR) atomicMin((int*)&misc[1], j);
        __syncthreads();
        const int t_start = misc[1], s0 = 64 * t_start;
        for (int s = s0 + tid; s < q0 + 256; s += NTHREADS) kbt[s - s0] = -(Et[s >> 6] + Flocal[(size_t)s * 8 + h]) * LOG2E;
        const int qrow = q0 + wave * 32 + r32;
        bf16x8 qf[4]; load_q(qf, proj + (size_t)qrow * EVEN_NP + EC_FQ + h * 64, lane);
        AttnAcc a; attn_init(a);
        const bf16* Kp = proj + EC_FK + h * 64; const bf16* Vtp = VtF + (size_t)h * 64 * S;
        KVRegs kr; kv_load(kr, Kp, EVEN_NP, Vtp, S, s0, tid); kv_store(kr, kvb, tid);
        __syncthreads();
        const float kbw = kbt[q0 + wave * 32 - s0];
        for (int t = t_start; t < nt; ++t) {
            LAS unsigned char* cur = kvb + ((t - t_start) & 1) * KV_BUF_BYTES;
            if (t + 1 < nt) kv_load(kr, Kp, EVEN_NP, Vtp, S, (t + 1) * 64, tid);
            const int key0 = t * 64;
            const bool vis = key0 <= q0 + wave * 32 + 31;
            const bool live = (key0 + 63 >= q0) || (kbw - kbt[key0 + 63 - s0] <= THR);
            if (vis && __builtin_amdgcn_readfirstlane((int)live)) {
                f32x16 p0, p1; attn_scores(p0, p1, cur, qf, lane);
#pragma unroll
                for (int g = 0; g < 4; ++g) {
                    const f32x4 b0 = *(const LAS f32x4*)(kbt + key0 - s0 + 8 * g + 4 * hi), b1 = *(const LAS f32x4*)(kbt + key0 - s0 + 32 + 8 * g + 4 * hi);
#pragma unroll
                    for (int e = 0; e < 4; ++e) { p0[4 * g + e] = p0[4 * g + e] * C2 + b0[e]; p1[4 * g + e] = p1[4 * g + e] * C2 + b1[e]; }
                }
                if (key0 + 63 > q0 + wave * 32) {
#pragma unroll
                    for (int r = 0; r < 16; ++r) { const int kv = key0 + crow(r, hi); if (kv > qrow) p0[r] = -INFINITY; if (kv + 32 > qrow) p1[r] = -INFINITY; }
                }
                attn_update(a, p0, p1, cur, lane);
            }
            if (t + 1 < nt) kv_store(kr, kvb + ((t + 1 - t_start) & 1) * KV_BUF_BYTES, tid);
            __syncthreads();
        }
        attn_store(a, obase + (size_t)qrow * opitch + h * 64, lane);
    }
}

constexpr int MR_KIMG = 32768, MR_VTP = 520, MR_VIMG = 64 * MR_VTP;
__device__ __forceinline__ void kv256_load(v4u (&rk)[4], v4u (&rv)[4], const bf16* Kp, size_t kpitch, const bf16* Vp, size_t vpitch, int tid) {
#pragma unroll
    for (int i = 0; i < 4; ++i) { const int piece = tid + 512 * i;
        rk[i] = *(const GAS v4u*)(Kp + (size_t)(piece >> 3) * kpitch + (piece & 7) * 8);
        rv[i] = *(const GAS v4u*)(Vp + (size_t)(piece >> 5) * vpitch + (piece & 31) * 8); }
}
__device__ __forceinline__ void kv256_store(const v4u (&rk)[4], const v4u (&rv)[4], LAS unsigned char* kimg, LAS unsigned char* vimg, int tid) {
#pragma unroll
    for (int i = 0; i < 4; ++i) { const int piece = tid + 512 * i;
        *(LAS v4u*)(kimg + ((piece & 7) * 256 + (piece >> 3)) * 16) = rk[i];
        LAS unsigned char* vp = vimg + (piece >> 5) * MR_VTP + (piece & 31) * 16;
        *(LAS u32x2*)vp = (u32x2){rv[i].x, rv[i].y}; *(LAS u32x2*)(vp + 8) = (u32x2){rv[i].z, rv[i].w}; }
}
__device__ __forceinline__ void memattn_phase(const InTab& in, unsigned char* ws, int L, LAS unsigned char* lds, int G, int tid, int wave, int lane) {
    const bf16* QM = (const bf16*)(ws + WS_BIG + B_QM); bf16* OM = (bf16*)(ws + WS_BIG + B_OM);
    const bf16* memK = (const bf16*)(ws + WS_MEMK) + (size_t)L * 256 * 256; const bf16* memVt = (const bf16*)(ws + WS_MEMK + 256 * 1024) + (size_t)L * 256 * 256;
    const float* qn = in.get(20) + (size_t)L * 64;
    LAS unsigned char* kvb = lds;
    const int r32 = lane & 31, hi = lane >> 5;
    for (int un = blockIdx.x; un < 256; un += G) {
        const int QB = un >> 2, hm = un & 3, qrow = QB * 256 + wave * 32 + r32;
        bf16x8 qf[4];
        {
            const bf16* qp = QM + (size_t)qrow * MEMW + hm * 64; float x[4][8]; float ss = 0.f;
#pragma unroll
            for (int ks = 0; ks < 4; ++ks) { const v4u w = *(const GAS v4u*)(qp + 16 * ks + 8 * hi); unpack8(w, x[ks]);
#pragma unroll
                for (int j = 0; j < 8; ++j) ss += x[ks][j] * x[ks][j]; }
            ss = sh32_sum(ss);
            const float r = rsqrtf(ss * (1.0f / 64.0f) + RMS_EPS);
#pragma unroll
            for (int ks = 0; ks < 4; ++ks) {
#pragma unroll
                for (int j = 0; j < 8; ++j) x[ks][j] = x[ks][j] * r * qn[16 * ks + 8 * hi + j];
                qf[ks] = __builtin_bit_cast(bf16x8, pack8(x[ks])); }
        }
        AttnAcc a; attn_init(a);
        const bf16* Kp = memK + hm * 64; const bf16* Vtp = memVt + (size_t)hm * 64 * 256;
        __syncthreads();
        { v4u rk[4], rv[4]; kv256_load(rk, rv, Kp, 256, Vtp, 256, tid); kv256_store(rk, rv, kvb, kvb + MR_KIMG, tid); }
        __syncthreads();
#pragma unroll 1
        for (int t = 0; t < 4; ++t) {
            f32x16 p0, p1; attn_scores<4096>(p0, p1, kvb + t * 64 * 16, qf, lane);
            attn_update<MR_VTP, 0>(a, p0, p1, kvb + MR_KIMG + t * 128, lane, C2);
        }
        attn_store(a, OM + (size_t)qrow * MEMW + hm * 64, lane);
    }
}

constexpr int MF_QP = 528;
__device__ __forceinline__ void memfused_phase(const InTab& in, unsigned char* ws, int L, const float* ssq, float* H, bf16* HBo, float* ssq_out, LAS unsigned char* lds, int G, int tid, int wave, int lane) {
    const bf16* HBi = (const bf16*)(ws + WS_HB);
    const bf16* Wq = (const bf16*)(ws + WS_W + (L ? W_MEMQ2 : W_MEMQ)); const bf16* Wo = (const bf16*)(ws + WS_W + (L ? W_MEMO2 : W_MEMO));
    const bf16* memK = (const bf16*)(ws + WS_MEMK) + (size_t)L * 256 * 256; const bf16* memVt = (const bf16*)(ws + WS_MEMK + 256 * 1024) + (size_t)L * 256 * 256;
    const float* qn = in.get(20) + (size_t)L * 64;
    LAS unsigned char* qs = lds; LAS unsigned char* os = lds + 64 * MF_QP; LAS float* xq = (LAS float*)(lds + 2 * 64 * MF_QP); LAS float* xs = xq + 512;
    const int r32 = lane & 31, hi = lane >> 5;
    for (int un = blockIdx.x; un < S / 64; un += G) {
        const int r0 = un * 64;
        f32x16 qa[2];
#pragma unroll
        for (int r = 0; r < 16; ++r) { qa[0][r] = 0.f; qa[1][r] = 0.f; }
        { const bf16* ap = Wq + (size_t)(32 * wave + r32) * DM + 8 * hi; const bf16* bp0 = HBi + (size_t)(r0 + r32) * DM + 8 * hi; const bf16* bp1 = bp0 + (size_t)32 * DM;
#pragma unroll 1
          for (int k8 = 0; k8 < 64; k8 += 8) {
              bf16x8 a[8], b0[8], b1[8];
#pragma unroll
              for (int j = 0; j < 8; ++j) { a[j] = *(const GAS bf16x8*)(ap + 16 * (k8 + j)); b0[j] = *(const GAS bf16x8*)(bp0 + 16 * (k8 + j)); b1[j] = *(const GAS bf16x8*)(bp1 + 16 * (k8 + j)); }
#pragma unroll
              for (int j = 0; j < 8; ++j) { qa[0] = __builtin_amdgcn_mfma_f32_32x32x16_bf16(a[j], b0[j], qa[0], 0, 0, 0); qa[1] = __builtin_amdgcn_mfma_f32_32x32x16_bf16(a[j], b1[j], qa[1], 0, 0, 0); } } }
        __syncthreads();
#pragma unroll
        for (int rt = 0; rt < 2; ++rt) { const float rr = pg8::row_rstd(ssq, r0 + 32 * rt + r32); float ss = 0.f;
#pragma unroll
            for (int r = 0; r < 16; ++r) { qa[rt][r] *= rr; ss += qa[rt][r] * qa[rt][r]; }
            ss = sh32_sum(ss);
            if (hi == 0) xq[wave * 64 + 32 * rt + r32] = ss; }
        __syncthreads();
#pragma unroll
        for (int rt = 0; rt < 2; ++rt) { const float tot = xq[wave * 64 + 32 * rt + r32] + xq[(wave ^ 1) * 64 + 32 * rt + r32];
            const float rh = rsqrtf(tot * (1.0f / 64.0f) + RMS_EPS);
            LAS unsigned char* qrow = qs + (32 * rt + r32) * MF_QP + (32 * wave) * 2;
#pragma unroll
            for (int g = 0; g < 4; ++g) { const int d = 32 * (wave & 1) + 8 * g + 4 * hi;
                u32x2 w; w.x = cvtpk(qa[rt][4 * g] * rh * qn[d], qa[rt][4 * g + 1] * rh * qn[d + 1]); w.y = cvtpk(qa[rt][4 * g + 2] * rh * qn[d + 2], qa[rt][4 * g + 3] * rh * qn[d + 3]);
                *(LAS u32x2*)(qrow + (8 * g + 4 * hi) * 2) = w; } }
        __syncthreads();
        { const int rt = wave & 1, hm = wave >> 1;
          bf16x8 qf[4];
#pragma unroll
          for (int ks = 0; ks < 4; ++ks) qf[ks] = *(const LAS bf16x8*)(qs + (32 * rt + r32) * MF_QP + (hm * 64 + 16 * ks + 8 * hi) * 2);
          AttnAcc a; attn_init(a);
          const bf16* kp = memK + hm * 64 + 8 * hi; const bf16* vp = memVt + (size_t)(hm * 64 + r32) * 256 + 4 * hi;
#pragma unroll 1
          for (int t = 0; t < 4; ++t) {
              f32x16 p0, p1;
#pragma unroll
              for (int r = 0; r < 16; ++r) { p0[r] = 0.f; p1[r] = 0.f; }
#pragma unroll
              for (int ks = 0; ks < 4; ++ks) { const bf16x8 k0 = *(const GAS bf16x8*)(kp + (size_t)(64 * t + r32) * 256 + 16 * ks), k1 = *(const GAS bf16x8*)(kp + (size_t)(64 * t + 32 + r32) * 256 + 16 * ks);
                  p0 = __builtin_amdgcn_mfma_f32_32x32x16_bf16(k0, qf[ks], p0, 0, 0, 0); p1 = __builtin_amdgcn_mfma_f32_32x32x16_bf16(k1, qf[ks], p1, 0, 0, 0); }
              float mx = fmaxf(p0[0], p1[0]);
#pragma unroll
              for (int r = 0; r < 16; ++r) { p0[r] *= C2; p1[r] *= C2; }
              mx = fmaxf(p0[0], p1[0]);
#pragma unroll
              for (int r = 1; r < 16; ++r) mx = fmaxf(mx, fmaxf(p0[r], p1[r]));
              mx = sh32_max(mx);
              const float mnew = fmaxf(a.m, mx); const float alpha = __builtin_amdgcn_exp2f(a.m - mnew); float sum = 0.f;
#pragma unroll
              for (int r = 0; r < 16; ++r) { p0[r] = __builtin_amdgcn_exp2f(p0[r] - mnew); p1[r] = __builtin_amdgcn_exp2f(p1[r] - mnew); sum += p0[r] + p1[r]; }
              a.l = a.l * alpha + sum; a.m = mnew;
#pragma unroll
              for (int r = 0; r < 16; ++r) { a.o0[r] *= alpha; a.o1[r] *= alpha; }
#pragma unroll
              for (int half = 0; half < 2; ++half)
#pragma unroll
                  for (int s2 = 0; s2 < 2; ++s2) { v4u pw;
                      if (half == 0) { pw.x = cvtpk(p0[8 * s2 + 0], p0[8 * s2 + 1]); pw.y = cvtpk(p0[8 * s2 + 2], p0[8 * s2 + 3]); pw.z = cvtpk(p0[8 * s2 + 4], p0[8 * s2 + 5]); pw.w = cvtpk(p0[8 * s2 + 6], p0[8 * s2 + 7]); }
                      else           { pw.x = cvtpk(p1[8 * s2 + 0], p1[8 * s2 + 1]); pw.y = cvtpk(p1[8 * s2 + 2], p1[8 * s2 + 3]); pw.z = cvtpk(p1[8 * s2 + 4], p1[8 * s2 + 5]); pw.w = cvtpk(p1[8 * s2 + 6], p1[8 * s2 + 7]); }
                      const bf16x8 pb = __builtin_bit_cast(bf16x8, pw);
                      const int key = 64 * t + 32 * half + 16 * s2;
#pragma unroll
                      for (int d0 = 0; d0 < 2; ++d0) { const u32x2 lo = *(const GAS u32x2*)(vp + (size_t)(32 * d0) * 256 + key), h2 = *(const GAS u32x2*)(vp + (size_t)(32 * d0) * 256 + key + 8);
                          const bf16x8 va = __builtin_bit_cast(bf16x8, (v4u){lo.x, lo.y, h2.x, h2.y});
                          if (d0 == 0) a.o0 = __builtin_amdgcn_mfma_f32_32x32x16_bf16(va, pb, a.o0, 0, 0, 0); else a.o1 = __builtin_amdgcn_mfma_f32_32x32x16_bf16(va, pb, a.o1, 0, 0, 0); } }
          }
          const float inv = 1.0f / sh32_sum(a.l);
          LAS unsigned char* orow = os + (32 * rt + r32) * MF_QP + (hm * 64) * 2;
#pragma unroll
          for (int g = 0; g < 4; ++g) { u32x2 w0, w1;
              w0.x = cvtpk(a.o0[4 * g] * inv, a.o0[4 * g + 1] * inv); w0.y = cvtpk(a.o0[4 * g + 2] * inv, a.o0[4 * g + 3] * inv);
              w1.x = cvtpk(a.o1[4 * g] * inv, a.o1[4 * g + 1] * inv); w1.y = cvtpk(a.o1[4 * g + 2] * inv, a.o1[4 * g + 3] * inv);
              *(LAS u32x2*)(orow + (8 * g + 4 * hi) * 2) = w0; *(LAS u32x2*)(orow + (32 + 8 * g + 4 * hi) * 2) = w1; } }
        __syncthreads();
        float rowsq[2];
#pragma unroll 1
        for (int rt = 0; rt < 2; ++rt) {
            f32x16 oc[4];
#pragma unroll
            for (int ct = 0; ct < 4; ++ct)
#pragma unroll
                for (int r = 0; r < 16; ++r) oc[ct][r] = 0.f;
            const bf16* ap = Wo + (size_t)(128 * wave + r32) * MEMW + 8 * hi;
#pragma unroll 4
            for (int ks = 0; ks < 16; ++ks) { const bf16x8 b = *(const LAS bf16x8*)(os + (32 * rt + r32) * MF_QP + (16 * ks + 8 * hi) * 2);
#pragma unroll
                for (int ct = 0; ct < 4; ++ct) { const bf16x8 a = *(const GAS bf16x8*)(ap + (size_t)(32 * ct) * MEMW + 16 * ks); oc[ct] = __builtin_amdgcn_mfma_f32_32x32x16_bf16(a, b, oc[ct], 0, 0, 0); } }
            const int row = r0 + 32 * rt + r32; float sq = 0.f;
#pragma unroll
            for (int ct = 0; ct < 4; ++ct)
#pragma unroll
                for (int g = 0; g < 4; ++g) { const int col = 128 * wave + 32 * ct + 8 * g + 4 * hi;
                    float* hp = H + (size_t)row * DM + col; f32x4 hv = *(const GAS f32x4*)hp;
                    hv[0] += oc[ct][4 * g]; hv[1] += oc[ct][4 * g + 1]; hv[2] += oc[ct][4 * g + 2]; hv[3] += oc[ct][4 * g + 3];
                    *(GAS f32x4*)hp = hv; sq += (hv[0] * hv[0] + hv[1] * hv[1]) + (hv[2] * hv[2] + hv[3] * hv[3]);
                    u32x2 w; w.x = cvtpk(hv[0], hv[1]); w.y = cvtpk(hv[2], hv[3]); *(GAS u32x2*)(HBo + (size_t)row * DM + col) = w; }
            rowsq[rt] = sh32_sum(sq);
        }
        if (hi == 0) { xs[wave * 64 + r32] = rowsq[0]; xs[wave * 64 + 32 + r32] = rowsq[1]; }
        __syncthreads();
        if (tid < 64) { float t2 = 0.f;
#pragma unroll
            for (int w8 = 0; w8 < 8; ++w8) t2 += xs[w8 * 64 + tid];
            float* sp = ssq_out + (size_t)(r0 + tid) * 16; *(GAS f32x4*)sp = (f32x4){t2, 0.f, 0.f, 0.f};
            *(GAS f32x4*)(sp + 4) = (f32x4){0.f, 0.f, 0.f, 0.f}; *(GAS f32x4*)(sp + 8) = (f32x4){0.f, 0.f, 0.f, 0.f}; *(GAS f32x4*)(sp + 12) = (f32x4){0.f, 0.f, 0.f, 0.f}; }
    }
}

constexpr size_t WS_MSEL = 7 * MiB;
constexpr size_t WS_MLSE = 8 * MiB;
constexpr size_t B_OP0 = 64 * MiB, B_OP1 = 128 * MiB;
__device__ __forceinline__ bool gate_better(float g1, int n1, float g2, int n2) { return g1 > g2 || (g1 == g2 && n1 < n2); }
__device__ __forceinline__ void moba_gate_phase(unsigned char* ws, int G, int wave, int lane) {
    const bf16* Q = (const bf16*)(ws + WS_BIG + B_PROJ); const float* ksum = (const float*)(ws + WS_KSUM); unsigned* selg = (unsigned*)(ws + WS_MSEL);
    const int r32 = lane & 31, hi = lane >> 5;
    const int NW = G * NWAVES;
    const int gwid = (int)blockIdx.x * NWAVES + wave;
    const int per_head = NW / 16;
    if (per_head == 0) return;
    const int h = gwid / per_head, wi = gwid % per_head;
    if (h >= 16) return;
    float af[2][32];
#pragma unroll
    for (int g = 0; g < 2; ++g)
#pragma unroll
        for (int kk = 0; kk < 32; ++kk) af[g][kk] = ksum[(size_t)(32 * g + r32) * 1024 + h * 64 + 2 * kk + hi] * (1.0f / 256.0f);
    for (int tile = wi; tile < S / 32; tile += per_head) {
        const int t = tile * 32 + r32, own = (tile * 32) >> 8;
        float bq[32];
        { const bf16* qp = Q + (size_t)t * DM + h * 64;
#pragma unroll
          for (int c = 0; c < 8; ++c) { const unsigned sh = hi ? 0u : 16u;   const v4u w = *(const GAS v4u*)(qp + 8 * c);
              bq[4 * c + 0] = __uint_as_float((w.x << sh) & 0xffff0000u); bq[4 * c + 1] = __uint_as_float((w.y << sh) & 0xffff0000u);
              bq[4 * c + 2] = __uint_as_float((w.z << sh) & 0xffff0000u); bq[4 * c + 3] = __uint_as_float((w.w << sh) & 0xffff0000u); } }
        float g0 = -INFINITY, g1 = -INFINITY, g2 = -INFINITY; int n0 = 255, n1 = 255, n2 = 255;
#pragma unroll
        for (int g = 0; g < 2; ++g) {
            if (32 * g < own) {
                f32x16 c;
#pragma unroll
                for (int r = 0; r < 16; ++r) c[r] = 0.f;
#pragma unroll
                for (int kk = 0; kk < 32; ++kk) c = __builtin_amdgcn_mfma_f32_32x32x2f32(af[g][kk], bq[kk], c, 0, 0, 0);
#pragma unroll
                for (int r = 0; r < 16; ++r) { const int n = 32 * g + crow(r, hi); const float gv = (n < own) ? c[r] : -INFINITY;
                    if (n < own) {
                        if (gate_better(gv, n, g0, n0)) { g2 = g1; n2 = n1; g1 = g0; n1 = n0; g0 = gv; n0 = n; }
                        else if (gate_better(gv, n, g1, n1)) { g2 = g1; n2 = n1; g1 = gv; n1 = n; }
                        else if (gate_better(gv, n, g2, n2)) { g2 = gv; n2 = n; } } }
            }
        }
        const float p0 = sh32_get(g0, lane), p1 = sh32_get(g1, lane), p2 = sh32_get(g2, lane);
        const int pn0 = __float_as_int(sh32_get(__int_as_float(n0), lane)), pn1 = __float_as_int(sh32_get(__int_as_float(n1), lane)), pn2 = __float_as_int(sh32_get(__int_as_float(n2), lane));
        float fg[3]; int fn[3]; int ia = 0, ib = 0;
#pragma unroll
        for (int k = 0; k < 3; ++k) {
            const float ga = (ia == 0) ? g0 : (ia == 1) ? g1 : (ia == 2) ? g2 : -INFINITY; const int na = (ia == 0) ? n0 : (ia == 1) ? n1 : (ia == 2) ? n2 : 255;
            const float gb = (ib == 0) ? p0 : (ib == 1) ? p1 : (ib == 2) ? p2 : -INFINITY; const int nb = (ib == 0) ? pn0 : (ib == 1) ? pn1 : (ib == 2) ? pn2 : 255;
            const bool ta = (na != 255) && (nb == 255 || gate_better(ga, na, gb, nb));
            if (ta) { fg[k] = ga; fn[k] = na; ++ia; } else { fg[k] = gb; fn[k] = nb; ++ib; }
        }
        (void)fg;
        if (hi == 0) selg[(size_t)h * S + t] = (unsigned)(fn[0] & 255) | ((unsigned)(fn[1] & 255) << 8) | ((unsigned)(fn[2] & 255) << 16);
    }
}
constexpr int CW_MOBAQ = 192;
__device__ __forceinline__ void moba_route_phase(unsigned char* ws, unsigned char* spare, LAS unsigned char* lds, int G, int tid, int wave, int lane, int qword) {
    const bf16* Q = (const bf16*)(ws + WS_BIG + B_PROJ); const bf16* Kb = Q + (size_t)S * DM; const bf16* Vt = (const bf16*)(ws + WS_BIG + B_VTM);
    const unsigned* selg = (const unsigned*)(ws + WS_MSEL); float* lse = (float*)(ws + WS_MLSE);
    unsigned* qctr = (unsigned*)(ws + WS_CTL) + qword;
    LAS unsigned char* kimg = lds; LAS unsigned char* vimg = lds + MR_KIMG;
    LAS int* list = (LAS int*)(lds + MR_KIMG + MR_VIMG);
    LAS int* wtot = list + 16384;
    LAS int* ubox = wtot + 256;
    const int r32 = lane & 31, hi = lane >> 5;
    const int NUNITS = 16 * 63;
    for (;;) {
        __syncthreads();
        if (tid == 0) ubox[0] = (int)atomicAdd(qctr, 1u);
        __syncthreads();
        const int u = ubox[0];
        if (u >= NUNITS) break;
        const int c = 0, rem = u;
        const int n = rem >> 4, h = rem & 15;
        const int tlo = 256 * (n + 1);
        v4u kst[4], vst[4];
        { const bf16* Kp = Kb + (size_t)(256 * n) * DM + h * 64; const bf16* Vp = Vt + (size_t)h * 64 * S + 256 * n;
#pragma unroll
          for (int i = 0; i < 4; ++i) { const int piece = tid + 512 * i;
              kst[i] = *(const GAS v4u*)(Kp + (size_t)(piece >> 3) * DM + (piece & 7) * 8);
              vst[i] = *(const GAS v4u*)(Vp + (size_t)(piece >> 5) * S + (piece & 31) * 8); } }
        int myent[32]; bool mysel[32];
#pragma unroll
        for (int i = 0; i < 32; ++i) { const int t = 512 * i + tid; mysel[i] = false; myent[i] = 0;
            if (t >= tlo) { const unsigned w = selg[(size_t)h * S + t];
                const int slot = ((w & 255u) == (unsigned)n) ? 0 : (((w >> 8) & 255u) == (unsigned)n) ? 1 : (((w >> 16) & 255u) == (unsigned)n) ? 2 : -1;
                if (slot >= 0) { mysel[i] = true; myent[i] = t | (slot << 16); } }
            const unsigned long long mk = __ballot(mysel[i]);
            if (lane == 0) wtot[i * 8 + wave] = __popcll(mk); }
        __syncthreads();
        int cnt = 0;
#pragma unroll
        for (int i = 0; i < 32; ++i) { int base = cnt;
#pragma unroll
            for (int w8 = 0; w8 < 8; ++w8) { const int v = wtot[i * 8 + w8]; if (w8 < wave) base += v; cnt += v; }
            const unsigned long long mk = __ballot(mysel[i]);
            if (mysel[i]) list[base + __popcll(mk & ((1ull << lane) - 1ull))] = myent[i]; }
#pragma unroll
        for (int i = 0; i < 4; ++i) { const int piece = tid + 512 * i;
            *(LAS v4u*)(kimg + ((piece & 7) * 256 + (piece >> 3)) * 16) = kst[i];
            LAS unsigned char* vp = vimg + (piece >> 5) * MR_VTP + (piece & 31) * 16;
            *(LAS u32x2*)vp = (u32x2){vst[i].x, vst[i].y}; *(LAS u32x2*)(vp + 8) = (u32x2){vst[i].z, vst[i].w}; }
        __syncthreads();
        if (cnt == 0) continue;
        const int ntile = (cnt + 31) >> 5;
        for (int ti = wave; ti < ntile; ti += NWAVES) {
            const int e = ti * 32 + r32; const bool live = e < cnt;
            const int ent = list[live ? e : 0]; const int t = ent & 0xffff, slot = ent >> 16;
            bf16x8 qf[4]; load_q(qf, Q + (size_t)t * DM + h * 64, lane);
            AttnAcc a; attn_init(a);
#pragma unroll 1
            for (int j = 0; j < 4; ++j) {
                f32x16 p0, p1; attn_scores<4096>(p0, p1, kimg + j * 64 * 16, qf, lane);
                attn_update<MR_VTP, 0>(a, p0, p1, vimg + j * 128, lane, C2);
            }
            const float l = sh32_sum(a.l); const float inv = 1.0f / l;
            if (live) {
                bf16* orow = (bf16*)(slot == 0 ? ws + WS_BIG + B_OP0 : slot == 1 ? ws + WS_BIG + B_OP1 : spare) + ((size_t)t * 16 + h) * 64;
#pragma unroll
                for (int g = 0; g < 4; g += 2) {
#pragma unroll
                    for (int d0 = 0; d0 < 2; ++d0) {
                        u32x2 wa, wb;
                        if (d0 == 0) { wa.x = cvtpk(a.o0[4 * g] * inv, a.o0[4 * g + 1] * inv); wa.y = cvtpk(a.o0[4 * g + 2] * inv, a.o0[4 * g + 3] * inv);
                                       wb.x = cvtpk(a.o0[4 * g + 4] * inv, a.o0[4 * g + 5] * inv); wb.y = cvtpk(a.o0[4 * g + 6] * inv, a.o0[4 * g + 7] * inv); }
                        else         { wa.x = cvtpk(a.o1[4 * g] * inv, a.o1[4 * g + 1] * inv); wa.y = cvtpk(a.o1[4 * g + 2] * inv, a.o1[4 * g + 3] * inv);
                                       wb.x = cvtpk(a.o1[4 * g + 4] * inv, a.o1[4 * g + 5] * inv); wb.y = cvtpk(a.o1[4 * g + 6] * inv, a.o1[4 * g + 7] * inv); }
                        { auto rx = __builtin_amdgcn_permlane32_swap(wa.x, wb.x, false, false); wa.x = rx[0]; wb.x = rx[1]; }
                        { auto ry = __builtin_amdgcn_permlane32_swap(wa.y, wb.y, false, false); wa.y = ry[0]; wb.y = ry[1]; }
                        *(GAS v4u*)(orow + 32 * d0 + 8 * g + 8 * hi) = (v4u){wa.x, wa.y, wb.x, wb.y};
                    } }
                if (hi == 0) lse[((size_t)slot * S + t) * 16 + h] = a.m + __builtin_amdgcn_logf(l);
            }
        }
    }
}
__device__ __forceinline__ void moba_own_phase(unsigned char* ws, unsigned char* spare, LAS unsigned char* lds, int G, int tid, int wave, int lane, bf16* obase, size_t opitch) {
    bf16* Q = (bf16*)(ws + WS_BIG + B_PROJ); const bf16* Kb = Q + (size_t)S * DM; const bf16* Vt = (const bf16*)(ws + WS_BIG + B_VTM);
    const unsigned* selg = (const unsigned*)(ws + WS_MSEL); const float* lse = (const float*)(ws + WS_MLSE);
    LAS unsigned char* kvb = lds;
    const int r32 = lane & 31, hi = lane >> 5;
    LAS unsigned char* vimg = lds + MR_KIMG;
    v4u rk[4], rv[4];
    if ((int)blockIdx.x < 1024) { const int h0 = (int)blockIdx.x & 15, q00 = ((int)blockIdx.x >> 4) * 256; kv256_load(rk, rv, Kb + (size_t)q00 * DM + h0 * 64, DM, Vt + (size_t)h0 * 64 * S + q00, S, tid); }
    for (int un = blockIdx.x; un < 1024; un += G) {
        const int h = un & 15, QB = un >> 4, q0 = QB * 256, qrow = q0 + wave * 32 + r32;
        bf16x8 qf[4]; load_q(qf, Q + (size_t)qrow * DM + h * 64, lane);
        AttnAcc a; attn_init(a);
        __syncthreads();
        kv256_store(rk, rv, kvb, vimg, tid);
        __syncthreads();
        { const int un2 = un + G; if (un2 < 1024) { const int h2 = un2 & 15, q02 = (un2 >> 4) * 256; kv256_load(rk, rv, Kb + (size_t)q02 * DM + h2 * 64, DM, Vt + (size_t)h2 * 64 * S + q02, S, tid); } }
#pragma unroll 1
        for (int t = 0; t < 4; ++t) {
            const int key0 = q0 + t * 64;
            if (key0 <= q0 + wave * 32 + 31) {
                f32x16 p0, p1; attn_scores<4096>(p0, p1, kvb + t * 64 * 16, qf, lane);
#pragma unroll
                for (int r = 0; r < 16; ++r) { const int kv = key0 + crow(r, hi); p0[r] = (kv > qrow) ? -INFINITY : p0[r]; p1[r] = (kv + 32 > qrow) ? -INFINITY : p1[r]; }
                attn_update<MR_VTP, 0>(a, p0, p1, vimg + t * 128, lane, C2);
            }
        }
        const unsigned sw = selg[(size_t)h * S + qrow];
        float L[3];
#pragma unroll
        for (int j = 0; j < 3; ++j) L[j] = (((sw >> (8 * j)) & 255u) != 255u) ? lse[((size_t)j * S + qrow) * 16 + h] : -INFINITY;
        const float M = fmaxf(fmaxf(a.m, L[0]), fmaxf(L[1], L[2]));
        const float so = __builtin_amdgcn_exp2f(a.m - M);
        float W = sh32_sum(a.l) * so;
#pragma unroll
        for (int r = 0; r < 16; ++r) { a.o0[r] *= so; a.o1[r] *= so; }
#pragma unroll
        for (int j = 0; j < 3; ++j) {
            if (L[j] != -INFINITY) {
                const float wj = __builtin_amdgcn_exp2f(L[j] - M); W += wj;
                const bf16* orow = (const bf16*)(j == 0 ? ws + WS_BIG + B_OP0 : j == 1 ? ws + WS_BIG + B_OP1 : spare) + ((size_t)qrow * 16 + h) * 64;
#pragma unroll
                for (int g = 0; g < 4; ++g) { const u32x2 w0 = *(const GAS u32x2*)(orow + 8 * g + 4 * hi), w1 = *(const GAS u32x2*)(orow + 32 + 8 * g + 4 * hi);
                    a.o0[4 * g] += wj * bflo(w0.x); a.o0[4 * g + 1] += wj * bfhi(w0.x); a.o0[4 * g + 2] += wj * bflo(w0.y); a.o0[4 * g + 3] += wj * bfhi(w0.y);
                    a.o1[4 * g] += wj * bflo(w1.x); a.o1[4 * g + 1] += wj * bfhi(w1.x); a.o1[4 * g + 2] += wj * bflo(w1.y); a.o1[4 * g + 3] += wj * bfhi(w1.y); }
            }
        }
        const float inv = 1.0f / W;
        bf16* orow = obase + (size_t)qrow * opitch + h * 64;
#pragma unroll
        for (int g = 0; g < 4; ++g) { u32x2 w0, w1;
            w0.x = cvtpk(a.o0[4 * g] * inv, a.o0[4 * g + 1] * inv); w0.y = cvtpk(a.o0[4 * g + 2] * inv, a.o0[4 * g + 3] * inv);
            w1.x = cvtpk(a.o1[4 * g] * inv, a.o1[4 * g + 1] * inv); w1.y = cvtpk(a.o1[4 * g + 2] * inv, a.o1[4 * g + 3] * inv);
            *(GAS u32x2*)(orow + 8 * g + 4 * hi) = w0; *(GAS u32x2*)(orow + 32 + 8 * g + 4 * hi) = w1; }
    }
}

typedef float f32x4v __attribute__((ext_vector_type(4)));
__device__ __forceinline__ unsigned mono_key(float s) { if (s == 0.f) s = 0.f; const unsigned u = __float_as_uint(s); return (u & 0x80000000u) ? ~u : (u | 0x80000000u); }
__device__ __forceinline__ float unmono_f(unsigned u) { return __uint_as_float((u & 0x80000000u) ? (u ^ 0x80000000u) : ~u); }
constexpr int DS_CAP = 512;
__device__ __forceinline__ int wave_sum_dpp(int v) {
    v += __builtin_amdgcn_update_dpp(0, v, 0xB1, 0xF, 0xF, true); v += __builtin_amdgcn_update_dpp(0, v, 0x4E, 0xF, 0xF, true);
    v += __builtin_amdgcn_update_dpp(0, v, 0x141, 0xF, 0xF, true); v += __builtin_amdgcn_update_dpp(0, v, 0x140, 0xF, 0xF, true);
    v += __builtin_amdgcn_update_dpp(0, v, 0x142, 0xA, 0xF, false); v += __builtin_amdgcn_update_dpp(0, v, 0x143, 0xC, 0xF, false);
    return __builtin_amdgcn_readlane(v, 63); }
__device__ __forceinline__ unsigned wave_or(unsigned u) { int v = (int)u;
    v |= __builtin_amdgcn_update_dpp(0, v, 0xB1, 0xF, 0xF, true); v |= __builtin_amdgcn_update_dpp(0, v, 0x4E, 0xF, 0xF, true);
    v |= __builtin_amdgcn_update_dpp(0, v, 0x141, 0xF, 0xF, true); v |= __builtin_amdgcn_update_dpp(0, v, 0x140, 0xF, 0xF, true);
    v |= __builtin_amdgcn_update_dpp(0, v, 0x142, 0xA, 0xF, false); v |= __builtin_amdgcn_update_dpp(0, v, 0x143, 0xC, 0xF, false);
    return (unsigned)__builtin_amdgcn_readlane(v, 63); }
template <bool EXACT>
__device__ __forceinline__ unsigned dsa_compact(LAS u32x2* ent, int n, int& nkeep, int lane) {
    unsigned k[8]; unsigned ix[8]; unsigned orv = 0u, nandv = 0u;
#pragma unroll
    for (int j = 0; j < 8; ++j) { const int e = lane + 64 * j; const bool in = e < n; const u32x2 v = ent[in ? e : 0]; const unsigned mk = mono_key(__uint_as_float(v.x)); k[j] = in ? mk : 0u; ix[j] = v.y; orv |= k[j]; nandv |= in ? ~mk : 0u; }
    unsigned T = 0u; int cntT = n; int bit0 = 31;
    if (!EXACT) {
        const unsigned diff = (unsigned)__builtin_amdgcn_readfirstlane((int)(wave_or(orv) & wave_or(nandv)));
        if (diff != 0u) { bit0 = 31 - __builtin_clz(diff); const unsigned anyk = (unsigned)__builtin_amdgcn_readfirstlane((int)k[0]);
            T = (bit0 == 31) ? 0u : (anyk & ~((2u << bit0) - 1u)); }
    }
    for (int bit = bit0; bit >= 0; --bit) {
        const unsigned cand = T | (1u << bit); int cl = 0;
#pragma unroll
        for (int j = 0; j < 8; ++j) cl += (k[j] >= cand) ? 1 : 0;
        const int c = wave_sum_dpp(cl);
        if (c >= 256) { T = cand; cntT = c; if (!EXACT && c <= 320) break; }
    }
    int Jstar = 0x10000;
    if (cntT > (EXACT ? 256 : 320)) {
        int gl = 0;
#pragma unroll
        for (int j = 0; j < 8; ++j) gl += (k[j] > T) ? 1 : 0;
        const int gt = wave_sum_dpp(gl);
        const int need = 256 - gt; int Jm = 0;
        for (int bit = 14; bit >= 0; --bit) { const int cand = Jm | (1 << bit); int cl = 0;
#pragma unroll
            for (int j = 0; j < 8; ++j) cl += (k[j] == T && (int)ix[j] < cand) ? 1 : 0;
            if (wave_sum_dpp(cl) < need) Jm = cand; }
        Jstar = Jm + 1;
    }
    int base = 0;
    const unsigned long long lt = (1ull << lane) - 1ull;
#pragma unroll
    for (int j = 0; j < 8; ++j) { const bool pred = (k[j] > T) || (k[j] == T && T != 0u && (int)ix[j] < Jstar);
        const unsigned long long mask = __builtin_amdgcn_ballot_w64(pred); const int pos = base + __popcll(mask & lt);
        if (pred) ent[pos] = (u32x2){__float_as_uint(unmono_f(k[j])), ix[j]};
        base += __popcll(mask); }
    nkeep = base;
    return T;
}
#define DSA_HEADSUM(s, msk, P, B, W, tf) asm("v_max_f32_e32 %1, 0, %3\n\tv_mul_f32_e32 %0, %11, %1\n\tv_max_f32_e32 %1, 0, %4\n\tv_fmac_f32_e32 %0, %12, %1\n\tv_max_f32_e32 %1, 0, %5\n\tv_fmac_f32_e32 %0, %13, %1\n\t" \
        "v_max_f32_e32 %1, 0, %6\n\tv_fmac_f32_e32 %0, %14, %1\n\tv_max_f32_e32 %1, 0, %7\n\tv_fmac_f32_e32 %0, %15, %1\n\tv_max_f32_e32 %1, 0, %8\n\tv_fmac_f32_e32 %0, %16, %1\n\t" \
        "v_max_f32_e32 %1, 0, %9\n\tv_fmac_f32_e32 %0, %17, %1\n\tv_max_f32_e32 %1, 0, %10\n\tv_fmac_f32_e32 %0, %18, %1\n\tv_cmp_ge_f32_e64 %2, %0, %19" \
        : "=&v"(s), "=&v"(tmp_), "=s"(msk) : "v"(P[B + 0]), "v"(P[B + 1]), "v"(P[B + 2]), "v"(P[B + 3]), "v"(P[B + 4]), "v"(P[B + 5]), "v"(P[B + 6]), "v"(P[B + 7]), \
          "v"(W[0]), "v"(W[1]), "v"(W[2]), "v"(W[3]), "v"(W[4]), "v"(W[5]), "v"(W[6]), "v"(W[7]), "v"(tf))
struct DsaState { float tf0, tf1; int cnt0, cnt1; unsigned long long need; };
template <bool NOCOMPACT = false, bool NOINSERT = false>
__device__ __forceinline__ void dsa_tile(const bf16x8 (&af)[4], const bf16x8 (&bc)[4], const float (&w0)[8], const float (&w1)[8], int key0, int q0t, int q1t, bool lastt, DsaState& st,
                                         LAS u32x2* ents, int lane) {
    const int r32 = lane & 31, hi = lane >> 5;
if (st.need) {
#pragma unroll 1
        for (int hh = 0; hh < 2; ++hh) {
            const int c0 = __builtin_amdgcn_readlane(st.cnt0, 0), c0b = __builtin_amdgcn_readlane(st.cnt0, 32);
            const int c1 = __builtin_amdgcn_readlane(st.cnt1, 0), c1b = __builtin_amdgcn_readlane(st.cnt1, 32);
            const int n0 = hh ? c0b : c0, n1 = hh ? c1b : c1;
            if (NOCOMPACT) { if (n0 > DS_CAP - 32 && hi == hh) st.cnt0 = 256; if (n1 > DS_CAP - 32 && hi == hh) st.cnt1 = 256; continue; }
            if (n0 > DS_CAP - 32) { int nk; const unsigned T = dsa_compact<false>(ents + hh * DS_CAP, n0, nk, lane); if (hi == hh) { st.tf0 = unmono_f(T + 1u); st.cnt0 = nk; } }
            if (n1 > DS_CAP - 32) { int nk; const unsigned T = dsa_compact<false>(ents + (2 + hh) * DS_CAP, n1, nk, lane); if (hi == hh) { st.tf1 = unmono_f(T + 1u); st.cnt1 = nk; } }
        }
    }
    f32x16 p;
#pragma unroll
    for (int r = 0; r < 16; ++r) p[r] = 0.f;
#pragma unroll
    for (int ks = 0; ks < 4; ++ks) p = __builtin_amdgcn_mfma_f32_32x32x16_bf16(af[ks], bc[ks], p, 0, 0, 0);
    asm volatile("s_nop 15\n\ts_nop 7" : "+v"(p));
    float s0, s1, tmp_; unsigned long long m0, m1;
    DSA_HEADSUM(s0, m0, p, 0, w0, st.tf0); DSA_HEADSUM(s1, m1, p, 8, w1, st.tf1);
    const int key = key0 + r32;
    if (lastt) { m0 &= __builtin_amdgcn_ballot_w64(key <= q0t); m1 &= __builtin_amdgcn_ballot_w64(key <= q1t); }
    if (NOINSERT) { st.cnt0 ^= (int)__popcll(m0 ^ m1); return; }
    {
        const bool pr0 = __builtin_amdgcn_inverse_ballot_w64(m0), pr1 = __builtin_amdgcn_inverse_ballot_w64(m1);
        const unsigned h0 = hi ? (unsigned)(m0 >> 32) : (unsigned)m0, h1 = hi ? (unsigned)(m1 >> 32) : (unsigned)m1;
        const unsigned lowmask = (1u << r32) - 1u;
        if (pr0) ents[hi * DS_CAP + st.cnt0 + __popc(h0 & lowmask)] = (u32x2){__float_as_uint(s0), (unsigned)key};
        if (pr1) ents[(2 + hi) * DS_CAP + st.cnt1 + __popc(h1 & lowmask)] = (u32x2){__float_as_uint(s1), (unsigned)key};
        st.cnt0 += __popc(h0); st.cnt1 += __popc(h1);
        st.need = __builtin_amdgcn_ballot_w64(max(st.cnt0, st.cnt1) > DS_CAP - 32);
    }
}
template <bool NOCOMPACT = false, bool NOINSERT = false, bool HALFLD = false>
__device__ __forceinline__ void dsa_select_phase(unsigned char* ws, LAS unsigned char* lds, int G, int tid, int wave, int lane, int jm = -1) {
    const bf16* proj = (const bf16*)(ws + WS_BIG + B_PROJ); const bf16* IKc = (const bf16*)(ws + WS_BIG + B_IKC); const float* IW = (const float*)(ws + WS_IW);
    unsigned short* selg = (unsigned short*)(ws + WS_BIG + B_SEL);
    LAS u32x2* ents = (LAS u32x2*)lds + wave * 4 * DS_CAP;
    const int r32 = lane & 31, hi = lane >> 5;
    const int NWG = G * NWAVES, gw = (int)blockIdx.x * NWAVES + wave;
    for (int pu = gw; pu < 2048; pu += NWG) {
        for (int uu = 0; uu < 2; ++uu) {
            const int unit = uu ? 4095 - pu : pu, tw = unit * 4;
            bf16x8 af[4];
            { const int i = r32, qi = 2 * (i >> 4) + ((i >> 2) & 1), hd = 4 * ((i >> 3) & 1) + (i & 3);
              const bf16* ap = proj + (size_t)(tw + qi) * EVEN_NP + EC_IQ + hd * 64 + 8 * hi;
#pragma unroll
              for (int ks = 0; ks < 4; ++ks) af[ks] = *(const GAS bf16x8*)(ap + 16 * ks); }
            float w0[8], w1[8];
            { const f32x4 a = *(const GAS f32x4*)(IW + (size_t)(tw + hi) * 8), b = *(const GAS f32x4*)(IW + (size_t)(tw + hi) * 8 + 4);
              const f32x4 c = *(const GAS f32x4*)(IW + (size_t)(tw + 2 + hi) * 8), d = *(const GAS f32x4*)(IW + (size_t)(tw + 2 + hi) * 8 + 4);
#pragma unroll
              for (int j = 0; j < 4; ++j) { w0[j] = a[j]; w0[4 + j] = b[j]; w1[j] = c[j]; w1[4 + j] = d[j]; } }
            const int q0t = tw + hi, q1t = tw + 2 + hi;
            DsaState st; st.tf0 = -INFINITY; st.tf1 = -INFINITY; st.cnt0 = 0; st.cnt1 = 0; st.need = 0ull;
            const int ntile = ((tw + 3) >> 5) + 1;
            const bf16* kp = IKc + (size_t)lane * 8; asm volatile("" : "+v"(kp));
            bf16x8 bA[4], bB[4], bC[4];
#define DSA_LOADB(dst, jj) do { const bf16* p_ = kp + (size_t)((jj) & jm) * 2048; \
                if (HALFLD) { asm volatile("global_load_dwordx4 %0, %2, off\n\tglobal_load_dwordx4 %1, %2, off offset:1024" : "=&v"(dst[0]), "=&v"(dst[1]) : "v"(p_) : "memory"); } else \
                asm volatile("global_load_dwordx4 %0, %4, off\n\tglobal_load_dwordx4 %1, %4, off offset:1024\n\tglobal_load_dwordx4 %2, %4, off offset:2048\n\tglobal_load_dwordx4 %3, %4, off offset:3072" \
                             : "=&v"(dst[0]), "=&v"(dst[1]), "=&v"(dst[2]), "=&v"(dst[3]) : "v"(p_) : "memory"); } while (0)
#define DSA_WAITB(dst, n) do { if (HALFLD) { if ((n) == 0) asm volatile("s_waitcnt vmcnt(0)" : "+v"(dst[0]), "+v"(dst[1]) :: "memory"); else asm volatile("s_waitcnt vmcnt(4)" : "+v"(dst[0]), "+v"(dst[1]) :: "memory"); dst[2] = dst[0]; dst[3] = dst[1]; } else asm volatile("s_waitcnt vmcnt(" #n ")" : "+v"(dst[0]), "+v"(dst[1]), "+v"(dst[2]), "+v"(dst[3]) :: "memory"); } while (0)
            asm volatile("" : "+v"(af[0]), "+v"(af[1]), "+v"(af[2]), "+v"(af[3]));
#pragma unroll
            for (int r = 0; r < 8; ++r) asm volatile("" : "+v"(w0[r]), "+v"(w1[r]));
            DSA_LOADB(bA, 0); DSA_LOADB(bB, min(1, ntile - 1));
#pragma unroll 1
            for (int j = 0; j < ntile; j += 3) {
                DSA_LOADB(bC, min(j + 2, ntile - 1));
                DSA_WAITB(bA, 8);
                dsa_tile<NOCOMPACT, NOINSERT>(af, bA, w0, w1, 32 * j, q0t, q1t, j == ntile - 1, st, ents, lane);
                DSA_LOADB(bA, min(j + 3, ntile - 1));
                DSA_WAITB(bB, 8);
                if (j + 1 < ntile) dsa_tile<NOCOMPACT, NOINSERT>(af, bB, w0, w1, 32 * (j + 1), q0t, q1t, j + 1 == ntile - 1, st, ents, lane);
                DSA_LOADB(bB, min(j + 4, ntile - 1));
                DSA_WAITB(bC, 8);
                if (j + 2 < ntile) dsa_tile<NOCOMPACT, NOINSERT>(af, bC, w0, w1, 32 * (j + 2), q0t, q1t, j + 2 == ntile - 1, st, ents, lane);
            }
            DSA_WAITB(bA, 0);
#undef DSA_LOADB
#undef DSA_WAITB
            const int cnt0 = st.cnt0, cnt1 = st.cnt1;
#pragma unroll 1
            for (int qq = 0; qq < 4; ++qq) {
                const int hh = qq & 1, sl = qq >> 1;
                int n = sl ? __builtin_amdgcn_readlane(cnt1, 32 * hh) : __builtin_amdgcn_readlane(cnt0, 32 * hh);
                LAS u32x2* ee = ents + qq * DS_CAP;
                if (n > 256) { int nk = 256; if (!NOCOMPACT) (void)dsa_compact<true>(ee, n, nk, lane); n = 256; }
                unsigned short* row = selg + (size_t)(tw + qq) * 256;
#pragma unroll
                for (int e4 = 0; e4 < 4; ++e4) { const int e = lane + 64 * e4; row[e] = (e < n) ? (unsigned short)ee[e].y : (unsigned short)0u; }
            }
        }
    }
}

typedef __bf16 bf16x2v __attribute__((ext_vector_type(2)));
__device__ __forceinline__ float dot2bf(unsigned a, unsigned b, float acc) { return __builtin_amdgcn_fdot2_f32_bf16(__builtin_bit_cast(bf16x2v, a), __builtin_bit_cast(bf16x2v, b), acc, false); }
__device__ __forceinline__ float dsa_kscale(const InTab& in, int lane) { const float g = wave_max(fabsf(in.get(11)[lane])); return 127.0f / (8.2f * g); }
__device__ __forceinline__ void dsa_quant_phase(const InTab& in, unsigned char* ws, unsigned char* spare, int G, int wave, int lane) {
    const bf16* proj = (const bf16*)(ws + WS_BIG + B_PROJ);
    const float SK = dsa_kscale(in, lane);
    const float SV = 127.0f / fmaxf(__uint_as_float(((const unsigned*)(ws + WS_CTL))[CW_VMAX + (lane >> 3)]), 1e-20f);
    for (int u = blockIdx.x; u < S / 64; u += G) {
        const int tw0 = u * 64 + wave * 8;
        const bf16* pr = proj + (size_t)tw0 * EVEN_NP + lane * 8; unsigned char* dst = spare + (size_t)tw0 * 1024 + lane * 16;
        v4u kr[8], vr[8];
#pragma unroll
        for (int i = 0; i < 8; ++i) { kr[i] = *(const GAS v4u*)(pr + (size_t)i * EVEN_NP + EC_DK); vr[i] = *(const GAS v4u*)(pr + (size_t)i * EVEN_NP + EC_DV); }
#pragma unroll
        for (int i = 0; i < 8; ++i) { float a[8], b[8]; unpack8(kr[i], a); unpack8(vr[i], b); v4u o;
#pragma unroll
            for (int j = 0; j < 8; ++j) { a[j] = fminf(fmaxf(a[j] * SK, -127.f), 127.f); b[j] = fminf(fmaxf(b[j] * SV, -127.f), 127.f); }
            o.x = q8pack4(a[0], a[1], a[2], a[3]); o.y = q8pack4(a[4], a[5], a[6], a[7]); o.z = q8pack4(b[0], b[1], b[2], b[3]); o.w = q8pack4(b[4], b[5], b[6], b[7]);
            *(GAS v4u*)(dst + (size_t)i * 1024) = o; }
    }
}
#define SP_IDXA(A, i) (((i) & 1) ? (A[(i) >> 3][((i) >> 1) & 3] >> 16) : (A[(i) >> 3][((i) >> 1) & 3] & 0xffffu))
__device__ __forceinline__ void dsa_sparse_phase(const InTab& in, unsigned char* ws, const unsigned char* spare, int G, int wave, int lane, bf16* obase, size_t opitch) {
    const bf16* proj = (const bf16*)(ws + WS_BIG + B_PROJ); const unsigned short* selg = (const unsigned short*)(ws + WS_BIG + B_SEL);
    const int h = (int)blockIdx.x & 7, wg = (int)blockIdx.x >> 3, nwg = G >> 3;
    const int kg = lane >> 3, ds8 = (lane & 7) * 8;
    const unsigned char* kvu = spare + h * 128;
    const unsigned lpart = (unsigned)(lane & 7) * 16u;
    const float SK = dsa_kscale(in, lane);
    const float vmaxh = fmaxf(__uint_as_float(((const unsigned*)(ws + WS_CTL))[CW_VMAX + h]), 1e-20f);
    const int stride = nwg * NWAVES;
    int t = wg * NWAVES + wave;
    if (t >= S) return;
    v4u iw[4], qw;
#pragma unroll
    for (int c = 0; c < 4; ++c) iw[c] = *(const GAS v4u*)(selg + (size_t)t * 256 + 32 * kg + 8 * c);
    qw = *(const GAS v4u*)(proj + (size_t)t * EVEN_NP + EC_DQ + h * 64 + ds8);
    v4u ka[8], kb[8];
#define SP_LOAD(A, dst, i0) _Pragma("unroll") for (int j = 0; j < 8; ++j) { const unsigned off = (SP_IDXA(A, (i0) + j) << 10) + lpart; dst[j] = *(const GAS v4u*)(kvu + off); }
#define SP_QK(src, i0) _Pragma("unroll") for (int j = 0; j < 8; ++j) { \
            int d = __builtin_amdgcn_sdot4((int)q0, (int)src[j].x, 0, false); d = __builtin_amdgcn_sdot4((int)q1, (int)src[j].y, d, false); \
            d += shx_i<1>(d); d += shx_i<2>(d); d += dpp_hmirror_i(d); sc[(i0) + j] = (float)d * qsc; vw[(i0) + j] = (u32x2){src[j].z, src[j].w}; }
    SP_LOAD(iw, ka, 0); SP_LOAD(iw, kb, 8);
#pragma unroll 1
    for (; t < S; t += stride) {
        unsigned q0, q1; float qsc;
        { float qv[8]; unpack8(qw, qv); float qm = 0.f;
#pragma unroll
          for (int j = 0; j < 8; ++j) qm = fmaxf(qm, fabsf(qv[j]));
          qm = fmaxf(qm, shx<1>(qm)); qm = fmaxf(qm, shx<2>(qm)); qm = fmaxf(qm, __int_as_float(dpp_hmirror_i(__float_as_int(qm)))); qm = fmaxf(qm, 1e-20f);
          const float sq = 127.0f / qm;
          q0 = q8pack4(qv[0] * sq, qv[1] * sq, qv[2] * sq, qv[3] * sq); q1 = q8pack4(qv[4] * sq, qv[5] * sq, qv[6] * sq, qv[7] * sq);
          qsc = C2 / (sq * SK); }
        float sc[32]; u32x2 vw[32];
        SP_QK(ka, 0);  SP_LOAD(iw, ka, 16);
        SP_QK(kb, 8);  SP_LOAD(iw, kb, 24);
        { const int tn = (t + stride < S) ? t + stride : t;
#pragma unroll
          for (int c = 0; c < 4; ++c) iw[c] = *(const GAS v4u*)(selg + (size_t)tn * 256 + 32 * kg + 8 * c);
          qw = *(const GAS v4u*)(proj + (size_t)tn * EVEN_NP + EC_DQ + h * 64 + ds8); }
        SP_QK(ka, 16);
        SP_QK(kb, 24);
        if (t < 255) {
#pragma unroll
            for (int i = 0; i < 32; ++i) if (32 * kg + i > t) sc[i] = -INFINITY;
        }
        float mx = sc[0];
#pragma unroll
        for (int i = 1; i < 32; ++i) mx = fmaxf(mx, sc[i]);
        mx = fmaxf(mx, shx<8>(mx)); mx = fmaxf(mx, shx<16>(mx)); mx = sh32_max(mx);
        mx -= 6.988684686772166f;
        SP_LOAD(iw, ka, 0);
        int acc[8]; unsigned lsum = 0u;
#pragma unroll
        for (int e = 0; e < 8; ++e) acc[e] = 0;
#pragma unroll
        for (int i = 0; i < 32; i += 4) {
            if (i == 16) { SP_LOAD(iw, kb, 8); }
            unsigned pw = __builtin_amdgcn_cvt_pk_u8_f32(__builtin_amdgcn_exp2f(sc[i] - mx), 0u, 0u);
            pw = __builtin_amdgcn_cvt_pk_u8_f32(__builtin_amdgcn_exp2f(sc[i + 1] - mx), 1u, pw);
            pw = __builtin_amdgcn_cvt_pk_u8_f32(__builtin_amdgcn_exp2f(sc[i + 2] - mx), 2u, pw);
            pw = __builtin_amdgcn_cvt_pk_u8_f32(__builtin_amdgcn_exp2f(sc[i + 3] - mx), 3u, pw);
            lsum = __builtin_amdgcn_udot4(pw, 0x01010101u, lsum, false);
#pragma unroll
            for (int hw = 0; hw < 2; ++hw) {
                const unsigned A = hw ? vw[i].y : vw[i].x, B = hw ? vw[i + 1].y : vw[i + 1].x, C = hw ? vw[i + 2].y : vw[i + 2].x, D = hw ? vw[i + 3].y : vw[i + 3].x;
                const unsigned ablo = __builtin_amdgcn_perm(B, A, 0x05010400u), abhi = __builtin_amdgcn_perm(B, A, 0x07030602u);
                const unsigned cdlo = __builtin_amdgcn_perm(D, C, 0x05010400u), cdhi = __builtin_amdgcn_perm(D, C, 0x07030602u);
                const unsigned t0_ = __builtin_amdgcn_perm(cdlo, ablo, 0x05040100u), t1_ = __builtin_amdgcn_perm(cdlo, ablo, 0x07060302u);
                const unsigned t2_ = __builtin_amdgcn_perm(cdhi, abhi, 0x05040100u), t3_ = __builtin_amdgcn_perm(cdhi, abhi, 0x07060302u);
                acc[4 * hw + 0] = __builtin_amdgcn_sdot4((int)pw, (int)t0_, acc[4 * hw + 0], false); acc[4 * hw + 1] = __builtin_amdgcn_sdot4((int)pw, (int)t1_, acc[4 * hw + 1], false);
                acc[4 * hw + 2] = __builtin_amdgcn_sdot4((int)pw, (int)t2_, acc[4 * hw + 2], false); acc[4 * hw + 3] = __builtin_amdgcn_sdot4((int)pw, (int)t3_, acc[4 * hw + 3], false);
            }
        }
        int ls = (int)lsum; ls += shx_i<8>(ls); ls += shx_i<16>(ls); { auto r = __builtin_amdgcn_permlane32_swap((unsigned)ls, (unsigned)ls, false, false); ls = (int)r[0] + (int)r[1]; }
        const float inv = (vmaxh * (1.0f / 127.0f)) / (float)ls;
        float o[8];
#pragma unroll
        for (int e = 0; e < 8; ++e) { int a = acc[e]; a += shx_i<8>(a); a += shx_i<16>(a); { auto r = __builtin_amdgcn_permlane32_swap((unsigned)a, (unsigned)a, false, false); a = (int)r[0] + (int)r[1]; } o[e] = (float)a * inv; }
        if (kg == 0) *(GAS v4u*)(obase + (size_t)t * opitch + h * 64 + ds8) = pack8(o);
    }
#undef SP_LOAD
#undef SP_QK
}
#undef SP_IDXA

struct Args { InPtrs in; float* out; unsigned char* ws; int ph_lo, ph_hi, li, pad; };
constexpr int PH_PER_LAYER = 13, N_PHASES = 1 + 2 * PH_PER_LAYER;

__global__ void __launch_bounds__(NTHREADS, 2) hyb_fwd(Args args) {
    extern __shared__ __attribute__((aligned(16))) unsigned char lds_raw[];
    LAS unsigned char* lds = (LAS unsigned char*)lds_raw;
    volatile LAS unsigned* MISC = (volatile LAS unsigned*)(lds + MISC_OFF);
    const int tid = threadIdx.x, lane = tid & 63, wave = __builtin_amdgcn_readfirstlane(tid >> 6);
    const int G = gridDim.x;
    const int vcu = (G % 8 == 0) ? ((int)blockIdx.x % 8) * (G / 8) + (int)blockIdx.x / 8 : (int)blockIdx.x;
    unsigned char* ws = args.ws;
    gu32* ctl = (gu32*)(ws + WS_CTL);
    for (int u = tid; u < (LDS_BYTES - LDSCTL_OFF) / 4; u += NTHREADS) ((LAS unsigned*)(lds + LDSCTL_OFF))[u] = 0u;
    __syncthreads();
    if (tid == 0) {
#pragma unroll
        for (int i = 0; i < 26; ++i) *(LAS unsigned long long*)(lds + INTAB_OFF + 8 * i) = (unsigned long long)args.in.p[i]; }
    __syncthreads();
    XcdBarrier bar = xcd_barrier_post((unsigned*)(ctl + CW_BAR) + args.li * XCD_BAR_WORDS, MISC + 8);
    const int tid0 = tid; unsigned char* const ws0 = ws;
    for (int ph = args.ph_lo; ph < args.ph_hi; ++ph) {
        int tid = tid0; asm volatile("" : "+v"(tid));
        unsigned char* ws = ws0; asm volatile("" : "+s"(ws));
        const int lane = tid & 63, wave = __builtin_amdgcn_readfirstlane(tid >> 6);
        LAS unsigned char* lds = (LAS unsigned char*)lds_raw; { unsigned lo_ = (unsigned)(uintptr_t)lds; asm volatile("" : "+s"(lo_)); lds = (LAS unsigned char*)(uintptr_t)lo_; }
        InTab inl; inl.ldsbase = lds;
        float* ssqA = (float*)(ws + WS_SSQ);
        bf16* HB = (bf16*)(ws + WS_HB);
        unsigned char* spare = (unsigned char*)args.out;
        unsigned char* Wr = ws + WS_W;
        unsigned char* BIG = ws + WS_BIG;
        const int gw = vcu * NWAVES + wave, NGW = G * NWAVES;
        if (ph == 0) {
#ifdef PROBE_P02
            conv_weights(inl, ws, 0, 1 | 2 | 4, lds, gw, NGW, wave, lane);
            copy_x(inl.get(0), spare + 32 * MiB, (float*)(spare + 48 * MiB), HB, ssqA, gw, NGW, lane);
            rope_tables((float*)(ws + WS_ROPE), (float*)(ws + WS_ROPE) + S * 8, (int)blockIdx.x * NTHREADS + tid, G * NTHREADS);
            __syncthreads();
            for (int un = blockIdx.x; un < 256; un += G) mem_kv(inl, ws, lds, un, tid, wave, lane);
            for (int idx = (int)blockIdx.x * NTHREADS + tid; idx < 1024 * 16; idx += G * NTHREADS) {
                const int k = idx >> 4, col = idx & 15;
                const float v = inl.get(5)[k] * inl.get(6)[(size_t)k * EVEN_SRC + (col < 8 ? ES_FL + col : ES_IW + col - 8)];
                const int ln = (k & 255) >> 2, e = k & 3, q = k >> 8, c = col >> 2;
                ((float*)(ws + WS_TW))[((((q * 4 + e) * 4 + c) * 64 + ln) << 2) + (col & 3)] = v; }
            __syncthreads();
#endif
#ifndef NO_P0
            conv_weights(inl, ws, 0, 1 | 2 | 4, lds, gw, NGW, wave, lane);
            conv_q8_weights(inl, ws, 0, 1, lds, (int)blockIdx.x, G, wave, lane);
            copy_x(inl.get(0), spare + 32 * MiB, (float*)(spare + 48 * MiB), HB, ssqA, gw, NGW, lane);
            if (blockIdx.x == 0 && tid < 384) { const int gi = tid >> 6, d = tid & 63;
                float v;
                if (gi == 0) v = inl.get(8)[d]; else if (gi == 1) v = inl.get(10)[d]; else if (gi == 2) v = inl.get(9)[d]; else if (gi == 3) v = inl.get(11)[d]; else if (gi == 4) v = inl.get(13)[d]; else v = inl.get(14)[d];
                ((float*)(ws + WS_GT))[tid] = v; }
            rope_tables((float*)(ws + WS_ROPE), (float*)(ws + WS_ROPE) + S * 8, (int)blockIdx.x * NTHREADS + tid, G * NTHREADS);
            __syncthreads();
            for (int un = blockIdx.x; un < 256; un += G) mem_kv(inl, ws, lds, un, tid, wave, lane);
            for (int idx = (int)blockIdx.x * NTHREADS + tid; idx < 1024 * 16; idx += G * NTHREADS) {
                const int k = idx >> 4, col = idx & 15;
                const float v = inl.get(5)[k] * inl.get(6)[(size_t)k * EVEN_SRC + (col < 8 ? ES_FL + col : ES_IW + col - 8)];
                const int ln = (k & 255) >> 2, e = k & 3, q = k >> 8, c = col >> 2;
                ((float*)(ws + WS_TW))[((((q * 4 + e) * 4 + c) * 64 + ln) << 2) + (col & 3)] = v; }
#endif
        } else {
            const int L = (ph - 1) / PH_PER_LAYER, sub = (ph - 1) % PH_PER_LAYER;
            const bool even = (L & 1) == 0;
            if (even && sub == 6) continue;
            if (!even && sub == 3) continue;
#ifndef MEM_UNFUSED
            if (sub == 9 || sub == 10) continue;
#endif
            float* ssq_in = ssqA;
            if (sub == 0 || sub == 11) {
                unsigned char* HQ = spare + 32 * MiB; float* sa = (float*)(spare + 48 * MiB);
                if (!(L == 0 && sub == 0)) { quant_rows(HB, HQ, sa, gw, NGW, lane); xcd_barrier(bar); }
                pg8::Gemm g{(const pg8::bf16_t*)HQ, (const pg8::bf16_t*)(Wr + (sub == 0 ? W_FFN1_IN : W_FFN2_IN)), S, FF2, DM / 2, DM / 2};
                pg8::StaticOrder So; So.init(S, FF2, G, (int)blockIdx.x);
                pg8::EpiSwiGLU8 E{(pg8::bf16_t*)(BIG + B_U), ssq_in, FF, sa, (const float*)(ws + WS_SB) + (sub == 0 ? 0 : 8192)};
#ifdef PROBE_GEMM8
                pg8::gemm_phase<pg8::EpiSwiGLU8, pg8::StaticOrder, true, true>(lds, g, So, E, tid); __syncthreads();
#endif
                pg8::gemm_phase<pg8::EpiSwiGLU8, pg8::StaticOrder, true, true>(lds, g, So, E, tid);
            } else if (sub == 1 || sub == 7 || sub == 10 || sub == 12) {
                pg8::Gemm g; float scale; int so;
                if (sub == 1)       { g = pg8::Gemm{(const pg8::bf16_t*)(BIG + B_U), (const pg8::bf16_t*)(Wr + W_FFN1_OUT), S, DM, FF, FF}; scale = 0.5f; so = 1; }
                else if (sub == 7)  { g = pg8::Gemm{(const pg8::bf16_t*)(BIG + B_PROJ), (const pg8::bf16_t*)(Wr + W_MIX_OUT), S, DM, DM, even ? EVEN_NP : DM}; scale = 1.0f; so = 2; }
                else if (sub == 10)  { g = pg8::Gemm{(const pg8::bf16_t*)(BIG + B_OM), (const pg8::bf16_t*)(Wr + (L ? W_MEMO2 : W_MEMO)), S, DM, MEMW, MEMW}; scale = 1.0f; so = 3; }
                else                { g = pg8::Gemm{(const pg8::bf16_t*)(BIG + B_U), (const pg8::bf16_t*)(Wr + W_FFN2_OUT), S, DM, FF, FF}; scale = 0.5f; so = 4; }
                const bool last = (sub == 12 && L == NLAYER - 1);
                pg8::StaticOrder So; So.init(S, DM, G, (int)blockIdx.x);
                pg8::EpiResid E{(pg8::bf16_t*)HB, last ? args.out : nullptr, ssqA, scale};
                pg8::gemm_phase<pg8::EpiResid, pg8::StaticOrder, true, true>(lds, g, So, E, tid);
#ifdef PROBE_GEMM2
                if (!last) { __syncthreads(); pg8::EpiResid E0 = E; E0.scale = 0.f; pg8::gemm_phase<pg8::EpiResid, pg8::StaticOrder, true, true>(lds, g, So, E0, tid); }
#endif
            } else if (sub == 2) {
                const int N = even ? EVEN_NP : ODD_N;
                pg8::Gemm g{(const pg8::bf16_t*)HB, (const pg8::bf16_t*)(Wr + W_MIX_IN), S, N, DM, DM};
                pg8::EpiProj E;
                E.O = (pg8::bf16_t*)(BIG + B_PROJ); E.ldc = even ? EVEN_NP : DM; E.ssq = ssq_in; E.split_cols = even ? 0 : DM; E.split_stride = (size_t)S * DM; E.even = even ? 1 : 0;
                E.gtab = (const float*)(ws + WS_GT);
                E.cosT = (const float*)(ws + WS_ROPE); E.sinT = E.cosT + S * 8;
                E.Vt = (pg8::bf16_t*)(BIG + (even ? B_VTF : B_VTM)); E.IKf = (pg8::bf16_t*)(BIG + B_IKC);
                E.xch = (LAS float*)(lds + 131072);
                E.ksum = (float*)(ws + WS_KSUM);
                pg8::StaticOrder So; So.init(S, N, G, (int)blockIdx.x);
#ifdef PROBE_MIXIN2
                pg8::gemm_phase<pg8::EpiProj, pg8::StaticOrder, true, true>(lds, g, So, E, tid); __syncthreads();
#endif
                pg8::gemm_phase<pg8::EpiProj, pg8::StaticOrder, true, true>(lds, g, So, E, tid);
#ifndef MEM_UNFUSED
            } else if (sub == 8) {
                memfused_phase(inl, ws, L, ssq_in, args.out, HB, ssqA, lds, G, tid, wave, lane);
                {
                    __syncthreads();
                    if (L == 0) conv_weights(inl, ws, 1, 1 | 2 | 4 | 8 | 16 | 32, lds, gw, NGW, wave, lane);
                    else        conv_weights(inl, ws, 1, 64 | 128, lds, gw, NGW, wave, lane);
                }
#endif
            } else if (sub == 8) {
                if ((int)blockIdx.x >= 64 && G > 64) {
                    const int cw = ((int)blockIdx.x - 64) * NWAVES + wave, ncw = (G - 64) * NWAVES;
                    if (L == 0) conv_weights(inl, ws, 1, 1 | 2 | 4 | 8 | 16 | 32, lds, cw, ncw, wave, lane);
                    else        conv_weights(inl, ws, 1, 64 | 128, lds, cw, ncw, wave, lane);
                    conv_q8_weights(inl, ws, 1, L == 0 ? 1 : 64, lds, (int)blockIdx.x - 64, G - 64, wave, lane);
                }
                pg8::Gemm g{(const pg8::bf16_t*)HB, (const pg8::bf16_t*)(Wr + (L ? W_MEMQ2 : W_MEMQ)), S, MEMW, DM, DM};
                pg8::EpiScale E{(pg8::bf16_t*)(BIG + B_QM), MEMW, ssq_in, 0, 0};
                pg8::StaticOrder So; So.init(S, g.N, G, (int)blockIdx.x);
                pg8::gemm_phase<pg8::EpiScale, pg8::StaticOrder, true, true>(lds, g, So, E, tid);
            } else if (sub == 3) {
                if (even) post_even(inl, ws, HB, ssq_in, lds, G, tid, wave, lane);
                if (L == 0) { __syncthreads(); conv_weights(inl, ws, 0, 8 | 16 | 32 | 64 | 128, lds, gw, NGW, wave, lane); conv_q8_weights(inl, ws, 0, 64, lds, (int)blockIdx.x, G, wave, lane); }
            } else if (sub == 4) {
                if (even) {
                    int nrep = 1;
#ifdef PROBE_DSA2
                    nrep = 2;
#endif
                    asm volatile("" : "+s"(nrep));
#ifdef PROBE_SELHL
                    dsa_select_phase<true, true, true>(ws, lds, G, tid, wave, lane); __syncthreads();
#endif
#ifdef PROBE_SELNI
                    dsa_select_phase<true, true>(ws, lds, G, tid, wave, lane); __syncthreads();
#endif
#ifdef PROBE_SELL1
                    { int jm0 = 0; asm volatile("" : "+s"(jm0)); dsa_select_phase<true>(ws, lds, G, tid, wave, lane, jm0); __syncthreads(); }
#endif
#ifdef PROBE_SELNC
                    dsa_select_phase<true>(ws, lds, G, tid, wave, lane); __syncthreads();
#endif
                    dsa_quant_phase(inl, ws, spare, G, wave, lane);
                    for (int rep = 0; rep < nrep; ++rep) { dsa_select_phase<false>(ws, lds, G, tid, wave, lane); __syncthreads(); }
                } else {
                    moba_gate_phase(ws, G, wave, lane);
                }
            } else if (sub == 5) {
                if (even) {
                    bf16* projb = (bf16*)(BIG + B_PROJ);
#ifdef PROBE_FOX2
                    fox_phase(inl, ws, lds, G, tid, wave, lane, (bf16*)(spare + 32 * MiB), 512, CW_FOXQ + 64); __syncthreads();
#endif
#ifdef PROBE_SPARSE2
                    dsa_sparse_phase(inl, ws, spare, G, wave, lane, (bf16*)(spare + 48 * MiB), 512);
#endif
                    fox_phase(inl, ws, lds, G, tid, wave, lane, projb + EC_FQ, EVEN_NP, CW_FOXQ);
                    dsa_sparse_phase(inl, ws, spare, G, wave, lane, projb + EC_DQ, EVEN_NP);
                } else {
#ifdef PROBE_MOBA2
                    moba_route_phase(ws, spare, lds, G, tid, wave, lane, CW_MOBAQ + 64); __syncthreads();
#endif
                    moba_route_phase(ws, spare, lds, G, tid, wave, lane, CW_MOBAQ);
                }
            } else if (sub == 6) {
#ifdef PROBE_OWN2
                if (!even) { moba_own_phase(ws, spare, lds, G, tid, wave, lane, (bf16*)(BIG + 160 * MiB), 0); __syncthreads(); }
#endif
                if (!even) moba_own_phase(ws, spare, lds, G, tid, wave, lane, (bf16*)(BIG + B_PROJ), DM);
            } else if (sub == 9) {
#ifdef PROBE_MEM2
                memattn_phase(inl, ws, L, lds, G, tid, wave, lane); __syncthreads();
#endif
                memattn_phase(inl, ws, L, lds, G, tid, wave, lane);
            }
        }
        if (ph + 1 < args.ph_hi) xcd_barrier(bar);
#ifdef PROBE_BAR2
        if (ph + 1 < args.ph_hi) xcd_barrier(bar);
#endif
    }
}

#ifndef MK_N_LAUNCHES
#define MK_N_LAUNCHES 1
#endif
extern "C" void kernel_launch(void* const* d_in, const int* in_sizes, int n_in, void* d_out, int out_size, void* d_ws, size_t ws_size, hipStream_t stream) {
    static int grid = 0;
    if (grid == 0) {
        if (n_in != 26 || in_sizes[0] != S * DM || out_size != S * DM || ws_size < WS_END) {
            fprintf(stderr, "kernel_launch: unexpected problem (n_in %d, in0 %d, out %d, ws %zu); nothing launched\n", n_in, n_in > 0 ? in_sizes[0] : -1, out_size, ws_size); grid = -1; return; }
        int dev = 0, cus = 0, per_cu = 0;
        if (hipGetDevice(&dev) != hipSuccess || hipDeviceGetAttribute(&cus, hipDeviceAttributeMultiprocessorCount, dev) != hipSuccess) { grid = -1; return; }
        if (hipFuncSetAttribute((const void*)hyb_fwd, hipFuncAttributeMaxDynamicSharedMemorySize, LDS_BYTES) != hipSuccess) { fprintf(stderr, "kernel_launch: hipFuncSetAttribute failed\n"); grid = -1; return; }
        if (hipOccupancyMaxActiveBlocksPerMultiprocessor(&per_cu, (const void*)hyb_fwd, NTHREADS, LDS_BYTES) != hipSuccess || per_cu < 1)
            fprintf(stderr, "kernel_launch: note: occupancy query reports %d workgroups per CU\n", per_cu);
        (void)hipGetLastError();
        grid = cus;
    }
    if (grid < 0) return;
    if (hipMemsetAsync((char*)d_ws + WS_CTL, 0, CTL_ZERO_BYTES, stream) != hipSuccess) { fprintf(stderr, "kernel_launch: hipMemsetAsync failed\n"); return; }
    Args a{};
    for (int i = 0; i < 26; ++i) a.in.p[i] = (const float*)d_in[i];
    a.out = (float*)d_out; a.ws = (unsigned char*)d_ws;
#if MK_N_LAUNCHES == 1
    a.ph_lo = 0; a.ph_hi = N_PHASES; a.li = 0;
    hipLaunchKernelGGL(hyb_fwd, dim3(grid), dim3(NTHREADS), LDS_BYTES, stream, a);
#else
    for (int ph = 0; ph < N_PHASES; ++ph) { a.ph_lo = ph; a.ph_hi = ph + 1; a.li = 0; hipLaunchKernelGGL(hyb_fwd, dim3(grid), dim3(NTHREADS), LDS_BYTES, stream, a); }
#endif
    const hipError_t le = hipPeekAtLastError();
    if (le != hipSuccess) fprintf(stderr, "kernel_launch: launch failed: %s\n", hipGetErrorName(le));
}
```

```cpp
#include <hip/hip_runtime.h>
#include <cstdio>
#include <cstdint>
#define MEM_UNFUSED 1

template <int M> __device__ __forceinline__ int shx_i(int v) {
    if constexpr (M == 1) return __builtin_amdgcn_mov_dpp(v, 0xB1, 0xF, 0xF, true);
    else if constexpr (M == 2) return __builtin_amdgcn_mov_dpp(v, 0x4E, 0xF, 0xF, true);
    else if constexpr (M == 8) return __builtin_amdgcn_mov_dpp(v, 0x128, 0xF, 0xF, true);
    else return __builtin_amdgcn_ds_swizzle(v, (M << 10) | 0x1f);
}
__device__ __forceinline__ int dpp_hmirror_i(int v) { return __builtin_amdgcn_mov_dpp(v, 0x141, 0xF, 0xF, true); }
template <int M> __device__ __forceinline__ float shx(float v) { return __int_as_float(shx_i<M>(__float_as_int(v))); }
__device__ __forceinline__ float sh32_sum(float v) { auto r = __builtin_amdgcn_permlane32_swap(__float_as_uint(v), __float_as_uint(v), false, false); return __uint_as_float(r[0]) + __uint_as_float(r[1]); }
__device__ __forceinline__ float sh32_max(float v) { auto r = __builtin_amdgcn_permlane32_swap(__float_as_uint(v), __float_as_uint(v), false, false); return fmaxf(__uint_as_float(r[0]), __uint_as_float(r[1])); }
__device__ __forceinline__ int sum32_i(int c) { c += shx_i<1>(c); c += shx_i<2>(c); c += shx_i<4>(c); c += shx_i<8>(c); c += shx_i<16>(c); return c; }
namespace pg8 {
#define PG8_LAS __attribute__((address_space(3)))
typedef unsigned short bf16_t;
typedef short bf16x8 __attribute__((ext_vector_type(8)));
typedef float f32x4 __attribute__((ext_vector_type(4)));
typedef unsigned u32x4 __attribute__((ext_vector_type(4)));
constexpr int BM = 256, BK = 64, HALF = 128, HTB = HALF * BK * 2  , STAGE_BYTES = 8 * HTB, NXCD = 8, WGM = 8;

__host__ __device__ __forceinline__ int lds_byte(int r, int c) { const int st = (r >> 4) * 2 + (c >> 5), rr = r & 15, cc = c & 31, ob = rr * 64 + cc * 2; return st * 1024 + (ob ^ (((ob >> 9) & 1) << 5)); }
__host__ __device__ __forceinline__ void stage_rc(int b, int& R, int& C) { const int st = b / 1024, sb = b % 1024, swz = sb ^ (((sb >> 9) & 1) << 5); R = (st >> 1) * 16 + swz / 64; C = (st & 1) * 32 + (swz % 64) / 2; }
__host__ __device__ __forceinline__ int perm32(int rho) { const int n = rho >> 4, i = rho & 15; return 8 * (i >> 2) + 4 * n + (i & 3); }

struct Unit { int pm, pn; };
struct Gemm { const bf16_t* A; const bf16_t* Bt; int M, N, K, lda; };

struct StaticOrder {
    int nM, nN, nwg, G, c;
    __host__ __device__ __forceinline__ void init(int M, int N, int G_, int c_) { nM = M / BM; nN = N / BM; nwg = nM * nN; G = G_; c = c_; }
    __host__ __device__ __forceinline__ bool next(int i, Unit& u) const {
        const long L = (long)i * G + c; if (L >= nwg) return false;
        int wgid = (int)L; { const int q = nwg / NXCD, r = nwg % NXCD, xcd = wgid % NXCD, off = wgid / NXCD; wgid = (xcd < r ? xcd * (q + 1) : r * (q + 1) + (xcd - r) * q) + off; }
        const int nig = WGM * nN, gid = wgid / nig, fm = gid * WGM, gsz = (nM - fm) < WGM ? (nM - fm) : WGM;
        u.pm = fm + ((wgid % nig) % gsz); u.pn = (wgid % nig) / gsz; return true;
    }
    __device__ __forceinline__ void a_ready(const Unit&) const {}
    __device__ __forceinline__ void done(const Unit&) const {}
};

__device__ __forceinline__ unsigned cvt_pk_bf16(float lo, float hi) { unsigned r; asm volatile("v_cvt_pk_bf16_f32 %0, %1, %2" : "=v"(r) : "v"(lo), "v"(hi)); return r; }
typedef float f32x2 __attribute__((ext_vector_type(2)));
constexpr float RMS_EPS_F = 1e-6f;
#define EGAS __attribute__((address_space(1)))
__device__ __forceinline__ float silu_f(float x) { return x * __builtin_amdgcn_rcpf(1.0f + __builtin_amdgcn_exp2f(-1.4426950408889634f * x)); }
__device__ __forceinline__ float row_rstd(const float* ssq, int row) {
    const f32x4* p = (const f32x4*)(ssq + (size_t)row * 16); const f32x4 a = p[0], b = p[1], c = p[2], d = p[3];
    const float s = ((a[0] + a[1]) + (a[2] + a[3])) + ((b[0] + b[1]) + (b[2] + b[3])) + ((c[0] + c[1]) + (c[2] + c[3])) + ((d[0] + d[1]) + (d[2] + d[3]));
    return rsqrtf(s * (1.0f / 1024.0f) + RMS_EPS_F); }
__device__ __forceinline__ void row_rstd8(const float* ssq, int row0, int fq, float (&r)[8]) {
    f32x4 q[8];
#pragma unroll
    for (int i = 0; i < 8; ++i) q[i] = *(const EGAS f32x4*)(ssq + (size_t)(row0 + (i >> 2) * HALF + (i & 3) * 16) * 16 + 4 * fq);
#pragma unroll
    for (int i = 0; i < 8; ++i) { float s = (q[i][0] + q[i][1]) + (q[i][2] + q[i][3]); s += shx<16>(s); s = sh32_sum(s); r[i] = rsqrtf(s * (1.0f / 1024.0f) + RMS_EPS_F); }
}

struct EpiSwiGLU {
    static constexpr bool PERM = true, AFTER_DRAIN = false;
    bf16_t* U; const float* ssq; int ldu;
    __device__ __forceinline__ void operator()(const f32x4 (&acc)[2][2][4][2], const Unit& u, int wr, int wc, int fr, int fq) const {
        const int row0 = u.pm * BM + wr * 64 + fr, col0 = u.pn * HALF + wc * 32 + 8 * fq;
        float r8[8]; row_rstd8(ssq, row0, fq, r8);
#pragma unroll
        for (int ai = 0; ai < 2; ++ai)
#pragma unroll
            for (int m = 0; m < 4; ++m) {
                const int row = row0 + ai * HALF + m * 16; const float r = r8[ai * 4 + m];
                const f32x4 a0 = acc[ai][0][m][0] * r, a1 = acc[ai][0][m][1] * r, b0 = acc[ai][1][m][0] * r, b1 = acc[ai][1][m][1] * r;
                u32x4 w;
                w.x = cvt_pk_bf16(silu_f(a0[0]) * b0[0], silu_f(a0[1]) * b0[1]); w.y = cvt_pk_bf16(silu_f(a0[2]) * b0[2], silu_f(a0[3]) * b0[3]);
                w.z = cvt_pk_bf16(silu_f(a1[0]) * b1[0], silu_f(a1[1]) * b1[1]); w.w = cvt_pk_bf16(silu_f(a1[2]) * b1[2], silu_f(a1[3]) * b1[3]);
                *(EGAS u32x4*)(U + (size_t)row * ldu + col0) = w;
            }
    }
};
typedef int i32x4 __attribute__((ext_vector_type(4)));
struct EpiSwiGLU8 {
    static constexpr bool PERM = true, AFTER_DRAIN = false, I8 = true;
    bf16_t* U; const float* ssq; int ldu; const float* sa; const float* sb;
    __device__ __forceinline__ void operator()(const i32x4 (&acc)[2][2][4][2], const Unit& u, int wr, int wc, int fr, int fq) const {
        const int row0 = u.pm * BM + wr * 64 + fr, col0 = u.pn * HALF + wc * 32 + 8 * fq, wrow = u.pn * BM + wc * 32 + 8 * fq;
        const f32x4 sA0 = *(const EGAS f32x4*)(sb + wrow), sA1 = *(const EGAS f32x4*)(sb + wrow + 4), sB0 = *(const EGAS f32x4*)(sb + wrow + HALF), sB1 = *(const EGAS f32x4*)(sb + wrow + HALF + 4);
        float r8[8];
#pragma unroll
        for (int i = 0; i < 8; ++i) r8[i] = *(const EGAS float*)(sa + row0 + (i >> 2) * HALF + (i & 3) * 16);
#pragma unroll
        for (int ai = 0; ai < 2; ++ai)
#pragma unroll
            for (int m = 0; m < 4; ++m) {
                const int row = row0 + ai * HALF + m * 16; const float r = r8[ai * 4 + m];
                const float nr = -1.4426950408889634f * r, ir2 = __builtin_amdgcn_rcpf(r * r);
                u32x4 w; float o[8];
#pragma unroll
                for (int h2 = 0; h2 < 2; ++h2) {
                    const f32x4 z = __builtin_convertvector(acc[ai][0][m][h2], f32x4) * (h2 ? sA1 : sA0), ww = __builtin_convertvector(acc[ai][1][m][h2], f32x4) * (h2 ? sB1 : sB0);
                    const f32x4 zw = z * ww, t = z * nr;
#pragma unroll
                    for (int e2 = 0; e2 < 4; ++e2) { const float ex = __builtin_amdgcn_exp2f(t[e2]); o[4 * h2 + e2] = zw[e2] * __builtin_amdgcn_rcpf(__builtin_fmaf(ex, ir2, ir2)); }
                }
                w.x = cvt_pk_bf16(o[0], o[1]); w.y = cvt_pk_bf16(o[2], o[3]); w.z = cvt_pk_bf16(o[4], o[5]); w.w = cvt_pk_bf16(o[6], o[7]);
                *(EGAS u32x4*)(U + (size_t)row * ldu + col0) = w;
            }
    }
};
struct EpiResid {
    static constexpr bool PERM = true, AFTER_DRAIN = false;
    bf16_t* HB; float* Hout; float* ssq_out; float scale;
    __device__ __forceinline__ void operator()(const f32x4 (&acc)[2][2][4][2], const Unit& u, int wr, int wc, int fr, int fq) const {
        const int row0 = u.pm * BM + wr * 64 + fr, col0 = u.pn * BM + wc * 32 + 8 * fq;
        u32x4 win[2][4][2];
#pragma unroll
        for (int ai = 0; ai < 2; ++ai)
#pragma unroll
            for (int m = 0; m < 4; ++m)
#pragma unroll
                for (int bj = 0; bj < 2; ++bj) win[ai][m][bj] = *(const EGAS u32x4*)(HB + (size_t)(row0 + ai * HALF + m * 16) * 1024 + col0 + bj * HALF);
#pragma unroll
        for (int ai = 0; ai < 2; ++ai)
#pragma unroll
            for (int m = 0; m < 4; ++m) {
                const int row = row0 + ai * HALF + m * 16; float sq = 0.f;
#pragma unroll
                for (int bj = 0; bj < 2; ++bj) {
                    bf16_t* hbp = HB + (size_t)row * 1024 + col0 + bj * HALF;
                    const u32x4 wi = win[ai][m][bj];
                    f32x4 h0, h1;
                    h0[0] = __uint_as_float(wi.x << 16); h0[1] = __uint_as_float(wi.x & 0xffff0000u); h0[2] = __uint_as_float(wi.y << 16); h0[3] = __uint_as_float(wi.y & 0xffff0000u);
                    h1[0] = __uint_as_float(wi.z << 16); h1[1] = __uint_as_float(wi.z & 0xffff0000u); h1[2] = __uint_as_float(wi.w << 16); h1[3] = __uint_as_float(wi.w & 0xffff0000u);
                    h0 = h0 + acc[ai][bj][m][0] * scale; h1 = h1 + acc[ai][bj][m][1] * scale;
                    if (Hout) { float* hp = Hout + (size_t)row * 1024 + col0 + bj * HALF; *(EGAS f32x4*)hp = h0; *(EGAS f32x4*)(hp + 4) = h1; }
                    else {
                        sq += (h0[0] * h0[0] + h0[1] * h0[1]) + (h0[2] * h0[2] + h0[3] * h0[3]) + (h1[0] * h1[0] + h1[1] * h1[1]) + (h1[2] * h1[2] + h1[3] * h1[3]);
                        u32x4 w; w.x = cvt_pk_bf16(h0[0], h0[1]); w.y = cvt_pk_bf16(h0[2], h0[3]); w.z = cvt_pk_bf16(h1[0], h1[1]); w.w = cvt_pk_bf16(h1[2], h1[3]);
                        *(EGAS u32x4*)hbp = w; }
                }
                if (!Hout) { sq += shx<16>(sq); sq = sh32_sum(sq); if (fq == 0) *(EGAS float*)(ssq_out + (size_t)row * 16 + u.pn * 4 + wc) = sq; }
            }
    }
};
struct EpiScale {
    static constexpr bool PERM = true, AFTER_DRAIN = false;
    bf16_t* O; int ldc; const float* ssq; int split_cols; size_t split_stride;
    __device__ __forceinline__ void operator()(const f32x4 (&acc)[2][2][4][2], const Unit& u, int wr, int wc, int fr, int fq) const {
        const int row0 = u.pm * BM + wr * 64 + fr; int colt = u.pn * BM; bf16_t* base = O;
        if (split_cols) { const int t = colt / split_cols; base += (size_t)t * split_stride; colt -= t * split_cols; }
        const int col0 = colt + wc * 32 + 8 * fq;
        float r8[8]; row_rstd8(ssq, row0, fq, r8);
#pragma unroll
        for (int ai = 0; ai < 2; ++ai)
#pragma unroll
            for (int m = 0; m < 4; ++m) {
                const int row = row0 + ai * HALF + m * 16; const float r = r8[ai * 4 + m];
                bf16_t* rowp = base + (size_t)row * ldc + col0;
#pragma unroll
                for (int bj = 0; bj < 2; ++bj) { const f32x4 v0 = acc[ai][bj][m][0] * r, v1 = acc[ai][bj][m][1] * r;
                    u32x4 w; w.x = cvt_pk_bf16(v0[0], v0[1]); w.y = cvt_pk_bf16(v0[2], v0[3]); w.z = cvt_pk_bf16(v1[0], v1[1]); w.w = cvt_pk_bf16(v1[2], v1[3]);
                    *(EGAS u32x4*)(rowp + bj * HALF) = w; }
            }
    }
};

enum { KIND_PLAIN = 0, KIND_NORM = 1, KIND_NORM_ROPE = 2, KIND_ROPE = 3, KIND_VT = 4, KIND_NORM_ROPE_KSUM = 5, KIND_IK = 6, KIND_SKIP = 7 };
struct EpiProj {
    static constexpr bool PERM = true, AFTER_DRAIN = false;
    bf16_t* O; int ldc; const float* ssq; int split_cols; size_t split_stride;
    int even;
    const float* gtab;
    const float* cosT; const float* sinT;
    bf16_t* Vt;
    bf16_t* IKf;
    PG8_LAS float* xch;
    float* ksum;
    __device__ __forceinline__ void operator()(const f32x4 (&acc)[2][2][4][2], const Unit& u, int wr, int wc, int fr, int fq) const {
        const int S_ = 16384;
        int kind; int gsel = 0; int vcol0 = 0;
        if (even) { const int p = u.pn;
            kind = (p < 2) ? KIND_NORM : (p < 4) ? KIND_NORM_ROPE : (p < 6) ? KIND_NORM : (p < 8) ? KIND_NORM_ROPE : (p < 10) ? KIND_VT : (p < 12) ? KIND_PLAIN : (p < 14) ? KIND_ROPE : KIND_IK;
            gsel = (p < 8) ? (p >> 1) : 0; vcol0 = (p - 8) * 256;
        } else { const int p = u.pn; kind = (p < 4) ? KIND_NORM_ROPE : (p < 8) ? KIND_NORM_ROPE_KSUM : KIND_VT; gsel = (p < 8) ? 4 + (p >> 2) : 0; vcol0 = (p - 8) * 256; }
        const float* gn = gtab + gsel * 64;
        const int row0 = u.pm * BM + wr * 64 + fr; int colt = u.pn * BM; bf16_t* base = O;
        if (split_cols) { const int t = colt / split_cols; base += (size_t)t * split_stride; colt -= t * split_cols; }
        const int co0 = wc * 32 + 8 * fq;
        const int hd0 = 32 * (wc & 1) + 8 * fq;
        int xo = ((wr * 64 + fr) * 2) * 4 + wc, xp = ((wr * 64 + fr) * 2) * 4 + (wc ^ 1);
        asm volatile("" : "+v"(xo), "+v"(xp));
        const bool normk = (kind == KIND_NORM || kind == KIND_NORM_ROPE || kind == KIND_NORM_ROPE_KSUM);
        const bool ropek = (kind == KIND_NORM_ROPE || kind == KIND_ROPE || kind == KIND_NORM_ROPE_KSUM || kind == KIND_IK);
        float gv[8];
#pragma unroll
        for (int e2 = 0; e2 < 8; ++e2) gv[e2] = normk ? *(const EGAS float*)(gn + hd0 + e2) : 1.0f;
        float r8[8]; row_rstd8(ssq, row0, fq, r8);
        if (normk) {
#pragma unroll
            for (int ai = 0; ai < 2; ++ai)
#pragma unroll
                for (int m = 0; m < 4; ++m)
#pragma unroll
                    for (int bj = 0; bj < 2; ++bj) { const f32x4 v0 = acc[ai][bj][m][0], v1 = acc[ai][bj][m][1];
                        float ss = (v0[0] * v0[0] + v0[1] * v0[1]) + (v0[2] * v0[2] + v0[3] * v0[3]) + (v1[0] * v1[0] + v1[1] * v1[1]) + (v1[2] * v1[2] + v1[3] * v1[3]);
                        ss += shx<16>(ss); ss = sh32_sum(ss);
                        if (fq == 0) xch[xo + (ai * 128 + m * 16) * 8 + bj * 4] = ss; }
            asm volatile("s_waitcnt lgkmcnt(0)" ::: "memory"); __builtin_amdgcn_s_barrier(); asm volatile("" ::: "memory");
        }
        float csum[2][8];
#pragma unroll
        for (int b2 = 0; b2 < 2; ++b2)
#pragma unroll
            for (int e2 = 0; e2 < 8; ++e2) csum[b2][e2] = 0.f;
        if (kind != KIND_SKIP) {
        const float* tabT = (fq & 1) ? sinT : cosT;
        f32x4 nt0 = {0.f, 0.f, 0.f, 0.f}, nt1 = {0.f, 0.f, 0.f, 0.f};
        if (ropek) { nt0 = *(const EGAS f32x4*)(tabT + (unsigned)(row0 * 8)); nt1 = *(const EGAS f32x4*)(tabT + (unsigned)(row0 * 8 + 4)); }
#pragma unroll
        for (int ai = 0; ai < 2; ++ai)
#pragma unroll
            for (int m = 0; m < 4; ++m) {
                const int row = row0 + ai * HALF + m * 16; const float r = r8[ai * 4 + m];
                f32x4 t0 = nt0, t1 = nt1;
                if (ropek && ai * 4 + m < 7) { const int rn = row0 + ((ai * 4 + m + 1) >> 2) * HALF + ((ai * 4 + m + 1) & 3) * 16;
                    nt0 = *(const EGAS f32x4*)(tabT + (unsigned)(rn * 8)); nt1 = *(const EGAS f32x4*)(tabT + (unsigned)(rn * 8 + 4)); }
#pragma unroll
                for (int bj = 0; bj < 2; ++bj) {
                    if (kind == KIND_IK && (bj == 1 || wc >= 2)) continue;
                    float x[8];
                    { const f32x4 v0 = acc[ai][bj][m][0], v1 = acc[ai][bj][m][1];
#pragma unroll
                      for (int e2 = 0; e2 < 4; ++e2) { x[e2] = v0[e2]; x[4 + e2] = v1[e2]; } }
                    float sc = r;
                    if (normk) { const float tot = xch[xo + (ai * 128 + m * 16) * 8 + bj * 4] + xch[xp + (ai * 128 + m * 16) * 8 + bj * 4];
                        sc = r * rsqrtf(tot * (r * r) * (1.0f / 64.0f) + RMS_EPS_F); }
#pragma unroll
                    for (int e2 = 0; e2 < 8; ++e2) x[e2] = x[e2] * sc * gv[e2];
                    if (ropek) {
                        f32x4 ta = t0, tb = t1; asm volatile("" : "+v"(ta), "+v"(tb));
#pragma unroll
                        for (int e2 = 0; e2 < 8; ++e2) { const float mine = (e2 < 4) ? ta[e2 & 3] : tb[e2 & 3]; const float oth = shx<16>(mine);
                            const float cse = (fq & 1) ? oth : mine, sne = (fq & 1) ? mine : oth; const float other = shx<16>(x[e2]);
                            if ((wc & 1) == 0 && fq == 0) x[e2] = x[e2] * cse - other * sne;
                            else if ((wc & 1) == 0 && fq == 1) x[e2] = x[e2] * cse + other * sne; }
                    }
                    if (kind == KIND_VT) {
                        bf16_t* vp = Vt + (unsigned)((vcol0 + bj * HALF + co0) * S_ + (row & ~1));
#pragma unroll
                        for (int e2 = 0; e2 < 8; ++e2) { const float other = shx<1>(x[e2]);
                            const unsigned w = (fr & 1) ? cvt_pk_bf16(other, x[e2]) : cvt_pk_bf16(x[e2], other);
                            if (((e2 >> 2) & 1) == (fr & 1)) *(EGAS unsigned*)(vp + (unsigned)(e2 * S_)) = w; }
                    } else if (kind == KIND_IK) {
                        const int c8 = 4 * wc + fq;
                        u32x4 w; w.x = cvt_pk_bf16(x[0], x[1]); w.y = cvt_pk_bf16(x[2], x[3]); w.z = cvt_pk_bf16(x[4], x[5]); w.w = cvt_pk_bf16(x[6], x[7]);
                        *(EGAS u32x4*)(IKf + (unsigned)((((row >> 5) * 4 + (c8 >> 1)) * 64 + (c8 & 1) * 32 + (row & 31)) * 8)) = w;
                    } else {
                        u32x4 w; w.x = cvt_pk_bf16(x[0], x[1]); w.y = cvt_pk_bf16(x[2], x[3]); w.z = cvt_pk_bf16(x[4], x[5]); w.w = cvt_pk_bf16(x[6], x[7]);
                        *(EGAS u32x4*)(base + (unsigned)(row * ldc + colt + bj * HALF + co0)) = w;
                        if (kind == KIND_NORM_ROPE_KSUM) {
                            csum[bj][0] += __uint_as_float(w.x << 16); csum[bj][1] += __uint_as_float(w.x & 0xffff0000u); csum[bj][2] += __uint_as_float(w.y << 16); csum[bj][3] += __uint_as_float(w.y & 0xffff0000u);
                            csum[bj][4] += __uint_as_float(w.z << 16); csum[bj][5] += __uint_as_float(w.z & 0xffff0000u); csum[bj][6] += __uint_as_float(w.w << 16); csum[bj][7] += __uint_as_float(w.w & 0xffff0000u); }
                    }
                }
            }
        }
        if (kind == KIND_NORM_ROPE_KSUM) {
#pragma unroll
            for (int b2 = 0; b2 < 2; ++b2)
#pragma unroll
                for (int e2 = 0; e2 < 8; ++e2) { float v = csum[b2][e2]; v += shx<1>(v); v += shx<2>(v); v += __int_as_float(dpp_hmirror_i(__float_as_int(v))); v += shx<8>(v);
                    if (fr == 0) xch[2816 + wr * 256 + b2 * HALF + wc * 32 + 8 * fq + e2] = v; }
        }
        if (normk) { asm volatile("s_waitcnt lgkmcnt(0)" ::: "memory"); __builtin_amdgcn_s_barrier(); asm volatile("" ::: "memory"); }
        if (kind == KIND_NORM_ROPE_KSUM) { int t2 = (wr * 4 + wc) * 64 + fq * 16 + fr; asm volatile("" : "+v"(t2));
            if (t2 < BM) *(EGAS float*)(ksum + (unsigned)(u.pm * 1024 + (u.pn - 4) * BM + t2)) = xch[2816 + t2] + xch[2816 + 256 + t2]; }
    }
};

struct EpiPartial {
    static constexpr bool PERM = true, AFTER_DRAIN = false;
    float* P; int M;
    __device__ __forceinline__ void operator()(const f32x4 (&acc)[2][2][4][2], const Unit& u, int wr, int wc, int fr, int fq) const {
        const int row0 = u.pm * BM + wr * 64 + fr; float* base = P + (size_t)u.pn * M * 256 + wc * 32 + 8 * fq;
#pragma unroll
        for (int ai = 0; ai < 2; ++ai)
#pragma unroll
            for (int m = 0; m < 4; ++m) { float* rp = base + (unsigned)((row0 + ai * HALF + m * 16) * 256);
#pragma unroll
                for (int bj = 0; bj < 2; ++bj) { *(f32x4*)(rp + bj * HALF) = acc[ai][bj][m][0]; *(f32x4*)(rp + bj * HALF + 4) = acc[ai][bj][m][1]; } }
    }
};
typedef int i32x4 __attribute__((ext_vector_type(4)));
template <class E, class = void> struct epi_i8 { static constexpr bool value = false; };
template <class E> struct epi_i8<E, decltype((void)E::I8)> { static constexpr bool value = E::I8; };
template <bool I8> struct acc_sel { typedef f32x4 type; };
template <> struct acc_sel<true> { typedef i32x4 type; };
template <class Epi, class Sched, bool ALIGN_EPI = false, bool SP2 = false, int KSPLIT = 0, int LDB = 0>
__device__ __forceinline__ void gemm_phase(PG8_LAS unsigned char* lds, const Gemm g, const Sched& S, const Epi& E, const int tid) {
    const int wid = __builtin_amdgcn_readfirstlane(tid >> 6), lane = tid & 63, wr = wid >> 2, wc = wid & 3, fr = lane & 15, fq = lane >> 4;
    const int K = g.K, nt = K / BK;
    unsigned voffA[2], voffB[2];
#pragma unroll
    for (int i = 0; i < 2; ++i) { int R, C; stage_rc(tid * 16 + i * 8192, R, C); const int Rb = Epi::PERM ? ((R & ~31) + perm32(R & 31)) : R;
        voffA[i] = (unsigned)(R * g.lda + C) * 2u; voffB[i] = (unsigned)(Rb * (LDB ? LDB : K) + C) * 2u; }
    const size_t kstep = (size_t)(BK * 2);
    const size_t hstepA = (size_t)HALF * g.lda * 2, hstepB = (size_t)HALF * (LDB ? LDB : K) * 2;
    const size_t tstepA = 2 * hstepA, tstepB = 2 * hstepB;
    const unsigned ldsw = (unsigned)wid * 1024u;
    const int aoff = lds_byte(wr * 64 + fr, fq * 8), boff = lds_byte(wc * 32 + fr, fq * 8);
#define PG8_SA(b, h) (((b) * 2 + (h)) * HTB)
#define PG8_SB(b, h) ((4 + (b) * 2 + (h)) * HTB)
#define PG8_STAGE(bufoff, gbase, voff) do { _Pragma("unroll") for (int _i = 0; _i < 2; ++_i) \
        __builtin_amdgcn_global_load_lds((const unsigned*)((const char*)(gbase) + (voff)[_i]), (PG8_LAS unsigned*)(lds + (bufoff) + ldsw + _i * 8192), 16, 0, 0); } while (0)
#define PG8_LDA(dst, b, h) do { _Pragma("unroll") for (int m = 0; m < 4; ++m) _Pragma("unroll") for (int k = 0; k < 2; ++k) dst[m][k] = *(const PG8_LAS bf16x8*)(lds + PG8_SA(b, h) + aoff + m * 2048 + k * 1024); } while (0)
#define PG8_LDB(dst, b, h) do { _Pragma("unroll") for (int n = 0; n < 2; ++n) _Pragma("unroll") for (int k = 0; k < 2; ++k) dst[n][k] = *(const PG8_LAS bf16x8*)(lds + PG8_SB(b, h) + boff + n * 2048 + k * 1024); } while (0)
#define PG8_MMA(ai, bj, At, Bt) do { __builtin_amdgcn_s_setprio(1); _Pragma("unroll") for (int m = 0; m < 4; ++m) _Pragma("unroll") for (int n = 0; n < 2; ++n) _Pragma("unroll") for (int k = 0; k < 2; ++k) \
        { if constexpr (I8) acc[ai][bj][m][n] = __builtin_amdgcn_mfma_i32_16x16x64_i8(__builtin_bit_cast(i32x4, Bt[n][k]), __builtin_bit_cast(i32x4, At[m][k]), acc[ai][bj][m][n], 0, 0, 0); \
          else acc[ai][bj][m][n] = __builtin_amdgcn_mfma_f32_16x16x32_bf16(Bt[n][k], At[m][k], acc[ai][bj][m][n], 0, 0, 0); } __builtin_amdgcn_s_setprio(0); } while (0)
#define PG8_WAIT_V(n) asm volatile("s_waitcnt vmcnt(" #n ")" ::: "memory")
#define PG8_WAIT_L(n) asm volatile("s_waitcnt lgkmcnt(" #n ")" ::: "memory")
#define PG8_BAR __builtin_amdgcn_s_barrier()
#define PG8_SCHED __builtin_amdgcn_sched_barrier(0)
    Unit cur, nxt; int ui = 0;
    if (!S.next(0, cur)) return;
    constexpr bool I8 = epi_i8<Epi>::value; typedef typename acc_sel<I8>::type acc_t;
    acc_t acc[2][2][4][2]; acc_t zacc; zacc[0] = 0; zacc[1] = 0; zacc[2] = 0; zacc[3] = 0;
#pragma unroll
    for (int a = 0; a < 2; ++a)
#pragma unroll
        for (int b = 0; b < 2; ++b)
#pragma unroll
            for (int m = 0; m < 4; ++m)
#pragma unroll
                for (int n = 0; n < 2; ++n) acc[a][b][m][n] = zacc;
    bf16x8 At[4][2], B0[2][2], B1[2][2];
    const char* cA = (const char*)g.A + (size_t)cur.pm * tstepA + (KSPLIT ? (size_t)cur.pn * KSPLIT : (size_t)0); const char* cB = (const char*)g.Bt + (KSPLIT ? (size_t)cur.pn * KSPLIT : (size_t)cur.pn * tstepB);
    S.a_ready(cur);
    if constexpr (SP2) {
        PG8_STAGE(PG8_SB(0, 0), cB, voffB); PG8_STAGE(PG8_SB(0, 1), cB + hstepB, voffB); PG8_STAGE(PG8_SA(0, 0), cA, voffA); PG8_STAGE(PG8_SA(0, 1), cA + hstepA, voffA);
        if (wr == 1) PG8_BAR;
        PG8_WAIT_V(2); PG8_BAR;
        PG8_STAGE(PG8_SB(1, 0), cB + kstep, voffB); PG8_STAGE(PG8_SA(1, 0), cA + kstep, voffA); PG8_STAGE(PG8_SB(1, 1), cB + hstepB + kstep, voffB);
        PG8_WAIT_V(6); PG8_BAR;
    } else {
        PG8_STAGE(PG8_SB(0, 0), cB, voffB); PG8_STAGE(PG8_SA(0, 0), cA, voffA); PG8_STAGE(PG8_SB(0, 1), cB + hstepB, voffB); PG8_STAGE(PG8_SA(0, 1), cA + hstepA, voffA);
        if (wr == 1) PG8_BAR;
        PG8_WAIT_V(4); PG8_BAR;
        PG8_STAGE(PG8_SB(1, 0), cB + kstep, voffB); PG8_STAGE(PG8_SA(1, 0), cA + kstep, voffA); PG8_STAGE(PG8_SB(1, 1), cB + hstepB + kstep, voffB);
        PG8_WAIT_V(6); PG8_BAR;
    }
    for (;;) {
        const bool has_next = S.next(ui + 1, nxt);
        const char* nA = has_next ? (const char*)g.A + (size_t)nxt.pm * tstepA + (KSPLIT ? (size_t)nxt.pn * KSPLIT : (size_t)0) : cA; const char* nB = has_next ? (const char*)g.Bt + (KSPLIT ? (size_t)nxt.pn * KSPLIT : (size_t)nxt.pn * tstepB) : cB;
        for (int t = 0; t < nt; t += 2) {
            const bool last = (t == nt - 2);
            const char* a1 = cA + (size_t)(t + 1) * kstep;
            const char* a2 = last ? nA : cA + (size_t)(t + 2) * kstep; const char* b2 = last ? nB : cB + (size_t)(t + 2) * kstep;
            const char* a3 = a2 + kstep; const char* b3 = b2 + kstep;
            if (last && has_next) S.a_ready(nxt);
            if constexpr (SP2) {
            PG8_LDB(B0, 0, 0); PG8_LDB(B1, 0, 1); PG8_SCHED; PG8_LDA(At, 0, 0); PG8_STAGE(PG8_SA(1, 1), a1 + hstepA, voffA);
            PG8_WAIT_V(8); PG8_WAIT_L(0); PG8_BAR; PG8_MMA(0, 0, At, B0); PG8_MMA(0, 1, At, B1); PG8_BAR; PG8_SCHED;
            PG8_LDA(At, 0, 1); PG8_STAGE(PG8_SB(0, 0), b2, voffB); PG8_STAGE(PG8_SB(0, 1), b2 + hstepB, voffB); PG8_STAGE(PG8_SA(0, 0), a2, voffA);
            PG8_WAIT_V(8); PG8_WAIT_L(0); PG8_BAR; PG8_MMA(1, 0, At, B0); PG8_MMA(1, 1, At, B1); PG8_BAR; PG8_SCHED;
            PG8_LDB(B0, 1, 0); PG8_LDB(B1, 1, 1); PG8_SCHED; PG8_LDA(At, 1, 0); PG8_STAGE(PG8_SA(0, 1), a2 + hstepA, voffA);
            PG8_WAIT_V(8); PG8_WAIT_L(0); PG8_BAR; PG8_MMA(0, 0, At, B0); PG8_MMA(0, 1, At, B1); PG8_BAR; PG8_SCHED;
            PG8_LDA(At, 1, 1); PG8_STAGE(PG8_SB(1, 0), b3, voffB); PG8_STAGE(PG8_SB(1, 1), b3 + hstepB, voffB); PG8_STAGE(PG8_SA(1, 0), a3, voffA);
            PG8_WAIT_V(8); PG8_WAIT_L(0); PG8_BAR; PG8_MMA(1, 0, At, B0); PG8_MMA(1, 1, At, B1); PG8_BAR; PG8_SCHED;
            } else {
            PG8_LDB(B0, 0, 0); PG8_SCHED; PG8_LDA(At, 0, 0); PG8_STAGE(PG8_SA(1, 1), a1 + hstepA, voffA);
            PG8_WAIT_L(8); PG8_BAR; PG8_WAIT_L(0); PG8_MMA(0, 0, At, B0); PG8_BAR; PG8_SCHED;
            PG8_LDB(B1, 0, 1); PG8_STAGE(PG8_SB(0, 0), b2, voffB);
            PG8_BAR; PG8_WAIT_L(0); PG8_MMA(0, 1, At, B1); PG8_BAR;
            PG8_LDA(At, 0, 1); PG8_STAGE(PG8_SA(0, 0), a2, voffA);
            PG8_BAR; PG8_WAIT_L(0); PG8_MMA(1, 0, At, B0); PG8_BAR; PG8_SCHED;
            PG8_STAGE(PG8_SB(0, 1), b2 + hstepB, voffB);
            PG8_WAIT_V(6); PG8_BAR; PG8_MMA(1, 1, At, B1); PG8_BAR;
            PG8_LDB(B0, 1, 0); PG8_SCHED; PG8_LDA(At, 1, 0); PG8_STAGE(PG8_SA(0, 1), a2 + hstepA, voffA);
            PG8_WAIT_L(8); PG8_BAR; PG8_WAIT_L(0); PG8_MMA(0, 0, At, B0); PG8_BAR; PG8_SCHED;
            PG8_LDB(B1, 1, 1); PG8_STAGE(PG8_SB(1, 0), b3, voffB);
            PG8_BAR; PG8_WAIT_L(0); PG8_MMA(0, 1, At, B1); PG8_BAR;
            PG8_LDA(At, 1, 1); PG8_STAGE(PG8_SA(1, 0), a3, voffA);
            PG8_BAR; PG8_WAIT_L(0); PG8_MMA(1, 0, At, B0); PG8_BAR; PG8_SCHED;
            PG8_STAGE(PG8_SB(1, 1), b3 + hstepB, voffB);
            PG8_WAIT_V(6); PG8_BAR; PG8_MMA(1, 1, At, B1); PG8_BAR;
            }
        }
        if constexpr (ALIGN_EPI) { if (wr == 0) PG8_BAR; }
        if constexpr (!Epi::AFTER_DRAIN) { E(acc, cur, wr, wc, fr, fq); S.done(cur); }
        if (!has_next) break;
#pragma unroll
        for (int a = 0; a < 2; ++a)
#pragma unroll
            for (int b = 0; b < 2; ++b)
#pragma unroll
                for (int m = 0; m < 4; ++m)
#pragma unroll
                    for (int n = 0; n < 2; ++n) acc[a][b][m][n] = zacc;
        cur = nxt; cA = nA; cB = nB; ++ui;
        if constexpr (ALIGN_EPI) { if (wr == 1) PG8_BAR; }
    }
    PG8_WAIT_V(0);
    if constexpr (!ALIGN_EPI) { if (wr == 0) PG8_BAR; }
    PG8_BAR;
    if constexpr (Epi::AFTER_DRAIN) { E.fused(acc, cur, wr, wc, fr, fq, lds, wid, lane); S.done(cur); }
#undef PG8_SA
#undef PG8_SB
#undef PG8_STAGE
#undef PG8_LDA
#undef PG8_LDB
#undef PG8_MMA
#undef PG8_WAIT_V
#undef PG8_WAIT_L
#undef PG8_BAR
#undef PG8_SCHED
}
}

constexpr int S = 16384, DM = 1024, FF = 2816, FF2 = 5632, EVEN_SRC = 3664, EVEN_NP = 3840, ODD_N = 3072, NLAYER = 2, MEMT = 256, MEMW = 256;
constexpr float RMS_EPS = 1e-6f;
constexpr float LOG2E = 1.4426950408889634f;
constexpr float C2 = 0.125f * LOG2E;
constexpr int NWAVES = 8, NTHREADS = 512;
constexpr int EC_FQ = 0, EC_DQ = 512, EC_FK = 1024, EC_DK = 1536, EC_FV = 2048, EC_DV = 2560, EC_IQ = 3072, EC_IK = 3584;
constexpr int ES_FQ = 0, ES_FK = 512, ES_FV = 1024, ES_FL = 1536, ES_DQ = 1544, ES_DK = 2056, ES_DV = 2568, ES_IQ = 3080, ES_IK = 3592, ES_IW = 3656;

constexpr size_t MiB = 1u << 20;
constexpr size_t WS_CTL = 0, CTL_ZERO_BYTES = 1 * MiB;
constexpr size_t WS_SSQ = 1 * MiB;
constexpr size_t WS_KSUM = 6 * MiB;
constexpr size_t WS_GT = 11 * MiB + 131072;
constexpr size_t WS_TW = 11 * MiB;
constexpr size_t WS_ROPE = 2 * MiB;
constexpr size_t WS_FL = 3 * MiB;
constexpr size_t WS_MEMK = 4 * MiB;
constexpr size_t WS_IW = 5 * MiB;
constexpr size_t WS_SB = 5 * MiB + 512 * 1024;
constexpr size_t WS_W = 12 * MiB;
constexpr size_t WS_BIG = 60 * MiB;
constexpr size_t WS_HB = 224 * MiB;
constexpr size_t WS_END = 256 * MiB;
constexpr size_t W_FFN1_IN = 0, W_FFN1_OUT = 11 * MiB, W_MIX_IN = 17 * MiB, W_MIX_OUT = 25 * MiB, W_MEMQ = 27 * MiB, W_MEMO = 28 * MiB, W_FFN2_IN = 29 * MiB, W_FFN2_OUT = 40 * MiB, W_MEMQ2 = 46 * MiB, W_MEMO2 = 47 * MiB;
constexpr size_t B_U = 0;
constexpr size_t B_PROJ = 0;
constexpr size_t B_VTF = 120 * MiB;
constexpr size_t B_IKC = 136 * MiB;
constexpr size_t B_VTM = 96 * MiB;
constexpr size_t B_SEL = 156 * MiB;
constexpr size_t B_QP = 0;
constexpr size_t B_QM = 140 * MiB, B_OM = 148 * MiB;
constexpr int CW_TMO = 0, CW_CODE = 1, CW_BAR = 4096;
constexpr int CW_SELQ = 336;
constexpr int CW_VMAX = 320;

constexpr int RING_BYTES = 147456;
constexpr int LDSCTL_OFF = RING_BYTES, MISC_OFF = LDSCTL_OFF + 320;
constexpr int LDS_BYTES = 163840;

#define GAS __attribute__((address_space(1)))
#define LAS __attribute__((address_space(3)))
typedef unsigned short bf16;
typedef unsigned v4u __attribute__((ext_vector_type(4)));
typedef float f32x4 __attribute__((ext_vector_type(4)));
typedef short bf16x8 __attribute__((ext_vector_type(8)));
typedef GAS unsigned gu32;
typedef GAS unsigned long long gu64;
#define RLX_AGENT __ATOMIC_RELAXED, __HIP_MEMORY_SCOPE_AGENT
#define LDS_WAIT() asm volatile("s_waitcnt lgkmcnt(0)" ::: "memory")
#define VM_WAIT() asm volatile("s_waitcnt vmcnt(0)" ::: "memory")
__device__ __forceinline__ unsigned long long rt() { return __builtin_amdgcn_s_memrealtime(); }
__device__ __forceinline__ unsigned f2bf(float f) { unsigned u = __builtin_bit_cast(unsigned, f); return (u + 0x7fffu + ((u >> 16) & 1u)) >> 16; }
__device__ __forceinline__ unsigned pk2(float lo, float hi) { return f2bf(lo) | (f2bf(hi) << 16); }

#define XB_TMO      128
#define XB_XCNT(j)  (256  + 64 * (j))
#define XB_XSUB(j)  (1280 + 64 * (j))
#define XB_XGEN(j)  (2304 + 64 * (j))
#define XB_TOP      3328
#define XB_TOPGEN   3392
#define XCD_BAR_WORDS 3456
#define XB_SPIN_CAP (1u << 18)

__device__ __forceinline__ unsigned xb_ld(unsigned* p)              { return __hip_atomic_load(p, __ATOMIC_RELAXED, __HIP_MEMORY_SCOPE_AGENT); }
__device__ __forceinline__ unsigned xb_add(unsigned* p, unsigned v) { return __hip_atomic_fetch_add(p, v, __ATOMIC_RELAXED, __HIP_MEMORY_SCOPE_AGENT); }
__device__ __forceinline__ unsigned xb_xcc_id() { return (unsigned)__builtin_amdgcn_s_getreg((3 << 11) | 20) & 0xFu; }
#define XB_SPIN(cond, bar) do { unsigned _sp = 0; while (cond) { __builtin_amdgcn_s_sleep(1); \
    if ((++_sp & 255u) == 0u) { if (xb_ld(&(bar)[XB_TMO])) break; if (_sp > XB_SPIN_CAP) { atomicAdd(&(bar)[XB_TMO], 1u); break; } } } } while (0)

struct XcdBarrier {
    unsigned* bar; unsigned x;
    volatile LAS unsigned* st;
};

__device__ __forceinline__ XcdBarrier xcd_barrier_post(unsigned* bar, volatile LAS unsigned* st) {
    XcdBarrier b; b.bar = bar; b.x = xb_xcc_id(); b.st = st;
    if (threadIdx.x == 0) (void)xb_add(&bar[XB_XCNT(b.x)], 1u);
    return b;
}
__device__ __forceinline__ void xcd_barrier_complete(unsigned* bar, unsigned x, unsigned& nloc, unsigned& nx) {
    const unsigned G = gridDim.x * gridDim.y * gridDim.z;
    unsigned sum, cnt, mine, sp = 0u;
    for (;;) {
        sum = 0u; cnt = 0u; mine = 0u;
#pragma unroll
        for (unsigned j = 0; j < 16; ++j) { const unsigned c = xb_ld(&bar[XB_XCNT(j)]); sum += c; cnt += (c > 0u) ? 1u : 0u; mine = (j == x) ? c : mine; }
        if (sum == G) break;
        __builtin_amdgcn_s_sleep(1);
        if ((++sp & 255u) == 0u) { if (xb_ld(&bar[XB_TMO])) break; if (sp > XB_SPIN_CAP) { atomicAdd(&bar[XB_TMO], 1u); break; } }
    }
    nloc = mine > 0u ? mine : 1u; nx = cnt > 0u ? cnt : 1u;
}

__device__ __forceinline__ void xcd_barrier(const XcdBarrier& b) {
    asm volatile("s_waitcnt vmcnt(0)" ::: "memory");
    __syncthreads();
    if (threadIdx.x == 0) {
        unsigned* bar = b.bar;
        __builtin_amdgcn_s_waitcnt(0);
        unsigned nloc = b.st[0], nx = b.st[1];
        if (nloc == 0u) { unsigned x_ = b.x; asm volatile("" : "+s"(x_)); xcd_barrier_complete(bar, x_, nloc, nx); b.st[0] = nloc; b.st[1] = nx; }
        const unsigned old = xb_add(&bar[XB_XSUB(b.x)], 1u);
        const unsigned gen = old / nloc;
        if (old + 1u == (gen + 1u) * nloc) {
            __builtin_amdgcn_fence(__ATOMIC_RELEASE, "agent");
            asm volatile("s_waitcnt vmcnt(0)" ::: "memory");
            const unsigned og = xb_add(&bar[XB_TOP], 1u);
            const unsigned tg = og / nx;
            if (og + 1u == (tg + 1u) * nx) xb_add(&bar[XB_TOPGEN], 1u);
            else XB_SPIN(xb_ld(&bar[XB_TOPGEN]) == tg, bar);
            __builtin_amdgcn_fence(__ATOMIC_ACQUIRE, "agent");
            xb_add(&bar[XB_XGEN(b.x)], 1u);
            asm volatile("s_waitcnt vmcnt(0)" ::: "memory");
        } else {
            XB_SPIN(xb_ld(&bar[XB_XGEN(b.x)]) == gen, bar);
            __builtin_amdgcn_fence(__ATOMIC_ACQUIRE, "agent");
            asm volatile("s_waitcnt vmcnt(0)" ::: "memory");
        }
    }
    __syncthreads();
}

typedef float f32x16 __attribute__((ext_vector_type(16)));
typedef float f32x2_t __attribute__((ext_vector_type(2)));
typedef __bf16 bf16x2_t __attribute__((ext_vector_type(2)));
typedef unsigned u32x2 __attribute__((ext_vector_type(2)));
__device__ __forceinline__ unsigned cvtpk(float lo, float hi) { f32x2_t v = {lo, hi}; bf16x2_t b = __builtin_convertvector(v, bf16x2_t); return __builtin_bit_cast(unsigned, b); }
__device__ __forceinline__ float bflo(unsigned w) { return __uint_as_float(w << 16); }
__device__ __forceinline__ float bfhi(unsigned w) { return __uint_as_float(w & 0xffff0000u); }
__device__ __forceinline__ void unpack8(const v4u& w, float (&x)[8]) { x[0] = bflo(w.x); x[1] = bfhi(w.x); x[2] = bflo(w.y); x[3] = bfhi(w.y); x[4] = bflo(w.z); x[5] = bfhi(w.z); x[6] = bflo(w.w); x[7] = bfhi(w.w); }
__device__ __forceinline__ v4u pack8(const float (&x)[8]) { v4u w; w.x = cvtpk(x[0], x[1]); w.y = cvtpk(x[2], x[3]); w.z = cvtpk(x[4], x[5]); w.w = cvtpk(x[6], x[7]); return w; }
__device__ __forceinline__ unsigned q8pack4(float a, float b, float c, float d) {
    const int ia = (int)__builtin_rintf(a), ib = (int)__builtin_rintf(b), ic = (int)__builtin_rintf(c), id = (int)__builtin_rintf(d);
    return (unsigned)(ia & 255) | ((unsigned)(ib & 255) << 8) | ((unsigned)(ic & 255) << 16) | ((unsigned)(id & 255) << 24); }
__device__ __forceinline__ float wave_sum(float v) { v += shx<1>(v); v += shx<2>(v); v += shx<4>(v); v += shx<8>(v); v += shx<16>(v); return sh32_sum(v); }
__device__ __forceinline__ float wave_max(float v) { v = fmaxf(v, shx<1>(v)); v = fmaxf(v, shx<2>(v)); v = fmaxf(v, shx<4>(v)); v = fmaxf(v, shx<8>(v)); v = fmaxf(v, shx<16>(v)); return sh32_max(v); }
__device__ __forceinline__ int crow(int r, int hi) { return (r & 3) + 8 * (r >> 2) + 4 * hi; }

__device__ __forceinline__ int even_map(int n) {
    if (n < 512) return ES_FQ + n;
    if (n < 1024) return ES_DQ + (n - 512);
    if (n < 1536) return ES_FK + (n - 1024);
    if (n < 2048) return ES_DK + (n - 1536);
    if (n < 2560) return ES_FV + (n - 2048);
    if (n < 3072) return ES_DV + (n - 2560);
    if (n < 3584) return ES_IQ + (n - 3072);
    if (n < 3648) return ES_IK + (n - 3584);
    return -1;
}
__device__ __forceinline__ void conv_item(const float* W, int K, int Nsrc, int nblk, const float* gain, bf16* WT, int mode, LAS float* scr, int item, int lane) {
    const int kb = item / nblk, nb = item % nblk, k0 = 32 * kb, n0 = 128 * nb;
    const int n = n0 + 4 * (lane & 31);
    int sc;
    if (mode == 0) sc = n; else if (mode == 1) { const int T = n >> 8, hf = (n >> 7) & 1, j = n & 127; sc = hf * FF + 128 * T + j; } else sc = even_map(n);
    f32x4 v[16]; float gk[16];
#pragma unroll
    for (int i = 0; i < 16; ++i) { const int kk = 2 * i + (lane >> 5); v[i] = (f32x4){0.f, 0.f, 0.f, 0.f};
        if (sc >= 0) v[i] = *(const GAS f32x4*)(W + (size_t)(k0 + kk) * Nsrc + sc);
        gk[i] = gain ? *(const GAS float*)(gain + k0 + kk) : 1.0f; }
#pragma unroll
    for (int i = 0; i < 16; ++i) { const int kk = 2 * i + (lane >> 5); const float g = gk[i];
        *(LAS f32x4*)(scr + kk * 132 + 4 * (lane & 31)) = v[i] * g; }
    LDS_WAIT(); asm volatile("" ::: "memory");
    const int c = lane & 3;
#pragma unroll
    for (int j = 0; j < 8; ++j) { const int nn = (lane >> 2) + 16 * j; const LAS float* s = scr + (8 * c) * 132 + nn;
        v4u o; o.x = cvtpk(s[0 * 132], s[1 * 132]); o.y = cvtpk(s[2 * 132], s[3 * 132]); o.z = cvtpk(s[4 * 132], s[5 * 132]); o.w = cvtpk(s[6 * 132], s[7 * 132]);
        *(GAS v4u*)(WT + (size_t)(n0 + nn) * K + k0 + 8 * c) = o; }
    LDS_WAIT(); asm volatile("" ::: "memory");
}
__device__ __forceinline__ void conv_q8_item(const float* W, const float* gain, unsigned char* W8, float* sb, LAS float* red, int item, int wave, int lane) {
    const int n = 32 * item + (lane & 31), kq = 2 * wave + (lane >> 5);
    const int T = n >> 8, hf = (n >> 7) & 1, jn = n & 127, sc = hf * FF + 128 * T + jn;
    const float* wp = W + (size_t)(64 * kq) * FF2 + sc;
    float v[64]; float mx = 0.f;
    const float ga = *(const GAS float*)(gain + wave * 64 + lane), gb = *(const GAS float*)(gain + 512 + wave * 64 + lane);
#pragma unroll
    for (int k = 0; k < 64; ++k) v[k] = *(const GAS float*)(wp + (size_t)k * FF2);
    __syncthreads();
    red[256 + wave * 64 + lane] = ga; red[768 + wave * 64 + lane] = gb;
    __syncthreads();
    { const LAS f32x4* gl = (const LAS f32x4*)(red + 256 + 64 * kq);
#pragma unroll
      for (int k = 0; k < 16; ++k) { const f32x4 g = gl[k]; v[4 * k] *= g[0]; v[4 * k + 1] *= g[1]; v[4 * k + 2] *= g[2]; v[4 * k + 3] *= g[3]; } }
#pragma unroll
    for (int k = 0; k < 64; ++k) mx = fmaxf(mx, fabsf(v[k]));
    mx = sh32_max(mx);
    if (lane < 32) red[wave * 32 + lane] = mx;
    __syncthreads();
    mx = red[lane & 31];
#pragma unroll
    for (int w = 1; w < 8; ++w) mx = fmaxf(mx, red[w * 32 + (lane & 31)]);
    mx = fmaxf(mx, 1e-30f);
    const float inv = 127.0f / mx;
    unsigned char* op = W8 + (size_t)n * DM + 64 * kq;
#pragma unroll
    for (int k0 = 0; k0 < 64; k0 += 16) {
        v4u o; o.x = q8pack4(v[k0] * inv, v[k0 + 1] * inv, v[k0 + 2] * inv, v[k0 + 3] * inv); o.y = q8pack4(v[k0 + 4] * inv, v[k0 + 5] * inv, v[k0 + 6] * inv, v[k0 + 7] * inv);
        o.z = q8pack4(v[k0 + 8] * inv, v[k0 + 9] * inv, v[k0 + 10] * inv, v[k0 + 11] * inv); o.w = q8pack4(v[k0 + 12] * inv, v[k0 + 13] * inv, v[k0 + 14] * inv, v[k0 + 15] * inv);
        *(GAS v4u*)(op + k0) = o; }
    if (wave == 0 && lane < 32) sb[n] = mx * (1.0f / 127.0f);
}
struct InPtrs { const float* p[26]; };
constexpr int INTAB_OFF = LDSCTL_OFF + 1024;
struct InTab { LAS unsigned char* ldsbase;
    __device__ __forceinline__ const float* get(int k) const { const u32x2 v = *(const LAS u32x2*)(ldsbase + INTAB_OFF + 8 * k);
        const unsigned lo = (unsigned)__builtin_amdgcn_readfirstlane((int)v.x), hi = (unsigned)__builtin_amdgcn_readfirstlane((int)v.y);
        return (const float*)(((unsigned long long)hi << 32) | lo); } };
__device__ __forceinline__ void conv_weights(const InTab& in, unsigned char* ws, int L, int mask, LAS unsigned char* lds, int gw, int NGW, int wave, int lane) {
    LAS float* scr = (LAS float*)(lds + wave * 17408);
    unsigned char* Wr = ws + WS_W;
    const bool even = (L & 1) == 0;
    const int mixN = even ? EVEN_NP : ODD_N, mixSrc = even ? EVEN_SRC : ODD_N;
    const int I_FIN = (DM / 32) * (FF2 / 128), I_FOUT = (FF / 32) * (DM / 128), I_MIN = (DM / 32) * (mixN / 128), I_MOUT = (DM / 32) * (DM / 128), I_MQ = (DM / 32) * (MEMW / 128), I_MO = (MEMW / 32) * (DM / 128);
    const int n0 = 0, n1 = (mask & 2) ? I_FOUT : 0,   n2 = (mask & 4) ? I_MIN : 0, n3 = (mask & 8) ? I_MOUT : 0, n4 = (mask & 16) ? I_MQ : 0, n5 = (mask & 32) ? I_MO : 0,
              n6 = 0, n7 = (mask & 128) ? I_FOUT : 0;
    const int NITEMS = n0 + n1 + n2 + n3 + n4 + n5 + n6 + n7;
    for (int it = gw; it < NITEMS; it += NGW) {
        int r = it;
        if (r < n1) { conv_item(in.get(4) + (size_t)L * FF * DM, FF, DM, DM / 128, nullptr, (bf16*)(Wr + W_FFN1_OUT), 0, scr, r, lane); continue; } r -= n1;
        if (r < n7) { conv_item(in.get(25) + (size_t)L * FF * DM, FF, DM, DM / 128, nullptr, (bf16*)(Wr + W_FFN2_OUT), 0, scr, r, lane); continue; } r -= n7;
        if (r < n2) { conv_item(even ? in.get(6) : in.get(12), DM, mixSrc, mixN / 128, in.get(5) + (size_t)L * DM, (bf16*)(Wr + W_MIX_IN), even ? 2 : 0, scr, r, lane); continue; } r -= n2;
        if (r < n3) { conv_item(in.get(15) + (size_t)L * DM * DM, DM, DM, DM / 128, nullptr, (bf16*)(Wr + W_MIX_OUT), 0, scr, r, lane); continue; } r -= n3;
        if (r < n4) { conv_item(in.get(18) + (size_t)L * DM * MEMW, DM, MEMW, MEMW / 128, in.get(16) + (size_t)L * DM, (bf16*)(Wr + (L ? W_MEMQ2 : W_MEMQ)), 0, scr, r, lane); continue; } r -= n4;
        conv_item(in.get(22) + (size_t)L * MEMW * DM, MEMW, DM, DM / 128, nullptr, (bf16*)(Wr + (L ? W_MEMO2 : W_MEMO)), 0, scr, r, lane);
    }
}
__device__ __forceinline__ void conv_q8_weights(const InTab& in, unsigned char* ws, int L, int mask, LAS unsigned char* lds, int wg, int nwg, int wave, int lane) {
    unsigned char* Wr = ws + WS_W; float* sb1 = (float*)(ws + WS_SB); float* sb2 = sb1 + 8192;
    const int NI = FF2 / 32;
    const int n0 = (mask & 1) ? NI : 0, n6 = (mask & 64) ? NI : 0;
    for (int it = wg; it < n0 + n6; it += nwg) {
        if (it < n0) conv_q8_item(in.get(3) + (size_t)L * DM * FF2, in.get(2) + (size_t)L * DM, Wr + W_FFN1_IN, sb1, (LAS float*)lds, it, wave, lane);
        else         conv_q8_item(in.get(24) + (size_t)L * DM * FF2, in.get(23) + (size_t)L * DM, Wr + W_FFN2_IN, sb2, (LAS float*)lds, it - n0, wave, lane);
    }
    __syncthreads();
}
__device__ __forceinline__ void copy_x(const float* x, unsigned char* HQ, float* sa, bf16* HB, float* ssq0, int gw, int NGW, int lane) {
    for (int m = gw; m < S; m += NGW) {
        const GAS f32x4* xr = (const GAS f32x4*)(x + (size_t)m * DM) + lane;
        GAS u32x2* hb = (GAS u32x2*)(HB + (size_t)m * DM) + lane;
        float s = 0.f, am = 0.f; f32x4 v[4];
#pragma unroll
        for (int j = 0; j < 4; ++j) { v[j] = xr[64 * j]; s += (v[j].x * v[j].x + v[j].y * v[j].y) + (v[j].z * v[j].z + v[j].w * v[j].w);
            am = fmaxf(fmaxf(am, fmaxf(fabsf(v[j].x), fabsf(v[j].y))), fmaxf(fabsf(v[j].z), fabsf(v[j].w)));
            u32x2 w; w.x = cvtpk(v[j].x, v[j].y); w.y = cvtpk(v[j].z, v[j].w); hb[64 * j] = w; }
        s = wave_sum(s); am = fmaxf(wave_max(am), 1e-30f);
        const float inv = 127.0f / am;
#pragma unroll
        for (int j = 0; j < 4; ++j) *(GAS unsigned*)(HQ + (size_t)m * DM + 4 * (lane + 64 * j)) = q8pack4(v[j].x * inv, v[j].y * inv, v[j].z * inv, v[j].w * inv);
        if (lane < 16) ssq0[(size_t)m * 16 + lane] = (lane == 0) ? s : 0.f;
        if (lane == 0) sa[m] = am * (1.0f / 127.0f) * rsqrtf(s * (1.0f / DM) + RMS_EPS);
    }
}
__device__ __forceinline__ void quant_rows(const bf16* HB, unsigned char* HQ, float* sa, int gw, int NGW, int lane) {
    for (int m = gw; m < S; m += NGW) {
        const GAS u32x2* hb = (const GAS u32x2*)(HB + (size_t)m * DM) + lane;
        float v[16]; float am = 0.f, s = 0.f;
#pragma unroll
        for (int j = 0; j < 4; ++j) { const u32x2 w = hb[64 * j]; v[4 * j] = bflo(w.x); v[4 * j + 1] = bfhi(w.x); v[4 * j + 2] = bflo(w.y); v[4 * j + 3] = bfhi(w.y);
            s += (v[4 * j] * v[4 * j] + v[4 * j + 1] * v[4 * j + 1]) + (v[4 * j + 2] * v[4 * j + 2] + v[4 * j + 3] * v[4 * j + 3]);
            am = fmaxf(fmaxf(am, fmaxf(fabsf(v[4 * j]), fabsf(v[4 * j + 1]))), fmaxf(fabsf(v[4 * j + 2]), fabsf(v[4 * j + 3]))); }
        am = fmaxf(wave_max(am), 1e-30f); s = wave_sum(s);
        const float inv = 127.0f / am;
#pragma unroll
        for (int j = 0; j < 4; ++j) *(GAS unsigned*)(HQ + (size_t)m * DM + 4 * (lane + 64 * j)) = q8pack4(v[4 * j] * inv, v[4 * j + 1] * inv, v[4 * j + 2] * inv, v[4 * j + 3] * inv);
        if (lane == 0) sa[m] = am * (1.0f / 127.0f) * rsqrtf(s * (1.0f / DM) + RMS_EPS);
    }
}
__device__ __forceinline__ void rope_tables(float* cosT, float* sinT, int gtid, int nthreads) {
    for (int idx = gtid; idx < S * 8; idx += nthreads) {
        const int t = idx >> 3, j = idx & 7;
        float inv;
        switch (j) { case 0: inv = 1.0f; break; case 1: inv = 0.193922743f; break; case 2: inv = 0.0376060307f; break; case 3: inv = 0.00729266461f; break;
                     case 4: inv = 0.00141421356f; break; case 5: inv = 0.000274248188f; break; case 6: inv = 5.3182961e-05f; break; default: inv = 1.03133862e-05f; break; }
        const float ang = (float)t * inv;
        const float kq = __builtin_rintf(ang * 0.63661977236758134f);
        float r = ang - kq * 1.5703125f; r = r - kq * 0.00048351287841796875f; r = r - kq * 3.1391647326017846e-07f;
        const float r2 = r * r;
        float sp = 2.7557319e-6f; sp = sp * r2 - 1.9841270e-4f; sp = sp * r2 + 8.3333333e-3f; sp = sp * r2 - 1.6666667e-1f; const float sn = r + r * r2 * sp;
        float cp = -2.7557319e-7f; cp = cp * r2 + 2.4801587e-5f; cp = cp * r2 - 1.3888889e-3f; cp = cp * r2 + 4.1666667e-2f; cp = cp * r2 - 0.5f; const float cs = 1.0f + r2 * cp;
        const int q = ((int)kq) & 3;
        const float sv = (q == 0) ? sn : (q == 1) ? cs : (q == 2) ? -sn : -cs;
        const float cv = (q == 0) ? cs : (q == 1) ? -sn : (q == 2) ? -cs : sn;
        cosT[idx] = cv; sinT[idx] = sv;
    }
}
__device__ __forceinline__ void mem_kv(const InTab& in, unsigned char* ws, LAS unsigned char* lds, int unit, int tid, int wave, int lane) {
    LAS float* memn = (LAS float*)lds;
    LAS f32x4* part = (LAS f32x4*)(lds + 16 * 1028 * 4);
    bf16* memK = (bf16*)(ws + WS_MEMK); bf16* memVt = (bf16*)(ws + WS_MEMK + 256 * 1024);
    const int L = unit >> 7, rb = (unit >> 3) & 15, cb = unit & 7;
    const float* gm = in.get(17) + (size_t)L * DM; const float* wkv = in.get(19) + (size_t)L * DM * 512; const float* kn = in.get(21) + (size_t)L * 64;
    __syncthreads();
    for (int i = 0; i < 2; ++i) { const int r = wave * 2 + i; const float* mrow = in.get(1) + (size_t)(rb * 16 + r) * DM;
        f32x4 v[4]; float s = 0.f;
#pragma unroll
        for (int j = 0; j < 4; ++j) { v[j] = *((const GAS f32x4*)mrow + lane + 64 * j); s += (v[j].x * v[j].x + v[j].y * v[j].y) + (v[j].z * v[j].z + v[j].w * v[j].w); }
        const float rstd = rsqrtf(wave_sum(s) * (1.0f / DM) + RMS_EPS);
#pragma unroll
        for (int j = 0; j < 4; ++j) { const f32x4 g = *((const GAS f32x4*)gm + lane + 64 * j); *(LAS f32x4*)(memn + r * 1028 + 4 * (lane + 64 * j)) = v[j] * rstd * g; } }
    __syncthreads();
    {
        const int cl = lane & 15, sl = wave * 4 + (lane >> 4);
        const float* wp = wkv + (size_t)(4 * sl) * 512 + cb * 64 + cl * 4;
        f32x4 acc[16];
#pragma unroll
        for (int r = 0; r < 16; ++r) acc[r] = (f32x4){0.f, 0.f, 0.f, 0.f};
#pragma unroll 2
        for (int j = 0; j < 8; ++j) {
            const f32x4 w0 = *(const GAS f32x4*)(wp + (size_t)(128 * j) * 512), w1 = *(const GAS f32x4*)(wp + (size_t)(128 * j + 1) * 512),
                        w2 = *(const GAS f32x4*)(wp + (size_t)(128 * j + 2) * 512), w3 = *(const GAS f32x4*)(wp + (size_t)(128 * j + 3) * 512);
#pragma unroll
            for (int r = 0; r < 16; ++r) { const f32x4 mv = *(const LAS f32x4*)(memn + r * 1028 + 4 * (sl + 32 * j));
                acc[r] = acc[r] + w0 * mv.x + w1 * mv.y + w2 * mv.z + w3 * mv.w; }
        }
#pragma unroll
        for (int r = 0; r < 16; ++r) {
#pragma unroll
            for (int c = 0; c < 4; ++c) { float v = acc[r][c]; v += shx<16>(v); v = sh32_sum(v); acc[r][c] = v; }
            if (lane < 16) part[(wave * 16 + r) * 16 + cl] = acc[r]; }
    }
    __syncthreads();
    if (tid < 256) {
        const int r = tid >> 4, c4 = (tid & 15) * 4;
        f32x4 acc = part[tid];
#pragma unroll
        for (int w = 1; w < 8; ++w) acc = acc + part[w * 256 + tid];
        const int tok = rb * 16 + r;
        if (cb < 4) {
            float ss = (acc.x * acc.x + acc.y * acc.y) + (acc.z * acc.z + acc.w * acc.w);
            ss += shx<1>(ss); ss += shx<2>(ss); ss += shx<4>(ss); ss += shx<8>(ss);
            const float rs = rsqrtf(ss * (1.0f / 64.0f) + RMS_EPS);
            u32x2 w; w.x = cvtpk(acc.x * rs * kn[c4], acc.y * rs * kn[c4 + 1]); w.y = cvtpk(acc.z * rs * kn[c4 + 2], acc.w * rs * kn[c4 + 3]);
            *(GAS u32x2*)(memK + (size_t)L * 65536 + (size_t)tok * 256 + cb * 64 + c4) = w;
        } else {
            const int c = (cb - 4) * 64 + c4; bf16* vp = memVt + (size_t)L * 65536 + (size_t)c * 256 + tok;
            vp[0] = (bf16)(cvtpk(acc.x, 0.f) & 0xffffu); vp[256] = (bf16)(cvtpk(acc.y, 0.f) & 0xffffu); vp[512] = (bf16)(cvtpk(acc.z, 0.f) & 0xffffu); vp[768] = (bf16)(cvtpk(acc.w, 0.f) & 0xffffu);
        }
    }
}

__device__ __forceinline__ void head_norm8(float (&x)[8], const float* gain, int lane) {
    float ss = 0.f;
#pragma unroll
    for (int j = 0; j < 8; ++j) ss += x[j] * x[j];
    ss += shx<1>(ss); ss += shx<2>(ss); ss += shx<4>(ss);
    const float r = rsqrtf(ss * (1.0f / 64.0f) + RMS_EPS);
    const int d0 = 8 * (lane & 7);
#pragma unroll
    for (int j = 0; j < 8; ++j) x[j] = x[j] * r * gain[d0 + j];
}
__device__ __forceinline__ void rope8(float (&x)[8], const float (&cs)[8], const float (&sn)[8], int lane) {
    const int sub = lane & 7;
#pragma unroll
    for (int j = 0; j < 8; ++j) {
        const float other = shx<1>(x[j]);
        if (sub == 0) x[j] = x[j] * cs[j] - other * sn[j];
        else if (sub == 1) x[j] = x[j] * cs[j] + other * sn[j];
    }
}
__device__ __forceinline__ float sh32_get(float v, int lane) { auto r = __builtin_amdgcn_permlane32_swap(__float_as_uint(v), __float_as_uint(v), false, false); return __uint_as_float((lane < 32) ? r[1] : r[0]); }
__device__ __forceinline__ float reduce_scatter64(float (&v)[64], int lane) {
    { const bool up = (lane & 32) != 0;
#pragma unroll
      for (int j = 0; j < 32; ++j) { const float send = up ? v[j] : v[j + 32], keep = up ? v[j + 32] : v[j]; v[j] = keep + sh32_get(send, lane); } }
    { const bool up = (lane & 16) != 0;
#pragma unroll
      for (int j = 0; j < 16; ++j) { const float send = up ? v[j] : v[j + 16], keep = up ? v[j + 16] : v[j]; v[j] = keep + shx<16>(send); } }
    { const bool up = (lane & 8) != 0;
#pragma unroll
      for (int j = 0; j < 8; ++j) { const float send = up ? v[j] : v[j + 8], keep = up ? v[j + 8] : v[j]; v[j] = keep + shx<8>(send); } }
    { const bool up = (lane & 4) != 0;
#pragma unroll
      for (int j = 0; j < 4; ++j) { const float send = up ? v[j] : v[j + 4], keep = up ? v[j + 4] : v[j]; v[j] = keep + shx<4>(send); } }
    { const bool up = (lane & 2) != 0;
#pragma unroll
      for (int j = 0; j < 2; ++j) { const float send = up ? v[j] : v[j + 2], keep = up ? v[j + 2] : v[j]; v[j] = keep + shx<2>(send); } }
    { const bool up = (lane & 1) != 0; const float send = up ? v[0] : v[1], keep = up ? v[1] : v[0]; v[0] = keep + shx<1>(send); }
    return v[0];
}
__device__ __forceinline__ void post_even(const InTab& in, unsigned char* ws, const bf16* HBp, const float* ssq, LAS unsigned char* lds, int G, int tid, int wave, int lane) {
    float* Flocal = (float*)(ws + WS_FL); float* Btot = Flocal + S * 8; float* IW = (float*)(ws + WS_IW);
    const float* bfg = in.get(7);
    LAS f32x4* Tw = (LAS f32x4*)lds;
    LAS float* lf = (LAS float*)(lds + 65536);
    { const GAS f32x4* src = (const GAS f32x4*)(ws + WS_TW);
#pragma unroll
      for (int i = 0; i < 8; ++i) Tw[tid + 512 * i] = src[tid + 512 * i]; }
    __syncthreads();
    for (int u = blockIdx.x; u < S / 64; u += G) {
        const int t0 = u * 64, tw0 = t0 + wave * 8;
        { const bf16* vr = (const bf16*)(ws + WS_BIG + B_PROJ) + (size_t)tw0 * EVEN_NP + EC_DV + lane * 8; float vm = 0.f;
          v4u wv[8];
#pragma unroll
          for (int i = 0; i < 8; ++i) wv[i] = *(const GAS v4u*)(vr + (size_t)i * EVEN_NP);
#pragma unroll
          for (int i = 0; i < 8; i += 4) asm volatile("" : "+v"(wv[i].x), "+v"(wv[i + 1].x), "+v"(wv[i + 2].x), "+v"(wv[i + 3].x));
#pragma unroll
          for (int i = 0; i < 8; ++i) { float x[8]; unpack8(wv[i], x);
#pragma unroll
              for (int j = 0; j < 8; ++j) vm = fmaxf(vm, fabsf(x[j])); }
          vm = fmaxf(vm, shx<1>(vm)); vm = fmaxf(vm, shx<2>(vm)); vm = fmaxf(vm, shx<4>(vm));
          if ((lane & 7) == 0) atomicMax((unsigned*)(ws + WS_CTL) + CW_VMAX + (lane >> 3), __float_as_uint(vm)); }
#pragma unroll 1
        for (int rb = 0; rb < 2; ++rb) {
            float acc[64];
#pragma unroll
            for (int j = 0; j < 64; ++j) acc[j] = 0.f;
            u32x2 hw[4][4];
#pragma unroll
            for (int q = 0; q < 4; ++q)
#pragma unroll
                for (int r = 0; r < 4; ++r) hw[q][r] = *((const GAS u32x2*)(HBp + (size_t)(tw0 + rb * 4 + r) * DM) + lane + 64 * q);
#pragma unroll
            for (int q = 0; q < 4; ++q) asm volatile("" : "+v"(hw[q][0].x), "+v"(hw[q][1].x), "+v"(hw[q][2].x), "+v"(hw[q][3].x));
#pragma unroll
            for (int q = 0; q < 4; ++q) {
                f32x4 hv[4];
#pragma unroll
                for (int r = 0; r < 4; ++r) { const u32x2 w = hw[q][r]; hv[r][0] = bflo(w.x); hv[r][1] = bfhi(w.x); hv[r][2] = bflo(w.y); hv[r][3] = bfhi(w.y); }
#pragma unroll
                for (int e = 0; e < 4; ++e)
#pragma unroll
                    for (int c = 0; c < 4; ++c) { const f32x4 w = Tw[((q * 4 + e) * 4 + c) * 64 + lane];
#pragma unroll
                        for (int r = 0; r < 4; ++r) { acc[r * 16 + 4 * c + 0] += hv[r][e] * w[0]; acc[r * 16 + 4 * c + 1] += hv[r][e] * w[1]; acc[r * 16 + 4 * c + 2] += hv[r][e] * w[2]; acc[r * 16 + 4 * c + 3] += hv[r][e] * w[3]; } }
            }
            const float zs = reduce_scatter64(acc, lane);
            const int rl = wave * 8 + rb * 4 + (lane >> 4), t = t0 + rl, j = lane & 15;
            const float z = zs * pg8::row_rstd(ssq, t);
            if (j < 8) { const float zz = z + bfg[j]; lf[rl * 8 + j] = (zz > 15.f) ? -expf(-zz) : -log1pf(expf(-zz)); }
            else IW[(size_t)t * 8 + (j - 8)] = z * 0.044194173824159216f;
        }
        __syncthreads();
        {
            float v = lf[lane * 8 + wave];
#pragma unroll
            for (int o = 1; o < 64; o <<= 1) { const float up = __int_as_float(__builtin_amdgcn_ds_bpermute(((lane - o) & 63) << 2, __float_as_int(v))); if (lane >= o) v += up; }
            Flocal[(size_t)(t0 + lane) * 8 + wave] = v;
            if (lane == 63) Btot[u * 8 + wave] = v;
        }
        __syncthreads();
    }
}

__device__ __forceinline__ void post_odd(unsigned char* ws, LAS unsigned char* lds, int G, int tid) {
    const bf16* Kb = (const bf16*)(ws + WS_BIG + B_PROJ) + (size_t)S * DM; float* ksum = (float*)(ws + WS_KSUM);
    LAS float* red = (LAS float*)lds;
    for (int u = blockIdx.x; u < 256; u += G) {
        const int n = u >> 2, cg = u & 3, c2 = tid & 127, rg = tid >> 7;
        const bf16* kp = Kb + (size_t)(n * 256 + rg * 64) * DM + cg * 256 + c2 * 2;
        float s0 = 0.f, s1 = 0.f;
#pragma unroll 16
        for (int r = 0; r < 64; ++r) { const unsigned w = *(const GAS unsigned*)(kp + (size_t)r * DM); s0 += bflo(w); s1 += bfhi(w); }
        __syncthreads();
        red[rg * 256 + c2 * 2] = s0; red[rg * 256 + c2 * 2 + 1] = s1;
        __syncthreads();
        if (tid < 256) ksum[(size_t)n * 1024 + cg * 256 + tid] = (red[tid] + red[256 + tid]) + (red[512 + tid] + red[768 + tid]);
    }
}

constexpr int KV_K_BYTES = 8192, KV_VT_PITCH = 136, KV_BUF_BYTES = KV_K_BYTES + 64 * KV_VT_PITCH;
struct KVRegs { v4u k, v; };
__device__ __forceinline__ void kv_load(KVRegs& r, const bf16* Kp, size_t kpitch, const bf16* Vtp, size_t vtpitch, int key0, int tid) {
    r.k = *(const GAS v4u*)(Kp + (size_t)(key0 + (tid & 63)) * kpitch + (tid >> 6) * 8);
    r.v = *(const GAS v4u*)(Vtp + (size_t)(tid >> 3) * vtpitch + key0 + (tid & 7) * 8);
}
__device__ __forceinline__ void kv_store(const KVRegs& r, LAS unsigned char* buf, int tid) {
    *(LAS v4u*)(buf + ((tid >> 6) * 64 + (tid & 63)) * 16) = r.k;
    LAS unsigned char* vp = buf + KV_K_BYTES + (tid >> 3) * KV_VT_PITCH + (tid & 7) * 16;
    *(LAS u32x2*)vp = (u32x2){r.v.x, r.v.y}; *(LAS u32x2*)(vp + 8) = (u32x2){r.v.z, r.v.w};
}
struct AttnAcc { float m, l; f32x16 o0, o1; };
__device__ __forceinline__ void attn_init(AttnAcc& a) { a.m = -INFINITY; a.l = 0.f;
#pragma unroll
    for (int r = 0; r < 16; ++r) { a.o0[r] = 0.f; a.o1[r] = 0.f; } }
template <int CHS = 1024>
__device__ __forceinline__ void attn_scores(f32x16& p0, f32x16& p1, const LAS unsigned char* buf, const bf16x8 (&qf)[4], int lane) {
    const int r32 = lane & 31, hi = lane >> 5;
#pragma unroll
    for (int r = 0; r < 16; ++r) { p0[r] = 0.f; p1[r] = 0.f; }
#pragma unroll
    for (int ks = 0; ks < 4; ++ks) {
        const bf16x8 k0 = *(const LAS bf16x8*)(buf + (2 * ks + hi) * CHS + r32 * 16);
        const bf16x8 k1 = *(const LAS bf16x8*)(buf + (2 * ks + hi) * CHS + (32 + r32) * 16);
        p0 = __builtin_amdgcn_mfma_f32_32x32x16_bf16(k0, qf[ks], p0, 0, 0, 0);
        p1 = __builtin_amdgcn_mfma_f32_32x32x16_bf16(k1, qf[ks], p1, 0, 0, 0);
    }
}
template <int VTP = KV_VT_PITCH, int VOFF = KV_K_BYTES>
__device__ __forceinline__ void attn_update(AttnAcc& a, f32x16& p0, f32x16& p1, const LAS unsigned char* buf, int lane, const float sc = 1.0f) {
    const int r32 = lane & 31, hi = lane >> 5;
    float mx = fmaxf(p0[0], p1[0]);
#pragma unroll
    for (int r = 1; r < 16; ++r) mx = fmaxf(mx, fmaxf(p0[r], p1[r]));
    mx = sh32_max(mx) * sc;
    if (__builtin_amdgcn_ballot_w64(!(mx - a.m <= 8.0f)) != 0ull) {
        const float mnew = fmaxf(a.m, mx);
        const float msafe = (mnew == -INFINITY) ? 0.f : mnew;
        const float alpha = __builtin_amdgcn_exp2f(a.m - msafe);
        a.l *= alpha; a.m = mnew;
#pragma unroll
        for (int r = 0; r < 16; ++r) { a.o0[r] *= alpha; a.o1[r] *= alpha; }
    }
    const float msafe = (a.m == -INFINITY) ? 0.f : a.m;
    float sum = 0.f;
#pragma unroll
    for (int r = 0; r < 16; ++r) { p0[r] = __builtin_amdgcn_exp2f(__builtin_fmaf(p0[r], sc, -msafe)); p1[r] = __builtin_amdgcn_exp2f(__builtin_fmaf(p1[r], sc, -msafe)); sum += p0[r] + p1[r]; }
    a.l += sum;
    const LAS unsigned char* vt = buf + VOFF + r32 * VTP + hi * 8;
#pragma unroll
    for (int half = 0; half < 2; ++half) {
#pragma unroll
        for (int s = 0; s < 2; ++s) {
            v4u pw;
            if (half == 0) { pw.x = cvtpk(p0[8 * s + 0], p0[8 * s + 1]); pw.y = cvtpk(p0[8 * s + 2], p0[8 * s + 3]); pw.z = cvtpk(p0[8 * s + 4], p0[8 * s + 5]); pw.w = cvtpk(p0[8 * s + 6], p0[8 * s + 7]); }
            else           { pw.x = cvtpk(p1[8 * s + 0], p1[8 * s + 1]); pw.y = cvtpk(p1[8 * s + 2], p1[8 * s + 3]); pw.z = cvtpk(p1[8 * s + 4], p1[8 * s + 5]); pw.w = cvtpk(p1[8 * s + 6], p1[8 * s + 7]); }
            const bf16x8 pb = __builtin_bit_cast(bf16x8, pw);
            const int kb = (32 * half + 16 * s) * 2;
#pragma unroll
            for (int d0 = 0; d0 < 2; ++d0) {
                const u32x2 lo = *(const LAS u32x2*)(vt + d0 * 32 * VTP + kb), hi2 = *(const LAS u32x2*)(vt + d0 * 32 * VTP + kb + 16);
                const bf16x8 va = __builtin_bit_cast(bf16x8, (v4u){lo.x, lo.y, hi2.x, hi2.y});
                if (d0 == 0) a.o0 = __builtin_amdgcn_mfma_f32_32x32x16_bf16(va, pb, a.o0, 0, 0, 0);
                else         a.o1 = __builtin_amdgcn_mfma_f32_32x32x16_bf16(va, pb, a.o1, 0, 0, 0);
            }
        }
    }
}
__device__ __forceinline__ void attn_store(const AttnAcc& a, bf16* orow, int lane) {
    const int hi = lane >> 5;
    float l = sh32_sum(a.l);
    const float inv = (l > 0.f) ? 1.0f / l : 0.f;
#pragma unroll
    for (int g = 0; g < 4; ++g) {
        u32x2 w0, w1;
        w0.x = cvtpk(a.o0[4 * g] * inv, a.o0[4 * g + 1] * inv); w0.y = cvtpk(a.o0[4 * g + 2] * inv, a.o0[4 * g + 3] * inv);
        w1.x = cvtpk(a.o1[4 * g] * inv, a.o1[4 * g + 1] * inv); w1.y = cvtpk(a.o1[4 * g + 2] * inv, a.o1[4 * g + 3] * inv);
        *(GAS u32x2*)(orow + 8 * g + 4 * hi) = w0; *(GAS u32x2*)(orow + 32 + 8 * g + 4 * hi) = w1;
    }
}
__device__ __forceinline__ void load_q(bf16x8 (&qf)[4], const bf16* qrow, int lane) {
    const int hi = lane >> 5;
#pragma unroll
    for (int ks = 0; ks < 4; ++ks) qf[ks] = *(const GAS bf16x8*)(qrow + 16 * ks + 8 * hi);
}

constexpr int CW_FOXQ = 64;
__device__ __forceinline__ void fox_phase(const InTab& in, unsigned char* ws, LAS unsigned char* lds, int G, int tid, int wave, int lane, bf16* obase, size_t opitch, int qword) {
    bf16* proj = (bf16*)(ws + WS_BIG + B_PROJ); const bf16* VtF = (const bf16*)(ws + WS_BIG + B_VTF);
    const float* Flocal = (const float*)(ws + WS_FL); const float* Btot = Flocal + S * 8;
    unsigned* qctr = (unsigned*)(ws + WS_CTL) + qword;
    LAS unsigned char* kvb = lds; LAS float* kbt = (LAS float*)(lds + 2 * KV_BUF_BYTES); LAS float* bt = (LAS float*)(lds + 2 * KV_BUF_BYTES + 65536); LAS float* Et = bt + 272;
    LAS int* misc = (LAS int*)(Et + 272);
    const int r32 = lane & 31, hi = lane >> 5;
    if (wave == 0) { const float gq = wave_max(fabsf(in.get(8)[lane])), gk = wave_max(fabsf(in.get(9)[lane])); if (lane == 0) { ((LAS float*)misc)[2] = gq; ((LAS float*)misc)[3] = gk; } }
    __syncthreads();
    const float THR = 2.0f * (0.125f * LOG2E * 64.0f * 1.02f) * ((LAS float*)misc)[2] * ((LAS float*)misc)[3] + 32.0f;
    for (;;) {
        __syncthreads();
        if (tid == 0) misc[0] = (int)atomicAdd(qctr, 1u);
        __syncthreads();
        const int u = misc[0];
        if (u >= 512) break;
        const int QB = 63 - (u >> 3), h = u & 7, q0 = QB * 256, nt = 4 * (QB + 1);
        for (int j = tid; j < nt; j += NTHREADS) bt[j] = Btot[j * 8 + h];
        if (tid == 0) misc[1] = 4 * QB;
        __syncthreads();
        { float v = (tid < nt) ? bt[tid] : 0.f;
#pragma unroll
          for (int o = 1; o < 64; o <<= 1) { const float up = __int_as_float(__builtin_amdgcn_ds_bpermute(((lane - o) & 63) << 2, __float_as_int(v))); if (lane >= o) v += up; }
          if (lane == 63 && wave < 4) ((LAS float*)misc)[4 + wave] = v;
          __syncthreads();
          float off = 0.f;
#pragma unroll
          for (int w = 0; w < 3; ++w) if (w < wave) off += ((LAS float*)misc)[4 + w];
          if (tid < nt) kbt[tid] = v + off;
          __syncthreads();
          const float pq = QB ? kbt[4 * QB - 1] : 0.f;
          for (int j = tid; j <= nt; j += NTHREADS) Et[j] = (j ? kbt[j - 1] : 0.f) - pq; }
        __syncthreads();
        for (int j = tid; j < 4 * QB; j += NTHREADS) if (Et[j + 1] * LOG2E <= THR) atomicMin((int*)&misc[1], j);
        __syncthreads();
        const int t_start = misc[1], s0 = 64 * t_start;
        for (int s = s0 + tid; s < q0 + 256; s += NTHREADS) kbt[s - s0] = -(Et[s >> 6] + Flocal[(size_t)s * 8 + h]) * LOG2E;
        const int qrow = q0 + wave * 32 + r32;
        bf16x8 qf[4]; load_q(qf, proj + (size_t)qrow * EVEN_NP + EC_FQ + h * 64, lane);
        AttnAcc a; attn_init(a);
        const bf16* Kp = proj + EC_FK + h * 64; const bf16* Vtp = VtF + (size_t)h * 64 * S;
        KVRegs kr; kv_load(kr, Kp, EVEN_NP, Vtp, S, s0, tid); kv_store(kr, kvb, tid);
        __syncthreads();
        const float kbw = kbt[q0 + wave * 32 - s0];
        for (int t = t_start; t < nt; ++t) {
            LAS unsigned char* cur = kvb + ((t - t_start) & 1) * KV_BUF_BYTES;
            if (t + 1 < nt) kv_load(kr, Kp, EVEN_NP, Vtp, S, (t + 1) * 64, tid);
            const int key0 = t * 64;
            const bool vis = key0 <= q0 + wave * 32 + 31;
            const bool live = (key0 + 63 >= q0) || (kbw - kbt[key0 + 63 - s0] <= THR);
            if (vis && __builtin_amdgcn_readfirstlane((int)live)) {
                f32x16 p0, p1; attn_scores(p0, p1, cur, qf, lane);
#pragma unroll
                for (int g = 0; g < 4; ++g) {
                    const f32x4 b0 = *(const LAS f32x4*)(kbt + key0 - s0 + 8 * g + 4 * hi), b1 = *(const LAS f32x4*)(kbt + key0 - s0 + 32 + 8 * g + 4 * hi);
#pragma unroll
                    for (int e = 0; e < 4; ++e) { p0[4 * g + e] = p0[4 * g + e] * C2 + b0[e]; p1[4 * g + e] = p1[4 * g + e] * C2 + b1[e]; }
                }
                if (key0 + 63 > q0 + wave * 32) {
#pragma unroll
                    for (int r = 0; r < 16; ++r) { const int kv = key0 + crow(r, hi); if (kv > qrow) p0[r] = -INFINITY; if (kv + 32 > qrow) p1[r] = -INFINITY; }
                }
                attn_update(a, p0, p1, cur, lane);
            }
            if (t + 1 < nt) kv_store(kr, kvb + ((t + 1 - t_start) & 1) * KV_BUF_BYTES, tid);
            __syncthreads();
        }
        attn_store(a, obase + (size_t)qrow * opitch + h * 64, lane);
    }
}

constexpr int MR_KIMG = 32768, MR_VTP = 520, MR_VIMG = 64 * MR_VTP;
__device__ __forceinline__ void kv256_load(v4u (&rk)[4], v4u (&rv)[4], const bf16* Kp, size_t kpitch, const bf16* Vp, size_t vpitch, int tid) {
#pragma unroll
    for (int i = 0; i < 4; ++i) { const int piece = tid + 512 * i;
        rk[i] = *(const GAS v4u*)(Kp + (size_t)(piece >> 3) * kpitch + (piece & 7) * 8);
        rv[i] = *(const GAS v4u*)(Vp + (size_t)(piece >> 5) * vpitch + (piece & 31) * 8); }
}
__device__ __forceinline__ void kv256_store(const v4u (&rk)[4], const v4u (&rv)[4], LAS unsigned char* kimg, LAS unsigned char* vimg, int tid) {
#pragma unroll
    for (int i = 0; i < 4; ++i) { const int piece = tid + 512 * i;
        *(LAS v4u*)(kimg + ((piece & 7) * 256 + (piece >> 3)) * 16) = rk[i];
        LAS unsigned char* vp = vimg + (piece >> 5) * MR_VTP + (piece & 31) * 16;
        *(LAS u32x2*)vp = (u32x2){rv[i].x, rv[i].y}; *(LAS u32x2*)(vp + 8) = (u32x2){rv[i].z, rv[i].w}; }
}
__device__ __forceinline__ void memattn_phase(const InTab& in, unsigned char* ws, int L, LAS unsigned char* lds, int G, int tid, int wave, int lane) {
    const bf16* QM = (const bf16*)(ws + WS_BIG + B_QM); bf16* OM = (bf16*)(ws + WS_BIG + B_OM);
    const bf16* memK = (const bf16*)(ws + WS_MEMK) + (size_t)L * 256 * 256; const bf16* memVt = (const bf16*)(ws + WS_MEMK + 256 * 1024) + (size_t)L * 256 * 256;
    const float* qn = in.get(20) + (size_t)L * 64;
    LAS unsigned char* kvb = lds;
    const int r32 = lane & 31, hi = lane >> 5;
    for (int un = blockIdx.x; un < 256; un += G) {
        const int QB = un >> 2, hm = un & 3, qrow = QB * 256 + wave * 32 + r32;
        bf16x8 qf[4];
        {
            const bf16* qp = QM + (size_t)qrow * MEMW + hm * 64; float x[4][8]; float ss = 0.f;
#pragma unroll
            for (int ks = 0; ks < 4; ++ks) { const v4u w = *(const GAS v4u*)(qp + 16 * ks + 8 * hi); unpack8(w, x[ks]);
#pragma unroll
                for (int j = 0; j < 8; ++j) ss += x[ks][j] * x[ks][j]; }
            ss = sh32_sum(ss);
            const float r = rsqrtf(ss * (1.0f / 64.0f) + RMS_EPS);
#pragma unroll
            for (int ks = 0; ks < 4; ++ks) {
#pragma unroll
                for (int j = 0; j < 8; ++j) x[ks][j] = x[ks][j] * r * qn[16 * ks + 8 * hi + j];
                qf[ks] = __builtin_bit_cast(bf16x8, pack8(x[ks])); }
        }
        AttnAcc a; attn_init(a);
        const bf16* Kp = memK + hm * 64; const bf16* Vtp = memVt + (size_t)hm * 64 * 256;
        __syncthreads();
        { v4u rk[4], rv[4]; kv256_load(rk, rv, Kp, 256, Vtp, 256, tid); kv256_store(rk, rv, kvb, kvb + MR_KIMG, tid); }
        __syncthreads();
#pragma unroll 1
        for (int t = 0; t < 4; ++t) {
            f32x16 p0, p1; attn_scores<4096>(p0, p1, kvb + t * 64 * 16, qf, lane);
            attn_update<MR_VTP, 0>(a, p0, p1, kvb + MR_KIMG + t * 128, lane, C2);
        }
        attn_store(a, OM + (size_t)qrow * MEMW + hm * 64, lane);
    }
}

constexpr int MF_QP = 528;
__device__ __forceinline__ void memfused_phase(const InTab& in, unsigned char* ws, int L, const float* ssq, float* H, bf16* HBo, float* ssq_out, LAS unsigned char* lds, int G, int tid, int wave, int lane) {
    const bf16* HBi = (const bf16*)(ws + WS_HB);
    const bf16* Wq = (const bf16*)(ws + WS_W + (L ? W_MEMQ2 : W_MEMQ)); const bf16* Wo = (const bf16*)(ws + WS_W + (L ? W_MEMO2 : W_MEMO));
    const bf16* memK = (const bf16*)(ws + WS_MEMK) + (size_t)L * 256 * 256; const bf16* memVt = (const bf16*)(ws + WS_MEMK + 256 * 1024) + (size_t)L * 256 * 256;
    const float* qn = in.get(20) + (size_t)L * 64;
    LAS unsigned char* qs = lds; LAS unsigned char* os = lds + 64 * MF_QP; LAS float* xq = (LAS float*)(lds + 2 * 64 * MF_QP); LAS float* xs = xq + 512;
    const int r32 = lane & 31, hi = lane >> 5;
    for (int un = blockIdx.x; un < S / 64; un += G) {
        const int r0 = un * 64;
        f32x16 qa[2];
#pragma unroll
        for (int r = 0; r < 16; ++r) { qa[0][r] = 0.f; qa[1][r] = 0.f; }
        { const bf16* ap = Wq + (size_t)(32 * wave + r32) * DM + 8 * hi; const bf16* bp0 = HBi + (size_t)(r0 + r32) * DM + 8 * hi; const bf16* bp1 = bp0 + (size_t)32 * DM;
#pragma unroll 1
          for (int k8 = 0; k8 < 64; k8 += 8) {
              bf16x8 a[8], b0[8], b1[8];
#pragma unroll
              for (int j = 0; j < 8; ++j) { a[j] = *(const GAS bf16x8*)(ap + 16 * (k8 + j)); b0[j] = *(const GAS bf16x8*)(bp0 + 16 * (k8 + j)); b1[j] = *(const GAS bf16x8*)(bp1 + 16 * (k8 + j)); }
#pragma unroll
              for (int j = 0; j < 8; ++j) { qa[0] = __builtin_amdgcn_mfma_f32_32x32x16_bf16(a[j], b0[j], qa[0], 0, 0, 0); qa[1] = __builtin_amdgcn_mfma_f32_32x32x16_bf16(a[j], b1[j], qa[1], 0, 0, 0); } } }
        __syncthreads();
#pragma unroll
        for (int rt = 0; rt < 2; ++rt) { const float rr = pg8::row_rstd(ssq, r0 + 32 * rt + r32); float ss = 0.f;
#pragma unroll
            for (int r = 0; r < 16; ++r) { qa[rt][r] *= rr; ss += qa[rt][r] * qa[rt][r]; }
            ss = sh32_sum(ss);
            if (hi == 0) xq[wave * 64 + 32 * rt + r32] = ss; }
        __syncthreads();
#pragma unroll
        for (int rt = 0; rt < 2; ++rt) { const float tot = xq[wave * 64 + 32 * rt + r32] + xq[(wave ^ 1) * 64 + 32 * rt + r32];
            const float rh = rsqrtf(tot * (1.0f / 64.0f) + RMS_EPS);
            LAS unsigned char* qrow = qs + (32 * rt + r32) * MF_QP + (32 * wave) * 2;
#pragma unroll
            for (int g = 0; g < 4; ++g) { const int d = 32 * (wave & 1) + 8 * g + 4 * hi;
                u32x2 w; w.x = cvtpk(qa[rt][4 * g] * rh * qn[d], qa[rt][4 * g + 1] * rh * qn[d + 1]); w.y = cvtpk(qa[rt][4 * g + 2] * rh * qn[d + 2], qa[rt][4 * g + 3] * rh * qn[d + 3]);
                *(LAS u32x2*)(qrow + (8 * g + 4 * hi) * 2) = w; } }
        __syncthreads();
        { const int rt = wave & 1, hm = wave >> 1;
          bf16x8 qf[4];
#pragma unroll
          for (int ks = 0; ks < 4; ++ks) qf[ks] = *(const LAS bf16x8*)(qs + (32 * rt + r32) * MF_QP + (hm * 64 + 16 * ks + 8 * hi) * 2);
          AttnAcc a; attn_init(a);
          const bf16* kp = memK + hm * 64 + 8 * hi; const bf16* vp = memVt + (size_t)(hm * 64 + r32) * 256 + 4 * hi;
#pragma unroll 1
          for (int t = 0; t < 4; ++t) {
              f32x16 p0, p1;
#pragma unroll
              for (int r = 0; r < 16; ++r) { p0[r] = 0.f; p1[r] = 0.f; }
#pragma unroll
              for (int ks = 0; ks < 4; ++ks) { const bf16x8 k0 = *(const GAS bf16x8*)(kp + (size_t)(64 * t + r32) * 256 + 16 * ks), k1 = *(const GAS bf16x8*)(kp + (size_t)(64 * t + 32 + r32) * 256 + 16 * ks);
                  p0 = __builtin_amdgcn_mfma_f32_32x32x16_bf16(k0, qf[ks], p0, 0, 0, 0); p1 = __builtin_amdgcn_mfma_f32_32x32x16_bf16(k1, qf[ks], p1, 0, 0, 0); }
              float mx = fmaxf(p0[0], p1[0]);
#pragma unroll
              for (int r = 0; r < 16; ++r) { p0[r] *= C2; p1[r] *= C2; }
              mx = fmaxf(p0[0], p1[0]);
#pragma unroll
              for (int r = 1; r < 16; ++r) mx = fmaxf(mx, fmaxf(p0[r], p1[r]));
              mx = sh32_max(mx);
              const float mnew = fmaxf(a.m, mx); const float alpha = __builtin_amdgcn_exp2f(a.m - mnew); float sum = 0.f;
#pragma unroll
              for (int r = 0; r < 16; ++r) { p0[r] = __builtin_amdgcn_exp2f(p0[r] - mnew); p1[r] = __builtin_amdgcn_exp2f(p1[r] - mnew); sum += p0[r] + p1[r]; }
              a.l = a.l * alpha + sum; a.m = mnew;
#pragma unroll
              for (int r = 0; r < 16; ++r) { a.o0[r] *= alpha; a.o1[r] *= alpha; }
#pragma unroll
              for (int half = 0; half < 2; ++half)
#pragma unroll
                  for (int s2 = 0; s2 < 2; ++s2) { v4u pw;
                      if (half == 0) { pw.x = cvtpk(p0[8 * s2 + 0], p0[8 * s2 + 1]); pw.y = cvtpk(p0[8 * s2 + 2], p0[8 * s2 + 3]); pw.z = cvtpk(p0[8 * s2 + 4], p0[8 * s2 + 5]); pw.w = cvtpk(p0[8 * s2 + 6], p0[8 * s2 + 7]); }
                      else           { pw.x = cvtpk(p1[8 * s2 + 0], p1[8 * s2 + 1]); pw.y = cvtpk(p1[8 * s2 + 2], p1[8 * s2 + 3]); pw.z = cvtpk(p1[8 * s2 + 4], p1[8 * s2 + 5]); pw.w = cvtpk(p1[8 * s2 + 6], p1[8 * s2 + 7]); }
                      const bf16x8 pb = __builtin_bit_cast(bf16x8, pw);
                      const int key = 64 * t + 32 * half + 16 * s2;
#pragma unroll
                      for (int d0 = 0; d0 < 2; ++d0) { const u32x2 lo = *(const GAS u32x2*)(vp + (size_t)(32 * d0) * 256 + key), h2 = *(const GAS u32x2*)(vp + (size_t)(32 * d0) * 256 + key + 8);
                          const bf16x8 va = __builtin_bit_cast(bf16x8, (v4u){lo.x, lo.y, h2.x, h2.y});
                          if (d0 == 0) a.o0 = __builtin_amdgcn_mfma_f32_32x32x16_bf16(va, pb, a.o0, 0, 0, 0); else a.o1 = __builtin_amdgcn_mfma_f32_32x32x16_bf16(va, pb, a.o1, 0, 0, 0); } }
          }
          const float inv = 1.0f / sh32_sum(a.l);
          LAS unsigned char* orow = os + (32 * rt + r32) * MF_QP + (hm * 64) * 2;
#pragma unroll
          for (int g = 0; g < 4; ++g) { u32x2 w0, w1;
              w0.x = cvtpk(a.o0[4 * g] * inv, a.o0[4 * g + 1] * inv); w0.y = cvtpk(a.o0[4 * g + 2] * inv, a.o0[4 * g + 3] * inv);
              w1.x = cvtpk(a.o1[4 * g] * inv, a.o1[4 * g + 1] * inv); w1.y = cvtpk(a.o1[4 * g + 2] * inv, a.o1[4 * g + 3] * inv);
              *(LAS u32x2*)(orow + (8 * g + 4 * hi) * 2) = w0; *(LAS u32x2*)(orow + (32 + 8 * g + 4 * hi) * 2) = w1; } }
        __syncthreads();
        float rowsq[2];
#pragma unroll 1
        for (int rt = 0; rt < 2; ++rt) {
            f32x16 oc[4];
#pragma unroll
            for (int ct = 0; ct < 4; ++ct)
#pragma unroll
                for (int r = 0; r < 16; ++r) oc[ct][r] = 0.f;
            const bf16* ap = Wo + (size_t)(128 * wave + r32) * MEMW + 8 * hi;
#pragma unroll 4
            for (int ks = 0; ks < 16; ++ks) { const bf16x8 b = *(const LAS bf16x8*)(os + (32 * rt + r32) * MF_QP + (16 * ks + 8 * hi) * 2);
#pragma unroll
                for (int ct = 0; ct < 4; ++ct) { const bf16x8 a = *(const GAS bf16x8*)(ap + (size_t)(32 * ct) * MEMW + 16 * ks); oc[ct] = __builtin_amdgcn_mfma_f32_32x32x16_bf16(a, b, oc[ct], 0, 0, 0); } }
            const int row = r0 + 32 * rt + r32; float sq = 0.f;
#pragma unroll
            for (int ct = 0; ct < 4; ++ct)
#pragma unroll
                for (int g = 0; g < 4; ++g) { const int col = 128 * wave + 32 * ct + 8 * g + 4 * hi;
                    float* hp = H + (size_t)row * DM + col; f32x4 hv = *(const GAS f32x4*)hp;
                    hv[0] += oc[ct][4 * g]; hv[1] += oc[ct][4 * g + 1]; hv[2] += oc[ct][4 * g + 2]; hv[3] += oc[ct][4 * g + 3];
                    *(GAS f32x4*)hp = hv; sq += (hv[0] * hv[0] + hv[1] * hv[1]) + (hv[2] * hv[2] + hv[3] * hv[3]);
                    u32x2 w; w.x = cvtpk(hv[0], hv[1]); w.y = cvtpk(hv[2], hv[3]); *(GAS u32x2*)(HBo + (size_t)row * DM + col) = w; }
            rowsq[rt] = sh32_sum(sq);
        }
        if (hi == 0) { xs[wave * 64 + r32] = rowsq[0]; xs[wave * 64 + 32 + r32] = rowsq[1]; }
        __syncthreads();
        if (tid < 64) { float t2 = 0.f;
#pragma unroll
            for (int w8 = 0; w8 < 8; ++w8) t2 += xs[w8 * 64 + tid];
            float* sp = ssq_out + (size_t)(r0 + tid) * 16; *(GAS f32x4*)sp = (f32x4){t2, 0.f, 0.f, 0.f};
            *(GAS f32x4*)(sp + 4) = (f32x4){0.f, 0.f, 0.f, 0.f}; *(GAS f32x4*)(sp + 8) = (f32x4){0.f, 0.f, 0.f, 0.f}; *(GAS f32x4*)(sp + 12) = (f32x4){0.f, 0.f, 0.f, 0.f}; }
    }
}

constexpr size_t WS_MSEL = 7 * MiB;
constexpr size_t WS_MLSE = 8 * MiB;
constexpr size_t B_OP0 = 64 * MiB, B_OP1 = 128 * MiB;
__device__ __forceinline__ bool gate_better(float g1, int n1, float g2, int n2) { return g1 > g2 || (g1 == g2 && n1 < n2); }
__device__ __forceinline__ void moba_gate_phase(unsigned char* ws, int G, int wave, int lane) {
    const bf16* Q = (const bf16*)(ws + WS_BIG + B_PROJ); const float* ksum = (const float*)(ws + WS_KSUM); unsigned* selg = (unsigned*)(ws + WS_MSEL);
    const int r32 = lane & 31, hi = lane >> 5;
    const int NW = G * NWAVES;
    const int gwid = (int)blockIdx.x * NWAVES + wave;
    const int per_head = NW / 16;
    if (per_head == 0) return;
    const int h = gwid / per_head, wi = gwid % per_head;
    if (h >= 16) return;
    float af[2][32];
#pragma unroll
    for (int g = 0; g < 2; ++g)
#pragma unroll
        for (int kk = 0; kk < 32; ++kk) af[g][kk] = ksum[(size_t)(32 * g + r32) * 1024 + h * 64 + 2 * kk + hi] * (1.0f / 256.0f);
    for (int tile = wi; tile < S / 32; tile += per_head) {
        const int t = tile * 32 + r32, own = (tile * 32) >> 8;
        float bq[32];
        { const bf16* qp = Q + (size_t)t * DM + h * 64;
#pragma unroll
          for (int c = 0; c < 8; ++c) { const unsigned sh = hi ? 0u : 16u;   const v4u w = *(const GAS v4u*)(qp + 8 * c);
              bq[4 * c + 0] = __uint_as_float((w.x << sh) & 0xffff0000u); bq[4 * c + 1] = __uint_as_float((w.y << sh) & 0xffff0000u);
              bq[4 * c + 2] = __uint_as_float((w.z << sh) & 0xffff0000u); bq[4 * c + 3] = __uint_as_float((w.w << sh) & 0xffff0000u); } }
        float g0 = -INFINITY, g1 = -INFINITY, g2 = -INFINITY; int n0 = 255, n1 = 255, n2 = 255;
#pragma unroll
        for (int g = 0; g < 2; ++g) {
            if (32 * g < own) {
                f32x16 c;
#pragma unroll
                for (int r = 0; r < 16; ++r) c[r] = 0.f;
#pragma unroll
                for (int kk = 0; kk < 32; ++kk) c = __builtin_amdgcn_mfma_f32_32x32x2f32(af[g][kk], bq[kk], c, 0, 0, 0);
#pragma unroll
                for (int r = 0; r < 16; ++r) { const int n = 32 * g + crow(r, hi); const float gv = (n < own) ? c[r] : -INFINITY;
                    if (n < own) {
                        if (gate_better(gv, n, g0, n0)) { g2 = g1; n2 = n1; g1 = g0; n1 = n0; g0 = gv; n0 = n; }
                        else if (gate_better(gv, n, g1, n1)) { g2 = g1; n2 = n1; g1 = gv; n1 = n; }
                        else if (gate_better(gv, n, g2, n2)) { g2 = gv; n2 = n; } } }
            }
        }
        const float p0 = sh32_get(g0, lane), p1 = sh32_get(g1, lane), p2 = sh32_get(g2, lane);
        const int pn0 = __float_as_int(sh32_get(__int_as_float(n0), lane)), pn1 = __float_as_int(sh32_get(__int_as_float(n1), lane)), pn2 = __float_as_int(sh32_get(__int_as_float(n2), lane));
        float fg[3]; int fn[3]; int ia = 0, ib = 0;
#pragma unroll
        for (int k = 0; k < 3; ++k) {
            const float ga = (ia == 0) ? g0 : (ia == 1) ? g1 : (ia == 2) ? g2 : -INFINITY; const int na = (ia == 0) ? n0 : (ia == 1) ? n1 : (ia == 2) ? n2 : 255;
            const float gb = (ib == 0) ? p0 : (ib == 1) ? p1 : (ib == 2) ? p2 : -INFINITY; const int nb = (ib == 0) ? pn0 : (ib == 1) ? pn1 : (ib == 2) ? pn2 : 255;
            const bool ta = (na != 255) && (nb == 255 || gate_better(ga, na, gb, nb));
            if (ta) { fg[k] = ga; fn[k] = na; ++ia; } else { fg[k] = gb; fn[k] = nb; ++ib; }
        }
        (void)fg;
        if (hi == 0) selg[(size_t)h * S + t] = (unsigned)(fn[0] & 255) | ((unsigned)(fn[1] & 255) << 8) | ((unsigned)(fn[2] & 255) << 16);
    }
}
constexpr int CW_MOBAQ = 192;
__device__ __forceinline__ void moba_route_phase(unsigned char* ws, unsigned char* spare, LAS unsigned char* lds, int G, int tid, int wave, int lane, int qword, int notiles = 0) {
    const bf16* Q = (const bf16*)(ws + WS_BIG + B_PROJ); const bf16* Kb = Q + (size_t)S * DM; const bf16* Vt = (const bf16*)(ws + WS_BIG + B_VTM);
    const unsigned* selg = (const unsigned*)(ws + WS_MSEL); float* lse = (float*)(ws + WS_MLSE);
    unsigned* qctr = (unsigned*)(ws + WS_CTL) + qword;
    LAS unsigned char* kimg = lds; LAS unsigned char* vimg = lds + MR_KIMG;
    LAS int* list = (LAS int*)(lds + MR_KIMG + MR_VIMG);
    LAS int* wtot = list + 16384;
    LAS int* ubox = wtot + 256;
    const int r32 = lane & 31, hi = lane >> 5;
    const int NUNITS = 16 * 63;
    for (;;) {
        __syncthreads();
        if (tid == 0) ubox[0] = (int)atomicAdd(qctr, 1u);
        __syncthreads();
        const int u = ubox[0];
        if (u >= NUNITS) break;
        const int c = 0, rem = u;
        const int n = rem >> 4, h = rem & 15;
        const int tlo = 256 * (n + 1);
        v4u kst[4], vst[4];
        { const bf16* Kp = Kb + (size_t)(256 * n) * DM + h * 64; const bf16* Vp = Vt + (size_t)h * 64 * S + 256 * n;
#pragma unroll
          for (int i = 0; i < 4; ++i) { const int piece = tid + 512 * i;
              kst[i] = *(const GAS v4u*)(Kp + (size_t)(piece >> 3) * DM + (piece & 7) * 8);
              vst[i] = *(const GAS v4u*)(Vp + (size_t)(piece >> 5) * S + (piece & 31) * 8); } }
        int myent[32]; bool mysel[32];
        unsigned wsel[32];
#pragma unroll
        for (int i = 0; i < 32; ++i) wsel[i] = *(const GAS unsigned*)(selg + (size_t)h * S + 512 * i + tid);
#pragma unroll
        for (int i = 0; i < 32; ++i) { const int t = 512 * i + tid; mysel[i] = false; myent[i] = 0;
            { const unsigned w = wsel[i];
                const int slot = ((w & 255u) == (unsigned)n) ? 0 : (((w >> 8) & 255u) == (unsigned)n) ? 1 : (((w >> 16) & 255u) == (unsigned)n) ? 2 : -1;
                if (t >= tlo && slot >= 0) { mysel[i] = true; myent[i] = t | (slot << 16); } }
            const unsigned long long mk = __ballot(mysel[i]);
            if (lane == 0) wtot[i * 8 + wave] = __popcll(mk); }
        __syncthreads();
        int cnt = 0;
#pragma unroll
        for (int i = 0; i < 32; ++i) { int base = cnt;
#pragma unroll
            for (int w8 = 0; w8 < 8; ++w8) { const int v = wtot[i * 8 + w8]; if (w8 < wave) base += v; cnt += v; }
            const unsigned long long mk = __ballot(mysel[i]);
            if (mysel[i]) list[base + __popcll(mk & ((1ull << lane) - 1ull))] = myent[i]; }
#pragma unroll
        for (int i = 0; i < 4; ++i) { const int piece = tid + 512 * i;
            *(LAS v4u*)(kimg + ((piece & 7) * 256 + (piece >> 3)) * 16) = kst[i];
            LAS unsigned char* vp = vimg + (piece >> 5) * MR_VTP + (piece & 31) * 16;
            *(LAS u32x2*)vp = (u32x2){vst[i].x, vst[i].y}; *(LAS u32x2*)(vp + 8) = (u32x2){vst[i].z, vst[i].w}; }
        __syncthreads();
        if (cnt == 0 || notiles) continue;
        const int ntile = (cnt + 31) >> 5;
        for (int ti = wave; ti < ntile; ti += NWAVES) {
            const int e = ti * 32 + r32; const bool live = e < cnt;
            const int ent = list[live ? e : 0]; const int t = ent & 0xffff, slot = ent >> 16;
            bf16x8 qf[4]; load_q(qf, Q + (size_t)t * DM + h * 64, lane);
            AttnAcc a; attn_init(a);
#pragma unroll
            for (int j = 0; j < 4; ++j) {
                f32x16 p0, p1; attn_scores<4096>(p0, p1, kimg + j * 64 * 16, qf, lane);
                attn_update<MR_VTP, 0>(a, p0, p1, vimg + j * 128, lane, C2);
            }
            const float l = sh32_sum(a.l); const float inv = 1.0f / l;
            if (live) {
                bf16* orow = (bf16*)(slot == 0 ? ws + WS_BIG + B_OP0 : slot == 1 ? ws + WS_BIG + B_OP1 : spare) + ((size_t)t * 16 + h) * 64;
#pragma unroll
                for (int g = 0; g < 4; g += 2) {
#pragma unroll
                    for (int d0 = 0; d0 < 2; ++d0) {
                        u32x2 wa, wb;
                        if (d0 == 0) { wa.x = cvtpk(a.o0[4 * g] * inv, a.o0[4 * g + 1] * inv); wa.y = cvtpk(a.o0[4 * g + 2] * inv, a.o0[4 * g + 3] * inv);
                                       wb.x = cvtpk(a.o0[4 * g + 4] * inv, a.o0[4 * g + 5] * inv); wb.y = cvtpk(a.o0[4 * g + 6] * inv, a.o0[4 * g + 7] * inv); }
                        else         { wa.x = cvtpk(a.o1[4 * g] * inv, a.o1[4 * g + 1] * inv); wa.y = cvtpk(a.o1[4 * g + 2] * inv, a.o1[4 * g + 3] * inv);
                                       wb.x = cvtpk(a.o1[4 * g + 4] * inv, a.o1[4 * g + 5] * inv); wb.y = cvtpk(a.o1[4 * g + 6] * inv, a.o1[4 * g + 7] * inv); }
                        { auto rx = __builtin_amdgcn_permlane32_swap(wa.x, wb.x, false, false); wa.x = rx[0]; wb.x = rx[1]; }
                        { auto ry = __builtin_amdgcn_permlane32_swap(wa.y, wb.y, false, false); wa.y = ry[0]; wb.y = ry[1]; }
                        *(GAS v4u*)(orow + 32 * d0 + 8 * g + 8 * hi) = (v4u){wa.x, wa.y, wb.x, wb.y};
                    } }
                if (hi == 0) lse[((size_t)slot * S + t) * 16 + h] = a.m + __builtin_amdgcn_logf(l);
            }
        }
    }
}
__device__ __forceinline__ void moba_own_phase(unsigned char* ws, unsigned char* spare, LAS unsigned char* lds, int G, int tid, int wave, int lane, bf16* obase, size_t opitch) {
    bf16* Q = (bf16*)(ws + WS_BIG + B_PROJ); const bf16* Kb = Q + (size_t)S * DM; const bf16* Vt = (const bf16*)(ws + WS_BIG + B_VTM);
    const unsigned* selg = (const unsigned*)(ws + WS_MSEL); const float* lse = (const float*)(ws + WS_MLSE);
    LAS unsigned char* kvb = lds;
    const int r32 = lane & 31, hi = lane >> 5;
    LAS unsigned char* vimg = lds + MR_KIMG;
    v4u rk[4], rv[4];
    if ((int)blockIdx.x < 1024) { const int h0 = (int)blockIdx.x & 15, q00 = ((int)blockIdx.x >> 4) * 256; kv256_load(rk, rv, Kb + (size_t)q00 * DM + h0 * 64, DM, Vt + (size_t)h0 * 64 * S + q00, S, tid); }
    for (int un = blockIdx.x; un < 1024; un += G) {
        const int h = un & 15, QB = un >> 4, q0 = QB * 256, qrow = q0 + wave * 32 + r32;
        bf16x8 qf[4]; load_q(qf, Q + (size_t)qrow * DM + h * 64, lane);
        const unsigned sw = *(const GAS unsigned*)(selg + (size_t)h * S + qrow);
        float lraw[3];
#pragma unroll
        for (int j = 0; j < 3; ++j) lraw[j] = *(const GAS float*)(lse + ((size_t)j * S + qrow) * 16 + h);
        AttnAcc a; attn_init(a);
        __syncthreads();
        kv256_store(rk, rv, kvb, vimg, tid);
        __syncthreads();
        { const int un2 = un + G; if (un2 < 1024) { const int h2 = un2 & 15, q02 = (un2 >> 4) * 256; kv256_load(rk, rv, Kb + (size_t)q02 * DM + h2 * 64, DM, Vt + (size_t)h2 * 64 * S + q02, S, tid); } }
#pragma unroll 1
        for (int t = 0; t < 4; ++t) {
            const int key0 = q0 + t * 64;
            if (key0 <= q0 + wave * 32 + 31) {
                f32x16 p0, p1; attn_scores<4096>(p0, p1, kvb + t * 64 * 16, qf, lane);
#pragma unroll
                for (int r = 0; r < 16; ++r) { const int kv = key0 + crow(r, hi); p0[r] = (kv > qrow) ? -INFINITY : p0[r]; p1[r] = (kv + 32 > qrow) ? -INFINITY : p1[r]; }
                attn_update<MR_VTP, 0>(a, p0, p1, vimg + t * 128, lane, C2);
            }
        }
        u32x2 pw[3][4][2];
#pragma unroll
        for (int j = 0; j < 3; ++j) {
            const bf16* orow = (const bf16*)(j == 0 ? ws + WS_BIG + B_OP0 : j == 1 ? ws + WS_BIG + B_OP1 : spare) + ((size_t)qrow * 16 + h) * 64;
#pragma unroll
            for (int g = 0; g < 4; ++g) { pw[j][g][0] = *(const GAS u32x2*)(orow + 8 * g + 4 * hi); pw[j][g][1] = *(const GAS u32x2*)(orow + 32 + 8 * g + 4 * hi); }
        }
#pragma unroll
        for (int g = 0; g < 4; ++g) asm volatile("" : "+v"(pw[2][g][0].x), "+v"(pw[2][g][0].y), "+v"(pw[2][g][1].x), "+v"(pw[2][g][1].y));
        float L[3];
#pragma unroll
        for (int j = 0; j < 3; ++j) L[j] = (((sw >> (8 * j)) & 255u) != 255u) ? lraw[j] : -INFINITY;
        const float M = fmaxf(fmaxf(a.m, L[0]), fmaxf(L[1], L[2]));
        const float so = __builtin_amdgcn_exp2f(a.m - M);
        float W = sh32_sum(a.l) * so;
#pragma unroll
        for (int r = 0; r < 16; ++r) { a.o0[r] *= so; a.o1[r] *= so; }
#pragma unroll
        for (int j = 0; j < 3; ++j) {
            if (L[j] != -INFINITY) {
                const float wj = __builtin_amdgcn_exp2f(L[j] - M); W += wj;
#pragma unroll
                for (int g = 0; g < 4; ++g) { const u32x2 w0 = pw[j][g][0], w1 = pw[j][g][1];
                    a.o0[4 * g] += wj * bflo(w0.x); a.o0[4 * g + 1] += wj * bfhi(w0.x); a.o0[4 * g + 2] += wj * bflo(w0.y); a.o0[4 * g + 3] += wj * bfhi(w0.y);
                    a.o1[4 * g] += wj * bflo(w1.x); a.o1[4 * g + 1] += wj * bfhi(w1.x); a.o1[4 * g + 2] += wj * bflo(w1.y); a.o1[4 * g + 3] += wj * bfhi(w1.y); }
            }
        }
        const float inv = 1.0f / W;
        bf16* orow = obase + (size_t)qrow * opitch + h * 64;
#pragma unroll
        for (int g = 0; g < 4; ++g) { u32x2 w0, w1;
            w0.x = cvtpk(a.o0[4 * g] * inv, a.o0[4 * g + 1] * inv); w0.y = cvtpk(a.o0[4 * g + 2] * inv, a.o0[4 * g + 3] * inv);
            w1.x = cvtpk(a.o1[4 * g] * inv, a.o1[4 * g + 1] * inv); w1.y = cvtpk(a.o1[4 * g + 2] * inv, a.o1[4 * g + 3] * inv);
            *(GAS u32x2*)(orow + 8 * g + 4 * hi) = w0; *(GAS u32x2*)(orow + 32 + 8 * g + 4 * hi) = w1; }
    }
}

typedef float f32x4v __attribute__((ext_vector_type(4)));
__device__ __forceinline__ unsigned mono_key(float s) { if (s == 0.f) s = 0.f; const unsigned u = __float_as_uint(s); return (u & 0x80000000u) ? ~u : (u | 0x80000000u); }
__device__ __forceinline__ float unmono_f(unsigned u) { return __uint_as_float((u & 0x80000000u) ? (u ^ 0x80000000u) : ~u); }
constexpr int DS_CAP = 512;
__device__ __forceinline__ int wave_sum_dpp(int v) {
    v += __builtin_amdgcn_update_dpp(0, v, 0xB1, 0xF, 0xF, true); v += __builtin_amdgcn_update_dpp(0, v, 0x4E, 0xF, 0xF, true);
    v += __builtin_amdgcn_update_dpp(0, v, 0x141, 0xF, 0xF, true); v += __builtin_amdgcn_update_dpp(0, v, 0x140, 0xF, 0xF, true);
    v += __builtin_amdgcn_update_dpp(0, v, 0x142, 0xA, 0xF, false); v += __builtin_amdgcn_update_dpp(0, v, 0x143, 0xC, 0xF, false);
    return __builtin_amdgcn_readlane(v, 63); }
__device__ __forceinline__ unsigned wave_or(unsigned u) { int v = (int)u;
    v |= __builtin_amdgcn_update_dpp(0, v, 0xB1, 0xF, 0xF, true); v |= __builtin_amdgcn_update_dpp(0, v, 0x4E, 0xF, 0xF, true);
    v |= __builtin_amdgcn_update_dpp(0, v, 0x141, 0xF, 0xF, true); v |= __builtin_amdgcn_update_dpp(0, v, 0x140, 0xF, 0xF, true);
    v |= __builtin_amdgcn_update_dpp(0, v, 0x142, 0xA, 0xF, false); v |= __builtin_amdgcn_update_dpp(0, v, 0x143, 0xC, 0xF, false);
    return (unsigned)__builtin_amdgcn_readlane(v, 63); }
__device__ __forceinline__ float wave_sumf_dpp(float v) {
    v += __int_as_float(__builtin_amdgcn_update_dpp(0, __float_as_int(v), 0xB1, 0xF, 0xF, true)); v += __int_as_float(__builtin_amdgcn_update_dpp(0, __float_as_int(v), 0x4E, 0xF, 0xF, true));
    v += __int_as_float(__builtin_amdgcn_update_dpp(0, __float_as_int(v), 0x141, 0xF, 0xF, true)); v += __int_as_float(__builtin_amdgcn_update_dpp(0, __float_as_int(v), 0x140, 0xF, 0xF, true));
    v += __int_as_float(__builtin_amdgcn_update_dpp(0, __float_as_int(v), 0x142, 0xA, 0xF, false)); v += __int_as_float(__builtin_amdgcn_update_dpp(0, __float_as_int(v), 0x143, 0xC, 0xF, false));
    return __int_as_float(__builtin_amdgcn_readlane(__float_as_int(v), 63)); }
__device__ __forceinline__ unsigned wave_minu_dpp(unsigned u) { const int big = -1; int v = (int)u;
    v = (int)min((unsigned)v, (unsigned)__builtin_amdgcn_update_dpp(big, v, 0xB1, 0xF, 0xF, true)); v = (int)min((unsigned)v, (unsigned)__builtin_amdgcn_update_dpp(big, v, 0x4E, 0xF, 0xF, true));
    v = (int)min((unsigned)v, (unsigned)__builtin_amdgcn_update_dpp(big, v, 0x141, 0xF, 0xF, true)); v = (int)min((unsigned)v, (unsigned)__builtin_amdgcn_update_dpp(big, v, 0x140, 0xF, 0xF, true));
    v = (int)min((unsigned)v, (unsigned)__builtin_amdgcn_update_dpp(big, v, 0x142, 0xA, 0xF, false)); v = (int)min((unsigned)v, (unsigned)__builtin_amdgcn_update_dpp(big, v, 0x143, 0xC, 0xF, false));
    return (unsigned)__builtin_amdgcn_readlane(v, 63); }
template <bool EXACT>
__device__ __forceinline__ unsigned dsa_compact(LAS u32x2* ent, int n, int& nkeep, int lane) {
    unsigned k[8]; unsigned ix[8]; unsigned orv = 0u, nandv = 0u;
#pragma unroll
    for (int j = 0; j < 8; ++j) { const int e = lane + 64 * j; const bool in = e < n; const u32x2 v = ent[in ? e : 0]; const unsigned mk = mono_key(__uint_as_float(v.x)); k[j] = in ? mk : 0u; ix[j] = v.y; orv |= k[j]; nandv |= in ? ~mk : 0u; }
    unsigned T = 0u; int cntT = n; int bit0 = 31;
    bool found = false;
    if (!EXACT) {
        float fs = 0.f; unsigned kmin = 0xFFFFFFFFu;
#pragma unroll
        for (int j = 0; j < 8; ++j) { if (k[j] != 0u) { fs += unmono_f(k[j]); kmin = min(kmin, k[j]); } }
        const float sum = wave_sumf_dpp(fs); const float lo = unmono_f(wave_minu_dpp(kmin));
        const float mu = sum / (float)n - lo;
        if (mu > 0.f && mu < 3.0e38f) {
            const float xs[7] = {0.25f, 0.35f, 0.45f, 0.55f, 0.7f, 0.9f, 1.2f};
            unsigned tp[7]; int cl[7];
#pragma unroll
            for (int i = 0; i < 7; ++i) { tp[i] = (unsigned)__builtin_amdgcn_readfirstlane((int)mono_key(lo + mu * xs[i])); cl[i] = 0; }
#pragma unroll
            for (int j = 0; j < 8; ++j)
#pragma unroll
                for (int i = 0; i < 7; ++i) cl[i] += (k[j] >= tp[i]) ? 1 : 0;
            const int s0 = wave_sum_dpp(cl[0] | (cl[1] << 10) | (cl[2] << 20)), s1 = wave_sum_dpp(cl[3] | (cl[4] << 10) | (cl[5] << 20)), s2 = wave_sum_dpp(cl[6]);
            const int c7[7] = {s0 & 1023, (s0 >> 10) & 1023, (s0 >> 20) & 1023, s1 & 1023, (s1 >> 10) & 1023, (s1 >> 20) & 1023, s2};
#pragma unroll
            for (int i = 0; i < 7; ++i) if (c7[i] >= 256) { T = tp[i]; cntT = c7[i]; }
            found = (cntT >= 256) && (cntT <= 416) && (T != 0u);
            if (!found) { T = 0u; cntT = n; }
        }
    }
    if (!found) {
        const unsigned diff = (unsigned)__builtin_amdgcn_readfirstlane((int)(wave_or(orv) & wave_or(nandv)));
        if (diff != 0u) { bit0 = 31 - __builtin_clz(diff); const unsigned anyk = (unsigned)__builtin_amdgcn_readfirstlane((int)k[0]);
            T = (bit0 == 31) ? 0u : (anyk & ~((2u << bit0) - 1u)); }
    }
    if (!found)
    for (int bit = bit0; bit >= 0; --bit) {
        const unsigned cand = T | (1u << bit); int cl = 0;
#pragma unroll
        for (int j = 0; j < 8; ++j) cl += (k[j] >= cand) ? 1 : 0;
        const int c = wave_sum_dpp(cl);
        if (c >= 256) { T = cand; cntT = c; if (!EXACT && c <= 320) break; }
    }
    int Jstar = 0x10000;
    if (!found && cntT > (EXACT ? 256 : 320)) {
        int gl = 0;
#pragma unroll
        for (int j = 0; j < 8; ++j) gl += (k[j] > T) ? 1 : 0;
        const int gt = wave_sum_dpp(gl);
        const int need = 256 - gt; int Jm = 0;
        for (int bit = 14; bit >= 0; --bit) { const int cand = Jm | (1 << bit); int cl = 0;
#pragma unroll
            for (int j = 0; j < 8; ++j) cl += (k[j] == T && (int)ix[j] < cand) ? 1 : 0;
            if (wave_sum_dpp(cl) < need) Jm = cand; }
        Jstar = Jm + 1;
    }
    int base = 0;
    const unsigned long long lt = (1ull << lane) - 1ull;
#pragma unroll
    for (int j = 0; j < 8; ++j) { const bool pred = (k[j] > T) || (k[j] == T && T != 0u && (int)ix[j] < Jstar);
        const unsigned long long mask = __builtin_amdgcn_ballot_w64(pred); const int pos = base + __popcll(mask & lt);
        if (pred) ent[pos] = (u32x2){__float_as_uint(unmono_f(k[j])), ix[j]};
        base += __popcll(mask); }
    nkeep = base;
    return T;
}
#define DSA_HEADSUM(s, msk, P, B, W, tf) asm("v_max_f32_e32 %1, 0, %3\n\tv_mul_f32_e32 %0, %11, %1\n\tv_max_f32_e32 %1, 0, %4\n\tv_fmac_f32_e32 %0, %12, %1\n\tv_max_f32_e32 %1, 0, %5\n\tv_fmac_f32_e32 %0, %13, %1\n\t" \
        "v_max_f32_e32 %1, 0, %6\n\tv_fmac_f32_e32 %0, %14, %1\n\tv_max_f32_e32 %1, 0, %7\n\tv_fmac_f32_e32 %0, %15, %1\n\tv_max_f32_e32 %1, 0, %8\n\tv_fmac_f32_e32 %0, %16, %1\n\t" \
        "v_max_f32_e32 %1, 0, %9\n\tv_fmac_f32_e32 %0, %17, %1\n\tv_max_f32_e32 %1, 0, %10\n\tv_fmac_f32_e32 %0, %18, %1\n\tv_cmp_ge_f32_e64 %2, %0, %19" \
        : "=&v"(s), "=&v"(tmp_), "=s"(msk) : "v"(P[B + 0]), "v"(P[B + 1]), "v"(P[B + 2]), "v"(P[B + 3]), "v"(P[B + 4]), "v"(P[B + 5]), "v"(P[B + 6]), "v"(P[B + 7]), \
          "v"(W[0]), "v"(W[1]), "v"(W[2]), "v"(W[3]), "v"(W[4]), "v"(W[5]), "v"(W[6]), "v"(W[7]), "v"(tf))
struct DsaState { float tf0, tf1; int cnt0, cnt1; unsigned long long need; };
template <bool NOCOMPACT = false, bool NOINSERT = false>
__device__ __forceinline__ void dsa_tile(const bf16x8 (&af)[4], const bf16x8 (&bc)[4], const float (&w0)[8], const float (&w1)[8], int key0, int q0t, int q1t, bool lastt, DsaState& st,
                                         LAS u32x2* ents, int lane) {
    const int r32 = lane & 31, hi = lane >> 5;
if (st.need) {
#pragma unroll 1
        for (int hh = 0; hh < 2; ++hh) {
            const int c0 = __builtin_amdgcn_readlane(st.cnt0, 0), c0b = __builtin_amdgcn_readlane(st.cnt0, 32);
            const int c1 = __builtin_amdgcn_readlane(st.cnt1, 0), c1b = __builtin_amdgcn_readlane(st.cnt1, 32);
            const int n0 = hh ? c0b : c0, n1 = hh ? c1b : c1;
            if (NOCOMPACT) { if (n0 > DS_CAP - 32 && hi == hh) st.cnt0 = 256; if (n1 > DS_CAP - 32 && hi == hh) st.cnt1 = 256; continue; }
            if (n0 > DS_CAP - 32) { int nk; const unsigned T = dsa_compact<false>(ents + hh * DS_CAP, n0, nk, lane); if (hi == hh) { st.tf0 = unmono_f(T + 1u); st.cnt0 = nk; } }
            if (n1 > DS_CAP - 32) { int nk; const unsigned T = dsa_compact<false>(ents + (2 + hh) * DS_CAP, n1, nk, lane); if (hi == hh) { st.tf1 = unmono_f(T + 1u); st.cnt1 = nk; } }
        }
    }
    f32x16 p;
#pragma unroll
    for (int r = 0; r < 16; ++r) p[r] = 0.f;
#pragma unroll
    for (int ks = 0; ks < 4; ++ks) p = __builtin_amdgcn_mfma_f32_32x32x16_bf16(af[ks], bc[ks], p, 0, 0, 0);
    asm volatile("s_nop 15\n\ts_nop 7" : "+v"(p));
    float s0, s1, tmp_; unsigned long long m0, m1;
    DSA_HEADSUM(s0, m0, p, 0, w0, st.tf0); DSA_HEADSUM(s1, m1, p, 8, w1, st.tf1);
    const int key = key0 + r32;
    if (lastt) { m0 &= __builtin_amdgcn_ballot_w64(key <= q0t); m1 &= __builtin_amdgcn_ballot_w64(key <= q1t); }
    if (NOINSERT) { st.cnt0 ^= (int)__popcll(m0 ^ m1); return; }
    {
        const bool pr0 = __builtin_amdgcn_inverse_ballot_w64(m0), pr1 = __builtin_amdgcn_inverse_ballot_w64(m1);
        const unsigned h0 = hi ? (unsigned)(m0 >> 32) : (unsigned)m0, h1 = hi ? (unsigned)(m1 >> 32) : (unsigned)m1;
        const unsigned lowmask = (1u << r32) - 1u;
        if (pr0) ents[hi * DS_CAP + st.cnt0 + __popc(h0 & lowmask)] = (u32x2){__float_as_uint(s0), (unsigned)key};
        if (pr1) ents[(2 + hi) * DS_CAP + st.cnt1 + __popc(h1 & lowmask)] = (u32x2){__float_as_uint(s1), (unsigned)key};
        st.cnt0 += __popc(h0); st.cnt1 += __popc(h1);
        st.need = __builtin_amdgcn_ballot_w64(max(st.cnt0, st.cnt1) > DS_CAP - 32);
    }
}
template <bool NOCOMPACT = false, bool NOINSERT = false, bool HALFLD = false>
__device__ __forceinline__ void dsa_select_phase(unsigned char* ws, LAS unsigned char* lds, int G, int tid, int wave, int lane, int jm = -1) {
    const bf16* proj = (const bf16*)(ws + WS_BIG + B_PROJ); const bf16* IKc = (const bf16*)(ws + WS_BIG + B_IKC); const float* IW = (const float*)(ws + WS_IW);
    unsigned short* selg = (unsigned short*)(ws + WS_BIG + B_SEL);
    LAS u32x2* ents = (LAS u32x2*)lds + wave * 4 * DS_CAP;
    const int r32 = lane & 31, hi = lane >> 5;
    const int NWG = G * NWAVES, gw = (int)blockIdx.x * NWAVES + wave;
    for (int pu = gw; pu < 2048; pu += NWG) {
        for (int uu = 0; uu < 2; ++uu) {
            const int unit = uu ? 4095 - pu : pu, tw = unit * 4;
            bf16x8 af[4];
            { const int i = r32, qi = 2 * (i >> 4) + ((i >> 2) & 1), hd = 4 * ((i >> 3) & 1) + (i & 3);
              const bf16* ap = proj + (size_t)(tw + qi) * EVEN_NP + EC_IQ + hd * 64 + 8 * hi;
#pragma unroll
              for (int ks = 0; ks < 4; ++ks) af[ks] = *(const GAS bf16x8*)(ap + 16 * ks); }
            float w0[8], w1[8];
            { const f32x4 a = *(const GAS f32x4*)(IW + (size_t)(tw + hi) * 8), b = *(const GAS f32x4*)(IW + (size_t)(tw + hi) * 8 + 4);
              const f32x4 c = *(const GAS f32x4*)(IW + (size_t)(tw + 2 + hi) * 8), d = *(const GAS f32x4*)(IW + (size_t)(tw + 2 + hi) * 8 + 4);
#pragma unroll
              for (int j = 0; j < 4; ++j) { w0[j] = a[j]; w0[4 + j] = b[j]; w1[j] = c[j]; w1[4 + j] = d[j]; } }
            const int q0t = tw + hi, q1t = tw + 2 + hi;
            DsaState st; st.tf0 = -INFINITY; st.tf1 = -INFINITY; st.cnt0 = 0; st.cnt1 = 0; st.need = 0ull;
            const int ntile = ((tw + 3) >> 5) + 1;
            const bf16* kp = IKc + (size_t)lane * 8; asm volatile("" : "+v"(kp));
            bf16x8 bA[4], bB[4], bC[4];
#define DSA_LOADB(dst, jj) do { const bf16* p_ = kp + (size_t)((jj) & jm) * 2048; \
                if (HALFLD) { asm volatile("global_load_dwordx4 %0, %2, off\n\tglobal_load_dwordx4 %1, %2, off offset:1024" : "=&v"(dst[0]), "=&v"(dst[1]) : "v"(p_) : "memory"); } else \
                asm volatile("global_load_dwordx4 %0, %4, off\n\tglobal_load_dwordx4 %1, %4, off offset:1024\n\tglobal_load_dwordx4 %2, %4, off offset:2048\n\tglobal_load_dwordx4 %3, %4, off offset:3072" \
                             : "=&v"(dst[0]), "=&v"(dst[1]), "=&v"(dst[2]), "=&v"(dst[3]) : "v"(p_) : "memory"); } while (0)
#define DSA_WAITB(dst, n) do { if (HALFLD) { if ((n) == 0) asm volatile("s_waitcnt vmcnt(0)" : "+v"(dst[0]), "+v"(dst[1]) :: "memory"); else asm volatile("s_waitcnt vmcnt(4)" : "+v"(dst[0]), "+v"(dst[1]) :: "memory"); dst[2] = dst[0]; dst[3] = dst[1]; } else asm volatile("s_waitcnt vmcnt(" #n ")" : "+v"(dst[0]), "+v"(dst[1]), "+v"(dst[2]), "+v"(dst[3]) :: "memory"); } while (0)
            asm volatile("" : "+v"(af[0]), "+v"(af[1]), "+v"(af[2]), "+v"(af[3]));
#pragma unroll
            for (int r = 0; r < 8; ++r) asm volatile("" : "+v"(w0[r]), "+v"(w1[r]));
            DSA_LOADB(bA, 0); DSA_LOADB(bB, min(1, ntile - 1));
#pragma unroll 1
            for (int j = 0; j < ntile; j += 3) {
                DSA_LOADB(bC, min(j + 2, ntile - 1));
                DSA_WAITB(bA, 8);
                dsa_tile<NOCOMPACT, NOINSERT>(af, bA, w0, w1, 32 * j, q0t, q1t, j == ntile - 1, st, ents, lane);
                DSA_LOADB(bA, min(j + 3, ntile - 1));
                DSA_WAITB(bB, 8);
                if (j + 1 < ntile) dsa_tile<NOCOMPACT, NOINSERT>(af, bB, w0, w1, 32 * (j + 1), q0t, q1t, j + 1 == ntile - 1, st, ents, lane);
                DSA_LOADB(bB, min(j + 4, ntile - 1));
                DSA_WAITB(bC, 8);
                if (j + 2 < ntile) dsa_tile<NOCOMPACT, NOINSERT>(af, bC, w0, w1, 32 * (j + 2), q0t, q1t, j + 2 == ntile - 1, st, ents, lane);
            }
            DSA_WAITB(bA, 0);
#undef DSA_LOADB
#undef DSA_WAITB
            const int cnt0 = st.cnt0, cnt1 = st.cnt1;
#pragma unroll 1
            for (int qq = 0; qq < 4; ++qq) {
                const int hh = qq & 1, sl = qq >> 1;
                int n = sl ? __builtin_amdgcn_readlane(cnt1, 32 * hh) : __builtin_amdgcn_readlane(cnt0, 32 * hh);
                LAS u32x2* ee = ents + qq * DS_CAP;
                if (n > 256) { int nk = 256; if (!NOCOMPACT) (void)dsa_compact<true>(ee, n, nk, lane); n = 256; }
                unsigned short* row = selg + (size_t)(tw + qq) * 256;
#pragma unroll
                for (int e4 = 0; e4 < 4; ++e4) { const int e = lane + 64 * e4; row[e] = (e < n) ? (unsigned short)ee[e].y : (unsigned short)0u; }
            }
        }
    }
}

typedef __bf16 bf16x2v __attribute__((ext_vector_type(2)));
__device__ __forceinline__ float dot2bf(unsigned a, unsigned b, float acc) { return __builtin_amdgcn_fdot2_f32_bf16(__builtin_bit_cast(bf16x2v, a), __builtin_bit_cast(bf16x2v, b), acc, false); }
__device__ __forceinline__ float dsa_kscale(const InTab& in, int lane) { const float g = wave_max(fabsf(in.get(11)[lane])); return 127.0f / (8.2f * g); }
__device__ __forceinline__ void dsa_quant_phase(const InTab& in, unsigned char* ws, unsigned char* spare, int G, int wave, int lane) {
    const bf16* proj = (const bf16*)(ws + WS_BIG + B_PROJ);
    const float SK = dsa_kscale(in, lane);
    const float SV = 127.0f / fmaxf(__uint_as_float(((const unsigned*)(ws + WS_CTL))[CW_VMAX + (lane >> 3)]), 1e-20f);
    for (int u = blockIdx.x; u < S / 64; u += G) {
        const int tw0 = u * 64 + wave * 8;
        const bf16* pr = proj + (size_t)tw0 * EVEN_NP + lane * 8; unsigned char* dst = spare + (size_t)tw0 * 1024 + lane * 16;
        v4u kr[8], vr[8];
#pragma unroll
        for (int i = 0; i < 8; ++i) { kr[i] = *(const GAS v4u*)(pr + (size_t)i * EVEN_NP + EC_DK); vr[i] = *(const GAS v4u*)(pr + (size_t)i * EVEN_NP + EC_DV); }
#pragma unroll
        for (int i = 0; i < 8; ++i) { float a[8], b[8]; unpack8(kr[i], a); unpack8(vr[i], b); v4u o;
#pragma unroll
            for (int j = 0; j < 8; ++j) { a[j] = fminf(fmaxf(a[j] * SK, -127.f), 127.f); b[j] = fminf(fmaxf(b[j] * SV, -127.f), 127.f); }
            o.x = q8pack4(a[0], a[1], a[2], a[3]); o.y = q8pack4(a[4], a[5], a[6], a[7]); o.z = q8pack4(b[0], b[1], b[2], b[3]); o.w = q8pack4(b[4], b[5], b[6], b[7]);
            *(GAS v4u*)(dst + (size_t)i * 1024) = o; }
    }
}
#define SP_IDXA(A, i) (((i) & 1) ? (A[(i) >> 3][((i) >> 1) & 3] >> 16) : (A[(i) >> 3][((i) >> 1) & 3] & 0xffffu))
__device__ __forceinline__ void dsa_sparse_phase(const InTab& in, unsigned char* ws, const unsigned char* spare, int G, int wave, int lane, bf16* obase, size_t opitch) {
    const bf16* proj = (const bf16*)(ws + WS_BIG + B_PROJ); const unsigned short* selg = (const unsigned short*)(ws + WS_BIG + B_SEL);
    const int h = (int)blockIdx.x & 7, wg = (int)blockIdx.x >> 3, nwg = G >> 3;
    const int kg = lane >> 3, ds8 = (lane & 7) * 8;
    const unsigned char* kvu = spare + h * 128;
    const unsigned lpart = (unsigned)(lane & 7) * 16u;
    const float SK = dsa_kscale(in, lane);
    const float vmaxh = fmaxf(__uint_as_float(((const unsigned*)(ws + WS_CTL))[CW_VMAX + h]), 1e-20f);
    const int stride = nwg * NWAVES;
    int t = wg * NWAVES + wave;
    if (t >= S) return;
    v4u iw[4], qw;
#pragma unroll
    for (int c = 0; c < 4; ++c) iw[c] = *(const GAS v4u*)(selg + (size_t)t * 256 + 32 * kg + 8 * c);
    qw = *(const GAS v4u*)(proj + (size_t)t * EVEN_NP + EC_DQ + h * 64 + ds8);
    v4u ka[8], kb[8];
#define SP_LOAD(A, dst, i0) _Pragma("unroll") for (int j = 0; j < 8; ++j) { const unsigned off = (SP_IDXA(A, (i0) + j) << 10) + lpart; dst[j] = *(const GAS v4u*)(kvu + off); }
#define SP_QK(src, i0) _Pragma("unroll") for (int j = 0; j < 8; ++j) { \
            int d = __builtin_amdgcn_sdot4((int)q0, (int)src[j].x, 0, false); d = __builtin_amdgcn_sdot4((int)q1, (int)src[j].y, d, false); \
            d += shx_i<1>(d); d += shx_i<2>(d); d += dpp_hmirror_i(d); sc[(i0) + j] = (float)d * qsc; vw[(i0) + j] = (u32x2){src[j].z, src[j].w}; }
    SP_LOAD(iw, ka, 0); SP_LOAD(iw, kb, 8);
#pragma unroll 1
    for (; t < S; t += stride) {
        unsigned q0, q1; float qsc;
        { float qv[8]; unpack8(qw, qv); float qm = 0.f;
#pragma unroll
          for (int j = 0; j < 8; ++j) qm = fmaxf(qm, fabsf(qv[j]));
          qm = fmaxf(qm, shx<1>(qm)); qm = fmaxf(qm, shx<2>(qm)); qm = fmaxf(qm, __int_as_float(dpp_hmirror_i(__float_as_int(qm)))); qm = fmaxf(qm, 1e-20f);
          const float sq = 127.0f / qm;
          q0 = q8pack4(qv[0] * sq, qv[1] * sq, qv[2] * sq, qv[3] * sq); q1 = q8pack4(qv[4] * sq, qv[5] * sq, qv[6] * sq, qv[7] * sq);
          qsc = C2 / (sq * SK); }
        float sc[32]; u32x2 vw[32];
        SP_QK(ka, 0);  SP_LOAD(iw, ka, 16);
        SP_QK(kb, 8);  SP_LOAD(iw, kb, 24);
        { const int tn = (t + stride < S) ? t + stride : t;
#pragma unroll
          for (int c = 0; c < 4; ++c) iw[c] = *(const GAS v4u*)(selg + (size_t)tn * 256 + 32 * kg + 8 * c);
          qw = *(const GAS v4u*)(proj + (size_t)tn * EVEN_NP + EC_DQ + h * 64 + ds8); }
        SP_QK(ka, 16);
        SP_QK(kb, 24);
        if (t < 255) {
#pragma unroll
            for (int i = 0; i < 32; ++i) if (32 * kg + i > t) sc[i] = -INFINITY;
        }
        float mx = sc[0];
#pragma unroll
        for (int i = 1; i < 32; ++i) mx = fmaxf(mx, sc[i]);
        mx = fmaxf(mx, shx<8>(mx)); mx = fmaxf(mx, shx<16>(mx)); mx = sh32_max(mx);
        mx -= 6.988684686772166f;
        SP_LOAD(iw, ka, 0);
        int acc[8]; unsigned lsum = 0u;
#pragma unroll
        for (int e = 0; e < 8; ++e) acc[e] = 0;
#pragma unroll
        for (int i = 0; i < 32; i += 4) {
            if (i == 16) { SP_LOAD(iw, kb, 8); }
            unsigned pw = __builtin_amdgcn_cvt_pk_u8_f32(__builtin_amdgcn_exp2f(sc[i] - mx), 0u, 0u);
            pw = __builtin_amdgcn_cvt_pk_u8_f32(__builtin_amdgcn_exp2f(sc[i + 1] - mx), 1u, pw);
            pw = __builtin_amdgcn_cvt_pk_u8_f32(__builtin_amdgcn_exp2f(sc[i + 2] - mx), 2u, pw);
            pw = __builtin_amdgcn_cvt_pk_u8_f32(__builtin_amdgcn_exp2f(sc[i + 3] - mx), 3u, pw);
            lsum = __builtin_amdgcn_udot4(pw, 0x01010101u, lsum, false);
#pragma unroll
            for (int hw = 0; hw < 2; ++hw) {
                const unsigned A = hw ? vw[i].y : vw[i].x, B = hw ? vw[i + 1].y : vw[i + 1].x, C = hw ? vw[i + 2].y : vw[i + 2].x, D = hw ? vw[i + 3].y : vw[i + 3].x;
                const unsigned ablo = __builtin_amdgcn_perm(B, A, 0x05010400u), abhi = __builtin_amdgcn_perm(B, A, 0x07030602u);
                const unsigned cdlo = __builtin_amdgcn_perm(D, C, 0x05010400u), cdhi = __builtin_amdgcn_perm(D, C, 0x07030602u);
                const unsigned t0_ = __builtin_amdgcn_perm(cdlo, ablo, 0x05040100u), t1_ = __builtin_amdgcn_perm(cdlo, ablo, 0x07060302u);
                const unsigned t2_ = __builtin_amdgcn_perm(cdhi, abhi, 0x05040100u), t3_ = __builtin_amdgcn_perm(cdhi, abhi, 0x07060302u);
                acc[4 * hw + 0] = __builtin_amdgcn_sdot4((int)pw, (int)t0_, acc[4 * hw + 0], false); acc[4 * hw + 1] = __builtin_amdgcn_sdot4((int)pw, (int)t1_, acc[4 * hw + 1], false);
                acc[4 * hw + 2] = __builtin_amdgcn_sdot4((int)pw, (int)t2_, acc[4 * hw + 2], false); acc[4 * hw + 3] = __builtin_amdgcn_sdot4((int)pw, (int)t3_, acc[4 * hw + 3], false);
            }
        }
        int ls = (int)lsum; ls += shx_i<8>(ls); ls += shx_i<16>(ls); { auto r = __builtin_amdgcn_permlane32_swap((unsigned)ls, (unsigned)ls, false, false); ls = (int)r[0] + (int)r[1]; }
        const float inv = (vmaxh * (1.0f / 127.0f)) / (float)ls;
        float o[8];
#pragma unroll
        for (int e = 0; e < 8; ++e) { int a = acc[e]; a += shx_i<8>(a); a += shx_i<16>(a); { auto r = __builtin_amdgcn_permlane32_swap((unsigned)a, (unsigned)a, false, false); a = (int)r[0] + (int)r[1]; } o[e] = (float)a * inv; }
        if (kg == 0) *(GAS v4u*)(obase + (size_t)t * opitch + h * 64 + ds8) = pack8(o);
    }
#undef SP_LOAD
#undef SP_QK
}
#undef SP_IDXA

struct Args { InPtrs in; float* out; unsigned char* ws; int ph_lo, ph_hi, li, pad; };
constexpr int PH_PER_LAYER = 13, N_PHASES = 1 + 2 * PH_PER_LAYER;

__global__ void __launch_bounds__(NTHREADS, 2) hyb_fwd(Args args) {
    extern __shared__ __attribute__((aligned(16))) unsigned char lds_raw[];
    LAS unsigned char* lds = (LAS unsigned char*)lds_raw;
    volatile LAS unsigned* MISC = (volatile LAS unsigned*)(lds + MISC_OFF);
    const int tid = threadIdx.x, lane = tid & 63, wave = __builtin_amdgcn_readfirstlane(tid >> 6);
    const int G = gridDim.x;
    const int vcu = (G % 8 == 0) ? ((int)blockIdx.x % 8) * (G / 8) + (int)blockIdx.x / 8 : (int)blockIdx.x;
    unsigned char* ws = args.ws;
    gu32* ctl = (gu32*)(ws + WS_CTL);
    for (int u = tid; u < (LDS_BYTES - LDSCTL_OFF) / 4; u += NTHREADS) ((LAS unsigned*)(lds + LDSCTL_OFF))[u] = 0u;
    __syncthreads();
    if (tid == 0) {
#pragma unroll
        for (int i = 0; i < 26; ++i) *(LAS unsigned long long*)(lds + INTAB_OFF + 8 * i) = (unsigned long long)args.in.p[i]; }
    __syncthreads();
    XcdBarrier bar = xcd_barrier_post((unsigned*)(ctl + CW_BAR) + args.li * XCD_BAR_WORDS, MISC + 8);
    const int tid0 = tid; unsigned char* const ws0 = ws;
    for (int ph = args.ph_lo; ph < args.ph_hi; ++ph) {
        int tid = tid0; asm volatile("" : "+v"(tid));
        unsigned char* ws = ws0; asm volatile("" : "+s"(ws));
        const int lane = tid & 63, wave = __builtin_amdgcn_readfirstlane(tid >> 6);
        LAS unsigned char* lds = (LAS unsigned char*)lds_raw; { unsigned lo_ = (unsigned)(uintptr_t)lds; asm volatile("" : "+s"(lo_)); lds = (LAS unsigned char*)(uintptr_t)lo_; }
        InTab inl; inl.ldsbase = lds;
        float* ssqA = (float*)(ws + WS_SSQ);
        bf16* HB = (bf16*)(ws + WS_HB);
        unsigned char* spare = (unsigned char*)args.out;
        unsigned char* Wr = ws + WS_W;
        unsigned char* BIG = ws + WS_BIG;
        const int gw = vcu * NWAVES + wave, NGW = G * NWAVES;
        if (ph == 0) {
#ifdef PROBE_P02
            conv_weights(inl, ws, 0, 1 | 2 | 4, lds, gw, NGW, wave, lane);
            conv_q8_weights(inl, ws, 0, 1, lds, (int)blockIdx.x, G, wave, lane);
            copy_x(inl.get(0), spare + 32 * MiB, (float*)(spare + 48 * MiB), HB, ssqA, gw, NGW, lane);
            rope_tables((float*)(ws + WS_ROPE), (float*)(ws + WS_ROPE) + S * 8, (int)blockIdx.x * NTHREADS + tid, G * NTHREADS);
            __syncthreads();
            for (int un = blockIdx.x; un < 256; un += G) mem_kv(inl, ws, lds, un, tid, wave, lane);
            for (int idx = (int)blockIdx.x * NTHREADS + tid; idx < 1024 * 16; idx += G * NTHREADS) {
                const int k = idx >> 4, col = idx & 15;
                const float v = inl.get(5)[k] * inl.get(6)[(size_t)k * EVEN_SRC + (col < 8 ? ES_FL + col : ES_IW + col - 8)];
                const int ln = (k & 255) >> 2, e = k & 3, q = k >> 8, c = col >> 2;
                ((float*)(ws + WS_TW))[((((q * 4 + e) * 4 + c) * 64 + ln) << 2) + (col & 3)] = v; }
            __syncthreads();
#endif
#ifndef NO_P0
            conv_weights(inl, ws, 0, 1 | 2 | 4, lds, gw, NGW, wave, lane);
            conv_q8_weights(inl, ws, 0, 1, lds, (int)blockIdx.x, G, wave, lane);
            copy_x(inl.get(0), spare + 32 * MiB, (float*)(spare + 48 * MiB), HB, ssqA, gw, NGW, lane);
            if (blockIdx.x == 0 && tid < 384) { const int gi = tid >> 6, d = tid & 63;
                float v;
                if (gi == 0) v = inl.get(8)[d]; else if (gi == 1) v = inl.get(10)[d]; else if (gi == 2) v = inl.get(9)[d]; else if (gi == 3) v = inl.get(11)[d]; else if (gi == 4) v = inl.get(13)[d]; else v = inl.get(14)[d];
                ((float*)(ws + WS_GT))[tid] = v; }
            rope_tables((float*)(ws + WS_ROPE), (float*)(ws + WS_ROPE) + S * 8, (int)blockIdx.x * NTHREADS + tid, G * NTHREADS);
            __syncthreads();
            for (int un = blockIdx.x; un < 256; un += G) mem_kv(inl, ws, lds, un, tid, wave, lane);
            for (int idx = (int)blockIdx.x * NTHREADS + tid; idx < 1024 * 16; idx += G * NTHREADS) {
                const int k = idx >> 4, col = idx & 15;
                const float v = inl.get(5)[k] * inl.get(6)[(size_t)k * EVEN_SRC + (col < 8 ? ES_FL + col : ES_IW + col - 8)];
                const int ln = (k & 255) >> 2, e = k & 3, q = k >> 8, c = col >> 2;
                ((float*)(ws + WS_TW))[((((q * 4 + e) * 4 + c) * 64 + ln) << 2) + (col & 3)] = v; }
#endif
        } else {
            const int L = (ph - 1) / PH_PER_LAYER, sub = (ph - 1) % PH_PER_LAYER;
            const bool even = (L & 1) == 0;
            if (even && sub == 6) continue;
            if (!even && sub == 3) continue;
#ifndef MEM_UNFUSED
            if (sub == 9 || sub == 10) continue;
#endif
            float* ssq_in = ssqA;
            if (sub == 0 || sub == 11) {
                unsigned char* HQ = spare + 32 * MiB; float* sa = (float*)(spare + 48 * MiB);
                if (!(L == 0 && sub == 0)) { quant_rows(HB, HQ, sa, gw, NGW, lane); xcd_barrier(bar); }
                pg8::Gemm g{(const pg8::bf16_t*)HQ, (const pg8::bf16_t*)(Wr + (sub == 0 ? W_FFN1_IN : W_FFN2_IN)), S, FF2, DM / 2, DM / 2};
                pg8::StaticOrder So; So.init(S, FF2, G, (int)blockIdx.x);
                pg8::EpiSwiGLU8 E{(pg8::bf16_t*)(BIG + B_U), ssq_in, FF, sa, (const float*)(ws + WS_SB) + (sub == 0 ? 0 : 8192)};
#ifdef PROBE_GEMM8
                pg8::gemm_phase<pg8::EpiSwiGLU8, pg8::StaticOrder, true, true>(lds, g, So, E, tid); __syncthreads();
#endif
                pg8::gemm_phase<pg8::EpiSwiGLU8, pg8::StaticOrder, true, true>(lds, g, So, E, tid);
            } else if (sub == 1 || sub == 7 || sub == 10 || sub == 12) {
                pg8::Gemm g; float scale; int so;
                if (sub == 1)       { g = pg8::Gemm{(const pg8::bf16_t*)(BIG + B_U), (const pg8::bf16_t*)(Wr + W_FFN1_OUT), S, DM, FF, FF}; scale = 0.5f; so = 1; }
                else if (sub == 7)  { g = pg8::Gemm{(const pg8::bf16_t*)(BIG + B_PROJ), (const pg8::bf16_t*)(Wr + W_MIX_OUT), S, DM, DM, even ? EVEN_NP : DM}; scale = 1.0f; so = 2; }
                else if (sub == 10)  { g = pg8::Gemm{(const pg8::bf16_t*)(BIG + B_OM), (const pg8::bf16_t*)(Wr + (L ? W_MEMO2 : W_MEMO)), S, DM, MEMW, MEMW}; scale = 1.0f; so = 3; }
                else                { g = pg8::Gemm{(const pg8::bf16_t*)(BIG + B_U), (const pg8::bf16_t*)(Wr + W_FFN2_OUT), S, DM, FF, FF}; scale = 0.5f; so = 4; }
                const bool last = (sub == 12 && L == NLAYER - 1);
                pg8::StaticOrder So; So.init(S, DM, G, (int)blockIdx.x);
                pg8::EpiResid E{(pg8::bf16_t*)HB, last ? args.out : nullptr, ssqA, scale};
                pg8::gemm_phase<pg8::EpiResid, pg8::StaticOrder, true, true>(lds, g, So, E, tid);
#ifdef PROBE_GEMM2
                if (!last) { __syncthreads(); pg8::EpiResid E0 = E; E0.scale = 0.f;
#ifdef PROBE_GEMM2_ONLYFFN
                    if (sub == 1 || sub == 12)
#endif
                    {
#ifdef PROBE_GEMM2_HALFK
                    g.K = (g.K / 128) * 64;
#endif
                    pg8::gemm_phase<pg8::EpiResid, pg8::StaticOrder, true, true>(lds, g, So, E0, tid); } }
#endif
            } else if (sub == 2) {
                const int N = even ? EVEN_NP : ODD_N;
                pg8::Gemm g{(const pg8::bf16_t*)HB, (const pg8::bf16_t*)(Wr + W_MIX_IN), S, N, DM, DM};
                pg8::EpiProj E;
                E.O = (pg8::bf16_t*)(BIG + B_PROJ); E.ldc = even ? EVEN_NP : DM; E.ssq = ssq_in; E.split_cols = even ? 0 : DM; E.split_stride = (size_t)S * DM; E.even = even ? 1 : 0;
                E.gtab = (const float*)(ws + WS_GT);
                E.cosT = (const float*)(ws + WS_ROPE); E.sinT = E.cosT + S * 8;
                E.Vt = (pg8::bf16_t*)(BIG + (even ? B_VTF : B_VTM)); E.IKf = (pg8::bf16_t*)(BIG + B_IKC);
                E.xch = (LAS float*)(lds + 131072);
                E.ksum = (float*)(ws + WS_KSUM);
                pg8::StaticOrder So; So.init(S, N, G, (int)blockIdx.x);
#ifdef PROBE_MIXIN2
                pg8::gemm_phase<pg8::EpiProj, pg8::StaticOrder, true, true>(lds, g, So, E, tid); __syncthreads();
#endif
                pg8::gemm_phase<pg8::EpiProj, pg8::StaticOrder, true, true>(lds, g, So, E, tid);
#ifndef MEM_UNFUSED
            } else if (sub == 8) {
                memfused_phase(inl, ws, L, ssq_in, args.out, HB, ssqA, lds, G, tid, wave, lane);
                {
                    __syncthreads();
                    if (L == 0) conv_weights(inl, ws, 1, 1 | 2 | 4 | 8 | 16 | 32, lds, gw, NGW, wave, lane);
                    else        conv_weights(inl, ws, 1, 64 | 128, lds, gw, NGW, wave, lane);
                }
#endif
            } else if (sub == 8) {
                if ((int)blockIdx.x >= 64 && G > 64) {
                    const int cw = ((int)blockIdx.x - 64) * NWAVES + wave, ncw = (G - 64) * NWAVES;
                    if (L == 0) conv_weights(inl, ws, 1, 1 | 2 | 4 | 8 | 16 | 32, lds, cw, ncw, wave, lane);
                    else        conv_weights(inl, ws, 1, 64 | 128, lds, cw, ncw, wave, lane);
                    conv_q8_weights(inl, ws, 1, L == 0 ? 1 : 64, lds, (int)blockIdx.x - 64, G - 64, wave, lane);
                }
                pg8::Gemm g{(const pg8::bf16_t*)HB, (const pg8::bf16_t*)(Wr + (L ? W_MEMQ2 : W_MEMQ)), S, MEMW, DM, DM};
                pg8::EpiScale E{(pg8::bf16_t*)(BIG + B_QM), MEMW, ssq_in, 0, 0};
                pg8::StaticOrder So; So.init(S, g.N, G, (int)blockIdx.x);
                pg8::gemm_phase<pg8::EpiScale, pg8::StaticOrder, true, true>(lds, g, So, E, tid);
            } else if (sub == 3) {
                if (even) post_even(inl, ws, HB, ssq_in, lds, G, tid, wave, lane);
                if (L == 0) { __syncthreads(); conv_weights(inl, ws, 0, 8 | 16 | 32 | 64 | 128, lds, gw, NGW, wave, lane); conv_q8_weights(inl, ws, 0, 64, lds, (int)blockIdx.x, G, wave, lane); }
            } else if (sub == 4) {
                if (even) {
                    int nrep = 1;
#ifdef PROBE_DSA2
                    nrep = 2;
#endif
                    asm volatile("" : "+s"(nrep));
#ifdef PROBE_SELHL
                    dsa_select_phase<true, true, true>(ws, lds, G, tid, wave, lane); __syncthreads();
#endif
#ifdef PROBE_SELNI
                    dsa_select_phase<true, true>(ws, lds, G, tid, wave, lane); __syncthreads();
#endif
#ifdef PROBE_SELL1
                    { int jm0 = 0; asm volatile("" : "+s"(jm0)); dsa_select_phase<true>(ws, lds, G, tid, wave, lane, jm0); __syncthreads(); }
#endif
#ifdef PROBE_SELNC
                    dsa_select_phase<true>(ws, lds, G, tid, wave, lane); __syncthreads();
#endif
                    dsa_quant_phase(inl, ws, spare, G, wave, lane);
                    for (int rep = 0; rep < nrep; ++rep) { dsa_select_phase<false>(ws, lds, G, tid, wave, lane); __syncthreads(); }
                } else {
                    moba_gate_phase(ws, G, wave, lane);
                }
            } else if (sub == 5) {
                if (even) {
                    bf16* projb = (bf16*)(BIG + B_PROJ);
#ifdef PROBE_FOX2
                    fox_phase(inl, ws, lds, G, tid, wave, lane, (bf16*)(spare + 32 * MiB), 512, CW_FOXQ + 64); __syncthreads();
#endif
#ifdef PROBE_SPARSE2
                    dsa_sparse_phase(inl, ws, spare, G, wave, lane, (bf16*)(spare + 48 * MiB), 512);
#endif
                    fox_phase(inl, ws, lds, G, tid, wave, lane, projb + EC_FQ, EVEN_NP, CW_FOXQ);
                    dsa_sparse_phase(inl, ws, spare, G, wave, lane, projb + EC_DQ, EVEN_NP);
                } else {
#ifdef PROBE_MOBA2
#ifdef PROBE_MOBA_NOTILES
                    { int nt_ = 1; asm volatile("" : "+s"(nt_)); moba_route_phase(ws, spare, lds, G, tid, wave, lane, CW_MOBAQ + 64, nt_); __syncthreads(); }
#else
                    moba_route_phase(ws, spare, lds, G, tid, wave, lane, CW_MOBAQ + 64); __syncthreads();
#endif
#endif
                    moba_route_phase(ws, spare, lds, G, tid, wave, lane, CW_MOBAQ);
                }
            } else if (sub == 6) {
#ifdef PROBE_OWN2
                if (!even) { moba_own_phase(ws, spare, lds, G, tid, wave, lane, (bf16*)(BIG + 160 * MiB), 0); __syncthreads(); }
#endif
                if (!even) moba_own_phase(ws, spare, lds, G, tid, wave, lane, (bf16*)(BIG + B_PROJ), DM);
            } else if (sub == 9) {
#ifdef PROBE_MEM2
                memattn_phase(inl, ws, L, lds, G, tid, wave, lane); __syncthreads();
#endif
                memattn_phase(inl, ws, L, lds, G, tid, wave, lane);
            }
        }
        if (ph + 1 < args.ph_hi) xcd_barrier(bar);
#ifdef PROBE_BAR2
        if (ph + 1 < args.ph_hi) xcd_barrier(bar);
#endif
    }
}

#ifndef MK_N_LAUNCHES
#define MK_N_LAUNCHES 1
#endif
extern "C" void kernel_launch(void* const* d_in, const int* in_sizes, int n_in, void* d_out, int out_size, void* d_ws, size_t ws_size, hipStream_t stream) {
    static int grid = 0;
    if (grid == 0) {
        if (n_in != 26 || in_sizes[0] != S * DM || out_size != S * DM || ws_size < WS_END) {
            fprintf(stderr, "kernel_launch: unexpected problem (n_in %d, in0 %d, out %d, ws %zu); nothing launched\n", n_in, n_in > 0 ? in_sizes[0] : -1, out_size, ws_size); grid = -1; return; }
        int dev = 0, cus = 0, per_cu = 0;
        if (hipGetDevice(&dev) != hipSuccess || hipDeviceGetAttribute(&cus, hipDeviceAttributeMultiprocessorCount, dev) != hipSuccess) { grid = -1; return; }
        if (hipFuncSetAttribute((const void*)hyb_fwd, hipFuncAttributeMaxDynamicSharedMemorySize, LDS_BYTES) != hipSuccess) { fprintf(stderr, "kernel_launch: hipFuncSetAttribute failed\n"); grid = -1; return; }
        if (hipOccupancyMaxActiveBlocksPerMultiprocessor(&per_cu, (const void*)hyb_fwd, NTHREADS, LDS_BYTES) != hipSuccess || per_cu < 1)
            fprintf(stderr, "kernel_launch: note: occupancy query reports %d workgroups per CU\n", per_cu);
        (void)hipGetLastError();
        grid = cus;
    }
    if (grid < 0) return;
    if (hipMemsetAsync((char*)d_ws + WS_CTL, 0, CTL_ZERO_BYTES, stream) != hipSuccess) { fprintf(stderr, "kernel_launch: hipMemsetAsync failed\n"); return; }
    Args a{};
    for (int i = 0; i < 26; ++i) a.in.p[i] = (const float*)d_in[i];
    a.out = (float*)d_out; a.ws = (unsigned char*)d_ws;
#if MK_N_LAUNCHES == 1
    a.ph_lo = 0; a.ph_hi = N_PHASES; a.li = 0;
    hipLaunchKernelGGL(hyb_fwd, dim3(grid), dim3(NTHREADS), LDS_BYTES, stream, a);
#else
    for (int ph = 0; ph < N_PHASES; ++ph) { a.ph_lo = ph; a.ph_hi = ph + 1; a.li = 0; hipLaunchKernelGGL(hyb_fwd, dim3(grid), dim3(NTHREADS), LDS_BYTES, stream, a); }
#endif
    const hipError_t le = hipPeekAtLastError();
    if (le != hipSuccess) fprintf(stderr, "kernel_launch: launch failed: %s\n", hipGetErrorName(le));
}
```
